# Optimizing an MI355X kernel written in HIP

```python
import math
import jax, jax.numpy as jnp
from jax import lax
import numpy as np

D_MODEL = 1024
BATCH = 8
SEQ = 4096
DEPTH = 1

CHUNK = 64
N_MEM = 256
D_MIX = D_MODEL
CONV_CH = D_MIX // 2
SB_HEADS = 8
SB_HEAD_DIM = (D_MIX - CONV_CH) // SB_HEADS
SB_WIDTH = SB_HEADS * SB_HEAD_DIM
CONV_WIDTH = 31
Q_BLOCK = 128
MEM_HEADS = 4
MEM_HEAD_DIM = D_MODEL // MEM_HEADS
N_EXPERTS = 32
TOP_K = 4
D_FF = D_MODEL
SWIGLU_LIMIT = 7.0
SWIGLU_ALPHA = 1.702
EXPERT_BLOCK = 256
LN_EPS = 1e-5
DEEPNORM_ALPHA = (2.0 * DEPTH) ** 0.25
DEEPNORM_BETA = (8.0 * DEPTH) ** -0.25
IN_COLS = 2 * CONV_CH + 3 * SB_WIDTH

kernel_name = 'hybrid_conv_stickbreak_mem_moe_deepnorm'


def layer_norm(x, g, b):
    xf = x.astype(jnp.float32)
    mu = xf.mean(-1, keepdims=True)
    var = jnp.square(xf - mu).mean(-1, keepdims=True)
    y = (xf - mu) * lax.rsqrt(var + LN_EPS) * g.astype(jnp.float32) + b.astype(jnp.float32)
    return y.astype(x.dtype)


def conformer_conv(a, gate, w_dw, b_dw, g, b):
    u = a * jax.nn.sigmoid(gate)
    u = lax.conv_general_dilated(
        u, w_dw[:, None, :], window_strides=(1,), padding=[(CONV_WIDTH - 1, 0)],
        dimension_numbers=('NWC', 'WIO', 'NWC'), feature_group_count=CONV_CH) + b_dw
    return jax.nn.silu(layer_norm(u, g, b))


def stick_breaking_attention(q, k, v):
    T = q.shape[1]
    scale = SB_HEAD_DIM ** -0.5
    outs = []
    for q0 in range(0, T, Q_BLOCK):
        L = q0 + Q_BLOCK
        z = jnp.einsum('bqhd,bkhd->bhqk', q[:, q0:L], k[:, :L]).astype(jnp.float32) * scale
        t_idx = q0 + jnp.arange(Q_BLOCK)[:, None]
        s_idx = jnp.arange(L)[None, :]
        before = s_idx < t_idx
        log_beta = jax.nn.log_sigmoid(z)
        log_rem = jnp.where(before, jax.nn.log_sigmoid(-z), 0.0)
        between = lax.cumsum(log_rem, axis=3, reverse=True) - log_rem
        w = jnp.where(before, jnp.exp(log_beta + between), 0.0)
        outs.append(jnp.einsum('bhqk,bkhd->bqhd', w.astype(v.dtype), v[:, :L]))
    return jnp.concatenate(outs, axis=1)


def memory_cross_attention(h, mem_n, wq, wk, wv, wo):
    B, T, _ = h.shape
    M = mem_n.shape[1]
    q = (h @ wq).reshape(B, T, MEM_HEADS, MEM_HEAD_DIM)
    k = (mem_n @ wk).reshape(B, M, MEM_HEADS, MEM_HEAD_DIM)
    v = (mem_n @ wv).reshape(B, M, MEM_HEADS, MEM_HEAD_DIM)
    s = jnp.einsum('bqhd,bkhd->bhqk', q, k).astype(jnp.float32) * (MEM_HEAD_DIM ** -0.5)
    p = jax.nn.softmax(s, axis=-1).astype(v.dtype)
    o = jnp.einsum('bhqk,bkhd->bqhd', p, v).reshape(B, T, D_MODEL)
    return o @ wo


def routed_experts(h, w_router, b_router, w_gu, b_gu, w_down, b_down):
    B, T, D = h.shape
    xf = h.reshape(-1, D)
    n_tok = xf.shape[0]
    logits = (xf @ w_router + b_router).astype(jnp.float32)
    top_val, top_idx = lax.top_k(logits, TOP_K)
    gates = jax.nn.softmax(top_val, axis=-1)
    n_assign = n_tok * TOP_K
    e_flat = top_idx.reshape(-1).astype(jnp.int32)
    tok_flat = jnp.arange(n_assign, dtype=jnp.int32) // TOP_K
    g_flat = gates.reshape(-1)
    order = jnp.argsort(e_flat)
    e_sorted = e_flat[order]
    counts = jnp.bincount(e_flat, length=N_EXPERTS).astype(jnp.int32)
    padded = (counts + EXPERT_BLOCK - 1) // EXPERT_BLOCK * EXPERT_BLOCK
    start = jnp.cumsum(counts) - counts
    padded_end = jnp.cumsum(padded)
    padded_start = padded_end - padded
    rank = jnp.arange(n_assign, dtype=jnp.int32) - start[e_sorted]
    dest = padded_start[e_sorted] + rank
    n_slots = -(-n_assign // EXPERT_BLOCK) * EXPERT_BLOCK + N_EXPERTS * EXPERT_BLOCK
    n_blocks = n_slots // EXPERT_BLOCK
    slot_tok = jnp.zeros((n_slots,), jnp.int32).at[dest].set(tok_flat[order])
    slot_gate = jnp.zeros((n_slots,), jnp.float32).at[dest].set(g_flat[order])
    block_start = jnp.arange(n_blocks, dtype=jnp.int32) * EXPERT_BLOCK
    block_expert = jnp.minimum(jnp.searchsorted(padded_end, block_start, side='right'),
                               N_EXPERTS - 1).astype(jnp.int32)

    def expert_block(args):
        tok, gate, e = args
        xb = xf[tok]
        gu = xb @ w_gu[e] + b_gu[e]
        g_ = jnp.minimum(gu[:, :D_FF], SWIGLU_LIMIT)
        u_ = jnp.clip(gu[:, D_FF:], -SWIGLU_LIMIT, SWIGLU_LIMIT)
        act = (u_ + 1.0) * g_ * jax.nn.sigmoid(SWIGLU_ALPHA * g_)
        y = act @ w_down[e] + b_down[e]
        return y * gate[:, None].astype(y.dtype)

    ys = lax.map(expert_block, (slot_tok.reshape(n_blocks, EXPERT_BLOCK),
                                slot_gate.reshape(n_blocks, EXPERT_BLOCK), block_expert))
    out = jnp.zeros((n_tok, D), jnp.float32).at[slot_tok].add(
        ys.reshape(n_slots, D).astype(jnp.float32))
    return out.astype(h.dtype).reshape(B, T, D)


def setup_inputs(seed: int = 0) -> dict:
    key = jax.random.key(seed)
    ks = jax.random.split(key, 32)
    f32 = jnp.float32

    def nrm(k, shape, scale):
        return jax.random.normal(k, shape, f32) * scale

    def gain(k, shape):
        return 1.0 + 0.02 * jax.random.normal(k, shape, f32)

    def bias(k, shape):
        return 0.02 * jax.random.normal(k, shape, f32)

    Lr = DEPTH
    return {
        'x': jax.random.normal(ks[0], (BATCH, SEQ, D_MODEL), f32),
        'mem': jax.random.normal(ks[1], (BATCH, N_MEM, D_MODEL), f32),
        'ln_in_g': gain(ks[2], (D_MODEL,)),
        'ln_in_b': bias(ks[3], (D_MODEL,)),
        'ln_mem_g': gain(ks[4], (D_MODEL,)),
        'ln_mem_b': bias(ks[5], (D_MODEL,)),
        'w_in': nrm(ks[6], (Lr, D_MODEL, IN_COLS), D_MODEL ** -0.5),
        'b_in': bias(ks[7], (Lr, IN_COLS)),
        'w_dw': nrm(ks[8], (Lr, CONV_WIDTH, CONV_CH), CONV_WIDTH ** -0.5),
        'b_dw': bias(ks[9], (Lr, CONV_CH)),
        'ln_conv_g': gain(ks[10], (Lr, CONV_CH)),
        'ln_conv_b': bias(ks[11], (Lr, CONV_CH)),
        'w_out': nrm(ks[12], (Lr, D_MIX, D_MODEL), D_MIX ** -0.5 * DEEPNORM_BETA),
        'b_out': bias(ks[13], (Lr, D_MODEL)),
        'ln1_g': gain(ks[14], (Lr, D_MODEL)),
        'ln1_b': bias(ks[15], (Lr, D_MODEL)),
        'w_q_mem': nrm(ks[16], (Lr, D_MODEL, D_MODEL), D_MODEL ** -0.5),
        'w_k_mem': nrm(ks[17], (Lr, D_MODEL, D_MODEL), D_MODEL ** -0.5),
        'w_v_mem': nrm(ks[18], (Lr, D_MODEL, D_MODEL), D_MODEL ** -0.5),
        'w_o_mem': nrm(ks[19], (Lr, D_MODEL, D_MODEL), D_MODEL ** -0.5 * DEEPNORM_BETA),
        'ln2_g': gain(ks[20], (Lr, D_MODEL)),
        'ln2_b': bias(ks[21], (Lr, D_MODEL)),
        'w_router': nrm(ks[22], (Lr, D_MODEL, N_EXPERTS), D_MODEL ** -0.5),
        'b_router': nrm(ks[23], (Lr, N_EXPERTS), 0.01),
        'w_gu': nrm(ks[24], (Lr, N_EXPERTS, D_MODEL, 2 * D_FF), D_MODEL ** -0.5),
        'b_gu': bias(ks[25], (Lr, N_EXPERTS, 2 * D_FF)),
        'w_down': nrm(ks[26], (Lr, N_EXPERTS, D_FF, D_MODEL), D_FF ** -0.5 * DEEPNORM_BETA),
        'b_down': bias(ks[27], (Lr, N_EXPERTS, D_MODEL)),
        'ln3_g': gain(ks[28], (Lr, D_MODEL)),
        'ln3_b': bias(ks[29], (Lr, D_MODEL)),
    }


def reference(x, mem, ln_in_g, ln_in_b, ln_mem_g, ln_mem_b, w_in, b_in, w_dw, b_dw,
              ln_conv_g, ln_conv_b, w_out, b_out, ln1_g, ln1_b, w_q_mem, w_k_mem, w_v_mem,
              w_o_mem, ln2_g, ln2_b, w_router, b_router, w_gu, b_gu, w_down, b_down,
              ln3_g, ln3_b):
    B, T, _ = x.shape
    h = layer_norm(x, ln_in_g, ln_in_b)
    mem_n = layer_norm(mem, ln_mem_g, ln_mem_b)
    splits = [CONV_CH, 2 * CONV_CH, 2 * CONV_CH + SB_WIDTH, 2 * CONV_CH + 2 * SB_WIDTH]
    for l in range(DEPTH):
        proj = h @ w_in[l] + b_in[l]
        c_val, c_gate, q, k, v = jnp.split(proj, splits, axis=-1)
        conv_out = conformer_conv(c_val, c_gate, w_dw[l], b_dw[l], ln_conv_g[l], ln_conv_b[l])
        sb_out = stick_breaking_attention(
            q.reshape(B, T, SB_HEADS, SB_HEAD_DIM),
            k.reshape(B, T, SB_HEADS, SB_HEAD_DIM),
            v.reshape(B, T, SB_HEADS, SB_HEAD_DIM)).reshape(B, T, SB_WIDTH)
        mix = jnp.concatenate([conv_out, sb_out], axis=-1) @ w_out[l] + b_out[l]
        h = layer_norm(DEEPNORM_ALPHA * h + mix, ln1_g[l], ln1_b[l])
        ca = memory_cross_attention(h, mem_n, w_q_mem[l], w_k_mem[l], w_v_mem[l], w_o_mem[l])
        h = layer_norm(DEEPNORM_ALPHA * h + ca, ln2_g[l], ln2_b[l])
        moe = routed_experts(h, w_router[l], b_router[l], w_gu[l], b_gu[l], w_down[l], b_down[l])
        h = layer_norm(DEEPNORM_ALPHA * h + moe, ln3_g[l], ln3_b[l])
    return h
```

```cpp
#include <hip/hip_runtime.h>
#include <cstdio>
#include <cstdint>

#ifndef MK_N_LAUNCHES
#define MK_N_LAUNCHES 1
#endif

#define GAS __attribute__((address_space(1)))
#define LAS __attribute__((address_space(3)))
typedef unsigned short bf16;
typedef short bf16x8 __attribute__((ext_vector_type(8)));
typedef float f32x4 __attribute__((ext_vector_type(4)));
typedef float f32x2 __attribute__((ext_vector_type(2)));
typedef unsigned u32x4 __attribute__((ext_vector_type(4)));
typedef unsigned u32x2 __attribute__((ext_vector_type(2)));
typedef GAS unsigned gu32;
#define RLX_AGENT __ATOMIC_RELAXED, __HIP_MEMORY_SCOPE_AGENT
#define LDS_WAIT() asm volatile("s_waitcnt lgkmcnt(0)" ::: "memory")
#define VM_WAIT() asm volatile("s_waitcnt vmcnt(0)" ::: "memory")

constexpr int NB = 8, T_ = 4096, D = 1024, M = NB * T_, NMEM = 256, MM = NB * NMEM;
constexpr int CONV_CH = 512, SBH = 8, SBD = 64, SBW = 512, CWID = 31, NE = 32, TOPK = 4, DFF = 1024;
constexpr int INC = 2560;
constexpr float LN_EPS = 1e-5f;
constexpr float DN_ALPHA = 1.189207115002721f;
constexpr float LOG2E = 1.4426950408889634f;
constexpr float SB_QSCALE = 0.125f * LOG2E;
constexpr float MEM_QSCALE = 0.0625f * LOG2E;
constexpr int NBLK_MAX = M * TOPK / 256 + NE;
constexpr int LCAP = M;

constexpr size_t MiB = 1u << 20;
constexpr size_t WS_CTL = 0, CTL_ZERO_BYTES = 1 * MiB;
constexpr size_t WS_WIN_T = 1 * MiB;
constexpr size_t WS_WOUT_T = 6 * MiB;
constexpr size_t WS_WQ_T = 8 * MiB, WS_WK_T = 10 * MiB, WS_WV_T = 12 * MiB, WS_WO_T = 14 * MiB;
constexpr size_t WS_WGU_T = 16 * MiB;
constexpr size_t WS_WDN_T = 144 * MiB;
constexpr size_t WS_HB = 208 * MiB;
constexpr size_t WS_LTOK = 272 * MiB;
constexpr size_t WS_LGATE = 276 * MiB;
constexpr size_t WS_SIDX = 280 * MiB;
constexpr size_t WS_X = 288 * MiB;
constexpr size_t WS_U = WS_X;
constexpr size_t WS_Q = WS_X + 32 * MiB;
constexpr size_t WS_K = WS_X + 64 * MiB;
constexpr size_t WS_V = WS_X + 96 * MiB;
constexpr size_t WS_MIXIN = WS_X + 128 * MiB;
constexpr size_t WS_QM = WS_X + 192 * MiB;
constexpr size_t WS_SP = WS_X + 256 * MiB;
constexpr size_t WS_OB = WS_X + 320 * MiB;
constexpr size_t WS_MEMN = WS_X + 384 * MiB;
constexpr size_t WS_KM = WS_X + 388 * MiB;
constexpr size_t WS_VMT = WS_X + 392 * MiB;
constexpr size_t WS_ACT = WS_X;
constexpr size_t WS_YS = WS_X + 272 * MiB;
constexpr size_t WS_END = WS_X + 544 * MiB;
constexpr int CW_TMO = 0, CW_CODE = 1;
constexpr int CW_BAR = 4096;
constexpr int CW_ECNT = 131072;
constexpr int NPHASE = 14;

constexpr int RING_OFF = 0, RING_BYTES = 131072;
constexpr int LDSCTL_OFF = RING_BYTES, MISC_OFF = LDSCTL_OFF + 320;
constexpr int XTRA_OFF = LDSCTL_OFF + 1024;
constexpr int LDS_BYTES = 147456;
constexpr int NWAVES = 8;

__device__ __forceinline__ unsigned f2bf(float f) { unsigned u = __builtin_bit_cast(unsigned, f); return (u + 0x7fffu + ((u >> 16) & 1u)) >> 16; }
__device__ __forceinline__ unsigned pk2(float lo, float hi) { return f2bf(lo) | (f2bf(hi) << 16); }
__device__ __forceinline__ float bflo(unsigned u) { return __builtin_bit_cast(float, u << 16); }
__device__ __forceinline__ float bfhi(unsigned u) { return __builtin_bit_cast(float, u & 0xffff0000u); }
__device__ __forceinline__ float wave_sum(float v) {
#pragma unroll
    for (int o = 1; o < 64; o <<= 1) v += __shfl_xor(v, o);
    return v;
}
__device__ __forceinline__ float wave_max(float v) {
#pragma unroll
    for (int o = 1; o < 64; o <<= 1) v = fmaxf(v, __shfl_xor(v, o));
    return v;
}
__device__ __forceinline__ float sigmoidf_fast(float x) { return __builtin_amdgcn_rcpf(1.0f + __expf(-x)); }

namespace pg8 {
constexpr int BM = 256, BK = 64, HALF = 128, HTB = HALF * BK * 2, STAGE_BYTES = 8 * HTB, NXCD = 8, WGM = 8;
__host__ __device__ __forceinline__ int lds_byte(int r, int c) { const int st = (r >> 4) * 2 + (c >> 5), rr = r & 15, cc = c & 31, ob = rr * 64 + cc * 2; return st * 1024 + (ob ^ (((ob >> 9) & 1) << 5)); }
__host__ __device__ __forceinline__ void stage_rc(int b, int& R, int& C) { const int st = b / 1024, sb = b % 1024, swz = sb ^ (((sb >> 9) & 1) << 5); R = (st >> 1) * 16 + swz / 64; C = (st & 1) * 32 + (swz % 64) / 2; }
__host__ __device__ __forceinline__ int perm32(int rho) { const int n = rho >> 4, i = rho & 15; return 8 * (i >> 2) + 4 * n + (i & 3); }

struct Unit { int pm, pn, z, nvalid; unsigned aoff, boff, goff; };

__device__ __forceinline__ void tile_order(int L, int nM, int nN, int& pm, int& pn) {
    const int nwg = nM * nN; int wgid = L;
    { const int q = nwg / NXCD, r = nwg % NXCD, xcd = wgid % NXCD, off = wgid / NXCD; wgid = (xcd < r ? xcd * (q + 1) : r * (q + 1) + (xcd - r) * q) + off; }
    const int nig = WGM * nN, gid = wgid / nig, fm = gid * WGM, gsz = (nM - fm) < WGM ? (nM - fm) : WGM;
    pm = fm + ((wgid % nig) % gsz); pn = (wgid % nig) / gsz;
}
__device__ __forceinline__ unsigned cvt_pk_bf16(float lo, float hi) { unsigned r; asm volatile("v_cvt_pk_bf16_f32 %0, %1, %2" : "=v"(r) : "v"(lo), "v"(hi)); return r; }

__device__ __forceinline__ void store_tile_bf16(const f32x4 (&acc)[2][2][4][2], bf16* p0, size_t ldc, const float* bias, float scale, int wc, int fq) {
    const int cl = wc * 32 + 8 * fq;
    f32x4 bv[2][2];
#pragma unroll
    for (int bj = 0; bj < 2; ++bj)
#pragma unroll
        for (int n = 0; n < 2; ++n) bv[bj][n] = bias ? *(const f32x4*)(bias + cl + bj * HALF + 4 * n) : (f32x4){0.f, 0.f, 0.f, 0.f};
#pragma unroll
    for (int ai = 0; ai < 2; ++ai)
#pragma unroll
        for (int m = 0; m < 4; ++m) { bf16* rowp = p0 + (size_t)(ai * HALF + m * 16) * ldc + cl;
#pragma unroll
            for (int bj = 0; bj < 2; ++bj) { const f32x4 v0 = (acc[ai][bj][m][0] + bv[bj][0]) * scale, v1 = (acc[ai][bj][m][1] + bv[bj][1]) * scale;
                u32x4 w; w.x = cvt_pk_bf16(v0[0], v0[1]); w.y = cvt_pk_bf16(v0[2], v0[3]); w.z = cvt_pk_bf16(v1[0], v1[1]); w.w = cvt_pk_bf16(v1[2], v1[3]);
                *(u32x4*)(rowp + bj * HALF) = w; } }
}

template <class Epi, class Sched, bool GATHER>
__device__ __forceinline__ void gemm_phase(LAS unsigned char* lds, const char* wsb, const int lda, const int ldb, const int K, const Sched& S, const Epi& E, const int* glist) {
    const int tid = threadIdx.x, wid = __builtin_amdgcn_readfirstlane(tid >> 6), lane = tid & 63, wr = wid >> 2, wc = wid & 3, fr = lane & 15, fq = lane >> 4;
    const int nt = K / BK;
    unsigned voffA[2], voffB[2]; int Rr[2], Cc[2];
#pragma unroll
    for (int i = 0; i < 2; ++i) { int R, C; stage_rc(tid * 16 + i * 8192, R, C); const int Rb = Epi::PERM ? ((R & ~31) + perm32(R & 31)) : R;
        voffA[i] = (unsigned)(R * lda + C) * 2u; voffB[i] = (unsigned)(Rb * ldb + C) * 2u; Rr[i] = R; Cc[i] = C; }
    const size_t kstep = (size_t)(BK * 2);
    const size_t hstepA = (size_t)HALF * lda * 2, hstepB = (size_t)HALF * ldb * 2;
    const unsigned ldsw = (unsigned)wid * 1024u;
    const int aoff = lds_byte(wr * 64 + fr, fq * 8), boff = lds_byte(wc * 32 + fr, fq * 8);
    unsigned gc[2][2], gn[2][2];
#define PG8_SA(b, h) (((b) * 2 + (h)) * HTB)
#define PG8_SB(b, h) ((4 + (b) * 2 + (h)) * HTB)
#define PG8_STAGE_B(bufoff, gbase) do { _Pragma("unroll") for (int _i = 0; _i < 2; ++_i) \
        __builtin_amdgcn_global_load_lds((const unsigned*)((const char*)(gbase) + voffB[_i]), (LAS unsigned*)(lds + (bufoff) + ldsw + _i * 8192), 16, 0, 0); } while (0)
#define PG8_STAGE_A(bufoff, gbase, h, nx) do { _Pragma("unroll") for (int _i = 0; _i < 2; ++_i) { \
        const char* _p = GATHER ? (const char*)(gbase) + ((nx) ? gn[h][_i] : gc[h][_i]) : (const char*)(gbase) + (h) * hstepA + voffA[_i]; \
        __builtin_amdgcn_global_load_lds((const unsigned*)_p, (LAS unsigned*)(lds + (bufoff) + ldsw + _i * 8192), 16, 0, 0); } } while (0)
#define PG8_LDA(dst, b, h) do { _Pragma("unroll") for (int m = 0; m < 4; ++m) _Pragma("unroll") for (int k = 0; k < 2; ++k) dst[m][k] = *(const LAS bf16x8*)(lds + PG8_SA(b, h) + aoff + m * 2048 + k * 1024); } while (0)
#define PG8_LDB(dst, b, h) do { _Pragma("unroll") for (int n = 0; n < 2; ++n) _Pragma("unroll") for (int k = 0; k < 2; ++k) dst[n][k] = *(const LAS bf16x8*)(lds + PG8_SB(b, h) + boff + n * 2048 + k * 1024); } while (0)
#define PG8_MMA(ai, bj, At, Bt) do { __builtin_amdgcn_s_setprio(1); _Pragma("unroll") for (int m = 0; m < 4; ++m) _Pragma("unroll") for (int n = 0; n < 2; ++n) _Pragma("unroll") for (int k = 0; k < 2; ++k) \
        acc[ai][bj][m][n] = __builtin_amdgcn_mfma_f32_16x16x32_bf16(Bt[n][k], At[m][k], acc[ai][bj][m][n], 0, 0, 0); __builtin_amdgcn_s_setprio(0); } while (0)
#define PG8_WAIT_V(n) asm volatile("s_waitcnt vmcnt(" #n ")" ::: "memory")
#define PG8_WAIT_L(n) asm volatile("s_waitcnt lgkmcnt(" #n ")" ::: "memory")
#define PG8_BAR __builtin_amdgcn_s_barrier()
#define PG8_SCHED __builtin_amdgcn_sched_barrier(0)
#define PG8_GIDX(g, u) do { _Pragma("unroll") for (int _h = 0; _h < 2; ++_h) _Pragma("unroll") for (int _i = 0; _i < 2; ++_i) { const int _r = _h * HALF + Rr[_i]; \
        const int _tok = glist[(u).goff + (_r < (u).nvalid ? _r : (u).nvalid - 1)]; g[_h][_i] = (unsigned)_tok * (unsigned)(lda * 2) + (unsigned)(Cc[_i] * 2); } } while (0)
    Unit cur, nxt, nn; int ui = 0;
    if (!S.next(0, cur)) return;
    f32x4 acc[2][2][4][2];
#pragma unroll
    for (int a = 0; a < 2; ++a)
#pragma unroll
        for (int b = 0; b < 2; ++b)
#pragma unroll
            for (int m = 0; m < 4; ++m)
#pragma unroll
                for (int n = 0; n < 2; ++n) acc[a][b][m][n] = (f32x4){0.f, 0.f, 0.f, 0.f};
    bf16x8 At[4][2], B0[2][2], B1[2][2];
    const char* cA = wsb + cur.aoff; const char* cB = wsb + cur.boff;
    if constexpr (GATHER) { PG8_GIDX(gc, cur); if (S.next(1, nxt)) { PG8_GIDX(gn, nxt); } else { PG8_GIDX(gn, cur); }
        asm volatile("s_waitcnt vmcnt(0)" : "+v"(gc[0][0]), "+v"(gc[0][1]), "+v"(gc[1][0]), "+v"(gc[1][1]), "+v"(gn[0][0]), "+v"(gn[0][1]), "+v"(gn[1][0]), "+v"(gn[1][1]) :: "memory"); }
    else {
#pragma unroll
        for (int h = 0; h < 2; ++h)
#pragma unroll
            for (int i = 0; i < 2; ++i) { gc[h][i] = 0u; gn[h][i] = 0u; } }
    PG8_STAGE_B(PG8_SB(0, 0), cB); PG8_STAGE_B(PG8_SB(0, 1), cB + hstepB); PG8_STAGE_A(PG8_SA(0, 0), cA, 0, false); PG8_STAGE_A(PG8_SA(0, 1), cA, 1, false);
    if (wr == 1) PG8_BAR;
    PG8_WAIT_V(2); PG8_BAR;
    PG8_STAGE_B(PG8_SB(1, 0), cB + kstep); PG8_STAGE_A(PG8_SA(1, 0), cA + kstep, 0, false); PG8_STAGE_B(PG8_SB(1, 1), cB + hstepB + kstep);
    PG8_WAIT_V(6); PG8_BAR;
    for (;;) {
        const bool has_next = S.next(ui + 1, nxt);
        const char* nA = has_next ? wsb + nxt.aoff : cA; const char* nB = has_next ? wsb + nxt.boff : cB;
#pragma clang loop unroll(disable)
        for (int t = 0; t < nt; t += 2) {
            const bool last = (t == nt - 2);
            const char* a1 = cA + (size_t)(t + 1) * kstep;
            const char* a2 = last ? nA : cA + (size_t)(t + 2) * kstep; const char* b2 = last ? nB : cB + (size_t)(t + 2) * kstep;
            const char* a3 = a2 + kstep; const char* b3 = b2 + kstep;
            PG8_LDB(B0, 0, 0); PG8_LDB(B1, 0, 1); PG8_SCHED; PG8_LDA(At, 0, 0); PG8_STAGE_A(PG8_SA(1, 1), a1, 1, false);
            PG8_WAIT_V(8); PG8_WAIT_L(0); PG8_BAR; PG8_MMA(0, 0, At, B0); PG8_MMA(0, 1, At, B1); PG8_BAR; PG8_SCHED;
            PG8_LDA(At, 0, 1); PG8_STAGE_B(PG8_SB(0, 0), b2); PG8_STAGE_B(PG8_SB(0, 1), b2 + hstepB); PG8_STAGE_A(PG8_SA(0, 0), a2, 0, last);
            PG8_WAIT_V(8); PG8_WAIT_L(0); PG8_BAR; PG8_MMA(1, 0, At, B0); PG8_MMA(1, 1, At, B1); PG8_BAR; PG8_SCHED;
            PG8_LDB(B0, 1, 0); PG8_LDB(B1, 1, 1); PG8_SCHED; PG8_LDA(At, 1, 0); PG8_STAGE_A(PG8_SA(0, 1), a2, 1, last);
            PG8_WAIT_V(8); PG8_WAIT_L(0); PG8_BAR; PG8_MMA(0, 0, At, B0); PG8_MMA(0, 1, At, B1); PG8_BAR; PG8_SCHED;
            PG8_LDA(At, 1, 1); PG8_STAGE_B(PG8_SB(1, 0), b3); PG8_STAGE_B(PG8_SB(1, 1), b3 + hstepB); PG8_STAGE_A(PG8_SA(1, 0), a3, 0, last);
            PG8_WAIT_V(8); PG8_WAIT_L(0); PG8_BAR; PG8_MMA(1, 0, At, B0); PG8_MMA(1, 1, At, B1); PG8_BAR; PG8_SCHED;
        }
        if (wr == 0) PG8_BAR;
        if constexpr (GATHER) {
#pragma unroll
            for (int h = 0; h < 2; ++h)
#pragma unroll
                for (int i = 0; i < 2; ++i) gc[h][i] = gn[h][i];
            if (has_next && S.next(ui + 2, nn)) { PG8_GIDX(gn, nn); }
        }
        E(acc, cur, wr, wc, fr, fq);
        if constexpr (GATHER) asm volatile("" : "+v"(gn[0][0]), "+v"(gn[0][1]), "+v"(gn[1][0]), "+v"(gn[1][1]));
        if (!has_next) break;
#pragma unroll
        for (int a = 0; a < 2; ++a)
#pragma unroll
            for (int b = 0; b < 2; ++b)
#pragma unroll
                for (int m = 0; m < 4; ++m)
#pragma unroll
                    for (int n = 0; n < 2; ++n) acc[a][b][m][n] = (f32x4){0.f, 0.f, 0.f, 0.f};
        cur = nxt; cA = nA; cB = nB; ++ui;
        if (wr == 1) PG8_BAR;
    }
    PG8_WAIT_V(0);
    PG8_BAR;
#undef PG8_SA
#undef PG8_SB
#undef PG8_STAGE_A
#undef PG8_STAGE_B
#undef PG8_LDA
#undef PG8_LDB
#undef PG8_MMA
#undef PG8_WAIT_V
#undef PG8_WAIT_L
#undef PG8_BAR
#undef PG8_SCHED
#undef PG8_GIDX
}
}
using pg8::Unit;

#define XB_TMO      128
#define XB_XCNT(j)  (256  + 64 * (j))
#define XB_XSUB(j)  (1280 + 64 * (j))
#define XB_XGEN(j)  (2304 + 64 * (j))
#define XB_TOP      3328
#define XB_TOPGEN   3392
#define XCD_BAR_WORDS 3456
#define XB_SPIN_CAP (1u << 18)
__device__ __forceinline__ unsigned xb_ld(unsigned* p)              { return __hip_atomic_load(p, __ATOMIC_RELAXED, __HIP_MEMORY_SCOPE_AGENT); }
__device__ __forceinline__ unsigned xb_add(unsigned* p, unsigned v) { return __hip_atomic_fetch_add(p, v, __ATOMIC_RELAXED, __HIP_MEMORY_SCOPE_AGENT); }
__device__ __forceinline__ unsigned xb_xcc_id() { return (unsigned)__builtin_amdgcn_s_getreg((3 << 11) | 20) & 0xFu; }
#define XB_SPIN(cond, bar) do { unsigned _sp = 0; while (cond) { __builtin_amdgcn_s_sleep(1); \
    if ((++_sp & 255u) == 0u) { if (xb_ld(&(bar)[XB_TMO])) break; if (_sp > XB_SPIN_CAP) { atomicAdd(&(bar)[XB_TMO], 1u); break; } } } } while (0)
struct XcdBarrier { unsigned* bar; unsigned x; volatile LAS unsigned* st; };
__device__ __forceinline__ XcdBarrier xcd_barrier_post(unsigned* bar, volatile LAS unsigned* st) {
    XcdBarrier b; b.bar = bar; b.x = xb_xcc_id(); b.st = st;
    if (threadIdx.x == 0) (void)xb_add(&bar[XB_XCNT(b.x)], 1u);
    return b;
}
__device__ __forceinline__ void xcd_barrier_complete(unsigned* bar, unsigned x, unsigned& nloc, unsigned& nx) {
    const unsigned G = gridDim.x * gridDim.y * gridDim.z;
    unsigned sum, cnt, mine, sp = 0u;
    for (;;) {
        sum = 0u; cnt = 0u; mine = 0u;
#pragma unroll
        for (unsigned j = 0; j < 16; ++j) { const unsigned c = xb_ld(&bar[XB_XCNT(j)]); sum += c; cnt += (c > 0u) ? 1u : 0u; mine = (j == x) ? c : mine; }
        if (sum == G) break;
        __builtin_amdgcn_s_sleep(1);
        if ((++sp & 255u) == 0u) { if (xb_ld(&bar[XB_TMO])) break; if (sp > XB_SPIN_CAP) { atomicAdd(&bar[XB_TMO], 1u); break; } }
    }
    nloc = mine > 0u ? mine : 1u; nx = cnt > 0u ? cnt : 1u;
}
__device__ __forceinline__ void xcd_barrier(const XcdBarrier& b) {
    asm volatile("s_waitcnt vmcnt(0)" ::: "memory");
    __syncthreads();
    if (threadIdx.x == 0) {
        unsigned* bar = b.bar;
        __builtin_amdgcn_s_waitcnt(0);
        unsigned nloc = b.st[0], nx = b.st[1];
        if (nloc == 0u) { xcd_barrier_complete(bar, b.x, nloc, nx); b.st[0] = nloc; b.st[1] = nx; }
        const unsigned old = xb_add(&bar[XB_XSUB(b.x)], 1u);
        const unsigned gen = old / nloc;
        if (old + 1u == (gen + 1u) * nloc) {
            __builtin_amdgcn_fence(__ATOMIC_RELEASE, "agent");
            asm volatile("s_waitcnt vmcnt(0)" ::: "memory");
            const unsigned og = xb_add(&bar[XB_TOP], 1u);
            const unsigned tg = og / nx;
            if (og + 1u == (tg + 1u) * nx) xb_add(&bar[XB_TOPGEN], 1u);
            else XB_SPIN(xb_ld(&bar[XB_TOPGEN]) == tg, bar);
            __builtin_amdgcn_fence(__ATOMIC_ACQUIRE, "agent");
            xb_add(&bar[XB_XGEN(b.x)], 1u);
            asm volatile("s_waitcnt vmcnt(0)" ::: "memory");
        } else {
            XB_SPIN(xb_ld(&bar[XB_XGEN(b.x)]) == gen, bar);
            __builtin_amdgcn_fence(__ATOMIC_ACQUIRE, "agent");
            asm volatile("s_waitcnt vmcnt(0)" ::: "memory");
        }
    }
    __syncthreads();
}

struct Frame {
    LAS unsigned char* lds;
    volatile LAS unsigned* MISC;
    gu32* ctl;
    unsigned char* ws;
    int tid, lane, wave, vcu, G;
    float* hf;
    const float* const* in;
};
enum In { I_X = 0, I_MEM, I_LN_IN_G, I_LN_IN_B, I_LN_MEM_G, I_LN_MEM_B, I_W_IN, I_B_IN, I_W_DW, I_B_DW, I_LN_CONV_G, I_LN_CONV_B, I_W_OUT, I_B_OUT, I_LN1_G, I_LN1_B,
          I_WQ, I_WK, I_WV, I_WO, I_LN2_G, I_LN2_B, I_W_ROUTER, I_B_ROUTER, I_W_GU, I_B_GU, I_W_DOWN, I_B_DOWN, I_LN3_G, I_LN3_B, N_IN };

__device__ __forceinline__ void p0_transpose_item(const float* W, int K, int N, bf16* WT, int k0, int n0, int drow, LAS float* scr, int lane) {
#pragma unroll 8
    for (int i = 0; i < 32; ++i) { const int kk = 2 * i + (lane >> 5); scr[kk * 33 + (lane & 31)] = W[(size_t)(k0 + kk) * N + n0 + (lane & 31)]; }
    LDS_WAIT(); asm volatile("" ::: "memory");
    const int c = lane & 7;
#pragma unroll
    for (int j = 0; j < 4; ++j) { const int n = (lane >> 3) + 8 * j; const LAS float* s = scr + (8 * c) * 33 + n;
        u32x4 o; o.x = pk2(s[0 * 33], s[1 * 33]); o.y = pk2(s[2 * 33], s[3 * 33]); o.z = pk2(s[4 * 33], s[5 * 33]); o.w = pk2(s[6 * 33], s[7 * 33]);
        *(GAS u32x4*)(WT + (size_t)(drow + n) * K + k0 + 8 * c) = o; }
    LDS_WAIT(); asm volatile("" ::: "memory");
}
__device__ __forceinline__ void ln_row(f32x4 (&v)[4], const float* g, const float* b, int lane) {
    float s = 0.f;
#pragma unroll
    for (int j = 0; j < 4; ++j) s += (v[j].x + v[j].y) + (v[j].z + v[j].w);
    const float mean = wave_sum(s) * (1.f / D); float s2 = 0.f;
#pragma unroll
    for (int j = 0; j < 4; ++j) { v[j] = v[j] - mean; s2 += (v[j].x * v[j].x + v[j].y * v[j].y) + (v[j].z * v[j].z + v[j].w * v[j].w); }
    const float rstd = 1.f / sqrtf(wave_sum(s2) * (1.f / D) + LN_EPS);
#pragma unroll
    for (int j = 0; j < 4; ++j) { const f32x4 gg = ((const GAS f32x4*)g)[lane + 64 * j], bb = ((const GAS f32x4*)b)[lane + 64 * j]; v[j] = v[j] * rstd * gg + bb; }
}
__device__ __forceinline__ void store_row_bf16(const f32x4 (&v)[4], bf16* orow, int lane) {
    GAS u32x2* o8 = (GAS u32x2*)orow + lane;
#pragma unroll
    for (int j = 0; j < 4; ++j) o8[64 * j] = (u32x2){pk2(v[j].x, v[j].y), pk2(v[j].z, v[j].w)};
}
__device__ __forceinline__ void load_row_f32(f32x4 (&v)[4], const float* xrow, int lane) {
    const GAS f32x4* xr = (const GAS f32x4*)xrow + lane;
#pragma unroll
    for (int j = 0; j < 4; ++j) v[j] = xr[64 * j];
}
__device__ __forceinline__ void store_row_f32(const f32x4 (&v)[4], float* orow, int lane) {
    GAS f32x4* o = (GAS f32x4*)orow + lane;
#pragma unroll
    for (int j = 0; j < 4; ++j) o[64 * j] = v[j];
}

__device__ __forceinline__ void p0_prologue(Frame& F) {
    LAS float* scr = (LAS float*)(F.lds + RING_OFF + F.wave * 16384);
    const int gw = F.vcu * NWAVES + F.wave, NGW = F.G * NWAVES;
    constexpr int I_IN = 16 * 80, I_SQ = 16 * 32, I_GU = NE * 16 * 64, I_DN = NE * 16 * 32;
    constexpr int NITEMS = I_IN + 5 * I_SQ + I_GU + I_DN;
    for (int it = gw; it < NITEMS; it += NGW) {
        int r = it;
        if (r < I_IN) { const int kb = r / 80, nb = r % 80, n0 = 32 * nb; int drow;
            if (n0 < 512) drow = (n0 >> 7) * 256 + (n0 & 127); else if (n0 < 1024) drow = ((n0 - 512) >> 7) * 256 + 128 + (n0 & 127); else drow = n0;
            p0_transpose_item(F.in[I_W_IN], D, INC, (bf16*)(F.ws + WS_WIN_T), 64 * kb, n0, drow, scr, F.lane); continue; } r -= I_IN;
        if (r < 5 * I_SQ) { const int w = r / I_SQ, q = r % I_SQ, kb = q / 32, nb = q % 32;
            const float* src = F.in[w == 0 ? I_W_OUT : w == 1 ? I_WQ : w == 2 ? I_WK : w == 3 ? I_WV : I_WO];
            bf16* dst = (bf16*)(F.ws + (w == 0 ? WS_WOUT_T : w == 1 ? WS_WQ_T : w == 2 ? WS_WK_T : w == 3 ? WS_WV_T : WS_WO_T));
            p0_transpose_item(src, D, D, dst, 64 * kb, 32 * nb, 32 * nb, scr, F.lane); continue; } r -= 5 * I_SQ;
        if (r < I_GU) { const int e = r / (16 * 64), q = r % (16 * 64), kb = q / 64, nb = q % 64, n0 = 32 * nb;
            const int drow = (n0 < 1024) ? (n0 >> 7) * 256 + (n0 & 127) : ((n0 - 1024) >> 7) * 256 + 128 + (n0 & 127);
            p0_transpose_item(F.in[I_W_GU] + (size_t)e * D * 2 * DFF, D, 2 * DFF, (bf16*)(F.ws + WS_WGU_T) + (size_t)e * 2 * DFF * D, 64 * kb, n0, drow, scr, F.lane); continue; } r -= I_GU;
        { const int e = r / (16 * 32), q = r % (16 * 32), kb = q / 32, nb = q % 32;
            p0_transpose_item(F.in[I_W_DOWN] + (size_t)e * DFF * D, DFF, D, (bf16*)(F.ws + WS_WDN_T) + (size_t)e * D * DFF, 64 * kb, 32 * nb, 32 * nb, scr, F.lane); }
    }
    for (int m = gw; m < M + MM; m += NGW) {
        f32x4 v[4];
        if (m < M) { load_row_f32(v, F.in[I_X] + (size_t)m * D, F.lane); ln_row(v, F.in[I_LN_IN_G], F.in[I_LN_IN_B], F.lane);
            store_row_f32(v, F.hf + (size_t)m * D, F.lane); store_row_bf16(v, (bf16*)(F.ws + WS_HB) + (size_t)m * D, F.lane); }
        else { const int mm = m - M; load_row_f32(v, F.in[I_MEM] + (size_t)mm * D, F.lane); ln_row(v, F.in[I_LN_MEM_G], F.in[I_LN_MEM_B], F.lane);
            store_row_bf16(v, (bf16*)(F.ws + WS_MEMN) + (size_t)mm * D, F.lane); }
    }
}

constexpr unsigned TSTEP = 256u * 1024u * 2u;
struct SchedP1 { int G, c;
    __device__ __forceinline__ bool next(int i, Unit& u) const {
        const int L = i * G + c; if (L >= 1344) return false;
        u.nvalid = 256; u.goff = 0;
        if (L < 1280) { pg8::tile_order(L, 128, 10, u.pm, u.pn); u.z = 0; u.aoff = (unsigned)WS_HB + (unsigned)u.pm * TSTEP; u.boff = (unsigned)WS_WIN_T + (unsigned)u.pn * TSTEP; }
        else if (L < 1312) { const int j = L - 1280; u.pm = j & 7; u.pn = j >> 3; u.z = 1; u.aoff = (unsigned)WS_MEMN + (unsigned)u.pm * TSTEP; u.boff = (unsigned)WS_WK_T + (unsigned)u.pn * TSTEP; }
        else { const int j = L - 1312; u.pm = j & 3; u.pn = j >> 2; u.z = 2; u.aoff = (unsigned)WS_WV_T + (unsigned)u.pm * TSTEP; u.boff = (unsigned)WS_MEMN + (unsigned)u.pn * TSTEP; }
        return true; }
};
struct EpiP1 { static constexpr bool PERM = true;
    unsigned char* ws; const float* b_in;
    __device__ __forceinline__ void operator()(const f32x4 (&acc)[2][2][4][2], const Unit& u, int wr, int wc, int fr, int fq) const {
        const int row0 = u.pm * 256 + wr * 64 + fr;
        if (u.z == 0) {
            if (u.pn < 4) {
                const int ch = 128 * u.pn + wc * 32 + 8 * fq;
                f32x4 bv[2], bg[2];
#pragma unroll
                for (int n = 0; n < 2; ++n) { bv[n] = *(const f32x4*)(b_in + ch + 4 * n); bg[n] = *(const f32x4*)(b_in + 512 + ch + 4 * n); }
                bf16* U = (bf16*)(ws + WS_U);
#pragma unroll
                for (int ai = 0; ai < 2; ++ai)
#pragma unroll
                    for (int m = 0; m < 4; ++m) { f32x4 o[2];
#pragma unroll
                        for (int n = 0; n < 2; ++n) { const f32x4 a = acc[ai][0][m][n] + bv[n], g = acc[ai][1][m][n] + bg[n];
#pragma unroll
                            for (int j = 0; j < 4; ++j) o[n][j] = a[j] * sigmoidf_fast(g[j]); }
                        u32x4 w; w.x = pg8::cvt_pk_bf16(o[0][0], o[0][1]); w.y = pg8::cvt_pk_bf16(o[0][2], o[0][3]); w.z = pg8::cvt_pk_bf16(o[1][0], o[1][1]); w.w = pg8::cvt_pk_bf16(o[1][2], o[1][3]);
                        *(u32x4*)(U + (size_t)(row0 + ai * 128 + m * 16) * 512 + ch) = w; }
            } else {
                const int t = u.pn - 4, which = t >> 1, cb = (t & 1) * 256;
                bf16* dst = (bf16*)(ws + (which == 0 ? WS_Q : which == 1 ? WS_K : WS_V));
                pg8::store_tile_bf16(acc, dst + (size_t)row0 * 512 + cb, 512, b_in + 1024 + 256 * t, which == 0 ? SB_QSCALE : 1.0f, wc, fq);
            }
        } else if (u.z == 1) pg8::store_tile_bf16(acc, (bf16*)(ws + WS_KM) + (size_t)row0 * 1024 + 256 * u.pn, 1024, nullptr, 1.0f, wc, fq);
        else pg8::store_tile_bf16(acc, (bf16*)(ws + WS_VMT) + (size_t)row0 * 2048 + 256 * u.pn, 2048, nullptr, 1.0f, wc, fq);
    }
};

struct SchedPlain { int G, c, nM, nN; unsigned abase, bbase, atile, btile, acol, bcol, bgrp;
    __device__ __forceinline__ bool next(int i, Unit& u) const {
        const int L = i * G + c; if (L >= nM * nN) return false;
        pg8::tile_order(L, nM, nN, u.pm, u.pn); u.z = 0; u.nvalid = 256; u.goff = 0;
        u.aoff = abase + (unsigned)u.pm * atile + (unsigned)u.pn * acol; u.boff = bbase + (unsigned)u.pn * btile + (unsigned)(u.pm >> 4) * bgrp + (unsigned)u.pn * bcol; return true; }
};
struct EpiBf16 { static constexpr bool PERM = true;
    bf16* O; int ldc; float scale;
    __device__ __forceinline__ void operator()(const f32x4 (&acc)[2][2][4][2], const Unit& u, int wr, int wc, int fr, int fq) const {
        pg8::store_tile_bf16(acc, O + (size_t)(u.pm * 256 + wr * 64 + fr) * ldc + 256 * u.pn, (size_t)ldc, nullptr, scale, wc, fq); }
};
struct EpiResid { static constexpr bool PERM = false;
    float* hf; const float* bias;
    __device__ __forceinline__ void operator()(const f32x4 (&acc)[2][2][4][2], const Unit& u, int wr, int wc, int fr, int fq) const {
        const int row0 = u.pm * 256 + wr * 64 + fr, col0 = u.pn * 256 + wc * 32 + 4 * fq;
        f32x4 bv[2][2];
#pragma unroll
        for (int bj = 0; bj < 2; ++bj)
#pragma unroll
            for (int n = 0; n < 2; ++n) bv[bj][n] = bias ? *(const f32x4*)(bias + col0 + bj * 128 + n * 16) : (f32x4){0.f, 0.f, 0.f, 0.f};
#pragma unroll
        for (int ai = 0; ai < 2; ++ai)
#pragma unroll
            for (int m = 0; m < 4; ++m) { float* rowp = hf + (size_t)(row0 + ai * 128 + m * 16) * D + col0;
#pragma unroll
                for (int bj = 0; bj < 2; ++bj)
#pragma unroll
                    for (int n = 0; n < 2; ++n) { float* p = rowp + bj * 128 + n * 16; const f32x4 x = *(const f32x4*)p; *(f32x4*)p = x * DN_ALPHA + acc[ai][bj][m][n] + bv[bj][n]; }
                asm volatile("" ::: "memory"); }
    }
};

struct SchedMoe { int G, c, nN; const LAS int* tb; unsigned abase, wbase, wexp;
    bool gather;
    __device__ __forceinline__ bool next(int i, Unit& u) const {
        const int nblk = __builtin_amdgcn_readfirstlane(tb[32]); const int L = i * G + c; if (L >= nblk * nN) return false;
        pg8::tile_order(L, nblk, nN, u.pm, u.pn);
        int e = 0; while (tb[e + 1] <= u.pm) ++e;
        e = __builtin_amdgcn_readfirstlane(e);
        const int j = u.pm - tb[e], rem = tb[64 + e] - 256 * j;
        u.z = e; u.nvalid = rem < 256 ? rem : 256; u.goff = (unsigned)(e * LCAP + 256 * j);
        u.aoff = gather ? abase : abase + (unsigned)u.pm * TSTEP;
        u.boff = wbase + (unsigned)e * wexp + (unsigned)u.pn * TSTEP; return true; }
};
struct EpiAct { static constexpr bool PERM = true;
    bf16* ACT; const float* b_gu;
    __device__ __forceinline__ void operator()(const f32x4 (&acc)[2][2][4][2], const Unit& u, int wr, int wc, int fr, int fq) const {
        const int row0 = u.pm * 256 + wr * 64 + fr, ch = 128 * u.pn + wc * 32 + 8 * fq;
        const float* bb = b_gu + (size_t)u.z * 2 * DFF;
        f32x4 bg[2], bu[2];
#pragma unroll
        for (int n = 0; n < 2; ++n) { bg[n] = *(const f32x4*)(bb + ch + 4 * n); bu[n] = *(const f32x4*)(bb + DFF + ch + 4 * n); }
#pragma unroll
        for (int ai = 0; ai < 2; ++ai)
#pragma unroll
            for (int m = 0; m < 4; ++m) { f32x4 o[2];
#pragma unroll
                for (int n = 0; n < 2; ++n) { const f32x4 g = acc[ai][0][m][n] + bg[n], uu = acc[ai][1][m][n] + bu[n];
#pragma unroll
                    for (int j = 0; j < 4; ++j) { const float g_ = fminf(g[j], 7.0f), u_ = fminf(fmaxf(uu[j], -7.0f), 7.0f); o[n][j] = (u_ + 1.0f) * g_ * sigmoidf_fast(1.702f * g_); } }
                u32x4 w; w.x = pg8::cvt_pk_bf16(o[0][0], o[0][1]); w.y = pg8::cvt_pk_bf16(o[0][2], o[0][3]); w.z = pg8::cvt_pk_bf16(o[1][0], o[1][1]); w.w = pg8::cvt_pk_bf16(o[1][2], o[1][3]);
                *(u32x4*)(ACT + (size_t)(row0 + ai * 128 + m * 16) * DFF + ch) = w; }
    }
};
struct EpiDown { static constexpr bool PERM = true;
    bf16* YS; const float* b_down; const float* lgate;
    __device__ __forceinline__ void operator()(const f32x4 (&acc)[2][2][4][2], const Unit& u, int wr, int wc, int fr, int fq) const {
        const int r0 = wr * 64 + fr, cl = wc * 32 + 8 * fq;
        const float* bb = b_down + (size_t)u.z * D + 256 * u.pn + cl;
        f32x4 bv[2][2];
#pragma unroll
        for (int bj = 0; bj < 2; ++bj)
#pragma unroll
            for (int n = 0; n < 2; ++n) bv[bj][n] = *(const f32x4*)(bb + bj * 128 + 4 * n);
#pragma unroll
        for (int ai = 0; ai < 2; ++ai)
#pragma unroll
            for (int m = 0; m < 4; ++m) { const int r = r0 + ai * 128 + m * 16; const float gl = lgate[u.goff + (r < u.nvalid ? r : u.nvalid - 1)]; const float gt = (r < u.nvalid) ? gl : 0.f;
                bf16* rowp = YS + (size_t)(u.pm * 256 + r) * D + 256 * u.pn + cl;
#pragma unroll
                for (int bj = 0; bj < 2; ++bj) { const f32x4 v0 = (acc[ai][bj][m][0] + bv[bj][0]) * gt, v1 = (acc[ai][bj][m][1] + bv[bj][1]) * gt;
                    u32x4 w; w.x = pg8::cvt_pk_bf16(v0[0], v0[1]); w.y = pg8::cvt_pk_bf16(v0[2], v0[3]); w.z = pg8::cvt_pk_bf16(v1[0], v1[1]); w.w = pg8::cvt_pk_bf16(v1[2], v1[3]);
                    *(u32x4*)(rowp + bj * 128) = w; } }
    }
};
__device__ __forceinline__ void moe_table(Frame& F, LAS int* tb) {
    if (F.tid < 32) { int c = (int)__hip_atomic_load(F.ctl + CW_ECNT + 64 * F.tid, RLX_AGENT); if (c > LCAP) c = LCAP; tb[64 + F.tid] = c; }
    LDS_WAIT(); __syncthreads();
    if (F.tid == 0) { int s = 0; for (int e = 0; e < NE; ++e) { tb[e] = s; s += (tb[64 + e] + 255) >> 8; } tb[32] = s; }
    LDS_WAIT(); __syncthreads();
}

__device__ __forceinline__ void conv_phase(Frame& F) {
    LAS unsigned* ut = (LAS unsigned*)(F.lds + RING_OFF);
    LAS float* co = (LAS float*)(F.lds + RING_OFF + 65536);
    const int cp = F.tid & 255, half = F.tid >> 8;
    float w0[CWID], w1[CWID];
    { const float* wd = F.in[I_W_DW] + 2 * cp;
#pragma unroll
        for (int j = 0; j < CWID; ++j) { const f32x2 w = *(const GAS f32x2*)(wd + j * CONV_CH); w0[j] = w.x; w1[j] = w.y; } }
    const f32x2 bd = *(const GAS f32x2*)(F.in[I_B_DW] + 2 * cp);
    const f32x4 g0 = *(const GAS f32x4*)(F.in[I_LN_CONV_G] + 8 * F.lane), g1 = *(const GAS f32x4*)(F.in[I_LN_CONV_G] + 8 * F.lane + 4);
    const f32x4 b0 = *(const GAS f32x4*)(F.in[I_LN_CONV_B] + 8 * F.lane), b1 = *(const GAS f32x4*)(F.in[I_LN_CONV_B] + 8 * F.lane + 4);
    bf16* MX = (bf16*)(F.ws + WS_MIXIN);
    for (int it = F.vcu; it < NB * (T_ / 32); it += F.G) {
        const int b = it / (T_ / 32), t0 = (it % (T_ / 32)) * 32;
        const bf16* U = (const bf16*)(F.ws + WS_U) + (size_t)b * T_ * CONV_CH;
        for (int idx = F.tid; idx < 62 * 64; idx += 512) { const int r = idx >> 6, c16 = idx & 63, t = t0 - 30 + r;
            u32x4 v = (u32x4){0u, 0u, 0u, 0u}; if (t >= 0) v = *(const GAS u32x4*)(U + (size_t)t * CONV_CH + c16 * 8);
            *(LAS u32x4*)(ut + r * 256 + c16 * 4) = v; }
        LDS_WAIT(); __syncthreads();
        { float a0[16], a1[16];
#pragma unroll
            for (int tt = 0; tt < 16; ++tt) { a0[tt] = bd.x; a1[tt] = bd.y; }
#pragma unroll
            for (int r = 0; r < 46; ++r) { const unsigned uu = ut[(half * 16 + r) * 256 + cp]; const float u0 = bflo(uu), u1 = bfhi(uu);
#pragma unroll
                for (int tt = 0; tt < 16; ++tt) { const int j = r - tt; if (j >= 0 && j < CWID) { a0[tt] += w0[j] * u0; a1[tt] += w1[j] * u1; } } }
#pragma unroll
            for (int tt = 0; tt < 16; ++tt) *(LAS f32x2*)(co + (half * 16 + tt) * CONV_CH + 2 * cp) = (f32x2){a0[tt], a1[tt]};
        }
        LDS_WAIT(); __syncthreads();
#pragma unroll
        for (int q = 0; q < 4; ++q) { const int tt = 4 * F.wave + q;
            f32x4 x0 = *(const LAS f32x4*)(co + tt * CONV_CH + 8 * F.lane), x1 = *(const LAS f32x4*)(co + tt * CONV_CH + 8 * F.lane + 4);
            const float mean = wave_sum((x0.x + x0.y) + (x0.z + x0.w) + (x1.x + x1.y) + (x1.z + x1.w)) * (1.f / CONV_CH);
            x0 = x0 - mean; x1 = x1 - mean;
            const float var = wave_sum((x0.x * x0.x + x0.y * x0.y) + (x0.z * x0.z + x0.w * x0.w) + (x1.x * x1.x + x1.y * x1.y) + (x1.z * x1.z + x1.w * x1.w)) * (1.f / CONV_CH);
            const float rstd = 1.f / sqrtf(var + LN_EPS);
            x0 = x0 * rstd * g0 + b0; x1 = x1 * rstd * g1 + b1;
            float y[8] = {x0.x, x0.y, x0.z, x0.w, x1.x, x1.y, x1.z, x1.w};
#pragma unroll
            for (int j = 0; j < 8; ++j) y[j] = y[j] * sigmoidf_fast(y[j]);
            *(GAS u32x4*)(MX + (size_t)(b * T_ + t0 + tt) * D + 8 * F.lane) = (u32x4){pk2(y[0], y[1]), pk2(y[2], y[3]), pk2(y[4], y[5]), pk2(y[6], y[7])}; }
        __syncthreads();
    }
}

__device__ __forceinline__ void sb_attn_task(Frame& F, int b, int h, int tblk) {
    const bf16* Q = (const bf16*)(F.ws + WS_Q); const bf16* Kb = (const bf16*)(F.ws + WS_K); const bf16* V = (const bf16*)(F.ws + WS_V);
    const int t = tblk * 64 + F.lane; const size_t rowq = (size_t)b * T_ + t;
    float q[64], acc[64];
    { const GAS u32x4* qp = (const GAS u32x4*)(Q + rowq * SBW + h * SBD);
#pragma unroll
        for (int i = 0; i < 8; ++i) { const u32x4 w = qp[i]; q[8 * i + 0] = bflo(w.x); q[8 * i + 1] = bfhi(w.x); q[8 * i + 2] = bflo(w.y); q[8 * i + 3] = bfhi(w.y); q[8 * i + 4] = bflo(w.z); q[8 * i + 5] = bfhi(w.z); q[8 * i + 6] = bflo(w.w); q[8 * i + 7] = bfhi(w.w); } }
#pragma unroll
    for (int d = 0; d < 64; ++d) acc[d] = 0.f;
    float carry = 0.f;
    for (int s = tblk * 64 + 62; s >= 0; --s) {
        const size_t rowk = (size_t)b * T_ + s;
        const GAS u32x4* kp = (const GAS u32x4*)(Kb + rowk * SBW + h * SBD); const GAS u32x4* vp = (const GAS u32x4*)(V + rowk * SBW + h * SBD);
        float y = 0.f;
#pragma unroll
        for (int i = 0; i < 8; ++i) { const u32x4 w = kp[i];
            y += q[8 * i + 0] * bflo(w.x); y += q[8 * i + 1] * bfhi(w.x); y += q[8 * i + 2] * bflo(w.y); y += q[8 * i + 3] * bfhi(w.y);
            y += q[8 * i + 4] * bflo(w.z); y += q[8 * i + 5] * bfhi(w.z); y += q[8 * i + 6] * bflo(w.w); y += q[8 * i + 7] * bfhi(w.w); }
        const bool on = s < t;
        float L = __builtin_amdgcn_logf(1.0f + __builtin_amdgcn_exp2f(fminf(y, 100.f))); L = fmaxf(L, y);
        L = on ? L : 0.f; carry += L;
        const float w = on ? __builtin_amdgcn_exp2f(y - carry) : 0.f;
#pragma unroll
        for (int i = 0; i < 8; ++i) { const u32x4 x = vp[i];
            acc[8 * i + 0] += w * bflo(x.x); acc[8 * i + 1] += w * bfhi(x.x); acc[8 * i + 2] += w * bflo(x.y); acc[8 * i + 3] += w * bfhi(x.y);
            acc[8 * i + 4] += w * bflo(x.z); acc[8 * i + 5] += w * bfhi(x.z); acc[8 * i + 6] += w * bflo(x.w); acc[8 * i + 7] += w * bfhi(x.w); }
    }
    GAS u32x4* op = (GAS u32x4*)((bf16*)(F.ws + WS_MIXIN) + rowq * D + CONV_CH + h * SBD);
#pragma unroll
    for (int i = 0; i < 8; ++i) op[i] = (u32x4){pk2(acc[8 * i], acc[8 * i + 1]), pk2(acc[8 * i + 2], acc[8 * i + 3]), pk2(acc[8 * i + 4], acc[8 * i + 5]), pk2(acc[8 * i + 6], acc[8 * i + 7])};
}

__device__ __forceinline__ void ln_phase(Frame& F, const float* g, const float* b) {
    const int gw = F.vcu * NWAVES + F.wave, NGW = F.G * NWAVES;
    for (int m = gw; m < M; m += NGW) { f32x4 v[4]; load_row_f32(v, F.hf + (size_t)m * D, F.lane); ln_row(v, g, b, F.lane);
        store_row_f32(v, F.hf + (size_t)m * D, F.lane); store_row_bf16(v, (bf16*)(F.ws + WS_HB) + (size_t)m * D, F.lane); }
}
__device__ __forceinline__ void softmax_phase(Frame& F) {
    const int gw = F.vcu * NWAVES + F.wave, NGW = F.G * NWAVES;
    for (int m = gw; m < M; m += NGW) { GAS u32x2* p = (GAS u32x2*)((bf16*)(F.ws + WS_SP) + (size_t)m * D) + F.lane;
#pragma unroll
        for (int j = 0; j < 4; ++j) { const u32x2 w = p[64 * j]; float x0 = bflo(w.x), x1 = bfhi(w.x), x2 = bflo(w.y), x3 = bfhi(w.y);
            const float mx = wave_max(fmaxf(fmaxf(x0, x1), fmaxf(x2, x3)));
            x0 = __builtin_amdgcn_exp2f(x0 - mx); x1 = __builtin_amdgcn_exp2f(x1 - mx); x2 = __builtin_amdgcn_exp2f(x2 - mx); x3 = __builtin_amdgcn_exp2f(x3 - mx);
            const float inv = 1.0f / wave_sum((x0 + x1) + (x2 + x3));
            p[64 * j] = (u32x2){pk2(x0 * inv, x1 * inv), pk2(x2 * inv, x3 * inv)}; } }
}
__device__ __forceinline__ void ln2_router_phase(Frame& F) {
    LAS float* wT = (LAS float*)(F.lds + RING_OFF);
    LAS int* lcnt = (LAS int*)(F.lds + XTRA_OFF);
    LAS int* rec = (LAS int*)(F.lds + XTRA_OFF + 512);
    const float* wr_ = F.in[I_W_ROUTER];
    for (int idx = F.tid; idx < D * NE; idx += 512) { const int c = idx >> 5, e = idx & 31; wT[e * D + c] = wr_[idx]; }
    if (F.tid < 64) lcnt[F.tid] = 0;
    LDS_WAIT(); __syncthreads();
    const int gw = F.vcu * NWAVES + F.wave, NGW = F.G * NWAVES;
    const float brt = F.lane < NE ? F.in[I_B_ROUTER][F.lane] : 0.f;
    int it = 0;
    for (int m = gw; m < M; m += NGW, ++it) {
        f32x4 v[4]; load_row_f32(v, F.hf + (size_t)m * D, F.lane); ln_row(v, F.in[I_LN2_G], F.in[I_LN2_B], F.lane);
        store_row_f32(v, F.hf + (size_t)m * D, F.lane); store_row_bf16(v, (bf16*)(F.ws + WS_HB) + (size_t)m * D, F.lane);
        float logit = -INFINITY;
        for (int e = 0; e < NE; ++e) { float p = 0.f;
#pragma unroll
            for (int j = 0; j < 4; ++j) { const f32x4 w = *(const LAS f32x4*)(wT + e * D + 256 * j + 4 * F.lane); p += (v[j].x * w.x + v[j].y * w.y) + (v[j].z * w.z + v[j].w * w.w); }
            p = wave_sum(p); if (F.lane == e) logit = p + brt; }
        float tv[TOPK]; int te[TOPK];
#pragma unroll
        for (int k = 0; k < TOPK; ++k) { const float mx = wave_max(logit); const unsigned long long bal = __ballot(logit == mx); const int e = __builtin_ctzll(bal);
            tv[k] = mx; te[k] = e; if (F.lane == e) logit = -INFINITY; }
        float pe[TOPK], ps = 0.f;
#pragma unroll
        for (int k = 0; k < TOPK; ++k) { pe[k] = __expf(tv[k] - tv[0]); ps += pe[k]; }
        if (F.lane < TOPK) { const int k = F.lane; const int e = k == 0 ? te[0] : k == 1 ? te[1] : k == 2 ? te[2] : te[3]; const float g = (k == 0 ? pe[0] : k == 1 ? pe[1] : k == 2 ? pe[2] : pe[3]) / ps;
            const int lr = __hip_atomic_fetch_add(lcnt + e, 1, __ATOMIC_RELAXED, __HIP_MEMORY_SCOPE_WORKGROUP);
            LAS int* r = rec + ((F.wave * 16 + (it & 15)) * 4 + k) * 4; r[0] = e; r[1] = lr; r[2] = __builtin_bit_cast(int, g); r[3] = m; }
    }
    LDS_WAIT(); __syncthreads();
    if (F.tid < NE) lcnt[32 + F.tid] = (int)__hip_atomic_fetch_add(F.ctl + CW_ECNT + 64 * F.tid, (unsigned)lcnt[F.tid], RLX_AGENT);
    LDS_WAIT(); __syncthreads();
    int* ltok = (int*)(F.ws + WS_LTOK); float* lgate = (float*)(F.ws + WS_LGATE); int* sidx = (int*)(F.ws + WS_SIDX);
    const int nrec = it * 4;
    for (int i = F.lane; i < nrec; i += 64) { const LAS int* r = rec + (F.wave * 64 + i) * 4; const int e = r[0], pos = lcnt[32 + e] + r[1], tok = r[3];
        if (pos < LCAP) { ltok[e * LCAP + pos] = tok; lgate[e * LCAP + pos] = __builtin_bit_cast(float, r[2]); } sidx[tok * 4 + (i & 3)] = e * LCAP + pos; }
    __syncthreads();
}
__device__ __forceinline__ void final_phase(Frame& F, const LAS int* tb) {
    const int gw = F.vcu * NWAVES + F.wave, NGW = F.G * NWAVES;
    const int* sidx = (const int*)(F.ws + WS_SIDX); const bf16* YS = (const bf16*)(F.ws + WS_YS);
    for (int m = gw; m < M; m += NGW) { f32x4 v[4]; load_row_f32(v, F.hf + (size_t)m * D, F.lane);
#pragma unroll
        for (int j = 0; j < 4; ++j) v[j] = v[j] * DN_ALPHA;
        f32x4 s[4];
#pragma unroll
        for (int j = 0; j < 4; ++j) s[j] = (f32x4){0.f, 0.f, 0.f, 0.f};
#pragma unroll
        for (int k = 0; k < TOPK; ++k) { const int si = sidx[m * 4 + k], e = si / LCAP, pos = si - e * LCAP; const size_t slot = (size_t)tb[e] * 256 + pos;
            const GAS u32x2* yp = (const GAS u32x2*)(YS + slot * D) + F.lane;
#pragma unroll
            for (int j = 0; j < 4; ++j) { const u32x2 w = yp[64 * j]; s[j] = s[j] + (f32x4){bflo(w.x), bfhi(w.x), bflo(w.y), bfhi(w.y)}; } }
#pragma unroll
        for (int j = 0; j < 4; ++j) v[j] = v[j] + s[j];
        ln_row(v, F.in[I_LN3_G], F.in[I_LN3_B], F.lane); store_row_f32(v, F.hf + (size_t)m * D, F.lane); }
}

struct Args { const float* in[N_IN]; float* out; unsigned char* ws; int ph_lo, ph_hi, li, pad; };
__global__ void __launch_bounds__(NWAVES * 64, 2) mk_fwd(Args args) {
    extern __shared__ __attribute__((aligned(16))) unsigned char lds[];
    Frame F;
    F.lds = (LAS unsigned char*)lds; F.MISC = (volatile LAS unsigned*)(F.lds + MISC_OFF);
    F.tid = threadIdx.x; F.lane = F.tid & 63; F.wave = __builtin_amdgcn_readfirstlane(F.tid >> 6);
    F.G = gridDim.x; { const int bx = blockIdx.x; F.vcu = (F.G % 8 == 0) ? (bx % 8) * (F.G / 8) + bx / 8 : bx; }
    F.ws = args.ws; F.ctl = (gu32*)(args.ws + WS_CTL); F.hf = args.out; F.in = args.in;
    for (int u = F.tid; u < (LDS_BYTES - LDSCTL_OFF) / 4; u += NWAVES * 64) ((LAS unsigned*)(F.lds + LDSCTL_OFF))[u] = 0u;
    __syncthreads();
    XcdBarrier bar; bar.bar = (unsigned*)(F.ctl + CW_BAR) + args.li * XCD_BAR_WORDS; bar.x = 0; bar.st = nullptr;
    const int lo = args.ph_lo, hi = args.ph_hi;
    if (hi - lo > 1) bar = xcd_barrier_post((unsigned*)(F.ctl + CW_BAR) + args.li * XCD_BAR_WORDS, F.MISC + 8);
#ifndef PH_MASK
#define PH_MASK 0x3fff
#endif
#define IN(k) (((PH_MASK >> (k)) & 1) && lo <= (k) && (k) < hi)
#define SEAM(k) do { if (IN(k) && IN((k) + 1)) xcd_barrier(bar); } while (0)
    const char* wsb = (const char*)args.ws;
    LAS int* tb = (LAS int*)(F.lds + XTRA_OFF + 9216);

    if (IN(0)) { p0_prologue(F); __syncthreads(); } SEAM(0);
    if (IN(1)) { SchedP1 S{F.G, (int)blockIdx.x}; EpiP1 E{F.ws, F.in[I_B_IN]};
        pg8::gemm_phase<EpiP1, SchedP1, false>(F.lds + RING_OFF, wsb, D, D, D, S, E, nullptr); } SEAM(1);
    if (IN(2)) {
        conv_phase(F);
        const int gw = F.vcu * NWAVES + F.wave;
        if (F.G == 256) { const int bh = gw >> 5, j = gw & 31; sb_attn_task(F, bh >> 3, bh & 7, j); sb_attn_task(F, bh >> 3, bh & 7, 63 - j); }
        else { for (int tk = gw; tk < NB * SBH * 64; tk += F.G * NWAVES) sb_attn_task(F, (tk >> 6) >> 3, (tk >> 6) & 7, tk & 63); }
    } SEAM(2);
    if (IN(3)) { SchedPlain S{F.G, (int)blockIdx.x, 128, 4, (unsigned)WS_MIXIN, (unsigned)WS_WOUT_T, TSTEP, TSTEP, 0u, 0u, 0u}; EpiResid E{F.hf, F.in[I_B_OUT]};
        pg8::gemm_phase<EpiResid, SchedPlain, false>(F.lds + RING_OFF, wsb, D, D, D, S, E, nullptr); } SEAM(3);
    if (IN(4)) { ln_phase(F, F.in[I_LN1_G], F.in[I_LN1_B]); } SEAM(4);
    if (IN(5)) { SchedPlain S{F.G, (int)blockIdx.x, 128, 4, (unsigned)WS_HB, (unsigned)WS_WQ_T, TSTEP, TSTEP, 0u, 0u, 0u}; EpiBf16 E{(bf16*)(F.ws + WS_QM), D, MEM_QSCALE};
        pg8::gemm_phase<EpiBf16, SchedPlain, false>(F.lds + RING_OFF, wsb, D, D, D, S, E, nullptr); } SEAM(5);
    if (IN(6)) {
        SchedPlain S{F.G, (int)blockIdx.x, 128, 4, (unsigned)WS_QM, (unsigned)WS_KM, TSTEP, 0u, 512u, 512u, TSTEP}; EpiBf16 E{(bf16*)(F.ws + WS_SP), D, 1.0f};
        pg8::gemm_phase<EpiBf16, SchedPlain, false>(F.lds + RING_OFF, wsb, D, D, 256, S, E, nullptr); } SEAM(6);
    if (IN(7)) { softmax_phase(F); } SEAM(7);
    if (IN(8)) {
        SchedPlain S{F.G, (int)blockIdx.x, 128, 4, (unsigned)WS_SP, (unsigned)WS_VMT, TSTEP, 256u * 2048u * 2u, 512u, 0u, 512u}; EpiBf16 E{(bf16*)(F.ws + WS_OB), D, 1.0f};
        pg8::gemm_phase<EpiBf16, SchedPlain, false>(F.lds + RING_OFF, wsb, D, 2048, 256, S, E, nullptr); } SEAM(8);
    if (IN(9)) { SchedPlain S{F.G, (int)blockIdx.x, 128, 4, (unsigned)WS_OB, (unsigned)WS_WO_T, TSTEP, TSTEP, 0u, 0u, 0u}; EpiResid E{F.hf, nullptr};
        pg8::gemm_phase<EpiResid, SchedPlain, false>(F.lds + RING_OFF, wsb, D, D, D, S, E, nullptr); } SEAM(9);
    if (IN(10)) { ln2_router_phase(F); } SEAM(10);
    if (IN(11)) { moe_table(F, tb); SchedMoe S{F.G, (int)blockIdx.x, 8, tb, (unsigned)WS_HB, (unsigned)WS_WGU_T, 2048u * 1024u * 2u, true}; EpiAct E{(bf16*)(F.ws + WS_ACT), F.in[I_B_GU]};
        pg8::gemm_phase<EpiAct, SchedMoe, true>(F.lds + RING_OFF, wsb, D, D, D, S, E, (const int*)(F.ws + WS_LTOK)); } SEAM(11);
    if (IN(12)) { moe_table(F, tb); SchedMoe S{F.G, (int)blockIdx.x, 4, tb, (unsigned)WS_ACT, (unsigned)WS_WDN_T, 1024u * 1024u * 2u, false}; EpiDown E{(bf16*)(F.ws + WS_YS), F.in[I_B_DOWN], (const float*)(F.ws + WS_LGATE)};
        pg8::gemm_phase<EpiDown, SchedMoe, false>(F.lds + RING_OFF, wsb, D, D, D, S, E, nullptr); } SEAM(12);
    if (IN(13)) { moe_table(F, tb); final_phase(F, tb); }
#undef IN
#undef SEAM
}

extern "C" void kernel_launch(void* const* d_in, const int* in_sizes, int n_in, void* d_out, int out_size, void* d_ws, size_t ws_size, hipStream_t stream) {
    static int grid = 0;
    if (grid == 0) {
        if (n_in != N_IN || out_size != M * D || ws_size < WS_END) { fprintf(stderr, "kernel_launch: unexpected shapes (n_in %d, out %d, ws %zu)\n", n_in, out_size, ws_size); grid = -1; return; }
        int dev = 0, cus = 0, per_cu = 0;
        if (hipGetDevice(&dev) != hipSuccess || hipDeviceGetAttribute(&cus, hipDeviceAttributeMultiprocessorCount, dev) != hipSuccess) { grid = -1; return; }
        if (hipFuncSetAttribute((const void*)mk_fwd, hipFuncAttributeMaxDynamicSharedMemorySize, LDS_BYTES) != hipSuccess) { fprintf(stderr, "kernel_launch: hipFuncSetAttribute failed\n"); grid = -1; return; }
        if (hipOccupancyMaxActiveBlocksPerMultiprocessor(&per_cu, (const void*)mk_fwd, NWAVES * 64, LDS_BYTES) != hipSuccess || per_cu < 1) fprintf(stderr, "kernel_launch: occupancy query says %d\n", per_cu);
        (void)hipGetLastError();
        grid = cus;
    }
    if (grid < 0) return;
    if (hipMemsetAsync((char*)d_ws + WS_CTL, 0, CTL_ZERO_BYTES, stream) != hipSuccess) return;
    Args a{};
    for (int i = 0; i < N_IN; ++i) a.in[i] = (const float*)d_in[i];
    a.out = (float*)d_out; a.ws = (unsigned char*)d_ws;
    for (int li = 0; li < MK_N_LAUNCHES; ++li) {
        a.ph_lo = (MK_N_LAUNCHES == 1) ? 0 : li; a.ph_hi = (MK_N_LAUNCHES == 1) ? NPHASE : li + 1; a.li = (MK_N_LAUNCHES == 1) ? 0 : li;
        hipLaunchKernelGGL(mk_fwd, dim3(grid), dim3(NWAVES * 64), LDS_BYTES, stream, a);
        if (hipPeekAtLastError() != hipSuccess) { fprintf(stderr, "kernel_launch: launch %d failed\n", li); break; }
    }
}
```

```cpp
#include <hip/hip_runtime.h>
#include <cstdio>
#include <cstdint>

#ifndef MK_N_LAUNCHES
#define MK_N_LAUNCHES 1
#endif

#define GAS __attribute__((address_space(1)))
#define LAS __attribute__((address_space(3)))
typedef unsigned short bf16;
typedef short bf16x8 __attribute__((ext_vector_type(8)));
typedef float f32x4 __attribute__((ext_vector_type(4)));
typedef float f32x2 __attribute__((ext_vector_type(2)));
typedef unsigned u32x4 __attribute__((ext_vector_type(4)));
typedef unsigned u32x2 __attribute__((ext_vector_type(2)));
typedef GAS unsigned gu32;
#define RLX_AGENT __ATOMIC_RELAXED, __HIP_MEMORY_SCOPE_AGENT
#define LDS_WAIT() asm volatile("s_waitcnt lgkmcnt(0)" ::: "memory")
#define VM_WAIT() asm volatile("s_waitcnt vmcnt(0)" ::: "memory")

constexpr int NB = 8, T_ = 4096, D = 1024, M = NB * T_, NMEM = 256, MM = NB * NMEM;
constexpr int CONV_CH = 512, SBH = 8, SBD = 64, SBW = 512, CWID = 31, NE = 32, TOPK = 4, DFF = 1024;
constexpr int INC = 2560;
constexpr float LN_EPS = 1e-5f;
constexpr float DN_ALPHA = 1.189207115002721f;
constexpr float LOG2E = 1.4426950408889634f;
constexpr float SB_QSCALE = 0.125f * LOG2E;
constexpr float MEM_QSCALE = 0.0625f * LOG2E;
constexpr int NBLK_MAX = M * TOPK / 256 + NE;
constexpr int LCAP = M;

constexpr size_t MiB = 1u << 20;
constexpr size_t WS_CTL = 0, CTL_ZERO_BYTES = 1 * MiB;
constexpr size_t WS_WIN_T = 1 * MiB;
constexpr size_t WS_WOUT_T = 6 * MiB;
constexpr size_t WS_WQ_T = 8 * MiB, WS_WK_T = 10 * MiB, WS_WV_T = 12 * MiB, WS_WO_T = 14 * MiB;
constexpr size_t WS_WGU_T = 16 * MiB;
constexpr size_t WS_WDN_T = 144 * MiB;
constexpr size_t WS_HB = 208 * MiB;
constexpr size_t WS_LTOK = 272 * MiB;
constexpr size_t WS_LGATE = 276 * MiB;
constexpr size_t WS_SIDX = 280 * MiB;
constexpr size_t WS_X = 288 * MiB;
constexpr size_t WS_U = WS_X;
constexpr size_t WS_Q = WS_X + 32 * MiB;
constexpr size_t WS_K = WS_X + 64 * MiB;
constexpr size_t WS_V = WS_X + 96 * MiB;
constexpr size_t WS_MIXIN = WS_X + 128 * MiB;
constexpr size_t WS_QM = WS_X + 192 * MiB;
constexpr size_t WS_SP = WS_X + 256 * MiB;
constexpr size_t WS_OB = WS_X + 320 * MiB;
constexpr size_t WS_MEMN = WS_X + 384 * MiB;
constexpr size_t WS_KM = WS_X + 388 * MiB;
constexpr size_t WS_VMT = WS_X + 392 * MiB;
constexpr size_t WS_ACT = WS_X;
constexpr size_t WS_YS = WS_X + 272 * MiB;
constexpr size_t WS_END = WS_X + 544 * MiB;
constexpr int CW_TMO = 0, CW_CODE = 1;
constexpr int CW_BAR = 4096;
constexpr int CW_ECNT = 131072;
constexpr int NPHASE = 14;

constexpr int RING_OFF = 0, RING_BYTES = 131072;
constexpr int LDSCTL_OFF = RING_BYTES, MISC_OFF = LDSCTL_OFF + 320;
constexpr int XTRA_OFF = LDSCTL_OFF + 1024;
constexpr int LDS_BYTES = 147456;
constexpr int NWAVES = 8;

__device__ __forceinline__ unsigned f2bf(float f) { unsigned u = __builtin_bit_cast(unsigned, f); return (u + 0x7fffu + ((u >> 16) & 1u)) >> 16; }
__device__ __forceinline__ unsigned pk2(float lo, float hi) { return f2bf(lo) | (f2bf(hi) << 16); }
__device__ __forceinline__ float bflo(unsigned u) { return __builtin_bit_cast(float, u << 16); }
__device__ __forceinline__ float bfhi(unsigned u) { return __builtin_bit_cast(float, u & 0xffff0000u); }
__device__ __forceinline__ float wave_sum(float v) {
#pragma unroll
    for (int o = 1; o < 64; o <<= 1) v += __shfl_xor(v, o);
    return v;
}
__device__ __forceinline__ float wave_max(float v) {
#pragma unroll
    for (int o = 1; o < 64; o <<= 1) v = fmaxf(v, __shfl_xor(v, o));
    return v;
}
__device__ __forceinline__ float sigmoidf_fast(float x) { return __builtin_amdgcn_rcpf(1.0f + __expf(-x)); }

namespace pg8 {
constexpr int BM = 256, BK = 64, HALF = 128, HTB = HALF * BK * 2, STAGE_BYTES = 8 * HTB, NXCD = 8, WGM = 8;
__host__ __device__ __forceinline__ int lds_byte(int r, int c) { const int st = (r >> 4) * 2 + (c >> 5), rr = r & 15, cc = c & 31, ob = rr * 64 + cc * 2; return st * 1024 + (ob ^ (((ob >> 9) & 1) << 5)); }
__host__ __device__ __forceinline__ void stage_rc(int b, int& R, int& C) { const int st = b / 1024, sb = b % 1024, swz = sb ^ (((sb >> 9) & 1) << 5); R = (st >> 1) * 16 + swz / 64; C = (st & 1) * 32 + (swz % 64) / 2; }
__host__ __device__ __forceinline__ int perm32(int rho) { const int n = rho >> 4, i = rho & 15; return 8 * (i >> 2) + 4 * n + (i & 3); }

struct Unit { int pm, pn, z, nvalid; unsigned aoff, boff, goff; };

__device__ __forceinline__ void tile_order(int L, int nM, int nN, int& pm, int& pn) {
    const int nwg = nM * nN; int wgid = L;
    { const int q = nwg / NXCD, r = nwg % NXCD, xcd = wgid % NXCD, off = wgid / NXCD; wgid = (xcd < r ? xcd * (q + 1) : r * (q + 1) + (xcd - r) * q) + off; }
    const int nig = WGM * nN, gid = wgid / nig, fm = gid * WGM, gsz = (nM - fm) < WGM ? (nM - fm) : WGM;
    pm = fm + ((wgid % nig) % gsz); pn = (wgid % nig) / gsz;
}
__device__ __forceinline__ unsigned cvt_pk_bf16(float lo, float hi) { unsigned r; asm volatile("v_cvt_pk_bf16_f32 %0, %1, %2" : "=v"(r) : "v"(lo), "v"(hi)); return r; }

__device__ __forceinline__ void store_tile_bf16(const f32x4 (&acc)[2][2][4][2], bf16* p0, size_t ldc, const float* bias, float scale, int wc, int fq) {
    const int cl = wc * 32 + 8 * fq;
    f32x4 bv[2][2];
#pragma unroll
    for (int bj = 0; bj < 2; ++bj)
#pragma unroll
        for (int n = 0; n < 2; ++n) bv[bj][n] = bias ? *(const f32x4*)(bias + cl + bj * HALF + 4 * n) : (f32x4){0.f, 0.f, 0.f, 0.f};
#pragma unroll
    for (int ai = 0; ai < 2; ++ai)
#pragma unroll
        for (int m = 0; m < 4; ++m) { bf16* rowp = p0 + (size_t)(ai * HALF + m * 16) * ldc + cl;
#pragma unroll
            for (int bj = 0; bj < 2; ++bj) { const f32x4 v0 = (acc[ai][bj][m][0] + bv[bj][0]) * scale, v1 = (acc[ai][bj][m][1] + bv[bj][1]) * scale;
                u32x4 w; w.x = cvt_pk_bf16(v0[0], v0[1]); w.y = cvt_pk_bf16(v0[2], v0[3]); w.z = cvt_pk_bf16(v1[0], v1[1]); w.w = cvt_pk_bf16(v1[2], v1[3]);
                *(u32x4*)(rowp + bj * HALF) = w; } }
}

template <class Epi, class Sched, bool GATHER>
__device__ __forceinline__ void gemm_phase(LAS unsigned char* lds, const char* wsb, const int lda, const int ldb, const int K, const Sched& S, const Epi& E, const int* glist) {
    const int tid = threadIdx.x, wid = __builtin_amdgcn_readfirstlane(tid >> 6), lane = tid & 63, wr = wid >> 2, wc = wid & 3, fr = lane & 15, fq = lane >> 4;
    const int nt = K / BK;
    unsigned voffA[2], voffB[2]; int Rr[2], Cc[2];
#pragma unroll
    for (int i = 0; i < 2; ++i) { int R, C; stage_rc(tid * 16 + i * 8192, R, C); const int Rb = Epi::PERM ? ((R & ~31) + perm32(R & 31)) : R;
        voffA[i] = (unsigned)(R * lda + C) * 2u; voffB[i] = (unsigned)(Rb * ldb + C) * 2u; Rr[i] = R; Cc[i] = C; }
    const size_t kstep = (size_t)(BK * 2);
    const size_t hstepA = (size_t)HALF * lda * 2, hstepB = (size_t)HALF * ldb * 2;
    const unsigned ldsw = (unsigned)wid * 1024u;
    const int aoff = lds_byte(wr * 64 + fr, fq * 8), boff = lds_byte(wc * 32 + fr, fq * 8);
    unsigned gc[2][2], gn[2][2];
#define PG8_SA(b, h) (((b) * 2 + (h)) * HTB)
#define PG8_SB(b, h) ((4 + (b) * 2 + (h)) * HTB)
#define PG8_STAGE_B(bufoff, gbase) do { _Pragma("unroll") for (int _i = 0; _i < 2; ++_i) \
        __builtin_amdgcn_global_load_lds((const unsigned*)((const char*)(gbase) + voffB[_i]), (LAS unsigned*)(lds + (bufoff) + ldsw + _i * 8192), 16, 0, 0); } while (0)
#define PG8_STAGE_A(bufoff, gbase, h, nx) do { _Pragma("unroll") for (int _i = 0; _i < 2; ++_i) { \
        const char* _p = GATHER ? (const char*)(gbase) + ((nx) ? gn[h][_i] : gc[h][_i]) : (const char*)(gbase) + (h) * hstepA + voffA[_i]; \
        __builtin_amdgcn_global_load_lds((const unsigned*)_p, (LAS unsigned*)(lds + (bufoff) + ldsw + _i * 8192), 16, 0, 0); } } while (0)
#define PG8_LDA(dst, b, h) do { _Pragma("unroll") for (int m = 0; m < 4; ++m) _Pragma("unroll") for (int k = 0; k < 2; ++k) dst[m][k] = *(const LAS bf16x8*)(lds + PG8_SA(b, h) + aoff + m * 2048 + k * 1024); } while (0)
#define PG8_LDB(dst, b, h) do { _Pragma("unroll") for (int n = 0; n < 2; ++n) _Pragma("unroll") for (int k = 0; k < 2; ++k) dst[n][k] = *(const LAS bf16x8*)(lds + PG8_SB(b, h) + boff + n * 2048 + k * 1024); } while (0)
#define PG8_MMA(ai, bj, At, Bt) do { __builtin_amdgcn_s_setprio(1); _Pragma("unroll") for (int m = 0; m < 4; ++m) _Pragma("unroll") for (int n = 0; n < 2; ++n) _Pragma("unroll") for (int k = 0; k < 2; ++k) \
        acc[ai][bj][m][n] = __builtin_amdgcn_mfma_f32_16x16x32_bf16(Bt[n][k], At[m][k], acc[ai][bj][m][n], 0, 0, 0); __builtin_amdgcn_s_setprio(0); } while (0)
#define PG8_WAIT_V(n) asm volatile("s_waitcnt vmcnt(" #n ")" ::: "memory")
#define PG8_WAIT_L(n) asm volatile("s_waitcnt lgkmcnt(" #n ")" ::: "memory")
#define PG8_BAR __builtin_amdgcn_s_barrier()
#define PG8_SCHED __builtin_amdgcn_sched_barrier(0)
#define PG8_GIDX(g, u) do { _Pragma("unroll") for (int _h = 0; _h < 2; ++_h) _Pragma("unroll") for (int _i = 0; _i < 2; ++_i) { const int _r = _h * HALF + Rr[_i]; \
        const int _tok = glist[(u).goff + (_r < (u).nvalid ? _r : (u).nvalid - 1)]; g[_h][_i] = (unsigned)_tok * (unsigned)(lda * 2) + (unsigned)(Cc[_i] * 2); } } while (0)
    Unit cur, nxt, nn; int ui = 0;
    if (!S.next(0, cur)) return;
    f32x4 acc[2][2][4][2];
#pragma unroll
    for (int a = 0; a < 2; ++a)
#pragma unroll
        for (int b = 0; b < 2; ++b)
#pragma unroll
            for (int m = 0; m < 4; ++m)
#pragma unroll
                for (int n = 0; n < 2; ++n) acc[a][b][m][n] = (f32x4){0.f, 0.f, 0.f, 0.f};
    bf16x8 At[4][2], B0[2][2], B1[2][2];
    const char* cA = wsb + cur.aoff; const char* cB = wsb + cur.boff;
    if constexpr (GATHER) { PG8_GIDX(gc, cur); if (S.next(1, nxt)) { PG8_GIDX(gn, nxt); } else { PG8_GIDX(gn, cur); }
        asm volatile("s_waitcnt vmcnt(0)" : "+v"(gc[0][0]), "+v"(gc[0][1]), "+v"(gc[1][0]), "+v"(gc[1][1]), "+v"(gn[0][0]), "+v"(gn[0][1]), "+v"(gn[1][0]), "+v"(gn[1][1]) :: "memory"); }
    else {
#pragma unroll
        for (int h = 0; h < 2; ++h)
#pragma unroll
            for (int i = 0; i < 2; ++i) { gc[h][i] = 0u; gn[h][i] = 0u; } }
    PG8_STAGE_B(PG8_SB(0, 0), cB); PG8_STAGE_B(PG8_SB(0, 1), cB + hstepB); PG8_STAGE_A(PG8_SA(0, 0), cA, 0, false); PG8_STAGE_A(PG8_SA(0, 1), cA, 1, false);
    if (wr == 1) PG8_BAR;
    PG8_WAIT_V(2); PG8_BAR;
    PG8_STAGE_B(PG8_SB(1, 0), cB + kstep); PG8_STAGE_A(PG8_SA(1, 0), cA + kstep, 0, false); PG8_STAGE_B(PG8_SB(1, 1), cB + hstepB + kstep);
    PG8_WAIT_V(6); PG8_BAR;
    for (;;) {
        const bool has_next = S.next(ui + 1, nxt);
        const char* nA = has_next ? wsb + nxt.aoff : cA; const char* nB = has_next ? wsb + nxt.boff : cB;
#pragma clang loop unroll(disable)
        for (int t = 0; t < nt; t += 2) {
            const bool last = (t == nt - 2);
            const char* a1 = cA + (size_t)(t + 1) * kstep;
            const char* a2 = last ? nA : cA + (size_t)(t + 2) * kstep; const char* b2 = last ? nB : cB + (size_t)(t + 2) * kstep;
            const char* a3 = a2 + kstep; const char* b3 = b2 + kstep;
            PG8_LDB(B0, 0, 0); PG8_LDB(B1, 0, 1); PG8_SCHED; PG8_LDA(At, 0, 0); PG8_STAGE_A(PG8_SA(1, 1), a1, 1, false);
            PG8_WAIT_V(8); PG8_WAIT_L(0); PG8_BAR; PG8_MMA(0, 0, At, B0); PG8_MMA(0, 1, At, B1); PG8_BAR; PG8_SCHED;
            PG8_LDA(At, 0, 1); PG8_STAGE_B(PG8_SB(0, 0), b2); PG8_STAGE_B(PG8_SB(0, 1), b2 + hstepB); PG8_STAGE_A(PG8_SA(0, 0), a2, 0, last);
            PG8_WAIT_V(8); PG8_WAIT_L(0); PG8_BAR; PG8_MMA(1, 0, At, B0); PG8_MMA(1, 1, At, B1); PG8_BAR; PG8_SCHED;
            PG8_LDB(B0, 1, 0); PG8_LDB(B1, 1, 1); PG8_SCHED; PG8_LDA(At, 1, 0); PG8_STAGE_A(PG8_SA(0, 1), a2, 1, last);
            PG8_WAIT_V(8); PG8_WAIT_L(0); PG8_BAR; PG8_MMA(0, 0, At, B0); PG8_MMA(0, 1, At, B1); PG8_BAR; PG8_SCHED;
            PG8_LDA(At, 1, 1); PG8_STAGE_B(PG8_SB(1, 0), b3); PG8_STAGE_B(PG8_SB(1, 1), b3 + hstepB); PG8_STAGE_A(PG8_SA(1, 0), a3, 0, last);
            PG8_WAIT_V(8); PG8_WAIT_L(0); PG8_BAR; PG8_MMA(1, 0, At, B0); PG8_MMA(1, 1, At, B1); PG8_BAR; PG8_SCHED;
        }
        if (wr == 0) PG8_BAR;
        if constexpr (GATHER) {
#pragma unroll
            for (int h = 0; h < 2; ++h)
#pragma unroll
                for (int i = 0; i < 2; ++i) gc[h][i] = gn[h][i];
            if (has_next && S.next(ui + 2, nn)) { PG8_GIDX(gn, nn); }
        }
        E(acc, cur, wr, wc, fr, fq);
        if constexpr (GATHER) asm volatile("" : "+v"(gn[0][0]), "+v"(gn[0][1]), "+v"(gn[1][0]), "+v"(gn[1][1]));
        if (!has_next) break;
#pragma unroll
        for (int a = 0; a < 2; ++a)
#pragma unroll
            for (int b = 0; b < 2; ++b)
#pragma unroll
                for (int m = 0; m < 4; ++m)
#pragma unroll
                    for (int n = 0; n < 2; ++n) acc[a][b][m][n] = (f32x4){0.f, 0.f, 0.f, 0.f};
        cur = nxt; cA = nA; cB = nB; ++ui;
        if (wr == 1) PG8_BAR;
    }
    PG8_WAIT_V(0);
    PG8_BAR;
#undef PG8_SA
#undef PG8_SB
#undef PG8_STAGE_A
#undef PG8_STAGE_B
#undef PG8_LDA
#undef PG8_LDB
#undef PG8_MMA
#undef PG8_WAIT_V
#undef PG8_WAIT_L
#undef PG8_BAR
#undef PG8_SCHED
#undef PG8_GIDX
}
}
using pg8::Unit;

#define XB_TMO      128
#define XB_XCNT(j)  (256  + 64 * (j))
#define XB_XSUB(j)  (1280 + 64 * (j))
#define XB_XGEN(j)  (2304 + 64 * (j))
#define XB_TOP      3328
#define XB_TOPGEN   3392
#define XCD_BAR_WORDS 3456
#define XB_SPIN_CAP (1u << 18)
__device__ __forceinline__ unsigned xb_ld(unsigned* p)              { return __hip_atomic_load(p, __ATOMIC_RELAXED, __HIP_MEMORY_SCOPE_AGENT); }
__device__ __forceinline__ unsigned xb_add(unsigned* p, unsigned v) { return __hip_atomic_fetch_add(p, v, __ATOMIC_RELAXED, __HIP_MEMORY_SCOPE_AGENT); }
__device__ __forceinline__ unsigned xb_xcc_id() { return (unsigned)__builtin_amdgcn_s_getreg((3 << 11) | 20) & 0xFu; }
#define XB_SPIN(cond, bar) do { unsigned _sp = 0; while (cond) { __builtin_amdgcn_s_sleep(1); \
    if ((++_sp & 255u) == 0u) { if (xb_ld(&(bar)[XB_TMO])) break; if (_sp > XB_SPIN_CAP) { atomicAdd(&(bar)[XB_TMO], 1u); break; } } } } while (0)
struct XcdBarrier { unsigned* bar; unsigned x; volatile LAS unsigned* st; };
__device__ __forceinline__ XcdBarrier xcd_barrier_post(unsigned* bar, volatile LAS unsigned* st) {
    XcdBarrier b; b.bar = bar; b.x = xb_xcc_id(); b.st = st;
    if (threadIdx.x == 0) (void)xb_add(&bar[XB_XCNT(b.x)], 1u);
    return b;
}
__device__ __forceinline__ void xcd_barrier_complete(unsigned* bar, unsigned x, unsigned& nloc, unsigned& nx) {
    const unsigned G = gridDim.x * gridDim.y * gridDim.z;
    unsigned sum, cnt, mine, sp = 0u;
    for (;;) {
        sum = 0u; cnt = 0u; mine = 0u;
#pragma unroll
        for (unsigned j = 0; j < 16; ++j) { const unsigned c = xb_ld(&bar[XB_XCNT(j)]); sum += c; cnt += (c > 0u) ? 1u : 0u; mine = (j == x) ? c : mine; }
        if (sum == G) break;
        __builtin_amdgcn_s_sleep(1);
        if ((++sp & 255u) == 0u) { if (xb_ld(&bar[XB_TMO])) break; if (sp > XB_SPIN_CAP) { atomicAdd(&bar[XB_TMO], 1u); break; } }
    }
    nloc = mine > 0u ? mine : 1u; nx = cnt > 0u ? cnt : 1u;
}
__device__ __forceinline__ void xcd_barrier(const XcdBarrier& b) {
    asm volatile("s_waitcnt vmcnt(0)" ::: "memory");
    __syncthreads();
    if (threadIdx.x == 0) {
        unsigned* bar = b.bar;
        __builtin_amdgcn_s_waitcnt(0);
        unsigned nloc = b.st[0], nx = b.st[1];
        if (nloc == 0u) { xcd_barrier_complete(bar, b.x, nloc, nx); b.st[0] = nloc; b.st[1] = nx; }
        const unsigned old = xb_add(&bar[XB_XSUB(b.x)], 1u);
        const unsigned gen = old / nloc;
        if (old + 1u == (gen + 1u) * nloc) {
            __builtin_amdgcn_fence(__ATOMIC_RELEASE, "agent");
            asm volatile("s_waitcnt vmcnt(0)" ::: "memory");
            const unsigned og = xb_add(&bar[XB_TOP], 1u);
            const unsigned tg = og / nx;
            if (og + 1u == (tg + 1u) * nx) xb_add(&bar[XB_TOPGEN], 1u);
            else XB_SPIN(xb_ld(&bar[XB_TOPGEN]) == tg, bar);
            __builtin_amdgcn_fence(__ATOMIC_ACQUIRE, "agent");
            xb_add(&bar[XB_XGEN(b.x)], 1u);
            asm volatile("s_waitcnt vmcnt(0)" ::: "memory");
        } else {
            XB_SPIN(xb_ld(&bar[XB_XGEN(b.x)]) == gen, bar);
            __builtin_amdgcn_fence(__ATOMIC_ACQUIRE, "agent");
            asm volatile("s_waitcnt vmcnt(0)" ::: "memory");
        }
    }
    __syncthreads();
}

struct Frame {
    LAS unsigned char* lds;
    volatile LAS unsigned* MISC;
    gu32* ctl;
    unsigned char* ws;
    int tid, lane, wave, vcu, G;
    float* hf;
    const float* const* in;
};
enum In { I_X = 0, I_MEM, I_LN_IN_G, I_LN_IN_B, I_LN_MEM_G, I_LN_MEM_B, I_W_IN, I_B_IN, I_W_DW, I_B_DW, I_LN_CONV_G, I_LN_CONV_B, I_W_OUT, I_B_OUT, I_LN1_G, I_LN1_B,
          I_WQ, I_WK, I_WV, I_WO, I_LN2_G, I_LN2_B, I_W_ROUTER, I_B_ROUTER, I_W_GU, I_B_GU, I_W_DOWN, I_B_DOWN, I_LN3_G, I_LN3_B, N_IN };

__device__ __forceinline__ void p0_transpose_item(const float* W, int K, int N, bf16* WT, int k0, int n0, int drow, LAS float* scr, int lane) {
#pragma unroll 8
    for (int i = 0; i < 32; ++i) { const int kk = 2 * i + (lane >> 5); scr[kk * 33 + (lane & 31)] = W[(size_t)(k0 + kk) * N + n0 + (lane & 31)]; }
    LDS_WAIT(); asm volatile("" ::: "memory");
    const int c = lane & 7;
#pragma unroll
    for (int j = 0; j < 4; ++j) { const int n = (lane >> 3) + 8 * j; const LAS float* s = scr + (8 * c) * 33 + n;
        u32x4 o; o.x = pk2(s[0 * 33], s[1 * 33]); o.y = pk2(s[2 * 33], s[3 * 33]); o.z = pk2(s[4 * 33], s[5 * 33]); o.w = pk2(s[6 * 33], s[7 * 33]);
        *(GAS u32x4*)(WT + (size_t)(drow + n) * K + k0 + 8 * c) = o; }
    LDS_WAIT(); asm volatile("" ::: "memory");
}
__device__ __forceinline__ void ln_row(f32x4 (&v)[4], const float* g, const float* b, int lane) {
    float s = 0.f;
#pragma unroll
    for (int j = 0; j < 4; ++j) s += (v[j].x + v[j].y) + (v[j].z + v[j].w);
    const float mean = wave_sum(s) * (1.f / D); float s2 = 0.f;
#pragma unroll
    for (int j = 0; j < 4; ++j) { v[j] = v[j] - mean; s2 += (v[j].x * v[j].x + v[j].y * v[j].y) + (v[j].z * v[j].z + v[j].w * v[j].w); }
    const float rstd = 1.f / sqrtf(wave_sum(s2) * (1.f / D) + LN_EPS);
#pragma unroll
    for (int j = 0; j < 4; ++j) { const f32x4 gg = ((const GAS f32x4*)g)[lane + 64 * j], bb = ((const GAS f32x4*)b)[lane + 64 * j]; v[j] = v[j] * rstd * gg + bb; }
}
__device__ __forceinline__ void store_row_bf16(const f32x4 (&v)[4], bf16* orow, int lane) {
    GAS u32x2* o8 = (GAS u32x2*)orow + lane;
#pragma unroll
    for (int j = 0; j < 4; ++j) o8[64 * j] = (u32x2){pk2(v[j].x, v[j].y), pk2(v[j].z, v[j].w)};
}
__device__ __forceinline__ void load_row_f32(f32x4 (&v)[4], const float* xrow, int lane) {
    const GAS f32x4* xr = (const GAS f32x4*)xrow + lane;
#pragma unroll
    for (int j = 0; j < 4; ++j) v[j] = xr[64 * j];
}
__device__ __forceinline__ void store_row_f32(const f32x4 (&v)[4], float* orow, int lane) {
    GAS f32x4* o = (GAS f32x4*)orow + lane;
#pragma unroll
    for (int j = 0; j < 4; ++j) o[64 * j] = v[j];
}

__device__ __forceinline__ void p0_prologue(Frame& F) {
    LAS float* scr = (LAS float*)(F.lds + RING_OFF + F.wave * 16384);
    const int gw = F.vcu * NWAVES + F.wave, NGW = F.G * NWAVES;
    constexpr int I_IN = 16 * 80, I_SQ = 16 * 32, I_GU = NE * 16 * 64, I_DN = NE * 16 * 32;
    constexpr int NITEMS = I_IN + 5 * I_SQ + I_GU + I_DN;
    for (int it = gw; it < NITEMS; it += NGW) {
        int r = it;
        if (r < I_IN) { const int kb = r / 80, nb = r % 80, n0 = 32 * nb; int drow;
            if (n0 < 512) drow = (n0 >> 7) * 256 + (n0 & 127); else if (n0 < 1024) drow = ((n0 - 512) >> 7) * 256 + 128 + (n0 & 127); else drow = n0;
            p0_transpose_item(F.in[I_W_IN], D, INC, (bf16*)(F.ws + WS_WIN_T), 64 * kb, n0, drow, scr, F.lane); continue; } r -= I_IN;
        if (r < 5 * I_SQ) { const int w = r / I_SQ, q = r % I_SQ, kb = q / 32, nb = q % 32;
            const float* src = F.in[w == 0 ? I_W_OUT : w == 1 ? I_WQ : w == 2 ? I_WK : w == 3 ? I_WV : I_WO];
            bf16* dst = (bf16*)(F.ws + (w == 0 ? WS_WOUT_T : w == 1 ? WS_WQ_T : w == 2 ? WS_WK_T : w == 3 ? WS_WV_T : WS_WO_T));
            p0_transpose_item(src, D, D, dst, 64 * kb, 32 * nb, 32 * nb, scr, F.lane); continue; } r -= 5 * I_SQ;
        if (r < I_GU) { const int e = r / (16 * 64), q = r % (16 * 64), kb = q / 64, nb = q % 64, n0 = 32 * nb;
            const int drow = (n0 < 1024) ? (n0 >> 7) * 256 + (n0 & 127) : ((n0 - 1024) >> 7) * 256 + 128 + (n0 & 127);
            p0_transpose_item(F.in[I_W_GU] + (size_t)e * D * 2 * DFF, D, 2 * DFF, (bf16*)(F.ws + WS_WGU_T) + (size_t)e * 2 * DFF * D, 64 * kb, n0, drow, scr, F.lane); continue; } r -= I_GU;
        { const int e = r / (16 * 32), q = r % (16 * 32), kb = q / 32, nb = q % 32;
            p0_transpose_item(F.in[I_W_DOWN] + (size_t)e * DFF * D, DFF, D, (bf16*)(F.ws + WS_WDN_T) + (size_t)e * D * DFF, 64 * kb, 32 * nb, 32 * nb, scr, F.lane); }
    }
    for (int m = gw; m < M + MM; m += NGW) {
        f32x4 v[4];
        if (m < M) { load_row_f32(v, F.in[I_X] + (size_t)m * D, F.lane); ln_row(v, F.in[I_LN_IN_G], F.in[I_LN_IN_B], F.lane);
            store_row_f32(v, F.hf + (size_t)m * D, F.lane); store_row_bf16(v, (bf16*)(F.ws + WS_HB) + (size_t)m * D, F.lane); }
        else { const int mm = m - M; load_row_f32(v, F.in[I_MEM] + (size_t)mm * D, F.lane); ln_row(v, F.in[I_LN_MEM_G], F.in[I_LN_MEM_B], F.lane);
            store_row_bf16(v, (bf16*)(F.ws + WS_MEMN) + (size_t)mm * D, F.lane); }
    }
}

constexpr unsigned TSTEP = 256u * 1024u * 2u;
struct SchedP1 { int G, c;
    __device__ __forceinline__ bool next(int i, Unit& u) const {
        const int L = i * G + c; if (L >= 1344) return false;
        u.nvalid = 256; u.goff = 0;
        if (L < 1024) { pg8::tile_order(L, 128, 8, u.pm, u.pn); u.z = 0; u.aoff = (unsigned)WS_HB + (unsigned)u.pm * TSTEP; u.boff = (unsigned)WS_WIN_T + (unsigned)u.pn * TSTEP; }
        else if (L < 1280) { const int j = L - 1024; u.pm = j & 1; u.pn = j >> 1; u.z = 3; u.aoff = (unsigned)WS_WIN_T + (unsigned)(8 + u.pm) * TSTEP; u.boff = (unsigned)WS_HB + (unsigned)u.pn * TSTEP; }
        else if (L < 1312) { const int j = L - 1280; u.pm = j & 7; u.pn = j >> 3; u.z = 1; u.aoff = (unsigned)WS_MEMN + (unsigned)u.pm * TSTEP; u.boff = (unsigned)WS_WK_T + (unsigned)u.pn * TSTEP; }
        else { const int j = L - 1312; u.pm = j & 3; u.pn = j >> 2; u.z = 2; u.aoff = (unsigned)WS_WV_T + (unsigned)u.pm * TSTEP; u.boff = (unsigned)WS_MEMN + (unsigned)u.pn * TSTEP; }
        return true; }
};
struct EpiP1 { static constexpr bool PERM = true;
    unsigned char* ws; const float* b_in;
    __device__ __forceinline__ void operator()(const f32x4 (&acc)[2][2][4][2], const Unit& u, int wr, int wc, int fr, int fq) const {
        const int row0 = u.pm * 256 + wr * 64 + fr;
        if (u.z == 0) {
            if (u.pn < 4) {
                const int ch = 128 * u.pn + wc * 32 + 8 * fq;
                f32x4 bv[2], bg[2];
#pragma unroll
                for (int n = 0; n < 2; ++n) { bv[n] = *(const f32x4*)(b_in + ch + 4 * n); bg[n] = *(const f32x4*)(b_in + 512 + ch + 4 * n); }
                bf16* U = (bf16*)(ws + WS_U);
#pragma unroll
                for (int ai = 0; ai < 2; ++ai)
#pragma unroll
                    for (int m = 0; m < 4; ++m) { f32x4 o[2];
#pragma unroll
                        for (int n = 0; n < 2; ++n) { const f32x4 a = acc[ai][0][m][n] + bv[n], g = acc[ai][1][m][n] + bg[n];
#pragma unroll
                            for (int j = 0; j < 4; ++j) o[n][j] = a[j] * sigmoidf_fast(g[j]); }
                        u32x4 w; w.x = pg8::cvt_pk_bf16(o[0][0], o[0][1]); w.y = pg8::cvt_pk_bf16(o[0][2], o[0][3]); w.z = pg8::cvt_pk_bf16(o[1][0], o[1][1]); w.w = pg8::cvt_pk_bf16(o[1][2], o[1][3]);
                        *(u32x4*)(U + (size_t)(row0 + ai * 128 + m * 16) * 512 + ch) = w; }
            } else {
                const int t = u.pn - 4, which = t >> 1, cb = (t & 1) * 256;
                bf16* dst = (bf16*)(ws + (which == 0 ? WS_Q : WS_K));
                pg8::store_tile_bf16(acc, dst + (size_t)row0 * 512 + cb, 512, b_in + 1024 + 256 * t, which == 0 ? SB_QSCALE : 1.0f, wc, fq);
            }
        } else if (u.z == 3) {
            const float* rb = b_in + 2048 + row0; bf16* p0 = (bf16*)(ws + WS_V) + (size_t)row0 * M + 256 * u.pn; const int cl = wc * 32 + 8 * fq;
#pragma unroll
            for (int ai = 0; ai < 2; ++ai)
#pragma unroll
                for (int m = 0; m < 4; ++m) { const float bv = rb[ai * 128 + m * 16]; bf16* rowp = p0 + (size_t)(ai * 128 + m * 16) * M + cl;
#pragma unroll
                    for (int bj = 0; bj < 2; ++bj) { const f32x4 v0 = acc[ai][bj][m][0] + bv, v1 = acc[ai][bj][m][1] + bv;
                        u32x4 w; w.x = pg8::cvt_pk_bf16(v0[0], v0[1]); w.y = pg8::cvt_pk_bf16(v0[2], v0[3]); w.z = pg8::cvt_pk_bf16(v1[0], v1[1]); w.w = pg8::cvt_pk_bf16(v1[2], v1[3]);
                        *(u32x4*)(rowp + bj * 128) = w; } }
        } else if (u.z == 1) pg8::store_tile_bf16(acc, (bf16*)(ws + WS_KM) + (size_t)row0 * 1024 + 256 * u.pn, 1024, nullptr, 1.0f, wc, fq);
        else pg8::store_tile_bf16(acc, (bf16*)(ws + WS_VMT) + (size_t)row0 * 2048 + 256 * u.pn, 2048, nullptr, 1.0f, wc, fq);
    }
};

struct SchedPlain { int G, c, nM, nN; unsigned abase, bbase, atile, btile, acol, bcol, bgrp;
    __device__ __forceinline__ bool next(int i, Unit& u) const {
        const int L = i * G + c; if (L >= nM * nN) return false;
        pg8::tile_order(L, nM, nN, u.pm, u.pn); u.z = 0; u.nvalid = 256; u.goff = 0;
        u.aoff = abase + (unsigned)u.pm * atile + (unsigned)u.pn * acol; u.boff = bbase + (unsigned)u.pn * btile + (unsigned)(u.pm >> 4) * bgrp + (unsigned)u.pn * bcol; return true; }
};
struct EpiBf16 { static constexpr bool PERM = true;
    bf16* O; int ldc; float scale;
    __device__ __forceinline__ void operator()(const f32x4 (&acc)[2][2][4][2], const Unit& u, int wr, int wc, int fr, int fq) const {
        pg8::store_tile_bf16(acc, O + (size_t)(u.pm * 256 + wr * 64 + fr) * ldc + 256 * u.pn, (size_t)ldc, nullptr, scale, wc, fq); }
};
struct EpiResid { static constexpr bool PERM = false;
    float* hf; const float* bias;
    __device__ __forceinline__ void operator()(const f32x4 (&acc)[2][2][4][2], const Unit& u, int wr, int wc, int fr, int fq) const {
        const int row0 = u.pm * 256 + wr * 64 + fr, col0 = u.pn * 256 + wc * 32 + 4 * fq;
        f32x4 bv[2][2];
#pragma unroll
        for (int bj = 0; bj < 2; ++bj)
#pragma unroll
            for (int n = 0; n < 2; ++n) bv[bj][n] = bias ? *(const f32x4*)(bias + col0 + bj * 128 + n * 16) : (f32x4){0.f, 0.f, 0.f, 0.f};
#pragma unroll
        for (int ai = 0; ai < 2; ++ai)
#pragma unroll
            for (int m = 0; m < 4; ++m) { float* rowp = hf + (size_t)(row0 + ai * 128 + m * 16) * D + col0;
#pragma unroll
                for (int bj = 0; bj < 2; ++bj)
#pragma unroll
                    for (int n = 0; n < 2; ++n) { float* p = rowp + bj * 128 + n * 16; const f32x4 x = *(const f32x4*)p; *(f32x4*)p = x * DN_ALPHA + acc[ai][bj][m][n] + bv[bj][n]; }
                asm volatile("" ::: "memory"); }
    }
};

struct SchedMoe { int G, c, nN; const LAS int* tb; unsigned abase, wbase, wexp;
    bool gather;
    __device__ __forceinline__ bool next(int i, Unit& u) const {
        const int nblk = __builtin_amdgcn_readfirstlane(tb[32]); const int L = i * G + c; if (L >= nblk * nN) return false;
        pg8::tile_order(L, nblk, nN, u.pm, u.pn);
        int e = 0; while (tb[e + 1] <= u.pm) ++e;
        e = __builtin_amdgcn_readfirstlane(e);
        const int j = u.pm - tb[e], rem = tb[64 + e] - 256 * j;
        u.z = e; u.nvalid = rem < 256 ? rem : 256; u.goff = (unsigned)(e * LCAP + 256 * j);
        u.aoff = gather ? abase : abase + (unsigned)u.pm * TSTEP;
        u.boff = wbase + (unsigned)e * wexp + (unsigned)u.pn * TSTEP; return true; }
};
struct EpiAct { static constexpr bool PERM = true;
    bf16* ACT; const float* b_gu;
    __device__ __forceinline__ void operator()(const f32x4 (&acc)[2][2][4][2], const Unit& u, int wr, int wc, int fr, int fq) const {
        const int row0 = u.pm * 256 + wr * 64 + fr, ch = 128 * u.pn + wc * 32 + 8 * fq;
        const float* bb = b_gu + (size_t)u.z * 2 * DFF;
        f32x4 bg[2], bu[2];
#pragma unroll
        for (int n = 0; n < 2; ++n) { bg[n] = *(const f32x4*)(bb + ch + 4 * n); bu[n] = *(const f32x4*)(bb + DFF + ch + 4 * n); }
#pragma unroll
        for (int ai = 0; ai < 2; ++ai)
#pragma unroll
            for (int m = 0; m < 4; ++m) { f32x4 o[2];
#pragma unroll
                for (int n = 0; n < 2; ++n) { const f32x4 g = acc[ai][0][m][n] + bg[n], uu = acc[ai][1][m][n] + bu[n];
#pragma unroll
                    for (int j = 0; j < 4; ++j) { const float g_ = fminf(g[j], 7.0f), u_ = fminf(fmaxf(uu[j], -7.0f), 7.0f); o[n][j] = (u_ + 1.0f) * g_ * sigmoidf_fast(1.702f * g_); } }
                u32x4 w; w.x = pg8::cvt_pk_bf16(o[0][0], o[0][1]); w.y = pg8::cvt_pk_bf16(o[0][2], o[0][3]); w.z = pg8::cvt_pk_bf16(o[1][0], o[1][1]); w.w = pg8::cvt_pk_bf16(o[1][2], o[1][3]);
                *(u32x4*)(ACT + (size_t)(row0 + ai * 128 + m * 16) * DFF + ch) = w; }
    }
};
struct EpiDown { static constexpr bool PERM = true;
    bf16* YS; const float* b_down; const float* lgate;
    __device__ __forceinline__ void operator()(const f32x4 (&acc)[2][2][4][2], const Unit& u, int wr, int wc, int fr, int fq) const {
        const int r0 = wr * 64 + fr, cl = wc * 32 + 8 * fq;
        const float* bb = b_down + (size_t)u.z * D + 256 * u.pn + cl;
        f32x4 bv[2][2];
#pragma unroll
        for (int bj = 0; bj < 2; ++bj)
#pragma unroll
            for (int n = 0; n < 2; ++n) bv[bj][n] = *(const f32x4*)(bb + bj * 128 + 4 * n);
#pragma unroll
        for (int ai = 0; ai < 2; ++ai)
#pragma unroll
            for (int m = 0; m < 4; ++m) { const int r = r0 + ai * 128 + m * 16; const float gl = lgate[u.goff + (r < u.nvalid ? r : u.nvalid - 1)]; const float gt = (r < u.nvalid) ? gl : 0.f;
                bf16* rowp = YS + (size_t)(u.pm * 256 + r) * D + 256 * u.pn + cl;
#pragma unroll
                for (int bj = 0; bj < 2; ++bj) { const f32x4 v0 = (acc[ai][bj][m][0] + bv[bj][0]) * gt, v1 = (acc[ai][bj][m][1] + bv[bj][1]) * gt;
                    u32x4 w; w.x = pg8::cvt_pk_bf16(v0[0], v0[1]); w.y = pg8::cvt_pk_bf16(v0[2], v0[3]); w.z = pg8::cvt_pk_bf16(v1[0], v1[1]); w.w = pg8::cvt_pk_bf16(v1[2], v1[3]);
                    *(u32x4*)(rowp + bj * 128) = w; } }
    }
};
__device__ __forceinline__ void moe_table(Frame& F, LAS int* tb) {
    if (F.tid < 32) { int c = (int)__hip_atomic_load(F.ctl + CW_ECNT + 64 * F.tid, RLX_AGENT); if (c > LCAP) c = LCAP; tb[64 + F.tid] = c; }
    LDS_WAIT(); __syncthreads();
    if (F.tid == 0) { int s = 0; for (int e = 0; e < NE; ++e) { tb[e] = s; s += (tb[64 + e] + 255) >> 8; } tb[32] = s; }
    LDS_WAIT(); __syncthreads();
}

__device__ __forceinline__ void conv_phase(Frame& F) {
    LAS unsigned* ut = (LAS unsigned*)(F.lds + RING_OFF);
    LAS float* co = (LAS float*)(F.lds + RING_OFF + 65536);
    const int cp = F.tid & 255, half = F.tid >> 8;
    float w0[CWID], w1[CWID];
    { const float* wd = F.in[I_W_DW] + 2 * cp;
#pragma unroll
        for (int j = 0; j < CWID; ++j) { const f32x2 w = *(const GAS f32x2*)(wd + j * CONV_CH); w0[j] = w.x; w1[j] = w.y; } }
    const f32x2 bd = *(const GAS f32x2*)(F.in[I_B_DW] + 2 * cp);
    const f32x4 g0 = *(const GAS f32x4*)(F.in[I_LN_CONV_G] + 8 * F.lane), g1 = *(const GAS f32x4*)(F.in[I_LN_CONV_G] + 8 * F.lane + 4);
    const f32x4 b0 = *(const GAS f32x4*)(F.in[I_LN_CONV_B] + 8 * F.lane), b1 = *(const GAS f32x4*)(F.in[I_LN_CONV_B] + 8 * F.lane + 4);
    bf16* MX = (bf16*)(F.ws + WS_MIXIN);
    for (int it = F.vcu; it < NB * (T_ / 32); it += F.G) {
        const int b = it / (T_ / 32), t0 = (it % (T_ / 32)) * 32;
        const bf16* U = (const bf16*)(F.ws + WS_U) + (size_t)b * T_ * CONV_CH;
        for (int idx = F.tid; idx < 62 * 64; idx += 512) { const int r = idx >> 6, c16 = idx & 63, t = t0 - 30 + r;
            u32x4 v = (u32x4){0u, 0u, 0u, 0u}; if (t >= 0) v = *(const GAS u32x4*)(U + (size_t)t * CONV_CH + c16 * 8);
            *(LAS u32x4*)(ut + r * 256 + c16 * 4) = v; }
        LDS_WAIT(); __syncthreads();
        { float a0[16], a1[16];
#pragma unroll
            for (int tt = 0; tt < 16; ++tt) { a0[tt] = bd.x; a1[tt] = bd.y; }
#pragma unroll
            for (int r = 0; r < 46; ++r) { const unsigned uu = ut[(half * 16 + r) * 256 + cp]; const float u0 = bflo(uu), u1 = bfhi(uu);
#pragma unroll
                for (int tt = 0; tt < 16; ++tt) { const int j = r - tt; if (j >= 0 && j < CWID) { a0[tt] += w0[j] * u0; a1[tt] += w1[j] * u1; } } }
#pragma unroll
            for (int tt = 0; tt < 16; ++tt) *(LAS f32x2*)(co + (half * 16 + tt) * CONV_CH + 2 * cp) = (f32x2){a0[tt], a1[tt]};
        }
        LDS_WAIT(); __syncthreads();
#pragma unroll
        for (int q = 0; q < 4; ++q) { const int tt = 4 * F.wave + q;
            f32x4 x0 = *(const LAS f32x4*)(co + tt * CONV_CH + 8 * F.lane), x1 = *(const LAS f32x4*)(co + tt * CONV_CH + 8 * F.lane + 4);
            const float mean = wave_sum((x0.x + x0.y) + (x0.z + x0.w) + (x1.x + x1.y) + (x1.z + x1.w)) * (1.f / CONV_CH);
            x0 = x0 - mean; x1 = x1 - mean;
            const float var = wave_sum((x0.x * x0.x + x0.y * x0.y) + (x0.z * x0.z + x0.w * x0.w) + (x1.x * x1.x + x1.y * x1.y) + (x1.z * x1.z + x1.w * x1.w)) * (1.f / CONV_CH);
            const float rstd = 1.f / sqrtf(var + LN_EPS);
            x0 = x0 * rstd * g0 + b0; x1 = x1 * rstd * g1 + b1;
            float y[8] = {x0.x, x0.y, x0.z, x0.w, x1.x, x1.y, x1.z, x1.w};
#pragma unroll
            for (int j = 0; j < 8; ++j) y[j] = y[j] * sigmoidf_fast(y[j]);
            *(GAS u32x4*)(MX + (size_t)(b * T_ + t0 + tt) * D + 8 * F.lane) = (u32x4){pk2(y[0], y[1]), pk2(y[2], y[3]), pk2(y[4], y[5]), pk2(y[6], y[7])}; }
        __syncthreads();
    }
}

typedef float f32x16 __attribute__((ext_vector_type(16)));
__device__ __forceinline__ int crow(int r, int hi) { return (r & 3) + 8 * (r >> 2) + 4 * hi; }
__device__ __forceinline__ bf16x8 pack8(const float* v) {
    u32x4 w; w.x = pg8::cvt_pk_bf16(v[0], v[1]); w.y = pg8::cvt_pk_bf16(v[2], v[3]); w.z = pg8::cvt_pk_bf16(v[4], v[5]); w.w = pg8::cvt_pk_bf16(v[6], v[7]);
    return __builtin_bit_cast(bf16x8, w); }
constexpr float SB_EXIT = 150.0f;
struct SbFrag { bf16x8 k[4]; u32x2 v[2][2][2]; };
__device__ __forceinline__ void sb_load(SbFrag& f, const bf16* Kl, const bf16* Vl, int kt) {
    const bf16* kp = Kl + (size_t)(32 * kt) * SBW;
#pragma unroll
    for (int s = 0; s < 4; ++s) f.k[s] = *(const GAS bf16x8*)(kp + 16 * s);
#pragma unroll
    for (int dt = 0; dt < 2; ++dt)
#pragma unroll
        for (int s = 0; s < 2; ++s) { const bf16* vp = Vl + (size_t)dt * 32 * M + 32 * kt + 16 * s; f.v[dt][s][0] = *(const GAS u32x2*)vp; f.v[dt][s][1] = *(const GAS u32x2*)(vp + 8); }
}
__device__ __forceinline__ void sb_attn_wave(Frame& F, int b, int h, int qt) {
    const int c = F.lane & 31, hi = F.lane >> 5;
    const bf16* Q = (const bf16*)(F.ws + WS_Q); const bf16* Kb = (const bf16*)(F.ws + WS_K); const bf16* VT = (const bf16*)(F.ws + WS_V);
    bf16x8 tri[2];
#pragma unroll
    for (int s = 0; s < 2; ++s) { bf16x8 t;
#pragma unroll
        for (int j = 0; j < 8; ++j) { const int k = 16 * s + 8 * (j >> 2) + 4 * hi + (j & 3); t[j] = (k >= c) ? (short)0xBF80 : (short)0; }
        tri[s] = t; }
    bf16x8 qf[4];
    { const bf16* qp = Q + ((size_t)b * T_ + 32 * qt + c) * SBW + h * SBD + 8 * hi;
#pragma unroll
        for (int s = 0; s < 4; ++s) qf[s] = *(const GAS bf16x8*)(qp + 16 * s); }
    const bf16* Kl = Kb + ((size_t)b * T_ + c) * SBW + h * SBD + 8 * hi;
    const bf16* Vl = VT + (size_t)(h * SBD + c) * M + (size_t)b * T_ + 4 * hi;
    f32x16 o0, o1;
#pragma unroll
    for (int r = 0; r < 16; ++r) { o0[r] = 0.f; o1[r] = 0.f; }
    float carry = 0.f;
    SbFrag fa, fb;
    sb_load(fa, Kl, Vl, qt);
#define SB_TILE(f, DIAG) do { \
        f32x16 p; _Pragma("unroll") for (int r = 0; r < 16; ++r) p[r] = 0.f; \
        _Pragma("unroll") for (int s = 0; s < 4; ++s) p = __builtin_amdgcn_mfma_f32_32x32x16_bf16(f.k[s], qf[s], p, 0, 0, 0); \
        float L[16]; \
        _Pragma("unroll") for (int r = 0; r < 16; ++r) { const float y = p[r]; float l = __builtin_amdgcn_logf(1.0f + __builtin_amdgcn_exp2f(fminf(y, 100.f))); l = fmaxf(l, y); \
            if (DIAG) l = (crow(r, hi) >= c) ? 0.f : l; L[r] = l; } \
        const bf16x8 l0 = pack8(L), l1 = pack8(L + 8); \
        f32x16 a; _Pragma("unroll") for (int r = 0; r < 16; ++r) a[r] = p[r] - carry; \
        a = __builtin_amdgcn_mfma_f32_32x32x16_bf16(tri[0], l0, a, 0, 0, 0); a = __builtin_amdgcn_mfma_f32_32x32x16_bf16(tri[1], l1, a, 0, 0, 0); \
        const float tot = p[0] - a[0];                                     \
        float w[16]; \
        _Pragma("unroll") for (int r = 0; r < 16; ++r) { float x = __builtin_amdgcn_exp2f(a[r]); if (DIAG) x = (crow(r, hi) >= c) ? 0.f : x; w[r] = x; } \
        const bf16x8 p0 = pack8(w), p1 = pack8(w + 8); \
        { const bf16x8 v00 = __builtin_bit_cast(bf16x8, (u32x4){f.v[0][0][0].x, f.v[0][0][0].y, f.v[0][0][1].x, f.v[0][0][1].y}); \
          const bf16x8 v01 = __builtin_bit_cast(bf16x8, (u32x4){f.v[0][1][0].x, f.v[0][1][0].y, f.v[0][1][1].x, f.v[0][1][1].y}); \
          const bf16x8 v10 = __builtin_bit_cast(bf16x8, (u32x4){f.v[1][0][0].x, f.v[1][0][0].y, f.v[1][0][1].x, f.v[1][0][1].y}); \
          const bf16x8 v11 = __builtin_bit_cast(bf16x8, (u32x4){f.v[1][1][0].x, f.v[1][1][0].y, f.v[1][1][1].x, f.v[1][1][1].y}); \
          o0 = __builtin_amdgcn_mfma_f32_32x32x16_bf16(v00, p0, o0, 0, 0, 0); o0 = __builtin_amdgcn_mfma_f32_32x32x16_bf16(v01, p1, o0, 0, 0, 0); \
          o1 = __builtin_amdgcn_mfma_f32_32x32x16_bf16(v10, p0, o1, 0, 0, 0); o1 = __builtin_amdgcn_mfma_f32_32x32x16_bf16(v11, p1, o1, 0, 0, 0); } \
        carry = __shfl(tot, c); } while (0)
    if (qt > 0) sb_load(fb, Kl, Vl, qt - 1);
    SB_TILE(fa, true);
    int kt = qt - 1;
    while (kt >= 0) {
        if (__all(carry >= SB_EXIT)) break;
        if (kt > 0) sb_load(fa, Kl, Vl, kt - 1);
        SB_TILE(fb, false);
        --kt; if (kt < 0) break;
        if (__all(carry >= SB_EXIT)) break;
        if (kt > 0) sb_load(fb, Kl, Vl, kt - 1);
        SB_TILE(fa, false);
        --kt;
    }
#undef SB_TILE
    bf16* op = (bf16*)(F.ws + WS_MIXIN) + ((size_t)b * T_ + 32 * qt + c) * D + CONV_CH + h * SBD + 4 * hi;
#pragma unroll
    for (int g = 0; g < 4; ++g) {
        *(GAS u32x2*)(op + 8 * g) = (u32x2){pg8::cvt_pk_bf16(o0[4 * g], o0[4 * g + 1]), pg8::cvt_pk_bf16(o0[4 * g + 2], o0[4 * g + 3])};
        *(GAS u32x2*)(op + 32 + 8 * g) = (u32x2){pg8::cvt_pk_bf16(o1[4 * g], o1[4 * g + 1]), pg8::cvt_pk_bf16(o1[4 * g + 2], o1[4 * g + 3])}; }
}

__device__ __forceinline__ void ln_phase(Frame& F, const float* g, const float* b) {
    const int gw = F.vcu * NWAVES + F.wave, NGW = F.G * NWAVES;
    for (int m = gw; m < M; m += NGW) { f32x4 v[4]; load_row_f32(v, F.hf + (size_t)m * D, F.lane); ln_row(v, g, b, F.lane);
        store_row_f32(v, F.hf + (size_t)m * D, F.lane); store_row_bf16(v, (bf16*)(F.ws + WS_HB) + (size_t)m * D, F.lane); }
}
__device__ __forceinline__ void softmax_phase(Frame& F) {
    const int gw = F.vcu * NWAVES + F.wave, NGW = F.G * NWAVES;
    for (int m = gw; m < M; m += NGW) { GAS u32x2* p = (GAS u32x2*)((bf16*)(F.ws + WS_SP) + (size_t)m * D) + F.lane;
#pragma unroll
        for (int j = 0; j < 4; ++j) { const u32x2 w = p[64 * j]; float x0 = bflo(w.x), x1 = bfhi(w.x), x2 = bflo(w.y), x3 = bfhi(w.y);
            const float mx = wave_max(fmaxf(fmaxf(x0, x1), fmaxf(x2, x3)));
            x0 = __builtin_amdgcn_exp2f(x0 - mx); x1 = __builtin_amdgcn_exp2f(x1 - mx); x2 = __builtin_amdgcn_exp2f(x2 - mx); x3 = __builtin_amdgcn_exp2f(x3 - mx);
            const float inv = 1.0f / wave_sum((x0 + x1) + (x2 + x3));
            p[64 * j] = (u32x2){pk2(x0 * inv, x1 * inv), pk2(x2 * inv, x3 * inv)}; } }
}
__device__ __forceinline__ void ln2_router_phase(Frame& F) {
    LAS float* wT = (LAS float*)(F.lds + RING_OFF);
    LAS int* lcnt = (LAS int*)(F.lds + XTRA_OFF);
    LAS int* rec = (LAS int*)(F.lds + XTRA_OFF + 512);
    const float* wr_ = F.in[I_W_ROUTER];
    for (int idx = F.tid; idx < D * NE; idx += 512) { const int c = idx >> 5, e = idx & 31; wT[e * D + c] = wr_[idx]; }
    if (F.tid < 64) lcnt[F.tid] = 0;
    LDS_WAIT(); __syncthreads();
    const int gw = F.vcu * NWAVES + F.wave, NGW = F.G * NWAVES;
    const float brt = F.lane < NE ? F.in[I_B_ROUTER][F.lane] : 0.f;
    int it = 0;
    for (int m = gw; m < M; m += NGW, ++it) {
        f32x4 v[4]; load_row_f32(v, F.hf + (size_t)m * D, F.lane); ln_row(v, F.in[I_LN2_G], F.in[I_LN2_B], F.lane);
        store_row_f32(v, F.hf + (size_t)m * D, F.lane); store_row_bf16(v, (bf16*)(F.ws + WS_HB) + (size_t)m * D, F.lane);
        float logit = -INFINITY;
        for (int e = 0; e < NE; ++e) { float p = 0.f;
#pragma unroll
            for (int j = 0; j < 4; ++j) { const f32x4 w = *(const LAS f32x4*)(wT + e * D + 256 * j + 4 * F.lane); p += (v[j].x * w.x + v[j].y * w.y) + (v[j].z * w.z + v[j].w * w.w); }
            p = wave_sum(p); if (F.lane == e) logit = p + brt; }
        float tv[TOPK]; int te[TOPK];
#pragma unroll
        for (int k = 0; k < TOPK; ++k) { const float mx = wave_max(logit); const unsigned long long bal = __ballot(logit == mx); const int e = __builtin_ctzll(bal);
            tv[k] = mx; te[k] = e; if (F.lane == e) logit = -INFINITY; }
        float pe[TOPK], ps = 0.f;
#pragma unroll
        for (int k = 0; k < TOPK; ++k) { pe[k] = __expf(tv[k] - tv[0]); ps += pe[k]; }
        if (F.lane < TOPK) { const int k = F.lane; const int e = k == 0 ? te[0] : k == 1 ? te[1] : k == 2 ? te[2] : te[3]; const float g = (k == 0 ? pe[0] : k == 1 ? pe[1] : k == 2 ? pe[2] : pe[3]) / ps;
            const int lr = __hip_atomic_fetch_add(lcnt + e, 1, __ATOMIC_RELAXED, __HIP_MEMORY_SCOPE_WORKGROUP);
            LAS int* r = rec + ((F.wave * 16 + (it & 15)) * 4 + k) * 4; r[0] = e; r[1] = lr; r[2] = __builtin_bit_cast(int, g); r[3] = m; }
    }
    LDS_WAIT(); __syncthreads();
    if (F.tid < NE) lcnt[32 + F.tid] = (int)__hip_atomic_fetch_add(F.ctl + CW_ECNT + 64 * F.tid, (unsigned)lcnt[F.tid], RLX_AGENT);
    LDS_WAIT(); __syncthreads();
    int* ltok = (int*)(F.ws + WS_LTOK); float* lgate = (float*)(F.ws + WS_LGATE); int* sidx = (int*)(F.ws + WS_SIDX);
    const int nrec = it * 4;
    for (int i = F.lane; i < nrec; i += 64) { const LAS int* r = rec + (F.wave * 64 + i) * 4; const int e = r[0], pos = lcnt[32 + e] + r[1], tok = r[3];
        if (pos < LCAP) { ltok[e * LCAP + pos] = tok; lgate[e * LCAP + pos] = __builtin_bit_cast(float, r[2]); } sidx[tok * 4 + (i & 3)] = e * LCAP + pos; }
    __syncthreads();
}
__device__ __forceinline__ void final_phase(Frame& F, const LAS int* tb) {
    const int gw = F.vcu * NWAVES + F.wave, NGW = F.G * NWAVES;
    const int* sidx = (const int*)(F.ws + WS_SIDX); const bf16* YS = (const bf16*)(F.ws + WS_YS);
    for (int m = gw; m < M; m += NGW) { f32x4 v[4]; load_row_f32(v, F.hf + (size_t)m * D, F.lane);
#pragma unroll
        for (int j = 0; j < 4; ++j) v[j] = v[j] * DN_ALPHA;
        f32x4 s[4];
#pragma unroll
        for (int j = 0; j < 4; ++j) s[j] = (f32x4){0.f, 0.f, 0.f, 0.f};
#pragma unroll
        for (int k = 0; k < TOPK; ++k) { const int si = sidx[m * 4 + k], e = si / LCAP, pos = si - e * LCAP; const size_t slot = (size_t)tb[e] * 256 + pos;
            const GAS u32x2* yp = (const GAS u32x2*)(YS + slot * D) + F.lane;
#pragma unroll
            for (int j = 0; j < 4; ++j) { const u32x2 w = yp[64 * j]; s[j] = s[j] + (f32x4){bflo(w.x), bfhi(w.x), bflo(w.y), bfhi(w.y)}; } }
#pragma unroll
        for (int j = 0; j < 4; ++j) v[j] = v[j] + s[j];
        ln_row(v, F.in[I_LN3_G], F.in[I_LN3_B], F.lane); store_row_f32(v, F.hf + (size_t)m * D, F.lane); }
}

struct Args { const float* in[N_IN]; float* out; unsigned char* ws; int ph_lo, ph_hi, li, pad; };
__global__ void __launch_bounds__(NWAVES * 64, 2) mk_fwd(Args args) {
    extern __shared__ __attribute__((aligned(16))) unsigned char lds[];
    Frame F;
    F.lds = (LAS unsigned char*)lds; F.MISC = (volatile LAS unsigned*)(F.lds + MISC_OFF);
    F.tid = threadIdx.x; F.lane = F.tid & 63; F.wave = __builtin_amdgcn_readfirstlane(F.tid >> 6);
    F.G = gridDim.x; { const int bx = blockIdx.x; F.vcu = (F.G % 8 == 0) ? (bx % 8) * (F.G / 8) + bx / 8 : bx; }
    F.ws = args.ws; F.ctl = (gu32*)(args.ws + WS_CTL); F.hf = args.out; F.in = args.in;
    for (int u = F.tid; u < (LDS_BYTES - LDSCTL_OFF) / 4; u += NWAVES * 64) ((LAS unsigned*)(F.lds + LDSCTL_OFF))[u] = 0u;
    __syncthreads();
    XcdBarrier bar; bar.bar = (unsigned*)(F.ctl + CW_BAR) + args.li * XCD_BAR_WORDS; bar.x = 0; bar.st = nullptr;
    const int lo = args.ph_lo, hi = args.ph_hi;
    if (hi - lo > 1) bar = xcd_barrier_post((unsigned*)(F.ctl + CW_BAR) + args.li * XCD_BAR_WORDS, F.MISC + 8);
#ifndef PH_MASK
#define PH_MASK 0x3fff
#endif
#define IN(k) (((PH_MASK >> (k)) & 1) && lo <= (k) && (k) < hi)
#define SEAM(k) do { if (IN(k) && IN((k) + 1)) xcd_barrier(bar); } while (0)
    const char* wsb = (const char*)args.ws;
    LAS int* tb = (LAS int*)(F.lds + XTRA_OFF + 9216);

    if (IN(0)) { p0_prologue(F); __syncthreads(); } SEAM(0);
    if (IN(1)) { SchedP1 S{F.G, (int)blockIdx.x}; EpiP1 E{F.ws, F.in[I_B_IN]};
        pg8::gemm_phase<EpiP1, SchedP1, false>(F.lds + RING_OFF, wsb, D, D, D, S, E, nullptr); } SEAM(1);
    if (IN(2)) {
        conv_phase(F);
        const int gw = F.vcu * NWAVES + F.wave;
        for (int tk = gw; tk < NB * SBH * (T_ / 32); tk += F.G * NWAVES) sb_attn_wave(F, (tk >> 7) >> 3, (tk >> 7) & 7, tk & 127);
    } SEAM(2);
    if (IN(3)) { SchedPlain S{F.G, (int)blockIdx.x, 128, 4, (unsigned)WS_MIXIN, (unsigned)WS_WOUT_T, TSTEP, TSTEP, 0u, 0u, 0u}; EpiResid E{F.hf, F.in[I_B_OUT]};
        pg8::gemm_phase<EpiResid, SchedPlain, false>(F.lds + RING_OFF, wsb, D, D, D, S, E, nullptr); } SEAM(3);
    if (IN(4)) { ln_phase(F, F.in[I_LN1_G], F.in[I_LN1_B]); } SEAM(4);
    if (IN(5)) { SchedPlain S{F.G, (int)blockIdx.x, 128, 4, (unsigned)WS_HB, (unsigned)WS_WQ_T, TSTEP, TSTEP, 0u, 0u, 0u}; EpiBf16 E{(bf16*)(F.ws + WS_QM), D, MEM_QSCALE};
        pg8::gemm_phase<EpiBf16, SchedPlain, false>(F.lds + RING_OFF, wsb, D, D, D, S, E, nullptr); } SEAM(5);
    if (IN(6)) {
        SchedPlain S{F.G, (int)blockIdx.x, 128, 4, (unsigned)WS_QM, (unsigned)WS_KM, TSTEP, 0u, 512u, 512u, TSTEP}; EpiBf16 E{(bf16*)(F.ws + WS_SP), D, 1.0f};
        pg8::gemm_phase<EpiBf16, SchedPlain, false>(F.lds + RING_OFF, wsb, D, D, 256, S, E, nullptr); } SEAM(6);
    if (IN(7)) { softmax_phase(F); } SEAM(7);
    if (IN(8)) {
        SchedPlain S{F.G, (int)blockIdx.x, 128, 4, (unsigned)WS_SP, (unsigned)WS_VMT, TSTEP, 256u * 2048u * 2u, 512u, 0u, 512u}; EpiBf16 E{(bf16*)(F.ws + WS_OB), D, 1.0f};
        pg8::gemm_phase<EpiBf16, SchedPlain, false>(F.lds + RING_OFF, wsb, D, 2048, 256, S, E, nullptr); } SEAM(8);
    if (IN(9)) { SchedPlain S{F.G, (int)blockIdx.x, 128, 4, (unsigned)WS_OB, (unsigned)WS_WO_T, TSTEP, TSTEP, 0u, 0u, 0u}; EpiResid E{F.hf, nullptr};
        pg8::gemm_phase<EpiResid, SchedPlain, false>(F.lds + RING_OFF, wsb, D, D, D, S, E, nullptr); } SEAM(9);
    if (IN(10)) { ln2_router_phase(F); } SEAM(10);
    if (IN(11)) { moe_table(F, tb); SchedMoe S{F.G, (int)blockIdx.x, 8, tb, (unsigned)WS_HB, (unsigned)WS_WGU_T, 2048u * 1024u * 2u, true}; EpiAct E{(bf16*)(F.ws + WS_ACT), F.in[I_B_GU]};
        pg8::gemm_phase<EpiAct, SchedMoe, true>(F.lds + RING_OFF, wsb, D, D, D, S, E, (const int*)(F.ws + WS_LTOK)); } SEAM(11);
    if (IN(12)) { moe_table(F, tb); SchedMoe S{F.G, (int)blockIdx.x, 4, tb, (unsigned)WS_ACT, (unsigned)WS_WDN_T, 1024u * 1024u * 2u, false}; EpiDown E{(bf16*)(F.ws + WS_YS), F.in[I_B_DOWN], (const float*)(F.ws + WS_LGATE)};
        pg8::gemm_phase<EpiDown, SchedMoe, false>(F.lds + RING_OFF, wsb, D, D, D, S, E, nullptr); } SEAM(12);
    if (IN(13)) { moe_table(F, tb); final_phase(F, tb); }
#undef IN
#undef SEAM
}

extern "C" void kernel_launch(void* const* d_in, const int* in_sizes, int n_in, void* d_out, int out_size, void* d_ws, size_t ws_size, hipStream_t stream) {
    static int grid = 0;
    if (grid == 0) {
        if (n_in != N_IN || out_size != M * D || ws_size < WS_END) { fprintf(stderr, "kernel_launch: unexpected shapes (n_in %d, out %d, ws %zu)\n", n_in, out_size, ws_size); grid = -1; return; }
        int dev = 0, cus = 0, per_cu = 0;
        if (hipGetDevice(&dev) != hipSuccess || hipDeviceGetAttribute(&cus, hipDeviceAttributeMultiprocessorCount, dev) != hipSuccess) { grid = -1; return; }
        if (hipFuncSetAttribute((const void*)mk_fwd, hipFuncAttributeMaxDynamicSharedMemorySize, LDS_BYTES) != hipSuccess) { fprintf(stderr, "kernel_launch: hipFuncSetAttribute failed\n"); grid = -1; return; }
        if (hipOccupancyMaxActiveBlocksPerMultiprocessor(&per_cu, (const void*)mk_fwd, NWAVES * 64, LDS_BYTES) != hipSuccess || per_cu < 1) fprintf(stderr, "kernel_launch: occupancy query says %d\n", per_cu);
        (void)hipGetLastError();
        grid = cus;
    }
    if (grid < 0) return;
    if (hipMemsetAsync((char*)d_ws + WS_CTL, 0, CTL_ZERO_BYTES, stream) != hipSuccess) return;
    Args a{};
    for (int i = 0; i < N_IN; ++i) a.in[i] = (const float*)d_in[i];
    a.out = (float*)d_out; a.ws = (unsigned char*)d_ws;
    for (int li = 0; li < MK_N_LAUNCHES; ++li) {
        a.ph_lo = (MK_N_LAUNCHES == 1) ? 0 : li; a.ph_hi = (MK_N_LAUNCHES == 1) ? NPHASE : li + 1; a.li = (MK_N_LAUNCHES == 1) ? 0 : li;
        hipLaunchKernelGGL(mk_fwd, dim3(grid), dim3(NWAVES * 64), LDS_BYTES, stream, a);
        if (hipPeekAtLastError() != hipSuccess) { fprintf(stderr, "kernel_launch: launch %d failed\n", li); break; }
    }
}
```

```cpp
#include <hip/hip_runtime.h>
#include <cstdio>
#include <cstdint>

#ifndef MK_N_LAUNCHES
#define MK_N_LAUNCHES 1
#endif

#define GAS __attribute__((address_space(1)))
#define LAS __attribute__((address_space(3)))
typedef unsigned short bf16;
typedef short bf16x8 __attribute__((ext_vector_type(8)));
typedef float f32x4 __attribute__((ext_vector_type(4)));
typedef float f32x2 __attribute__((ext_vector_type(2)));
typedef unsigned u32x4 __attribute__((ext_vector_type(4)));
typedef unsigned u32x2 __attribute__((ext_vector_type(2)));
typedef GAS unsigned gu32;
#define RLX_AGENT __ATOMIC_RELAXED, __HIP_MEMORY_SCOPE_AGENT
#define LDS_WAIT() asm volatile("s_waitcnt lgkmcnt(0)" ::: "memory")
#define VM_WAIT() asm volatile("s_waitcnt vmcnt(0)" ::: "memory")

constexpr int NB = 8, T_ = 4096, D = 1024, M = NB * T_, NMEM = 256, MM = NB * NMEM;
constexpr int CONV_CH = 512, SBH = 8, SBD = 64, SBW = 512, CWID = 31, NE = 32, TOPK = 4, DFF = 1024;
constexpr int INC = 2560;
constexpr float LN_EPS = 1e-5f;
constexpr float DN_ALPHA = 1.189207115002721f;
constexpr float LOG2E = 1.4426950408889634f;
constexpr float SB_QSCALE = 0.125f * LOG2E;
constexpr float MEM_QSCALE = 0.0625f * LOG2E;
constexpr int NBLK_MAX = M * TOPK / 256 + NE;
constexpr int LCAP = M;

constexpr size_t MiB = 1u << 20;
constexpr size_t WS_CTL = 0, CTL_ZERO_BYTES = 1 * MiB;
constexpr size_t WS_WIN_T = 1 * MiB;
constexpr size_t WS_WOUT_T = 6 * MiB;
constexpr size_t WS_WQ_T = 8 * MiB, WS_WK_T = 10 * MiB, WS_WV_T = 12 * MiB, WS_WO_T = 14 * MiB;
constexpr size_t WS_WGU_T = 16 * MiB;
constexpr size_t WS_WDN_T = 144 * MiB;
constexpr size_t WS_HB = 208 * MiB;
constexpr size_t WS_LTOK = 272 * MiB;
constexpr size_t WS_LGATE = 276 * MiB;
constexpr size_t WS_SIDX = 280 * MiB;
constexpr size_t WS_X = 288 * MiB;
constexpr size_t WS_U = WS_X;
constexpr size_t WS_Q = WS_X + 32 * MiB;
constexpr size_t WS_K = WS_X + 64 * MiB;
constexpr size_t WS_V = WS_X + 96 * MiB;
constexpr size_t WS_MIXIN = WS_X + 128 * MiB;
constexpr size_t WS_QM = WS_X + 192 * MiB;
constexpr size_t WS_SP = WS_X + 256 * MiB;
constexpr size_t WS_OB = WS_X + 320 * MiB;
constexpr size_t WS_MEMN = WS_X + 384 * MiB;
constexpr size_t WS_KM = WS_X + 388 * MiB;
constexpr size_t WS_VMT = WS_X + 392 * MiB;
constexpr size_t WS_ACT = WS_X;
constexpr size_t WS_YS = WS_X + 272 * MiB;
constexpr size_t WS_END = WS_X + 544 * MiB;
constexpr int CW_TMO = 0, CW_CODE = 1;
constexpr int CW_BAR = 4096;
constexpr int CW_ECNT = 131072;
constexpr int NPHASE = 14;

constexpr int RING_OFF = 0, RING_BYTES = 131072;
constexpr int LDSCTL_OFF = RING_BYTES, MISC_OFF = LDSCTL_OFF + 320;
constexpr int XTRA_OFF = LDSCTL_OFF + 1024;
constexpr int LDS_BYTES = 147456;
constexpr int NWAVES = 8;

__device__ __forceinline__ unsigned f2bf(float f) { unsigned u = __builtin_bit_cast(unsigned, f); return (u + 0x7fffu + ((u >> 16) & 1u)) >> 16; }
__device__ __forceinline__ unsigned pk2(float lo, float hi) { return f2bf(lo) | (f2bf(hi) << 16); }
__device__ __forceinline__ float bflo(unsigned u) { return __builtin_bit_cast(float, u << 16); }
__device__ __forceinline__ float bfhi(unsigned u) { return __builtin_bit_cast(float, u & 0xffff0000u); }
__device__ __forceinline__ float wave_sum(float v) {
#pragma unroll
    for (int o = 1; o < 64; o <<= 1) v += __shfl_xor(v, o);
    return v;
}
__device__ __forceinline__ float wave_max(float v) {
#pragma unroll
    for (int o = 1; o < 64; o <<= 1) v = fmaxf(v, __shfl_xor(v, o));
    return v;
}
__device__ __forceinline__ float sigmoidf_fast(float x) { return __builtin_amdgcn_rcpf(1.0f + __expf(-x)); }

namespace pg8 {
constexpr int BM = 256, BK = 64, HALF = 128, HTB = HALF * BK * 2, STAGE_BYTES = 8 * HTB, NXCD = 8, WGM = 8;
__host__ __device__ __forceinline__ int lds_byte(int r, int c) { const int st = (r >> 4) * 2 + (c >> 5), rr = r & 15, cc = c & 31, ob = rr * 64 + cc * 2; return st * 1024 + (ob ^ (((ob >> 9) & 1) << 5)); }
__host__ __device__ __forceinline__ void stage_rc(int b, int& R, int& C) { const int st = b / 1024, sb = b % 1024, swz = sb ^ (((sb >> 9) & 1) << 5); R = (st >> 1) * 16 + swz / 64; C = (st & 1) * 32 + (swz % 64) / 2; }
__host__ __device__ __forceinline__ int perm32(int rho) { const int n = rho >> 4, i = rho & 15; return 8 * (i >> 2) + 4 * n + (i & 3); }

struct Unit { int pm, pn, z, nvalid; unsigned aoff, boff, goff; };

__device__ __forceinline__ void tile_order(int L, int nM, int nN, int& pm, int& pn) {
    const int nwg = nM * nN; int wgid = L;
    { const int q = nwg / NXCD, r = nwg % NXCD, xcd = wgid % NXCD, off = wgid / NXCD; wgid = (xcd < r ? xcd * (q + 1) : r * (q + 1) + (xcd - r) * q) + off; }
    const int nig = WGM * nN, gid = wgid / nig, fm = gid * WGM, gsz = (nM - fm) < WGM ? (nM - fm) : WGM;
    pm = fm + ((wgid % nig) % gsz); pn = (wgid % nig) / gsz;
}
__device__ __forceinline__ unsigned cvt_pk_bf16(float lo, float hi) { unsigned r; asm volatile("v_cvt_pk_bf16_f32 %0, %1, %2" : "=v"(r) : "v"(lo), "v"(hi)); return r; }

__device__ __forceinline__ void store_tile_bf16(const f32x4 (&acc)[2][2][4][2], bf16* p0, size_t ldc, const float* bias, float scale, int wc, int fq) {
    const int cl = wc * 32 + 8 * fq;
    f32x4 bv[2][2];
#pragma unroll
    for (int bj = 0; bj < 2; ++bj)
#pragma unroll
        for (int n = 0; n < 2; ++n) bv[bj][n] = bias ? *(const f32x4*)(bias + cl + bj * HALF + 4 * n) : (f32x4){0.f, 0.f, 0.f, 0.f};
#pragma unroll
    for (int ai = 0; ai < 2; ++ai)
#pragma unroll
        for (int m = 0; m < 4; ++m) { bf16* rowp = p0 + (size_t)(ai * HALF + m * 16) * ldc + cl;
#pragma unroll
            for (int bj = 0; bj < 2; ++bj) { const f32x4 v0 = (acc[ai][bj][m][0] + bv[bj][0]) * scale, v1 = (acc[ai][bj][m][1] + bv[bj][1]) * scale;
                u32x4 w; w.x = cvt_pk_bf16(v0[0], v0[1]); w.y = cvt_pk_bf16(v0[2], v0[3]); w.z = cvt_pk_bf16(v1[0], v1[1]); w.w = cvt_pk_bf16(v1[2], v1[3]);
                *(u32x4*)(rowp + bj * HALF) = w; } }
}

template <class Epi, class Sched, bool GATHER>
__device__ __forceinline__ void gemm_phase(LAS unsigned char* lds, const char* wsb, const int lda, const int ldb, const int K, const Sched& S, const Epi& E, const int* glist) {
    const int tid = threadIdx.x, wid = __builtin_amdgcn_readfirstlane(tid >> 6), lane = tid & 63, wr = wid >> 2, wc = wid & 3, fr = lane & 15, fq = lane >> 4;
    const int nt = K / BK;
    unsigned voffA[2], voffB[2]; int Rr[2], Cc[2];
#pragma unroll
    for (int i = 0; i < 2; ++i) { int R, C; stage_rc(tid * 16 + i * 8192, R, C); const int Rb = Epi::PERM ? ((R & ~31) + perm32(R & 31)) : R;
        voffA[i] = (unsigned)(R * lda + C) * 2u; voffB[i] = (unsigned)(Rb * ldb + C) * 2u; Rr[i] = R; Cc[i] = C; }
    const size_t kstep = (size_t)(BK * 2);
    const size_t hstepA = (size_t)HALF * lda * 2, hstepB = (size_t)HALF * ldb * 2;
    const unsigned ldsw = (unsigned)wid * 1024u;
    const int aoff = lds_byte(wr * 64 + fr, fq * 8), boff = lds_byte(wc * 32 + fr, fq * 8);
    unsigned gc[2][2], gn[2][2];
#define PG8_SA(b, h) (((b) * 2 + (h)) * HTB)
#define PG8_SB(b, h) ((4 + (b) * 2 + (h)) * HTB)
#define PG8_STAGE_B(bufoff, gbase) do { _Pragma("unroll") for (int _i = 0; _i < 2; ++_i) \
        __builtin_amdgcn_global_load_lds((const unsigned*)((const char*)(gbase) + voffB[_i]), (LAS unsigned*)(lds + (bufoff) + ldsw + _i * 8192), 16, 0, 0); } while (0)
#define PG8_STAGE_A(bufoff, gbase, h, nx) do { _Pragma("unroll") for (int _i = 0; _i < 2; ++_i) { \
        const char* _p = GATHER ? (const char*)(gbase) + ((nx) ? gn[h][_i] : gc[h][_i]) : (const char*)(gbase) + (h) * hstepA + voffA[_i]; \
        __builtin_amdgcn_global_load_lds((const unsigned*)_p, (LAS unsigned*)(lds + (bufoff) + ldsw + _i * 8192), 16, 0, 0); } } while (0)
#define PG8_LDA(dst, b, h) do { _Pragma("unroll") for (int m = 0; m < 4; ++m) _Pragma("unroll") for (int k = 0; k < 2; ++k) dst[m][k] = *(const LAS bf16x8*)(lds + PG8_SA(b, h) + aoff + m * 2048 + k * 1024); } while (0)
#define PG8_LDB(dst, b, h) do { _Pragma("unroll") for (int n = 0; n < 2; ++n) _Pragma("unroll") for (int k = 0; k < 2; ++k) dst[n][k] = *(const LAS bf16x8*)(lds + PG8_SB(b, h) + boff + n * 2048 + k * 1024); } while (0)
#define PG8_MMA(ai, bj, At, Bt) do { __builtin_amdgcn_s_setprio(1); _Pragma("unroll") for (int m = 0; m < 4; ++m) _Pragma("unroll") for (int n = 0; n < 2; ++n) _Pragma("unroll") for (int k = 0; k < 2; ++k) \
        acc[ai][bj][m][n] = __builtin_amdgcn_mfma_f32_16x16x32_bf16(Bt[n][k], At[m][k], acc[ai][bj][m][n], 0, 0, 0); __builtin_amdgcn_s_setprio(0); } while (0)
#define PG8_WAIT_V(n) asm volatile("s_waitcnt vmcnt(" #n ")" ::: "memory")
#define PG8_WAIT_L(n) asm volatile("s_waitcnt lgkmcnt(" #n ")" ::: "memory")
#define PG8_BAR __builtin_amdgcn_s_barrier()
#define PG8_SCHED __builtin_amdgcn_sched_barrier(0)
#define PG8_GIDX(g, u) do { _Pragma("unroll") for (int _h = 0; _h < 2; ++_h) _Pragma("unroll") for (int _i = 0; _i < 2; ++_i) { const int _r = _h * HALF + Rr[_i]; \
        const int _tok = glist[(u).goff + (_r < (u).nvalid ? _r : (u).nvalid - 1)]; g[_h][_i] = (unsigned)_tok * (unsigned)(lda * 2) + (unsigned)(Cc[_i] * 2); } } while (0)
    Unit cur, nxt, nn; int ui = 0;
    if (!S.next(0, cur)) return;
    f32x4 acc[2][2][4][2];
#pragma unroll
    for (int a = 0; a < 2; ++a)
#pragma unroll
        for (int b = 0; b < 2; ++b)
#pragma unroll
            for (int m = 0; m < 4; ++m)
#pragma unroll
                for (int n = 0; n < 2; ++n) acc[a][b][m][n] = (f32x4){0.f, 0.f, 0.f, 0.f};
    bf16x8 At[4][2], B0[2][2], B1[2][2];
    const char* cA = wsb + cur.aoff; const char* cB = wsb + cur.boff;
    if constexpr (GATHER) { PG8_GIDX(gc, cur); if (S.next(1, nxt)) { PG8_GIDX(gn, nxt); } else { PG8_GIDX(gn, cur); }
        asm volatile("s_waitcnt vmcnt(0)" : "+v"(gc[0][0]), "+v"(gc[0][1]), "+v"(gc[1][0]), "+v"(gc[1][1]), "+v"(gn[0][0]), "+v"(gn[0][1]), "+v"(gn[1][0]), "+v"(gn[1][1]) :: "memory"); }
    else {
#pragma unroll
        for (int h = 0; h < 2; ++h)
#pragma unroll
            for (int i = 0; i < 2; ++i) { gc[h][i] = 0u; gn[h][i] = 0u; } }
    PG8_STAGE_B(PG8_SB(0, 0), cB); PG8_STAGE_B(PG8_SB(0, 1), cB + hstepB); PG8_STAGE_A(PG8_SA(0, 0), cA, 0, false); PG8_STAGE_A(PG8_SA(0, 1), cA, 1, false);
    if (wr == 1) PG8_BAR;
    PG8_WAIT_V(2); PG8_BAR;
    PG8_STAGE_B(PG8_SB(1, 0), cB + kstep); PG8_STAGE_A(PG8_SA(1, 0), cA + kstep, 0, false); PG8_STAGE_B(PG8_SB(1, 1), cB + hstepB + kstep);
    PG8_WAIT_V(6); PG8_BAR;
    for (;;) {
        const bool has_next = S.next(ui + 1, nxt);
        const char* nA = has_next ? wsb + nxt.aoff : cA; const char* nB = has_next ? wsb + nxt.boff : cB;
#pragma clang loop unroll(disable)
        for (int t = 0; t < nt; t += 2) {
            const bool last = (t == nt - 2);
            const char* a1 = cA + (size_t)(t + 1) * kstep;
            const char* a2 = last ? nA : cA + (size_t)(t + 2) * kstep; const char* b2 = last ? nB : cB + (size_t)(t + 2) * kstep;
            const char* a3 = a2 + kstep; const char* b3 = b2 + kstep;
            PG8_LDB(B0, 0, 0); PG8_LDB(B1, 0, 1); PG8_SCHED; PG8_LDA(At, 0, 0); PG8_STAGE_A(PG8_SA(1, 1), a1, 1, false);
            PG8_WAIT_V(8); PG8_WAIT_L(0); PG8_BAR; PG8_MMA(0, 0, At, B0); PG8_MMA(0, 1, At, B1); PG8_BAR; PG8_SCHED;
            PG8_LDA(At, 0, 1); PG8_STAGE_B(PG8_SB(0, 0), b2); PG8_STAGE_B(PG8_SB(0, 1), b2 + hstepB); PG8_STAGE_A(PG8_SA(0, 0), a2, 0, last);
            PG8_WAIT_V(8); PG8_WAIT_L(0); PG8_BAR; PG8_MMA(1, 0, At, B0); PG8_MMA(1, 1, At, B1); PG8_BAR; PG8_SCHED;
            PG8_LDB(B0, 1, 0); PG8_LDB(B1, 1, 1); PG8_SCHED; PG8_LDA(At, 1, 0); PG8_STAGE_A(PG8_SA(0, 1), a2, 1, last);
            PG8_WAIT_V(8); PG8_WAIT_L(0); PG8_BAR; PG8_MMA(0, 0, At, B0); PG8_MMA(0, 1, At, B1); PG8_BAR; PG8_SCHED;
            PG8_LDA(At, 1, 1); PG8_STAGE_B(PG8_SB(1, 0), b3); PG8_STAGE_B(PG8_SB(1, 1), b3 + hstepB); PG8_STAGE_A(PG8_SA(1, 0), a3, 0, last);
            PG8_WAIT_V(8); PG8_WAIT_L(0); PG8_BAR; PG8_MMA(1, 0, At, B0); PG8_MMA(1, 1, At, B1); PG8_BAR; PG8_SCHED;
        }
        if (wr == 0) PG8_BAR;
        if constexpr (GATHER) {
#pragma unroll
            for (int h = 0; h < 2; ++h)
#pragma unroll
                for (int i = 0; i < 2; ++i) gc[h][i] = gn[h][i];
            if (has_next && S.next(ui + 2, nn)) { PG8_GIDX(gn, nn); }
        }
        E(acc, cur, wr, wc, fr, fq);
        if constexpr (GATHER) asm volatile("" : "+v"(gn[0][0]), "+v"(gn[0][1]), "+v"(gn[1][0]), "+v"(gn[1][1]));
        if (!has_next) break;
#pragma unroll
        for (int a = 0; a < 2; ++a)
#pragma unroll
            for (int b = 0; b < 2; ++b)
#pragma unroll
                for (int m = 0; m < 4; ++m)
#pragma unroll
                    for (int n = 0; n < 2; ++n) acc[a][b][m][n] = (f32x4){0.f, 0.f, 0.f, 0.f};
        cur = nxt; cA = nA; cB = nB; ++ui;
        if (wr == 1) PG8_BAR;
    }
    PG8_WAIT_V(0);
    PG8_BAR;
#undef PG8_SA
#undef PG8_SB
#undef PG8_STAGE_A
#undef PG8_STAGE_B
#undef PG8_LDA
#undef PG8_LDB
#undef PG8_MMA
#undef PG8_WAIT_V
#undef PG8_WAIT_L
#undef PG8_BAR
#undef PG8_SCHED
#undef PG8_GIDX
}
}
using pg8::Unit;

#define XB_TMO      128
#define XB_XCNT(j)  (256  + 64 * (j))
#define XB_XSUB(j)  (1280 + 64 * (j))
#define XB_XGEN(j)  (2304 + 64 * (j))
#define XB_TOP      3328
#define XB_TOPGEN   3392
#define XCD_BAR_WORDS 3456
#define XB_SPIN_CAP (1u << 18)
__device__ __forceinline__ unsigned xb_ld(unsigned* p)              { return __hip_atomic_load(p, __ATOMIC_RELAXED, __HIP_MEMORY_SCOPE_AGENT); }
__device__ __forceinline__ unsigned xb_add(unsigned* p, unsigned v) { return __hip_atomic_fetch_add(p, v, __ATOMIC_RELAXED, __HIP_MEMORY_SCOPE_AGENT); }
__device__ __forceinline__ unsigned xb_xcc_id() { return (unsigned)__builtin_amdgcn_s_getreg((3 << 11) | 20) & 0xFu; }
#define XB_SPIN(cond, bar) do { unsigned _sp = 0; while (cond) { __builtin_amdgcn_s_sleep(1); \
    if ((++_sp & 255u) == 0u) { if (xb_ld(&(bar)[XB_TMO])) break; if (_sp > XB_SPIN_CAP) { atomicAdd(&(bar)[XB_TMO], 1u); break; } } } } while (0)
struct XcdBarrier { unsigned* bar; unsigned x; volatile LAS unsigned* st; };
__device__ __forceinline__ XcdBarrier xcd_barrier_post(unsigned* bar, volatile LAS unsigned* st) {
    XcdBarrier b; b.bar = bar; b.x = xb_xcc_id(); b.st = st;
    if (threadIdx.x == 0) (void)xb_add(&bar[XB_XCNT(b.x)], 1u);
    return b;
}
__device__ __forceinline__ void xcd_barrier_complete(unsigned* bar, unsigned x, unsigned& nloc, unsigned& nx) {
    const unsigned G = gridDim.x * gridDim.y * gridDim.z;
    unsigned sum, cnt, mine, sp = 0u;
    for (;;) {
        sum = 0u; cnt = 0u; mine = 0u;
#pragma unroll
        for (unsigned j = 0; j < 16; ++j) { const unsigned c = xb_ld(&bar[XB_XCNT(j)]); sum += c; cnt += (c > 0u) ? 1u : 0u; mine = (j == x) ? c : mine; }
        if (sum == G) break;
        __builtin_amdgcn_s_sleep(1);
        if ((++sp & 255u) == 0u) { if (xb_ld(&bar[XB_TMO])) break; if (sp > XB_SPIN_CAP) { atomicAdd(&bar[XB_TMO], 1u); break; } }
    }
    nloc = mine > 0u ? mine : 1u; nx = cnt > 0u ? cnt : 1u;
}
__device__ __forceinline__ void xcd_barrier(const XcdBarrier& b) {
    asm volatile("s_waitcnt vmcnt(0)" ::: "memory");
    __syncthreads();
    if (threadIdx.x == 0) {
        unsigned* bar = b.bar;
        __builtin_amdgcn_s_waitcnt(0);
        unsigned nloc = b.st[0], nx = b.st[1];
        if (nloc == 0u) { xcd_barrier_complete(bar, b.x, nloc, nx); b.st[0] = nloc; b.st[1] = nx; }
        const unsigned old = xb_add(&bar[XB_XSUB(b.x)], 1u);
        const unsigned gen = old / nloc;
        if (old + 1u == (gen + 1u) * nloc) {
            __builtin_amdgcn_fence(__ATOMIC_RELEASE, "agent");
            asm volatile("s_waitcnt vmcnt(0)" ::: "memory");
            const unsigned og = xb_add(&bar[XB_TOP], 1u);
            const unsigned tg = og / nx;
            if (og + 1u == (tg + 1u) * nx) xb_add(&bar[XB_TOPGEN], 1u);
            else XB_SPIN(xb_ld(&bar[XB_TOPGEN]) == tg, bar);
            __builtin_amdgcn_fence(__ATOMIC_ACQUIRE, "agent");
            xb_add(&bar[XB_XGEN(b.x)], 1u);
            asm volatile("s_waitcnt vmcnt(0)" ::: "memory");
        } else {
            XB_SPIN(xb_ld(&bar[XB_XGEN(b.x)]) == gen, bar);
            __builtin_amdgcn_fence(__ATOMIC_ACQUIRE, "agent");
            asm volatile("s_waitcnt vmcnt(0)" ::: "memory");
        }
    }
    __syncthreads();
}

struct Frame {
    LAS unsigned char* lds;
    volatile LAS unsigned* MISC;
    gu32* ctl;
    unsigned char* ws;
    int tid, lane, wave, vcu, G;
    float* hf;
    const float* const* in;
};
enum In { I_X = 0, I_MEM, I_LN_IN_G, I_LN_IN_B, I_LN_MEM_G, I_LN_MEM_B, I_W_IN, I_B_IN, I_W_DW, I_B_DW, I_LN_CONV_G, I_LN_CONV_B, I_W_OUT, I_B_OUT, I_LN1_G, I_LN1_B,
          I_WQ, I_WK, I_WV, I_WO, I_LN2_G, I_LN2_B, I_W_ROUTER, I_B_ROUTER, I_W_GU, I_B_GU, I_W_DOWN, I_B_DOWN, I_LN3_G, I_LN3_B, N_IN };

__device__ __forceinline__ void p0_transpose_item(const float* W, int K, int N, bf16* WT, int k0, int n0, int drow, LAS float* scr, int lane) {
#pragma unroll 8
    for (int i = 0; i < 32; ++i) { const int kk = 2 * i + (lane >> 5); scr[kk * 33 + (lane & 31)] = W[(size_t)(k0 + kk) * N + n0 + (lane & 31)]; }
    LDS_WAIT(); asm volatile("" ::: "memory");
    const int c = lane & 7;
#pragma unroll
    for (int j = 0; j < 4; ++j) { const int n = (lane >> 3) + 8 * j; const LAS float* s = scr + (8 * c) * 33 + n;
        u32x4 o; o.x = pk2(s[0 * 33], s[1 * 33]); o.y = pk2(s[2 * 33], s[3 * 33]); o.z = pk2(s[4 * 33], s[5 * 33]); o.w = pk2(s[6 * 33], s[7 * 33]);
        *(GAS u32x4*)(WT + (size_t)(drow + n) * K + k0 + 8 * c) = o; }
    LDS_WAIT(); asm volatile("" ::: "memory");
}
__device__ __forceinline__ void ln_row(f32x4 (&v)[4], const float* g, const float* b, int lane) {
    float s = 0.f;
#pragma unroll
    for (int j = 0; j < 4; ++j) s += (v[j].x + v[j].y) + (v[j].z + v[j].w);
    const float mean = wave_sum(s) * (1.f / D); float s2 = 0.f;
#pragma unroll
    for (int j = 0; j < 4; ++j) { v[j] = v[j] - mean; s2 += (v[j].x * v[j].x + v[j].y * v[j].y) + (v[j].z * v[j].z + v[j].w * v[j].w); }
    const float rstd = 1.f / sqrtf(wave_sum(s2) * (1.f / D) + LN_EPS);
#pragma unroll
    for (int j = 0; j < 4; ++j) { const f32x4 gg = ((const GAS f32x4*)g)[lane + 64 * j], bb = ((const GAS f32x4*)b)[lane + 64 * j]; v[j] = v[j] * rstd * gg + bb; }
}
__device__ __forceinline__ void store_row_bf16(const f32x4 (&v)[4], bf16* orow, int lane) {
    GAS u32x2* o8 = (GAS u32x2*)orow + lane;
#pragma unroll
    for (int j = 0; j < 4; ++j) o8[64 * j] = (u32x2){pk2(v[j].x, v[j].y), pk2(v[j].z, v[j].w)};
}
__device__ __forceinline__ void load_row_bf16(f32x4 (&v)[4], const bf16* xrow, int lane) {
    const GAS u32x2* xr = (const GAS u32x2*)xrow + lane;
#pragma unroll
    for (int j = 0; j < 4; ++j) { const u32x2 w = xr[64 * j]; v[j] = (f32x4){bflo(w.x), bfhi(w.x), bflo(w.y), bfhi(w.y)}; }
}
__device__ __forceinline__ void load_row_f32(f32x4 (&v)[4], const float* xrow, int lane) {
    const GAS f32x4* xr = (const GAS f32x4*)xrow + lane;
#pragma unroll
    for (int j = 0; j < 4; ++j) v[j] = xr[64 * j];
}
__device__ __forceinline__ void store_row_f32(const f32x4 (&v)[4], float* orow, int lane) {
    GAS f32x4* o = (GAS f32x4*)orow + lane;
#pragma unroll
    for (int j = 0; j < 4; ++j) o[64 * j] = v[j];
}

__device__ __forceinline__ void p0_prologue(Frame& F) {
    LAS float* scr = (LAS float*)(F.lds + RING_OFF + F.wave * 16384);
    const int gw = F.vcu * NWAVES + F.wave, NGW = F.G * NWAVES;
    constexpr int I_IN = 16 * 80, I_SQ = 16 * 32, I_GU = NE * 16 * 64, I_DN = NE * 16 * 32;
    constexpr int NITEMS = I_IN + 5 * I_SQ + I_GU + I_DN;
    for (int it = gw; it < NITEMS; it += NGW) {
        int r = it;
        if (r < I_IN) { const int kb = r / 80, nb = r % 80, n0 = 32 * nb; int drow;
            if (n0 < 512) drow = (n0 >> 7) * 256 + (n0 & 127); else if (n0 < 1024) drow = ((n0 - 512) >> 7) * 256 + 128 + (n0 & 127); else drow = n0;
            p0_transpose_item(F.in[I_W_IN], D, INC, (bf16*)(F.ws + WS_WIN_T), 64 * kb, n0, drow, scr, F.lane); continue; } r -= I_IN;
        if (r < 5 * I_SQ) { const int w = r / I_SQ, q = r % I_SQ, kb = q / 32, nb = q % 32;
            const float* src = F.in[w == 0 ? I_W_OUT : w == 1 ? I_WQ : w == 2 ? I_WK : w == 3 ? I_WV : I_WO];
            bf16* dst = (bf16*)(F.ws + (w == 0 ? WS_WOUT_T : w == 1 ? WS_WQ_T : w == 2 ? WS_WK_T : w == 3 ? WS_WV_T : WS_WO_T));
            p0_transpose_item(src, D, D, dst, 64 * kb, 32 * nb, 32 * nb, scr, F.lane); continue; } r -= 5 * I_SQ;
        if (r < I_GU) { const int e = r / (16 * 64), q = r % (16 * 64), kb = q / 64, nb = q % 64, n0 = 32 * nb;
            const int drow = (n0 < 1024) ? (n0 >> 7) * 256 + (n0 & 127) : ((n0 - 1024) >> 7) * 256 + 128 + (n0 & 127);
            p0_transpose_item(F.in[I_W_GU] + (size_t)e * D * 2 * DFF, D, 2 * DFF, (bf16*)(F.ws + WS_WGU_T) + (size_t)e * 2 * DFF * D, 64 * kb, n0, drow, scr, F.lane); continue; } r -= I_GU;
        { const int e = r / (16 * 32), q = r % (16 * 32), kb = q / 32, nb = q % 32;
            p0_transpose_item(F.in[I_W_DOWN] + (size_t)e * DFF * D, DFF, D, (bf16*)(F.ws + WS_WDN_T) + (size_t)e * D * DFF, 64 * kb, 32 * nb, 32 * nb, scr, F.lane); }
    }
    for (int m = gw; m < M + MM; m += NGW) {
        f32x4 v[4];
        if (m < M) { load_row_f32(v, F.in[I_X] + (size_t)m * D, F.lane); ln_row(v, F.in[I_LN_IN_G], F.in[I_LN_IN_B], F.lane);
            store_row_bf16(v, (bf16*)(F.ws + WS_HB) + (size_t)m * D, F.lane); }
        else { const int mm = m - M; load_row_f32(v, F.in[I_MEM] + (size_t)mm * D, F.lane); ln_row(v, F.in[I_LN_MEM_G], F.in[I_LN_MEM_B], F.lane);
            store_row_bf16(v, (bf16*)(F.ws + WS_MEMN) + (size_t)mm * D, F.lane); }
    }
}

constexpr unsigned TSTEP = 256u * 1024u * 2u;
struct SchedP1 { int G, c;
    __device__ __forceinline__ bool next(int i, Unit& u) const {
        const int L = i * G + c; if (L >= 1344) return false;
        u.nvalid = 256; u.goff = 0;
        if (L < 1024) { pg8::tile_order(L, 128, 8, u.pm, u.pn); u.z = 0; u.aoff = (unsigned)WS_HB + (unsigned)u.pm * TSTEP; u.boff = (unsigned)WS_WIN_T + (unsigned)u.pn * TSTEP; }
        else if (L < 1280) { const int j = L - 1024; u.pm = j & 1; u.pn = j >> 1; u.z = 3; u.aoff = (unsigned)WS_WIN_T + (unsigned)(8 + u.pm) * TSTEP; u.boff = (unsigned)WS_HB + (unsigned)u.pn * TSTEP; }
        else if (L < 1312) { const int j = L - 1280; u.pm = j & 7; u.pn = j >> 3; u.z = 1; u.aoff = (unsigned)WS_MEMN + (unsigned)u.pm * TSTEP; u.boff = (unsigned)WS_WK_T + (unsigned)u.pn * TSTEP; }
        else { const int j = L - 1312; u.pm = j & 3; u.pn = j >> 2; u.z = 2; u.aoff = (unsigned)WS_WV_T + (unsigned)u.pm * TSTEP; u.boff = (unsigned)WS_MEMN + (unsigned)u.pn * TSTEP; }
        return true; }
};
struct EpiP1 { static constexpr bool PERM = true;
    unsigned char* ws; const float* b_in;
    __device__ __forceinline__ void operator()(const f32x4 (&acc)[2][2][4][2], const Unit& u, int wr, int wc, int fr, int fq) const {
        const int row0 = u.pm * 256 + wr * 64 + fr;
        if (u.z == 0) {
            if (u.pn < 4) {
                const int ch = 128 * u.pn + wc * 32 + 8 * fq;
                f32x4 bv[2], bg[2];
#pragma unroll
                for (int n = 0; n < 2; ++n) { bv[n] = *(const f32x4*)(b_in + ch + 4 * n); bg[n] = *(const f32x4*)(b_in + 512 + ch + 4 * n); }
                bf16* U = (bf16*)(ws + WS_U);
#pragma unroll
                for (int ai = 0; ai < 2; ++ai)
#pragma unroll
                    for (int m = 0; m < 4; ++m) { f32x4 o[2];
#pragma unroll
                        for (int n = 0; n < 2; ++n) { const f32x4 a = acc[ai][0][m][n] + bv[n], g = acc[ai][1][m][n] + bg[n];
#pragma unroll
                            for (int j = 0; j < 4; ++j) o[n][j] = a[j] * sigmoidf_fast(g[j]); }
                        u32x4 w; w.x = pg8::cvt_pk_bf16(o[0][0], o[0][1]); w.y = pg8::cvt_pk_bf16(o[0][2], o[0][3]); w.z = pg8::cvt_pk_bf16(o[1][0], o[1][1]); w.w = pg8::cvt_pk_bf16(o[1][2], o[1][3]);
                        *(u32x4*)(U + (size_t)(row0 + ai * 128 + m * 16) * 512 + ch) = w; }
            } else {
                const int t = u.pn - 4, which = t >> 1, cb = (t & 1) * 256;
                bf16* dst = (bf16*)(ws + (which == 0 ? WS_Q : WS_K));
                pg8::store_tile_bf16(acc, dst + (size_t)row0 * 512 + cb, 512, b_in + 1024 + 256 * t, which == 0 ? SB_QSCALE : 1.0f, wc, fq);
            }
        } else if (u.z == 3) {
            const float* rb = b_in + 2048 + row0; bf16* p0 = (bf16*)(ws + WS_V) + (size_t)row0 * M + 256 * u.pn; const int cl = wc * 32 + 8 * fq;
#pragma unroll
            for (int ai = 0; ai < 2; ++ai)
#pragma unroll
                for (int m = 0; m < 4; ++m) { const float bv = rb[ai * 128 + m * 16]; bf16* rowp = p0 + (size_t)(ai * 128 + m * 16) * M + cl;
#pragma unroll
                    for (int bj = 0; bj < 2; ++bj) { const f32x4 v0 = acc[ai][bj][m][0] + bv, v1 = acc[ai][bj][m][1] + bv;
                        u32x4 w; w.x = pg8::cvt_pk_bf16(v0[0], v0[1]); w.y = pg8::cvt_pk_bf16(v0[2], v0[3]); w.z = pg8::cvt_pk_bf16(v1[0], v1[1]); w.w = pg8::cvt_pk_bf16(v1[2], v1[3]);
                        *(u32x4*)(rowp + bj * 128) = w; } }
        } else if (u.z == 1) pg8::store_tile_bf16(acc, (bf16*)(ws + WS_KM) + (size_t)row0 * 1024 + 256 * u.pn, 1024, nullptr, 1.0f, wc, fq);
        else pg8::store_tile_bf16(acc, (bf16*)(ws + WS_VMT) + (size_t)row0 * 2048 + 256 * u.pn, 2048, nullptr, 1.0f, wc, fq);
    }
};

struct SchedPlain { int G, c, nM, nN; unsigned abase, bbase, atile, btile, acol, bcol, bgrp;
    __device__ __forceinline__ bool next(int i, Unit& u) const {
        const int L = i * G + c; if (L >= nM * nN) return false;
        pg8::tile_order(L, nM, nN, u.pm, u.pn); u.z = 0; u.nvalid = 256; u.goff = 0;
        u.aoff = abase + (unsigned)u.pm * atile + (unsigned)u.pn * acol; u.boff = bbase + (unsigned)u.pn * btile + (unsigned)(u.pm >> 4) * bgrp + (unsigned)u.pn * bcol; return true; }
};
struct EpiBf16 { static constexpr bool PERM = true;
    bf16* O; int ldc; float scale; const float* bias;
    __device__ __forceinline__ void operator()(const f32x4 (&acc)[2][2][4][2], const Unit& u, int wr, int wc, int fr, int fq) const {
        pg8::store_tile_bf16(acc, O + (size_t)(u.pm * 256 + wr * 64 + fr) * ldc + 256 * u.pn, (size_t)ldc, bias ? bias + 256 * u.pn : nullptr, scale, wc, fq); }
};
struct SchedMoe { int G, c, nN; const LAS int* tb; unsigned abase, wbase, wexp;
    bool gather;
    __device__ __forceinline__ bool next(int i, Unit& u) const {
        const int nblk = __builtin_amdgcn_readfirstlane(tb[32]); const int L = i * G + c; if (L >= nblk * nN) return false;
        pg8::tile_order(L, nblk, nN, u.pm, u.pn);
        int e = 0; while (tb[e + 1] <= u.pm) ++e;
        e = __builtin_amdgcn_readfirstlane(e);
        const int j = u.pm - tb[e], rem = tb[64 + e] - 256 * j;
        u.z = e; u.nvalid = rem < 256 ? rem : 256; u.goff = (unsigned)(e * LCAP + 256 * j);
        u.aoff = gather ? abase : abase + (unsigned)u.pm * TSTEP;
        u.boff = wbase + (unsigned)e * wexp + (unsigned)u.pn * TSTEP; return true; }
};
struct EpiAct { static constexpr bool PERM = true;
    bf16* ACT; const float* b_gu;
    __device__ __forceinline__ void operator()(const f32x4 (&acc)[2][2][4][2], const Unit& u, int wr, int wc, int fr, int fq) const {
        const int row0 = u.pm * 256 + wr * 64 + fr, ch = 128 * u.pn + wc * 32 + 8 * fq;
        const float* bb = b_gu + (size_t)u.z * 2 * DFF;
        f32x4 bg[2], bu[2];
#pragma unroll
        for (int n = 0; n < 2; ++n) { bg[n] = *(const f32x4*)(bb + ch + 4 * n); bu[n] = *(const f32x4*)(bb + DFF + ch + 4 * n); }
#pragma unroll
        for (int ai = 0; ai < 2; ++ai)
#pragma unroll
            for (int m = 0; m < 4; ++m) { f32x4 o[2];
#pragma unroll
                for (int n = 0; n < 2; ++n) { const f32x4 g = acc[ai][0][m][n] + bg[n], uu = acc[ai][1][m][n] + bu[n];
#pragma unroll
                    for (int j = 0; j < 4; ++j) { const float g_ = fminf(g[j], 7.0f), u_ = fminf(fmaxf(uu[j], -7.0f), 7.0f); o[n][j] = (u_ + 1.0f) * g_ * sigmoidf_fast(1.702f * g_); } }
                u32x4 w; w.x = pg8::cvt_pk_bf16(o[0][0], o[0][1]); w.y = pg8::cvt_pk_bf16(o[0][2], o[0][3]); w.z = pg8::cvt_pk_bf16(o[1][0], o[1][1]); w.w = pg8::cvt_pk_bf16(o[1][2], o[1][3]);
                *(u32x4*)(ACT + (size_t)(row0 + ai * 128 + m * 16) * DFF + ch) = w; }
    }
};
struct EpiDown { static constexpr bool PERM = true;
    bf16* YS; const float* b_down; const float* lgate;
    __device__ __forceinline__ void operator()(const f32x4 (&acc)[2][2][4][2], const Unit& u, int wr, int wc, int fr, int fq) const {
        const int r0 = wr * 64 + fr, cl = wc * 32 + 8 * fq;
        const float* bb = b_down + (size_t)u.z * D + 256 * u.pn + cl;
        f32x4 bv[2][2];
#pragma unroll
        for (int bj = 0; bj < 2; ++bj)
#pragma unroll
            for (int n = 0; n < 2; ++n) bv[bj][n] = *(const f32x4*)(bb + bj * 128 + 4 * n);
#pragma unroll
        for (int ai = 0; ai < 2; ++ai)
#pragma unroll
            for (int m = 0; m < 4; ++m) { const int r = r0 + ai * 128 + m * 16; const float gl = lgate[u.goff + (r < u.nvalid ? r : u.nvalid - 1)]; const float gt = (r < u.nvalid) ? gl : 0.f;
                bf16* rowp = YS + (size_t)(u.pm * 256 + r) * D + 256 * u.pn + cl;
#pragma unroll
                for (int bj = 0; bj < 2; ++bj) { const f32x4 v0 = (acc[ai][bj][m][0] + bv[bj][0]) * gt, v1 = (acc[ai][bj][m][1] + bv[bj][1]) * gt;
                    u32x4 w; w.x = pg8::cvt_pk_bf16(v0[0], v0[1]); w.y = pg8::cvt_pk_bf16(v0[2], v0[3]); w.z = pg8::cvt_pk_bf16(v1[0], v1[1]); w.w = pg8::cvt_pk_bf16(v1[2], v1[3]);
                    *(u32x4*)(rowp + bj * 128) = w; } }
    }
};
__device__ __forceinline__ void moe_table(Frame& F, LAS int* tb) {
    if (F.tid < 32) { int c = (int)__hip_atomic_load(F.ctl + CW_ECNT + 64 * F.tid, RLX_AGENT); if (c > LCAP) c = LCAP; tb[64 + F.tid] = c; }
    LDS_WAIT(); __syncthreads();
    if (F.tid == 0) { int s = 0; for (int e = 0; e < NE; ++e) { tb[e] = s; s += (tb[64 + e] + 255) >> 8; } tb[32] = s; }
    LDS_WAIT(); __syncthreads();
}

__device__ __forceinline__ void conv_phase(Frame& F) {
    LAS unsigned* ut = (LAS unsigned*)(F.lds + RING_OFF);
    LAS float* co = (LAS float*)(F.lds + RING_OFF + 65536);
    const int cp = F.tid & 255, half = F.tid >> 8;
    float w0[CWID], w1[CWID];
    { const float* wd = F.in[I_W_DW] + 2 * cp;
#pragma unroll
        for (int j = 0; j < CWID; ++j) { const f32x2 w = *(const GAS f32x2*)(wd + j * CONV_CH); w0[j] = w.x; w1[j] = w.y; } }
    const f32x2 bd = *(const GAS f32x2*)(F.in[I_B_DW] + 2 * cp);
    const f32x4 g0 = *(const GAS f32x4*)(F.in[I_LN_CONV_G] + 8 * F.lane), g1 = *(const GAS f32x4*)(F.in[I_LN_CONV_G] + 8 * F.lane + 4);
    const f32x4 b0 = *(const GAS f32x4*)(F.in[I_LN_CONV_B] + 8 * F.lane), b1 = *(const GAS f32x4*)(F.in[I_LN_CONV_B] + 8 * F.lane + 4);
    bf16* MX = (bf16*)(F.ws + WS_MIXIN);
    for (int it = F.vcu; it < NB * (T_ / 32); it += F.G) {
        const int b = it / (T_ / 32), t0 = (it % (T_ / 32)) * 32;
        const bf16* U = (const bf16*)(F.ws + WS_U) + (size_t)b * T_ * CONV_CH;
        for (int idx = F.tid; idx < 62 * 64; idx += 512) { const int r = idx >> 6, c16 = idx & 63, t = t0 - 30 + r;
            u32x4 v = (u32x4){0u, 0u, 0u, 0u}; if (t >= 0) v = *(const GAS u32x4*)(U + (size_t)t * CONV_CH + c16 * 8);
            *(LAS u32x4*)(ut + r * 256 + c16 * 4) = v; }
        LDS_WAIT(); __syncthreads();
        { float a0[16], a1[16];
#pragma unroll
            for (int tt = 0; tt < 16; ++tt) { a0[tt] = bd.x; a1[tt] = bd.y; }
#pragma unroll
            for (int r = 0; r < 46; ++r) { const unsigned uu = ut[(half * 16 + r) * 256 + cp]; const float u0 = bflo(uu), u1 = bfhi(uu);
#pragma unroll
                for (int tt = 0; tt < 16; ++tt) { const int j = r - tt; if (j >= 0 && j < CWID) { a0[tt] += w0[j] * u0; a1[tt] += w1[j] * u1; } } }
#pragma unroll
            for (int tt = 0; tt < 16; ++tt) *(LAS f32x2*)(co + (half * 16 + tt) * CONV_CH + 2 * cp) = (f32x2){a0[tt], a1[tt]};
        }
        LDS_WAIT(); __syncthreads();
#pragma unroll
        for (int q = 0; q < 4; ++q) { const int tt = 4 * F.wave + q;
            f32x4 x0 = *(const LAS f32x4*)(co + tt * CONV_CH + 8 * F.lane), x1 = *(const LAS f32x4*)(co + tt * CONV_CH + 8 * F.lane + 4);
            const float mean = wave_sum((x0.x + x0.y) + (x0.z + x0.w) + (x1.x + x1.y) + (x1.z + x1.w)) * (1.f / CONV_CH);
            x0 = x0 - mean; x1 = x1 - mean;
            const float var = wave_sum((x0.x * x0.x + x0.y * x0.y) + (x0.z * x0.z + x0.w * x0.w) + (x1.x * x1.x + x1.y * x1.y) + (x1.z * x1.z + x1.w * x1.w)) * (1.f / CONV_CH);
            const float rstd = 1.f / sqrtf(var + LN_EPS);
            x0 = x0 * rstd * g0 + b0; x1 = x1 * rstd * g1 + b1;
            float y[8] = {x0.x, x0.y, x0.z, x0.w, x1.x, x1.y, x1.z, x1.w};
#pragma unroll
            for (int j = 0; j < 8; ++j) y[j] = y[j] * sigmoidf_fast(y[j]);
            *(GAS u32x4*)(MX + (size_t)(b * T_ + t0 + tt) * D + 8 * F.lane) = (u32x4){pk2(y[0], y[1]), pk2(y[2], y[3]), pk2(y[4], y[5]), pk2(y[6], y[7])}; }
        __syncthreads();
    }
}

typedef float f32x16 __attribute__((ext_vector_type(16)));
__device__ __forceinline__ int crow(int r, int hi) { return (r & 3) + 8 * (r >> 2) + 4 * hi; }
__device__ __forceinline__ bf16x8 pack8(const float* v) {
    u32x4 w; w.x = pg8::cvt_pk_bf16(v[0], v[1]); w.y = pg8::cvt_pk_bf16(v[2], v[3]); w.z = pg8::cvt_pk_bf16(v[4], v[5]); w.w = pg8::cvt_pk_bf16(v[6], v[7]);
    return __builtin_bit_cast(bf16x8, w); }
constexpr float SB_EXIT = 150.0f;
struct SbFrag { bf16x8 k[4]; u32x2 v[2][2][2]; };
__device__ __forceinline__ void sb_load(SbFrag& f, const bf16* Kl, const bf16* Vl, int kt) {
    const bf16* kp = Kl + (size_t)(32 * kt) * SBW;
#pragma unroll
    for (int s = 0; s < 4; ++s) f.k[s] = *(const GAS bf16x8*)(kp + 16 * s);
#pragma unroll
    for (int dt = 0; dt < 2; ++dt)
#pragma unroll
        for (int s = 0; s < 2; ++s) { const bf16* vp = Vl + (size_t)dt * 32 * M + 32 * kt + 16 * s; f.v[dt][s][0] = *(const GAS u32x2*)vp; f.v[dt][s][1] = *(const GAS u32x2*)(vp + 8); }
}
__device__ __forceinline__ void sb_attn_wave(Frame& F, int b, int h, int qt) {
    const int c = F.lane & 31, hi = F.lane >> 5;
    const bf16* Q = (const bf16*)(F.ws + WS_Q); const bf16* Kb = (const bf16*)(F.ws + WS_K); const bf16* VT = (const bf16*)(F.ws + WS_V);
    bf16x8 tri[2];
#pragma unroll
    for (int s = 0; s < 2; ++s) { bf16x8 t;
#pragma unroll
        for (int j = 0; j < 8; ++j) { const int k = 16 * s + 8 * (j >> 2) + 4 * hi + (j & 3); t[j] = (k >= c) ? (short)0xBF80 : (short)0; }
        tri[s] = t; }
    bf16x8 qf[4];
    { const bf16* qp = Q + ((size_t)b * T_ + 32 * qt + c) * SBW + h * SBD + 8 * hi;
#pragma unroll
        for (int s = 0; s < 4; ++s) qf[s] = *(const GAS bf16x8*)(qp + 16 * s); }
    const bf16* Kl = Kb + ((size_t)b * T_ + c) * SBW + h * SBD + 8 * hi;
    const bf16* Vl = VT + (size_t)(h * SBD + c) * M + (size_t)b * T_ + 4 * hi;
    f32x16 o0, o1;
#pragma unroll
    for (int r = 0; r < 16; ++r) { o0[r] = 0.f; o1[r] = 0.f; }
    float carry = 0.f;
    SbFrag fa, fb;
    sb_load(fa, Kl, Vl, qt);
#define SB_TILE(f, DIAG) do { \
        f32x16 p; _Pragma("unroll") for (int r = 0; r < 16; ++r) p[r] = 0.f; \
        _Pragma("unroll") for (int s = 0; s < 4; ++s) p = __builtin_amdgcn_mfma_f32_32x32x16_bf16(f.k[s], qf[s], p, 0, 0, 0); \
        float L[16]; \
        _Pragma("unroll") for (int r = 0; r < 16; ++r) { const float y = p[r]; float l = __builtin_amdgcn_logf(1.0f + __builtin_amdgcn_exp2f(fminf(y, 100.f))); l = fmaxf(l, y); \
            if (DIAG) l = (crow(r, hi) >= c) ? 0.f : l; L[r] = l; } \
        const bf16x8 l0 = pack8(L), l1 = pack8(L + 8); \
        f32x16 a; _Pragma("unroll") for (int r = 0; r < 16; ++r) a[r] = p[r] - carry; \
        a = __builtin_amdgcn_mfma_f32_32x32x16_bf16(tri[0], l0, a, 0, 0, 0); a = __builtin_amdgcn_mfma_f32_32x32x16_bf16(tri[1], l1, a, 0, 0, 0); \
        const float tot = p[0] - a[0];                                     \
        float w[16]; \
        _Pragma("unroll") for (int r = 0; r < 16; ++r) { float x = __builtin_amdgcn_exp2f(a[r]); if (DIAG) x = (crow(r, hi) >= c) ? 0.f : x; w[r] = x; } \
        const bf16x8 p0 = pack8(w), p1 = pack8(w + 8); \
        { const bf16x8 v00 = __builtin_bit_cast(bf16x8, (u32x4){f.v[0][0][0].x, f.v[0][0][0].y, f.v[0][0][1].x, f.v[0][0][1].y}); \
          const bf16x8 v01 = __builtin_bit_cast(bf16x8, (u32x4){f.v[0][1][0].x, f.v[0][1][0].y, f.v[0][1][1].x, f.v[0][1][1].y}); \
          const bf16x8 v10 = __builtin_bit_cast(bf16x8, (u32x4){f.v[1][0][0].x, f.v[1][0][0].y, f.v[1][0][1].x, f.v[1][0][1].y}); \
          const bf16x8 v11 = __builtin_bit_cast(bf16x8, (u32x4){f.v[1][1][0].x, f.v[1][1][0].y, f.v[1][1][1].x, f.v[1][1][1].y}); \
          o0 = __builtin_amdgcn_mfma_f32_32x32x16_bf16(v00, p0, o0, 0, 0, 0); o0 = __builtin_amdgcn_mfma_f32_32x32x16_bf16(v01, p1, o0, 0, 0, 0); \
          o1 = __builtin_amdgcn_mfma_f32_32x32x16_bf16(v10, p0, o1, 0, 0, 0); o1 = __builtin_amdgcn_mfma_f32_32x32x16_bf16(v11, p1, o1, 0, 0, 0); } \
        carry = __shfl(tot, c); } while (0)
    if (qt > 0) sb_load(fb, Kl, Vl, qt - 1);
    SB_TILE(fa, true);
    int kt = qt - 1;
    while (kt >= 0) {
        if (__all(carry >= SB_EXIT)) break;
        if (kt > 0) sb_load(fa, Kl, Vl, kt - 1);
        SB_TILE(fb, false);
        --kt; if (kt < 0) break;
        if (__all(carry >= SB_EXIT)) break;
        if (kt > 0) sb_load(fb, Kl, Vl, kt - 1);
        SB_TILE(fa, false);
        --kt;
    }
#undef SB_TILE
    bf16* op = (bf16*)(F.ws + WS_MIXIN) + ((size_t)b * T_ + 32 * qt + c) * D + CONV_CH + h * SBD + 4 * hi;
#pragma unroll
    for (int g = 0; g < 4; ++g) {
        *(GAS u32x2*)(op + 8 * g) = (u32x2){pg8::cvt_pk_bf16(o0[4 * g], o0[4 * g + 1]), pg8::cvt_pk_bf16(o0[4 * g + 2], o0[4 * g + 3])};
        *(GAS u32x2*)(op + 32 + 8 * g) = (u32x2){pg8::cvt_pk_bf16(o1[4 * g], o1[4 * g + 1]), pg8::cvt_pk_bf16(o1[4 * g + 2], o1[4 * g + 3])}; }
}

__device__ __forceinline__ void resid_row(f32x4 (&v)[4], const bf16* hrow, const bf16* mrow, int lane) {
    f32x4 a[4]; load_row_bf16(v, hrow, lane); load_row_bf16(a, mrow, lane);
#pragma unroll
    for (int j = 0; j < 4; ++j) v[j] = v[j] * DN_ALPHA + a[j];
}
__device__ __forceinline__ void ln_phase(Frame& F, const float* g, const float* b) {
    const int gw = F.vcu * NWAVES + F.wave, NGW = F.G * NWAVES;
    for (int m = gw; m < M; m += NGW) { f32x4 v[4]; bf16* hrow = (bf16*)(F.ws + WS_HB) + (size_t)m * D; resid_row(v, hrow, (const bf16*)(F.ws + WS_QM) + (size_t)m * D, F.lane);
        ln_row(v, g, b, F.lane); store_row_bf16(v, hrow, F.lane); }
}
__device__ __forceinline__ void softmax_phase(Frame& F) {
    const int gw = F.vcu * NWAVES + F.wave, NGW = F.G * NWAVES;
    for (int m = gw; m < M; m += NGW) { GAS u32x2* p = (GAS u32x2*)((bf16*)(F.ws + WS_SP) + (size_t)m * D) + F.lane;
#pragma unroll
        for (int j = 0; j < 4; ++j) { const u32x2 w = p[64 * j]; float x0 = bflo(w.x), x1 = bfhi(w.x), x2 = bflo(w.y), x3 = bfhi(w.y);
            const float mx = wave_max(fmaxf(fmaxf(x0, x1), fmaxf(x2, x3)));
            x0 = __builtin_amdgcn_exp2f(x0 - mx); x1 = __builtin_amdgcn_exp2f(x1 - mx); x2 = __builtin_amdgcn_exp2f(x2 - mx); x3 = __builtin_amdgcn_exp2f(x3 - mx);
            const float inv = 1.0f / wave_sum((x0 + x1) + (x2 + x3));
            p[64 * j] = (u32x2){pk2(x0 * inv, x1 * inv), pk2(x2 * inv, x3 * inv)}; } }
}
__device__ __forceinline__ void ln2_router_phase(Frame& F) {
    LAS float* wT = (LAS float*)(F.lds + RING_OFF);
    LAS int* lcnt = (LAS int*)(F.lds + XTRA_OFF);
    LAS int* rec = (LAS int*)(F.lds + XTRA_OFF + 512);
    const float* wr_ = F.in[I_W_ROUTER];
    for (int idx = F.tid; idx < D * NE; idx += 512) { const int c = idx >> 5, e = idx & 31; wT[e * D + c] = wr_[idx]; }
    if (F.tid < 64) lcnt[F.tid] = 0;
    LDS_WAIT(); __syncthreads();
    const int gw = F.vcu * NWAVES + F.wave, NGW = F.G * NWAVES;
    const float brt = F.lane < NE ? F.in[I_B_ROUTER][F.lane] : 0.f;
    int it = 0;
    for (int m = gw; m < M; m += NGW, ++it) {
        f32x4 v[4]; bf16* hrow = (bf16*)(F.ws + WS_HB) + (size_t)m * D; resid_row(v, hrow, (const bf16*)(F.ws + WS_QM) + (size_t)m * D, F.lane);
        ln_row(v, F.in[I_LN2_G], F.in[I_LN2_B], F.lane); store_row_bf16(v, hrow, F.lane);
        float logit = -INFINITY;
        for (int e = 0; e < NE; ++e) { float p = 0.f;
#pragma unroll
            for (int j = 0; j < 4; ++j) { const f32x4 w = *(const LAS f32x4*)(wT + e * D + 256 * j + 4 * F.lane); p += (v[j].x * w.x + v[j].y * w.y) + (v[j].z * w.z + v[j].w * w.w); }
            p = wave_sum(p); if (F.lane == e) logit = p + brt; }
        float tv[TOPK]; int te[TOPK];
#pragma unroll
        for (int k = 0; k < TOPK; ++k) { const float mx = wave_max(logit); const unsigned long long bal = __ballot(logit == mx); const int e = __builtin_ctzll(bal);
            tv[k] = mx; te[k] = e; if (F.lane == e) logit = -INFINITY; }
        float pe[TOPK], ps = 0.f;
#pragma unroll
        for (int k = 0; k < TOPK; ++k) { pe[k] = __expf(tv[k] - tv[0]); ps += pe[k]; }
        if (F.lane < TOPK) { const int k = F.lane; const int e = k == 0 ? te[0] : k == 1 ? te[1] : k == 2 ? te[2] : te[3]; const float g = (k == 0 ? pe[0] : k == 1 ? pe[1] : k == 2 ? pe[2] : pe[3]) / ps;
            const int lr = __hip_atomic_fetch_add(lcnt + e, 1, __ATOMIC_RELAXED, __HIP_MEMORY_SCOPE_WORKGROUP);
            LAS int* r = rec + ((F.wave * 16 + (it & 15)) * 4 + k) * 4; r[0] = e; r[1] = lr; r[2] = __builtin_bit_cast(int, g); r[3] = m; }
    }
    LDS_WAIT(); __syncthreads();
    if (F.tid < NE) lcnt[32 + F.tid] = (int)__hip_atomic_fetch_add(F.ctl + CW_ECNT + 64 * F.tid, (unsigned)lcnt[F.tid], RLX_AGENT);
    LDS_WAIT(); __syncthreads();
    int* ltok = (int*)(F.ws + WS_LTOK); float* lgate = (float*)(F.ws + WS_LGATE); int* sidx = (int*)(F.ws + WS_SIDX);
    const int nrec = it * 4;
    for (int i = F.lane; i < nrec; i += 64) { const LAS int* r = rec + (F.wave * 64 + i) * 4; const int e = r[0], pos = lcnt[32 + e] + r[1], tok = r[3];
        if (pos < LCAP) { ltok[e * LCAP + pos] = tok; lgate[e * LCAP + pos] = __builtin_bit_cast(float, r[2]); } sidx[tok * 4 + (i & 3)] = e * LCAP + pos; }
    __syncthreads();
}
__device__ __forceinline__ void final_phase(Frame& F, const LAS int* tb) {
    const int gw = F.vcu * NWAVES + F.wave, NGW = F.G * NWAVES;
    const int* sidx = (const int*)(F.ws + WS_SIDX); const bf16* YS = (const bf16*)(F.ws + WS_YS);
    for (int m = gw; m < M; m += NGW) { f32x4 v[4]; load_row_bf16(v, (const bf16*)(F.ws + WS_HB) + (size_t)m * D, F.lane);
#pragma unroll
        for (int j = 0; j < 4; ++j) v[j] = v[j] * DN_ALPHA;
        f32x4 s[4];
#pragma unroll
        for (int j = 0; j < 4; ++j) s[j] = (f32x4){0.f, 0.f, 0.f, 0.f};
#pragma unroll
        for (int k = 0; k < TOPK; ++k) { const int si = sidx[m * 4 + k], e = si / LCAP, pos = si - e * LCAP; const size_t slot = (size_t)tb[e] * 256 + pos;
            const GAS u32x2* yp = (const GAS u32x2*)(YS + slot * D) + F.lane;
#pragma unroll
            for (int j = 0; j < 4; ++j) { const u32x2 w = yp[64 * j]; s[j] = s[j] + (f32x4){bflo(w.x), bfhi(w.x), bflo(w.y), bfhi(w.y)}; } }
#pragma unroll
        for (int j = 0; j < 4; ++j) v[j] = v[j] + s[j];
        ln_row(v, F.in[I_LN3_G], F.in[I_LN3_B], F.lane); store_row_f32(v, F.hf + (size_t)m * D, F.lane); }
}

struct Args { const float* in[N_IN]; float* out; unsigned char* ws; int ph_lo, ph_hi, li, pad; };
__global__ void __launch_bounds__(NWAVES * 64, 2) mk_fwd(Args args) {
    extern __shared__ __attribute__((aligned(16))) unsigned char lds[];
    Frame F;
    F.lds = (LAS unsigned char*)lds; F.MISC = (volatile LAS unsigned*)(F.lds + MISC_OFF);
    F.tid = threadIdx.x; F.lane = F.tid & 63; F.wave = __builtin_amdgcn_readfirstlane(F.tid >> 6);
    F.G = gridDim.x; { const int bx = blockIdx.x; F.vcu = (F.G % 8 == 0) ? (bx % 8) * (F.G / 8) + bx / 8 : bx; }
    F.ws = args.ws; F.ctl = (gu32*)(args.ws + WS_CTL); F.hf = args.out; F.in = args.in;
    for (int u = F.tid; u < (LDS_BYTES - LDSCTL_OFF) / 4; u += NWAVES * 64) ((LAS unsigned*)(F.lds + LDSCTL_OFF))[u] = 0u;
    __syncthreads();
    XcdBarrier bar; bar.bar = (unsigned*)(F.ctl + CW_BAR) + args.li * XCD_BAR_WORDS; bar.x = 0; bar.st = nullptr;
    const int lo = args.ph_lo, hi = args.ph_hi;
    if (hi - lo > 1) bar = xcd_barrier_post((unsigned*)(F.ctl + CW_BAR) + args.li * XCD_BAR_WORDS, F.MISC + 8);
#ifndef PH_MASK
#define PH_MASK 0x3fff
#endif
#define IN(k) (((PH_MASK >> (k)) & 1) && lo <= (k) && (k) < hi)
#ifndef REP_MASK
#define REP_MASK 0
#endif
#define REPS(k) (1 + ((REP_MASK >> (k)) & 1))
#define SEAM(k) do { if (IN(k) && IN((k) + 1)) xcd_barrier(bar); } while (0)
    const char* wsb = (const char*)args.ws;
    LAS int* tb = (LAS int*)(F.lds + XTRA_OFF + 9216);

    if (IN(0)) for (int rep = 0; rep < REPS(0); ++rep) { p0_prologue(F); __syncthreads(); } SEAM(0);
    if (IN(1)) for (int rep = 0; rep < REPS(1); ++rep) { SchedP1 S{F.G, (int)blockIdx.x}; EpiP1 E{F.ws, F.in[I_B_IN]};
        pg8::gemm_phase<EpiP1, SchedP1, false>(F.lds + RING_OFF, wsb, D, D, D, S, E, nullptr); } SEAM(1);
    if (IN(2)) for (int rep = 0; rep < REPS(2); ++rep) {
        conv_phase(F);
        const int gw = F.vcu * NWAVES + F.wave;
        for (int tk = gw; tk < NB * SBH * (T_ / 32); tk += F.G * NWAVES) sb_attn_wave(F, (tk >> 7) >> 3, (tk >> 7) & 7, tk & 127);
    } SEAM(2);
    if (IN(3)) { SchedPlain S{F.G, (int)blockIdx.x, 128, 4, (unsigned)WS_MIXIN, (unsigned)WS_WOUT_T, TSTEP, TSTEP, 0u, 0u, 0u}; EpiBf16 E{(bf16*)(F.ws + WS_QM), D, 1.0f, F.in[I_B_OUT]};
        pg8::gemm_phase<EpiBf16, SchedPlain, false>(F.lds + RING_OFF, wsb, D, D, D, S, E, nullptr); } SEAM(3);
    if (IN(4)) { ln_phase(F, F.in[I_LN1_G], F.in[I_LN1_B]); } SEAM(4);
    if (IN(5)) { SchedPlain S{F.G, (int)blockIdx.x, 128, 4, (unsigned)WS_HB, (unsigned)WS_WQ_T, TSTEP, TSTEP, 0u, 0u, 0u}; EpiBf16 E{(bf16*)(F.ws + WS_QM), D, MEM_QSCALE, nullptr};
        pg8::gemm_phase<EpiBf16, SchedPlain, false>(F.lds + RING_OFF, wsb, D, D, D, S, E, nullptr); } SEAM(5);
    if (IN(6)) {
        SchedPlain S{F.G, (int)blockIdx.x, 128, 4, (unsigned)WS_QM, (unsigned)WS_KM, TSTEP, 0u, 512u, 512u, TSTEP}; EpiBf16 E{(bf16*)(F.ws + WS_SP), D, 1.0f, nullptr};
        pg8::gemm_phase<EpiBf16, SchedPlain, false>(F.lds + RING_OFF, wsb, D, D, 256, S, E, nullptr); } SEAM(6);
    if (IN(7)) { softmax_phase(F); } SEAM(7);
    if (IN(8)) {
        SchedPlain S{F.G, (int)blockIdx.x, 128, 4, (unsigned)WS_SP, (unsigned)WS_VMT, TSTEP, 256u * 2048u * 2u, 512u, 0u, 512u}; EpiBf16 E{(bf16*)(F.ws + WS_OB), D, 1.0f, nullptr};
        pg8::gemm_phase<EpiBf16, SchedPlain, false>(F.lds + RING_OFF, wsb, D, 2048, 256, S, E, nullptr); } SEAM(8);
    if (IN(9)) { SchedPlain S{F.G, (int)blockIdx.x, 128, 4, (unsigned)WS_OB, (unsigned)WS_WO_T, TSTEP, TSTEP, 0u, 0u, 0u}; EpiBf16 E{(bf16*)(F.ws + WS_QM), D, 1.0f, nullptr};
        pg8::gemm_phase<EpiBf16, SchedPlain, false>(F.lds + RING_OFF, wsb, D, D, D, S, E, nullptr); } SEAM(9);
    if (IN(10)) { ln2_router_phase(F); } SEAM(10);
    if (IN(11)) for (int rep = 0; rep < REPS(11); ++rep) { moe_table(F, tb); SchedMoe S{F.G, (int)blockIdx.x, 8, tb, (unsigned)WS_HB, (unsigned)WS_WGU_T, 2048u * 1024u * 2u, true}; EpiAct E{(bf16*)(F.ws + WS_ACT), F.in[I_B_GU]};
        pg8::gemm_phase<EpiAct, SchedMoe, true>(F.lds + RING_OFF, wsb, D, D, D, S, E, (const int*)(F.ws + WS_LTOK)); } SEAM(11);
    if (IN(12)) for (int rep = 0; rep < REPS(12); ++rep) { moe_table(F, tb); SchedMoe S{F.G, (int)blockIdx.x, 4, tb, (unsigned)WS_ACT, (unsigned)WS_WDN_T, 1024u * 1024u * 2u, false}; EpiDown E{(bf16*)(F.ws + WS_YS), F.in[I_B_DOWN], (const float*)(F.ws + WS_LGATE)};
        pg8::gemm_phase<EpiDown, SchedMoe, false>(F.lds + RING_OFF, wsb, D, D, D, S, E, nullptr); } SEAM(12);
    if (IN(13)) { moe_table(F, tb); final_phase(F, tb); }
#undef IN
#undef SEAM
}

extern "C" void kernel_launch(void* const* d_in, const int* in_sizes, int n_in, void* d_out, int out_size, void* d_ws, size_t ws_size, hipStream_t stream) {
    static int grid = 0;
    if (grid == 0) {
        if (n_in != N_IN || out_size != M * D || ws_size < WS_END) { fprintf(stderr, "kernel_launch: unexpected shapes (n_in %d, out %d, ws %zu)\n", n_in, out_size, ws_size); grid = -1; return; }
        int dev = 0, cus = 0, per_cu = 0;
        if (hipGetDevice(&dev) != hipSuccess || hipDeviceGetAttribute(&cus, hipDeviceAttributeMultiprocessorCount, dev) != hipSuccess) { grid = -1; return; }
        if (hipFuncSetAttribute((const void*)mk_fwd, hipFuncAttributeMaxDynamicSharedMemorySize, LDS_BYTES) != hipSuccess) { fprintf(stderr, "kernel_launch: hipFuncSetAttribute failed\n"); grid = -1; return; }
        if (hipOccupancyMaxActiveBlocksPerMultiprocessor(&per_cu, (const void*)mk_fwd, NWAVES * 64, LDS_BYTES) != hipSuccess || per_cu < 1) fprintf(stderr, "kernel_launch: occupancy query says %d\n", per_cu);
        (void)hipGetLastError();
        grid = cus;
    }
    if (grid < 0) return;
    if (hipMemsetAsync((char*)d_ws + WS_CTL, 0, CTL_ZERO_BYTES, stream) != hipSuccess) return;
    Args a{};
    for (int i = 0; i < N_IN; ++i) a.in[i] = (const float*)d_in[i];
    a.out = (float*)d_out; a.ws = (unsigned char*)d_ws;
    for (int li = 0; li < MK_N_LAUNCHES; ++li) {
        a.ph_lo = (MK_N_LAUNCHES == 1) ? 0 : li; a.ph_hi = (MK_N_LAUNCHES == 1) ? NPHASE : li + 1; a.li = (MK_N_LAUNCHES == 1) ? 0 : li;
        hipLaunchKernelGGL(mk_fwd, dim3(grid), dim3(NWAVES * 64), LDS_BYTES, stream, a);
        if (hipPeekAtLastError() != hipSuccess) { fprintf(stderr, "kernel_launch: launch %d failed\n", li); break; }
    }
}
```

```cpp
#include <hip/hip_runtime.h>
#include <cstdio>
#include <cstdint>

#ifndef MK_N_LAUNCHES
#define MK_N_LAUNCHES 1
#endif

#define GAS __attribute__((address_space(1)))
#define LAS __attribute__((address_space(3)))
typedef unsigned short bf16;
typedef short bf16x8 __attribute__((ext_vector_type(8)));
typedef float f32x4 __attribute__((ext_vector_type(4)));
typedef float f32x2 __attribute__((ext_vector_type(2)));
typedef unsigned u32x4 __attribute__((ext_vector_type(4)));
typedef unsigned u32x2 __attribute__((ext_vector_type(2)));
typedef GAS unsigned gu32;
#define RLX_AGENT __ATOMIC_RELAXED, __HIP_MEMORY_SCOPE_AGENT
#define LDS_WAIT() asm volatile("s_waitcnt lgkmcnt(0)" ::: "memory")
#define VM_WAIT() asm volatile("s_waitcnt vmcnt(0)" ::: "memory")

constexpr int NB = 8, T_ = 4096, D = 1024, M = NB * T_, NMEM = 256, MM = NB * NMEM;
constexpr int CONV_CH = 512, SBH = 8, SBD = 64, SBW = 512, CWID = 31, NE = 32, TOPK = 4, DFF = 1024;
constexpr int INC = 2560;
constexpr float LN_EPS = 1e-5f;
constexpr float DN_ALPHA = 1.189207115002721f;
constexpr float LOG2E = 1.4426950408889634f;
constexpr float SB_QSCALE = 0.125f * LOG2E;
constexpr float MEM_QSCALE = 0.0625f * LOG2E;
constexpr float WGU_SC = 32.0f, WDN_SC = 64.0f;
constexpr int NBLK_MAX = M * TOPK / 256 + NE;
constexpr int LCAP = M;

constexpr size_t MiB = 1u << 20;
constexpr size_t WS_CTL = 0, CTL_ZERO_BYTES = 1 * MiB;
constexpr size_t WS_WIN_T = 1 * MiB;
constexpr size_t WS_WOUT_T = 6 * MiB;
constexpr size_t WS_WQ_T = 8 * MiB, WS_WK_T = 10 * MiB, WS_WV_T = 12 * MiB, WS_WO_T = 14 * MiB;
constexpr size_t WS_WGU_T = 16 * MiB;
constexpr size_t WS_WDN_T = 144 * MiB;
constexpr size_t WS_HB8 = 176 * MiB;
constexpr size_t WS_HB = 208 * MiB;
constexpr size_t WS_LTOK = 272 * MiB;
constexpr size_t WS_LGATE = 276 * MiB;
constexpr size_t WS_SIDX = 280 * MiB;
constexpr size_t WS_X = 288 * MiB;
constexpr size_t WS_U = WS_X;
constexpr size_t WS_Q = WS_X + 32 * MiB;
constexpr size_t WS_K = WS_X + 64 * MiB;
constexpr size_t WS_V = WS_X + 96 * MiB;
constexpr size_t WS_MIXIN = WS_X + 128 * MiB;
constexpr size_t WS_QM = WS_X + 192 * MiB;
constexpr size_t WS_SP = WS_X + 256 * MiB;
constexpr size_t WS_OB = WS_X + 320 * MiB;
constexpr size_t WS_MEMN = WS_X + 384 * MiB;
constexpr size_t WS_KM = WS_X + 388 * MiB;
constexpr size_t WS_VMT = WS_X + 392 * MiB;
constexpr size_t WS_ACT = WS_X;
constexpr size_t WS_YS = WS_X + 272 * MiB;
constexpr size_t WS_END = WS_X + 544 * MiB;
constexpr int CW_TMO = 0, CW_CODE = 1;
constexpr int CW_BAR = 4096;
constexpr int CW_ECNT = 131072;
constexpr int NPHASE = 14;

constexpr int RING_OFF = 0, RING_BYTES = 131072;
constexpr int LDSCTL_OFF = RING_BYTES, MISC_OFF = LDSCTL_OFF + 320;
constexpr int XTRA_OFF = LDSCTL_OFF + 1024;
constexpr int LDS_BYTES = 147456;
constexpr int NWAVES = 8;

__device__ __forceinline__ unsigned f2bf(float f) { unsigned u = __builtin_bit_cast(unsigned, f); return (u + 0x7fffu + ((u >> 16) & 1u)) >> 16; }
__device__ __forceinline__ unsigned pk2(float lo, float hi) { return f2bf(lo) | (f2bf(hi) << 16); }
__device__ __forceinline__ float bflo(unsigned u) { return __builtin_bit_cast(float, u << 16); }
__device__ __forceinline__ float bfhi(unsigned u) { return __builtin_bit_cast(float, u & 0xffff0000u); }
__device__ __forceinline__ float wave_sum(float v) {
#pragma unroll
    for (int o = 1; o < 64; o <<= 1) v += __shfl_xor(v, o);
    return v;
}
__device__ __forceinline__ float wave_max(float v) {
#pragma unroll
    for (int o = 1; o < 64; o <<= 1) v = fmaxf(v, __shfl_xor(v, o));
    return v;
}
__device__ __forceinline__ unsigned pk4_fp8(float a, float b, float c, float d) {
    int r = __builtin_amdgcn_cvt_pk_fp8_f32(a, b, 0, false); r = __builtin_amdgcn_cvt_pk_fp8_f32(c, d, r, true); return (unsigned)r; }
__device__ __forceinline__ float sigmoidf_fast(float x) { return __builtin_amdgcn_rcpf(1.0f + __expf(-x)); }

namespace pg8 {
constexpr int BM = 256, BK = 64, HALF = 128, HTB = HALF * BK * 2, STAGE_BYTES = 8 * HTB, NXCD = 8, WGM = 8;
__host__ __device__ __forceinline__ int lds_byte(int r, int c) { const int st = (r >> 4) * 2 + (c >> 5), rr = r & 15, cc = c & 31, ob = rr * 64 + cc * 2; return st * 1024 + (ob ^ (((ob >> 9) & 1) << 5)); }
__host__ __device__ __forceinline__ void stage_rc(int b, int& R, int& C) { const int st = b / 1024, sb = b % 1024, swz = sb ^ (((sb >> 9) & 1) << 5); R = (st >> 1) * 16 + swz / 64; C = (st & 1) * 32 + (swz % 64) / 2; }
__host__ __device__ __forceinline__ int perm32(int rho) { const int n = rho >> 4, i = rho & 15; return 8 * (i >> 2) + 4 * n + (i & 3); }

struct Unit { int pm, pn, z, nvalid; unsigned aoff, boff, goff; };

__device__ __forceinline__ void tile_order(int L, int nM, int nN, int& pm, int& pn) {
    const int nwg = nM * nN; int wgid = L;
    { const int q = nwg / NXCD, r = nwg % NXCD, xcd = wgid % NXCD, off = wgid / NXCD; wgid = (xcd < r ? xcd * (q + 1) : r * (q + 1) + (xcd - r) * q) + off; }
    const int nig = WGM * nN, gid = wgid / nig, fm = gid * WGM, gsz = (nM - fm) < WGM ? (nM - fm) : WGM;
    pm = fm + ((wgid % nig) % gsz); pn = (wgid % nig) / gsz;
}
__device__ __forceinline__ unsigned cvt_pk_bf16(float lo, float hi) { unsigned r; asm volatile("v_cvt_pk_bf16_f32 %0, %1, %2" : "=v"(r) : "v"(lo), "v"(hi)); return r; }

__device__ __forceinline__ void store_tile_bf16(const f32x4 (&acc)[2][2][4][2], bf16* p0, size_t ldc, const float* bias, float scale, int wc, int fq) {
    const int cl = wc * 32 + 8 * fq;
    f32x4 bv[2][2];
#pragma unroll
    for (int bj = 0; bj < 2; ++bj)
#pragma unroll
        for (int n = 0; n < 2; ++n) bv[bj][n] = bias ? *(const f32x4*)(bias + cl + bj * HALF + 4 * n) : (f32x4){0.f, 0.f, 0.f, 0.f};
#pragma unroll
    for (int ai = 0; ai < 2; ++ai)
#pragma unroll
        for (int m = 0; m < 4; ++m) { bf16* rowp = p0 + (size_t)(ai * HALF + m * 16) * ldc + cl;
#pragma unroll
            for (int bj = 0; bj < 2; ++bj) { const f32x4 v0 = (acc[ai][bj][m][0] + bv[bj][0]) * scale, v1 = (acc[ai][bj][m][1] + bv[bj][1]) * scale;
                u32x4 w; w.x = cvt_pk_bf16(v0[0], v0[1]); w.y = cvt_pk_bf16(v0[2], v0[3]); w.z = cvt_pk_bf16(v1[0], v1[1]); w.w = cvt_pk_bf16(v1[2], v1[3]);
                *(u32x4*)(rowp + bj * HALF) = w; } }
}

typedef int v8i __attribute__((ext_vector_type(8)));
template <class Epi, class Sched, bool GATHER, bool FP8 = false>
__device__ __forceinline__ void gemm_phase(LAS unsigned char* lds, const char* wsb, const int lda, const int ldb, const int K, const Sched& S, const Epi& E, const int* glist) {
    const int tid = threadIdx.x, wid = __builtin_amdgcn_readfirstlane(tid >> 6), lane = tid & 63, wr = wid >> 2, wc = wid & 3, fr = lane & 15, fq = lane >> 4;
    const int nt = K / BK;
    unsigned voffA[2], voffB[2]; int Rr[2], Cc[2];
#pragma unroll
    for (int i = 0; i < 2; ++i) { int R, C; stage_rc(tid * 16 + i * 8192, R, C); const int Rb = Epi::PERM ? ((R & ~31) + perm32(R & 31)) : R;
        voffA[i] = (unsigned)(R * lda + C) * 2u; voffB[i] = (unsigned)(Rb * ldb + C) * 2u; Rr[i] = R; Cc[i] = C; }
    const size_t kstep = (size_t)(BK * 2);
    const size_t hstepA = (size_t)HALF * lda * 2, hstepB = (size_t)HALF * ldb * 2;
    const unsigned ldsw = (unsigned)wid * 1024u;
    const int aoff = lds_byte(wr * 64 + fr, fq * 8), boff = lds_byte(wc * 32 + fr, fq * 8);
    unsigned gc[2][2], gn[2][2];
#define PG8_SA(b, h) (((b) * 2 + (h)) * HTB)
#define PG8_SB(b, h) ((4 + (b) * 2 + (h)) * HTB)
#define PG8_STAGE_B(bufoff, gbase) do { _Pragma("unroll") for (int _i = 0; _i < 2; ++_i) \
        __builtin_amdgcn_global_load_lds((const unsigned*)((const char*)(gbase) + voffB[_i]), (LAS unsigned*)(lds + (bufoff) + ldsw + _i * 8192), 16, 0, 0); } while (0)
#define PG8_STAGE_A(bufoff, gbase, h, nx) do { _Pragma("unroll") for (int _i = 0; _i < 2; ++_i) { \
        const char* _p = GATHER ? (const char*)(gbase) + ((nx) ? gn[h][_i] : gc[h][_i]) : (const char*)(gbase) + (h) * hstepA + voffA[_i]; \
        __builtin_amdgcn_global_load_lds((const unsigned*)_p, (LAS unsigned*)(lds + (bufoff) + ldsw + _i * 8192), 16, 0, 0); } } while (0)
#define PG8_LDA(dst, b, h) do { _Pragma("unroll") for (int m = 0; m < 4; ++m) { if constexpr (FP8) { const u32x4 _lo = *(const LAS u32x4*)(lds + PG8_SA(b, h) + aoff + m * 2048), _hi = *(const LAS u32x4*)(lds + PG8_SA(b, h) + aoff + m * 2048 + 1024); \
            dst##8[m] = (v8i){(int)_lo.x, (int)_lo.y, (int)_lo.z, (int)_lo.w, (int)_hi.x, (int)_hi.y, (int)_hi.z, (int)_hi.w}; } \
        else { _Pragma("unroll") for (int k = 0; k < 2; ++k) dst[m][k] = *(const LAS bf16x8*)(lds + PG8_SA(b, h) + aoff + m * 2048 + k * 1024); } } } while (0)
#define PG8_LDB(dst, b, h) do { _Pragma("unroll") for (int n = 0; n < 2; ++n) { if constexpr (FP8) { const u32x4 _lo = *(const LAS u32x4*)(lds + PG8_SB(b, h) + boff + n * 2048), _hi = *(const LAS u32x4*)(lds + PG8_SB(b, h) + boff + n * 2048 + 1024); \
            dst##8[n] = (v8i){(int)_lo.x, (int)_lo.y, (int)_lo.z, (int)_lo.w, (int)_hi.x, (int)_hi.y, (int)_hi.z, (int)_hi.w}; } \
        else { _Pragma("unroll") for (int k = 0; k < 2; ++k) dst[n][k] = *(const LAS bf16x8*)(lds + PG8_SB(b, h) + boff + n * 2048 + k * 1024); } } } while (0)
#define PG8_MMA(ai, bj, At, Bt) do { __builtin_amdgcn_s_setprio(1); if constexpr (FP8) asm volatile("s_nop 1"); _Pragma("unroll") for (int m = 0; m < 4; ++m) _Pragma("unroll") for (int n = 0; n < 2; ++n) { \
        if constexpr (FP8) asm volatile("v_mfma_f32_16x16x128_f8f6f4 %0, %1, %2, %0" : "+v"(acc[ai][bj][m][n]) : "v"(Bt##8[n]), "v"(At##8[m])); \
        else { _Pragma("unroll") for (int k = 0; k < 2; ++k) acc[ai][bj][m][n] = __builtin_amdgcn_mfma_f32_16x16x32_bf16(Bt[n][k], At[m][k], acc[ai][bj][m][n], 0, 0, 0); } } \
        __builtin_amdgcn_s_setprio(0); } while (0)
#define PG8_WAIT_V(n) asm volatile("s_waitcnt vmcnt(" #n ")" ::: "memory")
#define PG8_WAIT_L(n) asm volatile("s_waitcnt lgkmcnt(" #n ")" ::: "memory")
#define PG8_BAR __builtin_amdgcn_s_barrier()
#define PG8_SCHED __builtin_amdgcn_sched_barrier(0)
#define PG8_GIDX(g, u) do { _Pragma("unroll") for (int _h = 0; _h < 2; ++_h) _Pragma("unroll") for (int _i = 0; _i < 2; ++_i) { const int _r = _h * HALF + Rr[_i]; \
        const int _tok = glist[(u).goff + (_r < (u).nvalid ? _r : (u).nvalid - 1)]; g[_h][_i] = (unsigned)_tok * (unsigned)(lda * 2) + (unsigned)(Cc[_i] * 2); } } while (0)
    Unit cur, nxt, nn; int ui = 0;
    if (!S.next(0, cur)) return;
    f32x4 acc[2][2][4][2];
#pragma unroll
    for (int a = 0; a < 2; ++a)
#pragma unroll
        for (int b = 0; b < 2; ++b)
#pragma unroll
            for (int m = 0; m < 4; ++m)
#pragma unroll
                for (int n = 0; n < 2; ++n) acc[a][b][m][n] = (f32x4){0.f, 0.f, 0.f, 0.f};
    bf16x8 At[4][2], B0[2][2], B1[2][2];
    v8i At8[4], B08[2], B18[2];
    const char* cA = wsb + cur.aoff; const char* cB = wsb + cur.boff;
    if constexpr (GATHER) { PG8_GIDX(gc, cur); if (S.next(1, nxt)) { PG8_GIDX(gn, nxt); } else { PG8_GIDX(gn, cur); }
        asm volatile("s_waitcnt vmcnt(0)" : "+v"(gc[0][0]), "+v"(gc[0][1]), "+v"(gc[1][0]), "+v"(gc[1][1]), "+v"(gn[0][0]), "+v"(gn[0][1]), "+v"(gn[1][0]), "+v"(gn[1][1]) :: "memory"); }
    else {
#pragma unroll
        for (int h = 0; h < 2; ++h)
#pragma unroll
            for (int i = 0; i < 2; ++i) { gc[h][i] = 0u; gn[h][i] = 0u; } }
    PG8_STAGE_B(PG8_SB(0, 0), cB); PG8_STAGE_B(PG8_SB(0, 1), cB + hstepB); PG8_STAGE_A(PG8_SA(0, 0), cA, 0, false); PG8_STAGE_A(PG8_SA(0, 1), cA, 1, false);
    if (wr == 1) PG8_BAR;
    PG8_WAIT_V(2); PG8_BAR;
    PG8_STAGE_B(PG8_SB(1, 0), cB + kstep); PG8_STAGE_A(PG8_SA(1, 0), cA + kstep, 0, false); PG8_STAGE_B(PG8_SB(1, 1), cB + hstepB + kstep);
    PG8_WAIT_V(6); PG8_BAR;
    for (;;) {
        const bool has_next = S.next(ui + 1, nxt);
        const char* nA = has_next ? wsb + nxt.aoff : cA; const char* nB = has_next ? wsb + nxt.boff : cB;
#pragma clang loop unroll(disable)
        for (int t = 0; t < nt; t += 2) {
            const bool last = (t == nt - 2);
            const char* a1 = cA + (size_t)(t + 1) * kstep;
            const char* a2 = last ? nA : cA + (size_t)(t + 2) * kstep; const char* b2 = last ? nB : cB + (size_t)(t + 2) * kstep;
            const char* a3 = a2 + kstep; const char* b3 = b2 + kstep;
            PG8_LDB(B0, 0, 0); PG8_LDB(B1, 0, 1); PG8_SCHED; PG8_LDA(At, 0, 0); PG8_STAGE_A(PG8_SA(1, 1), a1, 1, false);
            PG8_WAIT_V(8); PG8_WAIT_L(0); PG8_BAR; PG8_MMA(0, 0, At, B0); PG8_MMA(0, 1, At, B1); PG8_BAR; PG8_SCHED;
            PG8_LDA(At, 0, 1); PG8_STAGE_B(PG8_SB(0, 0), b2); PG8_STAGE_B(PG8_SB(0, 1), b2 + hstepB); PG8_STAGE_A(PG8_SA(0, 0), a2, 0, last);
            PG8_WAIT_V(8); PG8_WAIT_L(0); PG8_BAR; PG8_MMA(1, 0, At, B0); PG8_MMA(1, 1, At, B1); PG8_BAR; PG8_SCHED;
            PG8_LDB(B0, 1, 0); PG8_LDB(B1, 1, 1); PG8_SCHED; PG8_LDA(At, 1, 0); PG8_STAGE_A(PG8_SA(0, 1), a2, 1, last);
            PG8_WAIT_V(8); PG8_WAIT_L(0); PG8_BAR; PG8_MMA(0, 0, At, B0); PG8_MMA(0, 1, At, B1); PG8_BAR; PG8_SCHED;
            PG8_LDA(At, 1, 1); PG8_STAGE_B(PG8_SB(1, 0), b3); PG8_STAGE_B(PG8_SB(1, 1), b3 + hstepB); PG8_STAGE_A(PG8_SA(1, 0), a3, 0, last);
            PG8_WAIT_V(8); PG8_WAIT_L(0); PG8_BAR; PG8_MMA(1, 0, At, B0); PG8_MMA(1, 1, At, B1); PG8_BAR; PG8_SCHED;
        }
        if constexpr (FP8) asm volatile("s_nop 15\n\ts_nop 7");
        if (wr == 0) PG8_BAR;
        if constexpr (GATHER) {
#pragma unroll
            for (int h = 0; h < 2; ++h)
#pragma unroll
                for (int i = 0; i < 2; ++i) gc[h][i] = gn[h][i];
            if (has_next && S.next(ui + 2, nn)) { PG8_GIDX(gn, nn); }
        }
        E(acc, cur, wr, wc, fr, fq);
        if constexpr (GATHER) asm volatile("" : "+v"(gn[0][0]), "+v"(gn[0][1]), "+v"(gn[1][0]), "+v"(gn[1][1]));
        if (!has_next) break;
#pragma unroll
        for (int a = 0; a < 2; ++a)
#pragma unroll
            for (int b = 0; b < 2; ++b)
#pragma unroll
                for (int m = 0; m < 4; ++m)
#pragma unroll
                    for (int n = 0; n < 2; ++n) acc[a][b][m][n] = (f32x4){0.f, 0.f, 0.f, 0.f};
        cur = nxt; cA = nA; cB = nB; ++ui;
        if (wr == 1) PG8_BAR;
    }
    PG8_WAIT_V(0);
    PG8_BAR;
#undef PG8_SA
#undef PG8_SB
#undef PG8_STAGE_A
#undef PG8_STAGE_B
#undef PG8_LDA
#undef PG8_LDB
#undef PG8_MMA
#undef PG8_WAIT_V
#undef PG8_WAIT_L
#undef PG8_BAR
#undef PG8_SCHED
#undef PG8_GIDX
}
}
using pg8::Unit;

#define XB_TMO      128
#define XB_XCNT(j)  (256  + 64 * (j))
#define XB_XSUB(j)  (1280 + 64 * (j))
#define XB_XGEN(j)  (2304 + 64 * (j))
#define XB_TOP      3328
#define XB_TOPGEN   3392
#define XCD_BAR_WORDS 3456
#define XB_SPIN_CAP (1u << 18)
__device__ __forceinline__ unsigned xb_ld(unsigned* p)              { return __hip_atomic_load(p, __ATOMIC_RELAXED, __HIP_MEMORY_SCOPE_AGENT); }
__device__ __forceinline__ unsigned xb_add(unsigned* p, unsigned v) { return __hip_atomic_fetch_add(p, v, __ATOMIC_RELAXED, __HIP_MEMORY_SCOPE_AGENT); }
__device__ __forceinline__ unsigned xb_xcc_id() { return (unsigned)__builtin_amdgcn_s_getreg((3 << 11) | 20) & 0xFu; }
#define XB_SPIN(cond, bar) do { unsigned _sp = 0; while (cond) { __builtin_amdgcn_s_sleep(1); \
    if ((++_sp & 255u) == 0u) { if (xb_ld(&(bar)[XB_TMO])) break; if (_sp > XB_SPIN_CAP) { atomicAdd(&(bar)[XB_TMO], 1u); break; } } } } while (0)
struct XcdBarrier { unsigned* bar; unsigned x; volatile LAS unsigned* st; };
__device__ __forceinline__ XcdBarrier xcd_barrier_post(unsigned* bar, volatile LAS unsigned* st) {
    XcdBarrier b; b.bar = bar; b.x = xb_xcc_id(); b.st = st;
    if (threadIdx.x == 0) (void)xb_add(&bar[XB_XCNT(b.x)], 1u);
    return b;
}
__device__ __forceinline__ void xcd_barrier_complete(unsigned* bar, unsigned x, unsigned& nloc, unsigned& nx) {
    const unsigned G = gridDim.x * gridDim.y * gridDim.z;
    unsigned sum, cnt, mine, sp = 0u;
    for (;;) {
        sum = 0u; cnt = 0u; mine = 0u;
#pragma unroll
        for (unsigned j = 0; j < 16; ++j) { const unsigned c = xb_ld(&bar[XB_XCNT(j)]); sum += c; cnt += (c > 0u) ? 1u : 0u; mine = (j == x) ? c : mine; }
        if (sum == G) break;
        __builtin_amdgcn_s_sleep(1);
        if ((++sp & 255u) == 0u) { if (xb_ld(&bar[XB_TMO])) break; if (sp > XB_SPIN_CAP) { atomicAdd(&bar[XB_TMO], 1u); break; } }
    }
    nloc = mine > 0u ? mine : 1u; nx = cnt > 0u ? cnt : 1u;
}
__device__ __forceinline__ void xcd_barrier(const XcdBarrier& b) {
    asm volatile("s_waitcnt vmcnt(0)" ::: "memory");
    __syncthreads();
    if (threadIdx.x == 0) {
        unsigned* bar = b.bar;
        __builtin_amdgcn_s_waitcnt(0);
        unsigned nloc = b.st[0], nx = b.st[1];
        if (nloc == 0u) { xcd_barrier_complete(bar, b.x, nloc, nx); b.st[0] = nloc; b.st[1] = nx; }
        const unsigned old = xb_add(&bar[XB_XSUB(b.x)], 1u);
        const unsigned gen = old / nloc;
        if (old + 1u == (gen + 1u) * nloc) {
            __builtin_amdgcn_fence(__ATOMIC_RELEASE, "agent");
            asm volatile("s_waitcnt vmcnt(0)" ::: "memory");
            const unsigned og = xb_add(&bar[XB_TOP], 1u);
            const unsigned tg = og / nx;
            if (og + 1u == (tg + 1u) * nx) xb_add(&bar[XB_TOPGEN], 1u);
            else XB_SPIN(xb_ld(&bar[XB_TOPGEN]) == tg, bar);
            __builtin_amdgcn_fence(__ATOMIC_ACQUIRE, "agent");
            xb_add(&bar[XB_XGEN(b.x)], 1u);
            asm volatile("s_waitcnt vmcnt(0)" ::: "memory");
        } else {
            XB_SPIN(xb_ld(&bar[XB_XGEN(b.x)]) == gen, bar);
            __builtin_amdgcn_fence(__ATOMIC_ACQUIRE, "agent");
            asm volatile("s_waitcnt vmcnt(0)" ::: "memory");
        }
    }
    __syncthreads();
}

struct Frame {
    LAS unsigned char* lds;
    volatile LAS unsigned* MISC;
    gu32* ctl;
    unsigned char* ws;
    int tid, lane, wave, vcu, G;
    float* hf;
    const float* const* in;
};
enum In { I_X = 0, I_MEM, I_LN_IN_G, I_LN_IN_B, I_LN_MEM_G, I_LN_MEM_B, I_W_IN, I_B_IN, I_W_DW, I_B_DW, I_LN_CONV_G, I_LN_CONV_B, I_W_OUT, I_B_OUT, I_LN1_G, I_LN1_B,
          I_WQ, I_WK, I_WV, I_WO, I_LN2_G, I_LN2_B, I_W_ROUTER, I_B_ROUTER, I_W_GU, I_B_GU, I_W_DOWN, I_B_DOWN, I_LN3_G, I_LN3_B, N_IN };

__device__ __forceinline__ void p0_transpose_item(const float* W, int K, int N, bf16* WT, int k0, int n0, int drow, LAS float* scr, int lane) {
#pragma unroll 8
    for (int i = 0; i < 32; ++i) { const int kk = 2 * i + (lane >> 5); scr[kk * 33 + (lane & 31)] = W[(size_t)(k0 + kk) * N + n0 + (lane & 31)]; }
    LDS_WAIT(); asm volatile("" ::: "memory");
    const int c = lane & 7;
#pragma unroll
    for (int j = 0; j < 4; ++j) { const int n = (lane >> 3) + 8 * j; const LAS float* s = scr + (8 * c) * 33 + n;
        u32x4 o; o.x = pk2(s[0 * 33], s[1 * 33]); o.y = pk2(s[2 * 33], s[3 * 33]); o.z = pk2(s[4 * 33], s[5 * 33]); o.w = pk2(s[6 * 33], s[7 * 33]);
        *(GAS u32x4*)(WT + (size_t)(drow + n) * K + k0 + 8 * c) = o; }
    LDS_WAIT(); asm volatile("" ::: "memory");
}
__device__ __forceinline__ void ln_row(f32x4 (&v)[4], const float* g, const float* b, int lane) {
    float s = 0.f;
#pragma unroll
    for (int j = 0; j < 4; ++j) s += (v[j].x + v[j].y) + (v[j].z + v[j].w);
    const float mean = wave_sum(s) * (1.f / D); float s2 = 0.f;
#pragma unroll
    for (int j = 0; j < 4; ++j) { v[j] = v[j] - mean; s2 += (v[j].x * v[j].x + v[j].y * v[j].y) + (v[j].z * v[j].z + v[j].w * v[j].w); }
    const float rstd = 1.f / sqrtf(wave_sum(s2) * (1.f / D) + LN_EPS);
#pragma unroll
    for (int j = 0; j < 4; ++j) { const f32x4 gg = ((const GAS f32x4*)g)[lane + 64 * j], bb = ((const GAS f32x4*)b)[lane + 64 * j]; v[j] = v[j] * rstd * gg + bb; }
}
__device__ __forceinline__ void store_row_bf16(const f32x4 (&v)[4], bf16* orow, int lane) {
    GAS u32x2* o8 = (GAS u32x2*)orow + lane;
#pragma unroll
    for (int j = 0; j < 4; ++j) o8[64 * j] = (u32x2){pk2(v[j].x, v[j].y), pk2(v[j].z, v[j].w)};
}
__device__ __forceinline__ void p0_transpose_item8(const float* W, int K, int N, unsigned char* WT, int k0, int n0, int drow, float sc, LAS float* scr, int lane) {
#pragma unroll 8
    for (int i = 0; i < 32; ++i) { const int kk = 2 * i + (lane >> 5); scr[kk * 33 + (lane & 31)] = W[(size_t)(k0 + kk) * N + n0 + (lane & 31)]; }
    LDS_WAIT(); asm volatile("" ::: "memory");
    const int c = lane & 7;
#pragma unroll
    for (int j = 0; j < 4; ++j) { const int n = (lane >> 3) + 8 * j; const LAS float* s = scr + (8 * c) * 33 + n;
        u32x2 o; o.x = pk4_fp8(s[0 * 33] * sc, s[1 * 33] * sc, s[2 * 33] * sc, s[3 * 33] * sc); o.y = pk4_fp8(s[4 * 33] * sc, s[5 * 33] * sc, s[6 * 33] * sc, s[7 * 33] * sc);
        *(GAS u32x2*)(WT + (size_t)(drow + n) * K + k0 + 8 * c) = o; }
    LDS_WAIT(); asm volatile("" ::: "memory");
}
__device__ __forceinline__ void load_row_bf16(f32x4 (&v)[4], const bf16* xrow, int lane) {
    const GAS u32x2* xr = (const GAS u32x2*)xrow + lane;
#pragma unroll
    for (int j = 0; j < 4; ++j) { const u32x2 w = xr[64 * j]; v[j] = (f32x4){bflo(w.x), bfhi(w.x), bflo(w.y), bfhi(w.y)}; }
}
__device__ __forceinline__ void load_row_f32(f32x4 (&v)[4], const float* xrow, int lane) {
    const GAS f32x4* xr = (const GAS f32x4*)xrow + lane;
#pragma unroll
    for (int j = 0; j < 4; ++j) v[j] = xr[64 * j];
}
__device__ __forceinline__ void store_row_f32(const f32x4 (&v)[4], float* orow, int lane) {
    GAS f32x4* o = (GAS f32x4*)orow + lane;
#pragma unroll
    for (int j = 0; j < 4; ++j) o[64 * j] = v[j];
}

__device__ __forceinline__ void p0_prologue(Frame& F) {
    LAS float* scr = (LAS float*)(F.lds + RING_OFF + F.wave * 16384);
    const int gw = F.vcu * NWAVES + F.wave, NGW = F.G * NWAVES;
    constexpr int I_IN = 16 * 80, I_SQ = 16 * 32, I_GU = NE * 16 * 64, I_DN = NE * 16 * 32;
    constexpr int NITEMS = I_IN + 5 * I_SQ + I_GU + I_DN;
    for (int it = gw; it < NITEMS; it += NGW) {
        int r = it;
        if (r < I_IN) { const int kb = r / 80, nb = r % 80, n0 = 32 * nb; int drow;
            if (n0 < 512) drow = (n0 >> 7) * 256 + (n0 & 127); else if (n0 < 1024) drow = ((n0 - 512) >> 7) * 256 + 128 + (n0 & 127); else drow = n0;
            p0_transpose_item(F.in[I_W_IN], D, INC, (bf16*)(F.ws + WS_WIN_T), 64 * kb, n0, drow, scr, F.lane); continue; } r -= I_IN;
        if (r < 5 * I_SQ) { const int w = r / I_SQ, q = r % I_SQ, kb = q / 32, nb = q % 32;
            const float* src = F.in[w == 0 ? I_W_OUT : w == 1 ? I_WQ : w == 2 ? I_WK : w == 3 ? I_WV : I_WO];
            bf16* dst = (bf16*)(F.ws + (w == 0 ? WS_WOUT_T : w == 1 ? WS_WQ_T : w == 2 ? WS_WK_T : w == 3 ? WS_WV_T : WS_WO_T));
            p0_transpose_item(src, D, D, dst, 64 * kb, 32 * nb, 32 * nb, scr, F.lane); continue; } r -= 5 * I_SQ;
        if (r < I_GU) { const int e = r / (16 * 64), q = r % (16 * 64), kb = q / 64, nb = q % 64, n0 = 32 * nb;
            const int drow = (n0 < 1024) ? (n0 >> 7) * 256 + (n0 & 127) : ((n0 - 1024) >> 7) * 256 + 128 + (n0 & 127);
            p0_transpose_item8(F.in[I_W_GU] + (size_t)e * D * 2 * DFF, D, 2 * DFF, F.ws + WS_WGU_T + (size_t)e * 2 * DFF * D, 64 * kb, n0, drow, WGU_SC, scr, F.lane); continue; } r -= I_GU;
        { const int e = r / (16 * 32), q = r % (16 * 32), kb = q / 32, nb = q % 32;
            p0_transpose_item8(F.in[I_W_DOWN] + (size_t)e * DFF * D, DFF, D, F.ws + WS_WDN_T + (size_t)e * D * DFF, 64 * kb, 32 * nb, 32 * nb, WDN_SC, scr, F.lane); }
    }
    for (int m = gw; m < M + MM; m += NGW) {
        f32x4 v[4];
        if (m < M) { load_row_f32(v, F.in[I_X] + (size_t)m * D, F.lane); ln_row(v, F.in[I_LN_IN_G], F.in[I_LN_IN_B], F.lane);
            store_row_bf16(v, (bf16*)(F.ws + WS_HB) + (size_t)m * D, F.lane); }
        else { const int mm = m - M; load_row_f32(v, F.in[I_MEM] + (size_t)mm * D, F.lane); ln_row(v, F.in[I_LN_MEM_G], F.in[I_LN_MEM_B], F.lane);
            store_row_bf16(v, (bf16*)(F.ws + WS_MEMN) + (size_t)mm * D, F.lane); }
    }
}

constexpr unsigned TSTEP = 256u * 1024u * 2u;
struct SchedP1 { int G, c;
    __device__ __forceinline__ bool next(int i, Unit& u) const {
        const int L = i * G + c; if (L >= 1344) return false;
        u.nvalid = 256; u.goff = 0;
        if (L < 1024) { pg8::tile_order(L, 128, 8, u.pm, u.pn); u.z = 0; u.aoff = (unsigned)WS_HB + (unsigned)u.pm * TSTEP; u.boff = (unsigned)WS_WIN_T + (unsigned)u.pn * TSTEP; }
        else if (L < 1280) { const int j = L - 1024; u.pm = j & 1; u.pn = j >> 1; u.z = 3; u.aoff = (unsigned)WS_WIN_T + (unsigned)(8 + u.pm) * TSTEP; u.boff = (unsigned)WS_HB + (unsigned)u.pn * TSTEP; }
        else if (L < 1312) { const int j = L - 1280; u.pm = j & 7; u.pn = j >> 3; u.z = 1; u.aoff = (unsigned)WS_MEMN + (unsigned)u.pm * TSTEP; u.boff = (unsigned)WS_WK_T + (unsigned)u.pn * TSTEP; }
        else { const int j = L - 1312; u.pm = j & 3; u.pn = j >> 2; u.z = 2; u.aoff = (unsigned)WS_WV_T + (unsigned)u.pm * TSTEP; u.boff = (unsigned)WS_MEMN + (unsigned)u.pn * TSTEP; }
        return true; }
};
struct EpiP1 { static constexpr bool PERM = true;
    unsigned char* ws; const float* b_in;
    __device__ __forceinline__ void operator()(const f32x4 (&acc)[2][2][4][2], const Unit& u, int wr, int wc, int fr, int fq) const {
        const int row0 = u.pm * 256 + wr * 64 + fr;
        if (u.z == 0) {
            if (u.pn < 4) {
                const int ch = 128 * u.pn + wc * 32 + 8 * fq;
                f32x4 bv[2], bg[2];
#pragma unroll
                for (int n = 0; n < 2; ++n) { bv[n] = *(const f32x4*)(b_in + ch + 4 * n); bg[n] = *(const f32x4*)(b_in + 512 + ch + 4 * n); }
                bf16* U = (bf16*)(ws + WS_U);
#pragma unroll
                for (int ai = 0; ai < 2; ++ai)
#pragma unroll
                    for (int m = 0; m < 4; ++m) { f32x4 o[2];
#pragma unroll
                        for (int n = 0; n < 2; ++n) { const f32x4 a = acc[ai][0][m][n] + bv[n], g = acc[ai][1][m][n] + bg[n];
#pragma unroll
                            for (int j = 0; j < 4; ++j) o[n][j] = a[j] * sigmoidf_fast(g[j]); }
                        u32x4 w; w.x = pg8::cvt_pk_bf16(o[0][0], o[0][1]); w.y = pg8::cvt_pk_bf16(o[0][2], o[0][3]); w.z = pg8::cvt_pk_bf16(o[1][0], o[1][1]); w.w = pg8::cvt_pk_bf16(o[1][2], o[1][3]);
                        *(u32x4*)(U + (size_t)(row0 + ai * 128 + m * 16) * 512 + ch) = w; }
            } else {
                const int t = u.pn - 4, which = t >> 1, cb = (t & 1) * 256;
                bf16* dst = (bf16*)(ws + (which == 0 ? WS_Q : WS_K));
                pg8::store_tile_bf16(acc, dst + (size_t)row0 * 512 + cb, 512, b_in + 1024 + 256 * t, which == 0 ? SB_QSCALE : 1.0f, wc, fq);
            }
        } else if (u.z == 3) {
            const float* rb = b_in + 2048 + row0; bf16* p0 = (bf16*)(ws + WS_V) + (size_t)row0 * M + 256 * u.pn; const int cl = wc * 32 + 8 * fq;
#pragma unroll
            for (int ai = 0; ai < 2; ++ai)
#pragma unroll
                for (int m = 0; m < 4; ++m) { const float bv = rb[ai * 128 + m * 16]; bf16* rowp = p0 + (size_t)(ai * 128 + m * 16) * M + cl;
#pragma unroll
                    for (int bj = 0; bj < 2; ++bj) { const f32x4 v0 = acc[ai][bj][m][0] + bv, v1 = acc[ai][bj][m][1] + bv;
                        u32x4 w; w.x = pg8::cvt_pk_bf16(v0[0], v0[1]); w.y = pg8::cvt_pk_bf16(v0[2], v0[3]); w.z = pg8::cvt_pk_bf16(v1[0], v1[1]); w.w = pg8::cvt_pk_bf16(v1[2], v1[3]);
                        *(u32x4*)(rowp + bj * 128) = w; } }
        } else if (u.z == 1) pg8::store_tile_bf16(acc, (bf16*)(ws + WS_KM) + (size_t)row0 * 1024 + 256 * u.pn, 1024, nullptr, 1.0f, wc, fq);
        else pg8::store_tile_bf16(acc, (bf16*)(ws + WS_VMT) + (size_t)row0 * 2048 + 256 * u.pn, 2048, nullptr, 1.0f, wc, fq);
    }
};

struct SchedPlain { int G, c, nM, nN; unsigned abase, bbase, atile, btile, acol, bcol, bgrp;
    __device__ __forceinline__ bool next(int i, Unit& u) const {
        const int L = i * G + c; if (L >= nM * nN) return false;
        pg8::tile_order(L, nM, nN, u.pm, u.pn); u.z = 0; u.nvalid = 256; u.goff = 0;
        u.aoff = abase + (unsigned)u.pm * atile + (unsigned)u.pn * acol; u.boff = bbase + (unsigned)u.pn * btile + (unsigned)(u.pm >> 4) * bgrp + (unsigned)u.pn * bcol; return true; }
};
struct EpiBf16 { static constexpr bool PERM = true;
    bf16* O; int ldc; float scale; const float* bias;
    __device__ __forceinline__ void operator()(const f32x4 (&acc)[2][2][4][2], const Unit& u, int wr, int wc, int fr, int fq) const {
        pg8::store_tile_bf16(acc, O + (size_t)(u.pm * 256 + wr * 64 + fr) * ldc + 256 * u.pn, (size_t)ldc, bias ? bias + 256 * u.pn : nullptr, scale, wc, fq); }
};
struct SchedMoe { int G, c, nN; const LAS int* tb; unsigned abase, wbase, wexp;
    bool gather;
    __device__ __forceinline__ bool next(int i, Unit& u) const {
        const int nblk = __builtin_amdgcn_readfirstlane(tb[32]); const int L = i * G + c; if (L >= nblk * nN) return false;
        pg8::tile_order(L, nblk, nN, u.pm, u.pn);
        int e = 0; while (tb[e + 1] <= u.pm) ++e;
        e = __builtin_amdgcn_readfirstlane(e);
        const int j = u.pm - tb[e], rem = tb[64 + e] - 256 * j;
        u.z = e; u.nvalid = rem < 256 ? rem : 256; u.goff = (unsigned)(e * LCAP + 256 * j);
        u.aoff = gather ? abase : abase + (unsigned)u.pm * (TSTEP / 2);
        u.boff = wbase + (unsigned)e * wexp + (unsigned)u.pn * (TSTEP / 2); return true; }
};
struct EpiAct { static constexpr bool PERM = true;
    unsigned char* ACT; const float* b_gu;
    __device__ __forceinline__ void operator()(const f32x4 (&acc)[2][2][4][2], const Unit& u, int wr, int wc, int fr, int fq) const {
        const int row0 = u.pm * 256 + wr * 64 + fr, ch = 128 * u.pn + wc * 32 + 8 * fq;
        const float* bb = b_gu + (size_t)u.z * 2 * DFF;
        f32x4 bg[2], bu[2];
#pragma unroll
        for (int n = 0; n < 2; ++n) { bg[n] = *(const f32x4*)(bb + ch + 4 * n); bu[n] = *(const f32x4*)(bb + DFF + ch + 4 * n); }
#pragma unroll
        for (int ai = 0; ai < 2; ++ai)
#pragma unroll
            for (int m = 0; m < 4; ++m) { f32x4 o[2];
#pragma unroll
                for (int n = 0; n < 2; ++n) { const f32x4 g = acc[ai][0][m][n] * (1.0f / WGU_SC) + bg[n], uu = acc[ai][1][m][n] * (1.0f / WGU_SC) + bu[n];
#pragma unroll
                    for (int j = 0; j < 4; ++j) { const float g_ = fminf(g[j], 7.0f), u_ = fminf(fmaxf(uu[j], -7.0f), 7.0f); o[n][j] = (u_ + 1.0f) * g_ * sigmoidf_fast(1.702f * g_); } }
                *(u32x2*)(ACT + (size_t)(row0 + ai * 128 + m * 16) * DFF + ch) = (u32x2){pk4_fp8(o[0][0], o[0][1], o[0][2], o[0][3]), pk4_fp8(o[1][0], o[1][1], o[1][2], o[1][3])}; }
    }
};
struct EpiDown { static constexpr bool PERM = true;
    bf16* YS; const float* b_down; const float* lgate;
    __device__ __forceinline__ void operator()(const f32x4 (&acc)[2][2][4][2], const Unit& u, int wr, int wc, int fr, int fq) const {
        const int r0 = wr * 64 + fr, cl = wc * 32 + 8 * fq;
        const float* bb = b_down + (size_t)u.z * D + 256 * u.pn + cl;
        f32x4 bv[2][2];
#pragma unroll
        for (int bj = 0; bj < 2; ++bj)
#pragma unroll
            for (int n = 0; n < 2; ++n) bv[bj][n] = *(const f32x4*)(bb + bj * 128 + 4 * n);
        float gts[2][4];
#pragma unroll
        for (int ai = 0; ai < 2; ++ai)
#pragma unroll
            for (int m = 0; m < 4; ++m) { const int r = r0 + ai * 128 + m * 16; gts[ai][m] = lgate[u.goff + (r < u.nvalid ? r : u.nvalid - 1)]; }
#pragma unroll
        for (int ai = 0; ai < 2; ++ai)
#pragma unroll
            for (int m = 0; m < 4; ++m) { const int r = r0 + ai * 128 + m * 16; const float gt = (r < u.nvalid) ? gts[ai][m] : 0.f;
                bf16* rowp = YS + (size_t)(u.pm * 256 + r) * D + 256 * u.pn + cl;
#pragma unroll
                for (int bj = 0; bj < 2; ++bj) { const f32x4 v0 = (acc[ai][bj][m][0] * (1.0f / WDN_SC) + bv[bj][0]) * gt, v1 = (acc[ai][bj][m][1] * (1.0f / WDN_SC) + bv[bj][1]) * gt;
                    u32x4 w; w.x = pg8::cvt_pk_bf16(v0[0], v0[1]); w.y = pg8::cvt_pk_bf16(v0[2], v0[3]); w.z = pg8::cvt_pk_bf16(v1[0], v1[1]); w.w = pg8::cvt_pk_bf16(v1[2], v1[3]);
                    *(u32x4*)(rowp + bj * 128) = w; } }
    }
};
__device__ __forceinline__ void moe_table(Frame& F, LAS int* tb) {
    if (F.tid < 32) { int c = (int)__hip_atomic_load(F.ctl + CW_ECNT + 64 * F.tid, RLX_AGENT); if (c > LCAP) c = LCAP; tb[64 + F.tid] = c; }
    LDS_WAIT(); __syncthreads();
    if (F.tid == 0) { int s = 0; for (int e = 0; e < NE; ++e) { tb[e] = s; s += (tb[64 + e] + 255) >> 8; } tb[32] = s; }
    LDS_WAIT(); __syncthreads();
}

__device__ __forceinline__ void conv_phase(Frame& F) {
    LAS unsigned* ut = (LAS unsigned*)(F.lds + RING_OFF);
    LAS float* co = (LAS float*)(F.lds + RING_OFF + 65536);
    const int cp = F.tid & 255, half = F.tid >> 8;
    float w0[CWID], w1[CWID];
    { const float* wd = F.in[I_W_DW] + 2 * cp;
#pragma unroll
        for (int j = 0; j < CWID; ++j) { const f32x2 w = *(const GAS f32x2*)(wd + j * CONV_CH); w0[j] = w.x; w1[j] = w.y; } }
    const f32x2 bd = *(const GAS f32x2*)(F.in[I_B_DW] + 2 * cp);
    const f32x4 g0 = *(const GAS f32x4*)(F.in[I_LN_CONV_G] + 8 * F.lane), g1 = *(const GAS f32x4*)(F.in[I_LN_CONV_G] + 8 * F.lane + 4);
    const f32x4 b0 = *(const GAS f32x4*)(F.in[I_LN_CONV_B] + 8 * F.lane), b1 = *(const GAS f32x4*)(F.in[I_LN_CONV_B] + 8 * F.lane + 4);
    bf16* MX = (bf16*)(F.ws + WS_MIXIN);
    for (int it = F.vcu; it < NB * (T_ / 32); it += F.G) {
        const int b = it / (T_ / 32), t0 = (it % (T_ / 32)) * 32;
        const bf16* U = (const bf16*)(F.ws + WS_U) + (size_t)b * T_ * CONV_CH;
        for (int idx = F.tid; idx < 62 * 64; idx += 512) { const int r = idx >> 6, c16 = idx & 63, t = t0 - 30 + r;
            u32x4 v = (u32x4){0u, 0u, 0u, 0u}; if (t >= 0) v = *(const GAS u32x4*)(U + (size_t)t * CONV_CH + c16 * 8);
            *(LAS u32x4*)(ut + r * 256 + c16 * 4) = v; }
        LDS_WAIT(); __syncthreads();
        { float a0[16], a1[16];
#pragma unroll
            for (int tt = 0; tt < 16; ++tt) { a0[tt] = bd.x; a1[tt] = bd.y; }
#pragma unroll
            for (int r = 0; r < 46; ++r) { const unsigned uu = ut[(half * 16 + r) * 256 + cp]; const float u0 = bflo(uu), u1 = bfhi(uu);
#pragma unroll
                for (int tt = 0; tt < 16; ++tt) { const int j = r - tt; if (j >= 0 && j < CWID) { a0[tt] += w0[j] * u0; a1[tt] += w1[j] * u1; } } }
#pragma unroll
            for (int tt = 0; tt < 16; ++tt) *(LAS f32x2*)(co + (half * 16 + tt) * CONV_CH + 2 * cp) = (f32x2){a0[tt], a1[tt]};
        }
        LDS_WAIT(); __syncthreads();
#pragma unroll
        for (int q = 0; q < 4; ++q) { const int tt = 4 * F.wave + q;
            f32x4 x0 = *(const LAS f32x4*)(co + tt * CONV_CH + 8 * F.lane), x1 = *(const LAS f32x4*)(co + tt * CONV_CH + 8 * F.lane + 4);
            const float mean = wave_sum((x0.x + x0.y) + (x0.z + x0.w) + (x1.x + x1.y) + (x1.z + x1.w)) * (1.f / CONV_CH);
            x0 = x0 - mean; x1 = x1 - mean;
            const float var = wave_sum((x0.x * x0.x + x0.y * x0.y) + (x0.z * x0.z + x0.w * x0.w) + (x1.x * x1.x + x1.y * x1.y) + (x1.z * x1.z + x1.w * x1.w)) * (1.f / CONV_CH);
            const float rstd = 1.f / sqrtf(var + LN_EPS);
            x0 = x0 * rstd * g0 + b0; x1 = x1 * rstd * g1 + b1;
            float y[8] = {x0.x, x0.y, x0.z, x0.w, x1.x, x1.y, x1.z, x1.w};
#pragma unroll
            for (int j = 0; j < 8; ++j) y[j] = y[j] * sigmoidf_fast(y[j]);
            *(GAS u32x4*)(MX + (size_t)(b * T_ + t0 + tt) * D + 8 * F.lane) = (u32x4){pk2(y[0], y[1]), pk2(y[2], y[3]), pk2(y[4], y[5]), pk2(y[6], y[7])}; }
        __syncthreads();
    }
}

typedef float f32x16 __attribute__((ext_vector_type(16)));
__device__ __forceinline__ int crow(int r, int hi) { return (r & 3) + 8 * (r >> 2) + 4 * hi; }
__device__ __forceinline__ bf16x8 pack8(const float* v) {
    u32x4 w; w.x = pg8::cvt_pk_bf16(v[0], v[1]); w.y = pg8::cvt_pk_bf16(v[2], v[3]); w.z = pg8::cvt_pk_bf16(v[4], v[5]); w.w = pg8::cvt_pk_bf16(v[6], v[7]);
    return __builtin_bit_cast(bf16x8, w); }
constexpr float SB_EXIT = 150.0f;
struct SbFrag { bf16x8 k[4]; u32x2 v[2][2][2]; };
__device__ __forceinline__ void sb_load(SbFrag& f, const bf16* Kl, const bf16* Vl, int kt) {
    const bf16* kp = Kl + (size_t)(32 * kt) * SBW;
#pragma unroll
    for (int s = 0; s < 4; ++s) f.k[s] = *(const GAS bf16x8*)(kp + 16 * s);
#pragma unroll
    for (int dt = 0; dt < 2; ++dt)
#pragma unroll
        for (int s = 0; s < 2; ++s) { const bf16* vp = Vl + (size_t)dt * 32 * M + 32 * kt + 16 * s; f.v[dt][s][0] = *(const GAS u32x2*)vp; f.v[dt][s][1] = *(const GAS u32x2*)(vp + 8); }
}
__device__ __forceinline__ void sb_attn_wave(Frame& F, int b, int h, int qt) {
    const int c = F.lane & 31, hi = F.lane >> 5;
    const bf16* Q = (const bf16*)(F.ws + WS_Q); const bf16* Kb = (const bf16*)(F.ws + WS_K); const bf16* VT = (const bf16*)(F.ws + WS_V);
    bf16x8 tri[2];
#pragma unroll
    for (int s = 0; s < 2; ++s) { bf16x8 t;
#pragma unroll
        for (int j = 0; j < 8; ++j) { const int k = 16 * s + 8 * (j >> 2) + 4 * hi + (j & 3); t[j] = (k >= c) ? (short)0xBF80 : (short)0; }
        tri[s] = t; }
    bf16x8 qf[4];
    { const bf16* qp = Q + ((size_t)b * T_ + 32 * qt + c) * SBW + h * SBD + 8 * hi;
#pragma unroll
        for (int s = 0; s < 4; ++s) qf[s] = *(const GAS bf16x8*)(qp + 16 * s); }
    const bf16* Kl = Kb + ((size_t)b * T_ + c) * SBW + h * SBD + 8 * hi;
    const bf16* Vl = VT + (size_t)(h * SBD + c) * M + (size_t)b * T_ + 4 * hi;
    f32x16 o0, o1;
#pragma unroll
    for (int r = 0; r < 16; ++r) { o0[r] = 0.f; o1[r] = 0.f; }
    float carry = 0.f;
    SbFrag fa, fb;
    sb_load(fa, Kl, Vl, qt);
#define SB_TILE(f, DIAG) do { \
        f32x16 p; _Pragma("unroll") for (int r = 0; r < 16; ++r) p[r] = 0.f; \
        _Pragma("unroll") for (int s = 0; s < 4; ++s) p = __builtin_amdgcn_mfma_f32_32x32x16_bf16(f.k[s], qf[s], p, 0, 0, 0); \
        float L[16]; \
        _Pragma("unroll") for (int r = 0; r < 16; ++r) { const float y = p[r]; float l = __builtin_amdgcn_logf(1.0f + __builtin_amdgcn_exp2f(fminf(y, 100.f))); l = fmaxf(l, y); \
            if (DIAG) l = (crow(r, hi) >= c) ? 0.f : l; L[r] = l; } \
        const bf16x8 l0 = pack8(L), l1 = pack8(L + 8); \
        f32x16 a; _Pragma("unroll") for (int r = 0; r < 16; ++r) a[r] = p[r] - carry; \
        a = __builtin_amdgcn_mfma_f32_32x32x16_bf16(tri[0], l0, a, 0, 0, 0); a = __builtin_amdgcn_mfma_f32_32x32x16_bf16(tri[1], l1, a, 0, 0, 0); \
        const float tot = p[0] - a[0];                                     \
        float w[16]; \
        _Pragma("unroll") for (int r = 0; r < 16; ++r) { float x = __builtin_amdgcn_exp2f(a[r]); if (DIAG) x = (crow(r, hi) >= c) ? 0.f : x; w[r] = x; } \
        const bf16x8 p0 = pack8(w), p1 = pack8(w + 8); \
        { const bf16x8 v00 = __builtin_bit_cast(bf16x8, (u32x4){f.v[0][0][0].x, f.v[0][0][0].y, f.v[0][0][1].x, f.v[0][0][1].y}); \
          const bf16x8 v01 = __builtin_bit_cast(bf16x8, (u32x4){f.v[0][1][0].x, f.v[0][1][0].y, f.v[0][1][1].x, f.v[0][1][1].y}); \
          const bf16x8 v10 = __builtin_bit_cast(bf16x8, (u32x4){f.v[1][0][0].x, f.v[1][0][0].y, f.v[1][0][1].x, f.v[1][0][1].y}); \
          const bf16x8 v11 = __builtin_bit_cast(bf16x8, (u32x4){f.v[1][1][0].x, f.v[1][1][0].y, f.v[1][1][1].x, f.v[1][1][1].y}); \
          o0 = __builtin_amdgcn_mfma_f32_32x32x16_bf16(v00, p0, o0, 0, 0, 0); o0 = __builtin_amdgcn_mfma_f32_32x32x16_bf16(v01, p1, o0, 0, 0, 0); \
          o1 = __builtin_amdgcn_mfma_f32_32x32x16_bf16(v10, p0, o1, 0, 0, 0); o1 = __builtin_amdgcn_mfma_f32_32x32x16_bf16(v11, p1, o1, 0, 0, 0); } \
        carry = __shfl(tot, c); } while (0)
    if (qt > 0) sb_load(fb, Kl, Vl, qt - 1);
    SB_TILE(fa, true);
    int kt = qt - 1;
    while (kt >= 0) {
        if (__all(carry >= SB_EXIT)) break;
        if (kt > 0) sb_load(fa, Kl, Vl, kt - 1);
        SB_TILE(fb, false);
        --kt; if (kt < 0) break;
        if (__all(carry >= SB_EXIT)) break;
        if (kt > 0) sb_load(fb, Kl, Vl, kt - 1);
        SB_TILE(fa, false);
        --kt;
    }
#undef SB_TILE
    bf16* op = (bf16*)(F.ws + WS_MIXIN) + ((size_t)b * T_ + 32 * qt + c) * D + CONV_CH + h * SBD + 4 * hi;
#pragma unroll
    for (int g = 0; g < 4; ++g) {
        *(GAS u32x2*)(op + 8 * g) = (u32x2){pg8::cvt_pk_bf16(o0[4 * g], o0[4 * g + 1]), pg8::cvt_pk_bf16(o0[4 * g + 2], o0[4 * g + 3])};
        *(GAS u32x2*)(op + 32 + 8 * g) = (u32x2){pg8::cvt_pk_bf16(o1[4 * g], o1[4 * g + 1]), pg8::cvt_pk_bf16(o1[4 * g + 2], o1[4 * g + 3])}; }
}

__device__ __forceinline__ void resid_row(f32x4 (&v)[4], const bf16* hrow, const bf16* mrow, int lane) {
    f32x4 a[4]; load_row_bf16(v, hrow, lane); load_row_bf16(a, mrow, lane);
#pragma unroll
    for (int j = 0; j < 4; ++j) v[j] = v[j] * DN_ALPHA + a[j];
}
__device__ __forceinline__ void ln_phase(Frame& F, const float* g, const float* b) {
    const int gw = F.vcu * NWAVES + F.wave, NGW = F.G * NWAVES;
    for (int m = gw; m < M; m += NGW) { f32x4 v[4]; bf16* hrow = (bf16*)(F.ws + WS_HB) + (size_t)m * D; resid_row(v, hrow, (const bf16*)(F.ws + WS_QM) + (size_t)m * D, F.lane);
        ln_row(v, g, b, F.lane); store_row_bf16(v, hrow, F.lane); }
}
__device__ __forceinline__ void softmax_phase(Frame& F) {
    const int gw = F.vcu * NWAVES + F.wave, NGW = F.G * NWAVES;
    for (int m = gw; m < M; m += NGW) { GAS u32x2* p = (GAS u32x2*)((bf16*)(F.ws + WS_SP) + (size_t)m * D) + F.lane;
#pragma unroll
        for (int j = 0; j < 4; ++j) { const u32x2 w = p[64 * j]; float x0 = bflo(w.x), x1 = bfhi(w.x), x2 = bflo(w.y), x3 = bfhi(w.y);
            const float mx = wave_max(fmaxf(fmaxf(x0, x1), fmaxf(x2, x3)));
            x0 = __builtin_amdgcn_exp2f(x0 - mx); x1 = __builtin_amdgcn_exp2f(x1 - mx); x2 = __builtin_amdgcn_exp2f(x2 - mx); x3 = __builtin_amdgcn_exp2f(x3 - mx);
            const float inv = 1.0f / wave_sum((x0 + x1) + (x2 + x3));
            p[64 * j] = (u32x2){pk2(x0 * inv, x1 * inv), pk2(x2 * inv, x3 * inv)}; } }
}
__device__ __forceinline__ void ln2_router_phase(Frame& F) {
    LAS float* wT = (LAS float*)(F.lds + RING_OFF);
    LAS int* lcnt = (LAS int*)(F.lds + XTRA_OFF);
    LAS int* rec = (LAS int*)(F.lds + XTRA_OFF + 512);
    const float* wr_ = F.in[I_W_ROUTER];
    for (int idx = F.tid; idx < D * NE; idx += 512) { const int c = idx >> 5, e = idx & 31; wT[e * D + c] = wr_[idx]; }
    if (F.tid < 64) lcnt[F.tid] = 0;
    LDS_WAIT(); __syncthreads();
    const int gw = F.vcu * NWAVES + F.wave, NGW = F.G * NWAVES;
    const float brt = F.lane < NE ? F.in[I_B_ROUTER][F.lane] : 0.f;
    int it = 0;
    for (int m = gw; m < M; m += NGW, ++it) {
        f32x4 v[4]; bf16* hrow = (bf16*)(F.ws + WS_HB) + (size_t)m * D; resid_row(v, hrow, (const bf16*)(F.ws + WS_QM) + (size_t)m * D, F.lane);
        ln_row(v, F.in[I_LN2_G], F.in[I_LN2_B], F.lane); store_row_bf16(v, hrow, F.lane);
        { GAS unsigned* h8 = (GAS unsigned*)(F.ws + WS_HB8 + (size_t)m * D) + F.lane;
#pragma unroll
            for (int j = 0; j < 4; ++j) h8[64 * j] = pk4_fp8(v[j].x, v[j].y, v[j].z, v[j].w); }
        float logit = -INFINITY;
        for (int e = 0; e < NE; ++e) { float p = 0.f;
#pragma unroll
            for (int j = 0; j < 4; ++j) { const f32x4 w = *(const LAS f32x4*)(wT + e * D + 256 * j + 4 * F.lane); p += (v[j].x * w.x + v[j].y * w.y) + (v[j].z * w.z + v[j].w * w.w); }
            p = wave_sum(p); if (F.lane == e) logit = p + brt; }
        float tv[TOPK]; int te[TOPK];
#pragma unroll
        for (int k = 0; k < TOPK; ++k) { const float mx = wave_max(logit); const unsigned long long bal = __ballot(logit == mx); const int e = __builtin_ctzll(bal);
            tv[k] = mx; te[k] = e; if (F.lane == e) logit = -INFINITY; }
        float pe[TOPK], ps = 0.f;
#pragma unroll
        for (int k = 0; k < TOPK; ++k) { pe[k] = __expf(tv[k] - tv[0]); ps += pe[k]; }
        if (F.lane < TOPK) { const int k = F.lane; const int e = k == 0 ? te[0] : k == 1 ? te[1] : k == 2 ? te[2] : te[3]; const float g = (k == 0 ? pe[0] : k == 1 ? pe[1] : k == 2 ? pe[2] : pe[3]) / ps;
            const int lr = __hip_atomic_fetch_add(lcnt + e, 1, __ATOMIC_RELAXED, __HIP_MEMORY_SCOPE_WORKGROUP);
            LAS int* r = rec + ((F.wave * 16 + (it & 15)) * 4 + k) * 4; r[0] = e; r[1] = lr; r[2] = __builtin_bit_cast(int, g); r[3] = m; }
    }
    LDS_WAIT(); __syncthreads();
    if (F.tid < NE) lcnt[32 + F.tid] = (int)__hip_atomic_fetch_add(F.ctl + CW_ECNT + 64 * F.tid, (unsigned)lcnt[F.tid], RLX_AGENT);
    LDS_WAIT(); __syncthreads();
    int* ltok = (int*)(F.ws + WS_LTOK); float* lgate = (float*)(F.ws + WS_LGATE); int* sidx = (int*)(F.ws + WS_SIDX);
    const int nrec = it * 4;
    for (int i = F.lane; i < nrec; i += 64) { const LAS int* r = rec + (F.wave * 64 + i) * 4; const int e = r[0], pos = lcnt[32 + e] + r[1], tok = r[3];
        if (pos < LCAP) { ltok[e * LCAP + pos] = tok; lgate[e * LCAP + pos] = __builtin_bit_cast(float, r[2]); } sidx[tok * 4 + (i & 3)] = e * LCAP + pos; }
    __syncthreads();
}
__device__ __forceinline__ void final_phase(Frame& F, const LAS int* tb) {
    const int gw = F.vcu * NWAVES + F.wave, NGW = F.G * NWAVES;
    const int* sidx = (const int*)(F.ws + WS_SIDX); const bf16* YS = (const bf16*)(F.ws + WS_YS);
    for (int m = gw; m < M; m += NGW) { f32x4 v[4]; load_row_bf16(v, (const bf16*)(F.ws + WS_HB) + (size_t)m * D, F.lane);
#pragma unroll
        for (int j = 0; j < 4; ++j) v[j] = v[j] * DN_ALPHA;
        f32x4 s[4];
#pragma unroll
        for (int j = 0; j < 4; ++j) s[j] = (f32x4){0.f, 0.f, 0.f, 0.f};
#pragma unroll
        for (int k = 0; k < TOPK; ++k) { const int si = sidx[m * 4 + k], e = si / LCAP, pos = si - e * LCAP; const size_t slot = (size_t)tb[e] * 256 + pos;
            const GAS u32x2* yp = (const GAS u32x2*)(YS + slot * D) + F.lane;
#pragma unroll
            for (int j = 0; j < 4; ++j) { const u32x2 w = yp[64 * j]; s[j] = s[j] + (f32x4){bflo(w.x), bfhi(w.x), bflo(w.y), bfhi(w.y)}; } }
#pragma unroll
        for (int j = 0; j < 4; ++j) v[j] = v[j] + s[j];
        ln_row(v, F.in[I_LN3_G], F.in[I_LN3_B], F.lane); store_row_f32(v, F.hf + (size_t)m * D, F.lane); }
}

struct Args { const float* in[N_IN]; float* out; unsigned char* ws; int ph_lo, ph_hi, li, pad; };
__global__ void __launch_bounds__(NWAVES * 64, 2) mk_fwd(Args args) {
    extern __shared__ __attribute__((aligned(16))) unsigned char lds[];
    Frame F;
    F.lds = (LAS unsigned char*)lds; F.MISC = (volatile LAS unsigned*)(F.lds + MISC_OFF);
    F.tid = threadIdx.x; F.lane = F.tid & 63; F.wave = __builtin_amdgcn_readfirstlane(F.tid >> 6);
    F.G = gridDim.x; { const int bx = blockIdx.x; F.vcu = (F.G % 8 == 0) ? (bx % 8) * (F.G / 8) + bx / 8 : bx; }
    F.ws = args.ws; F.ctl = (gu32*)(args.ws + WS_CTL); F.hf = args.out; F.in = args.in;
    for (int u = F.tid; u < (LDS_BYTES - LDSCTL_OFF) / 4; u += NWAVES * 64) ((LAS unsigned*)(F.lds + LDSCTL_OFF))[u] = 0u;
    __syncthreads();
    XcdBarrier bar; bar.bar = (unsigned*)(F.ctl + CW_BAR) + args.li * XCD_BAR_WORDS; bar.x = 0; bar.st = nullptr;
    const int lo = args.ph_lo, hi = args.ph_hi;
    if (hi - lo > 1) bar = xcd_barrier_post((unsigned*)(F.ctl + CW_BAR) + args.li * XCD_BAR_WORDS, F.MISC + 8);
#ifndef PH_MASK
#define PH_MASK 0x3fff
#endif
#define IN(k) (((PH_MASK >> (k)) & 1) && lo <= (k) && (k) < hi)
#ifndef REP_MASK
#define REP_MASK 0
#endif
#define REPS(k) (1 + ((REP_MASK >> (k)) & 1))
#define SEAM(k) do { if (IN(k) && IN((k) + 1)) xcd_barrier(bar); } while (0)
    const char* wsb = (const char*)args.ws;
    LAS int* tb = (LAS int*)(F.lds + XTRA_OFF + 9216);

    if (IN(0)) for (int rep = 0; rep < REPS(0); ++rep) { p0_prologue(F); __syncthreads(); } SEAM(0);
    if (IN(1)) for (int rep = 0; rep < REPS(1); ++rep) { SchedP1 S{F.G, (int)blockIdx.x}; EpiP1 E{F.ws, F.in[I_B_IN]};
        pg8::gemm_phase<EpiP1, SchedP1, false>(F.lds + RING_OFF, wsb, D, D, D, S, E, nullptr); } SEAM(1);
    if (IN(2)) for (int rep = 0; rep < REPS(2); ++rep) {
        conv_phase(F);
        const int gw = F.vcu * NWAVES + F.wave;
        for (int tk = gw; tk < NB * SBH * (T_ / 32); tk += F.G * NWAVES) sb_attn_wave(F, (tk >> 7) >> 3, (tk >> 7) & 7, tk & 127);
    } SEAM(2);
    if (IN(3)) { SchedPlain S{F.G, (int)blockIdx.x, 128, 4, (unsigned)WS_MIXIN, (unsigned)WS_WOUT_T, TSTEP, TSTEP, 0u, 0u, 0u}; EpiBf16 E{(bf16*)(F.ws + WS_QM), D, 1.0f, F.in[I_B_OUT]};
        pg8::gemm_phase<EpiBf16, SchedPlain, false>(F.lds + RING_OFF, wsb, D, D, D, S, E, nullptr); } SEAM(3);
    if (IN(4)) { ln_phase(F, F.in[I_LN1_G], F.in[I_LN1_B]); } SEAM(4);
    if (IN(5)) { SchedPlain S{F.G, (int)blockIdx.x, 128, 4, (unsigned)WS_HB, (unsigned)WS_WQ_T, TSTEP, TSTEP, 0u, 0u, 0u}; EpiBf16 E{(bf16*)(F.ws + WS_QM), D, MEM_QSCALE, nullptr};
        pg8::gemm_phase<EpiBf16, SchedPlain, false>(F.lds + RING_OFF, wsb, D, D, D, S, E, nullptr); } SEAM(5);
    if (IN(6)) {
        SchedPlain S{F.G, (int)blockIdx.x, 128, 4, (unsigned)WS_QM, (unsigned)WS_KM, TSTEP, 0u, 512u, 512u, TSTEP}; EpiBf16 E{(bf16*)(F.ws + WS_SP), D, 1.0f, nullptr};
        pg8::gemm_phase<EpiBf16, SchedPlain, false>(F.lds + RING_OFF, wsb, D, D, 256, S, E, nullptr); } SEAM(6);
    if (IN(7)) { softmax_phase(F); } SEAM(7);
    if (IN(8)) {
        SchedPlain S{F.G, (int)blockIdx.x, 128, 4, (unsigned)WS_SP, (unsigned)WS_VMT, TSTEP, 256u * 2048u * 2u, 512u, 0u, 512u}; EpiBf16 E{(bf16*)(F.ws + WS_OB), D, 1.0f, nullptr};
        pg8::gemm_phase<EpiBf16, SchedPlain, false>(F.lds + RING_OFF, wsb, D, 2048, 256, S, E, nullptr); } SEAM(8);
    if (IN(9)) { SchedPlain S{F.G, (int)blockIdx.x, 128, 4, (unsigned)WS_OB, (unsigned)WS_WO_T, TSTEP, TSTEP, 0u, 0u, 0u}; EpiBf16 E{(bf16*)(F.ws + WS_QM), D, 1.0f, nullptr};
        pg8::gemm_phase<EpiBf16, SchedPlain, false>(F.lds + RING_OFF, wsb, D, D, D, S, E, nullptr); } SEAM(9);
    if (IN(10)) { ln2_router_phase(F); } SEAM(10);
    if (IN(11)) for (int rep = 0; rep < REPS(11); ++rep) { moe_table(F, tb); SchedMoe S{F.G, (int)blockIdx.x, 8, tb, (unsigned)WS_HB8, (unsigned)WS_WGU_T, 2048u * 1024u, true}; EpiAct E{F.ws + WS_ACT, F.in[I_B_GU]};
        pg8::gemm_phase<EpiAct, SchedMoe, true, true>(F.lds + RING_OFF, wsb, D / 2, D / 2, D / 2, S, E, (const int*)(F.ws + WS_LTOK)); } SEAM(11);
    if (IN(12)) for (int rep = 0; rep < REPS(12); ++rep) { moe_table(F, tb); SchedMoe S{F.G, (int)blockIdx.x, 4, tb, (unsigned)WS_ACT, (unsigned)WS_WDN_T, 1024u * 1024u, false}; EpiDown E{(bf16*)(F.ws + WS_YS), F.in[I_B_DOWN], (const float*)(F.ws + WS_LGATE)};
        pg8::gemm_phase<EpiDown, SchedMoe, false, true>(F.lds + RING_OFF, wsb, D / 2, D / 2, D / 2, S, E, nullptr); } SEAM(12);
    if (IN(13)) { moe_table(F, tb); final_phase(F, tb); }
#undef IN
#undef SEAM
}

extern "C" void kernel_launch(void* const* d_in, const int* in_sizes, int n_in, void* d_out, int out_size, void* d_ws, size_t ws_size, hipStream_t stream) {
    static int grid = 0;
    if (grid == 0) {
        if (n_in != N_IN || out_size != M * D || ws_size < WS_END) { fprintf(stderr, "kernel_launch: unexpected shapes (n_in %d, out %d, ws %zu)\n", n_in, out_size, ws_size); grid = -1; return; }
        int dev = 0, cus = 0, per_cu = 0;
        if (hipGetDevice(&dev) != hipSuccess || hipDeviceGetAttribute(&cus, hipDeviceAttributeMultiprocessorCount, dev) != hipSuccess) { grid = -1; return; }
        if (hipFuncSetAttribute((const void*)mk_fwd, hipFuncAttributeMaxDynamicSharedMemorySize, LDS_BYTES) != hipSuccess) { fprintf(stderr, "kernel_launch: hipFuncSetAttribute failed\n"); grid = -1; return; }
        if (hipOccupancyMaxActiveBlocksPerMultiprocessor(&per_cu, (const void*)mk_fwd, NWAVES * 64, LDS_BYTES) != hipSuccess || per_cu < 1) fprintf(stderr, "kernel_launch: occupancy query says %d\n", per_cu);
        (void)hipGetLastError();
        grid = cus;
    }
    if (grid < 0) return;
    if (hipMemsetAsync((char*)d_ws + WS_CTL, 0, CTL_ZERO_BYTES, stream) != hipSuccess) return;
    Args a{};
    for (int i = 0; i < N_IN; ++i) a.in[i] = (const float*)d_in[i];
    a.out = (float*)d_out; a.ws = (unsigned char*)d_ws;
    for (int li = 0; li < MK_N_LAUNCHES; ++li) {
        a.ph_lo = (MK_N_LAUNCHES == 1) ? 0 : li; a.ph_hi = (MK_N_LAUNCHES == 1) ? NPHASE : li + 1; a.li = (MK_N_LAUNCHES == 1) ? 0 : li;
        hipLaunchKernelGGL(mk_fwd, dim3(grid), dim3(NWAVES * 64), LDS_BYTES, stream, a);
        if (hipPeekAtLastError() != hipSuccess) { fprintf(stderr, "kernel_launch: launch %d failed\n", li); break; }
    }
}
```

```cpp
#include <hip/hip_runtime.h>
#include <cstdio>
#include <cstdint>

#ifndef MK_N_LAUNCHES
#define MK_N_LAUNCHES 1
#endif

#define GAS __attribute__((address_space(1)))
#define LAS __attribute__((address_space(3)))
typedef unsigned short bf16;
typedef short bf16x8 __attribute__((ext_vector_type(8)));
typedef float f32x4 __attribute__((ext_vector_type(4)));
typedef float f32x2 __attribute__((ext_vector_type(2)));
typedef unsigned u32x4 __attribute__((ext_vector_type(4)));
typedef unsigned u32x2 __attribute__((ext_vector_type(2)));
typedef GAS unsigned gu32;
#define RLX_AGENT __ATOMIC_RELAXED, __HIP_MEMORY_SCOPE_AGENT
#define LDS_WAIT() asm volatile("s_waitcnt lgkmcnt(0)" ::: "memory")
#define VM_WAIT() asm volatile("s_waitcnt vmcnt(0)" ::: "memory")

constexpr int NB = 8, T_ = 4096, D = 1024, M = NB * T_, NMEM = 256, MM = NB * NMEM;
constexpr int CONV_CH = 512, SBH = 8, SBD = 64, SBW = 512, CWID = 31, NE = 32, TOPK = 4, DFF = 1024;
constexpr int INC = 2560;
constexpr float LN_EPS = 1e-5f;
constexpr float DN_ALPHA = 1.189207115002721f;
constexpr float LOG2E = 1.4426950408889634f;
constexpr float SB_QSCALE = 0.125f * LOG2E;
constexpr float MEM_QSCALE = 0.0625f * LOG2E;
constexpr float WGU_SC = 32.0f, WDN_SC = 64.0f;
constexpr int NBLK_MAX = M * TOPK / 256 + NE;
constexpr int LCAP = M;

constexpr size_t MiB = 1u << 20;
constexpr size_t WS_CTL = 0, CTL_ZERO_BYTES = 1 * MiB;
constexpr size_t WS_WIN_T = 1 * MiB;
constexpr size_t WS_WOUT_T = 6 * MiB;
constexpr size_t WS_WQ_T = 8 * MiB, WS_WK_T = 10 * MiB, WS_WV_T = 12 * MiB, WS_WO_T = 14 * MiB;
constexpr size_t WS_WGU_T = 16 * MiB;
constexpr size_t WS_WDN_T = 144 * MiB;
constexpr size_t WS_HB8 = 176 * MiB;
constexpr size_t WS_HB = 208 * MiB;
constexpr size_t WS_LTOK = 272 * MiB;
constexpr size_t WS_LGATE = 276 * MiB;
constexpr size_t WS_SIDX = 280 * MiB;
constexpr size_t WS_X = 288 * MiB;
constexpr size_t WS_U = WS_X;
constexpr size_t WS_Q = WS_X + 32 * MiB;
constexpr size_t WS_K = WS_X + 64 * MiB;
constexpr size_t WS_V = WS_X + 96 * MiB;
constexpr size_t WS_MIXIN = WS_X + 128 * MiB;
constexpr size_t WS_QM = WS_X + 192 * MiB;
constexpr size_t WS_SP = WS_X + 256 * MiB;
constexpr size_t WS_OB = WS_X + 320 * MiB;
constexpr size_t WS_MEMN = WS_X + 384 * MiB;
constexpr size_t WS_KM = WS_X + 388 * MiB;
constexpr size_t WS_VMT = WS_X + 392 * MiB;
constexpr size_t WS_ACT = WS_X;
constexpr size_t WS_YS = WS_X + 272 * MiB;
constexpr size_t WS_END = WS_X + 544 * MiB;
constexpr int CW_TMO = 0, CW_CODE = 1;
constexpr int CW_BAR = 4096;
constexpr int CW_ECNT = 131072;
constexpr int NPHASE = 14;

constexpr int RING_OFF = 0, RING_BYTES = 131072;
constexpr int LDSCTL_OFF = RING_BYTES, MISC_OFF = LDSCTL_OFF + 320;
constexpr int XTRA_OFF = LDSCTL_OFF + 1024;
constexpr int LDS_BYTES = 147456;
constexpr int NWAVES = 8;

__device__ __forceinline__ unsigned f2bf(float f) { unsigned u = __builtin_bit_cast(unsigned, f); return (u + 0x7fffu + ((u >> 16) & 1u)) >> 16; }
__device__ __forceinline__ unsigned pk2(float lo, float hi) { return f2bf(lo) | (f2bf(hi) << 16); }
__device__ __forceinline__ float bflo(unsigned u) { return __builtin_bit_cast(float, u << 16); }
__device__ __forceinline__ float bfhi(unsigned u) { return __builtin_bit_cast(float, u & 0xffff0000u); }
__device__ __forceinline__ float wave_sum(float v) {
#pragma unroll
    for (int o = 1; o < 64; o <<= 1) v += __shfl_xor(v, o);
    return v;
}
__device__ __forceinline__ float wave_max(float v) {
#pragma unroll
    for (int o = 1; o < 64; o <<= 1) v = fmaxf(v, __shfl_xor(v, o));
    return v;
}
__device__ __forceinline__ unsigned pk4_fp8(float a, float b, float c, float d) {
    int r = __builtin_amdgcn_cvt_pk_fp8_f32(a, b, 0, false); r = __builtin_amdgcn_cvt_pk_fp8_f32(c, d, r, true); return (unsigned)r; }
__device__ __forceinline__ float sigmoidf_fast(float x) { return __builtin_amdgcn_rcpf(1.0f + __expf(-x)); }

namespace pg8 {
constexpr int BM = 256, BK = 64, HALF = 128, HTB = HALF * BK * 2, STAGE_BYTES = 8 * HTB, NXCD = 8, WGM = 8;
__host__ __device__ __forceinline__ int lds_byte(int r, int c) { const int st = (r >> 4) * 2 + (c >> 5), rr = r & 15, cc = c & 31, ob = rr * 64 + cc * 2; return st * 1024 + (ob ^ (((ob >> 9) & 1) << 5)); }
__host__ __device__ __forceinline__ void stage_rc(int b, int& R, int& C) { const int st = b / 1024, sb = b % 1024, swz = sb ^ (((sb >> 9) & 1) << 5); R = (st >> 1) * 16 + swz / 64; C = (st & 1) * 32 + (swz % 64) / 2; }
__host__ __device__ __forceinline__ int perm32(int rho) { const int n = rho >> 4, i = rho & 15; return 8 * (i >> 2) + 4 * n + (i & 3); }

struct Unit { int pm, pn, z, nvalid; unsigned aoff, boff, goff; };

__device__ __forceinline__ void tile_order(int L, int nM, int nN, int& pm, int& pn) {
    const int nwg = nM * nN; int wgid = L;
    { const int q = nwg / NXCD, r = nwg % NXCD, xcd = wgid % NXCD, off = wgid / NXCD; wgid = (xcd < r ? xcd * (q + 1) : r * (q + 1) + (xcd - r) * q) + off; }
    const int nig = WGM * nN, gid = wgid / nig, fm = gid * WGM, gsz = (nM - fm) < WGM ? (nM - fm) : WGM;
    pm = fm + ((wgid % nig) % gsz); pn = (wgid % nig) / gsz;
}
__device__ __forceinline__ unsigned cvt_pk_bf16(float lo, float hi) { unsigned r; asm volatile("v_cvt_pk_bf16_f32 %0, %1, %2" : "=v"(r) : "v"(lo), "v"(hi)); return r; }

__device__ __forceinline__ void store_tile_bf16(const f32x4 (&acc)[2][2][4][2], bf16* p0, size_t ldc, const float* bias, float scale, int wc, int fq) {
    const int cl = wc * 32 + 8 * fq;
    f32x4 bv[2][2];
#pragma unroll
    for (int bj = 0; bj < 2; ++bj)
#pragma unroll
        for (int n = 0; n < 2; ++n) bv[bj][n] = bias ? *(const f32x4*)(bias + cl + bj * HALF + 4 * n) : (f32x4){0.f, 0.f, 0.f, 0.f};
#pragma unroll
    for (int ai = 0; ai < 2; ++ai)
#pragma unroll
        for (int m = 0; m < 4; ++m) { bf16* rowp = p0 + (size_t)(ai * HALF + m * 16) * ldc + cl;
#pragma unroll
            for (int bj = 0; bj < 2; ++bj) { const f32x4 v0 = (acc[ai][bj][m][0] + bv[bj][0]) * scale, v1 = (acc[ai][bj][m][1] + bv[bj][1]) * scale;
                u32x4 w; w.x = cvt_pk_bf16(v0[0], v0[1]); w.y = cvt_pk_bf16(v0[2], v0[3]); w.z = cvt_pk_bf16(v1[0], v1[1]); w.w = cvt_pk_bf16(v1[2], v1[3]);
                *(u32x4*)(rowp + bj * HALF) = w; } }
}

typedef int v8i __attribute__((ext_vector_type(8)));
template <class Epi, class Sched, bool GATHER, bool FP8 = false>
__device__ __forceinline__ void gemm_phase(LAS unsigned char* lds, const char* wsb, const int lda, const int ldb, const int K, const Sched& S, const Epi& E, const int* glist) {
    const int tid = threadIdx.x, wid = __builtin_amdgcn_readfirstlane(tid >> 6), lane = tid & 63, wr = wid >> 2, wc = wid & 3, fr = lane & 15, fq = lane >> 4;
    const int nt = K / BK;
    unsigned voffA[2], voffB[2]; int Rr[2], Cc[2];
#pragma unroll
    for (int i = 0; i < 2; ++i) { int R, C; stage_rc(tid * 16 + i * 8192, R, C); const int Rb = Epi::PERM ? ((R & ~31) + perm32(R & 31)) : R;
        voffA[i] = (unsigned)(R * lda + C) * 2u; voffB[i] = (unsigned)(Rb * ldb + C) * 2u; Rr[i] = R; Cc[i] = C; }
    const size_t kstep = (size_t)(BK * 2);
    const size_t hstepA = (size_t)HALF * lda * 2, hstepB = (size_t)HALF * ldb * 2;
    const unsigned ldsw = (unsigned)wid * 1024u;
    const int aoff = lds_byte(wr * 64 + fr, fq * 8), boff = lds_byte(wc * 32 + fr, fq * 8);
    unsigned gc[2][2], gn[2][2];
#define PG8_SA(b, h) (((b) * 2 + (h)) * HTB)
#define PG8_SB(b, h) ((4 + (b) * 2 + (h)) * HTB)
#define PG8_STAGE_B(bufoff, gbase) do { _Pragma("unroll") for (int _i = 0; _i < 2; ++_i) \
        __builtin_amdgcn_global_load_lds((const unsigned*)((const char*)(gbase) + voffB[_i]), (LAS unsigned*)(lds + (bufoff) + ldsw + _i * 8192), 16, 0, 0); } while (0)
#define PG8_STAGE_A(bufoff, gbase, h, nx) do { _Pragma("unroll") for (int _i = 0; _i < 2; ++_i) { \
        const char* _p = GATHER ? (const char*)(gbase) + ((nx) ? gn[h][_i] : gc[h][_i]) : (const char*)(gbase) + (h) * hstepA + voffA[_i]; \
        __builtin_amdgcn_global_load_lds((const unsigned*)_p, (LAS unsigned*)(lds + (bufoff) + ldsw + _i * 8192), 16, 0, 0); } } while (0)
#define PG8_LDA(dst, b, h) do { _Pragma("unroll") for (int m = 0; m < 4; ++m) { if constexpr (FP8) { const u32x4 _lo = *(const LAS u32x4*)(lds + PG8_SA(b, h) + aoff + m * 2048), _hi = *(const LAS u32x4*)(lds + PG8_SA(b, h) + aoff + m * 2048 + 1024); \
            dst##8[m] = (v8i){(int)_lo.x, (int)_lo.y, (int)_lo.z, (int)_lo.w, (int)_hi.x, (int)_hi.y, (int)_hi.z, (int)_hi.w}; } \
        else { _Pragma("unroll") for (int k = 0; k < 2; ++k) dst[m][k] = *(const LAS bf16x8*)(lds + PG8_SA(b, h) + aoff + m * 2048 + k * 1024); } } } while (0)
#define PG8_LDB(dst, b, h) do { _Pragma("unroll") for (int n = 0; n < 2; ++n) { if constexpr (FP8) { const u32x4 _lo = *(const LAS u32x4*)(lds + PG8_SB(b, h) + boff + n * 2048), _hi = *(const LAS u32x4*)(lds + PG8_SB(b, h) + boff + n * 2048 + 1024); \
            dst##8[n] = (v8i){(int)_lo.x, (int)_lo.y, (int)_lo.z, (int)_lo.w, (int)_hi.x, (int)_hi.y, (int)_hi.z, (int)_hi.w}; } \
        else { _Pragma("unroll") for (int k = 0; k < 2; ++k) dst[n][k] = *(const LAS bf16x8*)(lds + PG8_SB(b, h) + boff + n * 2048 + k * 1024); } } } while (0)
#define PG8_MMA(ai, bj, At, Bt) do { __builtin_amdgcn_s_setprio(1); if constexpr (FP8) asm volatile("s_nop 1"); _Pragma("unroll") for (int m = 0; m < 4; ++m) _Pragma("unroll") for (int n = 0; n < 2; ++n) { \
        if constexpr (FP8) asm volatile("v_mfma_f32_16x16x128_f8f6f4 %0, %1, %2, %0" : "+v"(acc[ai][bj][m][n]) : "v"(Bt##8[n]), "v"(At##8[m])); \
        else { _Pragma("unroll") for (int k = 0; k < 2; ++k) acc[ai][bj][m][n] = __builtin_amdgcn_mfma_f32_16x16x32_bf16(Bt[n][k], At[m][k], acc[ai][bj][m][n], 0, 0, 0); } } \
        __builtin_amdgcn_s_setprio(0); } while (0)
#define PG8_WAIT_V(n) asm volatile("s_waitcnt vmcnt(" #n ")" ::: "memory")
#define PG8_WAIT_L(n) asm volatile("s_waitcnt lgkmcnt(" #n ")" ::: "memory")
#define PG8_BAR __builtin_amdgcn_s_barrier()
#define PG8_SCHED __builtin_amdgcn_sched_barrier(0)
#define PG8_GIDX(g, u) do { _Pragma("unroll") for (int _h = 0; _h < 2; ++_h) _Pragma("unroll") for (int _i = 0; _i < 2; ++_i) { const int _r = _h * HALF + Rr[_i]; \
        const int _tok = glist[(u).goff + (_r < (u).nvalid ? _r : (u).nvalid - 1)]; g[_h][_i] = (unsigned)_tok * (unsigned)(lda * 2) + (unsigned)(Cc[_i] * 2); } } while (0)
    Unit cur, nxt, nn; int ui = 0;
    if (!S.next(0, cur)) return;
    f32x4 acc[2][2][4][2];
#pragma unroll
    for (int a = 0; a < 2; ++a)
#pragma unroll
        for (int b = 0; b < 2; ++b)
#pragma unroll
            for (int m = 0; m < 4; ++m)
#pragma unroll
                for (int n = 0; n < 2; ++n) acc[a][b][m][n] = (f32x4){0.f, 0.f, 0.f, 0.f};
    bf16x8 At[4][2], B0[2][2], B1[2][2];
    v8i At8[4], B08[2], B18[2];
    const char* cA = wsb + cur.aoff; const char* cB = wsb + cur.boff;
    if constexpr (GATHER) { PG8_GIDX(gc, cur); if (S.next(1, nxt)) { PG8_GIDX(gn, nxt); } else { PG8_GIDX(gn, cur); }
        asm volatile("s_waitcnt vmcnt(0)" : "+v"(gc[0][0]), "+v"(gc[0][1]), "+v"(gc[1][0]), "+v"(gc[1][1]), "+v"(gn[0][0]), "+v"(gn[0][1]), "+v"(gn[1][0]), "+v"(gn[1][1]) :: "memory"); }
    else {
#pragma unroll
        for (int h = 0; h < 2; ++h)
#pragma unroll
            for (int i = 0; i < 2; ++i) { gc[h][i] = 0u; gn[h][i] = 0u; } }
    PG8_STAGE_B(PG8_SB(0, 0), cB); PG8_STAGE_B(PG8_SB(0, 1), cB + hstepB); PG8_STAGE_A(PG8_SA(0, 0), cA, 0, false); PG8_STAGE_A(PG8_SA(0, 1), cA, 1, false);
    if (wr == 1) PG8_BAR;
    PG8_WAIT_V(2); PG8_BAR;
    PG8_STAGE_B(PG8_SB(1, 0), cB + kstep); PG8_STAGE_A(PG8_SA(1, 0), cA + kstep, 0, false); PG8_STAGE_B(PG8_SB(1, 1), cB + hstepB + kstep);
    PG8_WAIT_V(6); PG8_BAR;
    for (;;) {
        const bool has_next = S.next(ui + 1, nxt);
        const char* nA = has_next ? wsb + nxt.aoff : cA; const char* nB = has_next ? wsb + nxt.boff : cB;
#pragma clang loop unroll(disable)
        for (int t = 0; t < nt; t += 2) {
            const bool last = (t == nt - 2);
            const char* a1 = cA + (size_t)(t + 1) * kstep;
            const char* a2 = last ? nA : cA + (size_t)(t + 2) * kstep; const char* b2 = last ? nB : cB + (size_t)(t + 2) * kstep;
            const char* a3 = a2 + kstep; const char* b3 = b2 + kstep;
            PG8_LDB(B0, 0, 0); PG8_LDB(B1, 0, 1); PG8_SCHED; PG8_LDA(At, 0, 0); PG8_STAGE_A(PG8_SA(1, 1), a1, 1, false);
            PG8_WAIT_V(8); PG8_WAIT_L(0); PG8_BAR; PG8_MMA(0, 0, At, B0); PG8_MMA(0, 1, At, B1); PG8_BAR; PG8_SCHED;
            PG8_LDA(At, 0, 1); PG8_STAGE_B(PG8_SB(0, 0), b2); PG8_STAGE_B(PG8_SB(0, 1), b2 + hstepB); PG8_STAGE_A(PG8_SA(0, 0), a2, 0, last);
            PG8_WAIT_V(8); PG8_WAIT_L(0); PG8_BAR; PG8_MMA(1, 0, At, B0); PG8_MMA(1, 1, At, B1); PG8_BAR; PG8_SCHED;
            PG8_LDB(B0, 1, 0); PG8_LDB(B1, 1, 1); PG8_SCHED; PG8_LDA(At, 1, 0); PG8_STAGE_A(PG8_SA(0, 1), a2, 1, last);
            PG8_WAIT_V(8); PG8_WAIT_L(0); PG8_BAR; PG8_MMA(0, 0, At, B0); PG8_MMA(0, 1, At, B1); PG8_BAR; PG8_SCHED;
            PG8_LDA(At, 1, 1); PG8_STAGE_B(PG8_SB(1, 0), b3); PG8_STAGE_B(PG8_SB(1, 1), b3 + hstepB); PG8_STAGE_A(PG8_SA(1, 0), a3, 0, last);
            PG8_WAIT_V(8); PG8_WAIT_L(0); PG8_BAR; PG8_MMA(1, 0, At, B0); PG8_MMA(1, 1, At, B1); PG8_BAR; PG8_SCHED;
        }
        if constexpr (FP8) asm volatile("s_nop 15\n\ts_nop 7");
        if (wr == 0) PG8_BAR;
        if constexpr (GATHER) {
#pragma unroll
            for (int h = 0; h < 2; ++h)
#pragma unroll
                for (int i = 0; i < 2; ++i) gc[h][i] = gn[h][i];
            if (has_next && S.next(ui + 2, nn)) { PG8_GIDX(gn, nn); }
        }
        E(acc, cur, wr, wc, fr, fq);
        if constexpr (GATHER) asm volatile("" : "+v"(gn[0][0]), "+v"(gn[0][1]), "+v"(gn[1][0]), "+v"(gn[1][1]));
        if (!has_next) break;
#pragma unroll
        for (int a = 0; a < 2; ++a)
#pragma unroll
            for (int b = 0; b < 2; ++b)
#pragma unroll
                for (int m = 0; m < 4; ++m)
#pragma unroll
                    for (int n = 0; n < 2; ++n) acc[a][b][m][n] = (f32x4){0.f, 0.f, 0.f, 0.f};
        cur = nxt; cA = nA; cB = nB; ++ui;
        if (wr == 1) PG8_BAR;
    }
    PG8_WAIT_V(0);
    PG8_BAR;
#undef PG8_SA
#undef PG8_SB
#undef PG8_STAGE_A
#undef PG8_STAGE_B
#undef PG8_LDA
#undef PG8_LDB
#undef PG8_MMA
#undef PG8_WAIT_V
#undef PG8_WAIT_L
#undef PG8_BAR
#undef PG8_SCHED
#undef PG8_GIDX
}
}
using pg8::Unit;

#define XB_TMO      128
#define XB_XCNT(j)  (256  + 64 * (j))
#define XB_XSUB(j)  (1280 + 64 * (j))
#define XB_XGEN(j)  (2304 + 64 * (j))
#define XB_TOP      3328
#define XB_TOPGEN   3392
#define XCD_BAR_WORDS 3456
#define XB_SPIN_CAP (1u << 18)
__device__ __forceinline__ unsigned xb_ld(unsigned* p)              { return __hip_atomic_load(p, __ATOMIC_RELAXED, __HIP_MEMORY_SCOPE_AGENT); }
__device__ __forceinline__ unsigned xb_add(unsigned* p, unsigned v) { return __hip_atomic_fetch_add(p, v, __ATOMIC_RELAXED, __HIP_MEMORY_SCOPE_AGENT); }
__device__ __forceinline__ unsigned xb_xcc_id() { return (unsigned)__builtin_amdgcn_s_getreg((3 << 11) | 20) & 0xFu; }
#define XB_SPIN(cond, bar) do { unsigned _sp = 0; while (cond) { __builtin_amdgcn_s_sleep(1); \
    if ((++_sp & 255u) == 0u) { if (xb_ld(&(bar)[XB_TMO])) break; if (_sp > XB_SPIN_CAP) { atomicAdd(&(bar)[XB_TMO], 1u); break; } } } } while (0)
struct XcdBarrier { unsigned* bar; unsigned x; volatile LAS unsigned* st; };
__device__ __forceinline__ XcdBarrier xcd_barrier_post(unsigned* bar, volatile LAS unsigned* st) {
    XcdBarrier b; b.bar = bar; b.x = xb_xcc_id(); b.st = st;
    if (threadIdx.x == 0) (void)xb_add(&bar[XB_XCNT(b.x)], 1u);
    return b;
}
__device__ __forceinline__ void xcd_barrier_complete(unsigned* bar, unsigned x, unsigned& nloc, unsigned& nx) {
    const unsigned G = gridDim.x * gridDim.y * gridDim.z;
    unsigned sum, cnt, mine, sp = 0u;
    for (;;) {
        sum = 0u; cnt = 0u; mine = 0u;
#pragma unroll
        for (unsigned j = 0; j < 16; ++j) { const unsigned c = xb_ld(&bar[XB_XCNT(j)]); sum += c; cnt += (c > 0u) ? 1u : 0u; mine = (j == x) ? c : mine; }
        if (sum == G) break;
        __builtin_amdgcn_s_sleep(1);
        if ((++sp & 255u) == 0u) { if (xb_ld(&bar[XB_TMO])) break; if (sp > XB_SPIN_CAP) { atomicAdd(&bar[XB_TMO], 1u); break; } }
    }
    nloc = mine > 0u ? mine : 1u; nx = cnt > 0u ? cnt : 1u;
}
__device__ __forceinline__ void xcd_barrier(const XcdBarrier& b) {
    asm volatile("s_waitcnt vmcnt(0)" ::: "memory");
    __syncthreads();
    if (threadIdx.x == 0) {
        unsigned* bar = b.bar;
        __builtin_amdgcn_s_waitcnt(0);
        unsigned nloc = b.st[0], nx = b.st[1];
        if (nloc == 0u) { xcd_barrier_complete(bar, b.x, nloc, nx); b.st[0] = nloc; b.st[1] = nx; }
        const unsigned old = xb_add(&bar[XB_XSUB(b.x)], 1u);
        const unsigned gen = old / nloc;
        if (old + 1u == (gen + 1u) * nloc) {
            __builtin_amdgcn_fence(__ATOMIC_RELEASE, "agent");
            asm volatile("s_waitcnt vmcnt(0)" ::: "memory");
            const unsigned og = xb_add(&bar[XB_TOP], 1u);
            const unsigned tg = og / nx;
            if (og + 1u == (tg + 1u) * nx) xb_add(&bar[XB_TOPGEN], 1u);
            else XB_SPIN(xb_ld(&bar[XB_TOPGEN]) == tg, bar);
            __builtin_amdgcn_fence(__ATOMIC_ACQUIRE, "agent");
            xb_add(&bar[XB_XGEN(b.x)], 1u);
            asm volatile("s_waitcnt vmcnt(0)" ::: "memory");
        } else {
            XB_SPIN(xb_ld(&bar[XB_XGEN(b.x)]) == gen, bar);
            __builtin_amdgcn_fence(__ATOMIC_ACQUIRE, "agent");
            asm volatile("s_waitcnt vmcnt(0)" ::: "memory");
        }
    }
    __syncthreads();
}

struct Frame {
    LAS unsigned char* lds;
    volatile LAS unsigned* MISC;
    gu32* ctl;
    unsigned char* ws;
    int tid, lane, wave, vcu, G;
    float* hf;
    const float* const* in;
};
enum In { I_X = 0, I_MEM, I_LN_IN_G, I_LN_IN_B, I_LN_MEM_G, I_LN_MEM_B, I_W_IN, I_B_IN, I_W_DW, I_B_DW, I_LN_CONV_G, I_LN_CONV_B, I_W_OUT, I_B_OUT, I_LN1_G, I_LN1_B,
          I_WQ, I_WK, I_WV, I_WO, I_LN2_G, I_LN2_B, I_W_ROUTER, I_B_ROUTER, I_W_GU, I_B_GU, I_W_DOWN, I_B_DOWN, I_LN3_G, I_LN3_B, N_IN };

__device__ __forceinline__ void p0_transpose_item(const float* W, int K, int N, bf16* WT, int k0, int n0, int drow, LAS float* scr, int lane) {
#pragma unroll 8
    for (int i = 0; i < 32; ++i) { const int kk = 2 * i + (lane >> 5); scr[kk * 33 + (lane & 31)] = W[(size_t)(k0 + kk) * N + n0 + (lane & 31)]; }
    LDS_WAIT(); asm volatile("" ::: "memory");
    const int c = lane & 7;
#pragma unroll
    for (int j = 0; j < 4; ++j) { const int n = (lane >> 3) + 8 * j; const LAS float* s = scr + (8 * c) * 33 + n;
        u32x4 o; o.x = pk2(s[0 * 33], s[1 * 33]); o.y = pk2(s[2 * 33], s[3 * 33]); o.z = pk2(s[4 * 33], s[5 * 33]); o.w = pk2(s[6 * 33], s[7 * 33]);
        *(GAS u32x4*)(WT + (size_t)(drow + n) * K + k0 + 8 * c) = o; }
    LDS_WAIT(); asm volatile("" ::: "memory");
}
__device__ __forceinline__ void ln_row(f32x4 (&v)[4], const float* g, const float* b, int lane) {
    float s = 0.f;
#pragma unroll
    for (int j = 0; j < 4; ++j) s += (v[j].x + v[j].y) + (v[j].z + v[j].w);
    const float mean = wave_sum(s) * (1.f / D); float s2 = 0.f;
#pragma unroll
    for (int j = 0; j < 4; ++j) { v[j] = v[j] - mean; s2 += (v[j].x * v[j].x + v[j].y * v[j].y) + (v[j].z * v[j].z + v[j].w * v[j].w); }
    const float rstd = 1.f / sqrtf(wave_sum(s2) * (1.f / D) + LN_EPS);
#pragma unroll
    for (int j = 0; j < 4; ++j) { const f32x4 gg = ((const GAS f32x4*)g)[lane + 64 * j], bb = ((const GAS f32x4*)b)[lane + 64 * j]; v[j] = v[j] * rstd * gg + bb; }
}
__device__ __forceinline__ void store_row_bf16(const f32x4 (&v)[4], bf16* orow, int lane) {
    GAS u32x2* o8 = (GAS u32x2*)orow + lane;
#pragma unroll
    for (int j = 0; j < 4; ++j) o8[64 * j] = (u32x2){pk2(v[j].x, v[j].y), pk2(v[j].z, v[j].w)};
}
__device__ __forceinline__ void p0_transpose_item8(const float* W, int K, int N, unsigned char* WT, int k0, int n0, int drow, float sc, LAS float* scr, int lane) {
#pragma unroll 8
    for (int i = 0; i < 32; ++i) { const int kk = 2 * i + (lane >> 5); scr[kk * 33 + (lane & 31)] = W[(size_t)(k0 + kk) * N + n0 + (lane & 31)]; }
    LDS_WAIT(); asm volatile("" ::: "memory");
    const int c = lane & 7;
#pragma unroll
    for (int j = 0; j < 4; ++j) { const int n = (lane >> 3) + 8 * j; const LAS float* s = scr + (8 * c) * 33 + n;
        u32x2 o; o.x = pk4_fp8(s[0 * 33] * sc, s[1 * 33] * sc, s[2 * 33] * sc, s[3 * 33] * sc); o.y = pk4_fp8(s[4 * 33] * sc, s[5 * 33] * sc, s[6 * 33] * sc, s[7 * 33] * sc);
        *(GAS u32x2*)(WT + (size_t)(drow + n) * K + k0 + 8 * c) = o; }
    LDS_WAIT(); asm volatile("" ::: "memory");
}
__device__ __forceinline__ void load_row_bf16(f32x4 (&v)[4], const bf16* xrow, int lane) {
    const GAS u32x2* xr = (const GAS u32x2*)xrow + lane;
#pragma unroll
    for (int j = 0; j < 4; ++j) { const u32x2 w = xr[64 * j]; v[j] = (f32x4){bflo(w.x), bfhi(w.x), bflo(w.y), bfhi(w.y)}; }
}
__device__ __forceinline__ void load_row_f32(f32x4 (&v)[4], const float* xrow, int lane) {
    const GAS f32x4* xr = (const GAS f32x4*)xrow + lane;
#pragma unroll
    for (int j = 0; j < 4; ++j) v[j] = xr[64 * j];
}
__device__ __forceinline__ void store_row_f32(const f32x4 (&v)[4], float* orow, int lane) {
    GAS f32x4* o = (GAS f32x4*)orow + lane;
#pragma unroll
    for (int j = 0; j < 4; ++j) o[64 * j] = v[j];
}

__device__ __forceinline__ void p0_prologue(Frame& F) {
    LAS float* scr = (LAS float*)(F.lds + RING_OFF + F.wave * 16384);
    const int gw = F.vcu * NWAVES + F.wave, NGW = F.G * NWAVES;
    constexpr int I_IN = 16 * 80, I_SQ = 16 * 32, I_GU = NE * 16 * 64, I_DN = NE * 16 * 32;
    constexpr int NITEMS = I_IN + 5 * I_SQ + I_GU + I_DN;
    for (int it = gw; it < NITEMS; it += NGW) {
        int r = it;
        if (r < I_IN) { const int kb = r / 80, nb = r % 80, n0 = 32 * nb; int drow;
            if (n0 < 512) drow = (n0 >> 7) * 256 + (n0 & 127); else if (n0 < 1024) drow = ((n0 - 512) >> 7) * 256 + 128 + (n0 & 127); else drow = n0;
            p0_transpose_item(F.in[I_W_IN], D, INC, (bf16*)(F.ws + WS_WIN_T), 64 * kb, n0, drow, scr, F.lane); continue; } r -= I_IN;
        if (r < 5 * I_SQ) { const int w = r / I_SQ, q = r % I_SQ, kb = q / 32, nb = q % 32;
            const float* src = F.in[w == 0 ? I_W_OUT : w == 1 ? I_WQ : w == 2 ? I_WK : w == 3 ? I_WV : I_WO];
            bf16* dst = (bf16*)(F.ws + (w == 0 ? WS_WOUT_T : w == 1 ? WS_WQ_T : w == 2 ? WS_WK_T : w == 3 ? WS_WV_T : WS_WO_T));
            p0_transpose_item(src, D, D, dst, 64 * kb, 32 * nb, 32 * nb, scr, F.lane); continue; } r -= 5 * I_SQ;
        if (r < I_GU) { const int e = r / (16 * 64), q = r % (16 * 64), kb = q / 64, nb = q % 64, n0 = 32 * nb;
            const int drow = (n0 < 1024) ? (n0 >> 7) * 256 + (n0 & 127) : ((n0 - 1024) >> 7) * 256 + 128 + (n0 & 127);
            p0_transpose_item8(F.in[I_W_GU] + (size_t)e * D * 2 * DFF, D, 2 * DFF, F.ws + WS_WGU_T + (size_t)e * 2 * DFF * D, 64 * kb, n0, drow, WGU_SC, scr, F.lane); continue; } r -= I_GU;
        { const int e = r / (16 * 32), q = r % (16 * 32), kb = q / 32, nb = q % 32;
            p0_transpose_item8(F.in[I_W_DOWN] + (size_t)e * DFF * D, DFF, D, F.ws + WS_WDN_T + (size_t)e * D * DFF, 64 * kb, 32 * nb, 32 * nb, WDN_SC, scr, F.lane); }
    }
    for (int m = gw; m < M + MM; m += NGW) {
        f32x4 v[4];
        if (m < M) { load_row_f32(v, F.in[I_X] + (size_t)m * D, F.lane); ln_row(v, F.in[I_LN_IN_G], F.in[I_LN_IN_B], F.lane);
            store_row_bf16(v, (bf16*)(F.ws + WS_HB) + (size_t)m * D, F.lane); }
        else { const int mm = m - M; load_row_f32(v, F.in[I_MEM] + (size_t)mm * D, F.lane); ln_row(v, F.in[I_LN_MEM_G], F.in[I_LN_MEM_B], F.lane);
            store_row_bf16(v, (bf16*)(F.ws + WS_MEMN) + (size_t)mm * D, F.lane); }
    }
}

constexpr unsigned TSTEP = 256u * 1024u * 2u;
struct SchedP1 { int G, c;
    __device__ __forceinline__ bool next(int i, Unit& u) const {
        const int L = i * G + c; if (L >= 1344) return false;
        u.nvalid = 256; u.goff = 0;
        if (L < 1024) { pg8::tile_order(L, 128, 8, u.pm, u.pn); u.z = 0; u.aoff = (unsigned)WS_HB + (unsigned)u.pm * TSTEP; u.boff = (unsigned)WS_WIN_T + (unsigned)u.pn * TSTEP; }
        else if (L < 1280) { const int j = L - 1024; u.pm = j & 1; u.pn = j >> 1; u.z = 3; u.aoff = (unsigned)WS_WIN_T + (unsigned)(8 + u.pm) * TSTEP; u.boff = (unsigned)WS_HB + (unsigned)u.pn * TSTEP; }
        else if (L < 1312) { const int j = L - 1280; u.pm = j & 7; u.pn = j >> 3; u.z = 1; u.aoff = (unsigned)WS_MEMN + (unsigned)u.pm * TSTEP; u.boff = (unsigned)WS_WK_T + (unsigned)u.pn * TSTEP; }
        else { const int j = L - 1312; u.pm = j & 3; u.pn = j >> 2; u.z = 2; u.aoff = (unsigned)WS_WV_T + (unsigned)u.pm * TSTEP; u.boff = (unsigned)WS_MEMN + (unsigned)u.pn * TSTEP; }
        return true; }
};
struct EpiP1 { static constexpr bool PERM = true;
    unsigned char* ws; const float* b_in;
    __device__ __forceinline__ void operator()(const f32x4 (&acc)[2][2][4][2], const Unit& u, int wr, int wc, int fr, int fq) const {
        const int row0 = u.pm * 256 + wr * 64 + fr;
        if (u.z == 0) {
            if (u.pn < 4) {
                const int ch = 128 * u.pn + wc * 32 + 8 * fq;
                f32x4 bv[2], bg[2];
#pragma unroll
                for (int n = 0; n < 2; ++n) { bv[n] = *(const f32x4*)(b_in + ch + 4 * n); bg[n] = *(const f32x4*)(b_in + 512 + ch + 4 * n); }
                bf16* U = (bf16*)(ws + WS_U);
#pragma unroll
                for (int ai = 0; ai < 2; ++ai)
#pragma unroll
                    for (int m = 0; m < 4; ++m) { f32x4 o[2];
#pragma unroll
                        for (int n = 0; n < 2; ++n) { const f32x4 a = acc[ai][0][m][n] + bv[n], g = acc[ai][1][m][n] + bg[n];
#pragma unroll
                            for (int j = 0; j < 4; ++j) o[n][j] = a[j] * sigmoidf_fast(g[j]); }
                        u32x4 w; w.x = pg8::cvt_pk_bf16(o[0][0], o[0][1]); w.y = pg8::cvt_pk_bf16(o[0][2], o[0][3]); w.z = pg8::cvt_pk_bf16(o[1][0], o[1][1]); w.w = pg8::cvt_pk_bf16(o[1][2], o[1][3]);
                        *(u32x4*)(U + (size_t)(row0 + ai * 128 + m * 16) * 512 + ch) = w; }
            } else {
                const int t = u.pn - 4, which = t >> 1, cb = (t & 1) * 256;
                bf16* dst = (bf16*)(ws + (which == 0 ? WS_Q : WS_K));
                pg8::store_tile_bf16(acc, dst + (size_t)row0 * 512 + cb, 512, b_in + 1024 + 256 * t, which == 0 ? SB_QSCALE : 1.0f, wc, fq);
            }
        } else if (u.z == 3) {
            const float* rb = b_in + 2048 + row0; bf16* p0 = (bf16*)(ws + WS_V) + (size_t)row0 * M + 256 * u.pn; const int cl = wc * 32 + 8 * fq;
#pragma unroll
            for (int ai = 0; ai < 2; ++ai)
#pragma unroll
                for (int m = 0; m < 4; ++m) { const float bv = rb[ai * 128 + m * 16]; bf16* rowp = p0 + (size_t)(ai * 128 + m * 16) * M + cl;
#pragma unroll
                    for (int bj = 0; bj < 2; ++bj) { const f32x4 v0 = acc[ai][bj][m][0] + bv, v1 = acc[ai][bj][m][1] + bv;
                        u32x4 w; w.x = pg8::cvt_pk_bf16(v0[0], v0[1]); w.y = pg8::cvt_pk_bf16(v0[2], v0[3]); w.z = pg8::cvt_pk_bf16(v1[0], v1[1]); w.w = pg8::cvt_pk_bf16(v1[2], v1[3]);
                        *(u32x4*)(rowp + bj * 128) = w; } }
        } else if (u.z == 1) pg8::store_tile_bf16(acc, (bf16*)(ws + WS_KM) + (size_t)row0 * 1024 + 256 * u.pn, 1024, nullptr, 1.0f, wc, fq);
        else pg8::store_tile_bf16(acc, (bf16*)(ws + WS_VMT) + (size_t)row0 * 2048 + 256 * u.pn, 2048, nullptr, 1.0f, wc, fq);
    }
};

struct SchedPlain { int G, c, nM, nN; unsigned abase, bbase, atile, btile, acol, bcol, bgrp;
    __device__ __forceinline__ bool next(int i, Unit& u) const {
        const int L = i * G + c; if (L >= nM * nN) return false;
        pg8::tile_order(L, nM, nN, u.pm, u.pn); u.z = 0; u.nvalid = 256; u.goff = 0;
        u.aoff = abase + (unsigned)u.pm * atile + (unsigned)u.pn * acol; u.boff = bbase + (unsigned)u.pn * btile + (unsigned)(u.pm >> 4) * bgrp + (unsigned)u.pn * bcol; return true; }
};
struct EpiBf16 { static constexpr bool PERM = true;
    bf16* O; int ldc; float scale; const float* bias;
    __device__ __forceinline__ void operator()(const f32x4 (&acc)[2][2][4][2], const Unit& u, int wr, int wc, int fr, int fq) const {
        pg8::store_tile_bf16(acc, O + (size_t)(u.pm * 256 + wr * 64 + fr) * ldc + 256 * u.pn, (size_t)ldc, bias ? bias + 256 * u.pn : nullptr, scale, wc, fq); }
};
struct SchedMoe { int G, c, nN; const LAS int* tb; unsigned abase, wbase, wexp;
    bool gather;
    __device__ __forceinline__ bool next(int i, Unit& u) const {
        const int nblk = __builtin_amdgcn_readfirstlane(tb[32]); const int L = i * G + c; if (L >= nblk * nN) return false;
        pg8::tile_order(L, nblk, nN, u.pm, u.pn);
        int e = 0; while (tb[e + 1] <= u.pm) ++e;
        e = __builtin_amdgcn_readfirstlane(e);
        const int j = u.pm - tb[e], rem = tb[64 + e] - 256 * j;
        u.z = e; u.nvalid = rem < 256 ? rem : 256; u.goff = (unsigned)(e * LCAP + 256 * j);
        u.aoff = gather ? abase : abase + (unsigned)u.pm * (TSTEP / 2);
        u.boff = wbase + (unsigned)e * wexp + (unsigned)u.pn * (TSTEP / 2); return true; }
};
struct EpiAct { static constexpr bool PERM = true;
    unsigned char* ACT; const float* b_gu;
    __device__ __forceinline__ void operator()(const f32x4 (&acc)[2][2][4][2], const Unit& u, int wr, int wc, int fr, int fq) const {
        const int row0 = u.pm * 256 + wr * 64 + fr, ch = 128 * u.pn + wc * 32 + 8 * fq;
        const float* bb = b_gu + (size_t)u.z * 2 * DFF;
        f32x4 bg[2], bu[2];
#pragma unroll
        for (int n = 0; n < 2; ++n) { bg[n] = *(const f32x4*)(bb + ch + 4 * n); bu[n] = *(const f32x4*)(bb + DFF + ch + 4 * n); }
#pragma unroll
        for (int ai = 0; ai < 2; ++ai)
#pragma unroll
            for (int m = 0; m < 4; ++m) { f32x4 o[2];
#pragma unroll
                for (int n = 0; n < 2; ++n) { const f32x4 g = acc[ai][0][m][n] * (1.0f / WGU_SC) + bg[n], uu = acc[ai][1][m][n] * (1.0f / WGU_SC) + bu[n];
#pragma unroll
                    for (int j = 0; j < 4; ++j) { const float g_ = fminf(g[j], 7.0f), u_ = fminf(fmaxf(uu[j], -7.0f), 7.0f); o[n][j] = (u_ + 1.0f) * g_ * sigmoidf_fast(1.702f * g_); } }
                *(u32x2*)(ACT + (size_t)(row0 + ai * 128 + m * 16) * DFF + ch) = (u32x2){pk4_fp8(o[0][0], o[0][1], o[0][2], o[0][3]), pk4_fp8(o[1][0], o[1][1], o[1][2], o[1][3])}; }
    }
};
struct EpiDown { static constexpr bool PERM = true;
    bf16* YS; const float* b_down; const float* lgate;
    __device__ __forceinline__ void operator()(const f32x4 (&acc)[2][2][4][2], const Unit& u, int wr, int wc, int fr, int fq) const {
        const int r0 = wr * 64 + fr, cl = wc * 32 + 8 * fq;
        const float* bb = b_down + (size_t)u.z * D + 256 * u.pn + cl;
        f32x4 bv[2][2];
#pragma unroll
        for (int bj = 0; bj < 2; ++bj)
#pragma unroll
            for (int n = 0; n < 2; ++n) bv[bj][n] = *(const f32x4*)(bb + bj * 128 + 4 * n);
        float gts[2][4];
#pragma unroll
        for (int ai = 0; ai < 2; ++ai)
#pragma unroll
            for (int m = 0; m < 4; ++m) { const int r = r0 + ai * 128 + m * 16; gts[ai][m] = lgate[u.goff + (r < u.nvalid ? r : u.nvalid - 1)]; }
#pragma unroll
        for (int ai = 0; ai < 2; ++ai)
#pragma unroll
            for (int m = 0; m < 4; ++m) { const int r = r0 + ai * 128 + m * 16; const float gt = (r < u.nvalid) ? gts[ai][m] : 0.f;
                bf16* rowp = YS + (size_t)(u.pm * 256 + r) * D + 256 * u.pn + cl;
#pragma unroll
                for (int bj = 0; bj < 2; ++bj) { const f32x4 v0 = (acc[ai][bj][m][0] * (1.0f / WDN_SC) + bv[bj][0]) * gt, v1 = (acc[ai][bj][m][1] * (1.0f / WDN_SC) + bv[bj][1]) * gt;
                    u32x4 w; w.x = pg8::cvt_pk_bf16(v0[0], v0[1]); w.y = pg8::cvt_pk_bf16(v0[2], v0[3]); w.z = pg8::cvt_pk_bf16(v1[0], v1[1]); w.w = pg8::cvt_pk_bf16(v1[2], v1[3]);
                    *(u32x4*)(rowp + bj * 128) = w; } }
    }
};
__device__ __forceinline__ void moe_table(Frame& F, LAS int* tb) {
    if (F.tid < 32) { int c = (int)__hip_atomic_load(F.ctl + CW_ECNT + 64 * F.tid, RLX_AGENT); if (c > LCAP) c = LCAP; tb[64 + F.tid] = c; }
    LDS_WAIT(); __syncthreads();
    if (F.tid == 0) { int s = 0; for (int e = 0; e < NE; ++e) { tb[e] = s; s += (tb[64 + e] + 255) >> 8; } tb[32] = s; }
    LDS_WAIT(); __syncthreads();
}

__device__ __forceinline__ void conv_phase(Frame& F) {
    LAS unsigned* ut = (LAS unsigned*)(F.lds + RING_OFF);
    LAS float* co = (LAS float*)(F.lds + RING_OFF + 65536);
    const int cp = F.tid & 255, half = F.tid >> 8;
    float w0[CWID], w1[CWID];
    { const float* wd = F.in[I_W_DW] + 2 * cp;
#pragma unroll
        for (int j = 0; j < CWID; ++j) { const f32x2 w = *(const GAS f32x2*)(wd + j * CONV_CH); w0[j] = w.x; w1[j] = w.y; } }
    const f32x2 bd = *(const GAS f32x2*)(F.in[I_B_DW] + 2 * cp);
    const f32x4 g0 = *(const GAS f32x4*)(F.in[I_LN_CONV_G] + 8 * F.lane), g1 = *(const GAS f32x4*)(F.in[I_LN_CONV_G] + 8 * F.lane + 4);
    const f32x4 b0 = *(const GAS f32x4*)(F.in[I_LN_CONV_B] + 8 * F.lane), b1 = *(const GAS f32x4*)(F.in[I_LN_CONV_B] + 8 * F.lane + 4);
    bf16* MX = (bf16*)(F.ws + WS_MIXIN);
    for (int it = F.vcu; it < NB * (T_ / 32); it += F.G) {
        const int b = it / (T_ / 32), t0 = (it % (T_ / 32)) * 32;
        const bf16* U = (const bf16*)(F.ws + WS_U) + (size_t)b * T_ * CONV_CH;
        for (int idx = F.tid; idx < 62 * 64; idx += 512) { const int r = idx >> 6, c16 = idx & 63, t = t0 - 30 + r;
            u32x4 v = (u32x4){0u, 0u, 0u, 0u}; if (t >= 0) v = *(const GAS u32x4*)(U + (size_t)t * CONV_CH + c16 * 8);
            *(LAS u32x4*)(ut + r * 256 + c16 * 4) = v; }
        LDS_WAIT(); __syncthreads();
        { float a0[16], a1[16];
#pragma unroll
            for (int tt = 0; tt < 16; ++tt) { a0[tt] = bd.x; a1[tt] = bd.y; }
#pragma unroll
            for (int r = 0; r < 46; ++r) { const unsigned uu = ut[(half * 16 + r) * 256 + cp]; const float u0 = bflo(uu), u1 = bfhi(uu);
#pragma unroll
                for (int tt = 0; tt < 16; ++tt) { const int j = r - tt; if (j >= 0 && j < CWID) { a0[tt] += w0[j] * u0; a1[tt] += w1[j] * u1; } } }
#pragma unroll
            for (int tt = 0; tt < 16; ++tt) *(LAS f32x2*)(co + (half * 16 + tt) * CONV_CH + 2 * cp) = (f32x2){a0[tt], a1[tt]};
        }
        LDS_WAIT(); __syncthreads();
#pragma unroll
        for (int q = 0; q < 4; ++q) { const int tt = 4 * F.wave + q;
            f32x4 x0 = *(const LAS f32x4*)(co + tt * CONV_CH + 8 * F.lane), x1 = *(const LAS f32x4*)(co + tt * CONV_CH + 8 * F.lane + 4);
            const float mean = wave_sum((x0.x + x0.y) + (x0.z + x0.w) + (x1.x + x1.y) + (x1.z + x1.w)) * (1.f / CONV_CH);
            x0 = x0 - mean; x1 = x1 - mean;
            const float var = wave_sum((x0.x * x0.x + x0.y * x0.y) + (x0.z * x0.z + x0.w * x0.w) + (x1.x * x1.x + x1.y * x1.y) + (x1.z * x1.z + x1.w * x1.w)) * (1.f / CONV_CH);
            const float rstd = 1.f / sqrtf(var + LN_EPS);
            x0 = x0 * rstd * g0 + b0; x1 = x1 * rstd * g1 + b1;
            float y[8] = {x0.x, x0.y, x0.z, x0.w, x1.x, x1.y, x1.z, x1.w};
#pragma unroll
            for (int j = 0; j < 8; ++j) y[j] = y[j] * sigmoidf_fast(y[j]);
            *(GAS u32x4*)(MX + (size_t)(b * T_ + t0 + tt) * D + 8 * F.lane) = (u32x4){pk2(y[0], y[1]), pk2(y[2], y[3]), pk2(y[4], y[5]), pk2(y[6], y[7])}; }
        __syncthreads();
    }
}

typedef float f32x16 __attribute__((ext_vector_type(16)));
__device__ __forceinline__ int crow(int r, int hi) { return (r & 3) + 8 * (r >> 2) + 4 * hi; }
__device__ __forceinline__ bf16x8 pack8(const float* v) {
    u32x4 w; w.x = pg8::cvt_pk_bf16(v[0], v[1]); w.y = pg8::cvt_pk_bf16(v[2], v[3]); w.z = pg8::cvt_pk_bf16(v[4], v[5]); w.w = pg8::cvt_pk_bf16(v[6], v[7]);
    return __builtin_bit_cast(bf16x8, w); }
constexpr float SB_EXIT = 150.0f;
struct SbFrag { bf16x8 k[4]; u32x2 v[2][2][2]; };
__device__ __forceinline__ void sb_load(SbFrag& f, const bf16* Kl, const bf16* Vl, int kt) {
    const bf16* kp = Kl + (size_t)(32 * kt) * SBW;
#pragma unroll
    for (int s = 0; s < 4; ++s) f.k[s] = *(const GAS bf16x8*)(kp + 16 * s);
#pragma unroll
    for (int dt = 0; dt < 2; ++dt)
#pragma unroll
        for (int s = 0; s < 2; ++s) { const bf16* vp = Vl + (size_t)dt * 32 * M + 32 * kt + 16 * s; f.v[dt][s][0] = *(const GAS u32x2*)vp; f.v[dt][s][1] = *(const GAS u32x2*)(vp + 8); }
}
__device__ __forceinline__ void sb_attn_wave(Frame& F, int b, int h, int qt) {
    const int c = F.lane & 31, hi = F.lane >> 5;
    const bf16* Q = (const bf16*)(F.ws + WS_Q); const bf16* Kb = (const bf16*)(F.ws + WS_K); const bf16* VT = (const bf16*)(F.ws + WS_V);
    bf16x8 tri[2];
#pragma unroll
    for (int s = 0; s < 2; ++s) { bf16x8 t;
#pragma unroll
        for (int j = 0; j < 8; ++j) { const int k = 16 * s + 8 * (j >> 2) + 4 * hi + (j & 3); t[j] = (k >= c) ? (short)0xBF80 : (short)0; }
        tri[s] = t; }
    bf16x8 qf[4];
    { const bf16* qp = Q + ((size_t)b * T_ + 32 * qt + c) * SBW + h * SBD + 8 * hi;
#pragma unroll
        for (int s = 0; s < 4; ++s) qf[s] = *(const GAS bf16x8*)(qp + 16 * s); }
    const bf16* Kl = Kb + ((size_t)b * T_ + c) * SBW + h * SBD + 8 * hi;
    const bf16* Vl = VT + (size_t)(h * SBD + c) * M + (size_t)b * T_ + 4 * hi;
    f32x16 o0, o1;
#pragma unroll
    for (int r = 0; r < 16; ++r) { o0[r] = 0.f; o1[r] = 0.f; }
    float carry = 0.f;
    SbFrag fa, fb;
    sb_load(fa, Kl, Vl, qt);
#define SB_TILE(f, DIAG) do { \
        f32x16 p; _Pragma("unroll") for (int r = 0; r < 16; ++r) p[r] = 0.f; \
        _Pragma("unroll") for (int s = 0; s < 4; ++s) p = __builtin_amdgcn_mfma_f32_32x32x16_bf16(f.k[s], qf[s], p, 0, 0, 0); \
        float L[16]; \
        _Pragma("unroll") for (int r = 0; r < 16; ++r) { const float y = p[r]; float l = __builtin_amdgcn_logf(1.0f + __builtin_amdgcn_exp2f(fminf(y, 100.f))); l = fmaxf(l, y); \
            if (DIAG) l = (crow(r, hi) >= c) ? 0.f : l; L[r] = l; } \
        const bf16x8 l0 = pack8(L), l1 = pack8(L + 8); \
        f32x16 a; _Pragma("unroll") for (int r = 0; r < 16; ++r) a[r] = p[r] - carry; \
        a = __builtin_amdgcn_mfma_f32_32x32x16_bf16(tri[0], l0, a, 0, 0, 0); a = __builtin_amdgcn_mfma_f32_32x32x16_bf16(tri[1], l1, a, 0, 0, 0); \
        const float tot = p[0] - a[0];                                     \
        float w[16]; \
        _Pragma("unroll") for (int r = 0; r < 16; ++r) { float x = __builtin_amdgcn_exp2f(a[r]); if (DIAG) x = (crow(r, hi) >= c) ? 0.f : x; w[r] = x; } \
        const bf16x8 p0 = pack8(w), p1 = pack8(w + 8); \
        { const bf16x8 v00 = __builtin_bit_cast(bf16x8, (u32x4){f.v[0][0][0].x, f.v[0][0][0].y, f.v[0][0][1].x, f.v[0][0][1].y}); \
          const bf16x8 v01 = __builtin_bit_cast(bf16x8, (u32x4){f.v[0][1][0].x, f.v[0][1][0].y, f.v[0][1][1].x, f.v[0][1][1].y}); \
          const bf16x8 v10 = __builtin_bit_cast(bf16x8, (u32x4){f.v[1][0][0].x, f.v[1][0][0].y, f.v[1][0][1].x, f.v[1][0][1].y}); \
          const bf16x8 v11 = __builtin_bit_cast(bf16x8, (u32x4){f.v[1][1][0].x, f.v[1][1][0].y, f.v[1][1][1].x, f.v[1][1][1].y}); \
          o0 = __builtin_amdgcn_mfma_f32_32x32x16_bf16(v00, p0, o0, 0, 0, 0); o0 = __builtin_amdgcn_mfma_f32_32x32x16_bf16(v01, p1, o0, 0, 0, 0); \
          o1 = __builtin_amdgcn_mfma_f32_32x32x16_bf16(v10, p0, o1, 0, 0, 0); o1 = __builtin_amdgcn_mfma_f32_32x32x16_bf16(v11, p1, o1, 0, 0, 0); } \
        carry = __shfl(tot, c); } while (0)
    if (qt > 0) sb_load(fb, Kl, Vl, qt - 1);
    SB_TILE(fa, true);
    int kt = qt - 1;
    while (kt >= 0) {
        if (__all(carry >= SB_EXIT)) break;
        if (kt > 0) sb_load(fa, Kl, Vl, kt - 1);
        SB_TILE(fb, false);
        --kt; if (kt < 0) break;
        if (__all(carry >= SB_EXIT)) break;
        if (kt > 0) sb_load(fb, Kl, Vl, kt - 1);
        SB_TILE(fa, false);
        --kt;
    }
#undef SB_TILE
    bf16* op = (bf16*)(F.ws + WS_MIXIN) + ((size_t)b * T_ + 32 * qt + c) * D + CONV_CH + h * SBD + 4 * hi;
#pragma unroll
    for (int g = 0; g < 4; ++g) {
        *(GAS u32x2*)(op + 8 * g) = (u32x2){pg8::cvt_pk_bf16(o0[4 * g], o0[4 * g + 1]), pg8::cvt_pk_bf16(o0[4 * g + 2], o0[4 * g + 3])};
        *(GAS u32x2*)(op + 32 + 8 * g) = (u32x2){pg8::cvt_pk_bf16(o1[4 * g], o1[4 * g + 1]), pg8::cvt_pk_bf16(o1[4 * g + 2], o1[4 * g + 3])}; }
}

__device__ __forceinline__ void resid_row(f32x4 (&v)[4], const bf16* hrow, const bf16* mrow, int lane) {
    f32x4 a[4]; load_row_bf16(v, hrow, lane); load_row_bf16(a, mrow, lane);
#pragma unroll
    for (int j = 0; j < 4; ++j) v[j] = v[j] * DN_ALPHA + a[j];
}
__device__ __forceinline__ void ln_phase(Frame& F, const float* g, const float* b) {
    const int gw = F.vcu * NWAVES + F.wave, NGW = F.G * NWAVES;
    for (int m = gw; m < M; m += NGW) { f32x4 v[4]; bf16* hrow = (bf16*)(F.ws + WS_HB) + (size_t)m * D; resid_row(v, hrow, (const bf16*)(F.ws + WS_QM) + (size_t)m * D, F.lane);
        ln_row(v, g, b, F.lane); store_row_bf16(v, hrow, F.lane); }
}
__device__ __forceinline__ void softmax_phase(Frame& F) {
    const int gw = F.vcu * NWAVES + F.wave, NGW = F.G * NWAVES;
    for (int m = gw; m < M; m += NGW) { GAS u32x2* p = (GAS u32x2*)((bf16*)(F.ws + WS_SP) + (size_t)m * D) + F.lane;
#pragma unroll
        for (int j = 0; j < 4; ++j) { const u32x2 w = p[64 * j]; float x0 = bflo(w.x), x1 = bfhi(w.x), x2 = bflo(w.y), x3 = bfhi(w.y);
            const float mx = wave_max(fmaxf(fmaxf(x0, x1), fmaxf(x2, x3)));
            x0 = __builtin_amdgcn_exp2f(x0 - mx); x1 = __builtin_amdgcn_exp2f(x1 - mx); x2 = __builtin_amdgcn_exp2f(x2 - mx); x3 = __builtin_amdgcn_exp2f(x3 - mx);
            const float inv = 1.0f / wave_sum((x0 + x1) + (x2 + x3));
            p[64 * j] = (u32x2){pk2(x0 * inv, x1 * inv), pk2(x2 * inv, x3 * inv)}; } }
}
__device__ __forceinline__ void ln2_router_phase(Frame& F) {
    LAS float* wT = (LAS float*)(F.lds + RING_OFF);
    LAS int* lcnt = (LAS int*)(F.lds + XTRA_OFF);
    LAS int* rec = (LAS int*)(F.lds + XTRA_OFF + 512);
    const float* wr_ = F.in[I_W_ROUTER];
    for (int idx = F.tid; idx < D * NE; idx += 512) { const int c = idx >> 5, e = idx & 31; wT[e * D + c] = wr_[idx]; }
    if (F.tid < 64) lcnt[F.tid] = 0;
    LDS_WAIT(); __syncthreads();
    const int gw = F.vcu * NWAVES + F.wave, NGW = F.G * NWAVES;
    const float brt = F.in[I_B_ROUTER][F.lane >> 1];
    int it = 0;
    for (int m = gw; m < M; m += NGW, ++it) {
        f32x4 v[4]; bf16* hrow = (bf16*)(F.ws + WS_HB) + (size_t)m * D; resid_row(v, hrow, (const bf16*)(F.ws + WS_QM) + (size_t)m * D, F.lane);
        ln_row(v, F.in[I_LN2_G], F.in[I_LN2_B], F.lane); store_row_bf16(v, hrow, F.lane);
        { GAS unsigned* h8 = (GAS unsigned*)(F.ws + WS_HB8 + (size_t)m * D) + F.lane;
#pragma unroll
            for (int j = 0; j < 4; ++j) h8[64 * j] = pk4_fp8(v[j].x, v[j].y, v[j].z, v[j].w); }
        float ra[NE];
#pragma unroll
        for (int e = 0; e < NE; ++e) { float p = 0.f;
#pragma unroll
            for (int j = 0; j < 4; ++j) { const f32x4 w = *(const LAS f32x4*)(wT + e * D + 256 * j + 4 * F.lane); p += (v[j].x * w.x + v[j].y * w.y) + (v[j].z * w.z + v[j].w * w.w); }
            ra[e] = p; }
#pragma unroll
        for (int i = 0; i < 16; ++i) { const bool up = (F.lane & 32) != 0; const float keep = up ? ra[16 + i] : ra[i], send = up ? ra[i] : ra[16 + i]; ra[i] = keep + __shfl_xor(send, 32); }
#pragma unroll
        for (int i = 0; i < 8; ++i) { const bool up = (F.lane & 16) != 0; const float keep = up ? ra[8 + i] : ra[i], send = up ? ra[i] : ra[8 + i]; ra[i] = keep + __shfl_xor(send, 16); }
#pragma unroll
        for (int i = 0; i < 4; ++i) { const bool up = (F.lane & 8) != 0; const float keep = up ? ra[4 + i] : ra[i], send = up ? ra[i] : ra[4 + i]; ra[i] = keep + __shfl_xor(send, 8); }
#pragma unroll
        for (int i = 0; i < 2; ++i) { const bool up = (F.lane & 4) != 0; const float keep = up ? ra[2 + i] : ra[i], send = up ? ra[i] : ra[2 + i]; ra[i] = keep + __shfl_xor(send, 4); }
        { const bool up = (F.lane & 2) != 0; const float keep = up ? ra[1] : ra[0], send = up ? ra[0] : ra[1]; ra[0] = keep + __shfl_xor(send, 2); }
        ra[0] += __shfl_xor(ra[0], 1);
        float logit = (F.lane & 1) ? -INFINITY : ra[0] + brt;
        float tv[TOPK]; int te[TOPK];
#pragma unroll
        for (int k = 0; k < TOPK; ++k) { const float mx = wave_max(logit); const unsigned long long bal = __ballot(logit == mx); const int ln = __builtin_ctzll(bal);
            tv[k] = mx; te[k] = ln >> 1; if (F.lane == ln) logit = -INFINITY; }
        float pe[TOPK], ps = 0.f;
#pragma unroll
        for (int k = 0; k < TOPK; ++k) { pe[k] = __expf(tv[k] - tv[0]); ps += pe[k]; }
        if (F.lane < TOPK) { const int k = F.lane; const int e = k == 0 ? te[0] : k == 1 ? te[1] : k == 2 ? te[2] : te[3]; const float g = (k == 0 ? pe[0] : k == 1 ? pe[1] : k == 2 ? pe[2] : pe[3]) / ps;
            const int lr = __hip_atomic_fetch_add(lcnt + e, 1, __ATOMIC_RELAXED, __HIP_MEMORY_SCOPE_WORKGROUP);
            LAS int* r = rec + ((F.wave * 16 + (it & 15)) * 4 + k) * 4; r[0] = e; r[1] = lr; r[2] = __builtin_bit_cast(int, g); r[3] = m; }
    }
    LDS_WAIT(); __syncthreads();
    if (F.tid < NE) lcnt[32 + F.tid] = (int)__hip_atomic_fetch_add(F.ctl + CW_ECNT + 64 * F.tid, (unsigned)lcnt[F.tid], RLX_AGENT);
    LDS_WAIT(); __syncthreads();
    int* ltok = (int*)(F.ws + WS_LTOK); float* lgate = (float*)(F.ws + WS_LGATE); int* sidx = (int*)(F.ws + WS_SIDX);
    const int nrec = it * 4;
    for (int i = F.lane; i < nrec; i += 64) { const LAS int* r = rec + (F.wave * 64 + i) * 4; const int e = r[0], pos = lcnt[32 + e] + r[1], tok = r[3];
        if (pos < LCAP) { ltok[e * LCAP + pos] = tok; lgate[e * LCAP + pos] = __builtin_bit_cast(float, r[2]); } sidx[tok * 4 + (i & 3)] = e * LCAP + pos; }
    __syncthreads();
}
__device__ __forceinline__ void final_phase(Frame& F, const LAS int* tb) {
    const int gw = F.vcu * NWAVES + F.wave, NGW = F.G * NWAVES;
    const int* sidx = (const int*)(F.ws + WS_SIDX); const bf16* YS = (const bf16*)(F.ws + WS_YS);
    for (int m = gw; m < M; m += NGW) { f32x4 v[4]; load_row_bf16(v, (const bf16*)(F.ws + WS_HB) + (size_t)m * D, F.lane);
#pragma unroll
        for (int j = 0; j < 4; ++j) v[j] = v[j] * DN_ALPHA;
        f32x4 s[4];
#pragma unroll
        for (int j = 0; j < 4; ++j) s[j] = (f32x4){0.f, 0.f, 0.f, 0.f};
#pragma unroll
        for (int k = 0; k < TOPK; ++k) { const int si = sidx[m * 4 + k], e = si / LCAP, pos = si - e * LCAP; const size_t slot = (size_t)tb[e] * 256 + pos;
            const GAS u32x2* yp = (const GAS u32x2*)(YS + slot * D) + F.lane;
#pragma unroll
            for (int j = 0; j < 4; ++j) { const u32x2 w = yp[64 * j]; s[j] = s[j] + (f32x4){bflo(w.x), bfhi(w.x), bflo(w.y), bfhi(w.y)}; } }
#pragma unroll
        for (int j = 0; j < 4; ++j) v[j] = v[j] + s[j];
        ln_row(v, F.in[I_LN3_G], F.in[I_LN3_B], F.lane); store_row_f32(v, F.hf + (size_t)m * D, F.lane); }
}

struct Args { const float* in[N_IN]; float* out; unsigned char* ws; int ph_lo, ph_hi, li, pad; };
__global__ void __launch_bounds__(NWAVES * 64, 2) mk_fwd(Args args) {
    extern __shared__ __attribute__((aligned(16))) unsigned char lds[];
    Frame F;
    F.lds = (LAS unsigned char*)lds; F.MISC = (volatile LAS unsigned*)(F.lds + MISC_OFF);
    F.tid = threadIdx.x; F.lane = F.tid & 63; F.wave = __builtin_amdgcn_readfirstlane(F.tid >> 6);
    F.G = gridDim.x; { const int bx = blockIdx.x; F.vcu = (F.G % 8 == 0) ? (bx % 8) * (F.G / 8) + bx / 8 : bx; }
    F.ws = args.ws; F.ctl = (gu32*)(args.ws + WS_CTL); F.hf = args.out; F.in = args.in;
    for (int u = F.tid; u < (LDS_BYTES - LDSCTL_OFF) / 4; u += NWAVES * 64) ((LAS unsigned*)(F.lds + LDSCTL_OFF))[u] = 0u;
    __syncthreads();
    XcdBarrier bar; bar.bar = (unsigned*)(F.ctl + CW_BAR) + args.li * XCD_BAR_WORDS; bar.x = 0; bar.st = nullptr;
    const int lo = args.ph_lo, hi = args.ph_hi;
    if (hi - lo > 1) bar = xcd_barrier_post((unsigned*)(F.ctl + CW_BAR) + args.li * XCD_BAR_WORDS, F.MISC + 8);
#ifndef PH_MASK
#define PH_MASK 0x3fff
#endif
#define IN(k) (((PH_MASK >> (k)) & 1) && lo <= (k) && (k) < hi)
#ifndef REP_MASK
#define REP_MASK 0
#endif
#define REPS(k) (1 + ((REP_MASK >> (k)) & 1))
#define SEAM(k) do { if (IN(k) && IN((k) + 1)) xcd_barrier(bar); } while (0)
    const char* wsb = (const char*)args.ws;
    LAS int* tb = (LAS int*)(F.lds + XTRA_OFF + 9216);

    if (IN(0)) for (int rep = 0; rep < REPS(0); ++rep) { p0_prologue(F); __syncthreads(); } SEAM(0);
    if (IN(1)) for (int rep = 0; rep < REPS(1); ++rep) { SchedP1 S{F.G, (int)blockIdx.x}; EpiP1 E{F.ws, F.in[I_B_IN]};
        pg8::gemm_phase<EpiP1, SchedP1, false>(F.lds + RING_OFF, wsb, D, D, D, S, E, nullptr); } SEAM(1);
    if (IN(2)) for (int rep = 0; rep < REPS(2); ++rep) {
        conv_phase(F);
        const int gw = F.vcu * NWAVES + F.wave;
        for (int tk = gw; tk < NB * SBH * (T_ / 32); tk += F.G * NWAVES) sb_attn_wave(F, (tk >> 7) >> 3, (tk >> 7) & 7, tk & 127);
    } SEAM(2);
    if (IN(3)) { SchedPlain S{F.G, (int)blockIdx.x, 128, 4, (unsigned)WS_MIXIN, (unsigned)WS_WOUT_T, TSTEP, TSTEP, 0u, 0u, 0u}; EpiBf16 E{(bf16*)(F.ws + WS_QM), D, 1.0f, F.in[I_B_OUT]};
        pg8::gemm_phase<EpiBf16, SchedPlain, false>(F.lds + RING_OFF, wsb, D, D, D, S, E, nullptr); } SEAM(3);
    if (IN(4)) { ln_phase(F, F.in[I_LN1_G], F.in[I_LN1_B]); } SEAM(4);
    if (IN(5)) { SchedPlain S{F.G, (int)blockIdx.x, 128, 4, (unsigned)WS_HB, (unsigned)WS_WQ_T, TSTEP, TSTEP, 0u, 0u, 0u}; EpiBf16 E{(bf16*)(F.ws + WS_QM), D, MEM_QSCALE, nullptr};
        pg8::gemm_phase<EpiBf16, SchedPlain, false>(F.lds + RING_OFF, wsb, D, D, D, S, E, nullptr); } SEAM(5);
    if (IN(6)) {
        SchedPlain S{F.G, (int)blockIdx.x, 128, 4, (unsigned)WS_QM, (unsigned)WS_KM, TSTEP, 0u, 512u, 512u, TSTEP}; EpiBf16 E{(bf16*)(F.ws + WS_SP), D, 1.0f, nullptr};
        pg8::gemm_phase<EpiBf16, SchedPlain, false>(F.lds + RING_OFF, wsb, D, D, 256, S, E, nullptr); } SEAM(6);
    if (IN(7)) { softmax_phase(F); } SEAM(7);
    if (IN(8)) {
        SchedPlain S{F.G, (int)blockIdx.x, 128, 4, (unsigned)WS_SP, (unsigned)WS_VMT, TSTEP, 256u * 2048u * 2u, 512u, 0u, 512u}; EpiBf16 E{(bf16*)(F.ws + WS_OB), D, 1.0f, nullptr};
        pg8::gemm_phase<EpiBf16, SchedPlain, false>(F.lds + RING_OFF, wsb, D, 2048, 256, S, E, nullptr); } SEAM(8);
    if (IN(9)) { SchedPlain S{F.G, (int)blockIdx.x, 128, 4, (unsigned)WS_OB, (unsigned)WS_WO_T, TSTEP, TSTEP, 0u, 0u, 0u}; EpiBf16 E{(bf16*)(F.ws + WS_QM), D, 1.0f, nullptr};
        pg8::gemm_phase<EpiBf16, SchedPlain, false>(F.lds + RING_OFF, wsb, D, D, D, S, E, nullptr); } SEAM(9);
    if (IN(10)) { ln2_router_phase(F); } SEAM(10);
    if (IN(11)) for (int rep = 0; rep < REPS(11); ++rep) { moe_table(F, tb); SchedMoe S{F.G, (int)blockIdx.x, 8, tb, (unsigned)WS_HB8, (unsigned)WS_WGU_T, 2048u * 1024u, true}; EpiAct E{F.ws + WS_ACT, F.in[I_B_GU]};
        pg8::gemm_phase<EpiAct, SchedMoe, true, true>(F.lds + RING_OFF, wsb, D / 2, D / 2, D / 2, S, E, (const int*)(F.ws + WS_LTOK)); } SEAM(11);
    if (IN(12)) for (int rep = 0; rep < REPS(12); ++rep) { moe_table(F, tb); SchedMoe S{F.G, (int)blockIdx.x, 4, tb, (unsigned)WS_ACT, (unsigned)WS_WDN_T, 1024u * 1024u, false}; EpiDown E{(bf16*)(F.ws + WS_YS), F.in[I_B_DOWN], (const float*)(F.ws + WS_LGATE)};
        pg8::gemm_phase<EpiDown, SchedMoe, false, true>(F.lds + RING_OFF, wsb, D / 2, D / 2, D / 2, S, E, nullptr); } SEAM(12);
    if (IN(13)) { moe_table(F, tb); final_phase(F, tb); }
#undef IN
#undef SEAM
}

extern "C" void kernel_launch(void* const* d_in, const int* in_sizes, int n_in, void* d_out, int out_size, void* d_ws, size_t ws_size, hipStream_t stream) {
    static int grid = 0;
    if (grid == 0) {
        if (n_in != N_IN || out_size != M * D || ws_size < WS_END) { fprintf(stderr, "kernel_launch: unexpected shapes (n_in %d, out %d, ws %zu)\n", n_in, out_size, ws_size); grid = -1; return; }
        int dev = 0, cus = 0, per_cu = 0;
        if (hipGetDevice(&dev) != hipSuccess || hipDeviceGetAttribute(&cus, hipDeviceAttributeMultiprocessorCount, dev) != hipSuccess) { grid = -1; return; }
        if (hipFuncSetAttribute((const void*)mk_fwd, hipFuncAttributeMaxDynamicSharedMemorySize, LDS_BYTES) != hipSuccess) { fprintf(stderr, "kernel_launch: hipFuncSetAttribute failed\n"); grid = -1; return; }
        if (hipOccupancyMaxActiveBlocksPerMultiprocessor(&per_cu, (const void*)mk_fwd, NWAVES * 64, LDS_BYTES) != hipSuccess || per_cu < 1) fprintf(stderr, "kernel_launch: occupancy query says %d\n", per_cu);
        (void)hipGetLastError();
        grid = cus;
    }
    if (grid < 0) return;
    if (hipMemsetAsync((char*)d_ws + WS_CTL, 0, CTL_ZERO_BYTES, stream) != hipSuccess) return;
    Args a{};
    for (int i = 0; i < N_IN; ++i) a.in[i] = (const float*)d_in[i];
    a.out = (float*)d_out; a.ws = (unsigned char*)d_ws;
    for (int li = 0; li < MK_N_LAUNCHES; ++li) {
        a.ph_lo = (MK_N_LAUNCHES == 1) ? 0 : li; a.ph_hi = (MK_N_LAUNCHES == 1) ? NPHASE : li + 1; a.li = (MK_N_LAUNCHES == 1) ? 0 : li;
        hipLaunchKernelGGL(mk_fwd, dim3(grid), dim3(NWAVES * 64), LDS_BYTES, stream, a);
        if (hipPeekAtLastError() != hipSuccess) { fprintf(stderr, "kernel_launch: launch %d failed\n", li); break; }
    }
}
```

```cpp
#include <hip/hip_runtime.h>
#include <cstdio>
#include <cstdint>

#ifndef MK_N_LAUNCHES
#define MK_N_LAUNCHES 1
#endif

#define GAS __attribute__((address_space(1)))
#define LAS __attribute__((address_space(3)))
typedef unsigned short bf16;
typedef short bf16x8 __attribute__((ext_vector_type(8)));
typedef float f32x4 __attribute__((ext_vector_type(4)));
typedef float f32x2 __attribute__((ext_vector_type(2)));
typedef unsigned u32x4 __attribute__((ext_vector_type(4)));
typedef unsigned u32x2 __attribute__((ext_vector_type(2)));
typedef GAS unsigned gu32;
#define RLX_AGENT __ATOMIC_RELAXED, __HIP_MEMORY_SCOPE_AGENT
#define LDS_WAIT() asm volatile("s_waitcnt lgkmcnt(0)" ::: "memory")
#define VM_WAIT() asm volatile("s_waitcnt vmcnt(0)" ::: "memory")

constexpr int NB = 8, T_ = 4096, D = 1024, M = NB * T_, NMEM = 256, MM = NB * NMEM;
constexpr int CONV_CH = 512, SBH = 8, SBD = 64, SBW = 512, CWID = 31, NE = 32, TOPK = 4, DFF = 1024;
constexpr int INC = 2560;
constexpr float LN_EPS = 1e-5f;
constexpr float DN_ALPHA = 1.189207115002721f;
constexpr float LOG2E = 1.4426950408889634f;
constexpr float SB_QSCALE = 0.125f * LOG2E;
constexpr float MEM_QSCALE = 0.0625f * LOG2E;
constexpr float WGU_SC = 32.0f, WDN_SC = 64.0f;
constexpr int NBLK_MAX = M * TOPK / 256 + NE;
constexpr int LCAP = M;

constexpr size_t MiB = 1u << 20;
constexpr size_t WS_CTL = 0, CTL_ZERO_BYTES = 1 * MiB;
constexpr size_t WS_WIN_T = 1 * MiB;
constexpr size_t WS_WOUT_T = 6 * MiB;
constexpr size_t WS_WQ_T = 8 * MiB, WS_WK_T = 10 * MiB, WS_WV_T = 12 * MiB, WS_WO_T = 14 * MiB;
constexpr size_t WS_WGU_T = 16 * MiB;
constexpr size_t WS_WDN_T = 144 * MiB;
constexpr size_t WS_HB8 = 176 * MiB;
constexpr size_t WS_HB = 208 * MiB;
constexpr size_t WS_LTOK = 272 * MiB;
constexpr size_t WS_LGATE = 276 * MiB;
constexpr size_t WS_SIDX = 280 * MiB;
constexpr size_t WS_X = 288 * MiB;
constexpr size_t WS_U = WS_X;
constexpr size_t WS_Q = WS_X + 32 * MiB;
constexpr size_t WS_K = WS_X + 64 * MiB;
constexpr size_t WS_V = WS_X + 96 * MiB;
constexpr size_t WS_MIXIN = WS_X + 128 * MiB;
constexpr size_t WS_QM = WS_X + 192 * MiB;
constexpr size_t WS_SP = WS_X + 256 * MiB;
constexpr size_t WS_OB = WS_X + 320 * MiB;
constexpr size_t WS_MEMN = WS_X + 384 * MiB;
constexpr size_t WS_KM = WS_X + 388 * MiB;
constexpr size_t WS_VMT = WS_X + 392 * MiB;
constexpr size_t WS_ACT = WS_X;
constexpr size_t WS_YS = WS_X + 272 * MiB;
constexpr size_t WS_END = WS_X + 544 * MiB;
constexpr int CW_TMO = 0, CW_CODE = 1;
constexpr int CW_BAR = 4096;
constexpr int CW_ECNT = 131072;
constexpr int NPHASE = 14;

constexpr int RING_OFF = 0, RING_BYTES = 131072;
constexpr int LDSCTL_OFF = RING_BYTES, MISC_OFF = LDSCTL_OFF + 320;
constexpr int XTRA_OFF = LDSCTL_OFF + 1024;
constexpr int LDS_BYTES = 147456;
constexpr int NWAVES = 8;

__device__ __forceinline__ unsigned f2bf(float f) { unsigned u = __builtin_bit_cast(unsigned, f); return (u + 0x7fffu + ((u >> 16) & 1u)) >> 16; }
__device__ __forceinline__ unsigned pk2(float lo, float hi) { return f2bf(lo) | (f2bf(hi) << 16); }
__device__ __forceinline__ float bflo(unsigned u) { return __builtin_bit_cast(float, u << 16); }
__device__ __forceinline__ float bfhi(unsigned u) { return __builtin_bit_cast(float, u & 0xffff0000u); }
__device__ __forceinline__ float wave_sum(float v) {
#pragma unroll
    for (int o = 1; o < 64; o <<= 1) v += __shfl_xor(v, o);
    return v;
}
__device__ __forceinline__ float wave_max(float v) {
#pragma unroll
    for (int o = 1; o < 64; o <<= 1) v = fmaxf(v, __shfl_xor(v, o));
    return v;
}
__device__ __forceinline__ unsigned pk4_fp8(float a, float b, float c, float d) {
    int r = __builtin_amdgcn_cvt_pk_fp8_f32(a, b, 0, false); r = __builtin_amdgcn_cvt_pk_fp8_f32(c, d, r, true); return (unsigned)r; }
__device__ __forceinline__ float sigmoidf_fast(float x) { return __builtin_amdgcn_rcpf(1.0f + __expf(-x)); }

namespace pg8 {
constexpr int BM = 256, BK = 64, HALF = 128, HTB = HALF * BK * 2, STAGE_BYTES = 8 * HTB, NXCD = 8, WGM = 8;
__host__ __device__ __forceinline__ int lds_byte(int r, int c) { const int st = (r >> 4) * 2 + (c >> 5), rr = r & 15, cc = c & 31, ob = rr * 64 + cc * 2; return st * 1024 + (ob ^ (((ob >> 9) & 1) << 5)); }
__host__ __device__ __forceinline__ void stage_rc(int b, int& R, int& C) { const int st = b / 1024, sb = b % 1024, swz = sb ^ (((sb >> 9) & 1) << 5); R = (st >> 1) * 16 + swz / 64; C = (st & 1) * 32 + (swz % 64) / 2; }
__host__ __device__ __forceinline__ int perm32(int rho) { const int n = rho >> 4, i = rho & 15; return 8 * (i >> 2) + 4 * n + (i & 3); }

struct Unit { int pm, pn, z, nvalid; unsigned aoff, boff, goff; };

__device__ __forceinline__ void tile_order(int L, int nM, int nN, int& pm, int& pn) {
    const int nwg = nM * nN; int wgid = L;
    { const int q = nwg / NXCD, r = nwg % NXCD, xcd = wgid % NXCD, off = wgid / NXCD; wgid = (xcd < r ? xcd * (q + 1) : r * (q + 1) + (xcd - r) * q) + off; }
    const int nig = WGM * nN, gid = wgid / nig, fm = gid * WGM, gsz = (nM - fm) < WGM ? (nM - fm) : WGM;
    pm = fm + ((wgid % nig) % gsz); pn = (wgid % nig) / gsz;
}
__device__ __forceinline__ unsigned cvt_pk_bf16(float lo, float hi) { unsigned r; asm volatile("v_cvt_pk_bf16_f32 %0, %1, %2" : "=v"(r) : "v"(lo), "v"(hi)); return r; }

__device__ __forceinline__ void store_tile_bf16(const f32x4 (&acc)[2][2][4][2], bf16* p0, size_t ldc, const float* bias, float scale, int wc, int fq) {
    const int cl = wc * 32 + 8 * fq;
    f32x4 bv[2][2];
#pragma unroll
    for (int bj = 0; bj < 2; ++bj)
#pragma unroll
        for (int n = 0; n < 2; ++n) bv[bj][n] = bias ? *(const f32x4*)(bias + cl + bj * HALF + 4 * n) : (f32x4){0.f, 0.f, 0.f, 0.f};
#pragma unroll
    for (int ai = 0; ai < 2; ++ai)
#pragma unroll
        for (int m = 0; m < 4; ++m) { bf16* rowp = p0 + (size_t)(ai * HALF + m * 16) * ldc + cl;
#pragma unroll
            for (int bj = 0; bj < 2; ++bj) { const f32x4 v0 = (acc[ai][bj][m][0] + bv[bj][0]) * scale, v1 = (acc[ai][bj][m][1] + bv[bj][1]) * scale;
                u32x4 w; w.x = cvt_pk_bf16(v0[0], v0[1]); w.y = cvt_pk_bf16(v0[2], v0[3]); w.z = cvt_pk_bf16(v1[0], v1[1]); w.w = cvt_pk_bf16(v1[2], v1[3]);
                *(u32x4*)(rowp + bj * HALF) = w; } }
}

typedef int v8i __attribute__((ext_vector_type(8)));
template <class Epi, class Sched, bool GATHER, bool FP8 = false>
__device__ __forceinline__ void gemm_phase(LAS unsigned char* lds, const char* wsb, const int lda, const int ldb, const int K, const Sched& S, const Epi& E, const int* glist) {
    const int tid = threadIdx.x, wid = __builtin_amdgcn_readfirstlane(tid >> 6), lane = tid & 63, wr = wid >> 2, wc = wid & 3, fr = lane & 15, fq = lane >> 4;
    const int nt = K / BK;
    unsigned voffA[2], voffB[2]; int Rr[2], Cc[2];
#pragma unroll
    for (int i = 0; i < 2; ++i) { int R, C; stage_rc(tid * 16 + i * 8192, R, C); const int Rb = Epi::PERM ? ((R & ~31) + perm32(R & 31)) : R;
        voffA[i] = (unsigned)(R * lda + C) * 2u; voffB[i] = (unsigned)(Rb * ldb + C) * 2u; Rr[i] = R; Cc[i] = C; }
    const size_t kstep = (size_t)(BK * 2);
    const size_t hstepA = (size_t)HALF * lda * 2, hstepB = (size_t)HALF * ldb * 2;
    const unsigned ldsw = (unsigned)wid * 1024u;
    const int aoff = lds_byte(wr * 64 + fr, fq * 8), boff = lds_byte(wc * 32 + fr, fq * 8);
    unsigned gc[2][2], gn[2][2];
#define PG8_SA(b, h) (((b) * 2 + (h)) * HTB)
#define PG8_SB(b, h) ((4 + (b) * 2 + (h)) * HTB)
#define PG8_STAGE_B(bufoff, gbase) do { _Pragma("unroll") for (int _i = 0; _i < 2; ++_i) \
        __builtin_amdgcn_global_load_lds((const unsigned*)((const char*)(gbase) + voffB[_i]), (LAS unsigned*)(lds + (bufoff) + ldsw + _i * 8192), 16, 0, 0); } while (0)
#define PG8_STAGE_A(bufoff, gbase, h, nx) do { _Pragma("unroll") for (int _i = 0; _i < 2; ++_i) { \
        const char* _p = GATHER ? (const char*)(gbase) + ((nx) ? gn[h][_i] : gc[h][_i]) : (const char*)(gbase) + (h) * hstepA + voffA[_i]; \
        __builtin_amdgcn_global_load_lds((const unsigned*)_p, (LAS unsigned*)(lds + (bufoff) + ldsw + _i * 8192), 16, 0, 0); } } while (0)
#define PG8_LDA(dst, b, h) do { _Pragma("unroll") for (int m = 0; m < 4; ++m) { if constexpr (FP8) { const u32x4 _lo = *(const LAS u32x4*)(lds + PG8_SA(b, h) + aoff + m * 2048), _hi = *(const LAS u32x4*)(lds + PG8_SA(b, h) + aoff + m * 2048 + 1024); \
            dst##8[m] = (v8i){(int)_lo.x, (int)_lo.y, (int)_lo.z, (int)_lo.w, (int)_hi.x, (int)_hi.y, (int)_hi.z, (int)_hi.w}; } \
        else { _Pragma("unroll") for (int k = 0; k < 2; ++k) dst[m][k] = *(const LAS bf16x8*)(lds + PG8_SA(b, h) + aoff + m * 2048 + k * 1024); } } } while (0)
#define PG8_LDB(dst, b, h) do { _Pragma("unroll") for (int n = 0; n < 2; ++n) { if constexpr (FP8) { const u32x4 _lo = *(const LAS u32x4*)(lds + PG8_SB(b, h) + boff + n * 2048), _hi = *(const LAS u32x4*)(lds + PG8_SB(b, h) + boff + n * 2048 + 1024); \
            dst##8[n] = (v8i){(int)_lo.x, (int)_lo.y, (int)_lo.z, (int)_lo.w, (int)_hi.x, (int)_hi.y, (int)_hi.z, (int)_hi.w}; } \
        else { _Pragma("unroll") for (int k = 0; k < 2; ++k) dst[n][k] = *(const LAS bf16x8*)(lds + PG8_SB(b, h) + boff + n * 2048 + k * 1024); } } } while (0)
#define PG8_MMA(ai, bj, At, Bt) do { __builtin_amdgcn_s_setprio(1); if constexpr (FP8) asm volatile("s_nop 1"); _Pragma("unroll") for (int m = 0; m < 4; ++m) _Pragma("unroll") for (int n = 0; n < 2; ++n) { \
        if constexpr (FP8) asm volatile("v_mfma_f32_16x16x128_f8f6f4 %0, %1, %2, %0" : "+v"(acc[ai][bj][m][n]) : "v"(Bt##8[n]), "v"(At##8[m])); \
        else { _Pragma("unroll") for (int k = 0; k < 2; ++k) acc[ai][bj][m][n] = __builtin_amdgcn_mfma_f32_16x16x32_bf16(Bt[n][k], At[m][k], acc[ai][bj][m][n], 0, 0, 0); } } \
        __builtin_amdgcn_s_setprio(0); } while (0)
#define PG8_WAIT_V(n) asm volatile("s_waitcnt vmcnt(" #n ")" ::: "memory")
#define PG8_WAIT_L(n) asm volatile("s_waitcnt lgkmcnt(" #n ")" ::: "memory")
#define PG8_BAR __builtin_amdgcn_s_barrier()
#define PG8_SCHED __builtin_amdgcn_sched_barrier(0)
#define PG8_GIDX(g, u) do { _Pragma("unroll") for (int _h = 0; _h < 2; ++_h) _Pragma("unroll") for (int _i = 0; _i < 2; ++_i) { const int _r = _h * HALF + Rr[_i]; \
        const int _tok = glist[(u).goff + (_r < (u).nvalid ? _r : (u).nvalid - 1)]; g[_h][_i] = (unsigned)_tok * (unsigned)(lda * 2) + (unsigned)(Cc[_i] * 2); } } while (0)
    Unit cur, nxt, nn; int ui = 0;
    if (!S.next(0, cur)) return;
    f32x4 acc[2][2][4][2];
#pragma unroll
    for (int a = 0; a < 2; ++a)
#pragma unroll
        for (int b = 0; b < 2; ++b)
#pragma unroll
            for (int m = 0; m < 4; ++m)
#pragma unroll
                for (int n = 0; n < 2; ++n) acc[a][b][m][n] = (f32x4){0.f, 0.f, 0.f, 0.f};
    bf16x8 At[4][2], B0[2][2], B1[2][2];
    v8i At8[4], B08[2], B18[2];
    const char* cA = wsb + cur.aoff; const char* cB = wsb + cur.boff;
    if constexpr (GATHER) { PG8_GIDX(gc, cur); if (S.next(1, nxt)) { PG8_GIDX(gn, nxt); } else { PG8_GIDX(gn, cur); }
        asm volatile("s_waitcnt vmcnt(0)" : "+v"(gc[0][0]), "+v"(gc[0][1]), "+v"(gc[1][0]), "+v"(gc[1][1]), "+v"(gn[0][0]), "+v"(gn[0][1]), "+v"(gn[1][0]), "+v"(gn[1][1]) :: "memory"); }
    else {
#pragma unroll
        for (int h = 0; h < 2; ++h)
#pragma unroll
            for (int i = 0; i < 2; ++i) { gc[h][i] = 0u; gn[h][i] = 0u; } }
    PG8_STAGE_B(PG8_SB(0, 0), cB); PG8_STAGE_B(PG8_SB(0, 1), cB + hstepB); PG8_STAGE_A(PG8_SA(0, 0), cA, 0, false); PG8_STAGE_A(PG8_SA(0, 1), cA, 1, false);
    if (wr == 1) PG8_BAR;
    PG8_WAIT_V(2); PG8_BAR;
    PG8_STAGE_B(PG8_SB(1, 0), cB + kstep); PG8_STAGE_A(PG8_SA(1, 0), cA + kstep, 0, false); PG8_STAGE_B(PG8_SB(1, 1), cB + hstepB + kstep);
    PG8_WAIT_V(6); PG8_BAR;
    for (;;) {
        const bool has_next = S.next(ui + 1, nxt);
        const char* nA = has_next ? wsb + nxt.aoff : cA; const char* nB = has_next ? wsb + nxt.boff : cB;
#pragma clang loop unroll(disable)
        for (int t = 0; t < nt; t += 2) {
            const bool last = (t == nt - 2);
            const char* a1 = cA + (size_t)(t + 1) * kstep;
            const char* a2 = last ? nA : cA + (size_t)(t + 2) * kstep; const char* b2 = last ? nB : cB + (size_t)(t + 2) * kstep;
            const char* a3 = a2 + kstep; const char* b3 = b2 + kstep;
            PG8_LDB(B0, 0, 0); PG8_LDB(B1, 0, 1); PG8_SCHED; PG8_LDA(At, 0, 0); PG8_STAGE_A(PG8_SA(1, 1), a1, 1, false);
            PG8_WAIT_V(8); PG8_WAIT_L(0); PG8_BAR; PG8_MMA(0, 0, At, B0); PG8_MMA(0, 1, At, B1); PG8_BAR; PG8_SCHED;
            PG8_LDA(At, 0, 1); PG8_STAGE_B(PG8_SB(0, 0), b2); PG8_STAGE_B(PG8_SB(0, 1), b2 + hstepB); PG8_STAGE_A(PG8_SA(0, 0), a2, 0, last);
            PG8_WAIT_V(8); PG8_WAIT_L(0); PG8_BAR; PG8_MMA(1, 0, At, B0); PG8_MMA(1, 1, At, B1); PG8_BAR; PG8_SCHED;
            PG8_LDB(B0, 1, 0); PG8_LDB(B1, 1, 1); PG8_SCHED; PG8_LDA(At, 1, 0); PG8_STAGE_A(PG8_SA(0, 1), a2, 1, last);
            PG8_WAIT_V(8); PG8_WAIT_L(0); PG8_BAR; PG8_MMA(0, 0, At, B0); PG8_MMA(0, 1, At, B1); PG8_BAR; PG8_SCHED;
            PG8_LDA(At, 1, 1); PG8_STAGE_B(PG8_SB(1, 0), b3); PG8_STAGE_B(PG8_SB(1, 1), b3 + hstepB); PG8_STAGE_A(PG8_SA(1, 0), a3, 0, last);
            PG8_WAIT_V(8); PG8_WAIT_L(0); PG8_BAR; PG8_MMA(1, 0, At, B0); PG8_MMA(1, 1, At, B1); PG8_BAR; PG8_SCHED;
        }
        if constexpr (FP8) asm volatile("s_nop 15\n\ts_nop 7");
        if (wr == 0) PG8_BAR;
        if constexpr (GATHER) {
#pragma unroll
            for (int h = 0; h < 2; ++h)
#pragma unroll
                for (int i = 0; i < 2; ++i) gc[h][i] = gn[h][i];
            if (has_next && S.next(ui + 2, nn)) { PG8_GIDX(gn, nn); }
        }
        E(acc, cur, wr, wc, fr, fq);
        if constexpr (GATHER) asm volatile("" : "+v"(gn[0][0]), "+v"(gn[0][1]), "+v"(gn[1][0]), "+v"(gn[1][1]));
        if (!has_next) break;
#pragma unroll
        for (int a = 0; a < 2; ++a)
#pragma unroll
            for (int b = 0; b < 2; ++b)
#pragma unroll
                for (int m = 0; m < 4; ++m)
#pragma unroll
                    for (int n = 0; n < 2; ++n) acc[a][b][m][n] = (f32x4){0.f, 0.f, 0.f, 0.f};
        cur = nxt; cA = nA; cB = nB; ++ui;
        if (wr == 1) PG8_BAR;
    }
    PG8_WAIT_V(0);
    PG8_BAR;
#undef PG8_SA
#undef PG8_SB
#undef PG8_STAGE_A
#undef PG8_STAGE_B
#undef PG8_LDA
#undef PG8_LDB
#undef PG8_MMA
#undef PG8_WAIT_V
#undef PG8_WAIT_L
#undef PG8_BAR
#undef PG8_SCHED
#undef PG8_GIDX
}
}
using pg8::Unit;

#define XB_TMO      128
#define XB_XCNT(j)  (256  + 64 * (j))
#define XB_XSUB(j)  (1280 + 64 * (j))
#define XB_XGEN(j)  (2304 + 64 * (j))
#define XB_TOP      3328
#define XB_TOPGEN   3392
#define XCD_BAR_WORDS 3456
#define XB_SPIN_CAP (1u << 18)
__device__ __forceinline__ unsigned xb_ld(unsigned* p)              { return __hip_atomic_load(p, __ATOMIC_RELAXED, __HIP_MEMORY_SCOPE_AGENT); }
__device__ __forceinline__ unsigned xb_add(unsigned* p, unsigned v) { return __hip_atomic_fetch_add(p, v, __ATOMIC_RELAXED, __HIP_MEMORY_SCOPE_AGENT); }
__device__ __forceinline__ unsigned xb_xcc_id() { return (unsigned)__builtin_amdgcn_s_getreg((3 << 11) | 20) & 0xFu; }
#define XB_SPIN(cond, bar) do { unsigned _sp = 0; while (cond) { __builtin_amdgcn_s_sleep(1); \
    if ((++_sp & 255u) == 0u) { if (xb_ld(&(bar)[XB_TMO])) break; if (_sp > XB_SPIN_CAP) { atomicAdd(&(bar)[XB_TMO], 1u); break; } } } } while (0)
struct XcdBarrier { unsigned* bar; unsigned x; volatile LAS unsigned* st; };
__device__ __forceinline__ XcdBarrier xcd_barrier_post(unsigned* bar, volatile LAS unsigned* st) {
    XcdBarrier b; b.bar = bar; b.x = xb_xcc_id(); b.st = st;
    if (threadIdx.x == 0) (void)xb_add(&bar[XB_XCNT(b.x)], 1u);
    return b;
}
__device__ __forceinline__ void xcd_barrier_complete(unsigned* bar, unsigned x, unsigned& nloc, unsigned& nx) {
    const unsigned G = gridDim.x * gridDim.y * gridDim.z;
    unsigned sum, cnt, mine, sp = 0u;
    for (;;) {
        sum = 0u; cnt = 0u; mine = 0u;
#pragma unroll
        for (unsigned j = 0; j < 16; ++j) { const unsigned c = xb_ld(&bar[XB_XCNT(j)]); sum += c; cnt += (c > 0u) ? 1u : 0u; mine = (j == x) ? c : mine; }
        if (sum == G) break;
        __builtin_amdgcn_s_sleep(1);
        if ((++sp & 255u) == 0u) { if (xb_ld(&bar[XB_TMO])) break; if (sp > XB_SPIN_CAP) { atomicAdd(&bar[XB_TMO], 1u); break; } }
    }
    nloc = mine > 0u ? mine : 1u; nx = cnt > 0u ? cnt : 1u;
}
__device__ __forceinline__ void xcd_barrier(const XcdBarrier& b) {
    asm volatile("s_waitcnt vmcnt(0)" ::: "memory");
    __syncthreads();
    if (threadIdx.x == 0) {
        unsigned* bar = b.bar;
        __builtin_amdgcn_s_waitcnt(0);
        unsigned nloc = b.st[0], nx = b.st[1];
        if (nloc == 0u) { xcd_barrier_complete(bar, b.x, nloc, nx); b.st[0] = nloc; b.st[1] = nx; }
        const unsigned old = xb_add(&bar[XB_XSUB(b.x)], 1u);
        const unsigned gen = old / nloc;
        if (old + 1u == (gen + 1u) * nloc) {
            __builtin_amdgcn_fence(__ATOMIC_RELEASE, "agent");
            asm volatile("s_waitcnt vmcnt(0)" ::: "memory");
            const unsigned og = xb_add(&bar[XB_TOP], 1u);
            const unsigned tg = og / nx;
            if (og + 1u == (tg + 1u) * nx) xb_add(&bar[XB_TOPGEN], 1u);
            else XB_SPIN(xb_ld(&bar[XB_TOPGEN]) == tg, bar);
            __builtin_amdgcn_fence(__ATOMIC_ACQUIRE, "agent");
            xb_add(&bar[XB_XGEN(b.x)], 1u);
            asm volatile("s_waitcnt vmcnt(0)" ::: "memory");
        } else {
            XB_SPIN(xb_ld(&bar[XB_XGEN(b.x)]) == gen, bar);
            __builtin_amdgcn_fence(__ATOMIC_ACQUIRE, "agent");
            asm volatile("s_waitcnt vmcnt(0)" ::: "memory");
        }
    }
    __syncthreads();
}

struct Frame {
    LAS unsigned char* lds;
    volatile LAS unsigned* MISC;
    gu32* ctl;
    unsigned char* ws;
    int tid, lane, wave, vcu, G;
    float* hf;
    const float* const* in;
};
enum In { I_X = 0, I_MEM, I_LN_IN_G, I_LN_IN_B, I_LN_MEM_G, I_LN_MEM_B, I_W_IN, I_B_IN, I_W_DW, I_B_DW, I_LN_CONV_G, I_LN_CONV_B, I_W_OUT, I_B_OUT, I_LN1_G, I_LN1_B,
          I_WQ, I_WK, I_WV, I_WO, I_LN2_G, I_LN2_B, I_W_ROUTER, I_B_ROUTER, I_W_GU, I_B_GU, I_W_DOWN, I_B_DOWN, I_LN3_G, I_LN3_B, N_IN };

__device__ __forceinline__ void p0_transpose_item(const float* W, int K, int N, bf16* WT, int k0, int n0, int drow, LAS float* scr, int lane) {
#pragma unroll 8
    for (int i = 0; i < 32; ++i) { const int kk = 2 * i + (lane >> 5); scr[kk * 33 + (lane & 31)] = W[(size_t)(k0 + kk) * N + n0 + (lane & 31)]; }
    LDS_WAIT(); asm volatile("" ::: "memory");
    const int c = lane & 7;
#pragma unroll
    for (int j = 0; j < 4; ++j) { const int n = (lane >> 3) + 8 * j; const LAS float* s = scr + (8 * c) * 33 + n;
        u32x4 o; o.x = pk2(s[0 * 33], s[1 * 33]); o.y = pk2(s[2 * 33], s[3 * 33]); o.z = pk2(s[4 * 33], s[5 * 33]); o.w = pk2(s[6 * 33], s[7 * 33]);
        *(GAS u32x4*)(WT + (size_t)(drow + n) * K + k0 + 8 * c) = o; }
    LDS_WAIT(); asm volatile("" ::: "memory");
}
__device__ __forceinline__ void ln_row(f32x4 (&v)[4], const float* g, const float* b, int lane) {
    float s = 0.f;
#pragma unroll
    for (int j = 0; j < 4; ++j) s += (v[j].x + v[j].y) + (v[j].z + v[j].w);
    const float mean = wave_sum(s) * (1.f / D); float s2 = 0.f;
#pragma unroll
    for (int j = 0; j < 4; ++j) { v[j] = v[j] - mean; s2 += (v[j].x * v[j].x + v[j].y * v[j].y) + (v[j].z * v[j].z + v[j].w * v[j].w); }
    const float rstd = 1.f / sqrtf(wave_sum(s2) * (1.f / D) + LN_EPS);
#pragma unroll
    for (int j = 0; j < 4; ++j) { const f32x4 gg = ((const GAS f32x4*)g)[lane + 64 * j], bb = ((const GAS f32x4*)b)[lane + 64 * j]; v[j] = v[j] * rstd * gg + bb; }
}
__device__ __forceinline__ void store_row_bf16(const f32x4 (&v)[4], bf16* orow, int lane) {
    GAS u32x2* o8 = (GAS u32x2*)orow + lane;
#pragma unroll
    for (int j = 0; j < 4; ++j) o8[64 * j] = (u32x2){pk2(v[j].x, v[j].y), pk2(v[j].z, v[j].w)};
}
__device__ __forceinline__ void p0_transpose_item8(const float* W, int K, int N, unsigned char* WT, int k0, int n0, int drow, float sc, LAS float* scr, int lane) {
#pragma unroll 8
    for (int i = 0; i < 32; ++i) { const int kk = 2 * i + (lane >> 5); scr[kk * 33 + (lane & 31)] = W[(size_t)(k0 + kk) * N + n0 + (lane & 31)]; }
    LDS_WAIT(); asm volatile("" ::: "memory");
    const int c = lane & 7;
#pragma unroll
    for (int j = 0; j < 4; ++j) { const int n = (lane >> 3) + 8 * j; const LAS float* s = scr + (8 * c) * 33 + n;
        u32x2 o; o.x = pk4_fp8(s[0 * 33] * sc, s[1 * 33] * sc, s[2 * 33] * sc, s[3 * 33] * sc); o.y = pk4_fp8(s[4 * 33] * sc, s[5 * 33] * sc, s[6 * 33] * sc, s[7 * 33] * sc);
        *(GAS u32x2*)(WT + (size_t)(drow + n) * K + k0 + 8 * c) = o; }
    LDS_WAIT(); asm volatile("" ::: "memory");
}
__device__ __forceinline__ void load_row_bf16(f32x4 (&v)[4], const bf16* xrow, int lane) {
    const GAS u32x2* xr = (const GAS u32x2*)xrow + lane;
#pragma unroll
    for (int j = 0; j < 4; ++j) { const u32x2 w = xr[64 * j]; v[j] = (f32x4){bflo(w.x), bfhi(w.x), bflo(w.y), bfhi(w.y)}; }
}
__device__ __forceinline__ void load_row_f32(f32x4 (&v)[4], const float* xrow, int lane) {
    const GAS f32x4* xr = (const GAS f32x4*)xrow + lane;
#pragma unroll
    for (int j = 0; j < 4; ++j) v[j] = xr[64 * j];
}
__device__ __forceinline__ void store_row_f32(const f32x4 (&v)[4], float* orow, int lane) {
    GAS f32x4* o = (GAS f32x4*)orow + lane;
#pragma unroll
    for (int j = 0; j < 4; ++j) o[64 * j] = v[j];
}

__device__ __forceinline__ void p0_prologue(Frame& F) {
    LAS float* scr = (LAS float*)(F.lds + RING_OFF + F.wave * 16384);
    const int gw = F.vcu * NWAVES + F.wave, NGW = F.G * NWAVES;
    constexpr int I_IN = 16 * 80, I_SQ = 16 * 32, I_GU = NE * 16 * 64, I_DN = NE * 16 * 32;
    constexpr int NITEMS = I_IN + 5 * I_SQ + I_GU + I_DN;
    for (int it = gw; it < NITEMS; it += NGW) {
        int r = it;
        if (r < I_IN) { const int kb = r / 80, nb = r % 80, n0 = 32 * nb; int drow;
            if (n0 < 512) drow = (n0 >> 7) * 256 + (n0 & 127); else if (n0 < 1024) drow = ((n0 - 512) >> 7) * 256 + 128 + (n0 & 127); else drow = n0;
            p0_transpose_item(F.in[I_W_IN], D, INC, (bf16*)(F.ws + WS_WIN_T), 64 * kb, n0, drow, scr, F.lane); continue; } r -= I_IN;
        if (r < 5 * I_SQ) { const int w = r / I_SQ, q = r % I_SQ, kb = q / 32, nb = q % 32;
            const float* src = F.in[w == 0 ? I_W_OUT : w == 1 ? I_WQ : w == 2 ? I_WK : w == 3 ? I_WV : I_WO];
            bf16* dst = (bf16*)(F.ws + (w == 0 ? WS_WOUT_T : w == 1 ? WS_WQ_T : w == 2 ? WS_WK_T : w == 3 ? WS_WV_T : WS_WO_T));
            p0_transpose_item(src, D, D, dst, 64 * kb, 32 * nb, 32 * nb, scr, F.lane); continue; } r -= 5 * I_SQ;
        if (r < I_GU) { const int e = r / (16 * 64), q = r % (16 * 64), kb = q / 64, nb = q % 64, n0 = 32 * nb;
            const int drow = (n0 < 1024) ? (n0 >> 7) * 256 + (n0 & 127) : ((n0 - 1024) >> 7) * 256 + 128 + (n0 & 127);
            p0_transpose_item8(F.in[I_W_GU] + (size_t)e * D * 2 * DFF, D, 2 * DFF, F.ws + WS_WGU_T + (size_t)e * 2 * DFF * D, 64 * kb, n0, drow, WGU_SC, scr, F.lane); continue; } r -= I_GU;
        { const int e = r / (16 * 32), q = r % (16 * 32), kb = q / 32, nb = q % 32;
            p0_transpose_item8(F.in[I_W_DOWN] + (size_t)e * DFF * D, DFF, D, F.ws + WS_WDN_T + (size_t)e * D * DFF, 64 * kb, 32 * nb, 32 * nb, WDN_SC, scr, F.lane); }
    }
    for (int m = gw; m < M + MM; m += NGW) {
        f32x4 v[4];
        if (m < M) { load_row_f32(v, F.in[I_X] + (size_t)m * D, F.lane); ln_row(v, F.in[I_LN_IN_G], F.in[I_LN_IN_B], F.lane);
            store_row_bf16(v, (bf16*)(F.ws + WS_HB) + (size_t)m * D, F.lane); }
        else { const int mm = m - M; load_row_f32(v, F.in[I_MEM] + (size_t)mm * D, F.lane); ln_row(v, F.in[I_LN_MEM_G], F.in[I_LN_MEM_B], F.lane);
            store_row_bf16(v, (bf16*)(F.ws + WS_MEMN) + (size_t)mm * D, F.lane); }
    }
}

constexpr unsigned TSTEP = 256u * 1024u * 2u;
struct SchedP1 { int G, c;
    __device__ __forceinline__ bool next(int i, Unit& u) const {
        const int L = i * G + c; if (L >= 1344) return false;
        u.nvalid = 256; u.goff = 0;
        if (L < 1024) { pg8::tile_order(L, 128, 8, u.pm, u.pn); u.z = 0; u.aoff = (unsigned)WS_HB + (unsigned)u.pm * TSTEP; u.boff = (unsigned)WS_WIN_T + (unsigned)u.pn * TSTEP; }
        else if (L < 1280) { const int j = L - 1024; u.pm = j & 1; u.pn = j >> 1; u.z = 3; u.aoff = (unsigned)WS_WIN_T + (unsigned)(8 + u.pm) * TSTEP; u.boff = (unsigned)WS_HB + (unsigned)u.pn * TSTEP; }
        else if (L < 1312) { const int j = L - 1280; u.pm = j & 7; u.pn = j >> 3; u.z = 1; u.aoff = (unsigned)WS_MEMN + (unsigned)u.pm * TSTEP; u.boff = (unsigned)WS_WK_T + (unsigned)u.pn * TSTEP; }
        else { const int j = L - 1312; u.pm = j & 3; u.pn = j >> 2; u.z = 2; u.aoff = (unsigned)WS_WV_T + (unsigned)u.pm * TSTEP; u.boff = (unsigned)WS_MEMN + (unsigned)u.pn * TSTEP; }
        return true; }
};
struct EpiP1 { static constexpr bool PERM = true;
    unsigned char* ws; const float* b_in;
    __device__ __forceinline__ void operator()(const f32x4 (&acc)[2][2][4][2], const Unit& u, int wr, int wc, int fr, int fq) const {
        const int row0 = u.pm * 256 + wr * 64 + fr;
        if (u.z == 0) {
            if (u.pn < 4) {
                const int ch = 128 * u.pn + wc * 32 + 8 * fq;
                f32x4 bv[2], bg[2];
#pragma unroll
                for (int n = 0; n < 2; ++n) { bv[n] = *(const f32x4*)(b_in + ch + 4 * n); bg[n] = *(const f32x4*)(b_in + 512 + ch + 4 * n); }
                bf16* U = (bf16*)(ws + WS_U);
#pragma unroll
                for (int ai = 0; ai < 2; ++ai)
#pragma unroll
                    for (int m = 0; m < 4; ++m) { f32x4 o[2];
#pragma unroll
                        for (int n = 0; n < 2; ++n) { const f32x4 a = acc[ai][0][m][n] + bv[n], g = acc[ai][1][m][n] + bg[n];
#pragma unroll
                            for (int j = 0; j < 4; ++j) o[n][j] = a[j] * sigmoidf_fast(g[j]); }
                        u32x4 w; w.x = pg8::cvt_pk_bf16(o[0][0], o[0][1]); w.y = pg8::cvt_pk_bf16(o[0][2], o[0][3]); w.z = pg8::cvt_pk_bf16(o[1][0], o[1][1]); w.w = pg8::cvt_pk_bf16(o[1][2], o[1][3]);
                        *(u32x4*)(U + (size_t)(row0 + ai * 128 + m * 16) * 512 + ch) = w; }
            } else {
                const int t = u.pn - 4, which = t >> 1, cb = (t & 1) * 256;
                bf16* dst = (bf16*)(ws + (which == 0 ? WS_Q : WS_K));
                pg8::store_tile_bf16(acc, dst + (size_t)row0 * 512 + cb, 512, b_in + 1024 + 256 * t, which == 0 ? SB_QSCALE : 1.0f, wc, fq);
            }
        } else if (u.z == 3) {
            const float* rb = b_in + 2048 + row0; bf16* p0 = (bf16*)(ws + WS_V) + (size_t)row0 * M + 256 * u.pn; const int cl = wc * 32 + 8 * fq;
#pragma unroll
            for (int ai = 0; ai < 2; ++ai)
#pragma unroll
                for (int m = 0; m < 4; ++m) { const float bv = rb[ai * 128 + m * 16]; bf16* rowp = p0 + (size_t)(ai * 128 + m * 16) * M + cl;
#pragma unroll
                    for (int bj = 0; bj < 2; ++bj) { const f32x4 v0 = acc[ai][bj][m][0] + bv, v1 = acc[ai][bj][m][1] + bv;
                        u32x4 w; w.x = pg8::cvt_pk_bf16(v0[0], v0[1]); w.y = pg8::cvt_pk_bf16(v0[2], v0[3]); w.z = pg8::cvt_pk_bf16(v1[0], v1[1]); w.w = pg8::cvt_pk_bf16(v1[2], v1[3]);
                        *(u32x4*)(rowp + bj * 128) = w; } }
        } else if (u.z == 1) pg8::store_tile_bf16(acc, (bf16*)(ws + WS_KM) + (size_t)row0 * 1024 + 256 * u.pn, 1024, nullptr, 1.0f, wc, fq);
        else pg8::store_tile_bf16(acc, (bf16*)(ws + WS_VMT) + (size_t)row0 * 2048 + 256 * u.pn, 2048, nullptr, 1.0f, wc, fq);
    }
};

struct SchedPlain { int G, c, nM, nN; unsigned abase, bbase, atile, btile, acol, bcol, bgrp;
    __device__ __forceinline__ bool next(int i, Unit& u) const {
        const int L = i * G + c; if (L >= nM * nN) return false;
        pg8::tile_order(L, nM, nN, u.pm, u.pn); u.z = 0; u.nvalid = 256; u.goff = 0;
        u.aoff = abase + (unsigned)u.pm * atile + (unsigned)u.pn * acol; u.boff = bbase + (unsigned)u.pn * btile + (unsigned)(u.pm >> 4) * bgrp + (unsigned)u.pn * bcol; return true; }
};
struct EpiBf16 { static constexpr bool PERM = true;
    bf16* O; int ldc; float scale; const float* bias;
    __device__ __forceinline__ void operator()(const f32x4 (&acc)[2][2][4][2], const Unit& u, int wr, int wc, int fr, int fq) const {
        pg8::store_tile_bf16(acc, O + (size_t)(u.pm * 256 + wr * 64 + fr) * ldc + 256 * u.pn, (size_t)ldc, bias ? bias + 256 * u.pn : nullptr, scale, wc, fq); }
};
struct SchedMoe { int G, c, nN; const LAS int* tb; unsigned abase, wbase, wexp;
    bool gather;
    __device__ __forceinline__ bool next(int i, Unit& u) const {
        const int nblk = __builtin_amdgcn_readfirstlane(tb[32]); const int L = i * G + c; if (L >= nblk * nN) return false;
        pg8::tile_order(L, nblk, nN, u.pm, u.pn);
        int e = 0; while (tb[e + 1] <= u.pm) ++e;
        e = __builtin_amdgcn_readfirstlane(e);
        const int j = u.pm - tb[e], rem = tb[64 + e] - 256 * j;
        u.z = e; u.nvalid = rem < 256 ? rem : 256; u.goff = (unsigned)(e * LCAP + 256 * j);
        u.aoff = gather ? abase : abase + (unsigned)u.pm * (TSTEP / 2);
        u.boff = wbase + (unsigned)e * wexp + (unsigned)u.pn * (TSTEP / 2); return true; }
};
struct EpiAct { static constexpr bool PERM = true;
    unsigned char* ACT; const float* b_gu;
    __device__ __forceinline__ void operator()(const f32x4 (&acc)[2][2][4][2], const Unit& u, int wr, int wc, int fr, int fq) const {
        const int row0 = u.pm * 256 + wr * 64 + fr, ch = 128 * u.pn + wc * 32 + 8 * fq;
        const float* bb = b_gu + (size_t)u.z * 2 * DFF;
        f32x4 bg[2], bu[2];
#pragma unroll
        for (int n = 0; n < 2; ++n) { bg[n] = *(const f32x4*)(bb + ch + 4 * n); bu[n] = *(const f32x4*)(bb + DFF + ch + 4 * n); }
#pragma unroll
        for (int ai = 0; ai < 2; ++ai)
#pragma unroll
            for (int m = 0; m < 4; ++m) { f32x4 o[2];
#pragma unroll
                for (int n = 0; n < 2; ++n) { const f32x4 g = acc[ai][0][m][n] * (1.0f / WGU_SC) + bg[n], uu = acc[ai][1][m][n] * (1.0f / WGU_SC) + bu[n];
#pragma unroll
                    for (int j = 0; j < 4; ++j) { const float g_ = fminf(g[j], 7.0f), u_ = fminf(fmaxf(uu[j], -7.0f), 7.0f); o[n][j] = (u_ + 1.0f) * g_ * sigmoidf_fast(1.702f * g_); } }
                *(u32x2*)(ACT + (size_t)(row0 + ai * 128 + m * 16) * DFF + ch) = (u32x2){pk4_fp8(o[0][0], o[0][1], o[0][2], o[0][3]), pk4_fp8(o[1][0], o[1][1], o[1][2], o[1][3])}; }
    }
};
struct EpiDown { static constexpr bool PERM = true;
    bf16* YS; const float* b_down; const float* lgate;
    __device__ __forceinline__ void operator()(const f32x4 (&acc)[2][2][4][2], const Unit& u, int wr, int wc, int fr, int fq) const {
        const int r0 = wr * 64 + fr, cl = wc * 32 + 8 * fq;
        const float* bb = b_down + (size_t)u.z * D + 256 * u.pn + cl;
        f32x4 bv[2][2];
#pragma unroll
        for (int bj = 0; bj < 2; ++bj)
#pragma unroll
            for (int n = 0; n < 2; ++n) bv[bj][n] = *(const f32x4*)(bb + bj * 128 + 4 * n);
        float gts[2][4];
#pragma unroll
        for (int ai = 0; ai < 2; ++ai)
#pragma unroll
            for (int m = 0; m < 4; ++m) { const int r = r0 + ai * 128 + m * 16; gts[ai][m] = lgate[u.goff + (r < u.nvalid ? r : u.nvalid - 1)]; }
#pragma unroll
        for (int ai = 0; ai < 2; ++ai)
#pragma unroll
            for (int m = 0; m < 4; ++m) { const int r = r0 + ai * 128 + m * 16; const float gt = (r < u.nvalid) ? gts[ai][m] : 0.f;
                bf16* rowp = YS + (size_t)(u.pm * 256 + r) * D + 256 * u.pn + cl;
#pragma unroll
                for (int bj = 0; bj < 2; ++bj) { const f32x4 v0 = (acc[ai][bj][m][0] * (1.0f / WDN_SC) + bv[bj][0]) * gt, v1 = (acc[ai][bj][m][1] * (1.0f / WDN_SC) + bv[bj][1]) * gt;
                    u32x4 w; w.x = pg8::cvt_pk_bf16(v0[0], v0[1]); w.y = pg8::cvt_pk_bf16(v0[2], v0[3]); w.z = pg8::cvt_pk_bf16(v1[0], v1[1]); w.w = pg8::cvt_pk_bf16(v1[2], v1[3]);
                    *(u32x4*)(rowp + bj * 128) = w; } }
    }
};
__device__ __forceinline__ void moe_table(Frame& F, LAS int* tb) {
    if (F.tid < 32) { int c = (int)__hip_atomic_load(F.ctl + CW_ECNT + 64 * F.tid, RLX_AGENT); if (c > LCAP) c = LCAP; tb[64 + F.tid] = c; }
    LDS_WAIT(); __syncthreads();
    if (F.tid == 0) { int s = 0; for (int e = 0; e < NE; ++e) { tb[e] = s; s += (tb[64 + e] + 255) >> 8; } tb[32] = s; }
    LDS_WAIT(); __syncthreads();
}

__device__ __forceinline__ void conv_phase(Frame& F) {
    LAS unsigned* ut = (LAS unsigned*)(F.lds + RING_OFF);
    LAS float* co = (LAS float*)(F.lds + RING_OFF + 65536);
    const int cp = F.tid & 255, half = F.tid >> 8;
    float w0[CWID], w1[CWID];
    { const float* wd = F.in[I_W_DW] + 2 * cp;
#pragma unroll
        for (int j = 0; j < CWID; ++j) { const f32x2 w = *(const GAS f32x2*)(wd + j * CONV_CH); w0[j] = w.x; w1[j] = w.y; } }
    const f32x2 bd = *(const GAS f32x2*)(F.in[I_B_DW] + 2 * cp);
    const f32x4 g0 = *(const GAS f32x4*)(F.in[I_LN_CONV_G] + 8 * F.lane), g1 = *(const GAS f32x4*)(F.in[I_LN_CONV_G] + 8 * F.lane + 4);
    const f32x4 b0 = *(const GAS f32x4*)(F.in[I_LN_CONV_B] + 8 * F.lane), b1 = *(const GAS f32x4*)(F.in[I_LN_CONV_B] + 8 * F.lane + 4);
    bf16* MX = (bf16*)(F.ws + WS_MIXIN);
    for (int it = F.vcu; it < NB * (T_ / 32); it += F.G) {
        const int b = it / (T_ / 32), t0 = (it % (T_ / 32)) * 32;
        const bf16* U = (const bf16*)(F.ws + WS_U) + (size_t)b * T_ * CONV_CH;
        for (int idx = F.tid; idx < 62 * 64; idx += 512) { const int r = idx >> 6, c16 = idx & 63, t = t0 - 30 + r;
            u32x4 v = (u32x4){0u, 0u, 0u, 0u}; if (t >= 0) v = *(const GAS u32x4*)(U + (size_t)t * CONV_CH + c16 * 8);
            *(LAS u32x4*)(ut + r * 256 + c16 * 4) = v; }
        LDS_WAIT(); __syncthreads();
        { float a0[16], a1[16];
#pragma unroll
            for (int tt = 0; tt < 16; ++tt) { a0[tt] = bd.x; a1[tt] = bd.y; }
#pragma unroll
            for (int r = 0; r < 46; ++r) { const unsigned uu = ut[(half * 16 + r) * 256 + cp]; const float u0 = bflo(uu), u1 = bfhi(uu);
#pragma unroll
                for (int tt = 0; tt < 16; ++tt) { const int j = r - tt; if (j >= 0 && j < CWID) { a0[tt] += w0[j] * u0; a1[tt] += w1[j] * u1; } } }
#pragma unroll
            for (int tt = 0; tt < 16; ++tt) *(LAS f32x2*)(co + (half * 16 + tt) * CONV_CH + 2 * cp) = (f32x2){a0[tt], a1[tt]};
        }
        LDS_WAIT(); __syncthreads();
#pragma unroll
        for (int q = 0; q < 4; ++q) { const int tt = 4 * F.wave + q;
            f32x4 x0 = *(const LAS f32x4*)(co + tt * CONV_CH + 8 * F.lane), x1 = *(const LAS f32x4*)(co + tt * CONV_CH + 8 * F.lane + 4);
            const float mean = wave_sum((x0.x + x0.y) + (x0.z + x0.w) + (x1.x + x1.y) + (x1.z + x1.w)) * (1.f / CONV_CH);
            x0 = x0 - mean; x1 = x1 - mean;
            const float var = wave_sum((x0.x * x0.x + x0.y * x0.y) + (x0.z * x0.z + x0.w * x0.w) + (x1.x * x1.x + x1.y * x1.y) + (x1.z * x1.z + x1.w * x1.w)) * (1.f / CONV_CH);
            const float rstd = 1.f / sqrtf(var + LN_EPS);
            x0 = x0 * rstd * g0 + b0; x1 = x1 * rstd * g1 + b1;
            float y[8] = {x0.x, x0.y, x0.z, x0.w, x1.x, x1.y, x1.z, x1.w};
#pragma unroll
            for (int j = 0; j < 8; ++j) y[j] = y[j] * sigmoidf_fast(y[j]);
            *(GAS u32x4*)(MX + (size_t)(b * T_ + t0 + tt) * D + 8 * F.lane) = (u32x4){pk2(y[0], y[1]), pk2(y[2], y[3]), pk2(y[4], y[5]), pk2(y[6], y[7])}; }
        __syncthreads();
    }
}

typedef float f32x16 __attribute__((ext_vector_type(16)));
__device__ __forceinline__ int crow(int r, int hi) { return (r & 3) + 8 * (r >> 2) + 4 * hi; }
__device__ __forceinline__ bf16x8 pack8(const float* v) {
    u32x4 w; w.x = pg8::cvt_pk_bf16(v[0], v[1]); w.y = pg8::cvt_pk_bf16(v[2], v[3]); w.z = pg8::cvt_pk_bf16(v[4], v[5]); w.w = pg8::cvt_pk_bf16(v[6], v[7]);
    return __builtin_bit_cast(bf16x8, w); }
constexpr float SB_EXIT = 150.0f;
struct SbStage { u32x4 k[4], v[4]; };
__device__ __forceinline__ void sb_gload(SbStage& g, const bf16* Kt, const bf16* Vt, int lane) {
#pragma unroll
    for (int i = 0; i < 4; ++i) { const int c = (lane & 7) ^ ((4 * i + (lane >> 4)) & 7); g.k[i] = *(const GAS u32x4*)(Kt + (size_t)(8 * i) * SBW + 8 * c); }
#pragma unroll
    for (int i = 0; i < 4; ++i) g.v[i] = *(const GAS u32x4*)(Vt + (size_t)(16 * i) * M);
}
__device__ __forceinline__ void sb_lwrite(const SbStage& g, LAS unsigned char* buf, int lane) {
#pragma unroll
    for (int i = 0; i < 4; ++i) *(LAS u32x4*)(buf + 1024 * i + 16 * lane) = g.k[i];
#pragma unroll
    for (int i = 0; i < 4; ++i) *(LAS u32x4*)(buf + 4096 + 1024 * i + 16 * lane) = g.v[i];
}
__device__ __forceinline__ void sb_attn_wave(Frame& F, int b, int h, int qt) {
    const int c = F.lane & 31, hi = F.lane >> 5;
    const bf16* Q = (const bf16*)(F.ws + WS_Q); const bf16* Kb = (const bf16*)(F.ws + WS_K); const bf16* VT = (const bf16*)(F.ws + WS_V);
    LAS unsigned char* wbuf = F.lds + RING_OFF + F.wave * 16384;
    bf16x8 tri[2];
#pragma unroll
    for (int s = 0; s < 2; ++s) { bf16x8 t;
#pragma unroll
        for (int j = 0; j < 8; ++j) { const int k = 16 * s + 8 * (j >> 2) + 4 * hi + (j & 3); t[j] = (k >= c) ? (short)0xBF80 : (short)0; }
        tri[s] = t; }
    bf16x8 qf[4];
    { const bf16* qp = Q + ((size_t)b * T_ + 32 * qt + c) * SBW + h * SBD + 8 * hi;
#pragma unroll
        for (int s = 0; s < 4; ++s) qf[s] = *(const GAS bf16x8*)(qp + 16 * s); }
    const bf16* Ksrc = Kb + ((size_t)b * T_ + (F.lane >> 3)) * SBW + h * SBD;
    const bf16* Vsrc = VT + (size_t)(h * SBD + (F.lane >> 2)) * M + (size_t)b * T_ + 8 * ((F.lane & 3) ^ ((F.lane >> 4) & 3));

    const int ksw = (c >> 1) & 7, vsw = (c >> 2) & 3;

    f32x16 o0, o1;
#pragma unroll
    for (int r = 0; r < 16; ++r) { o0[r] = 0.f; o1[r] = 0.f; }
    float carry = 0.f;
    SbStage st;
    sb_gload(st, Ksrc + (size_t)(32 * qt) * SBW, Vsrc + 32 * qt, F.lane); sb_lwrite(st, wbuf, F.lane);
    for (int kt = qt; kt >= 0; --kt) {
        LAS unsigned char* buf = wbuf + ((qt - kt) & 1) * 8192;
        if (kt > 0) sb_gload(st, Ksrc + (size_t)(32 * (kt - 1)) * SBW, Vsrc + 32 * (kt - 1), F.lane);
        const bool diag = (kt == qt);
        bf16x8 kf[4];
#pragma unroll
        for (int s = 0; s < 4; ++s) kf[s] = *(const LAS bf16x8*)(buf + c * 128 + 16 * ((2 * s + hi) ^ ksw));
        f32x16 p;
#pragma unroll
        for (int r = 0; r < 16; ++r) p[r] = 0.f;
#pragma unroll
        for (int s = 0; s < 4; ++s) p = __builtin_amdgcn_mfma_f32_32x32x16_bf16(kf[s], qf[s], p, 0, 0, 0);
        u32x2 vv[2][2][2];
#pragma unroll
        for (int dt = 0; dt < 2; ++dt)
#pragma unroll
            for (int s = 0; s < 2; ++s)
#pragma unroll
                for (int q = 0; q < 2; ++q) vv[dt][s][q] = *(const LAS u32x2*)(buf + 4096 + (32 * dt + c) * 64 + 16 * ((2 * s + q) ^ vsw) + 8 * hi);
        float L[16];
#pragma unroll
        for (int r = 0; r < 16; ++r) { const float y = p[r]; float l = __builtin_amdgcn_logf(1.0f + __builtin_amdgcn_exp2f(y)); l = (y > 64.f) ? y : l;
            if (diag) l = (crow(r, hi) >= c) ? 0.f : l; L[r] = l; }
        const bf16x8 l0 = pack8(L), l1 = pack8(L + 8);
        f32x16 a;
#pragma unroll
        for (int r = 0; r < 16; ++r) a[r] = p[r] - carry;
        a = __builtin_amdgcn_mfma_f32_32x32x16_bf16(tri[0], l0, a, 0, 0, 0); a = __builtin_amdgcn_mfma_f32_32x32x16_bf16(tri[1], l1, a, 0, 0, 0);
        const float tot = p[0] - a[0];
        float w[16];
#pragma unroll
        for (int r = 0; r < 16; ++r) { float x = __builtin_amdgcn_exp2f(a[r]); if (diag) x = (crow(r, hi) >= c) ? 0.f : x; w[r] = x; }
        const bf16x8 p0 = pack8(w), p1 = pack8(w + 8);
        { const bf16x8 v00 = __builtin_bit_cast(bf16x8, (u32x4){vv[0][0][0].x, vv[0][0][0].y, vv[0][0][1].x, vv[0][0][1].y});
          const bf16x8 v01 = __builtin_bit_cast(bf16x8, (u32x4){vv[0][1][0].x, vv[0][1][0].y, vv[0][1][1].x, vv[0][1][1].y});
          const bf16x8 v10 = __builtin_bit_cast(bf16x8, (u32x4){vv[1][0][0].x, vv[1][0][0].y, vv[1][0][1].x, vv[1][0][1].y});
          const bf16x8 v11 = __builtin_bit_cast(bf16x8, (u32x4){vv[1][1][0].x, vv[1][1][0].y, vv[1][1][1].x, vv[1][1][1].y});
          o0 = __builtin_amdgcn_mfma_f32_32x32x16_bf16(v00, p0, o0, 0, 0, 0); o0 = __builtin_amdgcn_mfma_f32_32x32x16_bf16(v01, p1, o0, 0, 0, 0);
          o1 = __builtin_amdgcn_mfma_f32_32x32x16_bf16(v10, p0, o1, 0, 0, 0); o1 = __builtin_amdgcn_mfma_f32_32x32x16_bf16(v11, p1, o1, 0, 0, 0); }
        carry = __shfl(tot, c);
        if (__all(carry >= SB_EXIT)) break;
        if (kt > 0) sb_lwrite(st, wbuf + ((qt - kt + 1) & 1) * 8192, F.lane);
    }
    bf16* op = (bf16*)(F.ws + WS_MIXIN) + ((size_t)b * T_ + 32 * qt + c) * D + CONV_CH + h * SBD + 4 * hi;
#pragma unroll
    for (int g = 0; g < 4; ++g) {
        *(GAS u32x2*)(op + 8 * g) = (u32x2){pg8::cvt_pk_bf16(o0[4 * g], o0[4 * g + 1]), pg8::cvt_pk_bf16(o0[4 * g + 2], o0[4 * g + 3])};
        *(GAS u32x2*)(op + 32 + 8 * g) = (u32x2){pg8::cvt_pk_bf16(o1[4 * g], o1[4 * g + 1]), pg8::cvt_pk_bf16(o1[4 * g + 2], o1[4 * g + 3])}; }
}

__device__ __forceinline__ void resid_row(f32x4 (&v)[4], const bf16* hrow, const bf16* mrow, int lane) {
    f32x4 a[4]; load_row_bf16(v, hrow, lane); load_row_bf16(a, mrow, lane);
#pragma unroll
    for (int j = 0; j < 4; ++j) v[j] = v[j] * DN_ALPHA + a[j];
}
__device__ __forceinline__ void ln_phase(Frame& F, const float* g, const float* b) {
    const int gw = F.vcu * NWAVES + F.wave, NGW = F.G * NWAVES;
    for (int m = gw; m < M; m += NGW) { f32x4 v[4]; bf16* hrow = (bf16*)(F.ws + WS_HB) + (size_t)m * D; resid_row(v, hrow, (const bf16*)(F.ws + WS_QM) + (size_t)m * D, F.lane);
        ln_row(v, g, b, F.lane); store_row_bf16(v, hrow, F.lane); }
}
__device__ __forceinline__ void softmax_phase(Frame& F) {
    const int gw = F.vcu * NWAVES + F.wave, NGW = F.G * NWAVES;
    for (int m = gw; m < M; m += NGW) { GAS u32x2* p = (GAS u32x2*)((bf16*)(F.ws + WS_SP) + (size_t)m * D) + F.lane;
#pragma unroll
        for (int j = 0; j < 4; ++j) { const u32x2 w = p[64 * j]; float x0 = bflo(w.x), x1 = bfhi(w.x), x2 = bflo(w.y), x3 = bfhi(w.y);
            const float mx = wave_max(fmaxf(fmaxf(x0, x1), fmaxf(x2, x3)));
            x0 = __builtin_amdgcn_exp2f(x0 - mx); x1 = __builtin_amdgcn_exp2f(x1 - mx); x2 = __builtin_amdgcn_exp2f(x2 - mx); x3 = __builtin_amdgcn_exp2f(x3 - mx);
            const float inv = 1.0f / wave_sum((x0 + x1) + (x2 + x3));
            p[64 * j] = (u32x2){pk2(x0 * inv, x1 * inv), pk2(x2 * inv, x3 * inv)}; } }
}
__device__ __forceinline__ void ln2_router_phase(Frame& F) {
    LAS float* wT = (LAS float*)(F.lds + RING_OFF);
    LAS int* lcnt = (LAS int*)(F.lds + XTRA_OFF);
    LAS int* rec = (LAS int*)(F.lds + XTRA_OFF + 512);
    const float* wr_ = F.in[I_W_ROUTER];
    for (int idx = F.tid; idx < D * NE; idx += 512) { const int c = idx >> 5, e = idx & 31; wT[e * D + c] = wr_[idx]; }
    if (F.tid < 64) lcnt[F.tid] = 0;
    LDS_WAIT(); __syncthreads();
    const int gw = F.vcu * NWAVES + F.wave, NGW = F.G * NWAVES;
    const float brt = F.in[I_B_ROUTER][F.lane >> 1];
    int it = 0;
    for (int m = gw; m < M; m += NGW, ++it) {
        f32x4 v[4]; bf16* hrow = (bf16*)(F.ws + WS_HB) + (size_t)m * D; resid_row(v, hrow, (const bf16*)(F.ws + WS_QM) + (size_t)m * D, F.lane);
        ln_row(v, F.in[I_LN2_G], F.in[I_LN2_B], F.lane); store_row_bf16(v, hrow, F.lane);
        { GAS unsigned* h8 = (GAS unsigned*)(F.ws + WS_HB8 + (size_t)m * D) + F.lane;
#pragma unroll
            for (int j = 0; j < 4; ++j) h8[64 * j] = pk4_fp8(v[j].x, v[j].y, v[j].z, v[j].w); }
        float ra[NE];
#pragma unroll
        for (int e = 0; e < NE; ++e) { float p = 0.f;
#pragma unroll
            for (int j = 0; j < 4; ++j) { const f32x4 w = *(const LAS f32x4*)(wT + e * D + 256 * j + 4 * F.lane); p += (v[j].x * w.x + v[j].y * w.y) + (v[j].z * w.z + v[j].w * w.w); }
            ra[e] = p; }
#pragma unroll
        for (int i = 0; i < 16; ++i) { const bool up = (F.lane & 32) != 0; const float keep = up ? ra[16 + i] : ra[i], send = up ? ra[i] : ra[16 + i]; ra[i] = keep + __shfl_xor(send, 32); }
#pragma unroll
        for (int i = 0; i < 8; ++i) { const bool up = (F.lane & 16) != 0; const float keep = up ? ra[8 + i] : ra[i], send = up ? ra[i] : ra[8 + i]; ra[i] = keep + __shfl_xor(send, 16); }
#pragma unroll
        for (int i = 0; i < 4; ++i) { const bool up = (F.lane & 8) != 0; const float keep = up ? ra[4 + i] : ra[i], send = up ? ra[i] : ra[4 + i]; ra[i] = keep + __shfl_xor(send, 8); }
#pragma unroll
        for (int i = 0; i < 2; ++i) { const bool up = (F.lane & 4) != 0; const float keep = up ? ra[2 + i] : ra[i], send = up ? ra[i] : ra[2 + i]; ra[i] = keep + __shfl_xor(send, 4); }
        { const bool up = (F.lane & 2) != 0; const float keep = up ? ra[1] : ra[0], send = up ? ra[0] : ra[1]; ra[0] = keep + __shfl_xor(send, 2); }
        ra[0] += __shfl_xor(ra[0], 1);
        float logit = (F.lane & 1) ? -INFINITY : ra[0] + brt;
        float tv[TOPK]; int te[TOPK];
#pragma unroll
        for (int k = 0; k < TOPK; ++k) { const float mx = wave_max(logit); const unsigned long long bal = __ballot(logit == mx); const int ln = __builtin_ctzll(bal);
            tv[k] = mx; te[k] = ln >> 1; if (F.lane == ln) logit = -INFINITY; }
        float pe[TOPK], ps = 0.f;
#pragma unroll
        for (int k = 0; k < TOPK; ++k) { pe[k] = __expf(tv[k] - tv[0]); ps += pe[k]; }
        if (F.lane < TOPK) { const int k = F.lane; const int e = k == 0 ? te[0] : k == 1 ? te[1] : k == 2 ? te[2] : te[3]; const float g = (k == 0 ? pe[0] : k == 1 ? pe[1] : k == 2 ? pe[2] : pe[3]) / ps;
            const int lr = __hip_atomic_fetch_add(lcnt + e, 1, __ATOMIC_RELAXED, __HIP_MEMORY_SCOPE_WORKGROUP);
            LAS int* r = rec + ((F.wave * 16 + (it & 15)) * 4 + k) * 4; r[0] = e; r[1] = lr; r[2] = __builtin_bit_cast(int, g); r[3] = m; }
    }
    LDS_WAIT(); __syncthreads();
    if (F.tid < NE) lcnt[32 + F.tid] = (int)__hip_atomic_fetch_add(F.ctl + CW_ECNT + 64 * F.tid, (unsigned)lcnt[F.tid], RLX_AGENT);
    LDS_WAIT(); __syncthreads();
    int* ltok = (int*)(F.ws + WS_LTOK); float* lgate = (float*)(F.ws + WS_LGATE); int* sidx = (int*)(F.ws + WS_SIDX);
    const int nrec = it * 4;
    for (int i = F.lane; i < nrec; i += 64) { const LAS int* r = rec + (F.wave * 64 + i) * 4; const int e = r[0], pos = lcnt[32 + e] + r[1], tok = r[3];
        if (pos < LCAP) { ltok[e * LCAP + pos] = tok; lgate[e * LCAP + pos] = __builtin_bit_cast(float, r[2]); } sidx[tok * 4 + (i & 3)] = e * LCAP + pos; }
    __syncthreads();
}
__device__ __forceinline__ void final_phase(Frame& F, const LAS int* tb) {
    const int gw = F.vcu * NWAVES + F.wave, NGW = F.G * NWAVES;
    const int* sidx = (const int*)(F.ws + WS_SIDX); const bf16* YS = (const bf16*)(F.ws + WS_YS);
    for (int m = gw; m < M; m += NGW) { f32x4 v[4]; load_row_bf16(v, (const bf16*)(F.ws + WS_HB) + (size_t)m * D, F.lane);
#pragma unroll
        for (int j = 0; j < 4; ++j) v[j] = v[j] * DN_ALPHA;
        f32x4 s[4];
#pragma unroll
        for (int j = 0; j < 4; ++j) s[j] = (f32x4){0.f, 0.f, 0.f, 0.f};
#pragma unroll
        for (int k = 0; k < TOPK; ++k) { const int si = sidx[m * 4 + k], e = si / LCAP, pos = si - e * LCAP; const size_t slot = (size_t)tb[e] * 256 + pos;
            const GAS u32x2* yp = (const GAS u32x2*)(YS + slot * D) + F.lane;
#pragma unroll
            for (int j = 0; j < 4; ++j) { const u32x2 w = yp[64 * j]; s[j] = s[j] + (f32x4){bflo(w.x), bfhi(w.x), bflo(w.y), bfhi(w.y)}; } }
#pragma unroll
        for (int j = 0; j < 4; ++j) v[j] = v[j] + s[j];
        ln_row(v, F.in[I_LN3_G], F.in[I_LN3_B], F.lane); store_row_f32(v, F.hf + (size_t)m * D, F.lane); }
}

struct Args { const float* in[N_IN]; float* out; unsigned char* ws; int ph_lo, ph_hi, li, pad; };
__global__ void __launch_bounds__(NWAVES * 64, 2) mk_fwd(Args args) {
    extern __shared__ __attribute__((aligned(16))) unsigned char lds[];
    Frame F;
    F.lds = (LAS unsigned char*)lds; F.MISC = (volatile LAS unsigned*)(F.lds + MISC_OFF);
    F.tid = threadIdx.x; F.lane = F.tid & 63; F.wave = __builtin_amdgcn_readfirstlane(F.tid >> 6);
    F.G = gridDim.x; { const int bx = blockIdx.x; F.vcu = (F.G % 8 == 0) ? (bx % 8) * (F.G / 8) + bx / 8 : bx; }
    F.ws = args.ws; F.ctl = (gu32*)(args.ws + WS_CTL); F.hf = args.out; F.in = args.in;
    for (int u = F.tid; u < (LDS_BYTES - LDSCTL_OFF) / 4; u += NWAVES * 64) ((LAS unsigned*)(F.lds + LDSCTL_OFF))[u] = 0u;
    __syncthreads();
    XcdBarrier bar; bar.bar = (unsigned*)(F.ctl + CW_BAR) + args.li * XCD_BAR_WORDS; bar.x = 0; bar.st = nullptr;
    const int lo = args.ph_lo, hi = args.ph_hi;
    if (hi - lo > 1) bar = xcd_barrier_post((unsigned*)(F.ctl + CW_BAR) + args.li * XCD_BAR_WORDS, F.MISC + 8);
#ifndef PH_MASK
#define PH_MASK 0x3fff
#endif
#define IN(k) (((PH_MASK >> (k)) & 1) && lo <= (k) && (k) < hi)
#ifndef REP_MASK
#define REP_MASK 0
#endif
#define REPS(k) (1 + ((REP_MASK >> (k)) & 1))
#define SEAM(k) do { if (IN(k) && IN((k) + 1)) xcd_barrier(bar); } while (0)
    const char* wsb = (const char*)args.ws;
    LAS int* tb = (LAS int*)(F.lds + XTRA_OFF + 9216);

    if (IN(0)) for (int rep = 0; rep < REPS(0); ++rep) { p0_prologue(F); __syncthreads(); } SEAM(0);
    if (IN(1)) for (int rep = 0; rep < REPS(1); ++rep) { SchedP1 S{F.G, (int)blockIdx.x}; EpiP1 E{F.ws, F.in[I_B_IN]};
        pg8::gemm_phase<EpiP1, SchedP1, false>(F.lds + RING_OFF, wsb, D, D, D, S, E, nullptr); } SEAM(1);
    if (IN(2)) for (int rep = 0; rep < REPS(2); ++rep) {
        conv_phase(F);
        const int gw = F.vcu * NWAVES + F.wave;
        for (int tk = gw; tk < NB * SBH * (T_ / 32); tk += F.G * NWAVES) sb_attn_wave(F, (tk >> 7) >> 3, (tk >> 7) & 7, tk & 127);
    } SEAM(2);
    if (IN(3)) { SchedPlain S{F.G, (int)blockIdx.x, 128, 4, (unsigned)WS_MIXIN, (unsigned)WS_WOUT_T, TSTEP, TSTEP, 0u, 0u, 0u}; EpiBf16 E{(bf16*)(F.ws + WS_QM), D, 1.0f, F.in[I_B_OUT]};
        pg8::gemm_phase<EpiBf16, SchedPlain, false>(F.lds + RING_OFF, wsb, D, D, D, S, E, nullptr); } SEAM(3);
    if (IN(4)) { ln_phase(F, F.in[I_LN1_G], F.in[I_LN1_B]); } SEAM(4);
    if (IN(5)) { SchedPlain S{F.G, (int)blockIdx.x, 128, 4, (unsigned)WS_HB, (unsigned)WS_WQ_T, TSTEP, TSTEP, 0u, 0u, 0u}; EpiBf16 E{(bf16*)(F.ws + WS_QM), D, MEM_QSCALE, nullptr};
        pg8::gemm_phase<EpiBf16, SchedPlain, false>(F.lds + RING_OFF, wsb, D, D, D, S, E, nullptr); } SEAM(5);
    if (IN(6)) {
        SchedPlain S{F.G, (int)blockIdx.x, 128, 4, (unsigned)WS_QM, (unsigned)WS_KM, TSTEP, 0u, 512u, 512u, TSTEP}; EpiBf16 E{(bf16*)(F.ws + WS_SP), D, 1.0f, nullptr};
        pg8::gemm_phase<EpiBf16, SchedPlain, false>(F.lds + RING_OFF, wsb, D, D, 256, S, E, nullptr); } SEAM(6);
    if (IN(7)) { softmax_phase(F); } SEAM(7);
    if (IN(8)) {
        SchedPlain S{F.G, (int)blockIdx.x, 128, 4, (unsigned)WS_SP, (unsigned)WS_VMT, TSTEP, 256u * 2048u * 2u, 512u, 0u, 512u}; EpiBf16 E{(bf16*)(F.ws + WS_OB), D, 1.0f, nullptr};
        pg8::gemm_phase<EpiBf16, SchedPlain, false>(F.lds + RING_OFF, wsb, D, 2048, 256, S, E, nullptr); } SEAM(8);
    if (IN(9)) { SchedPlain S{F.G, (int)blockIdx.x, 128, 4, (unsigned)WS_OB, (unsigned)WS_WO_T, TSTEP, TSTEP, 0u, 0u, 0u}; EpiBf16 E{(bf16*)(F.ws + WS_QM), D, 1.0f, nullptr};
        pg8::gemm_phase<EpiBf16, SchedPlain, false>(F.lds + RING_OFF, wsb, D, D, D, S, E, nullptr); } SEAM(9);
    if (IN(10)) { ln2_router_phase(F); } SEAM(10);
    if (IN(11)) for (int rep = 0; rep < REPS(11); ++rep) { moe_table(F, tb); SchedMoe S{F.G, (int)blockIdx.x, 8, tb, (unsigned)WS_HB8, (unsigned)WS_WGU_T, 2048u * 1024u, true}; EpiAct E{F.ws + WS_ACT, F.in[I_B_GU]};
        pg8::gemm_phase<EpiAct, SchedMoe, true, true>(F.lds + RING_OFF, wsb, D / 2, D / 2, D / 2, S, E, (const int*)(F.ws + WS_LTOK)); } SEAM(11);
    if (IN(12)) for (int rep = 0; rep < REPS(12); ++rep) { moe_table(F, tb); SchedMoe S{F.G, (int)blockIdx.x, 4, tb, (unsigned)WS_ACT, (unsigned)WS_WDN_T, 1024u * 1024u, false}; EpiDown E{(bf16*)(F.ws + WS_YS), F.in[I_B_DOWN], (const float*)(F.ws + WS_LGATE)};
        pg8::gemm_phase<EpiDown, SchedMoe, false, true>(F.lds + RING_OFF, wsb, D / 2, D / 2, D / 2, S, E, nullptr); } SEAM(12);
    if (IN(13)) { moe_table(F, tb); final_phase(F, tb); }
#undef IN
#undef SEAM
}

extern "C" void kernel_launch(void* const* d_in, const int* in_sizes, int n_in, void* d_out, int out_size, void* d_ws, size_t ws_size, hipStream_t stream) {
    static int grid = 0;
    if (grid == 0) {
        if (n_in != N_IN || out_size != M * D || ws_size < WS_END) { fprintf(stderr, "kernel_launch: unexpected shapes (n_in %d, out %d, ws %zu)\n", n_in, out_size, ws_size); grid = -1; return; }
        int dev = 0, cus = 0, per_cu = 0;
        if (hipGetDevice(&dev) != hipSuccess || hipDeviceGetAttribute(&cus, hipDeviceAttributeMultiprocessorCount, dev) != hipSuccess) { grid = -1; return; }
        if (hipFuncSetAttribute((const void*)mk_fwd, hipFuncAttributeMaxDynamicSharedMemorySize, LDS_BYTES) != hipSuccess) { fprintf(stderr, "kernel_launch: hipFuncSetAttribute failed\n"); grid = -1; return; }
        if (hipOccupancyMaxActiveBlocksPerMultiprocessor(&per_cu, (const void*)mk_fwd, NWAVES * 64, LDS_BYTES) != hipSuccess || per_cu < 1) fprintf(stderr, "kernel_launch: occupancy query says %d\n", per_cu);
        (void)hipGetLastError();
        grid = cus;
    }
    if (grid < 0) return;
    if (hipMemsetAsync((char*)d_ws + WS_CTL, 0, CTL_ZERO_BYTES, stream) != hipSuccess) return;
    Args a{};
    for (int i = 0; i < N_IN; ++i) a.in[i] = (const float*)d_in[i];
    a.out = (float*)d_out; a.ws = (unsigned char*)d_ws;
    for (int li = 0; li < MK_N_LAUNCHES; ++li) {
        a.ph_lo = (MK_N_LAUNCHES == 1) ? 0 : li; a.ph_hi = (MK_N_LAUNCHES == 1) ? NPHASE : li + 1; a.li = (MK_N_LAUNCHES == 1) ? 0 : li;
        hipLaunchKernelGGL(mk_fwd, dim3(grid), dim3(NWAVES * 64), LDS_BYTES, stream, a);
        if (hipPeekAtLastError() != hipSuccess) { fprintf(stderr, "kernel_launch: launch %d failed\n", li); break; }
    }
}
```

```cpp
#include <hip/hip_runtime.h>
#include <cstdio>
#include <cstdint>

#ifndef MK_N_LAUNCHES
#define MK_N_LAUNCHES 1
#endif

#define GAS __attribute__((address_space(1)))
#define LAS __attribute__((address_space(3)))
typedef unsigned short bf16;
typedef short bf16x8 __attribute__((ext_vector_type(8)));
typedef float f32x4 __attribute__((ext_vector_type(4)));
typedef float f32x2 __attribute__((ext_vector_type(2)));
typedef unsigned u32x4 __attribute__((ext_vector_type(4)));
typedef unsigned u32x2 __attribute__((ext_vector_type(2)));
typedef GAS unsigned gu32;
#define RLX_AGENT __ATOMIC_RELAXED, __HIP_MEMORY_SCOPE_AGENT
#define LDS_WAIT() asm volatile("s_waitcnt lgkmcnt(0)" ::: "memory")
#define VM_WAIT() asm volatile("s_waitcnt vmcnt(0)" ::: "memory")

constexpr int NB = 8, T_ = 4096, D = 1024, M = NB * T_, NMEM = 256, MM = NB * NMEM;
constexpr int CONV_CH = 512, SBH = 8, SBD = 64, SBW = 512, CWID = 31, NE = 32, TOPK = 4, DFF = 1024;
constexpr int INC = 2560;
constexpr float LN_EPS = 1e-5f;
constexpr float DN_ALPHA = 1.189207115002721f;
constexpr float LOG2E = 1.4426950408889634f;
constexpr float SB_QSCALE = 0.125f * LOG2E;
constexpr float MEM_QSCALE = 0.0625f * LOG2E;
constexpr float WGU_SC = 32.0f, WDN_SC = 64.0f;
constexpr int NBLK_MAX = M * TOPK / 256 + NE;
constexpr int LCAP = M;

constexpr size_t MiB = 1u << 20;
constexpr size_t WS_CTL = 0, CTL_ZERO_BYTES = 1 * MiB;
constexpr size_t WS_WIN_T = 1 * MiB;
constexpr size_t WS_WOUT_T = 6 * MiB;
constexpr size_t WS_WQ_T = 8 * MiB, WS_WK_T = 10 * MiB, WS_WV_T = 12 * MiB, WS_WO_T = 14 * MiB;
constexpr size_t WS_WGU_T = 16 * MiB;
constexpr size_t WS_WDN_T = 144 * MiB;
constexpr size_t WS_HB8 = 176 * MiB;
constexpr size_t WS_HB = 208 * MiB;
constexpr size_t WS_LTOK = 272 * MiB;
constexpr size_t WS_LGATE = 276 * MiB;
constexpr size_t WS_SIDX = 280 * MiB;
constexpr size_t WS_X = 288 * MiB;
constexpr size_t WS_U = WS_X;
constexpr size_t WS_Q = WS_X + 32 * MiB;
constexpr size_t WS_K = WS_X + 64 * MiB;
constexpr size_t WS_V = WS_X + 96 * MiB;
constexpr size_t WS_MIXIN = WS_X + 128 * MiB;
constexpr size_t WS_QM = WS_X + 192 * MiB;
constexpr size_t WS_SP = WS_X + 256 * MiB;
constexpr size_t WS_OB = WS_X + 320 * MiB;
constexpr size_t WS_MEMN = WS_X + 384 * MiB;
constexpr size_t WS_KM = WS_X + 388 * MiB;
constexpr size_t WS_VMT = WS_X + 392 * MiB;
constexpr size_t WS_ACT = WS_X;
constexpr size_t WS_YS = WS_X + 272 * MiB;
constexpr size_t WS_END = WS_X + 544 * MiB;
constexpr int CW_TMO = 0, CW_CODE = 1;
constexpr int CW_BAR = 4096;
constexpr int CW_ECNT = 131072;
constexpr int NPHASE = 14;

constexpr int RING_OFF = 0, RING_BYTES = 131072;
constexpr int LDSCTL_OFF = RING_BYTES, MISC_OFF = LDSCTL_OFF + 320;
constexpr int XTRA_OFF = LDSCTL_OFF + 1024;
constexpr int LDS_BYTES = 147456;
constexpr int NWAVES = 8;

__device__ __forceinline__ unsigned f2bf(float f) { unsigned u = __builtin_bit_cast(unsigned, f); return (u + 0x7fffu + ((u >> 16) & 1u)) >> 16; }
__device__ __forceinline__ unsigned pk2(float lo, float hi) { return f2bf(lo) | (f2bf(hi) << 16); }
__device__ __forceinline__ float bflo(unsigned u) { return __builtin_bit_cast(float, u << 16); }
__device__ __forceinline__ float bfhi(unsigned u) { return __builtin_bit_cast(float, u & 0xffff0000u); }
__device__ __forceinline__ float wave_sum(float v) {
#pragma unroll
    for (int o = 1; o < 64; o <<= 1) v += __shfl_xor(v, o);
    return v;
}
__device__ __forceinline__ float wave_max(float v) {
#pragma unroll
    for (int o = 1; o < 64; o <<= 1) v = fmaxf(v, __shfl_xor(v, o));
    return v;
}
__device__ __forceinline__ unsigned pk4_fp8(float a, float b, float c, float d) {
    int r = __builtin_amdgcn_cvt_pk_fp8_f32(a, b, 0, false); r = __builtin_amdgcn_cvt_pk_fp8_f32(c, d, r, true); return (unsigned)r; }
__device__ __forceinline__ float sigmoidf_fast(float x) { return __builtin_amdgcn_rcpf(1.0f + __expf(-x)); }

namespace pg8 {
constexpr int BM = 256, BK = 64, HALF = 128, HTB = HALF * BK * 2, STAGE_BYTES = 8 * HTB, NXCD = 8, WGM = 8;
__host__ __device__ __forceinline__ int lds_byte(int r, int c) { const int st = (r >> 4) * 2 + (c >> 5), rr = r & 15, cc = c & 31, ob = rr * 64 + cc * 2; return st * 1024 + (ob ^ (((ob >> 9) & 1) << 5)); }
__host__ __device__ __forceinline__ void stage_rc(int b, int& R, int& C) { const int st = b / 1024, sb = b % 1024, swz = sb ^ (((sb >> 9) & 1) << 5); R = (st >> 1) * 16 + swz / 64; C = (st & 1) * 32 + (swz % 64) / 2; }
__host__ __device__ __forceinline__ int perm32(int rho) { const int n = rho >> 4, i = rho & 15; return 8 * (i >> 2) + 4 * n + (i & 3); }

struct Unit { int pm, pn, z, nvalid; unsigned aoff, boff, goff; };

__device__ __forceinline__ void tile_order(int L, int nM, int nN, int& pm, int& pn) {
    const int nwg = nM * nN; int wgid = L;
    { const int q = nwg / NXCD, r = nwg % NXCD, xcd = wgid % NXCD, off = wgid / NXCD; wgid = (xcd < r ? xcd * (q + 1) : r * (q + 1) + (xcd - r) * q) + off; }
    const int nig = WGM * nN, gid = wgid / nig, fm = gid * WGM, gsz = (nM - fm) < WGM ? (nM - fm) : WGM;
    pm = fm + ((wgid % nig) % gsz); pn = (wgid % nig) / gsz;
}
__device__ __forceinline__ unsigned cvt_pk_bf16(float lo, float hi) { unsigned r; asm volatile("v_cvt_pk_bf16_f32 %0, %1, %2" : "=v"(r) : "v"(lo), "v"(hi)); return r; }

__device__ __forceinline__ void store_tile_bf16(const f32x4 (&acc)[2][2][4][2], bf16* p0, size_t ldc, const float* bias, float scale, int wc, int fq) {
    const int cl = wc * 32 + 8 * fq;
    f32x4 bv[2][2];
#pragma unroll
    for (int bj = 0; bj < 2; ++bj)
#pragma unroll
        for (int n = 0; n < 2; ++n) bv[bj][n] = bias ? *(const f32x4*)(bias + cl + bj * HALF + 4 * n) : (f32x4){0.f, 0.f, 0.f, 0.f};
#pragma unroll
    for (int ai = 0; ai < 2; ++ai)
#pragma unroll
        for (int m = 0; m < 4; ++m) { bf16* rowp = p0 + (size_t)(ai * HALF + m * 16) * ldc + cl;
#pragma unroll
            for (int bj = 0; bj < 2; ++bj) { const f32x4 v0 = (acc[ai][bj][m][0] + bv[bj][0]) * scale, v1 = (acc[ai][bj][m][1] + bv[bj][1]) * scale;
                u32x4 w; w.x = cvt_pk_bf16(v0[0], v0[1]); w.y = cvt_pk_bf16(v0[2], v0[3]); w.z = cvt_pk_bf16(v1[0], v1[1]); w.w = cvt_pk_bf16(v1[2], v1[3]);
                *(u32x4*)(rowp + bj * HALF) = w; } }
}

typedef int v8i __attribute__((ext_vector_type(8)));
template <class Epi, class Sched, bool GATHER, bool FP8 = false>
__device__ __forceinline__ void gemm_phase(LAS unsigned char* lds, const char* wsb, const int lda, const int ldb, const int K, const Sched& S, const Epi& E, const int* glist) {
    int tid = threadIdx.x; asm volatile("" : "+v"(tid));
    const int wid = __builtin_amdgcn_readfirstlane(tid >> 6), lane = tid & 63, wr = wid >> 2, wc = wid & 3, fr = lane & 15, fq = lane >> 4;
    const int nt = K / BK;
    unsigned voffA[2], voffB[2];
#pragma unroll
    for (int i = 0; i < 2; ++i) { int R, C; stage_rc(tid * 16 + i * 8192, R, C); const int Rb = Epi::PERM ? ((R & ~31) + perm32(R & 31)) : R;
        voffA[i] = (unsigned)(R * lda + C) * 2u; voffB[i] = (unsigned)(Rb * ldb + C) * 2u; }
    const size_t kstep = (size_t)(BK * 2);
    const size_t hstepA = (size_t)HALF * lda * 2, hstepB = (size_t)HALF * ldb * 2;
    const unsigned ldsw = (unsigned)wid * 1024u;
    const int aoff = lds_byte(wr * 64 + fr, fq * 8), boff = lds_byte(wc * 32 + fr, fq * 8);
    unsigned gc[2][2], gn[2][2];
#define PG8_SA(b, h) (((b) * 2 + (h)) * HTB)
#define PG8_SB(b, h) ((4 + (b) * 2 + (h)) * HTB)
#define PG8_STAGE_B(bufoff, gbase) do { _Pragma("unroll") for (int _i = 0; _i < 2; ++_i) \
        __builtin_amdgcn_global_load_lds((const unsigned*)((const char*)(gbase) + voffB[_i]), (LAS unsigned*)(lds + (bufoff) + ldsw + _i * 8192), 16, 0, 0); } while (0)
#define PG8_STAGE_A(bufoff, gbase, h, nx) do { _Pragma("unroll") for (int _i = 0; _i < 2; ++_i) { \
        const char* _p = GATHER ? (const char*)(gbase) + ((nx) ? gn[h][_i] : gc[h][_i]) : (const char*)(gbase) + (h) * hstepA + voffA[_i]; \
        __builtin_amdgcn_global_load_lds((const unsigned*)_p, (LAS unsigned*)(lds + (bufoff) + ldsw + _i * 8192), 16, 0, 0); } } while (0)
#define PG8_LDA(dst, b, h) do { _Pragma("unroll") for (int m = 0; m < 4; ++m) { if constexpr (FP8) { const u32x4 _lo = *(const LAS u32x4*)(lds + PG8_SA(b, h) + aoff + m * 2048), _hi = *(const LAS u32x4*)(lds + PG8_SA(b, h) + aoff + m * 2048 + 1024); \
            dst##8[m] = (v8i){(int)_lo.x, (int)_lo.y, (int)_lo.z, (int)_lo.w, (int)_hi.x, (int)_hi.y, (int)_hi.z, (int)_hi.w}; } \
        else { _Pragma("unroll") for (int k = 0; k < 2; ++k) dst[m][k] = *(const LAS bf16x8*)(lds + PG8_SA(b, h) + aoff + m * 2048 + k * 1024); } } } while (0)
#define PG8_LDB(dst, b, h) do { _Pragma("unroll") for (int n = 0; n < 2; ++n) { if constexpr (FP8) { const u32x4 _lo = *(const LAS u32x4*)(lds + PG8_SB(b, h) + boff + n * 2048), _hi = *(const LAS u32x4*)(lds + PG8_SB(b, h) + boff + n * 2048 + 1024); \
            dst##8[n] = (v8i){(int)_lo.x, (int)_lo.y, (int)_lo.z, (int)_lo.w, (int)_hi.x, (int)_hi.y, (int)_hi.z, (int)_hi.w}; } \
        else { _Pragma("unroll") for (int k = 0; k < 2; ++k) dst[n][k] = *(const LAS bf16x8*)(lds + PG8_SB(b, h) + boff + n * 2048 + k * 1024); } } } while (0)
#define PG8_MMA(ai, bj, At, Bt) do { __builtin_amdgcn_s_setprio(1); if constexpr (FP8) asm volatile("s_nop 1"); _Pragma("unroll") for (int m = 0; m < 4; ++m) _Pragma("unroll") for (int n = 0; n < 2; ++n) { \
        if constexpr (FP8) asm volatile("v_mfma_f32_16x16x128_f8f6f4 %0, %1, %2, %0" : "+v"(acc[ai][bj][m][n]) : "v"(Bt##8[n]), "v"(At##8[m])); \
        else { _Pragma("unroll") for (int k = 0; k < 2; ++k) acc[ai][bj][m][n] = __builtin_amdgcn_mfma_f32_16x16x32_bf16(Bt[n][k], At[m][k], acc[ai][bj][m][n], 0, 0, 0); } } \
        __builtin_amdgcn_s_setprio(0); } while (0)
#define PG8_WAIT_V(n) asm volatile("s_waitcnt vmcnt(" #n ")" ::: "memory")
#define PG8_WAIT_L(n) asm volatile("s_waitcnt lgkmcnt(" #n ")" ::: "memory")
#define PG8_BAR __builtin_amdgcn_s_barrier()
#define PG8_SCHED __builtin_amdgcn_sched_barrier(0)
#define PG8_GIDX(g, u) do { _Pragma("unroll") for (int _h = 0; _h < 2; ++_h) _Pragma("unroll") for (int _i = 0; _i < 2; ++_i) { int _R, _C; stage_rc(tid * 16 + _i * 8192, _R, _C); const int _r = _h * HALF + _R; \
        const int _tok = glist[(u).goff + (_r < (u).nvalid ? _r : (u).nvalid - 1)]; g[_h][_i] = (unsigned)_tok * (unsigned)(lda * 2) + (unsigned)(_C * 2); } } while (0)
    Unit cur, nxt, nn; int ui = 0;
    if (!S.next(0, cur)) return;
    f32x4 acc[2][2][4][2];
#pragma unroll
    for (int a = 0; a < 2; ++a)
#pragma unroll
        for (int b = 0; b < 2; ++b)
#pragma unroll
            for (int m = 0; m < 4; ++m)
#pragma unroll
                for (int n = 0; n < 2; ++n) acc[a][b][m][n] = (f32x4){0.f, 0.f, 0.f, 0.f};
    bf16x8 At[4][2], B0[2][2], B1[2][2];
    v8i At8[4], B08[2], B18[2];
    const char* cA = wsb + cur.aoff; const char* cB = wsb + cur.boff;
    if constexpr (GATHER) { PG8_GIDX(gc, cur); if (S.next(1, nxt)) { PG8_GIDX(gn, nxt); } else { PG8_GIDX(gn, cur); }
        asm volatile("s_waitcnt vmcnt(0)" : "+v"(gc[0][0]), "+v"(gc[0][1]), "+v"(gc[1][0]), "+v"(gc[1][1]), "+v"(gn[0][0]), "+v"(gn[0][1]), "+v"(gn[1][0]), "+v"(gn[1][1]) :: "memory"); }
    else {
#pragma unroll
        for (int h = 0; h < 2; ++h)
#pragma unroll
            for (int i = 0; i < 2; ++i) { gc[h][i] = 0u; gn[h][i] = 0u; } }
    PG8_STAGE_B(PG8_SB(0, 0), cB); PG8_STAGE_B(PG8_SB(0, 1), cB + hstepB); PG8_STAGE_A(PG8_SA(0, 0), cA, 0, false); PG8_STAGE_A(PG8_SA(0, 1), cA, 1, false);
    if (wr == 1) PG8_BAR;
    PG8_WAIT_V(2); PG8_BAR;
    PG8_STAGE_B(PG8_SB(1, 0), cB + kstep); PG8_STAGE_A(PG8_SA(1, 0), cA + kstep, 0, false); PG8_STAGE_B(PG8_SB(1, 1), cB + hstepB + kstep);
    PG8_WAIT_V(6); PG8_BAR;
    for (;;) {
        const bool has_next = S.next(ui + 1, nxt);
        const char* nA = has_next ? wsb + nxt.aoff : cA; const char* nB = has_next ? wsb + nxt.boff : cB;
#pragma clang loop unroll(disable)
        for (int t = 0; t < nt; t += 2) {
            const bool last = (t == nt - 2);
            const char* a1 = cA + (size_t)(t + 1) * kstep;
            const char* a2 = last ? nA : cA + (size_t)(t + 2) * kstep; const char* b2 = last ? nB : cB + (size_t)(t + 2) * kstep;
            const char* a3 = a2 + kstep; const char* b3 = b2 + kstep;
            PG8_LDB(B0, 0, 0); PG8_LDB(B1, 0, 1); PG8_SCHED; PG8_LDA(At, 0, 0); PG8_STAGE_A(PG8_SA(1, 1), a1, 1, false);
            PG8_WAIT_V(8); PG8_WAIT_L(0); PG8_BAR; PG8_MMA(0, 0, At, B0); PG8_MMA(0, 1, At, B1); PG8_BAR; PG8_SCHED;
            PG8_LDA(At, 0, 1); PG8_STAGE_B(PG8_SB(0, 0), b2); PG8_STAGE_B(PG8_SB(0, 1), b2 + hstepB); PG8_STAGE_A(PG8_SA(0, 0), a2, 0, last);
            PG8_WAIT_V(8); PG8_WAIT_L(0); PG8_BAR; PG8_MMA(1, 0, At, B0); PG8_MMA(1, 1, At, B1); PG8_BAR; PG8_SCHED;
            PG8_LDB(B0, 1, 0); PG8_LDB(B1, 1, 1); PG8_SCHED; PG8_LDA(At, 1, 0); PG8_STAGE_A(PG8_SA(0, 1), a2, 1, last);
            PG8_WAIT_V(8); PG8_WAIT_L(0); PG8_BAR; PG8_MMA(0, 0, At, B0); PG8_MMA(0, 1, At, B1); PG8_BAR; PG8_SCHED;
            PG8_LDA(At, 1, 1); PG8_STAGE_B(PG8_SB(1, 0), b3); PG8_STAGE_B(PG8_SB(1, 1), b3 + hstepB); PG8_STAGE_A(PG8_SA(1, 0), a3, 0, last);
            PG8_WAIT_V(8); PG8_WAIT_L(0); PG8_BAR; PG8_MMA(1, 0, At, B0); PG8_MMA(1, 1, At, B1); PG8_BAR; PG8_SCHED;
        }
        if constexpr (FP8) asm volatile("s_nop 15\n\ts_nop 7");
        if (wr == 0) PG8_BAR;
        if constexpr (GATHER) {
#pragma unroll
            for (int h = 0; h < 2; ++h)
#pragma unroll
                for (int i = 0; i < 2; ++i) gc[h][i] = gn[h][i];
            if (has_next && S.next(ui + 2, nn)) { PG8_GIDX(gn, nn); }
        }
        E(acc, cur, wr, wc, fr, fq);
        if constexpr (GATHER) asm volatile("" : "+v"(gn[0][0]), "+v"(gn[0][1]), "+v"(gn[1][0]), "+v"(gn[1][1]));
        if (!has_next) break;
#pragma unroll
        for (int a = 0; a < 2; ++a)
#pragma unroll
            for (int b = 0; b < 2; ++b)
#pragma unroll
                for (int m = 0; m < 4; ++m)
#pragma unroll
                    for (int n = 0; n < 2; ++n) acc[a][b][m][n] = (f32x4){0.f, 0.f, 0.f, 0.f};
        cur = nxt; cA = nA; cB = nB; ++ui;
        if (wr == 1) PG8_BAR;
    }
    PG8_WAIT_V(0);
    PG8_BAR;
#undef PG8_SA
#undef PG8_SB
#undef PG8_STAGE_A
#undef PG8_STAGE_B
#undef PG8_LDA
#undef PG8_LDB
#undef PG8_MMA
#undef PG8_WAIT_V
#undef PG8_WAIT_L
#undef PG8_BAR
#undef PG8_SCHED
#undef PG8_GIDX
}
}
using pg8::Unit;

#define XB_TMO      128
#define XB_XCNT(j)  (256  + 64 * (j))
#define XB_XSUB(j)  (1280 + 64 * (j))
#define XB_XGEN(j)  (2304 + 64 * (j))
#define XB_TOP      3328
#define XB_TOPGEN   3392
#define XCD_BAR_WORDS 3456
#define XB_SPIN_CAP (1u << 18)
__device__ __forceinline__ unsigned xb_ld(unsigned* p)              { return __hip_atomic_load(p, __ATOMIC_RELAXED, __HIP_MEMORY_SCOPE_AGENT); }
__device__ __forceinline__ unsigned xb_add(unsigned* p, unsigned v) { return __hip_atomic_fetch_add(p, v, __ATOMIC_RELAXED, __HIP_MEMORY_SCOPE_AGENT); }
__device__ __forceinline__ unsigned xb_xcc_id() { return (unsigned)__builtin_amdgcn_s_getreg((3 << 11) | 20) & 0xFu; }
#define XB_SPIN(cond, bar) do { unsigned _sp = 0; while (cond) { __builtin_amdgcn_s_sleep(1); \
    if ((++_sp & 255u) == 0u) { if (xb_ld(&(bar)[XB_TMO])) break; if (_sp > XB_SPIN_CAP) { atomicAdd(&(bar)[XB_TMO], 1u); break; } } } } while (0)
struct XcdBarrier { unsigned* bar; unsigned x; volatile LAS unsigned* st; };
__device__ __forceinline__ XcdBarrier xcd_barrier_post(unsigned* bar, volatile LAS unsigned* st) {
    XcdBarrier b; b.bar = bar; b.x = xb_xcc_id(); b.st = st;
    if (threadIdx.x == 0) (void)xb_add(&bar[XB_XCNT(b.x)], 1u);
    return b;
}
__device__ __forceinline__ void xcd_barrier_complete(unsigned* bar, unsigned x, unsigned& nloc, unsigned& nx) {
    const unsigned G = gridDim.x * gridDim.y * gridDim.z;
    unsigned sum, cnt, mine, sp = 0u;
    for (;;) {
        sum = 0u; cnt = 0u; mine = 0u;
#pragma unroll
        for (unsigned j = 0; j < 16; ++j) { const unsigned c = xb_ld(&bar[XB_XCNT(j)]); sum += c; cnt += (c > 0u) ? 1u : 0u; mine = (j == x) ? c : mine; }
        if (sum == G) break;
        __builtin_amdgcn_s_sleep(1);
        if ((++sp & 255u) == 0u) { if (xb_ld(&bar[XB_TMO])) break; if (sp > XB_SPIN_CAP) { atomicAdd(&bar[XB_TMO], 1u); break; } }
    }
    nloc = mine > 0u ? mine : 1u; nx = cnt > 0u ? cnt : 1u;
}
__device__ __forceinline__ void xcd_barrier(const XcdBarrier& b) {
    asm volatile("s_waitcnt vmcnt(0)" ::: "memory");
    __syncthreads();
    if (threadIdx.x == 0) {
        unsigned* bar = b.bar;
        __builtin_amdgcn_s_waitcnt(0);
        unsigned nloc = b.st[0], nx = b.st[1];
        if (nloc == 0u) { xcd_barrier_complete(bar, b.x, nloc, nx); b.st[0] = nloc; b.st[1] = nx; }
        const unsigned old = xb_add(&bar[XB_XSUB(b.x)], 1u);
        const unsigned gen = old / nloc;
        if (old + 1u == (gen + 1u) * nloc) {
            __builtin_amdgcn_fence(__ATOMIC_RELEASE, "agent");
            asm volatile("s_waitcnt vmcnt(0)" ::: "memory");
            const unsigned og = xb_add(&bar[XB_TOP], 1u);
            const unsigned tg = og / nx;
            if (og + 1u == (tg + 1u) * nx) xb_add(&bar[XB_TOPGEN], 1u);
            else XB_SPIN(xb_ld(&bar[XB_TOPGEN]) == tg, bar);
            __builtin_amdgcn_fence(__ATOMIC_ACQUIRE, "agent");
            xb_add(&bar[XB_XGEN(b.x)], 1u);
            asm volatile("s_waitcnt vmcnt(0)" ::: "memory");
        } else {
            XB_SPIN(xb_ld(&bar[XB_XGEN(b.x)]) == gen, bar);
            __builtin_amdgcn_fence(__ATOMIC_ACQUIRE, "agent");
            asm volatile("s_waitcnt vmcnt(0)" ::: "memory");
        }
    }
    __syncthreads();
}

struct Frame {
    LAS unsigned char* lds;
    volatile LAS unsigned* MISC;
    gu32* ctl;
    unsigned char* ws;
    int tid, lane, wave, vcu, G;
    float* hf;
    const float* const* in;
};
enum In { I_X = 0, I_MEM, I_LN_IN_G, I_LN_IN_B, I_LN_MEM_G, I_LN_MEM_B, I_W_IN, I_B_IN, I_W_DW, I_B_DW, I_LN_CONV_G, I_LN_CONV_B, I_W_OUT, I_B_OUT, I_LN1_G, I_LN1_B,
          I_WQ, I_WK, I_WV, I_WO, I_LN2_G, I_LN2_B, I_W_ROUTER, I_B_ROUTER, I_W_GU, I_B_GU, I_W_DOWN, I_B_DOWN, I_LN3_G, I_LN3_B, N_IN };

__device__ __forceinline__ void p0_transpose_item(const float* W, int K, int N, bf16* WT, int k0, int n0, int drow, LAS float* scr, int lane) {
#pragma unroll 8
    for (int i = 0; i < 32; ++i) { const int kk = 2 * i + (lane >> 5); scr[kk * 33 + (lane & 31)] = W[(size_t)(k0 + kk) * N + n0 + (lane & 31)]; }
    LDS_WAIT(); asm volatile("" ::: "memory");
    const int c = lane & 7;
#pragma unroll
    for (int j = 0; j < 4; ++j) { const int n = (lane >> 3) + 8 * j; const LAS float* s = scr + (8 * c) * 33 + n;
        u32x4 o; o.x = pk2(s[0 * 33], s[1 * 33]); o.y = pk2(s[2 * 33], s[3 * 33]); o.z = pk2(s[4 * 33], s[5 * 33]); o.w = pk2(s[6 * 33], s[7 * 33]);
        *(GAS u32x4*)(WT + (size_t)(drow + n) * K + k0 + 8 * c) = o; }
    LDS_WAIT(); asm volatile("" ::: "memory");
}
__device__ __forceinline__ void ln_row(f32x4 (&v)[4], const float* g, const float* b, int lane) {
    float s = 0.f;
#pragma unroll
    for (int j = 0; j < 4; ++j) s += (v[j].x + v[j].y) + (v[j].z + v[j].w);
    const float mean = wave_sum(s) * (1.f / D); float s2 = 0.f;
#pragma unroll
    for (int j = 0; j < 4; ++j) { v[j] = v[j] - mean; s2 += (v[j].x * v[j].x + v[j].y * v[j].y) + (v[j].z * v[j].z + v[j].w * v[j].w); }
    const float rstd = 1.f / sqrtf(wave_sum(s2) * (1.f / D) + LN_EPS);
#pragma unroll
    for (int j = 0; j < 4; ++j) { const f32x4 gg = ((const GAS f32x4*)g)[lane + 64 * j], bb = ((const GAS f32x4*)b)[lane + 64 * j]; v[j] = v[j] * rstd * gg + bb; }
}
__device__ __forceinline__ void store_row_bf16(const f32x4 (&v)[4], bf16* orow, int lane) {
    GAS u32x2* o8 = (GAS u32x2*)orow + lane;
#pragma unroll
    for (int j = 0; j < 4; ++j) o8[64 * j] = (u32x2){pk2(v[j].x, v[j].y), pk2(v[j].z, v[j].w)};
}
__device__ __forceinline__ void p0_transpose_item8(const float* W, int K, int N, unsigned char* WT, int k0, int n0, int drow, float sc, LAS float* scr, int lane) {
#pragma unroll 8
    for (int i = 0; i < 32; ++i) { const int kk = 2 * i + (lane >> 5); scr[kk * 33 + (lane & 31)] = W[(size_t)(k0 + kk) * N + n0 + (lane & 31)]; }
    LDS_WAIT(); asm volatile("" ::: "memory");
    const int c = lane & 7;
#pragma unroll
    for (int j = 0; j < 4; ++j) { const int n = (lane >> 3) + 8 * j; const LAS float* s = scr + (8 * c) * 33 + n;
        u32x2 o; o.x = pk4_fp8(s[0 * 33] * sc, s[1 * 33] * sc, s[2 * 33] * sc, s[3 * 33] * sc); o.y = pk4_fp8(s[4 * 33] * sc, s[5 * 33] * sc, s[6 * 33] * sc, s[7 * 33] * sc);
        *(GAS u32x2*)(WT + (size_t)(drow + n) * K + k0 + 8 * c) = o; }
    LDS_WAIT(); asm volatile("" ::: "memory");
}
__device__ __forceinline__ void load_row_bf16(f32x4 (&v)[4], const bf16* xrow, int lane) {
    const GAS u32x2* xr = (const GAS u32x2*)xrow + lane;
#pragma unroll
    for (int j = 0; j < 4; ++j) { const u32x2 w = xr[64 * j]; v[j] = (f32x4){bflo(w.x), bfhi(w.x), bflo(w.y), bfhi(w.y)}; }
}
__device__ __forceinline__ void load_row_f32(f32x4 (&v)[4], const float* xrow, int lane) {
    const GAS f32x4* xr = (const GAS f32x4*)xrow + lane;
#pragma unroll
    for (int j = 0; j < 4; ++j) v[j] = xr[64 * j];
}
__device__ __forceinline__ void store_row_f32(const f32x4 (&v)[4], float* orow, int lane) {
    GAS f32x4* o = (GAS f32x4*)orow + lane;
#pragma unroll
    for (int j = 0; j < 4; ++j) o[64 * j] = v[j];
}

__device__ __forceinline__ void p0_prologue(Frame& F) {
    LAS float* scr = (LAS float*)(F.lds + RING_OFF + F.wave * 16384);
    const int gw = F.vcu * NWAVES + F.wave, NGW = F.G * NWAVES;
    constexpr int I_IN = 16 * 80, I_SQ = 16 * 32, I_GU = NE * 16 * 64, I_DN = NE * 16 * 32;
    constexpr int NITEMS = I_IN + 5 * I_SQ + I_GU + I_DN;
    for (int it = gw; it < NITEMS; it += NGW) {
        int r = it;
        if (r < I_IN) { const int kb = r / 80, nb = r % 80, n0 = 32 * nb; int drow;
            if (n0 < 512) drow = (n0 >> 7) * 256 + (n0 & 127); else if (n0 < 1024) drow = ((n0 - 512) >> 7) * 256 + 128 + (n0 & 127); else drow = n0;
            p0_transpose_item(F.in[I_W_IN], D, INC, (bf16*)(F.ws + WS_WIN_T), 64 * kb, n0, drow, scr, F.lane); continue; } r -= I_IN;
        if (r < 5 * I_SQ) { const int w = r / I_SQ, q = r % I_SQ, kb = q / 32, nb = q % 32;
            const float* src = F.in[w == 0 ? I_W_OUT : w == 1 ? I_WQ : w == 2 ? I_WK : w == 3 ? I_WV : I_WO];
            bf16* dst = (bf16*)(F.ws + (w == 0 ? WS_WOUT_T : w == 1 ? WS_WQ_T : w == 2 ? WS_WK_T : w == 3 ? WS_WV_T : WS_WO_T));
            p0_transpose_item(src, D, D, dst, 64 * kb, 32 * nb, 32 * nb, scr, F.lane); continue; } r -= 5 * I_SQ;
        if (r < I_GU) { const int e = r / (16 * 64), q = r % (16 * 64), kb = q / 64, nb = q % 64, n0 = 32 * nb;
            const int drow = (n0 < 1024) ? (n0 >> 7) * 256 + (n0 & 127) : ((n0 - 1024) >> 7) * 256 + 128 + (n0 & 127);
            p0_transpose_item8(F.in[I_W_GU] + (size_t)e * D * 2 * DFF, D, 2 * DFF, F.ws + WS_WGU_T + (size_t)e * 2 * DFF * D, 64 * kb, n0, drow, WGU_SC, scr, F.lane); continue; } r -= I_GU;
        { const int e = r / (16 * 32), q = r % (16 * 32), kb = q / 32, nb = q % 32;
            p0_transpose_item8(F.in[I_W_DOWN] + (size_t)e * DFF * D, DFF, D, F.ws + WS_WDN_T + (size_t)e * D * DFF, 64 * kb, 32 * nb, 32 * nb, WDN_SC, scr, F.lane); }
    }
    for (int m = gw; m < M + MM; m += NGW) {
        f32x4 v[4];
        if (m < M) { load_row_f32(v, F.in[I_X] + (size_t)m * D, F.lane); ln_row(v, F.in[I_LN_IN_G], F.in[I_LN_IN_B], F.lane);
            store_row_bf16(v, (bf16*)(F.ws + WS_HB) + (size_t)m * D, F.lane); }
        else { const int mm = m - M; load_row_f32(v, F.in[I_MEM] + (size_t)mm * D, F.lane); ln_row(v, F.in[I_LN_MEM_G], F.in[I_LN_MEM_B], F.lane);
            store_row_bf16(v, (bf16*)(F.ws + WS_MEMN) + (size_t)mm * D, F.lane); }
    }
}

constexpr unsigned TSTEP = 256u * 1024u * 2u;
struct SchedP1 { int G, c;
    __device__ __forceinline__ bool next(int i, Unit& u) const {
        const int L = i * G + c; if (L >= 1344) return false;
        u.nvalid = 256; u.goff = 0;
        if (L < 1024) { pg8::tile_order(L, 128, 8, u.pm, u.pn); u.z = 0; u.aoff = (unsigned)WS_HB + (unsigned)u.pm * TSTEP; u.boff = (unsigned)WS_WIN_T + (unsigned)u.pn * TSTEP; }
        else if (L < 1280) { const int j = L - 1024; u.pm = j & 1; u.pn = j >> 1; u.z = 3; u.aoff = (unsigned)WS_WIN_T + (unsigned)(8 + u.pm) * TSTEP; u.boff = (unsigned)WS_HB + (unsigned)u.pn * TSTEP; }
        else if (L < 1312) { const int j = L - 1280; u.pm = j & 7; u.pn = j >> 3; u.z = 1; u.aoff = (unsigned)WS_MEMN + (unsigned)u.pm * TSTEP; u.boff = (unsigned)WS_WK_T + (unsigned)u.pn * TSTEP; }
        else { const int j = L - 1312; u.pm = j & 3; u.pn = j >> 2; u.z = 2; u.aoff = (unsigned)WS_WV_T + (unsigned)u.pm * TSTEP; u.boff = (unsigned)WS_MEMN + (unsigned)u.pn * TSTEP; }
        return true; }
};
struct EpiP1 { static constexpr bool PERM = true;
    unsigned char* ws; const float* b_in;
    __device__ __forceinline__ void operator()(const f32x4 (&acc)[2][2][4][2], const Unit& u, int wr, int wc, int fr, int fq) const {
        const int row0 = u.pm * 256 + wr * 64 + fr;
        if (u.z == 0) {
            if (u.pn < 4) {
                const int ch = 128 * u.pn + wc * 32 + 8 * fq;
                f32x4 bv[2], bg[2];
#pragma unroll
                for (int n = 0; n < 2; ++n) { bv[n] = *(const f32x4*)(b_in + ch + 4 * n); bg[n] = *(const f32x4*)(b_in + 512 + ch + 4 * n); }
                bf16* U = (bf16*)(ws + WS_U);
#pragma unroll
                for (int ai = 0; ai < 2; ++ai)
#pragma unroll
                    for (int m = 0; m < 4; ++m) { f32x4 o[2];
#pragma unroll
                        for (int n = 0; n < 2; ++n) { const f32x4 a = acc[ai][0][m][n] + bv[n], g = acc[ai][1][m][n] + bg[n];
#pragma unroll
                            for (int j = 0; j < 4; ++j) o[n][j] = a[j] * sigmoidf_fast(g[j]); }
                        u32x4 w; w.x = pg8::cvt_pk_bf16(o[0][0], o[0][1]); w.y = pg8::cvt_pk_bf16(o[0][2], o[0][3]); w.z = pg8::cvt_pk_bf16(o[1][0], o[1][1]); w.w = pg8::cvt_pk_bf16(o[1][2], o[1][3]);
                        *(u32x4*)(U + (size_t)(row0 + ai * 128 + m * 16) * 512 + ch) = w; }
            } else {
                const int t = u.pn - 4, which = t >> 1, cb = (t & 1) * 256;
                bf16* dst = (bf16*)(ws + (which == 0 ? WS_Q : WS_K));
                pg8::store_tile_bf16(acc, dst + (size_t)row0 * 512 + cb, 512, b_in + 1024 + 256 * t, which == 0 ? SB_QSCALE : 1.0f, wc, fq);
            }
        } else if (u.z == 3) {
            const float* rb = b_in + 2048 + row0; bf16* p0 = (bf16*)(ws + WS_V) + (size_t)row0 * M + 256 * u.pn; const int cl = wc * 32 + 8 * fq;
#pragma unroll
            for (int ai = 0; ai < 2; ++ai)
#pragma unroll
                for (int m = 0; m < 4; ++m) { const float bv = rb[ai * 128 + m * 16]; bf16* rowp = p0 + (size_t)(ai * 128 + m * 16) * M + cl;
#pragma unroll
                    for (int bj = 0; bj < 2; ++bj) { const f32x4 v0 = acc[ai][bj][m][0] + bv, v1 = acc[ai][bj][m][1] + bv;
                        u32x4 w; w.x = pg8::cvt_pk_bf16(v0[0], v0[1]); w.y = pg8::cvt_pk_bf16(v0[2], v0[3]); w.z = pg8::cvt_pk_bf16(v1[0], v1[1]); w.w = pg8::cvt_pk_bf16(v1[2], v1[3]);
                        *(u32x4*)(rowp + bj * 128) = w; } }
        } else if (u.z == 1) pg8::store_tile_bf16(acc, (bf16*)(ws + WS_KM) + (size_t)row0 * 1024 + 256 * u.pn, 1024, nullptr, 1.0f, wc, fq);
        else pg8::store_tile_bf16(acc, (bf16*)(ws + WS_VMT) + (size_t)row0 * 2048 + 256 * u.pn, 2048, nullptr, 1.0f, wc, fq);
    }
};

struct SchedPlain { int G, c, nM, nN; unsigned abase, bbase, atile, btile, acol, bcol, bgrp;
    __device__ __forceinline__ bool next(int i, Unit& u) const {
        const int L = i * G + c; if (L >= nM * nN) return false;
        pg8::tile_order(L, nM, nN, u.pm, u.pn); u.z = 0; u.nvalid = 256; u.goff = 0;
        u.aoff = abase + (unsigned)u.pm * atile + (unsigned)u.pn * acol; u.boff = bbase + (unsigned)u.pn * btile + (unsigned)(u.pm >> 4) * bgrp + (unsigned)u.pn * bcol; return true; }
};
struct EpiBf16 { static constexpr bool PERM = true;
    bf16* O; int ldc; float scale; const float* bias;
    __device__ __forceinline__ void operator()(const f32x4 (&acc)[2][2][4][2], const Unit& u, int wr, int wc, int fr, int fq) const {
        pg8::store_tile_bf16(acc, O + (size_t)(u.pm * 256 + wr * 64 + fr) * ldc + 256 * u.pn, (size_t)ldc, bias ? bias + 256 * u.pn : nullptr, scale, wc, fq); }
};
struct SchedMoe { int G, c, nN; const LAS int* tb; unsigned abase, wbase, wexp;
    bool gather;
    __device__ __forceinline__ bool next(int i, Unit& u) const {
        const int nblk = __builtin_amdgcn_readfirstlane(tb[32]); const int L = i * G + c; if (L >= nblk * nN) return false;
        pg8::tile_order(L, nblk, nN, u.pm, u.pn);
        const int e = __builtin_amdgcn_readfirstlane(tb[128 + u.pm]);
        const int j = u.pm - tb[e], rem = tb[64 + e] - 256 * j;
        u.z = e; u.nvalid = rem < 256 ? rem : 256; u.goff = (unsigned)(e * LCAP + 256 * j);
        u.aoff = gather ? abase : abase + (unsigned)u.pm * (TSTEP / 2);
        u.boff = wbase + (unsigned)e * wexp + (unsigned)u.pn * (TSTEP / 2); return true; }
};
struct EpiAct { static constexpr bool PERM = true;
    unsigned char* ACT; const float* b_gu;
    __device__ __forceinline__ void operator()(const f32x4 (&acc)[2][2][4][2], const Unit& u, int wr, int wc, int fr, int fq) const {
        const int row0 = u.pm * 256 + wr * 64 + fr, ch = 128 * u.pn + wc * 32 + 8 * fq;
        const float* bb = b_gu + (size_t)u.z * 2 * DFF;
        f32x4 bg[2], bu[2];
#pragma unroll
        for (int n = 0; n < 2; ++n) { bg[n] = *(const f32x4*)(bb + ch + 4 * n); bu[n] = *(const f32x4*)(bb + DFF + ch + 4 * n); }
#pragma unroll
        for (int ai = 0; ai < 2; ++ai)
#pragma unroll
            for (int m = 0; m < 4; ++m) { f32x4 o[2];
#pragma unroll
                for (int n = 0; n < 2; ++n) { const f32x4 g = acc[ai][0][m][n] * (1.0f / WGU_SC) + bg[n], uu = acc[ai][1][m][n] * (1.0f / WGU_SC) + bu[n];
#pragma unroll
                    for (int j = 0; j < 4; ++j) { const float g_ = fminf(g[j], 7.0f), u_ = fminf(fmaxf(uu[j], -7.0f), 7.0f); o[n][j] = (u_ + 1.0f) * g_ * sigmoidf_fast(1.702f * g_); } }
                *(u32x2*)(ACT + (size_t)(row0 + ai * 128 + m * 16) * DFF + ch) = (u32x2){pk4_fp8(o[0][0], o[0][1], o[0][2], o[0][3]), pk4_fp8(o[1][0], o[1][1], o[1][2], o[1][3])}; }
    }
};
struct EpiDown { static constexpr bool PERM = true;
    bf16* YS; const float* b_down; const float* lgate;
    __device__ __forceinline__ void operator()(const f32x4 (&acc)[2][2][4][2], const Unit& u, int wr, int wc, int fr, int fq) const {
        const int r0 = wr * 64 + fr, cl = wc * 32 + 8 * fq;
        const float* bb = b_down + (size_t)u.z * D + 256 * u.pn + cl;
        f32x4 bv[2][2];
#pragma unroll
        for (int bj = 0; bj < 2; ++bj)
#pragma unroll
            for (int n = 0; n < 2; ++n) bv[bj][n] = *(const f32x4*)(bb + bj * 128 + 4 * n);
        float gts[2][4];
#pragma unroll
        for (int ai = 0; ai < 2; ++ai)
#pragma unroll
            for (int m = 0; m < 4; ++m) { const int r = r0 + ai * 128 + m * 16; gts[ai][m] = lgate[u.goff + (r < u.nvalid ? r : u.nvalid - 1)]; }
#pragma unroll
        for (int ai = 0; ai < 2; ++ai)
#pragma unroll
            for (int m = 0; m < 4; ++m) { const int r = r0 + ai * 128 + m * 16; const float gt = (r < u.nvalid) ? gts[ai][m] : 0.f;
                bf16* rowp = YS + (size_t)(u.pm * 256 + r) * D + 256 * u.pn + cl;
#pragma unroll
                for (int bj = 0; bj < 2; ++bj) { const f32x4 v0 = (acc[ai][bj][m][0] * (1.0f / WDN_SC) + bv[bj][0]) * gt, v1 = (acc[ai][bj][m][1] * (1.0f / WDN_SC) + bv[bj][1]) * gt;
                    u32x4 w; w.x = pg8::cvt_pk_bf16(v0[0], v0[1]); w.y = pg8::cvt_pk_bf16(v0[2], v0[3]); w.z = pg8::cvt_pk_bf16(v1[0], v1[1]); w.w = pg8::cvt_pk_bf16(v1[2], v1[3]);
                    *(u32x4*)(rowp + bj * 128) = w; } }
    }
};
__device__ __forceinline__ void moe_table(Frame& F, LAS int* tb) {
    if (F.tid < 32) { int c = (int)__hip_atomic_load(F.ctl + CW_ECNT + 64 * F.tid, RLX_AGENT); if (c > LCAP) c = LCAP; tb[64 + F.tid] = c; }
    LDS_WAIT(); __syncthreads();
    if (F.tid == 0) { int s = 0; for (int e = 0; e < NE; ++e) { tb[e] = s; s += (tb[64 + e] + 255) >> 8; } tb[32] = s; }
    LDS_WAIT(); __syncthreads();
    for (int b = F.tid; b < NBLK_MAX; b += NWAVES * 64) { int e = 0; while (e < NE - 1 && tb[e + 1] <= b) ++e; tb[128 + b] = e; }
    LDS_WAIT(); __syncthreads();
}

__device__ __forceinline__ void conv_phase(Frame& F) {
    LAS unsigned* ut = (LAS unsigned*)(F.lds + RING_OFF);
    LAS float* co = (LAS float*)(F.lds + RING_OFF + 65536);
    const int cp = F.tid & 255, half = F.tid >> 8;
    float w0[CWID], w1[CWID];
    { const float* wd = F.in[I_W_DW] + 2 * cp;
#pragma unroll
        for (int j = 0; j < CWID; ++j) { const f32x2 w = *(const GAS f32x2*)(wd + j * CONV_CH); w0[j] = w.x; w1[j] = w.y; } }
    const f32x2 bd = *(const GAS f32x2*)(F.in[I_B_DW] + 2 * cp);
    const f32x4 g0 = *(const GAS f32x4*)(F.in[I_LN_CONV_G] + 8 * F.lane), g1 = *(const GAS f32x4*)(F.in[I_LN_CONV_G] + 8 * F.lane + 4);
    const f32x4 b0 = *(const GAS f32x4*)(F.in[I_LN_CONV_B] + 8 * F.lane), b1 = *(const GAS f32x4*)(F.in[I_LN_CONV_B] + 8 * F.lane + 4);
    bf16* MX = (bf16*)(F.ws + WS_MIXIN);
    for (int it = F.vcu; it < NB * (T_ / 32); it += F.G) {
        const int b = it / (T_ / 32), t0 = (it % (T_ / 32)) * 32;
        const bf16* U = (const bf16*)(F.ws + WS_U) + (size_t)b * T_ * CONV_CH;
        for (int idx = F.tid; idx < 62 * 64; idx += 512) { const int r = idx >> 6, c16 = idx & 63, t = t0 - 30 + r;
            u32x4 v = (u32x4){0u, 0u, 0u, 0u}; if (t >= 0) v = *(const GAS u32x4*)(U + (size_t)t * CONV_CH + c16 * 8);
            *(LAS u32x4*)(ut + r * 256 + c16 * 4) = v; }
        LDS_WAIT(); __syncthreads();
        { float a0[16], a1[16];
#pragma unroll
            for (int tt = 0; tt < 16; ++tt) { a0[tt] = bd.x; a1[tt] = bd.y; }
#pragma unroll
            for (int r = 0; r < 46; ++r) { const unsigned uu = ut[(half * 16 + r) * 256 + cp]; const float u0 = bflo(uu), u1 = bfhi(uu);
#pragma unroll
                for (int tt = 0; tt < 16; ++tt) { const int j = r - tt; if (j >= 0 && j < CWID) { a0[tt] += w0[j] * u0; a1[tt] += w1[j] * u1; } } }
#pragma unroll
            for (int tt = 0; tt < 16; ++tt) *(LAS f32x2*)(co + (half * 16 + tt) * CONV_CH + 2 * cp) = (f32x2){a0[tt], a1[tt]};
        }
        LDS_WAIT(); __syncthreads();
#pragma unroll
        for (int q = 0; q < 4; ++q) { const int tt = 4 * F.wave + q;
            f32x4 x0 = *(const LAS f32x4*)(co + tt * CONV_CH + 8 * F.lane), x1 = *(const LAS f32x4*)(co + tt * CONV_CH + 8 * F.lane + 4);
            const float mean = wave_sum((x0.x + x0.y) + (x0.z + x0.w) + (x1.x + x1.y) + (x1.z + x1.w)) * (1.f / CONV_CH);
            x0 = x0 - mean; x1 = x1 - mean;
            const float var = wave_sum((x0.x * x0.x + x0.y * x0.y) + (x0.z * x0.z + x0.w * x0.w) + (x1.x * x1.x + x1.y * x1.y) + (x1.z * x1.z + x1.w * x1.w)) * (1.f / CONV_CH);
            const float rstd = 1.f / sqrtf(var + LN_EPS);
            x0 = x0 * rstd * g0 + b0; x1 = x1 * rstd * g1 + b1;
            float y[8] = {x0.x, x0.y, x0.z, x0.w, x1.x, x1.y, x1.z, x1.w};
#pragma unroll
            for (int j = 0; j < 8; ++j) y[j] = y[j] * sigmoidf_fast(y[j]);
            *(GAS u32x4*)(MX + (size_t)(b * T_ + t0 + tt) * D + 8 * F.lane) = (u32x4){pk2(y[0], y[1]), pk2(y[2], y[3]), pk2(y[4], y[5]), pk2(y[6], y[7])}; }
        __syncthreads();
    }
}

typedef float f32x16 __attribute__((ext_vector_type(16)));
__device__ __forceinline__ int crow(int r, int hi) { return (r & 3) + 8 * (r >> 2) + 4 * hi; }
__device__ __forceinline__ bf16x8 pack8(const float* v) {
    u32x4 w; w.x = pg8::cvt_pk_bf16(v[0], v[1]); w.y = pg8::cvt_pk_bf16(v[2], v[3]); w.z = pg8::cvt_pk_bf16(v[4], v[5]); w.w = pg8::cvt_pk_bf16(v[6], v[7]);
    return __builtin_bit_cast(bf16x8, w); }
constexpr float SB_EXIT = 150.0f;
struct SbStage { u32x4 k[4], v[4]; };
__device__ __forceinline__ void sb_gload(SbStage& g, const bf16* Kt, const bf16* Vt, int lane) {
#pragma unroll
    for (int i = 0; i < 4; ++i) { const int c = (lane & 7) ^ ((4 * i + (lane >> 4)) & 7); g.k[i] = *(const GAS u32x4*)(Kt + (size_t)(8 * i) * SBW + 8 * c); }
#pragma unroll
    for (int i = 0; i < 4; ++i) g.v[i] = *(const GAS u32x4*)(Vt + (size_t)(16 * i) * M);
}
__device__ __forceinline__ void sb_lwrite(const SbStage& g, LAS unsigned char* buf, int lane) {
#pragma unroll
    for (int i = 0; i < 4; ++i) *(LAS u32x4*)(buf + 1024 * i + 16 * lane) = g.k[i];
#pragma unroll
    for (int i = 0; i < 4; ++i) *(LAS u32x4*)(buf + 4096 + 1024 * i + 16 * lane) = g.v[i];
}
__device__ __forceinline__ void sb_attn_wave(Frame& F, int b, int h, int qt) {
    const int c = F.lane & 31, hi = F.lane >> 5;
    const bf16* Q = (const bf16*)(F.ws + WS_Q); const bf16* Kb = (const bf16*)(F.ws + WS_K); const bf16* VT = (const bf16*)(F.ws + WS_V);
    LAS unsigned char* wbuf = F.lds + RING_OFF + F.wave * 16384;
    bf16x8 tri[2];
#pragma unroll
    for (int s = 0; s < 2; ++s) { bf16x8 t;
#pragma unroll
        for (int j = 0; j < 8; ++j) { const int k = 16 * s + 8 * (j >> 2) + 4 * hi + (j & 3); t[j] = (k >= c) ? (short)0xBF80 : (short)0; }
        tri[s] = t; }
    bf16x8 qf[4];
    { const bf16* qp = Q + ((size_t)b * T_ + 32 * qt + c) * SBW + h * SBD + 8 * hi;
#pragma unroll
        for (int s = 0; s < 4; ++s) qf[s] = *(const GAS bf16x8*)(qp + 16 * s); }
    const bf16* Ksrc = Kb + ((size_t)b * T_ + (F.lane >> 3)) * SBW + h * SBD;
    const bf16* Vsrc = VT + (size_t)(h * SBD + (F.lane >> 2)) * M + (size_t)b * T_ + 8 * ((F.lane & 3) ^ ((F.lane >> 4) & 3));

    const int ksw = (c >> 1) & 7, vsw = (c >> 2) & 3;

    f32x16 o0, o1;
#pragma unroll
    for (int r = 0; r < 16; ++r) { o0[r] = 0.f; o1[r] = 0.f; }
    float carry = 0.f;
    SbStage st;
    sb_gload(st, Ksrc + (size_t)(32 * qt) * SBW, Vsrc + 32 * qt, F.lane); sb_lwrite(st, wbuf, F.lane);
    for (int kt = qt; kt >= 0; --kt) {
        LAS unsigned char* buf = wbuf + ((qt - kt) & 1) * 8192;
        if (kt > 0) sb_gload(st, Ksrc + (size_t)(32 * (kt - 1)) * SBW, Vsrc + 32 * (kt - 1), F.lane);
        const bool diag = (kt == qt);
        bf16x8 kf[4];
#pragma unroll
        for (int s = 0; s < 4; ++s) kf[s] = *(const LAS bf16x8*)(buf + c * 128 + 16 * ((2 * s + hi) ^ ksw));
        f32x16 p;
#pragma unroll
        for (int r = 0; r < 16; ++r) p[r] = 0.f;
#pragma unroll
        for (int s = 0; s < 4; ++s) p = __builtin_amdgcn_mfma_f32_32x32x16_bf16(kf[s], qf[s], p, 0, 0, 0);
        u32x2 vv[2][2][2];
#pragma unroll
        for (int dt = 0; dt < 2; ++dt)
#pragma unroll
            for (int s = 0; s < 2; ++s)
#pragma unroll
                for (int q = 0; q < 2; ++q) vv[dt][s][q] = *(const LAS u32x2*)(buf + 4096 + (32 * dt + c) * 64 + 16 * ((2 * s + q) ^ vsw) + 8 * hi);
        float L[16];
#pragma unroll
        for (int r = 0; r < 16; ++r) { const float y = p[r]; float l = __builtin_amdgcn_logf(1.0f + __builtin_amdgcn_exp2f(y)); l = (y > 64.f) ? y : l;
            if (diag) l = (crow(r, hi) >= c) ? 0.f : l; L[r] = l; }
        const bf16x8 l0 = pack8(L), l1 = pack8(L + 8);
        f32x16 a;
#pragma unroll
        for (int r = 0; r < 16; ++r) a[r] = p[r] - carry;
        a = __builtin_amdgcn_mfma_f32_32x32x16_bf16(tri[0], l0, a, 0, 0, 0); a = __builtin_amdgcn_mfma_f32_32x32x16_bf16(tri[1], l1, a, 0, 0, 0);
        const float tot = p[0] - a[0];
        float w[16];
#pragma unroll
        for (int r = 0; r < 16; ++r) { float x = __builtin_amdgcn_exp2f(a[r]); if (diag) x = (crow(r, hi) >= c) ? 0.f : x; w[r] = x; }
        const bf16x8 p0 = pack8(w), p1 = pack8(w + 8);
        { const bf16x8 v00 = __builtin_bit_cast(bf16x8, (u32x4){vv[0][0][0].x, vv[0][0][0].y, vv[0][0][1].x, vv[0][0][1].y});
          const bf16x8 v01 = __builtin_bit_cast(bf16x8, (u32x4){vv[0][1][0].x, vv[0][1][0].y, vv[0][1][1].x, vv[0][1][1].y});
          const bf16x8 v10 = __builtin_bit_cast(bf16x8, (u32x4){vv[1][0][0].x, vv[1][0][0].y, vv[1][0][1].x, vv[1][0][1].y});
          const bf16x8 v11 = __builtin_bit_cast(bf16x8, (u32x4){vv[1][1][0].x, vv[1][1][0].y, vv[1][1][1].x, vv[1][1][1].y});
          o0 = __builtin_amdgcn_mfma_f32_32x32x16_bf16(v00, p0, o0, 0, 0, 0); o0 = __builtin_amdgcn_mfma_f32_32x32x16_bf16(v01, p1, o0, 0, 0, 0);
          o1 = __builtin_amdgcn_mfma_f32_32x32x16_bf16(v10, p0, o1, 0, 0, 0); o1 = __builtin_amdgcn_mfma_f32_32x32x16_bf16(v11, p1, o1, 0, 0, 0); }
        carry = __shfl(tot, c);
        if (__all(carry >= SB_EXIT)) break;
        if (kt > 0) sb_lwrite(st, wbuf + ((qt - kt + 1) & 1) * 8192, F.lane);
    }
    bf16* op = (bf16*)(F.ws + WS_MIXIN) + ((size_t)b * T_ + 32 * qt + c) * D + CONV_CH + h * SBD + 4 * hi;
#pragma unroll
    for (int g = 0; g < 4; ++g) {
        *(GAS u32x2*)(op + 8 * g) = (u32x2){pg8::cvt_pk_bf16(o0[4 * g], o0[4 * g + 1]), pg8::cvt_pk_bf16(o0[4 * g + 2], o0[4 * g + 3])};
        *(GAS u32x2*)(op + 32 + 8 * g) = (u32x2){pg8::cvt_pk_bf16(o1[4 * g], o1[4 * g + 1]), pg8::cvt_pk_bf16(o1[4 * g + 2], o1[4 * g + 3])}; }
}

__device__ __forceinline__ void resid_row(f32x4 (&v)[4], const bf16* hrow, const bf16* mrow, int lane) {
    f32x4 a[4]; load_row_bf16(v, hrow, lane); load_row_bf16(a, mrow, lane);
#pragma unroll
    for (int j = 0; j < 4; ++j) v[j] = v[j] * DN_ALPHA + a[j];
}
__device__ __forceinline__ void ln_phase(Frame& F, const float* g, const float* b) {
    const int gw = F.vcu * NWAVES + F.wave, NGW = F.G * NWAVES;
    for (int m = gw; m < M; m += NGW) { f32x4 v[4]; bf16* hrow = (bf16*)(F.ws + WS_HB) + (size_t)m * D; resid_row(v, hrow, (const bf16*)(F.ws + WS_QM) + (size_t)m * D, F.lane);
        ln_row(v, g, b, F.lane); store_row_bf16(v, hrow, F.lane); }
}
__device__ __forceinline__ void softmax_phase(Frame& F) {
    const int gw = F.vcu * NWAVES + F.wave, NGW = F.G * NWAVES;
    for (int m = gw; m < M; m += NGW) { GAS u32x2* p = (GAS u32x2*)((bf16*)(F.ws + WS_SP) + (size_t)m * D) + F.lane;
#pragma unroll
        for (int j = 0; j < 4; ++j) { const u32x2 w = p[64 * j]; float x0 = bflo(w.x), x1 = bfhi(w.x), x2 = bflo(w.y), x3 = bfhi(w.y);
            const float mx = wave_max(fmaxf(fmaxf(x0, x1), fmaxf(x2, x3)));
            x0 = __builtin_amdgcn_exp2f(x0 - mx); x1 = __builtin_amdgcn_exp2f(x1 - mx); x2 = __builtin_amdgcn_exp2f(x2 - mx); x3 = __builtin_amdgcn_exp2f(x3 - mx);
            const float inv = 1.0f / wave_sum((x0 + x1) + (x2 + x3));
            p[64 * j] = (u32x2){pk2(x0 * inv, x1 * inv), pk2(x2 * inv, x3 * inv)}; } }
}
__device__ __forceinline__ void ln2_router_phase(Frame& F) {
    LAS float* wT = (LAS float*)(F.lds + RING_OFF);
    LAS int* lcnt = (LAS int*)(F.lds + XTRA_OFF);
    LAS int* rec = (LAS int*)(F.lds + XTRA_OFF + 512);
    const float* wr_ = F.in[I_W_ROUTER];
    for (int idx = F.tid; idx < D * NE; idx += 512) { const int c = idx >> 5, e = idx & 31; wT[e * D + c] = wr_[idx]; }
    if (F.tid < 64) lcnt[F.tid] = 0;
    LDS_WAIT(); __syncthreads();
    const int gw = F.vcu * NWAVES + F.wave, NGW = F.G * NWAVES;
    const float brt = F.in[I_B_ROUTER][F.lane >> 1];
    int it = 0;
    for (int m = gw; m < M; m += NGW, ++it) {
        f32x4 v[4]; bf16* hrow = (bf16*)(F.ws + WS_HB) + (size_t)m * D; resid_row(v, hrow, (const bf16*)(F.ws + WS_QM) + (size_t)m * D, F.lane);
        ln_row(v, F.in[I_LN2_G], F.in[I_LN2_B], F.lane); store_row_bf16(v, hrow, F.lane);
        { GAS unsigned* h8 = (GAS unsigned*)(F.ws + WS_HB8 + (size_t)m * D) + F.lane;
#pragma unroll
            for (int j = 0; j < 4; ++j) h8[64 * j] = pk4_fp8(v[j].x, v[j].y, v[j].z, v[j].w); }
        float ra[NE];
#pragma unroll
        for (int e = 0; e < NE; ++e) { float p = 0.f;
#pragma unroll
            for (int j = 0; j < 4; ++j) { const f32x4 w = *(const LAS f32x4*)(wT + e * D + 256 * j + 4 * F.lane); p += (v[j].x * w.x + v[j].y * w.y) + (v[j].z * w.z + v[j].w * w.w); }
            ra[e] = p; }
#pragma unroll
        for (int i = 0; i < 16; ++i) { const bool up = (F.lane & 32) != 0; const float keep = up ? ra[16 + i] : ra[i], send = up ? ra[i] : ra[16 + i]; ra[i] = keep + __shfl_xor(send, 32); }
#pragma unroll
        for (int i = 0; i < 8; ++i) { const bool up = (F.lane & 16) != 0; const float keep = up ? ra[8 + i] : ra[i], send = up ? ra[i] : ra[8 + i]; ra[i] = keep + __shfl_xor(send, 16); }
#pragma unroll
        for (int i = 0; i < 4; ++i) { const bool up = (F.lane & 8) != 0; const float keep = up ? ra[4 + i] : ra[i], send = up ? ra[i] : ra[4 + i]; ra[i] = keep + __shfl_xor(send, 8); }
#pragma unroll
        for (int i = 0; i < 2; ++i) { const bool up = (F.lane & 4) != 0; const float keep = up ? ra[2 + i] : ra[i], send = up ? ra[i] : ra[2 + i]; ra[i] = keep + __shfl_xor(send, 4); }
        { const bool up = (F.lane & 2) != 0; const float keep = up ? ra[1] : ra[0], send = up ? ra[0] : ra[1]; ra[0] = keep + __shfl_xor(send, 2); }
        ra[0] += __shfl_xor(ra[0], 1);
        float logit = (F.lane & 1) ? -INFINITY : ra[0] + brt;
        float tv[TOPK]; int te[TOPK];
#pragma unroll
        for (int k = 0; k < TOPK; ++k) { const float mx = wave_max(logit); const unsigned long long bal = __ballot(logit == mx); const int ln = __builtin_ctzll(bal);
            tv[k] = mx; te[k] = ln >> 1; if (F.lane == ln) logit = -INFINITY; }
        float pe[TOPK], ps = 0.f;
#pragma unroll
        for (int k = 0; k < TOPK; ++k) { pe[k] = __expf(tv[k] - tv[0]); ps += pe[k]; }
        if (F.lane < TOPK) { const int k = F.lane; const int e = k == 0 ? te[0] : k == 1 ? te[1] : k == 2 ? te[2] : te[3]; const float g = (k == 0 ? pe[0] : k == 1 ? pe[1] : k == 2 ? pe[2] : pe[3]) / ps;
            const int lr = __hip_atomic_fetch_add(lcnt + e, 1, __ATOMIC_RELAXED, __HIP_MEMORY_SCOPE_WORKGROUP);
            LAS int* r = rec + ((F.wave * 16 + (it & 15)) * 4 + k) * 4; r[0] = e; r[1] = lr; r[2] = __builtin_bit_cast(int, g); r[3] = m; }
    }
    LDS_WAIT(); __syncthreads();
    if (F.tid < NE) lcnt[32 + F.tid] = (int)__hip_atomic_fetch_add(F.ctl + CW_ECNT + 64 * F.tid, (unsigned)lcnt[F.tid], RLX_AGENT);
    LDS_WAIT(); __syncthreads();
    int* ltok = (int*)(F.ws + WS_LTOK); float* lgate = (float*)(F.ws + WS_LGATE); int* sidx = (int*)(F.ws + WS_SIDX);
    const int nrec = it * 4;
    for (int i = F.lane; i < nrec; i += 64) { const LAS int* r = rec + (F.wave * 64 + i) * 4; const int e = r[0], pos = lcnt[32 + e] + r[1], tok = r[3];
        if (pos < LCAP) { ltok[e * LCAP + pos] = tok; lgate[e * LCAP + pos] = __builtin_bit_cast(float, r[2]); } sidx[tok * 4 + (i & 3)] = e * LCAP + pos; }
    __syncthreads();
}
__device__ __forceinline__ void final_phase(Frame& F, const LAS int* tb) {
    const int gw = F.vcu * NWAVES + F.wave, NGW = F.G * NWAVES;
    const int* sidx = (const int*)(F.ws + WS_SIDX); const bf16* YS = (const bf16*)(F.ws + WS_YS);
    for (int m = gw; m < M; m += NGW) { f32x4 v[4]; load_row_bf16(v, (const bf16*)(F.ws + WS_HB) + (size_t)m * D, F.lane);
#pragma unroll
        for (int j = 0; j < 4; ++j) v[j] = v[j] * DN_ALPHA;
        f32x4 s[4];
#pragma unroll
        for (int j = 0; j < 4; ++j) s[j] = (f32x4){0.f, 0.f, 0.f, 0.f};
#pragma unroll
        for (int k = 0; k < TOPK; ++k) { const int si = sidx[m * 4 + k], e = si / LCAP, pos = si - e * LCAP; const size_t slot = (size_t)tb[e] * 256 + pos;
            const GAS u32x2* yp = (const GAS u32x2*)(YS + slot * D) + F.lane;
#pragma unroll
            for (int j = 0; j < 4; ++j) { const u32x2 w = yp[64 * j]; s[j] = s[j] + (f32x4){bflo(w.x), bfhi(w.x), bflo(w.y), bfhi(w.y)}; } }
#pragma unroll
        for (int j = 0; j < 4; ++j) v[j] = v[j] + s[j];
        ln_row(v, F.in[I_LN3_G], F.in[I_LN3_B], F.lane); store_row_f32(v, F.hf + (size_t)m * D, F.lane); }
}

struct Args { const float* in[N_IN]; float* out; unsigned char* ws; int ph_lo, ph_hi, li, pad; };
__global__ void __launch_bounds__(NWAVES * 64, 2) mk_fwd(Args args) {
    extern __shared__ __attribute__((aligned(16))) unsigned char lds[];
    Frame F;
    F.lds = (LAS unsigned char*)lds; F.MISC = (volatile LAS unsigned*)(F.lds + MISC_OFF);
    F.tid = threadIdx.x; F.lane = F.tid & 63; F.wave = __builtin_amdgcn_readfirstlane(F.tid >> 6);
    F.G = gridDim.x; { const int bx = blockIdx.x; F.vcu = (F.G % 8 == 0) ? (bx % 8) * (F.G / 8) + bx / 8 : bx; }
    F.ws = args.ws; F.ctl = (gu32*)(args.ws + WS_CTL); F.hf = args.out; F.in = args.in;
    for (int u = F.tid; u < (LDS_BYTES - LDSCTL_OFF) / 4; u += NWAVES * 64) ((LAS unsigned*)(F.lds + LDSCTL_OFF))[u] = 0u;
    __syncthreads();
    XcdBarrier bar; bar.bar = (unsigned*)(F.ctl + CW_BAR) + args.li * XCD_BAR_WORDS; bar.x = 0; bar.st = nullptr;
    const int lo = args.ph_lo, hi = args.ph_hi;
    if (hi - lo > 1) bar = xcd_barrier_post((unsigned*)(F.ctl + CW_BAR) + args.li * XCD_BAR_WORDS, F.MISC + 8);
#ifndef PH_MASK
#define PH_MASK 0x3fff
#endif
#define IN(k) (((PH_MASK >> (k)) & 1) && lo <= (k) && (k) < hi)
#ifndef REP_MASK
#define REP_MASK 0
#endif
#define REPS(k) (1 + ((REP_MASK >> (k)) & 1))
#define PH_BEGIN() do { int t_ = threadIdx.x; asm volatile("" : "+v"(t_)); F.tid = t_; F.lane = t_ & 63; } while (0)
#define SEAM(k) do { if (IN(k) && IN((k) + 1)) xcd_barrier(bar); } while (0)
    const char* wsb = (const char*)args.ws;
    LAS int* tb = (LAS int*)(F.lds + XTRA_OFF + 9216);

    if (IN(0)) for (int rep = 0; rep < REPS(0); ++rep) { PH_BEGIN(); p0_prologue(F); __syncthreads(); } SEAM(0);
    if (IN(1)) for (int rep = 0; rep < REPS(1); ++rep) { PH_BEGIN(); SchedP1 S{F.G, (int)blockIdx.x}; EpiP1 E{F.ws, F.in[I_B_IN]};
        pg8::gemm_phase<EpiP1, SchedP1, false>(F.lds + RING_OFF, wsb, D, D, D, S, E, nullptr); } SEAM(1);
    if (IN(2)) for (int rep = 0; rep < REPS(2); ++rep) { PH_BEGIN();
        conv_phase(F);
        const int gw = F.vcu * NWAVES + F.wave;
        for (int tk = gw; tk < NB * SBH * (T_ / 32); tk += F.G * NWAVES) sb_attn_wave(F, (tk >> 7) >> 3, (tk >> 7) & 7, tk & 127);
    } SEAM(2);
    if (IN(3)) { PH_BEGIN(); SchedPlain S{F.G, (int)blockIdx.x, 128, 4, (unsigned)WS_MIXIN, (unsigned)WS_WOUT_T, TSTEP, TSTEP, 0u, 0u, 0u}; EpiBf16 E{(bf16*)(F.ws + WS_QM), D, 1.0f, F.in[I_B_OUT]};
        pg8::gemm_phase<EpiBf16, SchedPlain, false>(F.lds + RING_OFF, wsb, D, D, D, S, E, nullptr); } SEAM(3);
    if (IN(4)) { PH_BEGIN(); ln_phase(F, F.in[I_LN1_G], F.in[I_LN1_B]); } SEAM(4);
    if (IN(5)) { PH_BEGIN(); SchedPlain S{F.G, (int)blockIdx.x, 128, 4, (unsigned)WS_HB, (unsigned)WS_WQ_T, TSTEP, TSTEP, 0u, 0u, 0u}; EpiBf16 E{(bf16*)(F.ws + WS_QM), D, MEM_QSCALE, nullptr};
        pg8::gemm_phase<EpiBf16, SchedPlain, false>(F.lds + RING_OFF, wsb, D, D, D, S, E, nullptr); } SEAM(5);
    if (IN(6)) { PH_BEGIN();
        SchedPlain S{F.G, (int)blockIdx.x, 128, 4, (unsigned)WS_QM, (unsigned)WS_KM, TSTEP, 0u, 512u, 512u, TSTEP}; EpiBf16 E{(bf16*)(F.ws + WS_SP), D, 1.0f, nullptr};
        pg8::gemm_phase<EpiBf16, SchedPlain, false>(F.lds + RING_OFF, wsb, D, D, 256, S, E, nullptr); } SEAM(6);
    if (IN(7)) { PH_BEGIN(); softmax_phase(F); } SEAM(7);
    if (IN(8)) { PH_BEGIN();
        SchedPlain S{F.G, (int)blockIdx.x, 128, 4, (unsigned)WS_SP, (unsigned)WS_VMT, TSTEP, 256u * 2048u * 2u, 512u, 0u, 512u}; EpiBf16 E{(bf16*)(F.ws + WS_OB), D, 1.0f, nullptr};
        pg8::gemm_phase<EpiBf16, SchedPlain, false>(F.lds + RING_OFF, wsb, D, 2048, 256, S, E, nullptr); } SEAM(8);
    if (IN(9)) { PH_BEGIN(); SchedPlain S{F.G, (int)blockIdx.x, 128, 4, (unsigned)WS_OB, (unsigned)WS_WO_T, TSTEP, TSTEP, 0u, 0u, 0u}; EpiBf16 E{(bf16*)(F.ws + WS_QM), D, 1.0f, nullptr};
        pg8::gemm_phase<EpiBf16, SchedPlain, false>(F.lds + RING_OFF, wsb, D, D, D, S, E, nullptr); } SEAM(9);
    if (IN(10)) { PH_BEGIN(); ln2_router_phase(F); } SEAM(10);
    if (IN(11)) for (int rep = 0; rep < REPS(11); ++rep) { PH_BEGIN(); moe_table(F, tb); SchedMoe S{F.G, (int)blockIdx.x, 8, tb, (unsigned)WS_HB8, (unsigned)WS_WGU_T, 2048u * 1024u, true}; EpiAct E{F.ws + WS_ACT, F.in[I_B_GU]};
        pg8::gemm_phase<EpiAct, SchedMoe, true, true>(F.lds + RING_OFF, wsb, D / 2, D / 2, D / 2, S, E, (const int*)(F.ws + WS_LTOK)); } SEAM(11);
    if (IN(12)) for (int rep = 0; rep < REPS(12); ++rep) { PH_BEGIN(); moe_table(F, tb); SchedMoe S{F.G, (int)blockIdx.x, 4, tb, (unsigned)WS_ACT, (unsigned)WS_WDN_T, 1024u * 1024u, false}; EpiDown E{(bf16*)(F.ws + WS_YS), F.in[I_B_DOWN], (const float*)(F.ws + WS_LGATE)};
        pg8::gemm_phase<EpiDown, SchedMoe, false, true>(F.lds + RING_OFF, wsb, D / 2, D / 2, D / 2, S, E, nullptr); } SEAM(12);
    if (IN(13)) { PH_BEGIN(); moe_table(F, tb); final_phase(F, tb); }
#undef IN
#undef SEAM
}

extern "C" void kernel_launch(void* const* d_in, const int* in_sizes, int n_in, void* d_out, int out_size, void* d_ws, size_t ws_size, hipStream_t stream) {
    static int grid = 0;
    if (grid == 0) {
        if (n_in != N_IN || out_size != M * D || ws_size < WS_END) { fprintf(stderr, "kernel_launch: unexpected shapes (n_in %d, out %d, ws %zu)\n", n_in, out_size, ws_size); grid = -1; return; }
        int dev = 0, cus = 0, per_cu = 0;
        if (hipGetDevice(&dev) != hipSuccess || hipDeviceGetAttribute(&cus, hipDeviceAttributeMultiprocessorCount, dev) != hipSuccess) { grid = -1; return; }
        if (hipFuncSetAttribute((const void*)mk_fwd, hipFuncAttributeMaxDynamicSharedMemorySize, LDS_BYTES) != hipSuccess) { fprintf(stderr, "kernel_launch: hipFuncSetAttribute failed\n"); grid = -1; return; }
        if (hipOccupancyMaxActiveBlocksPerMultiprocessor(&per_cu, (const void*)mk_fwd, NWAVES * 64, LDS_BYTES) != hipSuccess || per_cu < 1) fprintf(stderr, "kernel_launch: occupancy query says %d\n", per_cu);
        (void)hipGetLastError();
        grid = cus;
    }
    if (grid < 0) return;
    if (hipMemsetAsync((char*)d_ws + WS_CTL, 0, CTL_ZERO_BYTES, stream) != hipSuccess) return;
    Args a{};
    for (int i = 0; i < N_IN; ++i) a.in[i] = (const float*)d_in[i];
    a.out = (float*)d_out; a.ws = (unsigned char*)d_ws;
    for (int li = 0; li < MK_N_LAUNCHES; ++li) {
        a.ph_lo = (MK_N_LAUNCHES == 1) ? 0 : li; a.ph_hi = (MK_N_LAUNCHES == 1) ? NPHASE : li + 1; a.li = (MK_N_LAUNCHES == 1) ? 0 : li;
        hipLaunchKernelGGL(mk_fwd, dim3(grid), dim3(NWAVES * 64), LDS_BYTES, stream, a);
        if (hipPeekAtLastError() != hipSuccess) { fprintf(stderr, "kernel_launch: launch %d failed\n", li); break; }
    }
#ifdef PROBE_PHASES
    { const int pp[] = {PROBE_PHASES}; for (int ph : pp) { a.ph_lo = ph; a.ph_hi = ph + 1; a.li = 15; hipLaunchKernelGGL(mk_fwd, dim3(grid), dim3(NWAVES * 64), LDS_BYTES, stream, a); } }
#endif
}
```

```cpp
#include <hip/hip_runtime.h>
#include <cstdio>
#include <cstdint>

#ifndef MK_N_LAUNCHES
#define MK_N_LAUNCHES 1
#endif

#define GAS __attribute__((address_space(1)))
#define LAS __attribute__((address_space(3)))
typedef unsigned short bf16;
typedef short bf16x8 __attribute__((ext_vector_type(8)));
typedef float f32x4 __attribute__((ext_vector_type(4)));
typedef float f32x2 __attribute__((ext_vector_type(2)));
typedef unsigned u32x4 __attribute__((ext_vector_type(4)));
typedef unsigned u32x2 __attribute__((ext_vector_type(2)));
typedef GAS unsigned gu32;
#define RLX_AGENT __ATOMIC_RELAXED, __HIP_MEMORY_SCOPE_AGENT
#define LDS_WAIT() asm volatile("s_waitcnt lgkmcnt(0)" ::: "memory")
#define VM_WAIT() asm volatile("s_waitcnt vmcnt(0)" ::: "memory")

constexpr int NB = 8, T_ = 4096, D = 1024, M = NB * T_, NMEM = 256, MM = NB * NMEM;
constexpr int CONV_CH = 512, SBH = 8, SBD = 64, SBW = 512, CWID = 31, NE = 32, TOPK = 4, DFF = 1024;
constexpr int INC = 2560;
constexpr float LN_EPS = 1e-5f;
constexpr float DN_ALPHA = 1.189207115002721f;
constexpr float LOG2E = 1.4426950408889634f;
constexpr float SB_QSCALE = 0.125f * LOG2E;
constexpr float MEM_QSCALE = 0.0625f * LOG2E;
constexpr float WGU_SC = 32.0f, WDN_SC = 64.0f;
constexpr int NBLK_MAX = M * TOPK / 256 + NE;
constexpr int LCAP = M;

constexpr size_t MiB = 1u << 20;
constexpr size_t WS_CTL = 0, CTL_ZERO_BYTES = 1 * MiB;
constexpr size_t WS_WIN_T = 1 * MiB;
constexpr size_t WS_WOUT_T = 6 * MiB;
constexpr size_t WS_WQ_T = 8 * MiB, WS_WK_T = 10 * MiB, WS_WV_T = 12 * MiB, WS_WO_T = 14 * MiB;
constexpr size_t WS_WGU_T = 16 * MiB;
constexpr size_t WS_WDN_T = 144 * MiB;
constexpr size_t WS_HB8 = 176 * MiB;
constexpr size_t WS_HB = 208 * MiB;
constexpr size_t WS_LTOK = 272 * MiB;
constexpr size_t WS_LGATE = 276 * MiB;
constexpr size_t WS_SIDX = 280 * MiB;
constexpr size_t WS_WR = 281 * MiB;
constexpr size_t WS_HB2 = 832 * MiB;
constexpr size_t WS_X = 288 * MiB;
constexpr size_t WS_U = WS_X;
constexpr size_t WS_Q = WS_X + 32 * MiB;
constexpr size_t WS_K = WS_X + 64 * MiB;
constexpr size_t WS_V = WS_X + 96 * MiB;
constexpr size_t WS_MIXIN = WS_X + 128 * MiB;
constexpr size_t WS_QM = WS_X + 192 * MiB;
constexpr size_t WS_SP = WS_X + 256 * MiB;
constexpr size_t WS_OB = WS_X + 320 * MiB;
constexpr size_t WS_MEMN = WS_X + 384 * MiB;
constexpr size_t WS_KM = WS_X + 388 * MiB;
constexpr size_t WS_VMT = WS_X + 392 * MiB;
constexpr size_t WS_ACT = WS_X;
constexpr size_t WS_YS = WS_X + 272 * MiB;
constexpr size_t WS_END = 896 * MiB;
constexpr int CW_TMO = 0, CW_CODE = 1;
constexpr int CW_BAR = 4096;
constexpr int CW_ECNT = 131072;
constexpr int NPHASE = 14;

constexpr int RING_OFF = 0, RING_BYTES = 131072;
constexpr int LDS_BYTES = 163840;
constexpr int LDSCTL_OFF = LDS_BYTES - 1024, MISC_OFF = LDSCTL_OFF + 320;
constexpr int XTRA_OFF = RING_BYTES;
constexpr int TB_OFF = XTRA_OFF + 20480;
constexpr int WR_STRIDE = 1032;
constexpr int P10_WR = 0, P10_GB = 2 * 32 * WR_STRIDE * 2, P10_LCNT = P10_GB + 8192, P10_REC = P10_LCNT + 512;
static_assert(P10_REC + 8192 <= TB_OFF && TB_OFF + 4 * (128 + 544) <= LDSCTL_OFF, "LDS map");
constexpr int NWAVES = 8;

__device__ __forceinline__ unsigned f2bf(float f) { unsigned u = __builtin_bit_cast(unsigned, f); return (u + 0x7fffu + ((u >> 16) & 1u)) >> 16; }
__device__ __forceinline__ unsigned pk2(float lo, float hi) { return f2bf(lo) | (f2bf(hi) << 16); }
__device__ __forceinline__ float bflo(unsigned u) { return __builtin_bit_cast(float, u << 16); }
__device__ __forceinline__ float bfhi(unsigned u) { return __builtin_bit_cast(float, u & 0xffff0000u); }
__device__ __forceinline__ float wave_sum(float v) {
#pragma unroll
    for (int o = 1; o < 64; o <<= 1) v += __shfl_xor(v, o);
    return v;
}
__device__ __forceinline__ float wave_max(float v) {
#pragma unroll
    for (int o = 1; o < 64; o <<= 1) v = fmaxf(v, __shfl_xor(v, o));
    return v;
}
__device__ __forceinline__ unsigned pk4_fp8(float a, float b, float c, float d) {
    int r = __builtin_amdgcn_cvt_pk_fp8_f32(a, b, 0, false); r = __builtin_amdgcn_cvt_pk_fp8_f32(c, d, r, true); return (unsigned)r; }
__device__ __forceinline__ float sigmoidf_fast(float x) { return __builtin_amdgcn_rcpf(1.0f + __expf(-x)); }

namespace pg8 {
constexpr int BM = 256, BK = 64, HALF = 128, HTB = HALF * BK * 2, STAGE_BYTES = 8 * HTB, NXCD = 8, WGM = 8;
__host__ __device__ __forceinline__ int lds_byte(int r, int c) { const int st = (r >> 4) * 2 + (c >> 5), rr = r & 15, cc = c & 31, ob = rr * 64 + cc * 2; return st * 1024 + (ob ^ (((ob >> 9) & 1) << 5)); }
__host__ __device__ __forceinline__ void stage_rc(int b, int& R, int& C) { const int st = b / 1024, sb = b % 1024, swz = sb ^ (((sb >> 9) & 1) << 5); R = (st >> 1) * 16 + swz / 64; C = (st & 1) * 32 + (swz % 64) / 2; }
__host__ __device__ __forceinline__ int perm32(int rho) { const int n = rho >> 4, i = rho & 15; return 8 * (i >> 2) + 4 * n + (i & 3); }

struct Unit { int pm, pn, z, nvalid; unsigned aoff, boff, goff; };

__device__ __forceinline__ void tile_order(int L, int nM, int nN, int& pm, int& pn) {
    const int nwg = nM * nN; int wgid = L;
    { const int q = nwg / NXCD, r = nwg % NXCD, xcd = wgid % NXCD, off = wgid / NXCD; wgid = (xcd < r ? xcd * (q + 1) : r * (q + 1) + (xcd - r) * q) + off; }
    const int nig = WGM * nN, gid = wgid / nig, fm = gid * WGM, gsz = (nM - fm) < WGM ? (nM - fm) : WGM;
    pm = fm + ((wgid % nig) % gsz); pn = (wgid % nig) / gsz;
}
__device__ __forceinline__ unsigned cvt_pk_bf16(float lo, float hi) { unsigned r; asm volatile("v_cvt_pk_bf16_f32 %0, %1, %2" : "=v"(r) : "v"(lo), "v"(hi)); return r; }

__device__ __forceinline__ void store_tile_bf16(const f32x4 (&acc)[2][2][4][2], bf16* p0, size_t ldc, const float* bias, float scale, int wc, int fq) {
    const int cl = wc * 32 + 8 * fq;
    f32x4 bv[2][2];
#pragma unroll
    for (int bj = 0; bj < 2; ++bj)
#pragma unroll
        for (int n = 0; n < 2; ++n) bv[bj][n] = bias ? *(const f32x4*)(bias + cl + bj * HALF + 4 * n) : (f32x4){0.f, 0.f, 0.f, 0.f};
#pragma unroll
    for (int ai = 0; ai < 2; ++ai)
#pragma unroll
        for (int m = 0; m < 4; ++m) { bf16* rowp = p0 + (size_t)(ai * HALF + m * 16) * ldc + cl;
#pragma unroll
            for (int bj = 0; bj < 2; ++bj) { const f32x4 v0 = (acc[ai][bj][m][0] + bv[bj][0]) * scale, v1 = (acc[ai][bj][m][1] + bv[bj][1]) * scale;
                u32x4 w; w.x = cvt_pk_bf16(v0[0], v0[1]); w.y = cvt_pk_bf16(v0[2], v0[3]); w.z = cvt_pk_bf16(v1[0], v1[1]); w.w = cvt_pk_bf16(v1[2], v1[3]);
                *(u32x4*)(rowp + bj * HALF) = w; } }
}

typedef int v8i __attribute__((ext_vector_type(8)));
template <class Epi, class Sched, bool GATHER, bool FP8 = false>
__device__ __forceinline__ void gemm_phase(LAS unsigned char* lds, const char* wsb, const int lda, const int ldb, const int K, const Sched& S, const Epi& E, const int* glist) {
    int tid = threadIdx.x; asm volatile("" : "+v"(tid));
    const int wid = __builtin_amdgcn_readfirstlane(tid >> 6), lane = tid & 63, wr = wid >> 2, wc = wid & 3, fr = lane & 15, fq = lane >> 4;
    const int nt = K / BK;
    unsigned voffA[2], voffB[2];
#pragma unroll
    for (int i = 0; i < 2; ++i) { int R, C; stage_rc(tid * 16 + i * 8192, R, C); const int Rb = Epi::PERM ? ((R & ~31) + perm32(R & 31)) : R;
        voffA[i] = (unsigned)(R * lda + C) * 2u; voffB[i] = (unsigned)(Rb * ldb + C) * 2u; }
    const size_t kstep = (size_t)(BK * 2);
    const size_t hstepA = (size_t)HALF * lda * 2, hstepB = (size_t)HALF * ldb * 2;
    const unsigned ldsw = (unsigned)wid * 1024u;
    const int aoff = lds_byte(wr * 64 + fr, fq * 8), boff = lds_byte(wc * 32 + fr, fq * 8);
    unsigned gc[2][2], gn[2][2];
#define PG8_SA(b, h) (((b) * 2 + (h)) * HTB)
#define PG8_SB(b, h) ((4 + (b) * 2 + (h)) * HTB)
#define PG8_STAGE_B(bufoff, gbase) do { _Pragma("unroll") for (int _i = 0; _i < 2; ++_i) \
        __builtin_amdgcn_global_load_lds((const unsigned*)((const char*)(gbase) + voffB[_i]), (LAS unsigned*)(lds + (bufoff) + ldsw + _i * 8192), 16, 0, 0); } while (0)
#define PG8_STAGE_A(bufoff, gbase, h, nx) do { _Pragma("unroll") for (int _i = 0; _i < 2; ++_i) { \
        const char* _p = GATHER ? (const char*)(gbase) + ((nx) ? gn[h][_i] : gc[h][_i]) : (const char*)(gbase) + (h) * hstepA + voffA[_i]; \
        __builtin_amdgcn_global_load_lds((const unsigned*)_p, (LAS unsigned*)(lds + (bufoff) + ldsw + _i * 8192), 16, 0, 0); } } while (0)
#define PG8_LDA(dst, b, h) do { _Pragma("unroll") for (int m = 0; m < 4; ++m) { if constexpr (FP8) { const u32x4 _lo = *(const LAS u32x4*)(lds + PG8_SA(b, h) + aoff + m * 2048), _hi = *(const LAS u32x4*)(lds + PG8_SA(b, h) + aoff + m * 2048 + 1024); \
            dst##8[m] = (v8i){(int)_lo.x, (int)_lo.y, (int)_lo.z, (int)_lo.w, (int)_hi.x, (int)_hi.y, (int)_hi.z, (int)_hi.w}; } \
        else { _Pragma("unroll") for (int k = 0; k < 2; ++k) dst[m][k] = *(const LAS bf16x8*)(lds + PG8_SA(b, h) + aoff + m * 2048 + k * 1024); } } } while (0)
#define PG8_LDB(dst, b, h) do { _Pragma("unroll") for (int n = 0; n < 2; ++n) { if constexpr (FP8) { const u32x4 _lo = *(const LAS u32x4*)(lds + PG8_SB(b, h) + boff + n * 2048), _hi = *(const LAS u32x4*)(lds + PG8_SB(b, h) + boff + n * 2048 + 1024); \
            dst##8[n] = (v8i){(int)_lo.x, (int)_lo.y, (int)_lo.z, (int)_lo.w, (int)_hi.x, (int)_hi.y, (int)_hi.z, (int)_hi.w}; } \
        else { _Pragma("unroll") for (int k = 0; k < 2; ++k) dst[n][k] = *(const LAS bf16x8*)(lds + PG8_SB(b, h) + boff + n * 2048 + k * 1024); } } } while (0)
#define PG8_MMA(ai, bj, At, Bt) do { __builtin_amdgcn_s_setprio(1); if constexpr (FP8) asm volatile("s_nop 1"); _Pragma("unroll") for (int m = 0; m < 4; ++m) _Pragma("unroll") for (int n = 0; n < 2; ++n) { \
        if constexpr (FP8) asm volatile("v_mfma_f32_16x16x128_f8f6f4 %0, %1, %2, %0" : "+v"(acc[ai][bj][m][n]) : "v"(Bt##8[n]), "v"(At##8[m])); \
        else { _Pragma("unroll") for (int k = 0; k < 2; ++k) acc[ai][bj][m][n] = __builtin_amdgcn_mfma_f32_16x16x32_bf16(Bt[n][k], At[m][k], acc[ai][bj][m][n], 0, 0, 0); } } \
        __builtin_amdgcn_s_setprio(0); } while (0)
#define PG8_WAIT_V(n) asm volatile("s_waitcnt vmcnt(" #n ")" ::: "memory")
#define PG8_WAIT_L(n) asm volatile("s_waitcnt lgkmcnt(" #n ")" ::: "memory")
#define PG8_BAR __builtin_amdgcn_s_barrier()
#define PG8_SCHED __builtin_amdgcn_sched_barrier(0)
#define PG8_GIDX(g, u) do { _Pragma("unroll") for (int _h = 0; _h < 2; ++_h) _Pragma("unroll") for (int _i = 0; _i < 2; ++_i) { int _R, _C; stage_rc(tid * 16 + _i * 8192, _R, _C); const int _r = _h * HALF + _R; \
        const int _tok = glist[(u).goff + (_r < (u).nvalid ? _r : (u).nvalid - 1)]; g[_h][_i] = (unsigned)_tok * (unsigned)(lda * 2) + (unsigned)(_C * 2); } } while (0)
    Unit cur, nxt, nn; int ui = 0;
    if (!S.next(0, cur)) return;
    f32x4 acc[2][2][4][2];
#pragma unroll
    for (int a = 0; a < 2; ++a)
#pragma unroll
        for (int b = 0; b < 2; ++b)
#pragma unroll
            for (int m = 0; m < 4; ++m)
#pragma unroll
                for (int n = 0; n < 2; ++n) acc[a][b][m][n] = (f32x4){0.f, 0.f, 0.f, 0.f};
    bf16x8 At[4][2], B0[2][2], B1[2][2];
    v8i At8[4], B08[2], B18[2];
    const char* cA = wsb + cur.aoff; const char* cB = wsb + cur.boff;
    if constexpr (GATHER) { PG8_GIDX(gc, cur); if (S.next(1, nxt)) { PG8_GIDX(gn, nxt); } else { PG8_GIDX(gn, cur); }
        asm volatile("s_waitcnt vmcnt(0)" : "+v"(gc[0][0]), "+v"(gc[0][1]), "+v"(gc[1][0]), "+v"(gc[1][1]), "+v"(gn[0][0]), "+v"(gn[0][1]), "+v"(gn[1][0]), "+v"(gn[1][1]) :: "memory"); }
    else {
#pragma unroll
        for (int h = 0; h < 2; ++h)
#pragma unroll
            for (int i = 0; i < 2; ++i) { gc[h][i] = 0u; gn[h][i] = 0u; } }
    PG8_STAGE_B(PG8_SB(0, 0), cB); PG8_STAGE_B(PG8_SB(0, 1), cB + hstepB); PG8_STAGE_A(PG8_SA(0, 0), cA, 0, false); PG8_STAGE_A(PG8_SA(0, 1), cA, 1, false);
    if (wr == 1) PG8_BAR;
    PG8_WAIT_V(2); PG8_BAR;
    PG8_STAGE_B(PG8_SB(1, 0), cB + kstep); PG8_STAGE_A(PG8_SA(1, 0), cA + kstep, 0, false); PG8_STAGE_B(PG8_SB(1, 1), cB + hstepB + kstep);
    PG8_WAIT_V(6); PG8_BAR;
    for (;;) {
        const bool has_next = S.next(ui + 1, nxt);
        const char* nA = has_next ? wsb + nxt.aoff : cA; const char* nB = has_next ? wsb + nxt.boff : cB;
#pragma clang loop unroll(disable)
        for (int t = 0; t < nt; t += 2) {
            const bool last = (t == nt - 2);
            const char* a1 = cA + (size_t)(t + 1) * kstep;
            const char* a2 = last ? nA : cA + (size_t)(t + 2) * kstep; const char* b2 = last ? nB : cB + (size_t)(t + 2) * kstep;
            const char* a3 = a2 + kstep; const char* b3 = b2 + kstep;
            PG8_LDB(B0, 0, 0); PG8_LDB(B1, 0, 1); PG8_SCHED; PG8_LDA(At, 0, 0); PG8_STAGE_A(PG8_SA(1, 1), a1, 1, false);
            PG8_WAIT_V(8); PG8_WAIT_L(0); PG8_BAR; PG8_MMA(0, 0, At, B0); PG8_MMA(0, 1, At, B1); PG8_BAR; PG8_SCHED;
            PG8_LDA(At, 0, 1); PG8_STAGE_B(PG8_SB(0, 0), b2); PG8_STAGE_B(PG8_SB(0, 1), b2 + hstepB); PG8_STAGE_A(PG8_SA(0, 0), a2, 0, last);
            PG8_WAIT_V(8); PG8_WAIT_L(0); PG8_BAR; PG8_MMA(1, 0, At, B0); PG8_MMA(1, 1, At, B1); PG8_BAR; PG8_SCHED;
            PG8_LDB(B0, 1, 0); PG8_LDB(B1, 1, 1); PG8_SCHED; PG8_LDA(At, 1, 0); PG8_STAGE_A(PG8_SA(0, 1), a2, 1, last);
            PG8_WAIT_V(8); PG8_WAIT_L(0); PG8_BAR; PG8_MMA(0, 0, At, B0); PG8_MMA(0, 1, At, B1); PG8_BAR; PG8_SCHED;
            PG8_LDA(At, 1, 1); PG8_STAGE_B(PG8_SB(1, 0), b3); PG8_STAGE_B(PG8_SB(1, 1), b3 + hstepB); PG8_STAGE_A(PG8_SA(1, 0), a3, 0, last);
            PG8_WAIT_V(8); PG8_WAIT_L(0); PG8_BAR; PG8_MMA(1, 0, At, B0); PG8_MMA(1, 1, At, B1); PG8_BAR; PG8_SCHED;
        }
        if constexpr (FP8) asm volatile("s_nop 15\n\ts_nop 7");
        if (wr == 0) PG8_BAR;
        if constexpr (GATHER) {
#pragma unroll
            for (int h = 0; h < 2; ++h)
#pragma unroll
                for (int i = 0; i < 2; ++i) gc[h][i] = gn[h][i];
            if (has_next && S.next(ui + 2, nn)) { PG8_GIDX(gn, nn); }
        }
        E(acc, cur, wr, wc, fr, fq);
        if constexpr (GATHER) asm volatile("" : "+v"(gn[0][0]), "+v"(gn[0][1]), "+v"(gn[1][0]), "+v"(gn[1][1]));
        if (!has_next) break;
#pragma unroll
        for (int a = 0; a < 2; ++a)
#pragma unroll
            for (int b = 0; b < 2; ++b)
#pragma unroll
                for (int m = 0; m < 4; ++m)
#pragma unroll
                    for (int n = 0; n < 2; ++n) acc[a][b][m][n] = (f32x4){0.f, 0.f, 0.f, 0.f};
        cur = nxt; cA = nA; cB = nB; ++ui;
        if (wr == 1) PG8_BAR;
    }
    PG8_WAIT_V(0);
    PG8_BAR;
#undef PG8_SA
#undef PG8_SB
#undef PG8_STAGE_A
#undef PG8_STAGE_B
#undef PG8_LDA
#undef PG8_LDB
#undef PG8_MMA
#undef PG8_WAIT_V
#undef PG8_WAIT_L
#undef PG8_BAR
#undef PG8_SCHED
#undef PG8_GIDX
}
}
using pg8::Unit;

#define XB_TMO      128
#define XB_XCNT(j)  (256  + 64 * (j))
#define XB_XSUB(j)  (1280 + 64 * (j))
#define XB_XGEN(j)  (2304 + 64 * (j))
#define XB_TOP      3328
#define XB_TOPGEN   3392
#define XCD_BAR_WORDS 3456
#define XB_SPIN_CAP (1u << 18)
__device__ __forceinline__ unsigned xb_ld(unsigned* p)              { return __hip_atomic_load(p, __ATOMIC_RELAXED, __HIP_MEMORY_SCOPE_AGENT); }
__device__ __forceinline__ unsigned xb_add(unsigned* p, unsigned v) { return __hip_atomic_fetch_add(p, v, __ATOMIC_RELAXED, __HIP_MEMORY_SCOPE_AGENT); }
__device__ __forceinline__ unsigned xb_xcc_id() { return (unsigned)__builtin_amdgcn_s_getreg((3 << 11) | 20) & 0xFu; }
#define XB_SPIN(cond, bar) do { unsigned _sp = 0; while (cond) { __builtin_amdgcn_s_sleep(1); \
    if ((++_sp & 255u) == 0u) { if (xb_ld(&(bar)[XB_TMO])) break; if (_sp > XB_SPIN_CAP) { atomicAdd(&(bar)[XB_TMO], 1u); break; } } } } while (0)
struct XcdBarrier { unsigned* bar; unsigned x; volatile LAS unsigned* st; };
__device__ __forceinline__ XcdBarrier xcd_barrier_post(unsigned* bar, volatile LAS unsigned* st) {
    XcdBarrier b; b.bar = bar; b.x = xb_xcc_id(); b.st = st;
    if (threadIdx.x == 0) (void)xb_add(&bar[XB_XCNT(b.x)], 1u);
    return b;
}
__device__ __forceinline__ void xcd_barrier_complete(unsigned* bar, unsigned x, unsigned& nloc, unsigned& nx) {
    const unsigned G = gridDim.x * gridDim.y * gridDim.z;
    unsigned sum, cnt, mine, sp = 0u;
    for (;;) {
        sum = 0u; cnt = 0u; mine = 0u;
#pragma unroll
        for (unsigned j = 0; j < 16; ++j) { const unsigned c = xb_ld(&bar[XB_XCNT(j)]); sum += c; cnt += (c > 0u) ? 1u : 0u; mine = (j == x) ? c : mine; }
        if (sum == G) break;
        __builtin_amdgcn_s_sleep(1);
        if ((++sp & 255u) == 0u) { if (xb_ld(&bar[XB_TMO])) break; if (sp > XB_SPIN_CAP) { atomicAdd(&bar[XB_TMO], 1u); break; } }
    }
    nloc = mine > 0u ? mine : 1u; nx = cnt > 0u ? cnt : 1u;
}
__device__ __forceinline__ void xcd_barrier(const XcdBarrier& b) {
    asm volatile("s_waitcnt vmcnt(0)" ::: "memory");
    __syncthreads();
    if (threadIdx.x == 0) {
        unsigned* bar = b.bar;
        __builtin_amdgcn_s_waitcnt(0);
        unsigned nloc = b.st[0], nx = b.st[1];
        if (nloc == 0u) { xcd_barrier_complete(bar, b.x, nloc, nx); b.st[0] = nloc; b.st[1] = nx; }
        const unsigned old = xb_add(&bar[XB_XSUB(b.x)], 1u);
        const unsigned gen = old / nloc;
        if (old + 1u == (gen + 1u) * nloc) {
            __builtin_amdgcn_fence(__ATOMIC_RELEASE, "agent");
            asm volatile("s_waitcnt vmcnt(0)" ::: "memory");
            const unsigned og = xb_add(&bar[XB_TOP], 1u);
            const unsigned tg = og / nx;
            if (og + 1u == (tg + 1u) * nx) xb_add(&bar[XB_TOPGEN], 1u);
            else XB_SPIN(xb_ld(&bar[XB_TOPGEN]) == tg, bar);
            __builtin_amdgcn_fence(__ATOMIC_ACQUIRE, "agent");
            xb_add(&bar[XB_XGEN(b.x)], 1u);
            asm volatile("s_waitcnt vmcnt(0)" ::: "memory");
        } else {
            XB_SPIN(xb_ld(&bar[XB_XGEN(b.x)]) == gen, bar);
            __builtin_amdgcn_fence(__ATOMIC_ACQUIRE, "agent");
            asm volatile("s_waitcnt vmcnt(0)" ::: "memory");
        }
    }
    __syncthreads();
}

struct Frame {
    LAS unsigned char* lds;
    volatile LAS unsigned* MISC;
    gu32* ctl;
    unsigned char* ws;
    int tid, lane, wave, vcu, G;
    float* hf;
    const float* const* in;
};
enum In { I_X = 0, I_MEM, I_LN_IN_G, I_LN_IN_B, I_LN_MEM_G, I_LN_MEM_B, I_W_IN, I_B_IN, I_W_DW, I_B_DW, I_LN_CONV_G, I_LN_CONV_B, I_W_OUT, I_B_OUT, I_LN1_G, I_LN1_B,
          I_WQ, I_WK, I_WV, I_WO, I_LN2_G, I_LN2_B, I_W_ROUTER, I_B_ROUTER, I_W_GU, I_B_GU, I_W_DOWN, I_B_DOWN, I_LN3_G, I_LN3_B, N_IN };

__device__ __forceinline__ void p0_transpose_item(const float* W, int K, int N, bf16* WT, int k0, int n0, int drow, LAS float* scr, int lane) {
#pragma unroll 8
    for (int i = 0; i < 32; ++i) { const int kk = 2 * i + (lane >> 5); scr[kk * 33 + (lane & 31)] = W[(size_t)(k0 + kk) * N + n0 + (lane & 31)]; }
    LDS_WAIT(); asm volatile("" ::: "memory");
    const int c = lane & 7;
#pragma unroll
    for (int j = 0; j < 4; ++j) { const int n = (lane >> 3) + 8 * j; const LAS float* s = scr + (8 * c) * 33 + n;
        u32x4 o; o.x = pk2(s[0 * 33], s[1 * 33]); o.y = pk2(s[2 * 33], s[3 * 33]); o.z = pk2(s[4 * 33], s[5 * 33]); o.w = pk2(s[6 * 33], s[7 * 33]);
        *(GAS u32x4*)(WT + (size_t)(drow + n) * K + k0 + 8 * c) = o; }
    LDS_WAIT(); asm volatile("" ::: "memory");
}
__device__ __forceinline__ void ln_row(f32x4 (&v)[4], const float* g, const float* b, int lane) {
    float s = 0.f;
#pragma unroll
    for (int j = 0; j < 4; ++j) s += (v[j].x + v[j].y) + (v[j].z + v[j].w);
    const float mean = wave_sum(s) * (1.f / D); float s2 = 0.f;
#pragma unroll
    for (int j = 0; j < 4; ++j) { v[j] = v[j] - mean; s2 += (v[j].x * v[j].x + v[j].y * v[j].y) + (v[j].z * v[j].z + v[j].w * v[j].w); }
    const float rstd = 1.f / sqrtf(wave_sum(s2) * (1.f / D) + LN_EPS);
#pragma unroll
    for (int j = 0; j < 4; ++j) { const f32x4 gg = ((const GAS f32x4*)g)[lane + 64 * j], bb = ((const GAS f32x4*)b)[lane + 64 * j]; v[j] = v[j] * rstd * gg + bb; }
}
__device__ __forceinline__ void store_row_bf16(const f32x4 (&v)[4], bf16* orow, int lane) {
    GAS u32x2* o8 = (GAS u32x2*)orow + lane;
#pragma unroll
    for (int j = 0; j < 4; ++j) o8[64 * j] = (u32x2){pk2(v[j].x, v[j].y), pk2(v[j].z, v[j].w)};
}
__device__ __forceinline__ void p0_transpose_item8(const float* W, int K, int N, unsigned char* WT, int k0, int n0, int drow, float sc, LAS float* scr, int lane) {
#pragma unroll 8
    for (int i = 0; i < 32; ++i) { const int kk = 2 * i + (lane >> 5); scr[kk * 33 + (lane & 31)] = W[(size_t)(k0 + kk) * N + n0 + (lane & 31)]; }
    LDS_WAIT(); asm volatile("" ::: "memory");
    const int c = lane & 7;
#pragma unroll
    for (int j = 0; j < 4; ++j) { const int n = (lane >> 3) + 8 * j; const LAS float* s = scr + (8 * c) * 33 + n;
        u32x2 o; o.x = pk4_fp8(s[0 * 33] * sc, s[1 * 33] * sc, s[2 * 33] * sc, s[3 * 33] * sc); o.y = pk4_fp8(s[4 * 33] * sc, s[5 * 33] * sc, s[6 * 33] * sc, s[7 * 33] * sc);
        *(GAS u32x2*)(WT + (size_t)(drow + n) * K + k0 + 8 * c) = o; }
    LDS_WAIT(); asm volatile("" ::: "memory");
}
__device__ __forceinline__ void load_row_bf16(f32x4 (&v)[4], const bf16* xrow, int lane) {
    const GAS u32x2* xr = (const GAS u32x2*)xrow + lane;
#pragma unroll
    for (int j = 0; j < 4; ++j) { const u32x2 w = xr[64 * j]; v[j] = (f32x4){bflo(w.x), bfhi(w.x), bflo(w.y), bfhi(w.y)}; }
}
__device__ __forceinline__ void load_row_f32(f32x4 (&v)[4], const float* xrow, int lane) {
    const GAS f32x4* xr = (const GAS f32x4*)xrow + lane;
#pragma unroll
    for (int j = 0; j < 4; ++j) v[j] = xr[64 * j];
}
__device__ __forceinline__ void store_row_f32(const f32x4 (&v)[4], float* orow, int lane) {
    GAS f32x4* o = (GAS f32x4*)orow + lane;
#pragma unroll
    for (int j = 0; j < 4; ++j) o[64 * j] = v[j];
}

__device__ __forceinline__ void p0_prologue(Frame& F) {
    LAS float* scr = (LAS float*)(F.lds + RING_OFF + F.wave * 16384);
    const int gw = F.vcu * NWAVES + F.wave, NGW = F.G * NWAVES;
    constexpr int I_IN = 16 * 80, I_SQ = 16 * 32, I_GU = NE * 16 * 64, I_DN = NE * 16 * 32;
    constexpr int NITEMS = I_IN + 5 * I_SQ + I_GU + I_DN;
    for (int it = gw; it < NITEMS; it += NGW) {
        int r = it;
        if (r < I_IN) { const int kb = r / 80, nb = r % 80, n0 = 32 * nb; int drow;
            if (n0 < 512) drow = (n0 >> 7) * 256 + (n0 & 127); else if (n0 < 1024) drow = ((n0 - 512) >> 7) * 256 + 128 + (n0 & 127); else drow = n0;
            p0_transpose_item(F.in[I_W_IN], D, INC, (bf16*)(F.ws + WS_WIN_T), 64 * kb, n0, drow, scr, F.lane); continue; } r -= I_IN;
        if (r < 5 * I_SQ) { const int w = r / I_SQ, q = r % I_SQ, kb = q / 32, nb = q % 32;
            const float* src = F.in[w == 0 ? I_W_OUT : w == 1 ? I_WQ : w == 2 ? I_WK : w == 3 ? I_WV : I_WO];
            bf16* dst = (bf16*)(F.ws + (w == 0 ? WS_WOUT_T : w == 1 ? WS_WQ_T : w == 2 ? WS_WK_T : w == 3 ? WS_WV_T : WS_WO_T));
            p0_transpose_item(src, D, D, dst, 64 * kb, 32 * nb, 32 * nb, scr, F.lane); continue; } r -= 5 * I_SQ;
        if (r < I_GU) { const int e = r / (16 * 64), q = r % (16 * 64), kb = q / 64, nb = q % 64, n0 = 32 * nb;
            const int drow = (n0 < 1024) ? (n0 >> 7) * 256 + (n0 & 127) : ((n0 - 1024) >> 7) * 256 + 128 + (n0 & 127);
            p0_transpose_item8(F.in[I_W_GU] + (size_t)e * D * 2 * DFF, D, 2 * DFF, F.ws + WS_WGU_T + (size_t)e * 2 * DFF * D, 64 * kb, n0, drow, WGU_SC, scr, F.lane); continue; } r -= I_GU;
        { const int e = r / (16 * 32), q = r % (16 * 32), kb = q / 32, nb = q % 32;
            p0_transpose_item8(F.in[I_W_DOWN] + (size_t)e * DFF * D, DFF, D, F.ws + WS_WDN_T + (size_t)e * D * DFF, 64 * kb, 32 * nb, 32 * nb, WDN_SC, scr, F.lane); }
    }
    if (gw < 512) { const int idx = gw * 64 + F.lane, c = idx >> 5, e = idx & 31; const float w = F.in[I_W_ROUTER][idx];
        const unsigned hi = f2bf(w), lo = f2bf(w - __builtin_bit_cast(float, hi << 16)); bf16* wr = (bf16*)(F.ws + WS_WR);
        wr[e * WR_STRIDE + c] = (bf16)hi; wr[(32 + e) * WR_STRIDE + c] = (bf16)lo; }
    for (int m = gw; m < M + MM; m += NGW) {
        f32x4 v[4];
        if (m < M) { load_row_f32(v, F.in[I_X] + (size_t)m * D, F.lane); ln_row(v, F.in[I_LN_IN_G], F.in[I_LN_IN_B], F.lane);
            store_row_bf16(v, (bf16*)(F.ws + WS_HB) + (size_t)m * D, F.lane); }
        else { const int mm = m - M; load_row_f32(v, F.in[I_MEM] + (size_t)mm * D, F.lane); ln_row(v, F.in[I_LN_MEM_G], F.in[I_LN_MEM_B], F.lane);
            store_row_bf16(v, (bf16*)(F.ws + WS_MEMN) + (size_t)mm * D, F.lane); }
    }
}

constexpr unsigned TSTEP = 256u * 1024u * 2u;
struct SchedP1 { int G, c;
    __device__ __forceinline__ bool next(int i, Unit& u) const {
        const int L = i * G + c; if (L >= 1344) return false;
        u.nvalid = 256; u.goff = 0;
        if (L < 1024) { pg8::tile_order(L, 128, 8, u.pm, u.pn); u.z = 0; u.aoff = (unsigned)WS_HB + (unsigned)u.pm * TSTEP; u.boff = (unsigned)WS_WIN_T + (unsigned)u.pn * TSTEP; }
        else if (L < 1280) { const int j = L - 1024; u.pm = j & 1; u.pn = j >> 1; u.z = 3; u.aoff = (unsigned)WS_WIN_T + (unsigned)(8 + u.pm) * TSTEP; u.boff = (unsigned)WS_HB + (unsigned)u.pn * TSTEP; }
        else if (L < 1312) { const int j = L - 1280; u.pm = j & 7; u.pn = j >> 3; u.z = 1; u.aoff = (unsigned)WS_MEMN + (unsigned)u.pm * TSTEP; u.boff = (unsigned)WS_WK_T + (unsigned)u.pn * TSTEP; }
        else { const int j = L - 1312; u.pm = j & 3; u.pn = j >> 2; u.z = 2; u.aoff = (unsigned)WS_WV_T + (unsigned)u.pm * TSTEP; u.boff = (unsigned)WS_MEMN + (unsigned)u.pn * TSTEP; }
        return true; }
};
struct EpiP1 { static constexpr bool PERM = true;
    unsigned char* ws; const float* b_in;
    __device__ __forceinline__ void operator()(const f32x4 (&acc)[2][2][4][2], const Unit& u, int wr, int wc, int fr, int fq) const {
        const int row0 = u.pm * 256 + wr * 64 + fr;
        if (u.z == 0) {
            if (u.pn < 4) {
                const int ch = 128 * u.pn + wc * 32 + 8 * fq;
                f32x4 bv[2], bg[2];
#pragma unroll
                for (int n = 0; n < 2; ++n) { bv[n] = *(const f32x4*)(b_in + ch + 4 * n); bg[n] = *(const f32x4*)(b_in + 512 + ch + 4 * n); }
                bf16* U = (bf16*)(ws + WS_U);
#pragma unroll
                for (int ai = 0; ai < 2; ++ai)
#pragma unroll
                    for (int m = 0; m < 4; ++m) { f32x4 o[2];
#pragma unroll
                        for (int n = 0; n < 2; ++n) { const f32x4 a = acc[ai][0][m][n] + bv[n], g = acc[ai][1][m][n] + bg[n];
#pragma unroll
                            for (int j = 0; j < 4; ++j) o[n][j] = a[j] * sigmoidf_fast(g[j]); }
                        u32x4 w; w.x = pg8::cvt_pk_bf16(o[0][0], o[0][1]); w.y = pg8::cvt_pk_bf16(o[0][2], o[0][3]); w.z = pg8::cvt_pk_bf16(o[1][0], o[1][1]); w.w = pg8::cvt_pk_bf16(o[1][2], o[1][3]);
                        *(u32x4*)(U + (size_t)(row0 + ai * 128 + m * 16) * 512 + ch) = w; }
            } else {
                const int t = u.pn - 4, which = t >> 1, cb = (t & 1) * 256;
                bf16* dst = (bf16*)(ws + (which == 0 ? WS_Q : WS_K));
                pg8::store_tile_bf16(acc, dst + (size_t)row0 * 512 + cb, 512, b_in + 1024 + 256 * t, which == 0 ? SB_QSCALE : 1.0f, wc, fq);
            }
        } else if (u.z == 3) {
            const float* rb = b_in + 2048 + row0; bf16* p0 = (bf16*)(ws + WS_V) + (size_t)row0 * M + 256 * u.pn; const int cl = wc * 32 + 8 * fq;
#pragma unroll
            for (int ai = 0; ai < 2; ++ai)
#pragma unroll
                for (int m = 0; m < 4; ++m) { const float bv = rb[ai * 128 + m * 16]; bf16* rowp = p0 + (size_t)(ai * 128 + m * 16) * M + cl;
#pragma unroll
                    for (int bj = 0; bj < 2; ++bj) { const f32x4 v0 = acc[ai][bj][m][0] + bv, v1 = acc[ai][bj][m][1] + bv;
                        u32x4 w; w.x = pg8::cvt_pk_bf16(v0[0], v0[1]); w.y = pg8::cvt_pk_bf16(v0[2], v0[3]); w.z = pg8::cvt_pk_bf16(v1[0], v1[1]); w.w = pg8::cvt_pk_bf16(v1[2], v1[3]);
                        *(u32x4*)(rowp + bj * 128) = w; } }
        } else if (u.z == 1) pg8::store_tile_bf16(acc, (bf16*)(ws + WS_KM) + (size_t)row0 * 1024 + 256 * u.pn, 1024, nullptr, 1.0f, wc, fq);
        else pg8::store_tile_bf16(acc, (bf16*)(ws + WS_VMT) + (size_t)row0 * 2048 + 256 * u.pn, 2048, nullptr, 1.0f, wc, fq);
    }
};

struct SchedPlain { int G, c, nM, nN; unsigned abase, bbase, atile, btile, acol, bcol, bgrp;
    __device__ __forceinline__ bool next(int i, Unit& u) const {
        const int L = i * G + c; if (L >= nM * nN) return false;
        pg8::tile_order(L, nM, nN, u.pm, u.pn); u.z = 0; u.nvalid = 256; u.goff = 0;
        u.aoff = abase + (unsigned)u.pm * atile + (unsigned)u.pn * acol; u.boff = bbase + (unsigned)u.pn * btile + (unsigned)(u.pm >> 4) * bgrp + (unsigned)u.pn * bcol; return true; }
};
struct EpiBf16 { static constexpr bool PERM = true;
    bf16* O; int ldc; float scale; const float* bias;
    __device__ __forceinline__ void operator()(const f32x4 (&acc)[2][2][4][2], const Unit& u, int wr, int wc, int fr, int fq) const {
        pg8::store_tile_bf16(acc, O + (size_t)(u.pm * 256 + wr * 64 + fr) * ldc + 256 * u.pn, (size_t)ldc, bias ? bias + 256 * u.pn : nullptr, scale, wc, fq); }
};
struct SchedMoe { int G, c, nN; const LAS int* tb; unsigned abase, wbase, wexp;
    bool gather;
    __device__ __forceinline__ bool next(int i, Unit& u) const {
        const int nblk = __builtin_amdgcn_readfirstlane(tb[32]); const int L = i * G + c; if (L >= nblk * nN) return false;
        pg8::tile_order(L, nblk, nN, u.pm, u.pn);
        const int e = __builtin_amdgcn_readfirstlane(tb[128 + u.pm]);
        const int j = u.pm - tb[e], rem = tb[64 + e] - 256 * j;
        u.z = e; u.nvalid = rem < 256 ? rem : 256; u.goff = (unsigned)(e * LCAP + 256 * j);
        u.aoff = gather ? abase : abase + (unsigned)u.pm * (TSTEP / 2);
        u.boff = wbase + (unsigned)e * wexp + (unsigned)u.pn * (TSTEP / 2); return true; }
};
struct EpiAct { static constexpr bool PERM = true;
    unsigned char* ACT; const float* b_gu;
    __device__ __forceinline__ void operator()(const f32x4 (&acc)[2][2][4][2], const Unit& u, int wr, int wc, int fr, int fq) const {
        const int row0 = u.pm * 256 + wr * 64 + fr, ch = 128 * u.pn + wc * 32 + 8 * fq;
        const float* bb = b_gu + (size_t)u.z * 2 * DFF;
        f32x4 bg[2], bu[2];
#pragma unroll
        for (int n = 0; n < 2; ++n) { bg[n] = *(const f32x4*)(bb + ch + 4 * n); bu[n] = *(const f32x4*)(bb + DFF + ch + 4 * n); }
#pragma unroll
        for (int ai = 0; ai < 2; ++ai)
#pragma unroll
            for (int m = 0; m < 4; ++m) { f32x4 o[2];
#pragma unroll
                for (int n = 0; n < 2; ++n) { const f32x4 g = acc[ai][0][m][n] * (1.0f / WGU_SC) + bg[n], uu = acc[ai][1][m][n] * (1.0f / WGU_SC) + bu[n];
#pragma unroll
                    for (int j = 0; j < 4; ++j) { const float g_ = fminf(g[j], 7.0f), u_ = fminf(fmaxf(uu[j], -7.0f), 7.0f); o[n][j] = (u_ + 1.0f) * g_ * sigmoidf_fast(1.702f * g_); } }
                *(u32x2*)(ACT + (size_t)(row0 + ai * 128 + m * 16) * DFF + ch) = (u32x2){pk4_fp8(o[0][0], o[0][1], o[0][2], o[0][3]), pk4_fp8(o[1][0], o[1][1], o[1][2], o[1][3])}; }
    }
};
struct EpiDown { static constexpr bool PERM = true;
    bf16* YS; const float* b_down; const float* lgate;
    __device__ __forceinline__ void operator()(const f32x4 (&acc)[2][2][4][2], const Unit& u, int wr, int wc, int fr, int fq) const {
        const int r0 = wr * 64 + fr, cl = wc * 32 + 8 * fq;
        const float* bb = b_down + (size_t)u.z * D + 256 * u.pn + cl;
        f32x4 bv[2][2];
#pragma unroll
        for (int bj = 0; bj < 2; ++bj)
#pragma unroll
            for (int n = 0; n < 2; ++n) bv[bj][n] = *(const f32x4*)(bb + bj * 128 + 4 * n);
        float gts[2][4];
#pragma unroll
        for (int ai = 0; ai < 2; ++ai)
#pragma unroll
            for (int m = 0; m < 4; ++m) { const int r = r0 + ai * 128 + m * 16; gts[ai][m] = lgate[u.goff + (r < u.nvalid ? r : u.nvalid - 1)]; }
#pragma unroll
        for (int ai = 0; ai < 2; ++ai)
#pragma unroll
            for (int m = 0; m < 4; ++m) { const int r = r0 + ai * 128 + m * 16; const float gt = (r < u.nvalid) ? gts[ai][m] : 0.f;
                bf16* rowp = YS + (size_t)(u.pm * 256 + r) * D + 256 * u.pn + cl;
#pragma unroll
                for (int bj = 0; bj < 2; ++bj) { const f32x4 v0 = (acc[ai][bj][m][0] * (1.0f / WDN_SC) + bv[bj][0]) * gt, v1 = (acc[ai][bj][m][1] * (1.0f / WDN_SC) + bv[bj][1]) * gt;
                    u32x4 w; w.x = pg8::cvt_pk_bf16(v0[0], v0[1]); w.y = pg8::cvt_pk_bf16(v0[2], v0[3]); w.z = pg8::cvt_pk_bf16(v1[0], v1[1]); w.w = pg8::cvt_pk_bf16(v1[2], v1[3]);
                    *(u32x4*)(rowp + bj * 128) = w; } }
    }
};
__device__ __forceinline__ void moe_table(Frame& F, LAS int* tb) {
    if (F.tid < 32) { int c = (int)__hip_atomic_load(F.ctl + CW_ECNT + 64 * F.tid, RLX_AGENT); if (c > LCAP) c = LCAP; tb[64 + F.tid] = c; }
    LDS_WAIT(); __syncthreads();
    if (F.tid == 0) { int s = 0; for (int e = 0; e < NE; ++e) { tb[e] = s; s += (tb[64 + e] + 255) >> 8; } tb[32] = s; }
    LDS_WAIT(); __syncthreads();
    for (int b = F.tid; b < NBLK_MAX; b += NWAVES * 64) { int e = 0; while (e < NE - 1 && tb[e + 1] <= b) ++e; tb[128 + b] = e; }
    LDS_WAIT(); __syncthreads();
}

__device__ __forceinline__ void conv_phase(Frame& F) {
    LAS unsigned* ut = (LAS unsigned*)(F.lds + RING_OFF);
    LAS float* co = (LAS float*)(F.lds + RING_OFF + 65536);
    const int cp = F.tid & 255, half = F.tid >> 8;
    float w0[CWID], w1[CWID];
    { const float* wd = F.in[I_W_DW] + 2 * cp;
#pragma unroll
        for (int j = 0; j < CWID; ++j) { const f32x2 w = *(const GAS f32x2*)(wd + j * CONV_CH); w0[j] = w.x; w1[j] = w.y; } }
    const f32x2 bd = *(const GAS f32x2*)(F.in[I_B_DW] + 2 * cp);
    const f32x4 g0 = *(const GAS f32x4*)(F.in[I_LN_CONV_G] + 8 * F.lane), g1 = *(const GAS f32x4*)(F.in[I_LN_CONV_G] + 8 * F.lane + 4);
    const f32x4 b0 = *(const GAS f32x4*)(F.in[I_LN_CONV_B] + 8 * F.lane), b1 = *(const GAS f32x4*)(F.in[I_LN_CONV_B] + 8 * F.lane + 4);
    bf16* MX = (bf16*)(F.ws + WS_MIXIN);
    for (int it = F.vcu; it < NB * (T_ / 32); it += F.G) {
        const int b = it / (T_ / 32), t0 = (it % (T_ / 32)) * 32;
        const bf16* U = (const bf16*)(F.ws + WS_U) + (size_t)b * T_ * CONV_CH;
        for (int idx = F.tid; idx < 62 * 64; idx += 512) { const int r = idx >> 6, c16 = idx & 63, t = t0 - 30 + r;
            u32x4 v = (u32x4){0u, 0u, 0u, 0u}; if (t >= 0) v = *(const GAS u32x4*)(U + (size_t)t * CONV_CH + c16 * 8);
            *(LAS u32x4*)(ut + r * 256 + c16 * 4) = v; }
        LDS_WAIT(); __syncthreads();
        { float a0[16], a1[16];
#pragma unroll
            for (int tt = 0; tt < 16; ++tt) { a0[tt] = bd.x; a1[tt] = bd.y; }
#pragma unroll
            for (int r = 0; r < 46; ++r) { const unsigned uu = ut[(half * 16 + r) * 256 + cp]; const float u0 = bflo(uu), u1 = bfhi(uu);
#pragma unroll
                for (int tt = 0; tt < 16; ++tt) { const int j = r - tt; if (j >= 0 && j < CWID) { a0[tt] += w0[j] * u0; a1[tt] += w1[j] * u1; } } }
#pragma unroll
            for (int tt = 0; tt < 16; ++tt) *(LAS f32x2*)(co + (half * 16 + tt) * CONV_CH + 2 * cp) = (f32x2){a0[tt], a1[tt]};
        }
        LDS_WAIT(); __syncthreads();
#pragma unroll
        for (int q = 0; q < 4; ++q) { const int tt = 4 * F.wave + q;
            f32x4 x0 = *(const LAS f32x4*)(co + tt * CONV_CH + 8 * F.lane), x1 = *(const LAS f32x4*)(co + tt * CONV_CH + 8 * F.lane + 4);
            const float mean = wave_sum((x0.x + x0.y) + (x0.z + x0.w) + (x1.x + x1.y) + (x1.z + x1.w)) * (1.f / CONV_CH);
            x0 = x0 - mean; x1 = x1 - mean;
            const float var = wave_sum((x0.x * x0.x + x0.y * x0.y) + (x0.z * x0.z + x0.w * x0.w) + (x1.x * x1.x + x1.y * x1.y) + (x1.z * x1.z + x1.w * x1.w)) * (1.f / CONV_CH);
            const float rstd = 1.f / sqrtf(var + LN_EPS);
            x0 = x0 * rstd * g0 + b0; x1 = x1 * rstd * g1 + b1;
            float y[8] = {x0.x, x0.y, x0.z, x0.w, x1.x, x1.y, x1.z, x1.w};
#pragma unroll
            for (int j = 0; j < 8; ++j) y[j] = y[j] * sigmoidf_fast(y[j]);
            *(GAS u32x4*)(MX + (size_t)(b * T_ + t0 + tt) * D + 8 * F.lane) = (u32x4){pk2(y[0], y[1]), pk2(y[2], y[3]), pk2(y[4], y[5]), pk2(y[6], y[7])}; }
        __syncthreads();
    }
}

typedef float f32x16 __attribute__((ext_vector_type(16)));
__device__ __forceinline__ int crow(int r, int hi) { return (r & 3) + 8 * (r >> 2) + 4 * hi; }
__device__ __forceinline__ bf16x8 pack8(const float* v) {
    u32x4 w; w.x = pg8::cvt_pk_bf16(v[0], v[1]); w.y = pg8::cvt_pk_bf16(v[2], v[3]); w.z = pg8::cvt_pk_bf16(v[4], v[5]); w.w = pg8::cvt_pk_bf16(v[6], v[7]);
    return __builtin_bit_cast(bf16x8, w); }
constexpr float SB_EXIT = 150.0f;
struct SbStage { u32x4 k[4], v[4]; };
__device__ __forceinline__ void sb_gload(SbStage& g, const bf16* Kt, const bf16* Vt, int lane) {
#pragma unroll
    for (int i = 0; i < 4; ++i) { const int c = (lane & 7) ^ ((4 * i + (lane >> 4)) & 7); g.k[i] = *(const GAS u32x4*)(Kt + (size_t)(8 * i) * SBW + 8 * c); }
#pragma unroll
    for (int i = 0; i < 4; ++i) g.v[i] = *(const GAS u32x4*)(Vt + (size_t)(16 * i) * M);
}
__device__ __forceinline__ void sb_lwrite(const SbStage& g, LAS unsigned char* buf, int lane) {
#pragma unroll
    for (int i = 0; i < 4; ++i) *(LAS u32x4*)(buf + 1024 * i + 16 * lane) = g.k[i];
#pragma unroll
    for (int i = 0; i < 4; ++i) *(LAS u32x4*)(buf + 4096 + 1024 * i + 16 * lane) = g.v[i];
}
__device__ __forceinline__ void sb_attn_wave(Frame& F, int b, int h, int qt) {
    const int c = F.lane & 31, hi = F.lane >> 5;
    const bf16* Q = (const bf16*)(F.ws + WS_Q); const bf16* Kb = (const bf16*)(F.ws + WS_K); const bf16* VT = (const bf16*)(F.ws + WS_V);
    LAS unsigned char* wbuf = F.lds + RING_OFF + F.wave * 16384;
    bf16x8 tri[2];
#pragma unroll
    for (int s = 0; s < 2; ++s) { bf16x8 t;
#pragma unroll
        for (int j = 0; j < 8; ++j) { const int k = 16 * s + 8 * (j >> 2) + 4 * hi + (j & 3); t[j] = (k >= c) ? (short)0xBF80 : (short)0; }
        tri[s] = t; }
    bf16x8 qf[4];
    { const bf16* qp = Q + ((size_t)b * T_ + 32 * qt + c) * SBW + h * SBD + 8 * hi;
#pragma unroll
        for (int s = 0; s < 4; ++s) qf[s] = *(const GAS bf16x8*)(qp + 16 * s); }
    const bf16* Ksrc = Kb + ((size_t)b * T_ + (F.lane >> 3)) * SBW + h * SBD;
    const bf16* Vsrc = VT + (size_t)(h * SBD + (F.lane >> 2)) * M + (size_t)b * T_ + 8 * ((F.lane & 3) ^ ((F.lane >> 4) & 3));

    const int ksw = (c >> 1) & 7, vsw = (c >> 2) & 3;

    f32x16 o0, o1;
#pragma unroll
    for (int r = 0; r < 16; ++r) { o0[r] = 0.f; o1[r] = 0.f; }
    float carry = 0.f;
    SbStage st;
    sb_gload(st, Ksrc + (size_t)(32 * qt) * SBW, Vsrc + 32 * qt, F.lane); sb_lwrite(st, wbuf, F.lane);
    for (int kt = qt; kt >= 0; --kt) {
        LAS unsigned char* buf = wbuf + ((qt - kt) & 1) * 8192;
        if (kt > 0) sb_gload(st, Ksrc + (size_t)(32 * (kt - 1)) * SBW, Vsrc + 32 * (kt - 1), F.lane);
        const bool diag = (kt == qt);
        bf16x8 kf[4];
#pragma unroll
        for (int s = 0; s < 4; ++s) kf[s] = *(const LAS bf16x8*)(buf + c * 128 + 16 * ((2 * s + hi) ^ ksw));
        f32x16 p;
#pragma unroll
        for (int r = 0; r < 16; ++r) p[r] = 0.f;
#pragma unroll
        for (int s = 0; s < 4; ++s) p = __builtin_amdgcn_mfma_f32_32x32x16_bf16(kf[s], qf[s], p, 0, 0, 0);
        u32x2 vv[2][2][2];
#pragma unroll
        for (int dt = 0; dt < 2; ++dt)
#pragma unroll
            for (int s = 0; s < 2; ++s)
#pragma unroll
                for (int q = 0; q < 2; ++q) vv[dt][s][q] = *(const LAS u32x2*)(buf + 4096 + (32 * dt + c) * 64 + 16 * ((2 * s + q) ^ vsw) + 8 * hi);
        float L[16];
#pragma unroll
        for (int r = 0; r < 16; ++r) { const float y = p[r]; float l = __builtin_amdgcn_logf(1.0f + __builtin_amdgcn_exp2f(y)); l = (y > 64.f) ? y : l;
            if (diag) l = (crow(r, hi) >= c) ? 0.f : l; L[r] = l; }
        const bf16x8 l0 = pack8(L), l1 = pack8(L + 8);
        f32x16 a;
#pragma unroll
        for (int r = 0; r < 16; ++r) a[r] = p[r] - carry;
        a = __builtin_amdgcn_mfma_f32_32x32x16_bf16(tri[0], l0, a, 0, 0, 0); a = __builtin_amdgcn_mfma_f32_32x32x16_bf16(tri[1], l1, a, 0, 0, 0);
        const float tot = p[0] - a[0];
        float w[16];
#pragma unroll
        for (int r = 0; r < 16; ++r) { float x = __builtin_amdgcn_exp2f(a[r]); if (diag) x = (crow(r, hi) >= c) ? 0.f : x; w[r] = x; }
        const bf16x8 p0 = pack8(w), p1 = pack8(w + 8);
        { const bf16x8 v00 = __builtin_bit_cast(bf16x8, (u32x4){vv[0][0][0].x, vv[0][0][0].y, vv[0][0][1].x, vv[0][0][1].y});
          const bf16x8 v01 = __builtin_bit_cast(bf16x8, (u32x4){vv[0][1][0].x, vv[0][1][0].y, vv[0][1][1].x, vv[0][1][1].y});
          const bf16x8 v10 = __builtin_bit_cast(bf16x8, (u32x4){vv[1][0][0].x, vv[1][0][0].y, vv[1][0][1].x, vv[1][0][1].y});
          const bf16x8 v11 = __builtin_bit_cast(bf16x8, (u32x4){vv[1][1][0].x, vv[1][1][0].y, vv[1][1][1].x, vv[1][1][1].y});
          o0 = __builtin_amdgcn_mfma_f32_32x32x16_bf16(v00, p0, o0, 0, 0, 0); o0 = __builtin_amdgcn_mfma_f32_32x32x16_bf16(v01, p1, o0, 0, 0, 0);
          o1 = __builtin_amdgcn_mfma_f32_32x32x16_bf16(v10, p0, o1, 0, 0, 0); o1 = __builtin_amdgcn_mfma_f32_32x32x16_bf16(v11, p1, o1, 0, 0, 0); }
        carry = __shfl(tot, c);
        if (__all(carry >= SB_EXIT)) break;
        if (kt > 0) sb_lwrite(st, wbuf + ((qt - kt + 1) & 1) * 8192, F.lane);
    }
    bf16* op = (bf16*)(F.ws + WS_MIXIN) + ((size_t)b * T_ + 32 * qt + c) * D + CONV_CH + h * SBD + 4 * hi;
#pragma unroll
    for (int g = 0; g < 4; ++g) {
        *(GAS u32x2*)(op + 8 * g) = (u32x2){pg8::cvt_pk_bf16(o0[4 * g], o0[4 * g + 1]), pg8::cvt_pk_bf16(o0[4 * g + 2], o0[4 * g + 3])};
        *(GAS u32x2*)(op + 32 + 8 * g) = (u32x2){pg8::cvt_pk_bf16(o1[4 * g], o1[4 * g + 1]), pg8::cvt_pk_bf16(o1[4 * g + 2], o1[4 * g + 3])}; }
}

__device__ __forceinline__ void resid_row(f32x4 (&v)[4], const bf16* hrow, const bf16* mrow, int lane) {
    f32x4 a[4]; load_row_bf16(v, hrow, lane); load_row_bf16(a, mrow, lane);
#pragma unroll
    for (int j = 0; j < 4; ++j) v[j] = v[j] * DN_ALPHA + a[j];
}
__device__ __forceinline__ void ln_phase(Frame& F, const float* g, const float* b) {
    const int gw = F.vcu * NWAVES + F.wave, NGW = F.G * NWAVES;
    for (int m = gw; m < M; m += NGW) { f32x4 v[4]; bf16* hrow = (bf16*)(F.ws + WS_HB) + (size_t)m * D; resid_row(v, hrow, (const bf16*)(F.ws + WS_QM) + (size_t)m * D, F.lane);
        ln_row(v, g, b, F.lane); store_row_bf16(v, hrow, F.lane); }
}
__device__ __forceinline__ void softmax_phase(Frame& F) {
    const int gw = F.vcu * NWAVES + F.wave, NGW = F.G * NWAVES;
    for (int m = gw; m < M; m += NGW) { GAS u32x2* p = (GAS u32x2*)((bf16*)(F.ws + WS_SP) + (size_t)m * D) + F.lane;
#pragma unroll
        for (int j = 0; j < 4; ++j) { const u32x2 w = p[64 * j]; float x0 = bflo(w.x), x1 = bfhi(w.x), x2 = bflo(w.y), x3 = bfhi(w.y);
            const float mx = wave_max(fmaxf(fmaxf(x0, x1), fmaxf(x2, x3)));
            x0 = __builtin_amdgcn_exp2f(x0 - mx); x1 = __builtin_amdgcn_exp2f(x1 - mx); x2 = __builtin_amdgcn_exp2f(x2 - mx); x3 = __builtin_amdgcn_exp2f(x3 - mx);
            const float inv = 1.0f / wave_sum((x0 + x1) + (x2 + x3));
            p[64 * j] = (u32x2){pk2(x0 * inv, x1 * inv), pk2(x2 * inv, x3 * inv)}; } }
}
typedef float f32x4v __attribute__((ext_vector_type(4)));
__device__ __forceinline__ void ln2_router_phase(Frame& F) {
    LAS bf16* wr = (LAS bf16*)(F.lds + P10_WR);
    LAS float* gb = (LAS float*)(F.lds + P10_GB);
    LAS int* lcnt = (LAS int*)(F.lds + P10_LCNT);
    LAS int* rec = (LAS int*)(F.lds + P10_REC);
    for (int i = F.tid; i < 2 * 32 * WR_STRIDE * 2 / 16; i += 512) *(LAS u32x4*)(F.lds + P10_WR + 16 * i) = *(const GAS u32x4*)(F.ws + WS_WR + 16 * i);
    for (int i = F.tid; i < 512; i += 512) { *(LAS f32x4*)(gb + 4 * i) = ((const GAS f32x4*)(i < 256 ? F.in[I_LN2_G] : F.in[I_LN2_B]))[i & 255]; }
    if (F.tid < 64) lcnt[F.tid] = 0;
    LDS_WAIT(); __syncthreads();
    const bf16* H1 = (const bf16*)(F.ws + WS_HB); const bf16* CA = (const bf16*)(F.ws + WS_QM); bf16* H2 = (bf16*)(F.ws + WS_HB2);
    int* ltok = (int*)(F.ws + WS_LTOK); float* lgate = (float*)(F.ws + WS_LGATE); int* sidx = (int*)(F.ws + WS_SIDX);
    const int fr = F.lane & 15, fq = F.lane >> 4;
    for (int rb = F.vcu; rb < M / 128; rb += F.G) {
        const int m0 = rb * 128 + F.wave * 16;
        float mymean = 0.f, myrstd = 0.f;
        for (int i = 0; i < 16; ++i) { const int m = m0 + i;
            f32x4 v[4]; resid_row(v, H1 + (size_t)m * D, CA + (size_t)m * D, F.lane);
            float s1 = 0.f;
#pragma unroll
            for (int j = 0; j < 4; ++j) s1 += (v[j].x + v[j].y) + (v[j].z + v[j].w);
            const float mean = wave_sum(s1) * (1.f / D); float s2 = 0.f;
#pragma unroll
            for (int j = 0; j < 4; ++j) { v[j] = v[j] - mean; s2 += (v[j].x * v[j].x + v[j].y * v[j].y) + (v[j].z * v[j].z + v[j].w * v[j].w); }
            const float rstd = 1.f / sqrtf(wave_sum(s2) * (1.f / D) + LN_EPS);
            if (fr == i) { mymean = mean; myrstd = rstd; }
#pragma unroll
            for (int j = 0; j < 4; ++j) { const f32x4 gg = *(const LAS f32x4*)(gb + 4 * F.lane + 256 * j), bb = *(const LAS f32x4*)(gb + 1024 + 4 * F.lane + 256 * j); v[j] = v[j] * rstd * gg + bb; }
            store_row_bf16(v, H2 + (size_t)m * D, F.lane);
            { GAS unsigned* h8 = (GAS unsigned*)(F.ws + WS_HB8 + (size_t)m * D) + F.lane;
#pragma unroll
                for (int j = 0; j < 4; ++j) h8[64 * j] = pk4_fp8(v[j].x, v[j].y, v[j].z, v[j].w); }
        }
        f32x4v acc0 = {0.f, 0.f, 0.f, 0.f}, acc1 = {0.f, 0.f, 0.f, 0.f};
        { const bf16* hp = H1 + (size_t)(m0 + fr) * D + 8 * fq; const bf16* cp = CA + (size_t)(m0 + fr) * D + 8 * fq;
            const LAS bf16* wp = wr + fr * WR_STRIDE + 8 * fq; const LAS float* gp = gb + 8 * fq;
            const float sc = myrstd, sh = -mymean * myrstd;
#pragma unroll 2
            for (int s_ = 0; s_ < 32; ++s_) {
                const u32x4 hv = *(const GAS u32x4*)(hp + 32 * s_), cv = *(const GAS u32x4*)(cp + 32 * s_);
                const f32x4 g0 = *(const LAS f32x4*)(gp + 32 * s_), g1 = *(const LAS f32x4*)(gp + 32 * s_ + 4), b0 = *(const LAS f32x4*)(gp + 1024 + 32 * s_), b1 = *(const LAS f32x4*)(gp + 1024 + 32 * s_ + 4);
                float x[8];
                x[0] = bflo(hv.x) * DN_ALPHA + bflo(cv.x); x[1] = bfhi(hv.x) * DN_ALPHA + bfhi(cv.x); x[2] = bflo(hv.y) * DN_ALPHA + bflo(cv.y); x[3] = bfhi(hv.y) * DN_ALPHA + bfhi(cv.y);
                x[4] = bflo(hv.z) * DN_ALPHA + bflo(cv.z); x[5] = bfhi(hv.z) * DN_ALPHA + bfhi(cv.z); x[6] = bflo(hv.w) * DN_ALPHA + bflo(cv.w); x[7] = bfhi(hv.w) * DN_ALPHA + bfhi(cv.w);
                const float gg[8] = {g0.x, g0.y, g0.z, g0.w, g1.x, g1.y, g1.z, g1.w}, bb[8] = {b0.x, b0.y, b0.z, b0.w, b1.x, b1.y, b1.z, b1.w};
                float lo[8]; unsigned hp2[4];
#pragma unroll
                for (int j = 0; j < 8; ++j) x[j] = (x[j] * sc + sh) * gg[j] + bb[j];
#pragma unroll
                for (int j = 0; j < 4; ++j) { hp2[j] = pg8::cvt_pk_bf16(x[2 * j], x[2 * j + 1]); lo[2 * j] = x[2 * j] - bflo(hp2[j]); lo[2 * j + 1] = x[2 * j + 1] - bfhi(hp2[j]); }
                const bf16x8 bhi = __builtin_bit_cast(bf16x8, (u32x4){hp2[0], hp2[1], hp2[2], hp2[3]});
                const bf16x8 blo = pack8(lo);
                const bf16x8 wh0 = *(const LAS bf16x8*)(wp + 32 * s_), wh1 = *(const LAS bf16x8*)(wp + 16 * WR_STRIDE + 32 * s_);
                const bf16x8 wl0 = *(const LAS bf16x8*)(wp + 32 * WR_STRIDE + 32 * s_), wl1 = *(const LAS bf16x8*)(wp + 48 * WR_STRIDE + 32 * s_);
                acc0 = __builtin_amdgcn_mfma_f32_16x16x32_bf16(wh0, bhi, acc0, 0, 0, 0); acc1 = __builtin_amdgcn_mfma_f32_16x16x32_bf16(wh1, bhi, acc1, 0, 0, 0);
                acc0 = __builtin_amdgcn_mfma_f32_16x16x32_bf16(wh0, blo, acc0, 0, 0, 0); acc1 = __builtin_amdgcn_mfma_f32_16x16x32_bf16(wh1, blo, acc1, 0, 0, 0);
                acc0 = __builtin_amdgcn_mfma_f32_16x16x32_bf16(wl0, bhi, acc0, 0, 0, 0); acc1 = __builtin_amdgcn_mfma_f32_16x16x32_bf16(wl1, bhi, acc1, 0, 0, 0);
            } }
        float cand[8]; int eid[8];
        { const f32x4 br0 = *(const GAS f32x4*)(F.in[I_B_ROUTER] + 4 * fq), br1 = *(const GAS f32x4*)(F.in[I_B_ROUTER] + 16 + 4 * fq);
#pragma unroll
            for (int r = 0; r < 4; ++r) { cand[r] = acc0[r] + br0[r]; cand[4 + r] = acc1[r] + br1[r]; eid[r] = 4 * fq + r; eid[4 + r] = 16 + 4 * fq + r; } }
        float tv[TOPK]; int te[TOPK];
#pragma unroll
        for (int k = 0; k < TOPK; ++k) {
            float bv = cand[0]; int bi = eid[0];
#pragma unroll
            for (int r = 1; r < 8; ++r) if (cand[r] > bv) { bv = cand[r]; bi = eid[r]; }
#pragma unroll
            for (int o = 16; o <= 32; o <<= 1) { const float ov = __shfl_xor(bv, o); const int oi = __shfl_xor(bi, o); if (ov > bv || (ov == bv && oi < bi)) { bv = ov; bi = oi; } }
            tv[k] = bv; te[k] = bi;
#pragma unroll
            for (int r = 0; r < 8; ++r) if (eid[r] == bi) cand[r] = -INFINITY;
        }
        float pe[TOPK], ps = 0.f;
#pragma unroll
        for (int k = 0; k < TOPK; ++k) { pe[k] = __expf(tv[k] - tv[0]); ps += pe[k]; }
        if (fq == 0) {
#pragma unroll
            for (int k = 0; k < TOPK; ++k) { const int lr = __hip_atomic_fetch_add(lcnt + te[k], 1, __ATOMIC_RELAXED, __HIP_MEMORY_SCOPE_WORKGROUP);
                LAS int* r = rec + ((F.wave * 16 + fr) * 4 + k) * 4; r[0] = te[k]; r[1] = lr; r[2] = __builtin_bit_cast(int, pe[k] / ps); r[3] = m0 + fr; } }
        LDS_WAIT(); __syncthreads();
        if (F.tid < NE) lcnt[32 + F.tid] = (int)__hip_atomic_fetch_add(F.ctl + CW_ECNT + 64 * F.tid, (unsigned)lcnt[F.tid], RLX_AGENT);
        LDS_WAIT(); __syncthreads();
        { const LAS int* r = rec + (F.wave * 64 + F.lane) * 4; const int e = r[0], pos = lcnt[32 + e] + r[1], tok = r[3];
            if (pos < LCAP) { ltok[e * LCAP + pos] = tok; lgate[e * LCAP + pos] = __builtin_bit_cast(float, r[2]); } sidx[tok * 4 + (F.lane & 3)] = e * LCAP + pos; }
        __syncthreads();
        if (F.tid < 64) lcnt[F.tid] = 0;
        LDS_WAIT(); __syncthreads();
    }
}
__device__ __forceinline__ void final_phase(Frame& F, const LAS int* tb) {
    const int gw = F.vcu * NWAVES + F.wave, NGW = F.G * NWAVES;
    const int* sidx = (const int*)(F.ws + WS_SIDX); const bf16* YS = (const bf16*)(F.ws + WS_YS);
    for (int m = gw; m < M; m += NGW) { f32x4 v[4]; load_row_bf16(v, (const bf16*)(F.ws + WS_HB2) + (size_t)m * D, F.lane);
#pragma unroll
        for (int j = 0; j < 4; ++j) v[j] = v[j] * DN_ALPHA;
        f32x4 s[4];
#pragma unroll
        for (int j = 0; j < 4; ++j) s[j] = (f32x4){0.f, 0.f, 0.f, 0.f};
#pragma unroll
        for (int k = 0; k < TOPK; ++k) { const int si = sidx[m * 4 + k], e = si / LCAP, pos = si - e * LCAP; const size_t slot = (size_t)tb[e] * 256 + pos;
            const GAS u32x2* yp = (const GAS u32x2*)(YS + slot * D) + F.lane;
#pragma unroll
            for (int j = 0; j < 4; ++j) { const u32x2 w = yp[64 * j]; s[j] = s[j] + (f32x4){bflo(w.x), bfhi(w.x), bflo(w.y), bfhi(w.y)}; } }
#pragma unroll
        for (int j = 0; j < 4; ++j) v[j] = v[j] + s[j];
        ln_row(v, F.in[I_LN3_G], F.in[I_LN3_B], F.lane); store_row_f32(v, F.hf + (size_t)m * D, F.lane); }
}

struct Args { const float* in[N_IN]; float* out; unsigned char* ws; int ph_lo, ph_hi, li, pad; };
__global__ void __launch_bounds__(NWAVES * 64, 2) mk_fwd(Args args) {
    extern __shared__ __attribute__((aligned(16))) unsigned char lds[];
    Frame F;
    F.lds = (LAS unsigned char*)lds; F.MISC = (volatile LAS unsigned*)(F.lds + MISC_OFF);
    F.tid = threadIdx.x; F.lane = F.tid & 63; F.wave = __builtin_amdgcn_readfirstlane(F.tid >> 6);
    F.G = gridDim.x; { const int bx = blockIdx.x; F.vcu = (F.G % 8 == 0) ? (bx % 8) * (F.G / 8) + bx / 8 : bx; }
    F.ws = args.ws; F.ctl = (gu32*)(args.ws + WS_CTL); F.hf = args.out; F.in = args.in;
    for (int u = F.tid; u < (LDS_BYTES - LDSCTL_OFF) / 4; u += NWAVES * 64) ((LAS unsigned*)(F.lds + LDSCTL_OFF))[u] = 0u;
    __syncthreads();
    XcdBarrier bar; bar.bar = (unsigned*)(F.ctl + CW_BAR) + args.li * XCD_BAR_WORDS; bar.x = 0; bar.st = nullptr;
    const int lo = args.ph_lo, hi = args.ph_hi;
    if (hi - lo > 1) bar = xcd_barrier_post((unsigned*)(F.ctl + CW_BAR) + args.li * XCD_BAR_WORDS, F.MISC + 8);
#ifndef PH_MASK
#define PH_MASK 0x3fff
#endif
#define IN(k) (((PH_MASK >> (k)) & 1) && lo <= (k) && (k) < hi)
#ifndef REP_MASK
#define REP_MASK 0
#endif
#define REPS(k) (1 + ((REP_MASK >> (k)) & 1))
#define PH_BEGIN() do { int t_ = threadIdx.x; asm volatile("" : "+v"(t_)); F.tid = t_; F.lane = t_ & 63; } while (0)
#define SEAM(k) do { if (IN(k) && IN((k) + 1)) xcd_barrier(bar); } while (0)
    const char* wsb = (const char*)args.ws;
    LAS int* tb = (LAS int*)(F.lds + TB_OFF);

    if (IN(0)) for (int rep = 0; rep < REPS(0); ++rep) { PH_BEGIN(); p0_prologue(F); __syncthreads(); } SEAM(0);
    if (IN(1)) for (int rep = 0; rep < REPS(1); ++rep) { PH_BEGIN(); SchedP1 S{F.G, (int)blockIdx.x}; EpiP1 E{F.ws, F.in[I_B_IN]};
        pg8::gemm_phase<EpiP1, SchedP1, false>(F.lds + RING_OFF, wsb, D, D, D, S, E, nullptr); } SEAM(1);
    if (IN(2)) for (int rep = 0; rep < REPS(2); ++rep) { PH_BEGIN();
        conv_phase(F);
        const int gw = F.vcu * NWAVES + F.wave;
        for (int tk = gw; tk < NB * SBH * (T_ / 32); tk += F.G * NWAVES) sb_attn_wave(F, (tk >> 7) >> 3, (tk >> 7) & 7, tk & 127);
    } SEAM(2);
    if (IN(3)) { PH_BEGIN(); SchedPlain S{F.G, (int)blockIdx.x, 128, 4, (unsigned)WS_MIXIN, (unsigned)WS_WOUT_T, TSTEP, TSTEP, 0u, 0u, 0u}; EpiBf16 E{(bf16*)(F.ws + WS_QM), D, 1.0f, F.in[I_B_OUT]};
        pg8::gemm_phase<EpiBf16, SchedPlain, false>(F.lds + RING_OFF, wsb, D, D, D, S, E, nullptr); } SEAM(3);
    if (IN(4)) { PH_BEGIN(); ln_phase(F, F.in[I_LN1_G], F.in[I_LN1_B]); } SEAM(4);
    if (IN(5)) { PH_BEGIN(); SchedPlain S{F.G, (int)blockIdx.x, 128, 4, (unsigned)WS_HB, (unsigned)WS_WQ_T, TSTEP, TSTEP, 0u, 0u, 0u}; EpiBf16 E{(bf16*)(F.ws + WS_QM), D, MEM_QSCALE, nullptr};
        pg8::gemm_phase<EpiBf16, SchedPlain, false>(F.lds + RING_OFF, wsb, D, D, D, S, E, nullptr); } SEAM(5);
    if (IN(6)) { PH_BEGIN();
        SchedPlain S{F.G, (int)blockIdx.x, 128, 4, (unsigned)WS_QM, (unsigned)WS_KM, TSTEP, 0u, 512u, 512u, TSTEP}; EpiBf16 E{(bf16*)(F.ws + WS_SP), D, 1.0f, nullptr};
        pg8::gemm_phase<EpiBf16, SchedPlain, false>(F.lds + RING_OFF, wsb, D, D, 256, S, E, nullptr); } SEAM(6);
    if (IN(7)) { PH_BEGIN(); softmax_phase(F); } SEAM(7);
    if (IN(8)) { PH_BEGIN();
        SchedPlain S{F.G, (int)blockIdx.x, 128, 4, (unsigned)WS_SP, (unsigned)WS_VMT, TSTEP, 256u * 2048u * 2u, 512u, 0u, 512u}; EpiBf16 E{(bf16*)(F.ws + WS_OB), D, 1.0f, nullptr};
        pg8::gemm_phase<EpiBf16, SchedPlain, false>(F.lds + RING_OFF, wsb, D, 2048, 256, S, E, nullptr); } SEAM(8);
    if (IN(9)) { PH_BEGIN(); SchedPlain S{F.G, (int)blockIdx.x, 128, 4, (unsigned)WS_OB, (unsigned)WS_WO_T, TSTEP, TSTEP, 0u, 0u, 0u}; EpiBf16 E{(bf16*)(F.ws + WS_QM), D, 1.0f, nullptr};
        pg8::gemm_phase<EpiBf16, SchedPlain, false>(F.lds + RING_OFF, wsb, D, D, D, S, E, nullptr); } SEAM(9);
    if (IN(10)) { PH_BEGIN(); ln2_router_phase(F); } SEAM(10);
    if (IN(11)) for (int rep = 0; rep < REPS(11); ++rep) { PH_BEGIN(); moe_table(F, tb); SchedMoe S{F.G, (int)blockIdx.x, 8, tb, (unsigned)WS_HB8, (unsigned)WS_WGU_T, 2048u * 1024u, true}; EpiAct E{F.ws + WS_ACT, F.in[I_B_GU]};
        pg8::gemm_phase<EpiAct, SchedMoe, true, true>(F.lds + RING_OFF, wsb, D / 2, D / 2, D / 2, S, E, (const int*)(F.ws + WS_LTOK)); } SEAM(11);
    if (IN(12)) for (int rep = 0; rep < REPS(12); ++rep) { PH_BEGIN(); moe_table(F, tb); SchedMoe S{F.G, (int)blockIdx.x, 4, tb, (unsigned)WS_ACT, (unsigned)WS_WDN_T, 1024u * 1024u, false}; EpiDown E{(bf16*)(F.ws + WS_YS), F.in[I_B_DOWN], (const float*)(F.ws + WS_LGATE)};
        pg8::gemm_phase<EpiDown, SchedMoe, false, true>(F.lds + RING_OFF, wsb, D / 2, D / 2, D / 2, S, E, nullptr); } SEAM(12);
    if (IN(13)) { PH_BEGIN(); moe_table(F, tb); final_phase(F, tb); }
#undef IN
#undef SEAM
}

extern "C" void kernel_launch(void* const* d_in, const int* in_sizes, int n_in, void* d_out, int out_size, void* d_ws, size_t ws_size, hipStream_t stream) {
    static int grid = 0;
    if (grid == 0) {
        if (n_in != N_IN || out_size != M * D || ws_size < WS_END) { fprintf(stderr, "kernel_launch: unexpected shapes (n_in %d, out %d, ws %zu)\n", n_in, out_size, ws_size); grid = -1; return; }
        int dev = 0, cus = 0, per_cu = 0;
        if (hipGetDevice(&dev) != hipSuccess || hipDeviceGetAttribute(&cus, hipDeviceAttributeMultiprocessorCount, dev) != hipSuccess) { grid = -1; return; }
        if (hipFuncSetAttribute((const void*)mk_fwd, hipFuncAttributeMaxDynamicSharedMemorySize, LDS_BYTES) != hipSuccess) { fprintf(stderr, "kernel_launch: hipFuncSetAttribute failed\n"); grid = -1; return; }
        if (hipOccupancyMaxActiveBlocksPerMultiprocessor(&per_cu, (const void*)mk_fwd, NWAVES * 64, LDS_BYTES) != hipSuccess || per_cu < 1) fprintf(stderr, "kernel_launch: occupancy query says %d\n", per_cu);
        (void)hipGetLastError();
        grid = cus;
    }
    if (grid < 0) return;
    if (hipMemsetAsync((char*)d_ws + WS_CTL, 0, CTL_ZERO_BYTES, stream) != hipSuccess) return;
    Args a{};
    for (int i = 0; i < N_IN; ++i) a.in[i] = (const float*)d_in[i];
    a.out = (float*)d_out; a.ws = (unsigned char*)d_ws;
    for (int li = 0; li < MK_N_LAUNCHES; ++li) {
        a.ph_lo = (MK_N_LAUNCHES == 1) ? 0 : li; a.ph_hi = (MK_N_LAUNCHES == 1) ? NPHASE : li + 1; a.li = (MK_N_LAUNCHES == 1) ? 0 : li;
        hipLaunchKernelGGL(mk_fwd, dim3(grid), dim3(NWAVES * 64), LDS_BYTES, stream, a);
        if (hipPeekAtLastError() != hipSuccess) { fprintf(stderr, "kernel_launch: launch %d failed\n", li); break; }
    }
#ifdef PROBE_PHASES
    { const int pp[] = {PROBE_PHASES}; for (int ph : pp) { a.ph_lo = ph; a.ph_hi = ph + 1; a.li = 15; hipLaunchKernelGGL(mk_fwd, dim3(grid), dim3(NWAVES * 64), LDS_BYTES, stream, a); } }
#endif
}
```

```cpp
#include <hip/hip_runtime.h>
#include <cstdio>
#include <cstdint>

#ifndef MK_N_LAUNCHES
#define MK_N_LAUNCHES 1
#endif

#define GAS __attribute__((address_space(1)))
#define LAS __attribute__((address_space(3)))
typedef unsigned short bf16;
typedef short bf16x8 __attribute__((ext_vector_type(8)));
typedef float f32x4 __attribute__((ext_vector_type(4)));
typedef float f32x2 __attribute__((ext_vector_type(2)));
typedef unsigned u32x4 __attribute__((ext_vector_type(4)));
typedef unsigned u32x2 __attribute__((ext_vector_type(2)));
typedef GAS unsigned gu32;
#define RLX_AGENT __ATOMIC_RELAXED, __HIP_MEMORY_SCOPE_AGENT
#define LDS_WAIT() asm volatile("s_waitcnt lgkmcnt(0)" ::: "memory")
#define VM_WAIT() asm volatile("s_waitcnt vmcnt(0)" ::: "memory")

constexpr int NB = 8, T_ = 4096, D = 1024, M = NB * T_, NMEM = 256, MM = NB * NMEM;
constexpr int CONV_CH = 512, SBH = 8, SBD = 64, SBW = 512, CWID = 31, NE = 32, TOPK = 4, DFF = 1024;
constexpr int INC = 2560;
constexpr float LN_EPS = 1e-5f;
constexpr float DN_ALPHA = 1.189207115002721f;
constexpr float LOG2E = 1.4426950408889634f;
constexpr float SB_QSCALE = 0.125f * LOG2E;
constexpr float MEM_QSCALE = 0.0625f * LOG2E;
constexpr float WGU_SC = 32.0f, WDN_SC = 64.0f;
constexpr int NBLK_MAX = M * TOPK / 256 + NE;
constexpr int LCAP = M;

constexpr size_t MiB = 1u << 20;
constexpr size_t WS_CTL = 0, CTL_ZERO_BYTES = 1 * MiB;
constexpr size_t WS_WIN_T = 1 * MiB;
constexpr size_t WS_WOUT_T = 6 * MiB;
constexpr size_t WS_WQ_T = 8 * MiB, WS_WK_T = 10 * MiB, WS_WV_T = 12 * MiB, WS_WO_T = 14 * MiB;
constexpr size_t WS_WGU_T = 16 * MiB;
constexpr size_t WS_WDN_T = 144 * MiB;
constexpr size_t WS_HB8 = 176 * MiB;
constexpr size_t WS_HB = 208 * MiB;
constexpr size_t WS_LTOK = 272 * MiB;
constexpr size_t WS_LGATE = 276 * MiB;
constexpr size_t WS_SIDX = 280 * MiB;
constexpr size_t WS_WR = 281 * MiB;
constexpr size_t WS_HB2 = 832 * MiB;
constexpr size_t WS_X = 288 * MiB;
constexpr size_t WS_U = WS_X;
constexpr size_t WS_Q = WS_X + 32 * MiB;
constexpr size_t WS_K = WS_X + 64 * MiB;
constexpr size_t WS_V = WS_X + 96 * MiB;
constexpr size_t WS_MIXIN = WS_X + 128 * MiB;
constexpr size_t WS_QM = WS_X + 192 * MiB;
constexpr size_t WS_SP = WS_X + 256 * MiB;
constexpr size_t WS_OB = WS_X + 320 * MiB;
constexpr size_t WS_MEMN = WS_X + 384 * MiB;
constexpr size_t WS_KM = WS_X + 388 * MiB;
constexpr size_t WS_VMT = WS_X + 392 * MiB;
constexpr size_t WS_ACT = WS_X;
constexpr size_t WS_YS = WS_X + 272 * MiB;
constexpr size_t WS_END = 896 * MiB;
constexpr int CW_TMO = 0, CW_CODE = 1;
constexpr int CW_BAR = 4096;
constexpr int CW_ECNT = 131072;
constexpr int NPHASE = 12;

constexpr int RING_OFF = 0, RING_BYTES = 131072;
constexpr int LDS_BYTES = 163840;
constexpr int LDSCTL_OFF = LDS_BYTES - 1024, MISC_OFF = LDSCTL_OFF + 320;
constexpr int XTRA_OFF = RING_BYTES;
constexpr int TB_OFF = XTRA_OFF + 20480;
constexpr int WR_STRIDE = 1032;
constexpr int P10_WR = 0, P10_GB = 2 * 32 * WR_STRIDE * 2, P10_LCNT = P10_GB + 8192, P10_REC = P10_LCNT + 512;
static_assert(P10_REC + 8192 <= TB_OFF && TB_OFF + 4 * (128 + 544) <= LDSCTL_OFF, "LDS map");
constexpr int NWAVES = 8;

__device__ __forceinline__ unsigned f2bf(float f) { unsigned u = __builtin_bit_cast(unsigned, f); return (u + 0x7fffu + ((u >> 16) & 1u)) >> 16; }
__device__ __forceinline__ unsigned pk2(float lo, float hi) { return f2bf(lo) | (f2bf(hi) << 16); }
__device__ __forceinline__ float bflo(unsigned u) { return __builtin_bit_cast(float, u << 16); }
__device__ __forceinline__ float bfhi(unsigned u) { return __builtin_bit_cast(float, u & 0xffff0000u); }
__device__ __forceinline__ float wave_sum(float v) {
#pragma unroll
    for (int o = 1; o < 64; o <<= 1) v += __shfl_xor(v, o);
    return v;
}
__device__ __forceinline__ float wave_max(float v) {
#pragma unroll
    for (int o = 1; o < 64; o <<= 1) v = fmaxf(v, __shfl_xor(v, o));
    return v;
}
__device__ __forceinline__ unsigned pk4_fp8(float a, float b, float c, float d) {
    int r = __builtin_amdgcn_cvt_pk_fp8_f32(a, b, 0, false); r = __builtin_amdgcn_cvt_pk_fp8_f32(c, d, r, true); return (unsigned)r; }
__device__ __forceinline__ float sigmoidf_fast(float x) { return __builtin_amdgcn_rcpf(1.0f + __expf(-x)); }

namespace pg8 {
constexpr int BM = 256, BK = 64, HALF = 128, HTB = HALF * BK * 2, STAGE_BYTES = 8 * HTB, NXCD = 8, WGM = 8;
__host__ __device__ __forceinline__ int lds_byte(int r, int c) { const int st = (r >> 4) * 2 + (c >> 5), rr = r & 15, cc = c & 31, ob = rr * 64 + cc * 2; return st * 1024 + (ob ^ (((ob >> 9) & 1) << 5)); }
__host__ __device__ __forceinline__ void stage_rc(int b, int& R, int& C) { const int st = b / 1024, sb = b % 1024, swz = sb ^ (((sb >> 9) & 1) << 5); R = (st >> 1) * 16 + swz / 64; C = (st & 1) * 32 + (swz % 64) / 2; }
__host__ __device__ __forceinline__ int perm32(int rho) { const int n = rho >> 4, i = rho & 15; return 8 * (i >> 2) + 4 * n + (i & 3); }

struct Unit { int pm, pn, z, nvalid; unsigned aoff, boff, goff; };

__device__ __forceinline__ void tile_order(int L, int nM, int nN, int& pm, int& pn) {
    const int nwg = nM * nN; int wgid = L;
    { const int q = nwg / NXCD, r = nwg % NXCD, xcd = wgid % NXCD, off = wgid / NXCD; wgid = (xcd < r ? xcd * (q + 1) : r * (q + 1) + (xcd - r) * q) + off; }
    const int nig = WGM * nN, gid = wgid / nig, fm = gid * WGM, gsz = (nM - fm) < WGM ? (nM - fm) : WGM;
    pm = fm + ((wgid % nig) % gsz); pn = (wgid % nig) / gsz;
}
__device__ __forceinline__ unsigned cvt_pk_bf16(float lo, float hi) { unsigned r; asm volatile("v_cvt_pk_bf16_f32 %0, %1, %2" : "=v"(r) : "v"(lo), "v"(hi)); return r; }

__device__ __forceinline__ void store_tile_bf16(const f32x4 (&acc)[2][2][4][2], bf16* p0, size_t ldc, const float* bias, float scale, int wc, int fq) {
    const int cl = wc * 32 + 8 * fq;
    f32x4 bv[2][2];
#pragma unroll
    for (int bj = 0; bj < 2; ++bj)
#pragma unroll
        for (int n = 0; n < 2; ++n) bv[bj][n] = bias ? *(const f32x4*)(bias + cl + bj * HALF + 4 * n) : (f32x4){0.f, 0.f, 0.f, 0.f};
#pragma unroll
    for (int ai = 0; ai < 2; ++ai)
#pragma unroll
        for (int m = 0; m < 4; ++m) { bf16* rowp = p0 + (size_t)(ai * HALF + m * 16) * ldc + cl;
#pragma unroll
            for (int bj = 0; bj < 2; ++bj) { const f32x4 v0 = (acc[ai][bj][m][0] + bv[bj][0]) * scale, v1 = (acc[ai][bj][m][1] + bv[bj][1]) * scale;
                u32x4 w; w.x = cvt_pk_bf16(v0[0], v0[1]); w.y = cvt_pk_bf16(v0[2], v0[3]); w.z = cvt_pk_bf16(v1[0], v1[1]); w.w = cvt_pk_bf16(v1[2], v1[3]);
                *(u32x4*)(rowp + bj * HALF) = w; } }
}

typedef int v8i __attribute__((ext_vector_type(8)));
template <class Epi, class Sched, bool GATHER, bool FP8 = false>
__device__ __forceinline__ void gemm_phase(LAS unsigned char* lds, const char* wsb, const int lda, const int ldb, const int K, const Sched& S, const Epi& E, const int* glist) {
    int tid = threadIdx.x; asm volatile("" : "+v"(tid));
    const int wid = __builtin_amdgcn_readfirstlane(tid >> 6), lane = tid & 63, wr = wid >> 2, wc = wid & 3, fr = lane & 15, fq = lane >> 4;
    const int nt = K / BK;
    unsigned voffA[2], voffB[2];
#pragma unroll
    for (int i = 0; i < 2; ++i) { int R, C; stage_rc(tid * 16 + i * 8192, R, C); const int Rb = Epi::PERM ? ((R & ~31) + perm32(R & 31)) : R;
        voffA[i] = (unsigned)(R * lda + C) * 2u; voffB[i] = (unsigned)(Rb * ldb + C) * 2u; }
    const size_t kstep = (size_t)(BK * 2);
    const size_t hstepA = (size_t)HALF * lda * 2, hstepB = (size_t)HALF * ldb * 2;
    const unsigned ldsw = (unsigned)wid * 1024u;
    const int aoff = lds_byte(wr * 64 + fr, fq * 8), boff = lds_byte(wc * 32 + fr, fq * 8);
    unsigned gc[2][2], gn[2][2];
#define PG8_SA(b, h) (((b) * 2 + (h)) * HTB)
#define PG8_SB(b, h) ((4 + (b) * 2 + (h)) * HTB)
#define PG8_STAGE_B(bufoff, gbase) do { _Pragma("unroll") for (int _i = 0; _i < 2; ++_i) \
        __builtin_amdgcn_global_load_lds((const unsigned*)((const char*)(gbase) + voffB[_i]), (LAS unsigned*)(lds + (bufoff) + ldsw + _i * 8192), 16, 0, 0); } while (0)
#define PG8_STAGE_A(bufoff, gbase, h, nx) do { _Pragma("unroll") for (int _i = 0; _i < 2; ++_i) { \
        const char* _p = GATHER ? (const char*)(gbase) + ((nx) ? gn[h][_i] : gc[h][_i]) : (const char*)(gbase) + (h) * hstepA + voffA[_i]; \
        __builtin_amdgcn_global_load_lds((const unsigned*)_p, (LAS unsigned*)(lds + (bufoff) + ldsw + _i * 8192), 16, 0, 0); } } while (0)
#define PG8_LDA(dst, b, h) do { _Pragma("unroll") for (int m = 0; m < 4; ++m) { if constexpr (FP8) { const u32x4 _lo = *(const LAS u32x4*)(lds + PG8_SA(b, h) + aoff + m * 2048), _hi = *(const LAS u32x4*)(lds + PG8_SA(b, h) + aoff + m * 2048 + 1024); \
            dst##8[m] = (v8i){(int)_lo.x, (int)_lo.y, (int)_lo.z, (int)_lo.w, (int)_hi.x, (int)_hi.y, (int)_hi.z, (int)_hi.w}; } \
        else { _Pragma("unroll") for (int k = 0; k < 2; ++k) dst[m][k] = *(const LAS bf16x8*)(lds + PG8_SA(b, h) + aoff + m * 2048 + k * 1024); } } } while (0)
#define PG8_LDB(dst, b, h) do { _Pragma("unroll") for (int n = 0; n < 2; ++n) { if constexpr (FP8) { const u32x4 _lo = *(const LAS u32x4*)(lds + PG8_SB(b, h) + boff + n * 2048), _hi = *(const LAS u32x4*)(lds + PG8_SB(b, h) + boff + n * 2048 + 1024); \
            dst##8[n] = (v8i){(int)_lo.x, (int)_lo.y, (int)_lo.z, (int)_lo.w, (int)_hi.x, (int)_hi.y, (int)_hi.z, (int)_hi.w}; } \
        else { _Pragma("unroll") for (int k = 0; k < 2; ++k) dst[n][k] = *(const LAS bf16x8*)(lds + PG8_SB(b, h) + boff + n * 2048 + k * 1024); } } } while (0)
#define PG8_MMA(ai, bj, At, Bt) do { __builtin_amdgcn_s_setprio(1); if constexpr (FP8) asm volatile("s_nop 1"); _Pragma("unroll") for (int m = 0; m < 4; ++m) _Pragma("unroll") for (int n = 0; n < 2; ++n) { \
        if constexpr (FP8) asm volatile("v_mfma_f32_16x16x128_f8f6f4 %0, %1, %2, %0" : "+v"(acc[ai][bj][m][n]) : "v"(Bt##8[n]), "v"(At##8[m])); \
        else { _Pragma("unroll") for (int k = 0; k < 2; ++k) acc[ai][bj][m][n] = __builtin_amdgcn_mfma_f32_16x16x32_bf16(Bt[n][k], At[m][k], acc[ai][bj][m][n], 0, 0, 0); } } \
        __builtin_amdgcn_s_setprio(0); } while (0)
#define PG8_WAIT_V(n) asm volatile("s_waitcnt vmcnt(" #n ")" ::: "memory")
#define PG8_WAIT_L(n) asm volatile("s_waitcnt lgkmcnt(" #n ")" ::: "memory")
#define PG8_BAR __builtin_amdgcn_s_barrier()
#define PG8_SCHED __builtin_amdgcn_sched_barrier(0)
#define PG8_GIDX(g, u) do { _Pragma("unroll") for (int _h = 0; _h < 2; ++_h) _Pragma("unroll") for (int _i = 0; _i < 2; ++_i) { int _R, _C; stage_rc(tid * 16 + _i * 8192, _R, _C); const int _r = _h * HALF + _R; \
        const int _tok = glist[(u).goff + (_r < (u).nvalid ? _r : (u).nvalid - 1)]; g[_h][_i] = (unsigned)_tok * (unsigned)(lda * 2) + (unsigned)(_C * 2); } } while (0)
    Unit cur, nxt, nn; int ui = 0;
    if (!S.next(0, cur)) return;
    f32x4 acc[2][2][4][2];
#pragma unroll
    for (int a = 0; a < 2; ++a)
#pragma unroll
        for (int b = 0; b < 2; ++b)
#pragma unroll
            for (int m = 0; m < 4; ++m)
#pragma unroll
                for (int n = 0; n < 2; ++n) acc[a][b][m][n] = (f32x4){0.f, 0.f, 0.f, 0.f};
    bf16x8 At[4][2], B0[2][2], B1[2][2];
    v8i At8[4], B08[2], B18[2];
    const char* cA = wsb + cur.aoff; const char* cB = wsb + cur.boff;
    if constexpr (GATHER) { PG8_GIDX(gc, cur); if (S.next(1, nxt)) { PG8_GIDX(gn, nxt); } else { PG8_GIDX(gn, cur); }
        asm volatile("s_waitcnt vmcnt(0)" : "+v"(gc[0][0]), "+v"(gc[0][1]), "+v"(gc[1][0]), "+v"(gc[1][1]), "+v"(gn[0][0]), "+v"(gn[0][1]), "+v"(gn[1][0]), "+v"(gn[1][1]) :: "memory"); }
    else {
#pragma unroll
        for (int h = 0; h < 2; ++h)
#pragma unroll
            for (int i = 0; i < 2; ++i) { gc[h][i] = 0u; gn[h][i] = 0u; } }
    PG8_STAGE_B(PG8_SB(0, 0), cB); PG8_STAGE_B(PG8_SB(0, 1), cB + hstepB); PG8_STAGE_A(PG8_SA(0, 0), cA, 0, false); PG8_STAGE_A(PG8_SA(0, 1), cA, 1, false);
    if (wr == 1) PG8_BAR;
    PG8_WAIT_V(2); PG8_BAR;
    PG8_STAGE_B(PG8_SB(1, 0), cB + kstep); PG8_STAGE_A(PG8_SA(1, 0), cA + kstep, 0, false); PG8_STAGE_B(PG8_SB(1, 1), cB + hstepB + kstep);
    PG8_WAIT_V(6); PG8_BAR;
    for (;;) {
        const bool has_next = S.next(ui + 1, nxt);
        const char* nA = has_next ? wsb + nxt.aoff : cA; const char* nB = has_next ? wsb + nxt.boff : cB;
#pragma clang loop unroll(disable)
        for (int t = 0; t < nt; t += 2) {
            const bool last = (t == nt - 2);
            const char* a1 = cA + (size_t)(t + 1) * kstep;
            const char* a2 = last ? nA : cA + (size_t)(t + 2) * kstep; const char* b2 = last ? nB : cB + (size_t)(t + 2) * kstep;
            const char* a3 = a2 + kstep; const char* b3 = b2 + kstep;
            PG8_LDB(B0, 0, 0); PG8_LDB(B1, 0, 1); PG8_SCHED; PG8_LDA(At, 0, 0); PG8_STAGE_A(PG8_SA(1, 1), a1, 1, false);
            PG8_WAIT_V(8); PG8_WAIT_L(0); PG8_BAR; PG8_MMA(0, 0, At, B0); PG8_MMA(0, 1, At, B1); PG8_BAR; PG8_SCHED;
            PG8_LDA(At, 0, 1); PG8_STAGE_B(PG8_SB(0, 0), b2); PG8_STAGE_B(PG8_SB(0, 1), b2 + hstepB); PG8_STAGE_A(PG8_SA(0, 0), a2, 0, last);
            PG8_WAIT_V(8); PG8_WAIT_L(0); PG8_BAR; PG8_MMA(1, 0, At, B0); PG8_MMA(1, 1, At, B1); PG8_BAR; PG8_SCHED;
            PG8_LDB(B0, 1, 0); PG8_LDB(B1, 1, 1); PG8_SCHED; PG8_LDA(At, 1, 0); PG8_STAGE_A(PG8_SA(0, 1), a2, 1, last);
            PG8_WAIT_V(8); PG8_WAIT_L(0); PG8_BAR; PG8_MMA(0, 0, At, B0); PG8_MMA(0, 1, At, B1); PG8_BAR; PG8_SCHED;
            PG8_LDA(At, 1, 1); PG8_STAGE_B(PG8_SB(1, 0), b3); PG8_STAGE_B(PG8_SB(1, 1), b3 + hstepB); PG8_STAGE_A(PG8_SA(1, 0), a3, 0, last);
            PG8_WAIT_V(8); PG8_WAIT_L(0); PG8_BAR; PG8_MMA(1, 0, At, B0); PG8_MMA(1, 1, At, B1); PG8_BAR; PG8_SCHED;
        }
        if constexpr (FP8) asm volatile("s_nop 15\n\ts_nop 7");
        if (wr == 0) PG8_BAR;
        if constexpr (GATHER) {
#pragma unroll
            for (int h = 0; h < 2; ++h)
#pragma unroll
                for (int i = 0; i < 2; ++i) gc[h][i] = gn[h][i];
            if (has_next && S.next(ui + 2, nn)) { PG8_GIDX(gn, nn); }
        }
        E(acc, cur, wr, wc, fr, fq);
        if constexpr (GATHER) asm volatile("" : "+v"(gn[0][0]), "+v"(gn[0][1]), "+v"(gn[1][0]), "+v"(gn[1][1]));
        if (!has_next) break;
#pragma unroll
        for (int a = 0; a < 2; ++a)
#pragma unroll
            for (int b = 0; b < 2; ++b)
#pragma unroll
                for (int m = 0; m < 4; ++m)
#pragma unroll
                    for (int n = 0; n < 2; ++n) acc[a][b][m][n] = (f32x4){0.f, 0.f, 0.f, 0.f};
        cur = nxt; cA = nA; cB = nB; ++ui;
        if (wr == 1) PG8_BAR;
    }
    PG8_WAIT_V(0);
    PG8_BAR;
#undef PG8_SA
#undef PG8_SB
#undef PG8_STAGE_A
#undef PG8_STAGE_B
#undef PG8_LDA
#undef PG8_LDB
#undef PG8_MMA
#undef PG8_WAIT_V
#undef PG8_WAIT_L
#undef PG8_BAR
#undef PG8_SCHED
#undef PG8_GIDX
}
}
using pg8::Unit;

#define XB_TMO      128
#define XB_XCNT(j)  (256  + 64 * (j))
#define XB_XSUB(j)  (1280 + 64 * (j))
#define XB_XGEN(j)  (2304 + 64 * (j))
#define XB_TOP      3328
#define XB_TOPGEN   3392
#define XCD_BAR_WORDS 3456
#define XB_SPIN_CAP (1u << 18)
__device__ __forceinline__ unsigned xb_ld(unsigned* p)              { return __hip_atomic_load(p, __ATOMIC_RELAXED, __HIP_MEMORY_SCOPE_AGENT); }
__device__ __forceinline__ unsigned xb_add(unsigned* p, unsigned v) { return __hip_atomic_fetch_add(p, v, __ATOMIC_RELAXED, __HIP_MEMORY_SCOPE_AGENT); }
__device__ __forceinline__ unsigned xb_xcc_id() { return (unsigned)__builtin_amdgcn_s_getreg((3 << 11) | 20) & 0xFu; }
#define XB_SPIN(cond, bar) do { unsigned _sp = 0; while (cond) { __builtin_amdgcn_s_sleep(1); \
    if ((++_sp & 255u) == 0u) { if (xb_ld(&(bar)[XB_TMO])) break; if (_sp > XB_SPIN_CAP) { atomicAdd(&(bar)[XB_TMO], 1u); break; } } } } while (0)
struct XcdBarrier { unsigned* bar; unsigned x; volatile LAS unsigned* st; };
__device__ __forceinline__ XcdBarrier xcd_barrier_post(unsigned* bar, volatile LAS unsigned* st) {
    XcdBarrier b; b.bar = bar; b.x = xb_xcc_id(); b.st = st;
    if (threadIdx.x == 0) (void)xb_add(&bar[XB_XCNT(b.x)], 1u);
    return b;
}
__device__ __forceinline__ void xcd_barrier_complete(unsigned* bar, unsigned x, unsigned& nloc, unsigned& nx) {
    const unsigned G = gridDim.x * gridDim.y * gridDim.z;
    unsigned sum, cnt, mine, sp = 0u;
    for (;;) {
        sum = 0u; cnt = 0u; mine = 0u;
#pragma unroll
        for (unsigned j = 0; j < 16; ++j) { const unsigned c = xb_ld(&bar[XB_XCNT(j)]); sum += c; cnt += (c > 0u) ? 1u : 0u; mine = (j == x) ? c : mine; }
        if (sum == G) break;
        __builtin_amdgcn_s_sleep(1);
        if ((++sp & 255u) == 0u) { if (xb_ld(&bar[XB_TMO])) break; if (sp > XB_SPIN_CAP) { atomicAdd(&bar[XB_TMO], 1u); break; } }
    }
    nloc = mine > 0u ? mine : 1u; nx = cnt > 0u ? cnt : 1u;
}
__device__ __forceinline__ void xcd_barrier(const XcdBarrier& b) {
    asm volatile("s_waitcnt vmcnt(0)" ::: "memory");
    __syncthreads();
    if (threadIdx.x == 0) {
        unsigned* bar = b.bar;
        __builtin_amdgcn_s_waitcnt(0);
        unsigned nloc = b.st[0], nx = b.st[1];
        if (nloc == 0u) { xcd_barrier_complete(bar, b.x, nloc, nx); b.st[0] = nloc; b.st[1] = nx; }
        const unsigned old = xb_add(&bar[XB_XSUB(b.x)], 1u);
        const unsigned gen = old / nloc;
        if (old + 1u == (gen + 1u) * nloc) {
            __builtin_amdgcn_fence(__ATOMIC_RELEASE, "agent");
            asm volatile("s_waitcnt vmcnt(0)" ::: "memory");
            const unsigned og = xb_add(&bar[XB_TOP], 1u);
            const unsigned tg = og / nx;
            if (og + 1u == (tg + 1u) * nx) xb_add(&bar[XB_TOPGEN], 1u);
            else XB_SPIN(xb_ld(&bar[XB_TOPGEN]) == tg, bar);
            __builtin_amdgcn_fence(__ATOMIC_ACQUIRE, "agent");
            xb_add(&bar[XB_XGEN(b.x)], 1u);
            asm volatile("s_waitcnt vmcnt(0)" ::: "memory");
        } else {
            XB_SPIN(xb_ld(&bar[XB_XGEN(b.x)]) == gen, bar);
            __builtin_amdgcn_fence(__ATOMIC_ACQUIRE, "agent");
            asm volatile("s_waitcnt vmcnt(0)" ::: "memory");
        }
    }
    __syncthreads();
}

struct Frame {
    LAS unsigned char* lds;
    volatile LAS unsigned* MISC;
    gu32* ctl;
    unsigned char* ws;
    int tid, lane, wave, vcu, G;
    float* hf;
    const float* const* in;
};
enum In { I_X = 0, I_MEM, I_LN_IN_G, I_LN_IN_B, I_LN_MEM_G, I_LN_MEM_B, I_W_IN, I_B_IN, I_W_DW, I_B_DW, I_LN_CONV_G, I_LN_CONV_B, I_W_OUT, I_B_OUT, I_LN1_G, I_LN1_B,
          I_WQ, I_WK, I_WV, I_WO, I_LN2_G, I_LN2_B, I_W_ROUTER, I_B_ROUTER, I_W_GU, I_B_GU, I_W_DOWN, I_B_DOWN, I_LN3_G, I_LN3_B, N_IN };

__device__ __forceinline__ void p0_transpose_item(const float* W, int K, int N, bf16* WT, int k0, int n0, int drow, LAS float* scr, int lane) {
#pragma unroll 8
    for (int i = 0; i < 32; ++i) { const int kk = 2 * i + (lane >> 5); scr[kk * 33 + (lane & 31)] = W[(size_t)(k0 + kk) * N + n0 + (lane & 31)]; }
    LDS_WAIT(); asm volatile("" ::: "memory");
    const int c = lane & 7;
#pragma unroll
    for (int j = 0; j < 4; ++j) { const int n = (lane >> 3) + 8 * j; const LAS float* s = scr + (8 * c) * 33 + n;
        u32x4 o; o.x = pk2(s[0 * 33], s[1 * 33]); o.y = pk2(s[2 * 33], s[3 * 33]); o.z = pk2(s[4 * 33], s[5 * 33]); o.w = pk2(s[6 * 33], s[7 * 33]);
        *(GAS u32x4*)(WT + (size_t)(drow + n) * K + k0 + 8 * c) = o; }
    LDS_WAIT(); asm volatile("" ::: "memory");
}
__device__ __forceinline__ void ln_row(f32x4 (&v)[4], const float* g, const float* b, int lane) {
    float s = 0.f;
#pragma unroll
    for (int j = 0; j < 4; ++j) s += (v[j].x + v[j].y) + (v[j].z + v[j].w);
    const float mean = wave_sum(s) * (1.f / D); float s2 = 0.f;
#pragma unroll
    for (int j = 0; j < 4; ++j) { v[j] = v[j] - mean; s2 += (v[j].x * v[j].x + v[j].y * v[j].y) + (v[j].z * v[j].z + v[j].w * v[j].w); }
    const float rstd = 1.f / sqrtf(wave_sum(s2) * (1.f / D) + LN_EPS);
#pragma unroll
    for (int j = 0; j < 4; ++j) { const f32x4 gg = ((const GAS f32x4*)g)[lane + 64 * j], bb = ((const GAS f32x4*)b)[lane + 64 * j]; v[j] = v[j] * rstd * gg + bb; }
}
__device__ __forceinline__ void store_row_bf16(const f32x4 (&v)[4], bf16* orow, int lane) {
    GAS u32x2* o8 = (GAS u32x2*)orow + lane;
#pragma unroll
    for (int j = 0; j < 4; ++j) o8[64 * j] = (u32x2){pk2(v[j].x, v[j].y), pk2(v[j].z, v[j].w)};
}
__device__ __forceinline__ void p0_transpose_item8(const float* W, int K, int N, unsigned char* WT, int k0, int n0, int drow, float sc, LAS float* scr, int lane) {
#pragma unroll 8
    for (int i = 0; i < 32; ++i) { const int kk = 2 * i + (lane >> 5); scr[kk * 33 + (lane & 31)] = W[(size_t)(k0 + kk) * N + n0 + (lane & 31)]; }
    LDS_WAIT(); asm volatile("" ::: "memory");
    const int c = lane & 7;
#pragma unroll
    for (int j = 0; j < 4; ++j) { const int n = (lane >> 3) + 8 * j; const LAS float* s = scr + (8 * c) * 33 + n;
        u32x2 o; o.x = pk4_fp8(s[0 * 33] * sc, s[1 * 33] * sc, s[2 * 33] * sc, s[3 * 33] * sc); o.y = pk4_fp8(s[4 * 33] * sc, s[5 * 33] * sc, s[6 * 33] * sc, s[7 * 33] * sc);
        *(GAS u32x2*)(WT + (size_t)(drow + n) * K + k0 + 8 * c) = o; }
    LDS_WAIT(); asm volatile("" ::: "memory");
}
__device__ __forceinline__ void load_row_bf16(f32x4 (&v)[4], const bf16* xrow, int lane) {
    const GAS u32x2* xr = (const GAS u32x2*)xrow + lane;
#pragma unroll
    for (int j = 0; j < 4; ++j) { const u32x2 w = xr[64 * j]; v[j] = (f32x4){bflo(w.x), bfhi(w.x), bflo(w.y), bfhi(w.y)}; }
}
__device__ __forceinline__ void load_row_f32(f32x4 (&v)[4], const float* xrow, int lane) {
    const GAS f32x4* xr = (const GAS f32x4*)xrow + lane;
#pragma unroll
    for (int j = 0; j < 4; ++j) v[j] = xr[64 * j];
}
__device__ __forceinline__ void store_row_f32(const f32x4 (&v)[4], float* orow, int lane) {
    GAS f32x4* o = (GAS f32x4*)orow + lane;
#pragma unroll
    for (int j = 0; j < 4; ++j) o[64 * j] = v[j];
}

__device__ __forceinline__ void p0_prologue(Frame& F) {
    LAS float* scr = (LAS float*)(F.lds + RING_OFF + F.wave * 16384);
    const int gw = F.vcu * NWAVES + F.wave, NGW = F.G * NWAVES;
    constexpr int I_IN = 16 * 80, I_SQ = 16 * 32, I_GU = NE * 16 * 64, I_DN = NE * 16 * 32;
    constexpr int NITEMS = I_IN + 5 * I_SQ + I_GU + I_DN;
    for (int it = gw; it < NITEMS; it += NGW) {
        int r = it;
        if (r < I_IN) { const int kb = r / 80, nb = r % 80, n0 = 32 * nb; int drow;
            if (n0 < 512) drow = (n0 >> 7) * 256 + (n0 & 127); else if (n0 < 1024) drow = ((n0 - 512) >> 7) * 256 + 128 + (n0 & 127); else drow = n0;
            p0_transpose_item(F.in[I_W_IN], D, INC, (bf16*)(F.ws + WS_WIN_T), 64 * kb, n0, drow, scr, F.lane); continue; } r -= I_IN;
        if (r < 5 * I_SQ) { const int w = r / I_SQ, q = r % I_SQ, kb = q / 32, nb = q % 32;
            const float* src = F.in[w == 0 ? I_W_OUT : w == 1 ? I_WQ : w == 2 ? I_WK : w == 3 ? I_WV : I_WO];
            bf16* dst = (bf16*)(F.ws + (w == 0 ? WS_WOUT_T : w == 1 ? WS_WQ_T : w == 2 ? WS_WK_T : w == 3 ? WS_WV_T : WS_WO_T));
            p0_transpose_item(src, D, D, dst, 64 * kb, 32 * nb, 32 * nb, scr, F.lane); continue; } r -= 5 * I_SQ;
        if (r < I_GU) { const int e = r / (16 * 64), q = r % (16 * 64), kb = q / 64, nb = q % 64, n0 = 32 * nb;
            const int drow = (n0 < 1024) ? (n0 >> 7) * 256 + (n0 & 127) : ((n0 - 1024) >> 7) * 256 + 128 + (n0 & 127);
            p0_transpose_item8(F.in[I_W_GU] + (size_t)e * D * 2 * DFF, D, 2 * DFF, F.ws + WS_WGU_T + (size_t)e * 2 * DFF * D, 64 * kb, n0, drow, WGU_SC, scr, F.lane); continue; } r -= I_GU;
        { const int e = r / (16 * 32), q = r % (16 * 32), kb = q / 32, nb = q % 32;
            p0_transpose_item8(F.in[I_W_DOWN] + (size_t)e * DFF * D, DFF, D, F.ws + WS_WDN_T + (size_t)e * D * DFF, 64 * kb, 32 * nb, 32 * nb, WDN_SC, scr, F.lane); }
    }
    if (gw < 512) { const int idx = gw * 64 + F.lane, c = idx >> 5, e = idx & 31; const float w = F.in[I_W_ROUTER][idx];
        const unsigned hi = f2bf(w), lo = f2bf(w - __builtin_bit_cast(float, hi << 16)); bf16* wr = (bf16*)(F.ws + WS_WR);
        wr[e * WR_STRIDE + c] = (bf16)hi; wr[(32 + e) * WR_STRIDE + c] = (bf16)lo; }
    for (int m = gw; m < M + MM; m += NGW) {
        f32x4 v[4];
        if (m < M) { load_row_f32(v, F.in[I_X] + (size_t)m * D, F.lane); ln_row(v, F.in[I_LN_IN_G], F.in[I_LN_IN_B], F.lane);
            store_row_bf16(v, (bf16*)(F.ws + WS_HB) + (size_t)m * D, F.lane); }
        else { const int mm = m - M; load_row_f32(v, F.in[I_MEM] + (size_t)mm * D, F.lane); ln_row(v, F.in[I_LN_MEM_G], F.in[I_LN_MEM_B], F.lane);
            store_row_bf16(v, (bf16*)(F.ws + WS_MEMN) + (size_t)mm * D, F.lane); }
    }
}

constexpr unsigned TSTEP = 256u * 1024u * 2u;
struct SchedP1 { int G, c;
    __device__ __forceinline__ bool next(int i, Unit& u) const {
        const int L = i * G + c; if (L >= 1344) return false;
        u.nvalid = 256; u.goff = 0;
        if (L < 1024) { pg8::tile_order(L, 128, 8, u.pm, u.pn); u.z = 0; u.aoff = (unsigned)WS_HB + (unsigned)u.pm * TSTEP; u.boff = (unsigned)WS_WIN_T + (unsigned)u.pn * TSTEP; }
        else if (L < 1280) { const int j = L - 1024; u.pm = j & 1; u.pn = j >> 1; u.z = 3; u.aoff = (unsigned)WS_WIN_T + (unsigned)(8 + u.pm) * TSTEP; u.boff = (unsigned)WS_HB + (unsigned)u.pn * TSTEP; }
        else if (L < 1312) { const int j = L - 1280; u.pm = j & 7; u.pn = j >> 3; u.z = 1; u.aoff = (unsigned)WS_MEMN + (unsigned)u.pm * TSTEP; u.boff = (unsigned)WS_WK_T + (unsigned)u.pn * TSTEP; }
        else { const int j = L - 1312; u.pm = j & 3; u.pn = j >> 2; u.z = 2; u.aoff = (unsigned)WS_WV_T + (unsigned)u.pm * TSTEP; u.boff = (unsigned)WS_MEMN + (unsigned)u.pn * TSTEP; }
        return true; }
};
struct EpiP1 { static constexpr bool PERM = true;
    unsigned char* ws; const float* b_in;
    __device__ __forceinline__ void operator()(const f32x4 (&acc)[2][2][4][2], const Unit& u, int wr, int wc, int fr, int fq) const {
        const int row0 = u.pm * 256 + wr * 64 + fr;
        if (u.z == 0) {
            if (u.pn < 4) {
                const int ch = 128 * u.pn + wc * 32 + 8 * fq;
                f32x4 bv[2], bg[2];
#pragma unroll
                for (int n = 0; n < 2; ++n) { bv[n] = *(const f32x4*)(b_in + ch + 4 * n); bg[n] = *(const f32x4*)(b_in + 512 + ch + 4 * n); }
                bf16* U = (bf16*)(ws + WS_U);
#pragma unroll
                for (int ai = 0; ai < 2; ++ai)
#pragma unroll
                    for (int m = 0; m < 4; ++m) { f32x4 o[2];
#pragma unroll
                        for (int n = 0; n < 2; ++n) { const f32x4 a = acc[ai][0][m][n] + bv[n], g = acc[ai][1][m][n] + bg[n];
#pragma unroll
                            for (int j = 0; j < 4; ++j) o[n][j] = a[j] * sigmoidf_fast(g[j]); }
                        u32x4 w; w.x = pg8::cvt_pk_bf16(o[0][0], o[0][1]); w.y = pg8::cvt_pk_bf16(o[0][2], o[0][3]); w.z = pg8::cvt_pk_bf16(o[1][0], o[1][1]); w.w = pg8::cvt_pk_bf16(o[1][2], o[1][3]);
                        *(u32x4*)(U + (size_t)(row0 + ai * 128 + m * 16) * 512 + ch) = w; }
            } else {
                const int t = u.pn - 4, which = t >> 1, cb = (t & 1) * 256;
                bf16* dst = (bf16*)(ws + (which == 0 ? WS_Q : WS_K));
                pg8::store_tile_bf16(acc, dst + (size_t)row0 * 512 + cb, 512, b_in + 1024 + 256 * t, which == 0 ? SB_QSCALE : 1.0f, wc, fq);
            }
        } else if (u.z == 3) {
            const float* rb = b_in + 2048 + row0; bf16* p0 = (bf16*)(ws + WS_V) + (size_t)row0 * M + 256 * u.pn; const int cl = wc * 32 + 8 * fq;
#pragma unroll
            for (int ai = 0; ai < 2; ++ai)
#pragma unroll
                for (int m = 0; m < 4; ++m) { const float bv = rb[ai * 128 + m * 16]; bf16* rowp = p0 + (size_t)(ai * 128 + m * 16) * M + cl;
#pragma unroll
                    for (int bj = 0; bj < 2; ++bj) { const f32x4 v0 = acc[ai][bj][m][0] + bv, v1 = acc[ai][bj][m][1] + bv;
                        u32x4 w; w.x = pg8::cvt_pk_bf16(v0[0], v0[1]); w.y = pg8::cvt_pk_bf16(v0[2], v0[3]); w.z = pg8::cvt_pk_bf16(v1[0], v1[1]); w.w = pg8::cvt_pk_bf16(v1[2], v1[3]);
                        *(u32x4*)(rowp + bj * 128) = w; } }
        } else if (u.z == 1) pg8::store_tile_bf16(acc, (bf16*)(ws + WS_KM) + (size_t)row0 * 1024 + 256 * u.pn, 1024, nullptr, 1.0f, wc, fq);
        else pg8::store_tile_bf16(acc, (bf16*)(ws + WS_VMT) + (size_t)row0 * 2048 + 256 * u.pn, 2048, nullptr, 1.0f, wc, fq);
    }
};

struct SchedPlain { int G, c, nM, nN; unsigned abase, bbase, atile, btile, acol, bcol, bgrp;
    __device__ __forceinline__ bool next(int i, Unit& u) const {
        const int L = i * G + c; if (L >= nM * nN) return false;
        pg8::tile_order(L, nM, nN, u.pm, u.pn); u.z = 0; u.nvalid = 256; u.goff = 0;
        u.aoff = abase + (unsigned)u.pm * atile + (unsigned)u.pn * acol; u.boff = bbase + (unsigned)u.pn * btile + (unsigned)(u.pm >> 4) * bgrp + (unsigned)u.pn * bcol; return true; }
};
struct EpiBf16 { static constexpr bool PERM = true;
    bf16* O; int ldc; float scale; const float* bias;
    __device__ __forceinline__ void operator()(const f32x4 (&acc)[2][2][4][2], const Unit& u, int wr, int wc, int fr, int fq) const {
        pg8::store_tile_bf16(acc, O + (size_t)(u.pm * 256 + wr * 64 + fr) * ldc + 256 * u.pn, (size_t)ldc, bias ? bias + 256 * u.pn : nullptr, scale, wc, fq); }
};
struct SchedMoe { int G, c, nN; const LAS int* tb; unsigned abase, wbase, wexp;
    bool gather;
    __device__ __forceinline__ bool next(int i, Unit& u) const {
        const int nblk = __builtin_amdgcn_readfirstlane(tb[32]); const int L = i * G + c; if (L >= nblk * nN) return false;
        pg8::tile_order(L, nblk, nN, u.pm, u.pn);
        const int e = __builtin_amdgcn_readfirstlane(tb[128 + u.pm]);
        const int j = u.pm - tb[e], rem = tb[64 + e] - 256 * j;
        u.z = e; u.nvalid = rem < 256 ? rem : 256; u.goff = (unsigned)(e * LCAP + 256 * j);
        u.aoff = gather ? abase : abase + (unsigned)u.pm * (TSTEP / 2);
        u.boff = wbase + (unsigned)e * wexp + (unsigned)u.pn * (TSTEP / 2); return true; }
};
struct EpiAct { static constexpr bool PERM = true;
    unsigned char* ACT; const float* b_gu;
    __device__ __forceinline__ void operator()(const f32x4 (&acc)[2][2][4][2], const Unit& u, int wr, int wc, int fr, int fq) const {
        const int row0 = u.pm * 256 + wr * 64 + fr, ch = 128 * u.pn + wc * 32 + 8 * fq;
        const float* bb = b_gu + (size_t)u.z * 2 * DFF;
        f32x4 bg[2], bu[2];
#pragma unroll
        for (int n = 0; n < 2; ++n) { bg[n] = *(const f32x4*)(bb + ch + 4 * n); bu[n] = *(const f32x4*)(bb + DFF + ch + 4 * n); }
#pragma unroll
        for (int ai = 0; ai < 2; ++ai)
#pragma unroll
            for (int m = 0; m < 4; ++m) { f32x4 o[2];
#pragma unroll
                for (int n = 0; n < 2; ++n) { const f32x4 g = acc[ai][0][m][n] * (1.0f / WGU_SC) + bg[n], uu = acc[ai][1][m][n] * (1.0f / WGU_SC) + bu[n];
#pragma unroll
                    for (int j = 0; j < 4; ++j) { const float g_ = fminf(g[j], 7.0f), u_ = fminf(fmaxf(uu[j], -7.0f), 7.0f); o[n][j] = (u_ + 1.0f) * g_ * sigmoidf_fast(1.702f * g_); } }
                *(u32x2*)(ACT + (size_t)(row0 + ai * 128 + m * 16) * DFF + ch) = (u32x2){pk4_fp8(o[0][0], o[0][1], o[0][2], o[0][3]), pk4_fp8(o[1][0], o[1][1], o[1][2], o[1][3])}; }
    }
};
struct EpiDown { static constexpr bool PERM = true;
    bf16* YS; const float* b_down; const float* lgate;
    __device__ __forceinline__ void operator()(const f32x4 (&acc)[2][2][4][2], const Unit& u, int wr, int wc, int fr, int fq) const {
        const int r0 = wr * 64 + fr, cl = wc * 32 + 8 * fq;
        const float* bb = b_down + (size_t)u.z * D + 256 * u.pn + cl;
        f32x4 bv[2][2];
#pragma unroll
        for (int bj = 0; bj < 2; ++bj)
#pragma unroll
            for (int n = 0; n < 2; ++n) bv[bj][n] = *(const f32x4*)(bb + bj * 128 + 4 * n);
        float gts[2][4];
#pragma unroll
        for (int ai = 0; ai < 2; ++ai)
#pragma unroll
            for (int m = 0; m < 4; ++m) { const int r = r0 + ai * 128 + m * 16; gts[ai][m] = lgate[u.goff + (r < u.nvalid ? r : u.nvalid - 1)]; }
#pragma unroll
        for (int ai = 0; ai < 2; ++ai)
#pragma unroll
            for (int m = 0; m < 4; ++m) { const int r = r0 + ai * 128 + m * 16; const float gt = (r < u.nvalid) ? gts[ai][m] : 0.f;
                bf16* rowp = YS + (size_t)(u.pm * 256 + r) * D + 256 * u.pn + cl;
#pragma unroll
                for (int bj = 0; bj < 2; ++bj) { const f32x4 v0 = (acc[ai][bj][m][0] * (1.0f / WDN_SC) + bv[bj][0]) * gt, v1 = (acc[ai][bj][m][1] * (1.0f / WDN_SC) + bv[bj][1]) * gt;
                    u32x4 w; w.x = pg8::cvt_pk_bf16(v0[0], v0[1]); w.y = pg8::cvt_pk_bf16(v0[2], v0[3]); w.z = pg8::cvt_pk_bf16(v1[0], v1[1]); w.w = pg8::cvt_pk_bf16(v1[2], v1[3]);
                    *(u32x4*)(rowp + bj * 128) = w; } }
    }
};
__device__ __forceinline__ void moe_table(Frame& F, LAS int* tb) {
    if (F.tid < 32) { int c = (int)__hip_atomic_load(F.ctl + CW_ECNT + 64 * F.tid, RLX_AGENT); if (c > LCAP) c = LCAP; tb[64 + F.tid] = c; }
    LDS_WAIT(); __syncthreads();
    if (F.tid == 0) { int s = 0; for (int e = 0; e < NE; ++e) { tb[e] = s; s += (tb[64 + e] + 255) >> 8; } tb[32] = s; }
    LDS_WAIT(); __syncthreads();
    for (int b = F.tid; b < NBLK_MAX; b += NWAVES * 64) { int e = 0; while (e < NE - 1 && tb[e + 1] <= b) ++e; tb[128 + b] = e; }
    LDS_WAIT(); __syncthreads();
}

__device__ __forceinline__ void conv_phase(Frame& F) {
    LAS unsigned* ut = (LAS unsigned*)(F.lds + RING_OFF);
    LAS float* co = (LAS float*)(F.lds + RING_OFF + 65536);
    const int cp = F.tid & 255, half = F.tid >> 8;
    float w0[CWID], w1[CWID];
    { const float* wd = F.in[I_W_DW] + 2 * cp;
#pragma unroll
        for (int j = 0; j < CWID; ++j) { const f32x2 w = *(const GAS f32x2*)(wd + j * CONV_CH); w0[j] = w.x; w1[j] = w.y; } }
    const f32x2 bd = *(const GAS f32x2*)(F.in[I_B_DW] + 2 * cp);
    const f32x4 g0 = *(const GAS f32x4*)(F.in[I_LN_CONV_G] + 8 * F.lane), g1 = *(const GAS f32x4*)(F.in[I_LN_CONV_G] + 8 * F.lane + 4);
    const f32x4 b0 = *(const GAS f32x4*)(F.in[I_LN_CONV_B] + 8 * F.lane), b1 = *(const GAS f32x4*)(F.in[I_LN_CONV_B] + 8 * F.lane + 4);
    bf16* MX = (bf16*)(F.ws + WS_MIXIN);
    for (int it = F.vcu; it < NB * (T_ / 32); it += F.G) {
        const int b = it / (T_ / 32), t0 = (it % (T_ / 32)) * 32;
        const bf16* U = (const bf16*)(F.ws + WS_U) + (size_t)b * T_ * CONV_CH;
        for (int idx = F.tid; idx < 62 * 64; idx += 512) { const int r = idx >> 6, c16 = idx & 63, t = t0 - 30 + r;
            u32x4 v = (u32x4){0u, 0u, 0u, 0u}; if (t >= 0) v = *(const GAS u32x4*)(U + (size_t)t * CONV_CH + c16 * 8);
            *(LAS u32x4*)(ut + r * 256 + c16 * 4) = v; }
        LDS_WAIT(); __syncthreads();
        { float a0[16], a1[16];
#pragma unroll
            for (int tt = 0; tt < 16; ++tt) { a0[tt] = bd.x; a1[tt] = bd.y; }
#pragma unroll
            for (int r = 0; r < 46; ++r) { const unsigned uu = ut[(half * 16 + r) * 256 + cp]; const float u0 = bflo(uu), u1 = bfhi(uu);
#pragma unroll
                for (int tt = 0; tt < 16; ++tt) { const int j = r - tt; if (j >= 0 && j < CWID) { a0[tt] += w0[j] * u0; a1[tt] += w1[j] * u1; } } }
#pragma unroll
            for (int tt = 0; tt < 16; ++tt) *(LAS f32x2*)(co + (half * 16 + tt) * CONV_CH + 2 * cp) = (f32x2){a0[tt], a1[tt]};
        }
        LDS_WAIT(); __syncthreads();
#pragma unroll
        for (int q = 0; q < 4; ++q) { const int tt = 4 * F.wave + q;
            f32x4 x0 = *(const LAS f32x4*)(co + tt * CONV_CH + 8 * F.lane), x1 = *(const LAS f32x4*)(co + tt * CONV_CH + 8 * F.lane + 4);
            const float mean = wave_sum((x0.x + x0.y) + (x0.z + x0.w) + (x1.x + x1.y) + (x1.z + x1.w)) * (1.f / CONV_CH);
            x0 = x0 - mean; x1 = x1 - mean;
            const float var = wave_sum((x0.x * x0.x + x0.y * x0.y) + (x0.z * x0.z + x0.w * x0.w) + (x1.x * x1.x + x1.y * x1.y) + (x1.z * x1.z + x1.w * x1.w)) * (1.f / CONV_CH);
            const float rstd = 1.f / sqrtf(var + LN_EPS);
            x0 = x0 * rstd * g0 + b0; x1 = x1 * rstd * g1 + b1;
            float y[8] = {x0.x, x0.y, x0.z, x0.w, x1.x, x1.y, x1.z, x1.w};
#pragma unroll
            for (int j = 0; j < 8; ++j) y[j] = y[j] * sigmoidf_fast(y[j]);
            *(GAS u32x4*)(MX + (size_t)(b * T_ + t0 + tt) * D + 8 * F.lane) = (u32x4){pk2(y[0], y[1]), pk2(y[2], y[3]), pk2(y[4], y[5]), pk2(y[6], y[7])}; }
        __syncthreads();
    }
}

typedef float f32x16 __attribute__((ext_vector_type(16)));
__device__ __forceinline__ int crow(int r, int hi) { return (r & 3) + 8 * (r >> 2) + 4 * hi; }
__device__ __forceinline__ bf16x8 pack8(const float* v) {
    u32x4 w; w.x = pg8::cvt_pk_bf16(v[0], v[1]); w.y = pg8::cvt_pk_bf16(v[2], v[3]); w.z = pg8::cvt_pk_bf16(v[4], v[5]); w.w = pg8::cvt_pk_bf16(v[6], v[7]);
    return __builtin_bit_cast(bf16x8, w); }
constexpr float SB_EXIT = 150.0f;
struct SbStage { u32x4 k[4], v[4]; };
__device__ __forceinline__ void sb_gload(SbStage& g, const bf16* Kt, const bf16* Vt, int lane) {
#pragma unroll
    for (int i = 0; i < 4; ++i) { const int c = (lane & 7) ^ ((4 * i + (lane >> 4)) & 7); g.k[i] = *(const GAS u32x4*)(Kt + (size_t)(8 * i) * SBW + 8 * c); }
#pragma unroll
    for (int i = 0; i < 4; ++i) g.v[i] = *(const GAS u32x4*)(Vt + (size_t)(16 * i) * M);
}
__device__ __forceinline__ void sb_lwrite(const SbStage& g, LAS unsigned char* buf, int lane) {
#pragma unroll
    for (int i = 0; i < 4; ++i) *(LAS u32x4*)(buf + 1024 * i + 16 * lane) = g.k[i];
#pragma unroll
    for (int i = 0; i < 4; ++i) *(LAS u32x4*)(buf + 4096 + 1024 * i + 16 * lane) = g.v[i];
}
__device__ __forceinline__ void sb_attn_wave(Frame& F, int b, int h, int qt) {
    const int c = F.lane & 31, hi = F.lane >> 5;
    const bf16* Q = (const bf16*)(F.ws + WS_Q); const bf16* Kb = (const bf16*)(F.ws + WS_K); const bf16* VT = (const bf16*)(F.ws + WS_V);
    LAS unsigned char* wbuf = F.lds + RING_OFF + F.wave * 16384;
    bf16x8 tri[2];
#pragma unroll
    for (int s = 0; s < 2; ++s) { bf16x8 t;
#pragma unroll
        for (int j = 0; j < 8; ++j) { const int k = 16 * s + 8 * (j >> 2) + 4 * hi + (j & 3); t[j] = (k >= c) ? (short)0xBF80 : (short)0; }
        tri[s] = t; }
    bf16x8 qf[4];
    { const bf16* qp = Q + ((size_t)b * T_ + 32 * qt + c) * SBW + h * SBD + 8 * hi;
#pragma unroll
        for (int s = 0; s < 4; ++s) qf[s] = *(const GAS bf16x8*)(qp + 16 * s); }
    const bf16* Ksrc = Kb + ((size_t)b * T_ + (F.lane >> 3)) * SBW + h * SBD;
    const bf16* Vsrc = VT + (size_t)(h * SBD + (F.lane >> 2)) * M + (size_t)b * T_ + 8 * ((F.lane & 3) ^ ((F.lane >> 4) & 3));

    const int ksw = (c >> 1) & 7, vsw = (c >> 2) & 3;

    f32x16 o0, o1;
#pragma unroll
    for (int r = 0; r < 16; ++r) { o0[r] = 0.f; o1[r] = 0.f; }
    float carry = 0.f;
    SbStage st;
    sb_gload(st, Ksrc + (size_t)(32 * qt) * SBW, Vsrc + 32 * qt, F.lane); sb_lwrite(st, wbuf, F.lane);
    for (int kt = qt; kt >= 0; --kt) {
        LAS unsigned char* buf = wbuf + ((qt - kt) & 1) * 8192;
        if (kt > 0) sb_gload(st, Ksrc + (size_t)(32 * (kt - 1)) * SBW, Vsrc + 32 * (kt - 1), F.lane);
        const bool diag = (kt == qt);
        bf16x8 kf[4];
#pragma unroll
        for (int s = 0; s < 4; ++s) kf[s] = *(const LAS bf16x8*)(buf + c * 128 + 16 * ((2 * s + hi) ^ ksw));
        f32x16 p;
#pragma unroll
        for (int r = 0; r < 16; ++r) p[r] = 0.f;
#pragma unroll
        for (int s = 0; s < 4; ++s) p = __builtin_amdgcn_mfma_f32_32x32x16_bf16(kf[s], qf[s], p, 0, 0, 0);
        u32x2 vv[2][2][2];
#pragma unroll
        for (int dt = 0; dt < 2; ++dt)
#pragma unroll
            for (int s = 0; s < 2; ++s)
#pragma unroll
                for (int q = 0; q < 2; ++q) vv[dt][s][q] = *(const LAS u32x2*)(buf + 4096 + (32 * dt + c) * 64 + 16 * ((2 * s + q) ^ vsw) + 8 * hi);
        float L[16];
#pragma unroll
        for (int r = 0; r < 16; ++r) { const float y = p[r]; float l = __builtin_amdgcn_logf(1.0f + __builtin_amdgcn_exp2f(y)); l = (y > 64.f) ? y : l;
            if (diag) l = (crow(r, hi) >= c) ? 0.f : l; L[r] = l; }
        const bf16x8 l0 = pack8(L), l1 = pack8(L + 8);
        f32x16 a;
#pragma unroll
        for (int r = 0; r < 16; ++r) a[r] = p[r] - carry;
        a = __builtin_amdgcn_mfma_f32_32x32x16_bf16(tri[0], l0, a, 0, 0, 0); a = __builtin_amdgcn_mfma_f32_32x32x16_bf16(tri[1], l1, a, 0, 0, 0);
        const float tot = p[0] - a[0];
        float w[16];
#pragma unroll
        for (int r = 0; r < 16; ++r) { float x = __builtin_amdgcn_exp2f(a[r]); if (diag) x = (crow(r, hi) >= c) ? 0.f : x; w[r] = x; }
        const bf16x8 p0 = pack8(w), p1 = pack8(w + 8);
        { const bf16x8 v00 = __builtin_bit_cast(bf16x8, (u32x4){vv[0][0][0].x, vv[0][0][0].y, vv[0][0][1].x, vv[0][0][1].y});
          const bf16x8 v01 = __builtin_bit_cast(bf16x8, (u32x4){vv[0][1][0].x, vv[0][1][0].y, vv[0][1][1].x, vv[0][1][1].y});
          const bf16x8 v10 = __builtin_bit_cast(bf16x8, (u32x4){vv[1][0][0].x, vv[1][0][0].y, vv[1][0][1].x, vv[1][0][1].y});
          const bf16x8 v11 = __builtin_bit_cast(bf16x8, (u32x4){vv[1][1][0].x, vv[1][1][0].y, vv[1][1][1].x, vv[1][1][1].y});
          o0 = __builtin_amdgcn_mfma_f32_32x32x16_bf16(v00, p0, o0, 0, 0, 0); o0 = __builtin_amdgcn_mfma_f32_32x32x16_bf16(v01, p1, o0, 0, 0, 0);
          o1 = __builtin_amdgcn_mfma_f32_32x32x16_bf16(v10, p0, o1, 0, 0, 0); o1 = __builtin_amdgcn_mfma_f32_32x32x16_bf16(v11, p1, o1, 0, 0, 0); }
        carry = __shfl(tot, c);
        if (__all(carry >= SB_EXIT)) break;
        if (kt > 0) sb_lwrite(st, wbuf + ((qt - kt + 1) & 1) * 8192, F.lane);
    }
    bf16* op = (bf16*)(F.ws + WS_MIXIN) + ((size_t)b * T_ + 32 * qt + c) * D + CONV_CH + h * SBD + 4 * hi;
#pragma unroll
    for (int g = 0; g < 4; ++g) {
        *(GAS u32x2*)(op + 8 * g) = (u32x2){pg8::cvt_pk_bf16(o0[4 * g], o0[4 * g + 1]), pg8::cvt_pk_bf16(o0[4 * g + 2], o0[4 * g + 3])};
        *(GAS u32x2*)(op + 32 + 8 * g) = (u32x2){pg8::cvt_pk_bf16(o1[4 * g], o1[4 * g + 1]), pg8::cvt_pk_bf16(o1[4 * g + 2], o1[4 * g + 3])}; }
}

__device__ __forceinline__ void resid_row(f32x4 (&v)[4], const bf16* hrow, const bf16* mrow, int lane) {
    f32x4 a[4]; load_row_bf16(v, hrow, lane); load_row_bf16(a, mrow, lane);
#pragma unroll
    for (int j = 0; j < 4; ++j) v[j] = v[j] * DN_ALPHA + a[j];
}
__device__ __forceinline__ void ln_phase(Frame& F, const float* g, const float* b) {
    const int gw = F.vcu * NWAVES + F.wave, NGW = F.G * NWAVES;
    for (int m = gw; m < M; m += NGW) { f32x4 v[4]; bf16* hrow = (bf16*)(F.ws + WS_HB) + (size_t)m * D; resid_row(v, hrow, (const bf16*)(F.ws + WS_QM) + (size_t)m * D, F.lane);
        ln_row(v, g, b, F.lane); store_row_bf16(v, hrow, F.lane); }
}
__device__ __forceinline__ void softmax_phase(Frame& F) {
    const int gw = F.vcu * NWAVES + F.wave, NGW = F.G * NWAVES;
    for (int m = gw; m < M; m += NGW) { GAS u32x2* p = (GAS u32x2*)((bf16*)(F.ws + WS_SP) + (size_t)m * D) + F.lane;
#pragma unroll
        for (int j = 0; j < 4; ++j) { const u32x2 w = p[64 * j]; float x0 = bflo(w.x), x1 = bfhi(w.x), x2 = bflo(w.y), x3 = bfhi(w.y);
            const float mx = wave_max(fmaxf(fmaxf(x0, x1), fmaxf(x2, x3)));
            x0 = __builtin_amdgcn_exp2f(x0 - mx); x1 = __builtin_amdgcn_exp2f(x1 - mx); x2 = __builtin_amdgcn_exp2f(x2 - mx); x3 = __builtin_amdgcn_exp2f(x3 - mx);
            const float inv = 1.0f / wave_sum((x0 + x1) + (x2 + x3));
            p[64 * j] = (u32x2){pk2(x0 * inv, x1 * inv), pk2(x2 * inv, x3 * inv)}; } }
}
__device__ __forceinline__ void xattn_phase(Frame& F) {
    LAS unsigned char* tb0 = F.lds + RING_OFF;
    const bf16* QM = (const bf16*)(F.ws + WS_QM); const bf16* KM = (const bf16*)(F.ws + WS_KM); const bf16* VMT = (const bf16*)(F.ws + WS_VMT); bf16* OB = (bf16*)(F.ws + WS_OB);
    const int c = F.lane & 31, h5 = F.lane >> 5;
    const int tr = F.tid >> 5, tc = F.tid & 31;
    for (int u = F.vcu; u < NB * 4 * 16; u += F.G) {
        const int b = u >> 6, h = (u >> 4) & 3, qt = u & 15;
        const size_t rowq = (size_t)b * T_ + 256 * qt + 32 * F.wave + c;
        const bf16* qp = QM + rowq * D + h * 256 + 8 * h5;
        const int kr = F.tid >> 4, kc = F.tid & 15;
        const bf16* ksrc = KM + ((size_t)b * NMEM + kr) * D + h * 256 + 8 * kc;
        const int kwofs = kr * 256 + ((kc ^ kr) & 15) * 16;
        const bf16* vsrc = VMT + ((size_t)h * 256 + tr) * (size_t)MM + (size_t)b * NMEM + 8 * tc;
        const int wofs0 = tr * 512 + ((tc ^ tr) & 31) * 16, wofs1 = (tr + 16) * 512 + ((tc ^ (tr + 16)) & 31) * 16;
        u32x4 st0, st1;
        __syncthreads();
        st0 = *(const GAS u32x4*)ksrc;
        *(LAS u32x4*)(tb0 + kwofs) = st0;
        LDS_WAIT(); __syncthreads();
        f32x16 sacc[8];
#pragma unroll
        for (int dh = 0; dh < 2; ++dh) {
            bf16x8 qf[8];
#pragma unroll
            for (int s_ = 0; s_ < 8; ++s_) qf[s_] = *(const GAS bf16x8*)(qp + 128 * dh + 16 * s_);
#pragma unroll
            for (int kt = 0; kt < 8; ++kt) { const int i = dh * 8 + kt;
                LAS unsigned char* buf = tb0 + (i & 1) * 16384; LAS unsigned char* nbuf = tb0 + ((i + 1) & 1) * 16384;
                if (i < 15) st0 = *(const GAS u32x4*)(ksrc + (size_t)(32 * ((i + 1) & 7)) * D + 128 * ((i + 1) >> 3));
                else { st0 = *(const GAS u32x4*)vsrc; st1 = *(const GAS u32x4*)(vsrc + (size_t)16 * MM); }
                f32x16 a;
                if (dh == 0) {
#pragma unroll
                    for (int r = 0; r < 16; ++r) a[r] = 0.f; }
                else a = sacc[kt];
#pragma unroll
                for (int s_ = 0; s_ < 8; ++s_) { const bf16x8 kf = *(const LAS bf16x8*)(buf + c * 256 + (((2 * s_ + h5) ^ c) & 15) * 16); a = __builtin_amdgcn_mfma_f32_32x32x16_bf16(kf, qf[s_], a, 0, 0, 0); }
                sacc[kt] = a;
                if (i < 15) *(LAS u32x4*)(nbuf + kwofs) = st0; else { *(LAS u32x4*)(nbuf + wofs0) = st0; *(LAS u32x4*)(nbuf + wofs1) = st1; }
                LDS_WAIT(); __syncthreads();
            }
        }
        float mx = sacc[0][0];
#pragma unroll
        for (int kt = 0; kt < 8; ++kt)
#pragma unroll
            for (int r = 0; r < 16; ++r) mx = fmaxf(mx, sacc[kt][r]);
        mx = fmaxf(mx, __shfl_xor(mx, 32));
        float sum = 0.f; bf16x8 pb[8][2];
#pragma unroll
        for (int kt = 0; kt < 8; ++kt) { float p[16];
#pragma unroll
            for (int r = 0; r < 16; ++r) { p[r] = __builtin_amdgcn_exp2f(sacc[kt][r] - mx); sum += p[r]; }
            pb[kt][0] = pack8(p); pb[kt][1] = pack8(p + 8); }
        sum += __shfl_xor(sum, 32);
        const float inv = 1.0f / sum;
        bf16* op = OB + rowq * D + h * 256 + 4 * h5;
        for (int dt = 0; dt < 8; ++dt) {
            LAS unsigned char* buf = tb0 + (dt & 1) * 16384; LAS unsigned char* nbuf = tb0 + ((dt + 1) & 1) * 16384;
            if (dt < 7) { st0 = *(const GAS u32x4*)(vsrc + (size_t)(32 * (dt + 1)) * MM); st1 = *(const GAS u32x4*)(vsrc + (size_t)(32 * (dt + 1) + 16) * MM); }
            f32x16 o;
#pragma unroll
            for (int r = 0; r < 16; ++r) o[r] = 0.f;
#pragma unroll
            for (int kt = 0; kt < 8; ++kt)
#pragma unroll
                for (int s2 = 0; s2 < 2; ++s2) { const LAS unsigned char* rp = buf + c * 512 + 8 * h5;
                    const u32x2 v0 = *(const LAS u32x2*)(rp + (((4 * kt + 2 * s2) ^ c) & 31) * 16), v1 = *(const LAS u32x2*)(rp + (((4 * kt + 2 * s2 + 1) ^ c) & 31) * 16);
                    o = __builtin_amdgcn_mfma_f32_32x32x16_bf16(__builtin_bit_cast(bf16x8, (u32x4){v0.x, v0.y, v1.x, v1.y}), pb[kt][s2], o, 0, 0, 0); }
#pragma unroll
            for (int g = 0; g < 4; ++g) *(GAS u32x2*)(op + 32 * dt + 8 * g) = (u32x2){pg8::cvt_pk_bf16(o[4 * g] * inv, o[4 * g + 1] * inv), pg8::cvt_pk_bf16(o[4 * g + 2] * inv, o[4 * g + 3] * inv)};
            if (dt < 7) { *(LAS u32x4*)(nbuf + wofs0) = st0; *(LAS u32x4*)(nbuf + wofs1) = st1; }
            LDS_WAIT(); __syncthreads();
        }
    }
}
typedef float f32x4v __attribute__((ext_vector_type(4)));
__device__ __forceinline__ void ln2_router_phase(Frame& F) {
    LAS bf16* wr = (LAS bf16*)(F.lds + P10_WR);
    LAS float* gb = (LAS float*)(F.lds + P10_GB);
    LAS int* lcnt = (LAS int*)(F.lds + P10_LCNT);
    LAS int* rec = (LAS int*)(F.lds + P10_REC);
    for (int i = F.tid; i < 2 * 32 * WR_STRIDE * 2 / 16; i += 512) *(LAS u32x4*)(F.lds + P10_WR + 16 * i) = *(const GAS u32x4*)(F.ws + WS_WR + 16 * i);
    for (int i = F.tid; i < 512; i += 512) { *(LAS f32x4*)(gb + 4 * i) = ((const GAS f32x4*)(i < 256 ? F.in[I_LN2_G] : F.in[I_LN2_B]))[i & 255]; }
    if (F.tid < 64) lcnt[F.tid] = 0;
    LDS_WAIT(); __syncthreads();
    const bf16* H1 = (const bf16*)(F.ws + WS_HB); const bf16* CA = (const bf16*)(F.ws + WS_QM); bf16* H2 = (bf16*)(F.ws + WS_HB2);
    int* ltok = (int*)(F.ws + WS_LTOK); float* lgate = (float*)(F.ws + WS_LGATE); int* sidx = (int*)(F.ws + WS_SIDX);
    const int fr = F.lane & 15, fq = F.lane >> 4;
    for (int rb = F.vcu; rb < M / 128; rb += F.G) {
        const int m0 = rb * 128 + F.wave * 16;
        float mymean = 0.f, myrstd = 0.f;
        for (int i = 0; i < 16; ++i) { const int m = m0 + i;
            f32x4 v[4]; resid_row(v, H1 + (size_t)m * D, CA + (size_t)m * D, F.lane);
            float s1 = 0.f;
#pragma unroll
            for (int j = 0; j < 4; ++j) s1 += (v[j].x + v[j].y) + (v[j].z + v[j].w);
            const float mean = wave_sum(s1) * (1.f / D); float s2 = 0.f;
#pragma unroll
            for (int j = 0; j < 4; ++j) { v[j] = v[j] - mean; s2 += (v[j].x * v[j].x + v[j].y * v[j].y) + (v[j].z * v[j].z + v[j].w * v[j].w); }
            const float rstd = 1.f / sqrtf(wave_sum(s2) * (1.f / D) + LN_EPS);
            if (fr == i) { mymean = mean; myrstd = rstd; }
#pragma unroll
            for (int j = 0; j < 4; ++j) { const f32x4 gg = *(const LAS f32x4*)(gb + 4 * F.lane + 256 * j), bb = *(const LAS f32x4*)(gb + 1024 + 4 * F.lane + 256 * j); v[j] = v[j] * rstd * gg + bb; }
            store_row_bf16(v, H2 + (size_t)m * D, F.lane);
            { GAS unsigned* h8 = (GAS unsigned*)(F.ws + WS_HB8 + (size_t)m * D) + F.lane;
#pragma unroll
                for (int j = 0; j < 4; ++j) h8[64 * j] = pk4_fp8(v[j].x, v[j].y, v[j].z, v[j].w); }
        }
        f32x4v acc0 = {0.f, 0.f, 0.f, 0.f}, acc1 = {0.f, 0.f, 0.f, 0.f};
        { const bf16* hp = H1 + (size_t)(m0 + fr) * D + 8 * fq; const bf16* cp = CA + (size_t)(m0 + fr) * D + 8 * fq;
            const LAS bf16* wp = wr + fr * WR_STRIDE + 8 * fq; const LAS float* gp = gb + 8 * fq;
            const float sc = myrstd, sh = -mymean * myrstd;
#pragma unroll 2
            for (int s_ = 0; s_ < 32; ++s_) {
                const u32x4 hv = *(const GAS u32x4*)(hp + 32 * s_), cv = *(const GAS u32x4*)(cp + 32 * s_);
                const f32x4 g0 = *(const LAS f32x4*)(gp + 32 * s_), g1 = *(const LAS f32x4*)(gp + 32 * s_ + 4), b0 = *(const LAS f32x4*)(gp + 1024 + 32 * s_), b1 = *(const LAS f32x4*)(gp + 1024 + 32 * s_ + 4);
                float x[8];
                x[0] = bflo(hv.x) * DN_ALPHA + bflo(cv.x); x[1] = bfhi(hv.x) * DN_ALPHA + bfhi(cv.x); x[2] = bflo(hv.y) * DN_ALPHA + bflo(cv.y); x[3] = bfhi(hv.y) * DN_ALPHA + bfhi(cv.y);
                x[4] = bflo(hv.z) * DN_ALPHA + bflo(cv.z); x[5] = bfhi(hv.z) * DN_ALPHA + bfhi(cv.z); x[6] = bflo(hv.w) * DN_ALPHA + bflo(cv.w); x[7] = bfhi(hv.w) * DN_ALPHA + bfhi(cv.w);
                const float gg[8] = {g0.x, g0.y, g0.z, g0.w, g1.x, g1.y, g1.z, g1.w}, bb[8] = {b0.x, b0.y, b0.z, b0.w, b1.x, b1.y, b1.z, b1.w};
                float lo[8]; unsigned hp2[4];
#pragma unroll
                for (int j = 0; j < 8; ++j) x[j] = (x[j] * sc + sh) * gg[j] + bb[j];
#pragma unroll
                for (int j = 0; j < 4; ++j) { hp2[j] = pg8::cvt_pk_bf16(x[2 * j], x[2 * j + 1]); lo[2 * j] = x[2 * j] - bflo(hp2[j]); lo[2 * j + 1] = x[2 * j + 1] - bfhi(hp2[j]); }
                const bf16x8 bhi = __builtin_bit_cast(bf16x8, (u32x4){hp2[0], hp2[1], hp2[2], hp2[3]});
                const bf16x8 blo = pack8(lo);
                const bf16x8 wh0 = *(const LAS bf16x8*)(wp + 32 * s_), wh1 = *(const LAS bf16x8*)(wp + 16 * WR_STRIDE + 32 * s_);
                const bf16x8 wl0 = *(const LAS bf16x8*)(wp + 32 * WR_STRIDE + 32 * s_), wl1 = *(const LAS bf16x8*)(wp + 48 * WR_STRIDE + 32 * s_);
                acc0 = __builtin_amdgcn_mfma_f32_16x16x32_bf16(wh0, bhi, acc0, 0, 0, 0); acc1 = __builtin_amdgcn_mfma_f32_16x16x32_bf16(wh1, bhi, acc1, 0, 0, 0);
                acc0 = __builtin_amdgcn_mfma_f32_16x16x32_bf16(wh0, blo, acc0, 0, 0, 0); acc1 = __builtin_amdgcn_mfma_f32_16x16x32_bf16(wh1, blo, acc1, 0, 0, 0);
                acc0 = __builtin_amdgcn_mfma_f32_16x16x32_bf16(wl0, bhi, acc0, 0, 0, 0); acc1 = __builtin_amdgcn_mfma_f32_16x16x32_bf16(wl1, bhi, acc1, 0, 0, 0);
            } }
        float cand[8]; int eid[8];
        { const f32x4 br0 = *(const GAS f32x4*)(F.in[I_B_ROUTER] + 4 * fq), br1 = *(const GAS f32x4*)(F.in[I_B_ROUTER] + 16 + 4 * fq);
#pragma unroll
            for (int r = 0; r < 4; ++r) { cand[r] = acc0[r] + br0[r]; cand[4 + r] = acc1[r] + br1[r]; eid[r] = 4 * fq + r; eid[4 + r] = 16 + 4 * fq + r; } }
        float tv[TOPK]; int te[TOPK];
#pragma unroll
        for (int k = 0; k < TOPK; ++k) {
            float bv = cand[0]; int bi = eid[0];
#pragma unroll
            for (int r = 1; r < 8; ++r) if (cand[r] > bv) { bv = cand[r]; bi = eid[r]; }
#pragma unroll
            for (int o = 16; o <= 32; o <<= 1) { const float ov = __shfl_xor(bv, o); const int oi = __shfl_xor(bi, o); if (ov > bv || (ov == bv && oi < bi)) { bv = ov; bi = oi; } }
            tv[k] = bv; te[k] = bi;
#pragma unroll
            for (int r = 0; r < 8; ++r) if (eid[r] == bi) cand[r] = -INFINITY;
        }
        float pe[TOPK], ps = 0.f;
#pragma unroll
        for (int k = 0; k < TOPK; ++k) { pe[k] = __expf(tv[k] - tv[0]); ps += pe[k]; }
        if (fq == 0) {
#pragma unroll
            for (int k = 0; k < TOPK; ++k) { const int lr = __hip_atomic_fetch_add(lcnt + te[k], 1, __ATOMIC_RELAXED, __HIP_MEMORY_SCOPE_WORKGROUP);
                LAS int* r = rec + ((F.wave * 16 + fr) * 4 + k) * 4; r[0] = te[k]; r[1] = lr; r[2] = __builtin_bit_cast(int, pe[k] / ps); r[3] = m0 + fr; } }
        LDS_WAIT(); __syncthreads();
        if (F.tid < NE) lcnt[32 + F.tid] = (int)__hip_atomic_fetch_add(F.ctl + CW_ECNT + 64 * F.tid, (unsigned)lcnt[F.tid], RLX_AGENT);
        LDS_WAIT(); __syncthreads();
        { const LAS int* r = rec + (F.wave * 64 + F.lane) * 4; const int e = r[0], pos = lcnt[32 + e] + r[1], tok = r[3];
            if (pos < LCAP) { ltok[e * LCAP + pos] = tok; lgate[e * LCAP + pos] = __builtin_bit_cast(float, r[2]); } sidx[tok * 4 + (F.lane & 3)] = e * LCAP + pos; }
        __syncthreads();
        if (F.tid < 64) lcnt[F.tid] = 0;
        LDS_WAIT(); __syncthreads();
    }
}
__device__ __forceinline__ void final_phase(Frame& F, const LAS int* tb) {
    const int gw = F.vcu * NWAVES + F.wave, NGW = F.G * NWAVES;
    const int* sidx = (const int*)(F.ws + WS_SIDX); const bf16* YS = (const bf16*)(F.ws + WS_YS);
    for (int m = gw; m < M; m += NGW) { f32x4 v[4]; load_row_bf16(v, (const bf16*)(F.ws + WS_HB2) + (size_t)m * D, F.lane);
#pragma unroll
        for (int j = 0; j < 4; ++j) v[j] = v[j] * DN_ALPHA;
        f32x4 s[4];
#pragma unroll
        for (int j = 0; j < 4; ++j) s[j] = (f32x4){0.f, 0.f, 0.f, 0.f};
#pragma unroll
        for (int k = 0; k < TOPK; ++k) { const int si = sidx[m * 4 + k], e = si / LCAP, pos = si - e * LCAP; const size_t slot = (size_t)tb[e] * 256 + pos;
            const GAS u32x2* yp = (const GAS u32x2*)(YS + slot * D) + F.lane;
#pragma unroll
            for (int j = 0; j < 4; ++j) { const u32x2 w = yp[64 * j]; s[j] = s[j] + (f32x4){bflo(w.x), bfhi(w.x), bflo(w.y), bfhi(w.y)}; } }
#pragma unroll
        for (int j = 0; j < 4; ++j) v[j] = v[j] + s[j];
        ln_row(v, F.in[I_LN3_G], F.in[I_LN3_B], F.lane); store_row_f32(v, F.hf + (size_t)m * D, F.lane); }
}

struct Args { const float* in[N_IN]; float* out; unsigned char* ws; int ph_lo, ph_hi, li, pad; };
__global__ void __launch_bounds__(NWAVES * 64, 2) mk_fwd(Args args) {
    extern __shared__ __attribute__((aligned(16))) unsigned char lds[];
    Frame F;
    F.lds = (LAS unsigned char*)lds; F.MISC = (volatile LAS unsigned*)(F.lds + MISC_OFF);
    F.tid = threadIdx.x; F.lane = F.tid & 63; F.wave = __builtin_amdgcn_readfirstlane(F.tid >> 6);
    F.G = gridDim.x; { const int bx = blockIdx.x; F.vcu = (F.G % 8 == 0) ? (bx % 8) * (F.G / 8) + bx / 8 : bx; }
    F.ws = args.ws; F.ctl = (gu32*)(args.ws + WS_CTL); F.hf = args.out; F.in = args.in;
    for (int u = F.tid; u < (LDS_BYTES - LDSCTL_OFF) / 4; u += NWAVES * 64) ((LAS unsigned*)(F.lds + LDSCTL_OFF))[u] = 0u;
    __syncthreads();
    XcdBarrier bar; bar.bar = (unsigned*)(F.ctl + CW_BAR) + args.li * XCD_BAR_WORDS; bar.x = 0; bar.st = nullptr;
    const int lo = args.ph_lo, hi = args.ph_hi;
    if (hi - lo > 1) bar = xcd_barrier_post((unsigned*)(F.ctl + CW_BAR) + args.li * XCD_BAR_WORDS, F.MISC + 8);
#ifndef PH_MASK
#define PH_MASK 0xfff
#endif
#define IN(k) (((PH_MASK >> (k)) & 1) && lo <= (k) && (k) < hi)
#ifndef REP_MASK
#define REP_MASK 0
#endif
#define REPS(k) (1 + ((REP_MASK >> (k)) & 1))
#define PH_BEGIN() do { int t_ = threadIdx.x; asm volatile("" : "+v"(t_)); F.tid = t_; F.lane = t_ & 63; } while (0)
#define SEAM(k) do { if (IN(k) && IN((k) + 1)) xcd_barrier(bar); } while (0)
    const char* wsb = (const char*)args.ws;
    LAS int* tb = (LAS int*)(F.lds + TB_OFF);

    if (IN(0)) for (int rep = 0; rep < REPS(0); ++rep) { PH_BEGIN(); p0_prologue(F); __syncthreads(); } SEAM(0);
    if (IN(1)) for (int rep = 0; rep < REPS(1); ++rep) { PH_BEGIN(); SchedP1 S{F.G, (int)blockIdx.x}; EpiP1 E{F.ws, F.in[I_B_IN]};
        pg8::gemm_phase<EpiP1, SchedP1, false>(F.lds + RING_OFF, wsb, D, D, D, S, E, nullptr); } SEAM(1);
    if (IN(2)) for (int rep = 0; rep < REPS(2); ++rep) { PH_BEGIN();
        conv_phase(F);
        const int gw = F.vcu * NWAVES + F.wave;
        for (int tk = gw; tk < NB * SBH * (T_ / 32); tk += F.G * NWAVES) sb_attn_wave(F, (tk >> 7) >> 3, (tk >> 7) & 7, tk & 127);
    } SEAM(2);
    if (IN(3)) { PH_BEGIN(); SchedPlain S{F.G, (int)blockIdx.x, 128, 4, (unsigned)WS_MIXIN, (unsigned)WS_WOUT_T, TSTEP, TSTEP, 0u, 0u, 0u}; EpiBf16 E{(bf16*)(F.ws + WS_QM), D, 1.0f, F.in[I_B_OUT]};
        pg8::gemm_phase<EpiBf16, SchedPlain, false>(F.lds + RING_OFF, wsb, D, D, D, S, E, nullptr); } SEAM(3);
    if (IN(4)) { PH_BEGIN(); ln_phase(F, F.in[I_LN1_G], F.in[I_LN1_B]); } SEAM(4);
    if (IN(5)) { PH_BEGIN(); SchedPlain S{F.G, (int)blockIdx.x, 128, 4, (unsigned)WS_HB, (unsigned)WS_WQ_T, TSTEP, TSTEP, 0u, 0u, 0u}; EpiBf16 E{(bf16*)(F.ws + WS_QM), D, MEM_QSCALE, nullptr};
        pg8::gemm_phase<EpiBf16, SchedPlain, false>(F.lds + RING_OFF, wsb, D, D, D, S, E, nullptr); } SEAM(5);
    if (IN(6)) { PH_BEGIN(); xattn_phase(F); } SEAM(6);
    if (IN(7)) { PH_BEGIN(); SchedPlain S{F.G, (int)blockIdx.x, 128, 4, (unsigned)WS_OB, (unsigned)WS_WO_T, TSTEP, TSTEP, 0u, 0u, 0u}; EpiBf16 E{(bf16*)(F.ws + WS_QM), D, 1.0f, nullptr};
        pg8::gemm_phase<EpiBf16, SchedPlain, false>(F.lds + RING_OFF, wsb, D, D, D, S, E, nullptr); } SEAM(7);
    if (IN(8)) { PH_BEGIN(); ln2_router_phase(F); } SEAM(8);
    if (IN(9)) for (int rep = 0; rep < REPS(9); ++rep) { PH_BEGIN(); moe_table(F, tb); SchedMoe S{F.G, (int)blockIdx.x, 8, tb, (unsigned)WS_HB8, (unsigned)WS_WGU_T, 2048u * 1024u, true}; EpiAct E{F.ws + WS_ACT, F.in[I_B_GU]};
        pg8::gemm_phase<EpiAct, SchedMoe, true, true>(F.lds + RING_OFF, wsb, D / 2, D / 2, D / 2, S, E, (const int*)(F.ws + WS_LTOK)); } SEAM(9);
    if (IN(10)) for (int rep = 0; rep < REPS(10); ++rep) { PH_BEGIN(); moe_table(F, tb); SchedMoe S{F.G, (int)blockIdx.x, 4, tb, (unsigned)WS_ACT, (unsigned)WS_WDN_T, 1024u * 1024u, false}; EpiDown E{(bf16*)(F.ws + WS_YS), F.in[I_B_DOWN], (const float*)(F.ws + WS_LGATE)};
        pg8::gemm_phase<EpiDown, SchedMoe, false, true>(F.lds + RING_OFF, wsb, D / 2, D / 2, D / 2, S, E, nullptr); } SEAM(10);
    if (IN(11)) { PH_BEGIN(); moe_table(F, tb); final_phase(F, tb); }
#undef IN
#undef SEAM
}

extern "C" void kernel_launch(void* const* d_in, const int* in_sizes, int n_in, void* d_out, int out_size, void* d_ws, size_t ws_size, hipStream_t stream) {
    static int grid = 0;
    if (grid == 0) {
        if (n_in != N_IN || out_size != M * D || ws_size < WS_END) { fprintf(stderr, "kernel_launch: unexpected shapes (n_in %d, out %d, ws %zu)\n", n_in, out_size, ws_size); grid = -1; return; }
        int dev = 0, cus = 0, per_cu = 0;
        if (hipGetDevice(&dev) != hipSuccess || hipDeviceGetAttribute(&cus, hipDeviceAttributeMultiprocessorCount, dev) != hipSuccess) { grid = -1; return; }
        if (hipFuncSetAttribute((const void*)mk_fwd, hipFuncAttributeMaxDynamicSharedMemorySize, LDS_BYTES) != hipSuccess) { fprintf(stderr, "kernel_launch: hipFuncSetAttribute failed\n"); grid = -1; return; }
        if (hipOccupancyMaxActiveBlocksPerMultiprocessor(&per_cu, (const void*)mk_fwd, NWAVES * 64, LDS_BYTES) != hipSuccess || per_cu < 1) fprintf(stderr, "kernel_launch: occupancy query says %d\n", per_cu);
        (void)hipGetLastError();
        grid = cus;
    }
    if (grid < 0) return;
    if (hipMemsetAsync((char*)d_ws + WS_CTL, 0, CTL_ZERO_BYTES, stream) != hipSuccess) return;
    Args a{};
    for (int i = 0; i < N_IN; ++i) a.in[i] = (const float*)d_in[i];
    a.out = (float*)d_out; a.ws = (unsigned char*)d_ws;
    for (int li = 0; li < MK_N_LAUNCHES; ++li) {
        a.ph_lo = (MK_N_LAUNCHES == 1) ? 0 : li; a.ph_hi = (MK_N_LAUNCHES == 1) ? NPHASE : li + 1; a.li = (MK_N_LAUNCHES == 1) ? 0 : li;
        hipLaunchKernelGGL(mk_fwd, dim3(grid), dim3(NWAVES * 64), LDS_BYTES, stream, a);
        if (hipPeekAtLastError() != hipSuccess) { fprintf(stderr, "kernel_launch: launch %d failed\n", li); break; }
    }
#ifdef PROBE_PHASES
    { const int pp[] = {PROBE_PHASES}; for (int ph : pp) { a.ph_lo = ph; a.ph_hi = ph + 1; a.li = 15; hipLaunchKernelGGL(mk_fwd, dim3(grid), dim3(NWAVES * 64), LDS_BYTES, stream, a); } }
#endif
}
```

```cpp
#include <hip/hip_runtime.h>
#include <cstdio>
#include <cstdint>

#ifndef MK_N_LAUNCHES
#define MK_N_LAUNCHES 1
#endif

#define GAS __attribute__((address_space(1)))
#define LAS __attribute__((address_space(3)))
typedef unsigned short bf16;
typedef short bf16x8 __attribute__((ext_vector_type(8)));
typedef float f32x4 __attribute__((ext_vector_type(4)));
typedef float f32x2 __attribute__((ext_vector_type(2)));
typedef unsigned u32x4 __attribute__((ext_vector_type(4)));
typedef unsigned u32x2 __attribute__((ext_vector_type(2)));
typedef GAS unsigned gu32;
#define RLX_AGENT __ATOMIC_RELAXED, __HIP_MEMORY_SCOPE_AGENT
#define LDS_WAIT() asm volatile("s_waitcnt lgkmcnt(0)" ::: "memory")
#define VM_WAIT() asm volatile("s_waitcnt vmcnt(0)" ::: "memory")

constexpr int NB = 8, T_ = 4096, D = 1024, M = NB * T_, NMEM = 256, MM = NB * NMEM;
constexpr int CONV_CH = 512, SBH = 8, SBD = 64, SBW = 512, CWID = 31, NE = 32, TOPK = 4, DFF = 1024;
constexpr int INC = 2560;
constexpr float LN_EPS = 1e-5f;
constexpr float DN_ALPHA = 1.189207115002721f;
constexpr float LOG2E = 1.4426950408889634f;
constexpr float SB_QSCALE = 0.125f * LOG2E;
constexpr float MEM_QSCALE = 0.0625f * LOG2E;
constexpr float WGU_SC = 32.0f, WDN_SC = 64.0f;
constexpr int NBLK_MAX = M * TOPK / 256 + NE;
constexpr int LCAP = M;

constexpr size_t MiB = 1u << 20;
constexpr size_t WS_CTL = 0, CTL_ZERO_BYTES = 1 * MiB;
constexpr size_t WS_WIN_T = 1 * MiB;
constexpr size_t WS_WOUT_T = 6 * MiB;
constexpr size_t WS_WQ_T = 8 * MiB, WS_WK_T = 10 * MiB, WS_WV_T = 12 * MiB, WS_WO_T = 14 * MiB;
constexpr size_t WS_WGU_T = 16 * MiB;
constexpr size_t WS_WDN_T = 144 * MiB;
constexpr size_t WS_HB8 = 176 * MiB;
constexpr size_t WS_HB = 208 * MiB;
constexpr size_t WS_LTOK = 272 * MiB;
constexpr size_t WS_LGATE = 276 * MiB;
constexpr size_t WS_SIDX = 280 * MiB;
constexpr size_t WS_WR = 281 * MiB;
constexpr size_t WS_HB2 = 832 * MiB;
constexpr size_t WS_X = 288 * MiB;
constexpr size_t WS_U = WS_X;
constexpr size_t WS_Q = WS_X + 32 * MiB;
constexpr size_t WS_K = WS_X + 64 * MiB;
constexpr size_t WS_V = WS_X + 96 * MiB;
constexpr size_t WS_MIXIN = WS_X + 128 * MiB;
constexpr size_t WS_QM = WS_X + 192 * MiB;
constexpr size_t WS_SP = WS_X + 256 * MiB;
constexpr size_t WS_OB = WS_X + 320 * MiB;
constexpr size_t WS_MEMN = WS_X + 384 * MiB;
constexpr size_t WS_KM = WS_X + 388 * MiB;
constexpr size_t WS_VMT = WS_X + 392 * MiB;
constexpr size_t WS_ACT = WS_X;
constexpr size_t WS_YS = WS_X + 272 * MiB;
constexpr size_t WS_END = 896 * MiB;
constexpr int CW_TMO = 0, CW_CODE = 1;
constexpr int CW_BAR = 4096;
constexpr int CW_ECNT = 131072;
constexpr int NPHASE = 12;

constexpr int RING_OFF = 0, RING_BYTES = 131072;
constexpr int LDS_BYTES = 163840;
constexpr int LDSCTL_OFF = LDS_BYTES - 1024, MISC_OFF = LDSCTL_OFF + 320;
constexpr int XTRA_OFF = RING_BYTES;
constexpr int TB_OFF = XTRA_OFF + 20480;
constexpr int WR_STRIDE = 1032;
constexpr int P10_WR = 0, P10_GB = 2 * 32 * WR_STRIDE * 2, P10_LCNT = P10_GB + 8192, P10_REC = P10_LCNT + 512;
static_assert(P10_REC + 8192 <= TB_OFF && TB_OFF + 4 * (128 + 544) <= LDSCTL_OFF, "LDS map");
constexpr int NWAVES = 8;

__device__ __forceinline__ unsigned f2bf(float f) { unsigned u = __builtin_bit_cast(unsigned, f); return (u + 0x7fffu + ((u >> 16) & 1u)) >> 16; }
__device__ __forceinline__ unsigned pk2(float lo, float hi) { return f2bf(lo) | (f2bf(hi) << 16); }
__device__ __forceinline__ float bflo(unsigned u) { return __builtin_bit_cast(float, u << 16); }
__device__ __forceinline__ float bfhi(unsigned u) { return __builtin_bit_cast(float, u & 0xffff0000u); }
__device__ __forceinline__ float wave_sum(float v) {
#pragma unroll
    for (int o = 1; o < 64; o <<= 1) v += __shfl_xor(v, o);
    return v;
}
__device__ __forceinline__ float wave_max(float v) {
#pragma unroll
    for (int o = 1; o < 64; o <<= 1) v = fmaxf(v, __shfl_xor(v, o));
    return v;
}
__device__ __forceinline__ unsigned pk4_fp8(float a, float b, float c, float d) {
    int r = __builtin_amdgcn_cvt_pk_fp8_f32(a, b, 0, false); r = __builtin_amdgcn_cvt_pk_fp8_f32(c, d, r, true); return (unsigned)r; }
__device__ __forceinline__ float sigmoidf_fast(float x) { return __builtin_amdgcn_rcpf(1.0f + __expf(-x)); }

namespace pg8 {
constexpr int BM = 256, BK = 64, HALF = 128, HTB = HALF * BK * 2, STAGE_BYTES = 8 * HTB, NXCD = 8, WGM = 8;
__host__ __device__ __forceinline__ int lds_byte(int r, int c) { const int st = (r >> 4) * 2 + (c >> 5), rr = r & 15, cc = c & 31, ob = rr * 64 + cc * 2; return st * 1024 + (ob ^ (((ob >> 9) & 1) << 5)); }
__host__ __device__ __forceinline__ void stage_rc(int b, int& R, int& C) { const int st = b / 1024, sb = b % 1024, swz = sb ^ (((sb >> 9) & 1) << 5); R = (st >> 1) * 16 + swz / 64; C = (st & 1) * 32 + (swz % 64) / 2; }
__host__ __device__ __forceinline__ int perm32(int rho) { const int n = rho >> 4, i = rho & 15; return 8 * (i >> 2) + 4 * n + (i & 3); }

struct Unit { int pm, pn, z, nvalid; unsigned aoff, boff, goff; };

__device__ __forceinline__ void tile_order(int L, int nM, int nN, int& pm, int& pn) {
    const int nwg = nM * nN; int wgid = L;
    { const int q = nwg / NXCD, r = nwg % NXCD, xcd = wgid % NXCD, off = wgid / NXCD; wgid = (xcd < r ? xcd * (q + 1) : r * (q + 1) + (xcd - r) * q) + off; }
    const int nig = WGM * nN, gid = wgid / nig, fm = gid * WGM, gsz = (nM - fm) < WGM ? (nM - fm) : WGM;
    pm = fm + ((wgid % nig) % gsz); pn = (wgid % nig) / gsz;
}
__device__ __forceinline__ unsigned cvt_pk_bf16(float lo, float hi) { unsigned r; asm volatile("v_cvt_pk_bf16_f32 %0, %1, %2" : "=v"(r) : "v"(lo), "v"(hi)); return r; }

__device__ __forceinline__ void store_tile_bf16(const f32x4 (&acc)[2][2][4][2], bf16* p0, size_t ldc, const float* bias, float scale, int wc, int fq) {
    const int cl = wc * 32 + 8 * fq;
    f32x4 bv[2][2];
#pragma unroll
    for (int bj = 0; bj < 2; ++bj)
#pragma unroll
        for (int n = 0; n < 2; ++n) bv[bj][n] = bias ? *(const f32x4*)(bias + cl + bj * HALF + 4 * n) : (f32x4){0.f, 0.f, 0.f, 0.f};
#pragma unroll
    for (int ai = 0; ai < 2; ++ai)
#pragma unroll
        for (int m = 0; m < 4; ++m) { bf16* rowp = p0 + (size_t)(ai * HALF + m * 16) * ldc + cl;
#pragma unroll
            for (int bj = 0; bj < 2; ++bj) { const f32x4 v0 = (acc[ai][bj][m][0] + bv[bj][0]) * scale, v1 = (acc[ai][bj][m][1] + bv[bj][1]) * scale;
                u32x4 w; w.x = cvt_pk_bf16(v0[0], v0[1]); w.y = cvt_pk_bf16(v0[2], v0[3]); w.z = cvt_pk_bf16(v1[0], v1[1]); w.w = cvt_pk_bf16(v1[2], v1[3]);
                *(u32x4*)(rowp + bj * HALF) = w; } }
}

typedef int v8i __attribute__((ext_vector_type(8)));
template <class Epi, class Sched, bool GATHER, bool FP8 = false>
__device__ __forceinline__ void gemm_phase(LAS unsigned char* lds, const char* wsb, const int lda, const int ldb, const int K, const Sched& S, const Epi& E, const int* glist) {
    int tid = threadIdx.x; asm volatile("" : "+v"(tid));
    const int wid = __builtin_amdgcn_readfirstlane(tid >> 6), lane = tid & 63, wr = wid >> 2, wc = wid & 3, fr = lane & 15, fq = lane >> 4;
    const int nt = K / BK;
    unsigned voffA[2], voffB[2];
#pragma unroll
    for (int i = 0; i < 2; ++i) { int R, C; stage_rc(tid * 16 + i * 8192, R, C); const int Rb = Epi::PERM ? ((R & ~31) + perm32(R & 31)) : R;
        voffA[i] = (unsigned)(R * lda + C) * 2u; voffB[i] = (unsigned)(Rb * ldb + C) * 2u; }
    const size_t kstep = (size_t)(BK * 2);
    const size_t hstepA = (size_t)HALF * lda * 2, hstepB = (size_t)HALF * ldb * 2;
    const unsigned ldsw = (unsigned)wid * 1024u;
    const int aoff = lds_byte(wr * 64 + fr, fq * 8), boff = lds_byte(wc * 32 + fr, fq * 8);
    unsigned gc[2][2], gn[2][2];
#define PG8_SA(b, h) (((b) * 2 + (h)) * HTB)
#define PG8_SB(b, h) ((4 + (b) * 2 + (h)) * HTB)
#define PG8_STAGE_B(bufoff, gbase) do { _Pragma("unroll") for (int _i = 0; _i < 2; ++_i) \
        __builtin_amdgcn_global_load_lds((const unsigned*)((const char*)(gbase) + voffB[_i]), (LAS unsigned*)(lds + (bufoff) + ldsw + _i * 8192), 16, 0, 0); } while (0)
#define PG8_STAGE_A(bufoff, gbase, h, nx) do { _Pragma("unroll") for (int _i = 0; _i < 2; ++_i) { \
        const char* _p = GATHER ? (const char*)(gbase) + ((nx) ? gn[h][_i] : gc[h][_i]) : (const char*)(gbase) + (h) * hstepA + voffA[_i]; \
        __builtin_amdgcn_global_load_lds((const unsigned*)_p, (LAS unsigned*)(lds + (bufoff) + ldsw + _i * 8192), 16, 0, 0); } } while (0)
#define PG8_LDA(dst, b, h) do { _Pragma("unroll") for (int m = 0; m < 4; ++m) { if constexpr (FP8) { const u32x4 _lo = *(const LAS u32x4*)(lds + PG8_SA(b, h) + aoff + m * 2048), _hi = *(const LAS u32x4*)(lds + PG8_SA(b, h) + aoff + m * 2048 + 1024); \
            dst##8[m] = (v8i){(int)_lo.x, (int)_lo.y, (int)_lo.z, (int)_lo.w, (int)_hi.x, (int)_hi.y, (int)_hi.z, (int)_hi.w}; } \
        else { _Pragma("unroll") for (int k = 0; k < 2; ++k) dst[m][k] = *(const LAS bf16x8*)(lds + PG8_SA(b, h) + aoff + m * 2048 + k * 1024); } } } while (0)
#define PG8_LDB(dst, b, h) do { _Pragma("unroll") for (int n = 0; n < 2; ++n) { if constexpr (FP8) { const u32x4 _lo = *(const LAS u32x4*)(lds + PG8_SB(b, h) + boff + n * 2048), _hi = *(const LAS u32x4*)(lds + PG8_SB(b, h) + boff + n * 2048 + 1024); \
            dst##8[n] = (v8i){(int)_lo.x, (int)_lo.y, (int)_lo.z, (int)_lo.w, (int)_hi.x, (int)_hi.y, (int)_hi.z, (int)_hi.w}; } \
        else { _Pragma("unroll") for (int k = 0; k < 2; ++k) dst[n][k] = *(const LAS bf16x8*)(lds + PG8_SB(b, h) + boff + n * 2048 + k * 1024); } } } while (0)
#define PG8_MMA(ai, bj, At, Bt) do { __builtin_amdgcn_s_setprio(1); if constexpr (FP8) asm volatile("s_nop 1"); _Pragma("unroll") for (int m = 0; m < 4; ++m) _Pragma("unroll") for (int n = 0; n < 2; ++n) { \
        if constexpr (FP8) asm volatile("v_mfma_f32_16x16x128_f8f6f4 %0, %1, %2, %0" : "+v"(acc[ai][bj][m][n]) : "v"(Bt##8[n]), "v"(At##8[m])); \
        else { _Pragma("unroll") for (int k = 0; k < 2; ++k) acc[ai][bj][m][n] = __builtin_amdgcn_mfma_f32_16x16x32_bf16(Bt[n][k], At[m][k], acc[ai][bj][m][n], 0, 0, 0); } } \
        __builtin_amdgcn_s_setprio(0); } while (0)
#define PG8_WAIT_V(n) asm volatile("s_waitcnt vmcnt(" #n ")" ::: "memory")
#define PG8_WAIT_L(n) asm volatile("s_waitcnt lgkmcnt(" #n ")" ::: "memory")
#define PG8_BAR __builtin_amdgcn_s_barrier()
#define PG8_SCHED __builtin_amdgcn_sched_barrier(0)
#define PG8_GIDX(g, u) do { _Pragma("unroll") for (int _h = 0; _h < 2; ++_h) _Pragma("unroll") for (int _i = 0; _i < 2; ++_i) { int _R, _C; stage_rc(tid * 16 + _i * 8192, _R, _C); const int _r = _h * HALF + _R; \
        const int _tok = glist[(u).goff + (_r < (u).nvalid ? _r : (u).nvalid - 1)]; g[_h][_i] = (unsigned)_tok * (unsigned)(lda * 2) + (unsigned)(_C * 2); } } while (0)
    Unit cur, nxt, nn; int ui = 0;
    if (!S.next(0, cur)) return;
    f32x4 acc[2][2][4][2];
#pragma unroll
    for (int a = 0; a < 2; ++a)
#pragma unroll
        for (int b = 0; b < 2; ++b)
#pragma unroll
            for (int m = 0; m < 4; ++m)
#pragma unroll
                for (int n = 0; n < 2; ++n) acc[a][b][m][n] = (f32x4){0.f, 0.f, 0.f, 0.f};
    bf16x8 At[4][2], B0[2][2], B1[2][2];
    v8i At8[4], B08[2], B18[2];
    const char* cA = wsb + cur.aoff; const char* cB = wsb + cur.boff;
    if constexpr (GATHER) { PG8_GIDX(gc, cur); if (S.next(1, nxt)) { PG8_GIDX(gn, nxt); } else { PG8_GIDX(gn, cur); }
        asm volatile("s_waitcnt vmcnt(0)" : "+v"(gc[0][0]), "+v"(gc[0][1]), "+v"(gc[1][0]), "+v"(gc[1][1]), "+v"(gn[0][0]), "+v"(gn[0][1]), "+v"(gn[1][0]), "+v"(gn[1][1]) :: "memory"); }
    else {
#pragma unroll
        for (int h = 0; h < 2; ++h)
#pragma unroll
            for (int i = 0; i < 2; ++i) { gc[h][i] = 0u; gn[h][i] = 0u; } }
    PG8_STAGE_B(PG8_SB(0, 0), cB); PG8_STAGE_B(PG8_SB(0, 1), cB + hstepB); PG8_STAGE_A(PG8_SA(0, 0), cA, 0, false); PG8_STAGE_A(PG8_SA(0, 1), cA, 1, false);
    if (wr == 1) PG8_BAR;
    PG8_WAIT_V(2); PG8_BAR;
    PG8_STAGE_B(PG8_SB(1, 0), cB + kstep); PG8_STAGE_A(PG8_SA(1, 0), cA + kstep, 0, false); PG8_STAGE_B(PG8_SB(1, 1), cB + hstepB + kstep);
    PG8_WAIT_V(6); PG8_BAR;
    for (;;) {
        const bool has_next = S.next(ui + 1, nxt);
        const char* nA = has_next ? wsb + nxt.aoff : cA; const char* nB = has_next ? wsb + nxt.boff : cB;
#pragma clang loop unroll(disable)
        for (int t = 0; t < nt; t += 2) {
            const bool last = (t == nt - 2);
            const char* a1 = cA + (size_t)(t + 1) * kstep;
            const char* a2 = last ? nA : cA + (size_t)(t + 2) * kstep; const char* b2 = last ? nB : cB + (size_t)(t + 2) * kstep;
            const char* a3 = a2 + kstep; const char* b3 = b2 + kstep;
            PG8_LDB(B0, 0, 0); PG8_LDB(B1, 0, 1); PG8_SCHED; PG8_LDA(At, 0, 0); PG8_STAGE_A(PG8_SA(1, 1), a1, 1, false);
            PG8_WAIT_V(8); PG8_WAIT_L(0); PG8_BAR; PG8_MMA(0, 0, At, B0); PG8_MMA(0, 1, At, B1); PG8_BAR; PG8_SCHED;
            PG8_LDA(At, 0, 1); PG8_STAGE_B(PG8_SB(0, 0), b2); PG8_STAGE_B(PG8_SB(0, 1), b2 + hstepB); PG8_STAGE_A(PG8_SA(0, 0), a2, 0, last);
            PG8_WAIT_V(8); PG8_WAIT_L(0); PG8_BAR; PG8_MMA(1, 0, At, B0); PG8_MMA(1, 1, At, B1); PG8_BAR; PG8_SCHED;
            PG8_LDB(B0, 1, 0); PG8_LDB(B1, 1, 1); PG8_SCHED; PG8_LDA(At, 1, 0); PG8_STAGE_A(PG8_SA(0, 1), a2, 1, last);
            PG8_WAIT_V(8); PG8_WAIT_L(0); PG8_BAR; PG8_MMA(0, 0, At, B0); PG8_MMA(0, 1, At, B1); PG8_BAR; PG8_SCHED;
            PG8_LDA(At, 1, 1); PG8_STAGE_B(PG8_SB(1, 0), b3); PG8_STAGE_B(PG8_SB(1, 1), b3 + hstepB); PG8_STAGE_A(PG8_SA(1, 0), a3, 0, last);
            PG8_WAIT_V(8); PG8_WAIT_L(0); PG8_BAR; PG8_MMA(1, 0, At, B0); PG8_MMA(1, 1, At, B1); PG8_BAR; PG8_SCHED;
        }
        if constexpr (FP8) asm volatile("s_nop 15\n\ts_nop 7");
        if (wr == 0) PG8_BAR;
        if constexpr (GATHER) {
#pragma unroll
            for (int h = 0; h < 2; ++h)
#pragma unroll
                for (int i = 0; i < 2; ++i) gc[h][i] = gn[h][i];
            if (has_next && S.next(ui + 2, nn)) { PG8_GIDX(gn, nn); }
        }
        E(acc, cur, wr, wc, fr, fq);
        if constexpr (GATHER) asm volatile("" : "+v"(gn[0][0]), "+v"(gn[0][1]), "+v"(gn[1][0]), "+v"(gn[1][1]));
        if (!has_next) break;
#pragma unroll
        for (int a = 0; a < 2; ++a)
#pragma unroll
            for (int b = 0; b < 2; ++b)
#pragma unroll
                for (int m = 0; m < 4; ++m)
#pragma unroll
                    for (int n = 0; n < 2; ++n) acc[a][b][m][n] = (f32x4){0.f, 0.f, 0.f, 0.f};
        cur = nxt; cA = nA; cB = nB; ++ui;
        if (wr == 1) PG8_BAR;
    }
    PG8_WAIT_V(0);
    PG8_BAR;
#undef PG8_SA
#undef PG8_SB
#undef PG8_STAGE_A
#undef PG8_STAGE_B
#undef PG8_LDA
#undef PG8_LDB
#undef PG8_MMA
#undef PG8_WAIT_V
#undef PG8_WAIT_L
#undef PG8_BAR
#undef PG8_SCHED
#undef PG8_GIDX
}
}
using pg8::Unit;

#define XB_TMO      128
#define XB_XCNT(j)  (256  + 64 * (j))
#define XB_XSUB(j)  (1280 + 64 * (j))
#define XB_XGEN(j)  (2304 + 64 * (j))
#define XB_TOP      3328
#define XB_TOPGEN   3392
#define XCD_BAR_WORDS 3456
#define XB_SPIN_CAP (1u << 18)
__device__ __forceinline__ unsigned xb_ld(unsigned* p)              { return __hip_atomic_load(p, __ATOMIC_RELAXED, __HIP_MEMORY_SCOPE_AGENT); }
__device__ __forceinline__ unsigned xb_add(unsigned* p, unsigned v) { return __hip_atomic_fetch_add(p, v, __ATOMIC_RELAXED, __HIP_MEMORY_SCOPE_AGENT); }
__device__ __forceinline__ unsigned xb_xcc_id() { return (unsigned)__builtin_amdgcn_s_getreg((3 << 11) | 20) & 0xFu; }
#define XB_SPIN(cond, bar) do { unsigned _sp = 0; while (cond) { __builtin_amdgcn_s_sleep(1); \
    if ((++_sp & 255u) == 0u) { if (xb_ld(&(bar)[XB_TMO])) break; if (_sp > XB_SPIN_CAP) { atomicAdd(&(bar)[XB_TMO], 1u); break; } } } } while (0)
struct XcdBarrier { unsigned* bar; unsigned x; volatile LAS unsigned* st; };
__device__ __forceinline__ XcdBarrier xcd_barrier_post(unsigned* bar, volatile LAS unsigned* st) {
    XcdBarrier b; b.bar = bar; b.x = xb_xcc_id(); b.st = st;
    if (threadIdx.x == 0) (void)xb_add(&bar[XB_XCNT(b.x)], 1u);
    return b;
}
__device__ __forceinline__ void xcd_barrier_complete(unsigned* bar, unsigned x, unsigned& nloc, unsigned& nx) {
    const unsigned G = gridDim.x * gridDim.y * gridDim.z;
    unsigned sum, cnt, mine, sp = 0u;
    for (;;) {
        sum = 0u; cnt = 0u; mine = 0u;
#pragma unroll
        for (unsigned j = 0; j < 16; ++j) { const unsigned c = xb_ld(&bar[XB_XCNT(j)]); sum += c; cnt += (c > 0u) ? 1u : 0u; mine = (j == x) ? c : mine; }
        if (sum == G) break;
        __builtin_amdgcn_s_sleep(1);
        if ((++sp & 255u) == 0u) { if (xb_ld(&bar[XB_TMO])) break; if (sp > XB_SPIN_CAP) { atomicAdd(&bar[XB_TMO], 1u); break; } }
    }
    nloc = mine > 0u ? mine : 1u; nx = cnt > 0u ? cnt : 1u;
}
__device__ __forceinline__ void xcd_barrier(const XcdBarrier& b) {
    asm volatile("s_waitcnt vmcnt(0)" ::: "memory");
    __syncthreads();
    if (threadIdx.x == 0) {
        unsigned* bar = b.bar;
        __builtin_amdgcn_s_waitcnt(0);
        unsigned nloc = b.st[0], nx = b.st[1];
        if (nloc == 0u) { xcd_barrier_complete(bar, b.x, nloc, nx); b.st[0] = nloc; b.st[1] = nx; }
        const unsigned old = xb_add(&bar[XB_XSUB(b.x)], 1u);
        const unsigned gen = old / nloc;
        if (old + 1u == (gen + 1u) * nloc) {
            __builtin_amdgcn_fence(__ATOMIC_RELEASE, "agent");
            asm volatile("s_waitcnt vmcnt(0)" ::: "memory");
            const unsigned og = xb_add(&bar[XB_TOP], 1u);
            const unsigned tg = og / nx;
            if (og + 1u == (tg + 1u) * nx) xb_add(&bar[XB_TOPGEN], 1u);
            else XB_SPIN(xb_ld(&bar[XB_TOPGEN]) == tg, bar);
            __builtin_amdgcn_fence(__ATOMIC_ACQUIRE, "agent");
            xb_add(&bar[XB_XGEN(b.x)], 1u);
            asm volatile("s_waitcnt vmcnt(0)" ::: "memory");
        } else {
            XB_SPIN(xb_ld(&bar[XB_XGEN(b.x)]) == gen, bar);
            __builtin_amdgcn_fence(__ATOMIC_ACQUIRE, "agent");
            asm volatile("s_waitcnt vmcnt(0)" ::: "memory");
        }
    }
    __syncthreads();
}

struct Frame {
    LAS unsigned char* lds;
    volatile LAS unsigned* MISC;
    gu32* ctl;
    unsigned char* ws;
    int tid, lane, wave, vcu, G;
    float* hf;
    const float* const* in;
};
enum In { I_X = 0, I_MEM, I_LN_IN_G, I_LN_IN_B, I_LN_MEM_G, I_LN_MEM_B, I_W_IN, I_B_IN, I_W_DW, I_B_DW, I_LN_CONV_G, I_LN_CONV_B, I_W_OUT, I_B_OUT, I_LN1_G, I_LN1_B,
          I_WQ, I_WK, I_WV, I_WO, I_LN2_G, I_LN2_B, I_W_ROUTER, I_B_ROUTER, I_W_GU, I_B_GU, I_W_DOWN, I_B_DOWN, I_LN3_G, I_LN3_B, N_IN };

__device__ __forceinline__ void p0_transpose_item(const float* W, int K, int N, bf16* WT, int k0, int n0, int drow, LAS float* scr, int lane) {
#pragma unroll 8
    for (int i = 0; i < 32; ++i) { const int kk = 2 * i + (lane >> 5); scr[kk * 33 + (lane & 31)] = W[(size_t)(k0 + kk) * N + n0 + (lane & 31)]; }
    LDS_WAIT(); asm volatile("" ::: "memory");
    const int c = lane & 7;
#pragma unroll
    for (int j = 0; j < 4; ++j) { const int n = (lane >> 3) + 8 * j; const LAS float* s = scr + (8 * c) * 33 + n;
        u32x4 o; o.x = pk2(s[0 * 33], s[1 * 33]); o.y = pk2(s[2 * 33], s[3 * 33]); o.z = pk2(s[4 * 33], s[5 * 33]); o.w = pk2(s[6 * 33], s[7 * 33]);
        *(GAS u32x4*)(WT + (size_t)(drow + n) * K + k0 + 8 * c) = o; }
    LDS_WAIT(); asm volatile("" ::: "memory");
}
__device__ __forceinline__ void ln_row(f32x4 (&v)[4], const float* g, const float* b, int lane) {
    float s = 0.f;
#pragma unroll
    for (int j = 0; j < 4; ++j) s += (v[j].x + v[j].y) + (v[j].z + v[j].w);
    const float mean = wave_sum(s) * (1.f / D); float s2 = 0.f;
#pragma unroll
    for (int j = 0; j < 4; ++j) { v[j] = v[j] - mean; s2 += (v[j].x * v[j].x + v[j].y * v[j].y) + (v[j].z * v[j].z + v[j].w * v[j].w); }
    const float rstd = 1.f / sqrtf(wave_sum(s2) * (1.f / D) + LN_EPS);
#pragma unroll
    for (int j = 0; j < 4; ++j) { const f32x4 gg = ((const GAS f32x4*)g)[lane + 64 * j], bb = ((const GAS f32x4*)b)[lane + 64 * j]; v[j] = v[j] * rstd * gg + bb; }
}
__device__ __forceinline__ void store_row_bf16(const f32x4 (&v)[4], bf16* orow, int lane) {
    GAS u32x2* o8 = (GAS u32x2*)orow + lane;
#pragma unroll
    for (int j = 0; j < 4; ++j) o8[64 * j] = (u32x2){pk2(v[j].x, v[j].y), pk2(v[j].z, v[j].w)};
}
__device__ __forceinline__ void p0_transpose_item8(const float* W, int K, int N, unsigned char* WT, int k0, int n0, int drow, float sc, LAS float* scr, int lane) {
#pragma unroll 8
    for (int i = 0; i < 32; ++i) { const int kk = 2 * i + (lane >> 5); scr[kk * 33 + (lane & 31)] = W[(size_t)(k0 + kk) * N + n0 + (lane & 31)]; }
    LDS_WAIT(); asm volatile("" ::: "memory");
    const int c = lane & 7;
#pragma unroll
    for (int j = 0; j < 4; ++j) { const int n = (lane >> 3) + 8 * j; const LAS float* s = scr + (8 * c) * 33 + n;
        u32x2 o; o.x = pk4_fp8(s[0 * 33] * sc, s[1 * 33] * sc, s[2 * 33] * sc, s[3 * 33] * sc); o.y = pk4_fp8(s[4 * 33] * sc, s[5 * 33] * sc, s[6 * 33] * sc, s[7 * 33] * sc);
        *(GAS u32x2*)(WT + (size_t)(drow + n) * K + k0 + 8 * c) = o; }
    LDS_WAIT(); asm volatile("" ::: "memory");
}
__device__ __forceinline__ void p0_transpose_item8b(const float* W, int K, int N, unsigned char* WT, int k0, int n0, int drow, float sc, LAS unsigned char* scr, int lane) {
    const int g = lane >> 3, c = lane & 7;
    f32x4 x[4][4];
#pragma unroll
    for (int q = 0; q < 4; ++q)
#pragma unroll
        for (int j = 0; j < 4; ++j) x[q][j] = *(const GAS f32x4*)(W + (size_t)(k0 + 32 * q + 4 * g + j) * N + n0 + 4 * c);
#pragma unroll
    for (int q = 0; q < 4; ++q)
#pragma unroll
        for (int e = 0; e < 4; ++e) *(LAS unsigned*)(scr + (4 * c + e) * 144 + 32 * q + 4 * g) = pk4_fp8(x[q][0][e] * sc, x[q][1][e] * sc, x[q][2][e] * sc, x[q][3][e] * sc);
    LDS_WAIT(); asm volatile("" ::: "memory");
#pragma unroll
    for (int i = 0; i < 4; ++i) { const int t = lane + 64 * i, n = t >> 3, ch = t & 7;
        *(GAS u32x4*)(WT + (size_t)(drow + n) * K + k0 + 16 * ch) = *(const LAS u32x4*)(scr + n * 144 + 16 * ch); }
    LDS_WAIT(); asm volatile("" ::: "memory");
}
__device__ __forceinline__ void load_row_bf16(f32x4 (&v)[4], const bf16* xrow, int lane) {
    const GAS u32x2* xr = (const GAS u32x2*)xrow + lane;
#pragma unroll
    for (int j = 0; j < 4; ++j) { const u32x2 w = xr[64 * j]; v[j] = (f32x4){bflo(w.x), bfhi(w.x), bflo(w.y), bfhi(w.y)}; }
}
__device__ __forceinline__ void load_row_f32(f32x4 (&v)[4], const float* xrow, int lane) {
    const GAS f32x4* xr = (const GAS f32x4*)xrow + lane;
#pragma unroll
    for (int j = 0; j < 4; ++j) v[j] = xr[64 * j];
}
__device__ __forceinline__ void store_row_f32(const f32x4 (&v)[4], float* orow, int lane) {
    GAS f32x4* o = (GAS f32x4*)orow + lane;
#pragma unroll
    for (int j = 0; j < 4; ++j) o[64 * j] = v[j];
}

__device__ __forceinline__ void p0_prologue(Frame& F) {
    LAS float* scr = (LAS float*)(F.lds + RING_OFF + F.wave * 16384);
    const int gw = F.vcu * NWAVES + F.wave, NGW = F.G * NWAVES;
    constexpr int I_IN = 16 * 80, I_SQ = 16 * 32, I_GU = NE * 8 * 64, I_DN = NE * 8 * 32;
    constexpr int NITEMS = I_IN + 5 * I_SQ + I_GU + I_DN;
    for (int it = gw; it < NITEMS; it += NGW) {
        int r = it;
        if (r < I_GU) { const int e = r / (8 * 64), q = r % (8 * 64), kb = q / 64, nb = q % 64, n0 = 32 * nb;
            const int drow = (n0 < 1024) ? (n0 >> 7) * 256 + (n0 & 127) : ((n0 - 1024) >> 7) * 256 + 128 + (n0 & 127);
            p0_transpose_item8b(F.in[I_W_GU] + (size_t)e * D * 2 * DFF, D, 2 * DFF, F.ws + WS_WGU_T + (size_t)e * 2 * DFF * D, 128 * kb, n0, drow, WGU_SC, (LAS unsigned char*)scr, F.lane); continue; } r -= I_GU;
        if (r < I_DN) { const int e = r / (8 * 32), q = r % (8 * 32), kb = q / 32, nb = q % 32;
            p0_transpose_item8b(F.in[I_W_DOWN] + (size_t)e * DFF * D, DFF, D, F.ws + WS_WDN_T + (size_t)e * D * DFF, 128 * kb, 32 * nb, 32 * nb, WDN_SC, (LAS unsigned char*)scr, F.lane); continue; } r -= I_DN;
        if (r < I_IN) { const int kb = r / 80, nb = r % 80, n0 = 32 * nb; int drow;
            if (n0 < 512) drow = (n0 >> 7) * 256 + (n0 & 127); else if (n0 < 1024) drow = ((n0 - 512) >> 7) * 256 + 128 + (n0 & 127); else drow = n0;
            p0_transpose_item(F.in[I_W_IN], D, INC, (bf16*)(F.ws + WS_WIN_T), 64 * kb, n0, drow, scr, F.lane); continue; } r -= I_IN;
        { const int w = r / I_SQ, q = r % I_SQ, kb = q / 32, nb = q % 32;
            const float* src = F.in[w == 0 ? I_W_OUT : w == 1 ? I_WQ : w == 2 ? I_WK : w == 3 ? I_WV : I_WO];
            bf16* dst = (bf16*)(F.ws + (w == 0 ? WS_WOUT_T : w == 1 ? WS_WQ_T : w == 2 ? WS_WK_T : w == 3 ? WS_WV_T : WS_WO_T));
            p0_transpose_item(src, D, D, dst, 64 * kb, 32 * nb, 32 * nb, scr, F.lane); }
    }
    if (gw < 512) { const int idx = gw * 64 + F.lane, c = idx >> 5, e = idx & 31; const float w = F.in[I_W_ROUTER][idx];
        const unsigned hi = f2bf(w), lo = f2bf(w - __builtin_bit_cast(float, hi << 16)); bf16* wr = (bf16*)(F.ws + WS_WR);
        wr[e * WR_STRIDE + c] = (bf16)hi; wr[(32 + e) * WR_STRIDE + c] = (bf16)lo; }
    for (int m = gw; m < M + MM; m += NGW) {
        f32x4 v[4];
        if (m < M) { load_row_f32(v, F.in[I_X] + (size_t)m * D, F.lane); ln_row(v, F.in[I_LN_IN_G], F.in[I_LN_IN_B], F.lane);
            store_row_bf16(v, (bf16*)(F.ws + WS_HB) + (size_t)m * D, F.lane); }
        else { const int mm = m - M; load_row_f32(v, F.in[I_MEM] + (size_t)mm * D, F.lane); ln_row(v, F.in[I_LN_MEM_G], F.in[I_LN_MEM_B], F.lane);
            store_row_bf16(v, (bf16*)(F.ws + WS_MEMN) + (size_t)mm * D, F.lane); }
    }
}

constexpr unsigned TSTEP = 256u * 1024u * 2u;
struct SchedP1 { int G, c;
    __device__ __forceinline__ bool next(int i, Unit& u) const {
        const int L = i * G + c; if (L >= 1344) return false;
        u.nvalid = 256; u.goff = 0;
        if (L < 1024) { pg8::tile_order(L, 128, 8, u.pm, u.pn); u.z = 0; u.aoff = (unsigned)WS_HB + (unsigned)u.pm * TSTEP; u.boff = (unsigned)WS_WIN_T + (unsigned)u.pn * TSTEP; }
        else if (L < 1280) { const int j = L - 1024; u.pm = j & 1; u.pn = j >> 1; u.z = 3; u.aoff = (unsigned)WS_WIN_T + (unsigned)(8 + u.pm) * TSTEP; u.boff = (unsigned)WS_HB + (unsigned)u.pn * TSTEP; }
        else if (L < 1312) { const int j = L - 1280; u.pm = j & 7; u.pn = j >> 3; u.z = 1; u.aoff = (unsigned)WS_MEMN + (unsigned)u.pm * TSTEP; u.boff = (unsigned)WS_WK_T + (unsigned)u.pn * TSTEP; }
        else { const int j = L - 1312; u.pm = j & 3; u.pn = j >> 2; u.z = 2; u.aoff = (unsigned)WS_WV_T + (unsigned)u.pm * TSTEP; u.boff = (unsigned)WS_MEMN + (unsigned)u.pn * TSTEP; }
        return true; }
};
struct EpiP1 { static constexpr bool PERM = true;
    unsigned char* ws; const float* b_in;
    __device__ __forceinline__ void operator()(const f32x4 (&acc)[2][2][4][2], const Unit& u, int wr, int wc, int fr, int fq) const {
        const int row0 = u.pm * 256 + wr * 64 + fr;
        if (u.z == 0) {
            if (u.pn < 4) {
                const int ch = 128 * u.pn + wc * 32 + 8 * fq;
                f32x4 bv[2], bg[2];
#pragma unroll
                for (int n = 0; n < 2; ++n) { bv[n] = *(const f32x4*)(b_in + ch + 4 * n); bg[n] = *(const f32x4*)(b_in + 512 + ch + 4 * n); }
                bf16* U = (bf16*)(ws + WS_U);
#pragma unroll
                for (int ai = 0; ai < 2; ++ai)
#pragma unroll
                    for (int m = 0; m < 4; ++m) { f32x4 o[2];
#pragma unroll
                        for (int n = 0; n < 2; ++n) { const f32x4 a = acc[ai][0][m][n] + bv[n], g = acc[ai][1][m][n] + bg[n];
#pragma unroll
                            for (int j = 0; j < 4; ++j) o[n][j] = a[j] * sigmoidf_fast(g[j]); }
                        u32x4 w; w.x = pg8::cvt_pk_bf16(o[0][0], o[0][1]); w.y = pg8::cvt_pk_bf16(o[0][2], o[0][3]); w.z = pg8::cvt_pk_bf16(o[1][0], o[1][1]); w.w = pg8::cvt_pk_bf16(o[1][2], o[1][3]);
                        *(u32x4*)(U + (size_t)(row0 + ai * 128 + m * 16) * 512 + ch) = w; }
            } else {
                const int t = u.pn - 4, which = t >> 1, cb = (t & 1) * 256;
                bf16* dst = (bf16*)(ws + (which == 0 ? WS_Q : WS_K));
                pg8::store_tile_bf16(acc, dst + (size_t)row0 * 512 + cb, 512, b_in + 1024 + 256 * t, which == 0 ? SB_QSCALE : 1.0f, wc, fq);
            }
        } else if (u.z == 3) {
            const float* rb = b_in + 2048 + row0; bf16* p0 = (bf16*)(ws + WS_V) + (size_t)row0 * M + 256 * u.pn; const int cl = wc * 32 + 8 * fq;
#pragma unroll
            for (int ai = 0; ai < 2; ++ai)
#pragma unroll
                for (int m = 0; m < 4; ++m) { const float bv = rb[ai * 128 + m * 16]; bf16* rowp = p0 + (size_t)(ai * 128 + m * 16) * M + cl;
#pragma unroll
                    for (int bj = 0; bj < 2; ++bj) { const f32x4 v0 = acc[ai][bj][m][0] + bv, v1 = acc[ai][bj][m][1] + bv;
                        u32x4 w; w.x = pg8::cvt_pk_bf16(v0[0], v0[1]); w.y = pg8::cvt_pk_bf16(v0[2], v0[3]); w.z = pg8::cvt_pk_bf16(v1[0], v1[1]); w.w = pg8::cvt_pk_bf16(v1[2], v1[3]);
                        *(u32x4*)(rowp + bj * 128) = w; } }
        } else if (u.z == 1) pg8::store_tile_bf16(acc, (bf16*)(ws + WS_KM) + (size_t)row0 * 1024 + 256 * u.pn, 1024, nullptr, 1.0f, wc, fq);
        else pg8::store_tile_bf16(acc, (bf16*)(ws + WS_VMT) + (size_t)row0 * 2048 + 256 * u.pn, 2048, nullptr, 1.0f, wc, fq);
    }
};

struct SchedPlain { int G, c, nM, nN; unsigned abase, bbase, atile, btile, acol, bcol, bgrp;
    __device__ __forceinline__ bool next(int i, Unit& u) const {
        const int L = i * G + c; if (L >= nM * nN) return false;
        pg8::tile_order(L, nM, nN, u.pm, u.pn); u.z = 0; u.nvalid = 256; u.goff = 0;
        u.aoff = abase + (unsigned)u.pm * atile + (unsigned)u.pn * acol; u.boff = bbase + (unsigned)u.pn * btile + (unsigned)(u.pm >> 4) * bgrp + (unsigned)u.pn * bcol; return true; }
};
struct EpiBf16 { static constexpr bool PERM = true;
    bf16* O; int ldc; float scale; const float* bias;
    __device__ __forceinline__ void operator()(const f32x4 (&acc)[2][2][4][2], const Unit& u, int wr, int wc, int fr, int fq) const {
        pg8::store_tile_bf16(acc, O + (size_t)(u.pm * 256 + wr * 64 + fr) * ldc + 256 * u.pn, (size_t)ldc, bias ? bias + 256 * u.pn : nullptr, scale, wc, fq); }
};
struct SchedMoe { int G, c, nN; const LAS int* tb; unsigned abase, wbase, wexp;
    bool gather;
    __device__ __forceinline__ bool next(int i, Unit& u) const {
        const int nblk = __builtin_amdgcn_readfirstlane(tb[32]); const int L = i * G + c; if (L >= nblk * nN) return false;
        pg8::tile_order(L, nblk, nN, u.pm, u.pn);
        const int e = __builtin_amdgcn_readfirstlane(tb[128 + u.pm]);
        const int j = u.pm - tb[e], rem = tb[64 + e] - 256 * j;
        u.z = e; u.nvalid = rem < 256 ? rem : 256; u.goff = (unsigned)(e * LCAP + 256 * j);
        u.aoff = gather ? abase : abase + (unsigned)u.pm * (TSTEP / 2);
        u.boff = wbase + (unsigned)e * wexp + (unsigned)u.pn * (TSTEP / 2); return true; }
};
struct EpiAct { static constexpr bool PERM = true;
    unsigned char* ACT; const float* b_gu;
    __device__ __forceinline__ void operator()(const f32x4 (&acc)[2][2][4][2], const Unit& u, int wr, int wc, int fr, int fq) const {
        const int row0 = u.pm * 256 + wr * 64 + fr, ch = 128 * u.pn + wc * 32 + 8 * fq;
        const float* bb = b_gu + (size_t)u.z * 2 * DFF;
        f32x4 bg[2], bu[2];
#pragma unroll
        for (int n = 0; n < 2; ++n) { bg[n] = *(const f32x4*)(bb + ch + 4 * n); bu[n] = *(const f32x4*)(bb + DFF + ch + 4 * n); }
#pragma unroll
        for (int ai = 0; ai < 2; ++ai)
#pragma unroll
            for (int m = 0; m < 4; ++m) { f32x4 o[2];
#pragma unroll
                for (int n = 0; n < 2; ++n) { const f32x4 g = acc[ai][0][m][n] * (1.0f / WGU_SC) + bg[n], uu = acc[ai][1][m][n] * (1.0f / WGU_SC) + bu[n];
#pragma unroll
                    for (int j = 0; j < 4; ++j) { const float g_ = fminf(g[j], 7.0f), u_ = fminf(fmaxf(uu[j], -7.0f), 7.0f); o[n][j] = (u_ + 1.0f) * g_ * sigmoidf_fast(1.702f * g_); } }
                *(u32x2*)(ACT + (size_t)(row0 + ai * 128 + m * 16) * DFF + ch) = (u32x2){pk4_fp8(o[0][0], o[0][1], o[0][2], o[0][3]), pk4_fp8(o[1][0], o[1][1], o[1][2], o[1][3])}; }
    }
};
struct EpiDown { static constexpr bool PERM = true;
    bf16* YS; const float* b_down; const float* lgate;
    __device__ __forceinline__ void operator()(const f32x4 (&acc)[2][2][4][2], const Unit& u, int wr, int wc, int fr, int fq) const {
        const int r0 = wr * 64 + fr, cl = wc * 32 + 8 * fq;
        const float* bb = b_down + (size_t)u.z * D + 256 * u.pn + cl;
        f32x4 bv[2][2];
#pragma unroll
        for (int bj = 0; bj < 2; ++bj)
#pragma unroll
            for (int n = 0; n < 2; ++n) bv[bj][n] = *(const f32x4*)(bb + bj * 128 + 4 * n);
        float gts[2][4];
#pragma unroll
        for (int ai = 0; ai < 2; ++ai)
#pragma unroll
            for (int m = 0; m < 4; ++m) { const int r = r0 + ai * 128 + m * 16; gts[ai][m] = lgate[u.goff + (r < u.nvalid ? r : u.nvalid - 1)]; }
#pragma unroll
        for (int ai = 0; ai < 2; ++ai)
#pragma unroll
            for (int m = 0; m < 4; ++m) { const int r = r0 + ai * 128 + m * 16; const float gt = (r < u.nvalid) ? gts[ai][m] : 0.f;
                bf16* rowp = YS + (size_t)(u.pm * 256 + r) * D + 256 * u.pn + cl;
#pragma unroll
                for (int bj = 0; bj < 2; ++bj) { const f32x4 v0 = (acc[ai][bj][m][0] * (1.0f / WDN_SC) + bv[bj][0]) * gt, v1 = (acc[ai][bj][m][1] * (1.0f / WDN_SC) + bv[bj][1]) * gt;
                    u32x4 w; w.x = pg8::cvt_pk_bf16(v0[0], v0[1]); w.y = pg8::cvt_pk_bf16(v0[2], v0[3]); w.z = pg8::cvt_pk_bf16(v1[0], v1[1]); w.w = pg8::cvt_pk_bf16(v1[2], v1[3]);
                    *(u32x4*)(rowp + bj * 128) = w; } }
    }
};
__device__ __forceinline__ void moe_table(Frame& F, LAS int* tb) {
    if (F.tid < 32) { int c = (int)__hip_atomic_load(F.ctl + CW_ECNT + 64 * F.tid, RLX_AGENT); if (c > LCAP) c = LCAP; tb[64 + F.tid] = c; }
    LDS_WAIT(); __syncthreads();
    if (F.tid == 0) { int s = 0; for (int e = 0; e < NE; ++e) { tb[e] = s; s += (tb[64 + e] + 255) >> 8; } tb[32] = s; }
    LDS_WAIT(); __syncthreads();
    for (int b = F.tid; b < NBLK_MAX; b += NWAVES * 64) { int e = 0; while (e < NE - 1 && tb[e + 1] <= b) ++e; tb[128 + b] = e; }
    LDS_WAIT(); __syncthreads();
}

__device__ __forceinline__ void conv_phase(Frame& F) {
    LAS unsigned* ut = (LAS unsigned*)(F.lds + RING_OFF);
    LAS float* co = (LAS float*)(F.lds + RING_OFF + 65536);
    const int cp = F.tid & 255, half = F.tid >> 8;
    float w0[CWID], w1[CWID];
    { const float* wd = F.in[I_W_DW] + 2 * cp;
#pragma unroll
        for (int j = 0; j < CWID; ++j) { const f32x2 w = *(const GAS f32x2*)(wd + j * CONV_CH); w0[j] = w.x; w1[j] = w.y; } }
    const f32x2 bd = *(const GAS f32x2*)(F.in[I_B_DW] + 2 * cp);
    const f32x4 g0 = *(const GAS f32x4*)(F.in[I_LN_CONV_G] + 8 * F.lane), g1 = *(const GAS f32x4*)(F.in[I_LN_CONV_G] + 8 * F.lane + 4);
    const f32x4 b0 = *(const GAS f32x4*)(F.in[I_LN_CONV_B] + 8 * F.lane), b1 = *(const GAS f32x4*)(F.in[I_LN_CONV_B] + 8 * F.lane + 4);
    bf16* MX = (bf16*)(F.ws + WS_MIXIN);
    for (int it = F.vcu; it < NB * (T_ / 32); it += F.G) {
        const int b = it / (T_ / 32), t0 = (it % (T_ / 32)) * 32;
        const bf16* U = (const bf16*)(F.ws + WS_U) + (size_t)b * T_ * CONV_CH;
        for (int idx = F.tid; idx < 62 * 64; idx += 512) { const int r = idx >> 6, c16 = idx & 63, t = t0 - 30 + r;
            u32x4 v = (u32x4){0u, 0u, 0u, 0u}; if (t >= 0) v = *(const GAS u32x4*)(U + (size_t)t * CONV_CH + c16 * 8);
            *(LAS u32x4*)(ut + r * 256 + c16 * 4) = v; }
        LDS_WAIT(); __syncthreads();
        { float a0[16], a1[16];
#pragma unroll
            for (int tt = 0; tt < 16; ++tt) { a0[tt] = bd.x; a1[tt] = bd.y; }
#pragma unroll
            for (int r = 0; r < 46; ++r) { const unsigned uu = ut[(half * 16 + r) * 256 + cp]; const float u0 = bflo(uu), u1 = bfhi(uu);
#pragma unroll
                for (int tt = 0; tt < 16; ++tt) { const int j = r - tt; if (j >= 0 && j < CWID) { a0[tt] += w0[j] * u0; a1[tt] += w1[j] * u1; } } }
#pragma unroll
            for (int tt = 0; tt < 16; ++tt) *(LAS f32x2*)(co + (half * 16 + tt) * CONV_CH + 2 * cp) = (f32x2){a0[tt], a1[tt]};
        }
        LDS_WAIT(); __syncthreads();
#pragma unroll
        for (int q = 0; q < 4; ++q) { const int tt = 4 * F.wave + q;
            f32x4 x0 = *(const LAS f32x4*)(co + tt * CONV_CH + 8 * F.lane), x1 = *(const LAS f32x4*)(co + tt * CONV_CH + 8 * F.lane + 4);
            const float mean = wave_sum((x0.x + x0.y) + (x0.z + x0.w) + (x1.x + x1.y) + (x1.z + x1.w)) * (1.f / CONV_CH);
            x0 = x0 - mean; x1 = x1 - mean;
            const float var = wave_sum((x0.x * x0.x + x0.y * x0.y) + (x0.z * x0.z + x0.w * x0.w) + (x1.x * x1.x + x1.y * x1.y) + (x1.z * x1.z + x1.w * x1.w)) * (1.f / CONV_CH);
            const float rstd = 1.f / sqrtf(var + LN_EPS);
            x0 = x0 * rstd * g0 + b0; x1 = x1 * rstd * g1 + b1;
            float y[8] = {x0.x, x0.y, x0.z, x0.w, x1.x, x1.y, x1.z, x1.w};
#pragma unroll
            for (int j = 0; j < 8; ++j) y[j] = y[j] * sigmoidf_fast(y[j]);
            *(GAS u32x4*)(MX + (size_t)(b * T_ + t0 + tt) * D + 8 * F.lane) = (u32x4){pk2(y[0], y[1]), pk2(y[2], y[3]), pk2(y[4], y[5]), pk2(y[6], y[7])}; }
        __syncthreads();
    }
}

typedef float f32x16 __attribute__((ext_vector_type(16)));
__device__ __forceinline__ int crow(int r, int hi) { return (r & 3) + 8 * (r >> 2) + 4 * hi; }
__device__ __forceinline__ bf16x8 pack8(const float* v) {
    u32x4 w; w.x = pg8::cvt_pk_bf16(v[0], v[1]); w.y = pg8::cvt_pk_bf16(v[2], v[3]); w.z = pg8::cvt_pk_bf16(v[4], v[5]); w.w = pg8::cvt_pk_bf16(v[6], v[7]);
    return __builtin_bit_cast(bf16x8, w); }
constexpr float SB_EXIT = 150.0f;
struct SbStage { u32x4 k[4], v[4]; };
__device__ __forceinline__ void sb_gload(SbStage& g, const bf16* Kt, const bf16* Vt, int lane) {
#pragma unroll
    for (int i = 0; i < 4; ++i) { const int c = (lane & 7) ^ ((4 * i + (lane >> 4)) & 7); g.k[i] = *(const GAS u32x4*)(Kt + (size_t)(8 * i) * SBW + 8 * c); }
#pragma unroll
    for (int i = 0; i < 4; ++i) g.v[i] = *(const GAS u32x4*)(Vt + (size_t)(16 * i) * M);
}
__device__ __forceinline__ void sb_lwrite(const SbStage& g, LAS unsigned char* buf, int lane) {
#pragma unroll
    for (int i = 0; i < 4; ++i) *(LAS u32x4*)(buf + 1024 * i + 16 * lane) = g.k[i];
#pragma unroll
    for (int i = 0; i < 4; ++i) *(LAS u32x4*)(buf + 4096 + 1024 * i + 16 * lane) = g.v[i];
}
__device__ __forceinline__ void sb_attn_wave(Frame& F, int b, int h, int qt) {
    const int c = F.lane & 31, hi = F.lane >> 5;
    const bf16* Q = (const bf16*)(F.ws + WS_Q); const bf16* Kb = (const bf16*)(F.ws + WS_K); const bf16* VT = (const bf16*)(F.ws + WS_V);
    LAS unsigned char* wbuf = F.lds + RING_OFF + F.wave * 16384;
    bf16x8 tri[2];
#pragma unroll
    for (int s = 0; s < 2; ++s) { bf16x8 t;
#pragma unroll
        for (int j = 0; j < 8; ++j) { const int k = 16 * s + 8 * (j >> 2) + 4 * hi + (j & 3); t[j] = (k >= c) ? (short)0xBF80 : (short)0; }
        tri[s] = t; }
    bf16x8 qf[4];
    { const bf16* qp = Q + ((size_t)b * T_ + 32 * qt + c) * SBW + h * SBD + 8 * hi;
#pragma unroll
        for (int s = 0; s < 4; ++s) qf[s] = *(const GAS bf16x8*)(qp + 16 * s); }
    const bf16* Ksrc = Kb + ((size_t)b * T_ + (F.lane >> 3)) * SBW + h * SBD;
    const bf16* Vsrc = VT + (size_t)(h * SBD + (F.lane >> 2)) * M + (size_t)b * T_ + 8 * ((F.lane & 3) ^ ((F.lane >> 4) & 3));

    const int ksw = (c >> 1) & 7, vsw = (c >> 2) & 3;

    f32x16 o0, o1;
#pragma unroll
    for (int r = 0; r < 16; ++r) { o0[r] = 0.f; o1[r] = 0.f; }
    float carry = 0.f;
    SbStage st;
    sb_gload(st, Ksrc + (size_t)(32 * qt) * SBW, Vsrc + 32 * qt, F.lane); sb_lwrite(st, wbuf, F.lane);
    for (int kt = qt; kt >= 0; --kt) {
        LAS unsigned char* buf = wbuf + ((qt - kt) & 1) * 8192;
        if (kt > 0) sb_gload(st, Ksrc + (size_t)(32 * (kt - 1)) * SBW, Vsrc + 32 * (kt - 1), F.lane);
        const bool diag = (kt == qt);
        bf16x8 kf[4];
#pragma unroll
        for (int s = 0; s < 4; ++s) kf[s] = *(const LAS bf16x8*)(buf + c * 128 + 16 * ((2 * s + hi) ^ ksw));
        f32x16 p;
#pragma unroll
        for (int r = 0; r < 16; ++r) p[r] = 0.f;
#pragma unroll
        for (int s = 0; s < 4; ++s) p = __builtin_amdgcn_mfma_f32_32x32x16_bf16(kf[s], qf[s], p, 0, 0, 0);
        u32x2 vv[2][2][2];
#pragma unroll
        for (int dt = 0; dt < 2; ++dt)
#pragma unroll
            for (int s = 0; s < 2; ++s)
#pragma unroll
                for (int q = 0; q < 2; ++q) vv[dt][s][q] = *(const LAS u32x2*)(buf + 4096 + (32 * dt + c) * 64 + 16 * ((2 * s + q) ^ vsw) + 8 * hi);
        float L[16];
#pragma unroll
        for (int r = 0; r < 16; ++r) { const float y = p[r]; float l = __builtin_amdgcn_logf(1.0f + __builtin_amdgcn_exp2f(y)); l = (y > 64.f) ? y : l;
            if (diag) l = (crow(r, hi) >= c) ? 0.f : l; L[r] = l; }
        const bf16x8 l0 = pack8(L), l1 = pack8(L + 8);
        f32x16 a;
#pragma unroll
        for (int r = 0; r < 16; ++r) a[r] = p[r] - carry;
        a = __builtin_amdgcn_mfma_f32_32x32x16_bf16(tri[0], l0, a, 0, 0, 0); a = __builtin_amdgcn_mfma_f32_32x32x16_bf16(tri[1], l1, a, 0, 0, 0);
        const float tot = p[0] - a[0];
        float w[16];
#pragma unroll
        for (int r = 0; r < 16; ++r) { float x = __builtin_amdgcn_exp2f(a[r]); if (diag) x = (crow(r, hi) >= c) ? 0.f : x; w[r] = x; }
        const bf16x8 p0 = pack8(w), p1 = pack8(w + 8);
        { const bf16x8 v00 = __builtin_bit_cast(bf16x8, (u32x4){vv[0][0][0].x, vv[0][0][0].y, vv[0][0][1].x, vv[0][0][1].y});
          const bf16x8 v01 = __builtin_bit_cast(bf16x8, (u32x4){vv[0][1][0].x, vv[0][1][0].y, vv[0][1][1].x, vv[0][1][1].y});
          const bf16x8 v10 = __builtin_bit_cast(bf16x8, (u32x4){vv[1][0][0].x, vv[1][0][0].y, vv[1][0][1].x, vv[1][0][1].y});
          const bf16x8 v11 = __builtin_bit_cast(bf16x8, (u32x4){vv[1][1][0].x, vv[1][1][0].y, vv[1][1][1].x, vv[1][1][1].y});
          o0 = __builtin_amdgcn_mfma_f32_32x32x16_bf16(v00, p0, o0, 0, 0, 0); o0 = __builtin_amdgcn_mfma_f32_32x32x16_bf16(v01, p1, o0, 0, 0, 0);
          o1 = __builtin_amdgcn_mfma_f32_32x32x16_bf16(v10, p0, o1, 0, 0, 0); o1 = __builtin_amdgcn_mfma_f32_32x32x16_bf16(v11, p1, o1, 0, 0, 0); }
        carry = __shfl(tot, c);
        if (__all(carry >= SB_EXIT)) break;
        if (kt > 0) sb_lwrite(st, wbuf + ((qt - kt + 1) & 1) * 8192, F.lane);
    }
    bf16* op = (bf16*)(F.ws + WS_MIXIN) + ((size_t)b * T_ + 32 * qt + c) * D + CONV_CH + h * SBD + 4 * hi;
#pragma unroll
    for (int g = 0; g < 4; ++g) {
        *(GAS u32x2*)(op + 8 * g) = (u32x2){pg8::cvt_pk_bf16(o0[4 * g], o0[4 * g + 1]), pg8::cvt_pk_bf16(o0[4 * g + 2], o0[4 * g + 3])};
        *(GAS u32x2*)(op + 32 + 8 * g) = (u32x2){pg8::cvt_pk_bf16(o1[4 * g], o1[4 * g + 1]), pg8::cvt_pk_bf16(o1[4 * g + 2], o1[4 * g + 3])}; }
}

__device__ __forceinline__ void resid_row(f32x4 (&v)[4], const bf16* hrow, const bf16* mrow, int lane) {
    f32x4 a[4]; load_row_bf16(v, hrow, lane); load_row_bf16(a, mrow, lane);
#pragma unroll
    for (int j = 0; j < 4; ++j) v[j] = v[j] * DN_ALPHA + a[j];
}
__device__ __forceinline__ void ln_phase(Frame& F, const float* g, const float* b) {
    const int gw = F.vcu * NWAVES + F.wave, NGW = F.G * NWAVES;
    for (int m = gw; m < M; m += NGW) { f32x4 v[4]; bf16* hrow = (bf16*)(F.ws + WS_HB) + (size_t)m * D; resid_row(v, hrow, (const bf16*)(F.ws + WS_QM) + (size_t)m * D, F.lane);
        ln_row(v, g, b, F.lane); store_row_bf16(v, hrow, F.lane); }
}
__device__ __forceinline__ void softmax_phase(Frame& F) {
    const int gw = F.vcu * NWAVES + F.wave, NGW = F.G * NWAVES;
    for (int m = gw; m < M; m += NGW) { GAS u32x2* p = (GAS u32x2*)((bf16*)(F.ws + WS_SP) + (size_t)m * D) + F.lane;
#pragma unroll
        for (int j = 0; j < 4; ++j) { const u32x2 w = p[64 * j]; float x0 = bflo(w.x), x1 = bfhi(w.x), x2 = bflo(w.y), x3 = bfhi(w.y);
            const float mx = wave_max(fmaxf(fmaxf(x0, x1), fmaxf(x2, x3)));
            x0 = __builtin_amdgcn_exp2f(x0 - mx); x1 = __builtin_amdgcn_exp2f(x1 - mx); x2 = __builtin_amdgcn_exp2f(x2 - mx); x3 = __builtin_amdgcn_exp2f(x3 - mx);
            const float inv = 1.0f / wave_sum((x0 + x1) + (x2 + x3));
            p[64 * j] = (u32x2){pk2(x0 * inv, x1 * inv), pk2(x2 * inv, x3 * inv)}; } }
}
__device__ __forceinline__ void xattn_phase(Frame& F) {
    LAS unsigned char* tb0 = F.lds + RING_OFF;
    const bf16* QM = (const bf16*)(F.ws + WS_QM); const bf16* KM = (const bf16*)(F.ws + WS_KM); const bf16* VMT = (const bf16*)(F.ws + WS_VMT); bf16* OB = (bf16*)(F.ws + WS_OB);
    const int c = F.lane & 31, h5 = F.lane >> 5;
    const int tr = F.tid >> 5, tc = F.tid & 31;
    const int kr = F.tid >> 4, kc = F.tid & 15;
    for (int u = F.vcu; u < NB * 4 * 16; u += F.G) {
        const int b = u >> 6, h = (u >> 4) & 3, qt = u & 15;
        const size_t rowq = (size_t)b * T_ + 256 * qt + 32 * F.wave + c;
        const bf16* qp = QM + rowq * D + h * 256 + 8 * h5;
        const bf16* ksrc = KM + ((size_t)b * NMEM + kr) * D + h * 256 + 8 * kc;
        const int kw0 = kr * 256 + ((kc ^ kr) & 15) * 16, kw1 = (kr + 32) * 256 + ((kc ^ (kr + 32)) & 15) * 16;
        const bf16* vsrc = VMT + ((size_t)h * 256 + tr) * (size_t)MM + (size_t)b * NMEM + 8 * tc;
        int vw[4];
#pragma unroll
        for (int j = 0; j < 4; ++j) vw[j] = (tr + 16 * j) * 512 + ((tc ^ (tr + 16 * j)) & 31) * 16;
        u32x4 st[4];
        __syncthreads();
        st[0] = *(const GAS u32x4*)ksrc; st[1] = *(const GAS u32x4*)(ksrc + (size_t)32 * D);
        *(LAS u32x4*)(tb0 + kw0) = st[0]; *(LAS u32x4*)(tb0 + kw1) = st[1];
        LDS_WAIT(); __syncthreads();
        f32x16 sacc[8];
#pragma unroll
        for (int dh = 0; dh < 2; ++dh) {
            bf16x8 qf[8];
#pragma unroll
            for (int s_ = 0; s_ < 8; ++s_) qf[s_] = *(const GAS bf16x8*)(qp + 128 * dh + 16 * s_);
#pragma unroll
            for (int kp = 0; kp < 4; ++kp) { const int i = dh * 4 + kp;
                LAS unsigned char* buf = tb0 + (i & 1) * 32768; LAS unsigned char* nbuf = tb0 + ((i + 1) & 1) * 32768;
                if (i < 7) { const bf16* p = ksrc + (size_t)(64 * ((i + 1) & 3)) * D + 128 * ((i + 1) >> 2); st[0] = *(const GAS u32x4*)p; st[1] = *(const GAS u32x4*)(p + (size_t)32 * D); }
                else {
#pragma unroll
                    for (int j = 0; j < 4; ++j) st[j] = *(const GAS u32x4*)(vsrc + (size_t)(16 * j) * MM); }
#pragma unroll
                for (int k2 = 0; k2 < 2; ++k2) { const int kt = 2 * kp + k2;
                    f32x16 a;
                    if (dh == 0) {
#pragma unroll
                        for (int r = 0; r < 16; ++r) a[r] = 0.f; }
                    else a = sacc[kt];
#pragma unroll
                    for (int s_ = 0; s_ < 8; ++s_) { const bf16x8 kf = *(const LAS bf16x8*)(buf + (32 * k2 + c) * 256 + (((2 * s_ + h5) ^ c) & 15) * 16); a = __builtin_amdgcn_mfma_f32_32x32x16_bf16(kf, qf[s_], a, 0, 0, 0); }
                    sacc[kt] = a; }
                if (i < 7) { *(LAS u32x4*)(nbuf + kw0) = st[0]; *(LAS u32x4*)(nbuf + kw1) = st[1]; }
                else {
#pragma unroll
                    for (int j = 0; j < 4; ++j) *(LAS u32x4*)(nbuf + vw[j]) = st[j]; }
                LDS_WAIT(); __syncthreads();
            }
        }
        float mx = sacc[0][0];
#pragma unroll
        for (int kt = 0; kt < 8; ++kt)
#pragma unroll
            for (int r = 0; r < 16; ++r) mx = fmaxf(mx, sacc[kt][r]);
        mx = fmaxf(mx, __shfl_xor(mx, 32));
        float sum = 0.f; bf16x8 pb[8][2];
#pragma unroll
        for (int kt = 0; kt < 8; ++kt) { float p[16];
#pragma unroll
            for (int r = 0; r < 16; ++r) { p[r] = __builtin_amdgcn_exp2f(sacc[kt][r] - mx); sum += p[r]; }
            pb[kt][0] = pack8(p); pb[kt][1] = pack8(p + 8); }
        sum += __shfl_xor(sum, 32);
        const float inv = 1.0f / sum;
        bf16* op = OB + rowq * D + h * 256 + 4 * h5;
        for (int dp = 0; dp < 4; ++dp) {
            LAS unsigned char* buf = tb0 + (dp & 1) * 32768; LAS unsigned char* nbuf = tb0 + ((dp + 1) & 1) * 32768;
            if (dp < 3) {
#pragma unroll
                for (int j = 0; j < 4; ++j) st[j] = *(const GAS u32x4*)(vsrc + (size_t)(64 * (dp + 1) + 16 * j) * MM); }
#pragma unroll
            for (int d2 = 0; d2 < 2; ++d2) { const int dt = 2 * dp + d2;
                f32x16 o;
#pragma unroll
                for (int r = 0; r < 16; ++r) o[r] = 0.f;
#pragma unroll
                for (int kt = 0; kt < 8; ++kt)
#pragma unroll
                    for (int s2 = 0; s2 < 2; ++s2) { const LAS unsigned char* rp = buf + (32 * d2 + c) * 512 + 8 * h5;
                        const u32x2 v0 = *(const LAS u32x2*)(rp + (((4 * kt + 2 * s2) ^ c) & 31) * 16), v1 = *(const LAS u32x2*)(rp + (((4 * kt + 2 * s2 + 1) ^ c) & 31) * 16);
                        o = __builtin_amdgcn_mfma_f32_32x32x16_bf16(__builtin_bit_cast(bf16x8, (u32x4){v0.x, v0.y, v1.x, v1.y}), pb[kt][s2], o, 0, 0, 0); }
#pragma unroll
                for (int g = 0; g < 4; ++g) *(GAS u32x2*)(op + 32 * dt + 8 * g) = (u32x2){pg8::cvt_pk_bf16(o[4 * g] * inv, o[4 * g + 1] * inv), pg8::cvt_pk_bf16(o[4 * g + 2] * inv, o[4 * g + 3] * inv)}; }
            if (dp < 3) {
#pragma unroll
                for (int j = 0; j < 4; ++j) *(LAS u32x4*)(nbuf + vw[j]) = st[j]; }
            LDS_WAIT(); __syncthreads();
        }
    }
}
typedef float f32x4v __attribute__((ext_vector_type(4)));
__device__ __forceinline__ void ln2_router_phase(Frame& F) {
    LAS bf16* wr = (LAS bf16*)(F.lds + P10_WR);
    LAS float* gb = (LAS float*)(F.lds + P10_GB);
    LAS int* lcnt = (LAS int*)(F.lds + P10_LCNT);
    LAS int* rec = (LAS int*)(F.lds + P10_REC);
    for (int i = F.tid; i < 2 * 32 * WR_STRIDE * 2 / 16; i += 512) *(LAS u32x4*)(F.lds + P10_WR + 16 * i) = *(const GAS u32x4*)(F.ws + WS_WR + 16 * i);
    for (int i = F.tid; i < 512; i += 512) { *(LAS f32x4*)(gb + 4 * i) = ((const GAS f32x4*)(i < 256 ? F.in[I_LN2_G] : F.in[I_LN2_B]))[i & 255]; }
    if (F.tid < 64) lcnt[F.tid] = 0;
    LDS_WAIT(); __syncthreads();
    const bf16* H1 = (const bf16*)(F.ws + WS_HB); const bf16* CA = (const bf16*)(F.ws + WS_QM); bf16* H2 = (bf16*)(F.ws + WS_HB2);
    int* ltok = (int*)(F.ws + WS_LTOK); float* lgate = (float*)(F.ws + WS_LGATE); int* sidx = (int*)(F.ws + WS_SIDX);
    const int fr = F.lane & 15, fq = F.lane >> 4;
    for (int rb = F.vcu; rb < M / 128; rb += F.G) {
        const int m0 = rb * 128 + F.wave * 16;
        float mymean = 0.f, myrstd = 0.f;
        for (int i = 0; i < 16; ++i) { const int m = m0 + i;
            f32x4 v[4]; resid_row(v, H1 + (size_t)m * D, CA + (size_t)m * D, F.lane);
            float s1 = 0.f;
#pragma unroll
            for (int j = 0; j < 4; ++j) s1 += (v[j].x + v[j].y) + (v[j].z + v[j].w);
            const float mean = wave_sum(s1) * (1.f / D); float s2 = 0.f;
#pragma unroll
            for (int j = 0; j < 4; ++j) { v[j] = v[j] - mean; s2 += (v[j].x * v[j].x + v[j].y * v[j].y) + (v[j].z * v[j].z + v[j].w * v[j].w); }
            const float rstd = 1.f / sqrtf(wave_sum(s2) * (1.f / D) + LN_EPS);
            if (fr == i) { mymean = mean; myrstd = rstd; }
#pragma unroll
            for (int j = 0; j < 4; ++j) { const f32x4 gg = *(const LAS f32x4*)(gb + 4 * F.lane + 256 * j), bb = *(const LAS f32x4*)(gb + 1024 + 4 * F.lane + 256 * j); v[j] = v[j] * rstd * gg + bb; }
            store_row_bf16(v, H2 + (size_t)m * D, F.lane);
            { GAS unsigned* h8 = (GAS unsigned*)(F.ws + WS_HB8 + (size_t)m * D) + F.lane;
#pragma unroll
                for (int j = 0; j < 4; ++j) h8[64 * j] = pk4_fp8(v[j].x, v[j].y, v[j].z, v[j].w); }
        }
        f32x4v acc0 = {0.f, 0.f, 0.f, 0.f}, acc1 = {0.f, 0.f, 0.f, 0.f};
        { const bf16* hp = H1 + (size_t)(m0 + fr) * D + 8 * fq; const bf16* cp = CA + (size_t)(m0 + fr) * D + 8 * fq;
            const LAS bf16* wp = wr + fr * WR_STRIDE + 8 * fq; const LAS float* gp = gb + 8 * fq;
            const float sc = myrstd, sh = -mymean * myrstd;
#pragma unroll 2
            for (int s_ = 0; s_ < 32; ++s_) {
                const u32x4 hv = *(const GAS u32x4*)(hp + 32 * s_), cv = *(const GAS u32x4*)(cp + 32 * s_);
                const f32x4 g0 = *(const LAS f32x4*)(gp + 32 * s_), g1 = *(const LAS f32x4*)(gp + 32 * s_ + 4), b0 = *(const LAS f32x4*)(gp + 1024 + 32 * s_), b1 = *(const LAS f32x4*)(gp + 1024 + 32 * s_ + 4);
                float x[8];
                x[0] = bflo(hv.x) * DN_ALPHA + bflo(cv.x); x[1] = bfhi(hv.x) * DN_ALPHA + bfhi(cv.x); x[2] = bflo(hv.y) * DN_ALPHA + bflo(cv.y); x[3] = bfhi(hv.y) * DN_ALPHA + bfhi(cv.y);
                x[4] = bflo(hv.z) * DN_ALPHA + bflo(cv.z); x[5] = bfhi(hv.z) * DN_ALPHA + bfhi(cv.z); x[6] = bflo(hv.w) * DN_ALPHA + bflo(cv.w); x[7] = bfhi(hv.w) * DN_ALPHA + bfhi(cv.w);
                const float gg[8] = {g0.x, g0.y, g0.z, g0.w, g1.x, g1.y, g1.z, g1.w}, bb[8] = {b0.x, b0.y, b0.z, b0.w, b1.x, b1.y, b1.z, b1.w};
                float lo[8]; unsigned hp2[4];
#pragma unroll
                for (int j = 0; j < 8; ++j) x[j] = (x[j] * sc + sh) * gg[j] + bb[j];
#pragma unroll
                for (int j = 0; j < 4; ++j) { hp2[j] = pg8::cvt_pk_bf16(x[2 * j], x[2 * j + 1]); lo[2 * j] = x[2 * j] - bflo(hp2[j]); lo[2 * j + 1] = x[2 * j + 1] - bfhi(hp2[j]); }
                const bf16x8 bhi = __builtin_bit_cast(bf16x8, (u32x4){hp2[0], hp2[1], hp2[2], hp2[3]});
                const bf16x8 blo = pack8(lo);
                const bf16x8 wh0 = *(const LAS bf16x8*)(wp + 32 * s_), wh1 = *(const LAS bf16x8*)(wp + 16 * WR_STRIDE + 32 * s_);
                const bf16x8 wl0 = *(const LAS bf16x8*)(wp + 32 * WR_STRIDE + 32 * s_), wl1 = *(const LAS bf16x8*)(wp + 48 * WR_STRIDE + 32 * s_);
                acc0 = __builtin_amdgcn_mfma_f32_16x16x32_bf16(wh0, bhi, acc0, 0, 0, 0); acc1 = __builtin_amdgcn_mfma_f32_16x16x32_bf16(wh1, bhi, acc1, 0, 0, 0);
                acc0 = __builtin_amdgcn_mfma_f32_16x16x32_bf16(wh0, blo, acc0, 0, 0, 0); acc1 = __builtin_amdgcn_mfma_f32_16x16x32_bf16(wh1, blo, acc1, 0, 0, 0);
                acc0 = __builtin_amdgcn_mfma_f32_16x16x32_bf16(wl0, bhi, acc0, 0, 0, 0); acc1 = __builtin_amdgcn_mfma_f32_16x16x32_bf16(wl1, bhi, acc1, 0, 0, 0);
            } }
        float cand[8]; int eid[8];
        { const f32x4 br0 = *(const GAS f32x4*)(F.in[I_B_ROUTER] + 4 * fq), br1 = *(const GAS f32x4*)(F.in[I_B_ROUTER] + 16 + 4 * fq);
#pragma unroll
            for (int r = 0; r < 4; ++r) { cand[r] = acc0[r] + br0[r]; cand[4 + r] = acc1[r] + br1[r]; eid[r] = 4 * fq + r; eid[4 + r] = 16 + 4 * fq + r; } }
        float tv[TOPK]; int te[TOPK];
#pragma unroll
        for (int k = 0; k < TOPK; ++k) {
            float bv = cand[0]; int bi = eid[0];
#pragma unroll
            for (int r = 1; r < 8; ++r) if (cand[r] > bv) { bv = cand[r]; bi = eid[r]; }
#pragma unroll
            for (int o = 16; o <= 32; o <<= 1) { const float ov = __shfl_xor(bv, o); const int oi = __shfl_xor(bi, o); if (ov > bv || (ov == bv && oi < bi)) { bv = ov; bi = oi; } }
            tv[k] = bv; te[k] = bi;
#pragma unroll
            for (int r = 0; r < 8; ++r) if (eid[r] == bi) cand[r] = -INFINITY;
        }
        float pe[TOPK], ps = 0.f;
#pragma unroll
        for (int k = 0; k < TOPK; ++k) { pe[k] = __expf(tv[k] - tv[0]); ps += pe[k]; }
        if (fq == 0) {
#pragma unroll
            for (int k = 0; k < TOPK; ++k) { const int lr = __hip_atomic_fetch_add(lcnt + te[k], 1, __ATOMIC_RELAXED, __HIP_MEMORY_SCOPE_WORKGROUP);
                LAS int* r = rec + ((F.wave * 16 + fr) * 4 + k) * 4; r[0] = te[k]; r[1] = lr; r[2] = __builtin_bit_cast(int, pe[k] / ps); r[3] = m0 + fr; } }
        LDS_WAIT(); __syncthreads();
        if (F.tid < NE) lcnt[32 + F.tid] = (int)__hip_atomic_fetch_add(F.ctl + CW_ECNT + 64 * F.tid, (unsigned)lcnt[F.tid], RLX_AGENT);
        LDS_WAIT(); __syncthreads();
        { const LAS int* r = rec + (F.wave * 64 + F.lane) * 4; const int e = r[0], pos = lcnt[32 + e] + r[1], tok = r[3];
            if (pos < LCAP) { ltok[e * LCAP + pos] = tok; lgate[e * LCAP + pos] = __builtin_bit_cast(float, r[2]); } sidx[tok * 4 + (F.lane & 3)] = e * LCAP + pos; }
        __syncthreads();
        if (F.tid < 64) lcnt[F.tid] = 0;
        LDS_WAIT(); __syncthreads();
    }
}
__device__ __forceinline__ void final_phase(Frame& F, const LAS int* tb) {
    const int gw = F.vcu * NWAVES + F.wave, NGW = F.G * NWAVES;
    const int* sidx = (const int*)(F.ws + WS_SIDX); const bf16* YS = (const bf16*)(F.ws + WS_YS);
    for (int m = gw; m < M; m += NGW) { f32x4 v[4]; load_row_bf16(v, (const bf16*)(F.ws + WS_HB2) + (size_t)m * D, F.lane);
#pragma unroll
        for (int j = 0; j < 4; ++j) v[j] = v[j] * DN_ALPHA;
        f32x4 s[4];
#pragma unroll
        for (int j = 0; j < 4; ++j) s[j] = (f32x4){0.f, 0.f, 0.f, 0.f};
#pragma unroll
        for (int k = 0; k < TOPK; ++k) { const int si = sidx[m * 4 + k], e = si / LCAP, pos = si - e * LCAP; const size_t slot = (size_t)tb[e] * 256 + pos;
            const GAS u32x2* yp = (const GAS u32x2*)(YS + slot * D) + F.lane;
#pragma unroll
            for (int j = 0; j < 4; ++j) { const u32x2 w = yp[64 * j]; s[j] = s[j] + (f32x4){bflo(w.x), bfhi(w.x), bflo(w.y), bfhi(w.y)}; } }
#pragma unroll
        for (int j = 0; j < 4; ++j) v[j] = v[j] + s[j];
        ln_row(v, F.in[I_LN3_G], F.in[I_LN3_B], F.lane); store_row_f32(v, F.hf + (size_t)m * D, F.lane); }
}

struct Args { const float* in[N_IN]; float* out; unsigned char* ws; int ph_lo, ph_hi, li, pad; };
__global__ void __launch_bounds__(NWAVES * 64, 2) mk_fwd(Args args) {
    extern __shared__ __attribute__((aligned(16))) unsigned char lds[];
    Frame F;
    F.lds = (LAS unsigned char*)lds; F.MISC = (volatile LAS unsigned*)(F.lds + MISC_OFF);
    F.tid = threadIdx.x; F.lane = F.tid & 63; F.wave = __builtin_amdgcn_readfirstlane(F.tid >> 6);
    F.G = gridDim.x; { const int bx = blockIdx.x; F.vcu = (F.G % 8 == 0) ? (bx % 8) * (F.G / 8) + bx / 8 : bx; }
    F.ws = args.ws; F.ctl = (gu32*)(args.ws + WS_CTL); F.hf = args.out; F.in = args.in;
    for (int u = F.tid; u < (LDS_BYTES - LDSCTL_OFF) / 4; u += NWAVES * 64) ((LAS unsigned*)(F.lds + LDSCTL_OFF))[u] = 0u;
    __syncthreads();
    XcdBarrier bar; bar.bar = (unsigned*)(F.ctl + CW_BAR) + args.li * XCD_BAR_WORDS; bar.x = 0; bar.st = nullptr;
    const int lo = args.ph_lo, hi = args.ph_hi;
    if (hi - lo > 1) bar = xcd_barrier_post((unsigned*)(F.ctl + CW_BAR) + args.li * XCD_BAR_WORDS, F.MISC + 8);
#ifndef PH_MASK
#define PH_MASK 0xfff
#endif
#define IN(k) (((PH_MASK >> (k)) & 1) && lo <= (k) && (k) < hi)
#ifndef REP_MASK
#define REP_MASK 0
#endif
#define REPS(k) (1 + ((REP_MASK >> (k)) & 1))
#define PH_BEGIN() do { int t_ = threadIdx.x; asm volatile("" : "+v"(t_)); F.tid = t_; F.lane = t_ & 63; } while (0)
#define SEAM(k) do { if (IN(k) && IN((k) + 1)) xcd_barrier(bar); } while (0)
    const char* wsb = (const char*)args.ws;
    LAS int* tb = (LAS int*)(F.lds + TB_OFF);

    if (IN(0)) for (int rep = 0; rep < REPS(0); ++rep) { PH_BEGIN(); p0_prologue(F); __syncthreads(); } SEAM(0);
    if (IN(1)) for (int rep = 0; rep < REPS(1); ++rep) { PH_BEGIN(); SchedP1 S{F.G, (int)blockIdx.x}; EpiP1 E{F.ws, F.in[I_B_IN]};
        pg8::gemm_phase<EpiP1, SchedP1, false>(F.lds + RING_OFF, wsb, D, D, D, S, E, nullptr); } SEAM(1);
    if (IN(2)) for (int rep = 0; rep < REPS(2); ++rep) { PH_BEGIN();
        conv_phase(F);
        const int gw = F.vcu * NWAVES + F.wave;
        for (int tk = gw; tk < NB * SBH * (T_ / 32); tk += F.G * NWAVES) sb_attn_wave(F, (tk >> 7) >> 3, (tk >> 7) & 7, tk & 127);
    } SEAM(2);
    if (IN(3)) { PH_BEGIN(); SchedPlain S{F.G, (int)blockIdx.x, 128, 4, (unsigned)WS_MIXIN, (unsigned)WS_WOUT_T, TSTEP, TSTEP, 0u, 0u, 0u}; EpiBf16 E{(bf16*)(F.ws + WS_QM), D, 1.0f, F.in[I_B_OUT]};
        pg8::gemm_phase<EpiBf16, SchedPlain, false>(F.lds + RING_OFF, wsb, D, D, D, S, E, nullptr); } SEAM(3);
    if (IN(4)) { PH_BEGIN(); ln_phase(F, F.in[I_LN1_G], F.in[I_LN1_B]); } SEAM(4);
    if (IN(5)) { PH_BEGIN(); SchedPlain S{F.G, (int)blockIdx.x, 128, 4, (unsigned)WS_HB, (unsigned)WS_WQ_T, TSTEP, TSTEP, 0u, 0u, 0u}; EpiBf16 E{(bf16*)(F.ws + WS_QM), D, MEM_QSCALE, nullptr};
        pg8::gemm_phase<EpiBf16, SchedPlain, false>(F.lds + RING_OFF, wsb, D, D, D, S, E, nullptr); } SEAM(5);
    if (IN(6)) { PH_BEGIN(); xattn_phase(F); } SEAM(6);
    if (IN(7)) { PH_BEGIN(); SchedPlain S{F.G, (int)blockIdx.x, 128, 4, (unsigned)WS_OB, (unsigned)WS_WO_T, TSTEP, TSTEP, 0u, 0u, 0u}; EpiBf16 E{(bf16*)(F.ws + WS_QM), D, 1.0f, nullptr};
        pg8::gemm_phase<EpiBf16, SchedPlain, false>(F.lds + RING_OFF, wsb, D, D, D, S, E, nullptr); } SEAM(7);
    if (IN(8)) { PH_BEGIN(); ln2_router_phase(F); } SEAM(8);
    if (IN(9)) for (int rep = 0; rep < REPS(9); ++rep) { PH_BEGIN(); moe_table(F, tb); SchedMoe S{F.G, (int)blockIdx.x, 8, tb, (unsigned)WS_HB8, (unsigned)WS_WGU_T, 2048u * 1024u, true}; EpiAct E{F.ws + WS_ACT, F.in[I_B_GU]};
        pg8::gemm_phase<EpiAct, SchedMoe, true, true>(F.lds + RING_OFF, wsb, D / 2, D / 2, D / 2, S, E, (const int*)(F.ws + WS_LTOK)); } SEAM(9);
    if (IN(10)) for (int rep = 0; rep < REPS(10); ++rep) { PH_BEGIN(); moe_table(F, tb); SchedMoe S{F.G, (int)blockIdx.x, 4, tb, (unsigned)WS_ACT, (unsigned)WS_WDN_T, 1024u * 1024u, false}; EpiDown E{(bf16*)(F.ws + WS_YS), F.in[I_B_DOWN], (const float*)(F.ws + WS_LGATE)};
        pg8::gemm_phase<EpiDown, SchedMoe, false, true>(F.lds + RING_OFF, wsb, D / 2, D / 2, D / 2, S, E, nullptr); } SEAM(10);
    if (IN(11)) { PH_BEGIN(); moe_table(F, tb); final_phase(F, tb); }
#undef IN
#undef SEAM
}

extern "C" void kernel_launch(void* const* d_in, const int* in_sizes, int n_in, void* d_out, int out_size, void* d_ws, size_t ws_size, hipStream_t stream) {
    static int grid = 0;
    if (grid == 0) {
        if (n_in != N_IN || out_size != M * D || ws_size < WS_END) { fprintf(stderr, "kernel_launch: unexpected shapes (n_in %d, out %d, ws %zu)\n", n_in, out_size, ws_size); grid = -1; return; }
        int dev = 0, cus = 0, per_cu = 0;
        if (hipGetDevice(&dev) != hipSuccess || hipDeviceGetAttribute(&cus, hipDeviceAttributeMultiprocessorCount, dev) != hipSuccess) { grid = -1; return; }
        if (hipFuncSetAttribute((const void*)mk_fwd, hipFuncAttributeMaxDynamicSharedMemorySize, LDS_BYTES) != hipSuccess) { fprintf(stderr, "kernel_launch: hipFuncSetAttribute failed\n"); grid = -1; return; }
        if (hipOccupancyMaxActiveBlocksPerMultiprocessor(&per_cu, (const void*)mk_fwd, NWAVES * 64, LDS_BYTES) != hipSuccess || per_cu < 1) fprintf(stderr, "kernel_launch: occupancy query says %d\n", per_cu);
        (void)hipGetLastError();
        grid = cus;
    }
    if (grid < 0) return;
    if (hipMemsetAsync((char*)d_ws + WS_CTL, 0, CTL_ZERO_BYTES, stream) != hipSuccess) return;
    Args a{};
    for (int i = 0; i < N_IN; ++i) a.in[i] = (const float*)d_in[i];
    a.out = (float*)d_out; a.ws = (unsigned char*)d_ws;
    for (int li = 0; li < MK_N_LAUNCHES; ++li) {
        a.ph_lo = (MK_N_LAUNCHES == 1) ? 0 : li; a.ph_hi = (MK_N_LAUNCHES == 1) ? NPHASE : li + 1; a.li = (MK_N_LAUNCHES == 1) ? 0 : li;
        hipLaunchKernelGGL(mk_fwd, dim3(grid), dim3(NWAVES * 64), LDS_BYTES, stream, a);
        if (hipPeekAtLastError() != hipSuccess) { fprintf(stderr, "kernel_launch: launch %d failed\n", li); break; }
    }
#ifdef PROBE_PHASES
    { const int pp[] = {PROBE_PHASES}; for (int ph : pp) { a.ph_lo = ph; a.ph_hi = ph + 1; a.li = 15; hipLaunchKernelGGL(mk_fwd, dim3(grid), dim3(NWAVES * 64), LDS_BYTES, stream, a); } }
#endif
}
```

```cpp
#include <hip/hip_runtime.h>
#include <cstdio>
#include <cstdint>

#ifndef MK_N_LAUNCHES
#define MK_N_LAUNCHES 1
#endif

#define GAS __attribute__((address_space(1)))
#define LAS __attribute__((address_space(3)))
typedef unsigned short bf16;
typedef short bf16x8 __attribute__((ext_vector_type(8)));
typedef float f32x4 __attribute__((ext_vector_type(4)));
typedef float f32x2 __attribute__((ext_vector_type(2)));
typedef unsigned u32x4 __attribute__((ext_vector_type(4)));
typedef unsigned u32x2 __attribute__((ext_vector_type(2)));
typedef GAS unsigned gu32;
#define RLX_AGENT __ATOMIC_RELAXED, __HIP_MEMORY_SCOPE_AGENT
#define LDS_WAIT() asm volatile("s_waitcnt lgkmcnt(0)" ::: "memory")
#define VM_WAIT() asm volatile("s_waitcnt vmcnt(0)" ::: "memory")

constexpr int NB = 8, T_ = 4096, D = 1024, M = NB * T_, NMEM = 256, MM = NB * NMEM;
constexpr int CONV_CH = 512, SBH = 8, SBD = 64, SBW = 512, CWID = 31, NE = 32, TOPK = 4, DFF = 1024;
constexpr int INC = 2560;
constexpr float LN_EPS = 1e-5f;
constexpr float DN_ALPHA = 1.189207115002721f;
constexpr float LOG2E = 1.4426950408889634f;
constexpr float SB_QSCALE = 0.125f * LOG2E;
constexpr float MEM_QSCALE = 0.0625f * LOG2E;
constexpr float WGU_SC = 32.0f, WDN_SC = 64.0f, WQ_SC = 32.0f, WO_SC = 64.0f, OB_SC = 16.0f;
constexpr float WGU_SC_UNUSED = 0.f;
constexpr int NBLK_MAX = M * TOPK / 256 + NE;
constexpr int LCAP = M;

constexpr size_t MiB = 1u << 20;
constexpr size_t WS_CTL = 0, CTL_ZERO_BYTES = 1 * MiB;
constexpr size_t WS_WIN_T = 1 * MiB;
constexpr size_t WS_WOUT_T = 6 * MiB;
constexpr size_t WS_WQ_T = 8 * MiB, WS_WK_T = 10 * MiB, WS_WV_T = 12 * MiB, WS_WO_T = 14 * MiB;
constexpr size_t WS_WGU_T = 16 * MiB;
constexpr size_t WS_WDN_T = 144 * MiB;
constexpr size_t WS_HB8 = 176 * MiB;
constexpr size_t WS_HB = 208 * MiB;
constexpr size_t WS_LTOK = 272 * MiB;
constexpr size_t WS_LGATE = 276 * MiB;
constexpr size_t WS_SIDX = 280 * MiB;
constexpr size_t WS_WR = 281 * MiB;
constexpr size_t WS_HB2 = 832 * MiB;
constexpr size_t WS_X = 288 * MiB;
constexpr size_t WS_U = WS_X;
constexpr size_t WS_Q = WS_X + 32 * MiB;
constexpr size_t WS_K = WS_X + 64 * MiB;
constexpr size_t WS_V = WS_X + 96 * MiB;
constexpr size_t WS_MIXIN = WS_X + 128 * MiB;
constexpr size_t WS_QM = WS_X + 192 * MiB;
constexpr size_t WS_SP = WS_X + 256 * MiB;
constexpr size_t WS_OB = WS_X + 320 * MiB;
constexpr size_t WS_MEMN = WS_X + 384 * MiB;
constexpr size_t WS_KM = WS_X + 388 * MiB;
constexpr size_t WS_VMT = WS_X + 392 * MiB;
constexpr size_t WS_ACT = WS_X;
constexpr size_t WS_YS = WS_X + 272 * MiB;
constexpr size_t WS_END = 896 * MiB;
constexpr int CW_TMO = 0, CW_CODE = 1;
constexpr int CW_BAR = 4096;
constexpr int CW_ECNT = 131072;
constexpr int NPHASE = 12;

constexpr int RING_OFF = 0, RING_BYTES = 131072;
constexpr int LDS_BYTES = 163840;
constexpr int LDSCTL_OFF = LDS_BYTES - 1024, MISC_OFF = LDSCTL_OFF + 320;
constexpr int XTRA_OFF = RING_BYTES;
constexpr int TB_OFF = XTRA_OFF + 20480;
constexpr int WR_STRIDE = 1032;
constexpr int P10_WR = 0, P10_GB = 2 * 32 * WR_STRIDE * 2, P10_LCNT = P10_GB + 8192, P10_REC = P10_LCNT + 512;
static_assert(P10_REC + 8192 <= TB_OFF && TB_OFF + 4 * (128 + 544) <= LDSCTL_OFF, "LDS map");
constexpr int NWAVES = 8;

__device__ __forceinline__ unsigned f2bf(float f) { unsigned u = __builtin_bit_cast(unsigned, f); return (u + 0x7fffu + ((u >> 16) & 1u)) >> 16; }
__device__ __forceinline__ unsigned pk2(float lo, float hi) { return f2bf(lo) | (f2bf(hi) << 16); }
__device__ __forceinline__ float bflo(unsigned u) { return __builtin_bit_cast(float, u << 16); }
__device__ __forceinline__ float bfhi(unsigned u) { return __builtin_bit_cast(float, u & 0xffff0000u); }
__device__ __forceinline__ float wave_sum(float v) {
#pragma unroll
    for (int o = 1; o < 64; o <<= 1) v += __shfl_xor(v, o);
    return v;
}
__device__ __forceinline__ float wave_max(float v) {
#pragma unroll
    for (int o = 1; o < 64; o <<= 1) v = fmaxf(v, __shfl_xor(v, o));
    return v;
}
__device__ __forceinline__ unsigned pk4_fp8(float a, float b, float c, float d) {
    int r = __builtin_amdgcn_cvt_pk_fp8_f32(a, b, 0, false); r = __builtin_amdgcn_cvt_pk_fp8_f32(c, d, r, true); return (unsigned)r; }
__device__ __forceinline__ float sigmoidf_fast(float x) { return __builtin_amdgcn_rcpf(1.0f + __expf(-x)); }

namespace pg8 {
constexpr int BM = 256, BK = 64, HALF = 128, HTB = HALF * BK * 2, STAGE_BYTES = 8 * HTB, NXCD = 8, WGM = 8;
__host__ __device__ __forceinline__ int lds_byte(int r, int c) { const int st = (r >> 4) * 2 + (c >> 5), rr = r & 15, cc = c & 31, ob = rr * 64 + cc * 2; return st * 1024 + (ob ^ (((ob >> 9) & 1) << 5)); }
__host__ __device__ __forceinline__ void stage_rc(int b, int& R, int& C) { const int st = b / 1024, sb = b % 1024, swz = sb ^ (((sb >> 9) & 1) << 5); R = (st >> 1) * 16 + swz / 64; C = (st & 1) * 32 + (swz % 64) / 2; }
__host__ __device__ __forceinline__ int perm32(int rho) { const int n = rho >> 4, i = rho & 15; return 8 * (i >> 2) + 4 * n + (i & 3); }

struct Unit { int pm, pn, z, nvalid; unsigned aoff, boff, goff; };

__device__ __forceinline__ void tile_order(int L, int nM, int nN, int& pm, int& pn) {
    const int nwg = nM * nN; int wgid = L;
    { const int q = nwg / NXCD, r = nwg % NXCD, xcd = wgid % NXCD, off = wgid / NXCD; wgid = (xcd < r ? xcd * (q + 1) : r * (q + 1) + (xcd - r) * q) + off; }
    const int nig = WGM * nN, gid = wgid / nig, fm = gid * WGM, gsz = (nM - fm) < WGM ? (nM - fm) : WGM;
    pm = fm + ((wgid % nig) % gsz); pn = (wgid % nig) / gsz;
}
__device__ __forceinline__ unsigned cvt_pk_bf16(float lo, float hi) { unsigned r; asm volatile("v_cvt_pk_bf16_f32 %0, %1, %2" : "=v"(r) : "v"(lo), "v"(hi)); return r; }

__device__ __forceinline__ void store_tile_bf16(const f32x4 (&acc)[2][2][4][2], bf16* p0, size_t ldc, const float* bias, float scale, int wc, int fq) {
    const int cl = wc * 32 + 8 * fq;
    f32x4 bv[2][2];
#pragma unroll
    for (int bj = 0; bj < 2; ++bj)
#pragma unroll
        for (int n = 0; n < 2; ++n) bv[bj][n] = bias ? *(const f32x4*)(bias + cl + bj * HALF + 4 * n) : (f32x4){0.f, 0.f, 0.f, 0.f};
#pragma unroll
    for (int ai = 0; ai < 2; ++ai)
#pragma unroll
        for (int m = 0; m < 4; ++m) { bf16* rowp = p0 + (size_t)(ai * HALF + m * 16) * ldc + cl;
#pragma unroll
            for (int bj = 0; bj < 2; ++bj) { const f32x4 v0 = (acc[ai][bj][m][0] + bv[bj][0]) * scale, v1 = (acc[ai][bj][m][1] + bv[bj][1]) * scale;
                u32x4 w; w.x = cvt_pk_bf16(v0[0], v0[1]); w.y = cvt_pk_bf16(v0[2], v0[3]); w.z = cvt_pk_bf16(v1[0], v1[1]); w.w = cvt_pk_bf16(v1[2], v1[3]);
                *(u32x4*)(rowp + bj * HALF) = w; } }
}

typedef int v8i __attribute__((ext_vector_type(8)));
template <class Epi, class Sched, bool GATHER, bool FP8 = false>
__device__ __forceinline__ void gemm_phase(LAS unsigned char* lds, const char* wsb, const int lda, const int ldb, const int K, const Sched& S, const Epi& E, const int* glist) {
    int tid = threadIdx.x; asm volatile("" : "+v"(tid));
    const int wid = __builtin_amdgcn_readfirstlane(tid >> 6), lane = tid & 63, wr = wid >> 2, wc = wid & 3, fr = lane & 15, fq = lane >> 4;
    const int nt = K / BK;
    unsigned voffA[2], voffB[2];
#pragma unroll
    for (int i = 0; i < 2; ++i) { int R, C; stage_rc(tid * 16 + i * 8192, R, C); const int Rb = Epi::PERM ? ((R & ~31) + perm32(R & 31)) : R;
        voffA[i] = (unsigned)(R * lda + C) * 2u; voffB[i] = (unsigned)(Rb * ldb + C) * 2u; }
    const size_t kstep = (size_t)(BK * 2);
    const size_t hstepA = (size_t)HALF * lda * 2, hstepB = (size_t)HALF * ldb * 2;
    const unsigned ldsw = (unsigned)wid * 1024u;
    const int aoff = lds_byte(wr * 64 + fr, fq * 8), boff = lds_byte(wc * 32 + fr, fq * 8);
    unsigned gc[2][2], gn[2][2];
#define PG8_SA(b, h) (((b) * 2 + (h)) * HTB)
#define PG8_SB(b, h) ((4 + (b) * 2 + (h)) * HTB)
#define PG8_STAGE_B(bufoff, gbase) do { _Pragma("unroll") for (int _i = 0; _i < 2; ++_i) \
        __builtin_amdgcn_global_load_lds((const unsigned*)((const char*)(gbase) + voffB[_i]), (LAS unsigned*)(lds + (bufoff) + ldsw + _i * 8192), 16, 0, 0); } while (0)
#define PG8_STAGE_A(bufoff, gbase, h, nx) do { _Pragma("unroll") for (int _i = 0; _i < 2; ++_i) { \
        const char* _p = GATHER ? (const char*)(gbase) + ((nx) ? gn[h][_i] : gc[h][_i]) : (const char*)(gbase) + (h) * hstepA + voffA[_i]; \
        __builtin_amdgcn_global_load_lds((const unsigned*)_p, (LAS unsigned*)(lds + (bufoff) + ldsw + _i * 8192), 16, 0, 0); } } while (0)
#define PG8_LDA(dst, b, h) do { _Pragma("unroll") for (int m = 0; m < 4; ++m) { if constexpr (FP8) { const u32x4 _lo = *(const LAS u32x4*)(lds + PG8_SA(b, h) + aoff + m * 2048), _hi = *(const LAS u32x4*)(lds + PG8_SA(b, h) + aoff + m * 2048 + 1024); \
            dst##8[m] = (v8i){(int)_lo.x, (int)_lo.y, (int)_lo.z, (int)_lo.w, (int)_hi.x, (int)_hi.y, (int)_hi.z, (int)_hi.w}; } \
        else { _Pragma("unroll") for (int k = 0; k < 2; ++k) dst[m][k] = *(const LAS bf16x8*)(lds + PG8_SA(b, h) + aoff + m * 2048 + k * 1024); } } } while (0)
#define PG8_LDB(dst, b, h) do { _Pragma("unroll") for (int n = 0; n < 2; ++n) { if constexpr (FP8) { const u32x4 _lo = *(const LAS u32x4*)(lds + PG8_SB(b, h) + boff + n * 2048), _hi = *(const LAS u32x4*)(lds + PG8_SB(b, h) + boff + n * 2048 + 1024); \
            dst##8[n] = (v8i){(int)_lo.x, (int)_lo.y, (int)_lo.z, (int)_lo.w, (int)_hi.x, (int)_hi.y, (int)_hi.z, (int)_hi.w}; } \
        else { _Pragma("unroll") for (int k = 0; k < 2; ++k) dst[n][k] = *(const LAS bf16x8*)(lds + PG8_SB(b, h) + boff + n * 2048 + k * 1024); } } } while (0)
#define PG8_MMA(ai, bj, At, Bt) do { __builtin_amdgcn_s_setprio(1); if constexpr (FP8) asm volatile("s_nop 1"); _Pragma("unroll") for (int m = 0; m < 4; ++m) _Pragma("unroll") for (int n = 0; n < 2; ++n) { \
        if constexpr (FP8) asm volatile("v_mfma_f32_16x16x128_f8f6f4 %0, %1, %2, %0" : "+v"(acc[ai][bj][m][n]) : "v"(Bt##8[n]), "v"(At##8[m])); \
        else { _Pragma("unroll") for (int k = 0; k < 2; ++k) acc[ai][bj][m][n] = __builtin_amdgcn_mfma_f32_16x16x32_bf16(Bt[n][k], At[m][k], acc[ai][bj][m][n], 0, 0, 0); } } \
        __builtin_amdgcn_s_setprio(0); } while (0)
#define PG8_WAIT_V(n) asm volatile("s_waitcnt vmcnt(" #n ")" ::: "memory")
#define PG8_WAIT_L(n) asm volatile("s_waitcnt lgkmcnt(" #n ")" ::: "memory")
#define PG8_BAR __builtin_amdgcn_s_barrier()
#define PG8_SCHED __builtin_amdgcn_sched_barrier(0)
#define PG8_GIDX(g, u) do { _Pragma("unroll") for (int _h = 0; _h < 2; ++_h) _Pragma("unroll") for (int _i = 0; _i < 2; ++_i) { int _R, _C; stage_rc(tid * 16 + _i * 8192, _R, _C); const int _r = _h * HALF + _R; \
        const int _tok = glist[(u).goff + (_r < (u).nvalid ? _r : (u).nvalid - 1)]; g[_h][_i] = (unsigned)_tok * (unsigned)(lda * 2) + (unsigned)(_C * 2); } } while (0)
    Unit cur, nxt, nn; int ui = 0;
    if (!S.next(0, cur)) return;
    f32x4 acc[2][2][4][2];
#pragma unroll
    for (int a = 0; a < 2; ++a)
#pragma unroll
        for (int b = 0; b < 2; ++b)
#pragma unroll
            for (int m = 0; m < 4; ++m)
#pragma unroll
                for (int n = 0; n < 2; ++n) acc[a][b][m][n] = (f32x4){0.f, 0.f, 0.f, 0.f};
    bf16x8 At[4][2], B0[2][2], B1[2][2];
    v8i At8[4], B08[2], B18[2];
    const char* cA = wsb + cur.aoff; const char* cB = wsb + cur.boff;
    if constexpr (GATHER) { PG8_GIDX(gc, cur); if (S.next(1, nxt)) { PG8_GIDX(gn, nxt); } else { PG8_GIDX(gn, cur); }
        asm volatile("s_waitcnt vmcnt(0)" : "+v"(gc[0][0]), "+v"(gc[0][1]), "+v"(gc[1][0]), "+v"(gc[1][1]), "+v"(gn[0][0]), "+v"(gn[0][1]), "+v"(gn[1][0]), "+v"(gn[1][1]) :: "memory"); }
    else {
#pragma unroll
        for (int h = 0; h < 2; ++h)
#pragma unroll
            for (int i = 0; i < 2; ++i) { gc[h][i] = 0u; gn[h][i] = 0u; } }
    PG8_STAGE_B(PG8_SB(0, 0), cB); PG8_STAGE_B(PG8_SB(0, 1), cB + hstepB); PG8_STAGE_A(PG8_SA(0, 0), cA, 0, false); PG8_STAGE_A(PG8_SA(0, 1), cA, 1, false);
    if (wr == 1) PG8_BAR;
    PG8_WAIT_V(2); PG8_BAR;
    PG8_STAGE_B(PG8_SB(1, 0), cB + kstep); PG8_STAGE_A(PG8_SA(1, 0), cA + kstep, 0, false); PG8_STAGE_B(PG8_SB(1, 1), cB + hstepB + kstep);
    PG8_WAIT_V(6); PG8_BAR;
    for (;;) {
        const bool has_next = S.next(ui + 1, nxt);
        const char* nA = has_next ? wsb + nxt.aoff : cA; const char* nB = has_next ? wsb + nxt.boff : cB;
#pragma clang loop unroll(disable)
        for (int t = 0; t < nt; t += 2) {
            const bool last = (t == nt - 2);
            const char* a1 = cA + (size_t)(t + 1) * kstep;
            const char* a2 = last ? nA : cA + (size_t)(t + 2) * kstep; const char* b2 = last ? nB : cB + (size_t)(t + 2) * kstep;
            const char* a3 = a2 + kstep; const char* b3 = b2 + kstep;
            PG8_LDB(B0, 0, 0); PG8_LDB(B1, 0, 1); PG8_SCHED; PG8_LDA(At, 0, 0); PG8_STAGE_A(PG8_SA(1, 1), a1, 1, false);
            PG8_WAIT_V(8); PG8_WAIT_L(0); PG8_BAR; PG8_MMA(0, 0, At, B0); PG8_MMA(0, 1, At, B1); PG8_BAR; PG8_SCHED;
            PG8_LDA(At, 0, 1); PG8_STAGE_B(PG8_SB(0, 0), b2); PG8_STAGE_B(PG8_SB(0, 1), b2 + hstepB); PG8_STAGE_A(PG8_SA(0, 0), a2, 0, last);
            PG8_WAIT_V(8); PG8_WAIT_L(0); PG8_BAR; PG8_MMA(1, 0, At, B0); PG8_MMA(1, 1, At, B1); PG8_BAR; PG8_SCHED;
            PG8_LDB(B0, 1, 0); PG8_LDB(B1, 1, 1); PG8_SCHED; PG8_LDA(At, 1, 0); PG8_STAGE_A(PG8_SA(0, 1), a2, 1, last);
            PG8_WAIT_V(8); PG8_WAIT_L(0); PG8_BAR; PG8_MMA(0, 0, At, B0); PG8_MMA(0, 1, At, B1); PG8_BAR; PG8_SCHED;
            PG8_LDA(At, 1, 1); PG8_STAGE_B(PG8_SB(1, 0), b3); PG8_STAGE_B(PG8_SB(1, 1), b3 + hstepB); PG8_STAGE_A(PG8_SA(1, 0), a3, 0, last);
            PG8_WAIT_V(8); PG8_WAIT_L(0); PG8_BAR; PG8_MMA(1, 0, At, B0); PG8_MMA(1, 1, At, B1); PG8_BAR; PG8_SCHED;
        }
        if constexpr (FP8) asm volatile("s_nop 15\n\ts_nop 7");
        if (wr == 0) PG8_BAR;
        if constexpr (GATHER) {
#pragma unroll
            for (int h = 0; h < 2; ++h)
#pragma unroll
                for (int i = 0; i < 2; ++i) gc[h][i] = gn[h][i];
            if (has_next && S.next(ui + 2, nn)) { PG8_GIDX(gn, nn); }
        }
        E(acc, cur, wr, wc, fr, fq);
        if constexpr (GATHER) asm volatile("" : "+v"(gn[0][0]), "+v"(gn[0][1]), "+v"(gn[1][0]), "+v"(gn[1][1]));
        if (!has_next) break;
#pragma unroll
        for (int a = 0; a < 2; ++a)
#pragma unroll
            for (int b = 0; b < 2; ++b)
#pragma unroll
                for (int m = 0; m < 4; ++m)
#pragma unroll
                    for (int n = 0; n < 2; ++n) acc[a][b][m][n] = (f32x4){0.f, 0.f, 0.f, 0.f};
        cur = nxt; cA = nA; cB = nB; ++ui;
        if (wr == 1) PG8_BAR;
    }
    PG8_WAIT_V(0);
    PG8_BAR;
#undef PG8_SA
#undef PG8_SB
#undef PG8_STAGE_A
#undef PG8_STAGE_B
#undef PG8_LDA
#undef PG8_LDB
#undef PG8_MMA
#undef PG8_WAIT_V
#undef PG8_WAIT_L
#undef PG8_BAR
#undef PG8_SCHED
#undef PG8_GIDX
}
}
using pg8::Unit;

#define XB_TMO      128
#define XB_XCNT(j)  (256  + 64 * (j))
#define XB_XSUB(j)  (1280 + 64 * (j))
#define XB_XGEN(j)  (2304 + 64 * (j))
#define XB_TOP      3328
#define XB_TOPGEN   3392
#define XCD_BAR_WORDS 3456
#define XB_SPIN_CAP (1u << 18)
__device__ __forceinline__ unsigned xb_ld(unsigned* p)              { return __hip_atomic_load(p, __ATOMIC_RELAXED, __HIP_MEMORY_SCOPE_AGENT); }
__device__ __forceinline__ unsigned xb_add(unsigned* p, unsigned v) { return __hip_atomic_fetch_add(p, v, __ATOMIC_RELAXED, __HIP_MEMORY_SCOPE_AGENT); }
__device__ __forceinline__ unsigned xb_xcc_id() { return (unsigned)__builtin_amdgcn_s_getreg((3 << 11) | 20) & 0xFu; }
#define XB_SPIN(cond, bar) do { unsigned _sp = 0; while (cond) { __builtin_amdgcn_s_sleep(1); \
    if ((++_sp & 255u) == 0u) { if (xb_ld(&(bar)[XB_TMO])) break; if (_sp > XB_SPIN_CAP) { atomicAdd(&(bar)[XB_TMO], 1u); break; } } } } while (0)
struct XcdBarrier { unsigned* bar; unsigned x; volatile LAS unsigned* st; };
__device__ __forceinline__ XcdBarrier xcd_barrier_post(unsigned* bar, volatile LAS unsigned* st) {
    XcdBarrier b; b.bar = bar; b.x = xb_xcc_id(); b.st = st;
    if (threadIdx.x == 0) (void)xb_add(&bar[XB_XCNT(b.x)], 1u);
    return b;
}
__device__ __forceinline__ void xcd_barrier_complete(unsigned* bar, unsigned x, unsigned& nloc, unsigned& nx) {
    const unsigned G = gridDim.x * gridDim.y * gridDim.z;
    unsigned sum, cnt, mine, sp = 0u;
    for (;;) {
        sum = 0u; cnt = 0u; mine = 0u;
#pragma unroll
        for (unsigned j = 0; j < 16; ++j) { const unsigned c = xb_ld(&bar[XB_XCNT(j)]); sum += c; cnt += (c > 0u) ? 1u : 0u; mine = (j == x) ? c : mine; }
        if (sum == G) break;
        __builtin_amdgcn_s_sleep(1);
        if ((++sp & 255u) == 0u) { if (xb_ld(&bar[XB_TMO])) break; if (sp > XB_SPIN_CAP) { atomicAdd(&bar[XB_TMO], 1u); break; } }
    }
    nloc = mine > 0u ? mine : 1u; nx = cnt > 0u ? cnt : 1u;
}
__device__ __forceinline__ void xcd_barrier(const XcdBarrier& b) {
    asm volatile("s_waitcnt vmcnt(0)" ::: "memory");
    __syncthreads();
    if (threadIdx.x == 0) {
        unsigned* bar = b.bar;
        __builtin_amdgcn_s_waitcnt(0);
        unsigned nloc = b.st[0], nx = b.st[1];
        if (nloc == 0u) { xcd_barrier_complete(bar, b.x, nloc, nx); b.st[0] = nloc; b.st[1] = nx; }
        const unsigned old = xb_add(&bar[XB_XSUB(b.x)], 1u);
        const unsigned gen = old / nloc;
        if (old + 1u == (gen + 1u) * nloc) {
            __builtin_amdgcn_fence(__ATOMIC_RELEASE, "agent");
            asm volatile("s_waitcnt vmcnt(0)" ::: "memory");
            const unsigned og = xb_add(&bar[XB_TOP], 1u);
            const unsigned tg = og / nx;
            if (og + 1u == (tg + 1u) * nx) xb_add(&bar[XB_TOPGEN], 1u);
            else XB_SPIN(xb_ld(&bar[XB_TOPGEN]) == tg, bar);
            __builtin_amdgcn_fence(__ATOMIC_ACQUIRE, "agent");
            xb_add(&bar[XB_XGEN(b.x)], 1u);
            asm volatile("s_waitcnt vmcnt(0)" ::: "memory");
        } else {
            XB_SPIN(xb_ld(&bar[XB_XGEN(b.x)]) == gen, bar);
            __builtin_amdgcn_fence(__ATOMIC_ACQUIRE, "agent");
            asm volatile("s_waitcnt vmcnt(0)" ::: "memory");
        }
    }
    __syncthreads();
}

struct Frame {
    LAS unsigned char* lds;
    volatile LAS unsigned* MISC;
    gu32* ctl;
    unsigned char* ws;
    int tid, lane, wave, vcu, G;
    float* hf;
    const float* const* in;
};
enum In { I_X = 0, I_MEM, I_LN_IN_G, I_LN_IN_B, I_LN_MEM_G, I_LN_MEM_B, I_W_IN, I_B_IN, I_W_DW, I_B_DW, I_LN_CONV_G, I_LN_CONV_B, I_W_OUT, I_B_OUT, I_LN1_G, I_LN1_B,
          I_WQ, I_WK, I_WV, I_WO, I_LN2_G, I_LN2_B, I_W_ROUTER, I_B_ROUTER, I_W_GU, I_B_GU, I_W_DOWN, I_B_DOWN, I_LN3_G, I_LN3_B, N_IN };

__device__ __forceinline__ void p0_transpose_item(const float* W, int K, int N, bf16* WT, int k0, int n0, int drow, LAS float* scr, int lane) {
#pragma unroll 8
    for (int i = 0; i < 32; ++i) { const int kk = 2 * i + (lane >> 5); scr[kk * 33 + (lane & 31)] = W[(size_t)(k0 + kk) * N + n0 + (lane & 31)]; }
    LDS_WAIT(); asm volatile("" ::: "memory");
    const int c = lane & 7;
#pragma unroll
    for (int j = 0; j < 4; ++j) { const int n = (lane >> 3) + 8 * j; const LAS float* s = scr + (8 * c) * 33 + n;
        u32x4 o; o.x = pk2(s[0 * 33], s[1 * 33]); o.y = pk2(s[2 * 33], s[3 * 33]); o.z = pk2(s[4 * 33], s[5 * 33]); o.w = pk2(s[6 * 33], s[7 * 33]);
        *(GAS u32x4*)(WT + (size_t)(drow + n) * K + k0 + 8 * c) = o; }
    LDS_WAIT(); asm volatile("" ::: "memory");
}
__device__ __forceinline__ void ln_row(f32x4 (&v)[4], const float* g, const float* b, int lane) {
    float s = 0.f;
#pragma unroll
    for (int j = 0; j < 4; ++j) s += (v[j].x + v[j].y) + (v[j].z + v[j].w);
    const float mean = wave_sum(s) * (1.f / D); float s2 = 0.f;
#pragma unroll
    for (int j = 0; j < 4; ++j) { v[j] = v[j] - mean; s2 += (v[j].x * v[j].x + v[j].y * v[j].y) + (v[j].z * v[j].z + v[j].w * v[j].w); }
    const float rstd = 1.f / sqrtf(wave_sum(s2) * (1.f / D) + LN_EPS);
#pragma unroll
    for (int j = 0; j < 4; ++j) { const f32x4 gg = ((const GAS f32x4*)g)[lane + 64 * j], bb = ((const GAS f32x4*)b)[lane + 64 * j]; v[j] = v[j] * rstd * gg + bb; }
}
__device__ __forceinline__ void store_row_bf16(const f32x4 (&v)[4], bf16* orow, int lane) {
    GAS u32x2* o8 = (GAS u32x2*)orow + lane;
#pragma unroll
    for (int j = 0; j < 4; ++j) o8[64 * j] = (u32x2){pk2(v[j].x, v[j].y), pk2(v[j].z, v[j].w)};
}
__device__ __forceinline__ void p0_transpose_item8(const float* W, int K, int N, unsigned char* WT, int k0, int n0, int drow, float sc, LAS float* scr, int lane) {
#pragma unroll 8
    for (int i = 0; i < 32; ++i) { const int kk = 2 * i + (lane >> 5); scr[kk * 33 + (lane & 31)] = W[(size_t)(k0 + kk) * N + n0 + (lane & 31)]; }
    LDS_WAIT(); asm volatile("" ::: "memory");
    const int c = lane & 7;
#pragma unroll
    for (int j = 0; j < 4; ++j) { const int n = (lane >> 3) + 8 * j; const LAS float* s = scr + (8 * c) * 33 + n;
        u32x2 o; o.x = pk4_fp8(s[0 * 33] * sc, s[1 * 33] * sc, s[2 * 33] * sc, s[3 * 33] * sc); o.y = pk4_fp8(s[4 * 33] * sc, s[5 * 33] * sc, s[6 * 33] * sc, s[7 * 33] * sc);
        *(GAS u32x2*)(WT + (size_t)(drow + n) * K + k0 + 8 * c) = o; }
    LDS_WAIT(); asm volatile("" ::: "memory");
}
__device__ __forceinline__ void p0_transpose_item8b(const float* W, int K, int N, unsigned char* WT, int k0, int n0, int drow, float sc, LAS unsigned char* scr, int lane) {
    const int g = lane >> 3, c = lane & 7;
    f32x4 x[4][4];
#pragma unroll
    for (int q = 0; q < 4; ++q)
#pragma unroll
        for (int j = 0; j < 4; ++j) x[q][j] = *(const GAS f32x4*)(W + (size_t)(k0 + 32 * q + 4 * g + j) * N + n0 + 4 * c);
#pragma unroll
    for (int q = 0; q < 4; ++q)
#pragma unroll
        for (int e = 0; e < 4; ++e) *(LAS unsigned*)(scr + (4 * c + e) * 144 + 32 * q + 4 * g) = pk4_fp8(x[q][0][e] * sc, x[q][1][e] * sc, x[q][2][e] * sc, x[q][3][e] * sc);
    LDS_WAIT(); asm volatile("" ::: "memory");
#pragma unroll
    for (int i = 0; i < 4; ++i) { const int t = lane + 64 * i, n = t >> 3, ch = t & 7;
        *(GAS u32x4*)(WT + (size_t)(drow + n) * K + k0 + 16 * ch) = *(const LAS u32x4*)(scr + n * 144 + 16 * ch); }
    LDS_WAIT(); asm volatile("" ::: "memory");
}
__device__ __forceinline__ void load_row_bf16(f32x4 (&v)[4], const bf16* xrow, int lane) {
    const GAS u32x2* xr = (const GAS u32x2*)xrow + lane;
#pragma unroll
    for (int j = 0; j < 4; ++j) { const u32x2 w = xr[64 * j]; v[j] = (f32x4){bflo(w.x), bfhi(w.x), bflo(w.y), bfhi(w.y)}; }
}
__device__ __forceinline__ void load_row_f32(f32x4 (&v)[4], const float* xrow, int lane) {
    const GAS f32x4* xr = (const GAS f32x4*)xrow + lane;
#pragma unroll
    for (int j = 0; j < 4; ++j) v[j] = xr[64 * j];
}
__device__ __forceinline__ void store_row_f32(const f32x4 (&v)[4], float* orow, int lane) {
    GAS f32x4* o = (GAS f32x4*)orow + lane;
#pragma unroll
    for (int j = 0; j < 4; ++j) o[64 * j] = v[j];
}

__device__ __forceinline__ void p0_prologue(Frame& F) {
    LAS float* scr = (LAS float*)(F.lds + RING_OFF + F.wave * 16384);
    const int gw = F.vcu * NWAVES + F.wave, NGW = F.G * NWAVES;
    constexpr int I_IN = 16 * 80, I_SQ = 16 * 32, I_GU = NE * 8 * 64, I_DN = NE * 8 * 32;
    constexpr int NITEMS = I_IN + 3 * I_SQ + 2 * 256 + I_GU + I_DN;
    for (int it = gw; it < NITEMS; it += NGW) {
        int r = it;
        if (r < I_GU) { const int e = r / (8 * 64), q = r % (8 * 64), kb = q / 64, nb = q % 64, n0 = 32 * nb;
            const int drow = (n0 < 1024) ? (n0 >> 7) * 256 + (n0 & 127) : ((n0 - 1024) >> 7) * 256 + 128 + (n0 & 127);
            p0_transpose_item8b(F.in[I_W_GU] + (size_t)e * D * 2 * DFF, D, 2 * DFF, F.ws + WS_WGU_T + (size_t)e * 2 * DFF * D, 128 * kb, n0, drow, WGU_SC, (LAS unsigned char*)scr, F.lane); continue; } r -= I_GU;
        if (r < I_DN) { const int e = r / (8 * 32), q = r % (8 * 32), kb = q / 32, nb = q % 32;
            p0_transpose_item8b(F.in[I_W_DOWN] + (size_t)e * DFF * D, DFF, D, F.ws + WS_WDN_T + (size_t)e * D * DFF, 128 * kb, 32 * nb, 32 * nb, WDN_SC, (LAS unsigned char*)scr, F.lane); continue; } r -= I_DN;
        if (r < I_IN) { const int kb = r / 80, nb = r % 80, n0 = 32 * nb; int drow;
            if (n0 < 512) drow = (n0 >> 7) * 256 + (n0 & 127); else if (n0 < 1024) drow = ((n0 - 512) >> 7) * 256 + 128 + (n0 & 127); else drow = n0;
            p0_transpose_item(F.in[I_W_IN], D, INC, (bf16*)(F.ws + WS_WIN_T), 64 * kb, n0, drow, scr, F.lane); continue; } r -= I_IN;
        if (r < 3 * I_SQ) { const int w = r / I_SQ, q = r % I_SQ, kb = q / 32, nb = q % 32;
            const float* src = F.in[w == 0 ? I_W_OUT : w == 1 ? I_WK : I_WV];
            bf16* dst = (bf16*)(F.ws + (w == 0 ? WS_WOUT_T : w == 1 ? WS_WK_T : WS_WV_T));
            p0_transpose_item(src, D, D, dst, 64 * kb, 32 * nb, 32 * nb, scr, F.lane); continue; } r -= 3 * I_SQ;
        { const int w = r / 256, q = r % 256, kb = q / 32, nb = q % 32;
            p0_transpose_item8b(F.in[w == 0 ? I_WQ : I_WO], D, D, F.ws + (w == 0 ? WS_WQ_T : WS_WO_T), 128 * kb, 32 * nb, 32 * nb, w == 0 ? WQ_SC : WO_SC, (LAS unsigned char*)scr, F.lane); }
    }
    if (gw < 512) { const int idx = gw * 64 + F.lane, c = idx >> 5, e = idx & 31; const float w = F.in[I_W_ROUTER][idx];
        const unsigned hi = f2bf(w), lo = f2bf(w - __builtin_bit_cast(float, hi << 16)); bf16* wr = (bf16*)(F.ws + WS_WR);
        wr[e * WR_STRIDE + c] = (bf16)hi; wr[(32 + e) * WR_STRIDE + c] = (bf16)lo; }
    for (int m = gw; m < M + MM; m += NGW) {
        f32x4 v[4];
        if (m < M) { load_row_f32(v, F.in[I_X] + (size_t)m * D, F.lane); ln_row(v, F.in[I_LN_IN_G], F.in[I_LN_IN_B], F.lane);
            store_row_bf16(v, (bf16*)(F.ws + WS_HB) + (size_t)m * D, F.lane); }
        else { const int mm = m - M; load_row_f32(v, F.in[I_MEM] + (size_t)mm * D, F.lane); ln_row(v, F.in[I_LN_MEM_G], F.in[I_LN_MEM_B], F.lane);
            store_row_bf16(v, (bf16*)(F.ws + WS_MEMN) + (size_t)mm * D, F.lane); }
    }
}

constexpr unsigned TSTEP = 256u * 1024u * 2u;
struct SchedP1 { int G, c;
    __device__ __forceinline__ bool next(int i, Unit& u) const {
        const int L = i * G + c; if (L >= 1344) return false;
        u.nvalid = 256; u.goff = 0;
        if (L < 1024) { pg8::tile_order(L, 128, 8, u.pm, u.pn); u.z = 0; u.aoff = (unsigned)WS_HB + (unsigned)u.pm * TSTEP; u.boff = (unsigned)WS_WIN_T + (unsigned)u.pn * TSTEP; }
        else if (L < 1280) { const int j = L - 1024; u.pm = j & 1; u.pn = j >> 1; u.z = 3; u.aoff = (unsigned)WS_WIN_T + (unsigned)(8 + u.pm) * TSTEP; u.boff = (unsigned)WS_HB + (unsigned)u.pn * TSTEP; }
        else if (L < 1312) { const int j = L - 1280; u.pm = j & 7; u.pn = j >> 3; u.z = 1; u.aoff = (unsigned)WS_MEMN + (unsigned)u.pm * TSTEP; u.boff = (unsigned)WS_WK_T + (unsigned)u.pn * TSTEP; }
        else { const int j = L - 1312; u.pm = j & 3; u.pn = j >> 2; u.z = 2; u.aoff = (unsigned)WS_WV_T + (unsigned)u.pm * TSTEP; u.boff = (unsigned)WS_MEMN + (unsigned)u.pn * TSTEP; }
        return true; }
};
struct EpiP1 { static constexpr bool PERM = true;
    unsigned char* ws; const float* b_in;
    __device__ __forceinline__ void operator()(const f32x4 (&acc)[2][2][4][2], const Unit& u, int wr, int wc, int fr, int fq) const {
        const int row0 = u.pm * 256 + wr * 64 + fr;
        if (u.z == 0) {
            if (u.pn < 4) {
                const int ch = 128 * u.pn + wc * 32 + 8 * fq;
                f32x4 bv[2], bg[2];
#pragma unroll
                for (int n = 0; n < 2; ++n) { bv[n] = *(const f32x4*)(b_in + ch + 4 * n); bg[n] = *(const f32x4*)(b_in + 512 + ch + 4 * n); }
                bf16* U = (bf16*)(ws + WS_U);
#pragma unroll
                for (int ai = 0; ai < 2; ++ai)
#pragma unroll
                    for (int m = 0; m < 4; ++m) { f32x4 o[2];
#pragma unroll
                        for (int n = 0; n < 2; ++n) { const f32x4 a = acc[ai][0][m][n] + bv[n], g = acc[ai][1][m][n] + bg[n];
#pragma unroll
                            for (int j = 0; j < 4; ++j) o[n][j] = a[j] * sigmoidf_fast(g[j]); }
                        u32x4 w; w.x = pg8::cvt_pk_bf16(o[0][0], o[0][1]); w.y = pg8::cvt_pk_bf16(o[0][2], o[0][3]); w.z = pg8::cvt_pk_bf16(o[1][0], o[1][1]); w.w = pg8::cvt_pk_bf16(o[1][2], o[1][3]);
                        *(u32x4*)(U + (size_t)(row0 + ai * 128 + m * 16) * 512 + ch) = w; }
            } else {
                const int t = u.pn - 4, which = t >> 1, cb = (t & 1) * 256;
                bf16* dst = (bf16*)(ws + (which == 0 ? WS_Q : WS_K));
                pg8::store_tile_bf16(acc, dst + (size_t)row0 * 512 + cb, 512, b_in + 1024 + 256 * t, which == 0 ? SB_QSCALE : 1.0f, wc, fq);
            }
        } else if (u.z == 3) {
            const float* rb = b_in + 2048 + row0; bf16* p0 = (bf16*)(ws + WS_V) + (size_t)row0 * M + 256 * u.pn; const int cl = wc * 32 + 8 * fq;
#pragma unroll
            for (int ai = 0; ai < 2; ++ai)
#pragma unroll
                for (int m = 0; m < 4; ++m) { const float bv = rb[ai * 128 + m * 16]; bf16* rowp = p0 + (size_t)(ai * 128 + m * 16) * M + cl;
#pragma unroll
                    for (int bj = 0; bj < 2; ++bj) { const f32x4 v0 = acc[ai][bj][m][0] + bv, v1 = acc[ai][bj][m][1] + bv;
                        u32x4 w; w.x = pg8::cvt_pk_bf16(v0[0], v0[1]); w.y = pg8::cvt_pk_bf16(v0[2], v0[3]); w.z = pg8::cvt_pk_bf16(v1[0], v1[1]); w.w = pg8::cvt_pk_bf16(v1[2], v1[3]);
                        *(u32x4*)(rowp + bj * 128) = w; } }
        } else if (u.z == 1) pg8::store_tile_bf16(acc, (bf16*)(ws + WS_KM) + (size_t)row0 * 1024 + 256 * u.pn, 1024, nullptr, 1.0f, wc, fq);
        else pg8::store_tile_bf16(acc, (bf16*)(ws + WS_VMT) + (size_t)row0 * 2048 + 256 * u.pn, 2048, nullptr, 1.0f, wc, fq);
    }
};

struct SchedPlain { int G, c, nM, nN; unsigned abase, bbase, atile, btile, acol, bcol, bgrp;
    __device__ __forceinline__ bool next(int i, Unit& u) const {
        const int L = i * G + c; if (L >= nM * nN) return false;
        pg8::tile_order(L, nM, nN, u.pm, u.pn); u.z = 0; u.nvalid = 256; u.goff = 0;
        u.aoff = abase + (unsigned)u.pm * atile + (unsigned)u.pn * acol; u.boff = bbase + (unsigned)u.pn * btile + (unsigned)(u.pm >> 4) * bgrp + (unsigned)u.pn * bcol; return true; }
};
struct EpiBf16 { static constexpr bool PERM = true;
    bf16* O; int ldc; float scale; const float* bias;
    __device__ __forceinline__ void operator()(const f32x4 (&acc)[2][2][4][2], const Unit& u, int wr, int wc, int fr, int fq) const {
        pg8::store_tile_bf16(acc, O + (size_t)(u.pm * 256 + wr * 64 + fr) * ldc + 256 * u.pn, (size_t)ldc, bias ? bias + 256 * u.pn : nullptr, scale, wc, fq); }
};
struct SchedMoe { int G, c, nN; const LAS int* tb; unsigned abase, wbase, wexp;
    bool gather;
    __device__ __forceinline__ bool next(int i, Unit& u) const {
        const int nblk = __builtin_amdgcn_readfirstlane(tb[32]); const int L = i * G + c; if (L >= nblk * nN) return false;
        pg8::tile_order(L, nblk, nN, u.pm, u.pn);
        const int e = __builtin_amdgcn_readfirstlane(tb[128 + u.pm]);
        const int j = u.pm - tb[e], rem = tb[64 + e] - 256 * j;
        u.z = e; u.nvalid = rem < 256 ? rem : 256; u.goff = (unsigned)(e * LCAP + 256 * j);
        u.aoff = gather ? abase : abase + (unsigned)u.pm * (TSTEP / 2);
        u.boff = wbase + (unsigned)e * wexp + (unsigned)u.pn * (TSTEP / 2); return true; }
};
struct EpiAct { static constexpr bool PERM = true;
    unsigned char* ACT; const float* b_gu;
    __device__ __forceinline__ void operator()(const f32x4 (&acc)[2][2][4][2], const Unit& u, int wr, int wc, int fr, int fq) const {
        const int row0 = u.pm * 256 + wr * 64 + fr, ch = 128 * u.pn + wc * 32 + 8 * fq;
        const float* bb = b_gu + (size_t)u.z * 2 * DFF;
        f32x4 bg[2], bu[2];
#pragma unroll
        for (int n = 0; n < 2; ++n) { bg[n] = *(const f32x4*)(bb + ch + 4 * n); bu[n] = *(const f32x4*)(bb + DFF + ch + 4 * n); }
#pragma unroll
        for (int ai = 0; ai < 2; ++ai)
#pragma unroll
            for (int m = 0; m < 4; ++m) { f32x4 o[2];
#pragma unroll
                for (int n = 0; n < 2; ++n) { const f32x4 g = acc[ai][0][m][n] * (1.0f / WGU_SC) + bg[n], uu = acc[ai][1][m][n] * (1.0f / WGU_SC) + bu[n];
#pragma unroll
                    for (int j = 0; j < 4; ++j) { const float g_ = fminf(g[j], 7.0f), u_ = fminf(fmaxf(uu[j], -7.0f), 7.0f); o[n][j] = (u_ + 1.0f) * g_ * sigmoidf_fast(1.702f * g_); } }
                *(u32x2*)(ACT + (size_t)(row0 + ai * 128 + m * 16) * DFF + ch) = (u32x2){pk4_fp8(o[0][0], o[0][1], o[0][2], o[0][3]), pk4_fp8(o[1][0], o[1][1], o[1][2], o[1][3])}; }
    }
};
struct EpiDown { static constexpr bool PERM = true;
    bf16* YS; const float* b_down; const float* lgate;
    __device__ __forceinline__ void operator()(const f32x4 (&acc)[2][2][4][2], const Unit& u, int wr, int wc, int fr, int fq) const {
        const int r0 = wr * 64 + fr, cl = wc * 32 + 8 * fq;
        const float* bb = b_down + (size_t)u.z * D + 256 * u.pn + cl;
        f32x4 bv[2][2];
#pragma unroll
        for (int bj = 0; bj < 2; ++bj)
#pragma unroll
            for (int n = 0; n < 2; ++n) bv[bj][n] = *(const f32x4*)(bb + bj * 128 + 4 * n);
        float gts[2][4];
#pragma unroll
        for (int ai = 0; ai < 2; ++ai)
#pragma unroll
            for (int m = 0; m < 4; ++m) { const int r = r0 + ai * 128 + m * 16; gts[ai][m] = lgate[u.goff + (r < u.nvalid ? r : u.nvalid - 1)]; }
#pragma unroll
        for (int ai = 0; ai < 2; ++ai)
#pragma unroll
            for (int m = 0; m < 4; ++m) { const int r = r0 + ai * 128 + m * 16; const float gt = (r < u.nvalid) ? gts[ai][m] : 0.f;
                bf16* rowp = YS + (size_t)(u.pm * 256 + r) * D + 256 * u.pn + cl;
#pragma unroll
                for (int bj = 0; bj < 2; ++bj) { const f32x4 v0 = (acc[ai][bj][m][0] * (1.0f / WDN_SC) + bv[bj][0]) * gt, v1 = (acc[ai][bj][m][1] * (1.0f / WDN_SC) + bv[bj][1]) * gt;
                    u32x4 w; w.x = pg8::cvt_pk_bf16(v0[0], v0[1]); w.y = pg8::cvt_pk_bf16(v0[2], v0[3]); w.z = pg8::cvt_pk_bf16(v1[0], v1[1]); w.w = pg8::cvt_pk_bf16(v1[2], v1[3]);
                    *(u32x4*)(rowp + bj * 128) = w; } }
    }
};
__device__ __forceinline__ void moe_table(Frame& F, LAS int* tb) {
    if (F.tid < 32) { int c = (int)__hip_atomic_load(F.ctl + CW_ECNT + 64 * F.tid, RLX_AGENT); if (c > LCAP) c = LCAP; tb[64 + F.tid] = c; }
    LDS_WAIT(); __syncthreads();
    if (F.tid == 0) { int s = 0; for (int e = 0; e < NE; ++e) { tb[e] = s; s += (tb[64 + e] + 255) >> 8; } tb[32] = s; }
    LDS_WAIT(); __syncthreads();
    for (int b = F.tid; b < NBLK_MAX; b += NWAVES * 64) { int e = 0; while (e < NE - 1 && tb[e + 1] <= b) ++e; tb[128 + b] = e; }
    LDS_WAIT(); __syncthreads();
}

__device__ __forceinline__ void conv_phase(Frame& F) {
    LAS unsigned* ut = (LAS unsigned*)(F.lds + RING_OFF);
    LAS float* co = (LAS float*)(F.lds + RING_OFF + 65536);
    const int cp = F.tid & 255, half = F.tid >> 8;
    float w0[CWID], w1[CWID];
    { const float* wd = F.in[I_W_DW] + 2 * cp;
#pragma unroll
        for (int j = 0; j < CWID; ++j) { const f32x2 w = *(const GAS f32x2*)(wd + j * CONV_CH); w0[j] = w.x; w1[j] = w.y; } }
    const f32x2 bd = *(const GAS f32x2*)(F.in[I_B_DW] + 2 * cp);
    const f32x4 g0 = *(const GAS f32x4*)(F.in[I_LN_CONV_G] + 8 * F.lane), g1 = *(const GAS f32x4*)(F.in[I_LN_CONV_G] + 8 * F.lane + 4);
    const f32x4 b0 = *(const GAS f32x4*)(F.in[I_LN_CONV_B] + 8 * F.lane), b1 = *(const GAS f32x4*)(F.in[I_LN_CONV_B] + 8 * F.lane + 4);
    bf16* MX = (bf16*)(F.ws + WS_MIXIN);
    for (int it = F.vcu; it < NB * (T_ / 32); it += F.G) {
        const int b = it / (T_ / 32), t0 = (it % (T_ / 32)) * 32;
        const bf16* U = (const bf16*)(F.ws + WS_U) + (size_t)b * T_ * CONV_CH;
        for (int idx = F.tid; idx < 62 * 64; idx += 512) { const int r = idx >> 6, c16 = idx & 63, t = t0 - 30 + r;
            u32x4 v = (u32x4){0u, 0u, 0u, 0u}; if (t >= 0) v = *(const GAS u32x4*)(U + (size_t)t * CONV_CH + c16 * 8);
            *(LAS u32x4*)(ut + r * 256 + c16 * 4) = v; }
        LDS_WAIT(); __syncthreads();
        { float a0[16], a1[16];
#pragma unroll
            for (int tt = 0; tt < 16; ++tt) { a0[tt] = bd.x; a1[tt] = bd.y; }
#pragma unroll
            for (int r = 0; r < 46; ++r) { const unsigned uu = ut[(half * 16 + r) * 256 + cp]; const float u0 = bflo(uu), u1 = bfhi(uu);
#pragma unroll
                for (int tt = 0; tt < 16; ++tt) { const int j = r - tt; if (j >= 0 && j < CWID) { a0[tt] += w0[j] * u0; a1[tt] += w1[j] * u1; } } }
#pragma unroll
            for (int tt = 0; tt < 16; ++tt) *(LAS f32x2*)(co + (half * 16 + tt) * CONV_CH + 2 * cp) = (f32x2){a0[tt], a1[tt]};
        }
        LDS_WAIT(); __syncthreads();
#pragma unroll
        for (int q = 0; q < 4; ++q) { const int tt = 4 * F.wave + q;
            f32x4 x0 = *(const LAS f32x4*)(co + tt * CONV_CH + 8 * F.lane), x1 = *(const LAS f32x4*)(co + tt * CONV_CH + 8 * F.lane + 4);
            const float mean = wave_sum((x0.x + x0.y) + (x0.z + x0.w) + (x1.x + x1.y) + (x1.z + x1.w)) * (1.f / CONV_CH);
            x0 = x0 - mean; x1 = x1 - mean;
            const float var = wave_sum((x0.x * x0.x + x0.y * x0.y) + (x0.z * x0.z + x0.w * x0.w) + (x1.x * x1.x + x1.y * x1.y) + (x1.z * x1.z + x1.w * x1.w)) * (1.f / CONV_CH);
            const float rstd = 1.f / sqrtf(var + LN_EPS);
            x0 = x0 * rstd * g0 + b0; x1 = x1 * rstd * g1 + b1;
            float y[8] = {x0.x, x0.y, x0.z, x0.w, x1.x, x1.y, x1.z, x1.w};
#pragma unroll
            for (int j = 0; j < 8; ++j) y[j] = y[j] * sigmoidf_fast(y[j]);
            *(GAS u32x4*)(MX + (size_t)(b * T_ + t0 + tt) * D + 8 * F.lane) = (u32x4){pk2(y[0], y[1]), pk2(y[2], y[3]), pk2(y[4], y[5]), pk2(y[6], y[7])}; }
        __syncthreads();
    }
}

typedef float f32x16 __attribute__((ext_vector_type(16)));
__device__ __forceinline__ int crow(int r, int hi) { return (r & 3) + 8 * (r >> 2) + 4 * hi; }
__device__ __forceinline__ bf16x8 pack8(const float* v) {
    u32x4 w; w.x = pg8::cvt_pk_bf16(v[0], v[1]); w.y = pg8::cvt_pk_bf16(v[2], v[3]); w.z = pg8::cvt_pk_bf16(v[4], v[5]); w.w = pg8::cvt_pk_bf16(v[6], v[7]);
    return __builtin_bit_cast(bf16x8, w); }
constexpr float SB_EXIT = 150.0f;
struct SbStage { u32x4 k[4], v[4]; };
__device__ __forceinline__ void sb_gload(SbStage& g, const bf16* Kt, const bf16* Vt, int lane) {
#pragma unroll
    for (int i = 0; i < 4; ++i) { const int c = (lane & 7) ^ ((4 * i + (lane >> 4)) & 7); g.k[i] = *(const GAS u32x4*)(Kt + (size_t)(8 * i) * SBW + 8 * c); }
#pragma unroll
    for (int i = 0; i < 4; ++i) g.v[i] = *(const GAS u32x4*)(Vt + (size_t)(16 * i) * M);
}
__device__ __forceinline__ void sb_lwrite(const SbStage& g, LAS unsigned char* buf, int lane) {
#pragma unroll
    for (int i = 0; i < 4; ++i) *(LAS u32x4*)(buf + 1024 * i + 16 * lane) = g.k[i];
#pragma unroll
    for (int i = 0; i < 4; ++i) *(LAS u32x4*)(buf + 4096 + 1024 * i + 16 * lane) = g.v[i];
}
__device__ __forceinline__ void sb_attn_wave(Frame& F, int b, int h, int qt) {
    const int c = F.lane & 31, hi = F.lane >> 5;
    const bf16* Q = (const bf16*)(F.ws + WS_Q); const bf16* Kb = (const bf16*)(F.ws + WS_K); const bf16* VT = (const bf16*)(F.ws + WS_V);
    LAS unsigned char* wbuf = F.lds + RING_OFF + F.wave * 16384;
    bf16x8 tri[2];
#pragma unroll
    for (int s = 0; s < 2; ++s) { bf16x8 t;
#pragma unroll
        for (int j = 0; j < 8; ++j) { const int k = 16 * s + 8 * (j >> 2) + 4 * hi + (j & 3); t[j] = (k >= c) ? (short)0xBF80 : (short)0; }
        tri[s] = t; }
    bf16x8 qf[4];
    { const bf16* qp = Q + ((size_t)b * T_ + 32 * qt + c) * SBW + h * SBD + 8 * hi;
#pragma unroll
        for (int s = 0; s < 4; ++s) qf[s] = *(const GAS bf16x8*)(qp + 16 * s); }
    const bf16* Ksrc = Kb + ((size_t)b * T_ + (F.lane >> 3)) * SBW + h * SBD;
    const bf16* Vsrc = VT + (size_t)(h * SBD + (F.lane >> 2)) * M + (size_t)b * T_ + 8 * ((F.lane & 3) ^ ((F.lane >> 4) & 3));

    const int ksw = (c >> 1) & 7, vsw = (c >> 2) & 3;

    f32x16 o0, o1;
#pragma unroll
    for (int r = 0; r < 16; ++r) { o0[r] = 0.f; o1[r] = 0.f; }
    float carry = 0.f;
    SbStage st;
    sb_gload(st, Ksrc + (size_t)(32 * qt) * SBW, Vsrc + 32 * qt, F.lane); sb_lwrite(st, wbuf, F.lane);
    for (int kt = qt; kt >= 0; --kt) {
        LAS unsigned char* buf = wbuf + ((qt - kt) & 1) * 8192;
        if (kt > 0) sb_gload(st, Ksrc + (size_t)(32 * (kt - 1)) * SBW, Vsrc + 32 * (kt - 1), F.lane);
        const bool diag = (kt == qt);
        bf16x8 kf[4];
#pragma unroll
        for (int s = 0; s < 4; ++s) kf[s] = *(const LAS bf16x8*)(buf + c * 128 + 16 * ((2 * s + hi) ^ ksw));
        f32x16 p;
#pragma unroll
        for (int r = 0; r < 16; ++r) p[r] = 0.f;
#pragma unroll
        for (int s = 0; s < 4; ++s) p = __builtin_amdgcn_mfma_f32_32x32x16_bf16(kf[s], qf[s], p, 0, 0, 0);
        u32x2 vv[2][2][2];
#pragma unroll
        for (int dt = 0; dt < 2; ++dt)
#pragma unroll
            for (int s = 0; s < 2; ++s)
#pragma unroll
                for (int q = 0; q < 2; ++q) vv[dt][s][q] = *(const LAS u32x2*)(buf + 4096 + (32 * dt + c) * 64 + 16 * ((2 * s + q) ^ vsw) + 8 * hi);
        float L[16];
#pragma unroll
        for (int r = 0; r < 16; ++r) { const float y = p[r]; float l = __builtin_amdgcn_logf(1.0f + __builtin_amdgcn_exp2f(y)); l = (y > 64.f) ? y : l;
            if (diag) l = (crow(r, hi) >= c) ? 0.f : l; L[r] = l; }
        const bf16x8 l0 = pack8(L), l1 = pack8(L + 8);
        f32x16 a;
#pragma unroll
        for (int r = 0; r < 16; ++r) a[r] = p[r] - carry;
        a = __builtin_amdgcn_mfma_f32_32x32x16_bf16(tri[0], l0, a, 0, 0, 0); a = __builtin_amdgcn_mfma_f32_32x32x16_bf16(tri[1], l1, a, 0, 0, 0);
        const float tot = p[0] - a[0];
        float w[16];
#pragma unroll
        for (int r = 0; r < 16; ++r) { float x = __builtin_amdgcn_exp2f(a[r]); if (diag) x = (crow(r, hi) >= c) ? 0.f : x; w[r] = x; }
        const bf16x8 p0 = pack8(w), p1 = pack8(w + 8);
        { const bf16x8 v00 = __builtin_bit_cast(bf16x8, (u32x4){vv[0][0][0].x, vv[0][0][0].y, vv[0][0][1].x, vv[0][0][1].y});
          const bf16x8 v01 = __builtin_bit_cast(bf16x8, (u32x4){vv[0][1][0].x, vv[0][1][0].y, vv[0][1][1].x, vv[0][1][1].y});
          const bf16x8 v10 = __builtin_bit_cast(bf16x8, (u32x4){vv[1][0][0].x, vv[1][0][0].y, vv[1][0][1].x, vv[1][0][1].y});
          const bf16x8 v11 = __builtin_bit_cast(bf16x8, (u32x4){vv[1][1][0].x, vv[1][1][0].y, vv[1][1][1].x, vv[1][1][1].y});
          o0 = __builtin_amdgcn_mfma_f32_32x32x16_bf16(v00, p0, o0, 0, 0, 0); o0 = __builtin_amdgcn_mfma_f32_32x32x16_bf16(v01, p1, o0, 0, 0, 0);
          o1 = __builtin_amdgcn_mfma_f32_32x32x16_bf16(v10, p0, o1, 0, 0, 0); o1 = __builtin_amdgcn_mfma_f32_32x32x16_bf16(v11, p1, o1, 0, 0, 0); }
        carry = __shfl(tot, c);
        if (__all(carry >= SB_EXIT)) break;
        if (kt > 0) sb_lwrite(st, wbuf + ((qt - kt + 1) & 1) * 8192, F.lane);
    }
    bf16* op = (bf16*)(F.ws + WS_MIXIN) + ((size_t)b * T_ + 32 * qt + c) * D + CONV_CH + h * SBD + 4 * hi;
#pragma unroll
    for (int g = 0; g < 4; ++g) {
        *(GAS u32x2*)(op + 8 * g) = (u32x2){pg8::cvt_pk_bf16(o0[4 * g], o0[4 * g + 1]), pg8::cvt_pk_bf16(o0[4 * g + 2], o0[4 * g + 3])};
        *(GAS u32x2*)(op + 32 + 8 * g) = (u32x2){pg8::cvt_pk_bf16(o1[4 * g], o1[4 * g + 1]), pg8::cvt_pk_bf16(o1[4 * g + 2], o1[4 * g + 3])}; }
}

__device__ __forceinline__ void resid_row(f32x4 (&v)[4], const bf16* hrow, const bf16* mrow, int lane) {
    f32x4 a[4]; load_row_bf16(v, hrow, lane); load_row_bf16(a, mrow, lane);
#pragma unroll
    for (int j = 0; j < 4; ++j) v[j] = v[j] * DN_ALPHA + a[j];
}
__device__ __forceinline__ void ln_phase(Frame& F, const float* g, const float* b) {
    const int gw = F.vcu * NWAVES + F.wave, NGW = F.G * NWAVES;
    for (int m = gw; m < M; m += NGW) { f32x4 v[4]; bf16* hrow = (bf16*)(F.ws + WS_HB) + (size_t)m * D; resid_row(v, hrow, (const bf16*)(F.ws + WS_QM) + (size_t)m * D, F.lane);
        ln_row(v, g, b, F.lane); store_row_bf16(v, hrow, F.lane);
        { GAS unsigned* h8 = (GAS unsigned*)(F.ws + WS_HB8 + (size_t)m * D) + F.lane;
#pragma unroll
            for (int j = 0; j < 4; ++j) h8[64 * j] = pk4_fp8(v[j].x, v[j].y, v[j].z, v[j].w); } }
}
__device__ __forceinline__ void softmax_phase(Frame& F) {
    const int gw = F.vcu * NWAVES + F.wave, NGW = F.G * NWAVES;
    for (int m = gw; m < M; m += NGW) { GAS u32x2* p = (GAS u32x2*)((bf16*)(F.ws + WS_SP) + (size_t)m * D) + F.lane;
#pragma unroll
        for (int j = 0; j < 4; ++j) { const u32x2 w = p[64 * j]; float x0 = bflo(w.x), x1 = bfhi(w.x), x2 = bflo(w.y), x3 = bfhi(w.y);
            const float mx = wave_max(fmaxf(fmaxf(x0, x1), fmaxf(x2, x3)));
            x0 = __builtin_amdgcn_exp2f(x0 - mx); x1 = __builtin_amdgcn_exp2f(x1 - mx); x2 = __builtin_amdgcn_exp2f(x2 - mx); x3 = __builtin_amdgcn_exp2f(x3 - mx);
            const float inv = 1.0f / wave_sum((x0 + x1) + (x2 + x3));
            p[64 * j] = (u32x2){pk2(x0 * inv, x1 * inv), pk2(x2 * inv, x3 * inv)}; } }
}
__device__ __forceinline__ void xattn_phase(Frame& F) {
    LAS unsigned char* tb0 = F.lds + RING_OFF;
    const bf16* QM = (const bf16*)(F.ws + WS_QM); const bf16* KM = (const bf16*)(F.ws + WS_KM); const bf16* VMT = (const bf16*)(F.ws + WS_VMT); bf16* OB = (bf16*)(F.ws + WS_OB);
    const int c = F.lane & 31, h5 = F.lane >> 5;
    const int tr = F.tid >> 5, tc = F.tid & 31;
    const int kr = F.tid >> 4, kc = F.tid & 15;
    for (int u = F.vcu; u < NB * 4 * 16; u += F.G) {
        const int b = u >> 6, h = (u >> 4) & 3, qt = u & 15;
        const size_t rowq = (size_t)b * T_ + 256 * qt + 32 * F.wave + c;
        const bf16* qp = QM + rowq * D + h * 256 + 8 * h5;
        const bf16* ksrc = KM + ((size_t)b * NMEM + kr) * D + h * 256 + 8 * kc;
        const int kw0 = kr * 272 + kc * 16, kw1 = (kr + 32) * 272 + kc * 16;
        const bf16* vsrc = VMT + ((size_t)h * 256 + tr) * (size_t)MM + (size_t)b * NMEM + 8 * tc;
        int vw[4];
#pragma unroll
        for (int j = 0; j < 4; ++j) vw[j] = (tr + 16 * j) * 528 + tc * 16;
        u32x4 st[4];
        __syncthreads();
        st[0] = *(const GAS u32x4*)ksrc; st[1] = *(const GAS u32x4*)(ksrc + (size_t)32 * D);
        *(LAS u32x4*)(tb0 + kw0) = st[0]; *(LAS u32x4*)(tb0 + kw1) = st[1];
        LDS_WAIT(); __syncthreads();
        f32x16 sacc[8];
#pragma unroll
        for (int dh = 0; dh < 2; ++dh) {
            bf16x8 qf[8];
#pragma unroll
            for (int s_ = 0; s_ < 8; ++s_) qf[s_] = *(const GAS bf16x8*)(qp + 128 * dh + 16 * s_);
#pragma unroll
            for (int kp = 0; kp < 4; ++kp) { const int i = dh * 4 + kp;
                LAS unsigned char* buf = tb0 + (i & 1) * 34816; LAS unsigned char* nbuf = tb0 + ((i + 1) & 1) * 34816;
                if (i < 7) { const bf16* p = ksrc + (size_t)(64 * ((i + 1) & 3)) * D + 128 * ((i + 1) >> 2); st[0] = *(const GAS u32x4*)p; st[1] = *(const GAS u32x4*)(p + (size_t)32 * D); }
                else {
#pragma unroll
                    for (int j = 0; j < 4; ++j) st[j] = *(const GAS u32x4*)(vsrc + (size_t)(16 * j) * MM); }
#pragma unroll
                for (int k2 = 0; k2 < 2; ++k2) { const int kt = 2 * kp + k2;
                    f32x16 a;
                    if (dh == 0) {
#pragma unroll
                        for (int r = 0; r < 16; ++r) a[r] = 0.f; }
                    else a = sacc[kt];
#pragma unroll
                    for (int s_ = 0; s_ < 8; ++s_) { const bf16x8 kf = *(const LAS bf16x8*)(buf + c * 272 + h5 * 16 + (32 * k2 * 272 + 32 * s_)); a = __builtin_amdgcn_mfma_f32_32x32x16_bf16(kf, qf[s_], a, 0, 0, 0); }
                    sacc[kt] = a; }
                if (i < 7) { *(LAS u32x4*)(nbuf + kw0) = st[0]; *(LAS u32x4*)(nbuf + kw1) = st[1]; }
                else {
#pragma unroll
                    for (int j = 0; j < 4; ++j) *(LAS u32x4*)(nbuf + vw[j]) = st[j]; }
                LDS_WAIT(); __syncthreads();
            }
        }
        float mx = sacc[0][0];
#pragma unroll
        for (int kt = 0; kt < 8; ++kt)
#pragma unroll
            for (int r = 0; r < 16; ++r) mx = fmaxf(mx, sacc[kt][r]);
        mx = fmaxf(mx, __shfl_xor(mx, 32));
        float sum = 0.f; bf16x8 pb[8][2];
#pragma unroll
        for (int kt = 0; kt < 8; ++kt) { float p[16];
#pragma unroll
            for (int r = 0; r < 16; ++r) { p[r] = __builtin_amdgcn_exp2f(sacc[kt][r] - mx); sum += p[r]; }
            pb[kt][0] = pack8(p); pb[kt][1] = pack8(p + 8); }
        sum += __shfl_xor(sum, 32);
        const float inv = OB_SC / sum;
        unsigned char* op = (unsigned char*)OB + rowq * D + h * 256 + 4 * h5;
        for (int dp = 0; dp < 4; ++dp) {
            LAS unsigned char* buf = tb0 + (dp & 1) * 34816; LAS unsigned char* nbuf = tb0 + ((dp + 1) & 1) * 34816;
            if (dp < 3) {
#pragma unroll
                for (int j = 0; j < 4; ++j) st[j] = *(const GAS u32x4*)(vsrc + (size_t)(64 * (dp + 1) + 16 * j) * MM); }
#pragma unroll
            for (int d2 = 0; d2 < 2; ++d2) { const int dt = 2 * dp + d2;
                f32x16 o;
#pragma unroll
                for (int r = 0; r < 16; ++r) o[r] = 0.f;
#pragma unroll
                for (int kt = 0; kt < 8; ++kt)
#pragma unroll
                    for (int s2 = 0; s2 < 2; ++s2) { const LAS unsigned char* rp = buf + c * 528 + 8 * h5 + (32 * d2 * 528 + (4 * kt + 2 * s2) * 16);
                        const u32x2 v0 = *(const LAS u32x2*)rp, v1 = *(const LAS u32x2*)(rp + 16);
                        o = __builtin_amdgcn_mfma_f32_32x32x16_bf16(__builtin_bit_cast(bf16x8, (u32x4){v0.x, v0.y, v1.x, v1.y}), pb[kt][s2], o, 0, 0, 0); }
#pragma unroll
                for (int g = 0; g < 4; ++g) *(GAS unsigned*)(op + 32 * dt + 8 * g) = pk4_fp8(o[4 * g] * inv, o[4 * g + 1] * inv, o[4 * g + 2] * inv, o[4 * g + 3] * inv); }
            if (dp < 3) {
#pragma unroll
                for (int j = 0; j < 4; ++j) *(LAS u32x4*)(nbuf + vw[j]) = st[j]; }
            LDS_WAIT(); __syncthreads();
        }
    }
}
typedef float f32x4v __attribute__((ext_vector_type(4)));
__device__ __forceinline__ void ln2_router_phase(Frame& F) {
    LAS bf16* wr = (LAS bf16*)(F.lds + P10_WR);
    LAS float* gb = (LAS float*)(F.lds + P10_GB);
    LAS int* lcnt = (LAS int*)(F.lds + P10_LCNT);
    LAS int* rec = (LAS int*)(F.lds + P10_REC);
    for (int i = F.tid; i < 2 * 32 * WR_STRIDE * 2 / 16; i += 512) *(LAS u32x4*)(F.lds + P10_WR + 16 * i) = *(const GAS u32x4*)(F.ws + WS_WR + 16 * i);
    for (int i = F.tid; i < 512; i += 512) { *(LAS f32x4*)(gb + 4 * i) = ((const GAS f32x4*)(i < 256 ? F.in[I_LN2_G] : F.in[I_LN2_B]))[i & 255]; }
    if (F.tid < 64) lcnt[F.tid] = 0;
    LDS_WAIT(); __syncthreads();
    const bf16* H1 = (const bf16*)(F.ws + WS_HB); const bf16* CA = (const bf16*)(F.ws + WS_QM); bf16* H2 = (bf16*)(F.ws + WS_HB2);
    int* ltok = (int*)(F.ws + WS_LTOK); float* lgate = (float*)(F.ws + WS_LGATE); int* sidx = (int*)(F.ws + WS_SIDX);
    const int fr = F.lane & 15, fq = F.lane >> 4;
    for (int rb = F.vcu; rb < M / 128; rb += F.G) {
        const int m0 = rb * 128 + F.wave * 16;
        float mymean = 0.f, myrstd = 0.f;
        for (int i = 0; i < 16; ++i) { const int m = m0 + i;
            f32x4 v[4]; resid_row(v, H1 + (size_t)m * D, CA + (size_t)m * D, F.lane);
            float s1 = 0.f;
#pragma unroll
            for (int j = 0; j < 4; ++j) s1 += (v[j].x + v[j].y) + (v[j].z + v[j].w);
            const float mean = wave_sum(s1) * (1.f / D); float s2 = 0.f;
#pragma unroll
            for (int j = 0; j < 4; ++j) { v[j] = v[j] - mean; s2 += (v[j].x * v[j].x + v[j].y * v[j].y) + (v[j].z * v[j].z + v[j].w * v[j].w); }
            const float rstd = 1.f / sqrtf(wave_sum(s2) * (1.f / D) + LN_EPS);
            if (fr == i) { mymean = mean; myrstd = rstd; }
#pragma unroll
            for (int j = 0; j < 4; ++j) { const f32x4 gg = *(const LAS f32x4*)(gb + 4 * F.lane + 256 * j), bb = *(const LAS f32x4*)(gb + 1024 + 4 * F.lane + 256 * j); v[j] = v[j] * rstd * gg + bb; }
            store_row_bf16(v, H2 + (size_t)m * D, F.lane);
            { GAS unsigned* h8 = (GAS unsigned*)(F.ws + WS_HB8 + (size_t)m * D) + F.lane;
#pragma unroll
                for (int j = 0; j < 4; ++j) h8[64 * j] = pk4_fp8(v[j].x, v[j].y, v[j].z, v[j].w); }
        }
        f32x4v acc0 = {0.f, 0.f, 0.f, 0.f}, acc1 = {0.f, 0.f, 0.f, 0.f};
        { const bf16* hp = H1 + (size_t)(m0 + fr) * D + 8 * fq; const bf16* cp = CA + (size_t)(m0 + fr) * D + 8 * fq;
            const LAS bf16* wp = wr + fr * WR_STRIDE + 8 * fq; const LAS float* gp = gb + 8 * fq;
            const float sc = myrstd, sh = -mymean * myrstd;
#pragma unroll 2
            for (int s_ = 0; s_ < 32; ++s_) {
                const u32x4 hv = *(const GAS u32x4*)(hp + 32 * s_), cv = *(const GAS u32x4*)(cp + 32 * s_);
                const f32x4 g0 = *(const LAS f32x4*)(gp + 32 * s_), g1 = *(const LAS f32x4*)(gp + 32 * s_ + 4), b0 = *(const LAS f32x4*)(gp + 1024 + 32 * s_), b1 = *(const LAS f32x4*)(gp + 1024 + 32 * s_ + 4);
                float x[8];
                x[0] = bflo(hv.x) * DN_ALPHA + bflo(cv.x); x[1] = bfhi(hv.x) * DN_ALPHA + bfhi(cv.x); x[2] = bflo(hv.y) * DN_ALPHA + bflo(cv.y); x[3] = bfhi(hv.y) * DN_ALPHA + bfhi(cv.y);
                x[4] = bflo(hv.z) * DN_ALPHA + bflo(cv.z); x[5] = bfhi(hv.z) * DN_ALPHA + bfhi(cv.z); x[6] = bflo(hv.w) * DN_ALPHA + bflo(cv.w); x[7] = bfhi(hv.w) * DN_ALPHA + bfhi(cv.w);
                const float gg[8] = {g0.x, g0.y, g0.z, g0.w, g1.x, g1.y, g1.z, g1.w}, bb[8] = {b0.x, b0.y, b0.z, b0.w, b1.x, b1.y, b1.z, b1.w};
                float lo[8]; unsigned hp2[4];
#pragma unroll
                for (int j = 0; j < 8; ++j) x[j] = (x[j] * sc + sh) * gg[j] + bb[j];
#pragma unroll
                for (int j = 0; j < 4; ++j) { hp2[j] = pg8::cvt_pk_bf16(x[2 * j], x[2 * j + 1]); lo[2 * j] = x[2 * j] - bflo(hp2[j]); lo[2 * j + 1] = x[2 * j + 1] - bfhi(hp2[j]); }
                const bf16x8 bhi = __builtin_bit_cast(bf16x8, (u32x4){hp2[0], hp2[1], hp2[2], hp2[3]});
                const bf16x8 blo = pack8(lo);
                const bf16x8 wh0 = *(const LAS bf16x8*)(wp + 32 * s_), wh1 = *(const LAS bf16x8*)(wp + 16 * WR_STRIDE + 32 * s_);
                const bf16x8 wl0 = *(const LAS bf16x8*)(wp + 32 * WR_STRIDE + 32 * s_), wl1 = *(const LAS bf16x8*)(wp + 48 * WR_STRIDE + 32 * s_);
                acc0 = __builtin_amdgcn_mfma_f32_16x16x32_bf16(wh0, bhi, acc0, 0, 0, 0); acc1 = __builtin_amdgcn_mfma_f32_16x16x32_bf16(wh1, bhi, acc1, 0, 0, 0);
                acc0 = __builtin_amdgcn_mfma_f32_16x16x32_bf16(wh0, blo, acc0, 0, 0, 0); acc1 = __builtin_amdgcn_mfma_f32_16x16x32_bf16(wh1, blo, acc1, 0, 0, 0);
                acc0 = __builtin_amdgcn_mfma_f32_16x16x32_bf16(wl0, bhi, acc0, 0, 0, 0); acc1 = __builtin_amdgcn_mfma_f32_16x16x32_bf16(wl1, bhi, acc1, 0, 0, 0);
            } }
        float cand[8]; int eid[8];
        { const f32x4 br0 = *(const GAS f32x4*)(F.in[I_B_ROUTER] + 4 * fq), br1 = *(const GAS f32x4*)(F.in[I_B_ROUTER] + 16 + 4 * fq);
#pragma unroll
            for (int r = 0; r < 4; ++r) { cand[r] = acc0[r] + br0[r]; cand[4 + r] = acc1[r] + br1[r]; eid[r] = 4 * fq + r; eid[4 + r] = 16 + 4 * fq + r; } }
        float tv[TOPK]; int te[TOPK];
#pragma unroll
        for (int k = 0; k < TOPK; ++k) {
            float bv = cand[0]; int bi = eid[0];
#pragma unroll
            for (int r = 1; r < 8; ++r) if (cand[r] > bv) { bv = cand[r]; bi = eid[r]; }
#pragma unroll
            for (int o = 16; o <= 32; o <<= 1) { const float ov = __shfl_xor(bv, o); const int oi = __shfl_xor(bi, o); if (ov > bv || (ov == bv && oi < bi)) { bv = ov; bi = oi; } }
            tv[k] = bv; te[k] = bi;
#pragma unroll
            for (int r = 0; r < 8; ++r) if (eid[r] == bi) cand[r] = -INFINITY;
        }
        float pe[TOPK], ps = 0.f;
#pragma unroll
        for (int k = 0; k < TOPK; ++k) { pe[k] = __expf(tv[k] - tv[0]); ps += pe[k]; }
        if (fq == 0) {
#pragma unroll
            for (int k = 0; k < TOPK; ++k) { const int lr = __hip_atomic_fetch_add(lcnt + te[k], 1, __ATOMIC_RELAXED, __HIP_MEMORY_SCOPE_WORKGROUP);
                LAS int* r = rec + ((F.wave * 16 + fr) * 4 + k) * 4; r[0] = te[k]; r[1] = lr; r[2] = __builtin_bit_cast(int, pe[k] / ps); r[3] = m0 + fr; } }
        LDS_WAIT(); __syncthreads();
        if (F.tid < NE) lcnt[32 + F.tid] = (int)__hip_atomic_fetch_add(F.ctl + CW_ECNT + 64 * F.tid, (unsigned)lcnt[F.tid], RLX_AGENT);
        LDS_WAIT(); __syncthreads();
        { const LAS int* r = rec + (F.wave * 64 + F.lane) * 4; const int e = r[0], pos = lcnt[32 + e] + r[1], tok = r[3];
            if (pos < LCAP) { ltok[e * LCAP + pos] = tok; lgate[e * LCAP + pos] = __builtin_bit_cast(float, r[2]); } sidx[tok * 4 + (F.lane & 3)] = e * LCAP + pos; }
        __syncthreads();
        if (F.tid < 64) lcnt[F.tid] = 0;
        LDS_WAIT(); __syncthreads();
    }
}
__device__ __forceinline__ void final_phase(Frame& F, const LAS int* tb) {
    const int gw = F.vcu * NWAVES + F.wave, NGW = F.G * NWAVES;
    const int* sidx = (const int*)(F.ws + WS_SIDX); const bf16* YS = (const bf16*)(F.ws + WS_YS);
    for (int m = gw; m < M; m += NGW) { f32x4 v[4]; load_row_bf16(v, (const bf16*)(F.ws + WS_HB2) + (size_t)m * D, F.lane);
#pragma unroll
        for (int j = 0; j < 4; ++j) v[j] = v[j] * DN_ALPHA;
        f32x4 s[4];
#pragma unroll
        for (int j = 0; j < 4; ++j) s[j] = (f32x4){0.f, 0.f, 0.f, 0.f};
#pragma unroll
        for (int k = 0; k < TOPK; ++k) { const int si = sidx[m * 4 + k], e = si / LCAP, pos = si - e * LCAP; const size_t slot = (size_t)tb[e] * 256 + pos;
            const GAS u32x2* yp = (const GAS u32x2*)(YS + slot * D) + F.lane;
#pragma unroll
            for (int j = 0; j < 4; ++j) { const u32x2 w = yp[64 * j]; s[j] = s[j] + (f32x4){bflo(w.x), bfhi(w.x), bflo(w.y), bfhi(w.y)}; } }
#pragma unroll
        for (int j = 0; j < 4; ++j) v[j] = v[j] + s[j];
        ln_row(v, F.in[I_LN3_G], F.in[I_LN3_B], F.lane); store_row_f32(v, F.hf + (size_t)m * D, F.lane); }
}

struct Args { const float* in[N_IN]; float* out; unsigned char* ws; int ph_lo, ph_hi, li, pad; };
__global__ void __launch_bounds__(NWAVES * 64, 2) mk_fwd(Args args) {
    extern __shared__ __attribute__((aligned(16))) unsigned char lds[];
    Frame F;
    F.lds = (LAS unsigned char*)lds; F.MISC = (volatile LAS unsigned*)(F.lds + MISC_OFF);
    F.tid = threadIdx.x; F.lane = F.tid & 63; F.wave = __builtin_amdgcn_readfirstlane(F.tid >> 6);
    F.G = gridDim.x; { const int bx = blockIdx.x; F.vcu = (F.G % 8 == 0) ? (bx % 8) * (F.G / 8) + bx / 8 : bx; }
    F.ws = args.ws; F.ctl = (gu32*)(args.ws + WS_CTL); F.hf = args.out; F.in = args.in;
    for (int u = F.tid; u < (LDS_BYTES - LDSCTL_OFF) / 4; u += NWAVES * 64) ((LAS unsigned*)(F.lds + LDSCTL_OFF))[u] = 0u;
    __syncthreads();
    XcdBarrier bar; bar.bar = (unsigned*)(F.ctl + CW_BAR) + args.li * XCD_BAR_WORDS; bar.x = 0; bar.st = nullptr;
    const int lo = args.ph_lo, hi = args.ph_hi;
    if (hi - lo > 1) bar = xcd_barrier_post((unsigned*)(F.ctl + CW_BAR) + args.li * XCD_BAR_WORDS, F.MISC + 8);
#ifndef PH_MASK
#define PH_MASK 0xfff
#endif
#define IN(k) (((PH_MASK >> (k)) & 1) && lo <= (k) && (k) < hi)
#ifndef REP_MASK
#define REP_MASK 0
#endif
#define REPS(k) (1 + ((REP_MASK >> (k)) & 1))
#define PH_BEGIN() do { int t_ = threadIdx.x; asm volatile("" : "+v"(t_)); F.tid = t_; F.lane = t_ & 63; } while (0)
#define SEAM(k) do { if (IN(k) && IN((k) + 1)) xcd_barrier(bar); } while (0)
    const char* wsb = (const char*)args.ws;
    LAS int* tb = (LAS int*)(F.lds + TB_OFF);

    if (IN(0)) for (int rep = 0; rep < REPS(0); ++rep) { PH_BEGIN(); p0_prologue(F); __syncthreads(); } SEAM(0);
    if (IN(1)) for (int rep = 0; rep < REPS(1); ++rep) { PH_BEGIN(); SchedP1 S{F.G, (int)blockIdx.x}; EpiP1 E{F.ws, F.in[I_B_IN]};
        pg8::gemm_phase<EpiP1, SchedP1, false>(F.lds + RING_OFF, wsb, D, D, D, S, E, nullptr); } SEAM(1);
    if (IN(2)) for (int rep = 0; rep < REPS(2); ++rep) { PH_BEGIN();
        if (!(args.pad & 1)) conv_phase(F);
        if (args.pad & 2) continue;
        const int gw = F.vcu * NWAVES + F.wave;
        for (int tk = gw; tk < NB * SBH * (T_ / 32); tk += F.G * NWAVES) sb_attn_wave(F, (tk >> 7) >> 3, (tk >> 7) & 7, tk & 127);
    } SEAM(2);
    if (IN(3)) { PH_BEGIN(); SchedPlain S{F.G, (int)blockIdx.x, 128, 4, (unsigned)WS_MIXIN, (unsigned)WS_WOUT_T, TSTEP, TSTEP, 0u, 0u, 0u}; EpiBf16 E{(bf16*)(F.ws + WS_QM), D, 1.0f, F.in[I_B_OUT]};
        pg8::gemm_phase<EpiBf16, SchedPlain, false>(F.lds + RING_OFF, wsb, D, D, D, S, E, nullptr); } SEAM(3);
    if (IN(4)) { PH_BEGIN(); ln_phase(F, F.in[I_LN1_G], F.in[I_LN1_B]); } SEAM(4);
    if (IN(5)) { PH_BEGIN(); SchedPlain S{F.G, (int)blockIdx.x, 128, 4, (unsigned)WS_HB8, (unsigned)WS_WQ_T, TSTEP / 2, TSTEP / 2, 0u, 0u, 0u}; EpiBf16 E{(bf16*)(F.ws + WS_QM), D, MEM_QSCALE / WQ_SC, nullptr};
        pg8::gemm_phase<EpiBf16, SchedPlain, false, true>(F.lds + RING_OFF, wsb, D / 2, D / 2, D / 2, S, E, nullptr); } SEAM(5);
    if (IN(6)) { PH_BEGIN(); xattn_phase(F); } SEAM(6);
    if (IN(7)) { PH_BEGIN(); SchedPlain S{F.G, (int)blockIdx.x, 128, 4, (unsigned)WS_OB, (unsigned)WS_WO_T, TSTEP / 2, TSTEP / 2, 0u, 0u, 0u}; EpiBf16 E{(bf16*)(F.ws + WS_QM), D, 1.0f / (WO_SC * OB_SC), nullptr};
        pg8::gemm_phase<EpiBf16, SchedPlain, false, true>(F.lds + RING_OFF, wsb, D / 2, D / 2, D / 2, S, E, nullptr); } SEAM(7);
    if (IN(8)) { PH_BEGIN(); ln2_router_phase(F); } SEAM(8);
    if (IN(9)) for (int rep = 0; rep < REPS(9); ++rep) { PH_BEGIN(); moe_table(F, tb); SchedMoe S{F.G, (int)blockIdx.x, 8, tb, (unsigned)WS_HB8, (unsigned)WS_WGU_T, 2048u * 1024u, true}; EpiAct E{F.ws + WS_ACT, F.in[I_B_GU]};
        pg8::gemm_phase<EpiAct, SchedMoe, true, true>(F.lds + RING_OFF, wsb, D / 2, D / 2, D / 2, S, E, (const int*)(F.ws + WS_LTOK)); } SEAM(9);
    if (IN(10)) for (int rep = 0; rep < REPS(10); ++rep) { PH_BEGIN(); moe_table(F, tb); SchedMoe S{F.G, (int)blockIdx.x, 4, tb, (unsigned)WS_ACT, (unsigned)WS_WDN_T, 1024u * 1024u, false}; EpiDown E{(bf16*)(F.ws + WS_YS), F.in[I_B_DOWN], (const float*)(F.ws + WS_LGATE)};
        pg8::gemm_phase<EpiDown, SchedMoe, false, true>(F.lds + RING_OFF, wsb, D / 2, D / 2, D / 2, S, E, nullptr); } SEAM(10);
    if (IN(11)) { PH_BEGIN(); moe_table(F, tb); final_phase(F, tb); }
#undef IN
#undef SEAM
}

extern "C" void kernel_launch(void* const* d_in, const int* in_sizes, int n_in, void* d_out, int out_size, void* d_ws, size_t ws_size, hipStream_t stream) {
    static int grid = 0;
    if (grid == 0) {
        if (n_in != N_IN || out_size != M * D || ws_size < WS_END) { fprintf(stderr, "kernel_launch: unexpected shapes (n_in %d, out %d, ws %zu)\n", n_in, out_size, ws_size); grid = -1; return; }
        int dev = 0, cus = 0, per_cu = 0;
        if (hipGetDevice(&dev) != hipSuccess || hipDeviceGetAttribute(&cus, hipDeviceAttributeMultiprocessorCount, dev) != hipSuccess) { grid = -1; return; }
        if (hipFuncSetAttribute((const void*)mk_fwd, hipFuncAttributeMaxDynamicSharedMemorySize, LDS_BYTES) != hipSuccess) { fprintf(stderr, "kernel_launch: hipFuncSetAttribute failed\n"); grid = -1; return; }
        if (hipOccupancyMaxActiveBlocksPerMultiprocessor(&per_cu, (const void*)mk_fwd, NWAVES * 64, LDS_BYTES) != hipSuccess || per_cu < 1) fprintf(stderr, "kernel_launch: occupancy query says %d\n", per_cu);
        (void)hipGetLastError();
        grid = cus;
    }
    if (grid < 0) return;
    if (hipMemsetAsync((char*)d_ws + WS_CTL, 0, CTL_ZERO_BYTES, stream) != hipSuccess) return;
    Args a{};
    for (int i = 0; i < N_IN; ++i) a.in[i] = (const float*)d_in[i];
    a.out = (float*)d_out; a.ws = (unsigned char*)d_ws;
#ifdef PROBE_P2
    { a.ph_lo = 0; a.ph_hi = 3; a.li = 0; hipLaunchKernelGGL(mk_fwd, dim3(grid), dim3(NWAVES * 64), LDS_BYTES, stream, a);
      a.ph_lo = 2; a.ph_hi = 3; a.li = 1; a.pad = PROBE_P2; hipLaunchKernelGGL(mk_fwd, dim3(grid), dim3(NWAVES * 64), LDS_BYTES, stream, a); a.pad = 0;
      a.ph_lo = 3; a.ph_hi = NPHASE; a.li = 2; hipLaunchKernelGGL(mk_fwd, dim3(grid), dim3(NWAVES * 64), LDS_BYTES, stream, a); return; }
#endif
    for (int li = 0; li < MK_N_LAUNCHES; ++li) {
        a.ph_lo = (MK_N_LAUNCHES == 1) ? 0 : li; a.ph_hi = (MK_N_LAUNCHES == 1) ? NPHASE : li + 1; a.li = (MK_N_LAUNCHES == 1) ? 0 : li;
        hipLaunchKernelGGL(mk_fwd, dim3(grid), dim3(NWAVES * 64), LDS_BYTES, stream, a);
        if (hipPeekAtLastError() != hipSuccess) { fprintf(stderr, "kernel_launch: launch %d failed\n", li); break; }
    }
#ifdef PROBE_PHASES
    { const int pp[] = {PROBE_PHASES}; for (int ph : pp) { a.ph_lo = ph; a.ph_hi = ph + 1; a.li = 15; hipLaunchKernelGGL(mk_fwd, dim3(grid), dim3(NWAVES * 64), LDS_BYTES, stream, a); } }
#endif
}
```

```cpp
#include <hip/hip_runtime.h>
#include <cstdio>
#include <cstdint>

#ifndef MK_N_LAUNCHES
#define MK_N_LAUNCHES 1
#endif

#define GAS __attribute__((address_space(1)))
#define LAS __attribute__((address_space(3)))
typedef unsigned short bf16;
typedef short bf16x8 __attribute__((ext_vector_type(8)));
typedef float f32x4 __attribute__((ext_vector_type(4)));
typedef float f32x2 __attribute__((ext_vector_type(2)));
typedef unsigned u32x4 __attribute__((ext_vector_type(4)));
typedef unsigned u32x2 __attribute__((ext_vector_type(2)));
typedef GAS unsigned gu32;
#define RLX_AGENT __ATOMIC_RELAXED, __HIP_MEMORY_SCOPE_AGENT
#define LDS_WAIT() asm volatile("s_waitcnt lgkmcnt(0)" ::: "memory")
#define VM_WAIT() asm volatile("s_waitcnt vmcnt(0)" ::: "memory")

constexpr int NB = 8, T_ = 4096, D = 1024, M = NB * T_, NMEM = 256, MM = NB * NMEM;
constexpr int CONV_CH = 512, SBH = 8, SBD = 64, SBW = 512, CWID = 31, NE = 32, TOPK = 4, DFF = 1024;
constexpr int INC = 2560;
constexpr float LN_EPS = 1e-5f;
constexpr float DN_ALPHA = 1.189207115002721f;
constexpr float LOG2E = 1.4426950408889634f;
constexpr float SB_QSCALE = 0.125f * LOG2E;
constexpr float MEM_QSCALE = 0.0625f * LOG2E;
constexpr float WGU_SC = 32.0f, WDN_SC = 64.0f, WQ_SC = 32.0f, WO_SC = 64.0f, OB_SC = 16.0f, YS_SC = 16.0f;
constexpr float WGU_SC_UNUSED = 0.f;
constexpr int NBLK_MAX = M * TOPK / 256 + NE;
constexpr int LCAP = M;

constexpr size_t MiB = 1u << 20;
constexpr size_t WS_CTL = 0, CTL_ZERO_BYTES = 1 * MiB;
constexpr size_t WS_WIN_T = 1 * MiB;
constexpr size_t WS_WOUT_T = 6 * MiB;
constexpr size_t WS_WQ_T = 8 * MiB, WS_WK_T = 10 * MiB, WS_WV_T = 12 * MiB, WS_WO_T = 14 * MiB;
constexpr size_t WS_WGU_T = 16 * MiB;
constexpr size_t WS_WDN_T = 144 * MiB;
constexpr size_t WS_HB8 = 176 * MiB;
constexpr size_t WS_HB = 208 * MiB;
constexpr size_t WS_LTOK = 272 * MiB;
constexpr size_t WS_LGATE = 276 * MiB;
constexpr size_t WS_SIDX = 280 * MiB;
constexpr size_t WS_WR = 281 * MiB;
constexpr size_t WS_HB2 = 832 * MiB;
constexpr size_t WS_X = 288 * MiB;
constexpr size_t WS_U = WS_X;
constexpr size_t WS_Q = WS_X + 32 * MiB;
constexpr size_t WS_K = WS_X + 64 * MiB;
constexpr size_t WS_V = WS_X + 96 * MiB;
constexpr size_t WS_MIXIN = WS_X + 128 * MiB;
constexpr size_t WS_QM = WS_X + 192 * MiB;
constexpr size_t WS_SP = WS_X + 256 * MiB;
constexpr size_t WS_OB = WS_X + 320 * MiB;
constexpr size_t WS_MEMN = WS_X + 384 * MiB;
constexpr size_t WS_KM = WS_X + 388 * MiB;
constexpr size_t WS_VMT = WS_X + 392 * MiB;
constexpr size_t WS_ACT = WS_X;
constexpr size_t WS_YS = WS_X + 272 * MiB;
constexpr size_t WS_END = 896 * MiB;
constexpr int CW_TMO = 0, CW_CODE = 1;
constexpr int CW_BAR = 4096;
constexpr int CW_ECNT = 131072;
constexpr int NPHASE = 12;

constexpr int RING_OFF = 0, RING_BYTES = 131072;
constexpr int LDS_BYTES = 163840;
constexpr int LDSCTL_OFF = LDS_BYTES - 1024, MISC_OFF = LDSCTL_OFF + 320;
constexpr int XTRA_OFF = RING_BYTES;
constexpr int TB_OFF = XTRA_OFF + 20480;
constexpr int WR_STRIDE = 1032;
constexpr int P10_WR = 0, P10_GB = 2 * 32 * WR_STRIDE * 2, P10_LCNT = P10_GB + 8192, P10_REC = P10_LCNT + 512;
static_assert(P10_REC + 8192 <= TB_OFF && TB_OFF + 4 * (128 + 544) <= LDSCTL_OFF, "LDS map");
constexpr int NWAVES = 8;

__device__ __forceinline__ unsigned f2bf(float f) { unsigned u = __builtin_bit_cast(unsigned, f); return (u + 0x7fffu + ((u >> 16) & 1u)) >> 16; }
__device__ __forceinline__ unsigned pk2(float lo, float hi) { return f2bf(lo) | (f2bf(hi) << 16); }
__device__ __forceinline__ float bflo(unsigned u) { return __builtin_bit_cast(float, u << 16); }
__device__ __forceinline__ float bfhi(unsigned u) { return __builtin_bit_cast(float, u & 0xffff0000u); }
__device__ __forceinline__ float wave_sum(float v) {
#pragma unroll
    for (int o = 1; o < 64; o <<= 1) v += __shfl_xor(v, o);
    return v;
}
__device__ __forceinline__ float wave_max(float v) {
#pragma unroll
    for (int o = 1; o < 64; o <<= 1) v = fmaxf(v, __shfl_xor(v, o));
    return v;
}
__device__ __forceinline__ unsigned pk4_fp8(float a, float b, float c, float d) {
    int r = __builtin_amdgcn_cvt_pk_fp8_f32(a, b, 0, false); r = __builtin_amdgcn_cvt_pk_fp8_f32(c, d, r, true); return (unsigned)r; }
__device__ __forceinline__ float sigmoidf_fast(float x) { return __builtin_amdgcn_rcpf(1.0f + __expf(-x)); }

namespace pg8 {
constexpr int BM = 256, BK = 64, HALF = 128, HTB = HALF * BK * 2, STAGE_BYTES = 8 * HTB, NXCD = 8, WGM = 8;
__host__ __device__ __forceinline__ int lds_byte(int r, int c) { const int st = (r >> 4) * 2 + (c >> 5), rr = r & 15, cc = c & 31, ob = rr * 64 + cc * 2; return st * 1024 + (ob ^ (((ob >> 9) & 1) << 5)); }
__host__ __device__ __forceinline__ void stage_rc(int b, int& R, int& C) { const int st = b / 1024, sb = b % 1024, swz = sb ^ (((sb >> 9) & 1) << 5); R = (st >> 1) * 16 + swz / 64; C = (st & 1) * 32 + (swz % 64) / 2; }
__host__ __device__ __forceinline__ int perm32(int rho) { const int n = rho >> 4, i = rho & 15; return 8 * (i >> 2) + 4 * n + (i & 3); }

struct Unit { int pm, pn, z, nvalid; unsigned aoff, boff, goff; };

__device__ __forceinline__ void tile_order(int L, int nM, int nN, int& pm, int& pn) {
    const int nwg = nM * nN; int wgid = L;
    { const int q = nwg / NXCD, r = nwg % NXCD, xcd = wgid % NXCD, off = wgid / NXCD; wgid = (xcd < r ? xcd * (q + 1) : r * (q + 1) + (xcd - r) * q) + off; }
    const int nig = WGM * nN, gid = wgid / nig, fm = gid * WGM, gsz = (nM - fm) < WGM ? (nM - fm) : WGM;
    pm = fm + ((wgid % nig) % gsz); pn = (wgid % nig) / gsz;
}
__device__ __forceinline__ unsigned cvt_pk_bf16(float lo, float hi) { unsigned r; asm volatile("v_cvt_pk_bf16_f32 %0, %1, %2" : "=v"(r) : "v"(lo), "v"(hi)); return r; }

__device__ __forceinline__ void store_tile_bf16(const f32x4 (&acc)[2][2][4][2], bf16* p0, size_t ldc, const float* bias, float scale, int wc, int fq) {
    const int cl = wc * 32 + 8 * fq;
    f32x4 bv[2][2];
#pragma unroll
    for (int bj = 0; bj < 2; ++bj)
#pragma unroll
        for (int n = 0; n < 2; ++n) bv[bj][n] = bias ? *(const f32x4*)(bias + cl + bj * HALF + 4 * n) : (f32x4){0.f, 0.f, 0.f, 0.f};
#pragma unroll
    for (int ai = 0; ai < 2; ++ai)
#pragma unroll
        for (int m = 0; m < 4; ++m) { bf16* rowp = p0 + (size_t)(ai * HALF + m * 16) * ldc + cl;
#pragma unroll
            for (int bj = 0; bj < 2; ++bj) { const f32x4 v0 = (acc[ai][bj][m][0] + bv[bj][0]) * scale, v1 = (acc[ai][bj][m][1] + bv[bj][1]) * scale;
                u32x4 w; w.x = cvt_pk_bf16(v0[0], v0[1]); w.y = cvt_pk_bf16(v0[2], v0[3]); w.z = cvt_pk_bf16(v1[0], v1[1]); w.w = cvt_pk_bf16(v1[2], v1[3]);
                *(u32x4*)(rowp + bj * HALF) = w; } }
}

typedef int v8i __attribute__((ext_vector_type(8)));
template <class Epi, class Sched, bool GATHER, bool FP8 = false>
__device__ __forceinline__ void gemm_phase(LAS unsigned char* lds, const char* wsb, const int lda, const int ldb, const int K, const Sched& S, const Epi& E, const int* glist) {
    int tid = threadIdx.x; asm volatile("" : "+v"(tid));
    const int wid = __builtin_amdgcn_readfirstlane(tid >> 6), lane = tid & 63, wr = wid >> 2, wc = wid & 3, fr = lane & 15, fq = lane >> 4;
    const int nt = K / BK;
    unsigned voffA[2], voffB[2];
#pragma unroll
    for (int i = 0; i < 2; ++i) { int R, C; stage_rc(tid * 16 + i * 8192, R, C); const int Rb = Epi::PERM ? ((R & ~31) + perm32(R & 31)) : R;
        voffA[i] = (unsigned)(R * lda + C) * 2u; voffB[i] = (unsigned)(Rb * ldb + C) * 2u; }
    const size_t kstep = (size_t)(BK * 2);
    const size_t hstepA = (size_t)HALF * lda * 2, hstepB = (size_t)HALF * ldb * 2;
    const unsigned ldsw = (unsigned)wid * 1024u;
    const int aoff = lds_byte(wr * 64 + fr, fq * 8), boff = lds_byte(wc * 32 + fr, fq * 8);
    unsigned gc[2][2], gn[2][2];
#define PG8_SA(b, h) (((b) * 2 + (h)) * HTB)
#define PG8_SB(b, h) ((4 + (b) * 2 + (h)) * HTB)
#define PG8_STAGE_B(bufoff, gbase) do { _Pragma("unroll") for (int _i = 0; _i < 2; ++_i) \
        __builtin_amdgcn_global_load_lds((const unsigned*)((const char*)(gbase) + voffB[_i]), (LAS unsigned*)(lds + (bufoff) + ldsw + _i * 8192), 16, 0, 0); } while (0)
#define PG8_STAGE_A(bufoff, gbase, h, nx) do { _Pragma("unroll") for (int _i = 0; _i < 2; ++_i) { \
        const char* _p = GATHER ? (const char*)(gbase) + ((nx) ? gn[h][_i] : gc[h][_i]) : (const char*)(gbase) + (h) * hstepA + voffA[_i]; \
        __builtin_amdgcn_global_load_lds((const unsigned*)_p, (LAS unsigned*)(lds + (bufoff) + ldsw + _i * 8192), 16, 0, 0); } } while (0)
#define PG8_LDA(dst, b, h) do { _Pragma("unroll") for (int m = 0; m < 4; ++m) { if constexpr (FP8) { const u32x4 _lo = *(const LAS u32x4*)(lds + PG8_SA(b, h) + aoff + m * 2048), _hi = *(const LAS u32x4*)(lds + PG8_SA(b, h) + aoff + m * 2048 + 1024); \
            dst##8[m] = (v8i){(int)_lo.x, (int)_lo.y, (int)_lo.z, (int)_lo.w, (int)_hi.x, (int)_hi.y, (int)_hi.z, (int)_hi.w}; } \
        else { _Pragma("unroll") for (int k = 0; k < 2; ++k) dst[m][k] = *(const LAS bf16x8*)(lds + PG8_SA(b, h) + aoff + m * 2048 + k * 1024); } } } while (0)
#define PG8_LDB(dst, b, h) do { _Pragma("unroll") for (int n = 0; n < 2; ++n) { if constexpr (FP8) { const u32x4 _lo = *(const LAS u32x4*)(lds + PG8_SB(b, h) + boff + n * 2048), _hi = *(const LAS u32x4*)(lds + PG8_SB(b, h) + boff + n * 2048 + 1024); \
            dst##8[n] = (v8i){(int)_lo.x, (int)_lo.y, (int)_lo.z, (int)_lo.w, (int)_hi.x, (int)_hi.y, (int)_hi.z, (int)_hi.w}; } \
        else { _Pragma("unroll") for (int k = 0; k < 2; ++k) dst[n][k] = *(const LAS bf16x8*)(lds + PG8_SB(b, h) + boff + n * 2048 + k * 1024); } } } while (0)
#define PG8_MMA(ai, bj, At, Bt) do { __builtin_amdgcn_s_setprio(1); if constexpr (FP8) asm volatile("s_nop 1"); _Pragma("unroll") for (int m = 0; m < 4; ++m) _Pragma("unroll") for (int n = 0; n < 2; ++n) { \
        if constexpr (FP8) asm volatile("v_mfma_f32_16x16x128_f8f6f4 %0, %1, %2, %0" : "+v"(acc[ai][bj][m][n]) : "v"(Bt##8[n]), "v"(At##8[m])); \
        else { _Pragma("unroll") for (int k = 0; k < 2; ++k) acc[ai][bj][m][n] = __builtin_amdgcn_mfma_f32_16x16x32_bf16(Bt[n][k], At[m][k], acc[ai][bj][m][n], 0, 0, 0); } } \
        __builtin_amdgcn_s_setprio(0); } while (0)
#define PG8_WAIT_V(n) asm volatile("s_waitcnt vmcnt(" #n ")" ::: "memory")
#define PG8_WAIT_L(n) asm volatile("s_waitcnt lgkmcnt(" #n ")" ::: "memory")
#define PG8_BAR __builtin_amdgcn_s_barrier()
#define PG8_SCHED __builtin_amdgcn_sched_barrier(0)
#define PG8_GIDX(g, u) do { _Pragma("unroll") for (int _h = 0; _h < 2; ++_h) _Pragma("unroll") for (int _i = 0; _i < 2; ++_i) { int _R, _C; stage_rc(tid * 16 + _i * 8192, _R, _C); const int _r = _h * HALF + _R; \
        const int _tok = glist[(u).goff + (_r < (u).nvalid ? _r : (u).nvalid - 1)]; g[_h][_i] = (unsigned)_tok * (unsigned)(lda * 2) + (unsigned)(_C * 2); } } while (0)
    Unit cur, nxt, nn; int ui = 0;
    if (!S.next(0, cur)) return;
    f32x4 acc[2][2][4][2];
#pragma unroll
    for (int a = 0; a < 2; ++a)
#pragma unroll
        for (int b = 0; b < 2; ++b)
#pragma unroll
            for (int m = 0; m < 4; ++m)
#pragma unroll
                for (int n = 0; n < 2; ++n) acc[a][b][m][n] = (f32x4){0.f, 0.f, 0.f, 0.f};
    bf16x8 At[4][2], B0[2][2], B1[2][2];
    v8i At8[4], B08[2], B18[2];
    const char* cA = wsb + cur.aoff; const char* cB = wsb + cur.boff;
    if constexpr (GATHER) { PG8_GIDX(gc, cur); if (S.next(1, nxt)) { PG8_GIDX(gn, nxt); } else { PG8_GIDX(gn, cur); }
        asm volatile("s_waitcnt vmcnt(0)" : "+v"(gc[0][0]), "+v"(gc[0][1]), "+v"(gc[1][0]), "+v"(gc[1][1]), "+v"(gn[0][0]), "+v"(gn[0][1]), "+v"(gn[1][0]), "+v"(gn[1][1]) :: "memory"); }
    else {
#pragma unroll
        for (int h = 0; h < 2; ++h)
#pragma unroll
            for (int i = 0; i < 2; ++i) { gc[h][i] = 0u; gn[h][i] = 0u; } }
    PG8_STAGE_B(PG8_SB(0, 0), cB); PG8_STAGE_B(PG8_SB(0, 1), cB + hstepB); PG8_STAGE_A(PG8_SA(0, 0), cA, 0, false); PG8_STAGE_A(PG8_SA(0, 1), cA, 1, false);
    if (wr == 1) PG8_BAR;
    PG8_WAIT_V(2); PG8_BAR;
    PG8_STAGE_B(PG8_SB(1, 0), cB + kstep); PG8_STAGE_A(PG8_SA(1, 0), cA + kstep, 0, false); PG8_STAGE_B(PG8_SB(1, 1), cB + hstepB + kstep);
    PG8_WAIT_V(6); PG8_BAR;
    for (;;) {
        const bool has_next = S.next(ui + 1, nxt);
        const char* nA = has_next ? wsb + nxt.aoff : cA; const char* nB = has_next ? wsb + nxt.boff : cB;
#pragma clang loop unroll(disable)
        for (int t = 0; t < nt; t += 2) {
            const bool last = (t == nt - 2);
            const char* a1 = cA + (size_t)(t + 1) * kstep;
            const char* a2 = last ? nA : cA + (size_t)(t + 2) * kstep; const char* b2 = last ? nB : cB + (size_t)(t + 2) * kstep;
            const char* a3 = a2 + kstep; const char* b3 = b2 + kstep;
            PG8_LDB(B0, 0, 0); PG8_LDB(B1, 0, 1); PG8_SCHED; PG8_LDA(At, 0, 0); PG8_STAGE_A(PG8_SA(1, 1), a1, 1, false);
            PG8_WAIT_V(8); PG8_WAIT_L(0); PG8_BAR; PG8_MMA(0, 0, At, B0); PG8_MMA(0, 1, At, B1); PG8_BAR; PG8_SCHED;
            PG8_LDA(At, 0, 1); PG8_STAGE_B(PG8_SB(0, 0), b2); PG8_STAGE_B(PG8_SB(0, 1), b2 + hstepB); PG8_STAGE_A(PG8_SA(0, 0), a2, 0, last);
            PG8_WAIT_V(8); PG8_WAIT_L(0); PG8_BAR; PG8_MMA(1, 0, At, B0); PG8_MMA(1, 1, At, B1); PG8_BAR; PG8_SCHED;
            PG8_LDB(B0, 1, 0); PG8_LDB(B1, 1, 1); PG8_SCHED; PG8_LDA(At, 1, 0); PG8_STAGE_A(PG8_SA(0, 1), a2, 1, last);
            PG8_WAIT_V(8); PG8_WAIT_L(0); PG8_BAR; PG8_MMA(0, 0, At, B0); PG8_MMA(0, 1, At, B1); PG8_BAR; PG8_SCHED;
            PG8_LDA(At, 1, 1); PG8_STAGE_B(PG8_SB(1, 0), b3); PG8_STAGE_B(PG8_SB(1, 1), b3 + hstepB); PG8_STAGE_A(PG8_SA(1, 0), a3, 0, last);
            PG8_WAIT_V(8); PG8_WAIT_L(0); PG8_BAR; PG8_MMA(1, 0, At, B0); PG8_MMA(1, 1, At, B1); PG8_BAR; PG8_SCHED;
        }
        if constexpr (FP8) asm volatile("s_nop 15\n\ts_nop 7");
        if (wr == 0) PG8_BAR;
        if constexpr (GATHER) {
#pragma unroll
            for (int h = 0; h < 2; ++h)
#pragma unroll
                for (int i = 0; i < 2; ++i) gc[h][i] = gn[h][i];
            if (has_next && S.next(ui + 2, nn)) { PG8_GIDX(gn, nn); }
        }
        E(acc, cur, wr, wc, fr, fq);
        if constexpr (GATHER) asm volatile("" : "+v"(gn[0][0]), "+v"(gn[0][1]), "+v"(gn[1][0]), "+v"(gn[1][1]));
        if (!has_next) break;
#pragma unroll
        for (int a = 0; a < 2; ++a)
#pragma unroll
            for (int b = 0; b < 2; ++b)
#pragma unroll
                for (int m = 0; m < 4; ++m)
#pragma unroll
                    for (int n = 0; n < 2; ++n) acc[a][b][m][n] = (f32x4){0.f, 0.f, 0.f, 0.f};
        cur = nxt; cA = nA; cB = nB; ++ui;
        if (wr == 1) PG8_BAR;
    }
    PG8_WAIT_V(0);
    PG8_BAR;
#undef PG8_SA
#undef PG8_SB
#undef PG8_STAGE_A
#undef PG8_STAGE_B
#undef PG8_LDA
#undef PG8_LDB
#undef PG8_MMA
#undef PG8_WAIT_V
#undef PG8_WAIT_L
#undef PG8_BAR
#undef PG8_SCHED
#undef PG8_GIDX
}
}
using pg8::Unit;

#define XB_TMO      128
#define XB_XCNT(j)  (256  + 64 * (j))
#define XB_XSUB(j)  (1280 + 64 * (j))
#define XB_XGEN(j)  (2304 + 64 * (j))
#define XB_TOP      3328
#define XB_TOPGEN   3392
#define XCD_BAR_WORDS 3456
#define XB_SPIN_CAP (1u << 18)
__device__ __forceinline__ unsigned xb_ld(unsigned* p)              { return __hip_atomic_load(p, __ATOMIC_RELAXED, __HIP_MEMORY_SCOPE_AGENT); }
__device__ __forceinline__ unsigned xb_add(unsigned* p, unsigned v) { return __hip_atomic_fetch_add(p, v, __ATOMIC_RELAXED, __HIP_MEMORY_SCOPE_AGENT); }
__device__ __forceinline__ unsigned xb_xcc_id() { return (unsigned)__builtin_amdgcn_s_getreg((3 << 11) | 20) & 0xFu; }
#define XB_SPIN(cond, bar) do { unsigned _sp = 0; while (cond) { __builtin_amdgcn_s_sleep(1); \
    if ((++_sp & 255u) == 0u) { if (xb_ld(&(bar)[XB_TMO])) break; if (_sp > XB_SPIN_CAP) { atomicAdd(&(bar)[XB_TMO], 1u); break; } } } } while (0)
struct XcdBarrier { unsigned* bar; unsigned x; volatile LAS unsigned* st; };
__device__ __forceinline__ XcdBarrier xcd_barrier_post(unsigned* bar, volatile LAS unsigned* st) {
    XcdBarrier b; b.bar = bar; b.x = xb_xcc_id(); b.st = st;
    if (threadIdx.x == 0) (void)xb_add(&bar[XB_XCNT(b.x)], 1u);
    return b;
}
__device__ __forceinline__ void xcd_barrier_complete(unsigned* bar, unsigned x, unsigned& nloc, unsigned& nx) {
    const unsigned G = gridDim.x * gridDim.y * gridDim.z;
    unsigned sum, cnt, mine, sp = 0u;
    for (;;) {
        sum = 0u; cnt = 0u; mine = 0u;
#pragma unroll
        for (unsigned j = 0; j < 16; ++j) { const unsigned c = xb_ld(&bar[XB_XCNT(j)]); sum += c; cnt += (c > 0u) ? 1u : 0u; mine = (j == x) ? c : mine; }
        if (sum == G) break;
        __builtin_amdgcn_s_sleep(1);
        if ((++sp & 255u) == 0u) { if (xb_ld(&bar[XB_TMO])) break; if (sp > XB_SPIN_CAP) { atomicAdd(&bar[XB_TMO], 1u); break; } }
    }
    nloc = mine > 0u ? mine : 1u; nx = cnt > 0u ? cnt : 1u;
}
__device__ __forceinline__ void xcd_barrier(const XcdBarrier& b) {
    asm volatile("s_waitcnt vmcnt(0)" ::: "memory");
    __syncthreads();
    if (threadIdx.x == 0) {
        unsigned* bar = b.bar;
        __builtin_amdgcn_s_waitcnt(0);
        unsigned nloc = b.st[0], nx = b.st[1];
        if (nloc == 0u) { xcd_barrier_complete(bar, b.x, nloc, nx); b.st[0] = nloc; b.st[1] = nx; }
        const unsigned old = xb_add(&bar[XB_XSUB(b.x)], 1u);
        const unsigned gen = old / nloc;
        if (old + 1u == (gen + 1u) * nloc) {
            __builtin_amdgcn_fence(__ATOMIC_RELEASE, "agent");
            asm volatile("s_waitcnt vmcnt(0)" ::: "memory");
            const unsigned og = xb_add(&bar[XB_TOP], 1u);
            const unsigned tg = og / nx;
            if (og + 1u == (tg + 1u) * nx) xb_add(&bar[XB_TOPGEN], 1u);
            else XB_SPIN(xb_ld(&bar[XB_TOPGEN]) == tg, bar);
            __builtin_amdgcn_fence(__ATOMIC_ACQUIRE, "agent");
            xb_add(&bar[XB_XGEN(b.x)], 1u);
            asm volatile("s_waitcnt vmcnt(0)" ::: "memory");
        } else {
            XB_SPIN(xb_ld(&bar[XB_XGEN(b.x)]) == gen, bar);
            __builtin_amdgcn_fence(__ATOMIC_ACQUIRE, "agent");
            asm volatile("s_waitcnt vmcnt(0)" ::: "memory");
        }
    }
    __syncthreads();
}

struct Frame {
    LAS unsigned char* lds;
    volatile LAS unsigned* MISC;
    gu32* ctl;
    unsigned char* ws;
    int tid, lane, wave, vcu, G;
    float* hf;
    const float* const* in;
};
enum In { I_X = 0, I_MEM, I_LN_IN_G, I_LN_IN_B, I_LN_MEM_G, I_LN_MEM_B, I_W_IN, I_B_IN, I_W_DW, I_B_DW, I_LN_CONV_G, I_LN_CONV_B, I_W_OUT, I_B_OUT, I_LN1_G, I_LN1_B,
          I_WQ, I_WK, I_WV, I_WO, I_LN2_G, I_LN2_B, I_W_ROUTER, I_B_ROUTER, I_W_GU, I_B_GU, I_W_DOWN, I_B_DOWN, I_LN3_G, I_LN3_B, N_IN };

__device__ __forceinline__ void p0_transpose_item(const float* W, int K, int N, bf16* WT, int k0, int n0, int drow, LAS float* scr, int lane) {
#pragma unroll 8
    for (int i = 0; i < 32; ++i) { const int kk = 2 * i + (lane >> 5); scr[kk * 33 + (lane & 31)] = W[(size_t)(k0 + kk) * N + n0 + (lane & 31)]; }
    LDS_WAIT(); asm volatile("" ::: "memory");
    const int c = lane & 7;
#pragma unroll
    for (int j = 0; j < 4; ++j) { const int n = (lane >> 3) + 8 * j; const LAS float* s = scr + (8 * c) * 33 + n;
        u32x4 o; o.x = pk2(s[0 * 33], s[1 * 33]); o.y = pk2(s[2 * 33], s[3 * 33]); o.z = pk2(s[4 * 33], s[5 * 33]); o.w = pk2(s[6 * 33], s[7 * 33]);
        *(GAS u32x4*)(WT + (size_t)(drow + n) * K + k0 + 8 * c) = o; }
    LDS_WAIT(); asm volatile("" ::: "memory");
}
__device__ __forceinline__ void ln_row(f32x4 (&v)[4], const float* g, const float* b, int lane) {
    float s = 0.f;
#pragma unroll
    for (int j = 0; j < 4; ++j) s += (v[j].x + v[j].y) + (v[j].z + v[j].w);
    const float mean = wave_sum(s) * (1.f / D); float s2 = 0.f;
#pragma unroll
    for (int j = 0; j < 4; ++j) { v[j] = v[j] - mean; s2 += (v[j].x * v[j].x + v[j].y * v[j].y) + (v[j].z * v[j].z + v[j].w * v[j].w); }
    const float rstd = 1.f / sqrtf(wave_sum(s2) * (1.f / D) + LN_EPS);
#pragma unroll
    for (int j = 0; j < 4; ++j) { const f32x4 gg = ((const GAS f32x4*)g)[lane + 64 * j], bb = ((const GAS f32x4*)b)[lane + 64 * j]; v[j] = v[j] * rstd * gg + bb; }
}
__device__ __forceinline__ void store_row_bf16(const f32x4 (&v)[4], bf16* orow, int lane) {
    GAS u32x2* o8 = (GAS u32x2*)orow + lane;
#pragma unroll
    for (int j = 0; j < 4; ++j) o8[64 * j] = (u32x2){pk2(v[j].x, v[j].y), pk2(v[j].z, v[j].w)};
}
__device__ __forceinline__ void p0_transpose_item8(const float* W, int K, int N, unsigned char* WT, int k0, int n0, int drow, float sc, LAS float* scr, int lane) {
#pragma unroll 8
    for (int i = 0; i < 32; ++i) { const int kk = 2 * i + (lane >> 5); scr[kk * 33 + (lane & 31)] = W[(size_t)(k0 + kk) * N + n0 + (lane & 31)]; }
    LDS_WAIT(); asm volatile("" ::: "memory");
    const int c = lane & 7;
#pragma unroll
    for (int j = 0; j < 4; ++j) { const int n = (lane >> 3) + 8 * j; const LAS float* s = scr + (8 * c) * 33 + n;
        u32x2 o; o.x = pk4_fp8(s[0 * 33] * sc, s[1 * 33] * sc, s[2 * 33] * sc, s[3 * 33] * sc); o.y = pk4_fp8(s[4 * 33] * sc, s[5 * 33] * sc, s[6 * 33] * sc, s[7 * 33] * sc);
        *(GAS u32x2*)(WT + (size_t)(drow + n) * K + k0 + 8 * c) = o; }
    LDS_WAIT(); asm volatile("" ::: "memory");
}
__device__ __forceinline__ void p0_transpose_item8b(const float* W, int K, int N, unsigned char* WT, int k0, int n0, int drow, float sc, LAS unsigned char* scr, int lane) {
    const int g = lane >> 3, c = lane & 7;
    f32x4 x[4][4];
#pragma unroll
    for (int q = 0; q < 4; ++q)
#pragma unroll
        for (int j = 0; j < 4; ++j) x[q][j] = *(const GAS f32x4*)(W + (size_t)(k0 + 32 * q + 4 * g + j) * N + n0 + 4 * c);
#pragma unroll
    for (int q = 0; q < 4; ++q)
#pragma unroll
        for (int e = 0; e < 4; ++e) *(LAS unsigned*)(scr + (4 * c + e) * 144 + 32 * q + 4 * g) = pk4_fp8(x[q][0][e] * sc, x[q][1][e] * sc, x[q][2][e] * sc, x[q][3][e] * sc);
    LDS_WAIT(); asm volatile("" ::: "memory");
#pragma unroll
    for (int i = 0; i < 4; ++i) { const int t = lane + 64 * i, n = t >> 3, ch = t & 7;
        *(GAS u32x4*)(WT + (size_t)(drow + n) * K + k0 + 16 * ch) = *(const LAS u32x4*)(scr + n * 144 + 16 * ch); }
    LDS_WAIT(); asm volatile("" ::: "memory");
}
__device__ __forceinline__ void load_row_bf16(f32x4 (&v)[4], const bf16* xrow, int lane) {
    const GAS u32x2* xr = (const GAS u32x2*)xrow + lane;
#pragma unroll
    for (int j = 0; j < 4; ++j) { const u32x2 w = xr[64 * j]; v[j] = (f32x4){bflo(w.x), bfhi(w.x), bflo(w.y), bfhi(w.y)}; }
}
__device__ __forceinline__ void load_row_f32(f32x4 (&v)[4], const float* xrow, int lane) {
    const GAS f32x4* xr = (const GAS f32x4*)xrow + lane;
#pragma unroll
    for (int j = 0; j < 4; ++j) v[j] = xr[64 * j];
}
__device__ __forceinline__ void store_row_f32(const f32x4 (&v)[4], float* orow, int lane) {
    GAS f32x4* o = (GAS f32x4*)orow + lane;
#pragma unroll
    for (int j = 0; j < 4; ++j) o[64 * j] = v[j];
}

__device__ __forceinline__ void p0_prologue(Frame& F) {
    LAS float* scr = (LAS float*)(F.lds + RING_OFF + F.wave * 16384);
    const int gw = F.vcu * NWAVES + F.wave, NGW = F.G * NWAVES;
    constexpr int I_IN = 16 * 80, I_SQ = 16 * 32, I_GU = NE * 8 * 64, I_DN = NE * 8 * 32;
    constexpr int NITEMS = I_IN + 3 * I_SQ + 2 * 256 + I_GU + I_DN;
    for (int it = gw; it < NITEMS; it += NGW) {
        int r = it;
        if (r < I_GU) { const int e = r / (8 * 64), q = r % (8 * 64), kb = q / 64, nb = q % 64, n0 = 32 * nb;
            const int drow = (n0 < 1024) ? (n0 >> 7) * 256 + (n0 & 127) : ((n0 - 1024) >> 7) * 256 + 128 + (n0 & 127);
            p0_transpose_item8b(F.in[I_W_GU] + (size_t)e * D * 2 * DFF, D, 2 * DFF, F.ws + WS_WGU_T + (size_t)e * 2 * DFF * D, 128 * kb, n0, drow, WGU_SC, (LAS unsigned char*)scr, F.lane); continue; } r -= I_GU;
        if (r < I_DN) { const int e = r / (8 * 32), q = r % (8 * 32), kb = q / 32, nb = q % 32;
            p0_transpose_item8b(F.in[I_W_DOWN] + (size_t)e * DFF * D, DFF, D, F.ws + WS_WDN_T + (size_t)e * D * DFF, 128 * kb, 32 * nb, 32 * nb, WDN_SC, (LAS unsigned char*)scr, F.lane); continue; } r -= I_DN;
        if (r < I_IN) { const int kb = r / 80, nb = r % 80, n0 = 32 * nb; int drow;
            if (n0 < 512) drow = (n0 >> 7) * 256 + (n0 & 127); else if (n0 < 1024) drow = ((n0 - 512) >> 7) * 256 + 128 + (n0 & 127); else drow = n0;
            p0_transpose_item(F.in[I_W_IN], D, INC, (bf16*)(F.ws + WS_WIN_T), 64 * kb, n0, drow, scr, F.lane); continue; } r -= I_IN;
        if (r < 3 * I_SQ) { const int w = r / I_SQ, q = r % I_SQ, kb = q / 32, nb = q % 32;
            const float* src = F.in[w == 0 ? I_W_OUT : w == 1 ? I_WK : I_WV];
            bf16* dst = (bf16*)(F.ws + (w == 0 ? WS_WOUT_T : w == 1 ? WS_WK_T : WS_WV_T));
            p0_transpose_item(src, D, D, dst, 64 * kb, 32 * nb, 32 * nb, scr, F.lane); continue; } r -= 3 * I_SQ;
        { const int w = r / 256, q = r % 256, kb = q / 32, nb = q % 32;
            p0_transpose_item8b(F.in[w == 0 ? I_WQ : I_WO], D, D, F.ws + (w == 0 ? WS_WQ_T : WS_WO_T), 128 * kb, 32 * nb, 32 * nb, w == 0 ? WQ_SC : WO_SC, (LAS unsigned char*)scr, F.lane); }
    }
    if (gw < 512) { const int idx = gw * 64 + F.lane, c = idx >> 5, e = idx & 31; const float w = F.in[I_W_ROUTER][idx];
        const unsigned hi = f2bf(w), lo = f2bf(w - __builtin_bit_cast(float, hi << 16)); bf16* wr = (bf16*)(F.ws + WS_WR);
        wr[e * WR_STRIDE + c] = (bf16)hi; wr[(32 + e) * WR_STRIDE + c] = (bf16)lo; }
    for (int m = gw; m < M + MM; m += NGW) {
        f32x4 v[4];
        if (m < M) { load_row_f32(v, F.in[I_X] + (size_t)m * D, F.lane); ln_row(v, F.in[I_LN_IN_G], F.in[I_LN_IN_B], F.lane);
            store_row_bf16(v, (bf16*)(F.ws + WS_HB) + (size_t)m * D, F.lane); }
        else { const int mm = m - M; load_row_f32(v, F.in[I_MEM] + (size_t)mm * D, F.lane); ln_row(v, F.in[I_LN_MEM_G], F.in[I_LN_MEM_B], F.lane);
            store_row_bf16(v, (bf16*)(F.ws + WS_MEMN) + (size_t)mm * D, F.lane); }
    }
}

constexpr unsigned TSTEP = 256u * 1024u * 2u;
struct SchedP1 { int G, c;
    __device__ __forceinline__ bool next(int i, Unit& u) const {
        const int L = i * G + c; if (L >= 1344) return false;
        u.nvalid = 256; u.goff = 0;
        if (L < 1024) { pg8::tile_order(L, 128, 8, u.pm, u.pn); u.z = 0; u.aoff = (unsigned)WS_HB + (unsigned)u.pm * TSTEP; u.boff = (unsigned)WS_WIN_T + (unsigned)u.pn * TSTEP; }
        else if (L < 1280) { const int j = L - 1024; u.pm = j & 1; u.pn = j >> 1; u.z = 3; u.aoff = (unsigned)WS_WIN_T + (unsigned)(8 + u.pm) * TSTEP; u.boff = (unsigned)WS_HB + (unsigned)u.pn * TSTEP; }
        else if (L < 1312) { const int j = L - 1280; u.pm = j & 7; u.pn = j >> 3; u.z = 1; u.aoff = (unsigned)WS_MEMN + (unsigned)u.pm * TSTEP; u.boff = (unsigned)WS_WK_T + (unsigned)u.pn * TSTEP; }
        else { const int j = L - 1312; u.pm = j & 3; u.pn = j >> 2; u.z = 2; u.aoff = (unsigned)WS_WV_T + (unsigned)u.pm * TSTEP; u.boff = (unsigned)WS_MEMN + (unsigned)u.pn * TSTEP; }
        return true; }
};
struct EpiP1 { static constexpr bool PERM = true;
    unsigned char* ws; const float* b_in;
    __device__ __forceinline__ void operator()(const f32x4 (&acc)[2][2][4][2], const Unit& u, int wr, int wc, int fr, int fq) const {
        const int row0 = u.pm * 256 + wr * 64 + fr;
        if (u.z == 0) {
            if (u.pn < 4) {
                const int ch = 128 * u.pn + wc * 32 + 8 * fq;
                f32x4 bv[2], bg[2];
#pragma unroll
                for (int n = 0; n < 2; ++n) { bv[n] = *(const f32x4*)(b_in + ch + 4 * n); bg[n] = *(const f32x4*)(b_in + 512 + ch + 4 * n); }
                bf16* U = (bf16*)(ws + WS_U);
#pragma unroll
                for (int ai = 0; ai < 2; ++ai)
#pragma unroll
                    for (int m = 0; m < 4; ++m) { f32x4 o[2];
#pragma unroll
                        for (int n = 0; n < 2; ++n) { const f32x4 a = acc[ai][0][m][n] + bv[n], g = acc[ai][1][m][n] + bg[n];
#pragma unroll
                            for (int j = 0; j < 4; ++j) o[n][j] = a[j] * sigmoidf_fast(g[j]); }
                        u32x4 w; w.x = pg8::cvt_pk_bf16(o[0][0], o[0][1]); w.y = pg8::cvt_pk_bf16(o[0][2], o[0][3]); w.z = pg8::cvt_pk_bf16(o[1][0], o[1][1]); w.w = pg8::cvt_pk_bf16(o[1][2], o[1][3]);
                        *(u32x4*)(U + (size_t)(row0 + ai * 128 + m * 16) * 512 + ch) = w; }
            } else {
                const int t = u.pn - 4, which = t >> 1, cb = (t & 1) * 256;
                bf16* dst = (bf16*)(ws + (which == 0 ? WS_Q : WS_K));
                pg8::store_tile_bf16(acc, dst + (size_t)row0 * 512 + cb, 512, b_in + 1024 + 256 * t, which == 0 ? SB_QSCALE : 1.0f, wc, fq);
            }
        } else if (u.z == 3) {
            const float* rb = b_in + 2048 + row0; bf16* p0 = (bf16*)(ws + WS_V) + (size_t)row0 * M + 256 * u.pn; const int cl = wc * 32 + 8 * fq;
#pragma unroll
            for (int ai = 0; ai < 2; ++ai)
#pragma unroll
                for (int m = 0; m < 4; ++m) { const float bv = rb[ai * 128 + m * 16]; bf16* rowp = p0 + (size_t)(ai * 128 + m * 16) * M + cl;
#pragma unroll
                    for (int bj = 0; bj < 2; ++bj) { const f32x4 v0 = acc[ai][bj][m][0] + bv, v1 = acc[ai][bj][m][1] + bv;
                        u32x4 w; w.x = pg8::cvt_pk_bf16(v0[0], v0[1]); w.y = pg8::cvt_pk_bf16(v0[2], v0[3]); w.z = pg8::cvt_pk_bf16(v1[0], v1[1]); w.w = pg8::cvt_pk_bf16(v1[2], v1[3]);
                        *(u32x4*)(rowp + bj * 128) = w; } }
        } else if (u.z == 1) pg8::store_tile_bf16(acc, (bf16*)(ws + WS_KM) + (size_t)row0 * 1024 + 256 * u.pn, 1024, nullptr, 1.0f, wc, fq);
        else pg8::store_tile_bf16(acc, (bf16*)(ws + WS_VMT) + (size_t)row0 * 2048 + 256 * u.pn, 2048, nullptr, 1.0f, wc, fq);
    }
};

struct SchedPlain { int G, c, nM, nN; unsigned abase, bbase, atile, btile, acol, bcol, bgrp;
    __device__ __forceinline__ bool next(int i, Unit& u) const {
        const int L = i * G + c; if (L >= nM * nN) return false;
        pg8::tile_order(L, nM, nN, u.pm, u.pn); u.z = 0; u.nvalid = 256; u.goff = 0;
        u.aoff = abase + (unsigned)u.pm * atile + (unsigned)u.pn * acol; u.boff = bbase + (unsigned)u.pn * btile + (unsigned)(u.pm >> 4) * bgrp + (unsigned)u.pn * bcol; return true; }
};
struct EpiBf16 { static constexpr bool PERM = true;
    bf16* O; int ldc; float scale; const float* bias;
    __device__ __forceinline__ void operator()(const f32x4 (&acc)[2][2][4][2], const Unit& u, int wr, int wc, int fr, int fq) const {
        pg8::store_tile_bf16(acc, O + (size_t)(u.pm * 256 + wr * 64 + fr) * ldc + 256 * u.pn, (size_t)ldc, bias ? bias + 256 * u.pn : nullptr, scale, wc, fq); }
};
struct SchedMoe { int G, c, nN; const LAS int* tb; unsigned abase, wbase, wexp;
    bool gather;
    __device__ __forceinline__ bool next(int i, Unit& u) const {
        const int nblk = __builtin_amdgcn_readfirstlane(tb[32]); const int L = i * G + c; if (L >= nblk * nN) return false;
        pg8::tile_order(L, nblk, nN, u.pm, u.pn);
        const int e = __builtin_amdgcn_readfirstlane(tb[128 + u.pm]);
        const int j = u.pm - tb[e], rem = tb[64 + e] - 256 * j;
        u.z = e; u.nvalid = rem < 256 ? rem : 256; u.goff = (unsigned)(e * LCAP + 256 * j);
        u.aoff = gather ? abase : abase + (unsigned)u.pm * (TSTEP / 2);
        u.boff = wbase + (unsigned)e * wexp + (unsigned)u.pn * (TSTEP / 2); return true; }
};
struct EpiAct { static constexpr bool PERM = true;
    unsigned char* ACT; const float* b_gu;
    __device__ __forceinline__ void operator()(const f32x4 (&acc)[2][2][4][2], const Unit& u, int wr, int wc, int fr, int fq) const {
        const int row0 = u.pm * 256 + wr * 64 + fr, ch = 128 * u.pn + wc * 32 + 8 * fq;
        const float* bb = b_gu + (size_t)u.z * 2 * DFF;
        f32x4 bg[2], bu[2];
#pragma unroll
        for (int n = 0; n < 2; ++n) { bg[n] = *(const f32x4*)(bb + ch + 4 * n); bu[n] = *(const f32x4*)(bb + DFF + ch + 4 * n); }
#pragma unroll
        for (int ai = 0; ai < 2; ++ai)
#pragma unroll
            for (int m = 0; m < 4; ++m) { f32x4 o[2];
#pragma unroll
                for (int n = 0; n < 2; ++n) { const f32x4 g = acc[ai][0][m][n] * (1.0f / WGU_SC) + bg[n], uu = acc[ai][1][m][n] * (1.0f / WGU_SC) + bu[n];
#pragma unroll
                    for (int j = 0; j < 4; ++j) { const float g_ = fminf(g[j], 7.0f), u_ = fminf(fmaxf(uu[j], -7.0f), 7.0f); o[n][j] = (u_ + 1.0f) * g_ * sigmoidf_fast(1.702f * g_); } }
                *(u32x2*)(ACT + (size_t)(row0 + ai * 128 + m * 16) * DFF + ch) = (u32x2){pk4_fp8(o[0][0], o[0][1], o[0][2], o[0][3]), pk4_fp8(o[1][0], o[1][1], o[1][2], o[1][3])}; }
    }
};
struct EpiDown { static constexpr bool PERM = true;
    unsigned char* YS; const float* b_down; const float* lgate;
    __device__ __forceinline__ void operator()(const f32x4 (&acc)[2][2][4][2], const Unit& u, int wr, int wc, int fr, int fq) const {
        const int r0 = wr * 64 + fr, cl = wc * 32 + 8 * fq;
        const float* bb = b_down + (size_t)u.z * D + 256 * u.pn + cl;
        f32x4 bv[2][2];
#pragma unroll
        for (int bj = 0; bj < 2; ++bj)
#pragma unroll
            for (int n = 0; n < 2; ++n) bv[bj][n] = *(const f32x4*)(bb + bj * 128 + 4 * n);
        float gts[2][4];
#pragma unroll
        for (int ai = 0; ai < 2; ++ai)
#pragma unroll
            for (int m = 0; m < 4; ++m) { const int r = r0 + ai * 128 + m * 16; gts[ai][m] = lgate[u.goff + (r < u.nvalid ? r : u.nvalid - 1)]; }
#pragma unroll
        for (int ai = 0; ai < 2; ++ai)
#pragma unroll
            for (int m = 0; m < 4; ++m) { const int r = r0 + ai * 128 + m * 16; const float gt = (r < u.nvalid) ? gts[ai][m] * YS_SC : 0.f;
                unsigned char* rowp = YS + (size_t)(u.pm * 256 + r) * D + 256 * u.pn + cl;
#pragma unroll
                for (int bj = 0; bj < 2; ++bj) { const f32x4 v0 = (acc[ai][bj][m][0] * (1.0f / WDN_SC) + bv[bj][0]) * gt, v1 = (acc[ai][bj][m][1] * (1.0f / WDN_SC) + bv[bj][1]) * gt;
                    *(u32x2*)(rowp + bj * 128) = (u32x2){pk4_fp8(v0[0], v0[1], v0[2], v0[3]), pk4_fp8(v1[0], v1[1], v1[2], v1[3])}; } }
    }
};
__device__ __forceinline__ void moe_table(Frame& F, LAS int* tb) {
    if (F.tid < 32) { int c = (int)__hip_atomic_load(F.ctl + CW_ECNT + 64 * F.tid, RLX_AGENT); if (c > LCAP) c = LCAP; tb[64 + F.tid] = c; }
    LDS_WAIT(); __syncthreads();
    if (F.tid == 0) { int s = 0; for (int e = 0; e < NE; ++e) { tb[e] = s; s += (tb[64 + e] + 255) >> 8; } tb[32] = s; }
    LDS_WAIT(); __syncthreads();
    for (int b = F.tid; b < NBLK_MAX; b += NWAVES * 64) { int e = 0; while (e < NE - 1 && tb[e + 1] <= b) ++e; tb[128 + b] = e; }
    LDS_WAIT(); __syncthreads();
}

__device__ __forceinline__ void conv_phase(Frame& F) {
    LAS unsigned* ut = (LAS unsigned*)(F.lds + RING_OFF);
    LAS float* co = (LAS float*)(F.lds + RING_OFF + 65536);
    const int cp = F.tid & 255, half = F.tid >> 8;
    float w0[CWID], w1[CWID];
    { const float* wd = F.in[I_W_DW] + 2 * cp;
#pragma unroll
        for (int j = 0; j < CWID; ++j) { const f32x2 w = *(const GAS f32x2*)(wd + j * CONV_CH); w0[j] = w.x; w1[j] = w.y; } }
    const f32x2 bd = *(const GAS f32x2*)(F.in[I_B_DW] + 2 * cp);
    const f32x4 g0 = *(const GAS f32x4*)(F.in[I_LN_CONV_G] + 8 * F.lane), g1 = *(const GAS f32x4*)(F.in[I_LN_CONV_G] + 8 * F.lane + 4);
    const f32x4 b0 = *(const GAS f32x4*)(F.in[I_LN_CONV_B] + 8 * F.lane), b1 = *(const GAS f32x4*)(F.in[I_LN_CONV_B] + 8 * F.lane + 4);
    bf16* MX = (bf16*)(F.ws + WS_MIXIN);
    for (int it = F.vcu; it < NB * (T_ / 32); it += F.G) {
        const int b = it / (T_ / 32), t0 = (it % (T_ / 32)) * 32;
        const bf16* U = (const bf16*)(F.ws + WS_U) + (size_t)b * T_ * CONV_CH;
        for (int idx = F.tid; idx < 62 * 64; idx += 512) { const int r = idx >> 6, c16 = idx & 63, t = t0 - 30 + r;
            u32x4 v = (u32x4){0u, 0u, 0u, 0u}; if (t >= 0) v = *(const GAS u32x4*)(U + (size_t)t * CONV_CH + c16 * 8);
            *(LAS u32x4*)(ut + r * 256 + c16 * 4) = v; }
        LDS_WAIT(); __syncthreads();
        { float a0[16], a1[16];
#pragma unroll
            for (int tt = 0; tt < 16; ++tt) { a0[tt] = bd.x; a1[tt] = bd.y; }
#pragma unroll
            for (int r = 0; r < 46; ++r) { const unsigned uu = ut[(half * 16 + r) * 256 + cp]; const float u0 = bflo(uu), u1 = bfhi(uu);
#pragma unroll
                for (int tt = 0; tt < 16; ++tt) { const int j = r - tt; if (j >= 0 && j < CWID) { a0[tt] += w0[j] * u0; a1[tt] += w1[j] * u1; } } }
#pragma unroll
            for (int tt = 0; tt < 16; ++tt) *(LAS f32x2*)(co + (half * 16 + tt) * CONV_CH + 2 * cp) = (f32x2){a0[tt], a1[tt]};
        }
        LDS_WAIT(); __syncthreads();
#pragma unroll
        for (int q = 0; q < 4; ++q) { const int tt = 4 * F.wave + q;
            f32x4 x0 = *(const LAS f32x4*)(co + tt * CONV_CH + 8 * F.lane), x1 = *(const LAS f32x4*)(co + tt * CONV_CH + 8 * F.lane + 4);
            const float mean = wave_sum((x0.x + x0.y) + (x0.z + x0.w) + (x1.x + x1.y) + (x1.z + x1.w)) * (1.f / CONV_CH);
            x0 = x0 - mean; x1 = x1 - mean;
            const float var = wave_sum((x0.x * x0.x + x0.y * x0.y) + (x0.z * x0.z + x0.w * x0.w) + (x1.x * x1.x + x1.y * x1.y) + (x1.z * x1.z + x1.w * x1.w)) * (1.f / CONV_CH);
            const float rstd = 1.f / sqrtf(var + LN_EPS);
            x0 = x0 * rstd * g0 + b0; x1 = x1 * rstd * g1 + b1;
            float y[8] = {x0.x, x0.y, x0.z, x0.w, x1.x, x1.y, x1.z, x1.w};
#pragma unroll
            for (int j = 0; j < 8; ++j) y[j] = y[j] * sigmoidf_fast(y[j]);
            *(GAS u32x4*)(MX + (size_t)(b * T_ + t0 + tt) * D + 8 * F.lane) = (u32x4){pk2(y[0], y[1]), pk2(y[2], y[3]), pk2(y[4], y[5]), pk2(y[6], y[7])}; }
        __syncthreads();
    }
}

typedef float f32x16 __attribute__((ext_vector_type(16)));
__device__ __forceinline__ int crow(int r, int hi) { return (r & 3) + 8 * (r >> 2) + 4 * hi; }
__device__ __forceinline__ bf16x8 pack8(const float* v) {
    u32x4 w; w.x = pg8::cvt_pk_bf16(v[0], v[1]); w.y = pg8::cvt_pk_bf16(v[2], v[3]); w.z = pg8::cvt_pk_bf16(v[4], v[5]); w.w = pg8::cvt_pk_bf16(v[6], v[7]);
    return __builtin_bit_cast(bf16x8, w); }
constexpr float SB_EXIT = 150.0f;
struct SbStage { u32x4 k[4], v[4]; };
__device__ __forceinline__ void sb_gload(SbStage& g, const bf16* Kt, const bf16* Vt, int lane) {
#pragma unroll
    for (int i = 0; i < 4; ++i) { const int c = (lane & 7) ^ ((4 * i + (lane >> 4)) & 7); g.k[i] = *(const GAS u32x4*)(Kt + (size_t)(8 * i) * SBW + 8 * c); }
#pragma unroll
    for (int i = 0; i < 4; ++i) g.v[i] = *(const GAS u32x4*)(Vt + (size_t)(16 * i) * M);
}
__device__ __forceinline__ void sb_lwrite(const SbStage& g, LAS unsigned char* buf, int lane) {
#pragma unroll
    for (int i = 0; i < 4; ++i) *(LAS u32x4*)(buf + 1024 * i + 16 * lane) = g.k[i];
#pragma unroll
    for (int i = 0; i < 4; ++i) *(LAS u32x4*)(buf + 4096 + 1024 * i + 16 * lane) = g.v[i];
}
__device__ __forceinline__ void sb_attn_wave(Frame& F, int b, int h, int qt) {
    const int c = F.lane & 31, hi = F.lane >> 5;
    const bf16* Q = (const bf16*)(F.ws + WS_Q); const bf16* Kb = (const bf16*)(F.ws + WS_K); const bf16* VT = (const bf16*)(F.ws + WS_V);
    LAS unsigned char* wbuf = F.lds + RING_OFF + F.wave * 16384;
    bf16x8 tri[2];
#pragma unroll
    for (int s = 0; s < 2; ++s) { bf16x8 t;
#pragma unroll
        for (int j = 0; j < 8; ++j) { const int k = 16 * s + 8 * (j >> 2) + 4 * hi + (j & 3); t[j] = (k >= c) ? (short)0xBF80 : (short)0; }
        tri[s] = t; }
    bf16x8 qf[4];
    { const bf16* qp = Q + ((size_t)b * T_ + 32 * qt + c) * SBW + h * SBD + 8 * hi;
#pragma unroll
        for (int s = 0; s < 4; ++s) qf[s] = *(const GAS bf16x8*)(qp + 16 * s); }
    const bf16* Ksrc = Kb + ((size_t)b * T_ + (F.lane >> 3)) * SBW + h * SBD;
    const bf16* Vsrc = VT + (size_t)(h * SBD + (F.lane >> 2)) * M + (size_t)b * T_ + 8 * ((F.lane & 3) ^ ((F.lane >> 4) & 3));

    const int ksw = (c >> 1) & 7, vsw = (c >> 2) & 3;

    f32x16 o0, o1;
#pragma unroll
    for (int r = 0; r < 16; ++r) { o0[r] = 0.f; o1[r] = 0.f; }
    float carry = 0.f;
    SbStage st;
    sb_gload(st, Ksrc + (size_t)(32 * qt) * SBW, Vsrc + 32 * qt, F.lane); sb_lwrite(st, wbuf, F.lane);
    for (int kt = qt; kt >= 0; --kt) {
        LAS unsigned char* buf = wbuf + ((qt - kt) & 1) * 8192;
        if (kt > 0) sb_gload(st, Ksrc + (size_t)(32 * (kt - 1)) * SBW, Vsrc + 32 * (kt - 1), F.lane);
        const bool diag = (kt == qt);
        bf16x8 kf[4];
#pragma unroll
        for (int s = 0; s < 4; ++s) kf[s] = *(const LAS bf16x8*)(buf + c * 128 + 16 * ((2 * s + hi) ^ ksw));
        f32x16 p;
#pragma unroll
        for (int r = 0; r < 16; ++r) p[r] = 0.f;
#pragma unroll
        for (int s = 0; s < 4; ++s) p = __builtin_amdgcn_mfma_f32_32x32x16_bf16(kf[s], qf[s], p, 0, 0, 0);
        u32x2 vv[2][2][2];
#pragma unroll
        for (int dt = 0; dt < 2; ++dt)
#pragma unroll
            for (int s = 0; s < 2; ++s)
#pragma unroll
                for (int q = 0; q < 2; ++q) vv[dt][s][q] = *(const LAS u32x2*)(buf + 4096 + (32 * dt + c) * 64 + 16 * ((2 * s + q) ^ vsw) + 8 * hi);
        float L[16];
#pragma unroll
        for (int r = 0; r < 16; ++r) { const float y = p[r]; float l = __builtin_amdgcn_logf(1.0f + __builtin_amdgcn_exp2f(y)); l = (y > 64.f) ? y : l;
            if (diag) l = (crow(r, hi) >= c) ? 0.f : l; L[r] = l; }
        const bf16x8 l0 = pack8(L), l1 = pack8(L + 8);
        f32x16 a;
#pragma unroll
        for (int r = 0; r < 16; ++r) a[r] = p[r] - carry;
        a = __builtin_amdgcn_mfma_f32_32x32x16_bf16(tri[0], l0, a, 0, 0, 0); a = __builtin_amdgcn_mfma_f32_32x32x16_bf16(tri[1], l1, a, 0, 0, 0);
        const float tot = p[0] - a[0];
        float w[16];
#pragma unroll
        for (int r = 0; r < 16; ++r) { float x = __builtin_amdgcn_exp2f(a[r]); if (diag) x = (crow(r, hi) >= c) ? 0.f : x; w[r] = x; }
        const bf16x8 p0 = pack8(w), p1 = pack8(w + 8);
        { const bf16x8 v00 = __builtin_bit_cast(bf16x8, (u32x4){vv[0][0][0].x, vv[0][0][0].y, vv[0][0][1].x, vv[0][0][1].y});
          const bf16x8 v01 = __builtin_bit_cast(bf16x8, (u32x4){vv[0][1][0].x, vv[0][1][0].y, vv[0][1][1].x, vv[0][1][1].y});
          const bf16x8 v10 = __builtin_bit_cast(bf16x8, (u32x4){vv[1][0][0].x, vv[1][0][0].y, vv[1][0][1].x, vv[1][0][1].y});
          const bf16x8 v11 = __builtin_bit_cast(bf16x8, (u32x4){vv[1][1][0].x, vv[1][1][0].y, vv[1][1][1].x, vv[1][1][1].y});
          o0 = __builtin_amdgcn_mfma_f32_32x32x16_bf16(v00, p0, o0, 0, 0, 0); o0 = __builtin_amdgcn_mfma_f32_32x32x16_bf16(v01, p1, o0, 0, 0, 0);
          o1 = __builtin_amdgcn_mfma_f32_32x32x16_bf16(v10, p0, o1, 0, 0, 0); o1 = __builtin_amdgcn_mfma_f32_32x32x16_bf16(v11, p1, o1, 0, 0, 0); }
        carry = __shfl(tot, c);
        if (__all(carry >= SB_EXIT)) break;
        if (kt > 0) sb_lwrite(st, wbuf + ((qt - kt + 1) & 1) * 8192, F.lane);
    }
    bf16* op = (bf16*)(F.ws + WS_MIXIN) + ((size_t)b * T_ + 32 * qt + c) * D + CONV_CH + h * SBD + 4 * hi;
#pragma unroll
    for (int g = 0; g < 4; ++g) {
        *(GAS u32x2*)(op + 8 * g) = (u32x2){pg8::cvt_pk_bf16(o0[4 * g], o0[4 * g + 1]), pg8::cvt_pk_bf16(o0[4 * g + 2], o0[4 * g + 3])};
        *(GAS u32x2*)(op + 32 + 8 * g) = (u32x2){pg8::cvt_pk_bf16(o1[4 * g], o1[4 * g + 1]), pg8::cvt_pk_bf16(o1[4 * g + 2], o1[4 * g + 3])}; }
}

__device__ __forceinline__ void resid_row(f32x4 (&v)[4], const bf16* hrow, const bf16* mrow, int lane) {
    f32x4 a[4]; load_row_bf16(v, hrow, lane); load_row_bf16(a, mrow, lane);
#pragma unroll
    for (int j = 0; j < 4; ++j) v[j] = v[j] * DN_ALPHA + a[j];
}
__device__ __forceinline__ void ln_phase(Frame& F, const float* g, const float* b) {
    const int gw = F.vcu * NWAVES + F.wave, NGW = F.G * NWAVES;
    for (int m = gw; m < M; m += NGW) { f32x4 v[4]; bf16* hrow = (bf16*)(F.ws + WS_HB) + (size_t)m * D; resid_row(v, hrow, (const bf16*)(F.ws + WS_QM) + (size_t)m * D, F.lane);
        ln_row(v, g, b, F.lane); store_row_bf16(v, hrow, F.lane);
        { GAS unsigned* h8 = (GAS unsigned*)(F.ws + WS_HB8 + (size_t)m * D) + F.lane;
#pragma unroll
            for (int j = 0; j < 4; ++j) h8[64 * j] = pk4_fp8(v[j].x, v[j].y, v[j].z, v[j].w); } }
}
__device__ __forceinline__ void softmax_phase(Frame& F) {
    const int gw = F.vcu * NWAVES + F.wave, NGW = F.G * NWAVES;
    for (int m = gw; m < M; m += NGW) { GAS u32x2* p = (GAS u32x2*)((bf16*)(F.ws + WS_SP) + (size_t)m * D) + F.lane;
#pragma unroll
        for (int j = 0; j < 4; ++j) { const u32x2 w = p[64 * j]; float x0 = bflo(w.x), x1 = bfhi(w.x), x2 = bflo(w.y), x3 = bfhi(w.y);
            const float mx = wave_max(fmaxf(fmaxf(x0, x1), fmaxf(x2, x3)));
            x0 = __builtin_amdgcn_exp2f(x0 - mx); x1 = __builtin_amdgcn_exp2f(x1 - mx); x2 = __builtin_amdgcn_exp2f(x2 - mx); x3 = __builtin_amdgcn_exp2f(x3 - mx);
            const float inv = 1.0f / wave_sum((x0 + x1) + (x2 + x3));
            p[64 * j] = (u32x2){pk2(x0 * inv, x1 * inv), pk2(x2 * inv, x3 * inv)}; } }
}
__device__ __forceinline__ void xattn_phase(Frame& F) {
    LAS unsigned char* tb0 = F.lds + RING_OFF;
    const bf16* QM = (const bf16*)(F.ws + WS_QM); const bf16* KM = (const bf16*)(F.ws + WS_KM); const bf16* VMT = (const bf16*)(F.ws + WS_VMT); bf16* OB = (bf16*)(F.ws + WS_OB);
    const int c = F.lane & 31, h5 = F.lane >> 5;
    const int tr = F.tid >> 5, tc = F.tid & 31;
    const int kr = F.tid >> 4, kc = F.tid & 15;
    for (int u = F.vcu; u < NB * 4 * 16; u += F.G) {
        const int b = u >> 6, h = (u >> 4) & 3, qt = u & 15;
        const size_t rowq = (size_t)b * T_ + 256 * qt + 32 * F.wave + c;
        const bf16* qp = QM + rowq * D + h * 256 + 8 * h5;
        const bf16* ksrc = KM + ((size_t)b * NMEM + kr) * D + h * 256 + 8 * kc;
        const int kw0 = kr * 272 + kc * 16, kw1 = (kr + 32) * 272 + kc * 16;
        const bf16* vsrc = VMT + ((size_t)h * 256 + tr) * (size_t)MM + (size_t)b * NMEM + 8 * tc;
        int vw[4];
#pragma unroll
        for (int j = 0; j < 4; ++j) vw[j] = (tr + 16 * j) * 528 + tc * 16;
        u32x4 st[4];
        __syncthreads();
        st[0] = *(const GAS u32x4*)ksrc; st[1] = *(const GAS u32x4*)(ksrc + (size_t)32 * D);
        *(LAS u32x4*)(tb0 + kw0) = st[0]; *(LAS u32x4*)(tb0 + kw1) = st[1];
        LDS_WAIT(); __syncthreads();
        f32x16 sacc[8];
#pragma unroll
        for (int dh = 0; dh < 2; ++dh) {
            bf16x8 qf[8];
#pragma unroll
            for (int s_ = 0; s_ < 8; ++s_) qf[s_] = *(const GAS bf16x8*)(qp + 128 * dh + 16 * s_);
#pragma unroll
            for (int kp = 0; kp < 4; ++kp) { const int i = dh * 4 + kp;
                LAS unsigned char* buf = tb0 + (i & 1) * 34816; LAS unsigned char* nbuf = tb0 + ((i + 1) & 1) * 34816;
                if (i < 7) { const bf16* p = ksrc + (size_t)(64 * ((i + 1) & 3)) * D + 128 * ((i + 1) >> 2); st[0] = *(const GAS u32x4*)p; st[1] = *(const GAS u32x4*)(p + (size_t)32 * D); }
                else {
#pragma unroll
                    for (int j = 0; j < 4; ++j) st[j] = *(const GAS u32x4*)(vsrc + (size_t)(16 * j) * MM); }
#pragma unroll
                for (int k2 = 0; k2 < 2; ++k2) { const int kt = 2 * kp + k2;
                    f32x16 a;
                    if (dh == 0) {
#pragma unroll
                        for (int r = 0; r < 16; ++r) a[r] = 0.f; }
                    else a = sacc[kt];
#pragma unroll
                    for (int s_ = 0; s_ < 8; ++s_) { const bf16x8 kf = *(const LAS bf16x8*)(buf + c * 272 + h5 * 16 + (32 * k2 * 272 + 32 * s_)); a = __builtin_amdgcn_mfma_f32_32x32x16_bf16(kf, qf[s_], a, 0, 0, 0); }
                    sacc[kt] = a; }
                if (i < 7) { *(LAS u32x4*)(nbuf + kw0) = st[0]; *(LAS u32x4*)(nbuf + kw1) = st[1]; }
                else {
#pragma unroll
                    for (int j = 0; j < 4; ++j) *(LAS u32x4*)(nbuf + vw[j]) = st[j]; }
                LDS_WAIT(); __syncthreads();
            }
        }
        float mx = sacc[0][0];
#pragma unroll
        for (int kt = 0; kt < 8; ++kt)
#pragma unroll
            for (int r = 0; r < 16; ++r) mx = fmaxf(mx, sacc[kt][r]);
        mx = fmaxf(mx, __shfl_xor(mx, 32));
        float sum = 0.f; bf16x8 pb[8][2];
#pragma unroll
        for (int kt = 0; kt < 8; ++kt) { float p[16];
#pragma unroll
            for (int r = 0; r < 16; ++r) { p[r] = __builtin_amdgcn_exp2f(sacc[kt][r] - mx); sum += p[r]; }
            pb[kt][0] = pack8(p); pb[kt][1] = pack8(p + 8); }
        sum += __shfl_xor(sum, 32);
        const float inv = OB_SC / sum;
        unsigned char* op = (unsigned char*)OB + rowq * D + h * 256 + 4 * h5;
        for (int dp = 0; dp < 4; ++dp) {
            LAS unsigned char* buf = tb0 + (dp & 1) * 34816; LAS unsigned char* nbuf = tb0 + ((dp + 1) & 1) * 34816;
            if (dp < 3) {
#pragma unroll
                for (int j = 0; j < 4; ++j) st[j] = *(const GAS u32x4*)(vsrc + (size_t)(64 * (dp + 1) + 16 * j) * MM); }
#pragma unroll
            for (int d2 = 0; d2 < 2; ++d2) { const int dt = 2 * dp + d2;
                f32x16 o;
#pragma unroll
                for (int r = 0; r < 16; ++r) o[r] = 0.f;
#pragma unroll
                for (int kt = 0; kt < 8; ++kt)
#pragma unroll
                    for (int s2 = 0; s2 < 2; ++s2) { const LAS unsigned char* rp = buf + c * 528 + 8 * h5 + (32 * d2 * 528 + (4 * kt + 2 * s2) * 16);
                        const u32x2 v0 = *(const LAS u32x2*)rp, v1 = *(const LAS u32x2*)(rp + 16);
                        o = __builtin_amdgcn_mfma_f32_32x32x16_bf16(__builtin_bit_cast(bf16x8, (u32x4){v0.x, v0.y, v1.x, v1.y}), pb[kt][s2], o, 0, 0, 0); }
#pragma unroll
                for (int g = 0; g < 4; ++g) *(GAS unsigned*)(op + 32 * dt + 8 * g) = pk4_fp8(o[4 * g] * inv, o[4 * g + 1] * inv, o[4 * g + 2] * inv, o[4 * g + 3] * inv); }
            if (dp < 3) {
#pragma unroll
                for (int j = 0; j < 4; ++j) *(LAS u32x4*)(nbuf + vw[j]) = st[j]; }
            LDS_WAIT(); __syncthreads();
        }
    }
}
typedef float f32x4v __attribute__((ext_vector_type(4)));
__device__ __forceinline__ void ln2_router_phase(Frame& F) {
    LAS bf16* wr = (LAS bf16*)(F.lds + P10_WR);
    LAS float* gb = (LAS float*)(F.lds + P10_GB);
    LAS int* lcnt = (LAS int*)(F.lds + P10_LCNT);
    LAS int* rec = (LAS int*)(F.lds + P10_REC);
    for (int i = F.tid; i < 2 * 32 * WR_STRIDE * 2 / 16; i += 512) *(LAS u32x4*)(F.lds + P10_WR + 16 * i) = *(const GAS u32x4*)(F.ws + WS_WR + 16 * i);
    for (int i = F.tid; i < 512; i += 512) { *(LAS f32x4*)(gb + 4 * i) = ((const GAS f32x4*)(i < 256 ? F.in[I_LN2_G] : F.in[I_LN2_B]))[i & 255]; }
    if (F.tid < 64) lcnt[F.tid] = 0;
    LDS_WAIT(); __syncthreads();
    const bf16* H1 = (const bf16*)(F.ws + WS_HB); const bf16* CA = (const bf16*)(F.ws + WS_QM); bf16* H2 = (bf16*)(F.ws + WS_HB2);
    int* ltok = (int*)(F.ws + WS_LTOK); float* lgate = (float*)(F.ws + WS_LGATE); int* sidx = (int*)(F.ws + WS_SIDX);
    const int fr = F.lane & 15, fq = F.lane >> 4;
    for (int rb = F.vcu; rb < M / 128; rb += F.G) {
        const int m0 = rb * 128 + F.wave * 16;
        float mymean = 0.f, myrstd = 0.f;
        for (int i = 0; i < 16; ++i) { const int m = m0 + i;
            f32x4 v[4]; resid_row(v, H1 + (size_t)m * D, CA + (size_t)m * D, F.lane);
            float s1 = 0.f;
#pragma unroll
            for (int j = 0; j < 4; ++j) s1 += (v[j].x + v[j].y) + (v[j].z + v[j].w);
            const float mean = wave_sum(s1) * (1.f / D); float s2 = 0.f;
#pragma unroll
            for (int j = 0; j < 4; ++j) { v[j] = v[j] - mean; s2 += (v[j].x * v[j].x + v[j].y * v[j].y) + (v[j].z * v[j].z + v[j].w * v[j].w); }
            const float rstd = 1.f / sqrtf(wave_sum(s2) * (1.f / D) + LN_EPS);
            if (fr == i) { mymean = mean; myrstd = rstd; }
#pragma unroll
            for (int j = 0; j < 4; ++j) { const f32x4 gg = *(const LAS f32x4*)(gb + 4 * F.lane + 256 * j), bb = *(const LAS f32x4*)(gb + 1024 + 4 * F.lane + 256 * j); v[j] = v[j] * rstd * gg + bb; }
            store_row_bf16(v, H2 + (size_t)m * D, F.lane);
            { GAS unsigned* h8 = (GAS unsigned*)(F.ws + WS_HB8 + (size_t)m * D) + F.lane;
#pragma unroll
                for (int j = 0; j < 4; ++j) h8[64 * j] = pk4_fp8(v[j].x, v[j].y, v[j].z, v[j].w); }
        }
        f32x4v acc0 = {0.f, 0.f, 0.f, 0.f}, acc1 = {0.f, 0.f, 0.f, 0.f};
        { const bf16* hp = H1 + (size_t)(m0 + fr) * D + 8 * fq; const bf16* cp = CA + (size_t)(m0 + fr) * D + 8 * fq;
            const LAS bf16* wp = wr + fr * WR_STRIDE + 8 * fq; const LAS float* gp = gb + 8 * fq;
            const float sc = myrstd, sh = -mymean * myrstd;
#pragma unroll 2
            for (int s_ = 0; s_ < 32; ++s_) {
                const u32x4 hv = *(const GAS u32x4*)(hp + 32 * s_), cv = *(const GAS u32x4*)(cp + 32 * s_);
                const f32x4 g0 = *(const LAS f32x4*)(gp + 32 * s_), g1 = *(const LAS f32x4*)(gp + 32 * s_ + 4), b0 = *(const LAS f32x4*)(gp + 1024 + 32 * s_), b1 = *(const LAS f32x4*)(gp + 1024 + 32 * s_ + 4);
                float x[8];
                x[0] = bflo(hv.x) * DN_ALPHA + bflo(cv.x); x[1] = bfhi(hv.x) * DN_ALPHA + bfhi(cv.x); x[2] = bflo(hv.y) * DN_ALPHA + bflo(cv.y); x[3] = bfhi(hv.y) * DN_ALPHA + bfhi(cv.y);
                x[4] = bflo(hv.z) * DN_ALPHA + bflo(cv.z); x[5] = bfhi(hv.z) * DN_ALPHA + bfhi(cv.z); x[6] = bflo(hv.w) * DN_ALPHA + bflo(cv.w); x[7] = bfhi(hv.w) * DN_ALPHA + bfhi(cv.w);
                const float gg[8] = {g0.x, g0.y, g0.z, g0.w, g1.x, g1.y, g1.z, g1.w}, bb[8] = {b0.x, b0.y, b0.z, b0.w, b1.x, b1.y, b1.z, b1.w};
                float lo[8]; unsigned hp2[4];
#pragma unroll
                for (int j = 0; j < 8; ++j) x[j] = (x[j] * sc + sh) * gg[j] + bb[j];
#pragma unroll
                for (int j = 0; j < 4; ++j) { hp2[j] = pg8::cvt_pk_bf16(x[2 * j], x[2 * j + 1]); lo[2 * j] = x[2 * j] - bflo(hp2[j]); lo[2 * j + 1] = x[2 * j + 1] - bfhi(hp2[j]); }
                const bf16x8 bhi = __builtin_bit_cast(bf16x8, (u32x4){hp2[0], hp2[1], hp2[2], hp2[3]});
                const bf16x8 blo = pack8(lo);
                const bf16x8 wh0 = *(const LAS bf16x8*)(wp + 32 * s_), wh1 = *(const LAS bf16x8*)(wp + 16 * WR_STRIDE + 32 * s_);
                const bf16x8 wl0 = *(const LAS bf16x8*)(wp + 32 * WR_STRIDE + 32 * s_), wl1 = *(const LAS bf16x8*)(wp + 48 * WR_STRIDE + 32 * s_);
                acc0 = __builtin_amdgcn_mfma_f32_16x16x32_bf16(wh0, bhi, acc0, 0, 0, 0); acc1 = __builtin_amdgcn_mfma_f32_16x16x32_bf16(wh1, bhi, acc1, 0, 0, 0);
                acc0 = __builtin_amdgcn_mfma_f32_16x16x32_bf16(wh0, blo, acc0, 0, 0, 0); acc1 = __builtin_amdgcn_mfma_f32_16x16x32_bf16(wh1, blo, acc1, 0, 0, 0);
                acc0 = __builtin_amdgcn_mfma_f32_16x16x32_bf16(wl0, bhi, acc0, 0, 0, 0); acc1 = __builtin_amdgcn_mfma_f32_16x16x32_bf16(wl1, bhi, acc1, 0, 0, 0);
            } }
        float cand[8]; int eid[8];
        { const f32x4 br0 = *(const GAS f32x4*)(F.in[I_B_ROUTER] + 4 * fq), br1 = *(const GAS f32x4*)(F.in[I_B_ROUTER] + 16 + 4 * fq);
#pragma unroll
            for (int r = 0; r < 4; ++r) { cand[r] = acc0[r] + br0[r]; cand[4 + r] = acc1[r] + br1[r]; eid[r] = 4 * fq + r; eid[4 + r] = 16 + 4 * fq + r; } }
        float tv[TOPK]; int te[TOPK];
#pragma unroll
        for (int k = 0; k < TOPK; ++k) {
            float bv = cand[0]; int bi = eid[0];
#pragma unroll
            for (int r = 1; r < 8; ++r) if (cand[r] > bv) { bv = cand[r]; bi = eid[r]; }
#pragma unroll
            for (int o = 16; o <= 32; o <<= 1) { const float ov = __shfl_xor(bv, o); const int oi = __shfl_xor(bi, o); if (ov > bv || (ov == bv && oi < bi)) { bv = ov; bi = oi; } }
            tv[k] = bv; te[k] = bi;
#pragma unroll
            for (int r = 0; r < 8; ++r) if (eid[r] == bi) cand[r] = -INFINITY;
        }
        float pe[TOPK], ps = 0.f;
#pragma unroll
        for (int k = 0; k < TOPK; ++k) { pe[k] = __expf(tv[k] - tv[0]); ps += pe[k]; }
        if (fq == 0) {
#pragma unroll
            for (int k = 0; k < TOPK; ++k) { const int lr = __hip_atomic_fetch_add(lcnt + te[k], 1, __ATOMIC_RELAXED, __HIP_MEMORY_SCOPE_WORKGROUP);
                LAS int* r = rec + ((F.wave * 16 + fr) * 4 + k) * 4; r[0] = te[k]; r[1] = lr; r[2] = __builtin_bit_cast(int, pe[k] / ps); r[3] = m0 + fr; } }
        LDS_WAIT(); __syncthreads();
        if (F.tid < NE) lcnt[32 + F.tid] = (int)__hip_atomic_fetch_add(F.ctl + CW_ECNT + 64 * F.tid, (unsigned)lcnt[F.tid], RLX_AGENT);
        LDS_WAIT(); __syncthreads();
        { const LAS int* r = rec + (F.wave * 64 + F.lane) * 4; const int e = r[0], pos = lcnt[32 + e] + r[1], tok = r[3];
            if (pos < LCAP) { ltok[e * LCAP + pos] = tok; lgate[e * LCAP + pos] = __builtin_bit_cast(float, r[2]); } sidx[tok * 4 + (F.lane & 3)] = e * LCAP + pos; }
        __syncthreads();
        if (F.tid < 64) lcnt[F.tid] = 0;
        LDS_WAIT(); __syncthreads();
    }
}
__device__ __forceinline__ void final_phase(Frame& F, const LAS int* tb) {
    const int gw = F.vcu * NWAVES + F.wave, NGW = F.G * NWAVES;
    const int* sidx = (const int*)(F.ws + WS_SIDX); const unsigned char* YS = F.ws + WS_YS;
    typedef float f32x2v __attribute__((ext_vector_type(2)));
    for (int m = gw; m < M; m += NGW) { f32x4 v[4]; load_row_bf16(v, (const bf16*)(F.ws + WS_HB2) + (size_t)m * D, F.lane);
#pragma unroll
        for (int j = 0; j < 4; ++j) v[j] = v[j] * DN_ALPHA;
        f32x4 s[4];
#pragma unroll
        for (int j = 0; j < 4; ++j) s[j] = (f32x4){0.f, 0.f, 0.f, 0.f};
#pragma unroll
        for (int k = 0; k < TOPK; ++k) { const int si = sidx[m * 4 + k], e = si / LCAP, pos = si - e * LCAP; const size_t slot = (size_t)tb[e] * 256 + pos;
            const GAS unsigned* yp = (const GAS unsigned*)(YS + slot * D) + F.lane;
#pragma unroll
            for (int j = 0; j < 4; ++j) { const unsigned w = yp[64 * j]; const f32x2v lo = __builtin_amdgcn_cvt_pk_f32_fp8((int)w, false), hi = __builtin_amdgcn_cvt_pk_f32_fp8((int)w, true);
                s[j] = s[j] + (f32x4){lo.x, lo.y, hi.x, hi.y}; } }
#pragma unroll
        for (int j = 0; j < 4; ++j) v[j] = v[j] + s[j] * (1.0f / YS_SC);
        ln_row(v, F.in[I_LN3_G], F.in[I_LN3_B], F.lane); store_row_f32(v, F.hf + (size_t)m * D, F.lane); }
}

struct Args { const float* in[N_IN]; float* out; unsigned char* ws; int ph_lo, ph_hi, li, pad; };
__global__ void __launch_bounds__(NWAVES * 64, 2) mk_fwd(Args args) {
    extern __shared__ __attribute__((aligned(16))) unsigned char lds[];
    Frame F;
    F.lds = (LAS unsigned char*)lds; F.MISC = (volatile LAS unsigned*)(F.lds + MISC_OFF);
    F.tid = threadIdx.x; F.lane = F.tid & 63; F.wave = __builtin_amdgcn_readfirstlane(F.tid >> 6);
    F.G = gridDim.x; { const int bx = blockIdx.x; F.vcu = (F.G % 8 == 0) ? (bx % 8) * (F.G / 8) + bx / 8 : bx; }
    F.ws = args.ws; F.ctl = (gu32*)(args.ws + WS_CTL); F.hf = args.out; F.in = args.in;
    for (int u = F.tid; u < (LDS_BYTES - LDSCTL_OFF) / 4; u += NWAVES * 64) ((LAS unsigned*)(F.lds + LDSCTL_OFF))[u] = 0u;
    __syncthreads();
    XcdBarrier bar; bar.bar = (unsigned*)(F.ctl + CW_BAR) + args.li * XCD_BAR_WORDS; bar.x = 0; bar.st = nullptr;
    const int lo = args.ph_lo, hi = args.ph_hi;
    if (hi - lo > 1) bar = xcd_barrier_post((unsigned*)(F.ctl + CW_BAR) + args.li * XCD_BAR_WORDS, F.MISC + 8);
#ifndef PH_MASK
#define PH_MASK 0xfff
#endif
#define IN(k) (((PH_MASK >> (k)) & 1) && lo <= (k) && (k) < hi)
#ifndef REP_MASK
#define REP_MASK 0
#endif
#define REPS(k) (1 + ((REP_MASK >> (k)) & 1))
#define PH_BEGIN() do { int t_ = threadIdx.x; asm volatile("" : "+v"(t_)); F.tid = t_; F.lane = t_ & 63; } while (0)
#define SEAM(k) do { if (IN(k) && IN((k) + 1)) xcd_barrier(bar); } while (0)
    const char* wsb = (const char*)args.ws;
    LAS int* tb = (LAS int*)(F.lds + TB_OFF);

    if (IN(0)) for (int rep = 0; rep < REPS(0); ++rep) { PH_BEGIN(); p0_prologue(F); __syncthreads(); } SEAM(0);
    if (IN(1)) for (int rep = 0; rep < REPS(1); ++rep) { PH_BEGIN(); SchedP1 S{F.G, (int)blockIdx.x}; EpiP1 E{F.ws, F.in[I_B_IN]};
        pg8::gemm_phase<EpiP1, SchedP1, false>(F.lds + RING_OFF, wsb, D, D, D, S, E, nullptr); } SEAM(1);
    if (IN(2)) for (int rep = 0; rep < REPS(2); ++rep) { PH_BEGIN();
        if (!(args.pad & 1)) conv_phase(F);
        if (args.pad & 2) continue;
        const int gw = F.vcu * NWAVES + F.wave;
        for (int tk = gw; tk < NB * SBH * (T_ / 32); tk += F.G * NWAVES) sb_attn_wave(F, (tk >> 7) >> 3, (tk >> 7) & 7, tk & 127);
    } SEAM(2);
    if (IN(3)) { PH_BEGIN(); SchedPlain S{F.G, (int)blockIdx.x, 128, 4, (unsigned)WS_MIXIN, (unsigned)WS_WOUT_T, TSTEP, TSTEP, 0u, 0u, 0u}; EpiBf16 E{(bf16*)(F.ws + WS_QM), D, 1.0f, F.in[I_B_OUT]};
        pg8::gemm_phase<EpiBf16, SchedPlain, false>(F.lds + RING_OFF, wsb, D, D, D, S, E, nullptr); } SEAM(3);
    if (IN(4)) { PH_BEGIN(); ln_phase(F, F.in[I_LN1_G], F.in[I_LN1_B]); } SEAM(4);
    if (IN(5)) { PH_BEGIN(); SchedPlain S{F.G, (int)blockIdx.x, 128, 4, (unsigned)WS_HB8, (unsigned)WS_WQ_T, TSTEP / 2, TSTEP / 2, 0u, 0u, 0u}; EpiBf16 E{(bf16*)(F.ws + WS_QM), D, MEM_QSCALE / WQ_SC, nullptr};
        pg8::gemm_phase<EpiBf16, SchedPlain, false, true>(F.lds + RING_OFF, wsb, D / 2, D / 2, D / 2, S, E, nullptr); } SEAM(5);
    if (IN(6)) { PH_BEGIN(); xattn_phase(F); } SEAM(6);
    if (IN(7)) { PH_BEGIN(); SchedPlain S{F.G, (int)blockIdx.x, 128, 4, (unsigned)WS_OB, (unsigned)WS_WO_T, TSTEP / 2, TSTEP / 2, 0u, 0u, 0u}; EpiBf16 E{(bf16*)(F.ws + WS_QM), D, 1.0f / (WO_SC * OB_SC), nullptr};
        pg8::gemm_phase<EpiBf16, SchedPlain, false, true>(F.lds + RING_OFF, wsb, D / 2, D / 2, D / 2, S, E, nullptr); } SEAM(7);
    if (IN(8)) { PH_BEGIN(); ln2_router_phase(F); } SEAM(8);
    if (IN(9)) for (int rep = 0; rep < REPS(9); ++rep) { PH_BEGIN(); moe_table(F, tb); SchedMoe S{F.G, (int)blockIdx.x, 8, tb, (unsigned)WS_HB8, (unsigned)WS_WGU_T, 2048u * 1024u, true}; EpiAct E{F.ws + WS_ACT, F.in[I_B_GU]};
        pg8::gemm_phase<EpiAct, SchedMoe, true, true>(F.lds + RING_OFF, wsb, D / 2, D / 2, D / 2, S, E, (const int*)(F.ws + WS_LTOK)); } SEAM(9);
    if (IN(10)) for (int rep = 0; rep < REPS(10); ++rep) { PH_BEGIN(); moe_table(F, tb); SchedMoe S{F.G, (int)blockIdx.x, 4, tb, (unsigned)WS_ACT, (unsigned)WS_WDN_T, 1024u * 1024u, false}; EpiDown E{F.ws + WS_YS, F.in[I_B_DOWN], (const float*)(F.ws + WS_LGATE)};
        pg8::gemm_phase<EpiDown, SchedMoe, false, true>(F.lds + RING_OFF, wsb, D / 2, D / 2, D / 2, S, E, nullptr); } SEAM(10);
    if (IN(11)) { PH_BEGIN(); moe_table(F, tb); final_phase(F, tb); }
#undef IN
#undef SEAM
}

extern "C" void kernel_launch(void* const* d_in, const int* in_sizes, int n_in, void* d_out, int out_size, void* d_ws, size_t ws_size, hipStream_t stream) {
    static int grid = 0;
    if (grid == 0) {
        if (n_in != N_IN || out_size != M * D || ws_size < WS_END) { fprintf(stderr, "kernel_launch: unexpected shapes (n_in %d, out %d, ws %zu)\n", n_in, out_size, ws_size); grid = -1; return; }
        int dev = 0, cus = 0, per_cu = 0;
        if (hipGetDevice(&dev) != hipSuccess || hipDeviceGetAttribute(&cus, hipDeviceAttributeMultiprocessorCount, dev) != hipSuccess) { grid = -1; return; }
        if (hipFuncSetAttribute((const void*)mk_fwd, hipFuncAttributeMaxDynamicSharedMemorySize, LDS_BYTES) != hipSuccess) { fprintf(stderr, "kernel_launch: hipFuncSetAttribute failed\n"); grid = -1; return; }
        if (hipOccupancyMaxActiveBlocksPerMultiprocessor(&per_cu, (const void*)mk_fwd, NWAVES * 64, LDS_BYTES) != hipSuccess || per_cu < 1) fprintf(stderr, "kernel_launch: occupancy query says %d\n", per_cu);
        (void)hipGetLastError();
        grid = cus;
    }
    if (grid < 0) return;
    if (hipMemsetAsync((char*)d_ws + WS_CTL, 0, CTL_ZERO_BYTES, stream) != hipSuccess) return;
    Args a{};
    for (int i = 0; i < N_IN; ++i) a.in[i] = (const float*)d_in[i];
    a.out = (float*)d_out; a.ws = (unsigned char*)d_ws;
#ifdef PROBE_P2
    { a.ph_lo = 0; a.ph_hi = 3; a.li = 0; hipLaunchKernelGGL(mk_fwd, dim3(grid), dim3(NWAVES * 64), LDS_BYTES, stream, a);
      a.ph_lo = 2; a.ph_hi = 3; a.li = 1; a.pad = PROBE_P2; hipLaunchKernelGGL(mk_fwd, dim3(grid), dim3(NWAVES * 64), LDS_BYTES, stream, a); a.pad = 0;
      a.ph_lo = 3; a.ph_hi = NPHASE; a.li = 2; hipLaunchKernelGGL(mk_fwd, dim3(grid), dim3(NWAVES * 64), LDS_BYTES, stream, a); return; }
#endif
    for (int li = 0; li < MK_N_LAUNCHES; ++li) {
        a.ph_lo = (MK_N_LAUNCHES == 1) ? 0 : li; a.ph_hi = (MK_N_LAUNCHES == 1) ? NPHASE : li + 1; a.li = (MK_N_LAUNCHES == 1) ? 0 : li;
        hipLaunchKernelGGL(mk_fwd, dim3(grid), dim3(NWAVES * 64), LDS_BYTES, stream, a);
        if (hipPeekAtLastError() != hipSuccess) { fprintf(stderr, "kernel_launch: launch %d failed\n", li); break; }
    }
#ifdef PROBE_PHASES
    { const int pp[] = {PROBE_PHASES}; for (int ph : pp) { a.ph_lo = ph; a.ph_hi = ph + 1; a.li = 15; hipLaunchKernelGGL(mk_fwd, dim3(grid), dim3(NWAVES * 64), LDS_BYTES, stream, a); } }
#endif
}
```

```cpp
#include <hip/hip_runtime.h>
#include <cstdio>
#include <cstdint>

#ifndef MK_N_LAUNCHES
#define MK_N_LAUNCHES 1
#endif

#define GAS __attribute__((address_space(1)))
#define LAS __attribute__((address_space(3)))
typedef unsigned short bf16;
typedef short bf16x8 __attribute__((ext_vector_type(8)));
typedef float f32x4 __attribute__((ext_vector_type(4)));
typedef float f32x2 __attribute__((ext_vector_type(2)));
typedef unsigned u32x4 __attribute__((ext_vector_type(4)));
typedef unsigned u32x2 __attribute__((ext_vector_type(2)));
typedef GAS unsigned gu32;
#define RLX_AGENT __ATOMIC_RELAXED, __HIP_MEMORY_SCOPE_AGENT
#define LDS_WAIT() asm volatile("s_waitcnt lgkmcnt(0)" ::: "memory")
#define VM_WAIT() asm volatile("s_waitcnt vmcnt(0)" ::: "memory")

constexpr int NB = 8, T_ = 4096, D = 1024, M = NB * T_, NMEM = 256, MM = NB * NMEM;
constexpr int CONV_CH = 512, SBH = 8, SBD = 64, SBW = 512, CWID = 31, NE = 32, TOPK = 4, DFF = 1024;
constexpr int INC = 2560;
constexpr float LN_EPS = 1e-5f;
constexpr float DN_ALPHA = 1.189207115002721f;
constexpr float LOG2E = 1.4426950408889634f;
constexpr float SB_QSCALE = 0.125f * LOG2E;
constexpr float MEM_QSCALE = 0.0625f * LOG2E;
constexpr float WGU_SC = 32.0f, WDN_SC = 64.0f, WQ_SC = 32.0f, WO_SC = 64.0f, OB_SC = 16.0f, YS_SC = 16.0f;
constexpr float WGU_SC_UNUSED = 0.f;
constexpr int NBLK_MAX = M * TOPK / 256 + NE;
constexpr int LCAP = M;

constexpr size_t MiB = 1u << 20;
constexpr size_t WS_CTL = 0, CTL_ZERO_BYTES = 1 * MiB;
constexpr size_t WS_WIN_T = 1 * MiB;
constexpr size_t WS_WOUT_T = 6 * MiB;
constexpr size_t WS_WQ_T = 8 * MiB, WS_WK_T = 10 * MiB, WS_WV_T = 12 * MiB, WS_WO_T = 14 * MiB;
constexpr size_t WS_WGU_T = 16 * MiB;
constexpr size_t WS_WDN_T = 144 * MiB;
constexpr size_t WS_HB8 = 176 * MiB;
constexpr size_t WS_HB = 208 * MiB;
constexpr size_t WS_LTOK = 272 * MiB;
constexpr size_t WS_LGATE = 276 * MiB;
constexpr size_t WS_SIDX = 280 * MiB;
constexpr size_t WS_WR = 281 * MiB;
constexpr size_t WS_HB2 = 832 * MiB;
constexpr size_t WS_X = 288 * MiB;
constexpr size_t WS_U = WS_X;
constexpr size_t WS_Q = WS_X + 32 * MiB;
constexpr size_t WS_K = WS_X + 64 * MiB;
constexpr size_t WS_V = WS_X + 96 * MiB;
constexpr size_t WS_MIXIN = WS_X + 128 * MiB;
constexpr size_t WS_QM = WS_X + 192 * MiB;
constexpr size_t WS_SP = WS_X + 256 * MiB;
constexpr size_t WS_OB = WS_X + 320 * MiB;
constexpr size_t WS_MEMN = WS_X + 384 * MiB;
constexpr size_t WS_KM = WS_X + 388 * MiB;
constexpr size_t WS_VMT = WS_X + 392 * MiB;
constexpr size_t WS_ACT = WS_X;
constexpr size_t WS_YS = WS_X + 272 * MiB;
constexpr size_t WS_END = 896 * MiB;
constexpr int CW_TMO = 0, CW_CODE = 1;
constexpr int CW_BAR = 4096;
constexpr int CW_ECNT = 131072;
constexpr int NPHASE = 12;

constexpr int RING_OFF = 0, RING_BYTES = 131072;
constexpr int LDS_BYTES = 163840;
constexpr int LDSCTL_OFF = LDS_BYTES - 1024, MISC_OFF = LDSCTL_OFF + 320;
constexpr int XTRA_OFF = RING_BYTES;
constexpr int TB_OFF = XTRA_OFF + 20480;
constexpr int WR_STRIDE = 1032;
constexpr int P10_WR = 0, P10_GB = 2 * 32 * WR_STRIDE * 2, P10_LCNT = P10_GB + 8192, P10_REC = P10_LCNT + 512;
static_assert(P10_REC + 8192 <= TB_OFF && TB_OFF + 4 * (128 + 544) <= LDSCTL_OFF, "LDS map");
constexpr int NWAVES = 8;

__device__ __forceinline__ unsigned f2bf(float f) { unsigned u = __builtin_bit_cast(unsigned, f); return (u + 0x7fffu + ((u >> 16) & 1u)) >> 16; }
__device__ __forceinline__ unsigned pk2(float lo, float hi) { return f2bf(lo) | (f2bf(hi) << 16); }
__device__ __forceinline__ float bflo(unsigned u) { return __builtin_bit_cast(float, u << 16); }
__device__ __forceinline__ float bfhi(unsigned u) { return __builtin_bit_cast(float, u & 0xffff0000u); }
__device__ __forceinline__ float wave_sum(float v) {
#pragma unroll
    for (int o = 1; o < 64; o <<= 1) v += __shfl_xor(v, o);
    return v;
}
__device__ __forceinline__ float wave_max(float v) {
#pragma unroll
    for (int o = 1; o < 64; o <<= 1) v = fmaxf(v, __shfl_xor(v, o));
    return v;
}
__device__ __forceinline__ unsigned pk4_fp8(float a, float b, float c, float d) {
    int r = __builtin_amdgcn_cvt_pk_fp8_f32(a, b, 0, false); r = __builtin_amdgcn_cvt_pk_fp8_f32(c, d, r, true); return (unsigned)r; }
__device__ __forceinline__ float sigmoidf_fast(float x) { return __builtin_amdgcn_rcpf(1.0f + __expf(-x)); }

namespace pg8 {
constexpr int BM = 256, BK = 64, HALF = 128, HTB = HALF * BK * 2, STAGE_BYTES = 8 * HTB, NXCD = 8, WGM = 8;
__host__ __device__ __forceinline__ int lds_byte(int r, int c) { const int st = (r >> 4) * 2 + (c >> 5), rr = r & 15, cc = c & 31, ob = rr * 64 + cc * 2; return st * 1024 + (ob ^ (((ob >> 9) & 1) << 5)); }
__host__ __device__ __forceinline__ void stage_rc(int b, int& R, int& C) { const int st = b / 1024, sb = b % 1024, swz = sb ^ (((sb >> 9) & 1) << 5); R = (st >> 1) * 16 + swz / 64; C = (st & 1) * 32 + (swz % 64) / 2; }
__host__ __device__ __forceinline__ int perm32(int rho) { const int n = rho >> 4, i = rho & 15; return 8 * (i >> 2) + 4 * n + (i & 3); }

struct Unit { int pm, pn, z, nvalid; unsigned aoff, boff, goff; };

__device__ __forceinline__ void tile_order(int L, int nM, int nN, int& pm, int& pn) {
    const int nwg = nM * nN; int wgid = L;
    { const int q = nwg / NXCD, r = nwg % NXCD, xcd = wgid % NXCD, off = wgid / NXCD; wgid = (xcd < r ? xcd * (q + 1) : r * (q + 1) + (xcd - r) * q) + off; }
    const int nig = WGM * nN, gid = wgid / nig, fm = gid * WGM, gsz = (nM - fm) < WGM ? (nM - fm) : WGM;
    pm = fm + ((wgid % nig) % gsz); pn = (wgid % nig) / gsz;
}
__device__ __forceinline__ unsigned cvt_pk_bf16(float lo, float hi) { unsigned r; asm volatile("v_cvt_pk_bf16_f32 %0, %1, %2" : "=v"(r) : "v"(lo), "v"(hi)); return r; }

__device__ __forceinline__ void store_tile_bf16(const f32x4 (&acc)[2][2][4][2], bf16* p0, size_t ldc, const float* bias, float scale, int wc, int fq) {
    const int cl = wc * 32 + 8 * fq;
    f32x4 bv[2][2];
#pragma unroll
    for (int bj = 0; bj < 2; ++bj)
#pragma unroll
        for (int n = 0; n < 2; ++n) bv[bj][n] = bias ? *(const f32x4*)(bias + cl + bj * HALF + 4 * n) : (f32x4){0.f, 0.f, 0.f, 0.f};
#pragma unroll
    for (int ai = 0; ai < 2; ++ai)
#pragma unroll
        for (int m = 0; m < 4; ++m) { bf16* rowp = p0 + (size_t)(ai * HALF + m * 16) * ldc + cl;
#pragma unroll
            for (int bj = 0; bj < 2; ++bj) { const f32x4 v0 = (acc[ai][bj][m][0] + bv[bj][0]) * scale, v1 = (acc[ai][bj][m][1] + bv[bj][1]) * scale;
                u32x4 w; w.x = cvt_pk_bf16(v0[0], v0[1]); w.y = cvt_pk_bf16(v0[2], v0[3]); w.z = cvt_pk_bf16(v1[0], v1[1]); w.w = cvt_pk_bf16(v1[2], v1[3]);
                *(u32x4*)(rowp + bj * HALF) = w; } }
}

typedef int v8i __attribute__((ext_vector_type(8)));
#ifndef PG8_ALIGN
#define PG8_ALIGN true
#endif
template <class Epi, class Sched, bool GATHER, bool FP8 = false, bool ALIGN_EPI = PG8_ALIGN>
__device__ __forceinline__ void gemm_phase(LAS unsigned char* lds, const char* wsb, const int lda, const int ldb, const int K, const Sched& S, const Epi& E, const int* glist) {
    int tid = threadIdx.x; asm volatile("" : "+v"(tid));
    const int wid = __builtin_amdgcn_readfirstlane(tid >> 6), lane = tid & 63, wr = wid >> 2, wc = wid & 3, fr = lane & 15, fq = lane >> 4;
    const int nt = K / BK;
    unsigned voffA[2], voffB[2];
#pragma unroll
    for (int i = 0; i < 2; ++i) { int R, C; stage_rc(tid * 16 + i * 8192, R, C); const int Rb = Epi::PERM ? ((R & ~31) + perm32(R & 31)) : R;
        voffA[i] = (unsigned)(R * lda + C) * 2u; voffB[i] = (unsigned)(Rb * ldb + C) * 2u; }
    const size_t kstep = (size_t)(BK * 2);
    const size_t hstepA = (size_t)HALF * lda * 2, hstepB = (size_t)HALF * ldb * 2;
    const unsigned ldsw = (unsigned)wid * 1024u;
    const int aoff = lds_byte(wr * 64 + fr, fq * 8), boff = lds_byte(wc * 32 + fr, fq * 8);
    unsigned gc[2][2], gn[2][2];
#define PG8_SA(b, h) (((b) * 2 + (h)) * HTB)
#define PG8_SB(b, h) ((4 + (b) * 2 + (h)) * HTB)
#define PG8_STAGE_B(bufoff, gbase) do { _Pragma("unroll") for (int _i = 0; _i < 2; ++_i) \
        __builtin_amdgcn_global_load_lds((const unsigned*)((const char*)(gbase) + voffB[_i]), (LAS unsigned*)(lds + (bufoff) + ldsw + _i * 8192), 16, 0, 0); } while (0)
#define PG8_STAGE_A(bufoff, gbase, h, nx) do { _Pragma("unroll") for (int _i = 0; _i < 2; ++_i) { \
        const char* _p = GATHER ? (const char*)(gbase) + ((nx) ? gn[h][_i] : gc[h][_i]) : (const char*)(gbase) + (h) * hstepA + voffA[_i]; \
        __builtin_amdgcn_global_load_lds((const unsigned*)_p, (LAS unsigned*)(lds + (bufoff) + ldsw + _i * 8192), 16, 0, 0); } } while (0)
#define PG8_LDA(dst, b, h) do { _Pragma("unroll") for (int m = 0; m < 4; ++m) { if constexpr (FP8) { const u32x4 _lo = *(const LAS u32x4*)(lds + PG8_SA(b, h) + aoff + m * 2048), _hi = *(const LAS u32x4*)(lds + PG8_SA(b, h) + aoff + m * 2048 + 1024); \
            dst##8[m] = (v8i){(int)_lo.x, (int)_lo.y, (int)_lo.z, (int)_lo.w, (int)_hi.x, (int)_hi.y, (int)_hi.z, (int)_hi.w}; } \
        else { _Pragma("unroll") for (int k = 0; k < 2; ++k) dst[m][k] = *(const LAS bf16x8*)(lds + PG8_SA(b, h) + aoff + m * 2048 + k * 1024); } } } while (0)
#define PG8_LDB(dst, b, h) do { _Pragma("unroll") for (int n = 0; n < 2; ++n) { if constexpr (FP8) { const u32x4 _lo = *(const LAS u32x4*)(lds + PG8_SB(b, h) + boff + n * 2048), _hi = *(const LAS u32x4*)(lds + PG8_SB(b, h) + boff + n * 2048 + 1024); \
            dst##8[n] = (v8i){(int)_lo.x, (int)_lo.y, (int)_lo.z, (int)_lo.w, (int)_hi.x, (int)_hi.y, (int)_hi.z, (int)_hi.w}; } \
        else { _Pragma("unroll") for (int k = 0; k < 2; ++k) dst[n][k] = *(const LAS bf16x8*)(lds + PG8_SB(b, h) + boff + n * 2048 + k * 1024); } } } while (0)
#define PG8_MMA(ai, bj, At, Bt) do { __builtin_amdgcn_s_setprio(1); if constexpr (FP8) asm volatile("s_nop 1"); _Pragma("unroll") for (int m = 0; m < 4; ++m) _Pragma("unroll") for (int n = 0; n < 2; ++n) { \
        if constexpr (FP8) asm volatile("v_mfma_f32_16x16x128_f8f6f4 %0, %1, %2, %0" : "+v"(acc[ai][bj][m][n]) : "v"(Bt##8[n]), "v"(At##8[m])); \
        else { _Pragma("unroll") for (int k = 0; k < 2; ++k) acc[ai][bj][m][n] = __builtin_amdgcn_mfma_f32_16x16x32_bf16(Bt[n][k], At[m][k], acc[ai][bj][m][n], 0, 0, 0); } } \
        __builtin_amdgcn_s_setprio(0); } while (0)
#define PG8_WAIT_V(n) asm volatile("s_waitcnt vmcnt(" #n ")" ::: "memory")
#define PG8_WAIT_L(n) asm volatile("s_waitcnt lgkmcnt(" #n ")" ::: "memory")
#define PG8_BAR __builtin_amdgcn_s_barrier()
#define PG8_SCHED __builtin_amdgcn_sched_barrier(0)
#define PG8_GIDX(g, u) do { _Pragma("unroll") for (int _h = 0; _h < 2; ++_h) _Pragma("unroll") for (int _i = 0; _i < 2; ++_i) { int _R, _C; stage_rc(tid * 16 + _i * 8192, _R, _C); const int _r = _h * HALF + _R; \
        const int _tok = glist[(u).goff + (_r < (u).nvalid ? _r : (u).nvalid - 1)]; g[_h][_i] = (unsigned)_tok * (unsigned)(lda * 2) + (unsigned)(_C * 2); } } while (0)
    Unit cur, nxt, nn; int ui = 0;
    if (!S.next(0, cur)) return;
    f32x4 acc[2][2][4][2];
#pragma unroll
    for (int a = 0; a < 2; ++a)
#pragma unroll
        for (int b = 0; b < 2; ++b)
#pragma unroll
            for (int m = 0; m < 4; ++m)
#pragma unroll
                for (int n = 0; n < 2; ++n) acc[a][b][m][n] = (f32x4){0.f, 0.f, 0.f, 0.f};
    bf16x8 At[4][2], B0[2][2], B1[2][2];
    v8i At8[4], B08[2], B18[2];
    const char* cA = wsb + cur.aoff; const char* cB = wsb + cur.boff;
    if constexpr (GATHER) { PG8_GIDX(gc, cur); if (S.next(1, nxt)) { PG8_GIDX(gn, nxt); } else { PG8_GIDX(gn, cur); }
        asm volatile("s_waitcnt vmcnt(0)" : "+v"(gc[0][0]), "+v"(gc[0][1]), "+v"(gc[1][0]), "+v"(gc[1][1]), "+v"(gn[0][0]), "+v"(gn[0][1]), "+v"(gn[1][0]), "+v"(gn[1][1]) :: "memory"); }
    else {
#pragma unroll
        for (int h = 0; h < 2; ++h)
#pragma unroll
            for (int i = 0; i < 2; ++i) { gc[h][i] = 0u; gn[h][i] = 0u; } }
    PG8_STAGE_B(PG8_SB(0, 0), cB); PG8_STAGE_B(PG8_SB(0, 1), cB + hstepB); PG8_STAGE_A(PG8_SA(0, 0), cA, 0, false); PG8_STAGE_A(PG8_SA(0, 1), cA, 1, false);
    if (wr == 1) PG8_BAR;
    PG8_WAIT_V(2); PG8_BAR;
    PG8_STAGE_B(PG8_SB(1, 0), cB + kstep); PG8_STAGE_A(PG8_SA(1, 0), cA + kstep, 0, false); PG8_STAGE_B(PG8_SB(1, 1), cB + hstepB + kstep);
    PG8_WAIT_V(6); PG8_BAR;
    for (;;) {
        const bool has_next = S.next(ui + 1, nxt);
        const char* nA = has_next ? wsb + nxt.aoff : cA; const char* nB = has_next ? wsb + nxt.boff : cB;
#pragma clang loop unroll(disable)
        for (int t = 0; t < nt; t += 2) {
            const bool last = (t == nt - 2);
            const char* a1 = cA + (size_t)(t + 1) * kstep;
            const char* a2 = last ? nA : cA + (size_t)(t + 2) * kstep; const char* b2 = last ? nB : cB + (size_t)(t + 2) * kstep;
            const char* a3 = a2 + kstep; const char* b3 = b2 + kstep;
            PG8_LDB(B0, 0, 0); PG8_LDB(B1, 0, 1); PG8_SCHED; PG8_LDA(At, 0, 0); PG8_STAGE_A(PG8_SA(1, 1), a1, 1, false);
            PG8_WAIT_V(8); PG8_WAIT_L(0); PG8_BAR; PG8_MMA(0, 0, At, B0); PG8_MMA(0, 1, At, B1); PG8_BAR; PG8_SCHED;
            PG8_LDA(At, 0, 1); PG8_STAGE_B(PG8_SB(0, 0), b2); PG8_STAGE_B(PG8_SB(0, 1), b2 + hstepB); PG8_STAGE_A(PG8_SA(0, 0), a2, 0, last);
            PG8_WAIT_V(8); PG8_WAIT_L(0); PG8_BAR; PG8_MMA(1, 0, At, B0); PG8_MMA(1, 1, At, B1); PG8_BAR; PG8_SCHED;
            PG8_LDB(B0, 1, 0); PG8_LDB(B1, 1, 1); PG8_SCHED; PG8_LDA(At, 1, 0); PG8_STAGE_A(PG8_SA(0, 1), a2, 1, last);
            PG8_WAIT_V(8); PG8_WAIT_L(0); PG8_BAR; PG8_MMA(0, 0, At, B0); PG8_MMA(0, 1, At, B1); PG8_BAR; PG8_SCHED;
            PG8_LDA(At, 1, 1); PG8_STAGE_B(PG8_SB(1, 0), b3); PG8_STAGE_B(PG8_SB(1, 1), b3 + hstepB); PG8_STAGE_A(PG8_SA(1, 0), a3, 0, last);
            PG8_WAIT_V(8); PG8_WAIT_L(0); PG8_BAR; PG8_MMA(1, 0, At, B0); PG8_MMA(1, 1, At, B1); PG8_BAR; PG8_SCHED;
        }
        if constexpr (FP8) asm volatile("s_nop 15\n\ts_nop 7");
        if constexpr (ALIGN_EPI) { if (wr == 0) PG8_BAR; }
        if constexpr (GATHER) {
#pragma unroll
            for (int h = 0; h < 2; ++h)
#pragma unroll
                for (int i = 0; i < 2; ++i) gc[h][i] = gn[h][i];
            if (has_next && S.next(ui + 2, nn)) { PG8_GIDX(gn, nn); }
        }
        E(acc, cur, wr, wc, fr, fq);
        if constexpr (GATHER) asm volatile("" : "+v"(gn[0][0]), "+v"(gn[0][1]), "+v"(gn[1][0]), "+v"(gn[1][1]));
        if (!has_next) break;
#pragma unroll
        for (int a = 0; a < 2; ++a)
#pragma unroll
            for (int b = 0; b < 2; ++b)
#pragma unroll
                for (int m = 0; m < 4; ++m)
#pragma unroll
                    for (int n = 0; n < 2; ++n) acc[a][b][m][n] = (f32x4){0.f, 0.f, 0.f, 0.f};
        cur = nxt; cA = nA; cB = nB; ++ui;
        if constexpr (ALIGN_EPI) { if (wr == 1) PG8_BAR; }
    }
    PG8_WAIT_V(0);
    if constexpr (!ALIGN_EPI) { if (wr == 0) PG8_BAR; }
    PG8_BAR;
#undef PG8_SA
#undef PG8_SB
#undef PG8_STAGE_A
#undef PG8_STAGE_B
#undef PG8_LDA
#undef PG8_LDB
#undef PG8_MMA
#undef PG8_WAIT_V
#undef PG8_WAIT_L
#undef PG8_BAR
#undef PG8_SCHED
#undef PG8_GIDX
}
}
using pg8::Unit;

#define XB_TMO      128
#define XB_XCNT(j)  (256  + 64 * (j))
#define XB_XSUB(j)  (1280 + 64 * (j))
#define XB_XGEN(j)  (2304 + 64 * (j))
#define XB_TOP      3328
#define XB_TOPGEN   3392
#define XCD_BAR_WORDS 3456
#define XB_SPIN_CAP (1u << 18)
__device__ __forceinline__ unsigned xb_ld(unsigned* p)              { return __hip_atomic_load(p, __ATOMIC_RELAXED, __HIP_MEMORY_SCOPE_AGENT); }
__device__ __forceinline__ unsigned xb_add(unsigned* p, unsigned v) { return __hip_atomic_fetch_add(p, v, __ATOMIC_RELAXED, __HIP_MEMORY_SCOPE_AGENT); }
__device__ __forceinline__ unsigned xb_xcc_id() { return (unsigned)__builtin_amdgcn_s_getreg((3 << 11) | 20) & 0xFu; }
#define XB_SPIN(cond, bar) do { unsigned _sp = 0; while (cond) { __builtin_amdgcn_s_sleep(1); \
    if ((++_sp & 255u) == 0u) { if (xb_ld(&(bar)[XB_TMO])) break; if (_sp > XB_SPIN_CAP) { atomicAdd(&(bar)[XB_TMO], 1u); break; } } } } while (0)
struct XcdBarrier { unsigned* bar; unsigned x; volatile LAS unsigned* st; };
__device__ __forceinline__ XcdBarrier xcd_barrier_post(unsigned* bar, volatile LAS unsigned* st) {
    XcdBarrier b; b.bar = bar; b.x = xb_xcc_id(); b.st = st;
    if (threadIdx.x == 0) (void)xb_add(&bar[XB_XCNT(b.x)], 1u);
    return b;
}
__device__ __forceinline__ void xcd_barrier_complete(unsigned* bar, unsigned x, unsigned& nloc, unsigned& nx) {
    const unsigned G = gridDim.x * gridDim.y * gridDim.z;
    unsigned sum, cnt, mine, sp = 0u;
    for (;;) {
        sum = 0u; cnt = 0u; mine = 0u;
#pragma unroll
        for (unsigned j = 0; j < 16; ++j) { const unsigned c = xb_ld(&bar[XB_XCNT(j)]); sum += c; cnt += (c > 0u) ? 1u : 0u; mine = (j == x) ? c : mine; }
        if (sum == G) break;
        __builtin_amdgcn_s_sleep(1);
        if ((++sp & 255u) == 0u) { if (xb_ld(&bar[XB_TMO])) break; if (sp > XB_SPIN_CAP) { atomicAdd(&bar[XB_TMO], 1u); break; } }
    }
    nloc = mine > 0u ? mine : 1u; nx = cnt > 0u ? cnt : 1u;
}
__device__ __forceinline__ void xcd_barrier(const XcdBarrier& b) {
    asm volatile("s_waitcnt vmcnt(0)" ::: "memory");
    __syncthreads();
    if (threadIdx.x == 0) {
        unsigned* bar = b.bar;
        __builtin_amdgcn_s_waitcnt(0);
        unsigned nloc = b.st[0], nx = b.st[1];
        if (nloc == 0u) { xcd_barrier_complete(bar, b.x, nloc, nx); b.st[0] = nloc; b.st[1] = nx; }
        const unsigned old = xb_add(&bar[XB_XSUB(b.x)], 1u);
        const unsigned gen = old / nloc;
        if (old + 1u == (gen + 1u) * nloc) {
            __builtin_amdgcn_fence(__ATOMIC_RELEASE, "agent");
            asm volatile("s_waitcnt vmcnt(0)" ::: "memory");
            const unsigned og = xb_add(&bar[XB_TOP], 1u);
            const unsigned tg = og / nx;
            if (og + 1u == (tg + 1u) * nx) xb_add(&bar[XB_TOPGEN], 1u);
            else XB_SPIN(xb_ld(&bar[XB_TOPGEN]) == tg, bar);
            __builtin_amdgcn_fence(__ATOMIC_ACQUIRE, "agent");
            xb_add(&bar[XB_XGEN(b.x)], 1u);
            asm volatile("s_waitcnt vmcnt(0)" ::: "memory");
        } else {
            XB_SPIN(xb_ld(&bar[XB_XGEN(b.x)]) == gen, bar);
            __builtin_amdgcn_fence(__ATOMIC_ACQUIRE, "agent");
            asm volatile("s_waitcnt vmcnt(0)" ::: "memory");
        }
    }
    __syncthreads();
}

struct Frame {
    LAS unsigned char* lds;
    volatile LAS unsigned* MISC;
    gu32* ctl;
    unsigned char* ws;
    int tid, lane, wave, vcu, G;
    float* hf;
    const float* const* in;
};
enum In { I_X = 0, I_MEM, I_LN_IN_G, I_LN_IN_B, I_LN_MEM_G, I_LN_MEM_B, I_W_IN, I_B_IN, I_W_DW, I_B_DW, I_LN_CONV_G, I_LN_CONV_B, I_W_OUT, I_B_OUT, I_LN1_G, I_LN1_B,
          I_WQ, I_WK, I_WV, I_WO, I_LN2_G, I_LN2_B, I_W_ROUTER, I_B_ROUTER, I_W_GU, I_B_GU, I_W_DOWN, I_B_DOWN, I_LN3_G, I_LN3_B, N_IN };

__device__ __forceinline__ void p0_transpose_item(const float* W, int K, int N, bf16* WT, int k0, int n0, int drow, LAS float* scr, int lane) {
#pragma unroll 8
    for (int i = 0; i < 32; ++i) { const int kk = 2 * i + (lane >> 5); scr[kk * 33 + (lane & 31)] = W[(size_t)(k0 + kk) * N + n0 + (lane & 31)]; }
    LDS_WAIT(); asm volatile("" ::: "memory");
    const int c = lane & 7;
#pragma unroll
    for (int j = 0; j < 4; ++j) { const int n = (lane >> 3) + 8 * j; const LAS float* s = scr + (8 * c) * 33 + n;
        u32x4 o; o.x = pk2(s[0 * 33], s[1 * 33]); o.y = pk2(s[2 * 33], s[3 * 33]); o.z = pk2(s[4 * 33], s[5 * 33]); o.w = pk2(s[6 * 33], s[7 * 33]);
        *(GAS u32x4*)(WT + (size_t)(drow + n) * K + k0 + 8 * c) = o; }
    LDS_WAIT(); asm volatile("" ::: "memory");
}
__device__ __forceinline__ void ln_row(f32x4 (&v)[4], const float* g, const float* b, int lane) {
    float s = 0.f;
#pragma unroll
    for (int j = 0; j < 4; ++j) s += (v[j].x + v[j].y) + (v[j].z + v[j].w);
    const float mean = wave_sum(s) * (1.f / D); float s2 = 0.f;
#pragma unroll
    for (int j = 0; j < 4; ++j) { v[j] = v[j] - mean; s2 += (v[j].x * v[j].x + v[j].y * v[j].y) + (v[j].z * v[j].z + v[j].w * v[j].w); }
    const float rstd = 1.f / sqrtf(wave_sum(s2) * (1.f / D) + LN_EPS);
#pragma unroll
    for (int j = 0; j < 4; ++j) { const f32x4 gg = ((const GAS f32x4*)g)[lane + 64 * j], bb = ((const GAS f32x4*)b)[lane + 64 * j]; v[j] = v[j] * rstd * gg + bb; }
}
__device__ __forceinline__ void store_row_bf16(const f32x4 (&v)[4], bf16* orow, int lane) {
    GAS u32x2* o8 = (GAS u32x2*)orow + lane;
#pragma unroll
    for (int j = 0; j < 4; ++j) o8[64 * j] = (u32x2){pk2(v[j].x, v[j].y), pk2(v[j].z, v[j].w)};
}
__device__ __forceinline__ void p0_transpose_item8(const float* W, int K, int N, unsigned char* WT, int k0, int n0, int drow, float sc, LAS float* scr, int lane) {
#pragma unroll 8
    for (int i = 0; i < 32; ++i) { const int kk = 2 * i + (lane >> 5); scr[kk * 33 + (lane & 31)] = W[(size_t)(k0 + kk) * N + n0 + (lane & 31)]; }
    LDS_WAIT(); asm volatile("" ::: "memory");
    const int c = lane & 7;
#pragma unroll
    for (int j = 0; j < 4; ++j) { const int n = (lane >> 3) + 8 * j; const LAS float* s = scr + (8 * c) * 33 + n;
        u32x2 o; o.x = pk4_fp8(s[0 * 33] * sc, s[1 * 33] * sc, s[2 * 33] * sc, s[3 * 33] * sc); o.y = pk4_fp8(s[4 * 33] * sc, s[5 * 33] * sc, s[6 * 33] * sc, s[7 * 33] * sc);
        *(GAS u32x2*)(WT + (size_t)(drow + n) * K + k0 + 8 * c) = o; }
    LDS_WAIT(); asm volatile("" ::: "memory");
}
__device__ __forceinline__ void item8_load(f32x4 (&x)[4][4], const float* W, int N, int k0, int n0, int lane) {
    const int g = lane >> 3, c = lane & 7;
#pragma unroll
    for (int q = 0; q < 4; ++q)
#pragma unroll
        for (int j = 0; j < 4; ++j) x[q][j] = *(const GAS f32x4*)(W + (size_t)(k0 + 32 * q + 4 * g + j) * N + n0 + 4 * c);
}
__device__ __forceinline__ void item8_finish(const f32x4 (&x)[4][4], int K, unsigned char* WT, int k0, int drow, float sc, LAS unsigned char* scr, int lane) {
    const int g = lane >> 3, c = lane & 7;
#pragma unroll
    for (int q = 0; q < 4; ++q)
#pragma unroll
        for (int e = 0; e < 4; ++e) *(LAS unsigned*)(scr + (4 * c + e) * 144 + 32 * q + 4 * g) = pk4_fp8(x[q][0][e] * sc, x[q][1][e] * sc, x[q][2][e] * sc, x[q][3][e] * sc);
    LDS_WAIT(); asm volatile("" ::: "memory");
#pragma unroll
    for (int i = 0; i < 4; ++i) { const int t = lane + 64 * i, n = t >> 3, ch = t & 7;
        *(GAS u32x4*)(WT + (size_t)(drow + n) * K + k0 + 16 * ch) = *(const LAS u32x4*)(scr + n * 144 + 16 * ch); }
    LDS_WAIT(); asm volatile("" ::: "memory");
}
__device__ __forceinline__ void p0_transpose_item8b(const float* W, int K, int N, unsigned char* WT, int k0, int n0, int drow, float sc, LAS unsigned char* scr, int lane) {
    f32x4 x[4][4]; item8_load(x, W, N, k0, n0, lane); item8_finish(x, K, WT, k0, drow, sc, scr, lane);
}
__device__ __forceinline__ void load_row_bf16(f32x4 (&v)[4], const bf16* xrow, int lane) {
    const GAS u32x2* xr = (const GAS u32x2*)xrow + lane;
#pragma unroll
    for (int j = 0; j < 4; ++j) { const u32x2 w = xr[64 * j]; v[j] = (f32x4){bflo(w.x), bfhi(w.x), bflo(w.y), bfhi(w.y)}; }
}
__device__ __forceinline__ void load_row_f32(f32x4 (&v)[4], const float* xrow, int lane) {
    const GAS f32x4* xr = (const GAS f32x4*)xrow + lane;
#pragma unroll
    for (int j = 0; j < 4; ++j) v[j] = xr[64 * j];
}
__device__ __forceinline__ void store_row_f32(const f32x4 (&v)[4], float* orow, int lane) {
    GAS f32x4* o = (GAS f32x4*)orow + lane;
#pragma unroll
    for (int j = 0; j < 4; ++j) o[64 * j] = v[j];
}

constexpr int I_GU = NE * 8 * 64, I_DN = NE * 8 * 32, N_EXPERT_ITEMS = I_GU + I_DN;
struct ExpItem { const float* W; unsigned char* WT; int K, N, k0, n0, drow; float sc; };
__device__ __forceinline__ ExpItem expert_item_decode(Frame& F, int it) {
    ExpItem x;
    if (it < I_GU) { const int e = it / (8 * 64), q = it % (8 * 64), kb = q / 64, nb = q % 64, n0 = 32 * nb;
        x.W = F.in[I_W_GU] + (size_t)e * D * 2 * DFF; x.WT = F.ws + WS_WGU_T + (size_t)e * 2 * DFF * D; x.K = D; x.N = 2 * DFF; x.k0 = 128 * kb; x.n0 = n0;
        x.drow = (n0 < 1024) ? (n0 >> 7) * 256 + (n0 & 127) : ((n0 - 1024) >> 7) * 256 + 128 + (n0 & 127); x.sc = WGU_SC; }
    else { const int r = it - I_GU, e = r / (8 * 32), q = r % (8 * 32), kb = q / 32, nb = q % 32;
        x.W = F.in[I_W_DOWN] + (size_t)e * DFF * D; x.WT = F.ws + WS_WDN_T + (size_t)e * D * DFF; x.K = DFF; x.N = D; x.k0 = 128 * kb; x.n0 = 32 * nb; x.drow = 32 * nb; x.sc = WDN_SC; }
    return x;
}
__device__ __forceinline__ void expert_stream(Frame& F, int sw, int nsw, LAS unsigned char* scr) {
    for (int it = sw; it < N_EXPERT_ITEMS; it += 3 * nsw) {
        const int it2 = it + nsw, it3 = it + 2 * nsw; const bool two = it2 < N_EXPERT_ITEMS, three = it3 < N_EXPERT_ITEMS;
        const ExpItem a = expert_item_decode(F, it), b = expert_item_decode(F, two ? it2 : it), c = expert_item_decode(F, three ? it3 : it);
        f32x4 xa[4][4], xb[4][4], xc[4][4];
        item8_load(xa, a.W, a.N, a.k0, a.n0, F.lane);
        if (two) item8_load(xb, b.W, b.N, b.k0, b.n0, F.lane);
        if (three) item8_load(xc, c.W, c.N, c.k0, c.n0, F.lane);
        item8_finish(xa, a.K, a.WT, a.k0, a.drow, a.sc, scr, F.lane);
        if (two) item8_finish(xb, b.K, b.WT, b.k0, b.drow, b.sc, scr + 5120, F.lane);
        if (three) item8_finish(xc, c.K, c.WT, c.k0, c.drow, c.sc, scr + 10240, F.lane);
    }
}
__device__ __forceinline__ void p0_prologue(Frame& F) {
    LAS float* scr = (LAS float*)(F.lds + RING_OFF + F.wave * 16384);
    const int gw = F.vcu * NWAVES + F.wave, NGW = F.G * NWAVES;
    constexpr int I_IN = 16 * 80, I_SQ = 16 * 32;
    constexpr int NITEMS = I_IN + 3 * I_SQ + 2 * 256;
    for (int it = gw; it < NITEMS; it += NGW) {
        int r = it;
        if (r < I_IN) { const int kb = r / 80, nb = r % 80, n0 = 32 * nb; int drow;
            if (n0 < 512) drow = (n0 >> 7) * 256 + (n0 & 127); else if (n0 < 1024) drow = ((n0 - 512) >> 7) * 256 + 128 + (n0 & 127); else drow = n0;
            p0_transpose_item(F.in[I_W_IN], D, INC, (bf16*)(F.ws + WS_WIN_T), 64 * kb, n0, drow, scr, F.lane); continue; } r -= I_IN;
        if (r < 3 * I_SQ) { const int w = r / I_SQ, q = r % I_SQ, kb = q / 32, nb = q % 32;
            const float* src = F.in[w == 0 ? I_W_OUT : w == 1 ? I_WK : I_WV];
            bf16* dst = (bf16*)(F.ws + (w == 0 ? WS_WOUT_T : w == 1 ? WS_WK_T : WS_WV_T));
            p0_transpose_item(src, D, D, dst, 64 * kb, 32 * nb, 32 * nb, scr, F.lane); continue; } r -= 3 * I_SQ;
        { const int w = r / 256, q = r % 256, kb = q / 32, nb = q % 32;
            p0_transpose_item8b(F.in[w == 0 ? I_WQ : I_WO], D, D, F.ws + (w == 0 ? WS_WQ_T : WS_WO_T), 128 * kb, 32 * nb, 32 * nb, w == 0 ? WQ_SC : WO_SC, (LAS unsigned char*)scr, F.lane); }
    }
    if (gw < 512) { const int idx = gw * 64 + F.lane, c = idx >> 5, e = idx & 31; const float w = F.in[I_W_ROUTER][idx];
        const unsigned hi = f2bf(w), lo = f2bf(w - __builtin_bit_cast(float, hi << 16)); bf16* wr = (bf16*)(F.ws + WS_WR);
        wr[e * WR_STRIDE + c] = (bf16)hi; wr[(32 + e) * WR_STRIDE + c] = (bf16)lo; }
    for (int m = gw; m < M + MM; m += NGW) {
        f32x4 v[4];
        if (m < M) { load_row_f32(v, F.in[I_X] + (size_t)m * D, F.lane); ln_row(v, F.in[I_LN_IN_G], F.in[I_LN_IN_B], F.lane);
            store_row_bf16(v, (bf16*)(F.ws + WS_HB) + (size_t)m * D, F.lane); }
        else { const int mm = m - M; load_row_f32(v, F.in[I_MEM] + (size_t)mm * D, F.lane); ln_row(v, F.in[I_LN_MEM_G], F.in[I_LN_MEM_B], F.lane);
            store_row_bf16(v, (bf16*)(F.ws + WS_MEMN) + (size_t)mm * D, F.lane); }
    }
}

constexpr unsigned TSTEP = 256u * 1024u * 2u;
struct SchedP1 { int G, c;
    __device__ __forceinline__ bool next(int i, Unit& u) const {
        const int L = i * G + c; if (L >= 1344) return false;
        u.nvalid = 256; u.goff = 0;
        if (L < 1024) { pg8::tile_order(L, 128, 8, u.pm, u.pn); u.z = 0; u.aoff = (unsigned)WS_HB + (unsigned)u.pm * TSTEP; u.boff = (unsigned)WS_WIN_T + (unsigned)u.pn * TSTEP; }
        else if (L < 1280) { const int j = L - 1024; u.pm = j & 1; u.pn = j >> 1; u.z = 3; u.aoff = (unsigned)WS_WIN_T + (unsigned)(8 + u.pm) * TSTEP; u.boff = (unsigned)WS_HB + (unsigned)u.pn * TSTEP; }
        else if (L < 1312) { const int j = L - 1280; u.pm = j & 7; u.pn = j >> 3; u.z = 1; u.aoff = (unsigned)WS_MEMN + (unsigned)u.pm * TSTEP; u.boff = (unsigned)WS_WK_T + (unsigned)u.pn * TSTEP; }
        else { const int j = L - 1312; u.pm = j & 3; u.pn = j >> 2; u.z = 2; u.aoff = (unsigned)WS_WV_T + (unsigned)u.pm * TSTEP; u.boff = (unsigned)WS_MEMN + (unsigned)u.pn * TSTEP; }
        return true; }
};
struct EpiP1 { static constexpr bool PERM = true;
    unsigned char* ws; const float* b_in;
    __device__ __forceinline__ void operator()(const f32x4 (&acc)[2][2][4][2], const Unit& u, int wr, int wc, int fr, int fq) const {
        const int row0 = u.pm * 256 + wr * 64 + fr;
        if (u.z == 0) {
            if (u.pn < 4) {
                const int ch = 128 * u.pn + wc * 32 + 8 * fq;
                f32x4 bv[2], bg[2];
#pragma unroll
                for (int n = 0; n < 2; ++n) { bv[n] = *(const f32x4*)(b_in + ch + 4 * n); bg[n] = *(const f32x4*)(b_in + 512 + ch + 4 * n); }
                bf16* U = (bf16*)(ws + WS_U);
#pragma unroll
                for (int ai = 0; ai < 2; ++ai)
#pragma unroll
                    for (int m = 0; m < 4; ++m) { f32x4 o[2];
#pragma unroll
                        for (int n = 0; n < 2; ++n) { const f32x4 a = acc[ai][0][m][n] + bv[n], g = acc[ai][1][m][n] + bg[n];
#pragma unroll
                            for (int j = 0; j < 4; ++j) o[n][j] = a[j] * sigmoidf_fast(g[j]); }
                        u32x4 w; w.x = pg8::cvt_pk_bf16(o[0][0], o[0][1]); w.y = pg8::cvt_pk_bf16(o[0][2], o[0][3]); w.z = pg8::cvt_pk_bf16(o[1][0], o[1][1]); w.w = pg8::cvt_pk_bf16(o[1][2], o[1][3]);
                        *(u32x4*)(U + (size_t)(row0 + ai * 128 + m * 16) * 512 + ch) = w; }
            } else {
                const int t = u.pn - 4, which = t >> 1, cb = (t & 1) * 256;
                bf16* dst = (bf16*)(ws + (which == 0 ? WS_Q : WS_K));
                pg8::store_tile_bf16(acc, dst + (size_t)row0 * 512 + cb, 512, b_in + 1024 + 256 * t, which == 0 ? SB_QSCALE : 1.0f, wc, fq);
            }
        } else if (u.z == 3) {
            const float* rb = b_in + 2048 + row0; bf16* p0 = (bf16*)(ws + WS_V) + (size_t)row0 * M + 256 * u.pn; const int cl = wc * 32 + 8 * fq;
#pragma unroll
            for (int ai = 0; ai < 2; ++ai)
#pragma unroll
                for (int m = 0; m < 4; ++m) { const float bv = rb[ai * 128 + m * 16]; bf16* rowp = p0 + (size_t)(ai * 128 + m * 16) * M + cl;
#pragma unroll
                    for (int bj = 0; bj < 2; ++bj) { const f32x4 v0 = acc[ai][bj][m][0] + bv, v1 = acc[ai][bj][m][1] + bv;
                        u32x4 w; w.x = pg8::cvt_pk_bf16(v0[0], v0[1]); w.y = pg8::cvt_pk_bf16(v0[2], v0[3]); w.z = pg8::cvt_pk_bf16(v1[0], v1[1]); w.w = pg8::cvt_pk_bf16(v1[2], v1[3]);
                        *(u32x4*)(rowp + bj * 128) = w; } }
        } else if (u.z == 1) pg8::store_tile_bf16(acc, (bf16*)(ws + WS_KM) + (size_t)row0 * 1024 + 256 * u.pn, 1024, nullptr, 1.0f, wc, fq);
        else pg8::store_tile_bf16(acc, (bf16*)(ws + WS_VMT) + (size_t)row0 * 2048 + 256 * u.pn, 2048, nullptr, 1.0f, wc, fq);
    }
};

struct SchedPlain { int G, c, nM, nN; unsigned abase, bbase, atile, btile, acol, bcol, bgrp;
    __device__ __forceinline__ bool next(int i, Unit& u) const {
        const int L = i * G + c; if (L >= nM * nN) return false;
        pg8::tile_order(L, nM, nN, u.pm, u.pn); u.z = 0; u.nvalid = 256; u.goff = 0;
        u.aoff = abase + (unsigned)u.pm * atile + (unsigned)u.pn * acol; u.boff = bbase + (unsigned)u.pn * btile + (unsigned)(u.pm >> 4) * bgrp + (unsigned)u.pn * bcol; return true; }
};
struct EpiBf16 { static constexpr bool PERM = true;
    bf16* O; int ldc; float scale; const float* bias;
    __device__ __forceinline__ void operator()(const f32x4 (&acc)[2][2][4][2], const Unit& u, int wr, int wc, int fr, int fq) const {
        pg8::store_tile_bf16(acc, O + (size_t)(u.pm * 256 + wr * 64 + fr) * ldc + 256 * u.pn, (size_t)ldc, bias ? bias + 256 * u.pn : nullptr, scale, wc, fq); }
};
struct SchedMoe { int G, c, nN; const LAS int* tb; unsigned abase, wbase, wexp;
    bool gather;
    __device__ __forceinline__ bool next(int i, Unit& u) const {
        const int nblk = __builtin_amdgcn_readfirstlane(tb[32]); const int L = i * G + c; if (L >= nblk * nN) return false;
        pg8::tile_order(L, nblk, nN, u.pm, u.pn);
        const int e = __builtin_amdgcn_readfirstlane(tb[128 + u.pm]);
        const int j = u.pm - tb[e], rem = tb[64 + e] - 256 * j;
        u.z = e; u.nvalid = rem < 256 ? rem : 256; u.goff = (unsigned)(e * LCAP + 256 * j);
        u.aoff = gather ? abase : abase + (unsigned)u.pm * (TSTEP / 2);
        u.boff = wbase + (unsigned)e * wexp + (unsigned)u.pn * (TSTEP / 2); return true; }
};
struct EpiAct { static constexpr bool PERM = true;
    unsigned char* ACT; const float* b_gu;
    __device__ __forceinline__ void operator()(const f32x4 (&acc)[2][2][4][2], const Unit& u, int wr, int wc, int fr, int fq) const {
        const int row0 = u.pm * 256 + wr * 64 + fr, ch = 128 * u.pn + wc * 32 + 8 * fq;
        const float* bb = b_gu + (size_t)u.z * 2 * DFF;
        f32x4 bg[2], bu[2];
#pragma unroll
        for (int n = 0; n < 2; ++n) { bg[n] = *(const f32x4*)(bb + ch + 4 * n); bu[n] = *(const f32x4*)(bb + DFF + ch + 4 * n); }
#pragma unroll
        for (int ai = 0; ai < 2; ++ai)
#pragma unroll
            for (int m = 0; m < 4; ++m) { f32x4 o[2];
#pragma unroll
                for (int n = 0; n < 2; ++n) { const f32x4 g = acc[ai][0][m][n] * (1.0f / WGU_SC) + bg[n], uu = acc[ai][1][m][n] * (1.0f / WGU_SC) + bu[n];
#pragma unroll
                    for (int j = 0; j < 4; ++j) { const float g_ = fminf(g[j], 7.0f), u_ = fminf(fmaxf(uu[j], -7.0f), 7.0f); o[n][j] = (u_ + 1.0f) * g_ * sigmoidf_fast(1.702f * g_); } }
                *(u32x2*)(ACT + (size_t)(row0 + ai * 128 + m * 16) * DFF + ch) = (u32x2){pk4_fp8(o[0][0], o[0][1], o[0][2], o[0][3]), pk4_fp8(o[1][0], o[1][1], o[1][2], o[1][3])}; }
    }
};
struct EpiDown { static constexpr bool PERM = true;
    unsigned char* YS; const float* b_down; const float* lgate;
    __device__ __forceinline__ void operator()(const f32x4 (&acc)[2][2][4][2], const Unit& u, int wr, int wc, int fr, int fq) const {
        const int r0 = wr * 64 + fr, cl = wc * 32 + 8 * fq;
        const float* bb = b_down + (size_t)u.z * D + 256 * u.pn + cl;
        f32x4 bv[2][2];
#pragma unroll
        for (int bj = 0; bj < 2; ++bj)
#pragma unroll
            for (int n = 0; n < 2; ++n) bv[bj][n] = *(const f32x4*)(bb + bj * 128 + 4 * n);
        float gts[2][4];
#pragma unroll
        for (int ai = 0; ai < 2; ++ai)
#pragma unroll
            for (int m = 0; m < 4; ++m) { const int r = r0 + ai * 128 + m * 16; gts[ai][m] = lgate[u.goff + (r < u.nvalid ? r : u.nvalid - 1)]; }
#pragma unroll
        for (int ai = 0; ai < 2; ++ai)
#pragma unroll
            for (int m = 0; m < 4; ++m) { const int r = r0 + ai * 128 + m * 16; const float gt = (r < u.nvalid) ? gts[ai][m] * YS_SC : 0.f;
                unsigned char* rowp = YS + (size_t)(u.pm * 256 + r) * D + 256 * u.pn + cl;
#pragma unroll
                for (int bj = 0; bj < 2; ++bj) { const f32x4 v0 = (acc[ai][bj][m][0] * (1.0f / WDN_SC) + bv[bj][0]) * gt, v1 = (acc[ai][bj][m][1] * (1.0f / WDN_SC) + bv[bj][1]) * gt;
                    *(u32x2*)(rowp + bj * 128) = (u32x2){pk4_fp8(v0[0], v0[1], v0[2], v0[3]), pk4_fp8(v1[0], v1[1], v1[2], v1[3])}; } }
    }
};
__device__ __forceinline__ void moe_table(Frame& F, LAS int* tb) {
    if (F.tid < 32) { int c = (int)__hip_atomic_load(F.ctl + CW_ECNT + 64 * F.tid, RLX_AGENT); if (c > LCAP) c = LCAP; tb[64 + F.tid] = c; }
    LDS_WAIT(); __syncthreads();
    if (F.tid == 0) { int s = 0; for (int e = 0; e < NE; ++e) { tb[e] = s; s += (tb[64 + e] + 255) >> 8; } tb[32] = s; }
    LDS_WAIT(); __syncthreads();
    for (int b = F.tid; b < NBLK_MAX; b += NWAVES * 64) { int e = 0; while (e < NE - 1 && tb[e + 1] <= b) ++e; tb[128 + b] = e; }
    LDS_WAIT(); __syncthreads();
}

__device__ __forceinline__ void conv_phase(Frame& F) {
    LAS unsigned* ut = (LAS unsigned*)(F.lds + RING_OFF);
    LAS float* co = (LAS float*)(F.lds + RING_OFF + 65536);
    const int cp = F.tid & 255, half = F.tid >> 8;
    float w0[CWID], w1[CWID];
    { const float* wd = F.in[I_W_DW] + 2 * cp;
#pragma unroll
        for (int j = 0; j < CWID; ++j) { const f32x2 w = *(const GAS f32x2*)(wd + j * CONV_CH); w0[j] = w.x; w1[j] = w.y; } }
    const f32x2 bd = *(const GAS f32x2*)(F.in[I_B_DW] + 2 * cp);
    const f32x4 g0 = *(const GAS f32x4*)(F.in[I_LN_CONV_G] + 8 * F.lane), g1 = *(const GAS f32x4*)(F.in[I_LN_CONV_G] + 8 * F.lane + 4);
    const f32x4 b0 = *(const GAS f32x4*)(F.in[I_LN_CONV_B] + 8 * F.lane), b1 = *(const GAS f32x4*)(F.in[I_LN_CONV_B] + 8 * F.lane + 4);
    bf16* MX = (bf16*)(F.ws + WS_MIXIN);
    for (int it = F.vcu; it < NB * (T_ / 32); it += F.G) {
        const int b = it / (T_ / 32), t0 = (it % (T_ / 32)) * 32;
        const bf16* U = (const bf16*)(F.ws + WS_U) + (size_t)b * T_ * CONV_CH;
        for (int idx = F.tid; idx < 62 * 64; idx += 512) { const int r = idx >> 6, c16 = idx & 63, t = t0 - 30 + r;
            u32x4 v = (u32x4){0u, 0u, 0u, 0u}; if (t >= 0) v = *(const GAS u32x4*)(U + (size_t)t * CONV_CH + c16 * 8);
            *(LAS u32x4*)(ut + r * 256 + c16 * 4) = v; }
        LDS_WAIT(); __syncthreads();
        { float a0[16], a1[16];
#pragma unroll
            for (int tt = 0; tt < 16; ++tt) { a0[tt] = bd.x; a1[tt] = bd.y; }
#pragma unroll
            for (int r = 0; r < 46; ++r) { const unsigned uu = ut[(half * 16 + r) * 256 + cp]; const float u0 = bflo(uu), u1 = bfhi(uu);
#pragma unroll
                for (int tt = 0; tt < 16; ++tt) { const int j = r - tt; if (j >= 0 && j < CWID) { a0[tt] += w0[j] * u0; a1[tt] += w1[j] * u1; } } }
#pragma unroll
            for (int tt = 0; tt < 16; ++tt) *(LAS f32x2*)(co + (half * 16 + tt) * CONV_CH + 2 * cp) = (f32x2){a0[tt], a1[tt]};
        }
        LDS_WAIT(); __syncthreads();
#pragma unroll
        for (int q = 0; q < 4; ++q) { const int tt = 4 * F.wave + q;
            f32x4 x0 = *(const LAS f32x4*)(co + tt * CONV_CH + 8 * F.lane), x1 = *(const LAS f32x4*)(co + tt * CONV_CH + 8 * F.lane + 4);
            const float mean = wave_sum((x0.x + x0.y) + (x0.z + x0.w) + (x1.x + x1.y) + (x1.z + x1.w)) * (1.f / CONV_CH);
            x0 = x0 - mean; x1 = x1 - mean;
            const float var = wave_sum((x0.x * x0.x + x0.y * x0.y) + (x0.z * x0.z + x0.w * x0.w) + (x1.x * x1.x + x1.y * x1.y) + (x1.z * x1.z + x1.w * x1.w)) * (1.f / CONV_CH);
            const float rstd = 1.f / sqrtf(var + LN_EPS);
            x0 = x0 * rstd * g0 + b0; x1 = x1 * rstd * g1 + b1;
            float y[8] = {x0.x, x0.y, x0.z, x0.w, x1.x, x1.y, x1.z, x1.w};
#pragma unroll
            for (int j = 0; j < 8; ++j) y[j] = y[j] * sigmoidf_fast(y[j]);
            *(GAS u32x4*)(MX + (size_t)(b * T_ + t0 + tt) * D + 8 * F.lane) = (u32x4){pk2(y[0], y[1]), pk2(y[2], y[3]), pk2(y[4], y[5]), pk2(y[6], y[7])}; }
        __syncthreads();
    }
}

typedef float f32x16 __attribute__((ext_vector_type(16)));
__device__ __forceinline__ int crow(int r, int hi) { return (r & 3) + 8 * (r >> 2) + 4 * hi; }
__device__ __forceinline__ bf16x8 pack8(const float* v) {
    u32x4 w; w.x = pg8::cvt_pk_bf16(v[0], v[1]); w.y = pg8::cvt_pk_bf16(v[2], v[3]); w.z = pg8::cvt_pk_bf16(v[4], v[5]); w.w = pg8::cvt_pk_bf16(v[6], v[7]);
    return __builtin_bit_cast(bf16x8, w); }
constexpr float SB_EXIT = 150.0f;
struct SbStage { u32x4 k[4], v[4]; };
__device__ __forceinline__ void sb_gload(SbStage& g, const bf16* Kt, const bf16* Vt, int lane) {
#pragma unroll
    for (int i = 0; i < 4; ++i) { const int c = (lane & 7) ^ ((4 * i + (lane >> 4)) & 7); g.k[i] = *(const GAS u32x4*)(Kt + (size_t)(8 * i) * SBW + 8 * c); }
#pragma unroll
    for (int i = 0; i < 4; ++i) g.v[i] = *(const GAS u32x4*)(Vt + (size_t)(16 * i) * M);
}
__device__ __forceinline__ void sb_lwrite(const SbStage& g, LAS unsigned char* buf, int lane) {
#pragma unroll
    for (int i = 0; i < 4; ++i) *(LAS u32x4*)(buf + 1024 * i + 16 * lane) = g.k[i];
#pragma unroll
    for (int i = 0; i < 4; ++i) *(LAS u32x4*)(buf + 4096 + 1024 * i + 16 * lane) = g.v[i];
}
__device__ __forceinline__ void sb_attn_wave(Frame& F, int b, int h, int qt) {
    const int c = F.lane & 31, hi = F.lane >> 5;
    const bf16* Q = (const bf16*)(F.ws + WS_Q); const bf16* Kb = (const bf16*)(F.ws + WS_K); const bf16* VT = (const bf16*)(F.ws + WS_V);
    LAS unsigned char* wbuf = F.lds + RING_OFF + F.wave * 16384;
    bf16x8 tri[2];
#pragma unroll
    for (int s = 0; s < 2; ++s) { bf16x8 t;
#pragma unroll
        for (int j = 0; j < 8; ++j) { const int k = 16 * s + 8 * (j >> 2) + 4 * hi + (j & 3); t[j] = (k >= c) ? (short)0xBF80 : (short)0; }
        tri[s] = t; }
    bf16x8 qf[4];
    { const bf16* qp = Q + ((size_t)b * T_ + 32 * qt + c) * SBW + h * SBD + 8 * hi;
#pragma unroll
        for (int s = 0; s < 4; ++s) qf[s] = *(const GAS bf16x8*)(qp + 16 * s); }
    const bf16* Ksrc = Kb + ((size_t)b * T_ + (F.lane >> 3)) * SBW + h * SBD;
    const bf16* Vsrc = VT + (size_t)(h * SBD + (F.lane >> 2)) * M + (size_t)b * T_ + 8 * ((F.lane & 3) ^ ((F.lane >> 4) & 3));

    const int ksw = (c >> 1) & 7, vsw = (c >> 2) & 3;

    f32x16 o0, o1;
#pragma unroll
    for (int r = 0; r < 16; ++r) { o0[r] = 0.f; o1[r] = 0.f; }
    float carry = 0.f;
    SbStage st;
    sb_gload(st, Ksrc + (size_t)(32 * qt) * SBW, Vsrc + 32 * qt, F.lane); sb_lwrite(st, wbuf, F.lane);
    for (int kt = qt; kt >= 0; --kt) {
        LAS unsigned char* buf = wbuf + ((qt - kt) & 1) * 8192;
        if (kt > 0) sb_gload(st, Ksrc + (size_t)(32 * (kt - 1)) * SBW, Vsrc + 32 * (kt - 1), F.lane);
        const bool diag = (kt == qt);
        bf16x8 kf[4];
#pragma unroll
        for (int s = 0; s < 4; ++s) kf[s] = *(const LAS bf16x8*)(buf + c * 128 + 16 * ((2 * s + hi) ^ ksw));
        f32x16 p;
#pragma unroll
        for (int r = 0; r < 16; ++r) p[r] = 0.f;
#pragma unroll
        for (int s = 0; s < 4; ++s) p = __builtin_amdgcn_mfma_f32_32x32x16_bf16(kf[s], qf[s], p, 0, 0, 0);
        u32x2 vv[2][2][2];
#pragma unroll
        for (int dt = 0; dt < 2; ++dt)
#pragma unroll
            for (int s = 0; s < 2; ++s)
#pragma unroll
                for (int q = 0; q < 2; ++q) vv[dt][s][q] = *(const LAS u32x2*)(buf + 4096 + (32 * dt + c) * 64 + 16 * ((2 * s + q) ^ vsw) + 8 * hi);
        float L[16];
#pragma unroll
        for (int r = 0; r < 16; ++r) { const float y = p[r]; float l = __builtin_amdgcn_logf(1.0f + __builtin_amdgcn_exp2f(y)); l = (y > 64.f) ? y : l;
            if (diag) l = (crow(r, hi) >= c) ? 0.f : l; L[r] = l; }
        const bf16x8 l0 = pack8(L), l1 = pack8(L + 8);
        f32x16 a;
#pragma unroll
        for (int r = 0; r < 16; ++r) a[r] = p[r] - carry;
        a = __builtin_amdgcn_mfma_f32_32x32x16_bf16(tri[0], l0, a, 0, 0, 0); a = __builtin_amdgcn_mfma_f32_32x32x16_bf16(tri[1], l1, a, 0, 0, 0);
        const float tot = p[0] - a[0];
        float w[16];
#pragma unroll
        for (int r = 0; r < 16; ++r) { float x = __builtin_amdgcn_exp2f(a[r]); if (diag) x = (crow(r, hi) >= c) ? 0.f : x; w[r] = x; }
        const bf16x8 p0 = pack8(w), p1 = pack8(w + 8);
        { const bf16x8 v00 = __builtin_bit_cast(bf16x8, (u32x4){vv[0][0][0].x, vv[0][0][0].y, vv[0][0][1].x, vv[0][0][1].y});
          const bf16x8 v01 = __builtin_bit_cast(bf16x8, (u32x4){vv[0][1][0].x, vv[0][1][0].y, vv[0][1][1].x, vv[0][1][1].y});
          const bf16x8 v10 = __builtin_bit_cast(bf16x8, (u32x4){vv[1][0][0].x, vv[1][0][0].y, vv[1][0][1].x, vv[1][0][1].y});
          const bf16x8 v11 = __builtin_bit_cast(bf16x8, (u32x4){vv[1][1][0].x, vv[1][1][0].y, vv[1][1][1].x, vv[1][1][1].y});
          o0 = __builtin_amdgcn_mfma_f32_32x32x16_bf16(v00, p0, o0, 0, 0, 0); o0 = __builtin_amdgcn_mfma_f32_32x32x16_bf16(v01, p1, o0, 0, 0, 0);
          o1 = __builtin_amdgcn_mfma_f32_32x32x16_bf16(v10, p0, o1, 0, 0, 0); o1 = __builtin_amdgcn_mfma_f32_32x32x16_bf16(v11, p1, o1, 0, 0, 0); }
        carry = __shfl(tot, c);
        if (__all(carry >= SB_EXIT)) break;
        if (kt > 0) sb_lwrite(st, wbuf + ((qt - kt + 1) & 1) * 8192, F.lane);
    }
    bf16* op = (bf16*)(F.ws + WS_MIXIN) + ((size_t)b * T_ + 32 * qt + c) * D + CONV_CH + h * SBD + 4 * hi;
#pragma unroll
    for (int g = 0; g < 4; ++g) {
        *(GAS u32x2*)(op + 8 * g) = (u32x2){pg8::cvt_pk_bf16(o0[4 * g], o0[4 * g + 1]), pg8::cvt_pk_bf16(o0[4 * g + 2], o0[4 * g + 3])};
        *(GAS u32x2*)(op + 32 + 8 * g) = (u32x2){pg8::cvt_pk_bf16(o1[4 * g], o1[4 * g + 1]), pg8::cvt_pk_bf16(o1[4 * g + 2], o1[4 * g + 3])}; }
}

__device__ __forceinline__ void resid_row(f32x4 (&v)[4], const bf16* hrow, const bf16* mrow, int lane) {
    f32x4 a[4]; load_row_bf16(v, hrow, lane); load_row_bf16(a, mrow, lane);
#pragma unroll
    for (int j = 0; j < 4; ++j) v[j] = v[j] * DN_ALPHA + a[j];
}
__device__ __forceinline__ void ln_phase(Frame& F, const float* g, const float* b) {
    const int gw = F.vcu * NWAVES + F.wave, NGW = F.G * NWAVES;
    for (int m = gw; m < M; m += NGW) { f32x4 v[4]; bf16* hrow = (bf16*)(F.ws + WS_HB) + (size_t)m * D; resid_row(v, hrow, (const bf16*)(F.ws + WS_QM) + (size_t)m * D, F.lane);
        ln_row(v, g, b, F.lane); store_row_bf16(v, hrow, F.lane);
        { GAS unsigned* h8 = (GAS unsigned*)(F.ws + WS_HB8 + (size_t)m * D) + F.lane;
#pragma unroll
            for (int j = 0; j < 4; ++j) h8[64 * j] = pk4_fp8(v[j].x, v[j].y, v[j].z, v[j].w); } }
}
__device__ __forceinline__ void softmax_phase(Frame& F) {
    const int gw = F.vcu * NWAVES + F.wave, NGW = F.G * NWAVES;
    for (int m = gw; m < M; m += NGW) { GAS u32x2* p = (GAS u32x2*)((bf16*)(F.ws + WS_SP) + (size_t)m * D) + F.lane;
#pragma unroll
        for (int j = 0; j < 4; ++j) { const u32x2 w = p[64 * j]; float x0 = bflo(w.x), x1 = bfhi(w.x), x2 = bflo(w.y), x3 = bfhi(w.y);
            const float mx = wave_max(fmaxf(fmaxf(x0, x1), fmaxf(x2, x3)));
            x0 = __builtin_amdgcn_exp2f(x0 - mx); x1 = __builtin_amdgcn_exp2f(x1 - mx); x2 = __builtin_amdgcn_exp2f(x2 - mx); x3 = __builtin_amdgcn_exp2f(x3 - mx);
            const float inv = 1.0f / wave_sum((x0 + x1) + (x2 + x3));
            p[64 * j] = (u32x2){pk2(x0 * inv, x1 * inv), pk2(x2 * inv, x3 * inv)}; } }
}
__device__ __forceinline__ void xattn_phase(Frame& F) {
    LAS unsigned char* tb0 = F.lds + RING_OFF;
    const bf16* QM = (const bf16*)(F.ws + WS_QM); const bf16* KM = (const bf16*)(F.ws + WS_KM); const bf16* VMT = (const bf16*)(F.ws + WS_VMT); bf16* OB = (bf16*)(F.ws + WS_OB);
    const int c = F.lane & 31, h5 = F.lane >> 5;
    const int tr = F.tid >> 5, tc = F.tid & 31;
    const int kr = F.tid >> 4, kc = F.tid & 15;
    for (int u = F.vcu; u < NB * 4 * 16; u += F.G) {
        const int b = u >> 6, h = (u >> 4) & 3, qt = u & 15;
        const size_t rowq = (size_t)b * T_ + 256 * qt + 32 * F.wave + c;
        const bf16* qp = QM + rowq * D + h * 256 + 8 * h5;
        const bf16* ksrc = KM + ((size_t)b * NMEM + kr) * D + h * 256 + 8 * kc;
        const int kw0 = kr * 272 + kc * 16, kw1 = (kr + 32) * 272 + kc * 16;
        const bf16* vsrc = VMT + ((size_t)h * 256 + tr) * (size_t)MM + (size_t)b * NMEM + 8 * tc;
        int vw[4];
#pragma unroll
        for (int j = 0; j < 4; ++j) vw[j] = (tr + 16 * j) * 528 + tc * 16;
        u32x4 st[4];
        __syncthreads();
        st[0] = *(const GAS u32x4*)ksrc; st[1] = *(const GAS u32x4*)(ksrc + (size_t)32 * D);
        *(LAS u32x4*)(tb0 + kw0) = st[0]; *(LAS u32x4*)(tb0 + kw1) = st[1];
        LDS_WAIT(); __syncthreads();
        f32x16 sacc[8];
#pragma unroll
        for (int dh = 0; dh < 2; ++dh) {
            bf16x8 qf[8];
#pragma unroll
            for (int s_ = 0; s_ < 8; ++s_) qf[s_] = *(const GAS bf16x8*)(qp + 128 * dh + 16 * s_);
#pragma unroll
            for (int kp = 0; kp < 4; ++kp) { const int i = dh * 4 + kp;
                LAS unsigned char* buf = tb0 + (i & 1) * 34816; LAS unsigned char* nbuf = tb0 + ((i + 1) & 1) * 34816;
                if (i < 7) { const bf16* p = ksrc + (size_t)(64 * ((i + 1) & 3)) * D + 128 * ((i + 1) >> 2); st[0] = *(const GAS u32x4*)p; st[1] = *(const GAS u32x4*)(p + (size_t)32 * D); }
                else {
#pragma unroll
                    for (int j = 0; j < 4; ++j) st[j] = *(const GAS u32x4*)(vsrc + (size_t)(16 * j) * MM); }
#pragma unroll
                for (int k2 = 0; k2 < 2; ++k2) { const int kt = 2 * kp + k2;
                    f32x16 a;
                    if (dh == 0) {
#pragma unroll
                        for (int r = 0; r < 16; ++r) a[r] = 0.f; }
                    else a = sacc[kt];
#pragma unroll
                    for (int s_ = 0; s_ < 8; ++s_) { const bf16x8 kf = *(const LAS bf16x8*)(buf + c * 272 + h5 * 16 + (32 * k2 * 272 + 32 * s_)); a = __builtin_amdgcn_mfma_f32_32x32x16_bf16(kf, qf[s_], a, 0, 0, 0); }
                    sacc[kt] = a; }
                if (i < 7) { *(LAS u32x4*)(nbuf + kw0) = st[0]; *(LAS u32x4*)(nbuf + kw1) = st[1]; }
                else {
#pragma unroll
                    for (int j = 0; j < 4; ++j) *(LAS u32x4*)(nbuf + vw[j]) = st[j]; }
                LDS_WAIT(); __syncthreads();
            }
        }
        float mx = sacc[0][0];
#pragma unroll
        for (int kt = 0; kt < 8; ++kt)
#pragma unroll
            for (int r = 0; r < 16; ++r) mx = fmaxf(mx, sacc[kt][r]);
        mx = fmaxf(mx, __shfl_xor(mx, 32));
        float sum = 0.f; bf16x8 pb[8][2];
#pragma unroll
        for (int kt = 0; kt < 8; ++kt) { float p[16];
#pragma unroll
            for (int r = 0; r < 16; ++r) { p[r] = __builtin_amdgcn_exp2f(sacc[kt][r] - mx); sum += p[r]; }
            pb[kt][0] = pack8(p); pb[kt][1] = pack8(p + 8); }
        sum += __shfl_xor(sum, 32);
        const float inv = OB_SC / sum;
        unsigned char* op = (unsigned char*)OB + rowq * D + h * 256 + 4 * h5;
        for (int dp = 0; dp < 4; ++dp) {
            LAS unsigned char* buf = tb0 + (dp & 1) * 34816; LAS unsigned char* nbuf = tb0 + ((dp + 1) & 1) * 34816;
            if (dp < 3) {
#pragma unroll
                for (int j = 0; j < 4; ++j) st[j] = *(const GAS u32x4*)(vsrc + (size_t)(64 * (dp + 1) + 16 * j) * MM); }
#pragma unroll
            for (int d2 = 0; d2 < 2; ++d2) { const int dt = 2 * dp + d2;
                f32x16 o;
#pragma unroll
                for (int r = 0; r < 16; ++r) o[r] = 0.f;
#pragma unroll
                for (int kt = 0; kt < 8; ++kt)
#pragma unroll
                    for (int s2 = 0; s2 < 2; ++s2) { const LAS unsigned char* rp = buf + c * 528 + 8 * h5 + (32 * d2 * 528 + (4 * kt + 2 * s2) * 16);
                        const u32x2 v0 = *(const LAS u32x2*)rp, v1 = *(const LAS u32x2*)(rp + 16);
                        o = __builtin_amdgcn_mfma_f32_32x32x16_bf16(__builtin_bit_cast(bf16x8, (u32x4){v0.x, v0.y, v1.x, v1.y}), pb[kt][s2], o, 0, 0, 0); }
#pragma unroll
                for (int g = 0; g < 4; ++g) *(GAS unsigned*)(op + 32 * dt + 8 * g) = pk4_fp8(o[4 * g] * inv, o[4 * g + 1] * inv, o[4 * g + 2] * inv, o[4 * g + 3] * inv); }
            if (dp < 3) {
#pragma unroll
                for (int j = 0; j < 4; ++j) *(LAS u32x4*)(nbuf + vw[j]) = st[j]; }
            LDS_WAIT(); __syncthreads();
        }
    }
}
typedef float f32x4v __attribute__((ext_vector_type(4)));
__device__ __forceinline__ void ln2_router_phase(Frame& F) {
    LAS bf16* wr = (LAS bf16*)(F.lds + P10_WR);
    LAS float* gb = (LAS float*)(F.lds + P10_GB);
    LAS int* lcnt = (LAS int*)(F.lds + P10_LCNT);
    LAS int* rec = (LAS int*)(F.lds + P10_REC);
    for (int i = F.tid; i < 2 * 32 * WR_STRIDE * 2 / 16; i += 512) *(LAS u32x4*)(F.lds + P10_WR + 16 * i) = *(const GAS u32x4*)(F.ws + WS_WR + 16 * i);
    for (int i = F.tid; i < 512; i += 512) { *(LAS f32x4*)(gb + 4 * i) = ((const GAS f32x4*)(i < 256 ? F.in[I_LN2_G] : F.in[I_LN2_B]))[i & 255]; }
    if (F.tid < 64) lcnt[F.tid] = 0;
    LDS_WAIT(); __syncthreads();
    const bf16* H1 = (const bf16*)(F.ws + WS_HB); const bf16* CA = (const bf16*)(F.ws + WS_QM); bf16* H2 = (bf16*)(F.ws + WS_HB2);
    int* ltok = (int*)(F.ws + WS_LTOK); float* lgate = (float*)(F.ws + WS_LGATE); int* sidx = (int*)(F.ws + WS_SIDX);
    const int fr = F.lane & 15, fq = F.lane >> 4;
    for (int rb = F.vcu; rb < M / 128; rb += F.G) {
        const int m0 = rb * 128 + F.wave * 16;
        float mymean = 0.f, myrstd = 0.f;
        for (int i = 0; i < 16; ++i) { const int m = m0 + i;
            f32x4 v[4]; resid_row(v, H1 + (size_t)m * D, CA + (size_t)m * D, F.lane);
            float s1 = 0.f;
#pragma unroll
            for (int j = 0; j < 4; ++j) s1 += (v[j].x + v[j].y) + (v[j].z + v[j].w);
            const float mean = wave_sum(s1) * (1.f / D); float s2 = 0.f;
#pragma unroll
            for (int j = 0; j < 4; ++j) { v[j] = v[j] - mean; s2 += (v[j].x * v[j].x + v[j].y * v[j].y) + (v[j].z * v[j].z + v[j].w * v[j].w); }
            const float rstd = 1.f / sqrtf(wave_sum(s2) * (1.f / D) + LN_EPS);
            if (fr == i) { mymean = mean; myrstd = rstd; }
#pragma unroll
            for (int j = 0; j < 4; ++j) { const f32x4 gg = *(const LAS f32x4*)(gb + 4 * F.lane + 256 * j), bb = *(const LAS f32x4*)(gb + 1024 + 4 * F.lane + 256 * j); v[j] = v[j] * rstd * gg + bb; }
            store_row_bf16(v, H2 + (size_t)m * D, F.lane);
            { GAS unsigned* h8 = (GAS unsigned*)(F.ws + WS_HB8 + (size_t)m * D) + F.lane;
#pragma unroll
                for (int j = 0; j < 4; ++j) h8[64 * j] = pk4_fp8(v[j].x, v[j].y, v[j].z, v[j].w); }
        }
        f32x4v acc0 = {0.f, 0.f, 0.f, 0.f}, acc1 = {0.f, 0.f, 0.f, 0.f};
        { const bf16* hp = H1 + (size_t)(m0 + fr) * D + 8 * fq; const bf16* cp = CA + (size_t)(m0 + fr) * D + 8 * fq;
            const LAS bf16* wp = wr + fr * WR_STRIDE + 8 * fq; const LAS float* gp = gb + 8 * fq;
            const float sc = myrstd, sh = -mymean * myrstd;
#pragma unroll 2
            for (int s_ = 0; s_ < 32; ++s_) {
                const u32x4 hv = *(const GAS u32x4*)(hp + 32 * s_), cv = *(const GAS u32x4*)(cp + 32 * s_);
                const f32x4 g0 = *(const LAS f32x4*)(gp + 32 * s_), g1 = *(const LAS f32x4*)(gp + 32 * s_ + 4), b0 = *(const LAS f32x4*)(gp + 1024 + 32 * s_), b1 = *(const LAS f32x4*)(gp + 1024 + 32 * s_ + 4);
                float x[8];
                x[0] = bflo(hv.x) * DN_ALPHA + bflo(cv.x); x[1] = bfhi(hv.x) * DN_ALPHA + bfhi(cv.x); x[2] = bflo(hv.y) * DN_ALPHA + bflo(cv.y); x[3] = bfhi(hv.y) * DN_ALPHA + bfhi(cv.y);
                x[4] = bflo(hv.z) * DN_ALPHA + bflo(cv.z); x[5] = bfhi(hv.z) * DN_ALPHA + bfhi(cv.z); x[6] = bflo(hv.w) * DN_ALPHA + bflo(cv.w); x[7] = bfhi(hv.w) * DN_ALPHA + bfhi(cv.w);
                const float gg[8] = {g0.x, g0.y, g0.z, g0.w, g1.x, g1.y, g1.z, g1.w}, bb[8] = {b0.x, b0.y, b0.z, b0.w, b1.x, b1.y, b1.z, b1.w};
                float lo[8]; unsigned hp2[4];
#pragma unroll
                for (int j = 0; j < 8; ++j) x[j] = (x[j] * sc + sh) * gg[j] + bb[j];
#pragma unroll
                for (int j = 0; j < 4; ++j) { hp2[j] = pg8::cvt_pk_bf16(x[2 * j], x[2 * j + 1]); lo[2 * j] = x[2 * j] - bflo(hp2[j]); lo[2 * j + 1] = x[2 * j + 1] - bfhi(hp2[j]); }
                const bf16x8 bhi = __builtin_bit_cast(bf16x8, (u32x4){hp2[0], hp2[1], hp2[2], hp2[3]});
                const bf16x8 blo = pack8(lo);
                const bf16x8 wh0 = *(const LAS bf16x8*)(wp + 32 * s_), wh1 = *(const LAS bf16x8*)(wp + 16 * WR_STRIDE + 32 * s_);
                const bf16x8 wl0 = *(const LAS bf16x8*)(wp + 32 * WR_STRIDE + 32 * s_), wl1 = *(const LAS bf16x8*)(wp + 48 * WR_STRIDE + 32 * s_);
                acc0 = __builtin_amdgcn_mfma_f32_16x16x32_bf16(wh0, bhi, acc0, 0, 0, 0); acc1 = __builtin_amdgcn_mfma_f32_16x16x32_bf16(wh1, bhi, acc1, 0, 0, 0);
                acc0 = __builtin_amdgcn_mfma_f32_16x16x32_bf16(wh0, blo, acc0, 0, 0, 0); acc1 = __builtin_amdgcn_mfma_f32_16x16x32_bf16(wh1, blo, acc1, 0, 0, 0);
                acc0 = __builtin_amdgcn_mfma_f32_16x16x32_bf16(wl0, bhi, acc0, 0, 0, 0); acc1 = __builtin_amdgcn_mfma_f32_16x16x32_bf16(wl1, bhi, acc1, 0, 0, 0);
            } }
        float cand[8]; int eid[8];
        { const f32x4 br0 = *(const GAS f32x4*)(F.in[I_B_ROUTER] + 4 * fq), br1 = *(const GAS f32x4*)(F.in[I_B_ROUTER] + 16 + 4 * fq);
#pragma unroll
            for (int r = 0; r < 4; ++r) { cand[r] = acc0[r] + br0[r]; cand[4 + r] = acc1[r] + br1[r]; eid[r] = 4 * fq + r; eid[4 + r] = 16 + 4 * fq + r; } }
        float tv[TOPK]; int te[TOPK];
#pragma unroll
        for (int k = 0; k < TOPK; ++k) {
            float bv = cand[0]; int bi = eid[0];
#pragma unroll
            for (int r = 1; r < 8; ++r) if (cand[r] > bv) { bv = cand[r]; bi = eid[r]; }
#pragma unroll
            for (int o = 16; o <= 32; o <<= 1) { const float ov = __shfl_xor(bv, o); const int oi = __shfl_xor(bi, o); if (ov > bv || (ov == bv && oi < bi)) { bv = ov; bi = oi; } }
            tv[k] = bv; te[k] = bi;
#pragma unroll
            for (int r = 0; r < 8; ++r) if (eid[r] == bi) cand[r] = -INFINITY;
        }
        float pe[TOPK], ps = 0.f;
#pragma unroll
        for (int k = 0; k < TOPK; ++k) { pe[k] = __expf(tv[k] - tv[0]); ps += pe[k]; }
        if (fq == 0) {
#pragma unroll
            for (int k = 0; k < TOPK; ++k) { const int lr = __hip_atomic_fetch_add(lcnt + te[k], 1, __ATOMIC_RELAXED, __HIP_MEMORY_SCOPE_WORKGROUP);
                LAS int* r = rec + ((F.wave * 16 + fr) * 4 + k) * 4; r[0] = te[k]; r[1] = lr; r[2] = __builtin_bit_cast(int, pe[k] / ps); r[3] = m0 + fr; } }
        LDS_WAIT(); __syncthreads();
        if (F.tid < NE) lcnt[32 + F.tid] = (int)__hip_atomic_fetch_add(F.ctl + CW_ECNT + 64 * F.tid, (unsigned)lcnt[F.tid], RLX_AGENT);
        LDS_WAIT(); __syncthreads();
        { const LAS int* r = rec + (F.wave * 64 + F.lane) * 4; const int e = r[0], pos = lcnt[32 + e] + r[1], tok = r[3];
            if (pos < LCAP) { ltok[e * LCAP + pos] = tok; lgate[e * LCAP + pos] = __builtin_bit_cast(float, r[2]); } sidx[tok * 4 + (F.lane & 3)] = e * LCAP + pos; }
        __syncthreads();
        if (F.tid < 64) lcnt[F.tid] = 0;
        LDS_WAIT(); __syncthreads();
    }
}
__device__ __forceinline__ void final_phase(Frame& F, const LAS int* tb) {
    const int gw = F.vcu * NWAVES + F.wave, NGW = F.G * NWAVES;
    const int* sidx = (const int*)(F.ws + WS_SIDX); const unsigned char* YS = F.ws + WS_YS;
    typedef float f32x2v __attribute__((ext_vector_type(2)));
    for (int m = gw; m < M; m += NGW) { f32x4 v[4]; load_row_bf16(v, (const bf16*)(F.ws + WS_HB2) + (size_t)m * D, F.lane);
#pragma unroll
        for (int j = 0; j < 4; ++j) v[j] = v[j] * DN_ALPHA;
        f32x4 s[4];
#pragma unroll
        for (int j = 0; j < 4; ++j) s[j] = (f32x4){0.f, 0.f, 0.f, 0.f};
#pragma unroll
        for (int k = 0; k < TOPK; ++k) { const int si = sidx[m * 4 + k], e = si / LCAP, pos = si - e * LCAP; const size_t slot = (size_t)tb[e] * 256 + pos;
            const GAS unsigned* yp = (const GAS unsigned*)(YS + slot * D) + F.lane;
#pragma unroll
            for (int j = 0; j < 4; ++j) { const unsigned w = yp[64 * j]; const f32x2v lo = __builtin_amdgcn_cvt_pk_f32_fp8((int)w, false), hi = __builtin_amdgcn_cvt_pk_f32_fp8((int)w, true);
                s[j] = s[j] + (f32x4){lo.x, lo.y, hi.x, hi.y}; } }
#pragma unroll
        for (int j = 0; j < 4; ++j) v[j] = v[j] + s[j] * (1.0f / YS_SC);
        ln_row(v, F.in[I_LN3_G], F.in[I_LN3_B], F.lane); store_row_f32(v, F.hf + (size_t)m * D, F.lane); }
}

struct Args { const float* in[N_IN]; float* out; unsigned char* ws; int ph_lo, ph_hi, li, pad; };
__global__ void __launch_bounds__(NWAVES * 64, 2) mk_fwd(Args args) {
    extern __shared__ __attribute__((aligned(16))) unsigned char lds[];
    Frame F;
    F.lds = (LAS unsigned char*)lds; F.MISC = (volatile LAS unsigned*)(F.lds + MISC_OFF);
    F.tid = threadIdx.x; F.lane = F.tid & 63; F.wave = __builtin_amdgcn_readfirstlane(F.tid >> 6);
    F.G = gridDim.x; { const int bx = blockIdx.x; F.vcu = (F.G % 8 == 0) ? (bx % 8) * (F.G / 8) + bx / 8 : bx; }
    F.ws = args.ws; F.ctl = (gu32*)(args.ws + WS_CTL); F.hf = args.out; F.in = args.in;
    for (int u = F.tid; u < (LDS_BYTES - LDSCTL_OFF) / 4; u += NWAVES * 64) ((LAS unsigned*)(F.lds + LDSCTL_OFF))[u] = 0u;
    __syncthreads();
    XcdBarrier bar; bar.bar = (unsigned*)(F.ctl + CW_BAR) + args.li * XCD_BAR_WORDS; bar.x = 0; bar.st = nullptr;
    const int lo = args.ph_lo, hi = args.ph_hi;
    if (hi - lo > 1) bar = xcd_barrier_post((unsigned*)(F.ctl + CW_BAR) + args.li * XCD_BAR_WORDS, F.MISC + 8);
#ifndef PH_MASK
#define PH_MASK 0xfff
#endif
#define IN(k) (((PH_MASK >> (k)) & 1) && lo <= (k) && (k) < hi)
#ifndef REP_MASK
#define REP_MASK 0
#endif
#define REPS(k) (1 + ((REP_MASK >> (k)) & 1))
#define PH_BEGIN() do { int t_ = threadIdx.x; asm volatile("" : "+v"(t_)); F.tid = t_; F.lane = t_ & 63; } while (0)
#define SEAM(k) do { if (IN(k) && IN((k) + 1)) xcd_barrier(bar); } while (0)
    const char* wsb = (const char*)args.ws;
    LAS int* tb = (LAS int*)(F.lds + TB_OFF);

    if (IN(0)) for (int rep = 0; rep < REPS(0); ++rep) { PH_BEGIN(); p0_prologue(F); __syncthreads(); } SEAM(0);
    if (IN(1)) for (int rep = 0; rep < REPS(1); ++rep) { PH_BEGIN(); SchedP1 S{F.G, (int)blockIdx.x}; EpiP1 E{F.ws, F.in[I_B_IN]};
        pg8::gemm_phase<EpiP1, SchedP1, false>(F.lds + RING_OFF, wsb, D, D, D, S, E, nullptr); } SEAM(1);
    if (IN(2)) for (int rep = 0; rep < REPS(2); ++rep) { PH_BEGIN();
        if (!(args.pad & 1)) conv_phase(F);
        if (args.pad & 2) continue;
        const int gw = F.vcu * NWAVES + F.wave;
        if (F.wave < 5) { if (!(args.pad & 8)) for (int tk = F.vcu * 5 + F.wave; tk < NB * SBH * (T_ / 32); tk += F.G * 5) sb_attn_wave(F, (tk >> 7) >> 3, (tk >> 7) & 7, tk & 127); }
        else if (!(args.pad & 4)) expert_stream(F, F.vcu * 3 + (F.wave - 5), F.G * 3, F.lds + RING_OFF + F.wave * 16384);
    } SEAM(2);
    if (IN(3)) { PH_BEGIN(); SchedPlain S{F.G, (int)blockIdx.x, 128, 4, (unsigned)WS_MIXIN, (unsigned)WS_WOUT_T, TSTEP, TSTEP, 0u, 0u, 0u}; EpiBf16 E{(bf16*)(F.ws + WS_QM), D, 1.0f, F.in[I_B_OUT]};
        pg8::gemm_phase<EpiBf16, SchedPlain, false>(F.lds + RING_OFF, wsb, D, D, D, S, E, nullptr); } SEAM(3);
    if (IN(4)) { PH_BEGIN(); ln_phase(F, F.in[I_LN1_G], F.in[I_LN1_B]); } SEAM(4);
    if (IN(5)) { PH_BEGIN(); SchedPlain S{F.G, (int)blockIdx.x, 128, 4, (unsigned)WS_HB8, (unsigned)WS_WQ_T, TSTEP / 2, TSTEP / 2, 0u, 0u, 0u}; EpiBf16 E{(bf16*)(F.ws + WS_QM), D, MEM_QSCALE / WQ_SC, nullptr};
        pg8::gemm_phase<EpiBf16, SchedPlain, false, true>(F.lds + RING_OFF, wsb, D / 2, D / 2, D / 2, S, E, nullptr); } SEAM(5);
    if (IN(6)) { PH_BEGIN(); xattn_phase(F); } SEAM(6);
    if (IN(7)) { PH_BEGIN(); SchedPlain S{F.G, (int)blockIdx.x, 128, 4, (unsigned)WS_OB, (unsigned)WS_WO_T, TSTEP / 2, TSTEP / 2, 0u, 0u, 0u}; EpiBf16 E{(bf16*)(F.ws + WS_QM), D, 1.0f / (WO_SC * OB_SC), nullptr};
        pg8::gemm_phase<EpiBf16, SchedPlain, false, true>(F.lds + RING_OFF, wsb, D / 2, D / 2, D / 2, S, E, nullptr); } SEAM(7);
    if (IN(8)) { PH_BEGIN(); ln2_router_phase(F); } SEAM(8);
    if (IN(9)) for (int rep = 0; rep < REPS(9); ++rep) { PH_BEGIN(); moe_table(F, tb); SchedMoe S{F.G, (int)blockIdx.x, 8, tb, (unsigned)WS_HB8, (unsigned)WS_WGU_T, 2048u * 1024u, true}; EpiAct E{F.ws + WS_ACT, F.in[I_B_GU]};
        pg8::gemm_phase<EpiAct, SchedMoe, true, true>(F.lds + RING_OFF, wsb, D / 2, D / 2, D / 2, S, E, (const int*)(F.ws + WS_LTOK)); } SEAM(9);
    if (IN(10)) for (int rep = 0; rep < REPS(10); ++rep) { PH_BEGIN(); moe_table(F, tb); SchedMoe S{F.G, (int)blockIdx.x, 4, tb, (unsigned)WS_ACT, (unsigned)WS_WDN_T, 1024u * 1024u, false}; EpiDown E{F.ws + WS_YS, F.in[I_B_DOWN], (const float*)(F.ws + WS_LGATE)};
        pg8::gemm_phase<EpiDown, SchedMoe, false, true>(F.lds + RING_OFF, wsb, D / 2, D / 2, D / 2, S, E, nullptr); } SEAM(10);
    if (IN(11)) { PH_BEGIN(); moe_table(F, tb); final_phase(F, tb); }
#undef IN
#undef SEAM
}

extern "C" void kernel_launch(void* const* d_in, const int* in_sizes, int n_in, void* d_out, int out_size, void* d_ws, size_t ws_size, hipStream_t stream) {
    static int grid = 0;
    if (grid == 0) {
        if (n_in != N_IN || out_size != M * D || ws_size < WS_END) { fprintf(stderr, "kernel_launch: unexpected shapes (n_in %d, out %d, ws %zu)\n", n_in, out_size, ws_size); grid = -1; return; }
        int dev = 0, cus = 0, per_cu = 0;
        if (hipGetDevice(&dev) != hipSuccess || hipDeviceGetAttribute(&cus, hipDeviceAttributeMultiprocessorCount, dev) != hipSuccess) { grid = -1; return; }
        if (hipFuncSetAttribute((const void*)mk_fwd, hipFuncAttributeMaxDynamicSharedMemorySize, LDS_BYTES) != hipSuccess) { fprintf(stderr, "kernel_launch: hipFuncSetAttribute failed\n"); grid = -1; return; }
        if (hipOccupancyMaxActiveBlocksPerMultiprocessor(&per_cu, (const void*)mk_fwd, NWAVES * 64, LDS_BYTES) != hipSuccess || per_cu < 1) fprintf(stderr, "kernel_launch: occupancy query says %d\n", per_cu);
        (void)hipGetLastError();
        grid = cus;
    }
    if (grid < 0) return;
    if (hipMemsetAsync((char*)d_ws + WS_CTL, 0, CTL_ZERO_BYTES, stream) != hipSuccess) return;
    Args a{};
    for (int i = 0; i < N_IN; ++i) a.in[i] = (const float*)d_in[i];
    a.out = (float*)d_out; a.ws = (unsigned char*)d_ws;
#ifdef PROBE_P2
    { a.ph_lo = 0; a.ph_hi = 3; a.li = 0; hipLaunchKernelGGL(mk_fwd, dim3(grid), dim3(NWAVES * 64), LDS_BYTES, stream, a);
      a.ph_lo = 2; a.ph_hi = 3; a.li = 1; a.pad = PROBE_P2; hipLaunchKernelGGL(mk_fwd, dim3(grid), dim3(NWAVES * 64), LDS_BYTES, stream, a); a.pad = 0;
      a.ph_lo = 3; a.ph_hi = NPHASE; a.li = 2; hipLaunchKernelGGL(mk_fwd, dim3(grid), dim3(NWAVES * 64), LDS_BYTES, stream, a); return; }
#endif
    for (int li = 0; li < MK_N_LAUNCHES; ++li) {
        a.ph_lo = (MK_N_LAUNCHES == 1) ? 0 : li; a.ph_hi = (MK_N_LAUNCHES == 1) ? NPHASE : li + 1; a.li = (MK_N_LAUNCHES == 1) ? 0 : li;
        hipLaunchKernelGGL(mk_fwd, dim3(grid), dim3(NWAVES * 64), LDS_BYTES, stream, a);
        if (hipPeekAtLastError() != hipSuccess) { fprintf(stderr, "kernel_launch: launch %d failed\n", li); break; }
    }
#ifdef PROBE_PHASES
    { const int pp[] = {PROBE_PHASES}; for (int ph : pp) { a.ph_lo = ph; a.ph_hi = ph + 1; a.li = 15; hipLaunchKernelGGL(mk_fwd, dim3(grid), dim3(NWAVES * 64), LDS_BYTES, stream, a); } }
#endif
}
```

```cpp
#include <hip/hip_runtime.h>
#include <cstdio>
#include <cstdint>

#ifndef MK_N_LAUNCHES
#define MK_N_LAUNCHES 1
#endif

#define GAS __attribute__((address_space(1)))
#define LAS __attribute__((address_space(3)))
typedef unsigned short bf16;
typedef short bf16x8 __attribute__((ext_vector_type(8)));
typedef float f32x4 __attribute__((ext_vector_type(4)));
typedef float f32x2 __attribute__((ext_vector_type(2)));
typedef unsigned u32x4 __attribute__((ext_vector_type(4)));
typedef unsigned u32x2 __attribute__((ext_vector_type(2)));
typedef GAS unsigned gu32;
#define RLX_AGENT __ATOMIC_RELAXED, __HIP_MEMORY_SCOPE_AGENT
#define LDS_WAIT() asm volatile("s_waitcnt lgkmcnt(0)" ::: "memory")
#define VM_WAIT() asm volatile("s_waitcnt vmcnt(0)" ::: "memory")

constexpr int NB = 8, T_ = 4096, D = 1024, M = NB * T_, NMEM = 256, MM = NB * NMEM;
constexpr int CONV_CH = 512, SBH = 8, SBD = 64, SBW = 512, CWID = 31, NE = 32, TOPK = 4, DFF = 1024;
constexpr int INC = 2560;
constexpr float LN_EPS = 1e-5f;
constexpr float DN_ALPHA = 1.189207115002721f;
constexpr float LOG2E = 1.4426950408889634f;
constexpr float SB_QSCALE = 0.125f * LOG2E;
constexpr float MEM_QSCALE = 0.0625f * LOG2E;
constexpr float WGU_SC = 32.0f, WDN_SC = 64.0f, WQ_SC = 32.0f, WO_SC = 64.0f, OB_SC = 16.0f, YS_SC = 16.0f;
constexpr float WGU_SC_UNUSED = 0.f;
constexpr int NBLK_MAX = M * TOPK / 256 + NE;
constexpr int LCAP = M;

constexpr size_t MiB = 1u << 20;
constexpr size_t WS_CTL = 0, CTL_ZERO_BYTES = 1 * MiB;
constexpr size_t WS_WIN_T = 1 * MiB;
constexpr size_t WS_WOUT_T = 6 * MiB;
constexpr size_t WS_WQ_T = 8 * MiB, WS_WK_T = 10 * MiB, WS_WV_T = 12 * MiB, WS_WO_T = 14 * MiB;
constexpr size_t WS_WGU_T = 16 * MiB;
constexpr size_t WS_WDN_T = 144 * MiB;
constexpr size_t WS_HB8 = 176 * MiB;
constexpr size_t WS_HB = 208 * MiB;
constexpr size_t WS_LTOK = 272 * MiB;
constexpr size_t WS_LGATE = 276 * MiB;
constexpr size_t WS_SIDX = 280 * MiB;
constexpr size_t WS_WR = 281 * MiB;
constexpr size_t WS_HB2 = 832 * MiB;
constexpr size_t WS_X = 288 * MiB;
constexpr size_t WS_U = WS_X;
constexpr size_t WS_Q = WS_X + 32 * MiB;
constexpr size_t WS_K = WS_X + 64 * MiB;
constexpr size_t WS_V = WS_X + 96 * MiB;
constexpr size_t WS_MIXIN = WS_X + 128 * MiB;
constexpr size_t WS_QM = WS_X + 192 * MiB;
constexpr size_t WS_SP = WS_X + 256 * MiB;
constexpr size_t WS_OB = WS_X + 320 * MiB;
constexpr size_t WS_MEMN = WS_X + 384 * MiB;
constexpr size_t WS_KM = WS_X + 388 * MiB;
constexpr size_t WS_VMT = WS_X + 392 * MiB;
constexpr size_t WS_ACT = WS_X;
constexpr size_t WS_YS = WS_X + 272 * MiB;
constexpr size_t WS_END = 896 * MiB;
constexpr int CW_TMO = 0, CW_CODE = 1;
constexpr int CW_BAR = 4096;
constexpr int CW_ECNT = 131072;
constexpr int NPHASE = 12;

constexpr int RING_OFF = 0, RING_BYTES = 131072;
constexpr int LDS_BYTES = 163840;
constexpr int LDSCTL_OFF = LDS_BYTES - 1024, MISC_OFF = LDSCTL_OFF + 320;
constexpr int XTRA_OFF = RING_BYTES;
constexpr int TB_OFF = XTRA_OFF + 20480;
constexpr int WR_STRIDE = 1032;
constexpr int P10_WR = 0, P10_GB = 2 * 32 * WR_STRIDE * 2, P10_LCNT = P10_GB + 8192, P10_REC = P10_LCNT + 512;
static_assert(P10_REC + 8192 <= TB_OFF && TB_OFF + 4 * (128 + 544) <= LDSCTL_OFF, "LDS map");
constexpr int NWAVES = 8;

__device__ __forceinline__ unsigned f2bf(float f) { unsigned u = __builtin_bit_cast(unsigned, f); return (u + 0x7fffu + ((u >> 16) & 1u)) >> 16; }
__device__ __forceinline__ unsigned pk2(float lo, float hi) { return f2bf(lo) | (f2bf(hi) << 16); }
__device__ __forceinline__ float bflo(unsigned u) { return __builtin_bit_cast(float, u << 16); }
__device__ __forceinline__ float bfhi(unsigned u) { return __builtin_bit_cast(float, u & 0xffff0000u); }
__device__ __forceinline__ float wave_sum(float v) {
#pragma unroll
    for (int o = 1; o < 64; o <<= 1) v += __shfl_xor(v, o);
    return v;
}
__device__ __forceinline__ float wave_max(float v) {
#pragma unroll
    for (int o = 1; o < 64; o <<= 1) v = fmaxf(v, __shfl_xor(v, o));
    return v;
}
__device__ __forceinline__ unsigned pk4_fp8(float a, float b, float c, float d) {
    int r = __builtin_amdgcn_cvt_pk_fp8_f32(a, b, 0, false); r = __builtin_amdgcn_cvt_pk_fp8_f32(c, d, r, true); return (unsigned)r; }
__device__ __forceinline__ float sigmoidf_fast(float x) { return __builtin_amdgcn_rcpf(1.0f + __expf(-x)); }

namespace pg8 {
constexpr int BM = 256, BK = 64, HALF = 128, HTB = HALF * BK * 2, STAGE_BYTES = 8 * HTB, NXCD = 8, WGM = 8;
__host__ __device__ __forceinline__ int lds_byte(int r, int c) { const int st = (r >> 4) * 2 + (c >> 5), rr = r & 15, cc = c & 31, ob = rr * 64 + cc * 2; return st * 1024 + (ob ^ (((ob >> 9) & 1) << 5)); }
__host__ __device__ __forceinline__ void stage_rc(int b, int& R, int& C) { const int st = b / 1024, sb = b % 1024, swz = sb ^ (((sb >> 9) & 1) << 5); R = (st >> 1) * 16 + swz / 64; C = (st & 1) * 32 + (swz % 64) / 2; }
__host__ __device__ __forceinline__ int perm32(int rho) { const int n = rho >> 4, i = rho & 15; return 8 * (i >> 2) + 4 * n + (i & 3); }

struct Unit { int pm, pn, z, nvalid; unsigned aoff, boff, goff; };

__device__ __forceinline__ void tile_order(int L, int nM, int nN, int& pm, int& pn) {
    const int nwg = nM * nN; int wgid = L;
    { const int q = nwg / NXCD, r = nwg % NXCD, xcd = wgid % NXCD, off = wgid / NXCD; wgid = (xcd < r ? xcd * (q + 1) : r * (q + 1) + (xcd - r) * q) + off; }
    const int nig = WGM * nN, gid = wgid / nig, fm = gid * WGM, gsz = (nM - fm) < WGM ? (nM - fm) : WGM;
    pm = fm + ((wgid % nig) % gsz); pn = (wgid % nig) / gsz;
}
__device__ __forceinline__ unsigned cvt_pk_bf16(float lo, float hi) { unsigned r; asm volatile("v_cvt_pk_bf16_f32 %0, %1, %2" : "=v"(r) : "v"(lo), "v"(hi)); return r; }

__device__ __forceinline__ void store_tile_bf16(const f32x4 (&acc)[2][2][4][2], bf16* p0, size_t ldc, const float* bias, float scale, int wc, int fq) {
    const int cl = wc * 32 + 8 * fq;
    f32x4 bv[2][2];
#pragma unroll
    for (int bj = 0; bj < 2; ++bj)
#pragma unroll
        for (int n = 0; n < 2; ++n) bv[bj][n] = bias ? *(const f32x4*)(bias + cl + bj * HALF + 4 * n) : (f32x4){0.f, 0.f, 0.f, 0.f};
#pragma unroll
    for (int ai = 0; ai < 2; ++ai)
#pragma unroll
        for (int m = 0; m < 4; ++m) { bf16* rowp = p0 + (size_t)(ai * HALF + m * 16) * ldc + cl;
#pragma unroll
            for (int bj = 0; bj < 2; ++bj) { const f32x4 v0 = (acc[ai][bj][m][0] + bv[bj][0]) * scale, v1 = (acc[ai][bj][m][1] + bv[bj][1]) * scale;
                u32x4 w; w.x = cvt_pk_bf16(v0[0], v0[1]); w.y = cvt_pk_bf16(v0[2], v0[3]); w.z = cvt_pk_bf16(v1[0], v1[1]); w.w = cvt_pk_bf16(v1[2], v1[3]);
                *(u32x4*)(rowp + bj * HALF) = w; } }
}

typedef int v8i __attribute__((ext_vector_type(8)));
#ifndef PG8_ALIGN
#define PG8_ALIGN true
#endif
template <class Epi, class Sched, bool GATHER, bool FP8 = false, bool ALIGN_EPI = PG8_ALIGN>
__device__ __forceinline__ void gemm_phase(LAS unsigned char* lds, const char* wsb, const int lda, const int ldb, const int K, const Sched& S, const Epi& E, const int* glist) {
    int tid = threadIdx.x; asm volatile("" : "+v"(tid));
    const int wid = __builtin_amdgcn_readfirstlane(tid >> 6), lane = tid & 63, wr = wid >> 2, wc = wid & 3, fr = lane & 15, fq = lane >> 4;
    const int nt = K / BK;
    unsigned voffA[2], voffB[2];
#pragma unroll
    for (int i = 0; i < 2; ++i) { int R, C; stage_rc(tid * 16 + i * 8192, R, C); const int Rb = Epi::PERM ? ((R & ~31) + perm32(R & 31)) : R;
        voffA[i] = (unsigned)(R * lda + C) * 2u; voffB[i] = (unsigned)(Rb * ldb + C) * 2u; }
    const size_t kstep = (size_t)(BK * 2);
    const size_t hstepA = (size_t)HALF * lda * 2, hstepB = (size_t)HALF * ldb * 2;
    const unsigned ldsw = (unsigned)wid * 1024u;
    const int aoff = lds_byte(wr * 64 + fr, fq * 8), boff = lds_byte(wc * 32 + fr, fq * 8);
    unsigned gc[2][2], gn[2][2];
#define PG8_SA(b, h) (((b) * 2 + (h)) * HTB)
#define PG8_SB(b, h) ((4 + (b) * 2 + (h)) * HTB)
#define PG8_STAGE_B(bufoff, gbase) do { _Pragma("unroll") for (int _i = 0; _i < 2; ++_i) \
        __builtin_amdgcn_global_load_lds((const unsigned*)((const char*)(gbase) + voffB[_i]), (LAS unsigned*)(lds + (bufoff) + ldsw + _i * 8192), 16, 0, 0); } while (0)
#define PG8_STAGE_A(bufoff, gbase, h, nx) do { _Pragma("unroll") for (int _i = 0; _i < 2; ++_i) { \
        const char* _p = GATHER ? (const char*)(gbase) + ((nx) ? gn[h][_i] : gc[h][_i]) : (const char*)(gbase) + (h) * hstepA + voffA[_i]; \
        __builtin_amdgcn_global_load_lds((const unsigned*)_p, (LAS unsigned*)(lds + (bufoff) + ldsw + _i * 8192), 16, 0, 0); } } while (0)
#define PG8_LDA(dst, b, h) do { _Pragma("unroll") for (int m = 0; m < 4; ++m) { if constexpr (FP8) { const u32x4 _lo = *(const LAS u32x4*)(lds + PG8_SA(b, h) + aoff + m * 2048), _hi = *(const LAS u32x4*)(lds + PG8_SA(b, h) + aoff + m * 2048 + 1024); \
            dst##8[m] = (v8i){(int)_lo.x, (int)_lo.y, (int)_lo.z, (int)_lo.w, (int)_hi.x, (int)_hi.y, (int)_hi.z, (int)_hi.w}; } \
        else { _Pragma("unroll") for (int k = 0; k < 2; ++k) dst[m][k] = *(const LAS bf16x8*)(lds + PG8_SA(b, h) + aoff + m * 2048 + k * 1024); } } } while (0)
#define PG8_LDB(dst, b, h) do { _Pragma("unroll") for (int n = 0; n < 2; ++n) { if constexpr (FP8) { const u32x4 _lo = *(const LAS u32x4*)(lds + PG8_SB(b, h) + boff + n * 2048), _hi = *(const LAS u32x4*)(lds + PG8_SB(b, h) + boff + n * 2048 + 1024); \
            dst##8[n] = (v8i){(int)_lo.x, (int)_lo.y, (int)_lo.z, (int)_lo.w, (int)_hi.x, (int)_hi.y, (int)_hi.z, (int)_hi.w}; } \
        else { _Pragma("unroll") for (int k = 0; k < 2; ++k) dst[n][k] = *(const LAS bf16x8*)(lds + PG8_SB(b, h) + boff + n * 2048 + k * 1024); } } } while (0)
#define PG8_MMA(ai, bj, At, Bt) do { __builtin_amdgcn_s_setprio(1); if constexpr (FP8) asm volatile("s_nop 1"); _Pragma("unroll") for (int m = 0; m < 4; ++m) _Pragma("unroll") for (int n = 0; n < 2; ++n) { \
        if constexpr (FP8) asm volatile("v_mfma_f32_16x16x128_f8f6f4 %0, %1, %2, %0" : "+v"(acc[ai][bj][m][n]) : "v"(Bt##8[n]), "v"(At##8[m])); \
        else { _Pragma("unroll") for (int k = 0; k < 2; ++k) acc[ai][bj][m][n] = __builtin_amdgcn_mfma_f32_16x16x32_bf16(Bt[n][k], At[m][k], acc[ai][bj][m][n], 0, 0, 0); } } \
        __builtin_amdgcn_s_setprio(0); } while (0)
#define PG8_WAIT_V(n) asm volatile("s_waitcnt vmcnt(" #n ")" ::: "memory")
#define PG8_WAIT_L(n) asm volatile("s_waitcnt lgkmcnt(" #n ")" ::: "memory")
#define PG8_BAR __builtin_amdgcn_s_barrier()
#define PG8_SCHED __builtin_amdgcn_sched_barrier(0)
#define PG8_GIDX(g, u) do { _Pragma("unroll") for (int _h = 0; _h < 2; ++_h) _Pragma("unroll") for (int _i = 0; _i < 2; ++_i) { int _R, _C; stage_rc(tid * 16 + _i * 8192, _R, _C); const int _r = _h * HALF + _R; \
        const int _tok = glist[(u).goff + (_r < (u).nvalid ? _r : (u).nvalid - 1)]; g[_h][_i] = (unsigned)_tok * (unsigned)(lda * 2) + (unsigned)(_C * 2); } } while (0)
    Unit cur, nxt, nn; int ui = 0;
    if (!S.next(0, cur)) return;
    f32x4 acc[2][2][4][2];
#pragma unroll
    for (int a = 0; a < 2; ++a)
#pragma unroll
        for (int b = 0; b < 2; ++b)
#pragma unroll
            for (int m = 0; m < 4; ++m)
#pragma unroll
                for (int n = 0; n < 2; ++n) acc[a][b][m][n] = (f32x4){0.f, 0.f, 0.f, 0.f};
    bf16x8 At[4][2], B0[2][2], B1[2][2];
    v8i At8[4], B08[2], B18[2];
    const char* cA = wsb + cur.aoff; const char* cB = wsb + cur.boff;
    if constexpr (GATHER) { PG8_GIDX(gc, cur); if (S.next(1, nxt)) { PG8_GIDX(gn, nxt); } else { PG8_GIDX(gn, cur); }
        asm volatile("s_waitcnt vmcnt(0)" : "+v"(gc[0][0]), "+v"(gc[0][1]), "+v"(gc[1][0]), "+v"(gc[1][1]), "+v"(gn[0][0]), "+v"(gn[0][1]), "+v"(gn[1][0]), "+v"(gn[1][1]) :: "memory"); }
    else {
#pragma unroll
        for (int h = 0; h < 2; ++h)
#pragma unroll
            for (int i = 0; i < 2; ++i) { gc[h][i] = 0u; gn[h][i] = 0u; } }
    PG8_STAGE_B(PG8_SB(0, 0), cB); PG8_STAGE_B(PG8_SB(0, 1), cB + hstepB); PG8_STAGE_A(PG8_SA(0, 0), cA, 0, false); PG8_STAGE_A(PG8_SA(0, 1), cA, 1, false);
    if (wr == 1) PG8_BAR;
    PG8_WAIT_V(2); PG8_BAR;
    PG8_STAGE_B(PG8_SB(1, 0), cB + kstep); PG8_STAGE_A(PG8_SA(1, 0), cA + kstep, 0, false); PG8_STAGE_B(PG8_SB(1, 1), cB + hstepB + kstep);
    PG8_WAIT_V(6); PG8_BAR;
    for (;;) {
        const bool has_next = S.next(ui + 1, nxt);
        const char* nA = has_next ? wsb + nxt.aoff : cA; const char* nB = has_next ? wsb + nxt.boff : cB;
#pragma clang loop unroll(disable)
        for (int t = 0; t < nt; t += 2) {
            const bool last = (t == nt - 2);
            const char* a1 = cA + (size_t)(t + 1) * kstep;
            const char* a2 = last ? nA : cA + (size_t)(t + 2) * kstep; const char* b2 = last ? nB : cB + (size_t)(t + 2) * kstep;
            const char* a3 = a2 + kstep; const char* b3 = b2 + kstep;
            PG8_LDB(B0, 0, 0); PG8_LDB(B1, 0, 1); PG8_SCHED; PG8_LDA(At, 0, 0); PG8_STAGE_A(PG8_SA(1, 1), a1, 1, false);
            PG8_WAIT_V(8); PG8_WAIT_L(0); PG8_BAR; PG8_MMA(0, 0, At, B0); PG8_MMA(0, 1, At, B1); PG8_BAR; PG8_SCHED;
            PG8_LDA(At, 0, 1); PG8_STAGE_B(PG8_SB(0, 0), b2); PG8_STAGE_B(PG8_SB(0, 1), b2 + hstepB); PG8_STAGE_A(PG8_SA(0, 0), a2, 0, last);
            PG8_WAIT_V(8); PG8_WAIT_L(0); PG8_BAR; PG8_MMA(1, 0, At, B0); PG8_MMA(1, 1, At, B1); PG8_BAR; PG8_SCHED;
            PG8_LDB(B0, 1, 0); PG8_LDB(B1, 1, 1); PG8_SCHED; PG8_LDA(At, 1, 0); PG8_STAGE_A(PG8_SA(0, 1), a2, 1, last);
            PG8_WAIT_V(8); PG8_WAIT_L(0); PG8_BAR; PG8_MMA(0, 0, At, B0); PG8_MMA(0, 1, At, B1); PG8_BAR; PG8_SCHED;
            PG8_LDA(At, 1, 1); PG8_STAGE_B(PG8_SB(1, 0), b3); PG8_STAGE_B(PG8_SB(1, 1), b3 + hstepB); PG8_STAGE_A(PG8_SA(1, 0), a3, 0, last);
            PG8_WAIT_V(8); PG8_WAIT_L(0); PG8_BAR; PG8_MMA(1, 0, At, B0); PG8_MMA(1, 1, At, B1); PG8_BAR; PG8_SCHED;
        }
        if constexpr (FP8) asm volatile("s_nop 15\n\ts_nop 7");
        if constexpr (ALIGN_EPI) { if (wr == 0) PG8_BAR; }
        if constexpr (GATHER) {
#pragma unroll
            for (int h = 0; h < 2; ++h)
#pragma unroll
                for (int i = 0; i < 2; ++i) gc[h][i] = gn[h][i];
            if (has_next && S.next(ui + 2, nn)) { PG8_GIDX(gn, nn); }
        }
        E(acc, cur, wr, wc, fr, fq);
        if constexpr (GATHER) asm volatile("" : "+v"(gn[0][0]), "+v"(gn[0][1]), "+v"(gn[1][0]), "+v"(gn[1][1]));
        if (!has_next) break;
#pragma unroll
        for (int a = 0; a < 2; ++a)
#pragma unroll
            for (int b = 0; b < 2; ++b)
#pragma unroll
                for (int m = 0; m < 4; ++m)
#pragma unroll
                    for (int n = 0; n < 2; ++n) acc[a][b][m][n] = (f32x4){0.f, 0.f, 0.f, 0.f};
        cur = nxt; cA = nA; cB = nB; ++ui;
        if constexpr (ALIGN_EPI) { if (wr == 1) PG8_BAR; }
    }
    PG8_WAIT_V(0);
    if constexpr (!ALIGN_EPI) { if (wr == 0) PG8_BAR; }
    PG8_BAR;
#undef PG8_SA
#undef PG8_SB
#undef PG8_STAGE_A
#undef PG8_STAGE_B
#undef PG8_LDA
#undef PG8_LDB
#undef PG8_MMA
#undef PG8_WAIT_V
#undef PG8_WAIT_L
#undef PG8_BAR
#undef PG8_SCHED
#undef PG8_GIDX
}
}
using pg8::Unit;

#define XB_TMO      128
#define XB_XCNT(j)  (256  + 64 * (j))
#define XB_XSUB(j)  (1280 + 64 * (j))
#define XB_XGEN(j)  (2304 + 64 * (j))
#define XB_TOP      3328
#define XB_TOPGEN   3392
#define XCD_BAR_WORDS 3456
#define XB_SPIN_CAP (1u << 18)
__device__ __forceinline__ unsigned xb_ld(unsigned* p)              { return __hip_atomic_load(p, __ATOMIC_RELAXED, __HIP_MEMORY_SCOPE_AGENT); }
__device__ __forceinline__ unsigned xb_add(unsigned* p, unsigned v) { return __hip_atomic_fetch_add(p, v, __ATOMIC_RELAXED, __HIP_MEMORY_SCOPE_AGENT); }
__device__ __forceinline__ unsigned xb_xcc_id() { return (unsigned)__builtin_amdgcn_s_getreg((3 << 11) | 20) & 0xFu; }
#define XB_SPIN(cond, bar) do { unsigned _sp = 0; while (cond) { __builtin_amdgcn_s_sleep(1); \
    if ((++_sp & 255u) == 0u) { if (xb_ld(&(bar)[XB_TMO])) break; if (_sp > XB_SPIN_CAP) { atomicAdd(&(bar)[XB_TMO], 1u); break; } } } } while (0)
struct XcdBarrier { unsigned* bar; unsigned x; volatile LAS unsigned* st; };
__device__ __forceinline__ XcdBarrier xcd_barrier_post(unsigned* bar, volatile LAS unsigned* st) {
    XcdBarrier b; b.bar = bar; b.x = xb_xcc_id(); b.st = st;
    if (threadIdx.x == 0) (void)xb_add(&bar[XB_XCNT(b.x)], 1u);
    return b;
}
__device__ __forceinline__ void xcd_barrier_complete(unsigned* bar, unsigned x, unsigned& nloc, unsigned& nx) {
    const unsigned G = gridDim.x * gridDim.y * gridDim.z;
    unsigned sum, cnt, mine, sp = 0u;
    for (;;) {
        sum = 0u; cnt = 0u; mine = 0u;
#pragma unroll
        for (unsigned j = 0; j < 16; ++j) { const unsigned c = xb_ld(&bar[XB_XCNT(j)]); sum += c; cnt += (c > 0u) ? 1u : 0u; mine = (j == x) ? c : mine; }
        if (sum == G) break;
        __builtin_amdgcn_s_sleep(1);
        if ((++sp & 255u) == 0u) { if (xb_ld(&bar[XB_TMO])) break; if (sp > XB_SPIN_CAP) { atomicAdd(&bar[XB_TMO], 1u); break; } }
    }
    nloc = mine > 0u ? mine : 1u; nx = cnt > 0u ? cnt : 1u;
}
__device__ __forceinline__ void xcd_barrier(const XcdBarrier& b) {
    asm volatile("s_waitcnt vmcnt(0)" ::: "memory");
    __syncthreads();
    if (threadIdx.x == 0) {
        unsigned* bar = b.bar;
        __builtin_amdgcn_s_waitcnt(0);
        unsigned nloc = b.st[0], nx = b.st[1];
        if (nloc == 0u) { xcd_barrier_complete(bar, b.x, nloc, nx); b.st[0] = nloc; b.st[1] = nx; }
        const unsigned old = xb_add(&bar[XB_XSUB(b.x)], 1u);
        const unsigned gen = old / nloc;
        if (old + 1u == (gen + 1u) * nloc) {
            __builtin_amdgcn_fence(__ATOMIC_RELEASE, "agent");
            asm volatile("s_waitcnt vmcnt(0)" ::: "memory");
            const unsigned og = xb_add(&bar[XB_TOP], 1u);
            const unsigned tg = og / nx;
            if (og + 1u == (tg + 1u) * nx) xb_add(&bar[XB_TOPGEN], 1u);
            else XB_SPIN(xb_ld(&bar[XB_TOPGEN]) == tg, bar);
            __builtin_amdgcn_fence(__ATOMIC_ACQUIRE, "agent");
            xb_add(&bar[XB_XGEN(b.x)], 1u);
            asm volatile("s_waitcnt vmcnt(0)" ::: "memory");
        } else {
            XB_SPIN(xb_ld(&bar[XB_XGEN(b.x)]) == gen, bar);
            __builtin_amdgcn_fence(__ATOMIC_ACQUIRE, "agent");
            asm volatile("s_waitcnt vmcnt(0)" ::: "memory");
        }
    }
    __syncthreads();
}

struct Frame {
    LAS unsigned char* lds;
    volatile LAS unsigned* MISC;
    gu32* ctl;
    unsigned char* ws;
    int tid, lane, wave, vcu, G;
    float* hf;
    const float* const* in;
};
enum In { I_X = 0, I_MEM, I_LN_IN_G, I_LN_IN_B, I_LN_MEM_G, I_LN_MEM_B, I_W_IN, I_B_IN, I_W_DW, I_B_DW, I_LN_CONV_G, I_LN_CONV_B, I_W_OUT, I_B_OUT, I_LN1_G, I_LN1_B,
          I_WQ, I_WK, I_WV, I_WO, I_LN2_G, I_LN2_B, I_W_ROUTER, I_B_ROUTER, I_W_GU, I_B_GU, I_W_DOWN, I_B_DOWN, I_LN3_G, I_LN3_B, N_IN };

__device__ __forceinline__ void p0_transpose_item(const float* W, int K, int N, bf16* WT, int k0, int n0, int drow, LAS float* scr, int lane) {
#pragma unroll 8
    for (int i = 0; i < 32; ++i) { const int kk = 2 * i + (lane >> 5); scr[kk * 33 + (lane & 31)] = W[(size_t)(k0 + kk) * N + n0 + (lane & 31)]; }
    LDS_WAIT(); asm volatile("" ::: "memory");
    const int c = lane & 7;
#pragma unroll
    for (int j = 0; j < 4; ++j) { const int n = (lane >> 3) + 8 * j; const LAS float* s = scr + (8 * c) * 33 + n;
        u32x4 o; o.x = pk2(s[0 * 33], s[1 * 33]); o.y = pk2(s[2 * 33], s[3 * 33]); o.z = pk2(s[4 * 33], s[5 * 33]); o.w = pk2(s[6 * 33], s[7 * 33]);
        *(GAS u32x4*)(WT + (size_t)(drow + n) * K + k0 + 8 * c) = o; }
    LDS_WAIT(); asm volatile("" ::: "memory");
}
__device__ __forceinline__ void ln_row(f32x4 (&v)[4], const float* g, const float* b, int lane) {
    float s = 0.f;
#pragma unroll
    for (int j = 0; j < 4; ++j) s += (v[j].x + v[j].y) + (v[j].z + v[j].w);
    const float mean = wave_sum(s) * (1.f / D); float s2 = 0.f;
#pragma unroll
    for (int j = 0; j < 4; ++j) { v[j] = v[j] - mean; s2 += (v[j].x * v[j].x + v[j].y * v[j].y) + (v[j].z * v[j].z + v[j].w * v[j].w); }
    const float rstd = 1.f / sqrtf(wave_sum(s2) * (1.f / D) + LN_EPS);
#pragma unroll
    for (int j = 0; j < 4; ++j) { const f32x4 gg = ((const GAS f32x4*)g)[lane + 64 * j], bb = ((const GAS f32x4*)b)[lane + 64 * j]; v[j] = v[j] * rstd * gg + bb; }
}
__device__ __forceinline__ void store_row_bf16(const f32x4 (&v)[4], bf16* orow, int lane) {
    GAS u32x2* o8 = (GAS u32x2*)orow + lane;
#pragma unroll
    for (int j = 0; j < 4; ++j) o8[64 * j] = (u32x2){pk2(v[j].x, v[j].y), pk2(v[j].z, v[j].w)};
}
__device__ __forceinline__ void p0_transpose_item8(const float* W, int K, int N, unsigned char* WT, int k0, int n0, int drow, float sc, LAS float* scr, int lane) {
#pragma unroll 8
    for (int i = 0; i < 32; ++i) { const int kk = 2 * i + (lane >> 5); scr[kk * 33 + (lane & 31)] = W[(size_t)(k0 + kk) * N + n0 + (lane & 31)]; }
    LDS_WAIT(); asm volatile("" ::: "memory");
    const int c = lane & 7;
#pragma unroll
    for (int j = 0; j < 4; ++j) { const int n = (lane >> 3) + 8 * j; const LAS float* s = scr + (8 * c) * 33 + n;
        u32x2 o; o.x = pk4_fp8(s[0 * 33] * sc, s[1 * 33] * sc, s[2 * 33] * sc, s[3 * 33] * sc); o.y = pk4_fp8(s[4 * 33] * sc, s[5 * 33] * sc, s[6 * 33] * sc, s[7 * 33] * sc);
        *(GAS u32x2*)(WT + (size_t)(drow + n) * K + k0 + 8 * c) = o; }
    LDS_WAIT(); asm volatile("" ::: "memory");
}
__device__ __forceinline__ void item8_load(f32x4 (&x)[4][4], const float* W, int N, int k0, int n0, int lane) {
    const int g = lane >> 3, c = lane & 7;
#pragma unroll
    for (int q = 0; q < 4; ++q)
#pragma unroll
        for (int j = 0; j < 4; ++j) x[q][j] = *(const GAS f32x4*)(W + (size_t)(k0 + 32 * q + 4 * g + j) * N + n0 + 4 * c);
}
__device__ __forceinline__ void item8_finish(const f32x4 (&x)[4][4], int K, unsigned char* WT, int k0, int drow, float sc, LAS unsigned char* scr, int lane) {
    const int g = lane >> 3, c = lane & 7;
#pragma unroll
    for (int q = 0; q < 4; ++q)
#pragma unroll
        for (int e = 0; e < 4; ++e) *(LAS unsigned*)(scr + (4 * c + e) * 144 + 32 * q + 4 * g) = pk4_fp8(x[q][0][e] * sc, x[q][1][e] * sc, x[q][2][e] * sc, x[q][3][e] * sc);
    LDS_WAIT(); asm volatile("" ::: "memory");
#pragma unroll
    for (int i = 0; i < 4; ++i) { const int t = lane + 64 * i, n = t >> 3, ch = t & 7;
        *(GAS u32x4*)(WT + (size_t)(drow + n) * K + k0 + 16 * ch) = *(const LAS u32x4*)(scr + n * 144 + 16 * ch); }
    LDS_WAIT(); asm volatile("" ::: "memory");
}
__device__ __forceinline__ void p0_transpose_item8b(const float* W, int K, int N, unsigned char* WT, int k0, int n0, int drow, float sc, LAS unsigned char* scr, int lane) {
    f32x4 x[4][4]; item8_load(x, W, N, k0, n0, lane); item8_finish(x, K, WT, k0, drow, sc, scr, lane);
}
__device__ __forceinline__ void load_row_bf16(f32x4 (&v)[4], const bf16* xrow, int lane) {
    const GAS u32x2* xr = (const GAS u32x2*)xrow + lane;
#pragma unroll
    for (int j = 0; j < 4; ++j) { const u32x2 w = xr[64 * j]; v[j] = (f32x4){bflo(w.x), bfhi(w.x), bflo(w.y), bfhi(w.y)}; }
}
__device__ __forceinline__ void load_row_f32(f32x4 (&v)[4], const float* xrow, int lane) {
    const GAS f32x4* xr = (const GAS f32x4*)xrow + lane;
#pragma unroll
    for (int j = 0; j < 4; ++j) v[j] = xr[64 * j];
}
__device__ __forceinline__ void store_row_f32(const f32x4 (&v)[4], float* orow, int lane) {
    GAS f32x4* o = (GAS f32x4*)orow + lane;
#pragma unroll
    for (int j = 0; j < 4; ++j) o[64 * j] = v[j];
}

constexpr int I_GU = NE * 8 * 64, I_DN = NE * 8 * 32, N_EXPERT_ITEMS = I_GU + I_DN;
struct ExpItem { const float* W; unsigned char* WT; int K, N, k0, n0, drow; float sc; };
__device__ __forceinline__ ExpItem expert_item_decode(Frame& F, int it) {
    ExpItem x;
    if (it < I_GU) { const int e = it / (8 * 64), q = it % (8 * 64), kb = q / 64, nb = q % 64, n0 = 32 * nb;
        x.W = F.in[I_W_GU] + (size_t)e * D * 2 * DFF; x.WT = F.ws + WS_WGU_T + (size_t)e * 2 * DFF * D; x.K = D; x.N = 2 * DFF; x.k0 = 128 * kb; x.n0 = n0;
        x.drow = (n0 < 1024) ? (n0 >> 7) * 256 + (n0 & 127) : ((n0 - 1024) >> 7) * 256 + 128 + (n0 & 127); x.sc = WGU_SC; }
    else { const int r = it - I_GU, e = r / (8 * 32), q = r % (8 * 32), kb = q / 32, nb = q % 32;
        x.W = F.in[I_W_DOWN] + (size_t)e * DFF * D; x.WT = F.ws + WS_WDN_T + (size_t)e * D * DFF; x.K = DFF; x.N = D; x.k0 = 128 * kb; x.n0 = 32 * nb; x.drow = 32 * nb; x.sc = WDN_SC; }
    return x;
}
__device__ __forceinline__ void expert_stream(Frame& F, int sw, int nsw, LAS unsigned char* scr) {
    for (int it = sw; it < N_EXPERT_ITEMS; it += 3 * nsw) {
        const int it2 = it + nsw, it3 = it + 2 * nsw; const bool two = it2 < N_EXPERT_ITEMS, three = it3 < N_EXPERT_ITEMS;
        const ExpItem a = expert_item_decode(F, it), b = expert_item_decode(F, two ? it2 : it), c = expert_item_decode(F, three ? it3 : it);
        f32x4 xa[4][4], xb[4][4], xc[4][4];
        item8_load(xa, a.W, a.N, a.k0, a.n0, F.lane);
        if (two) item8_load(xb, b.W, b.N, b.k0, b.n0, F.lane);
        if (three) item8_load(xc, c.W, c.N, c.k0, c.n0, F.lane);
        item8_finish(xa, a.K, a.WT, a.k0, a.drow, a.sc, scr, F.lane);
        if (two) item8_finish(xb, b.K, b.WT, b.k0, b.drow, b.sc, scr + 5120, F.lane);
        if (three) item8_finish(xc, c.K, c.WT, c.k0, c.drow, c.sc, scr + 10240, F.lane);
    }
}
__device__ __forceinline__ void p0_prologue(Frame& F) {
    LAS float* scr = (LAS float*)(F.lds + RING_OFF + F.wave * 16384);
    const int gw = F.vcu * NWAVES + F.wave, NGW = F.G * NWAVES;
    constexpr int I_IN = 16 * 80, I_SQ = 16 * 32;
    constexpr int NITEMS = I_IN + 3 * I_SQ + 2 * 256;
    for (int it = gw; it < NITEMS; it += NGW) {
        int r = it;
        if (r < I_IN) { const int kb = r / 80, nb = r % 80, n0 = 32 * nb; int drow;
            if (n0 < 512) drow = (n0 >> 7) * 256 + (n0 & 127); else if (n0 < 1024) drow = ((n0 - 512) >> 7) * 256 + 128 + (n0 & 127); else drow = n0;
            p0_transpose_item(F.in[I_W_IN], D, INC, (bf16*)(F.ws + WS_WIN_T), 64 * kb, n0, drow, scr, F.lane); continue; } r -= I_IN;
        if (r < 3 * I_SQ) { const int w = r / I_SQ, q = r % I_SQ, kb = q / 32, nb = q % 32;
            const float* src = F.in[w == 0 ? I_W_OUT : w == 1 ? I_WK : I_WV];
            bf16* dst = (bf16*)(F.ws + (w == 0 ? WS_WOUT_T : w == 1 ? WS_WK_T : WS_WV_T));
            p0_transpose_item(src, D, D, dst, 64 * kb, 32 * nb, 32 * nb, scr, F.lane); continue; } r -= 3 * I_SQ;
        { const int w = r / 256, q = r % 256, kb = q / 32, nb = q % 32;
            p0_transpose_item8b(F.in[w == 0 ? I_WQ : I_WO], D, D, F.ws + (w == 0 ? WS_WQ_T : WS_WO_T), 128 * kb, 32 * nb, 32 * nb, w == 0 ? WQ_SC : WO_SC, (LAS unsigned char*)scr, F.lane); }
    }
    if (gw < 512) { const int idx = gw * 64 + F.lane, c = idx >> 5, e = idx & 31; const float w = F.in[I_W_ROUTER][idx];
        const unsigned hi = f2bf(w), lo = f2bf(w - __builtin_bit_cast(float, hi << 16)); bf16* wr = (bf16*)(F.ws + WS_WR);
        wr[e * WR_STRIDE + c] = (bf16)hi; wr[(32 + e) * WR_STRIDE + c] = (bf16)lo; }
    for (int m = gw; m < M + MM; m += NGW) {
        f32x4 v[4];
        if (m < M) { load_row_f32(v, F.in[I_X] + (size_t)m * D, F.lane); ln_row(v, F.in[I_LN_IN_G], F.in[I_LN_IN_B], F.lane);
            store_row_bf16(v, (bf16*)(F.ws + WS_HB) + (size_t)m * D, F.lane); }
        else { const int mm = m - M; load_row_f32(v, F.in[I_MEM] + (size_t)mm * D, F.lane); ln_row(v, F.in[I_LN_MEM_G], F.in[I_LN_MEM_B], F.lane);
            store_row_bf16(v, (bf16*)(F.ws + WS_MEMN) + (size_t)mm * D, F.lane); }
    }
}

constexpr unsigned TSTEP = 256u * 1024u * 2u;
struct SchedP1 { int G, c;
    __device__ __forceinline__ bool next(int i, Unit& u) const {
        const int L = i * G + c; if (L >= 1280) return false;
        u.nvalid = 256; u.goff = 0;
        if (L < 1024) { pg8::tile_order(L, 128, 8, u.pm, u.pn); u.z = 0; u.aoff = (unsigned)WS_HB + (unsigned)u.pm * TSTEP; u.boff = (unsigned)WS_WIN_T + (unsigned)u.pn * TSTEP; }
        else { const int j = L - 1024; u.pm = j & 1; u.pn = j >> 1; u.z = 3; u.aoff = (unsigned)WS_WIN_T + (unsigned)(8 + u.pm) * TSTEP; u.boff = (unsigned)WS_HB + (unsigned)u.pn * TSTEP; }
        return true; }
};
struct SchedKV { int v;
    __device__ __forceinline__ bool next(int i, Unit& u) const {
        if (i > 0 || v >= 64) return false;
        u.nvalid = 256; u.goff = 0;
        if (v < 32) { u.pm = v & 7; u.pn = v >> 3; u.z = 1; u.aoff = (unsigned)WS_MEMN + (unsigned)u.pm * TSTEP; u.boff = (unsigned)WS_WK_T + (unsigned)u.pn * TSTEP; }
        else { const int j = v - 32; u.pm = j & 3; u.pn = j >> 2; u.z = 2; u.aoff = (unsigned)WS_WV_T + (unsigned)u.pm * TSTEP; u.boff = (unsigned)WS_MEMN + (unsigned)u.pn * TSTEP; }
        return true; }
};
struct EpiP1 { static constexpr bool PERM = true;
    unsigned char* ws; const float* b_in;
    __device__ __forceinline__ void operator()(const f32x4 (&acc)[2][2][4][2], const Unit& u, int wr, int wc, int fr, int fq) const {
        const int row0 = u.pm * 256 + wr * 64 + fr;
        if (u.z == 0) {
            if (u.pn < 4) {
                const int ch = 128 * u.pn + wc * 32 + 8 * fq;
                f32x4 bv[2], bg[2];
#pragma unroll
                for (int n = 0; n < 2; ++n) { bv[n] = *(const f32x4*)(b_in + ch + 4 * n); bg[n] = *(const f32x4*)(b_in + 512 + ch + 4 * n); }
                bf16* U = (bf16*)(ws + WS_U);
#pragma unroll
                for (int ai = 0; ai < 2; ++ai)
#pragma unroll
                    for (int m = 0; m < 4; ++m) { f32x4 o[2];
#pragma unroll
                        for (int n = 0; n < 2; ++n) { const f32x4 a = acc[ai][0][m][n] + bv[n], g = acc[ai][1][m][n] + bg[n];
#pragma unroll
                            for (int j = 0; j < 4; ++j) o[n][j] = a[j] * sigmoidf_fast(g[j]); }
                        u32x4 w; w.x = pg8::cvt_pk_bf16(o[0][0], o[0][1]); w.y = pg8::cvt_pk_bf16(o[0][2], o[0][3]); w.z = pg8::cvt_pk_bf16(o[1][0], o[1][1]); w.w = pg8::cvt_pk_bf16(o[1][2], o[1][3]);
                        *(u32x4*)(U + (size_t)(row0 + ai * 128 + m * 16) * 512 + ch) = w; }
            } else {
                const int t = u.pn - 4, which = t >> 1, cb = (t & 1) * 256;
                bf16* dst = (bf16*)(ws + (which == 0 ? WS_Q : WS_K));
                pg8::store_tile_bf16(acc, dst + (size_t)row0 * 512 + cb, 512, b_in + 1024 + 256 * t, which == 0 ? SB_QSCALE : 1.0f, wc, fq);
            }
        } else if (u.z == 3) {
            const float* rb = b_in + 2048 + row0; bf16* p0 = (bf16*)(ws + WS_V) + (size_t)row0 * M + 256 * u.pn; const int cl = wc * 32 + 8 * fq;
#pragma unroll
            for (int ai = 0; ai < 2; ++ai)
#pragma unroll
                for (int m = 0; m < 4; ++m) { const float bv = rb[ai * 128 + m * 16]; bf16* rowp = p0 + (size_t)(ai * 128 + m * 16) * M + cl;
#pragma unroll
                    for (int bj = 0; bj < 2; ++bj) { const f32x4 v0 = acc[ai][bj][m][0] + bv, v1 = acc[ai][bj][m][1] + bv;
                        u32x4 w; w.x = pg8::cvt_pk_bf16(v0[0], v0[1]); w.y = pg8::cvt_pk_bf16(v0[2], v0[3]); w.z = pg8::cvt_pk_bf16(v1[0], v1[1]); w.w = pg8::cvt_pk_bf16(v1[2], v1[3]);
                        *(u32x4*)(rowp + bj * 128) = w; } }
        } else if (u.z == 1) pg8::store_tile_bf16(acc, (bf16*)(ws + WS_KM) + (size_t)row0 * 1024 + 256 * u.pn, 1024, nullptr, 1.0f, wc, fq);
        else pg8::store_tile_bf16(acc, (bf16*)(ws + WS_VMT) + (size_t)row0 * 2048 + 256 * u.pn, 2048, nullptr, 1.0f, wc, fq);
    }
};

struct SchedPlain { int G, c, nM, nN; unsigned abase, bbase, atile, btile, acol, bcol, bgrp;
    __device__ __forceinline__ bool next(int i, Unit& u) const {
        const int L = i * G + c; if (L >= nM * nN) return false;
        pg8::tile_order(L, nM, nN, u.pm, u.pn); u.z = 0; u.nvalid = 256; u.goff = 0;
        u.aoff = abase + (unsigned)u.pm * atile + (unsigned)u.pn * acol; u.boff = bbase + (unsigned)u.pn * btile + (unsigned)(u.pm >> 4) * bgrp + (unsigned)u.pn * bcol; return true; }
};
struct EpiBf16 { static constexpr bool PERM = true;
    bf16* O; int ldc; float scale; const float* bias;
    __device__ __forceinline__ void operator()(const f32x4 (&acc)[2][2][4][2], const Unit& u, int wr, int wc, int fr, int fq) const {
        pg8::store_tile_bf16(acc, O + (size_t)(u.pm * 256 + wr * 64 + fr) * ldc + 256 * u.pn, (size_t)ldc, bias ? bias + 256 * u.pn : nullptr, scale, wc, fq); }
};
struct SchedMoe { int G, c, nN; const LAS int* tb; unsigned abase, wbase, wexp;
    bool gather;
    __device__ __forceinline__ bool next(int i, Unit& u) const {
        const int nblk = __builtin_amdgcn_readfirstlane(tb[32]); const int L = i * G + c; if (L >= nblk * nN) return false;
        pg8::tile_order(L, nblk, nN, u.pm, u.pn);
        const int e = __builtin_amdgcn_readfirstlane(tb[128 + u.pm]);
        const int j = u.pm - tb[e], rem = tb[64 + e] - 256 * j;
        u.z = e; u.nvalid = rem < 256 ? rem : 256; u.goff = (unsigned)(e * LCAP + 256 * j);
        u.aoff = gather ? abase : abase + (unsigned)u.pm * (TSTEP / 2);
        u.boff = wbase + (unsigned)e * wexp + (unsigned)u.pn * (TSTEP / 2); return true; }
};
struct EpiAct { static constexpr bool PERM = true;
    unsigned char* ACT; const float* b_gu;
    __device__ __forceinline__ void operator()(const f32x4 (&acc)[2][2][4][2], const Unit& u, int wr, int wc, int fr, int fq) const {
        const int row0 = u.pm * 256 + wr * 64 + fr, ch = 128 * u.pn + wc * 32 + 8 * fq;
        const float* bb = b_gu + (size_t)u.z * 2 * DFF;
        f32x4 bg[2], bu[2];
#pragma unroll
        for (int n = 0; n < 2; ++n) { bg[n] = *(const f32x4*)(bb + ch + 4 * n); bu[n] = *(const f32x4*)(bb + DFF + ch + 4 * n); }
#pragma unroll
        for (int ai = 0; ai < 2; ++ai)
#pragma unroll
            for (int m = 0; m < 4; ++m) { f32x4 o[2];
#pragma unroll
                for (int n = 0; n < 2; ++n) { const f32x4 g = acc[ai][0][m][n] * (1.0f / WGU_SC) + bg[n], uu = acc[ai][1][m][n] * (1.0f / WGU_SC) + bu[n];
#pragma unroll
                    for (int j = 0; j < 4; ++j) { const float g_ = fminf(g[j], 7.0f), u_ = fminf(fmaxf(uu[j], -7.0f), 7.0f); o[n][j] = (u_ + 1.0f) * g_ * sigmoidf_fast(1.702f * g_); } }
                *(u32x2*)(ACT + (size_t)(row0 + ai * 128 + m * 16) * DFF + ch) = (u32x2){pk4_fp8(o[0][0], o[0][1], o[0][2], o[0][3]), pk4_fp8(o[1][0], o[1][1], o[1][2], o[1][3])}; }
    }
};
struct EpiDown { static constexpr bool PERM = true;
    unsigned char* YS; const float* b_down; const float* lgate;
    __device__ __forceinline__ void operator()(const f32x4 (&acc)[2][2][4][2], const Unit& u, int wr, int wc, int fr, int fq) const {
        const int r0 = wr * 64 + fr, cl = wc * 32 + 8 * fq;
        const float* bb = b_down + (size_t)u.z * D + 256 * u.pn + cl;
        f32x4 bv[2][2];
#pragma unroll
        for (int bj = 0; bj < 2; ++bj)
#pragma unroll
            for (int n = 0; n < 2; ++n) bv[bj][n] = *(const f32x4*)(bb + bj * 128 + 4 * n);
        float gts[2][4];
#pragma unroll
        for (int ai = 0; ai < 2; ++ai)
#pragma unroll
            for (int m = 0; m < 4; ++m) { const int r = r0 + ai * 128 + m * 16; gts[ai][m] = lgate[u.goff + (r < u.nvalid ? r : u.nvalid - 1)]; }
#pragma unroll
        for (int ai = 0; ai < 2; ++ai)
#pragma unroll
            for (int m = 0; m < 4; ++m) { const int r = r0 + ai * 128 + m * 16; const float gt = (r < u.nvalid) ? gts[ai][m] * YS_SC : 0.f;
                unsigned char* rowp = YS + (size_t)(u.pm * 256 + r) * D + 256 * u.pn + cl;
#pragma unroll
                for (int bj = 0; bj < 2; ++bj) { const f32x4 v0 = (acc[ai][bj][m][0] * (1.0f / WDN_SC) + bv[bj][0]) * gt, v1 = (acc[ai][bj][m][1] * (1.0f / WDN_SC) + bv[bj][1]) * gt;
                    *(u32x2*)(rowp + bj * 128) = (u32x2){pk4_fp8(v0[0], v0[1], v0[2], v0[3]), pk4_fp8(v1[0], v1[1], v1[2], v1[3])}; } }
    }
};
__device__ __forceinline__ void moe_table(Frame& F, LAS int* tb) {
    if (F.tid < 32) { int c = (int)__hip_atomic_load(F.ctl + CW_ECNT + 64 * F.tid, RLX_AGENT); if (c > LCAP) c = LCAP; tb[64 + F.tid] = c; }
    LDS_WAIT(); __syncthreads();
    if (F.tid == 0) { int s = 0; for (int e = 0; e < NE; ++e) { tb[e] = s; s += (tb[64 + e] + 255) >> 8; } tb[32] = s; }
    LDS_WAIT(); __syncthreads();
    for (int b = F.tid; b < NBLK_MAX; b += NWAVES * 64) { int e = 0; while (e < NE - 1 && tb[e + 1] <= b) ++e; tb[128 + b] = e; }
    LDS_WAIT(); __syncthreads();
}

__device__ __forceinline__ void conv_phase(Frame& F) {
    LAS unsigned* ut = (LAS unsigned*)(F.lds + RING_OFF);
    LAS float* co = (LAS float*)(F.lds + RING_OFF + 65536);
    const int cp = F.tid & 255, half = F.tid >> 8;
    float w0[CWID], w1[CWID];
    { const float* wd = F.in[I_W_DW] + 2 * cp;
#pragma unroll
        for (int j = 0; j < CWID; ++j) { const f32x2 w = *(const GAS f32x2*)(wd + j * CONV_CH); w0[j] = w.x; w1[j] = w.y; } }
    const f32x2 bd = *(const GAS f32x2*)(F.in[I_B_DW] + 2 * cp);
    const f32x4 g0 = *(const GAS f32x4*)(F.in[I_LN_CONV_G] + 8 * F.lane), g1 = *(const GAS f32x4*)(F.in[I_LN_CONV_G] + 8 * F.lane + 4);
    const f32x4 b0 = *(const GAS f32x4*)(F.in[I_LN_CONV_B] + 8 * F.lane), b1 = *(const GAS f32x4*)(F.in[I_LN_CONV_B] + 8 * F.lane + 4);
    bf16* MX = (bf16*)(F.ws + WS_MIXIN);
    for (int it = F.vcu; it < NB * (T_ / 32); it += F.G) {
        const int b = it / (T_ / 32), t0 = (it % (T_ / 32)) * 32;
        const bf16* U = (const bf16*)(F.ws + WS_U) + (size_t)b * T_ * CONV_CH;
        for (int idx = F.tid; idx < 62 * 64; idx += 512) { const int r = idx >> 6, c16 = idx & 63, t = t0 - 30 + r;
            u32x4 v = (u32x4){0u, 0u, 0u, 0u}; if (t >= 0) v = *(const GAS u32x4*)(U + (size_t)t * CONV_CH + c16 * 8);
            *(LAS u32x4*)(ut + r * 256 + c16 * 4) = v; }
        LDS_WAIT(); __syncthreads();
        { float a0[16], a1[16];
#pragma unroll
            for (int tt = 0; tt < 16; ++tt) { a0[tt] = bd.x; a1[tt] = bd.y; }
#pragma unroll
            for (int r = 0; r < 46; ++r) { const unsigned uu = ut[(half * 16 + r) * 256 + cp]; const float u0 = bflo(uu), u1 = bfhi(uu);
#pragma unroll
                for (int tt = 0; tt < 16; ++tt) { const int j = r - tt; if (j >= 0 && j < CWID) { a0[tt] += w0[j] * u0; a1[tt] += w1[j] * u1; } } }
#pragma unroll
            for (int tt = 0; tt < 16; ++tt) *(LAS f32x2*)(co + (half * 16 + tt) * CONV_CH + 2 * cp) = (f32x2){a0[tt], a1[tt]};
        }
        LDS_WAIT(); __syncthreads();
#pragma unroll
        for (int q = 0; q < 4; ++q) { const int tt = 4 * F.wave + q;
            f32x4 x0 = *(const LAS f32x4*)(co + tt * CONV_CH + 8 * F.lane), x1 = *(const LAS f32x4*)(co + tt * CONV_CH + 8 * F.lane + 4);
            const float mean = wave_sum((x0.x + x0.y) + (x0.z + x0.w) + (x1.x + x1.y) + (x1.z + x1.w)) * (1.f / CONV_CH);
            x0 = x0 - mean; x1 = x1 - mean;
            const float var = wave_sum((x0.x * x0.x + x0.y * x0.y) + (x0.z * x0.z + x0.w * x0.w) + (x1.x * x1.x + x1.y * x1.y) + (x1.z * x1.z + x1.w * x1.w)) * (1.f / CONV_CH);
            const float rstd = 1.f / sqrtf(var + LN_EPS);
            x0 = x0 * rstd * g0 + b0; x1 = x1 * rstd * g1 + b1;
            float y[8] = {x0.x, x0.y, x0.z, x0.w, x1.x, x1.y, x1.z, x1.w};
#pragma unroll
            for (int j = 0; j < 8; ++j) y[j] = y[j] * sigmoidf_fast(y[j]);
            *(GAS u32x4*)(MX + (size_t)(b * T_ + t0 + tt) * D + 8 * F.lane) = (u32x4){pk2(y[0], y[1]), pk2(y[2], y[3]), pk2(y[4], y[5]), pk2(y[6], y[7])}; }
        __syncthreads();
    }
}

typedef float f32x16 __attribute__((ext_vector_type(16)));
__device__ __forceinline__ int crow(int r, int hi) { return (r & 3) + 8 * (r >> 2) + 4 * hi; }
__device__ __forceinline__ bf16x8 pack8(const float* v) {
    u32x4 w; w.x = pg8::cvt_pk_bf16(v[0], v[1]); w.y = pg8::cvt_pk_bf16(v[2], v[3]); w.z = pg8::cvt_pk_bf16(v[4], v[5]); w.w = pg8::cvt_pk_bf16(v[6], v[7]);
    return __builtin_bit_cast(bf16x8, w); }
constexpr float SB_EXIT = 150.0f;
struct SbStage { u32x4 k[4], v[4]; };
__device__ __forceinline__ void sb_gload(SbStage& g, const bf16* Kt, const bf16* Vt, int lane) {
#pragma unroll
    for (int i = 0; i < 4; ++i) { const int c = (lane & 7) ^ ((4 * i + (lane >> 4)) & 7); g.k[i] = *(const GAS u32x4*)(Kt + (size_t)(8 * i) * SBW + 8 * c); }
#pragma unroll
    for (int i = 0; i < 4; ++i) g.v[i] = *(const GAS u32x4*)(Vt + (size_t)(16 * i) * M);
}
__device__ __forceinline__ void sb_lwrite(const SbStage& g, LAS unsigned char* buf, int lane) {
#pragma unroll
    for (int i = 0; i < 4; ++i) *(LAS u32x4*)(buf + 1024 * i + 16 * lane) = g.k[i];
#pragma unroll
    for (int i = 0; i < 4; ++i) *(LAS u32x4*)(buf + 4096 + 1024 * i + 16 * lane) = g.v[i];
}
__device__ __forceinline__ void sb_attn_wave(Frame& F, int b, int h, int qt) {
    const int c = F.lane & 31, hi = F.lane >> 5;
    const bf16* Q = (const bf16*)(F.ws + WS_Q); const bf16* Kb = (const bf16*)(F.ws + WS_K); const bf16* VT = (const bf16*)(F.ws + WS_V);
    LAS unsigned char* wbuf = F.lds + RING_OFF + F.wave * 16384;
    bf16x8 tri[2];
#pragma unroll
    for (int s = 0; s < 2; ++s) { bf16x8 t;
#pragma unroll
        for (int j = 0; j < 8; ++j) { const int k = 16 * s + 8 * (j >> 2) + 4 * hi + (j & 3); t[j] = (k >= c) ? (short)0xBF80 : (short)0; }
        tri[s] = t; }
    bf16x8 qf[4];
    { const bf16* qp = Q + ((size_t)b * T_ + 32 * qt + c) * SBW + h * SBD + 8 * hi;
#pragma unroll
        for (int s = 0; s < 4; ++s) qf[s] = *(const GAS bf16x8*)(qp + 16 * s); }
    const bf16* Ksrc = Kb + ((size_t)b * T_ + (F.lane >> 3)) * SBW + h * SBD;
    const bf16* Vsrc = VT + (size_t)(h * SBD + (F.lane >> 2)) * M + (size_t)b * T_ + 8 * ((F.lane & 3) ^ ((F.lane >> 4) & 3));

    const int ksw = (c >> 1) & 7, vsw = (c >> 2) & 3;

    f32x16 o0, o1;
#pragma unroll
    for (int r = 0; r < 16; ++r) { o0[r] = 0.f; o1[r] = 0.f; }
    float carry = 0.f;
    SbStage st;
    sb_gload(st, Ksrc + (size_t)(32 * qt) * SBW, Vsrc + 32 * qt, F.lane); sb_lwrite(st, wbuf, F.lane);
    for (int kt = qt; kt >= 0; --kt) {
        LAS unsigned char* buf = wbuf + ((qt - kt) & 1) * 8192;
        if (kt > 0) sb_gload(st, Ksrc + (size_t)(32 * (kt - 1)) * SBW, Vsrc + 32 * (kt - 1), F.lane);
        const bool diag = (kt == qt);
        bf16x8 kf[4];
#pragma unroll
        for (int s = 0; s < 4; ++s) kf[s] = *(const LAS bf16x8*)(buf + c * 128 + 16 * ((2 * s + hi) ^ ksw));
        f32x16 p;
#pragma unroll
        for (int r = 0; r < 16; ++r) p[r] = 0.f;
#pragma unroll
        for (int s = 0; s < 4; ++s) p = __builtin_amdgcn_mfma_f32_32x32x16_bf16(kf[s], qf[s], p, 0, 0, 0);
        u32x2 vv[2][2][2];
#pragma unroll
        for (int dt = 0; dt < 2; ++dt)
#pragma unroll
            for (int s = 0; s < 2; ++s)
#pragma unroll
                for (int q = 0; q < 2; ++q) vv[dt][s][q] = *(const LAS u32x2*)(buf + 4096 + (32 * dt + c) * 64 + 16 * ((2 * s + q) ^ vsw) + 8 * hi);
        float L[16];
#pragma unroll
        for (int r = 0; r < 16; ++r) { const float y = p[r]; float l = __builtin_amdgcn_logf(1.0f + __builtin_amdgcn_exp2f(y)); l = (y > 64.f) ? y : l;
            if (diag) l = (crow(r, hi) >= c) ? 0.f : l; L[r] = l; }
        const bf16x8 l0 = pack8(L), l1 = pack8(L + 8);
        f32x16 a;
#pragma unroll
        for (int r = 0; r < 16; ++r) a[r] = p[r] - carry;
        a = __builtin_amdgcn_mfma_f32_32x32x16_bf16(tri[0], l0, a, 0, 0, 0); a = __builtin_amdgcn_mfma_f32_32x32x16_bf16(tri[1], l1, a, 0, 0, 0);
        const float tot = p[0] - a[0];
        float w[16];
#pragma unroll
        for (int r = 0; r < 16; ++r) { float x = __builtin_amdgcn_exp2f(a[r]); if (diag) x = (crow(r, hi) >= c) ? 0.f : x; w[r] = x; }
        const bf16x8 p0 = pack8(w), p1 = pack8(w + 8);
        { const bf16x8 v00 = __builtin_bit_cast(bf16x8, (u32x4){vv[0][0][0].x, vv[0][0][0].y, vv[0][0][1].x, vv[0][0][1].y});
          const bf16x8 v01 = __builtin_bit_cast(bf16x8, (u32x4){vv[0][1][0].x, vv[0][1][0].y, vv[0][1][1].x, vv[0][1][1].y});
          const bf16x8 v10 = __builtin_bit_cast(bf16x8, (u32x4){vv[1][0][0].x, vv[1][0][0].y, vv[1][0][1].x, vv[1][0][1].y});
          const bf16x8 v11 = __builtin_bit_cast(bf16x8, (u32x4){vv[1][1][0].x, vv[1][1][0].y, vv[1][1][1].x, vv[1][1][1].y});
          o0 = __builtin_amdgcn_mfma_f32_32x32x16_bf16(v00, p0, o0, 0, 0, 0); o0 = __builtin_amdgcn_mfma_f32_32x32x16_bf16(v01, p1, o0, 0, 0, 0);
          o1 = __builtin_amdgcn_mfma_f32_32x32x16_bf16(v10, p0, o1, 0, 0, 0); o1 = __builtin_amdgcn_mfma_f32_32x32x16_bf16(v11, p1, o1, 0, 0, 0); }
        carry = __shfl(tot, c);
        if (__all(carry >= SB_EXIT)) break;
        if (kt > 0) sb_lwrite(st, wbuf + ((qt - kt + 1) & 1) * 8192, F.lane);
    }
    bf16* op = (bf16*)(F.ws + WS_MIXIN) + ((size_t)b * T_ + 32 * qt + c) * D + CONV_CH + h * SBD + 4 * hi;
#pragma unroll
    for (int g = 0; g < 4; ++g) {
        *(GAS u32x2*)(op + 8 * g) = (u32x2){pg8::cvt_pk_bf16(o0[4 * g], o0[4 * g + 1]), pg8::cvt_pk_bf16(o0[4 * g + 2], o0[4 * g + 3])};
        *(GAS u32x2*)(op + 32 + 8 * g) = (u32x2){pg8::cvt_pk_bf16(o1[4 * g], o1[4 * g + 1]), pg8::cvt_pk_bf16(o1[4 * g + 2], o1[4 * g + 3])}; }
}

__device__ __forceinline__ void resid_row(f32x4 (&v)[4], const bf16* hrow, const bf16* mrow, int lane) {
    f32x4 a[4]; load_row_bf16(v, hrow, lane); load_row_bf16(a, mrow, lane);
#pragma unroll
    for (int j = 0; j < 4; ++j) v[j] = v[j] * DN_ALPHA + a[j];
}
__device__ __forceinline__ void ln_phase(Frame& F, const float* g, const float* b) {
    int r0, r1;
    if (F.G == 256) { if (F.vcu < 64) { r0 = 64 * F.vcu; r1 = r0 + 64; } else { const int j = F.vcu - 64; r0 = 4096 + (j * 28672) / 192; r1 = 4096 + ((j + 1) * 28672) / 192; } }
    else { r0 = (int)(((long)F.vcu * M) / F.G); r1 = (int)(((long)(F.vcu + 1) * M) / F.G); }
    for (int m = r0 + F.wave; m < r1; m += NWAVES) { f32x4 v[4]; bf16* hrow = (bf16*)(F.ws + WS_HB) + (size_t)m * D; resid_row(v, hrow, (const bf16*)(F.ws + WS_QM) + (size_t)m * D, F.lane);
        ln_row(v, g, b, F.lane); store_row_bf16(v, hrow, F.lane);
        { GAS unsigned* h8 = (GAS unsigned*)(F.ws + WS_HB8 + (size_t)m * D) + F.lane;
#pragma unroll
            for (int j = 0; j < 4; ++j) h8[64 * j] = pk4_fp8(v[j].x, v[j].y, v[j].z, v[j].w); } }
}
__device__ __forceinline__ void softmax_phase(Frame& F) {
    const int gw = F.vcu * NWAVES + F.wave, NGW = F.G * NWAVES;
    for (int m = gw; m < M; m += NGW) { GAS u32x2* p = (GAS u32x2*)((bf16*)(F.ws + WS_SP) + (size_t)m * D) + F.lane;
#pragma unroll
        for (int j = 0; j < 4; ++j) { const u32x2 w = p[64 * j]; float x0 = bflo(w.x), x1 = bfhi(w.x), x2 = bflo(w.y), x3 = bfhi(w.y);
            const float mx = wave_max(fmaxf(fmaxf(x0, x1), fmaxf(x2, x3)));
            x0 = __builtin_amdgcn_exp2f(x0 - mx); x1 = __builtin_amdgcn_exp2f(x1 - mx); x2 = __builtin_amdgcn_exp2f(x2 - mx); x3 = __builtin_amdgcn_exp2f(x3 - mx);
            const float inv = 1.0f / wave_sum((x0 + x1) + (x2 + x3));
            p[64 * j] = (u32x2){pk2(x0 * inv, x1 * inv), pk2(x2 * inv, x3 * inv)}; } }
}
__device__ __forceinline__ void xattn_phase(Frame& F) {
    LAS unsigned char* tb0 = F.lds + RING_OFF;
    const bf16* QM = (const bf16*)(F.ws + WS_QM); const bf16* KM = (const bf16*)(F.ws + WS_KM); const bf16* VMT = (const bf16*)(F.ws + WS_VMT); bf16* OB = (bf16*)(F.ws + WS_OB);
    const int c = F.lane & 31, h5 = F.lane >> 5;
    const int tr = F.tid >> 5, tc = F.tid & 31;
    const int kr = F.tid >> 4, kc = F.tid & 15;
    for (int u = F.vcu; u < NB * 4 * 16; u += F.G) {
        const int b = u >> 6, h = (u >> 4) & 3, qt = u & 15;
        const size_t rowq = (size_t)b * T_ + 256 * qt + 32 * F.wave + c;
        const bf16* qp = QM + rowq * D + h * 256 + 8 * h5;
        const bf16* ksrc = KM + ((size_t)b * NMEM + kr) * D + h * 256 + 8 * kc;
        const int kw0 = kr * 272 + kc * 16, kw1 = (kr + 32) * 272 + kc * 16;
        const bf16* vsrc = VMT + ((size_t)h * 256 + tr) * (size_t)MM + (size_t)b * NMEM + 8 * tc;
        int vw[4];
#pragma unroll
        for (int j = 0; j < 4; ++j) vw[j] = (tr + 16 * j) * 528 + tc * 16;
        u32x4 st[4];
        __syncthreads();
        st[0] = *(const GAS u32x4*)ksrc; st[1] = *(const GAS u32x4*)(ksrc + (size_t)32 * D);
        *(LAS u32x4*)(tb0 + kw0) = st[0]; *(LAS u32x4*)(tb0 + kw1) = st[1];
        LDS_WAIT(); __syncthreads();
        f32x16 sacc[8];
#pragma unroll
        for (int dh = 0; dh < 2; ++dh) {
            bf16x8 qf[8];
#pragma unroll
            for (int s_ = 0; s_ < 8; ++s_) qf[s_] = *(const GAS bf16x8*)(qp + 128 * dh + 16 * s_);
#pragma unroll
            for (int kp = 0; kp < 4; ++kp) { const int i = dh * 4 + kp;
                LAS unsigned char* buf = tb0 + (i & 1) * 34816; LAS unsigned char* nbuf = tb0 + ((i + 1) & 1) * 34816;
                if (i < 7) { const bf16* p = ksrc + (size_t)(64 * ((i + 1) & 3)) * D + 128 * ((i + 1) >> 2); st[0] = *(const GAS u32x4*)p; st[1] = *(const GAS u32x4*)(p + (size_t)32 * D); }
                else {
#pragma unroll
                    for (int j = 0; j < 4; ++j) st[j] = *(const GAS u32x4*)(vsrc + (size_t)(16 * j) * MM); }
#pragma unroll
                for (int k2 = 0; k2 < 2; ++k2) { const int kt = 2 * kp + k2;
                    f32x16 a;
                    if (dh == 0) {
#pragma unroll
                        for (int r = 0; r < 16; ++r) a[r] = 0.f; }
                    else a = sacc[kt];
#pragma unroll
                    for (int s_ = 0; s_ < 8; ++s_) { const bf16x8 kf = *(const LAS bf16x8*)(buf + c * 272 + h5 * 16 + (32 * k2 * 272 + 32 * s_)); a = __builtin_amdgcn_mfma_f32_32x32x16_bf16(kf, qf[s_], a, 0, 0, 0); }
                    sacc[kt] = a; }
                if (i < 7) { *(LAS u32x4*)(nbuf + kw0) = st[0]; *(LAS u32x4*)(nbuf + kw1) = st[1]; }
                else {
#pragma unroll
                    for (int j = 0; j < 4; ++j) *(LAS u32x4*)(nbuf + vw[j]) = st[j]; }
                LDS_WAIT(); __syncthreads();
            }
        }
        float mx = sacc[0][0];
#pragma unroll
        for (int kt = 0; kt < 8; ++kt)
#pragma unroll
            for (int r = 0; r < 16; ++r) mx = fmaxf(mx, sacc[kt][r]);
        mx = fmaxf(mx, __shfl_xor(mx, 32));
        float sum = 0.f; bf16x8 pb[8][2];
#pragma unroll
        for (int kt = 0; kt < 8; ++kt) { float p[16];
#pragma unroll
            for (int r = 0; r < 16; ++r) { p[r] = __builtin_amdgcn_exp2f(sacc[kt][r] - mx); sum += p[r]; }
            pb[kt][0] = pack8(p); pb[kt][1] = pack8(p + 8); }
        sum += __shfl_xor(sum, 32);
        const float inv = OB_SC / sum;
        unsigned char* op = (unsigned char*)OB + rowq * D + h * 256 + 4 * h5;
        for (int dp = 0; dp < 4; ++dp) {
            LAS unsigned char* buf = tb0 + (dp & 1) * 34816; LAS unsigned char* nbuf = tb0 + ((dp + 1) & 1) * 34816;
            if (dp < 3) {
#pragma unroll
                for (int j = 0; j < 4; ++j) st[j] = *(const GAS u32x4*)(vsrc + (size_t)(64 * (dp + 1) + 16 * j) * MM); }
#pragma unroll
            for (int d2 = 0; d2 < 2; ++d2) { const int dt = 2 * dp + d2;
                f32x16 o;
#pragma unroll
                for (int r = 0; r < 16; ++r) o[r] = 0.f;
#pragma unroll
                for (int kt = 0; kt < 8; ++kt)
#pragma unroll
                    for (int s2 = 0; s2 < 2; ++s2) { const LAS unsigned char* rp = buf + c * 528 + 8 * h5 + (32 * d2 * 528 + (4 * kt + 2 * s2) * 16);
                        const u32x2 v0 = *(const LAS u32x2*)rp, v1 = *(const LAS u32x2*)(rp + 16);
                        o = __builtin_amdgcn_mfma_f32_32x32x16_bf16(__builtin_bit_cast(bf16x8, (u32x4){v0.x, v0.y, v1.x, v1.y}), pb[kt][s2], o, 0, 0, 0); }
#pragma unroll
                for (int g = 0; g < 4; ++g) *(GAS unsigned*)(op + 32 * dt + 8 * g) = pk4_fp8(o[4 * g] * inv, o[4 * g + 1] * inv, o[4 * g + 2] * inv, o[4 * g + 3] * inv); }
            if (dp < 3) {
#pragma unroll
                for (int j = 0; j < 4; ++j) *(LAS u32x4*)(nbuf + vw[j]) = st[j]; }
            LDS_WAIT(); __syncthreads();
        }
    }
}
typedef float f32x4v __attribute__((ext_vector_type(4)));
__device__ __forceinline__ void ln2_router_phase(Frame& F) {
    LAS bf16* wr = (LAS bf16*)(F.lds + P10_WR);
    LAS float* gb = (LAS float*)(F.lds + P10_GB);
    LAS int* lcnt = (LAS int*)(F.lds + P10_LCNT);
    LAS int* rec = (LAS int*)(F.lds + P10_REC);
    for (int i = F.tid; i < 2 * 32 * WR_STRIDE * 2 / 16; i += 512) *(LAS u32x4*)(F.lds + P10_WR + 16 * i) = *(const GAS u32x4*)(F.ws + WS_WR + 16 * i);
    for (int i = F.tid; i < 512; i += 512) { *(LAS f32x4*)(gb + 4 * i) = ((const GAS f32x4*)(i < 256 ? F.in[I_LN2_G] : F.in[I_LN2_B]))[i & 255]; }
    if (F.tid < 64) lcnt[F.tid] = 0;
    LDS_WAIT(); __syncthreads();
    const bf16* H1 = (const bf16*)(F.ws + WS_HB); const bf16* CA = (const bf16*)(F.ws + WS_QM); bf16* H2 = (bf16*)(F.ws + WS_HB2);
    int* ltok = (int*)(F.ws + WS_LTOK); float* lgate = (float*)(F.ws + WS_LGATE); int* sidx = (int*)(F.ws + WS_SIDX);
    const int fr = F.lane & 15, fq = F.lane >> 4;
    for (int rb = F.vcu; rb < M / 128; rb += F.G) {
        const int m0 = rb * 128 + F.wave * 16;
        float mymean = 0.f, myrstd = 0.f;
        for (int i = 0; i < 16; ++i) { const int m = m0 + i;
            f32x4 v[4]; resid_row(v, H1 + (size_t)m * D, CA + (size_t)m * D, F.lane);
            float s1 = 0.f;
#pragma unroll
            for (int j = 0; j < 4; ++j) s1 += (v[j].x + v[j].y) + (v[j].z + v[j].w);
            const float mean = wave_sum(s1) * (1.f / D); float s2 = 0.f;
#pragma unroll
            for (int j = 0; j < 4; ++j) { v[j] = v[j] - mean; s2 += (v[j].x * v[j].x + v[j].y * v[j].y) + (v[j].z * v[j].z + v[j].w * v[j].w); }
            const float rstd = 1.f / sqrtf(wave_sum(s2) * (1.f / D) + LN_EPS);
            if (fr == i) { mymean = mean; myrstd = rstd; }
#pragma unroll
            for (int j = 0; j < 4; ++j) { const f32x4 gg = *(const LAS f32x4*)(gb + 4 * F.lane + 256 * j), bb = *(const LAS f32x4*)(gb + 1024 + 4 * F.lane + 256 * j); v[j] = v[j] * rstd * gg + bb; }
            store_row_bf16(v, H2 + (size_t)m * D, F.lane);
            { GAS unsigned* h8 = (GAS unsigned*)(F.ws + WS_HB8 + (size_t)m * D) + F.lane;
#pragma unroll
                for (int j = 0; j < 4; ++j) h8[64 * j] = pk4_fp8(v[j].x, v[j].y, v[j].z, v[j].w); }
        }
        f32x4v acc0 = {0.f, 0.f, 0.f, 0.f}, acc1 = {0.f, 0.f, 0.f, 0.f};
        { const bf16* hp = H1 + (size_t)(m0 + fr) * D + 8 * fq; const bf16* cp = CA + (size_t)(m0 + fr) * D + 8 * fq;
            const LAS bf16* wp = wr + fr * WR_STRIDE + 8 * fq; const LAS float* gp = gb + 8 * fq;
            const float sc = myrstd, sh = -mymean * myrstd;
#pragma unroll 2
            for (int s_ = 0; s_ < 32; ++s_) {
                const u32x4 hv = *(const GAS u32x4*)(hp + 32 * s_), cv = *(const GAS u32x4*)(cp + 32 * s_);
                const f32x4 g0 = *(const LAS f32x4*)(gp + 32 * s_), g1 = *(const LAS f32x4*)(gp + 32 * s_ + 4), b0 = *(const LAS f32x4*)(gp + 1024 + 32 * s_), b1 = *(const LAS f32x4*)(gp + 1024 + 32 * s_ + 4);
                float x[8];
                x[0] = bflo(hv.x) * DN_ALPHA + bflo(cv.x); x[1] = bfhi(hv.x) * DN_ALPHA + bfhi(cv.x); x[2] = bflo(hv.y) * DN_ALPHA + bflo(cv.y); x[3] = bfhi(hv.y) * DN_ALPHA + bfhi(cv.y);
                x[4] = bflo(hv.z) * DN_ALPHA + bflo(cv.z); x[5] = bfhi(hv.z) * DN_ALPHA + bfhi(cv.z); x[6] = bflo(hv.w) * DN_ALPHA + bflo(cv.w); x[7] = bfhi(hv.w) * DN_ALPHA + bfhi(cv.w);
                const float gg[8] = {g0.x, g0.y, g0.z, g0.w, g1.x, g1.y, g1.z, g1.w}, bb[8] = {b0.x, b0.y, b0.z, b0.w, b1.x, b1.y, b1.z, b1.w};
                float lo[8]; unsigned hp2[4];
#pragma unroll
                for (int j = 0; j < 8; ++j) x[j] = (x[j] * sc + sh) * gg[j] + bb[j];
#pragma unroll
                for (int j = 0; j < 4; ++j) { hp2[j] = pg8::cvt_pk_bf16(x[2 * j], x[2 * j + 1]); lo[2 * j] = x[2 * j] - bflo(hp2[j]); lo[2 * j + 1] = x[2 * j + 1] - bfhi(hp2[j]); }
                const bf16x8 bhi = __builtin_bit_cast(bf16x8, (u32x4){hp2[0], hp2[1], hp2[2], hp2[3]});
                const bf16x8 blo = pack8(lo);
                const bf16x8 wh0 = *(const LAS bf16x8*)(wp + 32 * s_), wh1 = *(const LAS bf16x8*)(wp + 16 * WR_STRIDE + 32 * s_);
                const bf16x8 wl0 = *(const LAS bf16x8*)(wp + 32 * WR_STRIDE + 32 * s_), wl1 = *(const LAS bf16x8*)(wp + 48 * WR_STRIDE + 32 * s_);
                acc0 = __builtin_amdgcn_mfma_f32_16x16x32_bf16(wh0, bhi, acc0, 0, 0, 0); acc1 = __builtin_amdgcn_mfma_f32_16x16x32_bf16(wh1, bhi, acc1, 0, 0, 0);
                acc0 = __builtin_amdgcn_mfma_f32_16x16x32_bf16(wh0, blo, acc0, 0, 0, 0); acc1 = __builtin_amdgcn_mfma_f32_16x16x32_bf16(wh1, blo, acc1, 0, 0, 0);
                acc0 = __builtin_amdgcn_mfma_f32_16x16x32_bf16(wl0, bhi, acc0, 0, 0, 0); acc1 = __builtin_amdgcn_mfma_f32_16x16x32_bf16(wl1, bhi, acc1, 0, 0, 0);
            } }
        float cand[8]; int eid[8];
        { const f32x4 br0 = *(const GAS f32x4*)(F.in[I_B_ROUTER] + 4 * fq), br1 = *(const GAS f32x4*)(F.in[I_B_ROUTER] + 16 + 4 * fq);
#pragma unroll
            for (int r = 0; r < 4; ++r) { cand[r] = acc0[r] + br0[r]; cand[4 + r] = acc1[r] + br1[r]; eid[r] = 4 * fq + r; eid[4 + r] = 16 + 4 * fq + r; } }
        float tv[TOPK]; int te[TOPK];
#pragma unroll
        for (int k = 0; k < TOPK; ++k) {
            float bv = cand[0]; int bi = eid[0];
#pragma unroll
            for (int r = 1; r < 8; ++r) if (cand[r] > bv) { bv = cand[r]; bi = eid[r]; }
#pragma unroll
            for (int o = 16; o <= 32; o <<= 1) { const float ov = __shfl_xor(bv, o); const int oi = __shfl_xor(bi, o); if (ov > bv || (ov == bv && oi < bi)) { bv = ov; bi = oi; } }
            tv[k] = bv; te[k] = bi;
#pragma unroll
            for (int r = 0; r < 8; ++r) if (eid[r] == bi) cand[r] = -INFINITY;
        }
        float pe[TOPK], ps = 0.f;
#pragma unroll
        for (int k = 0; k < TOPK; ++k) { pe[k] = __expf(tv[k] - tv[0]); ps += pe[k]; }
        if (fq == 0) {
#pragma unroll
            for (int k = 0; k < TOPK; ++k) { const int lr = __hip_atomic_fetch_add(lcnt + te[k], 1, __ATOMIC_RELAXED, __HIP_MEMORY_SCOPE_WORKGROUP);
                LAS int* r = rec + ((F.wave * 16 + fr) * 4 + k) * 4; r[0] = te[k]; r[1] = lr; r[2] = __builtin_bit_cast(int, pe[k] / ps); r[3] = m0 + fr; } }
        LDS_WAIT(); __syncthreads();
        if (F.tid < NE) lcnt[32 + F.tid] = (int)__hip_atomic_fetch_add(F.ctl + CW_ECNT + 64 * F.tid, (unsigned)lcnt[F.tid], RLX_AGENT);
        LDS_WAIT(); __syncthreads();
        { const LAS int* r = rec + (F.wave * 64 + F.lane) * 4; const int e = r[0], pos = lcnt[32 + e] + r[1], tok = r[3];
            if (pos < LCAP) { ltok[e * LCAP + pos] = tok; lgate[e * LCAP + pos] = __builtin_bit_cast(float, r[2]); } sidx[tok * 4 + (F.lane & 3)] = e * LCAP + pos; }
        __syncthreads();
        if (F.tid < 64) lcnt[F.tid] = 0;
        LDS_WAIT(); __syncthreads();
    }
}
__device__ __forceinline__ void final_phase(Frame& F, const LAS int* tb) {
    const int gw = F.vcu * NWAVES + F.wave, NGW = F.G * NWAVES;
    const int* sidx = (const int*)(F.ws + WS_SIDX); const unsigned char* YS = F.ws + WS_YS;
    typedef float f32x2v __attribute__((ext_vector_type(2)));
    for (int m = gw; m < M; m += NGW) { f32x4 v[4]; load_row_bf16(v, (const bf16*)(F.ws + WS_HB2) + (size_t)m * D, F.lane);
#pragma unroll
        for (int j = 0; j < 4; ++j) v[j] = v[j] * DN_ALPHA;
        f32x4 s[4];
#pragma unroll
        for (int j = 0; j < 4; ++j) s[j] = (f32x4){0.f, 0.f, 0.f, 0.f};
#pragma unroll
        for (int k = 0; k < TOPK; ++k) { const int si = sidx[m * 4 + k], e = si / LCAP, pos = si - e * LCAP; const size_t slot = (size_t)tb[e] * 256 + pos;
            const GAS unsigned* yp = (const GAS unsigned*)(YS + slot * D) + F.lane;
#pragma unroll
            for (int j = 0; j < 4; ++j) { const unsigned w = yp[64 * j]; const f32x2v lo = __builtin_amdgcn_cvt_pk_f32_fp8((int)w, false), hi = __builtin_amdgcn_cvt_pk_f32_fp8((int)w, true);
                s[j] = s[j] + (f32x4){lo.x, lo.y, hi.x, hi.y}; } }
#pragma unroll
        for (int j = 0; j < 4; ++j) v[j] = v[j] + s[j] * (1.0f / YS_SC);
        ln_row(v, F.in[I_LN3_G], F.in[I_LN3_B], F.lane); store_row_f32(v, F.hf + (size_t)m * D, F.lane); }
}

struct Args { const float* in[N_IN]; float* out; unsigned char* ws; int ph_lo, ph_hi, li, pad; };
__global__ void __launch_bounds__(NWAVES * 64, 2) mk_fwd(Args args) {
    extern __shared__ __attribute__((aligned(16))) unsigned char lds[];
    Frame F;
    F.lds = (LAS unsigned char*)lds; F.MISC = (volatile LAS unsigned*)(F.lds + MISC_OFF);
    F.tid = threadIdx.x; F.lane = F.tid & 63; F.wave = __builtin_amdgcn_readfirstlane(F.tid >> 6);
    F.G = gridDim.x; { const int bx = blockIdx.x; F.vcu = (F.G % 8 == 0) ? (bx % 8) * (F.G / 8) + bx / 8 : bx; }
    F.ws = args.ws; F.ctl = (gu32*)(args.ws + WS_CTL); F.hf = args.out; F.in = args.in;
    for (int u = F.tid; u < (LDS_BYTES - LDSCTL_OFF) / 4; u += NWAVES * 64) ((LAS unsigned*)(F.lds + LDSCTL_OFF))[u] = 0u;
    __syncthreads();
    XcdBarrier bar; bar.bar = (unsigned*)(F.ctl + CW_BAR) + args.li * XCD_BAR_WORDS; bar.x = 0; bar.st = nullptr;
    const int lo = args.ph_lo, hi = args.ph_hi;
    if (hi - lo > 1) bar = xcd_barrier_post((unsigned*)(F.ctl + CW_BAR) + args.li * XCD_BAR_WORDS, F.MISC + 8);
#ifndef PH_MASK
#define PH_MASK 0xfff
#endif
#define IN(k) (((PH_MASK >> (k)) & 1) && lo <= (k) && (k) < hi)
#ifndef REP_MASK
#define REP_MASK 0
#endif
#define REPS(k) (1 + ((REP_MASK >> (k)) & 1))
#define PH_BEGIN() do { int t_ = threadIdx.x; asm volatile("" : "+v"(t_)); F.tid = t_; F.lane = t_ & 63; } while (0)
#define SEAM(k) do { if (IN(k) && IN((k) + 1)) xcd_barrier(bar); } while (0)
    const char* wsb = (const char*)args.ws;
    LAS int* tb = (LAS int*)(F.lds + TB_OFF);

    if (IN(0)) for (int rep = 0; rep < REPS(0); ++rep) { PH_BEGIN(); p0_prologue(F); __syncthreads(); } SEAM(0);
    if (IN(1)) for (int rep = 0; rep < REPS(1); ++rep) { PH_BEGIN(); SchedP1 S{F.G, (int)blockIdx.x}; EpiP1 E{F.ws, F.in[I_B_IN]};
        pg8::gemm_phase<EpiP1, SchedP1, false>(F.lds + RING_OFF, wsb, D, D, D, S, E, nullptr); } SEAM(1);
    if (IN(2)) for (int rep = 0; rep < REPS(2); ++rep) { PH_BEGIN();
        if (!(args.pad & 1)) conv_phase(F);
        if (args.pad & 2) continue;
        const int gw = F.vcu * NWAVES + F.wave;
        if (F.wave < 5) { if (!(args.pad & 8)) for (int tk = F.vcu * 5 + F.wave; tk < NB * SBH * (T_ / 32); tk += F.G * 5) sb_attn_wave(F, (tk >> 7) >> 3, (tk >> 7) & 7, tk & 127); }
        else if (!(args.pad & 4)) expert_stream(F, F.vcu * 3 + (F.wave - 5), F.G * 3, F.lds + RING_OFF + F.wave * 16384);
    } SEAM(2);
    if (IN(3)) { PH_BEGIN(); SchedPlain S{F.G, (int)blockIdx.x, 128, 4, (unsigned)WS_MIXIN, (unsigned)WS_WOUT_T, TSTEP, TSTEP, 0u, 0u, 0u}; EpiBf16 E{(bf16*)(F.ws + WS_QM), D, 1.0f, F.in[I_B_OUT]};
        pg8::gemm_phase<EpiBf16, SchedPlain, false>(F.lds + RING_OFF, wsb, D, D, D, S, E, nullptr); } SEAM(3);
    if (IN(4)) { PH_BEGIN();
        { SchedKV S{F.G == 256 ? F.vcu : (int)blockIdx.x}; EpiP1 E{F.ws, F.in[I_B_IN]};
            pg8::gemm_phase<EpiP1, SchedKV, false>(F.lds + RING_OFF, wsb, D, D, D, S, E, nullptr); }
        __syncthreads();
        ln_phase(F, F.in[I_LN1_G], F.in[I_LN1_B]); } SEAM(4);
    if (IN(5)) { PH_BEGIN(); SchedPlain S{F.G, (int)blockIdx.x, 128, 4, (unsigned)WS_HB8, (unsigned)WS_WQ_T, TSTEP / 2, TSTEP / 2, 0u, 0u, 0u}; EpiBf16 E{(bf16*)(F.ws + WS_QM), D, MEM_QSCALE / WQ_SC, nullptr};
        pg8::gemm_phase<EpiBf16, SchedPlain, false, true>(F.lds + RING_OFF, wsb, D / 2, D / 2, D / 2, S, E, nullptr); } SEAM(5);
    if (IN(6)) { PH_BEGIN(); xattn_phase(F); } SEAM(6);
    if (IN(7)) { PH_BEGIN(); SchedPlain S{F.G, (int)blockIdx.x, 128, 4, (unsigned)WS_OB, (unsigned)WS_WO_T, TSTEP / 2, TSTEP / 2, 0u, 0u, 0u}; EpiBf16 E{(bf16*)(F.ws + WS_QM), D, 1.0f / (WO_SC * OB_SC), nullptr};
        pg8::gemm_phase<EpiBf16, SchedPlain, false, true>(F.lds + RING_OFF, wsb, D / 2, D / 2, D / 2, S, E, nullptr); } SEAM(7);
    if (IN(8)) { PH_BEGIN(); ln2_router_phase(F); } SEAM(8);
    if (IN(9)) for (int rep = 0; rep < REPS(9); ++rep) { PH_BEGIN(); moe_table(F, tb); SchedMoe S{F.G, (int)blockIdx.x, 8, tb, (unsigned)WS_HB8, (unsigned)WS_WGU_T, 2048u * 1024u, true}; EpiAct E{F.ws + WS_ACT, F.in[I_B_GU]};
        pg8::gemm_phase<EpiAct, SchedMoe, true, true>(F.lds + RING_OFF, wsb, D / 2, D / 2, D / 2, S, E, (const int*)(F.ws + WS_LTOK)); } SEAM(9);
    if (IN(10)) for (int rep = 0; rep < REPS(10); ++rep) { PH_BEGIN(); moe_table(F, tb); SchedMoe S{F.G, (int)blockIdx.x, 4, tb, (unsigned)WS_ACT, (unsigned)WS_WDN_T, 1024u * 1024u, false}; EpiDown E{F.ws + WS_YS, F.in[I_B_DOWN], (const float*)(F.ws + WS_LGATE)};
        pg8::gemm_phase<EpiDown, SchedMoe, false, true>(F.lds + RING_OFF, wsb, D / 2, D / 2, D / 2, S, E, nullptr); } SEAM(10);
    if (IN(11)) { PH_BEGIN(); moe_table(F, tb); final_phase(F, tb); }
#undef IN
#undef SEAM
}

extern "C" void kernel_launch(void* const* d_in, const int* in_sizes, int n_in, void* d_out, int out_size, void* d_ws, size_t ws_size, hipStream_t stream) {
    static int grid = 0;
    if (grid == 0) {
        if (n_in != N_IN || out_size != M * D || ws_size < WS_END) { fprintf(stderr, "kernel_launch: unexpected shapes (n_in %d, out %d, ws %zu)\n", n_in, out_size, ws_size); grid = -1; return; }
        int dev = 0, cus = 0, per_cu = 0;
        if (hipGetDevice(&dev) != hipSuccess || hipDeviceGetAttribute(&cus, hipDeviceAttributeMultiprocessorCount, dev) != hipSuccess) { grid = -1; return; }
        if (hipFuncSetAttribute((const void*)mk_fwd, hipFuncAttributeMaxDynamicSharedMemorySize, LDS_BYTES) != hipSuccess) { fprintf(stderr, "kernel_launch: hipFuncSetAttribute failed\n"); grid = -1; return; }
        if (hipOccupancyMaxActiveBlocksPerMultiprocessor(&per_cu, (const void*)mk_fwd, NWAVES * 64, LDS_BYTES) != hipSuccess || per_cu < 1) fprintf(stderr, "kernel_launch: occupancy query says %d\n", per_cu);
        (void)hipGetLastError();
        grid = cus;
    }
    if (grid < 0) return;
    if (hipMemsetAsync((char*)d_ws + WS_CTL, 0, CTL_ZERO_BYTES, stream) != hipSuccess) return;
    Args a{};
    for (int i = 0; i < N_IN; ++i) a.in[i] = (const float*)d_in[i];
    a.out = (float*)d_out; a.ws = (unsigned char*)d_ws;
#ifdef PROBE_P2
    { a.ph_lo = 0; a.ph_hi = 3; a.li = 0; hipLaunchKernelGGL(mk_fwd, dim3(grid), dim3(NWAVES * 64), LDS_BYTES, stream, a);
      a.ph_lo = 2; a.ph_hi = 3; a.li = 1; a.pad = PROBE_P2; hipLaunchKernelGGL(mk_fwd, dim3(grid), dim3(NWAVES * 64), LDS_BYTES, stream, a); a.pad = 0;
      a.ph_lo = 3; a.ph_hi = NPHASE; a.li = 2; hipLaunchKernelGGL(mk_fwd, dim3(grid), dim3(NWAVES * 64), LDS_BYTES, stream, a); return; }
#endif
    for (int li = 0; li < MK_N_LAUNCHES; ++li) {
        a.ph_lo = (MK_N_LAUNCHES == 1) ? 0 : li; a.ph_hi = (MK_N_LAUNCHES == 1) ? NPHASE : li + 1; a.li = (MK_N_LAUNCHES == 1) ? 0 : li;
        hipLaunchKernelGGL(mk_fwd, dim3(grid), dim3(NWAVES * 64), LDS_BYTES, stream, a);
        if (hipPeekAtLastError() != hipSuccess) { fprintf(stderr, "kernel_launch: launch %d failed\n", li); break; }
    }
#ifdef PROBE_PHASES
    { const int pp[] = {PROBE_PHASES}; for (int ph : pp) { a.ph_lo = ph; a.ph_hi = ph + 1; a.li = 15; hipLaunchKernelGGL(mk_fwd, dim3(grid), dim3(NWAVES * 64), LDS_BYTES, stream, a); } }
#endif
}
```

```cpp
#include <hip/hip_runtime.h>
#include <cstdio>
#include <cstdint>

#ifndef MK_N_LAUNCHES
#define MK_N_LAUNCHES 1
#endif

#define GAS __attribute__((address_space(1)))
#define LAS __attribute__((address_space(3)))
typedef unsigned short bf16;
typedef short bf16x8 __attribute__((ext_vector_type(8)));
typedef float f32x4 __attribute__((ext_vector_type(4)));
typedef float f32x2 __attribute__((ext_vector_type(2)));
typedef unsigned u32x4 __attribute__((ext_vector_type(4)));
typedef unsigned u32x2 __attribute__((ext_vector_type(2)));
typedef GAS unsigned gu32;
#define RLX_AGENT __ATOMIC_RELAXED, __HIP_MEMORY_SCOPE_AGENT
#define LDS_WAIT() asm volatile("s_waitcnt lgkmcnt(0)" ::: "memory")
#define VM_WAIT() asm volatile("s_waitcnt vmcnt(0)" ::: "memory")

constexpr int NB = 8, T_ = 4096, D = 1024, M = NB * T_, NMEM = 256, MM = NB * NMEM;
constexpr int CONV_CH = 512, SBH = 8, SBD = 64, SBW = 512, CWID = 31, NE = 32, TOPK = 4, DFF = 1024;
constexpr int INC = 2560;
constexpr float LN_EPS = 1e-5f;
constexpr float DN_ALPHA = 1.189207115002721f;
constexpr float LOG2E = 1.4426950408889634f;
constexpr float SB_QSCALE = 0.125f * LOG2E;
constexpr float MEM_QSCALE = 0.0625f * LOG2E;
constexpr float WGU_SC = 32.0f, WDN_SC = 64.0f, WQ_SC = 32.0f, WO_SC = 64.0f, OB_SC = 16.0f, YS_SC = 16.0f;
constexpr float WGU_SC_UNUSED = 0.f;
constexpr int NBLK_MAX = M * TOPK / 256 + NE;
constexpr int LCAP = M;

constexpr size_t MiB = 1u << 20;
constexpr size_t WS_CTL = 0, CTL_ZERO_BYTES = 1 * MiB;
constexpr size_t WS_WIN_T = 1 * MiB;
constexpr size_t WS_WOUT_T = 6 * MiB;
constexpr size_t WS_WQ_T = 8 * MiB, WS_WK_T = 10 * MiB, WS_WV_T = 12 * MiB, WS_WO_T = 14 * MiB;
constexpr size_t WS_WGU_T = 16 * MiB;
constexpr size_t WS_WDN_T = 144 * MiB;
constexpr size_t WS_HB8 = 176 * MiB;
constexpr size_t WS_HB = 208 * MiB;
constexpr size_t WS_LTOK = 272 * MiB;
constexpr size_t WS_LGATE = 276 * MiB;
constexpr size_t WS_SIDX = 280 * MiB;
constexpr size_t WS_WR = 281 * MiB;
constexpr size_t WS_HB2 = 832 * MiB;
constexpr size_t WS_X = 288 * MiB;
constexpr size_t WS_U = WS_X;
constexpr size_t WS_Q = WS_X + 32 * MiB;
constexpr size_t WS_K = WS_X + 64 * MiB;
constexpr size_t WS_V = WS_X + 96 * MiB;
constexpr size_t WS_MIXIN = WS_X + 128 * MiB;
constexpr size_t WS_QM = WS_X + 192 * MiB;
constexpr size_t WS_SP = WS_X + 256 * MiB;
constexpr size_t WS_OB = WS_X + 320 * MiB;
constexpr size_t WS_MEMN = WS_X + 384 * MiB;
constexpr size_t WS_KM = WS_X + 388 * MiB;
constexpr size_t WS_VMT = WS_X + 392 * MiB;
constexpr size_t WS_ACT = WS_X;
constexpr size_t WS_YS = WS_X + 272 * MiB;
constexpr size_t WS_END = 896 * MiB;
constexpr int CW_TMO = 0, CW_CODE = 1;
constexpr int CW_BAR = 4096;
constexpr int CW_ECNT = 131072;
constexpr int NPHASE = 12;

constexpr int RING_OFF = 0, RING_BYTES = 131072;
constexpr int LDS_BYTES = 163840;
constexpr int LDSCTL_OFF = LDS_BYTES - 1024, MISC_OFF = LDSCTL_OFF + 320;
constexpr int XTRA_OFF = RING_BYTES;
constexpr int TB_OFF = XTRA_OFF + 20480;
constexpr int WR_STRIDE = 1032;
constexpr int P10_WR = 0, P10_GB = 2 * 32 * WR_STRIDE * 2, P10_LCNT = P10_GB + 8192, P10_REC = P10_LCNT + 512;
static_assert(P10_REC + 8192 <= TB_OFF && TB_OFF + 4 * (704 + 8 * 40) <= LDSCTL_OFF, "LDS map");
constexpr int NWAVES = 8;

__device__ __forceinline__ unsigned f2bf(float f) { unsigned u = __builtin_bit_cast(unsigned, f); return (u + 0x7fffu + ((u >> 16) & 1u)) >> 16; }
__device__ __forceinline__ unsigned pk2(float lo, float hi) { return f2bf(lo) | (f2bf(hi) << 16); }
__device__ __forceinline__ float bflo(unsigned u) { return __builtin_bit_cast(float, u << 16); }
__device__ __forceinline__ float bfhi(unsigned u) { return __builtin_bit_cast(float, u & 0xffff0000u); }
__device__ __forceinline__ float wave_sum(float v) {
#pragma unroll
    for (int o = 1; o < 64; o <<= 1) v += __shfl_xor(v, o);
    return v;
}
__device__ __forceinline__ float wave_max(float v) {
#pragma unroll
    for (int o = 1; o < 64; o <<= 1) v = fmaxf(v, __shfl_xor(v, o));
    return v;
}
__device__ __forceinline__ unsigned pk4_fp8(float a, float b, float c, float d) {
    int r = __builtin_amdgcn_cvt_pk_fp8_f32(a, b, 0, false); r = __builtin_amdgcn_cvt_pk_fp8_f32(c, d, r, true); return (unsigned)r; }
__device__ __forceinline__ float sigmoidf_fast(float x) { return __builtin_amdgcn_rcpf(1.0f + __expf(-x)); }

namespace pg8 {
constexpr int BM = 256, BK = 64, HALF = 128, HTB = HALF * BK * 2, STAGE_BYTES = 8 * HTB, NXCD = 8, WGM = 8;
__host__ __device__ __forceinline__ int lds_byte(int r, int c) { const int st = (r >> 4) * 2 + (c >> 5), rr = r & 15, cc = c & 31, ob = rr * 64 + cc * 2; return st * 1024 + (ob ^ (((ob >> 9) & 1) << 5)); }
__host__ __device__ __forceinline__ void stage_rc(int b, int& R, int& C) { const int st = b / 1024, sb = b % 1024, swz = sb ^ (((sb >> 9) & 1) << 5); R = (st >> 1) * 16 + swz / 64; C = (st & 1) * 32 + (swz % 64) / 2; }
__host__ __device__ __forceinline__ int perm32(int rho) { const int n = rho >> 4, i = rho & 15; return 8 * (i >> 2) + 4 * n + (i & 3); }

struct Unit { int pm, pn, z, nvalid; unsigned aoff, boff, goff; };

__device__ __forceinline__ void tile_order(int L, int nM, int nN, int& pm, int& pn) {
    const int nwg = nM * nN; int wgid = L;
    { const int q = nwg / NXCD, r = nwg % NXCD, xcd = wgid % NXCD, off = wgid / NXCD; wgid = (xcd < r ? xcd * (q + 1) : r * (q + 1) + (xcd - r) * q) + off; }
    const int nig = WGM * nN, gid = wgid / nig, fm = gid * WGM, gsz = (nM - fm) < WGM ? (nM - fm) : WGM;
    pm = fm + ((wgid % nig) % gsz); pn = (wgid % nig) / gsz;
}
__device__ __forceinline__ unsigned cvt_pk_bf16(float lo, float hi) { unsigned r; asm volatile("v_cvt_pk_bf16_f32 %0, %1, %2" : "=v"(r) : "v"(lo), "v"(hi)); return r; }

__device__ __forceinline__ void store_tile_bf16(const f32x4 (&acc)[2][2][4][2], bf16* p0, size_t ldc, const float* bias, float scale, int wc, int fq) {
    const int cl = wc * 32 + 8 * fq;
    f32x4 bv[2][2];
#pragma unroll
    for (int bj = 0; bj < 2; ++bj)
#pragma unroll
        for (int n = 0; n < 2; ++n) bv[bj][n] = bias ? *(const f32x4*)(bias + cl + bj * HALF + 4 * n) : (f32x4){0.f, 0.f, 0.f, 0.f};
#pragma unroll
    for (int ai = 0; ai < 2; ++ai)
#pragma unroll
        for (int m = 0; m < 4; ++m) { bf16* rowp = p0 + (size_t)(ai * HALF + m * 16) * ldc + cl;
#pragma unroll
            for (int bj = 0; bj < 2; ++bj) { const f32x4 v0 = (acc[ai][bj][m][0] + bv[bj][0]) * scale, v1 = (acc[ai][bj][m][1] + bv[bj][1]) * scale;
                u32x4 w; w.x = cvt_pk_bf16(v0[0], v0[1]); w.y = cvt_pk_bf16(v0[2], v0[3]); w.z = cvt_pk_bf16(v1[0], v1[1]); w.w = cvt_pk_bf16(v1[2], v1[3]);
                *(u32x4*)(rowp + bj * HALF) = w; } }
}

typedef int v8i __attribute__((ext_vector_type(8)));
#ifndef PG8_ALIGN
#define PG8_ALIGN true
#endif
template <class Epi, class Sched, bool GATHER, bool FP8 = false, bool ALIGN_EPI = PG8_ALIGN>
__device__ __forceinline__ void gemm_phase(LAS unsigned char* lds, const char* wsb, const int lda, const int ldb, const int K, const Sched& S, const Epi& E, const int* glist) {
    int tid = threadIdx.x; asm volatile("" : "+v"(tid));
    const int wid = __builtin_amdgcn_readfirstlane(tid >> 6), lane = tid & 63, wr = wid >> 2, wc = wid & 3, fr = lane & 15, fq = lane >> 4;
    const int nt = K / BK;
    unsigned voffA[2], voffB[2];
#pragma unroll
    for (int i = 0; i < 2; ++i) { int R, C; stage_rc(tid * 16 + i * 8192, R, C); const int Rb = Epi::PERM ? ((R & ~31) + perm32(R & 31)) : R;
        voffA[i] = (unsigned)(R * lda + C) * 2u; voffB[i] = (unsigned)(Rb * ldb + C) * 2u; }
    const size_t kstep = (size_t)(BK * 2);
    const size_t hstepA = (size_t)HALF * lda * 2, hstepB = (size_t)HALF * ldb * 2;
    const unsigned ldsw = (unsigned)wid * 1024u;
    const int aoff = lds_byte(wr * 64 + fr, fq * 8), boff = lds_byte(wc * 32 + fr, fq * 8);
    unsigned gc[2][2], gn[2][2];
#define PG8_SA(b, h) (((b) * 2 + (h)) * HTB)
#define PG8_SB(b, h) ((4 + (b) * 2 + (h)) * HTB)
#define PG8_STAGE_B(bufoff, gbase) do { _Pragma("unroll") for (int _i = 0; _i < 2; ++_i) \
        __builtin_amdgcn_global_load_lds((const unsigned*)((const char*)(gbase) + voffB[_i]), (LAS unsigned*)(lds + (bufoff) + ldsw + _i * 8192), 16, 0, 0); } while (0)
#define PG8_STAGE_A(bufoff, gbase, h, nx) do { _Pragma("unroll") for (int _i = 0; _i < 2; ++_i) { \
        const char* _p = GATHER ? (const char*)(gbase) + ((nx) ? gn[h][_i] : gc[h][_i]) : (const char*)(gbase) + (h) * hstepA + voffA[_i]; \
        __builtin_amdgcn_global_load_lds((const unsigned*)_p, (LAS unsigned*)(lds + (bufoff) + ldsw + _i * 8192), 16, 0, 0); } } while (0)
#define PG8_LDA(dst, b, h) do { _Pragma("unroll") for (int m = 0; m < 4; ++m) { if constexpr (FP8) { const u32x4 _lo = *(const LAS u32x4*)(lds + PG8_SA(b, h) + aoff + m * 2048), _hi = *(const LAS u32x4*)(lds + PG8_SA(b, h) + aoff + m * 2048 + 1024); \
            dst##8[m] = (v8i){(int)_lo.x, (int)_lo.y, (int)_lo.z, (int)_lo.w, (int)_hi.x, (int)_hi.y, (int)_hi.z, (int)_hi.w}; } \
        else { _Pragma("unroll") for (int k = 0; k < 2; ++k) dst[m][k] = *(const LAS bf16x8*)(lds + PG8_SA(b, h) + aoff + m * 2048 + k * 1024); } } } while (0)
#define PG8_LDB(dst, b, h) do { _Pragma("unroll") for (int n = 0; n < 2; ++n) { if constexpr (FP8) { const u32x4 _lo = *(const LAS u32x4*)(lds + PG8_SB(b, h) + boff + n * 2048), _hi = *(const LAS u32x4*)(lds + PG8_SB(b, h) + boff + n * 2048 + 1024); \
            dst##8[n] = (v8i){(int)_lo.x, (int)_lo.y, (int)_lo.z, (int)_lo.w, (int)_hi.x, (int)_hi.y, (int)_hi.z, (int)_hi.w}; } \
        else { _Pragma("unroll") for (int k = 0; k < 2; ++k) dst[n][k] = *(const LAS bf16x8*)(lds + PG8_SB(b, h) + boff + n * 2048 + k * 1024); } } } while (0)
#define PG8_MMA(ai, bj, At, Bt) do { __builtin_amdgcn_s_setprio(1); if constexpr (FP8) asm volatile("s_nop 1"); _Pragma("unroll") for (int m = 0; m < 4; ++m) _Pragma("unroll") for (int n = 0; n < 2; ++n) { \
        if constexpr (FP8) asm volatile("v_mfma_f32_16x16x128_f8f6f4 %0, %1, %2, %0" : "+v"(acc[ai][bj][m][n]) : "v"(Bt##8[n]), "v"(At##8[m])); \
        else { _Pragma("unroll") for (int k = 0; k < 2; ++k) acc[ai][bj][m][n] = __builtin_amdgcn_mfma_f32_16x16x32_bf16(Bt[n][k], At[m][k], acc[ai][bj][m][n], 0, 0, 0); } } \
        __builtin_amdgcn_s_setprio(0); } while (0)
#define PG8_WAIT_V(n) asm volatile("s_waitcnt vmcnt(" #n ")" ::: "memory")
#define PG8_WAIT_L(n) asm volatile("s_waitcnt lgkmcnt(" #n ")" ::: "memory")
#define PG8_BAR __builtin_amdgcn_s_barrier()
#define PG8_SCHED __builtin_amdgcn_sched_barrier(0)
#define PG8_GIDX(g, u) do { _Pragma("unroll") for (int _h = 0; _h < 2; ++_h) _Pragma("unroll") for (int _i = 0; _i < 2; ++_i) { int _R, _C; stage_rc(tid * 16 + _i * 8192, _R, _C); const int _r = _h * HALF + _R; \
        const int _tok = glist[(u).goff + (_r < (u).nvalid ? _r : (u).nvalid - 1)]; g[_h][_i] = (unsigned)_tok * (unsigned)(lda * 2) + (unsigned)(_C * 2); } } while (0)
    Unit cur, nxt, nn; int ui = 0;
    if (!S.next(0, cur)) return;
    f32x4 acc[2][2][4][2];
#pragma unroll
    for (int a = 0; a < 2; ++a)
#pragma unroll
        for (int b = 0; b < 2; ++b)
#pragma unroll
            for (int m = 0; m < 4; ++m)
#pragma unroll
                for (int n = 0; n < 2; ++n) acc[a][b][m][n] = (f32x4){0.f, 0.f, 0.f, 0.f};
    bf16x8 At[4][2], B0[2][2], B1[2][2];
    v8i At8[4], B08[2], B18[2];
    const char* cA = wsb + cur.aoff; const char* cB = wsb + cur.boff;
    if constexpr (GATHER) { PG8_GIDX(gc, cur); if (S.next(1, nxt)) { PG8_GIDX(gn, nxt); } else { PG8_GIDX(gn, cur); }
        asm volatile("s_waitcnt vmcnt(0)" : "+v"(gc[0][0]), "+v"(gc[0][1]), "+v"(gc[1][0]), "+v"(gc[1][1]), "+v"(gn[0][0]), "+v"(gn[0][1]), "+v"(gn[1][0]), "+v"(gn[1][1]) :: "memory"); }
    else {
#pragma unroll
        for (int h = 0; h < 2; ++h)
#pragma unroll
            for (int i = 0; i < 2; ++i) { gc[h][i] = 0u; gn[h][i] = 0u; } }
    PG8_STAGE_B(PG8_SB(0, 0), cB); PG8_STAGE_B(PG8_SB(0, 1), cB + hstepB); PG8_STAGE_A(PG8_SA(0, 0), cA, 0, false); PG8_STAGE_A(PG8_SA(0, 1), cA, 1, false);
    if (wr == 1) PG8_BAR;
    PG8_WAIT_V(2); PG8_BAR;
    PG8_STAGE_B(PG8_SB(1, 0), cB + kstep); PG8_STAGE_A(PG8_SA(1, 0), cA + kstep, 0, false); PG8_STAGE_B(PG8_SB(1, 1), cB + hstepB + kstep);
    PG8_WAIT_V(6); PG8_BAR;
    for (;;) {
        const bool has_next = S.next(ui + 1, nxt);
        const char* nA = has_next ? wsb + nxt.aoff : cA; const char* nB = has_next ? wsb + nxt.boff : cB;
#pragma clang loop unroll(disable)
        for (int t = 0; t < nt; t += 2) {
            const bool last = (t == nt - 2);
            const char* a1 = cA + (size_t)(t + 1) * kstep;
            const char* a2 = last ? nA : cA + (size_t)(t + 2) * kstep; const char* b2 = last ? nB : cB + (size_t)(t + 2) * kstep;
            const char* a3 = a2 + kstep; const char* b3 = b2 + kstep;
            PG8_LDB(B0, 0, 0); PG8_LDB(B1, 0, 1); PG8_SCHED; PG8_LDA(At, 0, 0); PG8_STAGE_A(PG8_SA(1, 1), a1, 1, false);
            PG8_WAIT_V(8); PG8_WAIT_L(0); PG8_BAR; PG8_MMA(0, 0, At, B0); PG8_MMA(0, 1, At, B1); PG8_BAR; PG8_SCHED;
            PG8_LDA(At, 0, 1); PG8_STAGE_B(PG8_SB(0, 0), b2); PG8_STAGE_B(PG8_SB(0, 1), b2 + hstepB); PG8_STAGE_A(PG8_SA(0, 0), a2, 0, last);
            PG8_WAIT_V(8); PG8_WAIT_L(0); PG8_BAR; PG8_MMA(1, 0, At, B0); PG8_MMA(1, 1, At, B1); PG8_BAR; PG8_SCHED;
            PG8_LDB(B0, 1, 0); PG8_LDB(B1, 1, 1); PG8_SCHED; PG8_LDA(At, 1, 0); PG8_STAGE_A(PG8_SA(0, 1), a2, 1, last);
            PG8_WAIT_V(8); PG8_WAIT_L(0); PG8_BAR; PG8_MMA(0, 0, At, B0); PG8_MMA(0, 1, At, B1); PG8_BAR; PG8_SCHED;
            PG8_LDA(At, 1, 1); PG8_STAGE_B(PG8_SB(1, 0), b3); PG8_STAGE_B(PG8_SB(1, 1), b3 + hstepB); PG8_STAGE_A(PG8_SA(1, 0), a3, 0, last);
            PG8_WAIT_V(8); PG8_WAIT_L(0); PG8_BAR; PG8_MMA(1, 0, At, B0); PG8_MMA(1, 1, At, B1); PG8_BAR; PG8_SCHED;
        }
        if constexpr (FP8) asm volatile("s_nop 15\n\ts_nop 7");
        if constexpr (ALIGN_EPI) { if (wr == 0) PG8_BAR; }
        if constexpr (GATHER) {
#pragma unroll
            for (int h = 0; h < 2; ++h)
#pragma unroll
                for (int i = 0; i < 2; ++i) gc[h][i] = gn[h][i];
            if (has_next && S.next(ui + 2, nn)) { PG8_GIDX(gn, nn); }
        }
        E(acc, cur, wr, wc, fr, fq);
        if constexpr (GATHER) asm volatile("" : "+v"(gn[0][0]), "+v"(gn[0][1]), "+v"(gn[1][0]), "+v"(gn[1][1]));
        if (!has_next) break;
#pragma unroll
        for (int a = 0; a < 2; ++a)
#pragma unroll
            for (int b = 0; b < 2; ++b)
#pragma unroll
                for (int m = 0; m < 4; ++m)
#pragma unroll
                    for (int n = 0; n < 2; ++n) acc[a][b][m][n] = (f32x4){0.f, 0.f, 0.f, 0.f};
        cur = nxt; cA = nA; cB = nB; ++ui;
        if constexpr (ALIGN_EPI) { if (wr == 1) PG8_BAR; }
    }
    PG8_WAIT_V(0);
    if constexpr (!ALIGN_EPI) { if (wr == 0) PG8_BAR; }
    PG8_BAR;
#undef PG8_SA
#undef PG8_SB
#undef PG8_STAGE_A
#undef PG8_STAGE_B
#undef PG8_LDA
#undef PG8_LDB
#undef PG8_MMA
#undef PG8_WAIT_V
#undef PG8_WAIT_L
#undef PG8_BAR
#undef PG8_SCHED
#undef PG8_GIDX
}
}
using pg8::Unit;

#define XB_TMO      128
#define XB_XCNT(j)  (256  + 64 * (j))
#define XB_XSUB(j)  (1280 + 64 * (j))
#define XB_XGEN(j)  (2304 + 64 * (j))
#define XB_TOP      3328
#define XB_TOPGEN   3392
#define XCD_BAR_WORDS 3456
#define XB_SPIN_CAP (1u << 18)
__device__ __forceinline__ unsigned xb_ld(unsigned* p)              { return __hip_atomic_load(p, __ATOMIC_RELAXED, __HIP_MEMORY_SCOPE_AGENT); }
__device__ __forceinline__ unsigned xb_add(unsigned* p, unsigned v) { return __hip_atomic_fetch_add(p, v, __ATOMIC_RELAXED, __HIP_MEMORY_SCOPE_AGENT); }
__device__ __forceinline__ unsigned xb_xcc_id() { return (unsigned)__builtin_amdgcn_s_getreg((3 << 11) | 20) & 0xFu; }
#define XB_SPIN(cond, bar) do { unsigned _sp = 0; while (cond) { __builtin_amdgcn_s_sleep(1); \
    if ((++_sp & 255u) == 0u) { if (xb_ld(&(bar)[XB_TMO])) break; if (_sp > XB_SPIN_CAP) { atomicAdd(&(bar)[XB_TMO], 1u); break; } } } } while (0)
struct XcdBarrier { unsigned* bar; unsigned x; volatile LAS unsigned* st; };
__device__ __forceinline__ XcdBarrier xcd_barrier_post(unsigned* bar, volatile LAS unsigned* st) {
    XcdBarrier b; b.bar = bar; b.x = xb_xcc_id(); b.st = st;
    if (threadIdx.x == 0) (void)xb_add(&bar[XB_XCNT(b.x)], 1u);
    return b;
}
__device__ __forceinline__ void xcd_barrier_complete(unsigned* bar, unsigned x, unsigned& nloc, unsigned& nx) {
    const unsigned G = gridDim.x * gridDim.y * gridDim.z;
    unsigned sum, cnt, mine, sp = 0u;
    for (;;) {
        sum = 0u; cnt = 0u; mine = 0u;
#pragma unroll
        for (unsigned j = 0; j < 16; ++j) { const unsigned c = xb_ld(&bar[XB_XCNT(j)]); sum += c; cnt += (c > 0u) ? 1u : 0u; mine = (j == x) ? c : mine; }
        if (sum == G) break;
        __builtin_amdgcn_s_sleep(1);
        if ((++sp & 255u) == 0u) { if (xb_ld(&bar[XB_TMO])) break; if (sp > XB_SPIN_CAP) { atomicAdd(&bar[XB_TMO], 1u); break; } }
    }
    nloc = mine > 0u ? mine : 1u; nx = cnt > 0u ? cnt : 1u;
}
__device__ __forceinline__ void xcd_barrier(const XcdBarrier& b) {
    asm volatile("s_waitcnt vmcnt(0)" ::: "memory");
    __syncthreads();
    if (threadIdx.x == 0) {
        unsigned* bar = b.bar;
        __builtin_amdgcn_s_waitcnt(0);
        unsigned nloc = b.st[0], nx = b.st[1];
        if (nloc == 0u) { xcd_barrier_complete(bar, b.x, nloc, nx); b.st[0] = nloc; b.st[1] = nx; }
        const unsigned old = xb_add(&bar[XB_XSUB(b.x)], 1u);
        const unsigned gen = old / nloc;
        if (old + 1u == (gen + 1u) * nloc) {
            __builtin_amdgcn_fence(__ATOMIC_RELEASE, "agent");
            asm volatile("s_waitcnt vmcnt(0)" ::: "memory");
            const unsigned og = xb_add(&bar[XB_TOP], 1u);
            const unsigned tg = og / nx;
            if (og + 1u == (tg + 1u) * nx) xb_add(&bar[XB_TOPGEN], 1u);
            else XB_SPIN(xb_ld(&bar[XB_TOPGEN]) == tg, bar);
            __builtin_amdgcn_fence(__ATOMIC_ACQUIRE, "agent");
            xb_add(&bar[XB_XGEN(b.x)], 1u);
            asm volatile("s_waitcnt vmcnt(0)" ::: "memory");
        } else {
            XB_SPIN(xb_ld(&bar[XB_XGEN(b.x)]) == gen, bar);
            __builtin_amdgcn_fence(__ATOMIC_ACQUIRE, "agent");
            asm volatile("s_waitcnt vmcnt(0)" ::: "memory");
        }
    }
    __syncthreads();
}

struct Frame {
    LAS unsigned char* lds;
    volatile LAS unsigned* MISC;
    gu32* ctl;
    unsigned char* ws;
    int tid, lane, wave, vcu, G;
    float* hf;
    const float* const* in;
};
enum In { I_X = 0, I_MEM, I_LN_IN_G, I_LN_IN_B, I_LN_MEM_G, I_LN_MEM_B, I_W_IN, I_B_IN, I_W_DW, I_B_DW, I_LN_CONV_G, I_LN_CONV_B, I_W_OUT, I_B_OUT, I_LN1_G, I_LN1_B,
          I_WQ, I_WK, I_WV, I_WO, I_LN2_G, I_LN2_B, I_W_ROUTER, I_B_ROUTER, I_W_GU, I_B_GU, I_W_DOWN, I_B_DOWN, I_LN3_G, I_LN3_B, N_IN };

__device__ __forceinline__ void p0_transpose_item(const float* W, int K, int N, bf16* WT, int k0, int n0, int drow, LAS float* scr, int lane) {
#pragma unroll 8
    for (int i = 0; i < 32; ++i) { const int kk = 2 * i + (lane >> 5); scr[kk * 33 + (lane & 31)] = W[(size_t)(k0 + kk) * N + n0 + (lane & 31)]; }
    LDS_WAIT(); asm volatile("" ::: "memory");
    const int c = lane & 7;
#pragma unroll
    for (int j = 0; j < 4; ++j) { const int n = (lane >> 3) + 8 * j; const LAS float* s = scr + (8 * c) * 33 + n;
        u32x4 o; o.x = pk2(s[0 * 33], s[1 * 33]); o.y = pk2(s[2 * 33], s[3 * 33]); o.z = pk2(s[4 * 33], s[5 * 33]); o.w = pk2(s[6 * 33], s[7 * 33]);
        *(GAS u32x4*)(WT + (size_t)(drow + n) * K + k0 + 8 * c) = o; }
    LDS_WAIT(); asm volatile("" ::: "memory");
}
__device__ __forceinline__ void ln_row(f32x4 (&v)[4], const float* g, const float* b, int lane) {
    float s = 0.f;
#pragma unroll
    for (int j = 0; j < 4; ++j) s += (v[j].x + v[j].y) + (v[j].z + v[j].w);
    const float mean = wave_sum(s) * (1.f / D); float s2 = 0.f;
#pragma unroll
    for (int j = 0; j < 4; ++j) { v[j] = v[j] - mean; s2 += (v[j].x * v[j].x + v[j].y * v[j].y) + (v[j].z * v[j].z + v[j].w * v[j].w); }
    const float rstd = 1.f / sqrtf(wave_sum(s2) * (1.f / D) + LN_EPS);
#pragma unroll
    for (int j = 0; j < 4; ++j) { const f32x4 gg = ((const GAS f32x4*)g)[lane + 64 * j], bb = ((const GAS f32x4*)b)[lane + 64 * j]; v[j] = v[j] * rstd * gg + bb; }
}
__device__ __forceinline__ void store_row_bf16(const f32x4 (&v)[4], bf16* orow, int lane) {
    GAS u32x2* o8 = (GAS u32x2*)orow + lane;
#pragma unroll
    for (int j = 0; j < 4; ++j) o8[64 * j] = (u32x2){pk2(v[j].x, v[j].y), pk2(v[j].z, v[j].w)};
}
__device__ __forceinline__ void p0_transpose_item8(const float* W, int K, int N, unsigned char* WT, int k0, int n0, int drow, float sc, LAS float* scr, int lane) {
#pragma unroll 8
    for (int i = 0; i < 32; ++i) { const int kk = 2 * i + (lane >> 5); scr[kk * 33 + (lane & 31)] = W[(size_t)(k0 + kk) * N + n0 + (lane & 31)]; }
    LDS_WAIT(); asm volatile("" ::: "memory");
    const int c = lane & 7;
#pragma unroll
    for (int j = 0; j < 4; ++j) { const int n = (lane >> 3) + 8 * j; const LAS float* s = scr + (8 * c) * 33 + n;
        u32x2 o; o.x = pk4_fp8(s[0 * 33] * sc, s[1 * 33] * sc, s[2 * 33] * sc, s[3 * 33] * sc); o.y = pk4_fp8(s[4 * 33] * sc, s[5 * 33] * sc, s[6 * 33] * sc, s[7 * 33] * sc);
        *(GAS u32x2*)(WT + (size_t)(drow + n) * K + k0 + 8 * c) = o; }
    LDS_WAIT(); asm volatile("" ::: "memory");
}
__device__ __forceinline__ void item8_load(f32x4 (&x)[4][4], const float* W, int N, int k0, int n0, int lane) {
    const int g = lane >> 3, c = lane & 7;
#pragma unroll
    for (int q = 0; q < 4; ++q)
#pragma unroll
        for (int j = 0; j < 4; ++j) x[q][j] = *(const GAS f32x4*)(W + (size_t)(k0 + 32 * q + 4 * g + j) * N + n0 + 4 * c);
}
__device__ __forceinline__ void item8_finish(const f32x4 (&x)[4][4], int K, unsigned char* WT, int k0, int drow, float sc, LAS unsigned char* scr, int lane) {
    const int g = lane >> 3, c = lane & 7;
#pragma unroll
    for (int q = 0; q < 4; ++q)
#pragma unroll
        for (int e = 0; e < 4; ++e) *(LAS unsigned*)(scr + (4 * c + e) * 144 + 32 * q + 4 * g) = pk4_fp8(x[q][0][e] * sc, x[q][1][e] * sc, x[q][2][e] * sc, x[q][3][e] * sc);
    LDS_WAIT(); asm volatile("" ::: "memory");
#pragma unroll
    for (int i = 0; i < 4; ++i) { const int t = lane + 64 * i, n = t >> 3, ch = t & 7;
        *(GAS u32x4*)(WT + (size_t)(drow + n) * K + k0 + 16 * ch) = *(const LAS u32x4*)(scr + n * 144 + 16 * ch); }
    LDS_WAIT(); asm volatile("" ::: "memory");
}
__device__ __forceinline__ void p0_transpose_item8b(const float* W, int K, int N, unsigned char* WT, int k0, int n0, int drow, float sc, LAS unsigned char* scr, int lane) {
    f32x4 x[4][4]; item8_load(x, W, N, k0, n0, lane); item8_finish(x, K, WT, k0, drow, sc, scr, lane);
}
__device__ __forceinline__ void load_row_bf16(f32x4 (&v)[4], const bf16* xrow, int lane) {
    const GAS u32x2* xr = (const GAS u32x2*)xrow + lane;
#pragma unroll
    for (int j = 0; j < 4; ++j) { const u32x2 w = xr[64 * j]; v[j] = (f32x4){bflo(w.x), bfhi(w.x), bflo(w.y), bfhi(w.y)}; }
}
__device__ __forceinline__ void load_row_f32(f32x4 (&v)[4], const float* xrow, int lane) {
    const GAS f32x4* xr = (const GAS f32x4*)xrow + lane;
#pragma unroll
    for (int j = 0; j < 4; ++j) v[j] = xr[64 * j];
}
__device__ __forceinline__ void store_row_f32(const f32x4 (&v)[4], float* orow, int lane) {
    GAS f32x4* o = (GAS f32x4*)orow + lane;
#pragma unroll
    for (int j = 0; j < 4; ++j) o[64 * j] = v[j];
}

constexpr int I_GU = NE * 8 * 64, I_DN = NE * 8 * 32, N_EXPERT_ITEMS = I_GU + I_DN;
struct ExpItem { const float* W; unsigned char* WT; int K, N, k0, n0, drow; float sc; };
__device__ __forceinline__ ExpItem expert_item_decode(Frame& F, int it) {
    ExpItem x;
    if (it < I_GU) { const int e = it / (8 * 64), q = it % (8 * 64), kb = q / 64, nb = q % 64, n0 = 32 * nb;
        x.W = F.in[I_W_GU] + (size_t)e * D * 2 * DFF; x.WT = F.ws + WS_WGU_T + (size_t)e * 2 * DFF * D; x.K = D; x.N = 2 * DFF; x.k0 = 128 * kb; x.n0 = n0;
        x.drow = (n0 < 1024) ? (n0 >> 7) * 256 + (n0 & 127) : ((n0 - 1024) >> 7) * 256 + 128 + (n0 & 127); x.sc = WGU_SC; }
    else { const int r = it - I_GU, e = r / (8 * 32), q = r % (8 * 32), kb = q / 32, nb = q % 32;
        x.W = F.in[I_W_DOWN] + (size_t)e * DFF * D; x.WT = F.ws + WS_WDN_T + (size_t)e * D * DFF; x.K = DFF; x.N = D; x.k0 = 128 * kb; x.n0 = 32 * nb; x.drow = 32 * nb; x.sc = WDN_SC; }
    return x;
}
__device__ __forceinline__ void expert_stream(Frame& F, int sw, int nsw, LAS unsigned char* scr) {
    for (int it = sw; it < N_EXPERT_ITEMS; it += 3 * nsw) {
        const int it2 = it + nsw, it3 = it + 2 * nsw; const bool two = it2 < N_EXPERT_ITEMS, three = it3 < N_EXPERT_ITEMS;
        const ExpItem a = expert_item_decode(F, it), b = expert_item_decode(F, two ? it2 : it), c = expert_item_decode(F, three ? it3 : it);
        f32x4 xa[4][4], xb[4][4], xc[4][4];
        item8_load(xa, a.W, a.N, a.k0, a.n0, F.lane);
        if (two) item8_load(xb, b.W, b.N, b.k0, b.n0, F.lane);
        if (three) item8_load(xc, c.W, c.N, c.k0, c.n0, F.lane);
        item8_finish(xa, a.K, a.WT, a.k0, a.drow, a.sc, scr, F.lane);
        if (two) item8_finish(xb, b.K, b.WT, b.k0, b.drow, b.sc, scr + 5120, F.lane);
        if (three) item8_finish(xc, c.K, c.WT, c.k0, c.drow, c.sc, scr + 10240, F.lane);
    }
}
__device__ __forceinline__ void p0_prologue(Frame& F) {
    LAS float* scr = (LAS float*)(F.lds + RING_OFF + F.wave * 16384);
    const int gw = F.vcu * NWAVES + F.wave, NGW = F.G * NWAVES;
    constexpr int I_IN = 16 * 80, I_SQ = 16 * 32;
    constexpr int NITEMS = I_IN + 3 * I_SQ + 2 * 256;
    for (int it = gw; it < NITEMS; it += NGW) {
        int r = it;
        if (r < I_IN) { const int kb = r / 80, nb = r % 80, n0 = 32 * nb; int drow;
            if (n0 < 512) drow = (n0 >> 7) * 256 + (n0 & 127); else if (n0 < 1024) drow = ((n0 - 512) >> 7) * 256 + 128 + (n0 & 127); else drow = n0;
            p0_transpose_item(F.in[I_W_IN], D, INC, (bf16*)(F.ws + WS_WIN_T), 64 * kb, n0, drow, scr, F.lane); continue; } r -= I_IN;
        if (r < 3 * I_SQ) { const int w = r / I_SQ, q = r % I_SQ, kb = q / 32, nb = q % 32;
            const float* src = F.in[w == 0 ? I_W_OUT : w == 1 ? I_WK : I_WV];
            bf16* dst = (bf16*)(F.ws + (w == 0 ? WS_WOUT_T : w == 1 ? WS_WK_T : WS_WV_T));
            p0_transpose_item(src, D, D, dst, 64 * kb, 32 * nb, 32 * nb, scr, F.lane); continue; } r -= 3 * I_SQ;
        { const int w = r / 256, q = r % 256, kb = q / 32, nb = q % 32;
            p0_transpose_item8b(F.in[w == 0 ? I_WQ : I_WO], D, D, F.ws + (w == 0 ? WS_WQ_T : WS_WO_T), 128 * kb, 32 * nb, 32 * nb, w == 0 ? WQ_SC : WO_SC, (LAS unsigned char*)scr, F.lane); }
    }
    if (gw < 512) { const int idx = gw * 64 + F.lane, c = idx >> 5, e = idx & 31; const float w = F.in[I_W_ROUTER][idx];
        const unsigned hi = f2bf(w), lo = f2bf(w - __builtin_bit_cast(float, hi << 16)); bf16* wr = (bf16*)(F.ws + WS_WR);
        wr[e * WR_STRIDE + c] = (bf16)hi; wr[(32 + e) * WR_STRIDE + c] = (bf16)lo; }
    for (int m = gw; m < M + MM; m += NGW) {
        f32x4 v[4];
        if (m < M) { load_row_f32(v, F.in[I_X] + (size_t)m * D, F.lane); ln_row(v, F.in[I_LN_IN_G], F.in[I_LN_IN_B], F.lane);
            store_row_bf16(v, (bf16*)(F.ws + WS_HB) + (size_t)m * D, F.lane); }
        else { const int mm = m - M; load_row_f32(v, F.in[I_MEM] + (size_t)mm * D, F.lane); ln_row(v, F.in[I_LN_MEM_G], F.in[I_LN_MEM_B], F.lane);
            store_row_bf16(v, (bf16*)(F.ws + WS_MEMN) + (size_t)mm * D, F.lane); }
    }
}

constexpr unsigned TSTEP = 256u * 1024u * 2u;
struct SchedP1 { int G, c;
    __device__ __forceinline__ bool next(int i, Unit& u) const {
        const int L = i * G + c; if (L >= 1280) return false;
        u.nvalid = 256; u.goff = 0;
        if (L < 1024) { pg8::tile_order(L, 128, 8, u.pm, u.pn); u.z = 0; u.aoff = (unsigned)WS_HB + (unsigned)u.pm * TSTEP; u.boff = (unsigned)WS_WIN_T + (unsigned)u.pn * TSTEP; }
        else { const int j = L - 1024; u.pm = j & 1; u.pn = j >> 1; u.z = 3; u.aoff = (unsigned)WS_WIN_T + (unsigned)(8 + u.pm) * TSTEP; u.boff = (unsigned)WS_HB + (unsigned)u.pn * TSTEP; }
        return true; }
};
struct SchedKV { int v;
    __device__ __forceinline__ bool next(int i, Unit& u) const {
        if (i > 0 || v >= 64) return false;
        u.nvalid = 256; u.goff = 0;
        if (v < 32) { u.pm = v & 7; u.pn = v >> 3; u.z = 1; u.aoff = (unsigned)WS_MEMN + (unsigned)u.pm * TSTEP; u.boff = (unsigned)WS_WK_T + (unsigned)u.pn * TSTEP; }
        else { const int j = v - 32; u.pm = j & 3; u.pn = j >> 2; u.z = 2; u.aoff = (unsigned)WS_WV_T + (unsigned)u.pm * TSTEP; u.boff = (unsigned)WS_MEMN + (unsigned)u.pn * TSTEP; }
        return true; }
};
struct EpiP1 { static constexpr bool PERM = true;
    unsigned char* ws; const float* b_in;
    __device__ __forceinline__ void operator()(const f32x4 (&acc)[2][2][4][2], const Unit& u, int wr, int wc, int fr, int fq) const {
        const int row0 = u.pm * 256 + wr * 64 + fr;
        if (u.z == 0) {
            if (u.pn < 4) {
                const int ch = 128 * u.pn + wc * 32 + 8 * fq;
                f32x4 bv[2], bg[2];
#pragma unroll
                for (int n = 0; n < 2; ++n) { bv[n] = *(const f32x4*)(b_in + ch + 4 * n); bg[n] = *(const f32x4*)(b_in + 512 + ch + 4 * n); }
                bf16* U = (bf16*)(ws + WS_U);
#pragma unroll
                for (int ai = 0; ai < 2; ++ai)
#pragma unroll
                    for (int m = 0; m < 4; ++m) { f32x4 o[2];
#pragma unroll
                        for (int n = 0; n < 2; ++n) { const f32x4 a = acc[ai][0][m][n] + bv[n], g = acc[ai][1][m][n] + bg[n];
#pragma unroll
                            for (int j = 0; j < 4; ++j) o[n][j] = a[j] * sigmoidf_fast(g[j]); }
                        u32x4 w; w.x = pg8::cvt_pk_bf16(o[0][0], o[0][1]); w.y = pg8::cvt_pk_bf16(o[0][2], o[0][3]); w.z = pg8::cvt_pk_bf16(o[1][0], o[1][1]); w.w = pg8::cvt_pk_bf16(o[1][2], o[1][3]);
                        *(u32x4*)(U + (size_t)(row0 + ai * 128 + m * 16) * 512 + ch) = w; }
            } else {
                const int t = u.pn - 4, which = t >> 1, cb = (t & 1) * 256;
                bf16* dst = (bf16*)(ws + (which == 0 ? WS_Q : WS_K));
                pg8::store_tile_bf16(acc, dst + (size_t)row0 * 512 + cb, 512, b_in + 1024 + 256 * t, which == 0 ? SB_QSCALE : 1.0f, wc, fq);
            }
        } else if (u.z == 3) {
            const float* rb = b_in + 2048 + row0; bf16* p0 = (bf16*)(ws + WS_V) + (size_t)row0 * M + 256 * u.pn; const int cl = wc * 32 + 8 * fq;
#pragma unroll
            for (int ai = 0; ai < 2; ++ai)
#pragma unroll
                for (int m = 0; m < 4; ++m) { const float bv = rb[ai * 128 + m * 16]; bf16* rowp = p0 + (size_t)(ai * 128 + m * 16) * M + cl;
#pragma unroll
                    for (int bj = 0; bj < 2; ++bj) { const f32x4 v0 = acc[ai][bj][m][0] + bv, v1 = acc[ai][bj][m][1] + bv;
                        u32x4 w; w.x = pg8::cvt_pk_bf16(v0[0], v0[1]); w.y = pg8::cvt_pk_bf16(v0[2], v0[3]); w.z = pg8::cvt_pk_bf16(v1[0], v1[1]); w.w = pg8::cvt_pk_bf16(v1[2], v1[3]);
                        *(u32x4*)(rowp + bj * 128) = w; } }
        } else if (u.z == 1) pg8::store_tile_bf16(acc, (bf16*)(ws + WS_KM) + (size_t)row0 * 1024 + 256 * u.pn, 1024, nullptr, 1.0f, wc, fq);
        else pg8::store_tile_bf16(acc, (bf16*)(ws + WS_VMT) + (size_t)row0 * 2048 + 256 * u.pn, 2048, nullptr, 1.0f, wc, fq);
    }
};

struct SchedPlain { int G, c, nM, nN; unsigned abase, bbase, atile, btile, acol, bcol, bgrp;
    __device__ __forceinline__ bool next(int i, Unit& u) const {
        const int L = i * G + c; if (L >= nM * nN) return false;
        pg8::tile_order(L, nM, nN, u.pm, u.pn); u.z = 0; u.nvalid = 256; u.goff = 0;
        u.aoff = abase + (unsigned)u.pm * atile + (unsigned)u.pn * acol; u.boff = bbase + (unsigned)u.pn * btile + (unsigned)(u.pm >> 4) * bgrp + (unsigned)u.pn * bcol; return true; }
};
struct EpiBf16 { static constexpr bool PERM = true;
    bf16* O; int ldc; float scale; const float* bias;
    __device__ __forceinline__ void operator()(const f32x4 (&acc)[2][2][4][2], const Unit& u, int wr, int wc, int fr, int fq) const {
        pg8::store_tile_bf16(acc, O + (size_t)(u.pm * 256 + wr * 64 + fr) * ldc + 256 * u.pn, (size_t)ldc, bias ? bias + 256 * u.pn : nullptr, scale, wc, fq); }
};
constexpr int MOE_MAX_UNITS = 40;
struct SchedMoe { const LAS int* ut;
    __device__ __forceinline__ bool next(int i, Unit& u) const {
        if (i >= MOE_MAX_UNITS) return false;
        const LAS int* p = ut + 8 * i;
        if (__builtin_amdgcn_readfirstlane(p[7]) == 0) return false;
        u.pm = __builtin_amdgcn_readfirstlane(p[0]); u.pn = __builtin_amdgcn_readfirstlane(p[1]); u.z = __builtin_amdgcn_readfirstlane(p[2]); u.nvalid = __builtin_amdgcn_readfirstlane(p[3]);
        u.aoff = (unsigned)__builtin_amdgcn_readfirstlane(p[4]); u.boff = (unsigned)__builtin_amdgcn_readfirstlane(p[5]); u.goff = (unsigned)__builtin_amdgcn_readfirstlane(p[6]); return true; }
};
__device__ __forceinline__ void moe_units(Frame& F, const LAS int* tb, LAS int* ut, int nN, unsigned abase, unsigned wbase, unsigned wexp, bool gather) {
    if (F.tid < MOE_MAX_UNITS) { const int i = F.tid, nblk = tb[32], L = i * F.G + (int)blockIdx.x; LAS int* p = ut + 8 * i;
        if (L < nblk * nN) { int pm, pn; pg8::tile_order(L, nblk, nN, pm, pn);
            const int e = tb[128 + pm], j = pm - tb[e], rem = tb[64 + e] - 256 * j;
            p[0] = pm; p[1] = pn; p[2] = e; p[3] = rem < 256 ? rem : 256; p[4] = (int)(gather ? abase : abase + (unsigned)pm * (TSTEP / 2));
            p[5] = (int)(wbase + (unsigned)e * wexp + (unsigned)pn * (TSTEP / 2)); p[6] = e * LCAP + 256 * j; p[7] = 1; }
        else p[7] = 0; }
    LDS_WAIT(); __syncthreads();
}
struct EpiAct { static constexpr bool PERM = true;
    unsigned char* ACT; const float* b_gu;
    __device__ __forceinline__ void operator()(const f32x4 (&acc)[2][2][4][2], const Unit& u, int wr, int wc, int fr, int fq) const {
        const int row0 = u.pm * 256 + wr * 64 + fr, ch = 128 * u.pn + wc * 32 + 8 * fq;
        const float* bb = b_gu + (size_t)u.z * 2 * DFF;
        f32x4 bg[2], bu[2];
#pragma unroll
        for (int n = 0; n < 2; ++n) { bg[n] = *(const f32x4*)(bb + ch + 4 * n); bu[n] = *(const f32x4*)(bb + DFF + ch + 4 * n); }
#pragma unroll
        for (int ai = 0; ai < 2; ++ai)
#pragma unroll
            for (int m = 0; m < 4; ++m) { f32x4 o[2];
#pragma unroll
                for (int n = 0; n < 2; ++n) { const f32x4 g = acc[ai][0][m][n] * (1.0f / WGU_SC) + bg[n], uu = acc[ai][1][m][n] * (1.0f / WGU_SC) + bu[n];
#pragma unroll
                    for (int j = 0; j < 4; ++j) { const float g_ = fminf(g[j], 7.0f), u_ = fminf(fmaxf(uu[j], -7.0f), 7.0f); o[n][j] = (u_ + 1.0f) * g_ * sigmoidf_fast(1.702f * g_); } }
                *(u32x2*)(ACT + (size_t)(row0 + ai * 128 + m * 16) * DFF + ch) = (u32x2){pk4_fp8(o[0][0], o[0][1], o[0][2], o[0][3]), pk4_fp8(o[1][0], o[1][1], o[1][2], o[1][3])}; }
    }
};
struct EpiDown { static constexpr bool PERM = true;
    unsigned char* YS; const float* b_down; const float* lgate;
    __device__ __forceinline__ void operator()(const f32x4 (&acc)[2][2][4][2], const Unit& u, int wr, int wc, int fr, int fq) const {
        const int r0 = wr * 64 + fr, cl = wc * 32 + 8 * fq;
        const float* bb = b_down + (size_t)u.z * D + 256 * u.pn + cl;
        f32x4 bv[2][2];
#pragma unroll
        for (int bj = 0; bj < 2; ++bj)
#pragma unroll
            for (int n = 0; n < 2; ++n) bv[bj][n] = *(const f32x4*)(bb + bj * 128 + 4 * n);
        float gts[2][4];
#pragma unroll
        for (int ai = 0; ai < 2; ++ai)
#pragma unroll
            for (int m = 0; m < 4; ++m) { const int r = r0 + ai * 128 + m * 16; gts[ai][m] = lgate[u.goff + (r < u.nvalid ? r : u.nvalid - 1)]; }
#pragma unroll
        for (int ai = 0; ai < 2; ++ai)
#pragma unroll
            for (int m = 0; m < 4; ++m) { const int r = r0 + ai * 128 + m * 16; const float gt = (r < u.nvalid) ? gts[ai][m] * YS_SC : 0.f;
                unsigned char* rowp = YS + (size_t)(u.pm * 256 + r) * D + 256 * u.pn + cl;
#pragma unroll
                for (int bj = 0; bj < 2; ++bj) { const f32x4 v0 = (acc[ai][bj][m][0] * (1.0f / WDN_SC) + bv[bj][0]) * gt, v1 = (acc[ai][bj][m][1] * (1.0f / WDN_SC) + bv[bj][1]) * gt;
                    *(u32x2*)(rowp + bj * 128) = (u32x2){pk4_fp8(v0[0], v0[1], v0[2], v0[3]), pk4_fp8(v1[0], v1[1], v1[2], v1[3])}; } }
    }
};
__device__ __forceinline__ void moe_table(Frame& F, LAS int* tb) {
    if (F.tid < 32) { int c = (int)__hip_atomic_load(F.ctl + CW_ECNT + 64 * F.tid, RLX_AGENT); if (c > LCAP) c = LCAP; tb[64 + F.tid] = c; }
    LDS_WAIT(); __syncthreads();
    if (F.tid == 0) { int s = 0; for (int e = 0; e < NE; ++e) { tb[e] = s; s += (tb[64 + e] + 255) >> 8; } tb[32] = s; }
    LDS_WAIT(); __syncthreads();
    for (int b = F.tid; b < NBLK_MAX; b += NWAVES * 64) { int e = 0; while (e < NE - 1 && tb[e + 1] <= b) ++e; tb[128 + b] = e; }
    LDS_WAIT(); __syncthreads();
}

__device__ __forceinline__ void conv_phase(Frame& F) {
    LAS unsigned* ut = (LAS unsigned*)(F.lds + RING_OFF);
    LAS float* co = (LAS float*)(F.lds + RING_OFF + 65536);
    const int cp = F.tid & 255, half = F.tid >> 8;
    float w0[CWID], w1[CWID];
    { const float* wd = F.in[I_W_DW] + 2 * cp;
#pragma unroll
        for (int j = 0; j < CWID; ++j) { const f32x2 w = *(const GAS f32x2*)(wd + j * CONV_CH); w0[j] = w.x; w1[j] = w.y; } }
    const f32x2 bd = *(const GAS f32x2*)(F.in[I_B_DW] + 2 * cp);
    const f32x4 g0 = *(const GAS f32x4*)(F.in[I_LN_CONV_G] + 8 * F.lane), g1 = *(const GAS f32x4*)(F.in[I_LN_CONV_G] + 8 * F.lane + 4);
    const f32x4 b0 = *(const GAS f32x4*)(F.in[I_LN_CONV_B] + 8 * F.lane), b1 = *(const GAS f32x4*)(F.in[I_LN_CONV_B] + 8 * F.lane + 4);
    bf16* MX = (bf16*)(F.ws + WS_MIXIN);
    for (int it = F.vcu; it < NB * (T_ / 32); it += F.G) {
        const int b = it / (T_ / 32), t0 = (it % (T_ / 32)) * 32;
        const bf16* U = (const bf16*)(F.ws + WS_U) + (size_t)b * T_ * CONV_CH;
        for (int idx = F.tid; idx < 62 * 64; idx += 512) { const int r = idx >> 6, c16 = idx & 63, t = t0 - 30 + r;
            u32x4 v = (u32x4){0u, 0u, 0u, 0u}; if (t >= 0) v = *(const GAS u32x4*)(U + (size_t)t * CONV_CH + c16 * 8);
            *(LAS u32x4*)(ut + r * 256 + c16 * 4) = v; }
        LDS_WAIT(); __syncthreads();
        { float a0[16], a1[16];
#pragma unroll
            for (int tt = 0; tt < 16; ++tt) { a0[tt] = bd.x; a1[tt] = bd.y; }
#pragma unroll
            for (int r = 0; r < 46; ++r) { const unsigned uu = ut[(half * 16 + r) * 256 + cp]; const float u0 = bflo(uu), u1 = bfhi(uu);
#pragma unroll
                for (int tt = 0; tt < 16; ++tt) { const int j = r - tt; if (j >= 0 && j < CWID) { a0[tt] += w0[j] * u0; a1[tt] += w1[j] * u1; } } }
#pragma unroll
            for (int tt = 0; tt < 16; ++tt) *(LAS f32x2*)(co + (half * 16 + tt) * CONV_CH + 2 * cp) = (f32x2){a0[tt], a1[tt]};
        }
        LDS_WAIT(); __syncthreads();
#pragma unroll
        for (int q = 0; q < 4; ++q) { const int tt = 4 * F.wave + q;
            f32x4 x0 = *(const LAS f32x4*)(co + tt * CONV_CH + 8 * F.lane), x1 = *(const LAS f32x4*)(co + tt * CONV_CH + 8 * F.lane + 4);
            const float mean = wave_sum((x0.x + x0.y) + (x0.z + x0.w) + (x1.x + x1.y) + (x1.z + x1.w)) * (1.f / CONV_CH);
            x0 = x0 - mean; x1 = x1 - mean;
            const float var = wave_sum((x0.x * x0.x + x0.y * x0.y) + (x0.z * x0.z + x0.w * x0.w) + (x1.x * x1.x + x1.y * x1.y) + (x1.z * x1.z + x1.w * x1.w)) * (1.f / CONV_CH);
            const float rstd = 1.f / sqrtf(var + LN_EPS);
            x0 = x0 * rstd * g0 + b0; x1 = x1 * rstd * g1 + b1;
            float y[8] = {x0.x, x0.y, x0.z, x0.w, x1.x, x1.y, x1.z, x1.w};
#pragma unroll
            for (int j = 0; j < 8; ++j) y[j] = y[j] * sigmoidf_fast(y[j]);
            *(GAS u32x4*)(MX + (size_t)(b * T_ + t0 + tt) * D + 8 * F.lane) = (u32x4){pk2(y[0], y[1]), pk2(y[2], y[3]), pk2(y[4], y[5]), pk2(y[6], y[7])}; }
        __syncthreads();
    }
}

typedef float f32x16 __attribute__((ext_vector_type(16)));
__device__ __forceinline__ int crow(int r, int hi) { return (r & 3) + 8 * (r >> 2) + 4 * hi; }
__device__ __forceinline__ bf16x8 pack8(const float* v) {
    u32x4 w; w.x = pg8::cvt_pk_bf16(v[0], v[1]); w.y = pg8::cvt_pk_bf16(v[2], v[3]); w.z = pg8::cvt_pk_bf16(v[4], v[5]); w.w = pg8::cvt_pk_bf16(v[6], v[7]);
    return __builtin_bit_cast(bf16x8, w); }
constexpr float SB_EXIT = 150.0f;
struct SbStage { u32x4 k[4], v[4]; };
__device__ __forceinline__ void sb_gload(SbStage& g, const bf16* Kt, const bf16* Vt, int lane) {
#pragma unroll
    for (int i = 0; i < 4; ++i) { const int c = (lane & 7) ^ ((4 * i + (lane >> 4)) & 7); g.k[i] = *(const GAS u32x4*)(Kt + (size_t)(8 * i) * SBW + 8 * c); }
#pragma unroll
    for (int i = 0; i < 4; ++i) g.v[i] = *(const GAS u32x4*)(Vt + (size_t)(16 * i) * M);
}
__device__ __forceinline__ void sb_lwrite(const SbStage& g, LAS unsigned char* buf, int lane) {
#pragma unroll
    for (int i = 0; i < 4; ++i) *(LAS u32x4*)(buf + 1024 * i + 16 * lane) = g.k[i];
#pragma unroll
    for (int i = 0; i < 4; ++i) *(LAS u32x4*)(buf + 4096 + 1024 * i + 16 * lane) = g.v[i];
}
__device__ __forceinline__ void sb_attn_wave(Frame& F, int b, int h, int qt) {
    const int c = F.lane & 31, hi = F.lane >> 5;
    const bf16* Q = (const bf16*)(F.ws + WS_Q); const bf16* Kb = (const bf16*)(F.ws + WS_K); const bf16* VT = (const bf16*)(F.ws + WS_V);
    LAS unsigned char* wbuf = F.lds + RING_OFF + F.wave * 16384;
    bf16x8 tri[2];
#pragma unroll
    for (int s = 0; s < 2; ++s) { bf16x8 t;
#pragma unroll
        for (int j = 0; j < 8; ++j) { const int k = 16 * s + 8 * (j >> 2) + 4 * hi + (j & 3); t[j] = (k >= c) ? (short)0xBF80 : (short)0; }
        tri[s] = t; }
    bf16x8 qf[4];
    { const bf16* qp = Q + ((size_t)b * T_ + 32 * qt + c) * SBW + h * SBD + 8 * hi;
#pragma unroll
        for (int s = 0; s < 4; ++s) qf[s] = *(const GAS bf16x8*)(qp + 16 * s); }
    const bf16* Ksrc = Kb + ((size_t)b * T_ + (F.lane >> 3)) * SBW + h * SBD;
    const bf16* Vsrc = VT + (size_t)(h * SBD + (F.lane >> 2)) * M + (size_t)b * T_ + 8 * ((F.lane & 3) ^ ((F.lane >> 4) & 3));

    const int ksw = (c >> 1) & 7, vsw = (c >> 2) & 3;

    f32x16 o0, o1;
#pragma unroll
    for (int r = 0; r < 16; ++r) { o0[r] = 0.f; o1[r] = 0.f; }
    float carry = 0.f;
    SbStage st;
    sb_gload(st, Ksrc + (size_t)(32 * qt) * SBW, Vsrc + 32 * qt, F.lane); sb_lwrite(st, wbuf, F.lane);
    for (int kt = qt; kt >= 0; --kt) {
        LAS unsigned char* buf = wbuf + ((qt - kt) & 1) * 8192;
        if (kt > 0) sb_gload(st, Ksrc + (size_t)(32 * (kt - 1)) * SBW, Vsrc + 32 * (kt - 1), F.lane);
        const bool diag = (kt == qt);
        bf16x8 kf[4];
#pragma unroll
        for (int s = 0; s < 4; ++s) kf[s] = *(const LAS bf16x8*)(buf + c * 128 + 16 * ((2 * s + hi) ^ ksw));
        f32x16 p;
#pragma unroll
        for (int r = 0; r < 16; ++r) p[r] = 0.f;
#pragma unroll
        for (int s = 0; s < 4; ++s) p = __builtin_amdgcn_mfma_f32_32x32x16_bf16(kf[s], qf[s], p, 0, 0, 0);
        u32x2 vv[2][2][2];
#pragma unroll
        for (int dt = 0; dt < 2; ++dt)
#pragma unroll
            for (int s = 0; s < 2; ++s)
#pragma unroll
                for (int q = 0; q < 2; ++q) vv[dt][s][q] = *(const LAS u32x2*)(buf + 4096 + (32 * dt + c) * 64 + 16 * ((2 * s + q) ^ vsw) + 8 * hi);
        float L[16];
#pragma unroll
        for (int r = 0; r < 16; ++r) { const float y = p[r]; float l = __builtin_amdgcn_logf(1.0f + __builtin_amdgcn_exp2f(y)); l = (y > 64.f) ? y : l;
            if (diag) l = (crow(r, hi) >= c) ? 0.f : l; L[r] = l; }
        const bf16x8 l0 = pack8(L), l1 = pack8(L + 8);
        f32x16 a;
#pragma unroll
        for (int r = 0; r < 16; ++r) a[r] = p[r] - carry;
        a = __builtin_amdgcn_mfma_f32_32x32x16_bf16(tri[0], l0, a, 0, 0, 0); a = __builtin_amdgcn_mfma_f32_32x32x16_bf16(tri[1], l1, a, 0, 0, 0);
        const float tot = p[0] - a[0];
        float w[16];
#pragma unroll
        for (int r = 0; r < 16; ++r) { float x = __builtin_amdgcn_exp2f(a[r]); if (diag) x = (crow(r, hi) >= c) ? 0.f : x; w[r] = x; }
        const bf16x8 p0 = pack8(w), p1 = pack8(w + 8);
        { const bf16x8 v00 = __builtin_bit_cast(bf16x8, (u32x4){vv[0][0][0].x, vv[0][0][0].y, vv[0][0][1].x, vv[0][0][1].y});
          const bf16x8 v01 = __builtin_bit_cast(bf16x8, (u32x4){vv[0][1][0].x, vv[0][1][0].y, vv[0][1][1].x, vv[0][1][1].y});
          const bf16x8 v10 = __builtin_bit_cast(bf16x8, (u32x4){vv[1][0][0].x, vv[1][0][0].y, vv[1][0][1].x, vv[1][0][1].y});
          const bf16x8 v11 = __builtin_bit_cast(bf16x8, (u32x4){vv[1][1][0].x, vv[1][1][0].y, vv[1][1][1].x, vv[1][1][1].y});
          o0 = __builtin_amdgcn_mfma_f32_32x32x16_bf16(v00, p0, o0, 0, 0, 0); o0 = __builtin_amdgcn_mfma_f32_32x32x16_bf16(v01, p1, o0, 0, 0, 0);
          o1 = __builtin_amdgcn_mfma_f32_32x32x16_bf16(v10, p0, o1, 0, 0, 0); o1 = __builtin_amdgcn_mfma_f32_32x32x16_bf16(v11, p1, o1, 0, 0, 0); }
        carry = __shfl(tot, c);
        if (__all(carry >= SB_EXIT)) break;
        if (kt > 0) sb_lwrite(st, wbuf + ((qt - kt + 1) & 1) * 8192, F.lane);
    }
    bf16* op = (bf16*)(F.ws + WS_MIXIN) + ((size_t)b * T_ + 32 * qt + c) * D + CONV_CH + h * SBD + 4 * hi;
#pragma unroll
    for (int g = 0; g < 4; ++g) {
        *(GAS u32x2*)(op + 8 * g) = (u32x2){pg8::cvt_pk_bf16(o0[4 * g], o0[4 * g + 1]), pg8::cvt_pk_bf16(o0[4 * g + 2], o0[4 * g + 3])};
        *(GAS u32x2*)(op + 32 + 8 * g) = (u32x2){pg8::cvt_pk_bf16(o1[4 * g], o1[4 * g + 1]), pg8::cvt_pk_bf16(o1[4 * g + 2], o1[4 * g + 3])}; }
}

__device__ __forceinline__ void resid_row(f32x4 (&v)[4], const bf16* hrow, const bf16* mrow, int lane) {
    f32x4 a[4]; load_row_bf16(v, hrow, lane); load_row_bf16(a, mrow, lane);
#pragma unroll
    for (int j = 0; j < 4; ++j) v[j] = v[j] * DN_ALPHA + a[j];
}
__device__ __forceinline__ void ln_phase(Frame& F, const float* g, const float* b) {
    int r0, r1;
    if (F.G == 256) { if (F.vcu < 64) { r0 = 64 * F.vcu; r1 = r0 + 64; } else { const int j = F.vcu - 64; r0 = 4096 + (j * 28672) / 192; r1 = 4096 + ((j + 1) * 28672) / 192; } }
    else { r0 = (int)(((long)F.vcu * M) / F.G); r1 = (int)(((long)(F.vcu + 1) * M) / F.G); }
    for (int m = r0 + F.wave; m < r1; m += NWAVES) { f32x4 v[4]; bf16* hrow = (bf16*)(F.ws + WS_HB) + (size_t)m * D; resid_row(v, hrow, (const bf16*)(F.ws + WS_QM) + (size_t)m * D, F.lane);
        ln_row(v, g, b, F.lane); store_row_bf16(v, hrow, F.lane);
        { GAS unsigned* h8 = (GAS unsigned*)(F.ws + WS_HB8 + (size_t)m * D) + F.lane;
#pragma unroll
            for (int j = 0; j < 4; ++j) h8[64 * j] = pk4_fp8(v[j].x, v[j].y, v[j].z, v[j].w); } }
}
__device__ __forceinline__ void softmax_phase(Frame& F) {
    const int gw = F.vcu * NWAVES + F.wave, NGW = F.G * NWAVES;
    for (int m = gw; m < M; m += NGW) { GAS u32x2* p = (GAS u32x2*)((bf16*)(F.ws + WS_SP) + (size_t)m * D) + F.lane;
#pragma unroll
        for (int j = 0; j < 4; ++j) { const u32x2 w = p[64 * j]; float x0 = bflo(w.x), x1 = bfhi(w.x), x2 = bflo(w.y), x3 = bfhi(w.y);
            const float mx = wave_max(fmaxf(fmaxf(x0, x1), fmaxf(x2, x3)));
            x0 = __builtin_amdgcn_exp2f(x0 - mx); x1 = __builtin_amdgcn_exp2f(x1 - mx); x2 = __builtin_amdgcn_exp2f(x2 - mx); x3 = __builtin_amdgcn_exp2f(x3 - mx);
            const float inv = 1.0f / wave_sum((x0 + x1) + (x2 + x3));
            p[64 * j] = (u32x2){pk2(x0 * inv, x1 * inv), pk2(x2 * inv, x3 * inv)}; } }
}
__device__ __forceinline__ void xattn_phase(Frame& F) {
    LAS unsigned char* tb0 = F.lds + RING_OFF;
    const bf16* QM = (const bf16*)(F.ws + WS_QM); const bf16* KM = (const bf16*)(F.ws + WS_KM); const bf16* VMT = (const bf16*)(F.ws + WS_VMT); bf16* OB = (bf16*)(F.ws + WS_OB);
    const int c = F.lane & 31, h5 = F.lane >> 5;
    const int tr = F.tid >> 5, tc = F.tid & 31;
    const int kr = F.tid >> 4, kc = F.tid & 15;
    for (int u = F.vcu; u < NB * 4 * 16; u += F.G) {
        const int b = u >> 6, h = (u >> 4) & 3, qt = u & 15;
        const size_t rowq = (size_t)b * T_ + 256 * qt + 32 * F.wave + c;
        const bf16* qp = QM + rowq * D + h * 256 + 8 * h5;
        const bf16* ksrc = KM + ((size_t)b * NMEM + kr) * D + h * 256 + 8 * kc;
        const int kw0 = kr * 272 + kc * 16, kw1 = (kr + 32) * 272 + kc * 16;
        const bf16* vsrc = VMT + ((size_t)h * 256 + tr) * (size_t)MM + (size_t)b * NMEM + 8 * tc;
        int vw[4];
#pragma unroll
        for (int j = 0; j < 4; ++j) vw[j] = (tr + 16 * j) * 528 + tc * 16;
        u32x4 st[4];
        __syncthreads();
        st[0] = *(const GAS u32x4*)ksrc; st[1] = *(const GAS u32x4*)(ksrc + (size_t)32 * D);
        *(LAS u32x4*)(tb0 + kw0) = st[0]; *(LAS u32x4*)(tb0 + kw1) = st[1];
        LDS_WAIT(); __syncthreads();
        f32x16 sacc[8];
#pragma unroll
        for (int dh = 0; dh < 2; ++dh) {
            bf16x8 qf[8];
#pragma unroll
            for (int s_ = 0; s_ < 8; ++s_) qf[s_] = *(const GAS bf16x8*)(qp + 128 * dh + 16 * s_);
#pragma unroll
            for (int kp = 0; kp < 4; ++kp) { const int i = dh * 4 + kp;
                LAS unsigned char* buf = tb0 + (i & 1) * 34816; LAS unsigned char* nbuf = tb0 + ((i + 1) & 1) * 34816;
                if (i < 7) { const bf16* p = ksrc + (size_t)(64 * ((i + 1) & 3)) * D + 128 * ((i + 1) >> 2); st[0] = *(const GAS u32x4*)p; st[1] = *(const GAS u32x4*)(p + (size_t)32 * D); }
                else {
#pragma unroll
                    for (int j = 0; j < 4; ++j) st[j] = *(const GAS u32x4*)(vsrc + (size_t)(16 * j) * MM); }
#pragma unroll
                for (int k2 = 0; k2 < 2; ++k2) { const int kt = 2 * kp + k2;
                    f32x16 a;
                    if (dh == 0) {
#pragma unroll
                        for (int r = 0; r < 16; ++r) a[r] = 0.f; }
                    else a = sacc[kt];
#pragma unroll
                    for (int s_ = 0; s_ < 8; ++s_) { const bf16x8 kf = *(const LAS bf16x8*)(buf + c * 272 + h5 * 16 + (32 * k2 * 272 + 32 * s_)); a = __builtin_amdgcn_mfma_f32_32x32x16_bf16(kf, qf[s_], a, 0, 0, 0); }
                    sacc[kt] = a; }
                if (i < 7) { *(LAS u32x4*)(nbuf + kw0) = st[0]; *(LAS u32x4*)(nbuf + kw1) = st[1]; }
                else {
#pragma unroll
                    for (int j = 0; j < 4; ++j) *(LAS u32x4*)(nbuf + vw[j]) = st[j]; }
                LDS_WAIT(); __syncthreads();
            }
        }
        float mx = sacc[0][0];
#pragma unroll
        for (int kt = 0; kt < 8; ++kt)
#pragma unroll
            for (int r = 0; r < 16; ++r) mx = fmaxf(mx, sacc[kt][r]);
        mx = fmaxf(mx, __shfl_xor(mx, 32));
        float sum = 0.f; bf16x8 pb[8][2];
#pragma unroll
        for (int kt = 0; kt < 8; ++kt) { float p[16];
#pragma unroll
            for (int r = 0; r < 16; ++r) { p[r] = __builtin_amdgcn_exp2f(sacc[kt][r] - mx); sum += p[r]; }
            pb[kt][0] = pack8(p); pb[kt][1] = pack8(p + 8); }
        sum += __shfl_xor(sum, 32);
        const float inv = OB_SC / sum;
        unsigned char* op = (unsigned char*)OB + rowq * D + h * 256 + 4 * h5;
        for (int dp = 0; dp < 4; ++dp) {
            LAS unsigned char* buf = tb0 + (dp & 1) * 34816; LAS unsigned char* nbuf = tb0 + ((dp + 1) & 1) * 34816;
            if (dp < 3) {
#pragma unroll
                for (int j = 0; j < 4; ++j) st[j] = *(const GAS u32x4*)(vsrc + (size_t)(64 * (dp + 1) + 16 * j) * MM); }
#pragma unroll
            for (int d2 = 0; d2 < 2; ++d2) { const int dt = 2 * dp + d2;
                f32x16 o;
#pragma unroll
                for (int r = 0; r < 16; ++r) o[r] = 0.f;
#pragma unroll
                for (int kt = 0; kt < 8; ++kt)
#pragma unroll
                    for (int s2 = 0; s2 < 2; ++s2) { const LAS unsigned char* rp = buf + c * 528 + 8 * h5 + (32 * d2 * 528 + (4 * kt + 2 * s2) * 16);
                        const u32x2 v0 = *(const LAS u32x2*)rp, v1 = *(const LAS u32x2*)(rp + 16);
                        o = __builtin_amdgcn_mfma_f32_32x32x16_bf16(__builtin_bit_cast(bf16x8, (u32x4){v0.x, v0.y, v1.x, v1.y}), pb[kt][s2], o, 0, 0, 0); }
#pragma unroll
                for (int g = 0; g < 4; ++g) *(GAS unsigned*)(op + 32 * dt + 8 * g) = pk4_fp8(o[4 * g] * inv, o[4 * g + 1] * inv, o[4 * g + 2] * inv, o[4 * g + 3] * inv); }
            if (dp < 3) {
#pragma unroll
                for (int j = 0; j < 4; ++j) *(LAS u32x4*)(nbuf + vw[j]) = st[j]; }
            LDS_WAIT(); __syncthreads();
        }
    }
}
typedef float f32x4v __attribute__((ext_vector_type(4)));
__device__ __forceinline__ void ln2_router_phase(Frame& F) {
    LAS bf16* wr = (LAS bf16*)(F.lds + P10_WR);
    LAS float* gb = (LAS float*)(F.lds + P10_GB);
    LAS int* lcnt = (LAS int*)(F.lds + P10_LCNT);
    LAS int* rec = (LAS int*)(F.lds + P10_REC);
    for (int i = F.tid; i < 2 * 32 * WR_STRIDE * 2 / 16; i += 512) *(LAS u32x4*)(F.lds + P10_WR + 16 * i) = *(const GAS u32x4*)(F.ws + WS_WR + 16 * i);
    for (int i = F.tid; i < 512; i += 512) { *(LAS f32x4*)(gb + 4 * i) = ((const GAS f32x4*)(i < 256 ? F.in[I_LN2_G] : F.in[I_LN2_B]))[i & 255]; }
    if (F.tid < 64) lcnt[F.tid] = 0;
    LDS_WAIT(); __syncthreads();
    const bf16* H1 = (const bf16*)(F.ws + WS_HB); const bf16* CA = (const bf16*)(F.ws + WS_QM); bf16* H2 = (bf16*)(F.ws + WS_HB2);
    int* ltok = (int*)(F.ws + WS_LTOK); float* lgate = (float*)(F.ws + WS_LGATE); int* sidx = (int*)(F.ws + WS_SIDX);
    const int fr = F.lane & 15, fq = F.lane >> 4;
    for (int rb = F.vcu; rb < M / 128; rb += F.G) {
        const int m0 = rb * 128 + F.wave * 16;
        float mymean = 0.f, myrstd = 0.f;
        for (int i = 0; i < 16; ++i) { const int m = m0 + i;
            f32x4 v[4]; resid_row(v, H1 + (size_t)m * D, CA + (size_t)m * D, F.lane);
            float s1 = 0.f;
#pragma unroll
            for (int j = 0; j < 4; ++j) s1 += (v[j].x + v[j].y) + (v[j].z + v[j].w);
            const float mean = wave_sum(s1) * (1.f / D); float s2 = 0.f;
#pragma unroll
            for (int j = 0; j < 4; ++j) { v[j] = v[j] - mean; s2 += (v[j].x * v[j].x + v[j].y * v[j].y) + (v[j].z * v[j].z + v[j].w * v[j].w); }
            const float rstd = 1.f / sqrtf(wave_sum(s2) * (1.f / D) + LN_EPS);
            if (fr == i) { mymean = mean; myrstd = rstd; }
#pragma unroll
            for (int j = 0; j < 4; ++j) { const f32x4 gg = *(const LAS f32x4*)(gb + 4 * F.lane + 256 * j), bb = *(const LAS f32x4*)(gb + 1024 + 4 * F.lane + 256 * j); v[j] = v[j] * rstd * gg + bb; }
            store_row_bf16(v, H2 + (size_t)m * D, F.lane);
            { GAS unsigned* h8 = (GAS unsigned*)(F.ws + WS_HB8 + (size_t)m * D) + F.lane;
#pragma unroll
                for (int j = 0; j < 4; ++j) h8[64 * j] = pk4_fp8(v[j].x, v[j].y, v[j].z, v[j].w); }
        }
        f32x4v acc0 = {0.f, 0.f, 0.f, 0.f}, acc1 = {0.f, 0.f, 0.f, 0.f};
        { const bf16* hp = H1 + (size_t)(m0 + fr) * D + 8 * fq; const bf16* cp = CA + (size_t)(m0 + fr) * D + 8 * fq;
            const LAS bf16* wp = wr + fr * WR_STRIDE + 8 * fq; const LAS float* gp = gb + 8 * fq;
            const float sc = myrstd, sh = -mymean * myrstd;
#pragma unroll 2
            for (int s_ = 0; s_ < 32; ++s_) {
                const u32x4 hv = *(const GAS u32x4*)(hp + 32 * s_), cv = *(const GAS u32x4*)(cp + 32 * s_);
                const f32x4 g0 = *(const LAS f32x4*)(gp + 32 * s_), g1 = *(const LAS f32x4*)(gp + 32 * s_ + 4), b0 = *(const LAS f32x4*)(gp + 1024 + 32 * s_), b1 = *(const LAS f32x4*)(gp + 1024 + 32 * s_ + 4);
                float x[8];
                x[0] = bflo(hv.x) * DN_ALPHA + bflo(cv.x); x[1] = bfhi(hv.x) * DN_ALPHA + bfhi(cv.x); x[2] = bflo(hv.y) * DN_ALPHA + bflo(cv.y); x[3] = bfhi(hv.y) * DN_ALPHA + bfhi(cv.y);
                x[4] = bflo(hv.z) * DN_ALPHA + bflo(cv.z); x[5] = bfhi(hv.z) * DN_ALPHA + bfhi(cv.z); x[6] = bflo(hv.w) * DN_ALPHA + bflo(cv.w); x[7] = bfhi(hv.w) * DN_ALPHA + bfhi(cv.w);
                const float gg[8] = {g0.x, g0.y, g0.z, g0.w, g1.x, g1.y, g1.z, g1.w}, bb[8] = {b0.x, b0.y, b0.z, b0.w, b1.x, b1.y, b1.z, b1.w};
                float lo[8]; unsigned hp2[4];
#pragma unroll
                for (int j = 0; j < 8; ++j) x[j] = (x[j] * sc + sh) * gg[j] + bb[j];
#pragma unroll
                for (int j = 0; j < 4; ++j) { hp2[j] = pg8::cvt_pk_bf16(x[2 * j], x[2 * j + 1]); lo[2 * j] = x[2 * j] - bflo(hp2[j]); lo[2 * j + 1] = x[2 * j + 1] - bfhi(hp2[j]); }
                const bf16x8 bhi = __builtin_bit_cast(bf16x8, (u32x4){hp2[0], hp2[1], hp2[2], hp2[3]});
                const bf16x8 blo = pack8(lo);
                const bf16x8 wh0 = *(const LAS bf16x8*)(wp + 32 * s_), wh1 = *(const LAS bf16x8*)(wp + 16 * WR_STRIDE + 32 * s_);
                const bf16x8 wl0 = *(const LAS bf16x8*)(wp + 32 * WR_STRIDE + 32 * s_), wl1 = *(const LAS bf16x8*)(wp + 48 * WR_STRIDE + 32 * s_);
                acc0 = __builtin_amdgcn_mfma_f32_16x16x32_bf16(wh0, bhi, acc0, 0, 0, 0); acc1 = __builtin_amdgcn_mfma_f32_16x16x32_bf16(wh1, bhi, acc1, 0, 0, 0);
                acc0 = __builtin_amdgcn_mfma_f32_16x16x32_bf16(wh0, blo, acc0, 0, 0, 0); acc1 = __builtin_amdgcn_mfma_f32_16x16x32_bf16(wh1, blo, acc1, 0, 0, 0);
                acc0 = __builtin_amdgcn_mfma_f32_16x16x32_bf16(wl0, bhi, acc0, 0, 0, 0); acc1 = __builtin_amdgcn_mfma_f32_16x16x32_bf16(wl1, bhi, acc1, 0, 0, 0);
            } }
        float cand[8]; int eid[8];
        { const f32x4 br0 = *(const GAS f32x4*)(F.in[I_B_ROUTER] + 4 * fq), br1 = *(const GAS f32x4*)(F.in[I_B_ROUTER] + 16 + 4 * fq);
#pragma unroll
            for (int r = 0; r < 4; ++r) { cand[r] = acc0[r] + br0[r]; cand[4 + r] = acc1[r] + br1[r]; eid[r] = 4 * fq + r; eid[4 + r] = 16 + 4 * fq + r; } }
        float tv[TOPK]; int te[TOPK];
#pragma unroll
        for (int k = 0; k < TOPK; ++k) {
            float bv = cand[0]; int bi = eid[0];
#pragma unroll
            for (int r = 1; r < 8; ++r) if (cand[r] > bv) { bv = cand[r]; bi = eid[r]; }
#pragma unroll
            for (int o = 16; o <= 32; o <<= 1) { const float ov = __shfl_xor(bv, o); const int oi = __shfl_xor(bi, o); if (ov > bv || (ov == bv && oi < bi)) { bv = ov; bi = oi; } }
            tv[k] = bv; te[k] = bi;
#pragma unroll
            for (int r = 0; r < 8; ++r) if (eid[r] == bi) cand[r] = -INFINITY;
        }
        float pe[TOPK], ps = 0.f;
#pragma unroll
        for (int k = 0; k < TOPK; ++k) { pe[k] = __expf(tv[k] - tv[0]); ps += pe[k]; }
        if (fq == 0) {
#pragma unroll
            for (int k = 0; k < TOPK; ++k) { const int lr = __hip_atomic_fetch_add(lcnt + te[k], 1, __ATOMIC_RELAXED, __HIP_MEMORY_SCOPE_WORKGROUP);
                LAS int* r = rec + ((F.wave * 16 + fr) * 4 + k) * 4; r[0] = te[k]; r[1] = lr; r[2] = __builtin_bit_cast(int, pe[k] / ps); r[3] = m0 + fr; } }
        LDS_WAIT(); __syncthreads();
        if (F.tid < NE) lcnt[32 + F.tid] = (int)__hip_atomic_fetch_add(F.ctl + CW_ECNT + 64 * F.tid, (unsigned)lcnt[F.tid], RLX_AGENT);
        LDS_WAIT(); __syncthreads();
        { const LAS int* r = rec + (F.wave * 64 + F.lane) * 4; const int e = r[0], pos = lcnt[32 + e] + r[1], tok = r[3];
            if (pos < LCAP) { ltok[e * LCAP + pos] = tok; lgate[e * LCAP + pos] = __builtin_bit_cast(float, r[2]); } sidx[tok * 4 + (F.lane & 3)] = e * LCAP + pos; }
        __syncthreads();
        if (F.tid < 64) lcnt[F.tid] = 0;
        LDS_WAIT(); __syncthreads();
    }
}
__device__ __forceinline__ void final_phase(Frame& F, const LAS int* tb) {
    const int gw = F.vcu * NWAVES + F.wave, NGW = F.G * NWAVES;
    const int* sidx = (const int*)(F.ws + WS_SIDX); const unsigned char* YS = F.ws + WS_YS;
    typedef float f32x2v __attribute__((ext_vector_type(2)));
    for (int m = gw; m < M; m += NGW) { f32x4 v[4]; load_row_bf16(v, (const bf16*)(F.ws + WS_HB2) + (size_t)m * D, F.lane);
#pragma unroll
        for (int j = 0; j < 4; ++j) v[j] = v[j] * DN_ALPHA;
        f32x4 s[4];
#pragma unroll
        for (int j = 0; j < 4; ++j) s[j] = (f32x4){0.f, 0.f, 0.f, 0.f};
#pragma unroll
        for (int k = 0; k < TOPK; ++k) { const int si = sidx[m * 4 + k], e = si / LCAP, pos = si - e * LCAP; const size_t slot = (size_t)tb[e] * 256 + pos;
            const GAS unsigned* yp = (const GAS unsigned*)(YS + slot * D) + F.lane;
#pragma unroll
            for (int j = 0; j < 4; ++j) { const unsigned w = yp[64 * j]; const f32x2v lo = __builtin_amdgcn_cvt_pk_f32_fp8((int)w, false), hi = __builtin_amdgcn_cvt_pk_f32_fp8((int)w, true);
                s[j] = s[j] + (f32x4){lo.x, lo.y, hi.x, hi.y}; } }
#pragma unroll
        for (int j = 0; j < 4; ++j) v[j] = v[j] + s[j] * (1.0f / YS_SC);
        ln_row(v, F.in[I_LN3_G], F.in[I_LN3_B], F.lane); store_row_f32(v, F.hf + (size_t)m * D, F.lane); }
}

struct Args { const float* in[N_IN]; float* out; unsigned char* ws; int ph_lo, ph_hi, li, pad; };
__global__ void __launch_bounds__(NWAVES * 64, 2) mk_fwd(Args args) {
    extern __shared__ __attribute__((aligned(16))) unsigned char lds[];
    Frame F;
    F.lds = (LAS unsigned char*)lds; F.MISC = (volatile LAS unsigned*)(F.lds + MISC_OFF);
    F.tid = threadIdx.x; F.lane = F.tid & 63; F.wave = __builtin_amdgcn_readfirstlane(F.tid >> 6);
    F.G = gridDim.x; { const int bx = blockIdx.x; F.vcu = (F.G % 8 == 0) ? (bx % 8) * (F.G / 8) + bx / 8 : bx; }
    F.ws = args.ws; F.ctl = (gu32*)(args.ws + WS_CTL); F.hf = args.out; F.in = args.in;
    for (int u = F.tid; u < (LDS_BYTES - LDSCTL_OFF) / 4; u += NWAVES * 64) ((LAS unsigned*)(F.lds + LDSCTL_OFF))[u] = 0u;
    __syncthreads();
    XcdBarrier bar; bar.bar = (unsigned*)(F.ctl + CW_BAR) + args.li * XCD_BAR_WORDS; bar.x = 0; bar.st = nullptr;
    const int lo = args.ph_lo, hi = args.ph_hi;
    if (hi - lo > 1) bar = xcd_barrier_post((unsigned*)(F.ctl + CW_BAR) + args.li * XCD_BAR_WORDS, F.MISC + 8);
#ifndef PH_MASK
#define PH_MASK 0xfff
#endif
#define IN(k) (((PH_MASK >> (k)) & 1) && lo <= (k) && (k) < hi)
#ifndef REP_MASK
#define REP_MASK 0
#endif
#define REPS(k) (1 + ((REP_MASK >> (k)) & 1))
#define PH_BEGIN() do { int t_ = threadIdx.x; asm volatile("" : "+v"(t_)); F.tid = t_; F.lane = t_ & 63; } while (0)
#define SEAM(k) do { if (IN(k) && IN((k) + 1)) xcd_barrier(bar); } while (0)
    const char* wsb = (const char*)args.ws;
    LAS int* tb = (LAS int*)(F.lds + TB_OFF);

    if (IN(0)) for (int rep = 0; rep < REPS(0); ++rep) { PH_BEGIN(); p0_prologue(F); __syncthreads(); } SEAM(0);
    if (IN(1)) for (int rep = 0; rep < REPS(1); ++rep) { PH_BEGIN(); SchedP1 S{F.G, (int)blockIdx.x}; EpiP1 E{F.ws, F.in[I_B_IN]};
        pg8::gemm_phase<EpiP1, SchedP1, false>(F.lds + RING_OFF, wsb, D, D, D, S, E, nullptr); } SEAM(1);
    if (IN(2)) for (int rep = 0; rep < REPS(2); ++rep) { PH_BEGIN();
        if (!(args.pad & 1)) conv_phase(F);
        if (args.pad & 2) continue;
        const int gw = F.vcu * NWAVES + F.wave;
        if (F.wave < 5) { if (!(args.pad & 8)) for (int tk = F.vcu * 5 + F.wave; tk < NB * SBH * (T_ / 32); tk += F.G * 5) sb_attn_wave(F, (tk >> 7) >> 3, (tk >> 7) & 7, tk & 127); }
        else if (!(args.pad & 4)) expert_stream(F, F.vcu * 3 + (F.wave - 5), F.G * 3, F.lds + RING_OFF + F.wave * 16384);
    } SEAM(2);
    if (IN(3)) { PH_BEGIN(); SchedPlain S{F.G, (int)blockIdx.x, 128, 4, (unsigned)WS_MIXIN, (unsigned)WS_WOUT_T, TSTEP, TSTEP, 0u, 0u, 0u}; EpiBf16 E{(bf16*)(F.ws + WS_QM), D, 1.0f, F.in[I_B_OUT]};
        pg8::gemm_phase<EpiBf16, SchedPlain, false>(F.lds + RING_OFF, wsb, D, D, D, S, E, nullptr); } SEAM(3);
    if (IN(4)) { PH_BEGIN();
        { SchedKV S{F.G == 256 ? F.vcu : (int)blockIdx.x}; EpiP1 E{F.ws, F.in[I_B_IN]};
            pg8::gemm_phase<EpiP1, SchedKV, false>(F.lds + RING_OFF, wsb, D, D, D, S, E, nullptr); }
        __syncthreads();
        ln_phase(F, F.in[I_LN1_G], F.in[I_LN1_B]); } SEAM(4);
    if (IN(5)) { PH_BEGIN(); SchedPlain S{F.G, (int)blockIdx.x, 128, 4, (unsigned)WS_HB8, (unsigned)WS_WQ_T, TSTEP / 2, TSTEP / 2, 0u, 0u, 0u}; EpiBf16 E{(bf16*)(F.ws + WS_QM), D, MEM_QSCALE / WQ_SC, nullptr};
        pg8::gemm_phase<EpiBf16, SchedPlain, false, true>(F.lds + RING_OFF, wsb, D / 2, D / 2, D / 2, S, E, nullptr); } SEAM(5);
    if (IN(6)) { PH_BEGIN(); xattn_phase(F); } SEAM(6);
    if (IN(7)) { PH_BEGIN(); SchedPlain S{F.G, (int)blockIdx.x, 128, 4, (unsigned)WS_OB, (unsigned)WS_WO_T, TSTEP / 2, TSTEP / 2, 0u, 0u, 0u}; EpiBf16 E{(bf16*)(F.ws + WS_QM), D, 1.0f / (WO_SC * OB_SC), nullptr};
        pg8::gemm_phase<EpiBf16, SchedPlain, false, true>(F.lds + RING_OFF, wsb, D / 2, D / 2, D / 2, S, E, nullptr); } SEAM(7);
    if (IN(8)) { PH_BEGIN(); ln2_router_phase(F); } SEAM(8);
    if (IN(9)) for (int rep = 0; rep < REPS(9); ++rep) { PH_BEGIN(); moe_table(F, tb); moe_units(F, tb, tb + 704, 8, (unsigned)WS_HB8, (unsigned)WS_WGU_T, 2048u * 1024u, true);
        SchedMoe S{tb + 704}; EpiAct E{F.ws + WS_ACT, F.in[I_B_GU]};
        pg8::gemm_phase<EpiAct, SchedMoe, true, true>(F.lds + RING_OFF, wsb, D / 2, D / 2, D / 2, S, E, (const int*)(F.ws + WS_LTOK)); } SEAM(9);
    if (IN(10)) for (int rep = 0; rep < REPS(10); ++rep) { PH_BEGIN(); moe_table(F, tb); moe_units(F, tb, tb + 704, 4, (unsigned)WS_ACT, (unsigned)WS_WDN_T, 1024u * 1024u, false);
        SchedMoe S{tb + 704}; EpiDown E{F.ws + WS_YS, F.in[I_B_DOWN], (const float*)(F.ws + WS_LGATE)};
        pg8::gemm_phase<EpiDown, SchedMoe, false, true>(F.lds + RING_OFF, wsb, D / 2, D / 2, D / 2, S, E, nullptr); } SEAM(10);
    if (IN(11)) { PH_BEGIN(); moe_table(F, tb); final_phase(F, tb); }
#undef IN
#undef SEAM
}

extern "C" void kernel_launch(void* const* d_in, const int* in_sizes, int n_in, void* d_out, int out_size, void* d_ws, size_t ws_size, hipStream_t stream) {
    static int grid = 0;
    if (grid == 0) {
        if (n_in != N_IN || out_size != M * D || ws_size < WS_END) { fprintf(stderr, "kernel_launch: unexpected shapes (n_in %d, out %d, ws %zu)\n", n_in, out_size, ws_size); grid = -1; return; }
        int dev = 0, cus = 0, per_cu = 0;
        if (hipGetDevice(&dev) != hipSuccess || hipDeviceGetAttribute(&cus, hipDeviceAttributeMultiprocessorCount, dev) != hipSuccess) { grid = -1; return; }
        if (hipFuncSetAttribute((const void*)mk_fwd, hipFuncAttributeMaxDynamicSharedMemorySize, LDS_BYTES) != hipSuccess) { fprintf(stderr, "kernel_launch: hipFuncSetAttribute failed\n"); grid = -1; return; }
        if (hipOccupancyMaxActiveBlocksPerMultiprocessor(&per_cu, (const void*)mk_fwd, NWAVES * 64, LDS_BYTES) != hipSuccess || per_cu < 1) fprintf(stderr, "kernel_launch: occupancy query says %d\n", per_cu);
        (void)hipGetLastError();
        grid = cus;
    }
    if (grid < 0) return;
    if (hipMemsetAsync((char*)d_ws + WS_CTL, 0, CTL_ZERO_BYTES, stream) != hipSuccess) return;
    Args a{};
    for (int i = 0; i < N_IN; ++i) a.in[i] = (const float*)d_in[i];
    a.out = (float*)d_out; a.ws = (unsigned char*)d_ws;
#ifdef PROBE_P2
    { a.ph_lo = 0; a.ph_hi = 3; a.li = 0; hipLaunchKernelGGL(mk_fwd, dim3(grid), dim3(NWAVES * 64), LDS_BYTES, stream, a);
      a.ph_lo = 2; a.ph_hi = 3; a.li = 1; a.pad = PROBE_P2; hipLaunchKernelGGL(mk_fwd, dim3(grid), dim3(NWAVES * 64), LDS_BYTES, stream, a); a.pad = 0;
      a.ph_lo = 3; a.ph_hi = NPHASE; a.li = 2; hipLaunchKernelGGL(mk_fwd, dim3(grid), dim3(NWAVES * 64), LDS_BYTES, stream, a); return; }
#endif
    for (int li = 0; li < MK_N_LAUNCHES; ++li) {
        a.ph_lo = (MK_N_LAUNCHES == 1) ? 0 : li; a.ph_hi = (MK_N_LAUNCHES == 1) ? NPHASE : li + 1; a.li = (MK_N_LAUNCHES == 1) ? 0 : li;
        hipLaunchKernelGGL(mk_fwd, dim3(grid), dim3(NWAVES * 64), LDS_BYTES, stream, a);
        if (hipPeekAtLastError() != hipSuccess) { fprintf(stderr, "kernel_launch: launch %d failed\n", li); break; }
    }
#ifdef PROBE_PHASES
    { const int pp[] = {PROBE_PHASES}; for (int ph : pp) { a.ph_lo = ph; a.ph_hi = ph + 1; a.li = 15; hipLaunchKernelGGL(mk_fwd, dim3(grid), dim3(NWAVES * 64), LDS_BYTES, stream, a); } }
#endif
}
```

```cpp
#include <hip/hip_runtime.h>
#include <cstdio>
#include <cstdint>

#ifndef MK_N_LAUNCHES
#define MK_N_LAUNCHES 1
#endif

#define GAS __attribute__((address_space(1)))
#define LAS __attribute__((address_space(3)))
typedef unsigned short bf16;
typedef short bf16x8 __attribute__((ext_vector_type(8)));
typedef float f32x4 __attribute__((ext_vector_type(4)));
typedef float f32x2 __attribute__((ext_vector_type(2)));
typedef unsigned u32x4 __attribute__((ext_vector_type(4)));
typedef unsigned u32x2 __attribute__((ext_vector_type(2)));
typedef GAS unsigned gu32;
#define RLX_AGENT __ATOMIC_RELAXED, __HIP_MEMORY_SCOPE_AGENT
#define LDS_WAIT() asm volatile("s_waitcnt lgkmcnt(0)" ::: "memory")
#define VM_WAIT() asm volatile("s_waitcnt vmcnt(0)" ::: "memory")

constexpr int NB = 8, T_ = 4096, D = 1024, M = NB * T_, NMEM = 256, MM = NB * NMEM;
constexpr int CONV_CH = 512, SBH = 8, SBD = 64, SBW = 512, CWID = 31, NE = 32, TOPK = 4, DFF = 1024;
constexpr int INC = 2560;
constexpr float LN_EPS = 1e-5f;
constexpr float DN_ALPHA = 1.189207115002721f;
constexpr float LOG2E = 1.4426950408889634f;
constexpr float SB_QSCALE = 0.125f * LOG2E;
constexpr float MEM_QSCALE = 0.0625f * LOG2E;
constexpr float WGU_SC = 32.0f, WDN_SC = 64.0f, WQ_SC = 32.0f, WO_SC = 64.0f, OB_SC = 16.0f, YS_SC = 16.0f;
constexpr float WGU_SC_UNUSED = 0.f;
constexpr int NBLK_MAX = M * TOPK / 256 + NE;
constexpr int LCAP = M;

constexpr size_t MiB = 1u << 20;
constexpr size_t WS_CTL = 0, CTL_ZERO_BYTES = 1 * MiB;
constexpr size_t WS_WIN_T = 1 * MiB;
constexpr size_t WS_WOUT_T = 6 * MiB;
constexpr size_t WS_WQ_T = 8 * MiB, WS_WK_T = 10 * MiB, WS_WV_T = 12 * MiB, WS_WO_T = 14 * MiB;
constexpr size_t WS_WGU_T = 16 * MiB;
constexpr size_t WS_WDN_T = 144 * MiB;
constexpr size_t WS_HB8 = 176 * MiB;
constexpr size_t WS_HB = 208 * MiB;
constexpr size_t WS_LTOK = 272 * MiB;
constexpr size_t WS_LGATE = 276 * MiB;
constexpr size_t WS_SIDX = 280 * MiB;
constexpr size_t WS_WR = 281 * MiB;
constexpr size_t WS_HB2 = 832 * MiB;
constexpr size_t WS_X = 288 * MiB;
constexpr size_t WS_U = WS_X;
constexpr size_t WS_Q = WS_X + 32 * MiB;
constexpr size_t WS_K = WS_X + 64 * MiB;
constexpr size_t WS_V = WS_X + 96 * MiB;
constexpr size_t WS_MIXIN = WS_X + 128 * MiB;
constexpr size_t WS_QM = WS_X + 192 * MiB;
constexpr size_t WS_SP = WS_X + 256 * MiB;
constexpr size_t WS_OB = WS_X + 320 * MiB;
constexpr size_t WS_MEMN = WS_X + 384 * MiB;
constexpr size_t WS_KM = WS_X + 388 * MiB;
constexpr size_t WS_VMT = WS_X + 392 * MiB;
constexpr size_t WS_ACT = WS_X;
constexpr size_t WS_YS = WS_X + 272 * MiB;
constexpr size_t WS_END = 896 * MiB;
constexpr int CW_TMO = 0, CW_CODE = 1;
constexpr int CW_BAR = 4096;
constexpr int CW_ECNT = 131072;
constexpr int NPHASE = 12;

constexpr int RING_OFF = 0, RING_BYTES = 131072;
constexpr int LDS_BYTES = 163840;
constexpr int LDSCTL_OFF = LDS_BYTES - 1024, MISC_OFF = LDSCTL_OFF + 320;
constexpr int XTRA_OFF = RING_BYTES;
constexpr int TB_OFF = XTRA_OFF + 20480;
constexpr int WR_STRIDE = 1032;
constexpr int P10_WR = 0, P10_GB = 2 * 32 * WR_STRIDE * 2, P10_LCNT = P10_GB + 8192, P10_REC = P10_LCNT + 512;
static_assert(P10_REC + 8192 <= TB_OFF && TB_OFF + 4 * (704 + 8 * 40) <= LDSCTL_OFF, "LDS map");
constexpr int NWAVES = 8;

__device__ __forceinline__ unsigned f2bf(float f) { unsigned u = __builtin_bit_cast(unsigned, f); return (u + 0x7fffu + ((u >> 16) & 1u)) >> 16; }
__device__ __forceinline__ unsigned pk2(float lo, float hi) { return f2bf(lo) | (f2bf(hi) << 16); }
__device__ __forceinline__ float bflo(unsigned u) { return __builtin_bit_cast(float, u << 16); }
__device__ __forceinline__ float bfhi(unsigned u) { return __builtin_bit_cast(float, u & 0xffff0000u); }
__device__ __forceinline__ float wave_sum(float v) {
#pragma unroll
    for (int o = 1; o < 64; o <<= 1) v += __shfl_xor(v, o);
    return v;
}
__device__ __forceinline__ float wave_max(float v) {
#pragma unroll
    for (int o = 1; o < 64; o <<= 1) v = fmaxf(v, __shfl_xor(v, o));
    return v;
}
__device__ __forceinline__ unsigned pk4_fp8(float a, float b, float c, float d) {
    int r = __builtin_amdgcn_cvt_pk_fp8_f32(a, b, 0, false); r = __builtin_amdgcn_cvt_pk_fp8_f32(c, d, r, true); return (unsigned)r; }
__device__ __forceinline__ float sigmoidf_fast(float x) { return __builtin_amdgcn_rcpf(1.0f + __expf(-x)); }

namespace pg8 {
constexpr int BM = 256, BK = 64, HALF = 128, HTB = HALF * BK * 2, STAGE_BYTES = 8 * HTB, NXCD = 8, WGM = 8;
__host__ __device__ __forceinline__ int lds_byte(int r, int c) { const int st = (r >> 4) * 2 + (c >> 5), rr = r & 15, cc = c & 31, ob = rr * 64 + cc * 2; return st * 1024 + (ob ^ (((ob >> 9) & 1) << 5)); }
__host__ __device__ __forceinline__ void stage_rc(int b, int& R, int& C) { const int st = b / 1024, sb = b % 1024, swz = sb ^ (((sb >> 9) & 1) << 5); R = (st >> 1) * 16 + swz / 64; C = (st & 1) * 32 + (swz % 64) / 2; }
__host__ __device__ __forceinline__ int perm32(int rho) { const int n = rho >> 4, i = rho & 15; return 8 * (i >> 2) + 4 * n + (i & 3); }

struct Unit { int pm, pn, z, nvalid; unsigned aoff, boff, goff; };

__device__ __forceinline__ void tile_order(int L, int nM, int nN, int& pm, int& pn) {
    const int nwg = nM * nN; int wgid = L;
    { const int q = nwg / NXCD, r = nwg % NXCD, xcd = wgid % NXCD, off = wgid / NXCD; wgid = (xcd < r ? xcd * (q + 1) : r * (q + 1) + (xcd - r) * q) + off; }
    const int nig = WGM * nN, gid = wgid / nig, fm = gid * WGM, gsz = (nM - fm) < WGM ? (nM - fm) : WGM;
    pm = fm + ((wgid % nig) % gsz); pn = (wgid % nig) / gsz;
}
__device__ __forceinline__ unsigned cvt_pk_bf16(float lo, float hi) { unsigned r; asm volatile("v_cvt_pk_bf16_f32 %0, %1, %2" : "=v"(r) : "v"(lo), "v"(hi)); return r; }

__device__ __forceinline__ void store_tile_bf16(const f32x4 (&acc)[2][2][4][2], bf16* p0, size_t ldc, const float* bias, float scale, int wc, int fq) {
    const int cl = wc * 32 + 8 * fq;
    f32x4 bv[2][2];
#pragma unroll
    for (int bj = 0; bj < 2; ++bj)
#pragma unroll
        for (int n = 0; n < 2; ++n) bv[bj][n] = bias ? *(const f32x4*)(bias + cl + bj * HALF + 4 * n) : (f32x4){0.f, 0.f, 0.f, 0.f};
#pragma unroll
    for (int ai = 0; ai < 2; ++ai)
#pragma unroll
        for (int m = 0; m < 4; ++m) { bf16* rowp = p0 + (size_t)(ai * HALF + m * 16) * ldc + cl;
#pragma unroll
            for (int bj = 0; bj < 2; ++bj) { const f32x4 v0 = (acc[ai][bj][m][0] + bv[bj][0]) * scale, v1 = (acc[ai][bj][m][1] + bv[bj][1]) * scale;
                u32x4 w; w.x = cvt_pk_bf16(v0[0], v0[1]); w.y = cvt_pk_bf16(v0[2], v0[3]); w.z = cvt_pk_bf16(v1[0], v1[1]); w.w = cvt_pk_bf16(v1[2], v1[3]);
                *(u32x4*)(rowp + bj * HALF) = w; } }
}

typedef int v8i __attribute__((ext_vector_type(8)));
#ifndef PG8_ALIGN
#define PG8_ALIGN true
#endif
template <class Epi, class Sched, bool GATHER, bool FP8 = false, bool ALIGN_EPI = PG8_ALIGN>
__device__ __forceinline__ void gemm_phase(LAS unsigned char* lds, const char* wsb, const int lda, const int ldb, const int K, const Sched& S, const Epi& E, const int* glist) {
    int tid = threadIdx.x; asm volatile("" : "+v"(tid));
    const int wid = __builtin_amdgcn_readfirstlane(tid >> 6), lane = tid & 63, wr = wid >> 2, wc = wid & 3, fr = lane & 15, fq = lane >> 4;
    const int nt = K / BK;
    unsigned voffA[2], voffB[2];
#pragma unroll
    for (int i = 0; i < 2; ++i) { int R, C; stage_rc(tid * 16 + i * 8192, R, C); const int Rb = Epi::PERM ? ((R & ~31) + perm32(R & 31)) : R;
        voffA[i] = (unsigned)(R * lda + C) * 2u; voffB[i] = (unsigned)(Rb * ldb + C) * 2u; }
    const size_t kstep = (size_t)(BK * 2);
    const size_t hstepA = (size_t)HALF * lda * 2, hstepB = (size_t)HALF * ldb * 2;
    const unsigned ldsw = (unsigned)wid * 1024u;
    const int aoff = lds_byte(wr * 64 + fr, fq * 8), boff = lds_byte(wc * 32 + fr, fq * 8);
    unsigned gc[2][2], gn[2][2];
#define PG8_SA(b, h) (((b) * 2 + (h)) * HTB)
#define PG8_SB(b, h) ((4 + (b) * 2 + (h)) * HTB)
#define PG8_STAGE_B(bufoff, gbase) do { _Pragma("unroll") for (int _i = 0; _i < 2; ++_i) \
        __builtin_amdgcn_global_load_lds((const unsigned*)((const char*)(gbase) + voffB[_i]), (LAS unsigned*)(lds + (bufoff) + ldsw + _i * 8192), 16, 0, 0); } while (0)
#define PG8_STAGE_A(bufoff, gbase, h, nx) do { _Pragma("unroll") for (int _i = 0; _i < 2; ++_i) { \
        const char* _p = GATHER ? (const char*)(gbase) + ((nx) ? gn[h][_i] : gc[h][_i]) : (const char*)(gbase) + (h) * hstepA + voffA[_i]; \
        __builtin_amdgcn_global_load_lds((const unsigned*)_p, (LAS unsigned*)(lds + (bufoff) + ldsw + _i * 8192), 16, 0, 0); } } while (0)
#define PG8_LDA(dst, b, h) do { _Pragma("unroll") for (int m = 0; m < 4; ++m) { if constexpr (FP8) { const u32x4 _lo = *(const LAS u32x4*)(lds + PG8_SA(b, h) + aoff + m * 2048), _hi = *(const LAS u32x4*)(lds + PG8_SA(b, h) + aoff + m * 2048 + 1024); \
            dst##8[m] = (v8i){(int)_lo.x, (int)_lo.y, (int)_lo.z, (int)_lo.w, (int)_hi.x, (int)_hi.y, (int)_hi.z, (int)_hi.w}; } \
        else { _Pragma("unroll") for (int k = 0; k < 2; ++k) dst[m][k] = *(const LAS bf16x8*)(lds + PG8_SA(b, h) + aoff + m * 2048 + k * 1024); } } } while (0)
#define PG8_LDB(dst, b, h) do { _Pragma("unroll") for (int n = 0; n < 2; ++n) { if constexpr (FP8) { const u32x4 _lo = *(const LAS u32x4*)(lds + PG8_SB(b, h) + boff + n * 2048), _hi = *(const LAS u32x4*)(lds + PG8_SB(b, h) + boff + n * 2048 + 1024); \
            dst##8[n] = (v8i){(int)_lo.x, (int)_lo.y, (int)_lo.z, (int)_lo.w, (int)_hi.x, (int)_hi.y, (int)_hi.z, (int)_hi.w}; } \
        else { _Pragma("unroll") for (int k = 0; k < 2; ++k) dst[n][k] = *(const LAS bf16x8*)(lds + PG8_SB(b, h) + boff + n * 2048 + k * 1024); } } } while (0)
#define PG8_MMA(ai, bj, At, Bt) do { __builtin_amdgcn_s_setprio(1); if constexpr (FP8) asm volatile("s_nop 1"); _Pragma("unroll") for (int m = 0; m < 4; ++m) _Pragma("unroll") for (int n = 0; n < 2; ++n) { \
        if constexpr (FP8) asm volatile("v_mfma_f32_16x16x128_f8f6f4 %0, %1, %2, %0" : "+v"(acc[ai][bj][m][n]) : "v"(Bt##8[n]), "v"(At##8[m])); \
        else { _Pragma("unroll") for (int k = 0; k < 2; ++k) acc[ai][bj][m][n] = __builtin_amdgcn_mfma_f32_16x16x32_bf16(Bt[n][k], At[m][k], acc[ai][bj][m][n], 0, 0, 0); } } \
        __builtin_amdgcn_s_setprio(0); } while (0)
#define PG8_WAIT_V(n) asm volatile("s_waitcnt vmcnt(" #n ")" ::: "memory")
#define PG8_WAIT_L(n) asm volatile("s_waitcnt lgkmcnt(" #n ")" ::: "memory")
#define PG8_BAR __builtin_amdgcn_s_barrier()
#define PG8_SCHED __builtin_amdgcn_sched_barrier(0)
#define PG8_GIDX(g, u) do { _Pragma("unroll") for (int _h = 0; _h < 2; ++_h) _Pragma("unroll") for (int _i = 0; _i < 2; ++_i) { int _R, _C; stage_rc(tid * 16 + _i * 8192, _R, _C); const int _r = _h * HALF + _R; \
        const int _tok = glist[(u).goff + (_r < (u).nvalid ? _r : (u).nvalid - 1)]; g[_h][_i] = (unsigned)_tok * (unsigned)(lda * 2) + (unsigned)(_C * 2); } } while (0)
    Unit cur, nxt, nn; int ui = 0;
    if (!S.next(0, cur)) return;
    f32x4 acc[2][2][4][2];
#pragma unroll
    for (int a = 0; a < 2; ++a)
#pragma unroll
        for (int b = 0; b < 2; ++b)
#pragma unroll
            for (int m = 0; m < 4; ++m)
#pragma unroll
                for (int n = 0; n < 2; ++n) acc[a][b][m][n] = (f32x4){0.f, 0.f, 0.f, 0.f};
    bf16x8 At[4][2], B0[2][2], B1[2][2];
    v8i At8[4], B08[2], B18[2];
    const char* cA = wsb + cur.aoff; const char* cB = wsb + cur.boff;
    if constexpr (GATHER) { PG8_GIDX(gc, cur); if (S.next(1, nxt)) { PG8_GIDX(gn, nxt); } else { PG8_GIDX(gn, cur); }
        asm volatile("s_waitcnt vmcnt(0)" : "+v"(gc[0][0]), "+v"(gc[0][1]), "+v"(gc[1][0]), "+v"(gc[1][1]), "+v"(gn[0][0]), "+v"(gn[0][1]), "+v"(gn[1][0]), "+v"(gn[1][1]) :: "memory"); }
    else {
#pragma unroll
        for (int h = 0; h < 2; ++h)
#pragma unroll
            for (int i = 0; i < 2; ++i) { gc[h][i] = 0u; gn[h][i] = 0u; } }
    PG8_STAGE_B(PG8_SB(0, 0), cB); PG8_STAGE_B(PG8_SB(0, 1), cB + hstepB); PG8_STAGE_A(PG8_SA(0, 0), cA, 0, false); PG8_STAGE_A(PG8_SA(0, 1), cA, 1, false);
    if (wr == 1) PG8_BAR;
    PG8_WAIT_V(2); PG8_BAR;
    PG8_STAGE_B(PG8_SB(1, 0), cB + kstep); PG8_STAGE_A(PG8_SA(1, 0), cA + kstep, 0, false); PG8_STAGE_B(PG8_SB(1, 1), cB + hstepB + kstep);
    PG8_WAIT_V(6); PG8_BAR;
    for (;;) {
        const bool has_next = S.next(ui + 1, nxt);
        const char* nA = has_next ? wsb + nxt.aoff : cA; const char* nB = has_next ? wsb + nxt.boff : cB;
#pragma clang loop unroll(disable)
        for (int t = 0; t < nt; t += 2) {
            const bool last = (t == nt - 2);
            const char* a1 = cA + (size_t)(t + 1) * kstep;
            const char* a2 = last ? nA : cA + (size_t)(t + 2) * kstep; const char* b2 = last ? nB : cB + (size_t)(t + 2) * kstep;
            const char* a3 = a2 + kstep; const char* b3 = b2 + kstep;
            PG8_LDB(B0, 0, 0); PG8_LDB(B1, 0, 1); PG8_SCHED; PG8_LDA(At, 0, 0); PG8_STAGE_A(PG8_SA(1, 1), a1, 1, false);
            PG8_WAIT_V(8); PG8_WAIT_L(0); PG8_BAR; PG8_MMA(0, 0, At, B0); PG8_MMA(0, 1, At, B1); PG8_BAR; PG8_SCHED;
            PG8_LDA(At, 0, 1); PG8_STAGE_B(PG8_SB(0, 0), b2); PG8_STAGE_B(PG8_SB(0, 1), b2 + hstepB); PG8_STAGE_A(PG8_SA(0, 0), a2, 0, last);
            PG8_WAIT_V(8); PG8_WAIT_L(0); PG8_BAR; PG8_MMA(1, 0, At, B0); PG8_MMA(1, 1, At, B1); PG8_BAR; PG8_SCHED;
            PG8_LDB(B0, 1, 0); PG8_LDB(B1, 1, 1); PG8_SCHED; PG8_LDA(At, 1, 0); PG8_STAGE_A(PG8_SA(0, 1), a2, 1, last);
            PG8_WAIT_V(8); PG8_WAIT_L(0); PG8_BAR; PG8_MMA(0, 0, At, B0); PG8_MMA(0, 1, At, B1); PG8_BAR; PG8_SCHED;
            PG8_LDA(At, 1, 1); PG8_STAGE_B(PG8_SB(1, 0), b3); PG8_STAGE_B(PG8_SB(1, 1), b3 + hstepB); PG8_STAGE_A(PG8_SA(1, 0), a3, 0, last);
            PG8_WAIT_V(8); PG8_WAIT_L(0); PG8_BAR; PG8_MMA(1, 0, At, B0); PG8_MMA(1, 1, At, B1); PG8_BAR; PG8_SCHED;
        }
        if constexpr (FP8) asm volatile("s_nop 15\n\ts_nop 7");
        if constexpr (ALIGN_EPI) { if (wr == 0) PG8_BAR; }
        if constexpr (GATHER) {
#pragma unroll
            for (int h = 0; h < 2; ++h)
#pragma unroll
                for (int i = 0; i < 2; ++i) gc[h][i] = gn[h][i];
            if (has_next && S.next(ui + 2, nn)) { PG8_GIDX(gn, nn); }
        }
        E(acc, cur, wr, wc, fr, fq);
        if constexpr (GATHER) asm volatile("" : "+v"(gn[0][0]), "+v"(gn[0][1]), "+v"(gn[1][0]), "+v"(gn[1][1]));
        if (!has_next) break;
#pragma unroll
        for (int a = 0; a < 2; ++a)
#pragma unroll
            for (int b = 0; b < 2; ++b)
#pragma unroll
                for (int m = 0; m < 4; ++m)
#pragma unroll
                    for (int n = 0; n < 2; ++n) acc[a][b][m][n] = (f32x4){0.f, 0.f, 0.f, 0.f};
        cur = nxt; cA = nA; cB = nB; ++ui;
        if constexpr (ALIGN_EPI) { if (wr == 1) PG8_BAR; }
    }
    PG8_WAIT_V(0);
    if constexpr (!ALIGN_EPI) { if (wr == 0) PG8_BAR; }
    PG8_BAR;
#undef PG8_SA
#undef PG8_SB
#undef PG8_STAGE_A
#undef PG8_STAGE_B
#undef PG8_LDA
#undef PG8_LDB
#undef PG8_MMA
#undef PG8_WAIT_V
#undef PG8_WAIT_L
#undef PG8_BAR
#undef PG8_SCHED
#undef PG8_GIDX
}
}
using pg8::Unit;

#define XB_TMO      128
#define XB_XCNT(j)  (256  + 64 * (j))
#define XB_XSUB(j)  (1280 + 64 * (j))
#define XB_XGEN(j)  (2304 + 64 * (j))
#define XB_TOP      3328
#define XB_TOPGEN   3392
#define XCD_BAR_WORDS 3456
#define XB_SPIN_CAP (1u << 18)
__device__ __forceinline__ unsigned xb_ld(unsigned* p)              { return __hip_atomic_load(p, __ATOMIC_RELAXED, __HIP_MEMORY_SCOPE_AGENT); }
__device__ __forceinline__ unsigned xb_add(unsigned* p, unsigned v) { return __hip_atomic_fetch_add(p, v, __ATOMIC_RELAXED, __HIP_MEMORY_SCOPE_AGENT); }
__device__ __forceinline__ unsigned xb_xcc_id() { return (unsigned)__builtin_amdgcn_s_getreg((3 << 11) | 20) & 0xFu; }
#define XB_SPIN(cond, bar) do { unsigned _sp = 0; while (cond) { __builtin_amdgcn_s_sleep(1); \
    if ((++_sp & 255u) == 0u) { if (xb_ld(&(bar)[XB_TMO])) break; if (_sp > XB_SPIN_CAP) { atomicAdd(&(bar)[XB_TMO], 1u); break; } } } } while (0)
struct XcdBarrier { unsigned* bar; unsigned x; volatile LAS unsigned* st; };
__device__ __forceinline__ XcdBarrier xcd_barrier_post(unsigned* bar, volatile LAS unsigned* st) {
    XcdBarrier b; b.bar = bar; b.x = xb_xcc_id(); b.st = st;
    if (threadIdx.x == 0) (void)xb_add(&bar[XB_XCNT(b.x)], 1u);
    return b;
}
__device__ __forceinline__ void xcd_barrier_complete(unsigned* bar, unsigned x, unsigned& nloc, unsigned& nx) {
    const unsigned G = gridDim.x * gridDim.y * gridDim.z;
    unsigned sum, cnt, mine, sp = 0u;
    for (;;) {
        sum = 0u; cnt = 0u; mine = 0u;
#pragma unroll
        for (unsigned j = 0; j < 16; ++j) { const unsigned c = xb_ld(&bar[XB_XCNT(j)]); sum += c; cnt += (c > 0u) ? 1u : 0u; mine = (j == x) ? c : mine; }
        if (sum == G) break;
        __builtin_amdgcn_s_sleep(1);
        if ((++sp & 255u) == 0u) { if (xb_ld(&bar[XB_TMO])) break; if (sp > XB_SPIN_CAP) { atomicAdd(&bar[XB_TMO], 1u); break; } }
    }
    nloc = mine > 0u ? mine : 1u; nx = cnt > 0u ? cnt : 1u;
}
__device__ __forceinline__ void xcd_barrier(const XcdBarrier& b) {
    asm volatile("s_waitcnt vmcnt(0)" ::: "memory");
    __syncthreads();
    if (threadIdx.x == 0) {
        unsigned* bar = b.bar;
        __builtin_amdgcn_s_waitcnt(0);
        unsigned nloc = b.st[0], nx = b.st[1];
        if (nloc == 0u) { xcd_barrier_complete(bar, b.x, nloc, nx); b.st[0] = nloc; b.st[1] = nx; }
        const unsigned old = xb_add(&bar[XB_XSUB(b.x)], 1u);
        const unsigned gen = old / nloc;
        if (old + 1u == (gen + 1u) * nloc) {
            __builtin_amdgcn_fence(__ATOMIC_RELEASE, "agent");
            asm volatile("s_waitcnt vmcnt(0)" ::: "memory");
            const unsigned og = xb_add(&bar[XB_TOP], 1u);
            const unsigned tg = og / nx;
            if (og + 1u == (tg + 1u) * nx) xb_add(&bar[XB_TOPGEN], 1u);
            else XB_SPIN(xb_ld(&bar[XB_TOPGEN]) == tg, bar);
            __builtin_amdgcn_fence(__ATOMIC_ACQUIRE, "agent");
            xb_add(&bar[XB_XGEN(b.x)], 1u);
            asm volatile("s_waitcnt vmcnt(0)" ::: "memory");
        } else {
            XB_SPIN(xb_ld(&bar[XB_XGEN(b.x)]) == gen, bar);
            __builtin_amdgcn_fence(__ATOMIC_ACQUIRE, "agent");
            asm volatile("s_waitcnt vmcnt(0)" ::: "memory");
        }
    }
    __syncthreads();
}

struct Frame {
    LAS unsigned char* lds;
    volatile LAS unsigned* MISC;
    gu32* ctl;
    unsigned char* ws;
    int tid, lane, wave, vcu, G;
    float* hf;
    const float* const* in;
};
enum In { I_X = 0, I_MEM, I_LN_IN_G, I_LN_IN_B, I_LN_MEM_G, I_LN_MEM_B, I_W_IN, I_B_IN, I_W_DW, I_B_DW, I_LN_CONV_G, I_LN_CONV_B, I_W_OUT, I_B_OUT, I_LN1_G, I_LN1_B,
          I_WQ, I_WK, I_WV, I_WO, I_LN2_G, I_LN2_B, I_W_ROUTER, I_B_ROUTER, I_W_GU, I_B_GU, I_W_DOWN, I_B_DOWN, I_LN3_G, I_LN3_B, N_IN };

__device__ __forceinline__ void p0_transpose_item(const float* W, int K, int N, bf16* WT, int k0, int n0, int drow, LAS float* scr, int lane) {
#pragma unroll 8
    for (int i = 0; i < 32; ++i) { const int kk = 2 * i + (lane >> 5); scr[kk * 33 + (lane & 31)] = W[(size_t)(k0 + kk) * N + n0 + (lane & 31)]; }
    LDS_WAIT(); asm volatile("" ::: "memory");
    const int c = lane & 7;
#pragma unroll
    for (int j = 0; j < 4; ++j) { const int n = (lane >> 3) + 8 * j; const LAS float* s = scr + (8 * c) * 33 + n;
        u32x4 o; o.x = pk2(s[0 * 33], s[1 * 33]); o.y = pk2(s[2 * 33], s[3 * 33]); o.z = pk2(s[4 * 33], s[5 * 33]); o.w = pk2(s[6 * 33], s[7 * 33]);
        *(GAS u32x4*)(WT + (size_t)(drow + n) * K + k0 + 8 * c) = o; }
    LDS_WAIT(); asm volatile("" ::: "memory");
}
__device__ __forceinline__ void ln_row(f32x4 (&v)[4], const float* g, const float* b, int lane) {
    float s = 0.f;
#pragma unroll
    for (int j = 0; j < 4; ++j) s += (v[j].x + v[j].y) + (v[j].z + v[j].w);
    const float mean = wave_sum(s) * (1.f / D); float s2 = 0.f;
#pragma unroll
    for (int j = 0; j < 4; ++j) { v[j] = v[j] - mean; s2 += (v[j].x * v[j].x + v[j].y * v[j].y) + (v[j].z * v[j].z + v[j].w * v[j].w); }
    const float rstd = 1.f / sqrtf(wave_sum(s2) * (1.f / D) + LN_EPS);
#pragma unroll
    for (int j = 0; j < 4; ++j) { const f32x4 gg = ((const GAS f32x4*)g)[lane + 64 * j], bb = ((const GAS f32x4*)b)[lane + 64 * j]; v[j] = v[j] * rstd * gg + bb; }
}
__device__ __forceinline__ void store_row_bf16(const f32x4 (&v)[4], bf16* orow, int lane) {
    GAS u32x2* o8 = (GAS u32x2*)orow + lane;
#pragma unroll
    for (int j = 0; j < 4; ++j) o8[64 * j] = (u32x2){pk2(v[j].x, v[j].y), pk2(v[j].z, v[j].w)};
}
__device__ __forceinline__ void p0_transpose_item8(const float* W, int K, int N, unsigned char* WT, int k0, int n0, int drow, float sc, LAS float* scr, int lane) {
#pragma unroll 8
    for (int i = 0; i < 32; ++i) { const int kk = 2 * i + (lane >> 5); scr[kk * 33 + (lane & 31)] = W[(size_t)(k0 + kk) * N + n0 + (lane & 31)]; }
    LDS_WAIT(); asm volatile("" ::: "memory");
    const int c = lane & 7;
#pragma unroll
    for (int j = 0; j < 4; ++j) { const int n = (lane >> 3) + 8 * j; const LAS float* s = scr + (8 * c) * 33 + n;
        u32x2 o; o.x = pk4_fp8(s[0 * 33] * sc, s[1 * 33] * sc, s[2 * 33] * sc, s[3 * 33] * sc); o.y = pk4_fp8(s[4 * 33] * sc, s[5 * 33] * sc, s[6 * 33] * sc, s[7 * 33] * sc);
        *(GAS u32x2*)(WT + (size_t)(drow + n) * K + k0 + 8 * c) = o; }
    LDS_WAIT(); asm volatile("" ::: "memory");
}
__device__ __forceinline__ void item8_load(f32x4 (&x)[4][4], const float* W, int N, int k0, int n0, int lane) {
    const int g = lane >> 3, c = lane & 7;
#pragma unroll
    for (int q = 0; q < 4; ++q)
#pragma unroll
        for (int j = 0; j < 4; ++j) x[q][j] = *(const GAS f32x4*)(W + (size_t)(k0 + 32 * q + 4 * g + j) * N + n0 + 4 * c);
}
__device__ __forceinline__ void item8_finish(const f32x4 (&x)[4][4], int K, unsigned char* WT, int k0, int drow, float sc, LAS unsigned char* scr, int lane) {
    const int g = lane >> 3, c = lane & 7;
#pragma unroll
    for (int q = 0; q < 4; ++q)
#pragma unroll
        for (int e = 0; e < 4; ++e) *(LAS unsigned*)(scr + (4 * c + e) * 144 + 32 * q + 4 * g) = pk4_fp8(x[q][0][e] * sc, x[q][1][e] * sc, x[q][2][e] * sc, x[q][3][e] * sc);
    LDS_WAIT(); asm volatile("" ::: "memory");
#pragma unroll
    for (int i = 0; i < 4; ++i) { const int t = lane + 64 * i, n = t >> 3, ch = t & 7;
        *(GAS u32x4*)(WT + (size_t)(drow + n) * K + k0 + 16 * ch) = *(const LAS u32x4*)(scr + n * 144 + 16 * ch); }
    LDS_WAIT(); asm volatile("" ::: "memory");
}
__device__ __forceinline__ void p0_transpose_item8b(const float* W, int K, int N, unsigned char* WT, int k0, int n0, int drow, float sc, LAS unsigned char* scr, int lane) {
    f32x4 x[4][4]; item8_load(x, W, N, k0, n0, lane); item8_finish(x, K, WT, k0, drow, sc, scr, lane);
}
__device__ __forceinline__ void load_row_bf16(f32x4 (&v)[4], const bf16* xrow, int lane) {
    const GAS u32x2* xr = (const GAS u32x2*)xrow + lane;
#pragma unroll
    for (int j = 0; j < 4; ++j) { const u32x2 w = xr[64 * j]; v[j] = (f32x4){bflo(w.x), bfhi(w.x), bflo(w.y), bfhi(w.y)}; }
}
__device__ __forceinline__ void load_row_f32(f32x4 (&v)[4], const float* xrow, int lane) {
    const GAS f32x4* xr = (const GAS f32x4*)xrow + lane;
#pragma unroll
    for (int j = 0; j < 4; ++j) v[j] = xr[64 * j];
}
__device__ __forceinline__ void store_row_f32(const f32x4 (&v)[4], float* orow, int lane) {
    GAS f32x4* o = (GAS f32x4*)orow + lane;
#pragma unroll
    for (int j = 0; j < 4; ++j) o[64 * j] = v[j];
}

constexpr int I_GU = NE * 8 * 64, I_DN = NE * 8 * 32, N_EXPERT_ITEMS = I_GU + I_DN;
struct ExpItem { const float* W; unsigned char* WT; int K, N, k0, n0, drow; float sc; };
__device__ __forceinline__ ExpItem expert_item_decode(Frame& F, int it) {
    ExpItem x;
    if (it < I_GU) { const int e = it / (8 * 64), q = it % (8 * 64), kb = q / 64, nb = q % 64, n0 = 32 * nb;
        x.W = F.in[I_W_GU] + (size_t)e * D * 2 * DFF; x.WT = F.ws + WS_WGU_T + (size_t)e * 2 * DFF * D; x.K = D; x.N = 2 * DFF; x.k0 = 128 * kb; x.n0 = n0;
        x.drow = (n0 < 1024) ? (n0 >> 7) * 256 + (n0 & 127) : ((n0 - 1024) >> 7) * 256 + 128 + (n0 & 127); x.sc = WGU_SC; }
    else { const int r = it - I_GU, e = r / (8 * 32), q = r % (8 * 32), kb = q / 32, nb = q % 32;
        x.W = F.in[I_W_DOWN] + (size_t)e * DFF * D; x.WT = F.ws + WS_WDN_T + (size_t)e * D * DFF; x.K = DFF; x.N = D; x.k0 = 128 * kb; x.n0 = 32 * nb; x.drow = 32 * nb; x.sc = WDN_SC; }
    return x;
}
__device__ __forceinline__ void expert_stream(Frame& F, int sw, int nsw, LAS unsigned char* scr) {
    for (int it = sw; it < N_EXPERT_ITEMS; it += 3 * nsw) {
        const int it2 = it + nsw, it3 = it + 2 * nsw; const bool two = it2 < N_EXPERT_ITEMS, three = it3 < N_EXPERT_ITEMS;
        const ExpItem a = expert_item_decode(F, it), b = expert_item_decode(F, two ? it2 : it), c = expert_item_decode(F, three ? it3 : it);
        f32x4 xa[4][4], xb[4][4], xc[4][4];
        item8_load(xa, a.W, a.N, a.k0, a.n0, F.lane);
        if (two) item8_load(xb, b.W, b.N, b.k0, b.n0, F.lane);
        if (three) item8_load(xc, c.W, c.N, c.k0, c.n0, F.lane);
        item8_finish(xa, a.K, a.WT, a.k0, a.drow, a.sc, scr, F.lane);
        if (two) item8_finish(xb, b.K, b.WT, b.k0, b.drow, b.sc, scr + 5120, F.lane);
        if (three) item8_finish(xc, c.K, c.WT, c.k0, c.drow, c.sc, scr + 10240, F.lane);
    }
}
__device__ __forceinline__ void p0_prologue(Frame& F) {
    LAS float* scr = (LAS float*)(F.lds + RING_OFF + F.wave * 16384);
    const int gw = F.vcu * NWAVES + F.wave, NGW = F.G * NWAVES;
    constexpr int I_IN = 16 * 80, I_SQ = 16 * 32;
    constexpr int NITEMS = I_IN + 3 * I_SQ + 2 * 256;
    for (int it = gw; it < NITEMS; it += NGW) {
        int r = it;
        if (r < I_IN) { const int kb = r / 80, nb = r % 80, n0 = 32 * nb; int drow;
            if (n0 < 512) drow = (n0 >> 7) * 256 + (n0 & 127); else if (n0 < 1024) drow = ((n0 - 512) >> 7) * 256 + 128 + (n0 & 127); else drow = n0;
            p0_transpose_item(F.in[I_W_IN], D, INC, (bf16*)(F.ws + WS_WIN_T), 64 * kb, n0, drow, scr, F.lane); continue; } r -= I_IN;
        if (r < 3 * I_SQ) { const int w = r / I_SQ, q = r % I_SQ, kb = q / 32, nb = q % 32;
            const float* src = F.in[w == 0 ? I_W_OUT : w == 1 ? I_WK : I_WV];
            bf16* dst = (bf16*)(F.ws + (w == 0 ? WS_WOUT_T : w == 1 ? WS_WK_T : WS_WV_T));
            p0_transpose_item(src, D, D, dst, 64 * kb, 32 * nb, 32 * nb, scr, F.lane); continue; } r -= 3 * I_SQ;
        { const int w = r / 256, q = r % 256, kb = q / 32, nb = q % 32;
            p0_transpose_item8b(F.in[w == 0 ? I_WQ : I_WO], D, D, F.ws + (w == 0 ? WS_WQ_T : WS_WO_T), 128 * kb, 32 * nb, 32 * nb, w == 0 ? WQ_SC : WO_SC, (LAS unsigned char*)scr, F.lane); }
    }
    if (gw < 512) { const int idx = gw * 64 + F.lane, c = idx >> 5, e = idx & 31; const float w = F.in[I_W_ROUTER][idx];
        const unsigned hi = f2bf(w), lo = f2bf(w - __builtin_bit_cast(float, hi << 16)); bf16* wr = (bf16*)(F.ws + WS_WR);
        wr[e * WR_STRIDE + c] = (bf16)hi; wr[(32 + e) * WR_STRIDE + c] = (bf16)lo; }
    for (int m = gw; m < M + MM; m += NGW) {
        f32x4 v[4];
        if (m < M) { load_row_f32(v, F.in[I_X] + (size_t)m * D, F.lane); ln_row(v, F.in[I_LN_IN_G], F.in[I_LN_IN_B], F.lane);
            store_row_bf16(v, (bf16*)(F.ws + WS_HB) + (size_t)m * D, F.lane); }
        else { const int mm = m - M; load_row_f32(v, F.in[I_MEM] + (size_t)mm * D, F.lane); ln_row(v, F.in[I_LN_MEM_G], F.in[I_LN_MEM_B], F.lane);
            store_row_bf16(v, (bf16*)(F.ws + WS_MEMN) + (size_t)mm * D, F.lane); }
    }
}

constexpr unsigned TSTEP = 256u * 1024u * 2u;
struct SchedP1 { int G, c;
    __device__ __forceinline__ bool next(int i, Unit& u) const {
        const int L = i * G + c; if (L >= 1280) return false;
        u.nvalid = 256; u.goff = 0;
        if (L < 1024) { pg8::tile_order(L, 128, 8, u.pm, u.pn); u.z = 0; u.aoff = (unsigned)WS_HB + (unsigned)u.pm * TSTEP; u.boff = (unsigned)WS_WIN_T + (unsigned)u.pn * TSTEP; }
        else { const int j = L - 1024; u.pm = j & 1; u.pn = j >> 1; u.z = 3; u.aoff = (unsigned)WS_WIN_T + (unsigned)(8 + u.pm) * TSTEP; u.boff = (unsigned)WS_HB + (unsigned)u.pn * TSTEP; }
        return true; }
};
struct SchedKV { int v;
    __device__ __forceinline__ bool next(int i, Unit& u) const {
        if (i > 0 || v >= 64) return false;
        u.nvalid = 256; u.goff = 0;
        if (v < 32) { u.pm = v & 7; u.pn = v >> 3; u.z = 1; u.aoff = (unsigned)WS_MEMN + (unsigned)u.pm * TSTEP; u.boff = (unsigned)WS_WK_T + (unsigned)u.pn * TSTEP; }
        else { const int j = v - 32; u.pm = j & 3; u.pn = j >> 2; u.z = 2; u.aoff = (unsigned)WS_WV_T + (unsigned)u.pm * TSTEP; u.boff = (unsigned)WS_MEMN + (unsigned)u.pn * TSTEP; }
        return true; }
};
struct EpiP1 { static constexpr bool PERM = true;
    unsigned char* ws; const float* b_in;
    __device__ __forceinline__ void operator()(const f32x4 (&acc)[2][2][4][2], const Unit& u, int wr, int wc, int fr, int fq) const {
        const int row0 = u.pm * 256 + wr * 64 + fr;
        if (u.z == 0) {
            if (u.pn < 4) {
                const int ch = 128 * u.pn + wc * 32 + 8 * fq;
                f32x4 bv[2], bg[2];
#pragma unroll
                for (int n = 0; n < 2; ++n) { bv[n] = *(const f32x4*)(b_in + ch + 4 * n); bg[n] = *(const f32x4*)(b_in + 512 + ch + 4 * n); }
                bf16* U = (bf16*)(ws + WS_U);
#pragma unroll
                for (int ai = 0; ai < 2; ++ai)
#pragma unroll
                    for (int m = 0; m < 4; ++m) { f32x4 o[2];
#pragma unroll
                        for (int n = 0; n < 2; ++n) { const f32x4 a = acc[ai][0][m][n] + bv[n], g = acc[ai][1][m][n] + bg[n];
#pragma unroll
                            for (int j = 0; j < 4; ++j) o[n][j] = a[j] * sigmoidf_fast(g[j]); }
                        u32x4 w; w.x = pg8::cvt_pk_bf16(o[0][0], o[0][1]); w.y = pg8::cvt_pk_bf16(o[0][2], o[0][3]); w.z = pg8::cvt_pk_bf16(o[1][0], o[1][1]); w.w = pg8::cvt_pk_bf16(o[1][2], o[1][3]);
                        *(u32x4*)(U + (size_t)(row0 + ai * 128 + m * 16) * 512 + ch) = w; }
            } else {
                const int t = u.pn - 4, which = t >> 1, cb = (t & 1) * 256;
                bf16* dst = (bf16*)(ws + (which == 0 ? WS_Q : WS_K));
                pg8::store_tile_bf16(acc, dst + (size_t)row0 * 512 + cb, 512, b_in + 1024 + 256 * t, which == 0 ? SB_QSCALE : 1.0f, wc, fq);
            }
        } else if (u.z == 3) {
            const float* rb = b_in + 2048 + row0; bf16* p0 = (bf16*)(ws + WS_V) + (size_t)row0 * M + 256 * u.pn; const int cl = wc * 32 + 8 * fq;
#pragma unroll
            for (int ai = 0; ai < 2; ++ai)
#pragma unroll
                for (int m = 0; m < 4; ++m) { const float bv = rb[ai * 128 + m * 16]; bf16* rowp = p0 + (size_t)(ai * 128 + m * 16) * M + cl;
#pragma unroll
                    for (int bj = 0; bj < 2; ++bj) { const f32x4 v0 = acc[ai][bj][m][0] + bv, v1 = acc[ai][bj][m][1] + bv;
                        u32x4 w; w.x = pg8::cvt_pk_bf16(v0[0], v0[1]); w.y = pg8::cvt_pk_bf16(v0[2], v0[3]); w.z = pg8::cvt_pk_bf16(v1[0], v1[1]); w.w = pg8::cvt_pk_bf16(v1[2], v1[3]);
                        *(u32x4*)(rowp + bj * 128) = w; } }
        } else if (u.z == 1) pg8::store_tile_bf16(acc, (bf16*)(ws + WS_KM) + (size_t)row0 * 1024 + 256 * u.pn, 1024, nullptr, 1.0f, wc, fq);
        else pg8::store_tile_bf16(acc, (bf16*)(ws + WS_VMT) + (size_t)row0 * 2048 + 256 * u.pn, 2048, nullptr, 1.0f, wc, fq);
    }
};

struct SchedPlain { int G, c, nM, nN; unsigned abase, bbase, atile, btile, acol, bcol, bgrp;
    __device__ __forceinline__ bool next(int i, Unit& u) const {
        const int L = i * G + c; if (L >= nM * nN) return false;
        pg8::tile_order(L, nM, nN, u.pm, u.pn); u.z = 0; u.nvalid = 256; u.goff = 0;
        u.aoff = abase + (unsigned)u.pm * atile + (unsigned)u.pn * acol; u.boff = bbase + (unsigned)u.pn * btile + (unsigned)(u.pm >> 4) * bgrp + (unsigned)u.pn * bcol; return true; }
};
struct EpiBf16 { static constexpr bool PERM = true;
    bf16* O; int ldc; float scale; const float* bias;
    __device__ __forceinline__ void operator()(const f32x4 (&acc)[2][2][4][2], const Unit& u, int wr, int wc, int fr, int fq) const {
        pg8::store_tile_bf16(acc, O + (size_t)(u.pm * 256 + wr * 64 + fr) * ldc + 256 * u.pn, (size_t)ldc, bias ? bias + 256 * u.pn : nullptr, scale, wc, fq); }
};
constexpr int MOE_MAX_UNITS = 40;
struct SchedMoe { const LAS int* ut;
    __device__ __forceinline__ bool next(int i, Unit& u) const {
        if (i >= MOE_MAX_UNITS) return false;
        const LAS int* p = ut + 8 * i;
        if (__builtin_amdgcn_readfirstlane(p[7]) == 0) return false;
        u.pm = __builtin_amdgcn_readfirstlane(p[0]); u.pn = __builtin_amdgcn_readfirstlane(p[1]); u.z = __builtin_amdgcn_readfirstlane(p[2]); u.nvalid = __builtin_amdgcn_readfirstlane(p[3]);
        u.aoff = (unsigned)__builtin_amdgcn_readfirstlane(p[4]); u.boff = (unsigned)__builtin_amdgcn_readfirstlane(p[5]); u.goff = (unsigned)__builtin_amdgcn_readfirstlane(p[6]); return true; }
};
__device__ __forceinline__ void moe_units(Frame& F, const LAS int* tb, LAS int* ut, int nN, unsigned abase, unsigned wbase, unsigned wexp, bool gather) {
    if (F.tid < MOE_MAX_UNITS) { const int i = F.tid, nblk = tb[32], L = i * F.G + (int)blockIdx.x; LAS int* p = ut + 8 * i;
        if (L < nblk * nN) { int pm, pn; pg8::tile_order(L, nblk, nN, pm, pn);
            const int e = tb[128 + pm], j = pm - tb[e], rem = tb[64 + e] - 256 * j;
            p[0] = pm; p[1] = pn; p[2] = e; p[3] = rem < 256 ? rem : 256; p[4] = (int)(gather ? abase : abase + (unsigned)pm * (TSTEP / 2));
            p[5] = (int)(wbase + (unsigned)e * wexp + (unsigned)pn * (TSTEP / 2)); p[6] = e * LCAP + 256 * j; p[7] = 1; }
        else p[7] = 0; }
    LDS_WAIT(); __syncthreads();
}
__device__ __forceinline__ f32x2 swiglu_pk(f32x2 g, f32x2 u) {
    f32x2 g_, u_; g_.x = fminf(g.x, 7.0f); g_.y = fminf(g.y, 7.0f); u_.x = __builtin_amdgcn_fmed3f(u.x, -7.0f, 7.0f); u_.y = __builtin_amdgcn_fmed3f(u.y, -7.0f, 7.0f);
    const f32x2 t = g_ * (-1.702f * LOG2E); f32x2 e; e.x = __builtin_amdgcn_exp2f(t.x); e.y = __builtin_amdgcn_exp2f(t.y);
    const f32x2 d = e + 1.0f; f32x2 r; r.x = __builtin_amdgcn_rcpf(d.x); r.y = __builtin_amdgcn_rcpf(d.y);
    return ((u_ + 1.0f) * g_) * r;
}
struct EpiAct { static constexpr bool PERM = true;
    unsigned char* ACT; const float* b_gu;
    __device__ __forceinline__ void operator()(const f32x4 (&acc)[2][2][4][2], const Unit& u, int wr, int wc, int fr, int fq) const {
        const int row0 = u.pm * 256 + wr * 64 + fr, ch = 128 * u.pn + wc * 32 + 8 * fq;
        const float* bb = b_gu + (size_t)u.z * 2 * DFF;
        f32x4 bg[2], bu[2];
#pragma unroll
        for (int n = 0; n < 2; ++n) { bg[n] = *(const f32x4*)(bb + ch + 4 * n); bu[n] = *(const f32x4*)(bb + DFF + ch + 4 * n); }
#pragma unroll
        for (int ai = 0; ai < 2; ++ai)
#pragma unroll
            for (int m = 0; m < 4; ++m) { f32x2 o[2][2];
#pragma unroll
                for (int n = 0; n < 2; ++n) { const f32x4 ag = acc[ai][0][m][n], au = acc[ai][1][m][n];
                    o[n][0] = swiglu_pk((f32x2){ag[0], ag[1]} * (1.0f / WGU_SC) + (f32x2){bg[n][0], bg[n][1]}, (f32x2){au[0], au[1]} * (1.0f / WGU_SC) + (f32x2){bu[n][0], bu[n][1]});
                    o[n][1] = swiglu_pk((f32x2){ag[2], ag[3]} * (1.0f / WGU_SC) + (f32x2){bg[n][2], bg[n][3]}, (f32x2){au[2], au[3]} * (1.0f / WGU_SC) + (f32x2){bu[n][2], bu[n][3]}); }
                *(u32x2*)(ACT + (size_t)(row0 + ai * 128 + m * 16) * DFF + ch) = (u32x2){pk4_fp8(o[0][0].x, o[0][0].y, o[0][1].x, o[0][1].y), pk4_fp8(o[1][0].x, o[1][0].y, o[1][1].x, o[1][1].y)}; }
    }
};
struct EpiDown { static constexpr bool PERM = true;
    unsigned char* YS; const float* b_down; const float* lgate;
    __device__ __forceinline__ void operator()(const f32x4 (&acc)[2][2][4][2], const Unit& u, int wr, int wc, int fr, int fq) const {
        const int r0 = wr * 64 + fr, cl = wc * 32 + 8 * fq;
        const float* bb = b_down + (size_t)u.z * D + 256 * u.pn + cl;
        f32x4 bv[2][2];
#pragma unroll
        for (int bj = 0; bj < 2; ++bj)
#pragma unroll
            for (int n = 0; n < 2; ++n) bv[bj][n] = *(const f32x4*)(bb + bj * 128 + 4 * n);
        float gts[2][4];
#pragma unroll
        for (int ai = 0; ai < 2; ++ai)
#pragma unroll
            for (int m = 0; m < 4; ++m) { const int r = r0 + ai * 128 + m * 16; gts[ai][m] = lgate[u.goff + (r < u.nvalid ? r : u.nvalid - 1)]; }
#pragma unroll
        for (int ai = 0; ai < 2; ++ai)
#pragma unroll
            for (int m = 0; m < 4; ++m) { const int r = r0 + ai * 128 + m * 16; const float gt = (r < u.nvalid) ? gts[ai][m] * YS_SC : 0.f;
                unsigned char* rowp = YS + (size_t)(u.pm * 256 + r) * D + 256 * u.pn + cl;
#pragma unroll
                for (int bj = 0; bj < 2; ++bj) { const f32x4 v0 = (acc[ai][bj][m][0] * (1.0f / WDN_SC) + bv[bj][0]) * gt, v1 = (acc[ai][bj][m][1] * (1.0f / WDN_SC) + bv[bj][1]) * gt;
                    *(u32x2*)(rowp + bj * 128) = (u32x2){pk4_fp8(v0[0], v0[1], v0[2], v0[3]), pk4_fp8(v1[0], v1[1], v1[2], v1[3])}; } }
    }
};
__device__ __forceinline__ void moe_table(Frame& F, LAS int* tb) {
    if (F.tid < 32) { int c = (int)__hip_atomic_load(F.ctl + CW_ECNT + 64 * F.tid, RLX_AGENT); if (c > LCAP) c = LCAP; tb[64 + F.tid] = c; }
    LDS_WAIT(); __syncthreads();
    if (F.tid == 0) { int s = 0; for (int e = 0; e < NE; ++e) { tb[e] = s; s += (tb[64 + e] + 255) >> 8; } tb[32] = s; }
    LDS_WAIT(); __syncthreads();
    for (int b = F.tid; b < NBLK_MAX; b += NWAVES * 64) { int e = 0; while (e < NE - 1 && tb[e + 1] <= b) ++e; tb[128 + b] = e; }
    LDS_WAIT(); __syncthreads();
}

__device__ __forceinline__ void conv_phase(Frame& F) {
    LAS unsigned* ut = (LAS unsigned*)(F.lds + RING_OFF);
    LAS float* co = (LAS float*)(F.lds + RING_OFF + 65536);
    const int cp = F.tid & 255, half = F.tid >> 8;
    float w0[CWID], w1[CWID];
    { const float* wd = F.in[I_W_DW] + 2 * cp;
#pragma unroll
        for (int j = 0; j < CWID; ++j) { const f32x2 w = *(const GAS f32x2*)(wd + j * CONV_CH); w0[j] = w.x; w1[j] = w.y; } }
    const f32x2 bd = *(const GAS f32x2*)(F.in[I_B_DW] + 2 * cp);
    const f32x4 g0 = *(const GAS f32x4*)(F.in[I_LN_CONV_G] + 8 * F.lane), g1 = *(const GAS f32x4*)(F.in[I_LN_CONV_G] + 8 * F.lane + 4);
    const f32x4 b0 = *(const GAS f32x4*)(F.in[I_LN_CONV_B] + 8 * F.lane), b1 = *(const GAS f32x4*)(F.in[I_LN_CONV_B] + 8 * F.lane + 4);
    bf16* MX = (bf16*)(F.ws + WS_MIXIN);
    for (int it = F.vcu; it < NB * (T_ / 32); it += F.G) {
        const int b = it / (T_ / 32), t0 = (it % (T_ / 32)) * 32;
        const bf16* U = (const bf16*)(F.ws + WS_U) + (size_t)b * T_ * CONV_CH;
        for (int idx = F.tid; idx < 62 * 64; idx += 512) { const int r = idx >> 6, c16 = idx & 63, t = t0 - 30 + r;
            u32x4 v = (u32x4){0u, 0u, 0u, 0u}; if (t >= 0) v = *(const GAS u32x4*)(U + (size_t)t * CONV_CH + c16 * 8);
            *(LAS u32x4*)(ut + r * 256 + c16 * 4) = v; }
        LDS_WAIT(); __syncthreads();
        { float a0[16], a1[16];
#pragma unroll
            for (int tt = 0; tt < 16; ++tt) { a0[tt] = bd.x; a1[tt] = bd.y; }
#pragma unroll
            for (int r = 0; r < 46; ++r) { const unsigned uu = ut[(half * 16 + r) * 256 + cp]; const float u0 = bflo(uu), u1 = bfhi(uu);
#pragma unroll
                for (int tt = 0; tt < 16; ++tt) { const int j = r - tt; if (j >= 0 && j < CWID) { a0[tt] += w0[j] * u0; a1[tt] += w1[j] * u1; } } }
#pragma unroll
            for (int tt = 0; tt < 16; ++tt) *(LAS f32x2*)(co + (half * 16 + tt) * CONV_CH + 2 * cp) = (f32x2){a0[tt], a1[tt]};
        }
        LDS_WAIT(); __syncthreads();
#pragma unroll
        for (int q = 0; q < 4; ++q) { const int tt = 4 * F.wave + q;
            f32x4 x0 = *(const LAS f32x4*)(co + tt * CONV_CH + 8 * F.lane), x1 = *(const LAS f32x4*)(co + tt * CONV_CH + 8 * F.lane + 4);
            const float mean = wave_sum((x0.x + x0.y) + (x0.z + x0.w) + (x1.x + x1.y) + (x1.z + x1.w)) * (1.f / CONV_CH);
            x0 = x0 - mean; x1 = x1 - mean;
            const float var = wave_sum((x0.x * x0.x + x0.y * x0.y) + (x0.z * x0.z + x0.w * x0.w) + (x1.x * x1.x + x1.y * x1.y) + (x1.z * x1.z + x1.w * x1.w)) * (1.f / CONV_CH);
            const float rstd = 1.f / sqrtf(var + LN_EPS);
            x0 = x0 * rstd * g0 + b0; x1 = x1 * rstd * g1 + b1;
            float y[8] = {x0.x, x0.y, x0.z, x0.w, x1.x, x1.y, x1.z, x1.w};
#pragma unroll
            for (int j = 0; j < 8; ++j) y[j] = y[j] * sigmoidf_fast(y[j]);
            *(GAS u32x4*)(MX + (size_t)(b * T_ + t0 + tt) * D + 8 * F.lane) = (u32x4){pk2(y[0], y[1]), pk2(y[2], y[3]), pk2(y[4], y[5]), pk2(y[6], y[7])}; }
        __syncthreads();
    }
}

typedef float f32x16 __attribute__((ext_vector_type(16)));
__device__ __forceinline__ int crow(int r, int hi) { return (r & 3) + 8 * (r >> 2) + 4 * hi; }
__device__ __forceinline__ bf16x8 pack8(const float* v) {
    u32x4 w; w.x = pg8::cvt_pk_bf16(v[0], v[1]); w.y = pg8::cvt_pk_bf16(v[2], v[3]); w.z = pg8::cvt_pk_bf16(v[4], v[5]); w.w = pg8::cvt_pk_bf16(v[6], v[7]);
    return __builtin_bit_cast(bf16x8, w); }
constexpr float SB_EXIT = 150.0f;
struct SbStage { u32x4 k[4], v[4]; };
__device__ __forceinline__ void sb_gload(SbStage& g, const bf16* Kt, const bf16* Vt, int lane) {
#pragma unroll
    for (int i = 0; i < 4; ++i) { const int c = (lane & 7) ^ ((4 * i + (lane >> 4)) & 7); g.k[i] = *(const GAS u32x4*)(Kt + (size_t)(8 * i) * SBW + 8 * c); }
#pragma unroll
    for (int i = 0; i < 4; ++i) g.v[i] = *(const GAS u32x4*)(Vt + (size_t)(16 * i) * M);
}
__device__ __forceinline__ void sb_lwrite(const SbStage& g, LAS unsigned char* buf, int lane) {
#pragma unroll
    for (int i = 0; i < 4; ++i) *(LAS u32x4*)(buf + 1024 * i + 16 * lane) = g.k[i];
#pragma unroll
    for (int i = 0; i < 4; ++i) *(LAS u32x4*)(buf + 4096 + 1024 * i + 16 * lane) = g.v[i];
}
__device__ __forceinline__ void sb_attn_wave(Frame& F, int b, int h, int qt) {
    const int c = F.lane & 31, hi = F.lane >> 5;
    const bf16* Q = (const bf16*)(F.ws + WS_Q); const bf16* Kb = (const bf16*)(F.ws + WS_K); const bf16* VT = (const bf16*)(F.ws + WS_V);
    LAS unsigned char* wbuf = F.lds + RING_OFF + F.wave * 16384;
    bf16x8 tri[2];
#pragma unroll
    for (int s = 0; s < 2; ++s) { bf16x8 t;
#pragma unroll
        for (int j = 0; j < 8; ++j) { const int k = 16 * s + 8 * (j >> 2) + 4 * hi + (j & 3); t[j] = (k >= c) ? (short)0xBF80 : (short)0; }
        tri[s] = t; }
    bf16x8 qf[4];
    { const bf16* qp = Q + ((size_t)b * T_ + 32 * qt + c) * SBW + h * SBD + 8 * hi;
#pragma unroll
        for (int s = 0; s < 4; ++s) qf[s] = *(const GAS bf16x8*)(qp + 16 * s); }
    const bf16* Ksrc = Kb + ((size_t)b * T_ + (F.lane >> 3)) * SBW + h * SBD;
    const bf16* Vsrc = VT + (size_t)(h * SBD + (F.lane >> 2)) * M + (size_t)b * T_ + 8 * ((F.lane & 3) ^ ((F.lane >> 4) & 3));

    const int ksw = (c >> 1) & 7, vsw = (c >> 2) & 3;

    f32x16 o0, o1;
#pragma unroll
    for (int r = 0; r < 16; ++r) { o0[r] = 0.f; o1[r] = 0.f; }
    float carry = 0.f;
    SbStage st;
    sb_gload(st, Ksrc + (size_t)(32 * qt) * SBW, Vsrc + 32 * qt, F.lane); sb_lwrite(st, wbuf, F.lane);
    for (int kt = qt; kt >= 0; --kt) {
        LAS unsigned char* buf = wbuf + ((qt - kt) & 1) * 8192;
        if (kt > 0) sb_gload(st, Ksrc + (size_t)(32 * (kt - 1)) * SBW, Vsrc + 32 * (kt - 1), F.lane);
        const bool diag = (kt == qt);
        bf16x8 kf[4];
#pragma unroll
        for (int s = 0; s < 4; ++s) kf[s] = *(const LAS bf16x8*)(buf + c * 128 + 16 * ((2 * s + hi) ^ ksw));
        f32x16 p;
#pragma unroll
        for (int r = 0; r < 16; ++r) p[r] = 0.f;
#pragma unroll
        for (int s = 0; s < 4; ++s) p = __builtin_amdgcn_mfma_f32_32x32x16_bf16(kf[s], qf[s], p, 0, 0, 0);
        u32x2 vv[2][2][2];
#pragma unroll
        for (int dt = 0; dt < 2; ++dt)
#pragma unroll
            for (int s = 0; s < 2; ++s)
#pragma unroll
                for (int q = 0; q < 2; ++q) vv[dt][s][q] = *(const LAS u32x2*)(buf + 4096 + (32 * dt + c) * 64 + 16 * ((2 * s + q) ^ vsw) + 8 * hi);
        float L[16];
#pragma unroll
        for (int r = 0; r < 16; ++r) { const float y = p[r]; float l = __builtin_amdgcn_logf(1.0f + __builtin_amdgcn_exp2f(y)); l = (y > 64.f) ? y : l;
            if (diag) l = (crow(r, hi) >= c) ? 0.f : l; L[r] = l; }
        const bf16x8 l0 = pack8(L), l1 = pack8(L + 8);
        f32x16 a;
#pragma unroll
        for (int r = 0; r < 16; ++r) a[r] = p[r] - carry;
        a = __builtin_amdgcn_mfma_f32_32x32x16_bf16(tri[0], l0, a, 0, 0, 0); a = __builtin_amdgcn_mfma_f32_32x32x16_bf16(tri[1], l1, a, 0, 0, 0);
        const float tot = p[0] - a[0];
        float w[16];
#pragma unroll
        for (int r = 0; r < 16; ++r) { float x = __builtin_amdgcn_exp2f(a[r]); if (diag) x = (crow(r, hi) >= c) ? 0.f : x; w[r] = x; }
        const bf16x8 p0 = pack8(w), p1 = pack8(w + 8);
        { const bf16x8 v00 = __builtin_bit_cast(bf16x8, (u32x4){vv[0][0][0].x, vv[0][0][0].y, vv[0][0][1].x, vv[0][0][1].y});
          const bf16x8 v01 = __builtin_bit_cast(bf16x8, (u32x4){vv[0][1][0].x, vv[0][1][0].y, vv[0][1][1].x, vv[0][1][1].y});
          const bf16x8 v10 = __builtin_bit_cast(bf16x8, (u32x4){vv[1][0][0].x, vv[1][0][0].y, vv[1][0][1].x, vv[1][0][1].y});
          const bf16x8 v11 = __builtin_bit_cast(bf16x8, (u32x4){vv[1][1][0].x, vv[1][1][0].y, vv[1][1][1].x, vv[1][1][1].y});
          o0 = __builtin_amdgcn_mfma_f32_32x32x16_bf16(v00, p0, o0, 0, 0, 0); o0 = __builtin_amdgcn_mfma_f32_32x32x16_bf16(v01, p1, o0, 0, 0, 0);
          o1 = __builtin_amdgcn_mfma_f32_32x32x16_bf16(v10, p0, o1, 0, 0, 0); o1 = __builtin_amdgcn_mfma_f32_32x32x16_bf16(v11, p1, o1, 0, 0, 0); }
        carry = __shfl(tot, c);
        if (__all(carry >= SB_EXIT)) break;
        if (kt > 0) sb_lwrite(st, wbuf + ((qt - kt + 1) & 1) * 8192, F.lane);
    }
    bf16* op = (bf16*)(F.ws + WS_MIXIN) + ((size_t)b * T_ + 32 * qt + c) * D + CONV_CH + h * SBD + 4 * hi;
#pragma unroll
    for (int g = 0; g < 4; ++g) {
        *(GAS u32x2*)(op + 8 * g) = (u32x2){pg8::cvt_pk_bf16(o0[4 * g], o0[4 * g + 1]), pg8::cvt_pk_bf16(o0[4 * g + 2], o0[4 * g + 3])};
        *(GAS u32x2*)(op + 32 + 8 * g) = (u32x2){pg8::cvt_pk_bf16(o1[4 * g], o1[4 * g + 1]), pg8::cvt_pk_bf16(o1[4 * g + 2], o1[4 * g + 3])}; }
}

__device__ __forceinline__ void resid_row(f32x4 (&v)[4], const bf16* hrow, const bf16* mrow, int lane) {
    f32x4 a[4]; load_row_bf16(v, hrow, lane); load_row_bf16(a, mrow, lane);
#pragma unroll
    for (int j = 0; j < 4; ++j) v[j] = v[j] * DN_ALPHA + a[j];
}
__device__ __forceinline__ void ln_phase(Frame& F, const float* g, const float* b) {
    int r0, r1;
    if (F.G == 256) { if (F.vcu < 64) { r0 = 64 * F.vcu; r1 = r0 + 64; } else { const int j = F.vcu - 64; r0 = 4096 + (j * 28672) / 192; r1 = 4096 + ((j + 1) * 28672) / 192; } }
    else { r0 = (int)(((long)F.vcu * M) / F.G); r1 = (int)(((long)(F.vcu + 1) * M) / F.G); }
    for (int m = r0 + F.wave; m < r1; m += NWAVES) { f32x4 v[4]; bf16* hrow = (bf16*)(F.ws + WS_HB) + (size_t)m * D; resid_row(v, hrow, (const bf16*)(F.ws + WS_QM) + (size_t)m * D, F.lane);
        ln_row(v, g, b, F.lane); store_row_bf16(v, hrow, F.lane);
        { GAS unsigned* h8 = (GAS unsigned*)(F.ws + WS_HB8 + (size_t)m * D) + F.lane;
#pragma unroll
            for (int j = 0; j < 4; ++j) h8[64 * j] = pk4_fp8(v[j].x, v[j].y, v[j].z, v[j].w); } }
}
__device__ __forceinline__ void softmax_phase(Frame& F) {
    const int gw = F.vcu * NWAVES + F.wave, NGW = F.G * NWAVES;
    for (int m = gw; m < M; m += NGW) { GAS u32x2* p = (GAS u32x2*)((bf16*)(F.ws + WS_SP) + (size_t)m * D) + F.lane;
#pragma unroll
        for (int j = 0; j < 4; ++j) { const u32x2 w = p[64 * j]; float x0 = bflo(w.x), x1 = bfhi(w.x), x2 = bflo(w.y), x3 = bfhi(w.y);
            const float mx = wave_max(fmaxf(fmaxf(x0, x1), fmaxf(x2, x3)));
            x0 = __builtin_amdgcn_exp2f(x0 - mx); x1 = __builtin_amdgcn_exp2f(x1 - mx); x2 = __builtin_amdgcn_exp2f(x2 - mx); x3 = __builtin_amdgcn_exp2f(x3 - mx);
            const float inv = 1.0f / wave_sum((x0 + x1) + (x2 + x3));
            p[64 * j] = (u32x2){pk2(x0 * inv, x1 * inv), pk2(x2 * inv, x3 * inv)}; } }
}
__device__ __forceinline__ void xattn_phase(Frame& F) {
    LAS unsigned char* tb0 = F.lds + RING_OFF;
    const bf16* QM = (const bf16*)(F.ws + WS_QM); const bf16* KM = (const bf16*)(F.ws + WS_KM); const bf16* VMT = (const bf16*)(F.ws + WS_VMT); bf16* OB = (bf16*)(F.ws + WS_OB);
    const int c = F.lane & 31, h5 = F.lane >> 5;
    const int tr = F.tid >> 5, tc = F.tid & 31;
    const int kr = F.tid >> 4, kc = F.tid & 15;
    for (int u = F.vcu; u < NB * 4 * 16; u += F.G) {
        const int b = u >> 6, h = (u >> 4) & 3, qt = u & 15;
        const size_t rowq = (size_t)b * T_ + 256 * qt + 32 * F.wave + c;
        const bf16* qp = QM + rowq * D + h * 256 + 8 * h5;
        const bf16* ksrc = KM + ((size_t)b * NMEM + kr) * D + h * 256 + 8 * kc;
        const int kw0 = kr * 272 + kc * 16, kw1 = (kr + 32) * 272 + kc * 16;
        const bf16* vsrc = VMT + ((size_t)h * 256 + tr) * (size_t)MM + (size_t)b * NMEM + 8 * tc;
        int vw[4];
#pragma unroll
        for (int j = 0; j < 4; ++j) vw[j] = (tr + 16 * j) * 528 + tc * 16;
        u32x4 st[4];
        __syncthreads();
        st[0] = *(const GAS u32x4*)ksrc; st[1] = *(const GAS u32x4*)(ksrc + (size_t)32 * D);
        *(LAS u32x4*)(tb0 + kw0) = st[0]; *(LAS u32x4*)(tb0 + kw1) = st[1];
        LDS_WAIT(); __syncthreads();
        f32x16 sacc[8];
#pragma unroll
        for (int dh = 0; dh < 2; ++dh) {
            bf16x8 qf[8];
#pragma unroll
            for (int s_ = 0; s_ < 8; ++s_) qf[s_] = *(const GAS bf16x8*)(qp + 128 * dh + 16 * s_);
#pragma unroll
            for (int kp = 0; kp < 4; ++kp) { const int i = dh * 4 + kp;
                LAS unsigned char* buf = tb0 + (i & 1) * 34816; LAS unsigned char* nbuf = tb0 + ((i + 1) & 1) * 34816;
                if (i < 7) { const bf16* p = ksrc + (size_t)(64 * ((i + 1) & 3)) * D + 128 * ((i + 1) >> 2); st[0] = *(const GAS u32x4*)p; st[1] = *(const GAS u32x4*)(p + (size_t)32 * D); }
                else {
#pragma unroll
                    for (int j = 0; j < 4; ++j) st[j] = *(const GAS u32x4*)(vsrc + (size_t)(16 * j) * MM); }
#pragma unroll
                for (int k2 = 0; k2 < 2; ++k2) { const int kt = 2 * kp + k2;
                    f32x16 a;
                    if (dh == 0) {
#pragma unroll
                        for (int r = 0; r < 16; ++r) a[r] = 0.f; }
                    else a = sacc[kt];
#pragma unroll
                    for (int s_ = 0; s_ < 8; ++s_) { const bf16x8 kf = *(const LAS bf16x8*)(buf + c * 272 + h5 * 16 + (32 * k2 * 272 + 32 * s_)); a = __builtin_amdgcn_mfma_f32_32x32x16_bf16(kf, qf[s_], a, 0, 0, 0); }
                    sacc[kt] = a; }
                if (i < 7) { *(LAS u32x4*)(nbuf + kw0) = st[0]; *(LAS u32x4*)(nbuf + kw1) = st[1]; }
                else {
#pragma unroll
                    for (int j = 0; j < 4; ++j) *(LAS u32x4*)(nbuf + vw[j]) = st[j]; }
                LDS_WAIT(); __syncthreads();
            }
        }
        float mx = sacc[0][0];
#pragma unroll
        for (int kt = 0; kt < 8; ++kt)
#pragma unroll
            for (int r = 0; r < 16; ++r) mx = fmaxf(mx, sacc[kt][r]);
        mx = fmaxf(mx, __shfl_xor(mx, 32));
        float sum = 0.f; bf16x8 pb[8][2];
#pragma unroll
        for (int kt = 0; kt < 8; ++kt) { float p[16];
#pragma unroll
            for (int r = 0; r < 16; ++r) { p[r] = __builtin_amdgcn_exp2f(sacc[kt][r] - mx); sum += p[r]; }
            pb[kt][0] = pack8(p); pb[kt][1] = pack8(p + 8); }
        sum += __shfl_xor(sum, 32);
        const float inv = OB_SC / sum;
        unsigned char* op = (unsigned char*)OB + rowq * D + h * 256 + 4 * h5;
        for (int dp = 0; dp < 4; ++dp) {
            LAS unsigned char* buf = tb0 + (dp & 1) * 34816; LAS unsigned char* nbuf = tb0 + ((dp + 1) & 1) * 34816;
            if (dp < 3) {
#pragma unroll
                for (int j = 0; j < 4; ++j) st[j] = *(const GAS u32x4*)(vsrc + (size_t)(64 * (dp + 1) + 16 * j) * MM); }
#pragma unroll
            for (int d2 = 0; d2 < 2; ++d2) { const int dt = 2 * dp + d2;
                f32x16 o;
#pragma unroll
                for (int r = 0; r < 16; ++r) o[r] = 0.f;
#pragma unroll
                for (int kt = 0; kt < 8; ++kt)
#pragma unroll
                    for (int s2 = 0; s2 < 2; ++s2) { const LAS unsigned char* rp = buf + c * 528 + 8 * h5 + (32 * d2 * 528 + (4 * kt + 2 * s2) * 16);
                        const u32x2 v0 = *(const LAS u32x2*)rp, v1 = *(const LAS u32x2*)(rp + 16);
                        o = __builtin_amdgcn_mfma_f32_32x32x16_bf16(__builtin_bit_cast(bf16x8, (u32x4){v0.x, v0.y, v1.x, v1.y}), pb[kt][s2], o, 0, 0, 0); }
#pragma unroll
                for (int g = 0; g < 4; ++g) *(GAS unsigned*)(op + 32 * dt + 8 * g) = pk4_fp8(o[4 * g] * inv, o[4 * g + 1] * inv, o[4 * g + 2] * inv, o[4 * g + 3] * inv); }
            if (dp < 3) {
#pragma unroll
                for (int j = 0; j < 4; ++j) *(LAS u32x4*)(nbuf + vw[j]) = st[j]; }
            LDS_WAIT(); __syncthreads();
        }
    }
}
typedef float f32x4v __attribute__((ext_vector_type(4)));
__device__ __forceinline__ void ln2_router_phase(Frame& F) {
    LAS bf16* wr = (LAS bf16*)(F.lds + P10_WR);
    LAS float* gb = (LAS float*)(F.lds + P10_GB);
    LAS int* lcnt = (LAS int*)(F.lds + P10_LCNT);
    LAS int* rec = (LAS int*)(F.lds + P10_REC);
    for (int i = F.tid; i < 2 * 32 * WR_STRIDE * 2 / 16; i += 512) *(LAS u32x4*)(F.lds + P10_WR + 16 * i) = *(const GAS u32x4*)(F.ws + WS_WR + 16 * i);
    for (int i = F.tid; i < 512; i += 512) { *(LAS f32x4*)(gb + 4 * i) = ((const GAS f32x4*)(i < 256 ? F.in[I_LN2_G] : F.in[I_LN2_B]))[i & 255]; }
    if (F.tid < 64) lcnt[F.tid] = 0;
    LDS_WAIT(); __syncthreads();
    const bf16* H1 = (const bf16*)(F.ws + WS_HB); const bf16* CA = (const bf16*)(F.ws + WS_QM); bf16* H2 = (bf16*)(F.ws + WS_HB2);
    int* ltok = (int*)(F.ws + WS_LTOK); float* lgate = (float*)(F.ws + WS_LGATE); int* sidx = (int*)(F.ws + WS_SIDX);
    const int fr = F.lane & 15, fq = F.lane >> 4;
    for (int rb = F.vcu; rb < M / 128; rb += F.G) {
        const int m0 = rb * 128 + F.wave * 16;
        float mymean = 0.f, myrstd = 0.f;
        for (int i = 0; i < 16; ++i) { const int m = m0 + i;
            f32x4 v[4]; resid_row(v, H1 + (size_t)m * D, CA + (size_t)m * D, F.lane);
            float s1 = 0.f;
#pragma unroll
            for (int j = 0; j < 4; ++j) s1 += (v[j].x + v[j].y) + (v[j].z + v[j].w);
            const float mean = wave_sum(s1) * (1.f / D); float s2 = 0.f;
#pragma unroll
            for (int j = 0; j < 4; ++j) { v[j] = v[j] - mean; s2 += (v[j].x * v[j].x + v[j].y * v[j].y) + (v[j].z * v[j].z + v[j].w * v[j].w); }
            const float rstd = 1.f / sqrtf(wave_sum(s2) * (1.f / D) + LN_EPS);
            if (fr == i) { mymean = mean; myrstd = rstd; }
#pragma unroll
            for (int j = 0; j < 4; ++j) { const f32x4 gg = *(const LAS f32x4*)(gb + 4 * F.lane + 256 * j), bb = *(const LAS f32x4*)(gb + 1024 + 4 * F.lane + 256 * j); v[j] = v[j] * rstd * gg + bb; }
            store_row_bf16(v, H2 + (size_t)m * D, F.lane);
            { GAS unsigned* h8 = (GAS unsigned*)(F.ws + WS_HB8 + (size_t)m * D) + F.lane;
#pragma unroll
                for (int j = 0; j < 4; ++j) h8[64 * j] = pk4_fp8(v[j].x, v[j].y, v[j].z, v[j].w); }
        }
        f32x4v acc0 = {0.f, 0.f, 0.f, 0.f}, acc1 = {0.f, 0.f, 0.f, 0.f};
        { const bf16* hp = H1 + (size_t)(m0 + fr) * D + 8 * fq; const bf16* cp = CA + (size_t)(m0 + fr) * D + 8 * fq;
            const LAS bf16* wp = wr + fr * WR_STRIDE + 8 * fq; const LAS float* gp = gb + 8 * fq;
            const float sc = myrstd, sh = -mymean * myrstd;
#pragma unroll 2
            for (int s_ = 0; s_ < 32; ++s_) {
                const u32x4 hv = *(const GAS u32x4*)(hp + 32 * s_), cv = *(const GAS u32x4*)(cp + 32 * s_);
                const f32x4 g0 = *(const LAS f32x4*)(gp + 32 * s_), g1 = *(const LAS f32x4*)(gp + 32 * s_ + 4), b0 = *(const LAS f32x4*)(gp + 1024 + 32 * s_), b1 = *(const LAS f32x4*)(gp + 1024 + 32 * s_ + 4);
                float x[8];
                x[0] = bflo(hv.x) * DN_ALPHA + bflo(cv.x); x[1] = bfhi(hv.x) * DN_ALPHA + bfhi(cv.x); x[2] = bflo(hv.y) * DN_ALPHA + bflo(cv.y); x[3] = bfhi(hv.y) * DN_ALPHA + bfhi(cv.y);
                x[4] = bflo(hv.z) * DN_ALPHA + bflo(cv.z); x[5] = bfhi(hv.z) * DN_ALPHA + bfhi(cv.z); x[6] = bflo(hv.w) * DN_ALPHA + bflo(cv.w); x[7] = bfhi(hv.w) * DN_ALPHA + bfhi(cv.w);
                const float gg[8] = {g0.x, g0.y, g0.z, g0.w, g1.x, g1.y, g1.z, g1.w}, bb[8] = {b0.x, b0.y, b0.z, b0.w, b1.x, b1.y, b1.z, b1.w};
                float lo[8]; unsigned hp2[4];
#pragma unroll
                for (int j = 0; j < 8; ++j) x[j] = (x[j] * sc + sh) * gg[j] + bb[j];
#pragma unroll
                for (int j = 0; j < 4; ++j) { hp2[j] = pg8::cvt_pk_bf16(x[2 * j], x[2 * j + 1]); lo[2 * j] = x[2 * j] - bflo(hp2[j]); lo[2 * j + 1] = x[2 * j + 1] - bfhi(hp2[j]); }
                const bf16x8 bhi = __builtin_bit_cast(bf16x8, (u32x4){hp2[0], hp2[1], hp2[2], hp2[3]});
                const bf16x8 blo = pack8(lo);
                const bf16x8 wh0 = *(const LAS bf16x8*)(wp + 32 * s_), wh1 = *(const LAS bf16x8*)(wp + 16 * WR_STRIDE + 32 * s_);
                const bf16x8 wl0 = *(const LAS bf16x8*)(wp + 32 * WR_STRIDE + 32 * s_), wl1 = *(const LAS bf16x8*)(wp + 48 * WR_STRIDE + 32 * s_);
                acc0 = __builtin_amdgcn_mfma_f32_16x16x32_bf16(wh0, bhi, acc0, 0, 0, 0); acc1 = __builtin_amdgcn_mfma_f32_16x16x32_bf16(wh1, bhi, acc1, 0, 0, 0);
                acc0 = __builtin_amdgcn_mfma_f32_16x16x32_bf16(wh0, blo, acc0, 0, 0, 0); acc1 = __builtin_amdgcn_mfma_f32_16x16x32_bf16(wh1, blo, acc1, 0, 0, 0);
                acc0 = __builtin_amdgcn_mfma_f32_16x16x32_bf16(wl0, bhi, acc0, 0, 0, 0); acc1 = __builtin_amdgcn_mfma_f32_16x16x32_bf16(wl1, bhi, acc1, 0, 0, 0);
            } }
        float cand[8]; int eid[8];
        { const f32x4 br0 = *(const GAS f32x4*)(F.in[I_B_ROUTER] + 4 * fq), br1 = *(const GAS f32x4*)(F.in[I_B_ROUTER] + 16 + 4 * fq);
#pragma unroll
            for (int r = 0; r < 4; ++r) { cand[r] = acc0[r] + br0[r]; cand[4 + r] = acc1[r] + br1[r]; eid[r] = 4 * fq + r; eid[4 + r] = 16 + 4 * fq + r; } }
        float tv[TOPK]; int te[TOPK];
#pragma unroll
        for (int k = 0; k < TOPK; ++k) {
            float bv = cand[0]; int bi = eid[0];
#pragma unroll
            for (int r = 1; r < 8; ++r) if (cand[r] > bv) { bv = cand[r]; bi = eid[r]; }
#pragma unroll
            for (int o = 16; o <= 32; o <<= 1) { const float ov = __shfl_xor(bv, o); const int oi = __shfl_xor(bi, o); if (ov > bv || (ov == bv && oi < bi)) { bv = ov; bi = oi; } }
            tv[k] = bv; te[k] = bi;
#pragma unroll
            for (int r = 0; r < 8; ++r) if (eid[r] == bi) cand[r] = -INFINITY;
        }
        float pe[TOPK], ps = 0.f;
#pragma unroll
        for (int k = 0; k < TOPK; ++k) { pe[k] = __expf(tv[k] - tv[0]); ps += pe[k]; }
        if (fq == 0) {
#pragma unroll
            for (int k = 0; k < TOPK; ++k) { const int lr = __hip_atomic_fetch_add(lcnt + te[k], 1, __ATOMIC_RELAXED, __HIP_MEMORY_SCOPE_WORKGROUP);
                LAS int* r = rec + ((F.wave * 16 + fr) * 4 + k) * 4; r[0] = te[k]; r[1] = lr; r[2] = __builtin_bit_cast(int, pe[k] / ps); r[3] = m0 + fr; } }
        LDS_WAIT(); __syncthreads();
        if (F.tid < NE) lcnt[32 + F.tid] = (int)__hip_atomic_fetch_add(F.ctl + CW_ECNT + 64 * F.tid, (unsigned)lcnt[F.tid], RLX_AGENT);
        LDS_WAIT(); __syncthreads();
        { const LAS int* r = rec + (F.wave * 64 + F.lane) * 4; const int e = r[0], pos = lcnt[32 + e] + r[1], tok = r[3];
            if (pos < LCAP) { ltok[e * LCAP + pos] = tok; lgate[e * LCAP + pos] = __builtin_bit_cast(float, r[2]); } sidx[tok * 4 + (F.lane & 3)] = e * LCAP + pos; }
        __syncthreads();
        if (F.tid < 64) lcnt[F.tid] = 0;
        LDS_WAIT(); __syncthreads();
    }
}
__device__ __forceinline__ void final_phase(Frame& F, const LAS int* tb) {
    const int gw = F.vcu * NWAVES + F.wave, NGW = F.G * NWAVES;
    const int* sidx = (const int*)(F.ws + WS_SIDX); const unsigned char* YS = F.ws + WS_YS;
    typedef float f32x2v __attribute__((ext_vector_type(2)));
    for (int m = gw; m < M; m += NGW) { f32x4 v[4]; load_row_bf16(v, (const bf16*)(F.ws + WS_HB2) + (size_t)m * D, F.lane);
#pragma unroll
        for (int j = 0; j < 4; ++j) v[j] = v[j] * DN_ALPHA;
        f32x4 s[4];
#pragma unroll
        for (int j = 0; j < 4; ++j) s[j] = (f32x4){0.f, 0.f, 0.f, 0.f};
#pragma unroll
        for (int k = 0; k < TOPK; ++k) { const int si = sidx[m * 4 + k], e = si / LCAP, pos = si - e * LCAP; const size_t slot = (size_t)tb[e] * 256 + pos;
            const GAS unsigned* yp = (const GAS unsigned*)(YS + slot * D) + F.lane;
#pragma unroll
            for (int j = 0; j < 4; ++j) { const unsigned w = yp[64 * j]; const f32x2v lo = __builtin_amdgcn_cvt_pk_f32_fp8((int)w, false), hi = __builtin_amdgcn_cvt_pk_f32_fp8((int)w, true);
                s[j] = s[j] + (f32x4){lo.x, lo.y, hi.x, hi.y}; } }
#pragma unroll
        for (int j = 0; j < 4; ++j) v[j] = v[j] + s[j] * (1.0f / YS_SC);
        ln_row(v, F.in[I_LN3_G], F.in[I_LN3_B], F.lane); store_row_f32(v, F.hf + (size_t)m * D, F.lane); }
}

struct Args { const float* in[N_IN]; float* out; unsigned char* ws; int ph_lo, ph_hi, li, pad; };
__global__ void __launch_bounds__(NWAVES * 64, 2) mk_fwd(Args args) {
    extern __shared__ __attribute__((aligned(16))) unsigned char lds[];
    Frame F;
    F.lds = (LAS unsigned char*)lds; F.MISC = (volatile LAS unsigned*)(F.lds + MISC_OFF);
    F.tid = threadIdx.x; F.lane = F.tid & 63; F.wave = __builtin_amdgcn_readfirstlane(F.tid >> 6);
    F.G = gridDim.x; { const int bx = blockIdx.x; F.vcu = (F.G % 8 == 0) ? (bx % 8) * (F.G / 8) + bx / 8 : bx; }
    F.ws = args.ws; F.ctl = (gu32*)(args.ws + WS_CTL); F.hf = args.out; F.in = args.in;
    for (int u = F.tid; u < (LDS_BYTES - LDSCTL_OFF) / 4; u += NWAVES * 64) ((LAS unsigned*)(F.lds + LDSCTL_OFF))[u] = 0u;
    __syncthreads();
    XcdBarrier bar; bar.bar = (unsigned*)(F.ctl + CW_BAR) + args.li * XCD_BAR_WORDS; bar.x = 0; bar.st = nullptr;
    const int lo = args.ph_lo, hi = args.ph_hi;
    if (hi - lo > 1) bar = xcd_barrier_post((unsigned*)(F.ctl + CW_BAR) + args.li * XCD_BAR_WORDS, F.MISC + 8);
#ifndef PH_MASK
#define PH_MASK 0xfff
#endif
#define IN(k) (((PH_MASK >> (k)) & 1) && lo <= (k) && (k) < hi)
#ifndef REP_MASK
#define REP_MASK 0
#endif
#define REPS(k) (1 + ((REP_MASK >> (k)) & 1))
#define PH_BEGIN() do { int t_ = threadIdx.x; asm volatile("" : "+v"(t_)); F.tid = t_; F.lane = t_ & 63; } while (0)
#define SEAM(k) do { if (IN(k) && IN((k) + 1)) xcd_barrier(bar); } while (0)
    const char* wsb = (const char*)args.ws;
    LAS int* tb = (LAS int*)(F.lds + TB_OFF);

    if (IN(0)) for (int rep = 0; rep < REPS(0); ++rep) { PH_BEGIN(); p0_prologue(F); __syncthreads(); } SEAM(0);
    if (IN(1)) for (int rep = 0; rep < REPS(1); ++rep) { PH_BEGIN(); SchedP1 S{F.G, (int)blockIdx.x}; EpiP1 E{F.ws, F.in[I_B_IN]};
        pg8::gemm_phase<EpiP1, SchedP1, false>(F.lds + RING_OFF, wsb, D, D, D, S, E, nullptr); } SEAM(1);
    if (IN(2)) for (int rep = 0; rep < REPS(2); ++rep) { PH_BEGIN();
        if (!(args.pad & 1)) conv_phase(F);
        if (args.pad & 2) continue;
        const int gw = F.vcu * NWAVES + F.wave;
        if (F.wave < 5) { if (!(args.pad & 8)) for (int tk = F.vcu * 5 + F.wave; tk < NB * SBH * (T_ / 32); tk += F.G * 5) sb_attn_wave(F, (tk >> 7) >> 3, (tk >> 7) & 7, tk & 127); }
        else if (!(args.pad & 4)) expert_stream(F, F.vcu * 3 + (F.wave - 5), F.G * 3, F.lds + RING_OFF + F.wave * 16384);
    } SEAM(2);
    if (IN(3)) { PH_BEGIN(); SchedPlain S{F.G, (int)blockIdx.x, 128, 4, (unsigned)WS_MIXIN, (unsigned)WS_WOUT_T, TSTEP, TSTEP, 0u, 0u, 0u}; EpiBf16 E{(bf16*)(F.ws + WS_QM), D, 1.0f, F.in[I_B_OUT]};
        pg8::gemm_phase<EpiBf16, SchedPlain, false>(F.lds + RING_OFF, wsb, D, D, D, S, E, nullptr); } SEAM(3);
    if (IN(4)) { PH_BEGIN();
        { SchedKV S{F.G == 256 ? F.vcu : (int)blockIdx.x}; EpiP1 E{F.ws, F.in[I_B_IN]};
            pg8::gemm_phase<EpiP1, SchedKV, false>(F.lds + RING_OFF, wsb, D, D, D, S, E, nullptr); }
        __syncthreads();
        ln_phase(F, F.in[I_LN1_G], F.in[I_LN1_B]); } SEAM(4);
    if (IN(5)) { PH_BEGIN(); SchedPlain S{F.G, (int)blockIdx.x, 128, 4, (unsigned)WS_HB8, (unsigned)WS_WQ_T, TSTEP / 2, TSTEP / 2, 0u, 0u, 0u}; EpiBf16 E{(bf16*)(F.ws + WS_QM), D, MEM_QSCALE / WQ_SC, nullptr};
        pg8::gemm_phase<EpiBf16, SchedPlain, false, true>(F.lds + RING_OFF, wsb, D / 2, D / 2, D / 2, S, E, nullptr); } SEAM(5);
    if (IN(6)) { PH_BEGIN(); xattn_phase(F); } SEAM(6);
    if (IN(7)) { PH_BEGIN(); SchedPlain S{F.G, (int)blockIdx.x, 128, 4, (unsigned)WS_OB, (unsigned)WS_WO_T, TSTEP / 2, TSTEP / 2, 0u, 0u, 0u}; EpiBf16 E{(bf16*)(F.ws + WS_QM), D, 1.0f / (WO_SC * OB_SC), nullptr};
        pg8::gemm_phase<EpiBf16, SchedPlain, false, true>(F.lds + RING_OFF, wsb, D / 2, D / 2, D / 2, S, E, nullptr); } SEAM(7);
    if (IN(8)) { PH_BEGIN(); ln2_router_phase(F); } SEAM(8);
    if (IN(9)) for (int rep = 0; rep < REPS(9); ++rep) { PH_BEGIN(); moe_table(F, tb); moe_units(F, tb, tb + 704, 8, (unsigned)WS_HB8, (unsigned)WS_WGU_T, 2048u * 1024u, true);
        SchedMoe S{tb + 704}; EpiAct E{F.ws + WS_ACT, F.in[I_B_GU]};
        pg8::gemm_phase<EpiAct, SchedMoe, true, true>(F.lds + RING_OFF, wsb, D / 2, D / 2, D / 2, S, E, (const int*)(F.ws + WS_LTOK)); } SEAM(9);
    if (IN(10)) for (int rep = 0; rep < REPS(10); ++rep) { PH_BEGIN(); moe_table(F, tb); moe_units(F, tb, tb + 704, 4, (unsigned)WS_ACT, (unsigned)WS_WDN_T, 1024u * 1024u, false);
        SchedMoe S{tb + 704}; EpiDown E{F.ws + WS_YS, F.in[I_B_DOWN], (const float*)(F.ws + WS_LGATE)};
        pg8::gemm_phase<EpiDown, SchedMoe, false, true>(F.lds + RING_OFF, wsb, D / 2, D / 2, D / 2, S, E, nullptr); } SEAM(10);
    if (IN(11)) { PH_BEGIN(); moe_table(F, tb); final_phase(F, tb); }
#undef IN
#undef SEAM
}

extern "C" void kernel_launch(void* const* d_in, const int* in_sizes, int n_in, void* d_out, int out_size, void* d_ws, size_t ws_size, hipStream_t stream) {
    static int grid = 0;
    if (grid == 0) {
        if (n_in != N_IN || out_size != M * D || ws_size < WS_END) { fprintf(stderr, "kernel_launch: unexpected shapes (n_in %d, out %d, ws %zu)\n", n_in, out_size, ws_size); grid = -1; return; }
        int dev = 0, cus = 0, per_cu = 0;
        if (hipGetDevice(&dev) != hipSuccess || hipDeviceGetAttribute(&cus, hipDeviceAttributeMultiprocessorCount, dev) != hipSuccess) { grid = -1; return; }
        if (hipFuncSetAttribute((const void*)mk_fwd, hipFuncAttributeMaxDynamicSharedMemorySize, LDS_BYTES) != hipSuccess) { fprintf(stderr, "kernel_launch: hipFuncSetAttribute failed\n"); grid = -1; return; }
        if (hipOccupancyMaxActiveBlocksPerMultiprocessor(&per_cu, (const void*)mk_fwd, NWAVES * 64, LDS_BYTES) != hipSuccess || per_cu < 1) fprintf(stderr, "kernel_launch: occupancy query says %d\n", per_cu);
        (void)hipGetLastError();
        grid = cus;
    }
    if (grid < 0) return;
    if (hipMemsetAsync((char*)d_ws + WS_CTL, 0, CTL_ZERO_BYTES, stream) != hipSuccess) return;
    Args a{};
    for (int i = 0; i < N_IN; ++i) a.in[i] = (const float*)d_in[i];
    a.out = (float*)d_out; a.ws = (unsigned char*)d_ws;
#ifdef PROBE_P2
    { a.ph_lo = 0; a.ph_hi = 3; a.li = 0; hipLaunchKernelGGL(mk_fwd, dim3(grid), dim3(NWAVES * 64), LDS_BYTES, stream, a);
      a.ph_lo = 2; a.ph_hi = 3; a.li = 1; a.pad = PROBE_P2; hipLaunchKernelGGL(mk_fwd, dim3(grid), dim3(NWAVES * 64), LDS_BYTES, stream, a); a.pad = 0;
      a.ph_lo = 3; a.ph_hi = NPHASE; a.li = 2; hipLaunchKernelGGL(mk_fwd, dim3(grid), dim3(NWAVES * 64), LDS_BYTES, stream, a); return; }
#endif
    for (int li = 0; li < MK_N_LAUNCHES; ++li) {
        a.ph_lo = (MK_N_LAUNCHES == 1) ? 0 : li; a.ph_hi = (MK_N_LAUNCHES == 1) ? NPHASE : li + 1; a.li = (MK_N_LAUNCHES == 1) ? 0 : li;
        hipLaunchKernelGGL(mk_fwd, dim3(grid), dim3(NWAVES * 64), LDS_BYTES, stream, a);
        if (hipPeekAtLastError() != hipSuccess) { fprintf(stderr, "kernel_launch: launch %d failed\n", li); break; }
    }
#ifdef PROBE_PHASES
    { const int pp[] = {PROBE_PHASES}; for (int ph : pp) { a.ph_lo = ph; a.ph_hi = ph + 1; a.li = 15; hipLaunchKernelGGL(mk_fwd, dim3(grid), dim3(NWAVES * 64), LDS_BYTES, stream, a); } }
#endif
}
```

```cpp
#include <hip/hip_runtime.h>
#include <cstdio>
#include <cstdint>

#ifndef MK_N_LAUNCHES
#define MK_N_LAUNCHES 1
#endif

#define GAS __attribute__((address_space(1)))
#define LAS __attribute__((address_space(3)))
typedef unsigned short bf16;
typedef short bf16x8 __attribute__((ext_vector_type(8)));
typedef float f32x4 __attribute__((ext_vector_type(4)));
typedef float f32x2 __attribute__((ext_vector_type(2)));
typedef unsigned u32x4 __attribute__((ext_vector_type(4)));
typedef unsigned u32x2 __attribute__((ext_vector_type(2)));
typedef GAS unsigned gu32;
#define RLX_AGENT __ATOMIC_RELAXED, __HIP_MEMORY_SCOPE_AGENT
#define LDS_WAIT() asm volatile("s_waitcnt lgkmcnt(0)" ::: "memory")
#define VM_WAIT() asm volatile("s_waitcnt vmcnt(0)" ::: "memory")

constexpr int NB = 8, T_ = 4096, D = 1024, M = NB * T_, NMEM = 256, MM = NB * NMEM;
constexpr int CONV_CH = 512, SBH = 8, SBD = 64, SBW = 512, CWID = 31, NE = 32, TOPK = 4, DFF = 1024;
constexpr int INC = 2560;
constexpr float LN_EPS = 1e-5f;
constexpr float DN_ALPHA = 1.189207115002721f;
constexpr float LOG2E = 1.4426950408889634f;
constexpr float SB_QSCALE = 0.125f * LOG2E;
constexpr float MEM_QSCALE = 0.0625f * LOG2E;
constexpr float WGU_SC = 32.0f, WDN_SC = 64.0f, WQ_SC = 32.0f, WO_SC = 64.0f, OB_SC = 16.0f, YS_SC = 16.0f, CA_SC = 64.0f, WOUT_SC = 64.0f, MIX_SC = 16.0f;
constexpr float WGU_SC_UNUSED = 0.f;
constexpr int NBLK_MAX = M * TOPK / 256 + NE;
constexpr int LCAP = M;

constexpr size_t MiB = 1u << 20;
constexpr size_t WS_CTL = 0, CTL_ZERO_BYTES = 1 * MiB;
constexpr size_t WS_WIN_T = 1 * MiB;
constexpr size_t WS_WOUT_T = 6 * MiB;
constexpr size_t WS_WQ_T = 8 * MiB, WS_WK_T = 10 * MiB, WS_WV_T = 12 * MiB, WS_WO_T = 14 * MiB;
constexpr size_t WS_WGU_T = 16 * MiB;
constexpr size_t WS_WDN_T = 144 * MiB;
constexpr size_t WS_HB8 = 176 * MiB;
constexpr size_t WS_HB = 208 * MiB;
constexpr size_t WS_LTOK = 272 * MiB;
constexpr size_t WS_LGATE = 276 * MiB;
constexpr size_t WS_SIDX = 280 * MiB;
constexpr size_t WS_WR = 281 * MiB;
constexpr size_t WS_HB2 = 832 * MiB;
constexpr size_t WS_X = 288 * MiB;
constexpr size_t WS_U = WS_X;
constexpr size_t WS_Q = WS_X + 32 * MiB;
constexpr size_t WS_K = WS_X + 64 * MiB;
constexpr size_t WS_V = WS_X + 96 * MiB;
constexpr size_t WS_MIXIN = WS_X + 128 * MiB;
constexpr size_t WS_QM = WS_X + 192 * MiB;
constexpr size_t WS_SP = WS_X + 256 * MiB;
constexpr size_t WS_OB = WS_X + 320 * MiB;
constexpr size_t WS_MEMN = WS_X + 384 * MiB;
constexpr size_t WS_KM = WS_X + 388 * MiB;
constexpr size_t WS_VMT = WS_X + 392 * MiB;
constexpr size_t WS_ACT = WS_X;
constexpr size_t WS_YS = WS_X + 272 * MiB;
constexpr size_t WS_END = 896 * MiB;
constexpr int CW_TMO = 0, CW_CODE = 1;
constexpr int CW_BAR = 4096;
constexpr int CW_ECNT = 131072;
constexpr int NPHASE = 12;

constexpr int RING_OFF = 0, RING_BYTES = 131072;
constexpr int LDS_BYTES = 163840;
constexpr int LDSCTL_OFF = LDS_BYTES - 1024, MISC_OFF = LDSCTL_OFF + 320;
constexpr int XTRA_OFF = RING_BYTES;
constexpr int TB_OFF = XTRA_OFF + 20480;
constexpr int WR_STRIDE = 1032;
constexpr int WR_ST_OFF = 2 * 32 * WR_STRIDE * 2;
constexpr int P10_WR = 0, P10_GB = 2 * 32 * WR_STRIDE * 2, P10_LCNT = P10_GB + 8192, P10_REC = P10_LCNT + 512;
static_assert(P10_REC + 8192 <= TB_OFF && TB_OFF + 4 * (704 + 8 * 40) <= LDSCTL_OFF, "LDS map");
constexpr int NWAVES = 8;
#ifndef MK_NATT
#define MK_NATT 6
#endif
constexpr int NATT = MK_NATT;

__device__ __forceinline__ unsigned f2bf(float f) { unsigned u = __builtin_bit_cast(unsigned, f); return (u + 0x7fffu + ((u >> 16) & 1u)) >> 16; }
__device__ __forceinline__ unsigned pk2(float lo, float hi) { unsigned r; asm("v_cvt_pk_bf16_f32 %0, %1, %2" : "=v"(r) : "v"(lo), "v"(hi)); return r; }
__device__ __forceinline__ float bflo(unsigned u) { return __builtin_bit_cast(float, u << 16); }
__device__ __forceinline__ float bfhi(unsigned u) { return __builtin_bit_cast(float, u & 0xffff0000u); }
#define DPP_F(v, ctrl) __builtin_bit_cast(float, __builtin_amdgcn_update_dpp(0, __builtin_bit_cast(int, (v)), (ctrl), 0xf, 0xf, true))
#define RDL_F(v, l) __builtin_bit_cast(float, __builtin_amdgcn_readlane(__builtin_bit_cast(int, (v)), (l)))
__device__ __forceinline__ float wave_sum(float v) {
    v += DPP_F(v, 0xB1); v += DPP_F(v, 0x4E); v += DPP_F(v, 0x141); v += DPP_F(v, 0x140);
    return (RDL_F(v, 0) + RDL_F(v, 16)) + (RDL_F(v, 32) + RDL_F(v, 48));
}
__device__ __forceinline__ float wave_max(float v) {
    v = fmaxf(v, DPP_F(v, 0xB1)); v = fmaxf(v, DPP_F(v, 0x4E)); v = fmaxf(v, DPP_F(v, 0x141)); v = fmaxf(v, DPP_F(v, 0x140));
    return fmaxf(fmaxf(RDL_F(v, 0), RDL_F(v, 16)), fmaxf(RDL_F(v, 32), RDL_F(v, 48)));
}
__device__ __forceinline__ unsigned pk4_fp8(float a, float b, float c, float d) {
    int r = __builtin_amdgcn_cvt_pk_fp8_f32(a, b, 0, false); r = __builtin_amdgcn_cvt_pk_fp8_f32(c, d, r, true); return (unsigned)r; }
__device__ __forceinline__ float sigmoidf_fast(float x) { return __builtin_amdgcn_rcpf(1.0f + __expf(-x)); }

namespace pg8 {
constexpr int BM = 256, BK = 64, HALF = 128, HTB = HALF * BK * 2, STAGE_BYTES = 8 * HTB, NXCD = 8, WGM = 8;
__host__ __device__ __forceinline__ int lds_byte(int r, int c) { const int st = (r >> 4) * 2 + (c >> 5), rr = r & 15, cc = c & 31, ob = rr * 64 + cc * 2; return st * 1024 + (ob ^ (((ob >> 9) & 1) << 5)); }
__host__ __device__ __forceinline__ void stage_rc(int b, int& R, int& C) { const int st = b / 1024, sb = b % 1024, swz = sb ^ (((sb >> 9) & 1) << 5); R = (st >> 1) * 16 + swz / 64; C = (st & 1) * 32 + (swz % 64) / 2; }
__host__ __device__ __forceinline__ int perm32(int rho) { const int n = rho >> 4, i = rho & 15; return 8 * (i >> 2) + 4 * n + (i & 3); }

struct Unit { int pm, pn, z, nvalid; unsigned aoff, boff, goff; };

__device__ __forceinline__ void tile_order(int L, int nM, int nN, int& pm, int& pn) {
    const int nwg = nM * nN; int wgid = L;
    { const int q = nwg / NXCD, r = nwg % NXCD, xcd = wgid % NXCD, off = wgid / NXCD; wgid = (xcd < r ? xcd * (q + 1) : r * (q + 1) + (xcd - r) * q) + off; }
    const int nig = WGM * nN, gid = wgid / nig, fm = gid * WGM, gsz = (nM - fm) < WGM ? (nM - fm) : WGM;
    pm = fm + ((wgid % nig) % gsz); pn = (wgid % nig) / gsz;
}
__device__ __forceinline__ unsigned cvt_pk_bf16(float lo, float hi) { unsigned r; asm volatile("v_cvt_pk_bf16_f32 %0, %1, %2" : "=v"(r) : "v"(lo), "v"(hi)); return r; }

__device__ __forceinline__ void store_tile_bf16(const f32x4 (&acc)[2][2][4][2], bf16* p0, size_t ldc, const float* bias, float scale, int wc, int fq) {
    const int cl = wc * 32 + 8 * fq;
    f32x4 bv[2][2];
#pragma unroll
    for (int bj = 0; bj < 2; ++bj)
#pragma unroll
        for (int n = 0; n < 2; ++n) bv[bj][n] = bias ? *(const f32x4*)(bias + cl + bj * HALF + 4 * n) : (f32x4){0.f, 0.f, 0.f, 0.f};
#pragma unroll
    for (int ai = 0; ai < 2; ++ai)
#pragma unroll
        for (int m = 0; m < 4; ++m) { bf16* rowp = p0 + (size_t)(ai * HALF + m * 16) * ldc + cl;
#pragma unroll
            for (int bj = 0; bj < 2; ++bj) { const f32x4 v0 = (acc[ai][bj][m][0] + bv[bj][0]) * scale, v1 = (acc[ai][bj][m][1] + bv[bj][1]) * scale;
                u32x4 w; w.x = cvt_pk_bf16(v0[0], v0[1]); w.y = cvt_pk_bf16(v0[2], v0[3]); w.z = cvt_pk_bf16(v1[0], v1[1]); w.w = cvt_pk_bf16(v1[2], v1[3]);
                *(u32x4*)(rowp + bj * HALF) = w; } }
}

__device__ __forceinline__ void store_tile_bf16_w(const f32x4 (&acc)[2][2][4][2], bf16* p0, size_t ldc, const float* bias, float scale, int wc, int fq) {
    const int cl = wc * 64 + 8 * fq;
    f32x4 bv[2][2];
#pragma unroll
    for (int bj = 0; bj < 2; ++bj)
#pragma unroll
        for (int n = 0; n < 2; ++n) bv[bj][n] = bias ? *(const f32x4*)(bias + cl + 32 * bj + 4 * n) : (f32x4){0.f, 0.f, 0.f, 0.f};
#pragma unroll
    for (int ai = 0; ai < 2; ++ai)
#pragma unroll
        for (int m = 0; m < 4; ++m) { bf16* rowp = p0 + (size_t)(ai * HALF + m * 16) * ldc + cl;
#pragma unroll
            for (int bj = 0; bj < 2; ++bj) { const f32x4 v0 = (acc[ai][bj][m][0] + bv[bj][0]) * scale, v1 = (acc[ai][bj][m][1] + bv[bj][1]) * scale;
                u32x4 w; w.x = cvt_pk_bf16(v0[0], v0[1]); w.y = cvt_pk_bf16(v0[2], v0[3]); w.z = cvt_pk_bf16(v1[0], v1[1]); w.w = cvt_pk_bf16(v1[2], v1[3]);
                *(u32x4*)(rowp + 32 * bj) = w; } }
}

typedef int v8i __attribute__((ext_vector_type(8)));
template <class T, class = void> struct HasPerm2 { static constexpr bool value = false; };
template <class T> struct HasPerm2<T, decltype((void)T::PERM2)> { static constexpr bool value = true; };
__host__ __device__ __forceinline__ int perm2_col(int bj, int r) { return 64 * (r >> 5) + 16 * ((r >> 2) & 3) + 8 * bj + 4 * ((r >> 4) & 1) + (r & 3); }
__host__ __device__ __forceinline__ int perm2b_col(int bj, int r) { return 64 * (r >> 5) + 32 * bj + 8 * ((r >> 2) & 3) + 4 * ((r >> 4) & 1) + (r & 3); }
template <class T, class = void> struct ATiled { static constexpr bool value = false; };
template <class T> struct ATiled<T, decltype((void)T::ATILED)> { static constexpr bool value = true; };
template <class T, class = void> struct Perm2Kind { static constexpr int value = 0; };
template <class T> struct Perm2Kind<T, decltype((void)T::PERM2)> { static constexpr int value = (int)T::PERM2; };
#ifndef PG8_ALIGN
#define PG8_ALIGN true
#endif
template <class Epi, class Sched, bool GATHER, bool FP8 = false, bool ALIGN_EPI = PG8_ALIGN>
__device__ __forceinline__ void gemm_phase(LAS unsigned char* lds, const char* wsb, const int lda, const int ldb, const int K, const Sched& S, const Epi& E, const int* glist) {
    int tid = threadIdx.x; asm volatile("" : "+v"(tid));
    const int wid = __builtin_amdgcn_readfirstlane(tid >> 6), lane = tid & 63, wr = wid >> 2, wc = wid & 3, fr = lane & 15, fq = lane >> 4;
    const int nt = K / BK;
    unsigned voffA[2], voffB[2], voffB2[2][2];
#pragma unroll
    for (int i = 0; i < 2; ++i) { int R, C; stage_rc(tid * 16 + i * 8192, R, C); const int Rb = Epi::PERM ? ((R & ~31) + perm32(R & 31)) : R;
        voffA[i] = ATiled<Epi>::value ? (unsigned)((R >> 4) * 16 * lda * 2 + ((2 * C) >> 5) * 512 + (R & 15) * 32 + ((2 * C) & 31)) : (unsigned)(R * lda + C) * 2u; voffB[i] = (unsigned)(Rb * ldb + C) * 2u;
        voffB2[0][i] = (unsigned)((Perm2Kind<Epi>::value == 2 ? perm2b_col(0, R) : perm2_col(0, R)) * ldb + C) * 2u; voffB2[1][i] = (unsigned)((Perm2Kind<Epi>::value == 2 ? perm2b_col(1, R) : perm2_col(1, R)) * ldb + C) * 2u; }
    const size_t kstep = (size_t)(BK * 2);
    const size_t kstepA = ATiled<Epi>::value ? (size_t)(BK * 2 * 16) : kstep;
    const size_t hstepA = (size_t)HALF * lda * 2, hstepB = (size_t)HALF * ldb * 2;
    const unsigned ldsw = (unsigned)wid * 1024u;
    const int aoff = lds_byte(wr * 64 + fr, fq * 8), boff = lds_byte(wc * 32 + fr, fq * 8);
    unsigned gc[2][2], gn[2][2];
#define PG8_SA(b, h) (((b) * 2 + (h)) * HTB)
#define PG8_SB(b, h) ((4 + (b) * 2 + (h)) * HTB)
#define PG8_STAGE_B(bufoff, gbase, bj) do { _Pragma("unroll") for (int _i = 0; _i < 2; ++_i) { \
        const char* _q = HasPerm2<Epi>::value ? (const char*)(gbase) + voffB2[bj][_i] : (const char*)(gbase) + (bj) * hstepB + voffB[_i]; \
        __builtin_amdgcn_global_load_lds((const unsigned*)_q, (LAS unsigned*)(lds + (bufoff) + ldsw + _i * 8192), 16, 0, 0); } } while (0)
#define PG8_STAGE_A(bufoff, gbase, h, nx) do { _Pragma("unroll") for (int _i = 0; _i < 2; ++_i) { \
        const char* _p = GATHER ? (const char*)(gbase) + ((nx) ? gn[h][_i] : gc[h][_i]) : (const char*)(gbase) + (h) * hstepA + voffA[_i]; \
        __builtin_amdgcn_global_load_lds((const unsigned*)_p, (LAS unsigned*)(lds + (bufoff) + ldsw + _i * 8192), 16, 0, 0); } } while (0)
#define PG8_LDA(dst, b, h) do { _Pragma("unroll") for (int m = 0; m < 4; ++m) { if constexpr (FP8) { const u32x4 _lo = *(const LAS u32x4*)(lds + PG8_SA(b, h) + aoff + m * 2048), _hi = *(const LAS u32x4*)(lds + PG8_SA(b, h) + aoff + m * 2048 + 1024); \
            dst##8[m] = (v8i){(int)_lo.x, (int)_lo.y, (int)_lo.z, (int)_lo.w, (int)_hi.x, (int)_hi.y, (int)_hi.z, (int)_hi.w}; } \
        else { _Pragma("unroll") for (int k = 0; k < 2; ++k) dst[m][k] = *(const LAS bf16x8*)(lds + PG8_SA(b, h) + aoff + m * 2048 + k * 1024); } } } while (0)
#define PG8_LDB(dst, b, h) do { _Pragma("unroll") for (int n = 0; n < 2; ++n) { if constexpr (FP8) { const u32x4 _lo = *(const LAS u32x4*)(lds + PG8_SB(b, h) + boff + n * 2048), _hi = *(const LAS u32x4*)(lds + PG8_SB(b, h) + boff + n * 2048 + 1024); \
            dst##8[n] = (v8i){(int)_lo.x, (int)_lo.y, (int)_lo.z, (int)_lo.w, (int)_hi.x, (int)_hi.y, (int)_hi.z, (int)_hi.w}; } \
        else { _Pragma("unroll") for (int k = 0; k < 2; ++k) dst[n][k] = *(const LAS bf16x8*)(lds + PG8_SB(b, h) + boff + n * 2048 + k * 1024); } } } while (0)
#define PG8_MMA(ai, bj, At, Bt) do { __builtin_amdgcn_s_setprio(1); if constexpr (FP8) asm volatile("s_nop 1"); _Pragma("unroll") for (int m = 0; m < 4; ++m) _Pragma("unroll") for (int n = 0; n < 2; ++n) { \
        if constexpr (FP8) asm volatile("v_mfma_f32_16x16x128_f8f6f4 %0, %1, %2, %0" : "+v"(acc[ai][bj][m][n]) : "v"(Bt##8[n]), "v"(At##8[m])); \
        else { _Pragma("unroll") for (int k = 0; k < 2; ++k) acc[ai][bj][m][n] = __builtin_amdgcn_mfma_f32_16x16x32_bf16(Bt[n][k], At[m][k], acc[ai][bj][m][n], 0, 0, 0); } } \
        __builtin_amdgcn_s_setprio(0); } while (0)
#define PG8_WAIT_V(n) asm volatile("s_waitcnt vmcnt(" #n ")" ::: "memory")
#define PG8_WAIT_L(n) asm volatile("s_waitcnt lgkmcnt(" #n ")" ::: "memory")
#define PG8_BAR __builtin_amdgcn_s_barrier()
#define PG8_SCHED __builtin_amdgcn_sched_barrier(0)
#define PG8_GIDX(g, u) do { _Pragma("unroll") for (int _h = 0; _h < 2; ++_h) _Pragma("unroll") for (int _i = 0; _i < 2; ++_i) { int _R, _C; stage_rc(tid * 16 + _i * 8192, _R, _C); const int _r = _h * HALF + _R; \
        const int _tok = glist[(u).goff + (_r < (u).nvalid ? _r : (u).nvalid - 1)]; g[_h][_i] = (unsigned)_tok * (unsigned)(lda * 2) + (unsigned)(_C * 2); } } while (0)
    Unit cur, nxt, nn; int ui = 0;
    if (!S.next(0, cur)) return;
    f32x4 acc[2][2][4][2];
#pragma unroll
    for (int a = 0; a < 2; ++a)
#pragma unroll
        for (int b = 0; b < 2; ++b)
#pragma unroll
            for (int m = 0; m < 4; ++m)
#pragma unroll
                for (int n = 0; n < 2; ++n) acc[a][b][m][n] = (f32x4){0.f, 0.f, 0.f, 0.f};
    bf16x8 At[4][2], B0[2][2], B1[2][2];
    v8i At8[4], B08[2], B18[2];
    const char* cA = wsb + cur.aoff; const char* cB = wsb + cur.boff;
    if constexpr (GATHER) { PG8_GIDX(gc, cur); if (S.next(1, nxt)) { PG8_GIDX(gn, nxt); } else { PG8_GIDX(gn, cur); }
        asm volatile("s_waitcnt vmcnt(0)" : "+v"(gc[0][0]), "+v"(gc[0][1]), "+v"(gc[1][0]), "+v"(gc[1][1]), "+v"(gn[0][0]), "+v"(gn[0][1]), "+v"(gn[1][0]), "+v"(gn[1][1]) :: "memory"); }
    else {
#pragma unroll
        for (int h = 0; h < 2; ++h)
#pragma unroll
            for (int i = 0; i < 2; ++i) { gc[h][i] = 0u; gn[h][i] = 0u; } }
    PG8_STAGE_B(PG8_SB(0, 0), cB, 0); PG8_STAGE_B(PG8_SB(0, 1), cB, 1); PG8_STAGE_A(PG8_SA(0, 0), cA, 0, false); PG8_STAGE_A(PG8_SA(0, 1), cA, 1, false);
    if (wr == 1) PG8_BAR;
    PG8_WAIT_V(2); PG8_BAR;
    PG8_STAGE_B(PG8_SB(1, 0), cB + kstep, 0); PG8_STAGE_A(PG8_SA(1, 0), cA + kstepA, 0, false); PG8_STAGE_B(PG8_SB(1, 1), cB + kstep, 1);
    PG8_WAIT_V(6); PG8_BAR;
    for (;;) {
        const bool has_next = S.next(ui + 1, nxt);
        const char* nA = has_next ? wsb + nxt.aoff : cA; const char* nB = has_next ? wsb + nxt.boff : cB;
#pragma clang loop unroll(disable)
        for (int t = 0; t < nt; t += 2) {
            const bool last = (t == nt - 2);
            const char* a1 = cA + (size_t)(t + 1) * kstepA;
            const char* a2 = last ? nA : cA + (size_t)(t + 2) * kstepA; const char* b2 = last ? nB : cB + (size_t)(t + 2) * kstep;
            const char* a3 = a2 + kstepA; const char* b3 = b2 + kstep;
            PG8_LDB(B0, 0, 0); PG8_LDB(B1, 0, 1); PG8_SCHED; PG8_LDA(At, 0, 0); PG8_STAGE_A(PG8_SA(1, 1), a1, 1, false);
            PG8_WAIT_V(8); PG8_WAIT_L(0); PG8_BAR; PG8_MMA(0, 0, At, B0); PG8_MMA(0, 1, At, B1); PG8_BAR; PG8_SCHED;
            PG8_LDA(At, 0, 1); PG8_STAGE_B(PG8_SB(0, 0), b2, 0); PG8_STAGE_B(PG8_SB(0, 1), b2, 1); PG8_STAGE_A(PG8_SA(0, 0), a2, 0, last);
            PG8_WAIT_V(8); PG8_WAIT_L(0); PG8_BAR; PG8_MMA(1, 0, At, B0); PG8_MMA(1, 1, At, B1); PG8_BAR; PG8_SCHED;
            PG8_LDB(B0, 1, 0); PG8_LDB(B1, 1, 1); PG8_SCHED; PG8_LDA(At, 1, 0); PG8_STAGE_A(PG8_SA(0, 1), a2, 1, last);
            PG8_WAIT_V(8); PG8_WAIT_L(0); PG8_BAR; PG8_MMA(0, 0, At, B0); PG8_MMA(0, 1, At, B1); PG8_BAR; PG8_SCHED;
            PG8_LDA(At, 1, 1); PG8_STAGE_B(PG8_SB(1, 0), b3, 0); PG8_STAGE_B(PG8_SB(1, 1), b3, 1); PG8_STAGE_A(PG8_SA(1, 0), a3, 0, last);
            PG8_WAIT_V(8); PG8_WAIT_L(0); PG8_BAR; PG8_MMA(1, 0, At, B0); PG8_MMA(1, 1, At, B1); PG8_BAR; PG8_SCHED;
        }
        if constexpr (FP8) asm volatile("s_nop 15\n\ts_nop 7");
        if constexpr (ALIGN_EPI) { if (wr == 0) PG8_BAR; }
        if constexpr (GATHER) {
#pragma unroll
            for (int h = 0; h < 2; ++h)
#pragma unroll
                for (int i = 0; i < 2; ++i) gc[h][i] = gn[h][i];
            if (has_next && S.next(ui + 2, nn)) { PG8_GIDX(gn, nn); }
        }
        E(acc, cur, wr, wc, fr, fq);
        if constexpr (GATHER) asm volatile("" : "+v"(gn[0][0]), "+v"(gn[0][1]), "+v"(gn[1][0]), "+v"(gn[1][1]));
        if (!has_next) break;
#pragma unroll
        for (int a = 0; a < 2; ++a)
#pragma unroll
            for (int b = 0; b < 2; ++b)
#pragma unroll
                for (int m = 0; m < 4; ++m)
#pragma unroll
                    for (int n = 0; n < 2; ++n) acc[a][b][m][n] = (f32x4){0.f, 0.f, 0.f, 0.f};
        cur = nxt; cA = nA; cB = nB; ++ui;
        if constexpr (ALIGN_EPI) { if (wr == 1) PG8_BAR; }
    }
    PG8_WAIT_V(0);
    if constexpr (!ALIGN_EPI) { if (wr == 0) PG8_BAR; }
    PG8_BAR;
#undef PG8_SA
#undef PG8_SB
#undef PG8_STAGE_A
#undef PG8_STAGE_B
#undef PG8_LDA
#undef PG8_LDB
#undef PG8_MMA
#undef PG8_WAIT_V
#undef PG8_WAIT_L
#undef PG8_BAR
#undef PG8_SCHED
#undef PG8_GIDX
}
}
using pg8::Unit;

#define XB_TMO      128
#define XB_XCNT(j)  (256  + 64 * (j))
#define XB_XSUB(j)  (1280 + 64 * (j))
#define XB_XGEN(j)  (2304 + 64 * (j))
#define XB_TOP      3328
#define XB_TOPGEN   3392
#define XCD_BAR_WORDS 3456
#define XB_SPIN_CAP (1u << 18)
__device__ __forceinline__ unsigned xb_ld(unsigned* p)              { return __hip_atomic_load(p, __ATOMIC_RELAXED, __HIP_MEMORY_SCOPE_AGENT); }
__device__ __forceinline__ unsigned xb_add(unsigned* p, unsigned v) { return __hip_atomic_fetch_add(p, v, __ATOMIC_RELAXED, __HIP_MEMORY_SCOPE_AGENT); }
__device__ __forceinline__ unsigned xb_xcc_id() { return (unsigned)__builtin_amdgcn_s_getreg((3 << 11) | 20) & 0xFu; }
#define XB_SPIN(cond, bar) do { unsigned _sp = 0; while (cond) { __builtin_amdgcn_s_sleep(1); \
    if ((++_sp & 255u) == 0u) { if (xb_ld(&(bar)[XB_TMO])) break; if (_sp > XB_SPIN_CAP) { atomicAdd(&(bar)[XB_TMO], 1u); break; } } } } while (0)
struct XcdBarrier { unsigned* bar; unsigned x; volatile LAS unsigned* st; };
__device__ __forceinline__ XcdBarrier xcd_barrier_post(unsigned* bar, volatile LAS unsigned* st) {
    XcdBarrier b; b.bar = bar; b.x = xb_xcc_id(); b.st = st;
    if (threadIdx.x == 0) (void)xb_add(&bar[XB_XCNT(b.x)], 1u);
    return b;
}
__device__ __forceinline__ void xcd_barrier_complete(unsigned* bar, unsigned x, unsigned& nloc, unsigned& nx) {
    const unsigned G = gridDim.x * gridDim.y * gridDim.z;
    unsigned sum, cnt, mine, sp = 0u;
    for (;;) {
        sum = 0u; cnt = 0u; mine = 0u;
#pragma unroll
        for (unsigned j = 0; j < 16; ++j) { const unsigned c = xb_ld(&bar[XB_XCNT(j)]); sum += c; cnt += (c > 0u) ? 1u : 0u; mine = (j == x) ? c : mine; }
        if (sum == G) break;
        __builtin_amdgcn_s_sleep(1);
        if ((++sp & 255u) == 0u) { if (xb_ld(&bar[XB_TMO])) break; if (sp > XB_SPIN_CAP) { atomicAdd(&bar[XB_TMO], 1u); break; } }
    }
    nloc = mine > 0u ? mine : 1u; nx = cnt > 0u ? cnt : 1u;
}
__device__ __forceinline__ void xcd_barrier(const XcdBarrier& b) {
    asm volatile("s_waitcnt vmcnt(0)" ::: "memory");
    __syncthreads();
    if (threadIdx.x == 0) {
        unsigned* bar = b.bar;
        __builtin_amdgcn_s_waitcnt(0);
        unsigned nloc = b.st[0], nx = b.st[1];
        if (nloc == 0u) { xcd_barrier_complete(bar, b.x, nloc, nx); b.st[0] = nloc; b.st[1] = nx; }
        const unsigned old = xb_add(&bar[XB_XSUB(b.x)], 1u);
        const unsigned gen = old / nloc;
        if (old + 1u == (gen + 1u) * nloc) {
            __builtin_amdgcn_fence(__ATOMIC_RELEASE, "agent");
            asm volatile("s_waitcnt vmcnt(0)" ::: "memory");
            const unsigned og = xb_add(&bar[XB_TOP], 1u);
            const unsigned tg = og / nx;
            if (og + 1u == (tg + 1u) * nx) xb_add(&bar[XB_TOPGEN], 1u);
            else XB_SPIN(xb_ld(&bar[XB_TOPGEN]) == tg, bar);
            __builtin_amdgcn_fence(__ATOMIC_ACQUIRE, "agent");
            xb_add(&bar[XB_XGEN(b.x)], 1u);
            asm volatile("s_waitcnt vmcnt(0)" ::: "memory");
        } else {
            XB_SPIN(xb_ld(&bar[XB_XGEN(b.x)]) == gen, bar);
            __builtin_amdgcn_fence(__ATOMIC_ACQUIRE, "agent");
            asm volatile("s_waitcnt vmcnt(0)" ::: "memory");
        }
    }
    __syncthreads();
}

struct Frame {
    LAS unsigned char* lds;
    volatile LAS unsigned* MISC;
    gu32* ctl;
    unsigned char* ws;
    int tid, lane, wave, vcu, G;
    float* hf;
    const float* const* in;
};
enum In { I_X = 0, I_MEM, I_LN_IN_G, I_LN_IN_B, I_LN_MEM_G, I_LN_MEM_B, I_W_IN, I_B_IN, I_W_DW, I_B_DW, I_LN_CONV_G, I_LN_CONV_B, I_W_OUT, I_B_OUT, I_LN1_G, I_LN1_B,
          I_WQ, I_WK, I_WV, I_WO, I_LN2_G, I_LN2_B, I_W_ROUTER, I_B_ROUTER, I_W_GU, I_B_GU, I_W_DOWN, I_B_DOWN, I_LN3_G, I_LN3_B, N_IN };

__device__ __forceinline__ void p0_transpose_item(const float* W, int K, int N, bf16* WT, int k0, int n0, int drow, LAS float* scr, int lane) {
#pragma unroll 8
    for (int i = 0; i < 32; ++i) { const int kk = 2 * i + (lane >> 5); scr[kk * 33 + (lane & 31)] = W[(size_t)(k0 + kk) * N + n0 + (lane & 31)]; }
    LDS_WAIT(); asm volatile("" ::: "memory");
    const int c = lane & 7;
#pragma unroll
    for (int j = 0; j < 4; ++j) { const int n = (lane >> 3) + 8 * j; const LAS float* s = scr + (8 * c) * 33 + n;
        u32x4 o; o.x = pk2(s[0 * 33], s[1 * 33]); o.y = pk2(s[2 * 33], s[3 * 33]); o.z = pk2(s[4 * 33], s[5 * 33]); o.w = pk2(s[6 * 33], s[7 * 33]);
        *(GAS u32x4*)(WT + (size_t)(drow + n) * K + k0 + 8 * c) = o; }
    LDS_WAIT(); asm volatile("" ::: "memory");
}
__device__ __forceinline__ void ln_row(f32x4 (&v)[4], const float* g, const float* b, int lane) {
    float s = 0.f;
#pragma unroll
    for (int j = 0; j < 4; ++j) s += (v[j].x + v[j].y) + (v[j].z + v[j].w);
    const float mean = wave_sum(s) * (1.f / D); float s2 = 0.f;
#pragma unroll
    for (int j = 0; j < 4; ++j) { v[j] = v[j] - mean; s2 += (v[j].x * v[j].x + v[j].y * v[j].y) + (v[j].z * v[j].z + v[j].w * v[j].w); }
    const float rstd = 1.f / sqrtf(wave_sum(s2) * (1.f / D) + LN_EPS);
#pragma unroll
    for (int j = 0; j < 4; ++j) { const f32x4 gg = ((const GAS f32x4*)g)[lane + 64 * j], bb = ((const GAS f32x4*)b)[lane + 64 * j]; v[j] = v[j] * rstd * gg + bb; }
}
__device__ __forceinline__ void store_row_bf16(const f32x4 (&v)[4], bf16* orow, int lane) {
    GAS u32x2* o8 = (GAS u32x2*)orow + lane;
#pragma unroll
    for (int j = 0; j < 4; ++j) o8[64 * j] = (u32x2){pk2(v[j].x, v[j].y), pk2(v[j].z, v[j].w)};
}
__device__ __forceinline__ void item8_load(f32x4 (&x)[4][4], const float* W, int N, int k0, int n0, int lane) {
    const int g = lane >> 3, c = lane & 7;
#pragma unroll
    for (int q = 0; q < 4; ++q)
#pragma unroll
        for (int j = 0; j < 4; ++j) x[q][j] = __builtin_nontemporal_load((const GAS f32x4*)(W + (size_t)(k0 + 32 * q + 4 * g + j) * N + n0 + 4 * c));
}
__device__ __forceinline__ void item8_finish(const f32x4 (&x)[4][4], int K, unsigned char* WT, int k0, int drow, float sc, LAS unsigned char* scr, int lane) {
    const int g = lane >> 3, c = lane & 7;
#pragma unroll
    for (int q = 0; q < 4; ++q)
#pragma unroll
        for (int e = 0; e < 4; ++e) *(LAS unsigned*)(scr + (4 * c + e) * 144 + 32 * q + 4 * g) = pk4_fp8(x[q][0][e] * sc, x[q][1][e] * sc, x[q][2][e] * sc, x[q][3][e] * sc);
    LDS_WAIT(); asm volatile("" ::: "memory");
#pragma unroll
    for (int i = 0; i < 4; ++i) { const int t = lane + 64 * i, n = t >> 3, ch = t & 7;
        __builtin_nontemporal_store(*(const LAS u32x4*)(scr + n * 144 + 16 * ch), (GAS u32x4*)(WT + (size_t)(drow + n) * K + k0 + 16 * ch)); }
    LDS_WAIT(); asm volatile("" ::: "memory");
}
__device__ __forceinline__ void p0_transpose_item8b(const float* W, int K, int N, unsigned char* WT, int k0, int n0, int drow, float sc, LAS unsigned char* scr, int lane) {
    f32x4 x[4][4]; item8_load(x, W, N, k0, n0, lane); item8_finish(x, K, WT, k0, drow, sc, scr, lane);
}
__device__ __forceinline__ void load_row_bf16(f32x4 (&v)[4], const bf16* xrow, int lane) {
    const GAS u32x2* xr = (const GAS u32x2*)xrow + lane;
#pragma unroll
    for (int j = 0; j < 4; ++j) { const u32x2 w = xr[64 * j]; v[j] = (f32x4){bflo(w.x), bfhi(w.x), bflo(w.y), bfhi(w.y)}; }
}
__device__ __forceinline__ void load_row_bf16_nt(f32x4 (&v)[4], const bf16* xrow, int lane) {
    const GAS u32x2* xr = (const GAS u32x2*)xrow + lane;
#pragma unroll
    for (int j = 0; j < 4; ++j) { const u32x2 w = __builtin_nontemporal_load(xr + 64 * j); v[j] = (f32x4){bflo(w.x), bfhi(w.x), bflo(w.y), bfhi(w.y)}; }
}
__device__ __forceinline__ void load_row_f32_nt(f32x4 (&v)[4], const float* xrow, int lane) {
    const GAS f32x4* xr = (const GAS f32x4*)xrow + lane;
#pragma unroll
    for (int j = 0; j < 4; ++j) v[j] = __builtin_nontemporal_load(xr + 64 * j);
}
__device__ __forceinline__ void store_row_f32_nt(const f32x4 (&v)[4], float* orow, int lane) {
    GAS f32x4* o = (GAS f32x4*)orow + lane;
#pragma unroll
    for (int j = 0; j < 4; ++j) __builtin_nontemporal_store(v[j], o + 64 * j);
}
__device__ __forceinline__ void load_row_f32(f32x4 (&v)[4], const float* xrow, int lane) {
    const GAS f32x4* xr = (const GAS f32x4*)xrow + lane;
#pragma unroll
    for (int j = 0; j < 4; ++j) v[j] = xr[64 * j];
}
__device__ __forceinline__ void store_row_f32(const f32x4 (&v)[4], float* orow, int lane) {
    GAS f32x4* o = (GAS f32x4*)orow + lane;
#pragma unroll
    for (int j = 0; j < 4; ++j) o[64 * j] = v[j];
}

constexpr int I_GU = NE * 8 * 64, I_DN = NE * 8 * 32, N_EXPERT_ITEMS = I_GU + I_DN;
struct ExpItem { const float* W; unsigned char* WT; int K, N, k0, n0, drow; float sc; };
__device__ __forceinline__ ExpItem expert_item_decode(Frame& F, int it) {
    ExpItem x;
    if (it < I_GU) { const int e = it / (8 * 64), q = it % (8 * 64), kb = q / 64, nb = q % 64, n0 = 32 * nb;
        x.W = F.in[I_W_GU] + (size_t)e * D * 2 * DFF; x.WT = F.ws + WS_WGU_T + (size_t)e * 2 * DFF * D; x.K = D; x.N = 2 * DFF; x.k0 = 128 * kb; x.n0 = n0;
        x.drow = (n0 < 1024) ? (n0 >> 7) * 256 + (n0 & 127) : ((n0 - 1024) >> 7) * 256 + 128 + (n0 & 127); x.sc = WGU_SC; }
    else { const int r = it - I_GU, e = r / (8 * 32), q = r % (8 * 32), kb = q / 32, nb = q % 32;
        x.W = F.in[I_W_DOWN] + (size_t)e * DFF * D; x.WT = F.ws + WS_WDN_T + (size_t)e * D * DFF; x.K = DFF; x.N = D; x.k0 = 128 * kb; x.n0 = 32 * nb; x.drow = 32 * nb; x.sc = WDN_SC; }
    return x;
}
__device__ __forceinline__ void expert_stream(Frame& F, int sw, int nsw, int iend, LAS unsigned char* scr) {
    for (int it = sw; it < iend; it += 3 * nsw) {
        const int it2 = it + nsw, it3 = it + 2 * nsw; const bool two = it2 < iend, three = it3 < iend;
        const ExpItem a = expert_item_decode(F, it), b = expert_item_decode(F, two ? it2 : it), c = expert_item_decode(F, three ? it3 : it);
        f32x4 xa[4][4], xb[4][4], xc[4][4];
        item8_load(xa, a.W, a.N, a.k0, a.n0, F.lane);
        if (two) item8_load(xb, b.W, b.N, b.k0, b.n0, F.lane);
        if (three) item8_load(xc, c.W, c.N, c.k0, c.n0, F.lane);
        item8_finish(xa, a.K, a.WT, a.k0, a.drow, a.sc, scr, F.lane);
        if (two) item8_finish(xb, b.K, b.WT, b.k0, b.drow, b.sc, scr + 5120, F.lane);
        if (three) item8_finish(xc, c.K, c.WT, c.k0, c.drow, c.sc, scr + 10240, F.lane);
    }
}
__device__ __forceinline__ void p0_prologue(Frame& F) {
    LAS float* scr = (LAS float*)(F.lds + RING_OFF + F.wave * 16384);
    const int gw = F.vcu * NWAVES + F.wave, NGW = F.G * NWAVES;
    constexpr int I_IN = 16 * 80, I_SQ = 16 * 32;
    constexpr int NITEMS = I_IN + 2 * I_SQ + 3 * 256;
    constexpr int P0_IW = 2, P0_RI = 8;
    const int NIW = F.G * P0_IW, NOW = F.G * (NWAVES - P0_IW);
    const bool itemw = F.wave < P0_IW;
    if (itemw) for (int it = F.vcu * P0_IW + F.wave; it < NITEMS; it += NIW) {
        int r = it;
        if (r < I_IN) { const int kb = r / 80, nb = r % 80, n0 = 32 * nb; int drow;
            if (n0 < 512) drow = (n0 >> 7) * 256 + 2 * (n0 & 127); else if (n0 < 1024) drow = ((n0 - 512) >> 7) * 256 + 2 * (n0 & 127) + 32; else drow = n0;
            p0_transpose_item(F.in[I_W_IN], D, INC, (bf16*)(F.ws + WS_WIN_T), 64 * kb, n0, drow, scr, F.lane); continue; } r -= I_IN;
        if (r < 2 * I_SQ) { const int w = r / I_SQ, q = r % I_SQ, kb = q / 32, nb = q % 32;
            const float* src = F.in[w == 0 ? I_WK : I_WV];
            bf16* dst = (bf16*)(F.ws + (w == 0 ? WS_WK_T : WS_WV_T));
            p0_transpose_item(src, D, D, dst, 64 * kb, 32 * nb, 32 * nb, scr, F.lane); continue; } r -= 2 * I_SQ;
        { const int w = r / 256, q = r % 256, kb = q / 32, nb = q % 32;
            p0_transpose_item8b(F.in[w == 0 ? I_WQ : w == 1 ? I_WO : I_W_OUT], D, D, F.ws + (w == 0 ? WS_WQ_T : w == 1 ? WS_WO_T : WS_WOUT_T), 128 * kb, 32 * nb, 32 * nb, w == 0 ? WQ_SC : w == 1 ? WO_SC : WOUT_SC, (LAS unsigned char*)scr, F.lane); }
    }
    if (gw < 512) { const int idx = gw * 64 + F.lane, c = idx >> 5, e = idx & 31; const float w = F.in[I_W_ROUTER][idx] * F.in[I_LN2_G][c];
        const unsigned hi = f2bf(w), lo = f2bf(w - __builtin_bit_cast(float, hi << 16)); bf16* wr = (bf16*)(F.ws + WS_WR);
        wr[e * WR_STRIDE + c] = (bf16)hi; wr[(32 + e) * WR_STRIDE + c] = (bf16)lo; }
    else if (gw < 512 + NE) { const int e = gw - 512; float sg = 0.f, sb = 0.f;
#pragma unroll 4
        for (int k = F.lane; k < D; k += 64) { const float w = F.in[I_W_ROUTER][k * NE + e]; sg += F.in[I_LN2_G][k] * w; sb += F.in[I_LN2_B][k] * w; }
        sg = wave_sum(sg); sb = wave_sum(sb);
        if (F.lane == 0) { float* st = (float*)(F.ws + WS_WR + WR_ST_OFF); st[e] = sg; st[NE + e] = sb + F.in[I_B_ROUTER][e]; } }
    int rbeg, rstep, rend;
    { const int split = (NIW * P0_RI < M + MM) ? NIW * P0_RI : M + MM;
        if (itemw) { rbeg = F.vcu * P0_IW + F.wave; rstep = NIW; rend = split; } else { rbeg = split + F.vcu * (NWAVES - P0_IW) + (F.wave - P0_IW); rstep = NOW; rend = M + MM; } }
#pragma unroll 2
    for (int m = rbeg; m < rend; m += rstep) {
        f32x4 v[4];
        if (m < M) { load_row_f32_nt(v, F.in[I_X] + (size_t)m * D, F.lane); ln_row(v, F.in[I_LN_IN_G], F.in[I_LN_IN_B], F.lane);
            store_row_bf16(v, (bf16*)(F.ws + WS_HB) + (size_t)m * D, F.lane); }
        else { const int mm = m - M; load_row_f32(v, F.in[I_MEM] + (size_t)mm * D, F.lane); ln_row(v, F.in[I_LN_MEM_G], F.in[I_LN_MEM_B], F.lane);
            store_row_bf16(v, (bf16*)(F.ws + WS_MEMN) + (size_t)mm * D, F.lane); }
    }
}

constexpr unsigned TSTEP = 256u * 1024u * 2u;
struct SchedP1 { int G, c;
    __device__ __forceinline__ bool next(int i, Unit& u) const {
        const int L = i * G + c; if (L >= 1280) return false;
        u.nvalid = 256; u.goff = 0;
        if (L < 1024) { pg8::tile_order(L, 128, 8, u.pm, u.pn); u.z = 0; u.aoff = (unsigned)WS_HB + (unsigned)u.pm * TSTEP; u.boff = (unsigned)WS_WIN_T + (unsigned)u.pn * TSTEP; }
        else { const int j = L - 1024; u.pm = j & 1; u.pn = j >> 1; u.z = 3; u.aoff = (unsigned)WS_WIN_T + (unsigned)(8 + u.pm) * TSTEP; u.boff = (unsigned)WS_HB + (unsigned)u.pn * TSTEP; }
        return true; }
};
struct SchedKV { int v;
    __device__ __forceinline__ bool next(int i, Unit& u) const {
        if (i > 0 || v >= 64) return false;
        u.nvalid = 256; u.goff = 0;
        if (v < 32) { u.pm = v & 7; u.pn = v >> 3; u.z = 1; u.aoff = (unsigned)WS_MEMN + (unsigned)u.pm * TSTEP; u.boff = (unsigned)WS_WK_T + (unsigned)u.pn * TSTEP; }
        else { const int j = v - 32; u.pm = j & 3; u.pn = j >> 2; u.z = 2; u.aoff = (unsigned)WS_WV_T + (unsigned)u.pm * TSTEP; u.boff = (unsigned)WS_MEMN + (unsigned)u.pn * TSTEP; }
        return true; }
};
struct EpiP1 { static constexpr bool PERM = true; static constexpr int PERM2 = 2;
    unsigned char* ws; const float* b_in;
    __device__ __forceinline__ void operator()(const f32x4 (&acc)[2][2][4][2], const Unit& u, int wr, int wc, int fr, int fq) const {
        const int row0 = u.pm * 256 + wr * 64 + fr;
        if (u.z == 0) {
            if (u.pn < 4) {
                const int ch = 128 * u.pn + wc * 32 + 8 * fq;
                f32x4 bv[2], bg[2];
#pragma unroll
                for (int n = 0; n < 2; ++n) { bv[n] = *(const f32x4*)(b_in + ch + 4 * n); bg[n] = *(const f32x4*)(b_in + 512 + ch + 4 * n); }
                bf16* U = (bf16*)(ws + WS_U);
#pragma unroll
                for (int ai = 0; ai < 2; ++ai)
#pragma unroll
                    for (int m = 0; m < 4; ++m) { f32x4 o[2];
#pragma unroll
                        for (int n = 0; n < 2; ++n) { const f32x4 a = acc[ai][0][m][n] + bv[n], g = acc[ai][1][m][n] + bg[n];
#pragma unroll
                            for (int j = 0; j < 4; ++j) o[n][j] = a[j] * sigmoidf_fast(g[j]); }
                        u32x4 w; w.x = pg8::cvt_pk_bf16(o[0][0], o[0][1]); w.y = pg8::cvt_pk_bf16(o[0][2], o[0][3]); w.z = pg8::cvt_pk_bf16(o[1][0], o[1][1]); w.w = pg8::cvt_pk_bf16(o[1][2], o[1][3]);
                        *(u32x4*)(U + (size_t)(row0 + ai * 128 + m * 16) * 512 + ch) = w; }
            } else {
                const int t = u.pn - 4, which = t >> 1, cb = (t & 1) * 256;
                bf16* dst = (bf16*)(ws + (which == 0 ? WS_Q : WS_K));
                pg8::store_tile_bf16_w(acc, dst + (size_t)row0 * 512 + cb, 512, b_in + 1024 + 256 * t, which == 0 ? SB_QSCALE : 1.0f, wc, fq);
            }
        } else if (u.z == 3) {
            const float* rb = b_in + 2048 + row0; bf16* p0 = (bf16*)(ws + WS_V) + (size_t)row0 * M + 256 * u.pn; const int cl = wc * 64 + 8 * fq;
#pragma unroll
            for (int ai = 0; ai < 2; ++ai)
#pragma unroll
                for (int m = 0; m < 4; ++m) { const float bv = rb[ai * 128 + m * 16]; bf16* rowp = p0 + (size_t)(ai * 128 + m * 16) * M + cl;
#pragma unroll
                    for (int bj = 0; bj < 2; ++bj) { const f32x4 v0 = acc[ai][bj][m][0] + bv, v1 = acc[ai][bj][m][1] + bv;
                        u32x4 w; w.x = pg8::cvt_pk_bf16(v0[0], v0[1]); w.y = pg8::cvt_pk_bf16(v0[2], v0[3]); w.z = pg8::cvt_pk_bf16(v1[0], v1[1]); w.w = pg8::cvt_pk_bf16(v1[2], v1[3]);
                        *(u32x4*)(rowp + bj * 32) = w; } }
        } else if (u.z == 1) pg8::store_tile_bf16_w(acc, (bf16*)(ws + WS_KM) + (size_t)row0 * 1024 + 256 * u.pn, 1024, nullptr, 1.0f, wc, fq);
        else pg8::store_tile_bf16_w(acc, (bf16*)(ws + WS_VMT) + (size_t)row0 * 2048 + 256 * u.pn, 2048, nullptr, 1.0f, wc, fq);
    }
};

struct SchedPlain { int G, c, nM, nN; unsigned abase, bbase, atile, btile, acol, bcol, bgrp;
    __device__ __forceinline__ bool next(int i, Unit& u) const {
        const int L = i * G + c; if (L >= nM * nN) return false;
        pg8::tile_order(L, nM, nN, u.pm, u.pn); u.z = 0; u.nvalid = 256; u.goff = 0;
        u.aoff = abase + (unsigned)u.pm * atile + (unsigned)u.pn * acol; u.boff = bbase + (unsigned)u.pn * btile + (unsigned)(u.pm >> 4) * bgrp + (unsigned)u.pn * bcol; return true; }
};
struct EpiBf16 { static constexpr bool PERM = true; static constexpr int PERM2 = 2;
    bf16* O; int ldc; float scale; const float* bias;
    __device__ __forceinline__ void operator()(const f32x4 (&acc)[2][2][4][2], const Unit& u, int wr, int wc, int fr, int fq) const {
        const int cl = 256 * u.pn + 64 * wc + 8 * fq; bf16* p0 = O + (size_t)(u.pm * 256 + wr * 64 + fr) * ldc + cl;
        f32x4 bv[2][2];
#pragma unroll
        for (int bj = 0; bj < 2; ++bj)
#pragma unroll
            for (int n = 0; n < 2; ++n) bv[bj][n] = bias ? *(const f32x4*)(bias + cl + 32 * bj + 4 * n) : (f32x4){0.f, 0.f, 0.f, 0.f};
#pragma unroll
        for (int ai = 0; ai < 2; ++ai)
#pragma unroll
            for (int m = 0; m < 4; ++m) { bf16* rowp = p0 + (size_t)(ai * 128 + m * 16) * ldc;
#pragma unroll
                for (int bj = 0; bj < 2; ++bj) { const f32x4 v0 = acc[ai][bj][m][0] * scale + bv[bj][0], v1 = acc[ai][bj][m][1] * scale + bv[bj][1];
                    u32x4 w; w.x = pg8::cvt_pk_bf16(v0[0], v0[1]); w.y = pg8::cvt_pk_bf16(v0[2], v0[3]); w.z = pg8::cvt_pk_bf16(v1[0], v1[1]); w.w = pg8::cvt_pk_bf16(v1[2], v1[3]);
                    *(u32x4*)(rowp + 32 * bj) = w; } }
    }
};
constexpr int CW_LNC = 65536;
constexpr size_t WS_LNX = WS_QM;
struct SchedOne { int L, nM, nN; unsigned abase, bbase, atile, btile;
    __device__ __forceinline__ bool next(int i, Unit& u) const {
        if (i > 0 || L >= nM * nN) return false;
        pg8::tile_order(L, nM, nN, u.pm, u.pn); u.z = 0; u.nvalid = 256; u.goff = 0; u.aoff = abase + (unsigned)u.pm * atile; u.boff = bbase + (unsigned)u.pn * btile; return true; }
};
constexpr int CW_LNC2 = CW_LNC + 8192;
constexpr size_t WS_LNX2 = WS_MIXIN, WS_LNST = WS_MIXIN + 2 * MiB;
template <int MODE> struct EpiLn { static constexpr bool PERM = true; static constexpr int PERM2 = 2;
    unsigned char* ws; gu32* ctl; const float* bias; const float* g; const float* b; LAS unsigned char* lds; float scale;
    __device__ __forceinline__ void operator()(f32x4 (&acc)[2][2][4][2], const Unit& u, int wr, int wc, int fr, int fq) const {
        typedef float f32x2v __attribute__((ext_vector_type(2)));
        LAS f32x2v* P = (LAS f32x2v*)lds;
        LAS f32x2v* S = (LAS f32x2v*)(lds + 8192);
        LAS unsigned* flag = (LAS unsigned*)(lds + 8192 + 2048);
        const int wid = wr * 4 + wc, lane = fq * 16 + fr;
        const int cl = 256 * u.pn + 64 * wc + 8 * fq;
        bf16* hp = (bf16*)(ws + WS_HB) + (size_t)(u.pm * 256 + wr * 64 + fr) * D + cl;
        { f32x4 bv[2][2];
#pragma unroll
            for (int bj = 0; bj < 2; ++bj)
#pragma unroll
                for (int n = 0; n < 2; ++n) bv[bj][n] = (MODE == 1) ? *(const f32x4*)(bias + cl + 32 * bj + 4 * n) : (f32x4){0.f, 0.f, 0.f, 0.f};
            unsigned char* cap = ws + WS_QM + (size_t)(u.pm * 256 + wr * 64 + fr) * D + cl;
#pragma unroll
            for (int ai = 0; ai < 2; ++ai) {
#pragma unroll
                for (int m = 0; m < 4; ++m) { const bf16* rowp = hp + (size_t)(ai * 128 + m * 16) * D;
#pragma unroll
                    for (int bj = 0; bj < 2; ++bj) { const u32x4 hw = *(const GAS u32x4*)(rowp + 32 * bj);
                        f32x4 t0 = acc[ai][bj][m][0] * scale, t1 = acc[ai][bj][m][1] * scale;
                        if (MODE == 2) { typedef float f32x2w __attribute__((ext_vector_type(2)));
                            const unsigned c0 = pk4_fp8(t0[0], t0[1], t0[2], t0[3]), c1 = pk4_fp8(t1[0], t1[1], t1[2], t1[3]);
                            *(GAS u32x2*)(cap + (size_t)(ai * 128 + m * 16) * D + 32 * bj) = (u32x2){c0, c1};
                            const f32x2w a0 = __builtin_amdgcn_cvt_pk_f32_fp8((int)c0, false), a1 = __builtin_amdgcn_cvt_pk_f32_fp8((int)c0, true), a2 = __builtin_amdgcn_cvt_pk_f32_fp8((int)c1, false), a3 = __builtin_amdgcn_cvt_pk_f32_fp8((int)c1, true);
                            t0 = (f32x4){a0.x, a0.y, a1.x, a1.y} * (1.0f / CA_SC); t1 = (f32x4){a2.x, a2.y, a3.x, a3.y} * (1.0f / CA_SC); }
                        acc[ai][bj][m][0] = t0 + bv[bj][0] + (f32x4){bflo(hw.x), bfhi(hw.x), bflo(hw.y), bfhi(hw.y)} * DN_ALPHA;
                        acc[ai][bj][m][1] = t1 + bv[bj][1] + (f32x4){bflo(hw.z), bfhi(hw.z), bflo(hw.w), bfhi(hw.w)} * DN_ALPHA; } }
            } }
#pragma unroll
        for (int ai = 0; ai < 2; ++ai)
#pragma unroll
            for (int m = 0; m < 4; ++m) {
                float sm = 0.f;
#pragma unroll
                for (int bj = 0; bj < 2; ++bj)
#pragma unroll
                    for (int n = 0; n < 2; ++n) { const f32x4 x = acc[ai][bj][m][n]; sm += (x[0] + x[1]) + (x[2] + x[3]); }
                sm += __shfl_xor(sm, 16); sm += __shfl_xor(sm, 32);
                const float mw = sm * (1.0f / 64.0f); float q = 0.f;
#pragma unroll
                for (int bj = 0; bj < 2; ++bj)
#pragma unroll
                    for (int n = 0; n < 2; ++n) { const f32x4 d = acc[ai][bj][m][n] - mw; q += (d[0] * d[0] + d[1] * d[1]) + (d[2] * d[2] + d[3] * d[3]); }
                q += __shfl_xor(q, 16); q += __shfl_xor(q, 32);
                if (fq == 0) P[(ai * 128 + wr * 64 + m * 16 + fr) * 4 + wc] = (f32x2v){mw, q};
            }
        asm volatile("s_waitcnt lgkmcnt(0)" ::: "memory"); __builtin_amdgcn_s_barrier(); asm volatile("" ::: "memory");
        const int row = wid * 32 + (lane & 31);
        unsigned long long* xb = (unsigned long long*)(ws + (MODE == 1 ? WS_LNX : WS_LNX2)) + (size_t)(u.pm * 256 + row) * 4;
        if (lane < 32) {
            const f32x2v a = P[row * 4 + 0], b2 = P[row * 4 + 1], c = P[row * 4 + 2], d = P[row * 4 + 3];
            const float mt = (a.x + b2.x + c.x + d.x) * 0.25f;
            const float da = a.x - mt, db = b2.x - mt, dc = c.x - mt, dd = d.x - mt;
            const float m2 = (a.y + b2.y) + (c.y + d.y) + 64.0f * ((da * da + db * db) + (dc * dc + dd * dd));
            __hip_atomic_store(xb + u.pn, ((unsigned long long)__builtin_bit_cast(unsigned, m2) << 32) | __builtin_bit_cast(unsigned, mt), RLX_AGENT);
        }
        asm volatile("s_waitcnt vmcnt(0)" ::: "memory");
        gu32* cnt = ctl + (MODE == 1 ? CW_LNC : CW_LNC2) + 64 * u.pm;
        if (lane == 0) __hip_atomic_fetch_add(cnt, 1u, RLX_AGENT);
        if (wid == 0) { unsigned spins = 0; bool dead = false;
            while ((unsigned)__builtin_amdgcn_readfirstlane(__hip_atomic_load(cnt, RLX_AGENT)) < 32u) { if (++spins > (1u << 21)) { dead = true; break; } __builtin_amdgcn_s_sleep(2); }
            __builtin_amdgcn_fence(__ATOMIC_ACQUIRE, "agent");
            if (lane == 0) flag[0] = dead ? 1u : 0u; }
        asm volatile("s_waitcnt vmcnt(0) lgkmcnt(0)" ::: "memory"); __builtin_amdgcn_s_barrier(); asm volatile("" ::: "memory");
        const bool bad = flag[0] != 0u;
        if (lane < 32) { float mt[4], m2[4], ms = 0.f;
#pragma unroll
            for (int t = 0; t < 4; ++t) { const unsigned long long w = __hip_atomic_load(xb + t, RLX_AGENT); mt[t] = __builtin_bit_cast(float, (unsigned)w); m2[t] = __builtin_bit_cast(float, (unsigned)(w >> 32)); ms += mt[t]; }
            const float mean = ms * 0.25f; float q = 0.f;
#pragma unroll
            for (int t = 0; t < 4; ++t) { const float dm = mt[t] - mean; q += m2[t] + 256.0f * dm * dm; }
            const f32x2v st = (f32x2v){mean, bad ? __builtin_nanf("") : 1.0f / sqrtf(q * (1.0f / D) + LN_EPS)}; S[row] = st;
            if (MODE == 2 && u.pn == 0) *(GAS f32x2v*)(ws + WS_LNST + (size_t)(u.pm * 256 + row) * 8) = st; }
        asm volatile("s_waitcnt lgkmcnt(0)" ::: "memory"); __builtin_amdgcn_s_barrier(); asm volatile("" ::: "memory");
        f32x4 gv[2][2], bb[2][2];
#pragma unroll
        for (int bj = 0; bj < 2; ++bj)
#pragma unroll
            for (int n = 0; n < 2; ++n) { gv[bj][n] = *(const f32x4*)(g + cl + 32 * bj + 4 * n); bb[bj][n] = *(const f32x4*)(b + cl + 32 * bj + 4 * n); }
        unsigned char* h8 = ws + WS_HB8 + (size_t)(u.pm * 256 + wr * 64 + fr) * D + cl;
#pragma unroll
        for (int ai = 0; ai < 2; ++ai)
#pragma unroll
            for (int m = 0; m < 4; ++m) { const f32x2v sr = S[ai * 128 + wr * 64 + m * 16 + fr]; const size_t ro = (size_t)(ai * 128 + m * 16) * D;
#pragma unroll
                for (int bj = 0; bj < 2; ++bj) { const f32x4 v0 = (acc[ai][bj][m][0] - sr.x) * sr.y * gv[bj][0] + bb[bj][0], v1 = (acc[ai][bj][m][1] - sr.x) * sr.y * gv[bj][1] + bb[bj][1];
                    *(GAS u32x4*)((MODE == 1 ? hp : (bf16*)(ws + WS_HB2) + (size_t)(u.pm * 256 + wr * 64 + fr) * D + cl) + ro + 32 * bj) = (u32x4){pk2(v0[0], v0[1]), pk2(v0[2], v0[3]), pk2(v1[0], v1[1]), pk2(v1[2], v1[3])};
                    *(GAS u32x2*)(h8 + ro + 32 * bj) = (u32x2){pk4_fp8(v0[0], v0[1], v0[2], v0[3]), pk4_fp8(v1[0], v1[1], v1[2], v1[3])}; } }
    }
};
struct EpiFp8 { static constexpr bool PERM = true; static constexpr int PERM2 = 1;
    unsigned char* O; int ldc; float scale;
    __device__ __forceinline__ void operator()(const f32x4 (&acc)[2][2][4][2], const Unit& u, int wr, int wc, int fr, int fq) const {
        const int cl = 256 * u.pn + 64 * wc + 16 * fq; unsigned char* p0 = O + (size_t)(u.pm * 256 + wr * 64 + fr) * ldc + cl;
#pragma unroll
        for (int ai = 0; ai < 2; ++ai)
#pragma unroll
            for (int m = 0; m < 4; ++m) { u32x4 w; const f32x4 a = acc[ai][0][m][0] * scale, b = acc[ai][0][m][1] * scale, c = acc[ai][1][m][0] * scale, d = acc[ai][1][m][1] * scale;
                w.x = pk4_fp8(a[0], a[1], a[2], a[3]); w.y = pk4_fp8(b[0], b[1], b[2], b[3]); w.z = pk4_fp8(c[0], c[1], c[2], c[3]); w.w = pk4_fp8(d[0], d[1], d[2], d[3]);
                *(u32x4*)(p0 + (size_t)(ai * 128 + m * 16) * ldc) = w; }
    }
};
constexpr int MOE_MAX_UNITS = 40;
struct SchedMoe { const LAS int* ut;
    __device__ __forceinline__ bool next(int i, Unit& u) const {
        if (i >= MOE_MAX_UNITS) return false;
        const LAS int* p = ut + 8 * i;
        if (__builtin_amdgcn_readfirstlane(p[7]) == 0) return false;
        u.pm = __builtin_amdgcn_readfirstlane(p[0]); u.pn = __builtin_amdgcn_readfirstlane(p[1]); u.z = __builtin_amdgcn_readfirstlane(p[2]); u.nvalid = __builtin_amdgcn_readfirstlane(p[3]);
        u.aoff = (unsigned)__builtin_amdgcn_readfirstlane(p[4]); u.boff = (unsigned)__builtin_amdgcn_readfirstlane(p[5]); u.goff = (unsigned)__builtin_amdgcn_readfirstlane(p[6]); return true; }
};
__device__ __forceinline__ void moe_units(Frame& F, const LAS int* tb, LAS int* ut, int nN, unsigned abase, unsigned wbase, unsigned wexp, bool gather) {
    if (F.tid < MOE_MAX_UNITS) { const int i = F.tid, nblk = tb[32], L = i * F.G + (int)blockIdx.x; LAS int* p = ut + 8 * i;
        if (L < nblk * nN) { int pm, pn; pg8::tile_order(L, nblk, nN, pm, pn);
            const int e = tb[128 + pm], j = pm - tb[e], rem = tb[64 + e] - 256 * j;
            p[0] = pm; p[1] = pn; p[2] = e; p[3] = rem < 256 ? rem : 256; p[4] = (int)(gather ? abase : abase + (unsigned)pm * (TSTEP / 2));
            p[5] = (int)(wbase + (unsigned)e * wexp + (unsigned)pn * (TSTEP / 2)); p[6] = e * LCAP + 256 * j; p[7] = 1; }
        else p[7] = 0; }
    LDS_WAIT(); __syncthreads();
}
__device__ __forceinline__ f32x2 swiglu_pk(f32x2 g, f32x2 u) {
    f32x2 g_, u_; g_.x = fminf(g.x, 7.0f); g_.y = fminf(g.y, 7.0f); u_.x = __builtin_amdgcn_fmed3f(u.x, -7.0f, 7.0f); u_.y = __builtin_amdgcn_fmed3f(u.y, -7.0f, 7.0f);
    const f32x2 t = g_ * (-1.702f * LOG2E); f32x2 e; e.x = __builtin_amdgcn_exp2f(t.x); e.y = __builtin_amdgcn_exp2f(t.y);
    const f32x2 d = e + 1.0f; f32x2 r; r.x = __builtin_amdgcn_rcpf(d.x); r.y = __builtin_amdgcn_rcpf(d.y);
    return ((u_ + 1.0f) * g_) * r;
}
struct EpiAct { static constexpr bool PERM = true;
    unsigned char* ACT; const float* b_gu;
    __device__ __forceinline__ void operator()(const f32x4 (&acc)[2][2][4][2], const Unit& u, int wr, int wc, int fr, int fq) const {
        const int ch = 128 * u.pn + wc * 32 + 8 * fq;
        unsigned char* ap = ACT + ((size_t)(u.pm * 16 + wr * 4) * (DFF / 32) + (4 * u.pn + wc)) * 512 + fr * 32 + 8 * fq;
        const float* bb = b_gu + (size_t)u.z * 2 * DFF;
        f32x4 bg[2], bu[2];
#pragma unroll
        for (int n = 0; n < 2; ++n) { bg[n] = *(const f32x4*)(bb + ch + 4 * n); bu[n] = *(const f32x4*)(bb + DFF + ch + 4 * n); }
#pragma unroll
        for (int ai = 0; ai < 2; ++ai)
#pragma unroll
            for (int m = 0; m < 4; ++m) { f32x2 o[2][2];
#pragma unroll
                for (int n = 0; n < 2; ++n) { const f32x4 ag = acc[ai][0][m][n], au = acc[ai][1][m][n];
                    o[n][0] = swiglu_pk((f32x2){ag[0], ag[1]} * (1.0f / WGU_SC) + (f32x2){bg[n][0], bg[n][1]}, (f32x2){au[0], au[1]} * (1.0f / WGU_SC) + (f32x2){bu[n][0], bu[n][1]});
                    o[n][1] = swiglu_pk((f32x2){ag[2], ag[3]} * (1.0f / WGU_SC) + (f32x2){bg[n][2], bg[n][3]}, (f32x2){au[2], au[3]} * (1.0f / WGU_SC) + (f32x2){bu[n][2], bu[n][3]}); }
                *(u32x2*)(ap + (size_t)(ai * 8 + m) * (16 * DFF)) = (u32x2){pk4_fp8(o[0][0].x, o[0][0].y, o[0][1].x, o[0][1].y), pk4_fp8(o[1][0].x, o[1][0].y, o[1][1].x, o[1][1].y)}; }
    }
};
struct EpiDown { static constexpr bool PERM = true; static constexpr int PERM2 = 1; static constexpr bool ATILED = true;
    unsigned char* YS; const float* b_down;
    __device__ __forceinline__ void operator()(const f32x4 (&acc)[2][2][4][2], const Unit& u, int wr, int wc, int fr, int fq) const {
        const int r0 = wr * 64 + fr, cl = 256 * u.pn + 64 * wc + 16 * fq;
        const float* bb = b_down + (size_t)u.z * D + cl;
        f32x4 bv[2][2];
#pragma unroll
        for (int bj = 0; bj < 2; ++bj)
#pragma unroll
            for (int n = 0; n < 2; ++n) bv[bj][n] = *(const f32x4*)(bb + 8 * bj + 4 * n) * YS_SC;
#pragma unroll
        for (int ai = 0; ai < 2; ++ai)
#pragma unroll
            for (int m = 0; m < 4; ++m) { const int r = r0 + ai * 128 + m * 16; u32x4 w;
                { const f32x4 a = acc[ai][0][m][0] * (YS_SC / WDN_SC) + bv[0][0], b = acc[ai][0][m][1] * (YS_SC / WDN_SC) + bv[0][1], c = acc[ai][1][m][0] * (YS_SC / WDN_SC) + bv[1][0], d = acc[ai][1][m][1] * (YS_SC / WDN_SC) + bv[1][1];
                    w.x = pk4_fp8(a[0], a[1], a[2], a[3]); w.y = pk4_fp8(b[0], b[1], b[2], b[3]); w.z = pk4_fp8(c[0], c[1], c[2], c[3]); w.w = pk4_fp8(d[0], d[1], d[2], d[3]); }
                *(u32x4*)(YS + (size_t)(u.pm * 256 + r) * D + cl) = w; }
    }
};
__device__ __forceinline__ void moe_table(Frame& F, LAS int* tb) {
    if (F.tid < 32) { int c = (int)__hip_atomic_load(F.ctl + CW_ECNT + 64 * F.tid, RLX_AGENT); if (c > LCAP) c = LCAP; tb[64 + F.tid] = c; }
    LDS_WAIT(); __syncthreads();
    if (F.tid == 0) { int s = 0; for (int e = 0; e < NE; ++e) { tb[e] = s; s += (tb[64 + e] + 255) >> 8; } tb[32] = s; }
    LDS_WAIT(); __syncthreads();
    for (int b = F.tid; b < NBLK_MAX; b += NWAVES * 64) { int e = 0; while (e < NE - 1 && tb[e + 1] <= b) ++e; tb[128 + b] = e; }
    LDS_WAIT(); __syncthreads();
}

constexpr int P2_RING = 48, P2_CUT = P2_RING * 1024, P2_CCO = 16 * 512 * 4;
constexpr int P2_PRIV = 81920, P2_SYNC = 151552;
static_assert(P2_CUT + P2_CCO <= P2_PRIV && P2_PRIV + 4 * 16384 <= P2_SYNC && P2_SYNC + 64 <= LDSCTL_OFF, "phase 2 LDS map");
__device__ __forceinline__ void conv_bar4(LAS int* cnt, int& gen, int lane) {
    gen += 4;
    asm volatile("s_waitcnt lgkmcnt(0)" ::: "memory");
    if (lane == 0) __hip_atomic_fetch_add(cnt, 1, __ATOMIC_RELAXED, __HIP_MEMORY_SCOPE_WORKGROUP);
    unsigned spins = 0;
    while (__builtin_amdgcn_readfirstlane(__hip_atomic_load(cnt, __ATOMIC_RELAXED, __HIP_MEMORY_SCOPE_WORKGROUP)) < gen) { if (++spins > (1u << 22)) break; __builtin_amdgcn_s_sleep(1); }
    asm volatile("" ::: "memory");
}
__device__ __forceinline__ void conv_phase4(Frame& F) {
    LAS unsigned* ut = (LAS unsigned*)(F.lds);
    LAS float* co = (LAS float*)(F.lds + P2_CUT);
    LAS int* cnt = (LAS int*)(F.lds + P2_SYNC);
    const int cp = F.tid & 255;
    f32x2 wv[CWID];
    { const float* wd = F.in[I_W_DW] + 2 * cp;
#pragma unroll
        for (int j = 0; j < CWID; ++j) wv[j] = *(const GAS f32x2*)(wd + j * CONV_CH); }
    const f32x2 bd = *(const GAS f32x2*)(F.in[I_B_DW] + 2 * cp);
    const f32x4 g0 = *(const GAS f32x4*)(F.in[I_LN_CONV_G] + 8 * F.lane), g1 = *(const GAS f32x4*)(F.in[I_LN_CONV_G] + 8 * F.lane + 4);
    const f32x4 b0 = *(const GAS f32x4*)(F.in[I_LN_CONV_B] + 8 * F.lane), b1 = *(const GAS f32x4*)(F.in[I_LN_CONV_B] + 8 * F.lane + 4);
    unsigned char* MX = F.ws + WS_MIXIN;
    int gen = 0;
    constexpr int NITEM = NB * (T_ / 16);
    const int ipw = (NITEM + F.G - 1) / F.G, it0 = F.vcu * ipw, it1 = (it0 + ipw < NITEM) ? it0 + ipw : NITEM;
    u32x4 stg[4];
#define CONV_FULL(item) do { const int b_ = (item) / (T_ / 16), t0_ = ((item) % (T_ / 16)) * 16; const bf16* U_ = (const bf16*)(F.ws + WS_U) + (size_t)b_ * T_ * CONV_CH; \
        for (int idx_ = F.tid; idx_ < 46 * 64; idx_ += 256) { const int r_ = idx_ >> 6, c16_ = idx_ & 63, t_ = t0_ - 30 + r_; \
            u32x4 v_ = (u32x4){0u, 0u, 0u, 0u}; if (t_ >= 0) v_ = *(const GAS u32x4*)(U_ + (size_t)t_ * CONV_CH + c16_ * 8); \
            *(LAS u32x4*)(ut + ((t_ + P2_RING) % P2_RING) * 256 + c16_ * 4) = v_; } } while (0)
#define CONV_FETCH16(item) do { const int b_ = (item) / (T_ / 16), t0_ = ((item) % (T_ / 16)) * 16; const bf16* U_ = (const bf16*)(F.ws + WS_U) + ((size_t)b_ * T_ + t0_) * CONV_CH; \
        _Pragma("unroll") for (int q_ = 0; q_ < 4; ++q_) { const int idx_ = F.tid + 256 * q_; stg[q_] = *(const GAS u32x4*)(U_ + (size_t)(idx_ >> 6) * CONV_CH + (idx_ & 63) * 8); } } while (0)
#define CONV_PUT16(item) do { const int t0_ = ((item) % (T_ / 16)) * 16; \
        _Pragma("unroll") for (int q_ = 0; q_ < 4; ++q_) { const int idx_ = F.tid + 256 * q_; *(LAS u32x4*)(ut + ((t0_ + (idx_ >> 6)) % P2_RING) * 256 + (idx_ & 63) * 4) = stg[q_]; } } while (0)
    if (it0 < it1) CONV_FULL(it0);
    for (int it = it0; it < it1; ++it) {
        const int b = it / (T_ / 16), t0 = (it % (T_ / 16)) * 16;
        const bool more = it + 1 < it1, nfull = ((it + 1) % (T_ / 16)) == 0;
        conv_bar4(cnt, gen, F.lane);
        if (more && !nfull) CONV_FETCH16(it + 1);
        { f32x2 av[16];
            const int s0 = __builtin_amdgcn_readfirstlane((t0 + P2_RING - 30) % P2_RING);
#pragma unroll
            for (int tt = 0; tt < 16; ++tt) av[tt] = bd;
#pragma unroll
            for (int r = 0; r < 46; ++r) { int pos = s0 + r; pos = (pos >= P2_RING) ? pos - P2_RING : pos;
                const unsigned uu = ut[pos * 256 + cp]; const f32x2 uv = {bflo(uu), bfhi(uu)};
#pragma unroll
                for (int tt = 0; tt < 16; ++tt) { const int j = r - tt; if (j >= 0 && j < CWID) av[tt] = wv[j] * uv + av[tt]; } }
#pragma unroll
            for (int tt = 0; tt < 16; ++tt) *(LAS f32x2*)(co + tt * CONV_CH + 2 * cp) = av[tt];
        }
        conv_bar4(cnt, gen, F.lane);
        if (more) { if (nfull) CONV_FULL(it + 1); else CONV_PUT16(it + 1); }
#pragma unroll
        for (int q = 0; q < 4; ++q) { const int tt = 4 * F.wave + q;
            f32x4 x0 = *(const LAS f32x4*)(co + tt * CONV_CH + 8 * F.lane), x1 = *(const LAS f32x4*)(co + tt * CONV_CH + 8 * F.lane + 4);
            const float mean = wave_sum((x0.x + x0.y) + (x0.z + x0.w) + (x1.x + x1.y) + (x1.z + x1.w)) * (1.f / CONV_CH);
            x0 = x0 - mean; x1 = x1 - mean;
            const float var = wave_sum((x0.x * x0.x + x0.y * x0.y) + (x0.z * x0.z + x0.w * x0.w) + (x1.x * x1.x + x1.y * x1.y) + (x1.z * x1.z + x1.w * x1.w)) * (1.f / CONV_CH);
            const float rstd = 1.f / sqrtf(var + LN_EPS);
            x0 = x0 * rstd * g0 + b0; x1 = x1 * rstd * g1 + b1;
            float y[8] = {x0.x, x0.y, x0.z, x0.w, x1.x, x1.y, x1.z, x1.w};
#pragma unroll
            for (int j = 0; j < 8; ++j) y[j] = y[j] * sigmoidf_fast(y[j]);
            *(GAS u32x2*)(MX + (size_t)(b * T_ + t0 + tt) * D + 8 * F.lane) = (u32x2){pk4_fp8(y[0] * MIX_SC, y[1] * MIX_SC, y[2] * MIX_SC, y[3] * MIX_SC), pk4_fp8(y[4] * MIX_SC, y[5] * MIX_SC, y[6] * MIX_SC, y[7] * MIX_SC)}; }
    }
#undef CONV_FULL
#undef CONV_FETCH16
#undef CONV_PUT16
    conv_bar4(cnt, gen, F.lane);
}

typedef float f32x16 __attribute__((ext_vector_type(16)));
__device__ __forceinline__ int crow(int r, int hi) { return (r & 3) + 8 * (r >> 2) + 4 * hi; }
__device__ __forceinline__ bf16x8 pack8(const float* v) {
    u32x4 w; w.x = pg8::cvt_pk_bf16(v[0], v[1]); w.y = pg8::cvt_pk_bf16(v[2], v[3]); w.z = pg8::cvt_pk_bf16(v[4], v[5]); w.w = pg8::cvt_pk_bf16(v[6], v[7]);
    return __builtin_bit_cast(bf16x8, w); }
constexpr float SB_EXIT = 150.0f;
struct SbStage { u32x4 k[4], v[4]; };
__device__ __forceinline__ void sb_gload(SbStage& g, const bf16* Kt, const bf16* Vt, int lane) {
#pragma unroll
    for (int i = 0; i < 4; ++i) { const int c = (lane & 7) ^ ((4 * i + (lane >> 4)) & 7); g.k[i] = *(const GAS u32x4*)(Kt + (size_t)(8 * i) * SBW + 8 * c); }
#pragma unroll
    for (int i = 0; i < 4; ++i) g.v[i] = *(const GAS u32x4*)(Vt + (size_t)(16 * i) * M);
}
__device__ __forceinline__ void sb_lwrite(const SbStage& g, LAS unsigned char* buf, int lane) {
#pragma unroll
    for (int i = 0; i < 4; ++i) *(LAS u32x4*)(buf + 1024 * i + 16 * lane) = g.k[i];
#pragma unroll
    for (int i = 0; i < 4; ++i) *(LAS u32x4*)(buf + 4096 + 1024 * i + 16 * lane) = g.v[i];
}
__device__ __forceinline__ void sb_attn_wave(Frame& F, int b, int h, int qt, LAS unsigned char* wbuf) {
    const int c = F.lane & 31, hi = F.lane >> 5;
    const bf16* Q = (const bf16*)(F.ws + WS_Q); const bf16* Kb = (const bf16*)(F.ws + WS_K); const bf16* VT = (const bf16*)(F.ws + WS_V);
    bf16x8 tri[2];
#pragma unroll
    for (int s = 0; s < 2; ++s) { bf16x8 t;
#pragma unroll
        for (int j = 0; j < 8; ++j) { const int k = 16 * s + 8 * (j >> 2) + 4 * hi + (j & 3); t[j] = (k >= c) ? (short)0xBF80 : (short)0; }
        tri[s] = t; }
    bf16x8 qf[4];
    { const bf16* qp = Q + ((size_t)b * T_ + 32 * qt + c) * SBW + h * SBD + 8 * hi;
#pragma unroll
        for (int s = 0; s < 4; ++s) qf[s] = *(const GAS bf16x8*)(qp + 16 * s); }
    const bf16* Ksrc = Kb + ((size_t)b * T_ + (F.lane >> 3)) * SBW + h * SBD;
    const bf16* Vsrc = VT + (size_t)(h * SBD + (F.lane >> 2)) * M + (size_t)b * T_ + 8 * ((F.lane & 3) ^ ((F.lane >> 4) & 3));

    const int ksw = (c >> 1) & 7, vsw = (c >> 2) & 3;

    f32x16 o0, o1;
#pragma unroll
    for (int r = 0; r < 16; ++r) { o0[r] = 0.f; o1[r] = 0.f; }
    float carry = 0.f;
    SbStage st;
    sb_gload(st, Ksrc + (size_t)(32 * qt) * SBW, Vsrc + 32 * qt, F.lane); sb_lwrite(st, wbuf, F.lane);
    for (int kt = qt; kt >= 0; --kt) {
        LAS unsigned char* buf = wbuf + ((qt - kt) & 1) * 8192;
        if (kt > 0) sb_gload(st, Ksrc + (size_t)(32 * (kt - 1)) * SBW, Vsrc + 32 * (kt - 1), F.lane);
        const bool diag = (kt == qt);
        bf16x8 kf[4];
#pragma unroll
        for (int s = 0; s < 4; ++s) kf[s] = *(const LAS bf16x8*)(buf + c * 128 + 16 * ((2 * s + hi) ^ ksw));
        f32x16 p;
#pragma unroll
        for (int r = 0; r < 16; ++r) p[r] = 0.f;
#pragma unroll
        for (int s = 0; s < 4; ++s) p = __builtin_amdgcn_mfma_f32_32x32x16_bf16(kf[s], qf[s], p, 0, 0, 0);
        u32x2 vv[2][2][2];
#pragma unroll
        for (int dt = 0; dt < 2; ++dt)
#pragma unroll
            for (int s = 0; s < 2; ++s)
#pragma unroll
                for (int q = 0; q < 2; ++q) vv[dt][s][q] = *(const LAS u32x2*)(buf + 4096 + (32 * dt + c) * 64 + 16 * ((2 * s + q) ^ vsw) + 8 * hi);
        float L[16];
#pragma unroll
        for (int r = 0; r < 16; ++r) { const float y = p[r]; float l = __builtin_amdgcn_logf(1.0f + __builtin_amdgcn_exp2f(y)); l = (y > 64.f) ? y : l;
            if (diag) l = (crow(r, hi) >= c) ? 0.f : l; L[r] = l; }
        const bf16x8 l0 = pack8(L), l1 = pack8(L + 8);
        f32x16 a;
#pragma unroll
        for (int r = 0; r < 16; ++r) a[r] = p[r] - carry;
        a = __builtin_amdgcn_mfma_f32_32x32x16_bf16(tri[0], l0, a, 0, 0, 0); a = __builtin_amdgcn_mfma_f32_32x32x16_bf16(tri[1], l1, a, 0, 0, 0);
        const float tot = p[0] - a[0];
        float w[16];
#pragma unroll
        for (int r = 0; r < 16; ++r) { float x = __builtin_amdgcn_exp2f(a[r]); if (diag) x = (crow(r, hi) >= c) ? 0.f : x; w[r] = x; }
        const bf16x8 p0 = pack8(w), p1 = pack8(w + 8);
        { const bf16x8 v00 = __builtin_bit_cast(bf16x8, (u32x4){vv[0][0][0].x, vv[0][0][0].y, vv[0][0][1].x, vv[0][0][1].y});
          const bf16x8 v01 = __builtin_bit_cast(bf16x8, (u32x4){vv[0][1][0].x, vv[0][1][0].y, vv[0][1][1].x, vv[0][1][1].y});
          const bf16x8 v10 = __builtin_bit_cast(bf16x8, (u32x4){vv[1][0][0].x, vv[1][0][0].y, vv[1][0][1].x, vv[1][0][1].y});
          const bf16x8 v11 = __builtin_bit_cast(bf16x8, (u32x4){vv[1][1][0].x, vv[1][1][0].y, vv[1][1][1].x, vv[1][1][1].y});
          o0 = __builtin_amdgcn_mfma_f32_32x32x16_bf16(v00, p0, o0, 0, 0, 0); o0 = __builtin_amdgcn_mfma_f32_32x32x16_bf16(v01, p1, o0, 0, 0, 0);
          o1 = __builtin_amdgcn_mfma_f32_32x32x16_bf16(v10, p0, o1, 0, 0, 0); o1 = __builtin_amdgcn_mfma_f32_32x32x16_bf16(v11, p1, o1, 0, 0, 0); }
        carry = __shfl(tot, c);
        if (__all(carry >= SB_EXIT)) break;
        if (kt > 0) sb_lwrite(st, wbuf + ((qt - kt + 1) & 1) * 8192, F.lane);
    }
#pragma unroll
    for (int g = 0; g < 4; ++g) {
        *(LAS unsigned*)(wbuf + c * 80 + 8 * g + 4 * hi) = pk4_fp8(o0[4 * g] * MIX_SC, o0[4 * g + 1] * MIX_SC, o0[4 * g + 2] * MIX_SC, o0[4 * g + 3] * MIX_SC);
        *(LAS unsigned*)(wbuf + c * 80 + 32 + 8 * g + 4 * hi) = pk4_fp8(o1[4 * g] * MIX_SC, o1[4 * g + 1] * MIX_SC, o1[4 * g + 2] * MIX_SC, o1[4 * g + 3] * MIX_SC); }
    unsigned char* ob = F.ws + WS_MIXIN + ((size_t)b * T_ + 32 * qt) * D + CONV_CH + h * SBD;
#pragma unroll
    for (int q2 = 0; q2 < 2; ++q2) { const int ci = F.lane + 64 * q2, rr = ci >> 2, pc = ci & 3;
        *(GAS u32x4*)(ob + (size_t)rr * D + 16 * pc) = *(const LAS u32x4*)(wbuf + rr * 80 + 16 * pc); }
}

template <bool NT = false> __device__ __forceinline__ void resid_row(f32x4 (&v)[4], const bf16* hrow, const bf16* mrow, int lane) {
    f32x4 a[4]; if (NT) { load_row_bf16_nt(v, hrow, lane); load_row_bf16_nt(a, mrow, lane); } else { load_row_bf16(v, hrow, lane); load_row_bf16(a, mrow, lane); }
#pragma unroll
    for (int j = 0; j < 4; ++j) v[j] = v[j] * DN_ALPHA + a[j];
}
__device__ __forceinline__ void ln_phase(Frame& F, const float* g, const float* b) {
    int r0, r1;
    r0 = (int)(((long)F.vcu * M) / F.G); r1 = (int)(((long)(F.vcu + 1) * M) / F.G);
#pragma unroll 2
    for (int m = r0 + F.wave; m < r1; m += NWAVES) { f32x4 v[4]; bf16* hrow = (bf16*)(F.ws + WS_HB) + (size_t)m * D; resid_row<true>(v, hrow, (const bf16*)(F.ws + WS_QM) + (size_t)m * D, F.lane);
        ln_row(v, g, b, F.lane); store_row_bf16(v, hrow, F.lane);
        { GAS unsigned* h8 = (GAS unsigned*)(F.ws + WS_HB8 + (size_t)m * D) + F.lane;
#pragma unroll
            for (int j = 0; j < 4; ++j) h8[64 * j] = pk4_fp8(v[j].x, v[j].y, v[j].z, v[j].w); } }
}
__device__ __forceinline__ void xattn_phase(Frame& F) {
    LAS unsigned char* tb0 = F.lds + RING_OFF;
    const bf16* QM = (const bf16*)(F.ws + WS_QM); const bf16* KM = (const bf16*)(F.ws + WS_KM); const bf16* VMT = (const bf16*)(F.ws + WS_VMT); bf16* OB = (bf16*)(F.ws + WS_OB);
    const int c = F.lane & 31, h5 = F.lane >> 5;
    const int tr = F.tid >> 5, tc = F.tid & 31;
    const int kr = F.tid >> 4, kc = F.tid & 15;
    constexpr int TBUF = 34816;
    for (int L = (int)blockIdx.x; L < NB * 4 * 16; L += F.G) {
        int pm_, pn_; pg8::tile_order(L, 128, 4, pm_, pn_);
        const int b = pm_ >> 4, h = pn_, qt = pm_ & 15;
        const size_t rowq = (size_t)b * T_ + 256 * qt + 32 * F.wave + c;
        const bf16* qp = QM + rowq * D + h * 256 + 8 * h5;
        const bf16* ksrc = KM + ((size_t)b * NMEM + kr) * D + h * 256 + 8 * kc;
        const int kw0 = kr * 272 + kc * 16, kw1 = (kr + 32) * 272 + kc * 16;
        const bf16* vsrc = VMT + ((size_t)h * 256 + tr) * (size_t)MM + (size_t)b * NMEM + 8 * tc;
        int vw[4];
#pragma unroll
        for (int j = 0; j < 4; ++j) vw[j] = (tr + 16 * j) * 528 + tc * 16;
        u32x4 st[2][4];
#define XA_LOAD(t) do { if ((t) < 8) { const bf16* p_ = ksrc + (size_t)(64 * ((t) & 3)) * D + 128 * ((t) >> 2); st[(t) & 1][0] = *(const GAS u32x4*)p_; st[(t) & 1][1] = *(const GAS u32x4*)(p_ + (size_t)32 * D); } \
        else { _Pragma("unroll") for (int j_ = 0; j_ < 4; ++j_) st[(t) & 1][j_] = *(const GAS u32x4*)(vsrc + (size_t)(64 * ((t) - 8) + 16 * j_) * MM); } } while (0)
#define XA_WRITE(t) do { LAS unsigned char* nb_ = tb0 + ((t) % 3) * TBUF; if ((t) < 8) { *(LAS u32x4*)(nb_ + kw0) = st[(t) & 1][0]; *(LAS u32x4*)(nb_ + kw1) = st[(t) & 1][1]; } \
        else { _Pragma("unroll") for (int j_ = 0; j_ < 4; ++j_) *(LAS u32x4*)(nb_ + vw[j_]) = st[(t) & 1][j_]; } } while (0)
        __syncthreads();
        XA_LOAD(0); XA_LOAD(1); XA_WRITE(0);
        LDS_WAIT(); __syncthreads();
        f32x16 sacc[8]; bf16x8 qf[8]; bf16x8 pb[8][2]; float inv = 0.f;
        unsigned char* ob0 = (unsigned char*)OB + ((size_t)b * T_ + 256 * qt + 32 * F.wave) * D + h * 256;
        LAS unsigned char* ost = tb0 + 3 * TBUF + F.wave * 2560;
#pragma unroll
        for (int i = 0; i < 12; ++i) {
            LAS unsigned char* buf = tb0 + (i % 3) * TBUF;
            if (i + 2 < 12) XA_LOAD(i + 2);
            if (i < 8) { const int dh = i >> 2, kp = i & 3;
                if (kp == 0) {
#pragma unroll
                    for (int s_ = 0; s_ < 8; ++s_) qf[s_] = *(const GAS bf16x8*)(qp + 128 * dh + 16 * s_); }
#pragma unroll
                for (int k2 = 0; k2 < 2; ++k2) { const int kt = 2 * kp + k2;
                    f32x16 a;
                    if (dh == 0) {
#pragma unroll
                        for (int r = 0; r < 16; ++r) a[r] = 0.f; }
                    else a = sacc[kt];
#pragma unroll
                    for (int s_ = 0; s_ < 8; ++s_) { const bf16x8 kf = *(const LAS bf16x8*)(buf + c * 272 + h5 * 16 + (32 * k2 * 272 + 32 * s_)); a = __builtin_amdgcn_mfma_f32_32x32x16_bf16(kf, qf[s_], a, 0, 0, 0); }
                    sacc[kt] = a; }
            } else { const int dp = i - 8;
                if (dp == 0) {
                    float mx = sacc[0][0];
#pragma unroll
                    for (int kt = 0; kt < 8; ++kt)
#pragma unroll
                        for (int r = 0; r < 16; ++r) mx = fmaxf(mx, sacc[kt][r]);
                    mx = fmaxf(mx, __shfl_xor(mx, 32));
                    float sum = 0.f;
#pragma unroll
                    for (int kt = 0; kt < 8; ++kt) { float p[16];
#pragma unroll
                        for (int r = 0; r < 16; ++r) { p[r] = __builtin_amdgcn_exp2f(sacc[kt][r] - mx); sum += p[r]; }
                        pb[kt][0] = pack8(p); pb[kt][1] = pack8(p + 8); }
                    sum += __shfl_xor(sum, 32);
                    inv = OB_SC / sum; }
#pragma unroll
                for (int d2 = 0; d2 < 2; ++d2) { const int dt = 2 * dp + d2;
                    f32x16 o;
#pragma unroll
                    for (int r = 0; r < 16; ++r) o[r] = 0.f;
#pragma unroll
                    for (int kt = 0; kt < 8; ++kt)
#pragma unroll
                        for (int s2 = 0; s2 < 2; ++s2) { const LAS unsigned char* rp = buf + c * 528 + 8 * h5 + (32 * d2 * 528 + (4 * kt + 2 * s2) * 16);
                            const u32x2 v0 = *(const LAS u32x2*)rp, v1 = *(const LAS u32x2*)(rp + 16);
                            o = __builtin_amdgcn_mfma_f32_32x32x16_bf16(__builtin_bit_cast(bf16x8, (u32x4){v0.x, v0.y, v1.x, v1.y}), pb[kt][s2], o, 0, 0, 0); }
#pragma unroll
                    for (int g = 0; g < 4; ++g) *(LAS unsigned*)(ost + c * 80 + 32 * d2 + 8 * g + 4 * h5) = pk4_fp8(o[4 * g] * inv, o[4 * g + 1] * inv, o[4 * g + 2] * inv, o[4 * g + 3] * inv); }
#pragma unroll
                for (int q2 = 0; q2 < 2; ++q2) { const int ci = F.lane + 64 * q2, rr = ci >> 2, pc = ci & 3;
                    *(GAS u32x4*)(ob0 + (size_t)rr * D + 64 * dp + 16 * pc) = *(const LAS u32x4*)(ost + rr * 80 + 16 * pc); }
            }
            if (i + 1 < 12) XA_WRITE(i + 1);
            LDS_WAIT(); __syncthreads();
        }
#undef XA_LOAD
#undef XA_WRITE
    }
}
typedef float f32x4v __attribute__((ext_vector_type(4)));
__device__ __forceinline__ void ln2_router_phase(Frame& F) {
    LAS bf16* wr = (LAS bf16*)(F.lds + P10_WR);
    LAS float* gb = (LAS float*)(F.lds + P10_GB);
    LAS int* lcnt = (LAS int*)(F.lds + P10_LCNT);
    LAS int* rec = (LAS int*)(F.lds + P10_REC);
    for (int i = F.tid; i < 2 * 32 * WR_STRIDE * 2 / 16; i += 512) *(LAS u32x4*)(F.lds + P10_WR + 16 * i) = *(const GAS u32x4*)(F.ws + WS_WR + 16 * i);
    for (int i = F.tid; i < 512; i += 512) { *(LAS f32x4*)(gb + 4 * i) = ((const GAS f32x4*)(i < 256 ? F.in[I_LN2_G] : F.in[I_LN2_B]))[i & 255]; }
    if (F.tid < 64) lcnt[F.tid] = 0;
    LDS_WAIT(); __syncthreads();
    const bf16* H1 = (const bf16*)(F.ws + WS_HB); const unsigned char* CA = F.ws + WS_QM; bf16* H2 = (bf16*)(F.ws + WS_HB2);
    typedef float f32x2w __attribute__((ext_vector_type(2)));
    int* ltok = (int*)(F.ws + WS_LTOK); float* lgate = (float*)(F.ws + WS_LGATE); int* sidx = (int*)(F.ws + WS_SIDX);
    const int fr = F.lane & 15, fq = F.lane >> 4;
    for (int rb = F.vcu; rb < M / 128; rb += F.G) {
        const int m0 = rb * 128 + F.wave * 16;
        float mymean, myrstd;
        { typedef float f32x2s __attribute__((ext_vector_type(2))); const f32x2s st = *(const GAS f32x2s*)(F.ws + WS_LNST + (size_t)(m0 + fr) * 8); mymean = st.x; myrstd = st.y; }
        f32x4v ah0 = {0.f, 0.f, 0.f, 0.f}, ah1 = {0.f, 0.f, 0.f, 0.f}, ac0 = {0.f, 0.f, 0.f, 0.f}, ac1 = {0.f, 0.f, 0.f, 0.f};
        { const bf16* hp = H1 + (size_t)(m0 + fr) * D + 8 * fq; const unsigned char* cp = CA + (size_t)(m0 + fr) * D + 8 * fq;
            const LAS bf16* wp = wr + fr * WR_STRIDE + 8 * fq;
            u32x4 hvb[8]; u32x2 cvb[8];
#pragma unroll
            for (int s_ = 0; s_ < 8; ++s_) { hvb[s_] = *(const GAS u32x4*)(hp + 32 * s_); cvb[s_] = *(const GAS u32x2*)(cp + 32 * s_); }
#pragma unroll
            for (int s_ = 0; s_ < 32; ++s_) {
                const u32x4 hv = hvb[s_ & 7]; const u32x2 cv = cvb[s_ & 7];
                const f32x2w c01 = __builtin_amdgcn_cvt_pk_f32_fp8((int)cv.x, false), c23 = __builtin_amdgcn_cvt_pk_f32_fp8((int)cv.x, true), c45 = __builtin_amdgcn_cvt_pk_f32_fp8((int)cv.y, false), c67 = __builtin_amdgcn_cvt_pk_f32_fp8((int)cv.y, true);
                if (s_ + 8 < 32) { hvb[s_ & 7] = *(const GAS u32x4*)(hp + 32 * (s_ + 8)); cvb[s_ & 7] = *(const GAS u32x2*)(cp + 32 * (s_ + 8)); }
                const bf16x8 bh = __builtin_bit_cast(bf16x8, hv);
                const bf16x8 bc = __builtin_bit_cast(bf16x8, (u32x4){pk2(c01.x, c01.y), pk2(c23.x, c23.y), pk2(c45.x, c45.y), pk2(c67.x, c67.y)});
                const bf16x8 wh0 = *(const LAS bf16x8*)(wp + 32 * s_), wh1 = *(const LAS bf16x8*)(wp + 16 * WR_STRIDE + 32 * s_);
                const bf16x8 wl0 = *(const LAS bf16x8*)(wp + 32 * WR_STRIDE + 32 * s_), wl1 = *(const LAS bf16x8*)(wp + 48 * WR_STRIDE + 32 * s_);
                ah0 = __builtin_amdgcn_mfma_f32_16x16x32_bf16(wh0, bh, ah0, 0, 0, 0); ah1 = __builtin_amdgcn_mfma_f32_16x16x32_bf16(wh1, bh, ah1, 0, 0, 0);
                ac0 = __builtin_amdgcn_mfma_f32_16x16x32_bf16(wh0, bc, ac0, 0, 0, 0); ac1 = __builtin_amdgcn_mfma_f32_16x16x32_bf16(wh1, bc, ac1, 0, 0, 0);
                ah0 = __builtin_amdgcn_mfma_f32_16x16x32_bf16(wl0, bh, ah0, 0, 0, 0); ah1 = __builtin_amdgcn_mfma_f32_16x16x32_bf16(wl1, bh, ah1, 0, 0, 0);
                ac0 = __builtin_amdgcn_mfma_f32_16x16x32_bf16(wl0, bc, ac0, 0, 0, 0); ac1 = __builtin_amdgcn_mfma_f32_16x16x32_bf16(wl1, bc, ac1, 0, 0, 0);
            } }
        float cand[8]; int eid[8];
        { const float* st = (const float*)(F.ws + WS_WR + WR_ST_OFF);
            const f32x4 s0 = *(const GAS f32x4*)(st + 4 * fq), s1 = *(const GAS f32x4*)(st + 16 + 4 * fq), t0 = *(const GAS f32x4*)(st + NE + 4 * fq), t1 = *(const GAS f32x4*)(st + NE + 16 + 4 * fq);
#pragma unroll
            for (int r = 0; r < 4; ++r) { cand[r] = myrstd * (ah0[r] * DN_ALPHA + ac0[r] * (1.0f / CA_SC) - mymean * s0[r]) + t0[r];
                cand[4 + r] = myrstd * (ah1[r] * DN_ALPHA + ac1[r] * (1.0f / CA_SC) - mymean * s1[r]) + t1[r]; eid[r] = 4 * fq + r; eid[4 + r] = 16 + 4 * fq + r; } }
        float tv[TOPK]; int te[TOPK];
#pragma unroll
        for (int k = 0; k < TOPK; ++k) {
            float bv = cand[0]; int bi = eid[0];
#pragma unroll
            for (int r = 1; r < 8; ++r) if (cand[r] > bv) { bv = cand[r]; bi = eid[r]; }
#pragma unroll
            for (int o = 16; o <= 32; o <<= 1) { const float ov = __shfl_xor(bv, o); const int oi = __shfl_xor(bi, o); if (ov > bv || (ov == bv && oi < bi)) { bv = ov; bi = oi; } }
            tv[k] = bv; te[k] = bi;
#pragma unroll
            for (int r = 0; r < 8; ++r) if (eid[r] == bi) cand[r] = -INFINITY;
        }
        float pe[TOPK], ps = 0.f;
#pragma unroll
        for (int k = 0; k < TOPK; ++k) { pe[k] = __expf(tv[k] - tv[0]); ps += pe[k]; }
        if (fq == 0) {
#pragma unroll
            for (int k = 0; k < TOPK; ++k) { const int lr = __hip_atomic_fetch_add(lcnt + te[k], 1, __ATOMIC_RELAXED, __HIP_MEMORY_SCOPE_WORKGROUP);
                LAS int* r = rec + ((F.wave * 16 + fr) * 4 + k) * 4; r[0] = te[k]; r[1] = lr; r[2] = __builtin_bit_cast(int, pe[k] / ps); r[3] = m0 + fr; } }
        LDS_WAIT(); __syncthreads();
        if (F.tid < NE) lcnt[32 + F.tid] = (int)__hip_atomic_fetch_add(F.ctl + CW_ECNT + 64 * F.tid, (unsigned)lcnt[F.tid], RLX_AGENT);
        LDS_WAIT(); __syncthreads();
        { const LAS int* r = rec + (F.wave * 64 + F.lane) * 4; const int e = r[0], pos = lcnt[32 + e] + r[1], tok = r[3];
            if (pos < LCAP) { ltok[e * LCAP + pos] = tok; lgate[e * LCAP + pos] = __builtin_bit_cast(float, r[2]); } sidx[tok * 4 + (F.lane & 3)] = e * LCAP + pos; }
        __syncthreads();
        if (F.tid < 64) lcnt[F.tid] = 0;
        LDS_WAIT(); __syncthreads();
    }
}
__device__ __forceinline__ void final_phase(Frame& F, const LAS int* tb) {
    const int gw = F.vcu * NWAVES + F.wave, NGW = F.G * NWAVES;
    const int* sidx = (const int*)(F.ws + WS_SIDX); const unsigned char* YS = F.ws + WS_YS; const float* lgate = (const float*)(F.ws + WS_LGATE);
    typedef float f32x2v __attribute__((ext_vector_type(2)));
    for (int m0 = gw; m0 < M; m0 += 2 * NGW) {
        const int mr[2] = {m0, (m0 + NGW < M) ? m0 + NGW : m0};
        int si[2][TOPK]; float gk[2][TOPK]; size_t slot[2][TOPK];
#pragma unroll
        for (int r = 0; r < 2; ++r)
#pragma unroll
            for (int k = 0; k < TOPK; ++k) si[r][k] = sidx[mr[r] * 4 + k];
#pragma unroll
        for (int r = 0; r < 2; ++r)
#pragma unroll
            for (int k = 0; k < TOPK; ++k) { const int e = si[r][k] / LCAP, pos = si[r][k] - e * LCAP; slot[r][k] = (size_t)tb[e] * 256 + pos; gk[r][k] = lgate[si[r][k]]; }
        u32x2 hw[2][4]; unsigned yw[2][TOPK][4];
#pragma unroll
        for (int r = 0; r < 2; ++r) { const GAS u32x2* hp = (const GAS u32x2*)((const bf16*)(F.ws + WS_HB2) + (size_t)mr[r] * D) + F.lane;
#pragma unroll
            for (int j = 0; j < 4; ++j) hw[r][j] = __builtin_nontemporal_load(hp + 64 * j);
#pragma unroll
            for (int k = 0; k < TOPK; ++k) { const GAS unsigned* yp = (const GAS unsigned*)(YS + slot[r][k] * D) + F.lane;
#pragma unroll
                for (int j = 0; j < 4; ++j) yw[r][k][j] = __builtin_nontemporal_load(yp + 64 * j); } }
#pragma unroll
        for (int r = 0; r < 2; ++r) { if (r == 1 && mr[1] == m0) break;
            f32x4 v[4];
#pragma unroll
            for (int j = 0; j < 4; ++j) { f32x4 sacc = {0.f, 0.f, 0.f, 0.f};
#pragma unroll
                for (int k = 0; k < TOPK; ++k) { const unsigned w = yw[r][k][j]; const f32x2v lo = __builtin_amdgcn_cvt_pk_f32_fp8((int)w, false), hi = __builtin_amdgcn_cvt_pk_f32_fp8((int)w, true);
                    sacc = sacc + (f32x4){lo.x, lo.y, hi.x, hi.y} * gk[r][k]; }
                v[j] = (f32x4){bflo(hw[r][j].x), bfhi(hw[r][j].x), bflo(hw[r][j].y), bfhi(hw[r][j].y)} * DN_ALPHA + sacc * (1.0f / YS_SC); }
            ln_row(v, F.in[I_LN3_G], F.in[I_LN3_B], F.lane); store_row_f32_nt(v, F.hf + (size_t)mr[r] * D, F.lane); }
    }
}

struct Args { const float* in[N_IN]; float* out; unsigned char* ws; int ph_lo, ph_hi, li, pad; };
__global__ void __launch_bounds__(NWAVES * 64, 2) mk_fwd(Args args) {
    extern __shared__ __attribute__((aligned(16))) unsigned char lds[];
    Frame F;
    F.lds = (LAS unsigned char*)lds; F.MISC = (volatile LAS unsigned*)(F.lds + MISC_OFF);
    F.tid = threadIdx.x; F.lane = F.tid & 63; F.wave = __builtin_amdgcn_readfirstlane(F.tid >> 6);
    F.G = gridDim.x; { const int bx = blockIdx.x; F.vcu = (F.G % 8 == 0) ? (bx % 8) * (F.G / 8) + bx / 8 : bx; }
    F.ws = args.ws; F.ctl = (gu32*)(args.ws + WS_CTL); F.hf = args.out; F.in = args.in;
    for (int u = F.tid; u < (LDS_BYTES - LDSCTL_OFF) / 4; u += NWAVES * 64) ((LAS unsigned*)(F.lds + LDSCTL_OFF))[u] = 0u;
    __syncthreads();
    XcdBarrier bar; bar.bar = (unsigned*)(F.ctl + CW_BAR) + args.li * XCD_BAR_WORDS; bar.x = 0; bar.st = nullptr;
    const int lo = args.ph_lo, hi = args.ph_hi;
    if (hi - lo > 1) bar = xcd_barrier_post((unsigned*)(F.ctl + CW_BAR) + args.li * XCD_BAR_WORDS, F.MISC + 8);
#ifndef PH_MASK
#define PH_MASK 0xfff
#endif
#define IN(k) (((PH_MASK >> (k)) & 1) && lo <= (k) && (k) < hi)
#ifndef REP_MASK
#define REP_MASK 0
#endif
#define REPS(k) (1 + ((REP_MASK >> (k)) & 1))
#define PH_BEGIN() do { int t_ = threadIdx.x; asm volatile("" : "+v"(t_)); F.tid = t_; F.lane = t_ & 63; } while (0)
#define SEAM(k) do { if (IN(k) && IN((k) + 1)) xcd_barrier(bar); } while (0)
    const char* wsb = (const char*)args.ws;
    LAS int* tb = (LAS int*)(F.lds + TB_OFF);

    if (IN(0)) for (int rep = 0; rep < REPS(0); ++rep) { PH_BEGIN(); p0_prologue(F); __syncthreads(); } SEAM(0);
    if (IN(1)) for (int rep = 0; rep < REPS(1); ++rep) { PH_BEGIN(); SchedP1 S{F.G, (int)blockIdx.x}; EpiP1 E{F.ws, F.in[I_B_IN]};
        pg8::gemm_phase<EpiP1, SchedP1, false>(F.lds + RING_OFF, wsb, D, D, D, S, E, nullptr); } SEAM(1);
    if (IN(2)) { PH_BEGIN();
        { SchedKV S{F.G == 256 ? F.vcu : (int)blockIdx.x}; EpiP1 E{F.ws, F.in[I_B_IN]};
            pg8::gemm_phase<EpiP1, SchedKV, false>(F.lds + RING_OFF, wsb, D, D, D, S, E, nullptr); }
        __syncthreads(); PH_BEGIN();
        LAS int* p2s = (LAS int*)(F.lds + P2_SYNC);
        if (F.tid < 2) p2s[F.tid] = 0;
        LDS_WAIT(); __syncthreads();
        if (F.wave >= NATT) { if (!(args.pad & 4)) {
            constexpr int NSW = NWAVES - NATT; const int w = F.wave - NATT;
            if (F.G == 256 && NSW == 2) { constexpr int CUT = 128 * 42;
                if (F.vcu < 64) expert_stream(F, F.vcu * NSW + w, 128, CUT, F.lds + P2_PRIV + (F.wave - 4) * 16384);
                else expert_stream(F, CUT + (F.vcu - 64) * NSW + w, 384, N_EXPERT_ITEMS, F.lds + P2_PRIV + (F.wave - 4) * 16384); }
            else expert_stream(F, F.vcu * NSW + w, F.G * NSW, N_EXPERT_ITEMS, F.lds + P2_PRIV + (F.wave - 4) * 16384); } }
        else {
            if (F.wave < 4 && !(args.pad & 1)) conv_phase4(F);
            if (!(args.pad & 8)) {
                LAS unsigned char* wbuf = F.wave < 4 ? F.lds + F.wave * 16384 : F.lds + P2_PRIV + (F.wave - 4) * 16384;
                const int ntask = NB * SBH * (T_ / 32), tpw = (ntask + F.G - 1) / F.G, t0 = F.vcu * tpw, t1 = (t0 + tpw < ntask) ? t0 + tpw : ntask;
                for (;;) { int j = 0; if (F.lane == 0) j = __hip_atomic_fetch_add(p2s + 1, 1, __ATOMIC_RELAXED, __HIP_MEMORY_SCOPE_WORKGROUP);
                    const int tk = t0 + __builtin_amdgcn_readfirstlane(j); if (tk >= t1) break;
                    sb_attn_wave(F, (tk >> 7) >> 3, (tk >> 7) & 7, tk & 127, wbuf); } }
        }
    } SEAM(2);
    if (IN(3)) {
        EpiLn<1> E{F.ws, F.ctl, F.in[I_B_OUT], F.in[I_LN1_G], F.in[I_LN1_B], F.lds + XTRA_OFF, 1.0f / (WOUT_SC * MIX_SC)};
        { PH_BEGIN(); SchedOne S{(int)blockIdx.x, 128, 4, (unsigned)WS_MIXIN, (unsigned)WS_WOUT_T, TSTEP / 2, TSTEP / 2};
            pg8::gemm_phase<EpiLn<1>, SchedOne, false, true>(F.lds + RING_OFF, wsb, D / 2, D / 2, D / 2, S, E, nullptr); }
        __syncthreads();
        { PH_BEGIN(); SchedOne S{(int)blockIdx.x + F.G, 128, 4, (unsigned)WS_MIXIN, (unsigned)WS_WOUT_T, TSTEP / 2, TSTEP / 2};
            pg8::gemm_phase<EpiLn<1>, SchedOne, false, true>(F.lds + RING_OFF, wsb, D / 2, D / 2, D / 2, S, E, nullptr); }
    } SEAM(3);
    if (IN(5)) { PH_BEGIN(); SchedPlain S{F.G, (int)blockIdx.x, 128, 4, (unsigned)WS_HB8, (unsigned)WS_WQ_T, TSTEP / 2, TSTEP / 2, 0u, 0u, 0u}; EpiBf16 E{(bf16*)(F.ws + WS_QM), D, MEM_QSCALE / WQ_SC, nullptr};
        pg8::gemm_phase<EpiBf16, SchedPlain, false, true>(F.lds + RING_OFF, wsb, D / 2, D / 2, D / 2, S, E, nullptr); }
    if (IN(5) && IN(6)) { asm volatile("s_waitcnt vmcnt(0)" ::: "memory"); __syncthreads();
        if (threadIdx.x == 0) { __builtin_amdgcn_fence(__ATOMIC_ACQUIRE, "agent"); asm volatile("s_waitcnt vmcnt(0)" ::: "memory"); }
        __syncthreads(); }
    if (IN(6)) { PH_BEGIN(); xattn_phase(F); } SEAM(6);
    if (IN(7)) {
        EpiLn<2> E{F.ws, F.ctl, nullptr, F.in[I_LN2_G], F.in[I_LN2_B], F.lds + XTRA_OFF, CA_SC / (WO_SC * OB_SC)};
        { PH_BEGIN(); SchedOne S{(int)blockIdx.x, 128, 4, (unsigned)WS_OB, (unsigned)WS_WO_T, TSTEP / 2, TSTEP / 2};
            pg8::gemm_phase<EpiLn<2>, SchedOne, false, true>(F.lds + RING_OFF, wsb, D / 2, D / 2, D / 2, S, E, nullptr); }
        __syncthreads();
        { PH_BEGIN(); SchedOne S{(int)blockIdx.x + F.G, 128, 4, (unsigned)WS_OB, (unsigned)WS_WO_T, TSTEP / 2, TSTEP / 2};
            pg8::gemm_phase<EpiLn<2>, SchedOne, false, true>(F.lds + RING_OFF, wsb, D / 2, D / 2, D / 2, S, E, nullptr); }
    } SEAM(7);
    if (IN(8)) { PH_BEGIN(); ln2_router_phase(F); } SEAM(8);
    if (IN(9)) for (int rep = 0; rep < REPS(9); ++rep) { PH_BEGIN(); moe_table(F, tb); moe_units(F, tb, tb + 704, 8, (unsigned)WS_HB8, (unsigned)WS_WGU_T, 2048u * 1024u, true);
        SchedMoe S{tb + 704}; EpiAct E{F.ws + WS_ACT, F.in[I_B_GU]};
        pg8::gemm_phase<EpiAct, SchedMoe, true, true>(F.lds + RING_OFF, wsb, D / 2, D / 2, D / 2, S, E, (const int*)(F.ws + WS_LTOK)); } SEAM(9);
    if (IN(10)) for (int rep = 0; rep < REPS(10); ++rep) { PH_BEGIN(); moe_table(F, tb); moe_units(F, tb, tb + 704, 4, (unsigned)WS_ACT, (unsigned)WS_WDN_T, 1024u * 1024u, false);
        SchedMoe S{tb + 704}; EpiDown E{F.ws + WS_YS, F.in[I_B_DOWN]};
        pg8::gemm_phase<EpiDown, SchedMoe, false, true>(F.lds + RING_OFF, wsb, D / 2, D / 2, D / 2, S, E, nullptr); } SEAM(10);
    if (IN(11)) { PH_BEGIN(); moe_table(F, tb); final_phase(F, tb); }
#undef IN
#undef SEAM
}

extern "C" void kernel_launch(void* const* d_in, const int* in_sizes, int n_in, void* d_out, int out_size, void* d_ws, size_t ws_size, hipStream_t stream) {
    static int grid = 0;
    if (grid == 0) {
        if (n_in != N_IN || out_size != M * D || ws_size < WS_END) { fprintf(stderr, "kernel_launch: unexpected shapes (n_in %d, out %d, ws %zu)\n", n_in, out_size, ws_size); grid = -1; return; }
        int dev = 0, cus = 0, per_cu = 0;
        if (hipGetDevice(&dev) != hipSuccess || hipDeviceGetAttribute(&cus, hipDeviceAttributeMultiprocessorCount, dev) != hipSuccess) { grid = -1; return; }
        if (hipFuncSetAttribute((const void*)mk_fwd, hipFuncAttributeMaxDynamicSharedMemorySize, LDS_BYTES) != hipSuccess) { fprintf(stderr, "kernel_launch: hipFuncSetAttribute failed\n"); grid = -1; return; }
        if (hipOccupancyMaxActiveBlocksPerMultiprocessor(&per_cu, (const void*)mk_fwd, NWAVES * 64, LDS_BYTES) != hipSuccess || per_cu < 1) fprintf(stderr, "kernel_launch: occupancy query says %d\n", per_cu);
        (void)hipGetLastError();
        grid = cus;
    }
    if (grid < 0) return;
    if (hipMemsetAsync((char*)d_ws + WS_CTL, 0, CTL_ZERO_BYTES, stream) != hipSuccess) return;
    Args a{};
    for (int i = 0; i < N_IN; ++i) a.in[i] = (const float*)d_in[i];
    a.out = (float*)d_out; a.ws = (unsigned char*)d_ws;
#ifdef PROBE_P2
    { a.ph_lo = 0; a.ph_hi = 3; a.li = 0; hipLaunchKernelGGL(mk_fwd, dim3(grid), dim3(NWAVES * 64), LDS_BYTES, stream, a);
      a.ph_lo = 2; a.ph_hi = 3; a.li = 1; a.pad = PROBE_P2; hipLaunchKernelGGL(mk_fwd, dim3(grid), dim3(NWAVES * 64), LDS_BYTES, stream, a); a.pad = 0;
      a.ph_lo = 3; a.ph_hi = NPHASE; a.li = 2; hipLaunchKernelGGL(mk_fwd, dim3(grid), dim3(NWAVES * 64), LDS_BYTES, stream, a); return; }
#endif
    constexpr int N_LAUNCH = (MK_N_LAUNCHES == 1) ? 1 : NPHASE;
    for (int li = 0; li < N_LAUNCH; ++li) {
        a.ph_lo = (N_LAUNCH == 1) ? 0 : li; a.ph_hi = (N_LAUNCH == 1) ? NPHASE : li + 1; a.li = (N_LAUNCH == 1) ? 0 : li;
        hipLaunchKernelGGL(mk_fwd, dim3(grid), dim3(NWAVES * 64), LDS_BYTES, stream, a);
        if (hipPeekAtLastError() != hipSuccess) { fprintf(stderr, "kernel_launch: launch %d failed\n", li); break; }
    }
#ifdef PROBE_PHASES
    { const int pp[] = {PROBE_PHASES}; for (int ph : pp) { a.ph_lo = ph; a.ph_hi = ph + 1; a.li = 15; hipLaunchKernelGGL(mk_fwd, dim3(grid), dim3(NWAVES * 64), LDS_BYTES, stream, a); } }
#endif
}
```

```cpp
#include <hip/hip_runtime.h>
#include <cstdio>
#include <cstdint>

#ifndef MK_N_LAUNCHES
#define MK_N_LAUNCHES 1
#endif

#define GAS __attribute__((address_space(1)))
#define LAS __attribute__((address_space(3)))
typedef unsigned short bf16;
typedef short bf16x8 __attribute__((ext_vector_type(8)));
typedef float f32x4 __attribute__((ext_vector_type(4)));
typedef float f32x2 __attribute__((ext_vector_type(2)));
typedef unsigned u32x4 __attribute__((ext_vector_type(4)));
typedef unsigned u32x2 __attribute__((ext_vector_type(2)));
typedef GAS unsigned gu32;
#define RLX_AGENT __ATOMIC_RELAXED, __HIP_MEMORY_SCOPE_AGENT
#define LDS_WAIT() asm volatile("s_waitcnt lgkmcnt(0)" ::: "memory")
#define VM_WAIT() asm volatile("s_waitcnt vmcnt(0)" ::: "memory")

constexpr int NB = 8, T_ = 4096, D = 1024, M = NB * T_, NMEM = 256, MM = NB * NMEM;
constexpr int CONV_CH = 512, SBH = 8, SBD = 64, SBW = 512, CWID = 31, NE = 32, TOPK = 4, DFF = 1024;
constexpr int INC = 2560;
constexpr float LN_EPS = 1e-5f;
constexpr float DN_ALPHA = 1.189207115002721f;
constexpr float LOG2E = 1.4426950408889634f;
constexpr float SB_QSCALE = 0.125f * LOG2E;
constexpr float MEM_QSCALE = 0.0625f * LOG2E;
constexpr float WGU_SC = 32.0f, WDN_SC = 64.0f, WQ_SC = 32.0f, WO_SC = 64.0f, OB_SC = 16.0f, YS_SC = 16.0f, CA_SC = 64.0f, WOUT_SC = 64.0f, MIX_SC = 16.0f;
constexpr float WGU_SC_UNUSED = 0.f;
constexpr int NBLK_MAX = M * TOPK / 256 + NE;
constexpr int LCAP = M;

constexpr size_t MiB = 1u << 20;
constexpr size_t WS_CTL = 0, CTL_ZERO_BYTES = 1 * MiB;
constexpr size_t WS_WIN_T = 1 * MiB;
constexpr size_t WS_WOUT_T = 6 * MiB;
constexpr size_t WS_WQ_T = 8 * MiB, WS_WK_T = 10 * MiB, WS_WV_T = 12 * MiB, WS_WO_T = 14 * MiB;
constexpr size_t WS_WGU_T = 16 * MiB;
constexpr size_t WS_WDN_T = 144 * MiB;
constexpr size_t WS_HB8 = 176 * MiB;
constexpr size_t WS_HB = 208 * MiB;
constexpr size_t WS_LTOK = 272 * MiB;
constexpr size_t WS_LGATE = 276 * MiB;
constexpr size_t WS_SIDX = 280 * MiB;
constexpr size_t WS_WR = 281 * MiB;
constexpr size_t WS_HB2 = 832 * MiB;
constexpr size_t WS_X = 288 * MiB;
constexpr size_t WS_U = WS_X;
constexpr size_t WS_Q = WS_X + 32 * MiB;
constexpr size_t WS_K = WS_X + 64 * MiB;
constexpr size_t WS_V = WS_X + 96 * MiB;
constexpr size_t WS_MIXIN = WS_X + 128 * MiB;
constexpr size_t WS_QM = WS_X + 192 * MiB;
constexpr size_t WS_SP = WS_X + 256 * MiB;
constexpr size_t WS_OB = WS_X + 320 * MiB;
constexpr size_t WS_MEMN = WS_X + 384 * MiB;
constexpr size_t WS_KM = WS_X + 388 * MiB;
constexpr size_t WS_VMT = WS_X + 392 * MiB;
constexpr size_t WS_ACT = WS_X;
constexpr size_t WS_YS = WS_X + 272 * MiB;
constexpr size_t WS_END = 896 * MiB;
constexpr int CW_TMO = 0, CW_CODE = 1;
constexpr int CW_BAR = 4096;
constexpr int CW_ECNT = 131072;
constexpr int NPHASE = 12;

constexpr int RING_OFF = 0, RING_BYTES = 131072;
constexpr int LDS_BYTES = 163840;
constexpr int LDSCTL_OFF = LDS_BYTES - 1024, MISC_OFF = LDSCTL_OFF + 320;
constexpr int XTRA_OFF = RING_BYTES;
constexpr int TB_OFF = XTRA_OFF + 20480;
constexpr int WR_STRIDE = 1032;
constexpr int WR_ST_OFF = 2 * 32 * WR_STRIDE * 2;
constexpr int P10_WR = 0, P10_GB = 2 * 32 * WR_STRIDE * 2, P10_LCNT = P10_GB + 8192, P10_REC = P10_LCNT + 512;
static_assert(P10_REC + 8192 <= TB_OFF && TB_OFF + 4 * (704 + 8 * 40) <= LDSCTL_OFF, "LDS map");
constexpr int NWAVES = 8;
#ifndef MK_NATT
#define MK_NATT 6
#endif
constexpr int NATT = MK_NATT;

__device__ __forceinline__ unsigned f2bf(float f) { unsigned u = __builtin_bit_cast(unsigned, f); return (u + 0x7fffu + ((u >> 16) & 1u)) >> 16; }
__device__ __forceinline__ unsigned pk2(float lo, float hi) { unsigned r; asm("v_cvt_pk_bf16_f32 %0, %1, %2" : "=v"(r) : "v"(lo), "v"(hi)); return r; }
__device__ __forceinline__ float bflo(unsigned u) { return __builtin_bit_cast(float, u << 16); }
__device__ __forceinline__ float bfhi(unsigned u) { return __builtin_bit_cast(float, u & 0xffff0000u); }
#define DPP_F(v, ctrl) __builtin_bit_cast(float, __builtin_amdgcn_update_dpp(0, __builtin_bit_cast(int, (v)), (ctrl), 0xf, 0xf, true))
#define RDL_F(v, l) __builtin_bit_cast(float, __builtin_amdgcn_readlane(__builtin_bit_cast(int, (v)), (l)))
__device__ __forceinline__ float wave_sum(float v) {
    v += DPP_F(v, 0xB1); v += DPP_F(v, 0x4E); v += DPP_F(v, 0x141); v += DPP_F(v, 0x140);
    return (RDL_F(v, 0) + RDL_F(v, 16)) + (RDL_F(v, 32) + RDL_F(v, 48));
}
__device__ __forceinline__ float wave_max(float v) {
    v = fmaxf(v, DPP_F(v, 0xB1)); v = fmaxf(v, DPP_F(v, 0x4E)); v = fmaxf(v, DPP_F(v, 0x141)); v = fmaxf(v, DPP_F(v, 0x140));
    return fmaxf(fmaxf(RDL_F(v, 0), RDL_F(v, 16)), fmaxf(RDL_F(v, 32), RDL_F(v, 48)));
}
__device__ __forceinline__ unsigned pk4_fp8(float a, float b, float c, float d) {
    int r = __builtin_amdgcn_cvt_pk_fp8_f32(a, b, 0, false); r = __builtin_amdgcn_cvt_pk_fp8_f32(c, d, r, true); return (unsigned)r; }
__device__ __forceinline__ float sigmoidf_fast(float x) { return __builtin_amdgcn_rcpf(1.0f + __expf(-x)); }

namespace pg8 {
constexpr int BM = 256, BK = 64, HALF = 128, HTB = HALF * BK * 2, STAGE_BYTES = 8 * HTB, NXCD = 8, WGM = 8;
__host__ __device__ __forceinline__ int lds_byte(int r, int c) { const int st = (r >> 4) * 2 + (c >> 5), rr = r & 15, cc = c & 31, ob = rr * 64 + cc * 2; return st * 1024 + (ob ^ (((ob >> 9) & 1) << 5)); }
__host__ __device__ __forceinline__ void stage_rc(int b, int& R, int& C) { const int st = b / 1024, sb = b % 1024, swz = sb ^ (((sb >> 9) & 1) << 5); R = (st >> 1) * 16 + swz / 64; C = (st & 1) * 32 + (swz % 64) / 2; }
__host__ __device__ __forceinline__ int perm32(int rho) { const int n = rho >> 4, i = rho & 15; return 8 * (i >> 2) + 4 * n + (i & 3); }

struct Unit { int pm, pn, z, nvalid; unsigned aoff, boff, goff; };

__device__ __forceinline__ void tile_order(int L, int nM, int nN, int& pm, int& pn) {
    const int nwg = nM * nN; int wgid = L;
    { const int q = nwg / NXCD, r = nwg % NXCD, xcd = wgid % NXCD, off = wgid / NXCD; wgid = (xcd < r ? xcd * (q + 1) : r * (q + 1) + (xcd - r) * q) + off; }
    const int nig = WGM * nN, gid = wgid / nig, fm = gid * WGM, gsz = (nM - fm) < WGM ? (nM - fm) : WGM;
    pm = fm + ((wgid % nig) % gsz); pn = (wgid % nig) / gsz;
}
__device__ __forceinline__ unsigned cvt_pk_bf16(float lo, float hi) { unsigned r; asm volatile("v_cvt_pk_bf16_f32 %0, %1, %2" : "=v"(r) : "v"(lo), "v"(hi)); return r; }

__device__ __forceinline__ void store_tile_bf16(const f32x4 (&acc)[2][2][4][2], bf16* p0, size_t ldc, const float* bias, float scale, int wc, int fq) {
    const int cl = wc * 32 + 8 * fq;
    f32x4 bv[2][2];
#pragma unroll
    for (int bj = 0; bj < 2; ++bj)
#pragma unroll
        for (int n = 0; n < 2; ++n) bv[bj][n] = bias ? *(const f32x4*)(bias + cl + bj * HALF + 4 * n) : (f32x4){0.f, 0.f, 0.f, 0.f};
#pragma unroll
    for (int ai = 0; ai < 2; ++ai)
#pragma unroll
        for (int m = 0; m < 4; ++m) { bf16* rowp = p0 + (size_t)(ai * HALF + m * 16) * ldc + cl;
#pragma unroll
            for (int bj = 0; bj < 2; ++bj) { const f32x4 v0 = (acc[ai][bj][m][0] + bv[bj][0]) * scale, v1 = (acc[ai][bj][m][1] + bv[bj][1]) * scale;
                u32x4 w; w.x = cvt_pk_bf16(v0[0], v0[1]); w.y = cvt_pk_bf16(v0[2], v0[3]); w.z = cvt_pk_bf16(v1[0], v1[1]); w.w = cvt_pk_bf16(v1[2], v1[3]);
                *(u32x4*)(rowp + bj * HALF) = w; } }
}

__device__ __forceinline__ void store_tile_bf16_w(const f32x4 (&acc)[2][2][4][2], bf16* p0, size_t ldc, const float* bias, float scale, int wc, int fq) {
    const int cl = wc * 64 + 8 * fq;
    f32x4 bv[2][2];
#pragma unroll
    for (int bj = 0; bj < 2; ++bj)
#pragma unroll
        for (int n = 0; n < 2; ++n) bv[bj][n] = bias ? *(const f32x4*)(bias + cl + 32 * bj + 4 * n) : (f32x4){0.f, 0.f, 0.f, 0.f};
#pragma unroll
    for (int ai = 0; ai < 2; ++ai)
#pragma unroll
        for (int m = 0; m < 4; ++m) { bf16* rowp = p0 + (size_t)(ai * HALF + m * 16) * ldc + cl;
#pragma unroll
            for (int bj = 0; bj < 2; ++bj) { const f32x4 v0 = (acc[ai][bj][m][0] + bv[bj][0]) * scale, v1 = (acc[ai][bj][m][1] + bv[bj][1]) * scale;
                u32x4 w; w.x = cvt_pk_bf16(v0[0], v0[1]); w.y = cvt_pk_bf16(v0[2], v0[3]); w.z = cvt_pk_bf16(v1[0], v1[1]); w.w = cvt_pk_bf16(v1[2], v1[3]);
                *(u32x4*)(rowp + 32 * bj) = w; } }
}

typedef int v8i __attribute__((ext_vector_type(8)));
template <class T, class = void> struct HasPerm2 { static constexpr bool value = false; };
template <class T> struct HasPerm2<T, decltype((void)T::PERM2)> { static constexpr bool value = true; };
__host__ __device__ __forceinline__ int perm2_col(int bj, int r) { return 64 * (r >> 5) + 16 * ((r >> 2) & 3) + 8 * bj + 4 * ((r >> 4) & 1) + (r & 3); }
__host__ __device__ __forceinline__ int perm2b_col(int bj, int r) { return 64 * (r >> 5) + 32 * bj + 8 * ((r >> 2) & 3) + 4 * ((r >> 4) & 1) + (r & 3); }
template <class T, class = void> struct ATiled { static constexpr bool value = false; };
template <class T> struct ATiled<T, decltype((void)T::ATILED)> { static constexpr bool value = true; };
template <class T, class = void> struct Perm2Kind { static constexpr int value = 0; };
template <class T> struct Perm2Kind<T, decltype((void)T::PERM2)> { static constexpr int value = (int)T::PERM2; };
#ifndef PG8_ALIGN
#define PG8_ALIGN true
#endif
template <class Epi, class Sched, bool GATHER, bool FP8 = false, bool ALIGN_EPI = PG8_ALIGN>
__device__ __forceinline__ void gemm_phase(LAS unsigned char* lds, const char* wsb, const int lda, const int ldb, const int K, const Sched& S, const Epi& E, const int* glist) {
    int tid = threadIdx.x; asm volatile("" : "+v"(tid));
    const int wid = __builtin_amdgcn_readfirstlane(tid >> 6), lane = tid & 63, wr = wid >> 2, wc = wid & 3, fr = lane & 15, fq = lane >> 4;
    const int nt = K / BK;
    unsigned voffA[2], voffB[2], voffB2[2][2];
#pragma unroll
    for (int i = 0; i < 2; ++i) { int R, C; stage_rc(tid * 16 + i * 8192, R, C); const int Rb = Epi::PERM ? ((R & ~31) + perm32(R & 31)) : R;
        voffA[i] = ATiled<Epi>::value ? (unsigned)((R >> 4) * 16 * lda * 2 + ((2 * C) >> 5) * 512 + (R & 15) * 32 + ((2 * C) & 31)) : (unsigned)(R * lda + C) * 2u; voffB[i] = (unsigned)(Rb * ldb + C) * 2u;
        voffB2[0][i] = (unsigned)((Perm2Kind<Epi>::value == 2 ? perm2b_col(0, R) : perm2_col(0, R)) * ldb + C) * 2u; voffB2[1][i] = (unsigned)((Perm2Kind<Epi>::value == 2 ? perm2b_col(1, R) : perm2_col(1, R)) * ldb + C) * 2u; }
    const size_t kstep = (size_t)(BK * 2);
    const size_t kstepA = ATiled<Epi>::value ? (size_t)(BK * 2 * 16) : kstep;
    const size_t hstepA = (size_t)HALF * lda * 2, hstepB = (size_t)HALF * ldb * 2;
    const unsigned ldsw = (unsigned)wid * 1024u;
    const int aoff = lds_byte(wr * 64 + fr, fq * 8), boff = lds_byte(wc * 32 + fr, fq * 8);
    unsigned gc[2][2], gn[2][2];
#define PG8_SA(b, h) (((b) * 2 + (h)) * HTB)
#define PG8_SB(b, h) ((4 + (b) * 2 + (h)) * HTB)
#define PG8_STAGE_B(bufoff, gbase, bj) do { _Pragma("unroll") for (int _i = 0; _i < 2; ++_i) { \
        const char* _q = HasPerm2<Epi>::value ? (const char*)(gbase) + voffB2[bj][_i] : (const char*)(gbase) + (bj) * hstepB + voffB[_i]; \
        __builtin_amdgcn_global_load_lds((const unsigned*)_q, (LAS unsigned*)(lds + (bufoff) + ldsw + _i * 8192), 16, 0, 0); } } while (0)
#define PG8_STAGE_A(bufoff, gbase, h, nx) do { _Pragma("unroll") for (int _i = 0; _i < 2; ++_i) { \
        const char* _p = GATHER ? (const char*)(gbase) + ((nx) ? gn[h][_i] : gc[h][_i]) : (const char*)(gbase) + (h) * hstepA + voffA[_i]; \
        __builtin_amdgcn_global_load_lds((const unsigned*)_p, (LAS unsigned*)(lds + (bufoff) + ldsw + _i * 8192), 16, 0, 0); } } while (0)
#define PG8_LDA(dst, b, h) do { _Pragma("unroll") for (int m = 0; m < 4; ++m) { if constexpr (FP8) { const u32x4 _lo = *(const LAS u32x4*)(lds + PG8_SA(b, h) + aoff + m * 2048), _hi = *(const LAS u32x4*)(lds + PG8_SA(b, h) + aoff + m * 2048 + 1024); \
            dst##8[m] = (v8i){(int)_lo.x, (int)_lo.y, (int)_lo.z, (int)_lo.w, (int)_hi.x, (int)_hi.y, (int)_hi.z, (int)_hi.w}; } \
        else { _Pragma("unroll") for (int k = 0; k < 2; ++k) dst[m][k] = *(const LAS bf16x8*)(lds + PG8_SA(b, h) + aoff + m * 2048 + k * 1024); } } } while (0)
#define PG8_LDB(dst, b, h) do { _Pragma("unroll") for (int n = 0; n < 2; ++n) { if constexpr (FP8) { const u32x4 _lo = *(const LAS u32x4*)(lds + PG8_SB(b, h) + boff + n * 2048), _hi = *(const LAS u32x4*)(lds + PG8_SB(b, h) + boff + n * 2048 + 1024); \
            dst##8[n] = (v8i){(int)_lo.x, (int)_lo.y, (int)_lo.z, (int)_lo.w, (int)_hi.x, (int)_hi.y, (int)_hi.z, (int)_hi.w}; } \
        else { _Pragma("unroll") for (int k = 0; k < 2; ++k) dst[n][k] = *(const LAS bf16x8*)(lds + PG8_SB(b, h) + boff + n * 2048 + k * 1024); } } } while (0)
#define PG8_MMA(ai, bj, At, Bt) do { __builtin_amdgcn_s_setprio(1); if constexpr (FP8) asm volatile("s_nop 1"); _Pragma("unroll") for (int m = 0; m < 4; ++m) _Pragma("unroll") for (int n = 0; n < 2; ++n) { \
        if constexpr (FP8) asm volatile("v_mfma_f32_16x16x128_f8f6f4 %0, %1, %2, %0" : "+v"(acc[ai][bj][m][n]) : "v"(Bt##8[n]), "v"(At##8[m])); \
        else { _Pragma("unroll") for (int k = 0; k < 2; ++k) acc[ai][bj][m][n] = __builtin_amdgcn_mfma_f32_16x16x32_bf16(Bt[n][k], At[m][k], acc[ai][bj][m][n], 0, 0, 0); } } \
        __builtin_amdgcn_s_setprio(0); } while (0)
#define PG8_WAIT_V(n) asm volatile("s_waitcnt vmcnt(" #n ")" ::: "memory")
#define PG8_WAIT_L(n) asm volatile("s_waitcnt lgkmcnt(" #n ")" ::: "memory")
#define PG8_BAR __builtin_amdgcn_s_barrier()
#define PG8_SCHED __builtin_amdgcn_sched_barrier(0)
#define PG8_GIDX(g, u) do { _Pragma("unroll") for (int _h = 0; _h < 2; ++_h) _Pragma("unroll") for (int _i = 0; _i < 2; ++_i) { int _R, _C; stage_rc(tid * 16 + _i * 8192, _R, _C); const int _r = _h * HALF + _R; \
        const int _tok = glist[(u).goff + (_r < (u).nvalid ? _r : (u).nvalid - 1)]; g[_h][_i] = (unsigned)_tok * (unsigned)(lda * 2) + (unsigned)(_C * 2); } } while (0)
    Unit cur, nxt, nn; int ui = 0;
    if (!S.next(0, cur)) return;
    f32x4 acc[2][2][4][2];
#pragma unroll
    for (int a = 0; a < 2; ++a)
#pragma unroll
        for (int b = 0; b < 2; ++b)
#pragma unroll
            for (int m = 0; m < 4; ++m)
#pragma unroll
                for (int n = 0; n < 2; ++n) acc[a][b][m][n] = (f32x4){0.f, 0.f, 0.f, 0.f};
    bf16x8 At[4][2], B0[2][2], B1[2][2];
    v8i At8[4], B08[2], B18[2];
    const char* cA = wsb + cur.aoff; const char* cB = wsb + cur.boff;
    if constexpr (GATHER) { PG8_GIDX(gc, cur); if (S.next(1, nxt)) { PG8_GIDX(gn, nxt); } else { PG8_GIDX(gn, cur); }
        asm volatile("s_waitcnt vmcnt(0)" : "+v"(gc[0][0]), "+v"(gc[0][1]), "+v"(gc[1][0]), "+v"(gc[1][1]), "+v"(gn[0][0]), "+v"(gn[0][1]), "+v"(gn[1][0]), "+v"(gn[1][1]) :: "memory"); }
    else {
#pragma unroll
        for (int h = 0; h < 2; ++h)
#pragma unroll
            for (int i = 0; i < 2; ++i) { gc[h][i] = 0u; gn[h][i] = 0u; } }
    PG8_STAGE_B(PG8_SB(0, 0), cB, 0); PG8_STAGE_B(PG8_SB(0, 1), cB, 1); PG8_STAGE_A(PG8_SA(0, 0), cA, 0, false); PG8_STAGE_A(PG8_SA(0, 1), cA, 1, false);
    if (wr == 1) PG8_BAR;
    PG8_WAIT_V(2); PG8_BAR;
    PG8_STAGE_B(PG8_SB(1, 0), cB + kstep, 0); PG8_STAGE_A(PG8_SA(1, 0), cA + kstepA, 0, false); PG8_STAGE_B(PG8_SB(1, 1), cB + kstep, 1);
    PG8_WAIT_V(6); PG8_BAR;
    for (;;) {
        const bool has_next = S.next(ui + 1, nxt);
        const char* nA = has_next ? wsb + nxt.aoff : cA; const char* nB = has_next ? wsb + nxt.boff : cB;
#pragma clang loop unroll(disable)
        for (int t = 0; t < nt; t += 2) {
            const bool last = (t == nt - 2);
            const char* a1 = cA + (size_t)(t + 1) * kstepA;
            const char* a2 = last ? nA : cA + (size_t)(t + 2) * kstepA; const char* b2 = last ? nB : cB + (size_t)(t + 2) * kstep;
            const char* a3 = a2 + kstepA; const char* b3 = b2 + kstep;
            PG8_LDB(B0, 0, 0); PG8_LDB(B1, 0, 1); PG8_SCHED; PG8_LDA(At, 0, 0); PG8_STAGE_A(PG8_SA(1, 1), a1, 1, false);
            PG8_WAIT_V(8); PG8_WAIT_L(0); PG8_BAR; PG8_MMA(0, 0, At, B0); PG8_MMA(0, 1, At, B1); PG8_BAR; PG8_SCHED;
            PG8_LDA(At, 0, 1); PG8_STAGE_B(PG8_SB(0, 0), b2, 0); PG8_STAGE_B(PG8_SB(0, 1), b2, 1); PG8_STAGE_A(PG8_SA(0, 0), a2, 0, last);
            PG8_WAIT_V(8); PG8_WAIT_L(0); PG8_BAR; PG8_MMA(1, 0, At, B0); PG8_MMA(1, 1, At, B1); PG8_BAR; PG8_SCHED;
            PG8_LDB(B0, 1, 0); PG8_LDB(B1, 1, 1); PG8_SCHED; PG8_LDA(At, 1, 0); PG8_STAGE_A(PG8_SA(0, 1), a2, 1, last);
            PG8_WAIT_V(8); PG8_WAIT_L(0); PG8_BAR; PG8_MMA(0, 0, At, B0); PG8_MMA(0, 1, At, B1); PG8_BAR; PG8_SCHED;
            PG8_LDA(At, 1, 1); PG8_STAGE_B(PG8_SB(1, 0), b3, 0); PG8_STAGE_B(PG8_SB(1, 1), b3, 1); PG8_STAGE_A(PG8_SA(1, 0), a3, 0, last);
            PG8_WAIT_V(8); PG8_WAIT_L(0); PG8_BAR; PG8_MMA(1, 0, At, B0); PG8_MMA(1, 1, At, B1); PG8_BAR; PG8_SCHED;
        }
        if constexpr (FP8) asm volatile("s_nop 15\n\ts_nop 7");
        if constexpr (ALIGN_EPI) { if (wr == 0) PG8_BAR; }
        if constexpr (GATHER) {
#pragma unroll
            for (int h = 0; h < 2; ++h)
#pragma unroll
                for (int i = 0; i < 2; ++i) gc[h][i] = gn[h][i];
            if (has_next && S.next(ui + 2, nn)) { PG8_GIDX(gn, nn); }
        }
        E(acc, cur, wr, wc, fr, fq);
        if constexpr (GATHER) asm volatile("" : "+v"(gn[0][0]), "+v"(gn[0][1]), "+v"(gn[1][0]), "+v"(gn[1][1]));
        if (!has_next) break;
#pragma unroll
        for (int a = 0; a < 2; ++a)
#pragma unroll
            for (int b = 0; b < 2; ++b)
#pragma unroll
                for (int m = 0; m < 4; ++m)
#pragma unroll
                    for (int n = 0; n < 2; ++n) acc[a][b][m][n] = (f32x4){0.f, 0.f, 0.f, 0.f};
        cur = nxt; cA = nA; cB = nB; ++ui;
        if constexpr (ALIGN_EPI) { if (wr == 1) PG8_BAR; }
    }
    PG8_WAIT_V(0);
    if constexpr (!ALIGN_EPI) { if (wr == 0) PG8_BAR; }
    PG8_BAR;
#undef PG8_SA
#undef PG8_SB
#undef PG8_STAGE_A
#undef PG8_STAGE_B
#undef PG8_LDA
#undef PG8_LDB
#undef PG8_MMA
#undef PG8_WAIT_V
#undef PG8_WAIT_L
#undef PG8_BAR
#undef PG8_SCHED
#undef PG8_GIDX
}
}
using pg8::Unit;

#define XB_TMO      128
#define XB_XCNT(j)  (256  + 64 * (j))
#define XB_XSUB(j)  (1280 + 64 * (j))
#define XB_XGEN(j)  (2304 + 64 * (j))
#define XB_TOP      3328
#define XB_TOPGEN   3392
#define XCD_BAR_WORDS 3456
#define XB_SPIN_CAP (1u << 18)
__device__ __forceinline__ unsigned xb_ld(unsigned* p)              { return __hip_atomic_load(p, __ATOMIC_RELAXED, __HIP_MEMORY_SCOPE_AGENT); }
__device__ __forceinline__ unsigned xb_add(unsigned* p, unsigned v) { return __hip_atomic_fetch_add(p, v, __ATOMIC_RELAXED, __HIP_MEMORY_SCOPE_AGENT); }
__device__ __forceinline__ unsigned xb_xcc_id() { return (unsigned)__builtin_amdgcn_s_getreg((3 << 11) | 20) & 0xFu; }
#define XB_SPIN(cond, bar) do { unsigned _sp = 0; while (cond) { __builtin_amdgcn_s_sleep(1); \
    if ((++_sp & 255u) == 0u) { if (xb_ld(&(bar)[XB_TMO])) break; if (_sp > XB_SPIN_CAP) { atomicAdd(&(bar)[XB_TMO], 1u); break; } } } } while (0)
struct XcdBarrier { unsigned* bar; unsigned x; volatile LAS unsigned* st; };
__device__ __forceinline__ XcdBarrier xcd_barrier_post(unsigned* bar, volatile LAS unsigned* st) {
    XcdBarrier b; b.bar = bar; b.x = xb_xcc_id(); b.st = st;
    if (threadIdx.x == 0) (void)xb_add(&bar[XB_XCNT(b.x)], 1u);
    return b;
}
__device__ __forceinline__ void xcd_barrier_complete(unsigned* bar, unsigned x, unsigned& nloc, unsigned& nx) {
    const unsigned G = gridDim.x * gridDim.y * gridDim.z;
    unsigned sum, cnt, mine, sp = 0u;
    for (;;) {
        sum = 0u; cnt = 0u; mine = 0u;
#pragma unroll
        for (unsigned j = 0; j < 16; ++j) { const unsigned c = xb_ld(&bar[XB_XCNT(j)]); sum += c; cnt += (c > 0u) ? 1u : 0u; mine = (j == x) ? c : mine; }
        if (sum == G) break;
        __builtin_amdgcn_s_sleep(1);
        if ((++sp & 255u) == 0u) { if (xb_ld(&bar[XB_TMO])) break; if (sp > XB_SPIN_CAP) { atomicAdd(&bar[XB_TMO], 1u); break; } }
    }
    nloc = mine > 0u ? mine : 1u; nx = cnt > 0u ? cnt : 1u;
}
__device__ __forceinline__ void xcd_barrier(const XcdBarrier& b) {
    asm volatile("s_waitcnt vmcnt(0)" ::: "memory");
    __syncthreads();
    if (threadIdx.x == 0) {
        unsigned* bar = b.bar;
        __builtin_amdgcn_s_waitcnt(0);
        unsigned nloc = b.st[0], nx = b.st[1];
        if (nloc == 0u) { xcd_barrier_complete(bar, b.x, nloc, nx); b.st[0] = nloc; b.st[1] = nx; }
        const unsigned old = xb_add(&bar[XB_XSUB(b.x)], 1u);
        const unsigned gen = old / nloc;
        if (old + 1u == (gen + 1u) * nloc) {
            __builtin_amdgcn_fence(__ATOMIC_RELEASE, "agent");
            asm volatile("s_waitcnt vmcnt(0)" ::: "memory");
            const unsigned og = xb_add(&bar[XB_TOP], 1u);
            const unsigned tg = og / nx;
            if (og + 1u == (tg + 1u) * nx) xb_add(&bar[XB_TOPGEN], 1u);
            else XB_SPIN(xb_ld(&bar[XB_TOPGEN]) == tg, bar);
            __builtin_amdgcn_fence(__ATOMIC_ACQUIRE, "agent");
            xb_add(&bar[XB_XGEN(b.x)], 1u);
            asm volatile("s_waitcnt vmcnt(0)" ::: "memory");
        } else {
            XB_SPIN(xb_ld(&bar[XB_XGEN(b.x)]) == gen, bar);
            __builtin_amdgcn_fence(__ATOMIC_ACQUIRE, "agent");
            asm volatile("s_waitcnt vmcnt(0)" ::: "memory");
        }
    }
    __syncthreads();
}

struct Frame {
    LAS unsigned char* lds;
    volatile LAS unsigned* MISC;
    gu32* ctl;
    unsigned char* ws;
    int tid, lane, wave, vcu, G;
    float* hf;
    const float* const* in;
};
enum In { I_X = 0, I_MEM, I_LN_IN_G, I_LN_IN_B, I_LN_MEM_G, I_LN_MEM_B, I_W_IN, I_B_IN, I_W_DW, I_B_DW, I_LN_CONV_G, I_LN_CONV_B, I_W_OUT, I_B_OUT, I_LN1_G, I_LN1_B,
          I_WQ, I_WK, I_WV, I_WO, I_LN2_G, I_LN2_B, I_W_ROUTER, I_B_ROUTER, I_W_GU, I_B_GU, I_W_DOWN, I_B_DOWN, I_LN3_G, I_LN3_B, N_IN };

__device__ __forceinline__ void p0_transpose_item(const float* W, int K, int N, bf16* WT, int k0, int n0, int drow, LAS float* scr, int lane) {
#pragma unroll 8
    for (int i = 0; i < 32; ++i) { const int kk = 2 * i + (lane >> 5); scr[kk * 33 + (lane & 31)] = W[(size_t)(k0 + kk) * N + n0 + (lane & 31)]; }
    LDS_WAIT(); asm volatile("" ::: "memory");
    const int c = lane & 7;
#pragma unroll
    for (int j = 0; j < 4; ++j) { const int n = (lane >> 3) + 8 * j; const LAS float* s = scr + (8 * c) * 33 + n;
        u32x4 o; o.x = pk2(s[0 * 33], s[1 * 33]); o.y = pk2(s[2 * 33], s[3 * 33]); o.z = pk2(s[4 * 33], s[5 * 33]); o.w = pk2(s[6 * 33], s[7 * 33]);
        *(GAS u32x4*)(WT + (size_t)(drow + n) * K + k0 + 8 * c) = o; }
    LDS_WAIT(); asm volatile("" ::: "memory");
}
__device__ __forceinline__ void ln_row(f32x4 (&v)[4], const float* g, const float* b, int lane) {
    float s = 0.f;
#pragma unroll
    for (int j = 0; j < 4; ++j) s += (v[j].x + v[j].y) + (v[j].z + v[j].w);
    const float mean = wave_sum(s) * (1.f / D); float s2 = 0.f;
#pragma unroll
    for (int j = 0; j < 4; ++j) { v[j] = v[j] - mean; s2 += (v[j].x * v[j].x + v[j].y * v[j].y) + (v[j].z * v[j].z + v[j].w * v[j].w); }
    const float rstd = 1.f / sqrtf(wave_sum(s2) * (1.f / D) + LN_EPS);
#pragma unroll
    for (int j = 0; j < 4; ++j) { const f32x4 gg = ((const GAS f32x4*)g)[lane + 64 * j], bb = ((const GAS f32x4*)b)[lane + 64 * j]; v[j] = v[j] * rstd * gg + bb; }
}
__device__ __forceinline__ void store_row_bf16(const f32x4 (&v)[4], bf16* orow, int lane) {
    GAS u32x2* o8 = (GAS u32x2*)orow + lane;
#pragma unroll
    for (int j = 0; j < 4; ++j) o8[64 * j] = (u32x2){pk2(v[j].x, v[j].y), pk2(v[j].z, v[j].w)};
}
__device__ __forceinline__ void item8_load(f32x4 (&x)[4][4], const float* W, int N, int k0, int n0, int lane) {
    const int g = lane >> 3, c = lane & 7;
#pragma unroll
    for (int q = 0; q < 4; ++q)
#pragma unroll
        for (int j = 0; j < 4; ++j) x[q][j] = __builtin_nontemporal_load((const GAS f32x4*)(W + (size_t)(k0 + 32 * q + 4 * g + j) * N + n0 + 4 * c));
}
__device__ __forceinline__ void item8_finish(const f32x4 (&x)[4][4], int K, unsigned char* WT, int k0, int drow, float sc, LAS unsigned char* scr, int lane) {
    const int g = lane >> 3, c = lane & 7;
#pragma unroll
    for (int q = 0; q < 4; ++q)
#pragma unroll
        for (int e = 0; e < 4; ++e) *(LAS unsigned*)(scr + (4 * c + e) * 144 + 32 * q + 4 * g) = pk4_fp8(x[q][0][e] * sc, x[q][1][e] * sc, x[q][2][e] * sc, x[q][3][e] * sc);
    LDS_WAIT(); asm volatile("" ::: "memory");
#pragma unroll
    for (int i = 0; i < 4; ++i) { const int t = lane + 64 * i, n = t >> 3, ch = t & 7;
        __builtin_nontemporal_store(*(const LAS u32x4*)(scr + n * 144 + 16 * ch), (GAS u32x4*)(WT + (size_t)(drow + n) * K + k0 + 16 * ch)); }
    LDS_WAIT(); asm volatile("" ::: "memory");
}
__device__ __forceinline__ void p0_transpose_item8b(const float* W, int K, int N, unsigned char* WT, int k0, int n0, int drow, float sc, LAS unsigned char* scr, int lane) {
    f32x4 x[4][4]; item8_load(x, W, N, k0, n0, lane); item8_finish(x, K, WT, k0, drow, sc, scr, lane);
}
__device__ __forceinline__ void load_row_bf16(f32x4 (&v)[4], const bf16* xrow, int lane) {
    const GAS u32x2* xr = (const GAS u32x2*)xrow + lane;
#pragma unroll
    for (int j = 0; j < 4; ++j) { const u32x2 w = xr[64 * j]; v[j] = (f32x4){bflo(w.x), bfhi(w.x), bflo(w.y), bfhi(w.y)}; }
}
__device__ __forceinline__ void load_row_bf16_nt(f32x4 (&v)[4], const bf16* xrow, int lane) {
    const GAS u32x2* xr = (const GAS u32x2*)xrow + lane;
#pragma unroll
    for (int j = 0; j < 4; ++j) { const u32x2 w = __builtin_nontemporal_load(xr + 64 * j); v[j] = (f32x4){bflo(w.x), bfhi(w.x), bflo(w.y), bfhi(w.y)}; }
}
__device__ __forceinline__ void load_row_f32_nt(f32x4 (&v)[4], const float* xrow, int lane) {
    const GAS f32x4* xr = (const GAS f32x4*)xrow + lane;
#pragma unroll
    for (int j = 0; j < 4; ++j) v[j] = __builtin_nontemporal_load(xr + 64 * j);
}
__device__ __forceinline__ void store_row_f32_nt(const f32x4 (&v)[4], float* orow, int lane) {
    GAS f32x4* o = (GAS f32x4*)orow + lane;
#pragma unroll
    for (int j = 0; j < 4; ++j) __builtin_nontemporal_store(v[j], o + 64 * j);
}
__device__ __forceinline__ void load_row_f32(f32x4 (&v)[4], const float* xrow, int lane) {
    const GAS f32x4* xr = (const GAS f32x4*)xrow + lane;
#pragma unroll
    for (int j = 0; j < 4; ++j) v[j] = xr[64 * j];
}
__device__ __forceinline__ void store_row_f32(const f32x4 (&v)[4], float* orow, int lane) {
    GAS f32x4* o = (GAS f32x4*)orow + lane;
#pragma unroll
    for (int j = 0; j < 4; ++j) o[64 * j] = v[j];
}

constexpr int I_GU = NE * 8 * 64, I_DN = NE * 8 * 32, N_EXPERT_ITEMS = I_GU + I_DN;
struct ExpItem { const float* W; unsigned char* WT; int K, N, k0, n0, drow; float sc; };
__device__ __forceinline__ ExpItem expert_item_decode(Frame& F, int it) {
    ExpItem x;
    if (it < I_GU) { const int e = it / (8 * 64), q = it % (8 * 64), kb = q / 64, nb = q % 64, n0 = 32 * nb;
        x.W = F.in[I_W_GU] + (size_t)e * D * 2 * DFF; x.WT = F.ws + WS_WGU_T + (size_t)e * 2 * DFF * D; x.K = D; x.N = 2 * DFF; x.k0 = 128 * kb; x.n0 = n0;
        x.drow = (n0 < 1024) ? (n0 >> 7) * 256 + (n0 & 127) : ((n0 - 1024) >> 7) * 256 + 128 + (n0 & 127); x.sc = WGU_SC; }
    else { const int r = it - I_GU, e = r / (8 * 32), q = r % (8 * 32), kb = q / 32, nb = q % 32;
        x.W = F.in[I_W_DOWN] + (size_t)e * DFF * D; x.WT = F.ws + WS_WDN_T + (size_t)e * D * DFF; x.K = DFF; x.N = D; x.k0 = 128 * kb; x.n0 = 32 * nb; x.drow = 32 * nb; x.sc = WDN_SC; }
    return x;
}
__device__ __forceinline__ void expert_stream(Frame& F, int sw, int nsw, int iend, LAS unsigned char* scr) {
    for (int it = sw; it < iend; it += 3 * nsw) {
        const int it2 = it + nsw, it3 = it + 2 * nsw; const bool two = it2 < iend, three = it3 < iend;
        const ExpItem a = expert_item_decode(F, it), b = expert_item_decode(F, two ? it2 : it), c = expert_item_decode(F, three ? it3 : it);
        f32x4 xa[4][4], xb[4][4], xc[4][4];
        item8_load(xa, a.W, a.N, a.k0, a.n0, F.lane);
        if (two) item8_load(xb, b.W, b.N, b.k0, b.n0, F.lane);
        if (three) item8_load(xc, c.W, c.N, c.k0, c.n0, F.lane);
        item8_finish(xa, a.K, a.WT, a.k0, a.drow, a.sc, scr, F.lane);
        if (two) item8_finish(xb, b.K, b.WT, b.k0, b.drow, b.sc, scr + 5120, F.lane);
        if (three) item8_finish(xc, c.K, c.WT, c.k0, c.drow, c.sc, scr + 10240, F.lane);
    }
}
__device__ __forceinline__ void p0_prologue(Frame& F) {
    LAS float* scr = (LAS float*)(F.lds + RING_OFF + F.wave * 16384);
    const int gw = F.vcu * NWAVES + F.wave, NGW = F.G * NWAVES;
    constexpr int I_IN = 16 * 80, I_SQ = 16 * 32;
    constexpr int NITEMS = I_IN + 2 * I_SQ + 3 * 256;
    constexpr int P0_IW = 2, P0_RI = 8;
    const int NIW = F.G * P0_IW, NOW = F.G * (NWAVES - P0_IW);
    const bool itemw = F.wave < P0_IW;
    if (itemw) for (int it = F.vcu * P0_IW + F.wave; it < NITEMS; it += NIW) {
        int r = it;
        if (r < I_IN) { const int kb = r / 80, nb = r % 80, n0 = 32 * nb; int drow;
            if (n0 < 512) drow = (n0 >> 7) * 256 + 2 * (n0 & 127); else if (n0 < 1024) drow = ((n0 - 512) >> 7) * 256 + 2 * (n0 & 127) + 32; else drow = n0;
            p0_transpose_item(F.in[I_W_IN], D, INC, (bf16*)(F.ws + WS_WIN_T), 64 * kb, n0, drow, scr, F.lane); continue; } r -= I_IN;
        if (r < 2 * I_SQ) { const int w = r / I_SQ, q = r % I_SQ, kb = q / 32, nb = q % 32;
            const float* src = F.in[w == 0 ? I_WK : I_WV];
            bf16* dst = (bf16*)(F.ws + (w == 0 ? WS_WK_T : WS_WV_T));
            p0_transpose_item(src, D, D, dst, 64 * kb, 32 * nb, 32 * nb, scr, F.lane); continue; } r -= 2 * I_SQ;
        { const int w = r / 256, q = r % 256, kb = q / 32, nb = q % 32;
            p0_transpose_item8b(F.in[w == 0 ? I_WQ : w == 1 ? I_WO : I_W_OUT], D, D, F.ws + (w == 0 ? WS_WQ_T : w == 1 ? WS_WO_T : WS_WOUT_T), 128 * kb, 32 * nb, 32 * nb, w == 0 ? WQ_SC : w == 1 ? WO_SC : WOUT_SC, (LAS unsigned char*)scr, F.lane); }
    }
    if (gw < 512) { const int idx = gw * 64 + F.lane, c = idx >> 5, e = idx & 31; const float w = F.in[I_W_ROUTER][idx] * F.in[I_LN2_G][c];
        const unsigned hi = f2bf(w), lo = f2bf(w - __builtin_bit_cast(float, hi << 16)); bf16* wr = (bf16*)(F.ws + WS_WR);
        wr[e * WR_STRIDE + c] = (bf16)hi; wr[(32 + e) * WR_STRIDE + c] = (bf16)lo; }
    else if (gw < 512 + NE) { const int e = gw - 512; float sg = 0.f, sb = 0.f;
#pragma unroll 4
        for (int k = F.lane; k < D; k += 64) { const float w = F.in[I_W_ROUTER][k * NE + e]; sg += F.in[I_LN2_G][k] * w; sb += F.in[I_LN2_B][k] * w; }
        sg = wave_sum(sg); sb = wave_sum(sb);
        if (F.lane == 0) { float* st = (float*)(F.ws + WS_WR + WR_ST_OFF); st[e] = sg; st[NE + e] = sb + F.in[I_B_ROUTER][e]; } }
    int rbeg, rstep, rend;
    { const int split = (NIW * P0_RI < M + MM) ? NIW * P0_RI : M + MM;
        if (itemw) { rbeg = F.vcu * P0_IW + F.wave; rstep = NIW; rend = split; } else { rbeg = split + F.vcu * (NWAVES - P0_IW) + (F.wave - P0_IW); rstep = NOW; rend = M + MM; } }
#pragma unroll 2
    for (int m = rbeg; m < rend; m += rstep) {
        f32x4 v[4];
        if (m < M) { load_row_f32_nt(v, F.in[I_X] + (size_t)m * D, F.lane); ln_row(v, F.in[I_LN_IN_G], F.in[I_LN_IN_B], F.lane);
            store_row_bf16(v, (bf16*)(F.ws + WS_HB) + (size_t)m * D, F.lane); }
        else { const int mm = m - M; load_row_f32(v, F.in[I_MEM] + (size_t)mm * D, F.lane); ln_row(v, F.in[I_LN_MEM_G], F.in[I_LN_MEM_B], F.lane);
            store_row_bf16(v, (bf16*)(F.ws + WS_MEMN) + (size_t)mm * D, F.lane); }
    }
}

constexpr unsigned TSTEP = 256u * 1024u * 2u;
struct SchedP1 { int G, c;
    __device__ __forceinline__ bool next(int i, Unit& u) const {
        const int L = i * G + c; if (L >= 1280) return false;
        u.nvalid = 256; u.goff = 0;
        if (L < 1024) { pg8::tile_order(L, 128, 8, u.pm, u.pn); u.z = 0; u.aoff = (unsigned)WS_HB + (unsigned)u.pm * TSTEP; u.boff = (unsigned)WS_WIN_T + (unsigned)u.pn * TSTEP; }
        else { const int j = L - 1024; u.pm = j & 1; u.pn = j >> 1; u.z = 3; u.aoff = (unsigned)WS_WIN_T + (unsigned)(8 + u.pm) * TSTEP; u.boff = (unsigned)WS_HB + (unsigned)u.pn * TSTEP; }
        return true; }
};
struct SchedKV { int v;
    __device__ __forceinline__ bool next(int i, Unit& u) const {
        if (i > 0 || v >= 64) return false;
        u.nvalid = 256; u.goff = 0;
        if (v < 32) { u.pm = v & 7; u.pn = v >> 3; u.z = 1; u.aoff = (unsigned)WS_MEMN + (unsigned)u.pm * TSTEP; u.boff = (unsigned)WS_WK_T + (unsigned)u.pn * TSTEP; }
        else { const int j = v - 32; u.pm = j & 3; u.pn = j >> 2; u.z = 2; u.aoff = (unsigned)WS_WV_T + (unsigned)u.pm * TSTEP; u.boff = (unsigned)WS_MEMN + (unsigned)u.pn * TSTEP; }
        return true; }
};
struct EpiP1 { static constexpr bool PERM = true; static constexpr int PERM2 = 2;
    unsigned char* ws; const float* b_in;
    __device__ __forceinline__ void operator()(const f32x4 (&acc)[2][2][4][2], const Unit& u, int wr, int wc, int fr, int fq) const {
        const int row0 = u.pm * 256 + wr * 64 + fr;
        if (u.z == 0) {
            if (u.pn < 4) {
                const int ch = 128 * u.pn + wc * 32 + 8 * fq;
                f32x4 bv[2], bg[2];
#pragma unroll
                for (int n = 0; n < 2; ++n) { bv[n] = *(const f32x4*)(b_in + ch + 4 * n); bg[n] = *(const f32x4*)(b_in + 512 + ch + 4 * n); }
                bf16* U = (bf16*)(ws + WS_U);
#pragma unroll
                for (int ai = 0; ai < 2; ++ai)
#pragma unroll
                    for (int m = 0; m < 4; ++m) { f32x4 o[2];
#pragma unroll
                        for (int n = 0; n < 2; ++n) { const f32x4 a = acc[ai][0][m][n] + bv[n], g = acc[ai][1][m][n] + bg[n];
#pragma unroll
                            for (int j = 0; j < 4; ++j) o[n][j] = a[j] * sigmoidf_fast(g[j]); }
                        u32x4 w; w.x = pg8::cvt_pk_bf16(o[0][0], o[0][1]); w.y = pg8::cvt_pk_bf16(o[0][2], o[0][3]); w.z = pg8::cvt_pk_bf16(o[1][0], o[1][1]); w.w = pg8::cvt_pk_bf16(o[1][2], o[1][3]);
                        *(u32x4*)(U + (size_t)(row0 + ai * 128 + m * 16) * 512 + ch) = w; }
            } else {
                const int t = u.pn - 4, which = t >> 1, cb = (t & 1) * 256;
                bf16* dst = (bf16*)(ws + (which == 0 ? WS_Q : WS_K));
                pg8::store_tile_bf16_w(acc, dst + (size_t)row0 * 512 + cb, 512, b_in + 1024 + 256 * t, which == 0 ? SB_QSCALE : 1.0f, wc, fq);
            }
        } else if (u.z == 3) {
            const float* rb = b_in + 2048 + row0; bf16* p0 = (bf16*)(ws + WS_V) + (size_t)row0 * M + 256 * u.pn; const int cl = wc * 64 + 8 * fq;
#pragma unroll
            for (int ai = 0; ai < 2; ++ai)
#pragma unroll
                for (int m = 0; m < 4; ++m) { const float bv = rb[ai * 128 + m * 16]; bf16* rowp = p0 + (size_t)(ai * 128 + m * 16) * M + cl;
#pragma unroll
                    for (int bj = 0; bj < 2; ++bj) { const f32x4 v0 = acc[ai][bj][m][0] + bv, v1 = acc[ai][bj][m][1] + bv;
                        u32x4 w; w.x = pg8::cvt_pk_bf16(v0[0], v0[1]); w.y = pg8::cvt_pk_bf16(v0[2], v0[3]); w.z = pg8::cvt_pk_bf16(v1[0], v1[1]); w.w = pg8::cvt_pk_bf16(v1[2], v1[3]);
                        *(u32x4*)(rowp + bj * 32) = w; } }
        } else if (u.z == 1) pg8::store_tile_bf16_w(acc, (bf16*)(ws + WS_KM) + (size_t)row0 * 1024 + 256 * u.pn, 1024, nullptr, 1.0f, wc, fq);
        else pg8::store_tile_bf16_w(acc, (bf16*)(ws + WS_VMT) + (size_t)row0 * 2048 + 256 * u.pn, 2048, nullptr, 1.0f, wc, fq);
    }
};

struct SchedPlain { int G, c, nM, nN; unsigned abase, bbase, atile, btile, acol, bcol, bgrp;
    __device__ __forceinline__ bool next(int i, Unit& u) const {
        const int L = i * G + c; if (L >= nM * nN) return false;
        pg8::tile_order(L, nM, nN, u.pm, u.pn); u.z = 0; u.nvalid = 256; u.goff = 0;
        u.aoff = abase + (unsigned)u.pm * atile + (unsigned)u.pn * acol; u.boff = bbase + (unsigned)u.pn * btile + (unsigned)(u.pm >> 4) * bgrp + (unsigned)u.pn * bcol; return true; }
};
struct EpiBf16 { static constexpr bool PERM = true; static constexpr int PERM2 = 2;
    bf16* O; int ldc; float scale; const float* bias;
    __device__ __forceinline__ void operator()(const f32x4 (&acc)[2][2][4][2], const Unit& u, int wr, int wc, int fr, int fq) const {
        const int cl = 256 * u.pn + 64 * wc + 8 * fq; bf16* p0 = O + (size_t)(u.pm * 256 + wr * 64 + fr) * ldc + cl;
        f32x4 bv[2][2];
#pragma unroll
        for (int bj = 0; bj < 2; ++bj)
#pragma unroll
            for (int n = 0; n < 2; ++n) bv[bj][n] = bias ? *(const f32x4*)(bias + cl + 32 * bj + 4 * n) : (f32x4){0.f, 0.f, 0.f, 0.f};
#pragma unroll
        for (int ai = 0; ai < 2; ++ai)
#pragma unroll
            for (int m = 0; m < 4; ++m) { bf16* rowp = p0 + (size_t)(ai * 128 + m * 16) * ldc;
#pragma unroll
                for (int bj = 0; bj < 2; ++bj) { const f32x4 v0 = acc[ai][bj][m][0] * scale + bv[bj][0], v1 = acc[ai][bj][m][1] * scale + bv[bj][1];
                    u32x4 w; w.x = pg8::cvt_pk_bf16(v0[0], v0[1]); w.y = pg8::cvt_pk_bf16(v0[2], v0[3]); w.z = pg8::cvt_pk_bf16(v1[0], v1[1]); w.w = pg8::cvt_pk_bf16(v1[2], v1[3]);
                    *(u32x4*)(rowp + 32 * bj) = w; } }
    }
};
constexpr int P3_SKEW = 3;
constexpr int CW_LNC = 65536;
constexpr size_t WS_LNX = WS_QM;
struct SchedOne { int L, nM, nN; unsigned abase, bbase, atile, btile;
    __device__ __forceinline__ bool next(int i, Unit& u) const {
        if (i > 0 || L >= nM * nN) return false;
        pg8::tile_order(L, nM, nN, u.pm, u.pn); u.z = 0; u.nvalid = 256; u.goff = 0; u.aoff = abase + (unsigned)u.pm * atile; u.boff = bbase + (unsigned)u.pn * btile; return true; }
};
struct EpiLn1 { static constexpr bool PERM = true; static constexpr int PERM2 = 2;
    unsigned char* ws; gu32* ctl; const float* bias; const float* g; const float* b; LAS unsigned char* lds; float scale;
    __device__ __forceinline__ void operator()(f32x4 (&acc)[2][2][4][2], const Unit& u, int wr, int wc, int fr, int fq) const {
        typedef float f32x2v __attribute__((ext_vector_type(2)));
        LAS f32x2v* P = (LAS f32x2v*)lds;
        LAS f32x2v* S = (LAS f32x2v*)(lds + 8192);
        LAS unsigned* flag = (LAS unsigned*)(lds + 8192 + 2048);
        const int wid = wr * 4 + wc, lane = fq * 16 + fr;
        const int cl = 256 * u.pn + 64 * wc + 8 * fq;
        bf16* hp = (bf16*)(ws + WS_HB) + (size_t)(u.pm * 256 + wr * 64 + fr) * D + cl;
        { f32x4 bv[2][2];
#pragma unroll
            for (int bj = 0; bj < 2; ++bj)
#pragma unroll
                for (int n = 0; n < 2; ++n) bv[bj][n] = *(const f32x4*)(bias + cl + 32 * bj + 4 * n);
#pragma unroll
            for (int ai = 0; ai < 2; ++ai) {
#pragma unroll
                for (int m = 0; m < 4; ++m) { const bf16* rowp = hp + (size_t)(ai * 128 + m * 16) * D;
#pragma unroll
                    for (int bj = 0; bj < 2; ++bj) { const u32x4 hw = *(const GAS u32x4*)(rowp + 32 * bj);
                        acc[ai][bj][m][0] = acc[ai][bj][m][0] * scale + bv[bj][0] + (f32x4){bflo(hw.x), bfhi(hw.x), bflo(hw.y), bfhi(hw.y)} * DN_ALPHA;
                        acc[ai][bj][m][1] = acc[ai][bj][m][1] * scale + bv[bj][1] + (f32x4){bflo(hw.z), bfhi(hw.z), bflo(hw.w), bfhi(hw.w)} * DN_ALPHA; } }
            } }
#pragma unroll
        for (int ai = 0; ai < 2; ++ai)
#pragma unroll
            for (int m = 0; m < 4; ++m) {
                float sm = 0.f;
#pragma unroll
                for (int bj = 0; bj < 2; ++bj)
#pragma unroll
                    for (int n = 0; n < 2; ++n) { const f32x4 x = acc[ai][bj][m][n]; sm += (x[0] + x[1]) + (x[2] + x[3]); }
                sm += __shfl_xor(sm, 16); sm += __shfl_xor(sm, 32);
                const float mw = sm * (1.0f / 64.0f); float q = 0.f;
#pragma unroll
                for (int bj = 0; bj < 2; ++bj)
#pragma unroll
                    for (int n = 0; n < 2; ++n) { const f32x4 d = acc[ai][bj][m][n] - mw; q += (d[0] * d[0] + d[1] * d[1]) + (d[2] * d[2] + d[3] * d[3]); }
                q += __shfl_xor(q, 16); q += __shfl_xor(q, 32);
                if (fq == 0) P[(ai * 128 + wr * 64 + m * 16 + fr) * 4 + wc] = (f32x2v){mw, q};
            }
        asm volatile("s_waitcnt lgkmcnt(0)" ::: "memory"); __builtin_amdgcn_s_barrier(); asm volatile("" ::: "memory");
        const int row = wid * 32 + (lane & 31);
        unsigned long long* xb = (unsigned long long*)(ws + WS_LNX) + (size_t)(u.pm * 256 + row) * 4;
        if (lane < 32) {
            const f32x2v a = P[row * 4 + 0], b2 = P[row * 4 + 1], c = P[row * 4 + 2], d = P[row * 4 + 3];
            const float mt = (a.x + b2.x + c.x + d.x) * 0.25f;
            const float da = a.x - mt, db = b2.x - mt, dc = c.x - mt, dd = d.x - mt;
            const float m2 = (a.y + b2.y) + (c.y + d.y) + 64.0f * ((da * da + db * db) + (dc * dc + dd * dd));
            __hip_atomic_store(xb + u.pn, ((unsigned long long)__builtin_bit_cast(unsigned, m2) << 32) | __builtin_bit_cast(unsigned, mt), RLX_AGENT);
        }
        asm volatile("s_waitcnt vmcnt(0)" ::: "memory");
        gu32* cnt = ctl + CW_LNC + 64 * u.pm;
        if (lane == 0) __hip_atomic_fetch_add(cnt, 1u, RLX_AGENT);
        if (wid == 0) { unsigned spins = 0; bool dead = false;
            while ((unsigned)__builtin_amdgcn_readfirstlane(__hip_atomic_load(cnt, RLX_AGENT)) < 32u) { if (++spins > (1u << 21)) { dead = true; break; } __builtin_amdgcn_s_sleep(2); }
            __builtin_amdgcn_fence(__ATOMIC_ACQUIRE, "agent");
            if (lane == 0) flag[0] = dead ? 1u : 0u; }
        asm volatile("s_waitcnt vmcnt(0) lgkmcnt(0)" ::: "memory"); __builtin_amdgcn_s_barrier(); asm volatile("" ::: "memory");
        const bool bad = flag[0] != 0u;
        if (lane < 32) { float mt[4], m2[4], ms = 0.f;
#pragma unroll
            for (int t = 0; t < 4; ++t) { const unsigned long long w = __hip_atomic_load(xb + t, RLX_AGENT); mt[t] = __builtin_bit_cast(float, (unsigned)w); m2[t] = __builtin_bit_cast(float, (unsigned)(w >> 32)); ms += mt[t]; }
            const float mean = ms * 0.25f; float q = 0.f;
#pragma unroll
            for (int t = 0; t < 4; ++t) { const float dm = mt[t] - mean; q += m2[t] + 256.0f * dm * dm; }
            S[row] = (f32x2v){mean, bad ? __builtin_nanf("") : 1.0f / sqrtf(q * (1.0f / D) + LN_EPS)}; }
        asm volatile("s_waitcnt lgkmcnt(0)" ::: "memory"); __builtin_amdgcn_s_barrier(); asm volatile("" ::: "memory");
        f32x4 gv[2][2], bb[2][2];
#pragma unroll
        for (int bj = 0; bj < 2; ++bj)
#pragma unroll
            for (int n = 0; n < 2; ++n) { gv[bj][n] = *(const f32x4*)(g + cl + 32 * bj + 4 * n); bb[bj][n] = *(const f32x4*)(b + cl + 32 * bj + 4 * n); }
        unsigned char* h8 = ws + WS_HB8 + (size_t)(u.pm * 256 + wr * 64 + fr) * D + cl;
#pragma unroll
        for (int ai = 0; ai < 2; ++ai)
#pragma unroll
            for (int m = 0; m < 4; ++m) { const f32x2v sr = S[ai * 128 + wr * 64 + m * 16 + fr]; const size_t ro = (size_t)(ai * 128 + m * 16) * D;
#pragma unroll
                for (int bj = 0; bj < 2; ++bj) { const f32x4 v0 = (acc[ai][bj][m][0] - sr.x) * sr.y * gv[bj][0] + bb[bj][0], v1 = (acc[ai][bj][m][1] - sr.x) * sr.y * gv[bj][1] + bb[bj][1];
                    *(GAS u32x4*)(hp + ro + 32 * bj) = (u32x4){pk2(v0[0], v0[1]), pk2(v0[2], v0[3]), pk2(v1[0], v1[1]), pk2(v1[2], v1[3])};
                    *(GAS u32x2*)(h8 + ro + 32 * bj) = (u32x2){pk4_fp8(v0[0], v0[1], v0[2], v0[3]), pk4_fp8(v1[0], v1[1], v1[2], v1[3])}; } }
    }
};
struct EpiFp8 { static constexpr bool PERM = true; static constexpr int PERM2 = 1;
    unsigned char* O; int ldc; float scale;
    __device__ __forceinline__ void operator()(const f32x4 (&acc)[2][2][4][2], const Unit& u, int wr, int wc, int fr, int fq) const {
        const int cl = 256 * u.pn + 64 * wc + 16 * fq; unsigned char* p0 = O + (size_t)(u.pm * 256 + wr * 64 + fr) * ldc + cl;
#pragma unroll
        for (int ai = 0; ai < 2; ++ai)
#pragma unroll
            for (int m = 0; m < 4; ++m) { u32x4 w; const f32x4 a = acc[ai][0][m][0] * scale, b = acc[ai][0][m][1] * scale, c = acc[ai][1][m][0] * scale, d = acc[ai][1][m][1] * scale;
                w.x = pk4_fp8(a[0], a[1], a[2], a[3]); w.y = pk4_fp8(b[0], b[1], b[2], b[3]); w.z = pk4_fp8(c[0], c[1], c[2], c[3]); w.w = pk4_fp8(d[0], d[1], d[2], d[3]);
                *(u32x4*)(p0 + (size_t)(ai * 128 + m * 16) * ldc) = w; }
    }
};
constexpr int MOE_MAX_UNITS = 40;
struct SchedMoe { const LAS int* ut;
    __device__ __forceinline__ bool next(int i, Unit& u) const {
        if (i >= MOE_MAX_UNITS) return false;
        const LAS int* p = ut + 8 * i;
        if (__builtin_amdgcn_readfirstlane(p[7]) == 0) return false;
        u.pm = __builtin_amdgcn_readfirstlane(p[0]); u.pn = __builtin_amdgcn_readfirstlane(p[1]); u.z = __builtin_amdgcn_readfirstlane(p[2]); u.nvalid = __builtin_amdgcn_readfirstlane(p[3]);
        u.aoff = (unsigned)__builtin_amdgcn_readfirstlane(p[4]); u.boff = (unsigned)__builtin_amdgcn_readfirstlane(p[5]); u.goff = (unsigned)__builtin_amdgcn_readfirstlane(p[6]); return true; }
};
__device__ __forceinline__ void moe_units(Frame& F, const LAS int* tb, LAS int* ut, int nN, unsigned abase, unsigned wbase, unsigned wexp, bool gather) {
    if (F.tid < MOE_MAX_UNITS) { const int i = F.tid, nblk = tb[32], L = i * F.G + (int)blockIdx.x; LAS int* p = ut + 8 * i;
        if (L < nblk * nN) { int pm, pn; pg8::tile_order(L, nblk, nN, pm, pn);
            const int e = tb[128 + pm], j = pm - tb[e], rem = tb[64 + e] - 256 * j;
            p[0] = pm; p[1] = pn; p[2] = e; p[3] = rem < 256 ? rem : 256; p[4] = (int)(gather ? abase : abase + (unsigned)pm * (TSTEP / 2));
            p[5] = (int)(wbase + (unsigned)e * wexp + (unsigned)pn * (TSTEP / 2)); p[6] = e * LCAP + 256 * j; p[7] = 1; }
        else p[7] = 0; }
    LDS_WAIT(); __syncthreads();
}
__device__ __forceinline__ f32x2 swiglu_pk(f32x2 g, f32x2 u) {
    f32x2 g_, u_; g_.x = fminf(g.x, 7.0f); g_.y = fminf(g.y, 7.0f); u_.x = __builtin_amdgcn_fmed3f(u.x, -7.0f, 7.0f); u_.y = __builtin_amdgcn_fmed3f(u.y, -7.0f, 7.0f);
    const f32x2 t = g_ * (-1.702f * LOG2E); f32x2 e; e.x = __builtin_amdgcn_exp2f(t.x); e.y = __builtin_amdgcn_exp2f(t.y);
    const f32x2 d = e + 1.0f; f32x2 r; r.x = __builtin_amdgcn_rcpf(d.x); r.y = __builtin_amdgcn_rcpf(d.y);
    return ((u_ + 1.0f) * g_) * r;
}
struct EpiAct { static constexpr bool PERM = true;
    unsigned char* ACT; const float* b_gu;
    __device__ __forceinline__ void operator()(const f32x4 (&acc)[2][2][4][2], const Unit& u, int wr, int wc, int fr, int fq) const {
        const int ch = 128 * u.pn + wc * 32 + 8 * fq;
        unsigned char* ap = ACT + ((size_t)(u.pm * 16 + wr * 4) * (DFF / 32) + (4 * u.pn + wc)) * 512 + fr * 32 + 8 * fq;
        const float* bb = b_gu + (size_t)u.z * 2 * DFF;
        f32x4 bg[2], bu[2];
#pragma unroll
        for (int n = 0; n < 2; ++n) { bg[n] = *(const f32x4*)(bb + ch + 4 * n); bu[n] = *(const f32x4*)(bb + DFF + ch + 4 * n); }
#pragma unroll
        for (int ai = 0; ai < 2; ++ai)
#pragma unroll
            for (int m = 0; m < 4; ++m) { f32x2 o[2][2];
#pragma unroll
                for (int n = 0; n < 2; ++n) { const f32x4 ag = acc[ai][0][m][n], au = acc[ai][1][m][n];
                    o[n][0] = swiglu_pk((f32x2){ag[0], ag[1]} * (1.0f / WGU_SC) + (f32x2){bg[n][0], bg[n][1]}, (f32x2){au[0], au[1]} * (1.0f / WGU_SC) + (f32x2){bu[n][0], bu[n][1]});
                    o[n][1] = swiglu_pk((f32x2){ag[2], ag[3]} * (1.0f / WGU_SC) + (f32x2){bg[n][2], bg[n][3]}, (f32x2){au[2], au[3]} * (1.0f / WGU_SC) + (f32x2){bu[n][2], bu[n][3]}); }
                *(u32x2*)(ap + (size_t)(ai * 8 + m) * (16 * DFF)) = (u32x2){pk4_fp8(o[0][0].x, o[0][0].y, o[0][1].x, o[0][1].y), pk4_fp8(o[1][0].x, o[1][0].y, o[1][1].x, o[1][1].y)}; }
    }
};
struct EpiDown { static constexpr bool PERM = true; static constexpr int PERM2 = 1; static constexpr bool ATILED = true;
    unsigned char* YS; const float* b_down;
    __device__ __forceinline__ void operator()(const f32x4 (&acc)[2][2][4][2], const Unit& u, int wr, int wc, int fr, int fq) const {
        const int r0 = wr * 64 + fr, cl = 256 * u.pn + 64 * wc + 16 * fq;
        const float* bb = b_down + (size_t)u.z * D + cl;
        f32x4 bv[2][2];
#pragma unroll
        for (int bj = 0; bj < 2; ++bj)
#pragma unroll
            for (int n = 0; n < 2; ++n) bv[bj][n] = *(const f32x4*)(bb + 8 * bj + 4 * n) * YS_SC;
#pragma unroll
        for (int ai = 0; ai < 2; ++ai)
#pragma unroll
            for (int m = 0; m < 4; ++m) { const int r = r0 + ai * 128 + m * 16; u32x4 w;
                { const f32x4 a = acc[ai][0][m][0] * (YS_SC / WDN_SC) + bv[0][0], b = acc[ai][0][m][1] * (YS_SC / WDN_SC) + bv[0][1], c = acc[ai][1][m][0] * (YS_SC / WDN_SC) + bv[1][0], d = acc[ai][1][m][1] * (YS_SC / WDN_SC) + bv[1][1];
                    w.x = pk4_fp8(a[0], a[1], a[2], a[3]); w.y = pk4_fp8(b[0], b[1], b[2], b[3]); w.z = pk4_fp8(c[0], c[1], c[2], c[3]); w.w = pk4_fp8(d[0], d[1], d[2], d[3]); }
                *(u32x4*)(YS + (size_t)(u.pm * 256 + r) * D + cl) = w; }
    }
};
__device__ __forceinline__ void moe_table(Frame& F, LAS int* tb) {
    if (F.tid < 32) { int c = (int)__hip_atomic_load(F.ctl + CW_ECNT + 64 * F.tid, RLX_AGENT); if (c > LCAP) c = LCAP; tb[64 + F.tid] = c; }
    LDS_WAIT(); __syncthreads();
    if (F.tid == 0) { int s = 0; for (int e = 0; e < NE; ++e) { tb[e] = s; s += (tb[64 + e] + 255) >> 8; } tb[32] = s; }
    LDS_WAIT(); __syncthreads();
    for (int b = F.tid; b < NBLK_MAX; b += NWAVES * 64) { int e = 0; while (e < NE - 1 && tb[e + 1] <= b) ++e; tb[128 + b] = e; }
    LDS_WAIT(); __syncthreads();
}

constexpr int P2_RING = 48, P2_CUT = P2_RING * 1024, P2_CCO = 16 * 512 * 4;
constexpr int P2_PRIV = 81920, P2_SYNC = 151552;
static_assert(P2_CUT + P2_CCO <= P2_PRIV && P2_PRIV + 4 * 16384 <= P2_SYNC && P2_SYNC + 64 <= LDSCTL_OFF, "phase 2 LDS map");
__device__ __forceinline__ void conv_bar4(LAS int* cnt, int& gen, int lane) {
    gen += 4;
    asm volatile("s_waitcnt lgkmcnt(0)" ::: "memory");
    if (lane == 0) __hip_atomic_fetch_add(cnt, 1, __ATOMIC_RELAXED, __HIP_MEMORY_SCOPE_WORKGROUP);
    unsigned spins = 0;
    while (__builtin_amdgcn_readfirstlane(__hip_atomic_load(cnt, __ATOMIC_RELAXED, __HIP_MEMORY_SCOPE_WORKGROUP)) < gen) { if (++spins > (1u << 22)) break; __builtin_amdgcn_s_sleep(1); }
    asm volatile("" ::: "memory");
}
__device__ __forceinline__ void conv_phase4(Frame& F) {
    LAS unsigned* ut = (LAS unsigned*)(F.lds);
    LAS float* co = (LAS float*)(F.lds + P2_CUT);
    LAS int* cnt = (LAS int*)(F.lds + P2_SYNC);
    const int cp = F.tid & 255;
    f32x2 wv[CWID];
    { const float* wd = F.in[I_W_DW] + 2 * cp;
#pragma unroll
        for (int j = 0; j < CWID; ++j) wv[j] = *(const GAS f32x2*)(wd + j * CONV_CH); }
    const f32x2 bd = *(const GAS f32x2*)(F.in[I_B_DW] + 2 * cp);
    const f32x4 g0 = *(const GAS f32x4*)(F.in[I_LN_CONV_G] + 8 * F.lane), g1 = *(const GAS f32x4*)(F.in[I_LN_CONV_G] + 8 * F.lane + 4);
    const f32x4 b0 = *(const GAS f32x4*)(F.in[I_LN_CONV_B] + 8 * F.lane), b1 = *(const GAS f32x4*)(F.in[I_LN_CONV_B] + 8 * F.lane + 4);
    unsigned char* MX = F.ws + WS_MIXIN;
    int gen = 0;
    constexpr int NITEM = NB * (T_ / 16);
    const int ipw = (NITEM + F.G - 1) / F.G, it0 = F.vcu * ipw, it1 = (it0 + ipw < NITEM) ? it0 + ipw : NITEM;
    u32x4 stg[4];
#define CONV_FULL(item) do { const int b_ = (item) / (T_ / 16), t0_ = ((item) % (T_ / 16)) * 16; const bf16* U_ = (const bf16*)(F.ws + WS_U) + (size_t)b_ * T_ * CONV_CH; \
        for (int idx_ = F.tid; idx_ < 46 * 64; idx_ += 256) { const int r_ = idx_ >> 6, c16_ = idx_ & 63, t_ = t0_ - 30 + r_; \
            u32x4 v_ = (u32x4){0u, 0u, 0u, 0u}; if (t_ >= 0) v_ = *(const GAS u32x4*)(U_ + (size_t)t_ * CONV_CH + c16_ * 8); \
            *(LAS u32x4*)(ut + ((t_ + P2_RING) % P2_RING) * 256 + c16_ * 4) = v_; } } while (0)
#define CONV_FETCH16(item) do { const int b_ = (item) / (T_ / 16), t0_ = ((item) % (T_ / 16)) * 16; const bf16* U_ = (const bf16*)(F.ws + WS_U) + ((size_t)b_ * T_ + t0_) * CONV_CH; \
        _Pragma("unroll") for (int q_ = 0; q_ < 4; ++q_) { const int idx_ = F.tid + 256 * q_; stg[q_] = *(const GAS u32x4*)(U_ + (size_t)(idx_ >> 6) * CONV_CH + (idx_ & 63) * 8); } } while (0)
#define CONV_PUT16(item) do { const int t0_ = ((item) % (T_ / 16)) * 16; \
        _Pragma("unroll") for (int q_ = 0; q_ < 4; ++q_) { const int idx_ = F.tid + 256 * q_; *(LAS u32x4*)(ut + ((t0_ + (idx_ >> 6)) % P2_RING) * 256 + (idx_ & 63) * 4) = stg[q_]; } } while (0)
    if (it0 < it1) CONV_FULL(it0);
    for (int it = it0; it < it1; ++it) {
        const int b = it / (T_ / 16), t0 = (it % (T_ / 16)) * 16;
        const bool more = it + 1 < it1, nfull = ((it + 1) % (T_ / 16)) == 0;
        conv_bar4(cnt, gen, F.lane);
        if (more && !nfull) CONV_FETCH16(it + 1);
        { f32x2 av[16];
            const int s0 = __builtin_amdgcn_readfirstlane((t0 + P2_RING - 30) % P2_RING);
#pragma unroll
            for (int tt = 0; tt < 16; ++tt) av[tt] = bd;
#pragma unroll
            for (int r = 0; r < 46; ++r) { int pos = s0 + r; pos = (pos >= P2_RING) ? pos - P2_RING : pos;
                const unsigned uu = ut[pos * 256 + cp]; const f32x2 uv = {bflo(uu), bfhi(uu)};
#pragma unroll
                for (int tt = 0; tt < 16; ++tt) { const int j = r - tt; if (j >= 0 && j < CWID) av[tt] = wv[j] * uv + av[tt]; } }
#pragma unroll
            for (int tt = 0; tt < 16; ++tt) *(LAS f32x2*)(co + tt * CONV_CH + 2 * cp) = av[tt];
        }
        conv_bar4(cnt, gen, F.lane);
        if (more) { if (nfull) CONV_FULL(it + 1); else CONV_PUT16(it + 1); }
#pragma unroll
        for (int q = 0; q < 4; ++q) { const int tt = 4 * F.wave + q;
            f32x4 x0 = *(const LAS f32x4*)(co + tt * CONV_CH + 8 * F.lane), x1 = *(const LAS f32x4*)(co + tt * CONV_CH + 8 * F.lane + 4);
            const float mean = wave_sum((x0.x + x0.y) + (x0.z + x0.w) + (x1.x + x1.y) + (x1.z + x1.w)) * (1.f / CONV_CH);
            x0 = x0 - mean; x1 = x1 - mean;
            const float var = wave_sum((x0.x * x0.x + x0.y * x0.y) + (x0.z * x0.z + x0.w * x0.w) + (x1.x * x1.x + x1.y * x1.y) + (x1.z * x1.z + x1.w * x1.w)) * (1.f / CONV_CH);
            const float rstd = 1.f / sqrtf(var + LN_EPS);
            x0 = x0 * rstd * g0 + b0; x1 = x1 * rstd * g1 + b1;
            float y[8] = {x0.x, x0.y, x0.z, x0.w, x1.x, x1.y, x1.z, x1.w};
#pragma unroll
            for (int j = 0; j < 8; ++j) y[j] = y[j] * sigmoidf_fast(y[j]);
            *(GAS u32x2*)(MX + (size_t)(b * T_ + t0 + tt) * D + 8 * F.lane) = (u32x2){pk4_fp8(y[0] * MIX_SC, y[1] * MIX_SC, y[2] * MIX_SC, y[3] * MIX_SC), pk4_fp8(y[4] * MIX_SC, y[5] * MIX_SC, y[6] * MIX_SC, y[7] * MIX_SC)}; }
    }
#undef CONV_FULL
#undef CONV_FETCH16
#undef CONV_PUT16
    conv_bar4(cnt, gen, F.lane);
}

typedef float f32x16 __attribute__((ext_vector_type(16)));
__device__ __forceinline__ int crow(int r, int hi) { return (r & 3) + 8 * (r >> 2) + 4 * hi; }
__device__ __forceinline__ bf16x8 pack8(const float* v) {
    u32x4 w; w.x = pg8::cvt_pk_bf16(v[0], v[1]); w.y = pg8::cvt_pk_bf16(v[2], v[3]); w.z = pg8::cvt_pk_bf16(v[4], v[5]); w.w = pg8::cvt_pk_bf16(v[6], v[7]);
    return __builtin_bit_cast(bf16x8, w); }
constexpr float SB_EXIT = 150.0f;
struct SbStage { u32x4 k[4], v[4]; };
__device__ __forceinline__ void sb_gload(SbStage& g, const bf16* Kt, const bf16* Vt, int lane) {
#pragma unroll
    for (int i = 0; i < 4; ++i) { const int c = (lane & 7) ^ ((4 * i + (lane >> 4)) & 7); g.k[i] = *(const GAS u32x4*)(Kt + (size_t)(8 * i) * SBW + 8 * c); }
#pragma unroll
    for (int i = 0; i < 4; ++i) g.v[i] = *(const GAS u32x4*)(Vt + (size_t)(16 * i) * M);
}
__device__ __forceinline__ void sb_lwrite(const SbStage& g, LAS unsigned char* buf, int lane) {
#pragma unroll
    for (int i = 0; i < 4; ++i) *(LAS u32x4*)(buf + 1024 * i + 16 * lane) = g.k[i];
#pragma unroll
    for (int i = 0; i < 4; ++i) *(LAS u32x4*)(buf + 4096 + 1024 * i + 16 * lane) = g.v[i];
}
__device__ __forceinline__ void sb_attn_wave(Frame& F, int b, int h, int qt, LAS unsigned char* wbuf) {
    const int c = F.lane & 31, hi = F.lane >> 5;
    const bf16* Q = (const bf16*)(F.ws + WS_Q); const bf16* Kb = (const bf16*)(F.ws + WS_K); const bf16* VT = (const bf16*)(F.ws + WS_V);
    bf16x8 tri[2];
#pragma unroll
    for (int s = 0; s < 2; ++s) { bf16x8 t;
#pragma unroll
        for (int j = 0; j < 8; ++j) { const int k = 16 * s + 8 * (j >> 2) + 4 * hi + (j & 3); t[j] = (k >= c) ? (short)0xBF80 : (short)0; }
        tri[s] = t; }
    bf16x8 qf[4];
    { const bf16* qp = Q + ((size_t)b * T_ + 32 * qt + c) * SBW + h * SBD + 8 * hi;
#pragma unroll
        for (int s = 0; s < 4; ++s) qf[s] = *(const GAS bf16x8*)(qp + 16 * s); }
    const bf16* Ksrc = Kb + ((size_t)b * T_ + (F.lane >> 3)) * SBW + h * SBD;
    const bf16* Vsrc = VT + (size_t)(h * SBD + (F.lane >> 2)) * M + (size_t)b * T_ + 8 * ((F.lane & 3) ^ ((F.lane >> 4) & 3));

    const int ksw = (c >> 1) & 7, vsw = (c >> 2) & 3;

    f32x16 o0, o1;
#pragma unroll
    for (int r = 0; r < 16; ++r) { o0[r] = 0.f; o1[r] = 0.f; }
    float carry = 0.f;
    SbStage st;
    sb_gload(st, Ksrc + (size_t)(32 * qt) * SBW, Vsrc + 32 * qt, F.lane); sb_lwrite(st, wbuf, F.lane);
    for (int kt = qt; kt >= 0; --kt) {
        LAS unsigned char* buf = wbuf + ((qt - kt) & 1) * 8192;
        if (kt > 0) sb_gload(st, Ksrc + (size_t)(32 * (kt - 1)) * SBW, Vsrc + 32 * (kt - 1), F.lane);
        const bool diag = (kt == qt);
        bf16x8 kf[4];
#pragma unroll
        for (int s = 0; s < 4; ++s) kf[s] = *(const LAS bf16x8*)(buf + c * 128 + 16 * ((2 * s + hi) ^ ksw));
        f32x16 p;
#pragma unroll
        for (int r = 0; r < 16; ++r) p[r] = 0.f;
#pragma unroll
        for (int s = 0; s < 4; ++s) p = __builtin_amdgcn_mfma_f32_32x32x16_bf16(kf[s], qf[s], p, 0, 0, 0);
        u32x2 vv[2][2][2];
#pragma unroll
        for (int dt = 0; dt < 2; ++dt)
#pragma unroll
            for (int s = 0; s < 2; ++s)
#pragma unroll
                for (int q = 0; q < 2; ++q) vv[dt][s][q] = *(const LAS u32x2*)(buf + 4096 + (32 * dt + c) * 64 + 16 * ((2 * s + q) ^ vsw) + 8 * hi);
        float L[16];
#pragma unroll
        for (int r = 0; r < 16; ++r) { const float y = p[r]; float l = __builtin_amdgcn_logf(1.0f + __builtin_amdgcn_exp2f(y)); l = (y > 64.f) ? y : l;
            if (diag) l = (crow(r, hi) >= c) ? 0.f : l; L[r] = l; }
        const bf16x8 l0 = pack8(L), l1 = pack8(L + 8);
        f32x16 a;
#pragma unroll
        for (int r = 0; r < 16; ++r) a[r] = p[r] - carry;
        a = __builtin_amdgcn_mfma_f32_32x32x16_bf16(tri[0], l0, a, 0, 0, 0); a = __builtin_amdgcn_mfma_f32_32x32x16_bf16(tri[1], l1, a, 0, 0, 0);
        const float tot = p[0] - a[0];
        float w[16];
#pragma unroll
        for (int r = 0; r < 16; ++r) { float x = __builtin_amdgcn_exp2f(a[r]); if (diag) x = (crow(r, hi) >= c) ? 0.f : x; w[r] = x; }
        const bf16x8 p0 = pack8(w), p1 = pack8(w + 8);
        { const bf16x8 v00 = __builtin_bit_cast(bf16x8, (u32x4){vv[0][0][0].x, vv[0][0][0].y, vv[0][0][1].x, vv[0][0][1].y});
          const bf16x8 v01 = __builtin_bit_cast(bf16x8, (u32x4){vv[0][1][0].x, vv[0][1][0].y, vv[0][1][1].x, vv[0][1][1].y});
          const bf16x8 v10 = __builtin_bit_cast(bf16x8, (u32x4){vv[1][0][0].x, vv[1][0][0].y, vv[1][0][1].x, vv[1][0][1].y});
          const bf16x8 v11 = __builtin_bit_cast(bf16x8, (u32x4){vv[1][1][0].x, vv[1][1][0].y, vv[1][1][1].x, vv[1][1][1].y});
          o0 = __builtin_amdgcn_mfma_f32_32x32x16_bf16(v00, p0, o0, 0, 0, 0); o0 = __builtin_amdgcn_mfma_f32_32x32x16_bf16(v01, p1, o0, 0, 0, 0);
          o1 = __builtin_amdgcn_mfma_f32_32x32x16_bf16(v10, p0, o1, 0, 0, 0); o1 = __builtin_amdgcn_mfma_f32_32x32x16_bf16(v11, p1, o1, 0, 0, 0); }
        carry = __shfl(tot, c);
        if (__all(carry >= SB_EXIT)) break;
        if (kt > 0) sb_lwrite(st, wbuf + ((qt - kt + 1) & 1) * 8192, F.lane);
    }
#pragma unroll
    for (int g = 0; g < 4; ++g) {
        *(LAS unsigned*)(wbuf + c * 80 + 8 * g + 4 * hi) = pk4_fp8(o0[4 * g] * MIX_SC, o0[4 * g + 1] * MIX_SC, o0[4 * g + 2] * MIX_SC, o0[4 * g + 3] * MIX_SC);
        *(LAS unsigned*)(wbuf + c * 80 + 32 + 8 * g + 4 * hi) = pk4_fp8(o1[4 * g] * MIX_SC, o1[4 * g + 1] * MIX_SC, o1[4 * g + 2] * MIX_SC, o1[4 * g + 3] * MIX_SC); }
    unsigned char* ob = F.ws + WS_MIXIN + ((size_t)b * T_ + 32 * qt) * D + CONV_CH + h * SBD;
#pragma unroll
    for (int q2 = 0; q2 < 2; ++q2) { const int ci = F.lane + 64 * q2, rr = ci >> 2, pc = ci & 3;
        *(GAS u32x4*)(ob + (size_t)rr * D + 16 * pc) = *(const LAS u32x4*)(wbuf + rr * 80 + 16 * pc); }
}

template <bool NT = false> __device__ __forceinline__ void resid_row(f32x4 (&v)[4], const bf16* hrow, const bf16* mrow, int lane) {
    f32x4 a[4]; if (NT) { load_row_bf16_nt(v, hrow, lane); load_row_bf16_nt(a, mrow, lane); } else { load_row_bf16(v, hrow, lane); load_row_bf16(a, mrow, lane); }
#pragma unroll
    for (int j = 0; j < 4; ++j) v[j] = v[j] * DN_ALPHA + a[j];
}
__device__ __forceinline__ void ln_phase(Frame& F, const float* g, const float* b) {
    int r0, r1;
    r0 = (int)(((long)F.vcu * M) / F.G); r1 = (int)(((long)(F.vcu + 1) * M) / F.G);
#pragma unroll 2
    for (int m = r0 + F.wave; m < r1; m += NWAVES) { f32x4 v[4]; bf16* hrow = (bf16*)(F.ws + WS_HB) + (size_t)m * D; resid_row<true>(v, hrow, (const bf16*)(F.ws + WS_QM) + (size_t)m * D, F.lane);
        ln_row(v, g, b, F.lane); store_row_bf16(v, hrow, F.lane);
        { GAS unsigned* h8 = (GAS unsigned*)(F.ws + WS_HB8 + (size_t)m * D) + F.lane;
#pragma unroll
            for (int j = 0; j < 4; ++j) h8[64 * j] = pk4_fp8(v[j].x, v[j].y, v[j].z, v[j].w); } }
}
__device__ __forceinline__ void xattn_phase(Frame& F) {
    LAS unsigned char* tb0 = F.lds + RING_OFF;
    const bf16* QM = (const bf16*)(F.ws + WS_QM); const bf16* KM = (const bf16*)(F.ws + WS_KM); const bf16* VMT = (const bf16*)(F.ws + WS_VMT); bf16* OB = (bf16*)(F.ws + WS_OB);
    const int c = F.lane & 31, h5 = F.lane >> 5;
    const int tr = F.tid >> 5, tc = F.tid & 31;
    const int kr = F.tid >> 4, kc = F.tid & 15;
    constexpr int TBUF = 34816;
    for (int L = (int)blockIdx.x; L < NB * 4 * 16; L += F.G) {
        int pm_, pn_; pg8::tile_order(L, 128, 4, pm_, pn_);
        const int b = pm_ >> 4, h = pn_, qt = pm_ & 15;
        const size_t rowq = (size_t)b * T_ + 256 * qt + 32 * F.wave + c;
        const bf16* qp = QM + rowq * D + h * 256 + 8 * h5;
        const bf16* ksrc = KM + ((size_t)b * NMEM + kr) * D + h * 256 + 8 * kc;
        const int kw0 = kr * 272 + kc * 16, kw1 = (kr + 32) * 272 + kc * 16;
        const bf16* vsrc = VMT + ((size_t)h * 256 + tr) * (size_t)MM + (size_t)b * NMEM + 8 * tc;
        int vw[4];
#pragma unroll
        for (int j = 0; j < 4; ++j) vw[j] = (tr + 16 * j) * 528 + tc * 16;
        u32x4 st[2][4];
#define XA_LOAD(t) do { if ((t) < 8) { const bf16* p_ = ksrc + (size_t)(64 * ((t) & 3)) * D + 128 * ((t) >> 2); st[(t) & 1][0] = *(const GAS u32x4*)p_; st[(t) & 1][1] = *(const GAS u32x4*)(p_ + (size_t)32 * D); } \
        else { _Pragma("unroll") for (int j_ = 0; j_ < 4; ++j_) st[(t) & 1][j_] = *(const GAS u32x4*)(vsrc + (size_t)(64 * ((t) - 8) + 16 * j_) * MM); } } while (0)
#define XA_WRITE(t) do { LAS unsigned char* nb_ = tb0 + ((t) % 3) * TBUF; if ((t) < 8) { *(LAS u32x4*)(nb_ + kw0) = st[(t) & 1][0]; *(LAS u32x4*)(nb_ + kw1) = st[(t) & 1][1]; } \
        else { _Pragma("unroll") for (int j_ = 0; j_ < 4; ++j_) *(LAS u32x4*)(nb_ + vw[j_]) = st[(t) & 1][j_]; } } while (0)
        __syncthreads();
        XA_LOAD(0); XA_LOAD(1); XA_WRITE(0);
        LDS_WAIT(); __syncthreads();
        f32x16 sacc[8]; bf16x8 qf[8]; bf16x8 pb[8][2]; float inv = 0.f;
        unsigned char* ob0 = (unsigned char*)OB + ((size_t)b * T_ + 256 * qt + 32 * F.wave) * D + h * 256;
        LAS unsigned char* ost = tb0 + 3 * TBUF + F.wave * 2560;
#pragma unroll
        for (int i = 0; i < 12; ++i) {
            LAS unsigned char* buf = tb0 + (i % 3) * TBUF;
            if (i + 2 < 12) XA_LOAD(i + 2);
            if (i < 8) { const int dh = i >> 2, kp = i & 3;
                if (kp == 0) {
#pragma unroll
                    for (int s_ = 0; s_ < 8; ++s_) qf[s_] = *(const GAS bf16x8*)(qp + 128 * dh + 16 * s_); }
#pragma unroll
                for (int k2 = 0; k2 < 2; ++k2) { const int kt = 2 * kp + k2;
                    f32x16 a;
                    if (dh == 0) {
#pragma unroll
                        for (int r = 0; r < 16; ++r) a[r] = 0.f; }
                    else a = sacc[kt];
#pragma unroll
                    for (int s_ = 0; s_ < 8; ++s_) { const bf16x8 kf = *(const LAS bf16x8*)(buf + c * 272 + h5 * 16 + (32 * k2 * 272 + 32 * s_)); a = __builtin_amdgcn_mfma_f32_32x32x16_bf16(kf, qf[s_], a, 0, 0, 0); }
                    sacc[kt] = a; }
            } else { const int dp = i - 8;
                if (dp == 0) {
                    float mx = sacc[0][0];
#pragma unroll
                    for (int kt = 0; kt < 8; ++kt)
#pragma unroll
                        for (int r = 0; r < 16; ++r) mx = fmaxf(mx, sacc[kt][r]);
                    mx = fmaxf(mx, __shfl_xor(mx, 32));
                    float sum = 0.f;
#pragma unroll
                    for (int kt = 0; kt < 8; ++kt) { float p[16];
#pragma unroll
                        for (int r = 0; r < 16; ++r) { p[r] = __builtin_amdgcn_exp2f(sacc[kt][r] - mx); sum += p[r]; }
                        pb[kt][0] = pack8(p); pb[kt][1] = pack8(p + 8); }
                    sum += __shfl_xor(sum, 32);
                    inv = OB_SC / sum; }
#pragma unroll
                for (int d2 = 0; d2 < 2; ++d2) { const int dt = 2 * dp + d2;
                    f32x16 o;
#pragma unroll
                    for (int r = 0; r < 16; ++r) o[r] = 0.f;
#pragma unroll
                    for (int kt = 0; kt < 8; ++kt)
#pragma unroll
                        for (int s2 = 0; s2 < 2; ++s2) { const LAS unsigned char* rp = buf + c * 528 + 8 * h5 + (32 * d2 * 528 + (4 * kt + 2 * s2) * 16);
                            const u32x2 v0 = *(const LAS u32x2*)rp, v1 = *(const LAS u32x2*)(rp + 16);
                            o = __builtin_amdgcn_mfma_f32_32x32x16_bf16(__builtin_bit_cast(bf16x8, (u32x4){v0.x, v0.y, v1.x, v1.y}), pb[kt][s2], o, 0, 0, 0); }
#pragma unroll
                    for (int g = 0; g < 4; ++g) *(LAS unsigned*)(ost + c * 80 + 32 * d2 + 8 * g + 4 * h5) = pk4_fp8(o[4 * g] * inv, o[4 * g + 1] * inv, o[4 * g + 2] * inv, o[4 * g + 3] * inv); }
#pragma unroll
                for (int q2 = 0; q2 < 2; ++q2) { const int ci = F.lane + 64 * q2, rr = ci >> 2, pc = ci & 3;
                    *(GAS u32x4*)(ob0 + (size_t)rr * D + 64 * dp + 16 * pc) = *(const LAS u32x4*)(ost + rr * 80 + 16 * pc); }
            }
            if (i + 1 < 12) XA_WRITE(i + 1);
            LDS_WAIT(); __syncthreads();
        }
#undef XA_LOAD
#undef XA_WRITE
    }
}
typedef float f32x4v __attribute__((ext_vector_type(4)));
__device__ __forceinline__ void ln2_router_phase(Frame& F) {
    LAS bf16* wr = (LAS bf16*)(F.lds + P10_WR);
    LAS float* gb = (LAS float*)(F.lds + P10_GB);
    LAS int* lcnt = (LAS int*)(F.lds + P10_LCNT);
    LAS int* rec = (LAS int*)(F.lds + P10_REC);
    for (int i = F.tid; i < 2 * 32 * WR_STRIDE * 2 / 16; i += 512) *(LAS u32x4*)(F.lds + P10_WR + 16 * i) = *(const GAS u32x4*)(F.ws + WS_WR + 16 * i);
    for (int i = F.tid; i < 512; i += 512) { *(LAS f32x4*)(gb + 4 * i) = ((const GAS f32x4*)(i < 256 ? F.in[I_LN2_G] : F.in[I_LN2_B]))[i & 255]; }
    if (F.tid < 64) lcnt[F.tid] = 0;
    LDS_WAIT(); __syncthreads();
    const bf16* H1 = (const bf16*)(F.ws + WS_HB); const unsigned char* CA = F.ws + WS_QM; bf16* H2 = (bf16*)(F.ws + WS_HB2);
    typedef float f32x2w __attribute__((ext_vector_type(2)));
    int* ltok = (int*)(F.ws + WS_LTOK); float* lgate = (float*)(F.ws + WS_LGATE); int* sidx = (int*)(F.ws + WS_SIDX);
    const int fr = F.lane & 15, fq = F.lane >> 4;
    for (int rb = F.vcu; rb < M / 128; rb += F.G) {
        const int m0 = rb * 128 + F.wave * 16;
        float mymean = 0.f, myrstd = 0.f;
        { u32x2 hr[4][4]; unsigned cq[4][4];
#define P8_LROW(slot, mm) do { const GAS u32x2* xr_ = (const GAS u32x2*)(H1 + (size_t)(mm) * D) + F.lane; const GAS unsigned* cr_ = (const GAS unsigned*)(CA + (size_t)(mm) * D) + F.lane; \
            _Pragma("unroll") for (int j_ = 0; j_ < 4; ++j_) { hr[slot][j_] = xr_[64 * j_]; cq[slot][j_] = cr_[64 * j_]; } } while (0)
            P8_LROW(0, m0); P8_LROW(1, m0 + 1); P8_LROW(2, m0 + 2); P8_LROW(3, m0 + 3);
#pragma unroll
            for (int i = 0; i < 16; ++i) { const int m = m0 + i; constexpr int dummy_ = 0; (void)dummy_;
                f32x4 v[4];
#pragma unroll
                for (int j = 0; j < 4; ++j) { const u32x2 w2 = hr[i & 3][j]; const unsigned w = cq[i & 3][j];
                    const f32x2w lo = __builtin_amdgcn_cvt_pk_f32_fp8((int)w, false), hi = __builtin_amdgcn_cvt_pk_f32_fp8((int)w, true);
                    v[j] = (f32x4){bflo(w2.x), bfhi(w2.x), bflo(w2.y), bfhi(w2.y)} * DN_ALPHA + (f32x4){lo.x, lo.y, hi.x, hi.y} * (1.0f / CA_SC); }
                if (i + 4 < 16) P8_LROW(i & 3, m + 4);
                float s1 = 0.f;
#pragma unroll
                for (int j = 0; j < 4; ++j) s1 += (v[j].x + v[j].y) + (v[j].z + v[j].w);
                const float mean = wave_sum(s1) * (1.f / D); float s2 = 0.f;
#pragma unroll
                for (int j = 0; j < 4; ++j) { v[j] = v[j] - mean; s2 += (v[j].x * v[j].x + v[j].y * v[j].y) + (v[j].z * v[j].z + v[j].w * v[j].w); }
                const float rstd = 1.f / sqrtf(wave_sum(s2) * (1.f / D) + LN_EPS);
                if (fr == i) { mymean = mean; myrstd = rstd; }
#pragma unroll
                for (int j = 0; j < 4; ++j) { const f32x4 gg = *(const LAS f32x4*)(gb + 4 * F.lane + 256 * j), bb = *(const LAS f32x4*)(gb + 1024 + 4 * F.lane + 256 * j); v[j] = v[j] * rstd * gg + bb; }
                store_row_bf16(v, H2 + (size_t)m * D, F.lane);
                { GAS unsigned* h8 = (GAS unsigned*)(F.ws + WS_HB8 + (size_t)m * D) + F.lane;
#pragma unroll
                    for (int j = 0; j < 4; ++j) h8[64 * j] = pk4_fp8(v[j].x, v[j].y, v[j].z, v[j].w); }
            }
#undef P8_LROW
        }
        f32x4v ah0 = {0.f, 0.f, 0.f, 0.f}, ah1 = {0.f, 0.f, 0.f, 0.f}, ac0 = {0.f, 0.f, 0.f, 0.f}, ac1 = {0.f, 0.f, 0.f, 0.f};
        { const bf16* hp = H1 + (size_t)(m0 + fr) * D + 8 * fq; const unsigned char* cp = CA + (size_t)(m0 + fr) * D + 8 * fq;
            const LAS bf16* wp = wr + fr * WR_STRIDE + 8 * fq;
            u32x4 hvb[8]; u32x2 cvb[8];
#pragma unroll
            for (int s_ = 0; s_ < 8; ++s_) { hvb[s_] = *(const GAS u32x4*)(hp + 32 * s_); cvb[s_] = *(const GAS u32x2*)(cp + 32 * s_); }
#pragma unroll
            for (int s_ = 0; s_ < 32; ++s_) {
                const u32x4 hv = hvb[s_ & 7]; const u32x2 cv = cvb[s_ & 7];
                const f32x2w c01 = __builtin_amdgcn_cvt_pk_f32_fp8((int)cv.x, false), c23 = __builtin_amdgcn_cvt_pk_f32_fp8((int)cv.x, true), c45 = __builtin_amdgcn_cvt_pk_f32_fp8((int)cv.y, false), c67 = __builtin_amdgcn_cvt_pk_f32_fp8((int)cv.y, true);
                if (s_ + 8 < 32) { hvb[s_ & 7] = *(const GAS u32x4*)(hp + 32 * (s_ + 8)); cvb[s_ & 7] = *(const GAS u32x2*)(cp + 32 * (s_ + 8)); }
                const bf16x8 bh = __builtin_bit_cast(bf16x8, hv);
                const bf16x8 bc = __builtin_bit_cast(bf16x8, (u32x4){pk2(c01.x, c01.y), pk2(c23.x, c23.y), pk2(c45.x, c45.y), pk2(c67.x, c67.y)});
                const bf16x8 wh0 = *(const LAS bf16x8*)(wp + 32 * s_), wh1 = *(const LAS bf16x8*)(wp + 16 * WR_STRIDE + 32 * s_);
                const bf16x8 wl0 = *(const LAS bf16x8*)(wp + 32 * WR_STRIDE + 32 * s_), wl1 = *(const LAS bf16x8*)(wp + 48 * WR_STRIDE + 32 * s_);
                ah0 = __builtin_amdgcn_mfma_f32_16x16x32_bf16(wh0, bh, ah0, 0, 0, 0); ah1 = __builtin_amdgcn_mfma_f32_16x16x32_bf16(wh1, bh, ah1, 0, 0, 0);
                ac0 = __builtin_amdgcn_mfma_f32_16x16x32_bf16(wh0, bc, ac0, 0, 0, 0); ac1 = __builtin_amdgcn_mfma_f32_16x16x32_bf16(wh1, bc, ac1, 0, 0, 0);
                ah0 = __builtin_amdgcn_mfma_f32_16x16x32_bf16(wl0, bh, ah0, 0, 0, 0); ah1 = __builtin_amdgcn_mfma_f32_16x16x32_bf16(wl1, bh, ah1, 0, 0, 0);
                ac0 = __builtin_amdgcn_mfma_f32_16x16x32_bf16(wl0, bc, ac0, 0, 0, 0); ac1 = __builtin_amdgcn_mfma_f32_16x16x32_bf16(wl1, bc, ac1, 0, 0, 0);
            } }
        float cand[8]; int eid[8];
        { const float* st = (const float*)(F.ws + WS_WR + WR_ST_OFF);
            const f32x4 s0 = *(const GAS f32x4*)(st + 4 * fq), s1 = *(const GAS f32x4*)(st + 16 + 4 * fq), t0 = *(const GAS f32x4*)(st + NE + 4 * fq), t1 = *(const GAS f32x4*)(st + NE + 16 + 4 * fq);
#pragma unroll
            for (int r = 0; r < 4; ++r) { cand[r] = myrstd * (ah0[r] * DN_ALPHA + ac0[r] * (1.0f / CA_SC) - mymean * s0[r]) + t0[r];
                cand[4 + r] = myrstd * (ah1[r] * DN_ALPHA + ac1[r] * (1.0f / CA_SC) - mymean * s1[r]) + t1[r]; eid[r] = 4 * fq + r; eid[4 + r] = 16 + 4 * fq + r; } }
        float tv[TOPK]; int te[TOPK];
#pragma unroll
        for (int k = 0; k < TOPK; ++k) {
            float bv = cand[0]; int bi = eid[0];
#pragma unroll
            for (int r = 1; r < 8; ++r) if (cand[r] > bv) { bv = cand[r]; bi = eid[r]; }
#pragma unroll
            for (int o = 16; o <= 32; o <<= 1) { const float ov = __shfl_xor(bv, o); const int oi = __shfl_xor(bi, o); if (ov > bv || (ov == bv && oi < bi)) { bv = ov; bi = oi; } }
            tv[k] = bv; te[k] = bi;
#pragma unroll
            for (int r = 0; r < 8; ++r) if (eid[r] == bi) cand[r] = -INFINITY;
        }
        float pe[TOPK], ps = 0.f;
#pragma unroll
        for (int k = 0; k < TOPK; ++k) { pe[k] = __expf(tv[k] - tv[0]); ps += pe[k]; }
        if (fq == 0) {
#pragma unroll
            for (int k = 0; k < TOPK; ++k) { const int lr = __hip_atomic_fetch_add(lcnt + te[k], 1, __ATOMIC_RELAXED, __HIP_MEMORY_SCOPE_WORKGROUP);
                LAS int* r = rec + ((F.wave * 16 + fr) * 4 + k) * 4; r[0] = te[k]; r[1] = lr; r[2] = __builtin_bit_cast(int, pe[k] / ps); r[3] = m0 + fr; } }
        LDS_WAIT(); __syncthreads();
        if (F.tid < NE) lcnt[32 + F.tid] = (int)__hip_atomic_fetch_add(F.ctl + CW_ECNT + 64 * F.tid, (unsigned)lcnt[F.tid], RLX_AGENT);
        LDS_WAIT(); __syncthreads();
        { const LAS int* r = rec + (F.wave * 64 + F.lane) * 4; const int e = r[0], pos = lcnt[32 + e] + r[1], tok = r[3];
            if (pos < LCAP) { ltok[e * LCAP + pos] = tok; lgate[e * LCAP + pos] = __builtin_bit_cast(float, r[2]); } sidx[tok * 4 + (F.lane & 3)] = e * LCAP + pos; }
        __syncthreads();
        if (F.tid < 64) lcnt[F.tid] = 0;
        LDS_WAIT(); __syncthreads();
    }
}
__device__ __forceinline__ void final_phase(Frame& F, const LAS int* tb) {
    const int gw = F.vcu * NWAVES + F.wave, NGW = F.G * NWAVES;
    const int* sidx = (const int*)(F.ws + WS_SIDX); const unsigned char* YS = F.ws + WS_YS; const float* lgate = (const float*)(F.ws + WS_LGATE);
    typedef float f32x2v __attribute__((ext_vector_type(2)));
    for (int m0 = gw; m0 < M; m0 += 2 * NGW) {
        const int mr[2] = {m0, (m0 + NGW < M) ? m0 + NGW : m0};
        int si[2][TOPK]; float gk[2][TOPK]; size_t slot[2][TOPK];
#pragma unroll
        for (int r = 0; r < 2; ++r)
#pragma unroll
            for (int k = 0; k < TOPK; ++k) si[r][k] = sidx[mr[r] * 4 + k];
#pragma unroll
        for (int r = 0; r < 2; ++r)
#pragma unroll
            for (int k = 0; k < TOPK; ++k) { const int e = si[r][k] / LCAP, pos = si[r][k] - e * LCAP; slot[r][k] = (size_t)tb[e] * 256 + pos; gk[r][k] = lgate[si[r][k]]; }
        u32x2 hw[2][4]; unsigned yw[2][TOPK][4];
#pragma unroll
        for (int r = 0; r < 2; ++r) { const GAS u32x2* hp = (const GAS u32x2*)((const bf16*)(F.ws + WS_HB2) + (size_t)mr[r] * D) + F.lane;
#pragma unroll
            for (int j = 0; j < 4; ++j) hw[r][j] = __builtin_nontemporal_load(hp + 64 * j);
#pragma unroll
            for (int k = 0; k < TOPK; ++k) { const GAS unsigned* yp = (const GAS unsigned*)(YS + slot[r][k] * D) + F.lane;
#pragma unroll
                for (int j = 0; j < 4; ++j) yw[r][k][j] = __builtin_nontemporal_load(yp + 64 * j); } }
#pragma unroll
        for (int r = 0; r < 2; ++r) { if (r == 1 && mr[1] == m0) break;
            f32x4 v[4];
#pragma unroll
            for (int j = 0; j < 4; ++j) { f32x4 sacc = {0.f, 0.f, 0.f, 0.f};
#pragma unroll
                for (int k = 0; k < TOPK; ++k) { const unsigned w = yw[r][k][j]; const f32x2v lo = __builtin_amdgcn_cvt_pk_f32_fp8((int)w, false), hi = __builtin_amdgcn_cvt_pk_f32_fp8((int)w, true);
                    sacc = sacc + (f32x4){lo.x, lo.y, hi.x, hi.y} * gk[r][k]; }
                v[j] = (f32x4){bflo(hw[r][j].x), bfhi(hw[r][j].x), bflo(hw[r][j].y), bfhi(hw[r][j].y)} * DN_ALPHA + sacc * (1.0f / YS_SC); }
            ln_row(v, F.in[I_LN3_G], F.in[I_LN3_B], F.lane); store_row_f32_nt(v, F.hf + (size_t)mr[r] * D, F.lane); }
    }
}

struct Args { const float* in[N_IN]; float* out; unsigned char* ws; int ph_lo, ph_hi, li, pad; };
__global__ void __launch_bounds__(NWAVES * 64, 2) mk_fwd(Args args) {
    extern __shared__ __attribute__((aligned(16))) unsigned char lds[];
    Frame F;
    F.lds = (LAS unsigned char*)lds; F.MISC = (volatile LAS unsigned*)(F.lds + MISC_OFF);
    F.tid = threadIdx.x; F.lane = F.tid & 63; F.wave = __builtin_amdgcn_readfirstlane(F.tid >> 6);
    F.G = gridDim.x; { const int bx = blockIdx.x; F.vcu = (F.G % 8 == 0) ? (bx % 8) * (F.G / 8) + bx / 8 : bx; }
    F.ws = args.ws; F.ctl = (gu32*)(args.ws + WS_CTL); F.hf = args.out; F.in = args.in;
    for (int u = F.tid; u < (LDS_BYTES - LDSCTL_OFF) / 4; u += NWAVES * 64) ((LAS unsigned*)(F.lds + LDSCTL_OFF))[u] = 0u;
    __syncthreads();
    XcdBarrier bar; bar.bar = (unsigned*)(F.ctl + CW_BAR) + args.li * XCD_BAR_WORDS; bar.x = 0; bar.st = nullptr;
    const int lo = args.ph_lo, hi = args.ph_hi;
    if (hi - lo > 1) bar = xcd_barrier_post((unsigned*)(F.ctl + CW_BAR) + args.li * XCD_BAR_WORDS, F.MISC + 8);
#ifndef PH_MASK
#define PH_MASK 0xfff
#endif
#define IN(k) (((PH_MASK >> (k)) & 1) && lo <= (k) && (k) < hi)
#ifndef REP_MASK
#define REP_MASK 0
#endif
#define REPS(k) (1 + ((REP_MASK >> (k)) & 1))
#define PH_BEGIN() do { int t_ = threadIdx.x; asm volatile("" : "+v"(t_)); F.tid = t_; F.lane = t_ & 63; } while (0)
#define SEAM(k) do { if (IN(k) && IN((k) + 1)) xcd_barrier(bar); } while (0)
    const char* wsb = (const char*)args.ws;
    LAS int* tb = (LAS int*)(F.lds + TB_OFF);

    if (IN(0)) for (int rep = 0; rep < REPS(0); ++rep) { PH_BEGIN(); p0_prologue(F); __syncthreads(); } SEAM(0);
    if (IN(1)) for (int rep = 0; rep < REPS(1); ++rep) { PH_BEGIN(); SchedP1 S{F.G, (int)blockIdx.x}; EpiP1 E{F.ws, F.in[I_B_IN]};
        pg8::gemm_phase<EpiP1, SchedP1, false>(F.lds + RING_OFF, wsb, D, D, D, S, E, nullptr); } SEAM(1);
    if (IN(2)) { PH_BEGIN();
        { SchedKV S{F.G == 256 ? F.vcu : (int)blockIdx.x}; EpiP1 E{F.ws, F.in[I_B_IN]};
            pg8::gemm_phase<EpiP1, SchedKV, false>(F.lds + RING_OFF, wsb, D, D, D, S, E, nullptr); }
        __syncthreads(); PH_BEGIN();
        LAS int* p2s = (LAS int*)(F.lds + P2_SYNC);
        if (F.tid < 2) p2s[F.tid] = 0;
        LDS_WAIT(); __syncthreads();
        if (F.wave >= NATT) { if (!(args.pad & 4)) {
            constexpr int NSW = NWAVES - NATT; const int w = F.wave - NATT;
            if (F.G == 256 && NSW == 2) { constexpr int CUT = 128 * 42;
                if (F.vcu < 64) expert_stream(F, F.vcu * NSW + w, 128, CUT, F.lds + P2_PRIV + (F.wave - 4) * 16384);
                else expert_stream(F, CUT + (F.vcu - 64) * NSW + w, 384, N_EXPERT_ITEMS, F.lds + P2_PRIV + (F.wave - 4) * 16384); }
            else expert_stream(F, F.vcu * NSW + w, F.G * NSW, N_EXPERT_ITEMS, F.lds + P2_PRIV + (F.wave - 4) * 16384); } }
        else {
            if (F.wave < 4 && !(args.pad & 1)) conv_phase4(F);
            if (!(args.pad & 8)) {
                LAS unsigned char* wbuf = F.wave < 4 ? F.lds + F.wave * 16384 : F.lds + P2_PRIV + (F.wave - 4) * 16384;
                const int ntask = NB * SBH * (T_ / 32), tpw = (ntask + F.G - 1) / F.G, t0 = F.vcu * tpw, t1 = (t0 + tpw < ntask) ? t0 + tpw : ntask;
                for (;;) { int j = 0; if (F.lane == 0) j = __hip_atomic_fetch_add(p2s + 1, 1, __ATOMIC_RELAXED, __HIP_MEMORY_SCOPE_WORKGROUP);
                    const int tk = t0 + __builtin_amdgcn_readfirstlane(j); if (tk >= t1) break;
                    sb_attn_wave(F, (tk >> 7) >> 3, (tk >> 7) & 7, tk & 127, wbuf); } }
        }
    } SEAM(2);
    if (IN(3)) {
        EpiLn1 E{F.ws, F.ctl, F.in[I_B_OUT], F.in[I_LN1_G], F.in[I_LN1_B], F.lds + XTRA_OFF, 1.0f / (WOUT_SC * MIX_SC)};
        if (((int)blockIdx.x & 7) >= 4) { for (int i = 0; i < P3_SKEW; ++i) __builtin_amdgcn_s_sleep(127); }
        { PH_BEGIN(); SchedOne S{(int)blockIdx.x, 128, 4, (unsigned)WS_MIXIN, (unsigned)WS_WOUT_T, TSTEP / 2, TSTEP / 2};
            pg8::gemm_phase<EpiLn1, SchedOne, false, true>(F.lds + RING_OFF, wsb, D / 2, D / 2, D / 2, S, E, nullptr); }
        __syncthreads();
        { PH_BEGIN(); SchedOne S{(int)blockIdx.x + F.G, 128, 4, (unsigned)WS_MIXIN, (unsigned)WS_WOUT_T, TSTEP / 2, TSTEP / 2};
            pg8::gemm_phase<EpiLn1, SchedOne, false, true>(F.lds + RING_OFF, wsb, D / 2, D / 2, D / 2, S, E, nullptr); }
    } SEAM(3);
    if (IN(5)) { PH_BEGIN(); SchedPlain S{F.G, (int)blockIdx.x, 128, 4, (unsigned)WS_HB8, (unsigned)WS_WQ_T, TSTEP / 2, TSTEP / 2, 0u, 0u, 0u}; EpiBf16 E{(bf16*)(F.ws + WS_QM), D, MEM_QSCALE / WQ_SC, nullptr};
        pg8::gemm_phase<EpiBf16, SchedPlain, false, true>(F.lds + RING_OFF, wsb, D / 2, D / 2, D / 2, S, E, nullptr); }
    if (IN(5) && IN(6)) { asm volatile("s_waitcnt vmcnt(0)" ::: "memory"); __syncthreads();
        if (threadIdx.x == 0) { __builtin_amdgcn_fence(__ATOMIC_ACQUIRE, "agent"); asm volatile("s_waitcnt vmcnt(0)" ::: "memory"); }
        __syncthreads(); }
    if (IN(6)) { PH_BEGIN(); xattn_phase(F); } SEAM(6);
    if (IN(7)) { PH_BEGIN(); SchedPlain S{F.G, (int)blockIdx.x, 128, 4, (unsigned)WS_OB, (unsigned)WS_WO_T, TSTEP / 2, TSTEP / 2, 0u, 0u, 0u}; EpiFp8 E{F.ws + WS_QM, D, CA_SC / (WO_SC * OB_SC)};
        pg8::gemm_phase<EpiFp8, SchedPlain, false, true>(F.lds + RING_OFF, wsb, D / 2, D / 2, D / 2, S, E, nullptr); } SEAM(7);
    if (IN(8)) { PH_BEGIN(); ln2_router_phase(F); } SEAM(8);
    if (IN(9)) for (int rep = 0; rep < REPS(9); ++rep) { PH_BEGIN(); moe_table(F, tb); moe_units(F, tb, tb + 704, 8, (unsigned)WS_HB8, (unsigned)WS_WGU_T, 2048u * 1024u, true);
        SchedMoe S{tb + 704}; EpiAct E{F.ws + WS_ACT, F.in[I_B_GU]};
        pg8::gemm_phase<EpiAct, SchedMoe, true, true>(F.lds + RING_OFF, wsb, D / 2, D / 2, D / 2, S, E, (const int*)(F.ws + WS_LTOK)); } SEAM(9);
    if (IN(10)) for (int rep = 0; rep < REPS(10); ++rep) { PH_BEGIN(); moe_table(F, tb); moe_units(F, tb, tb + 704, 4, (unsigned)WS_ACT, (unsigned)WS_WDN_T, 1024u * 1024u, false);
        SchedMoe S{tb + 704}; EpiDown E{F.ws + WS_YS, F.in[I_B_DOWN]};
        pg8::gemm_phase<EpiDown, SchedMoe, false, true>(F.lds + RING_OFF, wsb, D / 2, D / 2, D / 2, S, E, nullptr); } SEAM(10);
    if (IN(11)) { PH_BEGIN(); moe_table(F, tb); final_phase(F, tb); }
#undef IN
#undef SEAM
}

extern "C" void kernel_launch(void* const* d_in, const int* in_sizes, int n_in, void* d_out, int out_size, void* d_ws, size_t ws_size, hipStream_t stream) {
    static int grid = 0;
    if (grid == 0) {
        if (n_in != N_IN || out_size != M * D || ws_size < WS_END) { fprintf(stderr, "kernel_launch: unexpected shapes (n_in %d, out %d, ws %zu)\n", n_in, out_size, ws_size); grid = -1; return; }
        int dev = 0, cus = 0, per_cu = 0;
        if (hipGetDevice(&dev) != hipSuccess || hipDeviceGetAttribute(&cus, hipDeviceAttributeMultiprocessorCount, dev) != hipSuccess) { grid = -1; return; }
        if (hipFuncSetAttribute((const void*)mk_fwd, hipFuncAttributeMaxDynamicSharedMemorySize, LDS_BYTES) != hipSuccess) { fprintf(stderr, "kernel_launch: hipFuncSetAttribute failed\n"); grid = -1; return; }
        if (hipOccupancyMaxActiveBlocksPerMultiprocessor(&per_cu, (const void*)mk_fwd, NWAVES * 64, LDS_BYTES) != hipSuccess || per_cu < 1) fprintf(stderr, "kernel_launch: occupancy query says %d\n", per_cu);
        (void)hipGetLastError();
        grid = cus;
    }
    if (grid < 0) return;
    if (hipMemsetAsync((char*)d_ws + WS_CTL, 0, CTL_ZERO_BYTES, stream) != hipSuccess) return;
    Args a{};
    for (int i = 0; i < N_IN; ++i) a.in[i] = (const float*)d_in[i];
    a.out = (float*)d_out; a.ws = (unsigned char*)d_ws;
#ifdef PROBE_P2
    { a.ph_lo = 0; a.ph_hi = 3; a.li = 0; hipLaunchKernelGGL(mk_fwd, dim3(grid), dim3(NWAVES * 64), LDS_BYTES, stream, a);
      a.ph_lo = 2; a.ph_hi = 3; a.li = 1; a.pad = PROBE_P2; hipLaunchKernelGGL(mk_fwd, dim3(grid), dim3(NWAVES * 64), LDS_BYTES, stream, a); a.pad = 0;
      a.ph_lo = 3; a.ph_hi = NPHASE; a.li = 2; hipLaunchKernelGGL(mk_fwd, dim3(grid), dim3(NWAVES * 64), LDS_BYTES, stream, a); return; }
#endif
    constexpr int N_LAUNCH = (MK_N_LAUNCHES == 1) ? 1 : NPHASE;
    for (int li = 0; li < N_LAUNCH; ++li) {
        a.ph_lo = (N_LAUNCH == 1) ? 0 : li; a.ph_hi = (N_LAUNCH == 1) ? NPHASE : li + 1; a.li = (N_LAUNCH == 1) ? 0 : li;
        hipLaunchKernelGGL(mk_fwd, dim3(grid), dim3(NWAVES * 64), LDS_BYTES, stream, a);
        if (hipPeekAtLastError() != hipSuccess) { fprintf(stderr, "kernel_launch: launch %d failed\n", li); break; }
    }
#ifdef PROBE_PHASES
    { const int pp[] = {PROBE_PHASES}; for (int ph : pp) { a.ph_lo = ph; a.ph_hi = ph + 1; a.li = 15; hipLaunchKernelGGL(mk_fwd, dim3(grid), dim3(NWAVES * 64), LDS_BYTES, stream, a); } }
#endif
}
```

```cpp
#include <hip/hip_runtime.h>
#include <cstdio>
#include <cstdint>

#ifndef MK_N_LAUNCHES
#define MK_N_LAUNCHES 1
#endif

#define GAS __attribute__((address_space(1)))
#define LAS __attribute__((address_space(3)))
typedef unsigned short bf16;
typedef short bf16x8 __attribute__((ext_vector_type(8)));
typedef float f32x4 __attribute__((ext_vector_type(4)));
typedef float f32x2 __attribute__((ext_vector_type(2)));
typedef unsigned u32x4 __attribute__((ext_vector_type(4)));
typedef unsigned u32x2 __attribute__((ext_vector_type(2)));
typedef GAS unsigned gu32;
#define RLX_AGENT __ATOMIC_RELAXED, __HIP_MEMORY_SCOPE_AGENT
#define LDS_WAIT() asm volatile("s_waitcnt lgkmcnt(0)" ::: "memory")
#define VM_WAIT() asm volatile("s_waitcnt vmcnt(0)" ::: "memory")

constexpr int NB = 8, T_ = 4096, D = 1024, M = NB * T_, NMEM = 256, MM = NB * NMEM;
constexpr int CONV_CH = 512, SBH = 8, SBD = 64, SBW = 512, CWID = 31, NE = 32, TOPK = 4, DFF = 1024;
constexpr int INC = 2560;
constexpr float LN_EPS = 1e-5f;
constexpr float DN_ALPHA = 1.189207115002721f;
constexpr float LOG2E = 1.4426950408889634f;
constexpr float SB_QSCALE = 0.125f * LOG2E;
constexpr float MEM_QSCALE = 0.0625f * LOG2E;
constexpr float WGU_SC = 32.0f, WDN_SC = 64.0f, WQ_SC = 32.0f, WO_SC = 64.0f, OB_SC = 16.0f, YS_SC = 16.0f, CA_SC = 64.0f, WOUT_SC = 64.0f, MIX_SC = 16.0f;
constexpr float WGU_SC_UNUSED = 0.f;
constexpr int NBLK_MAX = M * TOPK / 256 + NE;
constexpr int LCAP = M;

constexpr size_t MiB = 1u << 20;
constexpr size_t WS_CTL = 0, CTL_ZERO_BYTES = 1 * MiB;
constexpr size_t WS_WIN_T = 1 * MiB;
constexpr size_t WS_WOUT_T = 6 * MiB;
constexpr size_t WS_WQ_T = 8 * MiB, WS_WK_T = 10 * MiB, WS_WV_T = 12 * MiB, WS_WO_T = 14 * MiB;
constexpr size_t WS_WGU_T = 16 * MiB;
constexpr size_t WS_WDN_T = 144 * MiB;
constexpr size_t WS_HB8 = 176 * MiB;
constexpr size_t WS_HB = 208 * MiB;
constexpr size_t WS_LTOK = 272 * MiB;
constexpr size_t WS_LGATE = 276 * MiB;
constexpr size_t WS_SIDX = 280 * MiB;
constexpr size_t WS_WR = 281 * MiB;
constexpr size_t WS_HB2 = 832 * MiB;
constexpr size_t WS_X = 288 * MiB;
constexpr size_t WS_U = WS_X;
constexpr size_t WS_Q = WS_X + 32 * MiB;
constexpr size_t WS_K = WS_X + 64 * MiB;
constexpr size_t WS_V = WS_X + 96 * MiB;
constexpr size_t WS_MIXIN = WS_X + 128 * MiB;
constexpr size_t WS_QM = WS_X + 192 * MiB;
constexpr size_t WS_SP = WS_X + 256 * MiB;
constexpr size_t WS_OB = WS_X + 320 * MiB;
constexpr size_t WS_MEMN = WS_X + 384 * MiB;
constexpr size_t WS_KM = WS_X + 388 * MiB;
constexpr size_t WS_VMT = WS_X + 392 * MiB;
constexpr size_t WS_VM = WS_VMT;
constexpr size_t WS_WQB = WS_X + 396 * MiB;
constexpr size_t WS_WOTB = WS_X + 398 * MiB;
constexpr size_t WS_G8 = WS_SP;
constexpr size_t WS_H8 = WS_SP + 8 * MiB;
constexpr size_t WS_P8 = WS_OB;
constexpr float G_SC = 64.0f, H_SC = 32.0f, P_SC = 256.0f;
constexpr size_t WS_ACT = WS_X;
constexpr size_t WS_YS = WS_X + 272 * MiB;
constexpr size_t WS_END = 896 * MiB;
constexpr int CW_TMO = 0, CW_CODE = 1;
constexpr int CW_BAR = 4096;
constexpr int CW_ECNT = 131072;
constexpr int NPHASE = 12;

constexpr int RING_OFF = 0, RING_BYTES = 131072;
constexpr int LDS_BYTES = 163840;
constexpr int LDSCTL_OFF = LDS_BYTES - 1024, MISC_OFF = LDSCTL_OFF + 320;
constexpr int XTRA_OFF = RING_BYTES;
constexpr int TB_OFF = XTRA_OFF + 20480;
constexpr int WR_STRIDE = 1032;
constexpr int WR_ST_OFF = 2 * 32 * WR_STRIDE * 2;
constexpr int P10_WR = 0, P10_GB = 2 * 32 * WR_STRIDE * 2, P10_LCNT = P10_GB + 8192, P10_REC = P10_LCNT + 512;
static_assert(P10_REC + 8192 <= TB_OFF && TB_OFF + 4 * (704 + 8 * 40) <= LDSCTL_OFF, "LDS map");
constexpr int NWAVES = 8;
#ifndef MK_NATT
#define MK_NATT 6
#endif
constexpr int NATT = MK_NATT;

__device__ __forceinline__ unsigned f2bf(float f) { unsigned u = __builtin_bit_cast(unsigned, f); return (u + 0x7fffu + ((u >> 16) & 1u)) >> 16; }
__device__ __forceinline__ unsigned pk2(float lo, float hi) { unsigned r; asm("v_cvt_pk_bf16_f32 %0, %1, %2" : "=v"(r) : "v"(lo), "v"(hi)); return r; }
__device__ __forceinline__ float bflo(unsigned u) { return __builtin_bit_cast(float, u << 16); }
__device__ __forceinline__ float bfhi(unsigned u) { return __builtin_bit_cast(float, u & 0xffff0000u); }
#define DPP_F(v, ctrl) __builtin_bit_cast(float, __builtin_amdgcn_update_dpp(0, __builtin_bit_cast(int, (v)), (ctrl), 0xf, 0xf, true))
#define RDL_F(v, l) __builtin_bit_cast(float, __builtin_amdgcn_readlane(__builtin_bit_cast(int, (v)), (l)))
__device__ __forceinline__ float wave_sum(float v) {
    v += DPP_F(v, 0xB1); v += DPP_F(v, 0x4E); v += DPP_F(v, 0x141); v += DPP_F(v, 0x140);
    return (RDL_F(v, 0) + RDL_F(v, 16)) + (RDL_F(v, 32) + RDL_F(v, 48));
}
__device__ __forceinline__ float wave_max(float v) {
    v = fmaxf(v, DPP_F(v, 0xB1)); v = fmaxf(v, DPP_F(v, 0x4E)); v = fmaxf(v, DPP_F(v, 0x141)); v = fmaxf(v, DPP_F(v, 0x140));
    return fmaxf(fmaxf(RDL_F(v, 0), RDL_F(v, 16)), fmaxf(RDL_F(v, 32), RDL_F(v, 48)));
}
__device__ __forceinline__ unsigned pk4_fp8(float a, float b, float c, float d) {
    int r = __builtin_amdgcn_cvt_pk_fp8_f32(a, b, 0, false); r = __builtin_amdgcn_cvt_pk_fp8_f32(c, d, r, true); return (unsigned)r; }
__device__ __forceinline__ float sigmoidf_fast(float x) { return __builtin_amdgcn_rcpf(1.0f + __expf(-x)); }

namespace pg8 {
constexpr int BM = 256, BK = 64, HALF = 128, HTB = HALF * BK * 2, STAGE_BYTES = 8 * HTB, NXCD = 8, WGM = 8;
__host__ __device__ __forceinline__ int lds_byte(int r, int c) { const int st = (r >> 4) * 2 + (c >> 5), rr = r & 15, cc = c & 31, ob = rr * 64 + cc * 2; return st * 1024 + (ob ^ (((ob >> 9) & 1) << 5)); }
__host__ __device__ __forceinline__ void stage_rc(int b, int& R, int& C) { const int st = b / 1024, sb = b % 1024, swz = sb ^ (((sb >> 9) & 1) << 5); R = (st >> 1) * 16 + swz / 64; C = (st & 1) * 32 + (swz % 64) / 2; }
__host__ __device__ __forceinline__ int perm32(int rho) { const int n = rho >> 4, i = rho & 15; return 8 * (i >> 2) + 4 * n + (i & 3); }

struct Unit { int pm, pn, z, nvalid; unsigned aoff, boff, goff; };

__device__ __forceinline__ void tile_order(int L, int nM, int nN, int& pm, int& pn) {
    const int nwg = nM * nN; int wgid = L;
    { const int q = nwg / NXCD, r = nwg % NXCD, xcd = wgid % NXCD, off = wgid / NXCD; wgid = (xcd < r ? xcd * (q + 1) : r * (q + 1) + (xcd - r) * q) + off; }
    const int nig = WGM * nN, gid = wgid / nig, fm = gid * WGM, gsz = (nM - fm) < WGM ? (nM - fm) : WGM;
    pm = fm + ((wgid % nig) % gsz); pn = (wgid % nig) / gsz;
}
__device__ __forceinline__ unsigned cvt_pk_bf16(float lo, float hi) { unsigned r; asm volatile("v_cvt_pk_bf16_f32 %0, %1, %2" : "=v"(r) : "v"(lo), "v"(hi)); return r; }

__device__ __forceinline__ void store_tile_bf16(const f32x4 (&acc)[2][2][4][2], bf16* p0, size_t ldc, const float* bias, float scale, int wc, int fq) {
    const int cl = wc * 32 + 8 * fq;
    f32x4 bv[2][2];
#pragma unroll
    for (int bj = 0; bj < 2; ++bj)
#pragma unroll
        for (int n = 0; n < 2; ++n) bv[bj][n] = bias ? *(const f32x4*)(bias + cl + bj * HALF + 4 * n) : (f32x4){0.f, 0.f, 0.f, 0.f};
#pragma unroll
    for (int ai = 0; ai < 2; ++ai)
#pragma unroll
        for (int m = 0; m < 4; ++m) { bf16* rowp = p0 + (size_t)(ai * HALF + m * 16) * ldc + cl;
#pragma unroll
            for (int bj = 0; bj < 2; ++bj) { const f32x4 v0 = (acc[ai][bj][m][0] + bv[bj][0]) * scale, v1 = (acc[ai][bj][m][1] + bv[bj][1]) * scale;
                u32x4 w; w.x = cvt_pk_bf16(v0[0], v0[1]); w.y = cvt_pk_bf16(v0[2], v0[3]); w.z = cvt_pk_bf16(v1[0], v1[1]); w.w = cvt_pk_bf16(v1[2], v1[3]);
                *(u32x4*)(rowp + bj * HALF) = w; } }
}

__device__ __forceinline__ void store_tile_bf16_w(const f32x4 (&acc)[2][2][4][2], bf16* p0, size_t ldc, const float* bias, float scale, int wc, int fq) {
    const int cl = wc * 64 + 8 * fq;
    f32x4 bv[2][2];
#pragma unroll
    for (int bj = 0; bj < 2; ++bj)
#pragma unroll
        for (int n = 0; n < 2; ++n) bv[bj][n] = bias ? *(const f32x4*)(bias + cl + 32 * bj + 4 * n) : (f32x4){0.f, 0.f, 0.f, 0.f};
#pragma unroll
    for (int ai = 0; ai < 2; ++ai)
#pragma unroll
        for (int m = 0; m < 4; ++m) { bf16* rowp = p0 + (size_t)(ai * HALF + m * 16) * ldc + cl;
#pragma unroll
            for (int bj = 0; bj < 2; ++bj) { const f32x4 v0 = (acc[ai][bj][m][0] + bv[bj][0]) * scale, v1 = (acc[ai][bj][m][1] + bv[bj][1]) * scale;
                u32x4 w; w.x = cvt_pk_bf16(v0[0], v0[1]); w.y = cvt_pk_bf16(v0[2], v0[3]); w.z = cvt_pk_bf16(v1[0], v1[1]); w.w = cvt_pk_bf16(v1[2], v1[3]);
                *(u32x4*)(rowp + 32 * bj) = w; } }
}

typedef int v8i __attribute__((ext_vector_type(8)));
template <class T, class = void> struct HasPerm2 { static constexpr bool value = false; };
template <class T> struct HasPerm2<T, decltype((void)T::PERM2)> { static constexpr bool value = true; };
__host__ __device__ __forceinline__ int perm2_col(int bj, int r) { return 64 * (r >> 5) + 16 * ((r >> 2) & 3) + 8 * bj + 4 * ((r >> 4) & 1) + (r & 3); }
__host__ __device__ __forceinline__ int perm2b_col(int bj, int r) { return 64 * (r >> 5) + 32 * bj + 8 * ((r >> 2) & 3) + 4 * ((r >> 4) & 1) + (r & 3); }
template <class T, class = void> struct ATiled { static constexpr bool value = false; };
template <class T> struct ATiled<T, decltype((void)T::ATILED)> { static constexpr bool value = true; };
template <class T, class = void> struct Perm2Kind { static constexpr int value = 0; };
template <class T> struct Perm2Kind<T, decltype((void)T::PERM2)> { static constexpr int value = (int)T::PERM2; };
#ifndef PG8_ALIGN
#define PG8_ALIGN true
#endif
template <class Epi, class Sched, bool GATHER, bool FP8 = false, bool ALIGN_EPI = PG8_ALIGN>
__device__ __forceinline__ void gemm_phase(LAS unsigned char* lds, const char* wsb, const int lda, const int ldb, const int K, const Sched& S, const Epi& E, const int* glist) {
    int tid = threadIdx.x; asm volatile("" : "+v"(tid));
    const int wid = __builtin_amdgcn_readfirstlane(tid >> 6), lane = tid & 63, wr = wid >> 2, wc = wid & 3, fr = lane & 15, fq = lane >> 4;
    const int nt = K / BK;
    unsigned voffA[2], voffB[2], voffB2[2][2];
#pragma unroll
    for (int i = 0; i < 2; ++i) { int R, C; stage_rc(tid * 16 + i * 8192, R, C); const int Rb = Epi::PERM ? ((R & ~31) + perm32(R & 31)) : R;
        voffA[i] = ATiled<Epi>::value ? (unsigned)((R >> 4) * 16 * lda * 2 + ((2 * C) >> 5) * 512 + (R & 15) * 32 + ((2 * C) & 31)) : (unsigned)(R * lda + C) * 2u; voffB[i] = (unsigned)(Rb * ldb + C) * 2u;
        voffB2[0][i] = (unsigned)((Perm2Kind<Epi>::value == 2 ? perm2b_col(0, R) : perm2_col(0, R)) * ldb + C) * 2u; voffB2[1][i] = (unsigned)((Perm2Kind<Epi>::value == 2 ? perm2b_col(1, R) : perm2_col(1, R)) * ldb + C) * 2u; }
    const size_t kstep = (size_t)(BK * 2);
    const size_t kstepA = ATiled<Epi>::value ? (size_t)(BK * 2 * 16) : kstep;
    const size_t hstepA = (size_t)HALF * lda * 2, hstepB = (size_t)HALF * ldb * 2;
    const unsigned ldsw = (unsigned)wid * 1024u;
    const int aoff = lds_byte(wr * 64 + fr, fq * 8), boff = lds_byte(wc * 32 + fr, fq * 8);
    unsigned gc[2][2], gn[2][2];
#define PG8_SA(b, h) (((b) * 2 + (h)) * HTB)
#define PG8_SB(b, h) ((4 + (b) * 2 + (h)) * HTB)
#define PG8_STAGE_B(bufoff, gbase, bj) do { _Pragma("unroll") for (int _i = 0; _i < 2; ++_i) { \
        const char* _q = HasPerm2<Epi>::value ? (const char*)(gbase) + voffB2[bj][_i] : (const char*)(gbase) + (bj) * hstepB + voffB[_i]; \
        __builtin_amdgcn_global_load_lds((const unsigned*)_q, (LAS unsigned*)(lds + (bufoff) + ldsw + _i * 8192), 16, 0, 0); } } while (0)
#define PG8_STAGE_A(bufoff, gbase, h, nx) do { _Pragma("unroll") for (int _i = 0; _i < 2; ++_i) { \
        const char* _p = GATHER ? (const char*)(gbase) + ((nx) ? gn[h][_i] : gc[h][_i]) : (const char*)(gbase) + (h) * hstepA + voffA[_i]; \
        __builtin_amdgcn_global_load_lds((const unsigned*)_p, (LAS unsigned*)(lds + (bufoff) + ldsw + _i * 8192), 16, 0, 0); } } while (0)
#define PG8_LDA(dst, b, h) do { _Pragma("unroll") for (int m = 0; m < 4; ++m) { if constexpr (FP8) { const u32x4 _lo = *(const LAS u32x4*)(lds + PG8_SA(b, h) + aoff + m * 2048), _hi = *(const LAS u32x4*)(lds + PG8_SA(b, h) + aoff + m * 2048 + 1024); \
            dst##8[m] = (v8i){(int)_lo.x, (int)_lo.y, (int)_lo.z, (int)_lo.w, (int)_hi.x, (int)_hi.y, (int)_hi.z, (int)_hi.w}; } \
        else { _Pragma("unroll") for (int k = 0; k < 2; ++k) dst[m][k] = *(const LAS bf16x8*)(lds + PG8_SA(b, h) + aoff + m * 2048 + k * 1024); } } } while (0)
#define PG8_LDB(dst, b, h) do { _Pragma("unroll") for (int n = 0; n < 2; ++n) { if constexpr (FP8) { const u32x4 _lo = *(const LAS u32x4*)(lds + PG8_SB(b, h) + boff + n * 2048), _hi = *(const LAS u32x4*)(lds + PG8_SB(b, h) + boff + n * 2048 + 1024); \
            dst##8[n] = (v8i){(int)_lo.x, (int)_lo.y, (int)_lo.z, (int)_lo.w, (int)_hi.x, (int)_hi.y, (int)_hi.z, (int)_hi.w}; } \
        else { _Pragma("unroll") for (int k = 0; k < 2; ++k) dst[n][k] = *(const LAS bf16x8*)(lds + PG8_SB(b, h) + boff + n * 2048 + k * 1024); } } } while (0)
#define PG8_MMA(ai, bj, At, Bt) do { __builtin_amdgcn_s_setprio(1); if constexpr (FP8) asm volatile("s_nop 1"); _Pragma("unroll") for (int m = 0; m < 4; ++m) _Pragma("unroll") for (int n = 0; n < 2; ++n) { \
        if constexpr (FP8) asm volatile("v_mfma_f32_16x16x128_f8f6f4 %0, %1, %2, %0" : "+v"(acc[ai][bj][m][n]) : "v"(Bt##8[n]), "v"(At##8[m])); \
        else { _Pragma("unroll") for (int k = 0; k < 2; ++k) acc[ai][bj][m][n] = __builtin_amdgcn_mfma_f32_16x16x32_bf16(Bt[n][k], At[m][k], acc[ai][bj][m][n], 0, 0, 0); } } \
        __builtin_amdgcn_s_setprio(0); } while (0)
#define PG8_WAIT_V(n) asm volatile("s_waitcnt vmcnt(" #n ")" ::: "memory")
#define PG8_WAIT_L(n) asm volatile("s_waitcnt lgkmcnt(" #n ")" ::: "memory")
#define PG8_BAR __builtin_amdgcn_s_barrier()
#define PG8_SCHED __builtin_amdgcn_sched_barrier(0)
#define PG8_GIDX(g, u) do { _Pragma("unroll") for (int _h = 0; _h < 2; ++_h) _Pragma("unroll") for (int _i = 0; _i < 2; ++_i) { int _R, _C; stage_rc(tid * 16 + _i * 8192, _R, _C); const int _r = _h * HALF + _R; \
        const int _tok = glist[(u).goff + (_r < (u).nvalid ? _r : (u).nvalid - 1)]; g[_h][_i] = (unsigned)_tok * (unsigned)(lda * 2) + (unsigned)(_C * 2); } } while (0)
    Unit cur, nxt, nn; int ui = 0;
    if (!S.next(0, cur)) return;
    f32x4 acc[2][2][4][2];
#pragma unroll
    for (int a = 0; a < 2; ++a)
#pragma unroll
        for (int b = 0; b < 2; ++b)
#pragma unroll
            for (int m = 0; m < 4; ++m)
#pragma unroll
                for (int n = 0; n < 2; ++n) acc[a][b][m][n] = (f32x4){0.f, 0.f, 0.f, 0.f};
    bf16x8 At[4][2], B0[2][2], B1[2][2];
    v8i At8[4], B08[2], B18[2];
    const char* cA = wsb + cur.aoff; const char* cB = wsb + cur.boff;
    if constexpr (GATHER) { PG8_GIDX(gc, cur); if (S.next(1, nxt)) { PG8_GIDX(gn, nxt); } else { PG8_GIDX(gn, cur); }
        asm volatile("s_waitcnt vmcnt(0)" : "+v"(gc[0][0]), "+v"(gc[0][1]), "+v"(gc[1][0]), "+v"(gc[1][1]), "+v"(gn[0][0]), "+v"(gn[0][1]), "+v"(gn[1][0]), "+v"(gn[1][1]) :: "memory"); }
    else {
#pragma unroll
        for (int h = 0; h < 2; ++h)
#pragma unroll
            for (int i = 0; i < 2; ++i) { gc[h][i] = 0u; gn[h][i] = 0u; } }
    PG8_STAGE_B(PG8_SB(0, 0), cB, 0); PG8_STAGE_B(PG8_SB(0, 1), cB, 1); PG8_STAGE_A(PG8_SA(0, 0), cA, 0, false); PG8_STAGE_A(PG8_SA(0, 1), cA, 1, false);
    if (wr == 1) PG8_BAR;
    PG8_WAIT_V(2); PG8_BAR;
    PG8_STAGE_B(PG8_SB(1, 0), cB + kstep, 0); PG8_STAGE_A(PG8_SA(1, 0), cA + kstepA, 0, false); PG8_STAGE_B(PG8_SB(1, 1), cB + kstep, 1);
    PG8_WAIT_V(6); PG8_BAR;
    for (;;) {
        const bool has_next = S.next(ui + 1, nxt);
        const char* nA = has_next ? wsb + nxt.aoff : cA; const char* nB = has_next ? wsb + nxt.boff : cB;
#pragma clang loop unroll(disable)
        for (int t = 0; t < nt; t += 2) {
            const bool last = (t == nt - 2);
            const char* a1 = cA + (size_t)(t + 1) * kstepA;
            const char* a2 = last ? nA : cA + (size_t)(t + 2) * kstepA; const char* b2 = last ? nB : cB + (size_t)(t + 2) * kstep;
            const char* a3 = a2 + kstepA; const char* b3 = b2 + kstep;
            PG8_LDB(B0, 0, 0); PG8_LDB(B1, 0, 1); PG8_SCHED; PG8_LDA(At, 0, 0); PG8_STAGE_A(PG8_SA(1, 1), a1, 1, false);
            PG8_WAIT_V(8); PG8_WAIT_L(0); PG8_BAR; PG8_MMA(0, 0, At, B0); PG8_MMA(0, 1, At, B1); PG8_BAR; PG8_SCHED;
            PG8_LDA(At, 0, 1); PG8_STAGE_B(PG8_SB(0, 0), b2, 0); PG8_STAGE_B(PG8_SB(0, 1), b2, 1); PG8_STAGE_A(PG8_SA(0, 0), a2, 0, last);
            PG8_WAIT_V(8); PG8_WAIT_L(0); PG8_BAR; PG8_MMA(1, 0, At, B0); PG8_MMA(1, 1, At, B1); PG8_BAR; PG8_SCHED;
            PG8_LDB(B0, 1, 0); PG8_LDB(B1, 1, 1); PG8_SCHED; PG8_LDA(At, 1, 0); PG8_STAGE_A(PG8_SA(0, 1), a2, 1, last);
            PG8_WAIT_V(8); PG8_WAIT_L(0); PG8_BAR; PG8_MMA(0, 0, At, B0); PG8_MMA(0, 1, At, B1); PG8_BAR; PG8_SCHED;
            PG8_LDA(At, 1, 1); PG8_STAGE_B(PG8_SB(1, 0), b3, 0); PG8_STAGE_B(PG8_SB(1, 1), b3, 1); PG8_STAGE_A(PG8_SA(1, 0), a3, 0, last);
            PG8_WAIT_V(8); PG8_WAIT_L(0); PG8_BAR; PG8_MMA(1, 0, At, B0); PG8_MMA(1, 1, At, B1); PG8_BAR; PG8_SCHED;
        }
        if constexpr (FP8) asm volatile("s_nop 15\n\ts_nop 7");
        if constexpr (ALIGN_EPI) { if (wr == 0) PG8_BAR; }
        if constexpr (GATHER) {
#pragma unroll
            for (int h = 0; h < 2; ++h)
#pragma unroll
                for (int i = 0; i < 2; ++i) gc[h][i] = gn[h][i];
            if (has_next && S.next(ui + 2, nn)) { PG8_GIDX(gn, nn); }
        }
        E(acc, cur, wr, wc, fr, fq);
        if constexpr (GATHER) asm volatile("" : "+v"(gn[0][0]), "+v"(gn[0][1]), "+v"(gn[1][0]), "+v"(gn[1][1]));
        if (!has_next) break;
#pragma unroll
        for (int a = 0; a < 2; ++a)
#pragma unroll
            for (int b = 0; b < 2; ++b)
#pragma unroll
                for (int m = 0; m < 4; ++m)
#pragma unroll
                    for (int n = 0; n < 2; ++n) acc[a][b][m][n] = (f32x4){0.f, 0.f, 0.f, 0.f};
        cur = nxt; cA = nA; cB = nB; ++ui;
        if constexpr (ALIGN_EPI) { if (wr == 1) PG8_BAR; }
    }
    PG8_WAIT_V(0);
    if constexpr (!ALIGN_EPI) { if (wr == 0) PG8_BAR; }
    PG8_BAR;
#undef PG8_SA
#undef PG8_SB
#undef PG8_STAGE_A
#undef PG8_STAGE_B
#undef PG8_LDA
#undef PG8_LDB
#undef PG8_MMA
#undef PG8_WAIT_V
#undef PG8_WAIT_L
#undef PG8_BAR
#undef PG8_SCHED
#undef PG8_GIDX
}
}
using pg8::Unit;

#define XB_TMO      128
#define XB_XCNT(j)  (256  + 64 * (j))
#define XB_XSUB(j)  (1280 + 64 * (j))
#define XB_XGEN(j)  (2304 + 64 * (j))
#define XB_TOP      3328
#define XB_TOPGEN   3392
#define XCD_BAR_WORDS 3456
#define XB_SPIN_CAP (1u << 18)
__device__ __forceinline__ unsigned xb_ld(unsigned* p)              { return __hip_atomic_load(p, __ATOMIC_RELAXED, __HIP_MEMORY_SCOPE_AGENT); }
__device__ __forceinline__ unsigned xb_add(unsigned* p, unsigned v) { return __hip_atomic_fetch_add(p, v, __ATOMIC_RELAXED, __HIP_MEMORY_SCOPE_AGENT); }
__device__ __forceinline__ unsigned xb_xcc_id() { return (unsigned)__builtin_amdgcn_s_getreg((3 << 11) | 20) & 0xFu; }
#define XB_SPIN(cond, bar) do { unsigned _sp = 0; while (cond) { __builtin_amdgcn_s_sleep(1); \
    if ((++_sp & 255u) == 0u) { if (xb_ld(&(bar)[XB_TMO])) break; if (_sp > XB_SPIN_CAP) { atomicAdd(&(bar)[XB_TMO], 1u); break; } } } } while (0)
struct XcdBarrier { unsigned* bar; unsigned x; volatile LAS unsigned* st; };
__device__ __forceinline__ XcdBarrier xcd_barrier_post(unsigned* bar, volatile LAS unsigned* st) {
    XcdBarrier b; b.bar = bar; b.x = xb_xcc_id(); b.st = st;
    if (threadIdx.x == 0) (void)xb_add(&bar[XB_XCNT(b.x)], 1u);
    return b;
}
__device__ __forceinline__ void xcd_barrier_complete(unsigned* bar, unsigned x, unsigned& nloc, unsigned& nx) {
    const unsigned G = gridDim.x * gridDim.y * gridDim.z;
    unsigned sum, cnt, mine, sp = 0u;
    for (;;) {
        sum = 0u; cnt = 0u; mine = 0u;
#pragma unroll
        for (unsigned j = 0; j < 16; ++j) { const unsigned c = xb_ld(&bar[XB_XCNT(j)]); sum += c; cnt += (c > 0u) ? 1u : 0u; mine = (j == x) ? c : mine; }
        if (sum == G) break;
        __builtin_amdgcn_s_sleep(1);
        if ((++sp & 255u) == 0u) { if (xb_ld(&bar[XB_TMO])) break; if (sp > XB_SPIN_CAP) { atomicAdd(&bar[XB_TMO], 1u); break; } }
    }
    nloc = mine > 0u ? mine : 1u; nx = cnt > 0u ? cnt : 1u;
}
__device__ __forceinline__ void xcd_barrier(const XcdBarrier& b) {
    asm volatile("s_waitcnt vmcnt(0)" ::: "memory");
    __syncthreads();
    if (threadIdx.x == 0) {
        unsigned* bar = b.bar;
        __builtin_amdgcn_s_waitcnt(0);
        unsigned nloc = b.st[0], nx = b.st[1];
        if (nloc == 0u) { xcd_barrier_complete(bar, b.x, nloc, nx); b.st[0] = nloc; b.st[1] = nx; }
        const unsigned old = xb_add(&bar[XB_XSUB(b.x)], 1u);
        const unsigned gen = old / nloc;
        if (old + 1u == (gen + 1u) * nloc) {
            __builtin_amdgcn_fence(__ATOMIC_RELEASE, "agent");
            asm volatile("s_waitcnt vmcnt(0)" ::: "memory");
            const unsigned og = xb_add(&bar[XB_TOP], 1u);
            const unsigned tg = og / nx;
            if (og + 1u == (tg + 1u) * nx) xb_add(&bar[XB_TOPGEN], 1u);
            else XB_SPIN(xb_ld(&bar[XB_TOPGEN]) == tg, bar);
            __builtin_amdgcn_fence(__ATOMIC_ACQUIRE, "agent");
            xb_add(&bar[XB_XGEN(b.x)], 1u);
            asm volatile("s_waitcnt vmcnt(0)" ::: "memory");
        } else {
            XB_SPIN(xb_ld(&bar[XB_XGEN(b.x)]) == gen, bar);
            __builtin_amdgcn_fence(__ATOMIC_ACQUIRE, "agent");
            asm volatile("s_waitcnt vmcnt(0)" ::: "memory");
        }
    }
    __syncthreads();
}

struct Frame {
    LAS unsigned char* lds;
    volatile LAS unsigned* MISC;
    gu32* ctl;
    unsigned char* ws;
    int tid, lane, wave, vcu, G;
    float* hf;
    const float* const* in;
};
enum In { I_X = 0, I_MEM, I_LN_IN_G, I_LN_IN_B, I_LN_MEM_G, I_LN_MEM_B, I_W_IN, I_B_IN, I_W_DW, I_B_DW, I_LN_CONV_G, I_LN_CONV_B, I_W_OUT, I_B_OUT, I_LN1_G, I_LN1_B,
          I_WQ, I_WK, I_WV, I_WO, I_LN2_G, I_LN2_B, I_W_ROUTER, I_B_ROUTER, I_W_GU, I_B_GU, I_W_DOWN, I_B_DOWN, I_LN3_G, I_LN3_B, N_IN };

__device__ __forceinline__ void p0_transpose_item(const float* W, int K, int N, bf16* WT, int k0, int n0, int drow, LAS float* scr, int lane) {
#pragma unroll 8
    for (int i = 0; i < 32; ++i) { const int kk = 2 * i + (lane >> 5); scr[kk * 33 + (lane & 31)] = W[(size_t)(k0 + kk) * N + n0 + (lane & 31)]; }
    LDS_WAIT(); asm volatile("" ::: "memory");
    const int c = lane & 7;
#pragma unroll
    for (int j = 0; j < 4; ++j) { const int n = (lane >> 3) + 8 * j; const LAS float* s = scr + (8 * c) * 33 + n;
        u32x4 o; o.x = pk2(s[0 * 33], s[1 * 33]); o.y = pk2(s[2 * 33], s[3 * 33]); o.z = pk2(s[4 * 33], s[5 * 33]); o.w = pk2(s[6 * 33], s[7 * 33]);
        *(GAS u32x4*)(WT + (size_t)(drow + n) * K + k0 + 8 * c) = o; }
    LDS_WAIT(); asm volatile("" ::: "memory");
}
__device__ __forceinline__ void ln_row(f32x4 (&v)[4], const float* g, const float* b, int lane) {
    float s = 0.f;
#pragma unroll
    for (int j = 0; j < 4; ++j) s += (v[j].x + v[j].y) + (v[j].z + v[j].w);
    const float mean = wave_sum(s) * (1.f / D); float s2 = 0.f;
#pragma unroll
    for (int j = 0; j < 4; ++j) { v[j] = v[j] - mean; s2 += (v[j].x * v[j].x + v[j].y * v[j].y) + (v[j].z * v[j].z + v[j].w * v[j].w); }
    const float rstd = 1.f / sqrtf(wave_sum(s2) * (1.f / D) + LN_EPS);
#pragma unroll
    for (int j = 0; j < 4; ++j) { const f32x4 gg = ((const GAS f32x4*)g)[lane + 64 * j], bb = ((const GAS f32x4*)b)[lane + 64 * j]; v[j] = v[j] * rstd * gg + bb; }
}
__device__ __forceinline__ void ln_row_r(f32x4 (&v)[4], const f32x4 (&gg)[4], const f32x4 (&bb)[4]) {
    float s = 0.f;
#pragma unroll
    for (int j = 0; j < 4; ++j) s += (v[j].x + v[j].y) + (v[j].z + v[j].w);
    const float mean = wave_sum(s) * (1.f / D); float s2 = 0.f;
#pragma unroll
    for (int j = 0; j < 4; ++j) { v[j] = v[j] - mean; s2 += (v[j].x * v[j].x + v[j].y * v[j].y) + (v[j].z * v[j].z + v[j].w * v[j].w); }
    const float rstd = 1.f / sqrtf(wave_sum(s2) * (1.f / D) + LN_EPS);
#pragma unroll
    for (int j = 0; j < 4; ++j) v[j] = v[j] * rstd * gg[j] + bb[j];
}
__device__ __forceinline__ void store_row_bf16(const f32x4 (&v)[4], bf16* orow, int lane) {
    GAS u32x2* o8 = (GAS u32x2*)orow + lane;
#pragma unroll
    for (int j = 0; j < 4; ++j) o8[64 * j] = (u32x2){pk2(v[j].x, v[j].y), pk2(v[j].z, v[j].w)};
}
__device__ __forceinline__ void item8_load(f32x4 (&x)[4][4], const float* W, int N, int k0, int n0, int lane) {
    const int g = lane >> 3, c = lane & 7;
#pragma unroll
    for (int q = 0; q < 4; ++q)
#pragma unroll
        for (int j = 0; j < 4; ++j) x[q][j] = __builtin_nontemporal_load((const GAS f32x4*)(W + (size_t)(k0 + 32 * q + 4 * g + j) * N + n0 + 4 * c));
}
__device__ __forceinline__ void item8_finish(const f32x4 (&x)[4][4], int K, unsigned char* WT, int k0, int drow, float sc, LAS unsigned char* scr, int lane) {
    const int g = lane >> 3, c = lane & 7;
#pragma unroll
    for (int q = 0; q < 4; ++q)
#pragma unroll
        for (int e = 0; e < 4; ++e) *(LAS unsigned*)(scr + (4 * c + e) * 144 + 32 * q + 4 * g) = pk4_fp8(x[q][0][e] * sc, x[q][1][e] * sc, x[q][2][e] * sc, x[q][3][e] * sc);
    LDS_WAIT(); asm volatile("" ::: "memory");
#pragma unroll
    for (int i = 0; i < 4; ++i) { const int t = lane + 64 * i, n = t >> 3, ch = t & 7;
        __builtin_nontemporal_store(*(const LAS u32x4*)(scr + n * 144 + 16 * ch), (GAS u32x4*)(WT + (size_t)(drow + n) * K + k0 + 16 * ch)); }
    LDS_WAIT(); asm volatile("" ::: "memory");
}
__device__ __forceinline__ void item16_finish(const f32x4 (&x)[4][4], int K, bf16* WT, int k0, int drow, LAS unsigned char* scr, int lane) {
    const int g = lane >> 3, c = lane & 7;
#pragma unroll
    for (int q = 0; q < 4; ++q)
#pragma unroll
        for (int e = 0; e < 4; ++e) *(LAS u32x2*)(scr + (4 * c + e) * 272 + (32 * q + 4 * g) * 2) = (u32x2){pk2(x[q][0][e], x[q][1][e]), pk2(x[q][2][e], x[q][3][e])};
    LDS_WAIT(); asm volatile("" ::: "memory");
#pragma unroll
    for (int i = 0; i < 8; ++i) { const int t = lane + 64 * i, n = t >> 4, ch = t & 15;
        *(GAS u32x4*)(WT + (size_t)(drow + n) * K + k0 + 8 * ch) = *(const LAS u32x4*)(scr + n * 272 + 16 * ch); }
    LDS_WAIT(); asm volatile("" ::: "memory");
}
__device__ __forceinline__ void p0_transpose_item16(const float* W, int K, int N, bf16* WT, int k0, int n0, int drow, LAS unsigned char* scr, int lane) {
    f32x4 x[4][4]; item8_load(x, W, N, k0, n0, lane); item16_finish(x, K, WT, k0, drow, scr, lane);
}
__device__ __forceinline__ void p0_transpose_item8b(const float* W, int K, int N, unsigned char* WT, int k0, int n0, int drow, float sc, LAS unsigned char* scr, int lane) {
    f32x4 x[4][4]; item8_load(x, W, N, k0, n0, lane); item8_finish(x, K, WT, k0, drow, sc, scr, lane);
}
__device__ __forceinline__ void load_row_bf16(f32x4 (&v)[4], const bf16* xrow, int lane) {
    const GAS u32x2* xr = (const GAS u32x2*)xrow + lane;
#pragma unroll
    for (int j = 0; j < 4; ++j) { const u32x2 w = xr[64 * j]; v[j] = (f32x4){bflo(w.x), bfhi(w.x), bflo(w.y), bfhi(w.y)}; }
}
__device__ __forceinline__ void load_row_bf16_nt(f32x4 (&v)[4], const bf16* xrow, int lane) {
    const GAS u32x2* xr = (const GAS u32x2*)xrow + lane;
#pragma unroll
    for (int j = 0; j < 4; ++j) { const u32x2 w = __builtin_nontemporal_load(xr + 64 * j); v[j] = (f32x4){bflo(w.x), bfhi(w.x), bflo(w.y), bfhi(w.y)}; }
}
__device__ __forceinline__ void load_row_f32_nt(f32x4 (&v)[4], const float* xrow, int lane) {
    const GAS f32x4* xr = (const GAS f32x4*)xrow + lane;
#pragma unroll
    for (int j = 0; j < 4; ++j) v[j] = __builtin_nontemporal_load(xr + 64 * j);
}
__device__ __forceinline__ void store_row_f32_nt(const f32x4 (&v)[4], float* orow, int lane) {
    GAS f32x4* o = (GAS f32x4*)orow + lane;
#pragma unroll
    for (int j = 0; j < 4; ++j) __builtin_nontemporal_store(v[j], o + 64 * j);
}
__device__ __forceinline__ void load_row_f32(f32x4 (&v)[4], const float* xrow, int lane) {
    const GAS f32x4* xr = (const GAS f32x4*)xrow + lane;
#pragma unroll
    for (int j = 0; j < 4; ++j) v[j] = xr[64 * j];
}
__device__ __forceinline__ void store_row_f32(const f32x4 (&v)[4], float* orow, int lane) {
    GAS f32x4* o = (GAS f32x4*)orow + lane;
#pragma unroll
    for (int j = 0; j < 4; ++j) o[64 * j] = v[j];
}

constexpr int I_GU = NE * 8 * 64, I_DN = NE * 8 * 32, N_EXPERT_ITEMS = I_GU + I_DN;
struct ExpItem { const float* W; unsigned char* WT; int K, N, k0, n0, drow; float sc; };
__device__ __forceinline__ ExpItem expert_item_decode(Frame& F, int it) {
    ExpItem x;
    if (it < I_GU) { const int e = it / (8 * 64), q = it % (8 * 64), kb = q / 64, nb = q % 64, n0 = 32 * nb;
        x.W = F.in[I_W_GU] + (size_t)e * D * 2 * DFF; x.WT = F.ws + WS_WGU_T + (size_t)e * 2 * DFF * D; x.K = D; x.N = 2 * DFF; x.k0 = 128 * kb; x.n0 = n0;
        x.drow = (n0 < 1024) ? (n0 >> 7) * 256 + (n0 & 127) : ((n0 - 1024) >> 7) * 256 + 128 + (n0 & 127); x.sc = WGU_SC; }
    else { const int r = it - I_GU, e = r / (8 * 32), q = r % (8 * 32), kb = q / 32, nb = q % 32;
        x.W = F.in[I_W_DOWN] + (size_t)e * DFF * D; x.WT = F.ws + WS_WDN_T + (size_t)e * D * DFF; x.K = DFF; x.N = D; x.k0 = 128 * kb; x.n0 = 32 * nb; x.drow = 32 * nb; x.sc = WDN_SC; }
    return x;
}
__device__ __forceinline__ void expert_stream(Frame& F, int sw, int nsw, int iend, LAS unsigned char* scr) {
    for (int it = sw; it < iend; it += 3 * nsw) {
        const int it2 = it + nsw, it3 = it + 2 * nsw; const bool two = it2 < iend, three = it3 < iend;
        const ExpItem a = expert_item_decode(F, it), b = expert_item_decode(F, two ? it2 : it), c = expert_item_decode(F, three ? it3 : it);
        f32x4 xa[4][4], xb[4][4], xc[4][4];
        item8_load(xa, a.W, a.N, a.k0, a.n0, F.lane);
        if (two) item8_load(xb, b.W, b.N, b.k0, b.n0, F.lane);
        if (three) item8_load(xc, c.W, c.N, c.k0, c.n0, F.lane);
        item8_finish(xa, a.K, a.WT, a.k0, a.drow, a.sc, scr, F.lane);
        if (two) item8_finish(xb, b.K, b.WT, b.k0, b.drow, b.sc, scr + 5120, F.lane);
        if (three) item8_finish(xc, c.K, c.WT, c.k0, c.drow, c.sc, scr + 10240, F.lane);
    }
}
__device__ __forceinline__ void p0_prologue(Frame& F) {
    LAS float* scr = (LAS float*)(F.lds + RING_OFF + F.wave * 16384);
    const int gw = F.vcu * NWAVES + F.wave, NGW = F.G * NWAVES;
    constexpr int I_IN = 8 * 80, I_SQ = 8 * 32;
    constexpr int NITEMS = I_IN + 3 * I_SQ + 256;
    constexpr int P0_IW = 2, P0_RI = 8;
    const int NIW = F.G * P0_IW, NOW = F.G * (NWAVES - P0_IW);
    const bool itemw = F.wave < P0_IW;
    if (itemw) for (int it = F.vcu * P0_IW + F.wave; it < NITEMS; it += NIW) {
        int r = it;
        if (r < I_IN) { const int kb = r / 80, nb = r % 80, n0 = 32 * nb; int drow;
            if (n0 < 512) drow = (n0 >> 7) * 256 + 2 * (n0 & 127); else if (n0 < 1024) drow = ((n0 - 512) >> 7) * 256 + 2 * (n0 & 127) + 32; else drow = n0;
            p0_transpose_item16(F.in[I_W_IN], D, INC, (bf16*)(F.ws + WS_WIN_T), 128 * kb, n0, drow, (LAS unsigned char*)scr, F.lane); continue; } r -= I_IN;
        if (r < 3 * I_SQ) { const int w = r / I_SQ, q = r % I_SQ, kb = q / 32, nb = q % 32;
            const float* src = F.in[w == 0 ? I_WK : w == 1 ? I_WV : I_WO];
            bf16* dst = (bf16*)(F.ws + (w == 0 ? WS_WK_T : w == 1 ? WS_WV_T : WS_WOTB));
            p0_transpose_item16(src, D, D, dst, 128 * kb, 32 * nb, 32 * nb, (LAS unsigned char*)scr, F.lane); continue; } r -= 3 * I_SQ;
        { const int q = r, kb = q / 32, nb = q % 32;
            p0_transpose_item8b(F.in[I_W_OUT], D, D, F.ws + WS_WOUT_T, 128 * kb, 32 * nb, 32 * nb, WOUT_SC, (LAS unsigned char*)scr, F.lane); }
    }
    if (gw < 512) { const int idx = gw * 64 + F.lane, c = idx >> 5, e = idx & 31; const float w = F.in[I_W_ROUTER][idx] * F.in[I_LN2_G][c];
        const unsigned hi = f2bf(w), lo = f2bf(w - __builtin_bit_cast(float, hi << 16)); bf16* wr = (bf16*)(F.ws + WS_WR);
        wr[e * WR_STRIDE + c] = (bf16)hi; wr[(32 + e) * WR_STRIDE + c] = (bf16)lo; }
    else if (gw < 512 + NE) { const int e = gw - 512; float sg = 0.f, sb = 0.f;
#pragma unroll 4
        for (int k = F.lane; k < D; k += 64) { const float w = F.in[I_W_ROUTER][k * NE + e]; sg += F.in[I_LN2_G][k] * w; sb += F.in[I_LN2_B][k] * w; }
        sg = wave_sum(sg); sb = wave_sum(sb);
        if (F.lane == 0) { float* st = (float*)(F.ws + WS_WR + WR_ST_OFF); st[e] = sg; st[NE + e] = sb + F.in[I_B_ROUTER][e]; } }
    int rbeg, rstep, rend;
    { const int split = (NIW * P0_RI < M + MM) ? NIW * P0_RI : M + MM;
        if (itemw) { rbeg = F.vcu * P0_IW + F.wave; rstep = NIW; rend = split; } else { rbeg = split + F.vcu * (NWAVES - P0_IW) + (F.wave - P0_IW); rstep = NOW; rend = M + MM + D; } }
    f32x4 gin[4], bin[4];
#pragma unroll
    for (int j = 0; j < 4; ++j) { gin[j] = ((const GAS f32x4*)F.in[I_LN_IN_G])[F.lane + 64 * j]; bin[j] = ((const GAS f32x4*)F.in[I_LN_IN_B])[F.lane + 64 * j]; }
#pragma unroll 2
    for (int m = rbeg; m < rend; m += rstep) {
        f32x4 v[4];
        if (m < M) { load_row_f32_nt(v, F.in[I_X] + (size_t)m * D, F.lane); ln_row_r(v, gin, bin);
            store_row_bf16(v, (bf16*)(F.ws + WS_HB) + (size_t)m * D, F.lane); }
        else if (m < M + MM) { const int mm = m - M; load_row_f32(v, F.in[I_MEM] + (size_t)mm * D, F.lane); ln_row(v, F.in[I_LN_MEM_G], F.in[I_LN_MEM_B], F.lane);
            store_row_bf16(v, (bf16*)(F.ws + WS_MEMN) + (size_t)mm * D, F.lane); }
        else { const int c = m - M - MM; load_row_f32(v, F.in[I_WQ] + (size_t)c * D, F.lane); store_row_bf16(v, (bf16*)(F.ws + WS_WQB) + (size_t)c * D, F.lane); }
    }
}

constexpr unsigned TSTEP = 256u * 1024u * 2u;
struct SchedP1 { int G, c;
    __device__ __forceinline__ bool next(int i, Unit& u) const {
        const int L = i * G + c; if (L >= 1280) return false;
        u.nvalid = 256; u.goff = 0;
        if (L < 1024) { pg8::tile_order(L, 128, 8, u.pm, u.pn); u.z = 0; u.aoff = (unsigned)WS_HB + (unsigned)u.pm * TSTEP; u.boff = (unsigned)WS_WIN_T + (unsigned)u.pn * TSTEP; }
        else { const int j = L - 1024; u.pm = j & 1; u.pn = j >> 1; u.z = 3; u.aoff = (unsigned)WS_WIN_T + (unsigned)(8 + u.pm) * TSTEP; u.boff = (unsigned)WS_HB + (unsigned)u.pn * TSTEP; }
        return true; }
};
struct SchedKV { int v;
    __device__ __forceinline__ bool next(int i, Unit& u) const {
        if (i > 0 || v >= 64) return false;
        u.nvalid = 256; u.goff = 0;
        if (v < 32) { u.pm = v & 7; u.pn = v >> 3; u.z = 1; u.aoff = (unsigned)WS_MEMN + (unsigned)u.pm * TSTEP; u.boff = (unsigned)WS_WK_T + (unsigned)u.pn * TSTEP; }
        else { const int j = v - 32; u.pm = j & 7; u.pn = j >> 3; u.z = 2; u.aoff = (unsigned)WS_MEMN + (unsigned)u.pm * TSTEP; u.boff = (unsigned)WS_WV_T + (unsigned)u.pn * TSTEP; }
        return true; }
};
struct EpiP1 { static constexpr bool PERM = true; static constexpr int PERM2 = 2;
    unsigned char* ws; const float* b_in;
    __device__ __forceinline__ void operator()(const f32x4 (&acc)[2][2][4][2], const Unit& u, int wr, int wc, int fr, int fq) const {
        const int row0 = u.pm * 256 + wr * 64 + fr;
        if (u.z == 0) {
            if (u.pn < 4) {
                const int ch = 128 * u.pn + wc * 32 + 8 * fq;
                f32x4 bv[2], bg[2];
#pragma unroll
                for (int n = 0; n < 2; ++n) { bv[n] = *(const f32x4*)(b_in + ch + 4 * n); bg[n] = *(const f32x4*)(b_in + 512 + ch + 4 * n); }
                bf16* U = (bf16*)(ws + WS_U);
#pragma unroll
                for (int ai = 0; ai < 2; ++ai)
#pragma unroll
                    for (int m = 0; m < 4; ++m) { f32x4 o[2];
#pragma unroll
                        for (int n = 0; n < 2; ++n) { const f32x4 a = acc[ai][0][m][n] + bv[n], g = acc[ai][1][m][n] + bg[n];
#pragma unroll
                            for (int j = 0; j < 4; ++j) o[n][j] = a[j] * sigmoidf_fast(g[j]); }
                        u32x4 w; w.x = pg8::cvt_pk_bf16(o[0][0], o[0][1]); w.y = pg8::cvt_pk_bf16(o[0][2], o[0][3]); w.z = pg8::cvt_pk_bf16(o[1][0], o[1][1]); w.w = pg8::cvt_pk_bf16(o[1][2], o[1][3]);
                        *(u32x4*)(U + (size_t)(row0 + ai * 128 + m * 16) * 512 + ch) = w; }
            } else {
                const int t = u.pn - 4, which = t >> 1, cb = (t & 1) * 256;
                bf16* dst = (bf16*)(ws + (which == 0 ? WS_Q : WS_K));
                pg8::store_tile_bf16_w(acc, dst + (size_t)row0 * 512 + cb, 512, b_in + 1024 + 256 * t, which == 0 ? SB_QSCALE : 1.0f, wc, fq);
            }
        } else if (u.z == 3) {
            const float* rb = b_in + 2048 + row0; bf16* p0 = (bf16*)(ws + WS_V) + (size_t)row0 * M + 256 * u.pn; const int cl = wc * 64 + 8 * fq;
#pragma unroll
            for (int ai = 0; ai < 2; ++ai)
#pragma unroll
                for (int m = 0; m < 4; ++m) { const float bv = rb[ai * 128 + m * 16]; bf16* rowp = p0 + (size_t)(ai * 128 + m * 16) * M + cl;
#pragma unroll
                    for (int bj = 0; bj < 2; ++bj) { const f32x4 v0 = acc[ai][bj][m][0] + bv, v1 = acc[ai][bj][m][1] + bv;
                        u32x4 w; w.x = pg8::cvt_pk_bf16(v0[0], v0[1]); w.y = pg8::cvt_pk_bf16(v0[2], v0[3]); w.z = pg8::cvt_pk_bf16(v1[0], v1[1]); w.w = pg8::cvt_pk_bf16(v1[2], v1[3]);
                        *(u32x4*)(rowp + bj * 32) = w; } }
        } else if (u.z == 1) pg8::store_tile_bf16_w(acc, (bf16*)(ws + WS_KM) + (size_t)row0 * 1024 + 256 * u.pn, 1024, nullptr, 1.0f, wc, fq);
        else pg8::store_tile_bf16_w(acc, (bf16*)(ws + WS_VM) + (size_t)row0 * 1024 + 256 * u.pn, 1024, nullptr, 1.0f, wc, fq);
    }
};

struct SchedPlain { int G, c, nM, nN; unsigned abase, bbase, atile, btile, acol, bcol, bgrp;
    __device__ __forceinline__ bool next(int i, Unit& u) const {
        const int L = i * G + c; if (L >= nM * nN) return false;
        pg8::tile_order(L, nM, nN, u.pm, u.pn); u.z = 0; u.nvalid = 256; u.goff = 0;
        u.aoff = abase + (unsigned)u.pm * atile + (unsigned)u.pn * acol; u.boff = bbase + (unsigned)u.pn * btile + (unsigned)(u.pm >> 4) * bgrp + (unsigned)u.pn * bcol; return true; }
};
struct EpiBf16 { static constexpr bool PERM = true; static constexpr int PERM2 = 2;
    bf16* O; int ldc; float scale; const float* bias;
    __device__ __forceinline__ void operator()(const f32x4 (&acc)[2][2][4][2], const Unit& u, int wr, int wc, int fr, int fq) const {
        const int cl = 256 * u.pn + 64 * wc + 8 * fq; bf16* p0 = O + (size_t)(u.pm * 256 + wr * 64 + fr) * ldc + cl;
        f32x4 bv[2][2];
#pragma unroll
        for (int bj = 0; bj < 2; ++bj)
#pragma unroll
            for (int n = 0; n < 2; ++n) bv[bj][n] = bias ? *(const f32x4*)(bias + cl + 32 * bj + 4 * n) : (f32x4){0.f, 0.f, 0.f, 0.f};
#pragma unroll
        for (int ai = 0; ai < 2; ++ai)
#pragma unroll
            for (int m = 0; m < 4; ++m) { bf16* rowp = p0 + (size_t)(ai * 128 + m * 16) * ldc;
#pragma unroll
                for (int bj = 0; bj < 2; ++bj) { const f32x4 v0 = acc[ai][bj][m][0] * scale + bv[bj][0], v1 = acc[ai][bj][m][1] * scale + bv[bj][1];
                    u32x4 w; w.x = pg8::cvt_pk_bf16(v0[0], v0[1]); w.y = pg8::cvt_pk_bf16(v0[2], v0[3]); w.z = pg8::cvt_pk_bf16(v1[0], v1[1]); w.w = pg8::cvt_pk_bf16(v1[2], v1[3]);
                    *(u32x4*)(rowp + 32 * bj) = w; } }
    }
};
constexpr int CW_LNC = 65536;
constexpr size_t WS_LNX = WS_QM;
struct SchedOne { int L, nM, nN; unsigned abase, bbase, atile, btile;
    __device__ __forceinline__ bool next(int i, Unit& u) const {
        if (i > 0 || L >= nM * nN) return false;
        pg8::tile_order(L, nM, nN, u.pm, u.pn); u.z = 0; u.nvalid = 256; u.goff = 0; u.aoff = abase + (unsigned)u.pm * atile; u.boff = bbase + (unsigned)u.pn * btile; return true; }
};
struct EpiLn1 { static constexpr bool PERM = true; static constexpr int PERM2 = 2;
    unsigned char* ws; gu32* ctl; const float* bias; const float* g; const float* b; LAS unsigned char* lds; float scale;
    __device__ __forceinline__ void operator()(f32x4 (&acc)[2][2][4][2], const Unit& u, int wr, int wc, int fr, int fq) const {
        typedef float f32x2v __attribute__((ext_vector_type(2)));
        LAS f32x2v* P = (LAS f32x2v*)lds;
        LAS f32x2v* S = (LAS f32x2v*)(lds + 8192);
        LAS unsigned* flag = (LAS unsigned*)(lds + 8192 + 2048);
        const int wid = wr * 4 + wc, lane = fq * 16 + fr;
        const int cl = 256 * u.pn + 64 * wc + 8 * fq;
        bf16* hp = (bf16*)(ws + WS_HB) + (size_t)(u.pm * 256 + wr * 64 + fr) * D + cl;
        { f32x4 bv[2][2];
#pragma unroll
            for (int bj = 0; bj < 2; ++bj)
#pragma unroll
                for (int n = 0; n < 2; ++n) bv[bj][n] = *(const f32x4*)(bias + cl + 32 * bj + 4 * n);
#pragma unroll
            for (int ai = 0; ai < 2; ++ai) {
#pragma unroll
                for (int m = 0; m < 4; ++m) { const bf16* rowp = hp + (size_t)(ai * 128 + m * 16) * D;
#pragma unroll
                    for (int bj = 0; bj < 2; ++bj) { const u32x4 hw = *(const GAS u32x4*)(rowp + 32 * bj);
                        acc[ai][bj][m][0] = acc[ai][bj][m][0] * scale + bv[bj][0] + (f32x4){bflo(hw.x), bfhi(hw.x), bflo(hw.y), bfhi(hw.y)} * DN_ALPHA;
                        acc[ai][bj][m][1] = acc[ai][bj][m][1] * scale + bv[bj][1] + (f32x4){bflo(hw.z), bfhi(hw.z), bflo(hw.w), bfhi(hw.w)} * DN_ALPHA; } }
            } }
#pragma unroll
        for (int ai = 0; ai < 2; ++ai)
#pragma unroll
            for (int m = 0; m < 4; ++m) {
                float sm = 0.f;
#pragma unroll
                for (int bj = 0; bj < 2; ++bj)
#pragma unroll
                    for (int n = 0; n < 2; ++n) { const f32x4 x = acc[ai][bj][m][n]; sm += (x[0] + x[1]) + (x[2] + x[3]); }
                sm += __shfl_xor(sm, 16); sm += __shfl_xor(sm, 32);
                const float mw = sm * (1.0f / 64.0f); float q = 0.f;
#pragma unroll
                for (int bj = 0; bj < 2; ++bj)
#pragma unroll
                    for (int n = 0; n < 2; ++n) { const f32x4 d = acc[ai][bj][m][n] - mw; q += (d[0] * d[0] + d[1] * d[1]) + (d[2] * d[2] + d[3] * d[3]); }
                q += __shfl_xor(q, 16); q += __shfl_xor(q, 32);
                if (fq == 0) P[(ai * 128 + wr * 64 + m * 16 + fr) * 4 + wc] = (f32x2v){mw, q};
            }
        asm volatile("s_waitcnt lgkmcnt(0)" ::: "memory"); __builtin_amdgcn_s_barrier(); asm volatile("" ::: "memory");
        const int row = wid * 32 + (lane & 31);
        unsigned long long* xb = (unsigned long long*)(ws + WS_LNX) + (size_t)(u.pm * 256 + row) * 4;
        if (lane < 32) {
            const f32x2v a = P[row * 4 + 0], b2 = P[row * 4 + 1], c = P[row * 4 + 2], d = P[row * 4 + 3];
            const float mt = (a.x + b2.x + c.x + d.x) * 0.25f;
            const float da = a.x - mt, db = b2.x - mt, dc = c.x - mt, dd = d.x - mt;
            const float m2 = (a.y + b2.y) + (c.y + d.y) + 64.0f * ((da * da + db * db) + (dc * dc + dd * dd));
            __hip_atomic_store(xb + u.pn, ((unsigned long long)__builtin_bit_cast(unsigned, m2) << 32) | __builtin_bit_cast(unsigned, mt), RLX_AGENT);
        }
        asm volatile("s_waitcnt vmcnt(0)" ::: "memory");
        gu32* cnt = ctl + CW_LNC + 64 * u.pm;
        if (lane == 0) __hip_atomic_fetch_add(cnt, 1u, RLX_AGENT);
        if (wid == 0) { unsigned spins = 0; bool dead = false;
            while ((unsigned)__builtin_amdgcn_readfirstlane(__hip_atomic_load(cnt, RLX_AGENT)) < 32u) { if (++spins > (1u << 21)) { dead = true; break; } __builtin_amdgcn_s_sleep(2); }
            __builtin_amdgcn_fence(__ATOMIC_ACQUIRE, "agent");
            if (lane == 0) flag[0] = dead ? 1u : 0u; }
        asm volatile("s_waitcnt vmcnt(0) lgkmcnt(0)" ::: "memory"); __builtin_amdgcn_s_barrier(); asm volatile("" ::: "memory");
        const bool bad = flag[0] != 0u;
        if (lane < 32) { float mt[4], m2[4], ms = 0.f;
#pragma unroll
            for (int t = 0; t < 4; ++t) { const unsigned long long w = __hip_atomic_load(xb + t, RLX_AGENT); mt[t] = __builtin_bit_cast(float, (unsigned)w); m2[t] = __builtin_bit_cast(float, (unsigned)(w >> 32)); ms += mt[t]; }
            const float mean = ms * 0.25f; float q = 0.f;
#pragma unroll
            for (int t = 0; t < 4; ++t) { const float dm = mt[t] - mean; q += m2[t] + 256.0f * dm * dm; }
            S[row] = (f32x2v){mean, bad ? __builtin_nanf("") : 1.0f / sqrtf(q * (1.0f / D) + LN_EPS)}; }
        asm volatile("s_waitcnt lgkmcnt(0)" ::: "memory"); __builtin_amdgcn_s_barrier(); asm volatile("" ::: "memory");
        f32x4 gv[2][2], bb[2][2];
#pragma unroll
        for (int bj = 0; bj < 2; ++bj)
#pragma unroll
            for (int n = 0; n < 2; ++n) { gv[bj][n] = *(const f32x4*)(g + cl + 32 * bj + 4 * n); bb[bj][n] = *(const f32x4*)(b + cl + 32 * bj + 4 * n); }
        unsigned char* h8 = ws + WS_HB8 + (size_t)(u.pm * 256 + wr * 64 + fr) * D + cl;
#pragma unroll
        for (int ai = 0; ai < 2; ++ai)
#pragma unroll
            for (int m = 0; m < 4; ++m) { const f32x2v sr = S[ai * 128 + wr * 64 + m * 16 + fr]; const size_t ro = (size_t)(ai * 128 + m * 16) * D;
#pragma unroll
                for (int bj = 0; bj < 2; ++bj) { const f32x4 v0 = (acc[ai][bj][m][0] - sr.x) * sr.y * gv[bj][0] + bb[bj][0], v1 = (acc[ai][bj][m][1] - sr.x) * sr.y * gv[bj][1] + bb[bj][1];
                    *(GAS u32x4*)(hp + ro + 32 * bj) = (u32x4){pk2(v0[0], v0[1]), pk2(v0[2], v0[3]), pk2(v1[0], v1[1]), pk2(v1[2], v1[3])};
                    *(GAS u32x2*)(h8 + ro + 32 * bj) = (u32x2){pk4_fp8(v0[0], v0[1], v0[2], v0[3]), pk4_fp8(v1[0], v1[1], v1[2], v1[3])}; } }
    }
};
struct EpiFp8 { static constexpr bool PERM = true; static constexpr int PERM2 = 1;
    unsigned char* O; int ldc; float scale;
    __device__ __forceinline__ void operator()(const f32x4 (&acc)[2][2][4][2], const Unit& u, int wr, int wc, int fr, int fq) const {
        const int cl = 256 * u.pn + 64 * wc + 16 * fq; unsigned char* p0 = O + (size_t)(u.pm * 256 + wr * 64 + fr) * ldc + cl;
#pragma unroll
        for (int ai = 0; ai < 2; ++ai)
#pragma unroll
            for (int m = 0; m < 4; ++m) { u32x4 w; const f32x4 a = acc[ai][0][m][0] * scale, b = acc[ai][0][m][1] * scale, c = acc[ai][1][m][0] * scale, d = acc[ai][1][m][1] * scale;
                w.x = pk4_fp8(a[0], a[1], a[2], a[3]); w.y = pk4_fp8(b[0], b[1], b[2], b[3]); w.z = pk4_fp8(c[0], c[1], c[2], c[3]); w.w = pk4_fp8(d[0], d[1], d[2], d[3]);
                *(u32x4*)(p0 + (size_t)(ai * 128 + m * 16) * ldc) = w; }
    }
};
struct SchedGH { int G, c;
    __device__ __forceinline__ bool next(int i, Unit& u) const {
        const int v = i * G + c; if (v >= 256) return false;
        u.nvalid = 256; u.goff = 0;
        const int w = v & 127, b = w >> 4, h = (w >> 2) & 3, t = w & 3;
        if (v < 128) { u.z = 0; u.pm = b * 4 + h; u.pn = t; u.aoff = (unsigned)WS_KM + (unsigned)((b * 256) * 1024 + h * 256) * 2u; u.boff = (unsigned)WS_WQB + (unsigned)((t * 256) * 1024 + h * 256) * 2u; }
        else { u.z = 1; u.pm = b * 4 + t; u.pn = h; u.aoff = (unsigned)WS_WOTB + (unsigned)((t * 256) * 1024 + h * 256) * 2u; u.boff = (unsigned)WS_VM + (unsigned)((b * 256) * 1024 + h * 256) * 2u; }
        return true; }
};
struct EpiGH { static constexpr bool PERM = true; static constexpr int PERM2 = 1;
    unsigned char* ws;
    __device__ __forceinline__ void operator()(const f32x4 (&acc)[2][2][4][2], const Unit& u, int wr, int wc, int fr, int fq) const {
        const float scale = u.z ? H_SC : G_SC * MEM_QSCALE;
        const int cl = 256 * u.pn + 64 * wc + 16 * fq; unsigned char* p0 = ws + (u.z ? WS_H8 : WS_G8) + (size_t)(u.pm * 256 + wr * 64 + fr) * D + cl;
#pragma unroll
        for (int ai = 0; ai < 2; ++ai)
#pragma unroll
            for (int m = 0; m < 4; ++m) { u32x4 w; const f32x4 a = acc[ai][0][m][0] * scale, b = acc[ai][0][m][1] * scale, c = acc[ai][1][m][0] * scale, d = acc[ai][1][m][1] * scale;
                w.x = pk4_fp8(a[0], a[1], a[2], a[3]); w.y = pk4_fp8(b[0], b[1], b[2], b[3]); w.z = pk4_fp8(c[0], c[1], c[2], c[3]); w.w = pk4_fp8(d[0], d[1], d[2], d[3]);
                *(u32x4*)(p0 + (size_t)(ai * 128 + m * 16) * D) = w; }
    }
};
struct EpiSoftmax { static constexpr bool PERM = true; static constexpr int PERM2 = 1;
    unsigned char* P8; LAS unsigned char* lds; int* parity;
    __device__ __forceinline__ void operator()(f32x4 (&acc)[2][2][4][2], const Unit& u, int wr, int wc, int fr, int fq) const {
        typedef float f32x2v __attribute__((ext_vector_type(2)));
        LAS f32x2v* T = (LAS f32x2v*)(lds + ((*parity) & 1) * 8192);
        float mw[2][4];
#pragma unroll
        for (int ai = 0; ai < 2; ++ai)
#pragma unroll
            for (int m = 0; m < 4; ++m) { float mx = -INFINITY;
#pragma unroll
                for (int bj = 0; bj < 2; ++bj)
#pragma unroll
                    for (int n = 0; n < 2; ++n) { f32x4 x = acc[ai][bj][m][n] * (1.0f / G_SC); acc[ai][bj][m][n] = x; mx = fmaxf(fmaxf(mx, fmaxf(x[0], x[1])), fmaxf(x[2], x[3])); }
                mx = fmaxf(mx, __shfl_xor(mx, 16)); mx = fmaxf(mx, __shfl_xor(mx, 32));
                float l = 0.f;
#pragma unroll
                for (int bj = 0; bj < 2; ++bj)
#pragma unroll
                    for (int n = 0; n < 2; ++n) { f32x4 x = acc[ai][bj][m][n];
#pragma unroll
                        for (int j = 0; j < 4; ++j) { x[j] = __builtin_amdgcn_exp2f(x[j] - mx); l += x[j]; }
                        acc[ai][bj][m][n] = x; }
                l += __shfl_xor(l, 16); l += __shfl_xor(l, 32);
                mw[ai][m] = mx;
                if (fq == 0) T[(ai * 128 + wr * 64 + m * 16 + fr) * 4 + wc] = (f32x2v){mx, l}; }
        asm volatile("s_waitcnt lgkmcnt(0)" ::: "memory"); __builtin_amdgcn_s_barrier(); asm volatile("" ::: "memory");
        const int cl = 256 * u.pn + 64 * wc + 16 * fq; unsigned char* p0 = P8 + (size_t)(u.pm * 256 + wr * 64 + fr) * D + cl;
#pragma unroll
        for (int ai = 0; ai < 2; ++ai)
#pragma unroll
            for (int m = 0; m < 4; ++m) { const LAS f32x2v* t = T + (ai * 128 + wr * 64 + m * 16 + fr) * 4;
                const f32x2v t0 = t[0], t1 = t[1], t2 = t[2], t3 = t[3];
                const float Mx = fmaxf(fmaxf(t0.x, t1.x), fmaxf(t2.x, t3.x));
                const float L = (t0.y * __builtin_amdgcn_exp2f(t0.x - Mx) + t1.y * __builtin_amdgcn_exp2f(t1.x - Mx)) + (t2.y * __builtin_amdgcn_exp2f(t2.x - Mx) + t3.y * __builtin_amdgcn_exp2f(t3.x - Mx));
                const float f = __builtin_amdgcn_exp2f(mw[ai][m] - Mx) * (P_SC / L);
                const f32x4 a = acc[ai][0][m][0] * f, b = acc[ai][0][m][1] * f, c = acc[ai][1][m][0] * f, d = acc[ai][1][m][1] * f; u32x4 w;
                w.x = pk4_fp8(a[0], a[1], a[2], a[3]); w.y = pk4_fp8(b[0], b[1], b[2], b[3]); w.z = pk4_fp8(c[0], c[1], c[2], c[3]); w.w = pk4_fp8(d[0], d[1], d[2], d[3]);
                *(u32x4*)(p0 + (size_t)(ai * 128 + m * 16) * D) = w; }
        ++(*parity);
    }
};
constexpr int MOE_MAX_UNITS = 40;
struct SchedMoe { const LAS int* ut;
    __device__ __forceinline__ bool next(int i, Unit& u) const {
        if (i >= MOE_MAX_UNITS) return false;
        const LAS int* p = ut + 8 * i;
        if (__builtin_amdgcn_readfirstlane(p[7]) == 0) return false;
        u.pm = __builtin_amdgcn_readfirstlane(p[0]); u.pn = __builtin_amdgcn_readfirstlane(p[1]); u.z = __builtin_amdgcn_readfirstlane(p[2]); u.nvalid = __builtin_amdgcn_readfirstlane(p[3]);
        u.aoff = (unsigned)__builtin_amdgcn_readfirstlane(p[4]); u.boff = (unsigned)__builtin_amdgcn_readfirstlane(p[5]); u.goff = (unsigned)__builtin_amdgcn_readfirstlane(p[6]); return true; }
};
__device__ __forceinline__ void moe_units(Frame& F, const LAS int* tb, LAS int* ut, int nN, unsigned abase, unsigned wbase, unsigned wexp, bool gather) {
    if (F.tid < MOE_MAX_UNITS) { const int i = F.tid, nblk = tb[32], L = i * F.G + (int)blockIdx.x; LAS int* p = ut + 8 * i;
        if (L < nblk * nN) { int pm, pn; pg8::tile_order(L, nblk, nN, pm, pn);
            const int e = tb[128 + pm], j = pm - tb[e], rem = tb[64 + e] - 256 * j;
            p[0] = pm; p[1] = pn; p[2] = e; p[3] = rem < 256 ? rem : 256; p[4] = (int)(gather ? abase : abase + (unsigned)pm * (TSTEP / 2));
            p[5] = (int)(wbase + (unsigned)e * wexp + (unsigned)pn * (TSTEP / 2)); p[6] = e * LCAP + 256 * j; p[7] = 1; }
        else p[7] = 0; }
    LDS_WAIT(); __syncthreads();
}
__device__ __forceinline__ f32x2 swiglu_pk(f32x2 g, f32x2 u) {
    f32x2 g_, u_; g_.x = fminf(g.x, 7.0f); g_.y = fminf(g.y, 7.0f); u_.x = __builtin_amdgcn_fmed3f(u.x, -7.0f, 7.0f); u_.y = __builtin_amdgcn_fmed3f(u.y, -7.0f, 7.0f);
    const f32x2 t = g_ * (-1.702f * LOG2E); f32x2 e; e.x = __builtin_amdgcn_exp2f(t.x); e.y = __builtin_amdgcn_exp2f(t.y);
    const f32x2 d = e + 1.0f; f32x2 r; r.x = __builtin_amdgcn_rcpf(d.x); r.y = __builtin_amdgcn_rcpf(d.y);
    return ((u_ + 1.0f) * g_) * r;
}
struct EpiAct { static constexpr bool PERM = true;
    unsigned char* ACT; const float* b_gu;
    __device__ __forceinline__ void operator()(const f32x4 (&acc)[2][2][4][2], const Unit& u, int wr, int wc, int fr, int fq) const {
        const int ch = 128 * u.pn + wc * 32 + 8 * fq;
        unsigned char* ap = ACT + ((size_t)(u.pm * 16 + wr * 4) * (DFF / 32) + (4 * u.pn + wc)) * 512 + fr * 32 + 8 * fq;
        const float* bb = b_gu + (size_t)u.z * 2 * DFF;
        f32x4 bg[2], bu[2];
#pragma unroll
        for (int n = 0; n < 2; ++n) { bg[n] = *(const f32x4*)(bb + ch + 4 * n); bu[n] = *(const f32x4*)(bb + DFF + ch + 4 * n); }
#pragma unroll
        for (int ai = 0; ai < 2; ++ai)
#pragma unroll
            for (int m = 0; m < 4; ++m) { f32x2 o[2][2];
#pragma unroll
                for (int n = 0; n < 2; ++n) { const f32x4 ag = acc[ai][0][m][n], au = acc[ai][1][m][n];
                    o[n][0] = swiglu_pk((f32x2){ag[0], ag[1]} * (1.0f / WGU_SC) + (f32x2){bg[n][0], bg[n][1]}, (f32x2){au[0], au[1]} * (1.0f / WGU_SC) + (f32x2){bu[n][0], bu[n][1]});
                    o[n][1] = swiglu_pk((f32x2){ag[2], ag[3]} * (1.0f / WGU_SC) + (f32x2){bg[n][2], bg[n][3]}, (f32x2){au[2], au[3]} * (1.0f / WGU_SC) + (f32x2){bu[n][2], bu[n][3]}); }
                *(u32x2*)(ap + (size_t)(ai * 8 + m) * (16 * DFF)) = (u32x2){pk4_fp8(o[0][0].x, o[0][0].y, o[0][1].x, o[0][1].y), pk4_fp8(o[1][0].x, o[1][0].y, o[1][1].x, o[1][1].y)}; }
    }
};
struct EpiDown { static constexpr bool PERM = true; static constexpr int PERM2 = 1; static constexpr bool ATILED = true;
    unsigned char* YS; const float* b_down;
    __device__ __forceinline__ void operator()(const f32x4 (&acc)[2][2][4][2], const Unit& u, int wr, int wc, int fr, int fq) const {
        const int r0 = wr * 64 + fr, cl = 256 * u.pn + 64 * wc + 16 * fq;
        const float* bb = b_down + (size_t)u.z * D + cl;
        f32x4 bv[2][2];
#pragma unroll
        for (int bj = 0; bj < 2; ++bj)
#pragma unroll
            for (int n = 0; n < 2; ++n) bv[bj][n] = *(const f32x4*)(bb + 8 * bj + 4 * n) * YS_SC;
#pragma unroll
        for (int ai = 0; ai < 2; ++ai)
#pragma unroll
            for (int m = 0; m < 4; ++m) { const int r = r0 + ai * 128 + m * 16; u32x4 w;
                { const f32x4 a = acc[ai][0][m][0] * (YS_SC / WDN_SC) + bv[0][0], b = acc[ai][0][m][1] * (YS_SC / WDN_SC) + bv[0][1], c = acc[ai][1][m][0] * (YS_SC / WDN_SC) + bv[1][0], d = acc[ai][1][m][1] * (YS_SC / WDN_SC) + bv[1][1];
                    w.x = pk4_fp8(a[0], a[1], a[2], a[3]); w.y = pk4_fp8(b[0], b[1], b[2], b[3]); w.z = pk4_fp8(c[0], c[1], c[2], c[3]); w.w = pk4_fp8(d[0], d[1], d[2], d[3]); }
                *(u32x4*)(YS + (size_t)(u.pm * 256 + r) * D + cl) = w; }
    }
};
__device__ __forceinline__ void moe_table(Frame& F, LAS int* tb) {
    if (F.tid < 32) { int c = (int)__hip_atomic_load(F.ctl + CW_ECNT + 64 * F.tid, RLX_AGENT); if (c > LCAP) c = LCAP; tb[64 + F.tid] = c; }
    LDS_WAIT(); __syncthreads();
    if (F.tid == 0) { int s = 0; for (int e = 0; e < NE; ++e) { tb[e] = s; s += (tb[64 + e] + 255) >> 8; } tb[32] = s; }
    LDS_WAIT(); __syncthreads();
    for (int b = F.tid; b < NBLK_MAX; b += NWAVES * 64) { int e = 0; while (e < NE - 1 && tb[e + 1] <= b) ++e; tb[128 + b] = e; }
    LDS_WAIT(); __syncthreads();
}

constexpr int P2_RING = 48, P2_CUT = P2_RING * 1024, P2_CCO = 16 * 512 * 4;
constexpr int P2_PRIV = 81920, P2_SYNC = 151552;
static_assert(P2_CUT + P2_CCO <= P2_PRIV && P2_PRIV + 4 * 16384 <= P2_SYNC && P2_SYNC + 64 <= LDSCTL_OFF, "phase 2 LDS map");
__device__ __forceinline__ void conv_bar4(LAS int* cnt, int& gen, int lane) {
    gen += 4;
    asm volatile("s_waitcnt lgkmcnt(0)" ::: "memory");
    if (lane == 0) __hip_atomic_fetch_add(cnt, 1, __ATOMIC_RELAXED, __HIP_MEMORY_SCOPE_WORKGROUP);
    unsigned spins = 0;
    while (__builtin_amdgcn_readfirstlane(__hip_atomic_load(cnt, __ATOMIC_RELAXED, __HIP_MEMORY_SCOPE_WORKGROUP)) < gen) { if (++spins > (1u << 22)) break; __builtin_amdgcn_s_sleep(1); }
    asm volatile("" ::: "memory");
}
__device__ __forceinline__ void conv_phase4(Frame& F) {
    LAS unsigned* ut = (LAS unsigned*)(F.lds);
    LAS float* co = (LAS float*)(F.lds + P2_CUT);
    LAS int* cnt = (LAS int*)(F.lds + P2_SYNC);
    const int cp = F.tid & 255;
    f32x2 wv[CWID];
    { const float* wd = F.in[I_W_DW] + 2 * cp;
#pragma unroll
        for (int j = 0; j < CWID; ++j) wv[j] = *(const GAS f32x2*)(wd + j * CONV_CH); }
    const f32x2 bd = *(const GAS f32x2*)(F.in[I_B_DW] + 2 * cp);
    const f32x4 g0 = *(const GAS f32x4*)(F.in[I_LN_CONV_G] + 8 * F.lane), g1 = *(const GAS f32x4*)(F.in[I_LN_CONV_G] + 8 * F.lane + 4);
    const f32x4 b0 = *(const GAS f32x4*)(F.in[I_LN_CONV_B] + 8 * F.lane), b1 = *(const GAS f32x4*)(F.in[I_LN_CONV_B] + 8 * F.lane + 4);
    unsigned char* MX = F.ws + WS_MIXIN;
    int gen = 0;
    constexpr int NITEM = NB * (T_ / 16);
    const int ipw = (NITEM + F.G - 1) / F.G, it0 = F.vcu * ipw, it1 = (it0 + ipw < NITEM) ? it0 + ipw : NITEM;
    u32x4 stg[4];
#define CONV_FULL(item) do { const int b_ = (item) / (T_ / 16), t0_ = ((item) % (T_ / 16)) * 16; const bf16* U_ = (const bf16*)(F.ws + WS_U) + (size_t)b_ * T_ * CONV_CH; \
        for (int idx_ = F.tid; idx_ < 46 * 64; idx_ += 256) { const int r_ = idx_ >> 6, c16_ = idx_ & 63, t_ = t0_ - 30 + r_; \
            u32x4 v_ = (u32x4){0u, 0u, 0u, 0u}; if (t_ >= 0) v_ = *(const GAS u32x4*)(U_ + (size_t)t_ * CONV_CH + c16_ * 8); \
            *(LAS u32x4*)(ut + ((t_ + P2_RING) % P2_RING) * 256 + c16_ * 4) = v_; } } while (0)
#define CONV_FETCH16(item) do { const int b_ = (item) / (T_ / 16), t0_ = ((item) % (T_ / 16)) * 16; const bf16* U_ = (const bf16*)(F.ws + WS_U) + ((size_t)b_ * T_ + t0_) * CONV_CH; \
        _Pragma("unroll") for (int q_ = 0; q_ < 4; ++q_) { const int idx_ = F.tid + 256 * q_; stg[q_] = *(const GAS u32x4*)(U_ + (size_t)(idx_ >> 6) * CONV_CH + (idx_ & 63) * 8); } } while (0)
#define CONV_PUT16(item) do { const int t0_ = ((item) % (T_ / 16)) * 16; \
        _Pragma("unroll") for (int q_ = 0; q_ < 4; ++q_) { const int idx_ = F.tid + 256 * q_; *(LAS u32x4*)(ut + ((t0_ + (idx_ >> 6)) % P2_RING) * 256 + (idx_ & 63) * 4) = stg[q_]; } } while (0)
    if (it0 < it1) CONV_FULL(it0);
    for (int it = it0; it < it1; ++it) {
        const int b = it / (T_ / 16), t0 = (it % (T_ / 16)) * 16;
        const bool more = it + 1 < it1, nfull = ((it + 1) % (T_ / 16)) == 0;
        conv_bar4(cnt, gen, F.lane);
        if (more && !nfull) CONV_FETCH16(it + 1);
        { f32x2 av[16];
            const int s0 = __builtin_amdgcn_readfirstlane((t0 + P2_RING - 30) % P2_RING);
#pragma unroll
            for (int tt = 0; tt < 16; ++tt) av[tt] = bd;
#pragma unroll
            for (int r = 0; r < 46; ++r) { int pos = s0 + r; pos = (pos >= P2_RING) ? pos - P2_RING : pos;
                const unsigned uu = ut[pos * 256 + cp]; const f32x2 uv = {bflo(uu), bfhi(uu)};
#pragma unroll
                for (int tt = 0; tt < 16; ++tt) { const int j = r - tt; if (j >= 0 && j < CWID) av[tt] = wv[j] * uv + av[tt]; } }
#pragma unroll
            for (int tt = 0; tt < 16; ++tt) *(LAS f32x2*)(co + tt * CONV_CH + 2 * cp) = av[tt];
        }
        conv_bar4(cnt, gen, F.lane);
        if (more) { if (nfull) CONV_FULL(it + 1); else CONV_PUT16(it + 1); }
#pragma unroll
        for (int q = 0; q < 4; ++q) { const int tt = 4 * F.wave + q;
            f32x4 x0 = *(const LAS f32x4*)(co + tt * CONV_CH + 8 * F.lane), x1 = *(const LAS f32x4*)(co + tt * CONV_CH + 8 * F.lane + 4);
            const float mean = wave_sum((x0.x + x0.y) + (x0.z + x0.w) + (x1.x + x1.y) + (x1.z + x1.w)) * (1.f / CONV_CH);
            x0 = x0 - mean; x1 = x1 - mean;
            const float var = wave_sum((x0.x * x0.x + x0.y * x0.y) + (x0.z * x0.z + x0.w * x0.w) + (x1.x * x1.x + x1.y * x1.y) + (x1.z * x1.z + x1.w * x1.w)) * (1.f / CONV_CH);
            const float rstd = 1.f / sqrtf(var + LN_EPS);
            x0 = x0 * rstd * g0 + b0; x1 = x1 * rstd * g1 + b1;
            float y[8] = {x0.x, x0.y, x0.z, x0.w, x1.x, x1.y, x1.z, x1.w};
#pragma unroll
            for (int j = 0; j < 8; ++j) y[j] = y[j] * sigmoidf_fast(y[j]);
            *(GAS u32x2*)(MX + (size_t)(b * T_ + t0 + tt) * D + 8 * F.lane) = (u32x2){pk4_fp8(y[0] * MIX_SC, y[1] * MIX_SC, y[2] * MIX_SC, y[3] * MIX_SC), pk4_fp8(y[4] * MIX_SC, y[5] * MIX_SC, y[6] * MIX_SC, y[7] * MIX_SC)}; }
    }
#undef CONV_FULL
#undef CONV_FETCH16
#undef CONV_PUT16
    conv_bar4(cnt, gen, F.lane);
}

typedef float f32x16 __attribute__((ext_vector_type(16)));
__device__ __forceinline__ int crow(int r, int hi) { return (r & 3) + 8 * (r >> 2) + 4 * hi; }
__device__ __forceinline__ bf16x8 pack8(const float* v) {
    u32x4 w; w.x = pg8::cvt_pk_bf16(v[0], v[1]); w.y = pg8::cvt_pk_bf16(v[2], v[3]); w.z = pg8::cvt_pk_bf16(v[4], v[5]); w.w = pg8::cvt_pk_bf16(v[6], v[7]);
    return __builtin_bit_cast(bf16x8, w); }
constexpr float SB_EXIT = 150.0f;
struct SbStage { u32x4 k[4], v[4]; };
__device__ __forceinline__ void sb_gload(SbStage& g, const bf16* Kt, const bf16* Vt, int lane) {
#pragma unroll
    for (int i = 0; i < 4; ++i) { const int c = (lane & 7) ^ ((4 * i + (lane >> 4)) & 7); g.k[i] = *(const GAS u32x4*)(Kt + (size_t)(8 * i) * SBW + 8 * c); }
#pragma unroll
    for (int i = 0; i < 4; ++i) g.v[i] = *(const GAS u32x4*)(Vt + (size_t)(16 * i) * M);
}
__device__ __forceinline__ void sb_lwrite(const SbStage& g, LAS unsigned char* buf, int lane) {
#pragma unroll
    for (int i = 0; i < 4; ++i) *(LAS u32x4*)(buf + 1024 * i + 16 * lane) = g.k[i];
#pragma unroll
    for (int i = 0; i < 4; ++i) *(LAS u32x4*)(buf + 4096 + 1024 * i + 16 * lane) = g.v[i];
}
__device__ __forceinline__ void sb_attn_wave(Frame& F, int b, int h, int qt, LAS unsigned char* wbuf) {
    const int c = F.lane & 31, hi = F.lane >> 5;
    const bf16* Q = (const bf16*)(F.ws + WS_Q); const bf16* Kb = (const bf16*)(F.ws + WS_K); const bf16* VT = (const bf16*)(F.ws + WS_V);
    bf16x8 tri[2];
#pragma unroll
    for (int s = 0; s < 2; ++s) { bf16x8 t;
#pragma unroll
        for (int j = 0; j < 8; ++j) { const int k = 16 * s + 8 * (j >> 2) + 4 * hi + (j & 3); t[j] = (k >= c) ? (short)0xBF80 : (short)0; }
        tri[s] = t; }
    bf16x8 qf[4];
    { const bf16* qp = Q + ((size_t)b * T_ + 32 * qt + c) * SBW + h * SBD + 8 * hi;
#pragma unroll
        for (int s = 0; s < 4; ++s) qf[s] = *(const GAS bf16x8*)(qp + 16 * s); }
    const bf16* Ksrc = Kb + ((size_t)b * T_ + (F.lane >> 3)) * SBW + h * SBD;
    const bf16* Vsrc = VT + (size_t)(h * SBD + (F.lane >> 2)) * M + (size_t)b * T_ + 8 * ((F.lane & 3) ^ ((F.lane >> 4) & 3));

    const int ksw = (c >> 1) & 7, vsw = (c >> 2) & 3;

    f32x16 o0, o1;
#pragma unroll
    for (int r = 0; r < 16; ++r) { o0[r] = 0.f; o1[r] = 0.f; }
    float carry = 0.f;
    SbStage st;
    sb_gload(st, Ksrc + (size_t)(32 * qt) * SBW, Vsrc + 32 * qt, F.lane); sb_lwrite(st, wbuf, F.lane);
    for (int kt = qt; kt >= 0; --kt) {
        LAS unsigned char* buf = wbuf + ((qt - kt) & 1) * 8192;
        const bool pf = kt > 0 && !__all(carry >= SB_EXIT - 24.f);
        if (pf) sb_gload(st, Ksrc + (size_t)(32 * (kt - 1)) * SBW, Vsrc + 32 * (kt - 1), F.lane);
        const bool diag = (kt == qt);
        bf16x8 kf[4];
#pragma unroll
        for (int s = 0; s < 4; ++s) kf[s] = *(const LAS bf16x8*)(buf + c * 128 + 16 * ((2 * s + hi) ^ ksw));
        f32x16 p;
#pragma unroll
        for (int r = 0; r < 16; ++r) p[r] = 0.f;
#pragma unroll
        for (int s = 0; s < 4; ++s) p = __builtin_amdgcn_mfma_f32_32x32x16_bf16(kf[s], qf[s], p, 0, 0, 0);
        u32x2 vv[2][2][2];
#pragma unroll
        for (int dt = 0; dt < 2; ++dt)
#pragma unroll
            for (int s = 0; s < 2; ++s)
#pragma unroll
                for (int q = 0; q < 2; ++q) vv[dt][s][q] = *(const LAS u32x2*)(buf + 4096 + (32 * dt + c) * 64 + 16 * ((2 * s + q) ^ vsw) + 8 * hi);
        float L[16];
#pragma unroll
        for (int r = 0; r < 16; ++r) { const float y = p[r]; float l = __builtin_amdgcn_logf(1.0f + __builtin_amdgcn_exp2f(y)); l = (y > 64.f) ? y : l;
            if (diag) l = (crow(r, hi) >= c) ? 0.f : l; L[r] = l; }
        const bf16x8 l0 = pack8(L), l1 = pack8(L + 8);
        f32x16 a;
#pragma unroll
        for (int r = 0; r < 16; ++r) a[r] = p[r] - carry;
        a = __builtin_amdgcn_mfma_f32_32x32x16_bf16(tri[0], l0, a, 0, 0, 0); a = __builtin_amdgcn_mfma_f32_32x32x16_bf16(tri[1], l1, a, 0, 0, 0);
        const float tot = p[0] - a[0];
        float w[16];
#pragma unroll
        for (int r = 0; r < 16; ++r) { float x = __builtin_amdgcn_exp2f(a[r]); if (diag) x = (crow(r, hi) >= c) ? 0.f : x; w[r] = x; }
        const bf16x8 p0 = pack8(w), p1 = pack8(w + 8);
        { const bf16x8 v00 = __builtin_bit_cast(bf16x8, (u32x4){vv[0][0][0].x, vv[0][0][0].y, vv[0][0][1].x, vv[0][0][1].y});
          const bf16x8 v01 = __builtin_bit_cast(bf16x8, (u32x4){vv[0][1][0].x, vv[0][1][0].y, vv[0][1][1].x, vv[0][1][1].y});
          const bf16x8 v10 = __builtin_bit_cast(bf16x8, (u32x4){vv[1][0][0].x, vv[1][0][0].y, vv[1][0][1].x, vv[1][0][1].y});
          const bf16x8 v11 = __builtin_bit_cast(bf16x8, (u32x4){vv[1][1][0].x, vv[1][1][0].y, vv[1][1][1].x, vv[1][1][1].y});
          o0 = __builtin_amdgcn_mfma_f32_32x32x16_bf16(v00, p0, o0, 0, 0, 0); o0 = __builtin_amdgcn_mfma_f32_32x32x16_bf16(v01, p1, o0, 0, 0, 0);
          o1 = __builtin_amdgcn_mfma_f32_32x32x16_bf16(v10, p0, o1, 0, 0, 0); o1 = __builtin_amdgcn_mfma_f32_32x32x16_bf16(v11, p1, o1, 0, 0, 0); }
        carry = __shfl(tot, c);
        if (__all(carry >= SB_EXIT)) break;
        if (kt > 0) { if (!pf) sb_gload(st, Ksrc + (size_t)(32 * (kt - 1)) * SBW, Vsrc + 32 * (kt - 1), F.lane); sb_lwrite(st, wbuf + ((qt - kt + 1) & 1) * 8192, F.lane); }
    }
#pragma unroll
    for (int g = 0; g < 4; ++g) {
        *(LAS unsigned*)(wbuf + c * 80 + 8 * g + 4 * hi) = pk4_fp8(o0[4 * g] * MIX_SC, o0[4 * g + 1] * MIX_SC, o0[4 * g + 2] * MIX_SC, o0[4 * g + 3] * MIX_SC);
        *(LAS unsigned*)(wbuf + c * 80 + 32 + 8 * g + 4 * hi) = pk4_fp8(o1[4 * g] * MIX_SC, o1[4 * g + 1] * MIX_SC, o1[4 * g + 2] * MIX_SC, o1[4 * g + 3] * MIX_SC); }
    unsigned char* ob = F.ws + WS_MIXIN + ((size_t)b * T_ + 32 * qt) * D + CONV_CH + h * SBD;
#pragma unroll
    for (int q2 = 0; q2 < 2; ++q2) { const int ci = F.lane + 64 * q2, rr = ci >> 2, pc = ci & 3;
        *(GAS u32x4*)(ob + (size_t)rr * D + 16 * pc) = *(const LAS u32x4*)(wbuf + rr * 80 + 16 * pc); }
}

template <bool NT = false> __device__ __forceinline__ void resid_row(f32x4 (&v)[4], const bf16* hrow, const bf16* mrow, int lane) {
    f32x4 a[4]; if (NT) { load_row_bf16_nt(v, hrow, lane); load_row_bf16_nt(a, mrow, lane); } else { load_row_bf16(v, hrow, lane); load_row_bf16(a, mrow, lane); }
#pragma unroll
    for (int j = 0; j < 4; ++j) v[j] = v[j] * DN_ALPHA + a[j];
}
__device__ __forceinline__ void ln_phase(Frame& F, const float* g, const float* b) {
    int r0, r1;
    r0 = (int)(((long)F.vcu * M) / F.G); r1 = (int)(((long)(F.vcu + 1) * M) / F.G);
#pragma unroll 2
    for (int m = r0 + F.wave; m < r1; m += NWAVES) { f32x4 v[4]; bf16* hrow = (bf16*)(F.ws + WS_HB) + (size_t)m * D; resid_row<true>(v, hrow, (const bf16*)(F.ws + WS_QM) + (size_t)m * D, F.lane);
        ln_row(v, g, b, F.lane); store_row_bf16(v, hrow, F.lane);
        { GAS unsigned* h8 = (GAS unsigned*)(F.ws + WS_HB8 + (size_t)m * D) + F.lane;
#pragma unroll
            for (int j = 0; j < 4; ++j) h8[64 * j] = pk4_fp8(v[j].x, v[j].y, v[j].z, v[j].w); } }
}
__device__ __forceinline__ void xattn_phase(Frame& F) {
    LAS unsigned char* tb0 = F.lds + RING_OFF;
    const bf16* QM = (const bf16*)(F.ws + WS_QM); const bf16* KM = (const bf16*)(F.ws + WS_KM); const bf16* VMT = (const bf16*)(F.ws + WS_VMT); bf16* OB = (bf16*)(F.ws + WS_OB);
    const int c = F.lane & 31, h5 = F.lane >> 5;
    const int tr = F.tid >> 5, tc = F.tid & 31;
    const int kr = F.tid >> 4, kc = F.tid & 15;
    constexpr int TBUF = 34816;
    for (int L = (int)blockIdx.x; L < NB * 4 * 16; L += F.G) {
        int pm_, pn_; pg8::tile_order(L, 128, 4, pm_, pn_);
        const int b = pm_ >> 4, h = pn_, qt = pm_ & 15;
        const size_t rowq = (size_t)b * T_ + 256 * qt + 32 * F.wave + c;
        const bf16* qp = QM + rowq * D + h * 256 + 8 * h5;
        const bf16* ksrc = KM + ((size_t)b * NMEM + kr) * D + h * 256 + 8 * kc;
        const int kw0 = kr * 272 + kc * 16, kw1 = (kr + 32) * 272 + kc * 16;
        const bf16* vsrc = VMT + ((size_t)h * 256 + tr) * (size_t)MM + (size_t)b * NMEM + 8 * tc;
        int vw[4];
#pragma unroll
        for (int j = 0; j < 4; ++j) vw[j] = (tr + 16 * j) * 528 + tc * 16;
        u32x4 st[2][4];
#define XA_LOAD(t) do { if ((t) < 8) { const bf16* p_ = ksrc + (size_t)(64 * ((t) & 3)) * D + 128 * ((t) >> 2); st[(t) & 1][0] = *(const GAS u32x4*)p_; st[(t) & 1][1] = *(const GAS u32x4*)(p_ + (size_t)32 * D); } \
        else { _Pragma("unroll") for (int j_ = 0; j_ < 4; ++j_) st[(t) & 1][j_] = *(const GAS u32x4*)(vsrc + (size_t)(64 * ((t) - 8) + 16 * j_) * MM); } } while (0)
#define XA_WRITE(t) do { LAS unsigned char* nb_ = tb0 + ((t) % 3) * TBUF; if ((t) < 8) { *(LAS u32x4*)(nb_ + kw0) = st[(t) & 1][0]; *(LAS u32x4*)(nb_ + kw1) = st[(t) & 1][1]; } \
        else { _Pragma("unroll") for (int j_ = 0; j_ < 4; ++j_) *(LAS u32x4*)(nb_ + vw[j_]) = st[(t) & 1][j_]; } } while (0)
        __syncthreads();
        XA_LOAD(0); XA_LOAD(1); XA_WRITE(0);
        LDS_WAIT(); __syncthreads();
        f32x16 sacc[8]; bf16x8 qf[8]; bf16x8 pb[8][2]; float inv = 0.f;
        unsigned char* ob0 = (unsigned char*)OB + ((size_t)b * T_ + 256 * qt + 32 * F.wave) * D + h * 256;
        LAS unsigned char* ost = tb0 + 3 * TBUF + F.wave * 2560;
#pragma unroll
        for (int i = 0; i < 12; ++i) {
            LAS unsigned char* buf = tb0 + (i % 3) * TBUF;
            if (i + 2 < 12) XA_LOAD(i + 2);
            if (i < 8) { const int dh = i >> 2, kp = i & 3;
                if (kp == 0) {
#pragma unroll
                    for (int s_ = 0; s_ < 8; ++s_) qf[s_] = *(const GAS bf16x8*)(qp + 128 * dh + 16 * s_); }
#pragma unroll
                for (int k2 = 0; k2 < 2; ++k2) { const int kt = 2 * kp + k2;
                    f32x16 a;
                    if (dh == 0) {
#pragma unroll
                        for (int r = 0; r < 16; ++r) a[r] = 0.f; }
                    else a = sacc[kt];
#pragma unroll
                    for (int s_ = 0; s_ < 8; ++s_) { const bf16x8 kf = *(const LAS bf16x8*)(buf + c * 272 + h5 * 16 + (32 * k2 * 272 + 32 * s_)); a = __builtin_amdgcn_mfma_f32_32x32x16_bf16(kf, qf[s_], a, 0, 0, 0); }
                    sacc[kt] = a; }
            } else { const int dp = i - 8;
                if (dp == 0) {
                    float mx = sacc[0][0];
#pragma unroll
                    for (int kt = 0; kt < 8; ++kt)
#pragma unroll
                        for (int r = 0; r < 16; ++r) mx = fmaxf(mx, sacc[kt][r]);
                    mx = fmaxf(mx, __shfl_xor(mx, 32));
                    float sum = 0.f;
#pragma unroll
                    for (int kt = 0; kt < 8; ++kt) { float p[16];
#pragma unroll
                        for (int r = 0; r < 16; ++r) { p[r] = __builtin_amdgcn_exp2f(sacc[kt][r] - mx); sum += p[r]; }
                        pb[kt][0] = pack8(p); pb[kt][1] = pack8(p + 8); }
                    sum += __shfl_xor(sum, 32);
                    inv = OB_SC / sum; }
#pragma unroll
                for (int d2 = 0; d2 < 2; ++d2) { const int dt = 2 * dp + d2;
                    f32x16 o;
#pragma unroll
                    for (int r = 0; r < 16; ++r) o[r] = 0.f;
#pragma unroll
                    for (int kt = 0; kt < 8; ++kt)
#pragma unroll
                        for (int s2 = 0; s2 < 2; ++s2) { const LAS unsigned char* rp = buf + c * 528 + 8 * h5 + (32 * d2 * 528 + (4 * kt + 2 * s2) * 16);
                            const u32x2 v0 = *(const LAS u32x2*)rp, v1 = *(const LAS u32x2*)(rp + 16);
                            o = __builtin_amdgcn_mfma_f32_32x32x16_bf16(__builtin_bit_cast(bf16x8, (u32x4){v0.x, v0.y, v1.x, v1.y}), pb[kt][s2], o, 0, 0, 0); }
#pragma unroll
                    for (int g = 0; g < 4; ++g) *(LAS unsigned*)(ost + c * 80 + 32 * d2 + 8 * g + 4 * h5) = pk4_fp8(o[4 * g] * inv, o[4 * g + 1] * inv, o[4 * g + 2] * inv, o[4 * g + 3] * inv); }
#pragma unroll
                for (int q2 = 0; q2 < 2; ++q2) { const int ci = F.lane + 64 * q2, rr = ci >> 2, pc = ci & 3;
                    *(GAS u32x4*)(ob0 + (size_t)rr * D + 64 * dp + 16 * pc) = *(const LAS u32x4*)(ost + rr * 80 + 16 * pc); }
            }
            if (i + 1 < 12) XA_WRITE(i + 1);
            LDS_WAIT(); __syncthreads();
        }
#undef XA_LOAD
#undef XA_WRITE
    }
}
typedef float f32x4v __attribute__((ext_vector_type(4)));
constexpr int P8_PITCH = 3088;
constexpr int P8_DT = 32 * P8_PITCH, P8_DS = P8_DT + 8 * 32 * 32 * 4, P8_ST = P8_DS + 128 * 32 * 4, P8_LCNT = P8_ST + 1024, P8_REC = P8_DT;
static_assert(P8_LCNT + 512 <= TB_OFF, "router phase LDS map");
__device__ __forceinline__ void ln2_router_phase(Frame& F) {
    typedef float f32x2w __attribute__((ext_vector_type(2)));
    LAS unsigned char* raw = F.lds;
    LAS float* dt = (LAS float*)(F.lds + P8_DT);
    LAS f32x2w* stl = (LAS f32x2w*)(F.lds + P8_ST);
    LAS float* ds = (LAS float*)(F.lds + P8_DS);
    LAS int* lcnt = (LAS int*)(F.lds + P8_LCNT);
    LAS int* rec = (LAS int*)(F.lds + P8_REC);
    const int fr = F.lane & 15, fq = F.lane >> 4;
    bf16x8 wh0[4], wh1[4], wl0[4], wl1[4];
    { const bf16* wp = (const bf16*)(F.ws + WS_WR) + fr * WR_STRIDE + 128 * F.wave + 8 * fq;
#pragma unroll
        for (int s_ = 0; s_ < 4; ++s_) { wh0[s_] = *(const GAS bf16x8*)(wp + 32 * s_); wh1[s_] = *(const GAS bf16x8*)(wp + 16 * WR_STRIDE + 32 * s_);
            wl0[s_] = *(const GAS bf16x8*)(wp + 32 * WR_STRIDE + 32 * s_); wl1[s_] = *(const GAS bf16x8*)(wp + 48 * WR_STRIDE + 32 * s_); } }
    f32x4 gg[4], bb[4];
#pragma unroll
    for (int j = 0; j < 4; ++j) { gg[j] = ((const GAS f32x4*)F.in[I_LN2_G])[F.lane + 64 * j]; bb[j] = ((const GAS f32x4*)F.in[I_LN2_B])[F.lane + 64 * j]; }
    const float* stv = (const float*)(F.ws + WS_WR + WR_ST_OFF);
    const f32x4 s0 = *(const GAS f32x4*)(stv + 4 * fq), s1 = *(const GAS f32x4*)(stv + 16 + 4 * fq), t0 = *(const GAS f32x4*)(stv + NE + 4 * fq), t1 = *(const GAS f32x4*)(stv + NE + 16 + 4 * fq);
    if (F.tid < 64) lcnt[F.tid] = 0;
    LDS_WAIT(); __syncthreads();
    const bf16* H1 = (const bf16*)(F.ws + WS_HB); const unsigned char* CA = F.ws + WS_QM; bf16* H2 = (bf16*)(F.ws + WS_HB2);
    int* ltok = (int*)(F.ws + WS_LTOK); float* lgate = (float*)(F.ws + WS_LGATE); int* sidx = (int*)(F.ws + WS_SIDX);
    for (int rb = F.vcu; rb < M / 128; rb += F.G) {
        u32x2 hr[4][4]; unsigned cq[4][4];
#define P8_LOAD(mb_) do { _Pragma("unroll") for (int i_ = 0; i_ < 4; ++i_) { const int m_ = (mb_) + 4 * F.wave + i_; const GAS u32x2* xr_ = (const GAS u32x2*)(H1 + (size_t)m_ * D) + F.lane; const GAS unsigned* cr_ = (const GAS unsigned*)(CA + (size_t)m_ * D) + F.lane; \
            _Pragma("unroll") for (int j_ = 0; j_ < 4; ++j_) { hr[i_][j_] = xr_[64 * j_]; cq[i_][j_] = cr_[64 * j_]; } } } while (0)
        P8_LOAD(rb * 128);
#pragma unroll
        for (int sb = 0; sb < 4; ++sb) { const int mb = rb * 128 + sb * 32;
            {
#pragma unroll
                for (int i = 0; i < 4; ++i) { const int r = 4 * F.wave + i, m = mb + r; LAS unsigned char* rp = raw + r * P8_PITCH;
                    f32x4 v[4];
#pragma unroll
                    for (int j = 0; j < 4; ++j) { const u32x2 w2 = hr[i][j]; const unsigned w = cq[i][j];
                        *(LAS u32x2*)(rp + (4 * F.lane + 256 * j) * 2) = w2; *(LAS unsigned*)(rp + 2048 + 4 * F.lane + 256 * j) = w;
                        const f32x2w lo = __builtin_amdgcn_cvt_pk_f32_fp8((int)w, false), hi = __builtin_amdgcn_cvt_pk_f32_fp8((int)w, true);
                        v[j] = (f32x4){bflo(w2.x), bfhi(w2.x), bflo(w2.y), bfhi(w2.y)} * DN_ALPHA + (f32x4){lo.x, lo.y, hi.x, hi.y} * (1.0f / CA_SC); }
                    float a1 = 0.f;
#pragma unroll
                    for (int j = 0; j < 4; ++j) a1 += (v[j].x + v[j].y) + (v[j].z + v[j].w);
                    const float mean = wave_sum(a1) * (1.f / D); float a2 = 0.f;
#pragma unroll
                    for (int j = 0; j < 4; ++j) { v[j] = v[j] - mean; a2 += (v[j].x * v[j].x + v[j].y * v[j].y) + (v[j].z * v[j].z + v[j].w * v[j].w); }
                    const float rstd = 1.f / sqrtf(wave_sum(a2) * (1.f / D) + LN_EPS);
                    if (F.lane == 0) stl[sb * 32 + r] = (f32x2w){mean, rstd};
#pragma unroll
                    for (int j = 0; j < 4; ++j) v[j] = v[j] * rstd * gg[j] + bb[j];
                    store_row_bf16(v, H2 + (size_t)m * D, F.lane);
                    { GAS unsigned* h8 = (GAS unsigned*)(F.ws + WS_HB8 + (size_t)m * D) + F.lane;
#pragma unroll
                        for (int j = 0; j < 4; ++j) h8[64 * j] = pk4_fp8(v[j].x, v[j].y, v[j].z, v[j].w); } } }
            if (sb + 1 < 4) P8_LOAD(mb + 32);
            LDS_WAIT(); __builtin_amdgcn_s_barrier(); asm volatile("" ::: "memory");
#pragma unroll
            for (int rt = 0; rt < 2; ++rt) { f32x4v ah0 = {0.f, 0.f, 0.f, 0.f}, ah1 = {0.f, 0.f, 0.f, 0.f}, ac0 = {0.f, 0.f, 0.f, 0.f}, ac1 = {0.f, 0.f, 0.f, 0.f};
                const LAS unsigned char* rp = raw + (16 * rt + fr) * P8_PITCH;
#pragma unroll
                for (int s_ = 0; s_ < 4; ++s_) { const int col = 128 * F.wave + 32 * s_ + 8 * fq;
                    const bf16x8 bh = *(const LAS bf16x8*)(rp + 2 * col); const u32x2 cv = *(const LAS u32x2*)(rp + 2048 + col);
                    const f32x2w c01 = __builtin_amdgcn_cvt_pk_f32_fp8((int)cv.x, false), c23 = __builtin_amdgcn_cvt_pk_f32_fp8((int)cv.x, true), c45 = __builtin_amdgcn_cvt_pk_f32_fp8((int)cv.y, false), c67 = __builtin_amdgcn_cvt_pk_f32_fp8((int)cv.y, true);
                    const bf16x8 bc = __builtin_bit_cast(bf16x8, (u32x4){pk2(c01.x, c01.y), pk2(c23.x, c23.y), pk2(c45.x, c45.y), pk2(c67.x, c67.y)});
                    ah0 = __builtin_amdgcn_mfma_f32_16x16x32_bf16(wh0[s_], bh, ah0, 0, 0, 0); ah1 = __builtin_amdgcn_mfma_f32_16x16x32_bf16(wh1[s_], bh, ah1, 0, 0, 0);
                    ac0 = __builtin_amdgcn_mfma_f32_16x16x32_bf16(wh0[s_], bc, ac0, 0, 0, 0); ac1 = __builtin_amdgcn_mfma_f32_16x16x32_bf16(wh1[s_], bc, ac1, 0, 0, 0);
                    ah0 = __builtin_amdgcn_mfma_f32_16x16x32_bf16(wl0[s_], bh, ah0, 0, 0, 0); ah1 = __builtin_amdgcn_mfma_f32_16x16x32_bf16(wl1[s_], bh, ah1, 0, 0, 0);
                    ac0 = __builtin_amdgcn_mfma_f32_16x16x32_bf16(wl0[s_], bc, ac0, 0, 0, 0); ac1 = __builtin_amdgcn_mfma_f32_16x16x32_bf16(wl1[s_], bc, ac1, 0, 0, 0); }
                LAS float* dp = dt + (F.wave * 32 + 16 * rt + fr) * 32 + 4 * fq;
                *(LAS f32x4*)dp = (f32x4){ah0[0], ah0[1], ah0[2], ah0[3]} * DN_ALPHA + (f32x4){ac0[0], ac0[1], ac0[2], ac0[3]} * (1.0f / CA_SC);
                *(LAS f32x4*)(dp + 16) = (f32x4){ah1[0], ah1[1], ah1[2], ah1[3]} * DN_ALPHA + (f32x4){ac1[0], ac1[1], ac1[2], ac1[3]} * (1.0f / CA_SC); }
            LDS_WAIT(); __builtin_amdgcn_s_barrier(); asm volatile("" ::: "memory");
            { const int row = F.tid >> 4, e2 = 2 * (F.tid & 15); f32x2w acc2 = (f32x2w){0.f, 0.f};
#pragma unroll
                for (int w = 0; w < 8; ++w) acc2 = acc2 + *(const LAS f32x2w*)(dt + (w * 32 + row) * 32 + e2);
                *(LAS f32x2w*)(ds + (sb * 32 + row) * 32 + e2) = acc2; }
        }
        LDS_WAIT(); __builtin_amdgcn_s_barrier(); asm volatile("" ::: "memory");
        { const int row = 16 * F.wave + fr; const f32x2w st = stl[row];
            const f32x4 d0 = *(const LAS f32x4*)(ds + row * 32 + 4 * fq), d1 = *(const LAS f32x4*)(ds + row * 32 + 16 + 4 * fq);
            float cand[8]; int eid[8];
#pragma unroll
            for (int r = 0; r < 4; ++r) { cand[r] = st.y * (d0[r] - st.x * s0[r]) + t0[r]; cand[4 + r] = st.y * (d1[r] - st.x * s1[r]) + t1[r]; eid[r] = 4 * fq + r; eid[4 + r] = 16 + 4 * fq + r; }
            float tv[TOPK]; int te[TOPK];
#pragma unroll
            for (int k = 0; k < TOPK; ++k) {
                float bv = cand[0]; int bi = eid[0];
#pragma unroll
                for (int r = 1; r < 8; ++r) if (cand[r] > bv) { bv = cand[r]; bi = eid[r]; }
#pragma unroll
                for (int o = 16; o <= 32; o <<= 1) { const float ov = __shfl_xor(bv, o); const int oi = __shfl_xor(bi, o); if (ov > bv || (ov == bv && oi < bi)) { bv = ov; bi = oi; } }
                tv[k] = bv; te[k] = bi;
#pragma unroll
                for (int r = 0; r < 8; ++r) if (eid[r] == bi) cand[r] = -INFINITY;
            }
            float pe[TOPK], ps = 0.f;
#pragma unroll
            for (int k = 0; k < TOPK; ++k) { pe[k] = __expf(tv[k] - tv[0]); ps += pe[k]; }
            if (fq == 0) {
#pragma unroll
                for (int k = 0; k < TOPK; ++k) { const int lr = __hip_atomic_fetch_add(lcnt + te[k], 1, __ATOMIC_RELAXED, __HIP_MEMORY_SCOPE_WORKGROUP);
                    LAS int* r = rec + (row * 4 + k) * 4; r[0] = te[k]; r[1] = lr; r[2] = __builtin_bit_cast(int, pe[k] / ps); r[3] = rb * 128 + row; } } }
        LDS_WAIT(); __syncthreads();
#undef P8_LOAD
        if (F.tid < NE) lcnt[32 + F.tid] = (int)__hip_atomic_fetch_add(F.ctl + CW_ECNT + 64 * F.tid, (unsigned)lcnt[F.tid], RLX_AGENT);
        LDS_WAIT(); __syncthreads();
        { const LAS int* r = rec + (F.wave * 64 + F.lane) * 4; const int e = r[0], pos = lcnt[32 + e] + r[1], tok = r[3];
            if (pos < LCAP) { ltok[e * LCAP + pos] = tok; lgate[e * LCAP + pos] = __builtin_bit_cast(float, r[2]); } sidx[tok * 4 + (F.lane & 3)] = e * LCAP + pos; }
        __syncthreads();
        if (F.tid < 64) lcnt[F.tid] = 0;
        LDS_WAIT(); __syncthreads();
    }
}
__device__ __forceinline__ void final_phase(Frame& F, const LAS int* tb) {
    const int gw = F.vcu * NWAVES + F.wave, NGW = F.G * NWAVES;
    const int* sidx = (const int*)(F.ws + WS_SIDX); const unsigned char* YS = F.ws + WS_YS; const float* lgate = (const float*)(F.ws + WS_LGATE);
    typedef float f32x2v __attribute__((ext_vector_type(2)));
    f32x4 g3[4], b3[4];
#pragma unroll
    for (int j = 0; j < 4; ++j) { g3[j] = ((const GAS f32x4*)F.in[I_LN3_G])[F.lane + 64 * j]; b3[j] = ((const GAS f32x4*)F.in[I_LN3_B])[F.lane + 64 * j]; }
    for (int m0 = gw; m0 < M; m0 += 2 * NGW) {
        const int mr[2] = {m0, (m0 + NGW < M) ? m0 + NGW : m0};
        int si[2][TOPK]; float gk[2][TOPK]; size_t slot[2][TOPK];
#pragma unroll
        for (int r = 0; r < 2; ++r)
#pragma unroll
            for (int k = 0; k < TOPK; ++k) si[r][k] = sidx[mr[r] * 4 + k];
#pragma unroll
        for (int r = 0; r < 2; ++r)
#pragma unroll
            for (int k = 0; k < TOPK; ++k) { const int e = si[r][k] / LCAP, pos = si[r][k] - e * LCAP; slot[r][k] = (size_t)tb[e] * 256 + pos; gk[r][k] = lgate[si[r][k]]; }
        u32x2 hw[2][4]; unsigned yw[2][TOPK][4];
#pragma unroll
        for (int r = 0; r < 2; ++r) { const GAS u32x2* hp = (const GAS u32x2*)((const bf16*)(F.ws + WS_HB2) + (size_t)mr[r] * D) + F.lane;
#pragma unroll
            for (int j = 0; j < 4; ++j) hw[r][j] = __builtin_nontemporal_load(hp + 64 * j);
#pragma unroll
            for (int k = 0; k < TOPK; ++k) { const GAS unsigned* yp = (const GAS unsigned*)(YS + slot[r][k] * D) + F.lane;
#pragma unroll
                for (int j = 0; j < 4; ++j) yw[r][k][j] = __builtin_nontemporal_load(yp + 64 * j); } }
#pragma unroll
        for (int r = 0; r < 2; ++r) { if (r == 1 && mr[1] == m0) break;
            f32x4 v[4];
#pragma unroll
            for (int j = 0; j < 4; ++j) { f32x4 sacc = {0.f, 0.f, 0.f, 0.f};
#pragma unroll
                for (int k = 0; k < TOPK; ++k) { const unsigned w = yw[r][k][j]; const f32x2v lo = __builtin_amdgcn_cvt_pk_f32_fp8((int)w, false), hi = __builtin_amdgcn_cvt_pk_f32_fp8((int)w, true);
                    sacc = sacc + (f32x4){lo.x, lo.y, hi.x, hi.y} * gk[r][k]; }
                v[j] = (f32x4){bflo(hw[r][j].x), bfhi(hw[r][j].x), bflo(hw[r][j].y), bfhi(hw[r][j].y)} * DN_ALPHA + sacc * (1.0f / YS_SC); }
            ln_row_r(v, g3, b3); store_row_f32_nt(v, F.hf + (size_t)mr[r] * D, F.lane); }
    }
}

struct Args { const float* in[N_IN]; float* out; unsigned char* ws; int ph_lo, ph_hi, li, pad; };
__global__ void __launch_bounds__(NWAVES * 64, 2) mk_fwd(Args args) {
    extern __shared__ __attribute__((aligned(16))) unsigned char lds[];
    Frame F;
    F.lds = (LAS unsigned char*)lds; F.MISC = (volatile LAS unsigned*)(F.lds + MISC_OFF);
    F.tid = threadIdx.x; F.lane = F.tid & 63; F.wave = __builtin_amdgcn_readfirstlane(F.tid >> 6);
    F.G = gridDim.x; { const int bx = blockIdx.x; F.vcu = (F.G % 8 == 0) ? (bx % 8) * (F.G / 8) + bx / 8 : bx; }
    F.ws = args.ws; F.ctl = (gu32*)(args.ws + WS_CTL); F.hf = args.out; F.in = args.in;
    for (int u = F.tid; u < (LDS_BYTES - LDSCTL_OFF) / 4; u += NWAVES * 64) ((LAS unsigned*)(F.lds + LDSCTL_OFF))[u] = 0u;
    __syncthreads();
    XcdBarrier bar; bar.bar = (unsigned*)(F.ctl + CW_BAR) + args.li * XCD_BAR_WORDS; bar.x = 0; bar.st = nullptr;
    const int lo = args.ph_lo, hi = args.ph_hi;
    if (hi - lo > 1) bar = xcd_barrier_post((unsigned*)(F.ctl + CW_BAR) + args.li * XCD_BAR_WORDS, F.MISC + 8);
#ifndef PH_MASK
#define PH_MASK 0xfff
#endif
#define IN(k) (((PH_MASK >> (k)) & 1) && lo <= (k) && (k) < hi)
#ifndef REP_MASK
#define REP_MASK 0
#endif
#define REPS(k) (1 + ((REP_MASK >> (k)) & 1))
#define PH_BEGIN() do { int t_ = threadIdx.x; asm volatile("" : "+v"(t_)); F.tid = t_; F.lane = t_ & 63; } while (0)
#define SEAM(k) do { if (IN(k) && IN((k) + 1)) xcd_barrier(bar); } while (0)
    const char* wsb = (const char*)args.ws;
    LAS int* tb = (LAS int*)(F.lds + TB_OFF);

    if (IN(0)) for (int rep = 0; rep < REPS(0); ++rep) { PH_BEGIN(); p0_prologue(F); __syncthreads(); } SEAM(0);
    if (IN(1)) for (int rep = 0; rep < REPS(1); ++rep) { PH_BEGIN(); SchedP1 S{F.G, (int)blockIdx.x}; EpiP1 E{F.ws, F.in[I_B_IN]};
        pg8::gemm_phase<EpiP1, SchedP1, false>(F.lds + RING_OFF, wsb, D, D, D, S, E, nullptr); } SEAM(1);
    if (IN(2)) { PH_BEGIN();
        { SchedKV S{(int)blockIdx.x}; EpiP1 E{F.ws, F.in[I_B_IN]};
            pg8::gemm_phase<EpiP1, SchedKV, false>(F.lds + RING_OFF, wsb, D, D, D, S, E, nullptr); }
        __syncthreads(); PH_BEGIN();
        LAS int* p2s = (LAS int*)(F.lds + P2_SYNC);
        if (F.tid < 2) p2s[F.tid] = 0;
        LDS_WAIT(); __syncthreads();
        if (F.wave >= NATT) { if (!(args.pad & 4)) {
            constexpr int NSW = NWAVES - NATT; const int w = F.wave - NATT;
            if (F.G == 256 && NSW == 2) { constexpr int CUT = 128 * 39;
                if ((int)blockIdx.x < 64) expert_stream(F, (int)blockIdx.x * NSW + w, 128, CUT, F.lds + P2_PRIV + (F.wave - 4) * 16384);
                else expert_stream(F, CUT + ((int)blockIdx.x - 64) * NSW + w, 384, N_EXPERT_ITEMS, F.lds + P2_PRIV + (F.wave - 4) * 16384); }
            else expert_stream(F, F.vcu * NSW + w, F.G * NSW, N_EXPERT_ITEMS, F.lds + P2_PRIV + (F.wave - 4) * 16384); } }
        else {
            if (F.wave < 4 && !(args.pad & 1)) conv_phase4(F);
            if (!(args.pad & 8)) {
                LAS unsigned char* wbuf = F.wave < 4 ? F.lds + F.wave * 16384 : F.lds + P2_PRIV + (F.wave - 4) * 16384;
                const int ntask = NB * SBH * (T_ / 32), tpw = (ntask + F.G - 1) / F.G, t0 = F.vcu * tpw, t1 = (t0 + tpw < ntask) ? t0 + tpw : ntask;
                for (;;) { int j = 0; if (F.lane == 0) j = __hip_atomic_fetch_add(p2s + 1, 1, __ATOMIC_RELAXED, __HIP_MEMORY_SCOPE_WORKGROUP);
                    const int tk = t0 + __builtin_amdgcn_readfirstlane(j); if (tk >= t1) break;
                    sb_attn_wave(F, (tk >> 7) >> 3, (tk >> 7) & 7, tk & 127, wbuf); } }
        }
    } SEAM(2);
    if (IN(3)) {
        EpiLn1 E{F.ws, F.ctl, F.in[I_B_OUT], F.in[I_LN1_G], F.in[I_LN1_B], F.lds + XTRA_OFF, 1.0f / (WOUT_SC * MIX_SC)};
        const bool gh_first = (((int)blockIdx.x & 7) >= 4);
        if (gh_first) { PH_BEGIN(); SchedGH S{F.G, (int)blockIdx.x}; EpiGH E2{F.ws};
            pg8::gemm_phase<EpiGH, SchedGH, false>(F.lds + RING_OFF, wsb, D, D, 256, S, E2, nullptr); __syncthreads(); }
        { PH_BEGIN(); SchedOne S{(int)blockIdx.x, 128, 4, (unsigned)WS_MIXIN, (unsigned)WS_WOUT_T, TSTEP / 2, TSTEP / 2};
            pg8::gemm_phase<EpiLn1, SchedOne, false, true>(F.lds + RING_OFF, wsb, D / 2, D / 2, D / 2, S, E, nullptr); }
        __syncthreads();
        { PH_BEGIN(); SchedOne S{(int)blockIdx.x + F.G, 128, 4, (unsigned)WS_MIXIN, (unsigned)WS_WOUT_T, TSTEP / 2, TSTEP / 2};
            pg8::gemm_phase<EpiLn1, SchedOne, false, true>(F.lds + RING_OFF, wsb, D / 2, D / 2, D / 2, S, E, nullptr); }
        if (!gh_first) { __syncthreads(); PH_BEGIN(); SchedGH S{F.G, (int)blockIdx.x}; EpiGH E2{F.ws};
            pg8::gemm_phase<EpiGH, SchedGH, false>(F.lds + RING_OFF, wsb, D, D, 256, S, E2, nullptr); }
    } SEAM(3);
    if (IN(5)) { PH_BEGIN(); int parity = 0;
        SchedPlain S{F.G, (int)blockIdx.x, 128, 4, (unsigned)WS_HB8, (unsigned)WS_G8, TSTEP / 2, TSTEP / 2, 0u, 0u, (unsigned)(1 * MiB)}; EpiSoftmax E{F.ws + WS_P8, F.lds + XTRA_OFF, &parity};
        pg8::gemm_phase<EpiSoftmax, SchedPlain, false, true>(F.lds + RING_OFF, wsb, D / 2, D / 2, D / 2, S, E, nullptr); } SEAM(5);
    if (IN(7)) { PH_BEGIN(); SchedPlain S{F.G, (int)blockIdx.x, 128, 4, (unsigned)WS_P8, (unsigned)WS_H8, TSTEP / 2, TSTEP / 2, 0u, 0u, (unsigned)(1 * MiB)}; EpiFp8 E{F.ws + WS_QM, D, CA_SC / (H_SC * P_SC)};
        pg8::gemm_phase<EpiFp8, SchedPlain, false, true>(F.lds + RING_OFF, wsb, D / 2, D / 2, D / 2, S, E, nullptr); } SEAM(7);
    if (IN(8)) { PH_BEGIN(); ln2_router_phase(F); } SEAM(8);
    if (IN(9)) for (int rep = 0; rep < REPS(9); ++rep) { PH_BEGIN(); moe_table(F, tb); moe_units(F, tb, tb + 704, 8, (unsigned)WS_HB8, (unsigned)WS_WGU_T, 2048u * 1024u, true);
        SchedMoe S{tb + 704}; EpiAct E{F.ws + WS_ACT, F.in[I_B_GU]};
        pg8::gemm_phase<EpiAct, SchedMoe, true, true>(F.lds + RING_OFF, wsb, D / 2, D / 2, D / 2, S, E, (const int*)(F.ws + WS_LTOK)); } SEAM(9);
    if (IN(10)) for (int rep = 0; rep < REPS(10); ++rep) { PH_BEGIN(); if (!IN(9)) moe_table(F, tb);
        moe_units(F, tb, tb + 704, 4, (unsigned)WS_ACT, (unsigned)WS_WDN_T, 1024u * 1024u, false);
        SchedMoe S{tb + 704}; EpiDown E{F.ws + WS_YS, F.in[I_B_DOWN]};
        pg8::gemm_phase<EpiDown, SchedMoe, false, true>(F.lds + RING_OFF, wsb, D / 2, D / 2, D / 2, S, E, nullptr); } SEAM(10);
    if (IN(11)) { PH_BEGIN(); if (!IN(10)) moe_table(F, tb); final_phase(F, tb); }
#undef IN
#undef SEAM
}

extern "C" void kernel_launch(void* const* d_in, const int* in_sizes, int n_in, void* d_out, int out_size, void* d_ws, size_t ws_size, hipStream_t stream) {
    static int grid = 0;
    if (grid == 0) {
        if (n_in != N_IN || out_size != M * D || ws_size < WS_END) { fprintf(stderr, "kernel_launch: unexpected shapes (n_in %d, out %d, ws %zu)\n", n_in, out_size, ws_size); grid = -1; return; }
        int dev = 0, cus = 0, per_cu = 0;
        if (hipGetDevice(&dev) != hipSuccess || hipDeviceGetAttribute(&cus, hipDeviceAttributeMultiprocessorCount, dev) != hipSuccess) { grid = -1; return; }
        if (hipFuncSetAttribute((const void*)mk_fwd, hipFuncAttributeMaxDynamicSharedMemorySize, LDS_BYTES) != hipSuccess) { fprintf(stderr, "kernel_launch: hipFuncSetAttribute failed\n"); grid = -1; return; }
        if (hipOccupancyMaxActiveBlocksPerMultiprocessor(&per_cu, (const void*)mk_fwd, NWAVES * 64, LDS_BYTES) != hipSuccess || per_cu < 1) fprintf(stderr, "kernel_launch: occupancy query says %d\n", per_cu);
        (void)hipGetLastError();
        grid = cus;
    }
    if (grid < 0) return;
    if (hipMemsetAsync((char*)d_ws + WS_CTL, 0, CTL_ZERO_BYTES, stream) != hipSuccess) return;
    Args a{};
    for (int i = 0; i < N_IN; ++i) a.in[i] = (const float*)d_in[i];
    a.out = (float*)d_out; a.ws = (unsigned char*)d_ws;
#ifdef PROBE_P2
    { a.ph_lo = 0; a.ph_hi = 3; a.li = 0; hipLaunchKernelGGL(mk_fwd, dim3(grid), dim3(NWAVES * 64), LDS_BYTES, stream, a);
      a.ph_lo = 2; a.ph_hi = 3; a.li = 1; a.pad = PROBE_P2; hipLaunchKernelGGL(mk_fwd, dim3(grid), dim3(NWAVES * 64), LDS_BYTES, stream, a); a.pad = 0;
      a.ph_lo = 3; a.ph_hi = NPHASE; a.li = 2; hipLaunchKernelGGL(mk_fwd, dim3(grid), dim3(NWAVES * 64), LDS_BYTES, stream, a); return; }
#endif
    constexpr int N_LAUNCH = (MK_N_LAUNCHES == 1) ? 1 : NPHASE;
    for (int li = 0; li < N_LAUNCH; ++li) {
        a.ph_lo = (N_LAUNCH == 1) ? 0 : li; a.ph_hi = (N_LAUNCH == 1) ? NPHASE : li + 1; a.li = (N_LAUNCH == 1) ? 0 : li;
        hipLaunchKernelGGL(mk_fwd, dim3(grid), dim3(NWAVES * 64), LDS_BYTES, stream, a);
        if (hipPeekAtLastError() != hipSuccess) { fprintf(stderr, "kernel_launch: launch %d failed\n", li); break; }
    }
#ifdef PROBE_PHASES
    { const int pp[] = {PROBE_PHASES}; for (int ph : pp) { a.ph_lo = ph; a.ph_hi = ph + 1; a.li = 15; hipLaunchKernelGGL(mk_fwd, dim3(grid), dim3(NWAVES * 64), LDS_BYTES, stream, a); } }
#endif
}
```
